# Optimizing an MI355X kernel written in HIP

```python
import jax
import jax.numpy as jnp
from jax import lax
import numpy as np

D_MODEL = 1024
BATCH = 2
SEQ = 8192
DEPTH = 2

GRID_W = 64
CTX_LEN = 256
N_MOD = 9
D_FF = ((8 * D_MODEL // 3 + 127) // 128) * 128
EPS = 1e-6

N_GROUPS = 4
GROUP_W = D_MODEL // N_GROUPS
MIX_W = N_GROUPS * GROUP_W

CONV_K = 31
LN_EPS = 1e-5
LRU_BLOCKS = 4
LRU_CONV_K = 4
LRU_C = 8.0
RWKV_HEAD = 64
RWKV_HEADS = GROUP_W // RWKV_HEAD
DECAY_LORA = 64
AAA_LORA = 64
GATE_LORA = 128
GN_EPS = 64e-5
QK_NOPE = 64
QK_ROPE = 32
V_HEAD = 64
MLA_HEADS = GROUP_W // V_HEAD
Q_LORA = 256
KV_LORA = 128
ROPE_BASE = 10000.0
Q_BLOCK = 128
SM_SCALE = (QK_NOPE + QK_ROPE) ** -0.5

A_COLS = 2 * GROUP_W
B_COLS = 2 * GROUP_W
C_COLS = 3 * GROUP_W + DECAY_LORA + AAA_LORA + GATE_LORA
D_COLS = Q_LORA + KV_LORA + QK_ROPE
IN_COLS = A_COLS + B_COLS + C_COLS + D_COLS
IN_SPLITS = (A_COLS, A_COLS + B_COLS, A_COLS + B_COLS + C_COLS)
RWKV_SPLITS = (GROUP_W, 2 * GROUP_W, 3 * GROUP_W, 3 * GROUP_W + DECAY_LORA,
               3 * GROUP_W + DECAY_LORA + AAA_LORA)

kernel_name = 'hybrid_parallel_group_dit_block'


def rms_norm(x, gain=None):
    xf = x.astype(jnp.float32)
    y = xf * lax.rsqrt(jnp.mean(xf * xf, axis=-1, keepdims=True) + EPS)
    if gain is not None:
        y = y * gain.astype(jnp.float32)
    return y.astype(x.dtype)


def layer_norm(x, gain, bias):
    xf = x.astype(jnp.float32)
    mu = jnp.mean(xf, axis=-1, keepdims=True)
    var = jnp.mean(jnp.square(xf - mu), axis=-1, keepdims=True)
    y = (xf - mu) * lax.rsqrt(var + LN_EPS)
    return (y * gain.astype(jnp.float32) + bias.astype(jnp.float32)).astype(x.dtype)


def group_norm_heads(y, gain, bias):
    yf = y.astype(jnp.float32)
    mu = jnp.mean(yf, axis=-1, keepdims=True)
    var = jnp.mean(jnp.square(yf - mu), axis=-1, keepdims=True)
    yn = (yf - mu) * lax.rsqrt(var + GN_EPS)
    g = gain.astype(jnp.float32).reshape(RWKV_HEADS, RWKV_HEAD)
    b = bias.astype(jnp.float32).reshape(RWKV_HEADS, RWKV_HEAD)
    return (yn * g + b).astype(y.dtype)


def l2_normalize(t):
    tf = t.astype(jnp.float32)
    return (tf * lax.rsqrt(jnp.maximum(jnp.sum(tf * tf, axis=-1, keepdims=True), 1e-24))).astype(t.dtype)


def modulate(x, shift, scale):
    return rms_norm(x) * (1 + scale) + shift


def swiglu(h, w13, w2):
    gate, up = jnp.split(h @ w13, 2, axis=-1)
    return (jax.nn.silu(gate) * up) @ w2


def depthwise_conv(x, w, b, pad_left, pad_right):
    y = lax.conv_general_dilated(
        x, w[:, None, :].astype(x.dtype), window_strides=(1,),
        padding=((pad_left, pad_right),), dimension_numbers=('NWC', 'WIO', 'NWC'),
        feature_group_count=x.shape[-1])
    return y + b


def token_shift(u, mu_prev, mu_next):
    zero = jnp.zeros_like(u[:, :1])
    prev = jnp.concatenate([zero, u[:, :-1]], axis=1)
    nxt = jnp.concatenate([u[:, 1:], zero], axis=1)
    return u + mu_prev * (prev - u) + mu_next * (nxt - u)


def linear_scan(a, b, h0, reverse):
    def combine(e1, e2):
        a1, b1 = e1
        a2, b2 = e2
        return a1 * a2, a2 * b1 + b2
    a_cum, h = lax.associative_scan(combine, (a, b), reverse=reverse, axis=1)
    return h + a_cum * h0[:, None, :]


def wkv7_scan(r, decay, k, v, kk, b, s0, reverse):
    def step(s, inp):
        r_t, w_t, k_t, v_t, kk_t, b_t = inp
        sa = jnp.einsum('bhvk,bhk->bhv', s, kk_t)
        s = s * w_t[:, :, None, :] - sa[..., None] * b_t[:, :, None, :] + v_t[..., None] * k_t[:, :, None, :]
        return s, jnp.einsum('bhvk,bhk->bhv', s, r_t)
    xs = tuple(jnp.moveaxis(t, 1, 0) for t in (r, decay, k, v, kk, b))
    s_final, ys = lax.scan(step, s0, xs, reverse=reverse)
    return jnp.moveaxis(ys, 0, 1), s_final


def axial_rope_tables(t_len, dtype):
    t = jnp.arange(t_len, dtype=jnp.int32)
    rows = (t // GRID_W).astype(jnp.float32)
    cols = (t % GRID_W).astype(jnp.float32)
    n_freq = QK_ROPE // 4
    inv_freq = ROPE_BASE ** (-jnp.arange(n_freq, dtype=jnp.float32) / n_freq)
    ang = jnp.stack([rows[:, None] * inv_freq, cols[:, None] * inv_freq], axis=1)
    ang = jnp.concatenate([ang, ang], axis=-1).reshape(t_len, QK_ROPE)
    return jnp.cos(ang).astype(dtype), jnp.sin(ang).astype(dtype)


def apply_rope(x, cos, sin):
    xs = x.reshape(x.shape[:-1] + (2, 2, QK_ROPE // 4))
    rot = jnp.stack([-xs[..., 1, :], xs[..., 0, :]], axis=-2).reshape(x.shape)
    return x * cos + rot * sin


def conformer_conv(u, dw_w, dw_b, ln_g, ln_b):
    val, gate = jnp.split(u, 2, axis=-1)
    z = val * jax.nn.sigmoid(gate)
    z = depthwise_conv(z, dw_w, dw_b, CONV_K // 2, CONV_K // 2)
    return jax.nn.silu(layer_norm(z, ln_g, ln_b))


def rglru_mixer(u, uc, need_ctx_out, conv_w, conv_b, w_a, b_a, w_x, b_x, lam):
    pad_l = LRU_CONV_K // 2
    pad_r = LRU_CONV_K - 1 - pad_l

    def prepare(v):
        xb, gb = jnp.split(v, 2, axis=-1)
        return depthwise_conv(xb, conv_w, conv_b, pad_l, pad_r), gb

    def gates(xv, d):
        xh = xv.reshape(xv.shape[:-1] + (LRU_BLOCKS, GROUP_W // LRU_BLOCKS))
        r = jax.nn.sigmoid(jnp.einsum('bthi,hij->bthj', xh, w_a[d]).reshape(xv.shape) + b_a[d])
        i = jax.nn.sigmoid(jnp.einsum('bthi,hij->bthj', xh, w_x[d]).reshape(xv.shape) + b_x[d])
        log_a = -LRU_C * r * jax.nn.softplus(-lam[d])
        return jnp.exp(log_a), jnp.sqrt(-jnp.expm1(2 * log_a)) * (i * xv)

    xl, gl = prepare(u)
    xc, gc = prepare(uc)
    outs_l, outs_c = [], []
    for d, rev in ((0, False), (1, True)):
        a_c, b_c = gates(xc, d)
        h_c = linear_scan(a_c, b_c, jnp.zeros_like(xc[:, 0]), rev)
        h_final = h_c[:, 0] if rev else h_c[:, -1]
        a_l, b_l = gates(xl, d)
        outs_l.append(linear_scan(a_l, b_l, h_final, rev))
        outs_c.append(h_c)
    y_l = (outs_l[0] + outs_l[1]) * jax.nn.gelu(gl)
    y_c = (outs_c[0] + outs_c[1]) * jax.nn.gelu(gc) if need_ctx_out else None
    return y_l, y_c


def rwkv7_mixer(u, uc, need_ctx_out, mu_prev, mu_next, w0, w_up, a0, a_up, g_up,
                k_k, k_a, r_k, gn_g, gn_b):
    def heads(t):
        return t.reshape(t.shape[:-1] + (RWKV_HEADS, RWKV_HEAD))

    def prepare(v):
        v = token_shift(v, mu_prev, mu_next)
        r, k, val, wd, ad, gd = jnp.split(v, RWKV_SPLITS, axis=-1)
        return heads(r), k, heads(val), jnp.tanh(wd), ad, gd, l2_normalize(heads(k * k_k))

    def run(p, d, reverse, s0):
        r, k, v, wd, ad, _, kk = p
        decay = jnp.exp(-jnp.exp(-jax.nn.softplus(-(w0[d] + wd @ w_up[d])) - 0.5))
        a = jax.nn.sigmoid(a0[d] + ad @ a_up[d])
        k_d = heads(k * (1 + (a - 1) * k_a))
        y, s = wkv7_scan(r, heads(decay), k_d, v, kk, kk * heads(a), s0, reverse)
        bonus = jnp.sum(r * k_d * r_k, axis=-1, keepdims=True) * v
        return y, bonus, s

    def readout(p, ys, bonuses):
        g = jax.nn.sigmoid(p[5]) @ g_up
        o = group_norm_heads(ys[0] + ys[1], gn_g, gn_b) + bonuses[0] + bonuses[1]
        return o.reshape(o.shape[:-2] + (GROUP_W,)) * g

    p_l = prepare(u)
    p_c = prepare(uc)
    s0 = jnp.zeros((u.shape[0], RWKV_HEADS, RWKV_HEAD, RWKV_HEAD), u.dtype)
    ys_l, bs_l, ys_c, bs_c = [], [], [], []
    for d, rev in ((0, False), (1, True)):
        y_c, b_c, s_c = run(p_c, d, rev, s0)
        y_l, b_l, _ = run(p_l, d, rev, s_c)
        ys_l.append(y_l)
        bs_l.append(b_l)
        ys_c.append(y_c)
        bs_c.append(b_c)
    out_l = readout(p_l, ys_l, bs_l)
    out_c = readout(p_c, ys_c, bs_c) if need_ctx_out else None
    return out_l, out_c


def mla_mixer(u, uc, need_ctx_out, q_norm, w_uq, kv_norm, w_ukv, cos, sin):
    def queries(v):
        cq = v[..., :Q_LORA]
        return (rms_norm(cq, q_norm) @ w_uq).reshape(v.shape[:2] + (MLA_HEADS, QK_NOPE + QK_ROPE))

    def keys_values(v):
        ckv = v[..., Q_LORA:Q_LORA + KV_LORA]
        k_rope = v[..., Q_LORA + KV_LORA:]
        kv = (rms_norm(ckv, kv_norm) @ w_ukv).reshape(v.shape[:2] + (MLA_HEADS, QK_NOPE + V_HEAD))
        return kv[..., :QK_NOPE], kv[..., QK_NOPE:], k_rope

    def assemble_k(k_nope, k_rope):
        k_rope = jnp.broadcast_to(k_rope[:, :, None, :], k_nope.shape[:-1] + (QK_ROPE,))
        return jnp.concatenate([k_nope, k_rope], axis=-1)

    def attend(q, k, v):
        s = jnp.einsum('bqhd,bkhd->bhqk', q, k, preferred_element_type=jnp.float32) * SM_SCALE
        p = jax.nn.softmax(s, axis=-1).astype(v.dtype)
        return jnp.einsum('bhqk,bkhd->bqhd', p, v)

    q = queries(u)
    q = jnp.concatenate([q[..., :QK_NOPE],
                         apply_rope(q[..., QK_NOPE:], cos[:, None, :], sin[:, None, :])], axis=-1)
    k_nope, v, k_rope = keys_values(u)
    k = assemble_k(k_nope, apply_rope(k_rope, cos, sin))
    k_nope_c, v_c, k_rope_c = keys_values(uc)
    k_c = assemble_k(k_nope_c, k_rope_c)
    k_all = jnp.concatenate([k, k_c], axis=1)
    v_all = jnp.concatenate([v, v_c], axis=1)
    bsz, t_len = q.shape[0], q.shape[1]
    q_blocks = jnp.moveaxis(q.reshape(bsz, t_len // Q_BLOCK, Q_BLOCK, MLA_HEADS, QK_NOPE + QK_ROPE), 1, 0)
    o = lax.map(lambda qb: attend(qb, k_all, v_all), q_blocks)
    o = jnp.moveaxis(o, 0, 1).reshape(bsz, t_len, MLA_HEADS * V_HEAD)
    o_c = None
    if need_ctx_out:
        o_c = attend(queries(uc), k_c, v_c).reshape(bsz, uc.shape[1], MLA_HEADS * V_HEAD)
    return o, o_c


def setup_inputs(seed: int = 0) -> dict:
    key = jax.random.key(seed)
    keys = list(jax.random.split(key, 48))

    def nrm(shape, scale):
        return jax.random.normal(keys.pop(), shape, jnp.float32) * scale

    def unif(shape, lo, hi):
        return jax.random.uniform(keys.pop(), shape, jnp.float32, lo, hi)

    L, D, G = DEPTH, D_MODEL, GROUP_W
    a8 = unif((L, 2, G), 0.9, 0.999)
    s = a8 ** (1.0 / LRU_C)
    lru_lambda = jnp.log(s) - jnp.log1p(-s)
    return {
        'x': nrm((BATCH, SEQ, D), 1.0),
        'c': nrm((BATCH, D), 1.0),
        'ctx': nrm((BATCH, CTX_LEN, D), 1.0),
        'c_ctx': nrm((D,), 1.0),
        'ada_w': nrm((L, D, N_MOD * D), 0.5 * D ** -0.5),
        'ada_b': nrm((L, N_MOD * D), 0.02),
        'ffn1_w13': nrm((L, D, 2 * D_FF), D ** -0.5),
        'ffn1_w2': nrm((L, D_FF, D), D_FF ** -0.5),
        'ffn2_w13': nrm((L, D, 2 * D_FF), D ** -0.5),
        'ffn2_w2': nrm((L, D_FF, D), D_FF ** -0.5),
        'w_in': nrm((L, D, IN_COLS), D ** -0.5),
        'w_out': nrm((L, MIX_W, D), MIX_W ** -0.5),
        'cv_dw_w': nrm((L, CONV_K, G), CONV_K ** -0.5),
        'cv_dw_b': nrm((L, G), 0.02),
        'cv_ln_g': 1.0 + nrm((L, G), 0.02),
        'cv_ln_b': nrm((L, G), 0.02),
        'lru_conv_w': nrm((L, LRU_CONV_K, G), LRU_CONV_K ** -0.5),
        'lru_conv_b': nrm((L, G), 0.02),
        'lru_wa': nrm((L, 2, LRU_BLOCKS, G // LRU_BLOCKS, G // LRU_BLOCKS), (G // LRU_BLOCKS) ** -0.5),
        'lru_ba': nrm((L, 2, G), 0.1),
        'lru_wx': nrm((L, 2, LRU_BLOCKS, G // LRU_BLOCKS, G // LRU_BLOCKS), (G // LRU_BLOCKS) ** -0.5),
        'lru_bx': nrm((L, 2, G), 0.1),
        'lru_lambda': lru_lambda,
        'rwkv_mu_prev': unif((L, C_COLS), 0.0, 0.5),
        'rwkv_mu_next': unif((L, C_COLS), 0.0, 0.5),
        'rwkv_w0': unif((L, 2, G), -6.0, 0.0),
        'rwkv_w_up': nrm((L, 2, DECAY_LORA, G), 0.1),
        'rwkv_a0': nrm((L, 2, G), 0.1),
        'rwkv_a_up': nrm((L, 2, AAA_LORA, G), 0.5 * AAA_LORA ** -0.5),
        'rwkv_g_up': nrm((L, GATE_LORA, G), GATE_LORA ** -0.5),
        'rwkv_k_k': 0.85 + nrm((L, G), 0.02),
        'rwkv_k_a': 1.0 + nrm((L, G), 0.02),
        'rwkv_r_k': nrm((L, RWKV_HEADS, RWKV_HEAD), 0.1),
        'rwkv_gn_g': 1.0 + nrm((L, G), 0.02),
        'rwkv_gn_b': nrm((L, G), 0.02),
        'mla_q_norm': 1.0 + nrm((L, Q_LORA), 0.02),
        'mla_w_uq': nrm((L, Q_LORA, MLA_HEADS * (QK_NOPE + QK_ROPE)), Q_LORA ** -0.5),
        'mla_kv_norm': 1.0 + nrm((L, KV_LORA), 0.02),
        'mla_w_ukv': nrm((L, KV_LORA, MLA_HEADS * (QK_NOPE + V_HEAD)), KV_LORA ** -0.5),
        'final_norm': 1.0 + nrm((D,), 0.02),
    }


def reference(x, c, ctx, c_ctx, ada_w, ada_b, ffn1_w13, ffn1_w2, ffn2_w13, ffn2_w2, w_in, w_out,
              cv_dw_w, cv_dw_b, cv_ln_g, cv_ln_b,
              lru_conv_w, lru_conv_b, lru_wa, lru_ba, lru_wx, lru_bx, lru_lambda,
              rwkv_mu_prev, rwkv_mu_next, rwkv_w0, rwkv_w_up, rwkv_a0, rwkv_a_up, rwkv_g_up,
              rwkv_k_k, rwkv_k_a, rwkv_r_k, rwkv_gn_g, rwkv_gn_b,
              mla_q_norm, mla_w_uq, mla_kv_norm, mla_w_ukv, final_norm):
    bsz, t_len, d_model = x.shape
    cos, sin = axial_rope_tables(t_len, x.dtype)
    silu_c = jax.nn.silu(c)
    silu_cc = jax.nn.silu(c_ctx)
    xc = ctx
    for l in range(DEPTH):
        need_ctx_out = l < DEPTH - 1
        mod = (silu_c @ ada_w[l] + ada_b[l]).reshape(bsz, N_MOD, 1, d_model)
        sh1, s1, g1, sh2, s2, g2, sh3, s3, g3 = [mod[:, i] for i in range(N_MOD)]
        mod_c = (silu_cc @ ada_w[l] + ada_b[l]).reshape(N_MOD, d_model)
        sh1c, s1c, g1c, sh2c, s2c, g2c, sh3c, s3c, g3c = [mod_c[i] for i in range(N_MOD)]

        x = x + 0.5 * g1 * swiglu(modulate(x, sh1, s1), ffn1_w13[l], ffn1_w2[l])
        xc = xc + 0.5 * g1c * swiglu(modulate(xc, sh1c, s1c), ffn1_w13[l], ffn1_w2[l])

        u = modulate(x, sh2, s2) @ w_in[l]
        uc = modulate(xc, sh2c, s2c) @ w_in[l]
        u_a, u_b, u_c, u_d = jnp.split(u, IN_SPLITS, axis=-1)
        uc_a, uc_b, uc_c, uc_d = jnp.split(uc, IN_SPLITS, axis=-1)

        y_a = conformer_conv(u_a, cv_dw_w[l], cv_dw_b[l], cv_ln_g[l], cv_ln_b[l])
        y_b, yc_b = rglru_mixer(u_b, uc_b, need_ctx_out, lru_conv_w[l], lru_conv_b[l],
                                lru_wa[l], lru_ba[l], lru_wx[l], lru_bx[l], lru_lambda[l])
        y_c, yc_c = rwkv7_mixer(u_c, uc_c, need_ctx_out, rwkv_mu_prev[l], rwkv_mu_next[l],
                                rwkv_w0[l], rwkv_w_up[l], rwkv_a0[l], rwkv_a_up[l], rwkv_g_up[l],
                                rwkv_k_k[l], rwkv_k_a[l], rwkv_r_k[l], rwkv_gn_g[l], rwkv_gn_b[l])
        y_d, yc_d = mla_mixer(u_d, uc_d, need_ctx_out, mla_q_norm[l], mla_w_uq[l],
                              mla_kv_norm[l], mla_w_ukv[l], cos, sin)
        y = jnp.concatenate([y_a, y_b, y_c, y_d], axis=-1) @ w_out[l]
        x = x + g2 * y

        if need_ctx_out:
            yc_a = conformer_conv(uc_a, cv_dw_w[l], cv_dw_b[l], cv_ln_g[l], cv_ln_b[l])
            yc = jnp.concatenate([yc_a, yc_b, yc_c, yc_d], axis=-1) @ w_out[l]
            xc = xc + g2c * yc
            xc = xc + 0.5 * g3c * swiglu(modulate(xc, sh3c, s3c), ffn2_w13[l], ffn2_w2[l])

        x = x + 0.5 * g3 * swiglu(modulate(x, sh3, s3), ffn2_w13[l], ffn2_w2[l])
    return rms_norm(x, final_norm)
```

```cpp
#include <hip/hip_runtime.h>
#include <hip/hip_cooperative_groups.h>
#include <cstdio>
#include <cstdint>
namespace cg = cooperative_groups;
namespace pg8 {
#define PG8_LAS __attribute__((address_space(3)))
typedef unsigned short bf16_t;
typedef short bf16x8 __attribute__((ext_vector_type(8)));
typedef float f32x4 __attribute__((ext_vector_type(4)));
typedef unsigned u32x4 __attribute__((ext_vector_type(4)));
constexpr int BM = 256, BK = 64, HALF = 128, HTB = HALF * BK * 2  , STAGE_BYTES = 8 * HTB, NXCD = 8, WGM = 8;

__host__ __device__ __forceinline__ int lds_byte(int r, int c) { const int st = (r >> 4) * 2 + (c >> 5), rr = r & 15, cc = c & 31, ob = rr * 64 + cc * 2; return st * 1024 + (ob ^ (((ob >> 9) & 1) << 5)); }
__host__ __device__ __forceinline__ void stage_rc(int b, int& R, int& C) { const int st = b / 1024, sb = b % 1024, swz = sb ^ (((sb >> 9) & 1) << 5); R = (st >> 1) * 16 + swz / 64; C = (st & 1) * 32 + (swz % 64) / 2; }
__host__ __device__ __forceinline__ int perm32(int rho) { const int n = rho >> 4, i = rho & 15; return 8 * (i >> 2) + 4 * n + (i & 3); }

struct Unit { int pm, pn, k0, nt; };
struct Gemm { const bf16_t* A; const bf16_t* Bt; int M, N, K; };

struct StaticOrder {
    int nM, nN, nwg, G, c, ntk;
    __host__ __device__ void init(int M, int N, int G_, int c_, int K_ = 1024) { nM = M / BM; nN = N / BM; nwg = nM * nN; G = G_; c = c_; ntk = K_ / BK; }
    __host__ __device__ bool next(int i, Unit& u) const {
        const long L = (long)i * G + c; if (L >= nwg) return false;
        int wgid = (int)L; { const int q = nwg / NXCD, r = nwg % NXCD, xcd = wgid % NXCD, off = wgid / NXCD; wgid = (xcd < r ? xcd * (q + 1) : r * (q + 1) + (xcd - r) * q) + off; }
        const int nig = WGM * nN, gid = wgid / nig, fm = gid * WGM, gsz = (nM - fm) < WGM ? (nM - fm) : WGM;
        u.pm = fm + ((wgid % nig) % gsz); u.pn = (wgid % nig) / gsz; u.k0 = 0; u.nt = ntk; return true;
    }
    __device__ __forceinline__ void a_ready(const Unit&) const {}
    __device__ __forceinline__ void done(const Unit&) const {}
};

struct SplitOrder {
    int G, c, np, ntk; StaticOrder so;
    __host__ __device__ void init(int G_, int c_, int K_) { G = G_; c = c_; np = K_ / 256; ntk = K_ / BK; so.init(16384, 1024, 256, 0, K_); }
    __host__ __device__ bool next(int i, Unit& u) const {
        const int L = i * G + c;
        if (L < 256) { StaticOrder t = so; t.c = L; return t.next(0, u); }
        const int it = L - 256; if (it >= 8 * np) return false;
        const int tile = it / np, piece = it % np; u.pm = 64 + (tile >> 2); u.pn = tile & 3; u.k0 = piece * 256; u.nt = 4; return true;
    }
    __device__ __forceinline__ void a_ready(const Unit&) const {}
    __device__ __forceinline__ void done(const Unit&) const {}
};
__device__ __forceinline__ unsigned cvt_pk_bf16(float lo, float hi) { unsigned r; asm volatile("v_cvt_pk_bf16_f32 %0, %1, %2" : "=v"(r) : "v"(lo), "v"(hi)); return r; }
typedef float f32x2 __attribute__((ext_vector_type(2)));
template <class Epi, class Sched, bool ALIGN_EPI = false, bool SP2 = false>
__device__ __forceinline__ void gemm_phase(PG8_LAS unsigned char* lds, const Gemm g, const Sched& S, const Epi& E) {
    int tid = threadIdx.x; asm volatile("" : "+v"(tid));
    const int wid = __builtin_amdgcn_readfirstlane(tid >> 6), lane = tid & 63, wr = wid >> 2, wc = wid & 3, fr = lane & 15, fq = lane >> 4;
    const int K = g.K;
    unsigned voffA[2], voffB[2];
#pragma unroll
    for (int i = 0; i < 2; ++i) { int R, C; stage_rc(tid * 16 + i * 8192, R, C); const int Rb = Epi::PERM ? ((R & ~31) + perm32(R & 31)) : R;
        voffA[i] = (unsigned)(R * K + C) * 2u; voffB[i] = (unsigned)(Rb * K + C) * 2u; }
    const size_t kstep = (size_t)(BK * 2);
    const size_t hstep = (size_t)HALF * K * 2;
    const size_t tstep = 2 * hstep;
    const unsigned ldsw = (unsigned)wid * 1024u;
    const int aoff = lds_byte(wr * 64 + fr, fq * 8), boff = lds_byte(wc * 32 + fr, fq * 8);
#define PG8_SA(b, h) (((b) * 2 + (h)) * HTB)
#define PG8_SB(b, h) ((4 + (b) * 2 + (h)) * HTB)
#define PG8_STAGE(bufoff, gbase, voff) do { _Pragma("unroll") for (int _i = 0; _i < 2; ++_i) \
        __builtin_amdgcn_global_load_lds((const unsigned*)((const char*)(gbase) + (voff)[_i]), (PG8_LAS unsigned*)(lds + (bufoff) + ldsw + _i * 8192), 16, 0, 0); } while (0)
#define PG8_LDA(dst, b, h) do { _Pragma("unroll") for (int m = 0; m < 4; ++m) _Pragma("unroll") for (int k = 0; k < 2; ++k) dst[m][k] = *(const PG8_LAS bf16x8*)(lds + PG8_SA(b, h) + aoff + m * 2048 + k * 1024); } while (0)
#define PG8_LDB(dst, b, h) do { _Pragma("unroll") for (int n = 0; n < 2; ++n) _Pragma("unroll") for (int k = 0; k < 2; ++k) dst[n][k] = *(const PG8_LAS bf16x8*)(lds + PG8_SB(b, h) + boff + n * 2048 + k * 1024); } while (0)
#define PG8_MMA(ai, bj, At, Bt) do { __builtin_amdgcn_s_setprio(1); _Pragma("unroll") for (int m = 0; m < 4; ++m) _Pragma("unroll") for (int n = 0; n < 2; ++n) _Pragma("unroll") for (int k = 0; k < 2; ++k) \
        acc[ai][bj][m][n] = __builtin_amdgcn_mfma_f32_16x16x32_bf16(Bt[n][k], At[m][k], acc[ai][bj][m][n], 0, 0, 0); __builtin_amdgcn_s_setprio(0); } while (0)
#define PG8_WAIT_V(n) asm volatile("s_waitcnt vmcnt(" #n ")" ::: "memory")
#define PG8_WAIT_L(n) asm volatile("s_waitcnt lgkmcnt(" #n ")" ::: "memory")
#define PG8_BAR __builtin_amdgcn_s_barrier()
#define PG8_SCHED __builtin_amdgcn_sched_barrier(0)
    Unit cur, nxt; int ui = 0;
    if (!S.next(0, cur)) return;
    f32x4 acc[2][2][4][2];
#pragma unroll
    for (int a = 0; a < 2; ++a)
#pragma unroll
        for (int b = 0; b < 2; ++b)
#pragma unroll
            for (int m = 0; m < 4; ++m)
#pragma unroll
                for (int n = 0; n < 2; ++n) acc[a][b][m][n] = (f32x4){0.f, 0.f, 0.f, 0.f};
    bf16x8 At[4][2], B0[2][2], B1[2][2];
    const char* cA = (const char*)g.A + (size_t)cur.pm * tstep + (size_t)cur.k0 * 2; const char* cB = (const char*)g.Bt + (size_t)cur.pn * tstep + (size_t)cur.k0 * 2;
    S.a_ready(cur);
    if constexpr (SP2) {
        PG8_STAGE(PG8_SB(0, 0), cB, voffB); PG8_STAGE(PG8_SB(0, 1), cB + hstep, voffB); PG8_STAGE(PG8_SA(0, 0), cA, voffA); PG8_STAGE(PG8_SA(0, 1), cA + hstep, voffA);
        if (wr == 1) PG8_BAR;
        PG8_WAIT_V(2); PG8_BAR;
        PG8_STAGE(PG8_SB(1, 0), cB + kstep, voffB); PG8_STAGE(PG8_SA(1, 0), cA + kstep, voffA); PG8_STAGE(PG8_SB(1, 1), cB + hstep + kstep, voffB);
        PG8_WAIT_V(6); PG8_BAR;
    } else {
        PG8_STAGE(PG8_SB(0, 0), cB, voffB); PG8_STAGE(PG8_SA(0, 0), cA, voffA); PG8_STAGE(PG8_SB(0, 1), cB + hstep, voffB); PG8_STAGE(PG8_SA(0, 1), cA + hstep, voffA);
        if (wr == 1) PG8_BAR;
        PG8_WAIT_V(4); PG8_BAR;
        PG8_STAGE(PG8_SB(1, 0), cB + kstep, voffB); PG8_STAGE(PG8_SA(1, 0), cA + kstep, voffA); PG8_STAGE(PG8_SB(1, 1), cB + hstep + kstep, voffB);
        PG8_WAIT_V(6); PG8_BAR;
    }
    for (;;) {
        const bool has_next = S.next(ui + 1, nxt);
        const char* nA = has_next ? (const char*)g.A + (size_t)nxt.pm * tstep + (size_t)nxt.k0 * 2 : cA; const char* nB = has_next ? (const char*)g.Bt + (size_t)nxt.pn * tstep + (size_t)nxt.k0 * 2 : cB;
        const int nt = cur.nt;
        for (int t = 0; t < nt; t += 2) {
            const bool last = (t == nt - 2);
            const char* a1 = cA + (size_t)(t + 1) * kstep;
            const char* a2 = last ? nA : cA + (size_t)(t + 2) * kstep; const char* b2 = last ? nB : cB + (size_t)(t + 2) * kstep;
            const char* a3 = a2 + kstep; const char* b3 = b2 + kstep;
            if (last && has_next) S.a_ready(nxt);
            if constexpr (SP2) {
            PG8_LDB(B0, 0, 0); PG8_LDB(B1, 0, 1); PG8_SCHED; PG8_LDA(At, 0, 0); PG8_STAGE(PG8_SA(1, 1), a1 + hstep, voffA);
            PG8_WAIT_V(8); PG8_WAIT_L(0); PG8_BAR; PG8_MMA(0, 0, At, B0); PG8_MMA(0, 1, At, B1); PG8_BAR; PG8_SCHED;
            PG8_LDA(At, 0, 1); PG8_STAGE(PG8_SB(0, 0), b2, voffB); PG8_STAGE(PG8_SB(0, 1), b2 + hstep, voffB); PG8_STAGE(PG8_SA(0, 0), a2, voffA);
            PG8_WAIT_V(8); PG8_WAIT_L(0); PG8_BAR; PG8_MMA(1, 0, At, B0); PG8_MMA(1, 1, At, B1); PG8_BAR; PG8_SCHED;
            PG8_LDB(B0, 1, 0); PG8_LDB(B1, 1, 1); PG8_SCHED; PG8_LDA(At, 1, 0); PG8_STAGE(PG8_SA(0, 1), a2 + hstep, voffA);
            PG8_WAIT_V(8); PG8_WAIT_L(0); PG8_BAR; PG8_MMA(0, 0, At, B0); PG8_MMA(0, 1, At, B1); PG8_BAR; PG8_SCHED;
            PG8_LDA(At, 1, 1); PG8_STAGE(PG8_SB(1, 0), b3, voffB); PG8_STAGE(PG8_SB(1, 1), b3 + hstep, voffB); PG8_STAGE(PG8_SA(1, 0), a3, voffA);
            PG8_WAIT_V(8); PG8_WAIT_L(0); PG8_BAR; PG8_MMA(1, 0, At, B0); PG8_MMA(1, 1, At, B1); PG8_BAR; PG8_SCHED;
            } else {
            PG8_LDB(B0, 0, 0); PG8_SCHED; PG8_LDA(At, 0, 0); PG8_STAGE(PG8_SA(1, 1), a1 + hstep, voffA);
            PG8_WAIT_L(8); PG8_BAR; PG8_WAIT_L(0); PG8_MMA(0, 0, At, B0); PG8_BAR; PG8_SCHED;
            PG8_LDB(B1, 0, 1); PG8_STAGE(PG8_SB(0, 0), b2, voffB);
            PG8_BAR; PG8_WAIT_L(0); PG8_MMA(0, 1, At, B1); PG8_BAR;
            PG8_LDA(At, 0, 1); PG8_STAGE(PG8_SA(0, 0), a2, voffA);
            PG8_BAR; PG8_WAIT_L(0); PG8_MMA(1, 0, At, B0); PG8_BAR; PG8_SCHED;
            PG8_STAGE(PG8_SB(0, 1), b2 + hstep, voffB);
            PG8_WAIT_V(6); PG8_BAR; PG8_MMA(1, 1, At, B1); PG8_BAR;
            PG8_LDB(B0, 1, 0); PG8_SCHED; PG8_LDA(At, 1, 0); PG8_STAGE(PG8_SA(0, 1), a2 + hstep, voffA);
            PG8_WAIT_L(8); PG8_BAR; PG8_WAIT_L(0); PG8_MMA(0, 0, At, B0); PG8_BAR; PG8_SCHED;
            PG8_LDB(B1, 1, 1); PG8_STAGE(PG8_SB(1, 0), b3, voffB);
            PG8_BAR; PG8_WAIT_L(0); PG8_MMA(0, 1, At, B1); PG8_BAR;
            PG8_LDA(At, 1, 1); PG8_STAGE(PG8_SA(1, 0), a3, voffA);
            PG8_BAR; PG8_WAIT_L(0); PG8_MMA(1, 0, At, B0); PG8_BAR; PG8_SCHED;
            PG8_STAGE(PG8_SB(1, 1), b3 + hstep, voffB);
            PG8_WAIT_V(6); PG8_BAR; PG8_MMA(1, 1, At, B1); PG8_BAR;
            }
        }
        if constexpr (ALIGN_EPI) { if (wr == 0) PG8_BAR; }
        if constexpr (!Epi::AFTER_DRAIN) { E(acc, cur, wr, wc, fr, fq); S.done(cur); }
        if (!has_next) break;
#pragma unroll
        for (int a = 0; a < 2; ++a)
#pragma unroll
            for (int b = 0; b < 2; ++b)
#pragma unroll
                for (int m = 0; m < 4; ++m)
#pragma unroll
                    for (int n = 0; n < 2; ++n) acc[a][b][m][n] = (f32x4){0.f, 0.f, 0.f, 0.f};
        cur = nxt; cA = nA; cB = nB; ++ui;
        if constexpr (ALIGN_EPI) { if (wr == 1) PG8_BAR; }
    }
    PG8_WAIT_V(0);
    if constexpr (!ALIGN_EPI) { if (wr == 0) PG8_BAR; }
    PG8_BAR;
    if constexpr (Epi::AFTER_DRAIN) { E.fused(acc, cur, wr, wc, fr, fq, lds, wid, lane); S.done(cur); }
#undef PG8_SA
#undef PG8_SB
#undef PG8_STAGE
#undef PG8_LDA
#undef PG8_LDB
#undef PG8_MMA
#undef PG8_WAIT_V
#undef PG8_WAIT_L
#undef PG8_BAR
#undef PG8_SCHED
}
}

using pg8::f32x4; using pg8::bf16x8;
typedef unsigned short bf16;
typedef unsigned v4u __attribute__((ext_vector_type(4)));
typedef unsigned v2u __attribute__((ext_vector_type(2)));
typedef short s16x4 __attribute__((ext_vector_type(4)));

constexpr int DM = 1024, TLEN = 8192, CTXL = 256, TT = 8448, NLAT = 16384, NR = 16896, DFF = 2816, UC = 2560, NTILE = 528;
constexpr int NSEG = 64, SEGLEN = 132;
constexpr size_t MiB = 1u << 20;
constexpr size_t A8 = (size_t)NR * 256 * 2;
constexpr size_t OFF_MOD = 0, MOD_BYTES = 256 * 1024;
constexpr size_t OFF_XCTX = 1 * MiB, OFF_XMY = 3 * MiB, OFF_HU = 36 * MiB, OFF_W = 127 * MiB, OFF_MIX = 168 * MiB;
constexpr size_t W_13A = OFF_W, W_2A = OFF_W + 11 * MiB, W_13B = OFF_W + 16 * MiB + MiB / 2, W_2B = OFF_W + 27 * MiB + MiB / 2,
                 W_IN = OFF_W + 33 * MiB, W_OUT = OFF_W + 38 * MiB, W_UQ = OFF_W + 40 * MiB, W_UKV = OFF_W + 40 * MiB + 256 * 1024;
constexpr size_t M_QB = OFF_MIX, M_KB = OFF_MIX + 12976128, M_VT = OFF_MIX + 25952256;
constexpr size_t M_LR0 = OFF_MIX + 4 * A8, M_LIX0 = OFF_MIX + 6 * A8, M_GB = OFF_MIX + 8 * A8, M_SEGA = OFF_MIX + 9 * A8, M_SEGB = M_SEGA + 2 * MiB;
constexpr size_t M_RR = OFF_MIX, M_KK = OFF_MIX + A8, M_VV = OFF_MIX + 2 * A8, M_WW = OFF_MIX + 3 * A8, M_BB = OFF_MIX + 7 * A8, M_KD = OFF_MIX + 9 * A8, M_GC = OFF_MIX + 11 * A8;
constexpr size_t M_YS = OFF_HU, M_PL = OFF_HU + 33 * MiB, M_SINIT = OFF_HU + 65 * MiB;
constexpr size_t WS_NEED = OFF_MIX + 12 * A8;
constexpr int LDS_BYTES = 131072 + 1024;
#ifndef REP_M1
#define REP_M1 1
#endif
#ifndef REP_M2
#define REP_M2 1
#endif
#ifndef REP_M3
#define REP_M3 1
#endif
#ifndef REP_SCAN
#define REP_SCAN 1
#endif
#ifndef REP_G1
#define REP_G1 1
#endif
constexpr float QSCALE = 0.10206207261596575f * 1.4426950408889634f;

struct Args { const float* in[40]; float* out; unsigned char* ws; };
typedef const __attribute__((address_space(4))) volatile unsigned long long kargq;
__device__ __forceinline__ const float* karg_in(int i) { kargq* p = (kargq*)__builtin_amdgcn_kernarg_segment_ptr(); return (const float*)p[i]; }
__device__ __forceinline__ float* karg_out() { kargq* p = (kargq*)__builtin_amdgcn_kernarg_segment_ptr(); return (float*)p[40]; }
__device__ __forceinline__ unsigned char* karg_ws() { kargq* p = (kargq*)__builtin_amdgcn_kernarg_segment_ptr(); return (unsigned char*)p[41]; }
#define IN(i) karg_in(i)
__device__ __forceinline__ int ltid() { int t = threadIdx.x; asm volatile("" : "+v"(t)); return t; }
__device__ __forceinline__ int lbid() { int t = blockIdx.x; asm volatile("" : "+s"(t)); return t; }
template <class T> __device__ __forceinline__ T* launder(T* p) { asm volatile("" : "+s"(p)); return p; }

__device__ __forceinline__ float bf2f(bf16 h) { return __uint_as_float((unsigned)h << 16); }
__device__ __forceinline__ unsigned f2bf(float f) { unsigned u = __float_as_uint(f); return (u + 0x7fffu + ((u >> 16) & 1u)) >> 16; }
__device__ __forceinline__ unsigned pk2(float lo, float hi) { return f2bf(lo) | (f2bf(hi) << 16); }
__device__ __forceinline__ float sigm(float x) { return 1.f / (1.f + __expf(-x)); }
__device__ __forceinline__ float siluf_(float x) { return x / (1.f + __expf(-x)); }
__device__ __forceinline__ float tanhf_(float y) { return 1.f - 2.f / (1.f + __expf(2.f * y)); }
__device__ __forceinline__ float geluf_(float x) { return 0.5f * x * (1.f + tanhf_(0.7978845608028654f * (x + 0.044715f * x * x * x))); }
__device__ __forceinline__ float wave_sum(float v) {
#pragma unroll
    for (int o = 1; o < 64; o <<= 1) v += __shfl_xor(v, o);
    return v;
}
struct TileInfo { int b, isctx, t0, seqbase, seqlen; };
__device__ __forceinline__ TileInfo tile_info(int tile) {
    TileInfo ti;
    if (tile < 512) { ti.b = tile >> 8; ti.isctx = 0; ti.t0 = (tile & 255) * 32; ti.seqbase = ti.b * TLEN; ti.seqlen = TLEN; }
    else { const int q = tile - 512; ti.b = q >> 3; ti.isctx = 1; ti.t0 = (q & 7) * 32; ti.seqbase = NLAT + ti.b * CTXL; ti.seqlen = CTXL; }
    return ti;
}

struct EpiSwiglu {
    static constexpr bool PERM = true, AFTER_DRAIN = false;
    bf16* H;
    __device__ __forceinline__ void operator()(const f32x4 (&acc)[2][2][4][2], const pg8::Unit& u, int wr, int wc, int fr, int fq) const {
        int pm = u.pm, pn = u.pn; asm volatile("" : "+s"(pm), "+s"(pn), "+s"(wr), "+s"(wc), "+v"(fr), "+v"(fq));
        bf16* tb = H + (size_t)pm * 256 * DFF + pn * 128;
        const unsigned loff = (unsigned)((wr * 64 + fr) * DFF + wc * 32 + 8 * fq);
#pragma unroll
        for (int ai = 0; ai < 2; ++ai)
#pragma unroll
            for (int m = 0; m < 4; ++m) {
                bf16* rowp = tb + (loff + (unsigned)((ai * 128 + m * 16) * DFF));
                const f32x4 g0 = acc[ai][0][m][0], g1 = acc[ai][0][m][1], u0 = acc[ai][1][m][0], u1 = acc[ai][1][m][1];
                v4u w;
                w.x = pg8::cvt_pk_bf16(siluf_(g0[0]) * u0[0], siluf_(g0[1]) * u0[1]); w.y = pg8::cvt_pk_bf16(siluf_(g0[2]) * u0[2], siluf_(g0[3]) * u0[3]);
                w.z = pg8::cvt_pk_bf16(siluf_(g1[0]) * u1[0], siluf_(g1[1]) * u1[1]); w.w = pg8::cvt_pk_bf16(siluf_(g1[2]) * u1[2], siluf_(g1[3]) * u1[3]);
                *(v4u*)rowp = w;
            }
    }
};
struct EpiU {
    static constexpr bool PERM = true, AFTER_DRAIN = false;
    bf16* O; int ldc;
    __device__ __forceinline__ void operator()(const f32x4 (&acc)[2][2][4][2], const pg8::Unit& u, int wr, int wc, int fr, int fq) const {
        int pm = u.pm, pn = u.pn; asm volatile("" : "+s"(pm), "+s"(pn), "+s"(wr), "+s"(wc), "+v"(fr), "+v"(fq));
        bf16* tb = O + (size_t)pm * 256 * ldc + pn * 256;
        const unsigned loff = (unsigned)((wr * 64 + fr) * ldc + wc * 32 + 8 * fq);
#pragma unroll
        for (int ai = 0; ai < 2; ++ai)
#pragma unroll
            for (int m = 0; m < 4; ++m) {
                bf16* rowp = tb + (loff + (unsigned)((ai * 128 + m * 16) * ldc));
#pragma unroll
                for (int bj = 0; bj < 2; ++bj) { const f32x4 v0 = acc[ai][bj][m][0], v1 = acc[ai][bj][m][1]; v4u w;
                    w.x = pg8::cvt_pk_bf16(v0[0], v0[1]); w.y = pg8::cvt_pk_bf16(v0[2], v0[3]); w.z = pg8::cvt_pk_bf16(v1[0], v1[1]); w.w = pg8::cvt_pk_bf16(v1[2], v1[3]);
                    *(v4u*)(rowp + bj * 128) = w; }
            }
    }
};
struct EpiResid {
    static constexpr bool PERM = false, AFTER_DRAIN = false;
    float* xlat; float* xctx; const float* gate; float coef;
    __device__ __forceinline__ void operator()(const f32x4 (&acc)[2][2][4][2], const pg8::Unit& u, int wr, int wc, int fr, int fq) const {
        int pm = u.pm, pn = u.pn; asm volatile("" : "+s"(pm), "+s"(pn), "+s"(wr), "+s"(wc), "+v"(fr), "+v"(fq));
        float* tb = (pm < 64 ? xlat + (size_t)pm * 256 * DM : xctx + (size_t)(pm - 64) * 256 * DM) + pn * 256;
        const float* g = gate + (pm < 64 ? (pm >> 5) : 2) * 9216 + pn * 256;
        const unsigned coff = (unsigned)(wc * 32 + 4 * fq), loff = (unsigned)((wr * 64 + fr) * DM) + coff;
        f32x4 gv[2][2];
#pragma unroll
        for (int bj = 0; bj < 2; ++bj)
#pragma unroll
            for (int n = 0; n < 2; ++n) gv[bj][n] = coef * *(const f32x4*)(g + (coff + (unsigned)(bj * 128 + n * 16)));
#pragma unroll
        for (int ai = 0; ai < 2; ++ai)
#pragma unroll
            for (int m = 0; m < 4; ++m) {
                float* xr = tb + (loff + (unsigned)((ai * 128 + m * 16) * DM));
#pragma unroll
                for (int bj = 0; bj < 2; ++bj)
#pragma unroll
                    for (int n = 0; n < 2; ++n) { float* xp = xr + (bj * 128 + n * 16);
                        if (pm < 64) { f32x4 xv = *(const f32x4*)xp; xv += gv[bj][n] * acc[ai][bj][m][n]; *(f32x4*)xp = xv; }
                        else { const f32x4 dv = gv[bj][n] * acc[ai][bj][m][n]; unsafeAtomicAdd(xp, dv[0]); unsafeAtomicAdd(xp + 1, dv[1]); unsafeAtomicAdd(xp + 2, dv[2]); unsafeAtomicAdd(xp + 3, dv[3]); } }
                asm volatile("" ::: "memory");
            }
    }
};

__device__ __forceinline__ void phase_modgemv(const Args& a, float* red, int G, int bid, int tid) {
    const float* c = IN(1); const float* cctx = IN(3); const float* ada_w = IN(4); const float* ada_b = IN(5);
    float* mod = (float*)(karg_ws() + OFF_MOD);
    const int w = tid >> 6, lane = tid & 63;
    for (int u = bid; u < 576; u += G) {
        const int l = u / 288, rem = u % 288, jt = rem >> 3, ks = rem & 7;
        const int kb = ks * 128 + w * 16, j0 = jt * 256 + lane * 4;
        f32x4 acc0 = {0.f, 0.f, 0.f, 0.f}, acc1 = acc0, acc2 = acc0;
        for (int kk = 0; kk < 16; ++kk) { const int k = kb + kk;
            const float s0 = siluf_(c[k]), s1 = siluf_(c[1024 + k]), s2 = siluf_(cctx[k]);
            const f32x4 wv = *(const f32x4*)(ada_w + ((size_t)(l * 1024 + k)) * 9216 + j0);
            acc0 += s0 * wv; acc1 += s1 * wv; acc2 += s2 * wv; }
        float* rp = red + (w * 3) * 256 + lane * 4;
        *(f32x4*)rp = acc0; *(f32x4*)(rp + 256) = acc1; *(f32x4*)(rp + 512) = acc2;
        __syncthreads();
        for (int o = tid; o < 768; o += 512) { const int m = o >> 8, jj = o & 255; float s = 0.f;
#pragma unroll
            for (int ww = 0; ww < 8; ++ww) s += red[(ww * 3 + m) * 256 + jj];
            const int j = jt * 256 + jj; if (ks == 0) s += ada_b[l * 9216 + j];
            atomicAdd(&mod[(l * 3 + m) * 9216 + j], s); }
        __syncthreads();
    }
}
__device__ __forceinline__ void phase_copy(const Args& a, int G, int bid, int tid) {
    const f32x4* x4 = (const f32x4*)IN(0); f32x4* o4 = (f32x4*)karg_out();
    for (int i = bid * 512 + tid; i < NLAT * DM / 4; i += G * 512) o4[i] = x4[i];
    const f32x4* c4 = (const f32x4*)IN(2); f32x4* xc4 = (f32x4*)(karg_ws() + OFF_XCTX);
    for (int i = bid * 512 + tid; i < 512 * DM / 4; i += G * 512) xc4[i] = c4[i];
}
__device__ __forceinline__ int swiglu_map(int n) { return n < DFF ? ((n >> 7) * 256 + (n & 127)) : ((((n - DFF) >> 7) * 256) + 128 + ((n - DFF) & 127)); }
__device__ __forceinline__ void transpose_item(const float* W, int K, int N, bf16* WT, float* scr, int item, int lane, int mode, const float* kscale) {
    const int nblk = N / 32, kb = item / nblk, nb = item % nblk, k0 = 64 * kb, n0 = 32 * nb;
#pragma unroll 8
    for (int i = 0; i < 32; ++i) { const int kk = 2 * i + (lane >> 5); float v = W[(size_t)(k0 + kk) * N + n0 + (lane & 31)]; if (kscale) v *= kscale[k0 + kk]; scr[kk * 33 + (lane & 31)] = v; }
    __builtin_amdgcn_wave_barrier();
    const int c = lane & 7;
#pragma unroll
    for (int j = 0; j < 4; ++j) { const int n = (lane >> 3) + 8 * j; const float* s = scr + (8 * c) * 33 + n;
        v4u o; o.x = pk2(s[0 * 33], s[1 * 33]); o.y = pk2(s[2 * 33], s[3 * 33]); o.z = pk2(s[4 * 33], s[5 * 33]); o.w = pk2(s[6 * 33], s[7 * 33]);
        const int nn = n0 + n, drow = mode ? swiglu_map(nn) : nn;
        *(v4u*)(WT + (size_t)drow * K + k0 + 8 * c) = o; }
    __builtin_amdgcn_wave_barrier();
}
__device__ __forceinline__ void convert_weights(const Args& a, int l, float* scr, int gw, int NGW, int lane, int G, int bid, int tid) {
    constexpr int I13 = 16 * 176, I2 = 44 * 32, IIN = 16 * 77, IOUT = 16 * 32, IUQ = 4 * 12, IUKV = 2 * 16;
    constexpr int NIT = 2 * I13 + 2 * I2 + IIN + IOUT + IUQ + IUKV;
    unsigned char* ws = karg_ws();
    for (int it = gw; it < NIT; it += NGW) {
        int r = it;
        if (r < I13) { transpose_item(IN(6) + (size_t)l * DM * 2 * DFF, DM, 2 * DFF, (bf16*)(ws + W_13A), scr, r, lane, 1, nullptr); continue; } r -= I13;
        if (r < I13) { transpose_item(IN(8) + (size_t)l * DM * 2 * DFF, DM, 2 * DFF, (bf16*)(ws + W_13B), scr, r, lane, 1, nullptr); continue; } r -= I13;
        if (r < I2) { transpose_item(IN(7) + (size_t)l * DFF * DM, DFF, DM, (bf16*)(ws + W_2A), scr, r, lane, 0, nullptr); continue; } r -= I2;
        if (r < I2) { transpose_item(IN(9) + (size_t)l * DFF * DM, DFF, DM, (bf16*)(ws + W_2B), scr, r, lane, 0, nullptr); continue; } r -= I2;
        if (r < IIN) { transpose_item(IN(10) + (size_t)l * DM * 2464, DM, 2464, (bf16*)(ws + W_IN), scr, r, lane, 0, nullptr); continue; } r -= IIN;
        if (r < IOUT) { transpose_item(IN(11) + (size_t)l * DM * DM, DM, DM, (bf16*)(ws + W_OUT), scr, r, lane, 0, nullptr); continue; } r -= IOUT;
        if (r < IUQ) { transpose_item(IN(36) + (size_t)l * 256 * 384, 256, 384, (bf16*)(ws + W_UQ), scr, r, lane, 0, IN(35) + l * 256); continue; } r -= IUQ;
        transpose_item(IN(38) + (size_t)l * 128 * 512, 128, 512, (bf16*)(ws + W_UKV), scr, r, lane, 0, IN(37) + l * 128);
    }
    v4u z = {0u, 0u, 0u, 0u}; v4u* zp = (v4u*)(ws + W_IN + (size_t)2464 * DM * 2);
    for (int i = bid * 512 + tid; i < 96 * DM * 2 / 16; i += G * 512) zp[i] = z;
}
__device__ __forceinline__ void phase_modulate(const Args& a, int l, int which, int gw, int NGW, int lane) {
    unsigned char* ws = karg_ws(); const float* outp = karg_out();
    const float* mod = (const float*)(ws + OFF_MOD) + (size_t)l * 3 * 9216;
    bf16* XM = (bf16*)(ws + OFF_XMY);
    for (int r = gw; r < NR; r += NGW) {
        const float* xr = r < NLAT ? outp + (size_t)r * DM : (const float*)(ws + OFF_XCTX) + (size_t)(r - NLAT) * DM;
        const float* mm = mod + (r < NLAT ? (r >> 13) : 2) * 9216 + which * 3 * 1024;
        f32x4 v[4]; float ss = 0.f;
#pragma unroll
        for (int j = 0; j < 4; ++j) { v[j] = *(const f32x4*)(xr + 4 * lane + 256 * j); ss += (v[j][0] * v[j][0] + v[j][1] * v[j][1]) + (v[j][2] * v[j][2] + v[j][3] * v[j][3]); }
        const float rstd = rsqrtf(wave_sum(ss) * (1.f / DM) + 1e-6f);
#pragma unroll
        for (int j = 0; j < 4; ++j) { const int c = 4 * lane + 256 * j; const f32x4 sh = *(const f32x4*)(mm + c), sc = *(const f32x4*)(mm + 1024 + c);
            const f32x4 o = v[j] * rstd * (1.f + sc) + sh; v2u w; w.x = pk2(o[0], o[1]); w.y = pk2(o[2], o[3]);
            *(v2u*)(XM + (size_t)r * DM + c) = w; }
    }
}
__device__ __forceinline__ void phase_final(const Args& a, int gw, int NGW, int lane) {
    const float* fn = IN(39); float* outp = karg_out();
    for (int r = gw; r < NLAT; r += NGW) {
        float* xr = outp + (size_t)r * DM; f32x4 v[4]; float ss = 0.f;
#pragma unroll
        for (int j = 0; j < 4; ++j) { v[j] = *(const f32x4*)(xr + 4 * lane + 256 * j); ss += (v[j][0] * v[j][0] + v[j][1] * v[j][1]) + (v[j][2] * v[j][2] + v[j][3] * v[j][3]); }
        const float rstd = rsqrtf(wave_sum(ss) * (1.f / DM) + 1e-6f);
#pragma unroll
        for (int j = 0; j < 4; ++j) { const int c = 4 * lane + 256 * j; const f32x4 g = *(const f32x4*)(fn + c); *(f32x4*)(xr + c) = v[j] * rstd * g; }
    }
}

__device__ __forceinline__ void phase_m1(const Args& a, int l, unsigned char* lds, int G, int bid, int tid_unused) {
    unsigned char* ws = karg_ws();
    const bf16* U = (const bf16*)(ws + OFF_HU);
    bf16* Y = (bf16*)(ws + OFF_XMY);
    for (int tile = bid; tile < NTILE; tile += G) {
        const TileInfo ti = tile_info(tile);
        const int row0 = tile * 32;
        {
            const int tid = ltid(); const int lane = tid & 63, wave = __builtin_amdgcn_readfirstlane(tid >> 6), ch = tid & 255, part = tid >> 8; (void)lane; (void)wave; (void)ch; (void)part;
            float* z = (float*)lds;
            float* cv = (float*)(lds + 65536);
            for (int tt = part; tt < 62; tt += 2) { const int t = ti.t0 - 15 + tt; float zz = 0.f;
                if (t >= 0 && t < ti.seqlen) { const bf16* ur = U + (size_t)(ti.seqbase + t) * UC; zz = bf2f(ur[ch]) * sigm(bf2f(ur[256 + ch])); }
                z[tt * 256 + ch] = zz; }
            __syncthreads();
            const float* dw = IN(12) + (size_t)l * 31 * 256 + ch;
            float acc[16]; const float bias = IN(13)[l * 256 + ch];
#pragma unroll
            for (int o = 0; o < 16; ++o) acc[o] = bias;
            for (int j = 0; j < 31; ++j) { const float w = dw[j * 256];
#pragma unroll
                for (int o = 0; o < 16; ++o) acc[o] += w * z[(part * 16 + o + j) * 256 + ch]; }
#pragma unroll
            for (int o = 0; o < 16; ++o) cv[(part * 16 + o) * 256 + ch] = acc[o];
            __syncthreads();
            const f32x4 lg = *(const f32x4*)(IN(14) + l * 256 + lane * 4), lb = *(const f32x4*)(IN(15) + l * 256 + lane * 4);
#pragma unroll
            for (int q = 0; q < 4; ++q) { const int t = wave * 4 + q; const f32x4 v = *(const f32x4*)(cv + t * 256 + lane * 4);
                const float mu = wave_sum((v[0] + v[1]) + (v[2] + v[3])) * (1.f / 256.f);
                const f32x4 dv = v - mu; const float var = wave_sum((dv[0] * dv[0] + dv[1] * dv[1]) + (dv[2] * dv[2] + dv[3] * dv[3])) * (1.f / 256.f);
                const f32x4 yn = dv * rsqrtf(var + 1e-5f) * lg + lb;
                v2u w; w.x = pk2(siluf_(yn[0]), siluf_(yn[1])); w.y = pk2(siluf_(yn[2]), siluf_(yn[3]));
                *(v2u*)(Y + (size_t)(row0 + t) * DM + lane * 4) = w; }
            __syncthreads();
        }
        {
            const int tid = ltid(); const int lane = tid & 63, wave = __builtin_amdgcn_readfirstlane(tid >> 6), ch = tid & 255, part = tid >> 8; (void)lane; (void)wave; (void)ch; (void)part;
            float* xv = (float*)lds;
            {
                const float* cw = IN(16) + (size_t)l * 4 * 256 + ch; const float w0 = cw[0], w1 = cw[256], w2 = cw[512], w3 = cw[768], cb = IN(17)[l * 256 + ch];
                float xin[19];
#pragma unroll
                for (int i = 0; i < 19; ++i) { const int t = ti.t0 + part * 16 + i - 2; xin[i] = (t >= 0 && t < ti.seqlen) ? bf2f(U[(size_t)(ti.seqbase + t) * UC + 512 + ch]) : 0.f; }
                bf16* GB = (bf16*)(ws + M_GB);
#pragma unroll
                for (int o = 0; o < 16; ++o) { const int tl = part * 16 + o;
                    xv[ch * 36 + tl] = cb + w0 * xin[o] + w1 * xin[o + 1] + w2 * xin[o + 2] + w3 * xin[o + 3];
                    GB[(size_t)(row0 + tl) * 256 + ch] = (bf16)f2bf(geluf_(bf2f(U[(size_t)(row0 + tl) * UC + 768 + ch]))); }
            }
            __syncthreads();
            {
                const int d = part, blk = ch >> 6, jc = ch & 63;
                const float* WA = IN(18) + ((size_t)((l * 2 + d) * 4 + blk) * 64) * 64 + jc;
                const float* WX = IN(20) + ((size_t)((l * 2 + d) * 4 + blk) * 64) * 64 + jc;
                float aa[32], ax[32];
#pragma unroll
                for (int t = 0; t < 32; ++t) { aa[t] = 0.f; ax[t] = 0.f; }
#pragma unroll 2
                for (int i = 0; i < 64; ++i) { const float wa = WA[i * 64], wx = WX[i * 64]; const float* xp = xv + (blk * 64 + i) * 36;
#pragma unroll
                    for (int t = 0; t < 32; t += 4) { const f32x4 x = *(const f32x4*)(xp + t);
                        aa[t] += x[0] * wa; aa[t + 1] += x[1] * wa; aa[t + 2] += x[2] * wa; aa[t + 3] += x[3] * wa;
                        ax[t] += x[0] * wx; ax[t + 1] += x[1] * wx; ax[t + 2] += x[2] * wx; ax[t + 3] += x[3] * wx; } }
                const float ba = IN(19)[(l * 2 + d) * 256 + ch], bx = IN(21)[(l * 2 + d) * 256 + ch];
                const float lam = IN(22)[(l * 2 + d) * 256 + ch];
                const float cch = -8.f * log1pf(__expf(-lam));
                bf16* LR = (bf16*)(ws + M_LR0 + (size_t)d * A8); bf16* LIX = (bf16*)(ws + M_LIX0 + (size_t)d * A8);
#pragma unroll
                for (int t = 0; t < 32; ++t) { const float r = sigm(aa[t] + ba), ii = sigm(ax[t] + bx) * xv[ch * 36 + t];
                    const unsigned rb = f2bf(r), ib = f2bf(ii);
                    LR[(size_t)(row0 + t) * 256 + ch] = (bf16)rb; LIX[(size_t)(row0 + t) * 256 + ch] = (bf16)ib;
                    aa[t] = __uint_as_float(rb << 16); ax[t] = __uint_as_float(ib << 16); }
                float A = 1.f, B = 0.f;
                if (d == 0) {
#pragma unroll
                    for (int t = 0; t < 32; ++t) { const float al = __expf(cch * aa[t]); const float bb = sqrtf(fmaxf(1.f - al * al, 0.f)) * ax[t]; B = al * B + bb; A *= al; }
                } else {
#pragma unroll
                    for (int t = 31; t >= 0; --t) { const float al = __expf(cch * aa[t]); const float bb = sqrtf(fmaxf(1.f - al * al, 0.f)) * ax[t]; B = al * B + bb; A *= al; }
                }
                ((float*)(ws + M_SEGA))[(size_t)(tile * 2 + d) * 256 + ch] = A;
                ((float*)(ws + M_SEGB))[(size_t)(tile * 2 + d) * 256 + ch] = B;
            }
            __syncthreads();
        }
        {
            const int tid = ltid(); const int lane = tid & 63, wave = __builtin_amdgcn_readfirstlane(tid >> 6), ch = tid & 255, part = tid >> 8; (void)lane; (void)wave; (void)ch; (void)part;
            bf16* As = (bf16*)lds;
            float* kr = (float*)(lds + 32768);
            float* rs = (float*)(lds + 32768 + 4096);
            for (int idx = tid; idx < 32 * 52; idx += 512) { const int t = idx / 52, cc = idx % 52;
                const v4u v = *(const v4u*)(U + (size_t)(row0 + t) * UC + 2048 + cc * 8);
                if (cc < 48) *(v4u*)(As + t * 392 + cc * 8) = v;
                else { const int c0 = (cc - 48) * 8; float* kp = kr + t * 32 + c0;
                    kp[0] = __uint_as_float(v.x << 16); kp[1] = __uint_as_float(v.x & 0xffff0000u); kp[2] = __uint_as_float(v.y << 16); kp[3] = __uint_as_float(v.y & 0xffff0000u);
                    kp[4] = __uint_as_float(v.z << 16); kp[5] = __uint_as_float(v.z & 0xffff0000u); kp[6] = __uint_as_float(v.w << 16); kp[7] = __uint_as_float(v.w & 0xffff0000u); } }
            __syncthreads();
#pragma unroll
            for (int q = 0; q < 4; ++q) { const int t = wave * 4 + q; float sq = 0.f, sk = 0.f;
#pragma unroll
                for (int j = 0; j < 4; ++j) { const float v = bf2f(As[t * 392 + lane + 64 * j]); sq += v * v; }
#pragma unroll
                for (int j = 0; j < 2; ++j) { const float v = bf2f(As[t * 392 + 256 + lane + 64 * j]); sk += v * v; }
                sq = wave_sum(sq); sk = wave_sum(sk);
                if (lane == 0) { rs[t * 2] = rsqrtf(sq * (1.f / 256.f) + 1e-6f); rs[t * 2 + 1] = rsqrtf(sk * (1.f / 128.f) + 1e-6f); } }
            __syncthreads();
            const int fr = lane & 15, fq = lane >> 4;
            bf16* QB = (bf16*)(ws + M_QB); bf16* KB = (bf16*)(ws + M_KB); bf16* VT = (bf16*)(ws + M_VT);
            const bf16* WUQ = (const bf16*)(ws + W_UQ); const bf16* WUKV = (const bf16*)(ws + W_UKV);
            const int keybase = ti.isctx ? TLEN : 0;
#pragma unroll 1
            for (int i = 0; i < 3; ++i) { const int nt = wave * 3 + i;
                f32x4 c0 = {0.f, 0.f, 0.f, 0.f}, c1 = c0;
#pragma unroll
                for (int ks = 0; ks < 8; ++ks) { const bf16x8 bfr = *(const bf16x8*)(WUQ + (size_t)(nt * 16 + fr) * 256 + ks * 32 + fq * 8);
                    const bf16x8 a0 = *(const bf16x8*)(As + fr * 392 + ks * 32 + fq * 8), a1 = *(const bf16x8*)(As + (16 + fr) * 392 + ks * 32 + fq * 8);
                    c0 = __builtin_amdgcn_mfma_f32_16x16x32_bf16(a0, bfr, c0, 0, 0, 0); c1 = __builtin_amdgcn_mfma_f32_16x16x32_bf16(a1, bfr, c1, 0, 0, 0); }
                const int hq = nt / 6, wt = nt % 6, dd = wt * 16 + fr;
#pragma unroll
                for (int mt = 0; mt < 2; ++mt)
#pragma unroll
                    for (int j = 0; j < 4; ++j) { const int tl = mt * 16 + fq * 4 + j; const int t = ti.t0 + tl;
                        float v = (mt ? c1[j] : c0[j]) * rs[tl * 2];
                        const float pv = __shfl_xor(v, 8);
                        if (wt >= 4 && !ti.isctx) { const int f = fr & 7; const float pos = (wt == 4) ? (float)(t >> 6) : (float)(t & 63);
                            const float ang = pos * __expf(-(float)f * (9.210340371976184f / 8.f)); float sn, cs; __sincosf(ang, &sn, &cs);
                            v = (fr & 8) ? (v * cs + pv * sn) : (v * cs - pv * sn); }
                        QB[((size_t)(ti.b * 4 + hq) * TT + keybase + t) * 96 + dd] = (bf16)f2bf(v * QSCALE); } }
#pragma unroll 1
            for (int i = 0; i < 4; ++i) { const int nt = wave * 4 + i;
                f32x4 c0 = {0.f, 0.f, 0.f, 0.f}, c1 = c0;
#pragma unroll
                for (int ks = 0; ks < 4; ++ks) { const bf16x8 bfr = *(const bf16x8*)(WUKV + (size_t)(nt * 16 + fr) * 128 + ks * 32 + fq * 8);
                    const bf16x8 a0 = *(const bf16x8*)(As + fr * 392 + 256 + ks * 32 + fq * 8), a1 = *(const bf16x8*)(As + (16 + fr) * 392 + 256 + ks * 32 + fq * 8);
                    c0 = __builtin_amdgcn_mfma_f32_16x16x32_bf16(a0, bfr, c0, 0, 0, 0); c1 = __builtin_amdgcn_mfma_f32_16x16x32_bf16(a1, bfr, c1, 0, 0, 0); }
                const int hk = nt >> 3, wt = nt & 7;
#pragma unroll
                for (int mt = 0; mt < 2; ++mt)
#pragma unroll
                    for (int j = 0; j < 4; ++j) { const int tl = mt * 16 + fq * 4 + j; const int key = keybase + ti.t0 + tl;
                        const float v = (mt ? c1[j] : c0[j]) * rs[tl * 2 + 1];
                        if (wt < 4) KB[((size_t)(ti.b * 4 + hk) * TT + key) * 96 + wt * 16 + fr] = (bf16)f2bf(v);
                        else VT[((size_t)(ti.b * 4 + hk) * 64 + (wt - 4) * 16 + fr) * TT + key] = (bf16)f2bf(v); } }
            { const int tl = tid >> 4, p = tid & 15, ax = p >> 3, f = p & 7; const int t = ti.t0 + tl;
                float x0 = kr[tl * 32 + ax * 16 + f], x1 = kr[tl * 32 + ax * 16 + 8 + f];
                if (!ti.isctx) { const float pos = ax == 0 ? (float)(t >> 6) : (float)(t & 63); const float ang = pos * __expf(-(float)f * (9.210340371976184f / 8.f));
                    float sn, cs; __sincosf(ang, &sn, &cs); const float y0 = x0 * cs - x1 * sn, y1 = x1 * cs + x0 * sn; x0 = y0; x1 = y1; }
                const bf16 b0 = (bf16)f2bf(x0), b1 = (bf16)f2bf(x1);
#pragma unroll
                for (int h = 0; h < 4; ++h) { bf16* kp = KB + ((size_t)(ti.b * 4 + h) * TT + keybase + t) * 96 + 64 + ax * 16 + f; kp[0] = b0; kp[8] = b1; } }
            __syncthreads();
        }
    }
}

__device__ __forceinline__ void attn_unit(unsigned char* lds, const bf16* QB, const bf16* KB, const bf16* VT, bf16* Y, int b, int h, int q0, int key_lo, int nkt, int tid) {
    const int lane = tid & 63, wave = tid >> 6, fr = lane & 15, fq = lane >> 4;
    const int bh = b * 4 + h;
    constexpr int KSTR = 104, VSTR = 72, KBUF = 64 * KSTR, VBUF = 64 * VSTR;
    bf16* Ks = (bf16*)lds;
    bf16* Vs = (bf16*)lds + 2 * KBUF;
    const int qw = q0 + wave * 32;
    bf16x8 qf[2][3];
#pragma unroll
    for (int qt = 0; qt < 2; ++qt)
#pragma unroll
        for (int ks = 0; ks < 3; ++ks) qf[qt][ks] = *(const bf16x8*)(QB + ((size_t)bh * TT + qw + qt * 16 + fr) * 96 + ks * 32 + fq * 8);
    float mrun[2] = {-1e30f, -1e30f}, lrun[2] = {0.f, 0.f};
    f32x4 o[4][2];
#pragma unroll
    for (int dt = 0; dt < 4; ++dt)
#pragma unroll
        for (int qt = 0; qt < 2; ++qt) o[dt][qt] = (f32x4){0.f, 0.f, 0.f, 0.f};
    const v4u* kg = (const v4u*)(KB + ((size_t)bh * TT + key_lo) * 96);
    const bf16* vg = VT + ((size_t)bh * 64 + (tid >> 3)) * TT + key_lo + (tid & 7) * 8;
    const int kc0 = tid, kc1 = 512 + tid;
    const int ko0 = (kc0 / 12) * KSTR + (kc0 % 12) * 8, ko1 = (kc1 / 12) * KSTR + (kc1 % 12) * 8, vo = (tid >> 3) * VSTR + (tid & 7) * 8;
    v4u rk0, rk1 = {0u, 0u, 0u, 0u}, rv;
    rk0 = kg[kc0]; if (tid < 256) rk1 = kg[kc1]; rv = *(const v4u*)vg;
    *(v4u*)(Ks + ko0) = rk0; if (tid < 256) *(v4u*)(Ks + ko1) = rk1; *(v4u*)(Vs + vo) = rv;
    __syncthreads();
    for (int kt = 0; kt < nkt; ++kt) {
        const int cur = kt & 1;
        if (kt + 1 < nkt) { const v4u* kn = kg + (size_t)(kt + 1) * 768; rk0 = kn[kc0]; if (tid < 256) rk1 = kn[kc1]; rv = *(const v4u*)(vg + (kt + 1) * 64); }
        const bf16* kb = Ks + cur * KBUF; const bf16* vb = Vs + cur * VBUF;
        f32x4 st[4][2];
#pragma unroll
        for (int k4 = 0; k4 < 4; ++k4) {
            st[k4][0] = (f32x4){0.f, 0.f, 0.f, 0.f}; st[k4][1] = st[k4][0];
#pragma unroll
            for (int ks = 0; ks < 3; ++ks) { const bf16x8 kf = *(const bf16x8*)(kb + (k4 * 16 + fr) * KSTR + ks * 32 + fq * 8);
                st[k4][0] = __builtin_amdgcn_mfma_f32_16x16x32_bf16(kf, qf[0][ks], st[k4][0], 0, 0, 0);
                st[k4][1] = __builtin_amdgcn_mfma_f32_16x16x32_bf16(kf, qf[1][ks], st[k4][1], 0, 0, 0); }
        }
        bf16x8 pb[2][2];
#pragma unroll
        for (int qt = 0; qt < 2; ++qt) {
            float mx = st[0][qt][0];
#pragma unroll
            for (int k4 = 0; k4 < 4; ++k4)
#pragma unroll
                for (int j = 0; j < 4; ++j) mx = fmaxf(mx, st[k4][qt][j]);
            mx = fmaxf(mx, __shfl_xor(mx, 16)); mx = fmaxf(mx, __shfl_xor(mx, 32));
            const float mn = fmaxf(mrun[qt], mx), alpha = exp2f(mrun[qt] - mn); mrun[qt] = mn;
            float ls = 0.f;
#pragma unroll
            for (int k4 = 0; k4 < 4; ++k4)
#pragma unroll
                for (int j = 0; j < 4; ++j) { const float p = exp2f(st[k4][qt][j] - mn); st[k4][qt][j] = p; ls += p; }
            lrun[qt] = lrun[qt] * alpha + ls;
#pragma unroll
            for (int dt = 0; dt < 4; ++dt) o[dt][qt] *= alpha;
#pragma unroll
            for (int u = 0; u < 2; ++u) { v4u w;
                w.x = pg8::cvt_pk_bf16(st[2 * u][qt][0], st[2 * u][qt][1]); w.y = pg8::cvt_pk_bf16(st[2 * u][qt][2], st[2 * u][qt][3]);
                w.z = pg8::cvt_pk_bf16(st[2 * u + 1][qt][0], st[2 * u + 1][qt][1]); w.w = pg8::cvt_pk_bf16(st[2 * u + 1][qt][2], st[2 * u + 1][qt][3]);
                pb[u][qt] = __builtin_bit_cast(bf16x8, w); }
        }
#pragma unroll
        for (int dt = 0; dt < 4; ++dt)
#pragma unroll
            for (int u = 0; u < 2; ++u) {
                const v2u lo = *(const v2u*)(vb + (dt * 16 + fr) * VSTR + 32 * u + 4 * fq), hi = *(const v2u*)(vb + (dt * 16 + fr) * VSTR + 32 * u + 16 + 4 * fq);
                v4u vw; vw.x = lo.x; vw.y = lo.y; vw.z = hi.x; vw.w = hi.y;
                const bf16x8 va = __builtin_bit_cast(bf16x8, vw);
                o[dt][0] = __builtin_amdgcn_mfma_f32_16x16x32_bf16(va, pb[u][0], o[dt][0], 0, 0, 0);
                o[dt][1] = __builtin_amdgcn_mfma_f32_16x16x32_bf16(va, pb[u][1], o[dt][1], 0, 0, 0);
            }
        if (kt + 1 < nkt) { const int nb = cur ^ 1; *(v4u*)(Ks + nb * KBUF + ko0) = rk0; if (tid < 256) *(v4u*)(Ks + nb * KBUF + ko1) = rk1; *(v4u*)(Vs + nb * VBUF + vo) = rv; }
        __syncthreads();
    }
#pragma unroll
    for (int qt = 0; qt < 2; ++qt) {
        float lt = lrun[qt]; lt += __shfl_xor(lt, 16); lt += __shfl_xor(lt, 32);
        const float inv = 1.f / lt;
        const int q = qw + qt * 16 + fr;
        const size_t row = q < TLEN ? (size_t)b * TLEN + q : (size_t)NLAT + b * CTXL + (q - TLEN);
#pragma unroll
        for (int dt = 0; dt < 4; ++dt) { const f32x4 v = o[dt][qt] * inv; v2u w; w.x = pk2(v[0], v[1]); w.y = pk2(v[2], v[3]);
            *(v2u*)(Y + row * DM + 768 + h * 64 + dt * 16 + fq * 4) = w; }
    }
}
__device__ __forceinline__ void lru_tile(const Args& a, int l, unsigned char* lds, int tile, int tid) {
    unsigned char* ws = karg_ws();
    const int ch = tid & 255, d = tid >> 8;
    const TileInfo ti = tile_info(tile);
    const int row0 = tile * 32;
    const float* SA = (const float*)(ws + M_SEGA); const float* SB = (const float*)(ws + M_SEGB);
    float hst = 0.f;
    const int ctile0 = 512 + ti.b * 8, ltile0 = ti.b * 256;
    if (d == 0) {
        const int nc = ti.isctx ? (tile - ctile0) : 8;
        for (int j = 0; j < nc; ++j) { const size_t o = (size_t)((ctile0 + j) * 2) * 256 + ch; hst = SA[o] * hst + SB[o]; }
        if (!ti.isctx) for (int j = ltile0; j < tile; ++j) { const size_t o = (size_t)(j * 2) * 256 + ch; hst = SA[o] * hst + SB[o]; }
    } else {
        const int lo = ti.isctx ? (tile - ctile0 + 1) : 0;
        for (int j = 7; j >= lo; --j) { const size_t o = (size_t)((ctile0 + j) * 2 + 1) * 256 + ch; hst = SA[o] * hst + SB[o]; }
        if (!ti.isctx) for (int j = ltile0 + 255; j > tile; --j) { const size_t o = (size_t)(j * 2 + 1) * 256 + ch; hst = SA[o] * hst + SB[o]; }
    }
    const float lam = IN(22)[(l * 2 + d) * 256 + ch];
    const float cch = -8.f * log1pf(__expf(-lam));
    const bf16* LR = (const bf16*)(ws + M_LR0 + (size_t)d * A8); const bf16* LIX = (const bf16*)(ws + M_LIX0 + (size_t)d * A8);
    float* hs = (float*)lds;
    for (int tt = 0; tt < 32; ++tt) { const int t = d ? 31 - tt : tt; const size_t o = (size_t)(row0 + t) * 256 + ch;
        const float al = __expf(cch * bf2f(LR[o])); const float bb = sqrtf(fmaxf(1.f - al * al, 0.f)) * bf2f(LIX[o]);
        hst = al * hst + bb; hs[(d * 32 + t) * 256 + ch] = hst; }
    __syncthreads();
    const bf16* GB = (const bf16*)(ws + M_GB); bf16* Y = (bf16*)(ws + OFF_XMY);
    for (int tt = 0; tt < 16; ++tt) { const int t = d * 16 + tt;
        const float y = (hs[t * 256 + ch] + hs[(32 + t) * 256 + ch]) * bf2f(GB[(size_t)(row0 + t) * 256 + ch]);
        Y[(size_t)(row0 + t) * DM + 256 + ch] = (bf16)f2bf(y); }
    __syncthreads();
}
__device__ __forceinline__ void phase_m2(const Args& a, int l, unsigned char* lds, int G, int bid, int tid) {
    unsigned char* ws = karg_ws();
    const bf16* QB = (const bf16*)(ws + M_QB); const bf16* KB = (const bf16*)(ws + M_KB); const bf16* VT = (const bf16*)(ws + M_VT);
    bf16* Y = (bf16*)(ws + OFF_XMY);
    const int nunits = (l == 0) ? 264 : 256;
    for (int u = bid; u < nunits; u += G) {
        if (u < 256) attn_unit(lds, QB, KB, VT, Y, u >> 7, (u >> 5) & 3, (u & 31) * 256, 0, 132, tid);
        else attn_unit(lds, QB, KB, VT, Y, (u - 256) >> 2, (u - 256) & 3, TLEN, TLEN, 4, tid);
    }
    for (int tile = bid; tile < NTILE; tile += G) lru_tile(a, l, lds, tile, tid);
}

__device__ __forceinline__ void phase_m3(const Args& a, int l, unsigned char* lds, int G, int bid, int tid) {
    unsigned char* ws = karg_ws();
    const bf16* U = (const bf16*)(ws + OFF_HU);
    const int lane = tid & 63, ch = tid & 255, part = tid >> 8;
    const float* mup = IN(23) + l * 1024; const float* mun = IN(24) + l * 1024;
    bf16* RR = (bf16*)(ws + M_RR); bf16* KKo = (bf16*)(ws + M_KK); bf16* VV = (bf16*)(ws + M_VV); bf16* GC = (bf16*)(ws + M_GC);
    float* kl = (float*)lds;
    float* tw = (float*)(lds + 32768);
    float* ta = (float*)(lds + 41984);
    float* tg = (float*)(lds + 51200);
    for (int tile = bid; tile < NTILE; tile += G) {
        const TileInfo ti = tile_info(tile);
        const int row0 = tile * 32;
        {
            const int tid2 = ltid(); const int chunk = tid2 & 127, tg8 = tid2 >> 7, c0 = chunk * 8;
            const bf16* ub = U + (size_t)row0 * UC + 1024 + c0;
            v4u rw[10];
#pragma unroll
            for (int q = 0; q < 10; ++q) { const int tl = tg8 * 8 + q - 1; const int t = ti.t0 + tl;
                rw[q] = (t >= 0 && t < ti.seqlen) ? *(const v4u*)(ub + (ptrdiff_t)tl * UC) : (v4u){0u, 0u, 0u, 0u}; }
            const f32x4 mp0 = *(const f32x4*)(mup + c0), mp1 = *(const f32x4*)(mup + c0 + 4), mn0 = *(const f32x4*)(mun + c0), mn1 = *(const f32x4*)(mun + c0 + 4);
            const float mp[8] = {mp0[0], mp0[1], mp0[2], mp0[3], mp1[0], mp1[1], mp1[2], mp1[3]}, mn[8] = {mn0[0], mn0[1], mn0[2], mn0[3], mn1[0], mn1[1], mn1[2], mn1[3]};
#pragma unroll
            for (int q = 0; q < 8; ++q) { const int tl = tg8 * 8 + q; float ts[8];
#pragma unroll
                for (int e = 0; e < 8; ++e) { const unsigned wm = rw[q][e >> 1], w0 = rw[q + 1][e >> 1], wn = rw[q + 2][e >> 1];
                    const float um = (e & 1) ? __uint_as_float(wm & 0xffff0000u) : __uint_as_float(wm << 16);
                    const float u0 = (e & 1) ? __uint_as_float(w0 & 0xffff0000u) : __uint_as_float(w0 << 16);
                    const float un = (e & 1) ? __uint_as_float(wn & 0xffff0000u) : __uint_as_float(wn << 16);
                    ts[e] = u0 + mp[e] * (um - u0) + mn[e] * (un - u0); }
                if (chunk < 32 || (chunk >= 64 && chunk < 96)) { v4u o; o.x = pk2(ts[0], ts[1]); o.y = pk2(ts[2], ts[3]); o.z = pk2(ts[4], ts[5]); o.w = pk2(ts[6], ts[7]);
                    bf16* dst = chunk < 32 ? RR + (size_t)(row0 + tl) * 256 + c0 : VV + (size_t)(row0 + tl) * 256 + (c0 - 512);
                    *(v4u*)dst = o; }
                else if (chunk < 64) { float* kp = kl + tl * 256 + (c0 - 256); *(f32x4*)kp = (f32x4){ts[0], ts[1], ts[2], ts[3]}; *(f32x4*)(kp + 4) = (f32x4){ts[4], ts[5], ts[6], ts[7]}; }
                else if (chunk < 104) {
#pragma unroll
                    for (int e = 0; e < 8; ++e) tw[(c0 - 768 + e) * 36 + tl] = tanhf_(ts[e]); }
                else if (chunk < 112) {
#pragma unroll
                    for (int e = 0; e < 8; ++e) ta[(c0 - 832 + e) * 36 + tl] = ts[e]; }
                else {
#pragma unroll
                    for (int e = 0; e < 8; ++e) tg[(c0 - 896 + e) * 36 + tl] = sigm(ts[e]); }
            }
        }
        __syncthreads();
        {
            const int tid2 = ltid(); const int ch = tid2 & 255, d = tid2 >> 8;
            const float* WU = IN(26) + ((size_t)(l * 2 + d) * 64) * 256 + ch; const float* AU = IN(28) + ((size_t)(l * 2 + d) * 64) * 256 + ch;
            float aw[32], aa[32];
#pragma unroll
            for (int t = 0; t < 32; ++t) { aw[t] = 0.f; aa[t] = 0.f; }
#pragma unroll 2
            for (int i = 0; i < 64; ++i) { const float wu = WU[i * 256], au = AU[i * 256];
#pragma unroll
                for (int t = 0; t < 32; t += 4) { const f32x4 x = *(const f32x4*)(tw + i * 36 + t), y = *(const f32x4*)(ta + i * 36 + t);
                    aw[t] += x[0] * wu; aw[t + 1] += x[1] * wu; aw[t + 2] += x[2] * wu; aw[t + 3] += x[3] * wu;
                    aa[t] += y[0] * au; aa[t + 1] += y[1] * au; aa[t + 2] += y[2] * au; aa[t + 3] += y[3] * au; } }
            const float w0 = IN(25)[(l * 2 + d) * 256 + ch], a0 = IN(27)[(l * 2 + d) * 256 + ch], kkc = IN(30)[l * 256 + ch], kac = IN(31)[l * 256 + ch];
            float* WW = (float*)(ws + M_WW) + (size_t)d * NR * 256; bf16* BB = (bf16*)(ws + M_BB + (size_t)d * A8); bf16* KD = (bf16*)(ws + M_KD + (size_t)d * A8);
#pragma unroll
            for (int t = 0; t < 32; ++t) { const size_t o = (size_t)(row0 + t) * 256 + ch;
                const float k = kl[t * 256 + ch];
                const float kr = k * kkc; const float nrm = wave_sum(kr * kr); const float kk = kr * rsqrtf(fmaxf(nrm, 1e-24f));
                const float e = sigm(w0 + aw[t]) * 0.6065306597126334f;
                const float av = sigm(a0 + aa[t]);
                WW[o] = __expf(-e);
                KD[o] = (bf16)f2bf(k * (1.f + (av - 1.f) * kac));
                BB[o] = (bf16)f2bf(kk * av);
                if (d == 0) KKo[o] = (bf16)f2bf(kk); }
        }
        {
            const float* GU = IN(29) + (size_t)l * 128 * 256 + ch;
            float ag[16];
#pragma unroll
            for (int t = 0; t < 16; ++t) ag[t] = 0.f;
#pragma unroll 2
            for (int i = 0; i < 128; ++i) { const float gu = GU[i * 256];
#pragma unroll
                for (int t = 0; t < 16; t += 4) { const f32x4 x = *(const f32x4*)(tg + i * 36 + part * 16 + t);
                    ag[t] += x[0] * gu; ag[t + 1] += x[1] * gu; ag[t + 2] += x[2] * gu; ag[t + 3] += x[3] * gu; } }
#pragma unroll
            for (int t = 0; t < 16; ++t) GC[(size_t)(row0 + part * 16 + t) * 256 + ch] = (bf16)f2bf(ag[t]);
        }
        __syncthreads();
    }
}

typedef const unsigned cu32;
typedef const float cf32;
__device__ __forceinline__ int chain_row(int b, int d, int tau) {
    return tau < CTXL ? (NLAT + b * CTXL + (d ? CTXL - 1 - tau : tau)) : (b * TLEN + (d ? TLEN - 1 - (tau - CTXL) : (tau - CTXL)));
}
template <int MODE>
__device__ __forceinline__ void rwkv_steps(float (&S)[64], int b, int h, int d, int tau0, int n, unsigned char* ws, int lane, float* wl) {
    const bf16* KKp = (const bf16*)(ws + M_KK); const bf16* RRp = (const bf16*)(ws + M_RR); const bf16* VVp = (const bf16*)(ws + M_VV);
    const float* WWp = (const float*)(ws + M_WW) + (size_t)d * NR * 256; const bf16* BBp = (const bf16*)(ws + M_BB + (size_t)d * A8); const bf16* KDp = (const bf16*)(ws + M_KD + (size_t)d * A8);
    float* YS = (float*)(ws + M_YS) + (size_t)d * NR * 256;
    float pk, pw, pb, pkd = 0.f, pr = 0.f, pv = 0.f; size_t poff;
#define RWKV_LOAD(s_) do { poff = (size_t)chain_row(b, d, tau0 + (s_)) * 256 + h * 64 + lane; pk = bf2f(KKp[poff]); pw = WWp[poff]; pb = bf2f(BBp[poff]); \
        if (MODE != 1) { pkd = bf2f(KDp[poff]); pv = bf2f(VVp[poff]); } if (MODE == 2) pr = bf2f(RRp[poff]); } while (0)
    RWKV_LOAD(0);
    for (int s = 0; s < n; ++s) {
        float* buf = wl + (s & 1) * 320;
        buf[lane] = pk; buf[64 + lane] = pw; buf[128 + lane] = pb;
        if (MODE != 1) buf[192 + lane] = pkd;
        if (MODE == 2) buf[256 + lane] = pr;
        const float vv = pv; const size_t yoff = poff;
        if (s + 1 < n) RWKV_LOAD(s + 1);
        float sa0 = 0.f, sa1 = 0.f, sa2 = 0.f, sa3 = 0.f;
#pragma unroll
        for (int i = 0; i < 64; i += 4) { const f32x4 k4 = *(const f32x4*)(buf + i);
            sa0 += S[i] * k4[0]; sa1 += S[i + 1] * k4[1]; sa2 += S[i + 2] * k4[2]; sa3 += S[i + 3] * k4[3]; }
        const float nsa = -((sa0 + sa1) + (sa2 + sa3));
        float y0 = 0.f, y1 = 0.f, y2 = 0.f, y3 = 0.f;
#pragma unroll
        for (int i = 0; i < 64; i += 4) { const f32x4 w4 = *(const f32x4*)(buf + 64 + i), b4 = *(const f32x4*)(buf + 128 + i);
            f32x4 t = nsa * b4;
            if (MODE != 1) { const f32x4 kd4 = *(const f32x4*)(buf + 192 + i); t += vv * kd4; }
            S[i] = S[i] * w4[0] + t[0]; S[i + 1] = S[i + 1] * w4[1] + t[1]; S[i + 2] = S[i + 2] * w4[2] + t[2]; S[i + 3] = S[i + 3] * w4[3] + t[3];
            if (MODE == 2) { const f32x4 r4 = *(const f32x4*)(buf + 256 + i); y0 += S[i] * r4[0]; y1 += S[i + 1] * r4[1]; y2 += S[i + 2] * r4[2]; y3 += S[i + 3] * r4[3]; } }
        if (MODE == 2) YS[yoff] = (y0 + y1) + (y2 + y3);
    }
#undef RWKV_LOAD
}
__device__ __forceinline__ void rwkv_pass1(float (&SL)[64], float (&SI)[64], int b, int h, int d, int tau0, int n, unsigned char* ws, int lane, float* wl) {
    const bf16* KKp = (const bf16*)(ws + M_KK); const bf16* VVp = (const bf16*)(ws + M_VV);
    const float* WWp = (const float*)(ws + M_WW) + (size_t)d * NR * 256; const bf16* BBp = (const bf16*)(ws + M_BB + (size_t)d * A8); const bf16* KDp = (const bf16*)(ws + M_KD + (size_t)d * A8);
    float pk, pw, pb, pkd, pv; size_t poff;
#define RWKV_LOAD(s_) do { poff = (size_t)chain_row(b, d, tau0 + (s_)) * 256 + h * 64 + lane; pk = bf2f(KKp[poff]); pw = WWp[poff]; pb = bf2f(BBp[poff]); pkd = bf2f(KDp[poff]); pv = bf2f(VVp[poff]); } while (0)
    RWKV_LOAD(0);
    for (int s = 0; s < n; ++s) {
        float* buf = wl + (s & 1) * 256;
        buf[lane] = pk; buf[64 + lane] = pw; buf[128 + lane] = pb; buf[192 + lane] = pkd;
        const float vv = pv;
        if (s + 1 < n) RWKV_LOAD(s + 1);
        float a0 = 0.f, a1 = 0.f, a2 = 0.f, a3 = 0.f, c0 = 0.f, c1 = 0.f, c2 = 0.f, c3 = 0.f;
        {
            f32x4 ka = *(const f32x4*)(buf), kb = *(const f32x4*)(buf + 4), na, nb;
#pragma unroll
            for (int i = 0; i < 64; i += 8) {
                if (i + 8 < 64) { na = *(const f32x4*)(buf + i + 8); nb = *(const f32x4*)(buf + i + 12); }
                a0 += SL[i] * ka[0]; a1 += SL[i + 1] * ka[1]; a2 += SL[i + 2] * ka[2]; a3 += SL[i + 3] * ka[3];
                c0 += SI[i] * ka[0]; c1 += SI[i + 1] * ka[1]; c2 += SI[i + 2] * ka[2]; c3 += SI[i + 3] * ka[3];
                a0 += SL[i + 4] * kb[0]; a1 += SL[i + 5] * kb[1]; a2 += SL[i + 6] * kb[2]; a3 += SL[i + 7] * kb[3];
                c0 += SI[i + 4] * kb[0]; c1 += SI[i + 5] * kb[1]; c2 += SI[i + 6] * kb[2]; c3 += SI[i + 7] * kb[3];
                asm volatile("" ::: "memory");
                ka = na; kb = nb; }
        }
        const float nsl = -((a0 + a1) + (a2 + a3)), nsi = -((c0 + c1) + (c2 + c3));
        {
            f32x4 cw = *(const f32x4*)(buf + 64), cb = *(const f32x4*)(buf + 128), ck = *(const f32x4*)(buf + 192), nw, nb, nk;
#pragma unroll
            for (int i = 0; i < 64; i += 4) {
                if (i + 4 < 64) { nw = *(const f32x4*)(buf + 64 + i + 4); nb = *(const f32x4*)(buf + 128 + i + 4); nk = *(const f32x4*)(buf + 192 + i + 4); }
                const f32x4 tl = nsl * cb + vv * ck, tiv = nsi * cb;
                SL[i] = SL[i] * cw[0] + tl[0]; SL[i + 1] = SL[i + 1] * cw[1] + tl[1]; SL[i + 2] = SL[i + 2] * cw[2] + tl[2]; SL[i + 3] = SL[i + 3] * cw[3] + tl[3];
                SI[i] = SI[i] * cw[0] + tiv[0]; SI[i + 1] = SI[i + 1] * cw[1] + tiv[1]; SI[i + 2] = SI[i + 2] * cw[2] + tiv[2]; SI[i + 3] = SI[i + 3] * cw[3] + tiv[3];
                asm volatile("" ::: "memory");
                cw = nw; cb = nb; ck = nk; }
        }
    }
#undef RWKV_LOAD
}
__device__ __forceinline__ void phase_m4(const Args& a, unsigned char* lds, int G, int bid, int tid) {
    const int lane = tid & 63, wave = __builtin_amdgcn_readfirstlane(tid >> 6);
    unsigned char* ws = karg_ws(); float* PL = (float*)(ws + M_PL);
    if (wave >= 4) return;
    for (int task = bid * 4 + wave; task < 16 * NSEG; task += G * 4) {
        const int seg = task & (NSEG - 1), chain = task >> 6;
        const int d = chain & 1, h = (chain >> 1) & 3, b = chain >> 3;
        float SL[64], SI[64]; int ln = lane; asm volatile("" : "+v"(ln));
#pragma unroll
        for (int i = 0; i < 64; ++i) { SL[i] = 0.f; SI[i] = (i == ln) ? 1.f : 0.f; }
        rwkv_pass1(SL, SI, b, h, d, seg * SEGLEN, SEGLEN, ws, lane, (float*)lds + wave * 512);
        float* o = PL + (((size_t)(chain * NSEG + seg) * 2) * 64 + lane) * 64;
#pragma unroll
        for (int i = 0; i < 64; i += 4) { *(f32x4*)(o + i) = (f32x4){SL[i], SL[i + 1], SL[i + 2], SL[i + 3]}; *(f32x4*)(o + 4096 + i) = (f32x4){SI[i], SI[i + 1], SI[i + 2], SI[i + 3]}; }
    }
}
__device__ __forceinline__ void phase_m5(const Args& a, unsigned char* lds, int G, int bid, int tid) {
    unsigned char* ws = karg_ws(); const float* PL = (const float*)(ws + M_PL); float* SI = (float*)(ws + M_SINIT);
    float* Sl = (float*)lds;
    float* Pl = (float*)(lds + 8192);
    typedef float f32x2v __attribute__((ext_vector_type(2)));
    const int rl = tid >> 5, c2 = (tid & 31) * 2;
    for (int u = bid; u < 64; u += G) {
        const int chain = u >> 2, row = (u & 3) * 16 + rl;
        f32x2v cur = {0.f, 0.f};
        const float* Pg = PL + ((size_t)(chain * NSEG) * 2 + 1) * 4096; const float* Lg = PL + ((size_t)(chain * NSEG) * 2) * 4096;
        f32x4 p0 = *(const f32x4*)(Pg + tid * 8), p1 = *(const f32x4*)(Pg + tid * 8 + 4); f32x2v lv = *(const f32x2v*)(Lg + row * 64 + c2);
        for (int g = 0; g < NSEG; ++g) {
            *(f32x2v*)(SI + ((size_t)(chain * NSEG + g) * 64 + row) * 64 + c2) = cur;
            if (g == NSEG - 1) break;
            *(f32x2v*)(Sl + rl * 66 + c2) = cur;
            *(f32x4*)(Pl + tid * 8) = p0; *(f32x4*)(Pl + tid * 8 + 4) = p1;
            f32x2v nw = lv;
            if (g + 2 < NSEG) { const float* Pn = Pg + (size_t)(g + 1) * 8192; const float* Ln = Lg + (size_t)(g + 1) * 8192;
                p0 = *(const f32x4*)(Pn + tid * 8); p1 = *(const f32x4*)(Pn + tid * 8 + 4); lv = *(const f32x2v*)(Ln + row * 64 + c2); }
            __syncthreads();
#pragma unroll 16
            for (int i = 0; i < 64; ++i) { const float sv = Sl[rl * 66 + i]; const f32x2v pv = *(const f32x2v*)(Pl + i * 64 + c2); nw += sv * pv; }
            cur = nw;
            __syncthreads();
        }
    }
}
__device__ __forceinline__ void phase_m6(const Args& a, unsigned char* lds, int G, int bid, int tid) {
    const int lane = tid & 63, wave = __builtin_amdgcn_readfirstlane(tid >> 6);
    unsigned char* ws = karg_ws(); const float* SI = (const float*)(ws + M_SINIT);
    if (wave >= 4) return;
    for (int task = bid * 4 + wave; task < 16 * NSEG; task += G * 4) {
        const int seg = task & (NSEG - 1), chain = task >> 6;
        const int d = chain & 1, h = (chain >> 1) & 3, b = chain >> 3;
        float S[64];
        const float* si = SI + ((size_t)(chain * NSEG + seg) * 64 + lane) * 64;
#pragma unroll
        for (int i = 0; i < 64; i += 4) { const f32x4 v = *(const f32x4*)(si + i); S[i] = v[0]; S[i + 1] = v[1]; S[i + 2] = v[2]; S[i + 3] = v[3]; }
        rwkv_steps<2>(S, b, h, d, seg * SEGLEN, SEGLEN, ws, lane, (float*)lds + wave * 640);
    }
}
__device__ __forceinline__ void phase_m7(const Args& a, int l, int gw, int NGW, int lane) {
    unsigned char* ws = karg_ws();
    const float* Y0 = (const float*)(ws + M_YS); const float* Y1 = Y0 + (size_t)NR * 256;
    const bf16* RR = (const bf16*)(ws + M_RR); const bf16* VV = (const bf16*)(ws + M_VV); const bf16* KD0 = (const bf16*)(ws + M_KD); const bf16* KD1 = (const bf16*)(ws + M_KD + A8);
    const bf16* GC = (const bf16*)(ws + M_GC); bf16* Y = (bf16*)(ws + OFF_XMY);
    for (int r = gw; r < NR; r += NGW) {
#pragma unroll
        for (int h = 0; h < 4; ++h) { const int c = h * 64 + lane; const size_t o = (size_t)r * 256 + c;
            const float ys = Y0[o] + Y1[o];
            const float mu = wave_sum(ys) * (1.f / 64.f); const float dv = ys - mu; const float var = wave_sum(dv * dv) * (1.f / 64.f);
            float ov = dv * rsqrtf(var + 64e-5f) * IN(33)[l * 256 + c] + IN(34)[l * 256 + c];
            const float rv = bf2f(RR[o]), rk = IN(32)[l * 256 + c], vv = bf2f(VV[o]);
            const float b0 = wave_sum(rv * bf2f(KD0[o]) * rk), b1 = wave_sum(rv * bf2f(KD1[o]) * rk);
            ov += (b0 + b1) * vv;
            Y[(size_t)r * DM + 512 + c] = (bf16)f2bf(ov * bf2f(GC[o])); }
    }
}

__global__ void __launch_bounds__(512, 2) mega(Args a) {
    extern __shared__ __attribute__((aligned(16))) unsigned char lds[];
    cg::grid_group grid = cg::this_grid();
    const int G = gridDim.x;
    PG8_LAS unsigned char* glds = (PG8_LAS unsigned char*)lds;
#define bid lbid()
#define tid ltid()
#define lane (ltid() & 63)
#define wave (__builtin_amdgcn_readfirstlane(ltid() >> 6))
#define gw (lbid() * 8 + __builtin_amdgcn_readfirstlane(ltid() >> 6))
#define NGW (G * 8)
#define GSYNC() do { grid.sync(); } while (0)

    phase_modgemv(a, (float*)lds, G, bid, tid);
    phase_copy(a, G, bid, tid);
    convert_weights(a, 0, (float*)(lds + 32768) + wave * (64 * 33), gw, NGW, lane, G, bid, tid);
    GSYNC();
#pragma clang loop unroll(full)
    for (int l = 0; l < 2; ++l) {
        if (l > 0) convert_weights(a, l, (float*)lds + wave * (64 * 33), gw, NGW, lane, G, bid, tid);
        phase_modulate(a, l, 0, gw, NGW, lane);
        GSYNC();
        for (int rp = 0; rp < REP_G1; ++rp)
        {
            unsigned char* ws = karg_ws(); float* outp = karg_out(); float* xctx = (float*)(ws + OFF_XCTX); bf16* XM = (bf16*)(ws + OFF_XMY); bf16* HU = (bf16*)(ws + OFF_HU); const float* modl = (const float*)(ws + OFF_MOD) + (size_t)l * 3 * 9216; (void)xctx; (void)XM; (void)HU; (void)modl; (void)outp;
            pg8::Gemm g{XM, (const bf16*)(ws + W_13A), NR, 2 * DFF, DM}; pg8::StaticOrder S; S.init(NR, 2 * DFF, G, bid, DM);
            EpiSwiglu E{HU};
            pg8::gemm_phase<EpiSwiglu, pg8::StaticOrder, true, true>(glds, g, S, E);
        }
        GSYNC();
        {
            unsigned char* ws = karg_ws(); float* outp = karg_out(); float* xctx = (float*)(ws + OFF_XCTX); bf16* XM = (bf16*)(ws + OFF_XMY); bf16* HU = (bf16*)(ws + OFF_HU); const float* modl = (const float*)(ws + OFF_MOD) + (size_t)l * 3 * 9216; (void)xctx; (void)XM; (void)HU; (void)modl; (void)outp;
            pg8::Gemm g{HU, (const bf16*)(ws + W_2A), NR, DM, DFF}; pg8::SplitOrder S; S.init(G, bid, DFF);
            EpiResid E{outp, xctx, modl + 2 * 1024, 0.5f};
            pg8::gemm_phase<EpiResid, pg8::SplitOrder, true, true>(glds, g, S, E);
        }
        GSYNC();
        phase_modulate(a, l, 1, gw, NGW, lane);
        GSYNC();
        {
            unsigned char* ws = karg_ws(); float* outp = karg_out(); float* xctx = (float*)(ws + OFF_XCTX); bf16* XM = (bf16*)(ws + OFF_XMY); bf16* HU = (bf16*)(ws + OFF_HU); const float* modl = (const float*)(ws + OFF_MOD) + (size_t)l * 3 * 9216; (void)xctx; (void)XM; (void)HU; (void)modl; (void)outp;
            pg8::Gemm g{XM, (const bf16*)(ws + W_IN), NR, UC, DM}; pg8::StaticOrder S; S.init(NR, UC, G, bid, DM);
            EpiU E{HU, UC};
            pg8::gemm_phase<EpiU, pg8::StaticOrder, true, true>(glds, g, S, E);
        }
        GSYNC();
        for (int rp = 0; rp < REP_M1; ++rp) { phase_m1(a, l, lds, G, bid, tid);
        GSYNC(); }
        for (int rp = 0; rp < REP_M2; ++rp) { phase_m2(a, l, lds, G, bid, tid);
        GSYNC(); }
        for (int rp = 0; rp < REP_M3; ++rp) { phase_m3(a, l, lds, G, bid, tid);
        GSYNC(); }
        for (int rp = 0; rp < REP_SCAN; ++rp) { phase_m4(a, lds, G, bid, tid);
        GSYNC();
        phase_m5(a, lds, G, bid, tid);
        GSYNC();
        phase_m6(a, lds, G, bid, tid);
        GSYNC(); }
        phase_m7(a, l, gw, NGW, lane);
        GSYNC();
        {
            unsigned char* ws = karg_ws(); float* outp = karg_out(); float* xctx = (float*)(ws + OFF_XCTX); bf16* XM = (bf16*)(ws + OFF_XMY); bf16* HU = (bf16*)(ws + OFF_HU); const float* modl = (const float*)(ws + OFF_MOD) + (size_t)l * 3 * 9216; (void)xctx; (void)XM; (void)HU; (void)modl; (void)outp;
            pg8::Gemm g{XM, (const bf16*)(ws + W_OUT), NR, DM, DM}; pg8::SplitOrder S; S.init(G, bid, DM);
            EpiResid E{outp, xctx, modl + 5 * 1024, 1.0f};
            pg8::gemm_phase<EpiResid, pg8::SplitOrder, true, true>(glds, g, S, E);
        }
        GSYNC();
        phase_modulate(a, l, 2, gw, NGW, lane);
        GSYNC();
        {
            unsigned char* ws = karg_ws(); float* outp = karg_out(); float* xctx = (float*)(ws + OFF_XCTX); bf16* XM = (bf16*)(ws + OFF_XMY); bf16* HU = (bf16*)(ws + OFF_HU); const float* modl = (const float*)(ws + OFF_MOD) + (size_t)l * 3 * 9216; (void)xctx; (void)XM; (void)HU; (void)modl; (void)outp;
            pg8::Gemm g{XM, (const bf16*)(ws + W_13B), NR, 2 * DFF, DM}; pg8::StaticOrder S; S.init(NR, 2 * DFF, G, bid, DM);
            EpiSwiglu E{HU};
            pg8::gemm_phase<EpiSwiglu, pg8::StaticOrder, true, true>(glds, g, S, E);
        }
        GSYNC();
        {
            unsigned char* ws = karg_ws(); float* outp = karg_out(); float* xctx = (float*)(ws + OFF_XCTX); bf16* XM = (bf16*)(ws + OFF_XMY); bf16* HU = (bf16*)(ws + OFF_HU); const float* modl = (const float*)(ws + OFF_MOD) + (size_t)l * 3 * 9216; (void)xctx; (void)XM; (void)HU; (void)modl; (void)outp;
            pg8::Gemm g{HU, (const bf16*)(ws + W_2B), NR, DM, DFF}; pg8::SplitOrder S; S.init(G, bid, DFF);
            EpiResid E{outp, xctx, modl + 8 * 1024, 0.5f};
            pg8::gemm_phase<EpiResid, pg8::SplitOrder, true, true>(glds, g, S, E);
        }
        GSYNC();
    }
    phase_final(a, gw, NGW, lane);
#undef bid
#undef tid
#undef lane
#undef wave
#undef gw
#undef NGW
}

extern "C" void kernel_launch(void* const* d_in, const int* in_sizes, int n_in, void* d_out, int out_size, void* d_ws, size_t ws_size, hipStream_t stream) {
    static int grid = 0;
    if (grid == 0) {
        int dev = 0, cus = 0, per_cu = 0;
        (void)hipGetDevice(&dev);
        (void)hipDeviceGetAttribute(&cus, hipDeviceAttributeMultiprocessorCount, dev);
        (void)hipFuncSetAttribute((const void*)mega, hipFuncAttributeMaxDynamicSharedMemorySize, LDS_BYTES);
        (void)hipOccupancyMaxActiveBlocksPerMultiprocessor(&per_cu, (const void*)mega, 512, LDS_BYTES);
        if (per_cu < 1) per_cu = 1;
        grid = cus * per_cu;
        if (n_in != 40 || ws_size < WS_NEED) { fprintf(stderr, "kernel_launch: unexpected n_in %d / ws %zu (need %zu)\n", n_in, ws_size, (size_t)WS_NEED); }
    }
    (void)hipMemsetAsync((char*)d_ws + OFF_MOD, 0, MOD_BYTES, stream);
    Args a{};
    for (int i = 0; i < 40; ++i) a.in[i] = (const float*)d_in[i];
    a.out = (float*)d_out; a.ws = (unsigned char*)d_ws;
    void* args[] = {&a};
    hipError_t e = hipLaunchCooperativeKernel((const void*)mega, dim3(grid), dim3(512), args, LDS_BYTES, stream);
    if (e != hipSuccess) fprintf(stderr, "cooperative launch failed: %s (grid %d)\n", hipGetErrorString(e), grid);
}
```

```cpp
#include <hip/hip_runtime.h>
#include <hip/hip_cooperative_groups.h>
#include <cstdio>
#include <cstdint>
namespace cg = cooperative_groups;
namespace pg8 {
#define PG8_LAS __attribute__((address_space(3)))
typedef unsigned short bf16_t;
typedef short bf16x8 __attribute__((ext_vector_type(8)));
typedef float f32x4 __attribute__((ext_vector_type(4)));
typedef unsigned u32x4 __attribute__((ext_vector_type(4)));
constexpr int BM = 256, BK = 64, HALF = 128, HTB = HALF * BK * 2  , STAGE_BYTES = 8 * HTB, NXCD = 8, WGM = 8;

__host__ __device__ __forceinline__ int lds_byte(int r, int c) { const int st = (r >> 4) * 2 + (c >> 5), rr = r & 15, cc = c & 31, ob = rr * 64 + cc * 2; return st * 1024 + (ob ^ (((ob >> 9) & 1) << 5)); }
__host__ __device__ __forceinline__ void stage_rc(int b, int& R, int& C) { const int st = b / 1024, sb = b % 1024, swz = sb ^ (((sb >> 9) & 1) << 5); R = (st >> 1) * 16 + swz / 64; C = (st & 1) * 32 + (swz % 64) / 2; }
__host__ __device__ __forceinline__ int perm32(int rho) { const int n = rho >> 4, i = rho & 15; return 8 * (i >> 2) + 4 * n + (i & 3); }

struct Unit { int pm, pn; };
struct Gemm { const bf16_t* A; const bf16_t* Bt; int M, N, K; };

struct StaticOrder {
    int nM, nN, nwg, G, c;
    __host__ __device__ void init(int M, int N, int G_, int c_) { nM = M / BM; nN = N / BM; nwg = nM * nN; G = G_; c = c_; }
    __host__ __device__ bool next(int i, Unit& u) const {
        const long L = (long)i * G + c; if (L >= nwg) return false;
        int wgid = (int)L; { const int q = nwg / NXCD, r = nwg % NXCD, xcd = wgid % NXCD, off = wgid / NXCD; wgid = (xcd < r ? xcd * (q + 1) : r * (q + 1) + (xcd - r) * q) + off; }
        const int nig = WGM * nN, gid = wgid / nig, fm = gid * WGM, gsz = (nM - fm) < WGM ? (nM - fm) : WGM;
        u.pm = fm + ((wgid % nig) % gsz); u.pn = (wgid % nig) / gsz; return true;
    }
    __device__ __forceinline__ void a_ready(const Unit&) const {}
    __device__ __forceinline__ void done(const Unit&) const {}
};

__device__ __forceinline__ unsigned cvt_pk_bf16(float lo, float hi) { unsigned r; asm volatile("v_cvt_pk_bf16_f32 %0, %1, %2" : "=v"(r) : "v"(lo), "v"(hi)); return r; }
typedef float f32x2 __attribute__((ext_vector_type(2)));
template <class Epi, class Sched, bool ALIGN_EPI = false, bool SP2 = false>
__device__ __forceinline__ void gemm_phase(PG8_LAS unsigned char* lds, const Gemm g, const Sched& S, const Epi& E) {
    int tid = threadIdx.x; asm volatile("" : "+v"(tid));
    const int wid = __builtin_amdgcn_readfirstlane(tid >> 6), lane = tid & 63, wr = wid >> 2, wc = wid & 3, fr = lane & 15, fq = lane >> 4;
    const int K = g.K, nt = K / BK;
    unsigned voffA[2], voffB[2];
#pragma unroll
    for (int i = 0; i < 2; ++i) { int R, C; stage_rc(tid * 16 + i * 8192, R, C); const int Rb = Epi::PERM ? ((R & ~31) + perm32(R & 31)) : R;
        voffA[i] = (unsigned)(R * K + C) * 2u; voffB[i] = (unsigned)(Rb * K + C) * 2u; }
    const size_t kstep = (size_t)(BK * 2);
    const size_t hstep = (size_t)HALF * K * 2;
    const size_t tstep = 2 * hstep;
    const unsigned ldsw = (unsigned)wid * 1024u;
    const int aoff = lds_byte(wr * 64 + fr, fq * 8), boff = lds_byte(wc * 32 + fr, fq * 8);
#define PG8_SA(b, h) (((b) * 2 + (h)) * HTB)
#define PG8_SB(b, h) ((4 + (b) * 2 + (h)) * HTB)
#define PG8_STAGE(bufoff, gbase, voff) do { _Pragma("unroll") for (int _i = 0; _i < 2; ++_i) \
        __builtin_amdgcn_global_load_lds((const unsigned*)((const char*)(gbase) + (voff)[_i]), (PG8_LAS unsigned*)(lds + (bufoff) + ldsw + _i * 8192), 16, 0, 0); } while (0)
#define PG8_LDA(dst, b, h) do { _Pragma("unroll") for (int m = 0; m < 4; ++m) _Pragma("unroll") for (int k = 0; k < 2; ++k) dst[m][k] = *(const PG8_LAS bf16x8*)(lds + PG8_SA(b, h) + aoff + m * 2048 + k * 1024); } while (0)
#define PG8_LDB(dst, b, h) do { _Pragma("unroll") for (int n = 0; n < 2; ++n) _Pragma("unroll") for (int k = 0; k < 2; ++k) dst[n][k] = *(const PG8_LAS bf16x8*)(lds + PG8_SB(b, h) + boff + n * 2048 + k * 1024); } while (0)
#define PG8_MMA(ai, bj, At, Bt) do { __builtin_amdgcn_s_setprio(1); _Pragma("unroll") for (int m = 0; m < 4; ++m) _Pragma("unroll") for (int n = 0; n < 2; ++n) _Pragma("unroll") for (int k = 0; k < 2; ++k) \
        acc[ai][bj][m][n] = __builtin_amdgcn_mfma_f32_16x16x32_bf16(Bt[n][k], At[m][k], acc[ai][bj][m][n], 0, 0, 0); __builtin_amdgcn_s_setprio(0); } while (0)
#define PG8_WAIT_V(n) asm volatile("s_waitcnt vmcnt(" #n ")" ::: "memory")
#define PG8_WAIT_L(n) asm volatile("s_waitcnt lgkmcnt(" #n ")" ::: "memory")
#define PG8_BAR __builtin_amdgcn_s_barrier()
#define PG8_SCHED __builtin_amdgcn_sched_barrier(0)
    Unit cur, nxt; int ui = 0;
    if (!S.next(0, cur)) return;
    f32x4 acc[2][2][4][2];
#pragma unroll
    for (int a = 0; a < 2; ++a)
#pragma unroll
        for (int b = 0; b < 2; ++b)
#pragma unroll
            for (int m = 0; m < 4; ++m)
#pragma unroll
                for (int n = 0; n < 2; ++n) acc[a][b][m][n] = (f32x4){0.f, 0.f, 0.f, 0.f};
    bf16x8 At[4][2], B0[2][2], B1[2][2];
    const char* cA = (const char*)g.A + (size_t)cur.pm * tstep; const char* cB = (const char*)g.Bt + (size_t)cur.pn * tstep;
    S.a_ready(cur);
    if constexpr (SP2) {
        PG8_STAGE(PG8_SB(0, 0), cB, voffB); PG8_STAGE(PG8_SB(0, 1), cB + hstep, voffB); PG8_STAGE(PG8_SA(0, 0), cA, voffA); PG8_STAGE(PG8_SA(0, 1), cA + hstep, voffA);
        if (wr == 1) PG8_BAR;
        PG8_WAIT_V(2); PG8_BAR;
        PG8_STAGE(PG8_SB(1, 0), cB + kstep, voffB); PG8_STAGE(PG8_SA(1, 0), cA + kstep, voffA); PG8_STAGE(PG8_SB(1, 1), cB + hstep + kstep, voffB);
        PG8_WAIT_V(6); PG8_BAR;
    } else {
        PG8_STAGE(PG8_SB(0, 0), cB, voffB); PG8_STAGE(PG8_SA(0, 0), cA, voffA); PG8_STAGE(PG8_SB(0, 1), cB + hstep, voffB); PG8_STAGE(PG8_SA(0, 1), cA + hstep, voffA);
        if (wr == 1) PG8_BAR;
        PG8_WAIT_V(4); PG8_BAR;
        PG8_STAGE(PG8_SB(1, 0), cB + kstep, voffB); PG8_STAGE(PG8_SA(1, 0), cA + kstep, voffA); PG8_STAGE(PG8_SB(1, 1), cB + hstep + kstep, voffB);
        PG8_WAIT_V(6); PG8_BAR;
    }
    for (;;) {
        const bool has_next = S.next(ui + 1, nxt);
        const char* nA = has_next ? (const char*)g.A + (size_t)nxt.pm * tstep : cA; const char* nB = has_next ? (const char*)g.Bt + (size_t)nxt.pn * tstep : cB;
        for (int t = 0; t < nt; t += 2) {
            const bool last = (t == nt - 2);
            const char* a1 = cA + (size_t)(t + 1) * kstep;
            const char* a2 = last ? nA : cA + (size_t)(t + 2) * kstep; const char* b2 = last ? nB : cB + (size_t)(t + 2) * kstep;
            const char* a3 = a2 + kstep; const char* b3 = b2 + kstep;
            if (last && has_next) S.a_ready(nxt);
            if constexpr (SP2) {
            PG8_LDB(B0, 0, 0); PG8_LDB(B1, 0, 1); PG8_SCHED; PG8_LDA(At, 0, 0); PG8_STAGE(PG8_SA(1, 1), a1 + hstep, voffA);
            PG8_WAIT_V(8); PG8_WAIT_L(0); PG8_BAR; PG8_MMA(0, 0, At, B0); PG8_MMA(0, 1, At, B1); PG8_BAR; PG8_SCHED;
            PG8_LDA(At, 0, 1); PG8_STAGE(PG8_SB(0, 0), b2, voffB); PG8_STAGE(PG8_SB(0, 1), b2 + hstep, voffB); PG8_STAGE(PG8_SA(0, 0), a2, voffA);
            PG8_WAIT_V(8); PG8_WAIT_L(0); PG8_BAR; PG8_MMA(1, 0, At, B0); PG8_MMA(1, 1, At, B1); PG8_BAR; PG8_SCHED;
            PG8_LDB(B0, 1, 0); PG8_LDB(B1, 1, 1); PG8_SCHED; PG8_LDA(At, 1, 0); PG8_STAGE(PG8_SA(0, 1), a2 + hstep, voffA);
            PG8_WAIT_V(8); PG8_WAIT_L(0); PG8_BAR; PG8_MMA(0, 0, At, B0); PG8_MMA(0, 1, At, B1); PG8_BAR; PG8_SCHED;
            PG8_LDA(At, 1, 1); PG8_STAGE(PG8_SB(1, 0), b3, voffB); PG8_STAGE(PG8_SB(1, 1), b3 + hstep, voffB); PG8_STAGE(PG8_SA(1, 0), a3, voffA);
            PG8_WAIT_V(8); PG8_WAIT_L(0); PG8_BAR; PG8_MMA(1, 0, At, B0); PG8_MMA(1, 1, At, B1); PG8_BAR; PG8_SCHED;
            } else {
            PG8_LDB(B0, 0, 0); PG8_SCHED; PG8_LDA(At, 0, 0); PG8_STAGE(PG8_SA(1, 1), a1 + hstep, voffA);
            PG8_WAIT_L(8); PG8_BAR; PG8_WAIT_L(0); PG8_MMA(0, 0, At, B0); PG8_BAR; PG8_SCHED;
            PG8_LDB(B1, 0, 1); PG8_STAGE(PG8_SB(0, 0), b2, voffB);
            PG8_BAR; PG8_WAIT_L(0); PG8_MMA(0, 1, At, B1); PG8_BAR;
            PG8_LDA(At, 0, 1); PG8_STAGE(PG8_SA(0, 0), a2, voffA);
            PG8_BAR; PG8_WAIT_L(0); PG8_MMA(1, 0, At, B0); PG8_BAR; PG8_SCHED;
            PG8_STAGE(PG8_SB(0, 1), b2 + hstep, voffB);
            PG8_WAIT_V(6); PG8_BAR; PG8_MMA(1, 1, At, B1); PG8_BAR;
            PG8_LDB(B0, 1, 0); PG8_SCHED; PG8_LDA(At, 1, 0); PG8_STAGE(PG8_SA(0, 1), a2 + hstep, voffA);
            PG8_WAIT_L(8); PG8_BAR; PG8_WAIT_L(0); PG8_MMA(0, 0, At, B0); PG8_BAR; PG8_SCHED;
            PG8_LDB(B1, 1, 1); PG8_STAGE(PG8_SB(1, 0), b3, voffB);
            PG8_BAR; PG8_WAIT_L(0); PG8_MMA(0, 1, At, B1); PG8_BAR;
            PG8_LDA(At, 1, 1); PG8_STAGE(PG8_SA(1, 0), a3, voffA);
            PG8_BAR; PG8_WAIT_L(0); PG8_MMA(1, 0, At, B0); PG8_BAR; PG8_SCHED;
            PG8_STAGE(PG8_SB(1, 1), b3 + hstep, voffB);
            PG8_WAIT_V(6); PG8_BAR; PG8_MMA(1, 1, At, B1); PG8_BAR;
            }
        }
        if constexpr (ALIGN_EPI) { if (wr == 0) PG8_BAR; }
        if constexpr (!Epi::AFTER_DRAIN) { E(acc, cur, wr, wc, fr, fq); S.done(cur); }
        if (!has_next) break;
#pragma unroll
        for (int a = 0; a < 2; ++a)
#pragma unroll
            for (int b = 0; b < 2; ++b)
#pragma unroll
                for (int m = 0; m < 4; ++m)
#pragma unroll
                    for (int n = 0; n < 2; ++n) acc[a][b][m][n] = (f32x4){0.f, 0.f, 0.f, 0.f};
        cur = nxt; cA = nA; cB = nB; ++ui;
        if constexpr (ALIGN_EPI) { if (wr == 1) PG8_BAR; }
    }
    PG8_WAIT_V(0);
    if constexpr (!ALIGN_EPI) { if (wr == 0) PG8_BAR; }
    PG8_BAR;
    if constexpr (Epi::AFTER_DRAIN) { E.fused(acc, cur, wr, wc, fr, fq, lds, wid, lane); S.done(cur); }
#undef PG8_SA
#undef PG8_SB
#undef PG8_STAGE
#undef PG8_LDA
#undef PG8_LDB
#undef PG8_MMA
#undef PG8_WAIT_V
#undef PG8_WAIT_L
#undef PG8_BAR
#undef PG8_SCHED
}
}

using pg8::f32x4; using pg8::bf16x8;
typedef unsigned short bf16;
typedef unsigned v4u __attribute__((ext_vector_type(4)));
typedef unsigned v2u __attribute__((ext_vector_type(2)));
typedef short s16x4 __attribute__((ext_vector_type(4)));

constexpr int DM = 1024, TLEN = 8192, CTXL = 256, TT = 8448, NLAT = 16384, NR = 16896, DFF = 2816, UC = 2560, NTILE = 528;
constexpr int NSEG = 64, SEGLEN = 132;
constexpr size_t MiB = 1u << 20;
constexpr size_t A8 = (size_t)NR * 256 * 2;
constexpr size_t OFF_MOD = 0, MOD_BYTES = 256 * 1024;
constexpr size_t OFF_XCTX = MiB / 4, OFF_XMY = 2 * MiB + MiB / 4, OFF_HU = 35 * MiB + MiB / 4, OFF_W = 126 * MiB, OFF_MIX = 166 * MiB + MiB / 2, OFF_PR = 265 * MiB + MiB / 2;
constexpr size_t W_13A = OFF_W, W_2A = OFF_W + 11 * MiB, W_13B = OFF_W + 16 * MiB + MiB / 2, W_2B = OFF_W + 27 * MiB + MiB / 2,
                 W_IN = OFF_W + 33 * MiB, W_OUT = OFF_W + 38 * MiB, W_UQ = OFF_W + 40 * MiB, W_UKV = OFF_W + 40 * MiB + 256 * 1024;
constexpr size_t M_QB = OFF_MIX, M_KB = OFF_MIX + 12976128, M_VT = OFF_MIX + 25952256;
constexpr size_t M_LR0 = OFF_MIX + 4 * A8, M_LIX0 = OFF_MIX + 6 * A8, M_GB = OFF_MIX + 8 * A8, M_SEGA = OFF_MIX + 9 * A8, M_SEGB = M_SEGA + 2 * MiB;
constexpr size_t M_RR = OFF_MIX, M_KK = OFF_MIX + A8, M_VV = OFF_MIX + 2 * A8, M_WW = OFF_MIX + 3 * A8, M_BB = OFF_MIX + 7 * A8, M_KD = OFF_MIX + 9 * A8, M_GC = OFF_MIX + 11 * A8;
constexpr size_t M_YS = OFF_HU, M_PL = OFF_HU + 33 * MiB, M_SINIT = OFF_HU + 65 * MiB;
constexpr size_t M_PR = OFF_PR;
constexpr size_t WS_NEED = OFF_PR + 33 * MiB;
constexpr int LDS_BYTES = 131072 + 1024;
#ifndef REP_M1
#define REP_M1 1
#endif
#ifndef REP_M2
#define REP_M2 1
#endif
#ifndef REP_M3
#define REP_M3 1
#endif
#ifndef REP_SCAN
#define REP_SCAN 1
#endif
#ifndef REP_G1
#define REP_G1 1
#endif
constexpr float QSCALE = 0.10206207261596575f * 1.4426950408889634f;

struct Args { const float* in[40]; float* out; unsigned char* ws; };
typedef const __attribute__((address_space(4))) volatile unsigned long long kargq;
__device__ __forceinline__ const float* karg_in(int i) { kargq* p = (kargq*)__builtin_amdgcn_kernarg_segment_ptr(); return (const float*)p[i]; }
__device__ __forceinline__ float* karg_out() { kargq* p = (kargq*)__builtin_amdgcn_kernarg_segment_ptr(); return (float*)p[40]; }
__device__ __forceinline__ unsigned char* karg_ws() { kargq* p = (kargq*)__builtin_amdgcn_kernarg_segment_ptr(); return (unsigned char*)p[41]; }
#define IN(i) karg_in(i)
__device__ __forceinline__ int ltid() { int t = threadIdx.x; asm volatile("" : "+v"(t)); return t; }
__device__ __forceinline__ int lbid() { int t = blockIdx.x; asm volatile("" : "+s"(t)); return t; }
template <class T> __device__ __forceinline__ T* launder(T* p) { asm volatile("" : "+s"(p)); return p; }

__device__ __forceinline__ float bf2f(bf16 h) { return __uint_as_float((unsigned)h << 16); }
__device__ __forceinline__ unsigned f2bf(float f) { unsigned u = __float_as_uint(f); return (u + 0x7fffu + ((u >> 16) & 1u)) >> 16; }
__device__ __forceinline__ unsigned pk2(float lo, float hi) { return f2bf(lo) | (f2bf(hi) << 16); }
__device__ __forceinline__ float sigm(float x) { return 1.f / (1.f + __expf(-x)); }
__device__ __forceinline__ float siluf_(float x) { return x / (1.f + __expf(-x)); }
__device__ __forceinline__ float tanhf_(float y) { return 1.f - 2.f / (1.f + __expf(2.f * y)); }
__device__ __forceinline__ float geluf_(float x) { return 0.5f * x * (1.f + tanhf_(0.7978845608028654f * (x + 0.044715f * x * x * x))); }
__device__ __forceinline__ float wave_sum(float v) {
#pragma unroll
    for (int o = 1; o < 64; o <<= 1) v += __shfl_xor(v, o);
    return v;
}
struct TileInfo { int b, isctx, t0, seqbase, seqlen; };
__device__ __forceinline__ TileInfo tile_info(int tile) {
    TileInfo ti;
    if (tile < 512) { ti.b = tile >> 8; ti.isctx = 0; ti.t0 = (tile & 255) * 32; ti.seqbase = ti.b * TLEN; ti.seqlen = TLEN; }
    else { const int q = tile - 512; ti.b = q >> 3; ti.isctx = 1; ti.t0 = (q & 7) * 32; ti.seqbase = NLAT + ti.b * CTXL; ti.seqlen = CTXL; }
    return ti;
}

struct EpiSwiglu {
    static constexpr bool PERM = true, AFTER_DRAIN = false;
    bf16* H;
    __device__ __forceinline__ void operator()(const f32x4 (&acc)[2][2][4][2], const pg8::Unit& u, int wr, int wc, int fr, int fq) const {
        int pm = u.pm, pn = u.pn; asm volatile("" : "+s"(pm), "+s"(pn), "+s"(wr), "+s"(wc), "+v"(fr), "+v"(fq));
        bf16* tb = H + (size_t)pm * 256 * DFF + pn * 128;
        const unsigned loff = (unsigned)((wr * 64 + fr) * DFF + wc * 32 + 8 * fq);
#pragma unroll
        for (int ai = 0; ai < 2; ++ai)
#pragma unroll
            for (int m = 0; m < 4; ++m) {
                bf16* rowp = tb + (loff + (unsigned)((ai * 128 + m * 16) * DFF));
                const f32x4 g0 = acc[ai][0][m][0], g1 = acc[ai][0][m][1], u0 = acc[ai][1][m][0], u1 = acc[ai][1][m][1];
                v4u w;
                w.x = pg8::cvt_pk_bf16(siluf_(g0[0]) * u0[0], siluf_(g0[1]) * u0[1]); w.y = pg8::cvt_pk_bf16(siluf_(g0[2]) * u0[2], siluf_(g0[3]) * u0[3]);
                w.z = pg8::cvt_pk_bf16(siluf_(g1[0]) * u1[0], siluf_(g1[1]) * u1[1]); w.w = pg8::cvt_pk_bf16(siluf_(g1[2]) * u1[2], siluf_(g1[3]) * u1[3]);
                *(v4u*)rowp = w;
            }
    }
};
struct EpiU {
    static constexpr bool PERM = true, AFTER_DRAIN = false;
    bf16* O; int ldc;
    __device__ __forceinline__ void operator()(const f32x4 (&acc)[2][2][4][2], const pg8::Unit& u, int wr, int wc, int fr, int fq) const {
        int pm = u.pm, pn = u.pn; asm volatile("" : "+s"(pm), "+s"(pn), "+s"(wr), "+s"(wc), "+v"(fr), "+v"(fq));
        bf16* tb = O + (size_t)pm * 256 * ldc + pn * 256;
        const unsigned loff = (unsigned)((wr * 64 + fr) * ldc + wc * 32 + 8 * fq);
#pragma unroll
        for (int ai = 0; ai < 2; ++ai)
#pragma unroll
            for (int m = 0; m < 4; ++m) {
                bf16* rowp = tb + (loff + (unsigned)((ai * 128 + m * 16) * ldc));
#pragma unroll
                for (int bj = 0; bj < 2; ++bj) { const f32x4 v0 = acc[ai][bj][m][0], v1 = acc[ai][bj][m][1]; v4u w;
                    w.x = pg8::cvt_pk_bf16(v0[0], v0[1]); w.y = pg8::cvt_pk_bf16(v0[2], v0[3]); w.z = pg8::cvt_pk_bf16(v1[0], v1[1]); w.w = pg8::cvt_pk_bf16(v1[2], v1[3]);
                    *(v4u*)(rowp + bj * 128) = w; }
            }
    }
};
struct EpiResid {
    static constexpr bool PERM = false, AFTER_DRAIN = false;
    float* xlat; float* xctx; const float* gate; float coef;
    __device__ __forceinline__ void operator()(const f32x4 (&acc)[2][2][4][2], const pg8::Unit& u, int wr, int wc, int fr, int fq) const {
        int pm = u.pm, pn = u.pn; asm volatile("" : "+s"(pm), "+s"(pn), "+s"(wr), "+s"(wc), "+v"(fr), "+v"(fq));
        float* tb = (pm < 64 ? xlat + (size_t)pm * 256 * DM : xctx + (size_t)(pm - 64) * 256 * DM) + pn * 256;
        const float* g = gate + (pm < 64 ? (pm >> 5) : 2) * 9216 + pn * 256;
        const unsigned coff = (unsigned)(wc * 32 + 4 * fq), loff = (unsigned)((wr * 64 + fr) * DM) + coff;
        f32x4 gv[2][2];
#pragma unroll
        for (int bj = 0; bj < 2; ++bj)
#pragma unroll
            for (int n = 0; n < 2; ++n) gv[bj][n] = coef * *(const f32x4*)(g + (coff + (unsigned)(bj * 128 + n * 16)));
#pragma unroll
        for (int ai = 0; ai < 2; ++ai)
#pragma unroll
            for (int m = 0; m < 4; ++m) {
                float* xr = tb + (loff + (unsigned)((ai * 128 + m * 16) * DM));
#pragma unroll
                for (int bj = 0; bj < 2; ++bj)
#pragma unroll
                    for (int n = 0; n < 2; ++n) { float* xp = xr + (bj * 128 + n * 16);
                        f32x4 xv = *(const f32x4*)xp; xv += gv[bj][n] * acc[ai][bj][m][n]; *(f32x4*)xp = xv; }
                asm volatile("" ::: "memory");
            }
    }
};

__device__ __forceinline__ void phase_modgemv(const Args& a, float* red, int G, int bid, int tid) {
    const float* c = IN(1); const float* cctx = IN(3); const float* ada_w = IN(4); const float* ada_b = IN(5);
    float* mod = (float*)(karg_ws() + OFF_MOD);
    const int w = tid >> 6, lane = tid & 63;
    for (int u = bid; u < 576; u += G) {
        const int l = u / 288, rem = u % 288, jt = rem >> 3, ks = rem & 7;
        const int kb = ks * 128 + w * 16, j0 = jt * 256 + lane * 4;
        f32x4 acc0 = {0.f, 0.f, 0.f, 0.f}, acc1 = acc0, acc2 = acc0;
        for (int kk = 0; kk < 16; ++kk) { const int k = kb + kk;
            const float s0 = siluf_(c[k]), s1 = siluf_(c[1024 + k]), s2 = siluf_(cctx[k]);
            const f32x4 wv = *(const f32x4*)(ada_w + ((size_t)(l * 1024 + k)) * 9216 + j0);
            acc0 += s0 * wv; acc1 += s1 * wv; acc2 += s2 * wv; }
        float* rp = red + (w * 3) * 256 + lane * 4;
        *(f32x4*)rp = acc0; *(f32x4*)(rp + 256) = acc1; *(f32x4*)(rp + 512) = acc2;
        __syncthreads();
        for (int o = tid; o < 768; o += 512) { const int m = o >> 8, jj = o & 255; float s = 0.f;
#pragma unroll
            for (int ww = 0; ww < 8; ++ww) s += red[(ww * 3 + m) * 256 + jj];
            const int j = jt * 256 + jj; if (ks == 0) s += ada_b[l * 9216 + j];
            atomicAdd(&mod[(l * 3 + m) * 9216 + j], s); }
        __syncthreads();
    }
}
__device__ __forceinline__ void phase_copy(const Args& a, int G, int bid, int tid) {
    const f32x4* x4 = (const f32x4*)IN(0); f32x4* o4 = (f32x4*)karg_out();
    for (int i = bid * 512 + tid; i < NLAT * DM / 4; i += G * 512) o4[i] = x4[i];
    const f32x4* c4 = (const f32x4*)IN(2); f32x4* xc4 = (f32x4*)(karg_ws() + OFF_XCTX);
    for (int i = bid * 512 + tid; i < 512 * DM / 4; i += G * 512) xc4[i] = c4[i];
}
__device__ __forceinline__ int swiglu_map(int n) { return n < DFF ? ((n >> 7) * 256 + (n & 127)) : ((((n - DFF) >> 7) * 256) + 128 + ((n - DFF) & 127)); }
__device__ __forceinline__ void transpose_item(const float* W, int K, int N, bf16* WT, float* scr, int item, int lane, int mode, const float* kscale) {
    const int nblk = N / 32, kb = item / nblk, nb = item % nblk, k0 = 64 * kb, n0 = 32 * nb;
#pragma unroll 8
    for (int i = 0; i < 32; ++i) { const int kk = 2 * i + (lane >> 5); float v = W[(size_t)(k0 + kk) * N + n0 + (lane & 31)]; if (kscale) v *= kscale[k0 + kk]; scr[kk * 33 + (lane & 31)] = v; }
    __builtin_amdgcn_wave_barrier();
    const int c = lane & 7;
#pragma unroll
    for (int j = 0; j < 4; ++j) { const int n = (lane >> 3) + 8 * j; const float* s = scr + (8 * c) * 33 + n;
        v4u o; o.x = pk2(s[0 * 33], s[1 * 33]); o.y = pk2(s[2 * 33], s[3 * 33]); o.z = pk2(s[4 * 33], s[5 * 33]); o.w = pk2(s[6 * 33], s[7 * 33]);
        const int nn = n0 + n, drow = mode ? swiglu_map(nn) : nn;
        *(v4u*)(WT + (size_t)drow * K + k0 + 8 * c) = o; }
    __builtin_amdgcn_wave_barrier();
}
__device__ __forceinline__ void convert_weights(const Args& a, int l, float* scr, int gw, int NGW, int lane, int G, int bid, int tid) {
    constexpr int I13 = 16 * 176, I2 = 44 * 32, IIN = 16 * 77, IOUT = 16 * 32, IUQ = 4 * 12, IUKV = 2 * 16;
    constexpr int NIT = 2 * I13 + 2 * I2 + IIN + IOUT + IUQ + IUKV;
    unsigned char* ws = karg_ws();
    for (int it = gw; it < NIT; it += NGW) {
        int r = it;
        if (r < I13) { transpose_item(IN(6) + (size_t)l * DM * 2 * DFF, DM, 2 * DFF, (bf16*)(ws + W_13A), scr, r, lane, 1, nullptr); continue; } r -= I13;
        if (r < I13) { transpose_item(IN(8) + (size_t)l * DM * 2 * DFF, DM, 2 * DFF, (bf16*)(ws + W_13B), scr, r, lane, 1, nullptr); continue; } r -= I13;
        if (r < I2) { transpose_item(IN(7) + (size_t)l * DFF * DM, DFF, DM, (bf16*)(ws + W_2A), scr, r, lane, 0, nullptr); continue; } r -= I2;
        if (r < I2) { transpose_item(IN(9) + (size_t)l * DFF * DM, DFF, DM, (bf16*)(ws + W_2B), scr, r, lane, 0, nullptr); continue; } r -= I2;
        if (r < IIN) { transpose_item(IN(10) + (size_t)l * DM * 2464, DM, 2464, (bf16*)(ws + W_IN), scr, r, lane, 0, nullptr); continue; } r -= IIN;
        if (r < IOUT) { transpose_item(IN(11) + (size_t)l * DM * DM, DM, DM, (bf16*)(ws + W_OUT), scr, r, lane, 0, nullptr); continue; } r -= IOUT;
        if (r < IUQ) { transpose_item(IN(36) + (size_t)l * 256 * 384, 256, 384, (bf16*)(ws + W_UQ), scr, r, lane, 0, IN(35) + l * 256); continue; } r -= IUQ;
        transpose_item(IN(38) + (size_t)l * 128 * 512, 128, 512, (bf16*)(ws + W_UKV), scr, r, lane, 0, IN(37) + l * 128);
    }
    v4u z = {0u, 0u, 0u, 0u}; v4u* zp = (v4u*)(ws + W_IN + (size_t)2464 * DM * 2);
    for (int i = bid * 512 + tid; i < 96 * DM * 2 / 16; i += G * 512) zp[i] = z;
}
__device__ __forceinline__ void phase_modulate(const Args& a, int l, int which, int gw, int NGW, int lane) {
    unsigned char* ws = karg_ws(); const float* outp = karg_out();
    const float* mod = (const float*)(ws + OFF_MOD) + (size_t)l * 3 * 9216;
    bf16* XM = (bf16*)(ws + OFF_XMY);
    for (int r = gw; r < NR; r += NGW) {
        const float* xr = r < NLAT ? outp + (size_t)r * DM : (const float*)(ws + OFF_XCTX) + (size_t)(r - NLAT) * DM;
        const float* mm = mod + (r < NLAT ? (r >> 13) : 2) * 9216 + which * 3 * 1024;
        f32x4 v[4]; float ss = 0.f;
#pragma unroll
        for (int j = 0; j < 4; ++j) { v[j] = *(const f32x4*)(xr + 4 * lane + 256 * j); ss += (v[j][0] * v[j][0] + v[j][1] * v[j][1]) + (v[j][2] * v[j][2] + v[j][3] * v[j][3]); }
        const float rstd = rsqrtf(wave_sum(ss) * (1.f / DM) + 1e-6f);
#pragma unroll
        for (int j = 0; j < 4; ++j) { const int c = 4 * lane + 256 * j; const f32x4 sh = *(const f32x4*)(mm + c), sc = *(const f32x4*)(mm + 1024 + c);
            const f32x4 o = v[j] * rstd * (1.f + sc) + sh; v2u w; w.x = pk2(o[0], o[1]); w.y = pk2(o[2], o[3]);
            *(v2u*)(XM + (size_t)r * DM + c) = w; }
    }
}
__device__ __forceinline__ void phase_final(const Args& a, int gw, int NGW, int lane) {
    const float* fn = IN(39); float* outp = karg_out();
    for (int r = gw; r < NLAT; r += NGW) {
        float* xr = outp + (size_t)r * DM; f32x4 v[4]; float ss = 0.f;
#pragma unroll
        for (int j = 0; j < 4; ++j) { v[j] = *(const f32x4*)(xr + 4 * lane + 256 * j); ss += (v[j][0] * v[j][0] + v[j][1] * v[j][1]) + (v[j][2] * v[j][2] + v[j][3] * v[j][3]); }
        const float rstd = rsqrtf(wave_sum(ss) * (1.f / DM) + 1e-6f);
#pragma unroll
        for (int j = 0; j < 4; ++j) { const int c = 4 * lane + 256 * j; const f32x4 g = *(const f32x4*)(fn + c); *(f32x4*)(xr + c) = v[j] * rstd * g; }
    }
}

__device__ __forceinline__ void phase_m1(const Args& a, int l, unsigned char* lds, int G, int bid, int tid_unused) {
    unsigned char* ws = karg_ws();
    const bf16* U = (const bf16*)(ws + OFF_HU);
    bf16* Y = (bf16*)(ws + OFF_XMY);
    for (int tile = bid; tile < NTILE; tile += G) {
        const TileInfo ti = tile_info(tile);
        const int row0 = tile * 32;
        {
            const int tid = ltid(); const int lane = tid & 63, wave = __builtin_amdgcn_readfirstlane(tid >> 6), ch = tid & 255, part = tid >> 8; (void)lane; (void)wave; (void)ch; (void)part;
            float* z = (float*)lds;
            float* cv = (float*)(lds + 65536);
            for (int tt = part; tt < 62; tt += 2) { const int t = ti.t0 - 15 + tt; float zz = 0.f;
                if (t >= 0 && t < ti.seqlen) { const bf16* ur = U + (size_t)(ti.seqbase + t) * UC; zz = bf2f(ur[ch]) * sigm(bf2f(ur[256 + ch])); }
                z[tt * 256 + ch] = zz; }
            __syncthreads();
            const float* dw = IN(12) + (size_t)l * 31 * 256 + ch;
            float acc[16]; const float bias = IN(13)[l * 256 + ch];
#pragma unroll
            for (int o = 0; o < 16; ++o) acc[o] = bias;
            for (int j = 0; j < 31; ++j) { const float w = dw[j * 256];
#pragma unroll
                for (int o = 0; o < 16; ++o) acc[o] += w * z[(part * 16 + o + j) * 256 + ch]; }
#pragma unroll
            for (int o = 0; o < 16; ++o) cv[(part * 16 + o) * 256 + ch] = acc[o];
            __syncthreads();
            const f32x4 lg = *(const f32x4*)(IN(14) + l * 256 + lane * 4), lb = *(const f32x4*)(IN(15) + l * 256 + lane * 4);
#pragma unroll
            for (int q = 0; q < 4; ++q) { const int t = wave * 4 + q; const f32x4 v = *(const f32x4*)(cv + t * 256 + lane * 4);
                const float mu = wave_sum((v[0] + v[1]) + (v[2] + v[3])) * (1.f / 256.f);
                const f32x4 dv = v - mu; const float var = wave_sum((dv[0] * dv[0] + dv[1] * dv[1]) + (dv[2] * dv[2] + dv[3] * dv[3])) * (1.f / 256.f);
                const f32x4 yn = dv * rsqrtf(var + 1e-5f) * lg + lb;
                v2u w; w.x = pk2(siluf_(yn[0]), siluf_(yn[1])); w.y = pk2(siluf_(yn[2]), siluf_(yn[3]));
                *(v2u*)(Y + (size_t)(row0 + t) * DM + lane * 4) = w; }
            __syncthreads();
        }
        {
            const int tid = ltid(); const int lane = tid & 63, wave = __builtin_amdgcn_readfirstlane(tid >> 6), ch = tid & 255, part = tid >> 8; (void)lane; (void)wave; (void)ch; (void)part;
            float* xv = (float*)lds;
            {
                const float* cw = IN(16) + (size_t)l * 4 * 256 + ch; const float w0 = cw[0], w1 = cw[256], w2 = cw[512], w3 = cw[768], cb = IN(17)[l * 256 + ch];
                float xin[19];
#pragma unroll
                for (int i = 0; i < 19; ++i) { const int t = ti.t0 + part * 16 + i - 2; xin[i] = (t >= 0 && t < ti.seqlen) ? bf2f(U[(size_t)(ti.seqbase + t) * UC + 512 + ch]) : 0.f; }
                bf16* GB = (bf16*)(ws + M_GB);
#pragma unroll
                for (int o = 0; o < 16; ++o) { const int tl = part * 16 + o;
                    xv[ch * 36 + tl] = cb + w0 * xin[o] + w1 * xin[o + 1] + w2 * xin[o + 2] + w3 * xin[o + 3];
                    GB[(size_t)(row0 + tl) * 256 + ch] = (bf16)f2bf(geluf_(bf2f(U[(size_t)(row0 + tl) * UC + 768 + ch]))); }
            }
            __syncthreads();
            {
                const int d = part, blk = ch >> 6, jc = ch & 63;
                const float* WA = IN(18) + ((size_t)((l * 2 + d) * 4 + blk) * 64) * 64 + jc;
                const float* WX = IN(20) + ((size_t)((l * 2 + d) * 4 + blk) * 64) * 64 + jc;
                float aa[32], ax[32];
#pragma unroll
                for (int t = 0; t < 32; ++t) { aa[t] = 0.f; ax[t] = 0.f; }
#pragma unroll 2
                for (int i = 0; i < 64; ++i) { const float wa = WA[i * 64], wx = WX[i * 64]; const float* xp = xv + (blk * 64 + i) * 36;
#pragma unroll
                    for (int t = 0; t < 32; t += 4) { const f32x4 x = *(const f32x4*)(xp + t);
                        aa[t] += x[0] * wa; aa[t + 1] += x[1] * wa; aa[t + 2] += x[2] * wa; aa[t + 3] += x[3] * wa;
                        ax[t] += x[0] * wx; ax[t + 1] += x[1] * wx; ax[t + 2] += x[2] * wx; ax[t + 3] += x[3] * wx; } }
                const float ba = IN(19)[(l * 2 + d) * 256 + ch], bx = IN(21)[(l * 2 + d) * 256 + ch];
                const float lam = IN(22)[(l * 2 + d) * 256 + ch];
                const float cch = -8.f * log1pf(__expf(-lam));
                bf16* LR = (bf16*)(ws + M_LR0 + (size_t)d * A8); bf16* LIX = (bf16*)(ws + M_LIX0 + (size_t)d * A8);
#pragma unroll
                for (int t = 0; t < 32; ++t) { const float r = sigm(aa[t] + ba), ii = sigm(ax[t] + bx) * xv[ch * 36 + t];
                    const unsigned rb = f2bf(r), ib = f2bf(ii);
                    LR[(size_t)(row0 + t) * 256 + ch] = (bf16)rb; LIX[(size_t)(row0 + t) * 256 + ch] = (bf16)ib;
                    aa[t] = __uint_as_float(rb << 16); ax[t] = __uint_as_float(ib << 16); }
                float A = 1.f, B = 0.f;
                if (d == 0) {
#pragma unroll
                    for (int t = 0; t < 32; ++t) { const float al = __expf(cch * aa[t]); const float bb = sqrtf(fmaxf(1.f - al * al, 0.f)) * ax[t]; B = al * B + bb; A *= al; }
                } else {
#pragma unroll
                    for (int t = 31; t >= 0; --t) { const float al = __expf(cch * aa[t]); const float bb = sqrtf(fmaxf(1.f - al * al, 0.f)) * ax[t]; B = al * B + bb; A *= al; }
                }
                ((float*)(ws + M_SEGA))[(size_t)(tile * 2 + d) * 256 + ch] = A;
                ((float*)(ws + M_SEGB))[(size_t)(tile * 2 + d) * 256 + ch] = B;
            }
            __syncthreads();
        }
        {
            const int tid = ltid(); const int lane = tid & 63, wave = __builtin_amdgcn_readfirstlane(tid >> 6), ch = tid & 255, part = tid >> 8; (void)lane; (void)wave; (void)ch; (void)part;
            bf16* As = (bf16*)lds;
            float* kr = (float*)(lds + 32768);
            float* rs = (float*)(lds + 32768 + 4096);
            for (int idx = tid; idx < 32 * 52; idx += 512) { const int t = idx / 52, cc = idx % 52;
                const v4u v = *(const v4u*)(U + (size_t)(row0 + t) * UC + 2048 + cc * 8);
                if (cc < 48) *(v4u*)(As + t * 392 + cc * 8) = v;
                else { const int c0 = (cc - 48) * 8; float* kp = kr + t * 32 + c0;
                    kp[0] = __uint_as_float(v.x << 16); kp[1] = __uint_as_float(v.x & 0xffff0000u); kp[2] = __uint_as_float(v.y << 16); kp[3] = __uint_as_float(v.y & 0xffff0000u);
                    kp[4] = __uint_as_float(v.z << 16); kp[5] = __uint_as_float(v.z & 0xffff0000u); kp[6] = __uint_as_float(v.w << 16); kp[7] = __uint_as_float(v.w & 0xffff0000u); } }
            __syncthreads();
#pragma unroll
            for (int q = 0; q < 4; ++q) { const int t = wave * 4 + q; float sq = 0.f, sk = 0.f;
#pragma unroll
                for (int j = 0; j < 4; ++j) { const float v = bf2f(As[t * 392 + lane + 64 * j]); sq += v * v; }
#pragma unroll
                for (int j = 0; j < 2; ++j) { const float v = bf2f(As[t * 392 + 256 + lane + 64 * j]); sk += v * v; }
                sq = wave_sum(sq); sk = wave_sum(sk);
                if (lane == 0) { rs[t * 2] = rsqrtf(sq * (1.f / 256.f) + 1e-6f); rs[t * 2 + 1] = rsqrtf(sk * (1.f / 128.f) + 1e-6f); } }
            __syncthreads();
            const int fr = lane & 15, fq = lane >> 4;
            bf16* QB = (bf16*)(ws + M_QB); bf16* KB = (bf16*)(ws + M_KB); bf16* VT = (bf16*)(ws + M_VT);
            const bf16* WUQ = (const bf16*)(ws + W_UQ); const bf16* WUKV = (const bf16*)(ws + W_UKV);
            const int keybase = ti.isctx ? TLEN : 0;
#pragma unroll 1
            for (int i = 0; i < 3; ++i) { const int nt = wave * 3 + i;
                f32x4 c0 = {0.f, 0.f, 0.f, 0.f}, c1 = c0;
#pragma unroll
                for (int ks = 0; ks < 8; ++ks) { const bf16x8 bfr = *(const bf16x8*)(WUQ + (size_t)(nt * 16 + fr) * 256 + ks * 32 + fq * 8);
                    const bf16x8 a0 = *(const bf16x8*)(As + fr * 392 + ks * 32 + fq * 8), a1 = *(const bf16x8*)(As + (16 + fr) * 392 + ks * 32 + fq * 8);
                    c0 = __builtin_amdgcn_mfma_f32_16x16x32_bf16(a0, bfr, c0, 0, 0, 0); c1 = __builtin_amdgcn_mfma_f32_16x16x32_bf16(a1, bfr, c1, 0, 0, 0); }
                const int hq = nt / 6, wt = nt % 6, dd = wt * 16 + fr;
#pragma unroll
                for (int mt = 0; mt < 2; ++mt)
#pragma unroll
                    for (int j = 0; j < 4; ++j) { const int tl = mt * 16 + fq * 4 + j; const int t = ti.t0 + tl;
                        float v = (mt ? c1[j] : c0[j]) * rs[tl * 2];
                        const float pv = __shfl_xor(v, 8);
                        if (wt >= 4 && !ti.isctx) { const int f = fr & 7; const float pos = (wt == 4) ? (float)(t >> 6) : (float)(t & 63);
                            const float ang = pos * __expf(-(float)f * (9.210340371976184f / 8.f)); float sn, cs; __sincosf(ang, &sn, &cs);
                            v = (fr & 8) ? (v * cs + pv * sn) : (v * cs - pv * sn); }
                        QB[((size_t)(ti.b * 4 + hq) * TT + keybase + t) * 96 + dd] = (bf16)f2bf(v * QSCALE); } }
#pragma unroll 1
            for (int i = 0; i < 4; ++i) { const int nt = wave * 4 + i;
                f32x4 c0 = {0.f, 0.f, 0.f, 0.f}, c1 = c0;
#pragma unroll
                for (int ks = 0; ks < 4; ++ks) { const bf16x8 bfr = *(const bf16x8*)(WUKV + (size_t)(nt * 16 + fr) * 128 + ks * 32 + fq * 8);
                    const bf16x8 a0 = *(const bf16x8*)(As + fr * 392 + 256 + ks * 32 + fq * 8), a1 = *(const bf16x8*)(As + (16 + fr) * 392 + 256 + ks * 32 + fq * 8);
                    c0 = __builtin_amdgcn_mfma_f32_16x16x32_bf16(a0, bfr, c0, 0, 0, 0); c1 = __builtin_amdgcn_mfma_f32_16x16x32_bf16(a1, bfr, c1, 0, 0, 0); }
                const int hk = nt >> 3, wt = nt & 7;
#pragma unroll
                for (int mt = 0; mt < 2; ++mt)
#pragma unroll
                    for (int j = 0; j < 4; ++j) { const int tl = mt * 16 + fq * 4 + j; const int key = keybase + ti.t0 + tl;
                        const float v = (mt ? c1[j] : c0[j]) * rs[tl * 2 + 1];
                        if (wt < 4) KB[((size_t)(ti.b * 4 + hk) * TT + key) * 96 + wt * 16 + fr] = (bf16)f2bf(v);
                        else VT[((size_t)(ti.b * 4 + hk) * 64 + (wt - 4) * 16 + fr) * TT + key] = (bf16)f2bf(v); } }
            { const int tl = tid >> 4, p = tid & 15, ax = p >> 3, f = p & 7; const int t = ti.t0 + tl;
                float x0 = kr[tl * 32 + ax * 16 + f], x1 = kr[tl * 32 + ax * 16 + 8 + f];
                if (!ti.isctx) { const float pos = ax == 0 ? (float)(t >> 6) : (float)(t & 63); const float ang = pos * __expf(-(float)f * (9.210340371976184f / 8.f));
                    float sn, cs; __sincosf(ang, &sn, &cs); const float y0 = x0 * cs - x1 * sn, y1 = x1 * cs + x0 * sn; x0 = y0; x1 = y1; }
                const bf16 b0 = (bf16)f2bf(x0), b1 = (bf16)f2bf(x1);
#pragma unroll
                for (int h = 0; h < 4; ++h) { bf16* kp = KB + ((size_t)(ti.b * 4 + h) * TT + keybase + t) * 96 + 64 + ax * 16 + f; kp[0] = b0; kp[8] = b1; } }
            __syncthreads();
        }
    }
}

__device__ __forceinline__ void attn_unit(unsigned char* lds, const bf16* QB, const bf16* KB, const bf16* VT, bf16* Y, int b, int h, int q0, int key_lo, int nkt, int tid) {
    const int lane = tid & 63, wave = tid >> 6, fr = lane & 15, fq = lane >> 4;
    const int bh = b * 4 + h;
    constexpr int KSTR = 104, VSTR = 72, KBUF = 64 * KSTR, VBUF = 64 * VSTR;
    bf16* Ks = (bf16*)lds;
    bf16* Vs = (bf16*)lds + 2 * KBUF;
    const int qw = q0 + wave * 32;
    bf16x8 qf[2][3];
#pragma unroll
    for (int qt = 0; qt < 2; ++qt)
#pragma unroll
        for (int ks = 0; ks < 3; ++ks) qf[qt][ks] = *(const bf16x8*)(QB + ((size_t)bh * TT + qw + qt * 16 + fr) * 96 + ks * 32 + fq * 8);
    float mrun[2] = {-1e30f, -1e30f}, lrun[2] = {0.f, 0.f};
    f32x4 o[4][2];
#pragma unroll
    for (int dt = 0; dt < 4; ++dt)
#pragma unroll
        for (int qt = 0; qt < 2; ++qt) o[dt][qt] = (f32x4){0.f, 0.f, 0.f, 0.f};
    const v4u* kg = (const v4u*)(KB + ((size_t)bh * TT + key_lo) * 96);
    const bf16* vg = VT + ((size_t)bh * 64 + (tid >> 3)) * TT + key_lo + (tid & 7) * 8;
    const int kc0 = tid, kc1 = 512 + tid;
    const int ko0 = (kc0 / 12) * KSTR + (kc0 % 12) * 8, ko1 = (kc1 / 12) * KSTR + (kc1 % 12) * 8, vo = (tid >> 3) * VSTR + (tid & 7) * 8;
    v4u rk0, rk1 = {0u, 0u, 0u, 0u}, rv;
    rk0 = kg[kc0]; if (tid < 256) rk1 = kg[kc1]; rv = *(const v4u*)vg;
    *(v4u*)(Ks + ko0) = rk0; if (tid < 256) *(v4u*)(Ks + ko1) = rk1; *(v4u*)(Vs + vo) = rv;
    __syncthreads();
    for (int kt = 0; kt < nkt; ++kt) {
        const int cur = kt & 1;
        if (kt + 1 < nkt) { const v4u* kn = kg + (size_t)(kt + 1) * 768; rk0 = kn[kc0]; if (tid < 256) rk1 = kn[kc1]; rv = *(const v4u*)(vg + (kt + 1) * 64); }
        const bf16* kb = Ks + cur * KBUF; const bf16* vb = Vs + cur * VBUF;
        f32x4 st[4][2];
#pragma unroll
        for (int k4 = 0; k4 < 4; ++k4) {
            st[k4][0] = (f32x4){0.f, 0.f, 0.f, 0.f}; st[k4][1] = st[k4][0];
#pragma unroll
            for (int ks = 0; ks < 3; ++ks) { const bf16x8 kf = *(const bf16x8*)(kb + (k4 * 16 + fr) * KSTR + ks * 32 + fq * 8);
                st[k4][0] = __builtin_amdgcn_mfma_f32_16x16x32_bf16(kf, qf[0][ks], st[k4][0], 0, 0, 0);
                st[k4][1] = __builtin_amdgcn_mfma_f32_16x16x32_bf16(kf, qf[1][ks], st[k4][1], 0, 0, 0); }
        }
        bf16x8 pb[2][2];
#pragma unroll
        for (int qt = 0; qt < 2; ++qt) {
            float mx = st[0][qt][0];
#pragma unroll
            for (int k4 = 0; k4 < 4; ++k4)
#pragma unroll
                for (int j = 0; j < 4; ++j) mx = fmaxf(mx, st[k4][qt][j]);
            mx = fmaxf(mx, __shfl_xor(mx, 16)); mx = fmaxf(mx, __shfl_xor(mx, 32));
            const float mn = fmaxf(mrun[qt], mx), alpha = exp2f(mrun[qt] - mn); mrun[qt] = mn;
            float ls = 0.f;
#pragma unroll
            for (int k4 = 0; k4 < 4; ++k4)
#pragma unroll
                for (int j = 0; j < 4; ++j) { const float p = exp2f(st[k4][qt][j] - mn); st[k4][qt][j] = p; ls += p; }
            lrun[qt] = lrun[qt] * alpha + ls;
#pragma unroll
            for (int dt = 0; dt < 4; ++dt) o[dt][qt] *= alpha;
#pragma unroll
            for (int u = 0; u < 2; ++u) { v4u w;
                w.x = pg8::cvt_pk_bf16(st[2 * u][qt][0], st[2 * u][qt][1]); w.y = pg8::cvt_pk_bf16(st[2 * u][qt][2], st[2 * u][qt][3]);
                w.z = pg8::cvt_pk_bf16(st[2 * u + 1][qt][0], st[2 * u + 1][qt][1]); w.w = pg8::cvt_pk_bf16(st[2 * u + 1][qt][2], st[2 * u + 1][qt][3]);
                pb[u][qt] = __builtin_bit_cast(bf16x8, w); }
        }
#pragma unroll
        for (int dt = 0; dt < 4; ++dt)
#pragma unroll
            for (int u = 0; u < 2; ++u) {
                const v2u lo = *(const v2u*)(vb + (dt * 16 + fr) * VSTR + 32 * u + 4 * fq), hi = *(const v2u*)(vb + (dt * 16 + fr) * VSTR + 32 * u + 16 + 4 * fq);
                v4u vw; vw.x = lo.x; vw.y = lo.y; vw.z = hi.x; vw.w = hi.y;
                const bf16x8 va = __builtin_bit_cast(bf16x8, vw);
                o[dt][0] = __builtin_amdgcn_mfma_f32_16x16x32_bf16(va, pb[u][0], o[dt][0], 0, 0, 0);
                o[dt][1] = __builtin_amdgcn_mfma_f32_16x16x32_bf16(va, pb[u][1], o[dt][1], 0, 0, 0);
            }
        if (kt + 1 < nkt) { const int nb = cur ^ 1; *(v4u*)(Ks + nb * KBUF + ko0) = rk0; if (tid < 256) *(v4u*)(Ks + nb * KBUF + ko1) = rk1; *(v4u*)(Vs + nb * VBUF + vo) = rv; }
        __syncthreads();
    }
#pragma unroll
    for (int qt = 0; qt < 2; ++qt) {
        float lt = lrun[qt]; lt += __shfl_xor(lt, 16); lt += __shfl_xor(lt, 32);
        const float inv = 1.f / lt;
        const int q = qw + qt * 16 + fr;
        const size_t row = q < TLEN ? (size_t)b * TLEN + q : (size_t)NLAT + b * CTXL + (q - TLEN);
#pragma unroll
        for (int dt = 0; dt < 4; ++dt) { const f32x4 v = o[dt][qt] * inv; v2u w; w.x = pk2(v[0], v[1]); w.y = pk2(v[2], v[3]);
            *(v2u*)(Y + row * DM + 768 + h * 64 + dt * 16 + fq * 4) = w; }
    }
}
__device__ __forceinline__ void lru_tile(const Args& a, int l, unsigned char* lds, int tile, int tid) {
    unsigned char* ws = karg_ws();
    const int ch = tid & 255, d = tid >> 8;
    const TileInfo ti = tile_info(tile);
    const int row0 = tile * 32;
    const float* SA = (const float*)(ws + M_SEGA); const float* SB = (const float*)(ws + M_SEGB);
    float hst = 0.f;
    const int ctile0 = 512 + ti.b * 8, ltile0 = ti.b * 256;
    if (d == 0) {
        const int nc = ti.isctx ? (tile - ctile0) : 8;
        for (int j = 0; j < nc; ++j) { const size_t o = (size_t)((ctile0 + j) * 2) * 256 + ch; hst = SA[o] * hst + SB[o]; }
        if (!ti.isctx) for (int j = ltile0; j < tile; ++j) { const size_t o = (size_t)(j * 2) * 256 + ch; hst = SA[o] * hst + SB[o]; }
    } else {
        const int lo = ti.isctx ? (tile - ctile0 + 1) : 0;
        for (int j = 7; j >= lo; --j) { const size_t o = (size_t)((ctile0 + j) * 2 + 1) * 256 + ch; hst = SA[o] * hst + SB[o]; }
        if (!ti.isctx) for (int j = ltile0 + 255; j > tile; --j) { const size_t o = (size_t)(j * 2 + 1) * 256 + ch; hst = SA[o] * hst + SB[o]; }
    }
    const float lam = IN(22)[(l * 2 + d) * 256 + ch];
    const float cch = -8.f * log1pf(__expf(-lam));
    const bf16* LR = (const bf16*)(ws + M_LR0 + (size_t)d * A8); const bf16* LIX = (const bf16*)(ws + M_LIX0 + (size_t)d * A8);
    float* hs = (float*)lds;
    for (int tt = 0; tt < 32; ++tt) { const int t = d ? 31 - tt : tt; const size_t o = (size_t)(row0 + t) * 256 + ch;
        const float al = __expf(cch * bf2f(LR[o])); const float bb = sqrtf(fmaxf(1.f - al * al, 0.f)) * bf2f(LIX[o]);
        hst = al * hst + bb; hs[(d * 32 + t) * 256 + ch] = hst; }
    __syncthreads();
    const bf16* GB = (const bf16*)(ws + M_GB); bf16* Y = (bf16*)(ws + OFF_XMY);
    for (int tt = 0; tt < 16; ++tt) { const int t = d * 16 + tt;
        const float y = (hs[t * 256 + ch] + hs[(32 + t) * 256 + ch]) * bf2f(GB[(size_t)(row0 + t) * 256 + ch]);
        Y[(size_t)(row0 + t) * DM + 256 + ch] = (bf16)f2bf(y); }
    __syncthreads();
}
__device__ __forceinline__ void phase_m2(const Args& a, int l, unsigned char* lds, int G, int bid, int tid) {
    unsigned char* ws = karg_ws();
    const bf16* QB = (const bf16*)(ws + M_QB); const bf16* KB = (const bf16*)(ws + M_KB); const bf16* VT = (const bf16*)(ws + M_VT);
    bf16* Y = (bf16*)(ws + OFF_XMY);
    const int nunits = (l == 0) ? 264 : 256;
    for (int u = bid; u < nunits; u += G) {
        if (u < 256) attn_unit(lds, QB, KB, VT, Y, u >> 7, (u >> 5) & 3, (u & 31) * 256, 0, 132, tid);
        else attn_unit(lds, QB, KB, VT, Y, (u - 256) >> 2, (u - 256) & 3, TLEN, TLEN, 4, tid);
    }
    for (int tile = bid; tile < NTILE; tile += G) lru_tile(a, l, lds, tile, tid);
}

__device__ __forceinline__ void phase_m3(const Args& a, int l, unsigned char* lds, int G, int bid, int tid) {
    unsigned char* ws = karg_ws();
    const bf16* U = (const bf16*)(ws + OFF_HU);
    const int lane = tid & 63, ch = tid & 255, part = tid >> 8;
    const float* mup = IN(23) + l * 1024; const float* mun = IN(24) + l * 1024;
    bf16* RR = (bf16*)(ws + M_RR); bf16* KKo = (bf16*)(ws + M_KK); bf16* VV = (bf16*)(ws + M_VV); bf16* GC = (bf16*)(ws + M_GC);
    float* kl = (float*)lds;
    float* tw = (float*)(lds + 32768);
    float* ta = (float*)(lds + 41984);
    float* tg = (float*)(lds + 51200);
    for (int tile = bid; tile < NTILE; tile += G) {
        const TileInfo ti = tile_info(tile);
        const int row0 = tile * 32;
        {
            const int tid2 = ltid(); const int chunk = tid2 & 127, tg8 = tid2 >> 7, c0 = chunk * 8;
            const bf16* ub = U + (size_t)row0 * UC + 1024 + c0;
            v4u rw[10];
#pragma unroll
            for (int q = 0; q < 10; ++q) { const int tl = tg8 * 8 + q - 1; const int t = ti.t0 + tl;
                rw[q] = (t >= 0 && t < ti.seqlen) ? *(const v4u*)(ub + (ptrdiff_t)tl * UC) : (v4u){0u, 0u, 0u, 0u}; }
            const f32x4 mp0 = *(const f32x4*)(mup + c0), mp1 = *(const f32x4*)(mup + c0 + 4), mn0 = *(const f32x4*)(mun + c0), mn1 = *(const f32x4*)(mun + c0 + 4);
            const float mp[8] = {mp0[0], mp0[1], mp0[2], mp0[3], mp1[0], mp1[1], mp1[2], mp1[3]}, mn[8] = {mn0[0], mn0[1], mn0[2], mn0[3], mn1[0], mn1[1], mn1[2], mn1[3]};
#pragma unroll
            for (int q = 0; q < 8; ++q) { const int tl = tg8 * 8 + q; float ts[8];
#pragma unroll
                for (int e = 0; e < 8; ++e) { const unsigned wm = rw[q][e >> 1], w0 = rw[q + 1][e >> 1], wn = rw[q + 2][e >> 1];
                    const float um = (e & 1) ? __uint_as_float(wm & 0xffff0000u) : __uint_as_float(wm << 16);
                    const float u0 = (e & 1) ? __uint_as_float(w0 & 0xffff0000u) : __uint_as_float(w0 << 16);
                    const float un = (e & 1) ? __uint_as_float(wn & 0xffff0000u) : __uint_as_float(wn << 16);
                    ts[e] = u0 + mp[e] * (um - u0) + mn[e] * (un - u0); }
                if (chunk < 32 || (chunk >= 64 && chunk < 96)) { v4u o; o.x = pk2(ts[0], ts[1]); o.y = pk2(ts[2], ts[3]); o.z = pk2(ts[4], ts[5]); o.w = pk2(ts[6], ts[7]);
                    bf16* dst = chunk < 32 ? RR + (size_t)(row0 + tl) * 256 + c0 : VV + (size_t)(row0 + tl) * 256 + (c0 - 512);
                    *(v4u*)dst = o; }
                else if (chunk < 64) { float* kp = kl + tl * 256 + (c0 - 256); *(f32x4*)kp = (f32x4){ts[0], ts[1], ts[2], ts[3]}; *(f32x4*)(kp + 4) = (f32x4){ts[4], ts[5], ts[6], ts[7]}; }
                else if (chunk < 104) {
#pragma unroll
                    for (int e = 0; e < 8; ++e) tw[(c0 - 768 + e) * 36 + tl] = tanhf_(ts[e]); }
                else if (chunk < 112) {
#pragma unroll
                    for (int e = 0; e < 8; ++e) ta[(c0 - 832 + e) * 36 + tl] = ts[e]; }
                else {
#pragma unroll
                    for (int e = 0; e < 8; ++e) tg[(c0 - 896 + e) * 36 + tl] = sigm(ts[e]); }
            }
        }
        __syncthreads();
        {
            const int tid2 = ltid(); const int ch = tid2 & 255, d = tid2 >> 8;
            const float* WU = IN(26) + ((size_t)(l * 2 + d) * 64) * 256 + ch; const float* AU = IN(28) + ((size_t)(l * 2 + d) * 64) * 256 + ch;
            float aw[32], aa[32];
#pragma unroll
            for (int t = 0; t < 32; ++t) { aw[t] = 0.f; aa[t] = 0.f; }
#pragma unroll 2
            for (int i = 0; i < 64; ++i) { const float wu = WU[i * 256], au = AU[i * 256];
#pragma unroll
                for (int t = 0; t < 32; t += 4) { const f32x4 x = *(const f32x4*)(tw + i * 36 + t), y = *(const f32x4*)(ta + i * 36 + t);
                    aw[t] += x[0] * wu; aw[t + 1] += x[1] * wu; aw[t + 2] += x[2] * wu; aw[t + 3] += x[3] * wu;
                    aa[t] += y[0] * au; aa[t + 1] += y[1] * au; aa[t + 2] += y[2] * au; aa[t + 3] += y[3] * au; } }
            const float w0 = IN(25)[(l * 2 + d) * 256 + ch], a0 = IN(27)[(l * 2 + d) * 256 + ch], kkc = IN(30)[l * 256 + ch], kac = IN(31)[l * 256 + ch];
            float* WW = (float*)(ws + M_WW) + (size_t)d * NR * 256; bf16* BB = (bf16*)(ws + M_BB + (size_t)d * A8); bf16* KD = (bf16*)(ws + M_KD + (size_t)d * A8);
#pragma unroll
            for (int t = 0; t < 32; ++t) { const size_t o = (size_t)(row0 + t) * 256 + ch;
                const float k = kl[t * 256 + ch];
                const float kr = k * kkc; const float nrm = wave_sum(kr * kr); const float kk = kr * rsqrtf(fmaxf(nrm, 1e-24f));
                const float e = sigm(w0 + aw[t]) * 0.6065306597126334f;
                const float av = sigm(a0 + aa[t]);
                WW[o] = __expf(-e);
                KD[o] = (bf16)f2bf(k * (1.f + (av - 1.f) * kac));
                BB[o] = (bf16)f2bf(kk * av);
                if (d == 0) KKo[o] = (bf16)f2bf(kk); }
        }
        {
            const float* GU = IN(29) + (size_t)l * 128 * 256 + ch;
            float ag[16];
#pragma unroll
            for (int t = 0; t < 16; ++t) ag[t] = 0.f;
#pragma unroll 2
            for (int i = 0; i < 128; ++i) { const float gu = GU[i * 256];
#pragma unroll
                for (int t = 0; t < 16; t += 4) { const f32x4 x = *(const f32x4*)(tg + i * 36 + part * 16 + t);
                    ag[t] += x[0] * gu; ag[t + 1] += x[1] * gu; ag[t + 2] += x[2] * gu; ag[t + 3] += x[3] * gu; } }
#pragma unroll
            for (int t = 0; t < 16; ++t) GC[(size_t)(row0 + part * 16 + t) * 256 + ch] = (bf16)f2bf(ag[t]);
        }
        __syncthreads();
    }
}

typedef const unsigned cu32;
typedef const float cf32;
__device__ __forceinline__ int chain_row(int b, int d, int tau) {
    return tau < CTXL ? (NLAT + b * CTXL + (d ? CTXL - 1 - tau : tau)) : (b * TLEN + (d ? TLEN - 1 - (tau - CTXL) : (tau - CTXL)));
}
template <int MODE>
__device__ __forceinline__ void rwkv_steps(float (&S)[64], int b, int h, int d, int tau0, int n, unsigned char* ws, int lane, float* wl) {
    const bf16* KKp = (const bf16*)(ws + M_KK); const bf16* RRp = (const bf16*)(ws + M_RR); const bf16* VVp = (const bf16*)(ws + M_VV);
    const float* WWp = (const float*)(ws + M_WW) + (size_t)d * NR * 256; const bf16* BBp = (const bf16*)(ws + M_BB + (size_t)d * A8); const bf16* KDp = (const bf16*)(ws + M_KD + (size_t)d * A8);
    float* YS = (float*)(ws + M_YS) + (size_t)d * NR * 256;
    float pk, pw, pb, pkd = 0.f, pr = 0.f, pv = 0.f; size_t poff;
#define RWKV_LOAD(s_) do { poff = (size_t)chain_row(b, d, tau0 + (s_)) * 256 + h * 64 + lane; pk = bf2f(KKp[poff]); pw = WWp[poff]; pb = bf2f(BBp[poff]); \
        if (MODE != 1) { pkd = bf2f(KDp[poff]); pv = bf2f(VVp[poff]); } if (MODE == 2) pr = bf2f(RRp[poff]); } while (0)
    RWKV_LOAD(0);
    for (int s = 0; s < n; ++s) {
        float* buf = wl + (s & 1) * 320;
        buf[lane] = pk; buf[64 + lane] = pw; buf[128 + lane] = pb;
        if (MODE != 1) buf[192 + lane] = pkd;
        if (MODE == 2) buf[256 + lane] = pr;
        const float vv = pv; const size_t yoff = poff;
        if (s + 1 < n) RWKV_LOAD(s + 1);
        float sa0 = 0.f, sa1 = 0.f, sa2 = 0.f, sa3 = 0.f;
#pragma unroll
        for (int i = 0; i < 64; i += 4) { const f32x4 k4 = *(const f32x4*)(buf + i);
            sa0 += S[i] * k4[0]; sa1 += S[i + 1] * k4[1]; sa2 += S[i + 2] * k4[2]; sa3 += S[i + 3] * k4[3]; }
        const float nsa = -((sa0 + sa1) + (sa2 + sa3));
        float y0 = 0.f, y1 = 0.f, y2 = 0.f, y3 = 0.f;
#pragma unroll
        for (int i = 0; i < 64; i += 4) { const f32x4 w4 = *(const f32x4*)(buf + 64 + i), b4 = *(const f32x4*)(buf + 128 + i);
            f32x4 t = nsa * b4;
            if (MODE != 1) { const f32x4 kd4 = *(const f32x4*)(buf + 192 + i); t += vv * kd4; }
            S[i] = S[i] * w4[0] + t[0]; S[i + 1] = S[i + 1] * w4[1] + t[1]; S[i + 2] = S[i + 2] * w4[2] + t[2]; S[i + 3] = S[i + 3] * w4[3] + t[3];
            if (MODE == 2) { const f32x4 r4 = *(const f32x4*)(buf + 256 + i); y0 += S[i] * r4[0]; y1 += S[i + 1] * r4[1]; y2 += S[i + 2] * r4[2]; y3 += S[i + 3] * r4[3]; } }
        if (MODE == 2) YS[yoff] = (y0 + y1) + (y2 + y3);
    }
#undef RWKV_LOAD
}
typedef float f32x2 __attribute__((ext_vector_type(2)));
__device__ __forceinline__ void rwkv_pass1(f32x2 (&SL)[32], f32x2 (&SI)[32], int b, int h, int d, int tau0, int n, unsigned char* ws, int lane, float* wl) {
    const bf16* KKp = (const bf16*)(ws + M_KK); const bf16* VVp = (const bf16*)(ws + M_VV); const bf16* RRp = (const bf16*)(ws + M_RR);
    const float* WWp = (const float*)(ws + M_WW) + (size_t)d * NR * 256; const bf16* BBp = (const bf16*)(ws + M_BB + (size_t)d * A8); const bf16* KDp = (const bf16*)(ws + M_KD + (size_t)d * A8);
    float* YS = (float*)(ws + M_YS) + (size_t)d * NR * 256; float* PR = (float*)(ws + M_PR) + (size_t)d * NR * 256;
    float pk, pw, pb, pkd, pv, pr; size_t poff;
#define RWKV_LOAD(s_) do { poff = (size_t)chain_row(b, d, tau0 + (s_)) * 256 + h * 64 + lane; pk = bf2f(KKp[poff]); pw = WWp[poff]; pb = bf2f(BBp[poff]); pkd = bf2f(KDp[poff]); pv = bf2f(VVp[poff]); pr = bf2f(RRp[poff]); } while (0)
    RWKV_LOAD(0);
    for (int s = 0; s < n; ++s) {
        float* buf = wl + (s & 1) * 320;
        buf[lane] = pk; buf[64 + lane] = pw; buf[128 + lane] = pb; buf[192 + lane] = pkd; buf[256 + lane] = pr;
        const float vv = pv; const size_t yoff = poff;
        if (s + 1 < n) RWKV_LOAD(s + 1);
        f32x2 aL0 = {0.f, 0.f}, aL1 = aL0, aI0 = aL0, aI1 = aL0;
#pragma unroll
        for (int q = 0; q < 16; ++q) { const f32x4 k4 = *(const f32x4*)(buf + 4 * q);
            aL0 += SL[2 * q] * k4.lo; aL1 += SL[2 * q + 1] * k4.hi; aI0 += SI[2 * q] * k4.lo; aI1 += SI[2 * q + 1] * k4.hi; }
        const f32x2 tL = aL0 + aL1, tI = aI0 + aI1;
        const float nsl = -(tL.x + tL.y), nsi = -(tI.x + tI.y);
        f32x2 yL0 = {0.f, 0.f}, yL1 = yL0, yI0 = yL0, yI1 = yL0;
#pragma unroll
        for (int q = 0; q < 16; ++q) {
            const f32x4 w4 = *(const f32x4*)(buf + 64 + 4 * q), b4 = *(const f32x4*)(buf + 128 + 4 * q), kd4 = *(const f32x4*)(buf + 192 + 4 * q), r4 = *(const f32x4*)(buf + 256 + 4 * q);
            const f32x4 tl = nsl * b4 + vv * kd4, tiv = nsi * b4;
            SL[2 * q] = SL[2 * q] * w4.lo + tl.lo; SL[2 * q + 1] = SL[2 * q + 1] * w4.hi + tl.hi;
            SI[2 * q] = SI[2 * q] * w4.lo + tiv.lo; SI[2 * q + 1] = SI[2 * q + 1] * w4.hi + tiv.hi;
            yL0 += SL[2 * q] * r4.lo; yL1 += SL[2 * q + 1] * r4.hi; yI0 += SI[2 * q] * r4.lo; yI1 += SI[2 * q + 1] * r4.hi; }
        const f32x2 yl = yL0 + yL1, yp = yI0 + yI1;
        YS[yoff] = yl.x + yl.y; PR[yoff] = yp.x + yp.y;
    }
#undef RWKV_LOAD
}
__device__ __forceinline__ void phase_m4(const Args& a, unsigned char* lds, int G, int bid, int tid) {
    const int lane = tid & 63, wave = __builtin_amdgcn_readfirstlane(tid >> 6);
    unsigned char* ws = karg_ws(); float* PL = (float*)(ws + M_PL);
    if (wave >= 4) return;
    for (int task = bid * 4 + wave; task < 16 * NSEG; task += G * 4) {
        const int seg = task & (NSEG - 1), chain = task >> 6;
        const int d = chain & 1, h = (chain >> 1) & 3, b = chain >> 3;
        f32x2 SL[32], SI[32]; int ln = lane; asm volatile("" : "+v"(ln));
#pragma unroll
        for (int i = 0; i < 32; ++i) { SL[i] = (f32x2){0.f, 0.f}; SI[i] = (f32x2){(2 * i == ln) ? 1.f : 0.f, (2 * i + 1 == ln) ? 1.f : 0.f}; }
        rwkv_pass1(SL, SI, b, h, d, seg * SEGLEN, SEGLEN, ws, lane, (float*)lds + wave * 640);
        float* o = PL + (((size_t)(chain * NSEG + seg) * 2) * 64 + lane) * 64;
#pragma unroll
        for (int i = 0; i < 32; i += 2) { *(f32x4*)(o + 2 * i) = (f32x4){SL[i].x, SL[i].y, SL[i + 1].x, SL[i + 1].y}; *(f32x4*)(o + 4096 + 2 * i) = (f32x4){SI[i].x, SI[i].y, SI[i + 1].x, SI[i + 1].y}; }
    }
}
__device__ __forceinline__ void phase_m5(const Args& a, unsigned char* lds, int G, int bid, int tid) {
    unsigned char* ws = karg_ws(); const float* PL = (const float*)(ws + M_PL); float* SI = (float*)(ws + M_SINIT);
    float* Sl = (float*)lds;
    float* Pl = (float*)(lds + 8192);
    typedef float f32x2v __attribute__((ext_vector_type(2)));
    const int rl = tid >> 5, c2 = (tid & 31) * 2;
    for (int u = bid; u < 64; u += G) {
        const int chain = u >> 2, row = (u & 3) * 16 + rl;
        f32x2v cur = {0.f, 0.f};
        const float* Pg = PL + ((size_t)(chain * NSEG) * 2 + 1) * 4096; const float* Lg = PL + ((size_t)(chain * NSEG) * 2) * 4096;
        f32x4 pa[4], pb[4]; f32x2v lv[4];
#pragma unroll
        for (int q = 0; q < 4; ++q) { const float* Pn = Pg + (size_t)q * 8192; const float* Ln = Lg + (size_t)q * 8192;
            pa[q] = *(const f32x4*)(Pn + tid * 8); pb[q] = *(const f32x4*)(Pn + tid * 8 + 4); lv[q] = *(const f32x2v*)(Ln + row * 64 + c2); }
        for (int g0 = 0; g0 < NSEG; g0 += 4) {
#pragma unroll
            for (int q = 0; q < 4; ++q) { const int g = g0 + q;
                *(f32x2v*)(SI + ((size_t)(chain * NSEG + g) * 64 + row) * 64 + c2) = cur;
                if (g < NSEG - 1) {
                    *(f32x2v*)(Sl + rl * 66 + c2) = cur;
                    *(f32x4*)(Pl + tid * 8) = pa[q]; *(f32x4*)(Pl + tid * 8 + 4) = pb[q];
                    f32x2v nw = lv[q];
                    if (g + 4 < NSEG - 1) { const float* Pn = Pg + (size_t)(g + 4) * 8192; const float* Ln = Lg + (size_t)(g + 4) * 8192;
                        pa[q] = *(const f32x4*)(Pn + tid * 8); pb[q] = *(const f32x4*)(Pn + tid * 8 + 4); lv[q] = *(const f32x2v*)(Ln + row * 64 + c2); }
                    __syncthreads();
#pragma unroll 16
                    for (int i = 0; i < 64; ++i) { const float sv = Sl[rl * 66 + i]; const f32x2v pv = *(const f32x2v*)(Pl + i * 64 + c2); nw += sv * pv; }
                    cur = nw;
                    __syncthreads();
                }
            }
        }
    }
}
__device__ __forceinline__ void phase_m6(const Args& a, unsigned char* lds, int G, int bid, int tid) {
    const int lane = tid & 63, wave = __builtin_amdgcn_readfirstlane(tid >> 6);
    unsigned char* ws = karg_ws(); const float* SI = (const float*)(ws + M_SINIT);
    float* wl = (float*)lds + wave * 256;
    for (int task = bid * 8 + wave; task < 16 * (NSEG - 1); task += G * 8) {
        const int seg = 1 + task % (NSEG - 1), chain = task / (NSEG - 1);
        const int d = chain & 1, h = (chain >> 1) & 3, b = chain >> 3;
        float* YS = (float*)(ws + M_YS) + (size_t)d * NR * 256; const float* PR = (const float*)(ws + M_PR) + (size_t)d * NR * 256;
        f32x2 S0[32];
        const float* si = SI + ((size_t)(chain * NSEG + seg) * 64 + lane) * 64;
#pragma unroll
        for (int i = 0; i < 32; i += 2) { const f32x4 v = *(const f32x4*)(si + 2 * i); S0[i] = v.lo; S0[i + 1] = v.hi; }
        const int tau0 = seg * SEGLEN;
        size_t o0 = (size_t)chain_row(b, d, tau0) * 256 + h * 64 + lane, o1 = (size_t)chain_row(b, d, tau0 + 1) * 256 + h * 64 + lane;
        float p0 = PR[o0], p1 = PR[o1], y0 = YS[o0], y1 = YS[o1];
        for (int s = 0; s < SEGLEN; s += 2) {
            wl[lane] = p0; wl[64 + lane] = p1;
            const size_t c0 = o0, c1 = o1; const float yy0 = y0, yy1 = y1;
            if (s + 2 < SEGLEN) { o0 = (size_t)chain_row(b, d, tau0 + s + 2) * 256 + h * 64 + lane; o1 = (size_t)chain_row(b, d, tau0 + s + 3) * 256 + h * 64 + lane; p0 = PR[o0]; p1 = PR[o1]; y0 = YS[o0]; y1 = YS[o1]; }
            f32x2 a0 = {0.f, 0.f}, a1 = a0, b0 = a0, b1 = a0;
#pragma unroll
            for (int q = 0; q < 16; ++q) { const f32x4 u = *(const f32x4*)(wl + 4 * q), w = *(const f32x4*)(wl + 64 + 4 * q);
                a0 += S0[2 * q] * u.lo; a1 += S0[2 * q + 1] * u.hi; b0 += S0[2 * q] * w.lo; b1 += S0[2 * q + 1] * w.hi; }
            const f32x2 ta = a0 + a1, tb = b0 + b1;
            YS[c0] = yy0 + (ta.x + ta.y); YS[c1] = yy1 + (tb.x + tb.y);
            asm volatile("" ::: "memory");
        }
    }
}
__device__ __forceinline__ void phase_m7(const Args& a, int l, int gw, int NGW, int lane) {
    unsigned char* ws = karg_ws();
    const float* Y0 = (const float*)(ws + M_YS); const float* Y1 = Y0 + (size_t)NR * 256;
    const bf16* RR = (const bf16*)(ws + M_RR); const bf16* VV = (const bf16*)(ws + M_VV); const bf16* KD0 = (const bf16*)(ws + M_KD); const bf16* KD1 = (const bf16*)(ws + M_KD + A8);
    const bf16* GC = (const bf16*)(ws + M_GC); bf16* Y = (bf16*)(ws + OFF_XMY);
    for (int r = gw; r < NR; r += NGW) {
#pragma unroll
        for (int h = 0; h < 4; ++h) { const int c = h * 64 + lane; const size_t o = (size_t)r * 256 + c;
            const float ys = Y0[o] + Y1[o];
            const float mu = wave_sum(ys) * (1.f / 64.f); const float dv = ys - mu; const float var = wave_sum(dv * dv) * (1.f / 64.f);
            float ov = dv * rsqrtf(var + 64e-5f) * IN(33)[l * 256 + c] + IN(34)[l * 256 + c];
            const float rv = bf2f(RR[o]), rk = IN(32)[l * 256 + c], vv = bf2f(VV[o]);
            const float b0 = wave_sum(rv * bf2f(KD0[o]) * rk), b1 = wave_sum(rv * bf2f(KD1[o]) * rk);
            ov += (b0 + b1) * vv;
            Y[(size_t)r * DM + 512 + c] = (bf16)f2bf(ov * bf2f(GC[o])); }
    }
}

__global__ void __launch_bounds__(512, 2) mega(Args a) {
    extern __shared__ __attribute__((aligned(16))) unsigned char lds[];
    cg::grid_group grid = cg::this_grid();
    const int G = gridDim.x;
    PG8_LAS unsigned char* glds = (PG8_LAS unsigned char*)lds;
#define bid lbid()
#define tid ltid()
#define lane (ltid() & 63)
#define wave (__builtin_amdgcn_readfirstlane(ltid() >> 6))
#define gw (lbid() * 8 + __builtin_amdgcn_readfirstlane(ltid() >> 6))
#define NGW (G * 8)
#define GSYNC() do { grid.sync(); } while (0)

    phase_modgemv(a, (float*)lds, G, bid, tid);
    phase_copy(a, G, bid, tid);
    convert_weights(a, 0, (float*)(lds + 32768) + wave * (64 * 33), gw, NGW, lane, G, bid, tid);
    GSYNC();
#pragma clang loop unroll(full)
    for (int l = 0; l < 2; ++l) {
        if (l > 0) convert_weights(a, l, (float*)lds + wave * (64 * 33), gw, NGW, lane, G, bid, tid);
        phase_modulate(a, l, 0, gw, NGW, lane);
        GSYNC();
        for (int rp = 0; rp < REP_G1; ++rp)
        {
            unsigned char* ws = karg_ws(); float* outp = karg_out(); float* xctx = (float*)(ws + OFF_XCTX); bf16* XM = (bf16*)(ws + OFF_XMY); bf16* HU = (bf16*)(ws + OFF_HU); const float* modl = (const float*)(ws + OFF_MOD) + (size_t)l * 3 * 9216; (void)xctx; (void)XM; (void)HU; (void)modl; (void)outp;
            pg8::Gemm g{XM, (const bf16*)(ws + W_13A), NR, 2 * DFF, DM}; pg8::StaticOrder S; S.init(NR, 2 * DFF, G, bid);
            EpiSwiglu E{HU};
            pg8::gemm_phase<EpiSwiglu, pg8::StaticOrder, true, true>(glds, g, S, E);
        }
        GSYNC();
        {
            unsigned char* ws = karg_ws(); float* outp = karg_out(); float* xctx = (float*)(ws + OFF_XCTX); bf16* XM = (bf16*)(ws + OFF_XMY); bf16* HU = (bf16*)(ws + OFF_HU); const float* modl = (const float*)(ws + OFF_MOD) + (size_t)l * 3 * 9216; (void)xctx; (void)XM; (void)HU; (void)modl; (void)outp;
            pg8::Gemm g{HU, (const bf16*)(ws + W_2A), NR, DM, DFF}; pg8::StaticOrder S; S.init(NR, DM, G, bid);
            EpiResid E{outp, xctx, modl + 2 * 1024, 0.5f};
            pg8::gemm_phase<EpiResid, pg8::StaticOrder, true, true>(glds, g, S, E);
        }
        GSYNC();
        phase_modulate(a, l, 1, gw, NGW, lane);
        GSYNC();
        {
            unsigned char* ws = karg_ws(); float* outp = karg_out(); float* xctx = (float*)(ws + OFF_XCTX); bf16* XM = (bf16*)(ws + OFF_XMY); bf16* HU = (bf16*)(ws + OFF_HU); const float* modl = (const float*)(ws + OFF_MOD) + (size_t)l * 3 * 9216; (void)xctx; (void)XM; (void)HU; (void)modl; (void)outp;
            pg8::Gemm g{XM, (const bf16*)(ws + W_IN), NR, UC, DM}; pg8::StaticOrder S; S.init(NR, UC, G, bid);
            EpiU E{HU, UC};
            pg8::gemm_phase<EpiU, pg8::StaticOrder, true, true>(glds, g, S, E);
        }
        GSYNC();
        for (int rp = 0; rp < REP_M1; ++rp) { phase_m1(a, l, lds, G, bid, tid);
        GSYNC(); }
        for (int rp = 0; rp < REP_M2; ++rp) { phase_m2(a, l, lds, G, bid, tid);
        GSYNC(); }
        for (int rp = 0; rp < REP_M3; ++rp) { phase_m3(a, l, lds, G, bid, tid);
        GSYNC(); }
        for (int rp = 0; rp < REP_SCAN; ++rp) { phase_m4(a, lds, G, bid, tid);
        GSYNC();
        phase_m5(a, lds, G, bid, tid);
        GSYNC();
        phase_m6(a, lds, G, bid, tid);
        GSYNC(); }
        phase_m7(a, l, gw, NGW, lane);
        GSYNC();
        {
            unsigned char* ws = karg_ws(); float* outp = karg_out(); float* xctx = (float*)(ws + OFF_XCTX); bf16* XM = (bf16*)(ws + OFF_XMY); bf16* HU = (bf16*)(ws + OFF_HU); const float* modl = (const float*)(ws + OFF_MOD) + (size_t)l * 3 * 9216; (void)xctx; (void)XM; (void)HU; (void)modl; (void)outp;
            pg8::Gemm g{XM, (const bf16*)(ws + W_OUT), NR, DM, DM}; pg8::StaticOrder S; S.init(NR, DM, G, bid);
            EpiResid E{outp, xctx, modl + 5 * 1024, 1.0f};
            pg8::gemm_phase<EpiResid, pg8::StaticOrder, true, true>(glds, g, S, E);
        }
        GSYNC();
        phase_modulate(a, l, 2, gw, NGW, lane);
        GSYNC();
        {
            unsigned char* ws = karg_ws(); float* outp = karg_out(); float* xctx = (float*)(ws + OFF_XCTX); bf16* XM = (bf16*)(ws + OFF_XMY); bf16* HU = (bf16*)(ws + OFF_HU); const float* modl = (const float*)(ws + OFF_MOD) + (size_t)l * 3 * 9216; (void)xctx; (void)XM; (void)HU; (void)modl; (void)outp;
            pg8::Gemm g{XM, (const bf16*)(ws + W_13B), NR, 2 * DFF, DM}; pg8::StaticOrder S; S.init(NR, 2 * DFF, G, bid);
            EpiSwiglu E{HU};
            pg8::gemm_phase<EpiSwiglu, pg8::StaticOrder, true, true>(glds, g, S, E);
        }
        GSYNC();
        {
            unsigned char* ws = karg_ws(); float* outp = karg_out(); float* xctx = (float*)(ws + OFF_XCTX); bf16* XM = (bf16*)(ws + OFF_XMY); bf16* HU = (bf16*)(ws + OFF_HU); const float* modl = (const float*)(ws + OFF_MOD) + (size_t)l * 3 * 9216; (void)xctx; (void)XM; (void)HU; (void)modl; (void)outp;
            pg8::Gemm g{HU, (const bf16*)(ws + W_2B), NR, DM, DFF}; pg8::StaticOrder S; S.init(NR, DM, G, bid);
            EpiResid E{outp, xctx, modl + 8 * 1024, 0.5f};
            pg8::gemm_phase<EpiResid, pg8::StaticOrder, true, true>(glds, g, S, E);
        }
        GSYNC();
    }
    phase_final(a, gw, NGW, lane);
#undef bid
#undef tid
#undef lane
#undef wave
#undef gw
#undef NGW
}

extern "C" void kernel_launch(void* const* d_in, const int* in_sizes, int n_in, void* d_out, int out_size, void* d_ws, size_t ws_size, hipStream_t stream) {
    static int grid = 0;
    if (grid == 0) {
        int dev = 0, cus = 0, per_cu = 0;
        (void)hipGetDevice(&dev);
        (void)hipDeviceGetAttribute(&cus, hipDeviceAttributeMultiprocessorCount, dev);
        (void)hipFuncSetAttribute((const void*)mega, hipFuncAttributeMaxDynamicSharedMemorySize, LDS_BYTES);
        (void)hipOccupancyMaxActiveBlocksPerMultiprocessor(&per_cu, (const void*)mega, 512, LDS_BYTES);
        if (per_cu < 1) per_cu = 1;
        grid = cus * per_cu;
        if (n_in != 40 || ws_size < WS_NEED) { fprintf(stderr, "kernel_launch: unexpected n_in %d / ws %zu (need %zu)\n", n_in, ws_size, (size_t)WS_NEED); }
    }
    (void)hipMemsetAsync((char*)d_ws + OFF_MOD, 0, MOD_BYTES, stream);
    Args a{};
    for (int i = 0; i < 40; ++i) a.in[i] = (const float*)d_in[i];
    a.out = (float*)d_out; a.ws = (unsigned char*)d_ws;
    void* args[] = {&a};
    hipError_t e = hipLaunchCooperativeKernel((const void*)mega, dim3(grid), dim3(512), args, LDS_BYTES, stream);
    if (e != hipSuccess) fprintf(stderr, "cooperative launch failed: %s (grid %d)\n", hipGetErrorString(e), grid);
}
```

```cpp
#include <hip/hip_runtime.h>
#include <hip/hip_cooperative_groups.h>
#include <cstdio>
#include <cstdint>
namespace cg = cooperative_groups;
namespace pg8 {
#define PG8_LAS __attribute__((address_space(3)))
typedef unsigned short bf16_t;
typedef short bf16x8 __attribute__((ext_vector_type(8)));
typedef float f32x4 __attribute__((ext_vector_type(4)));
typedef unsigned u32x4 __attribute__((ext_vector_type(4)));
constexpr int BM = 256, BK = 64, HALF = 128, HTB = HALF * BK * 2  , STAGE_BYTES = 8 * HTB, NXCD = 8, WGM = 8;

__host__ __device__ __forceinline__ int lds_byte(int r, int c) { const int st = (r >> 4) * 2 + (c >> 5), rr = r & 15, cc = c & 31, ob = rr * 64 + cc * 2; return st * 1024 + (ob ^ (((ob >> 9) & 1) << 5)); }
__host__ __device__ __forceinline__ void stage_rc(int b, int& R, int& C) { const int st = b / 1024, sb = b % 1024, swz = sb ^ (((sb >> 9) & 1) << 5); R = (st >> 1) * 16 + swz / 64; C = (st & 1) * 32 + (swz % 64) / 2; }
__host__ __device__ __forceinline__ int perm32(int rho) { const int n = rho >> 4, i = rho & 15; return 8 * (i >> 2) + 4 * n + (i & 3); }

struct Unit { int pm, pn; };
struct Gemm { const bf16_t* A; const bf16_t* Bt; int M, N, K; };

struct StaticOrder {
    int nM, nN, nwg, G, c;
    __host__ __device__ void init(int M, int N, int G_, int c_) { nM = M / BM; nN = N / BM; nwg = nM * nN; G = G_; c = c_; }
    __host__ __device__ bool next(int i, Unit& u) const {
        const long L = (long)i * G + c; if (L >= nwg) return false;
        int wgid = (int)L; { const int q = nwg / NXCD, r = nwg % NXCD, xcd = wgid % NXCD, off = wgid / NXCD; wgid = (xcd < r ? xcd * (q + 1) : r * (q + 1) + (xcd - r) * q) + off; }
        const int nig = WGM * nN, gid = wgid / nig, fm = gid * WGM, gsz = (nM - fm) < WGM ? (nM - fm) : WGM;
        u.pm = fm + ((wgid % nig) % gsz); u.pn = (wgid % nig) / gsz; return true;
    }
    __device__ __forceinline__ void a_ready(const Unit&) const {}
    __device__ __forceinline__ void done(const Unit&) const {}
};

__device__ __forceinline__ unsigned cvt_pk_bf16(float lo, float hi) { unsigned r; asm volatile("v_cvt_pk_bf16_f32 %0, %1, %2" : "=v"(r) : "v"(lo), "v"(hi)); return r; }
typedef float f32x2 __attribute__((ext_vector_type(2)));
template <class Epi, class Sched, bool ALIGN_EPI = false, bool SP2 = false>
__device__ __forceinline__ void gemm_phase(PG8_LAS unsigned char* lds, const Gemm g, const Sched& S, const Epi& E) {
    int tid = threadIdx.x; asm volatile("" : "+v"(tid));
    const int wid = __builtin_amdgcn_readfirstlane(tid >> 6), lane = tid & 63, wr = wid >> 2, wc = wid & 3, fr = lane & 15, fq = lane >> 4;
    const int K = g.K, nt = K / BK;
    unsigned voffA[2], voffB[2];
#pragma unroll
    for (int i = 0; i < 2; ++i) { int R, C; stage_rc(tid * 16 + i * 8192, R, C); const int Rb = Epi::PERM ? ((R & ~31) + perm32(R & 31)) : R;
        voffA[i] = (unsigned)(R * K + C) * 2u; voffB[i] = (unsigned)(Rb * K + C) * 2u; }
    const size_t kstep = (size_t)(BK * 2);
    const size_t hstep = (size_t)HALF * K * 2;
    const size_t tstep = 2 * hstep;
    const unsigned ldsw = (unsigned)wid * 1024u;
    const int aoff = lds_byte(wr * 64 + fr, fq * 8), boff = lds_byte(wc * 32 + fr, fq * 8);
#define PG8_SA(b, h) (((b) * 2 + (h)) * HTB)
#define PG8_SB(b, h) ((4 + (b) * 2 + (h)) * HTB)
#define PG8_STAGE(bufoff, gbase, voff) do { _Pragma("unroll") for (int _i = 0; _i < 2; ++_i) \
        __builtin_amdgcn_global_load_lds((const unsigned*)((const char*)(gbase) + (voff)[_i]), (PG8_LAS unsigned*)(lds + (bufoff) + ldsw + _i * 8192), 16, 0, 0); } while (0)
#define PG8_LDA(dst, b, h) do { _Pragma("unroll") for (int m = 0; m < 4; ++m) _Pragma("unroll") for (int k = 0; k < 2; ++k) dst[m][k] = *(const PG8_LAS bf16x8*)(lds + PG8_SA(b, h) + aoff + m * 2048 + k * 1024); } while (0)
#define PG8_LDB(dst, b, h) do { _Pragma("unroll") for (int n = 0; n < 2; ++n) _Pragma("unroll") for (int k = 0; k < 2; ++k) dst[n][k] = *(const PG8_LAS bf16x8*)(lds + PG8_SB(b, h) + boff + n * 2048 + k * 1024); } while (0)
#define PG8_MMA(ai, bj, At, Bt) do { __builtin_amdgcn_s_setprio(1); _Pragma("unroll") for (int m = 0; m < 4; ++m) _Pragma("unroll") for (int n = 0; n < 2; ++n) _Pragma("unroll") for (int k = 0; k < 2; ++k) \
        acc[ai][bj][m][n] = __builtin_amdgcn_mfma_f32_16x16x32_bf16(Bt[n][k], At[m][k], acc[ai][bj][m][n], 0, 0, 0); __builtin_amdgcn_s_setprio(0); } while (0)
#define PG8_WAIT_V(n) asm volatile("s_waitcnt vmcnt(" #n ")" ::: "memory")
#define PG8_WAIT_L(n) asm volatile("s_waitcnt lgkmcnt(" #n ")" ::: "memory")
#define PG8_BAR __builtin_amdgcn_s_barrier()
#define PG8_SCHED __builtin_amdgcn_sched_barrier(0)
    Unit cur, nxt; int ui = 0;
    if (!S.next(0, cur)) return;
    f32x4 acc[2][2][4][2];
#pragma unroll
    for (int a = 0; a < 2; ++a)
#pragma unroll
        for (int b = 0; b < 2; ++b)
#pragma unroll
            for (int m = 0; m < 4; ++m)
#pragma unroll
                for (int n = 0; n < 2; ++n) acc[a][b][m][n] = (f32x4){0.f, 0.f, 0.f, 0.f};
    bf16x8 At[4][2], B0[2][2], B1[2][2];
    const char* cA = (const char*)g.A + (size_t)cur.pm * tstep; const char* cB = (const char*)g.Bt + (size_t)cur.pn * tstep;
    S.a_ready(cur);
    if constexpr (SP2) {
        PG8_STAGE(PG8_SB(0, 0), cB, voffB); PG8_STAGE(PG8_SB(0, 1), cB + hstep, voffB); PG8_STAGE(PG8_SA(0, 0), cA, voffA); PG8_STAGE(PG8_SA(0, 1), cA + hstep, voffA);
        if (wr == 1) PG8_BAR;
        PG8_WAIT_V(2); PG8_BAR;
        PG8_STAGE(PG8_SB(1, 0), cB + kstep, voffB); PG8_STAGE(PG8_SA(1, 0), cA + kstep, voffA); PG8_STAGE(PG8_SB(1, 1), cB + hstep + kstep, voffB);
        PG8_WAIT_V(6); PG8_BAR;
    } else {
        PG8_STAGE(PG8_SB(0, 0), cB, voffB); PG8_STAGE(PG8_SA(0, 0), cA, voffA); PG8_STAGE(PG8_SB(0, 1), cB + hstep, voffB); PG8_STAGE(PG8_SA(0, 1), cA + hstep, voffA);
        if (wr == 1) PG8_BAR;
        PG8_WAIT_V(4); PG8_BAR;
        PG8_STAGE(PG8_SB(1, 0), cB + kstep, voffB); PG8_STAGE(PG8_SA(1, 0), cA + kstep, voffA); PG8_STAGE(PG8_SB(1, 1), cB + hstep + kstep, voffB);
        PG8_WAIT_V(6); PG8_BAR;
    }
    for (;;) {
        const bool has_next = S.next(ui + 1, nxt);
        const char* nA = has_next ? (const char*)g.A + (size_t)nxt.pm * tstep : cA; const char* nB = has_next ? (const char*)g.Bt + (size_t)nxt.pn * tstep : cB;
        for (int t = 0; t < nt; t += 2) {
            const bool last = (t == nt - 2);
            const char* a1 = cA + (size_t)(t + 1) * kstep;
            const char* a2 = last ? nA : cA + (size_t)(t + 2) * kstep; const char* b2 = last ? nB : cB + (size_t)(t + 2) * kstep;
            const char* a3 = a2 + kstep; const char* b3 = b2 + kstep;
            if (last && has_next) S.a_ready(nxt);
            if constexpr (SP2) {
            PG8_LDB(B0, 0, 0); PG8_LDB(B1, 0, 1); PG8_SCHED; PG8_LDA(At, 0, 0); PG8_STAGE(PG8_SA(1, 1), a1 + hstep, voffA);
            PG8_WAIT_V(8); PG8_WAIT_L(0); PG8_BAR; PG8_MMA(0, 0, At, B0); PG8_MMA(0, 1, At, B1); PG8_BAR; PG8_SCHED;
            PG8_LDA(At, 0, 1); PG8_STAGE(PG8_SB(0, 0), b2, voffB); PG8_STAGE(PG8_SB(0, 1), b2 + hstep, voffB); PG8_STAGE(PG8_SA(0, 0), a2, voffA);
            PG8_WAIT_V(8); PG8_WAIT_L(0); PG8_BAR; PG8_MMA(1, 0, At, B0); PG8_MMA(1, 1, At, B1); PG8_BAR; PG8_SCHED;
            PG8_LDB(B0, 1, 0); PG8_LDB(B1, 1, 1); PG8_SCHED; PG8_LDA(At, 1, 0); PG8_STAGE(PG8_SA(0, 1), a2 + hstep, voffA);
            PG8_WAIT_V(8); PG8_WAIT_L(0); PG8_BAR; PG8_MMA(0, 0, At, B0); PG8_MMA(0, 1, At, B1); PG8_BAR; PG8_SCHED;
            PG8_LDA(At, 1, 1); PG8_STAGE(PG8_SB(1, 0), b3, voffB); PG8_STAGE(PG8_SB(1, 1), b3 + hstep, voffB); PG8_STAGE(PG8_SA(1, 0), a3, voffA);
            PG8_WAIT_V(8); PG8_WAIT_L(0); PG8_BAR; PG8_MMA(1, 0, At, B0); PG8_MMA(1, 1, At, B1); PG8_BAR; PG8_SCHED;
            } else {
            PG8_LDB(B0, 0, 0); PG8_SCHED; PG8_LDA(At, 0, 0); PG8_STAGE(PG8_SA(1, 1), a1 + hstep, voffA);
            PG8_WAIT_L(8); PG8_BAR; PG8_WAIT_L(0); PG8_MMA(0, 0, At, B0); PG8_BAR; PG8_SCHED;
            PG8_LDB(B1, 0, 1); PG8_STAGE(PG8_SB(0, 0), b2, voffB);
            PG8_BAR; PG8_WAIT_L(0); PG8_MMA(0, 1, At, B1); PG8_BAR;
            PG8_LDA(At, 0, 1); PG8_STAGE(PG8_SA(0, 0), a2, voffA);
            PG8_BAR; PG8_WAIT_L(0); PG8_MMA(1, 0, At, B0); PG8_BAR; PG8_SCHED;
            PG8_STAGE(PG8_SB(0, 1), b2 + hstep, voffB);
            PG8_WAIT_V(6); PG8_BAR; PG8_MMA(1, 1, At, B1); PG8_BAR;
            PG8_LDB(B0, 1, 0); PG8_SCHED; PG8_LDA(At, 1, 0); PG8_STAGE(PG8_SA(0, 1), a2 + hstep, voffA);
            PG8_WAIT_L(8); PG8_BAR; PG8_WAIT_L(0); PG8_MMA(0, 0, At, B0); PG8_BAR; PG8_SCHED;
            PG8_LDB(B1, 1, 1); PG8_STAGE(PG8_SB(1, 0), b3, voffB);
            PG8_BAR; PG8_WAIT_L(0); PG8_MMA(0, 1, At, B1); PG8_BAR;
            PG8_LDA(At, 1, 1); PG8_STAGE(PG8_SA(1, 0), a3, voffA);
            PG8_BAR; PG8_WAIT_L(0); PG8_MMA(1, 0, At, B0); PG8_BAR; PG8_SCHED;
            PG8_STAGE(PG8_SB(1, 1), b3 + hstep, voffB);
            PG8_WAIT_V(6); PG8_BAR; PG8_MMA(1, 1, At, B1); PG8_BAR;
            }
        }
        if constexpr (ALIGN_EPI) { if (wr == 0) PG8_BAR; }
        if constexpr (!Epi::AFTER_DRAIN) { E(acc, cur, wr, wc, fr, fq); S.done(cur); }
        if (!has_next) break;
#pragma unroll
        for (int a = 0; a < 2; ++a)
#pragma unroll
            for (int b = 0; b < 2; ++b)
#pragma unroll
                for (int m = 0; m < 4; ++m)
#pragma unroll
                    for (int n = 0; n < 2; ++n) acc[a][b][m][n] = (f32x4){0.f, 0.f, 0.f, 0.f};
        cur = nxt; cA = nA; cB = nB; ++ui;
        if constexpr (ALIGN_EPI) { if (wr == 1) PG8_BAR; }
    }
    PG8_WAIT_V(0);
    if constexpr (!ALIGN_EPI) { if (wr == 0) PG8_BAR; }
    PG8_BAR;
    if constexpr (Epi::AFTER_DRAIN) { E.fused(acc, cur, wr, wc, fr, fq, lds, wid, lane); S.done(cur); }
#undef PG8_SA
#undef PG8_SB
#undef PG8_STAGE
#undef PG8_LDA
#undef PG8_LDB
#undef PG8_MMA
#undef PG8_WAIT_V
#undef PG8_WAIT_L
#undef PG8_BAR
#undef PG8_SCHED
}
}

using pg8::f32x4; using pg8::bf16x8;
typedef unsigned short bf16;
typedef unsigned v4u __attribute__((ext_vector_type(4)));
typedef unsigned v2u __attribute__((ext_vector_type(2)));
typedef short s16x4 __attribute__((ext_vector_type(4)));

constexpr int DM = 1024, TLEN = 8192, CTXL = 256, TT = 8448, NLAT = 16384, NR = 16896, DFF = 2816, UC = 2560, NTILE = 528;
constexpr int NSEG = 64, SEGLEN = 132;
constexpr size_t MiB = 1u << 20;
constexpr size_t A8 = (size_t)NR * 256 * 2;
constexpr size_t OFF_MOD = 0, MOD_BYTES = 256 * 1024;
constexpr size_t OFF_XCTX = MiB / 4, OFF_XMY = 2 * MiB + MiB / 4, OFF_HU = 35 * MiB + MiB / 4, OFF_W = 126 * MiB, OFF_MIX = 167 * MiB, OFF_PR = 266 * MiB;
constexpr size_t W_13A = OFF_W, W_2A = OFF_W + 11 * MiB, W_13B = OFF_W + 16 * MiB + MiB / 2, W_2B = OFF_W + 27 * MiB + MiB / 2,
                 W_IN = OFF_W + 33 * MiB, W_OUT = OFF_W + 38 * MiB, W_UQ = OFF_W + 40 * MiB, W_UKV = OFF_W + 40 * MiB + 256 * 1024,
                 W_WUP = OFF_W + 40 * MiB + 384 * 1024, W_AUP = W_WUP + 65536, W_GUP = W_AUP + 65536, W_LWA = W_GUP + 65536, W_LWX = W_LWA + 65536;
constexpr size_t M_QB = OFF_MIX, M_KB = OFF_MIX + 12976128, M_VT = OFF_MIX + 25952256;
constexpr size_t M_LR0 = OFF_MIX + 4 * A8, M_LIX0 = OFF_MIX + 6 * A8, M_GB = OFF_MIX + 8 * A8, M_SEGA = OFF_MIX + 9 * A8, M_SEGB = M_SEGA + 2 * MiB;
constexpr size_t M_RR = OFF_MIX, M_KK = OFF_MIX + A8, M_VV = OFF_MIX + 2 * A8, M_WW = OFF_MIX + 3 * A8, M_BB = OFF_MIX + 7 * A8, M_KD = OFF_MIX + 9 * A8, M_GC = OFF_MIX + 11 * A8;
constexpr size_t M_YS = OFF_HU, M_PL = OFF_HU + 33 * MiB, M_SINIT = OFF_HU + 65 * MiB;
constexpr size_t M_PR = OFF_PR;
constexpr size_t WS_NEED = OFF_PR + 33 * MiB;
constexpr int LDS_BYTES = 131072 + 1024;
#ifndef REP_M1
#define REP_M1 1
#endif
#ifndef REP_M2
#define REP_M2 1
#endif
#ifndef REP_M3
#define REP_M3 1
#endif
#ifndef REP_SCAN
#define REP_SCAN 1
#endif
#ifndef REP_G1
#define REP_G1 1
#endif
constexpr float QSCALE = 0.10206207261596575f * 1.4426950408889634f;

struct Args { const float* in[40]; float* out; unsigned char* ws; };
typedef const __attribute__((address_space(4))) volatile unsigned long long kargq;
__device__ __forceinline__ const float* karg_in(int i) { kargq* p = (kargq*)__builtin_amdgcn_kernarg_segment_ptr(); return (const float*)p[i]; }
__device__ __forceinline__ float* karg_out() { kargq* p = (kargq*)__builtin_amdgcn_kernarg_segment_ptr(); return (float*)p[40]; }
__device__ __forceinline__ unsigned char* karg_ws() { kargq* p = (kargq*)__builtin_amdgcn_kernarg_segment_ptr(); return (unsigned char*)p[41]; }
#define IN(i) karg_in(i)
__device__ __forceinline__ int ltid() { int t = threadIdx.x; asm volatile("" : "+v"(t)); return t; }
__device__ __forceinline__ int lbid() { int t = blockIdx.x; asm volatile("" : "+s"(t)); return t; }
template <class T> __device__ __forceinline__ T* launder(T* p) { asm volatile("" : "+s"(p)); return p; }

__device__ __forceinline__ float bf2f(bf16 h) { return __uint_as_float((unsigned)h << 16); }
__device__ __forceinline__ unsigned f2bf(float f) { unsigned u = __float_as_uint(f); return (u + 0x7fffu + ((u >> 16) & 1u)) >> 16; }
__device__ __forceinline__ unsigned pk2(float lo, float hi) { return f2bf(lo) | (f2bf(hi) << 16); }
__device__ __forceinline__ float sigm(float x) { return 1.f / (1.f + __expf(-x)); }
__device__ __forceinline__ float siluf_(float x) { return x / (1.f + __expf(-x)); }
__device__ __forceinline__ float tanhf_(float y) { return 1.f - 2.f / (1.f + __expf(2.f * y)); }
__device__ __forceinline__ float geluf_(float x) { return 0.5f * x * (1.f + tanhf_(0.7978845608028654f * (x + 0.044715f * x * x * x))); }
__device__ __forceinline__ float wave_sum(float v) {
#pragma unroll
    for (int o = 1; o < 64; o <<= 1) v += __shfl_xor(v, o);
    return v;
}
struct TileInfo { int b, isctx, t0, seqbase, seqlen; };
__device__ __forceinline__ TileInfo tile_info(int tile) {
    TileInfo ti;
    if (tile < 512) { ti.b = tile >> 8; ti.isctx = 0; ti.t0 = (tile & 255) * 32; ti.seqbase = ti.b * TLEN; ti.seqlen = TLEN; }
    else { const int q = tile - 512; ti.b = q >> 3; ti.isctx = 1; ti.t0 = (q & 7) * 32; ti.seqbase = NLAT + ti.b * CTXL; ti.seqlen = CTXL; }
    return ti;
}

struct EpiSwiglu {
    static constexpr bool PERM = true, AFTER_DRAIN = false;
    bf16* H;
    __device__ __forceinline__ void operator()(const f32x4 (&acc)[2][2][4][2], const pg8::Unit& u, int wr, int wc, int fr, int fq) const {
        int pm = u.pm, pn = u.pn; asm volatile("" : "+s"(pm), "+s"(pn), "+s"(wr), "+s"(wc), "+v"(fr), "+v"(fq));
        bf16* tb = H + (size_t)pm * 256 * DFF + pn * 128;
        const unsigned loff = (unsigned)((wr * 64 + fr) * DFF + wc * 32 + 8 * fq);
#pragma unroll
        for (int ai = 0; ai < 2; ++ai)
#pragma unroll
            for (int m = 0; m < 4; ++m) {
                bf16* rowp = tb + (loff + (unsigned)((ai * 128 + m * 16) * DFF));
                const f32x4 g0 = acc[ai][0][m][0], g1 = acc[ai][0][m][1], u0 = acc[ai][1][m][0], u1 = acc[ai][1][m][1];
                v4u w;
                w.x = pg8::cvt_pk_bf16(siluf_(g0[0]) * u0[0], siluf_(g0[1]) * u0[1]); w.y = pg8::cvt_pk_bf16(siluf_(g0[2]) * u0[2], siluf_(g0[3]) * u0[3]);
                w.z = pg8::cvt_pk_bf16(siluf_(g1[0]) * u1[0], siluf_(g1[1]) * u1[1]); w.w = pg8::cvt_pk_bf16(siluf_(g1[2]) * u1[2], siluf_(g1[3]) * u1[3]);
                *(v4u*)rowp = w;
            }
    }
};
struct EpiU {
    static constexpr bool PERM = true, AFTER_DRAIN = false;
    bf16* O; int ldc;
    __device__ __forceinline__ void operator()(const f32x4 (&acc)[2][2][4][2], const pg8::Unit& u, int wr, int wc, int fr, int fq) const {
        int pm = u.pm, pn = u.pn; asm volatile("" : "+s"(pm), "+s"(pn), "+s"(wr), "+s"(wc), "+v"(fr), "+v"(fq));
        bf16* tb = O + (size_t)pm * 256 * ldc + pn * 256;
        const unsigned loff = (unsigned)((wr * 64 + fr) * ldc + wc * 32 + 8 * fq);
#pragma unroll
        for (int ai = 0; ai < 2; ++ai)
#pragma unroll
            for (int m = 0; m < 4; ++m) {
                bf16* rowp = tb + (loff + (unsigned)((ai * 128 + m * 16) * ldc));
#pragma unroll
                for (int bj = 0; bj < 2; ++bj) { const f32x4 v0 = acc[ai][bj][m][0], v1 = acc[ai][bj][m][1]; v4u w;
                    w.x = pg8::cvt_pk_bf16(v0[0], v0[1]); w.y = pg8::cvt_pk_bf16(v0[2], v0[3]); w.z = pg8::cvt_pk_bf16(v1[0], v1[1]); w.w = pg8::cvt_pk_bf16(v1[2], v1[3]);
                    *(v4u*)(rowp + bj * 128) = w; }
            }
    }
};
struct EpiResid {
    static constexpr bool PERM = false, AFTER_DRAIN = false;
    float* xlat; float* xctx; const float* gate; float coef;
    __device__ __forceinline__ void operator()(const f32x4 (&acc)[2][2][4][2], const pg8::Unit& u, int wr, int wc, int fr, int fq) const {
        int pm = u.pm, pn = u.pn; asm volatile("" : "+s"(pm), "+s"(pn), "+s"(wr), "+s"(wc), "+v"(fr), "+v"(fq));
        float* tb = (pm < 64 ? xlat + (size_t)pm * 256 * DM : xctx + (size_t)(pm - 64) * 256 * DM) + pn * 256;
        const float* g = gate + (pm < 64 ? (pm >> 5) : 2) * 9216 + pn * 256;
        const unsigned coff = (unsigned)(wc * 32 + 4 * fq), loff = (unsigned)((wr * 64 + fr) * DM) + coff;
        f32x4 gv[2][2];
#pragma unroll
        for (int bj = 0; bj < 2; ++bj)
#pragma unroll
            for (int n = 0; n < 2; ++n) gv[bj][n] = coef * *(const f32x4*)(g + (coff + (unsigned)(bj * 128 + n * 16)));
#pragma unroll
        for (int ai = 0; ai < 2; ++ai)
#pragma unroll
            for (int m = 0; m < 4; ++m) {
                float* xr = tb + (loff + (unsigned)((ai * 128 + m * 16) * DM));
#pragma unroll
                for (int bj = 0; bj < 2; ++bj)
#pragma unroll
                    for (int n = 0; n < 2; ++n) { float* xp = xr + (bj * 128 + n * 16);
                        f32x4 xv = *(const f32x4*)xp; xv += gv[bj][n] * acc[ai][bj][m][n]; *(f32x4*)xp = xv; }
                asm volatile("" ::: "memory");
            }
    }
};

__device__ __forceinline__ void phase_modgemv(const Args& a, float* red, int G, int bid, int tid) {
    const float* c = IN(1); const float* cctx = IN(3); const float* ada_w = IN(4); const float* ada_b = IN(5);
    float* mod = (float*)(karg_ws() + OFF_MOD);
    const int w = tid >> 6, lane = tid & 63;
    for (int u = bid; u < 576; u += G) {
        const int l = u / 288, rem = u % 288, jt = rem >> 3, ks = rem & 7;
        const int kb = ks * 128 + w * 16, j0 = jt * 256 + lane * 4;
        f32x4 acc0 = {0.f, 0.f, 0.f, 0.f}, acc1 = acc0, acc2 = acc0;
        for (int kk = 0; kk < 16; ++kk) { const int k = kb + kk;
            const float s0 = siluf_(c[k]), s1 = siluf_(c[1024 + k]), s2 = siluf_(cctx[k]);
            const f32x4 wv = *(const f32x4*)(ada_w + ((size_t)(l * 1024 + k)) * 9216 + j0);
            acc0 += s0 * wv; acc1 += s1 * wv; acc2 += s2 * wv; }
        float* rp = red + (w * 3) * 256 + lane * 4;
        *(f32x4*)rp = acc0; *(f32x4*)(rp + 256) = acc1; *(f32x4*)(rp + 512) = acc2;
        __syncthreads();
        for (int o = tid; o < 768; o += 512) { const int m = o >> 8, jj = o & 255; float s = 0.f;
#pragma unroll
            for (int ww = 0; ww < 8; ++ww) s += red[(ww * 3 + m) * 256 + jj];
            const int j = jt * 256 + jj; if (ks == 0) s += ada_b[l * 9216 + j];
            atomicAdd(&mod[(l * 3 + m) * 9216 + j], s); }
        __syncthreads();
    }
}
__device__ __forceinline__ void phase_copy(const Args& a, int G, int bid, int tid) {
    const f32x4* x4 = (const f32x4*)IN(0); f32x4* o4 = (f32x4*)karg_out();
    for (int i = bid * 512 + tid; i < NLAT * DM / 4; i += G * 512) o4[i] = x4[i];
    const f32x4* c4 = (const f32x4*)IN(2); f32x4* xc4 = (f32x4*)(karg_ws() + OFF_XCTX);
    for (int i = bid * 512 + tid; i < 512 * DM / 4; i += G * 512) xc4[i] = c4[i];
}
__device__ __forceinline__ int swiglu_map(int n) { return n < DFF ? ((n >> 7) * 256 + (n & 127)) : ((((n - DFF) >> 7) * 256) + 128 + ((n - DFF) & 127)); }
__device__ __forceinline__ void transpose_item(const float* W, int K, int N, bf16* WT, float* scr, int item, int lane, int mode, const float* kscale) {
    const int nblk = N / 32, kb = item / nblk, nb = item % nblk, k0 = 64 * kb, n0 = 32 * nb;
#pragma unroll 8
    for (int i = 0; i < 32; ++i) { const int kk = 2 * i + (lane >> 5); float v = W[(size_t)(k0 + kk) * N + n0 + (lane & 31)]; if (kscale) v *= kscale[k0 + kk]; scr[kk * 33 + (lane & 31)] = v; }
    __builtin_amdgcn_wave_barrier();
    const int c = lane & 7;
#pragma unroll
    for (int j = 0; j < 4; ++j) { const int n = (lane >> 3) + 8 * j; const float* s = scr + (8 * c) * 33 + n;
        v4u o; o.x = pk2(s[0 * 33], s[1 * 33]); o.y = pk2(s[2 * 33], s[3 * 33]); o.z = pk2(s[4 * 33], s[5 * 33]); o.w = pk2(s[6 * 33], s[7 * 33]);
        const int nn = n0 + n, drow = mode ? swiglu_map(nn) : nn;
        *(v4u*)(WT + (size_t)drow * K + k0 + 8 * c) = o; }
    __builtin_amdgcn_wave_barrier();
}
__device__ __forceinline__ void convert_weights(const Args& a, int l, float* scr, int gw, int NGW, int lane, int G, int bid, int tid) {
    constexpr int I13 = 16 * 176, I2 = 44 * 32, IIN = 16 * 77, IOUT = 16 * 32, IUQ = 4 * 12, IUKV = 2 * 16;
    constexpr int IEX = 80;
    constexpr int NIT = 2 * I13 + 2 * I2 + IIN + IOUT + IUQ + IUKV + IEX;
    unsigned char* ws = karg_ws();
    for (int it = gw; it < NIT; it += NGW) {
        int r = it;
        if (r < I13) { transpose_item(IN(6) + (size_t)l * DM * 2 * DFF, DM, 2 * DFF, (bf16*)(ws + W_13A), scr, r, lane, 1, nullptr); continue; } r -= I13;
        if (r < I13) { transpose_item(IN(8) + (size_t)l * DM * 2 * DFF, DM, 2 * DFF, (bf16*)(ws + W_13B), scr, r, lane, 1, nullptr); continue; } r -= I13;
        if (r < I2) { transpose_item(IN(7) + (size_t)l * DFF * DM, DFF, DM, (bf16*)(ws + W_2A), scr, r, lane, 0, nullptr); continue; } r -= I2;
        if (r < I2) { transpose_item(IN(9) + (size_t)l * DFF * DM, DFF, DM, (bf16*)(ws + W_2B), scr, r, lane, 0, nullptr); continue; } r -= I2;
        if (r < IIN) { transpose_item(IN(10) + (size_t)l * DM * 2464, DM, 2464, (bf16*)(ws + W_IN), scr, r, lane, 0, nullptr); continue; } r -= IIN;
        if (r < IOUT) { transpose_item(IN(11) + (size_t)l * DM * DM, DM, DM, (bf16*)(ws + W_OUT), scr, r, lane, 0, nullptr); continue; } r -= IOUT;
        if (r < IUQ) { transpose_item(IN(36) + (size_t)l * 256 * 384, 256, 384, (bf16*)(ws + W_UQ), scr, r, lane, 0, IN(35) + l * 256); continue; } r -= IUQ;
        if (r < IUKV) { transpose_item(IN(38) + (size_t)l * 128 * 512, 128, 512, (bf16*)(ws + W_UKV), scr, r, lane, 0, IN(37) + l * 128); continue; } r -= IUKV;
        if (r < 16) { const int d = r >> 3; transpose_item(IN(26) + (size_t)(l * 2 + d) * 64 * 256, 64, 256, (bf16*)(ws + W_WUP) + d * 256 * 64, scr, r & 7, lane, 0, nullptr); continue; } r -= 16;
        if (r < 16) { const int d = r >> 3; transpose_item(IN(28) + (size_t)(l * 2 + d) * 64 * 256, 64, 256, (bf16*)(ws + W_AUP) + d * 256 * 64, scr, r & 7, lane, 0, nullptr); continue; } r -= 16;
        if (r < 16) { transpose_item(IN(29) + (size_t)l * 128 * 256, 128, 256, (bf16*)(ws + W_GUP), scr, r, lane, 0, nullptr); continue; } r -= 16;
        if (r < 16) { const int m = r >> 1; transpose_item(IN(18) + (size_t)(l * 8 + m) * 4096, 64, 64, (bf16*)(ws + W_LWA) + m * 4096, scr, r & 1, lane, 0, nullptr); continue; } r -= 16;
        { const int m = r >> 1; transpose_item(IN(20) + (size_t)(l * 8 + m) * 4096, 64, 64, (bf16*)(ws + W_LWX) + m * 4096, scr, r & 1, lane, 0, nullptr); }
    }
    v4u z = {0u, 0u, 0u, 0u}; v4u* zp = (v4u*)(ws + W_IN + (size_t)2464 * DM * 2);
    for (int i = bid * 512 + tid; i < 96 * DM * 2 / 16; i += G * 512) zp[i] = z;
}
__device__ __forceinline__ void phase_modulate(const Args& a, int l, int which, int gw, int NGW, int lane) {
    unsigned char* ws = karg_ws(); const float* outp = karg_out();
    const float* mod = (const float*)(ws + OFF_MOD) + (size_t)l * 3 * 9216;
    bf16* XM = (bf16*)(ws + OFF_XMY);
    for (int r = gw; r < NR; r += NGW) {
        const float* xr = r < NLAT ? outp + (size_t)r * DM : (const float*)(ws + OFF_XCTX) + (size_t)(r - NLAT) * DM;
        const float* mm = mod + (r < NLAT ? (r >> 13) : 2) * 9216 + which * 3 * 1024;
        f32x4 v[4]; float ss = 0.f;
#pragma unroll
        for (int j = 0; j < 4; ++j) { v[j] = *(const f32x4*)(xr + 4 * lane + 256 * j); ss += (v[j][0] * v[j][0] + v[j][1] * v[j][1]) + (v[j][2] * v[j][2] + v[j][3] * v[j][3]); }
        const float rstd = rsqrtf(wave_sum(ss) * (1.f / DM) + 1e-6f);
#pragma unroll
        for (int j = 0; j < 4; ++j) { const int c = 4 * lane + 256 * j; const f32x4 sh = *(const f32x4*)(mm + c), sc = *(const f32x4*)(mm + 1024 + c);
            const f32x4 o = v[j] * rstd * (1.f + sc) + sh; v2u w; w.x = pk2(o[0], o[1]); w.y = pk2(o[2], o[3]);
            *(v2u*)(XM + (size_t)r * DM + c) = w; }
    }
}
__device__ __forceinline__ void phase_final(const Args& a, int gw, int NGW, int lane) {
    const float* fn = IN(39); float* outp = karg_out();
    for (int r = gw; r < NLAT; r += NGW) {
        float* xr = outp + (size_t)r * DM; f32x4 v[4]; float ss = 0.f;
#pragma unroll
        for (int j = 0; j < 4; ++j) { v[j] = *(const f32x4*)(xr + 4 * lane + 256 * j); ss += (v[j][0] * v[j][0] + v[j][1] * v[j][1]) + (v[j][2] * v[j][2] + v[j][3] * v[j][3]); }
        const float rstd = rsqrtf(wave_sum(ss) * (1.f / DM) + 1e-6f);
#pragma unroll
        for (int j = 0; j < 4; ++j) { const int c = 4 * lane + 256 * j; const f32x4 g = *(const f32x4*)(fn + c); *(f32x4*)(xr + c) = v[j] * rstd * g; }
    }
}

__device__ __forceinline__ void phase_m1(const Args& a, int l, unsigned char* lds, int G, int bid, int tid_unused) {
    unsigned char* ws = karg_ws();
    const bf16* U = (const bf16*)(ws + OFF_HU);
    bf16* Y = (bf16*)(ws + OFF_XMY);
    for (int tile = bid; tile < NTILE; tile += G) {
        const TileInfo ti = tile_info(tile);
        const int row0 = tile * 32;
        {
            const int tid = ltid(); const int lane = tid & 63, wave = __builtin_amdgcn_readfirstlane(tid >> 6), ch = tid & 255, part = tid >> 8; (void)lane; (void)wave; (void)ch; (void)part;
            float* z = (float*)lds;
            float* cv = (float*)(lds + 65536);
            for (int tt = part; tt < 62; tt += 2) { const int t = ti.t0 - 15 + tt; float zz = 0.f;
                if (t >= 0 && t < ti.seqlen) { const bf16* ur = U + (size_t)(ti.seqbase + t) * UC; zz = bf2f(ur[ch]) * sigm(bf2f(ur[256 + ch])); }
                z[tt * 256 + ch] = zz; }
            __syncthreads();
            const float* dw = IN(12) + (size_t)l * 31 * 256 + ch;
            float acc[16]; const float bias = IN(13)[l * 256 + ch];
#pragma unroll
            for (int o = 0; o < 16; ++o) acc[o] = bias;
            for (int j = 0; j < 31; ++j) { const float w = dw[j * 256];
#pragma unroll
                for (int o = 0; o < 16; ++o) acc[o] += w * z[(part * 16 + o + j) * 256 + ch]; }
#pragma unroll
            for (int o = 0; o < 16; ++o) cv[(part * 16 + o) * 256 + ch] = acc[o];
            __syncthreads();
            const f32x4 lg = *(const f32x4*)(IN(14) + l * 256 + lane * 4), lb = *(const f32x4*)(IN(15) + l * 256 + lane * 4);
#pragma unroll
            for (int q = 0; q < 4; ++q) { const int t = wave * 4 + q; const f32x4 v = *(const f32x4*)(cv + t * 256 + lane * 4);
                const float mu = wave_sum((v[0] + v[1]) + (v[2] + v[3])) * (1.f / 256.f);
                const f32x4 dv = v - mu; const float var = wave_sum((dv[0] * dv[0] + dv[1] * dv[1]) + (dv[2] * dv[2] + dv[3] * dv[3])) * (1.f / 256.f);
                const f32x4 yn = dv * rsqrtf(var + 1e-5f) * lg + lb;
                v2u w; w.x = pk2(siluf_(yn[0]), siluf_(yn[1])); w.y = pk2(siluf_(yn[2]), siluf_(yn[3]));
                *(v2u*)(Y + (size_t)(row0 + t) * DM + lane * 4) = w; }
            __syncthreads();
        }
        {
            float* xvf = (float*)lds;
            bf16* xvb = (bf16*)(lds + 32768);
            bf16* rg = (bf16*)(lds + 49664);
            bf16* ixg = (bf16*)(lds + 82432);
            {
                const int tid = ltid(); const int ch = tid & 255, part = tid >> 8;
                const float* cw = IN(16) + (size_t)l * 4 * 256 + ch; const float w0 = cw[0], w1 = cw[256], w2 = cw[512], w3 = cw[768], cb = IN(17)[l * 256 + ch];
                float xin[19];
#pragma unroll
                for (int i = 0; i < 19; ++i) { const int t = ti.t0 + part * 16 + i - 2; xin[i] = (t >= 0 && t < ti.seqlen) ? bf2f(U[(size_t)(ti.seqbase + t) * UC + 512 + ch]) : 0.f; }
                bf16* GB = (bf16*)(ws + M_GB);
#pragma unroll
                for (int o = 0; o < 16; ++o) { const int tl = part * 16 + o;
                    const float v = cb + w0 * xin[o] + w1 * xin[o + 1] + w2 * xin[o + 2] + w3 * xin[o + 3];
                    xvf[tl * 256 + ch] = v; xvb[tl * 264 + ch] = (bf16)f2bf(v);
                    GB[(size_t)(row0 + tl) * 256 + ch] = (bf16)f2bf(geluf_(bf2f(U[(size_t)(row0 + tl) * UC + 768 + ch]))); }
            }
            __syncthreads();
            {
                const int tid = ltid(); const int ln = tid & 63, wv = __builtin_amdgcn_readfirstlane(tid >> 6), fr = ln & 15, fq = ln >> 4, blk = wv >> 1;
                const bf16* LWAt = (const bf16*)(ws + W_LWA); const bf16* LWXt = (const bf16*)(ws + W_LWX);
                bf16x8 af[2][2];
#pragma unroll
                for (int mt = 0; mt < 2; ++mt)
#pragma unroll
                    for (int ks = 0; ks < 2; ++ks) af[mt][ks] = *(const bf16x8*)(xvb + (mt * 16 + fr) * 264 + blk * 64 + ks * 32 + fq * 8);
#pragma unroll 1
                for (int dn = 0; dn < 4; ++dn) { const int d = dn >> 1, nt = wv * 2 + (dn & 1), ch = nt * 16 + fr, jj = (nt & 3) * 16 + fr;
                    f32x4 ca[2], cx[2];
#pragma unroll
                    for (int mt = 0; mt < 2; ++mt) { ca[mt] = (f32x4){0.f, 0.f, 0.f, 0.f}; cx[mt] = ca[mt]; }
#pragma unroll
                    for (int ks = 0; ks < 2; ++ks) { const size_t wo = ((size_t)(d * 4 + blk) * 64 + jj) * 64 + ks * 32 + fq * 8;
                        const bf16x8 ba = *(const bf16x8*)(LWAt + wo), bx = *(const bf16x8*)(LWXt + wo);
#pragma unroll
                        for (int mt = 0; mt < 2; ++mt) { ca[mt] = __builtin_amdgcn_mfma_f32_16x16x32_bf16(af[mt][ks], ba, ca[mt], 0, 0, 0); cx[mt] = __builtin_amdgcn_mfma_f32_16x16x32_bf16(af[mt][ks], bx, cx[mt], 0, 0, 0); } }
                    const float bga = IN(19)[(l * 2 + d) * 256 + ch], bgx = IN(21)[(l * 2 + d) * 256 + ch];
                    bf16* LR = (bf16*)(ws + M_LR0 + (size_t)d * A8); bf16* LIX = (bf16*)(ws + M_LIX0 + (size_t)d * A8);
#pragma unroll
                    for (int mt = 0; mt < 2; ++mt)
#pragma unroll
                        for (int j = 0; j < 4; ++j) { const int t = mt * 16 + fq * 4 + j;
                            const bf16 rb = (bf16)f2bf(sigm(ca[mt][j] + bga)), ib = (bf16)f2bf(sigm(cx[mt][j] + bgx) * xvf[t * 256 + ch]);
                            LR[(size_t)(row0 + t) * 256 + ch] = rb; LIX[(size_t)(row0 + t) * 256 + ch] = ib;
                            rg[(d * 32 + t) * 256 + ch] = rb; ixg[(d * 32 + t) * 256 + ch] = ib; }
                }
            }
            __syncthreads();
            {
                const int tid = ltid(); const int ch = tid & 255, d = tid >> 8;
                const float lam = IN(22)[(l * 2 + d) * 256 + ch];
                const float cch = -8.f * log1pf(__expf(-lam));
                float A = 1.f, B = 0.f;
#pragma unroll 8
                for (int tt = 0; tt < 32; ++tt) { const int t = d ? 31 - tt : tt;
                    const float al = __expf(cch * bf2f(rg[(d * 32 + t) * 256 + ch])); const float bb = sqrtf(fmaxf(1.f - al * al, 0.f)) * bf2f(ixg[(d * 32 + t) * 256 + ch]); B = al * B + bb; A *= al; }
                ((float*)(ws + M_SEGA))[(size_t)(tile * 2 + d) * 256 + ch] = A;
                ((float*)(ws + M_SEGB))[(size_t)(tile * 2 + d) * 256 + ch] = B;
            }
            __syncthreads();
        }
        {
            const int tid = ltid(); const int lane = tid & 63, wave = __builtin_amdgcn_readfirstlane(tid >> 6), ch = tid & 255, part = tid >> 8; (void)lane; (void)wave; (void)ch; (void)part;
            bf16* As = (bf16*)lds;
            float* kr = (float*)(lds + 32768);
            float* rs = (float*)(lds + 32768 + 4096);
            for (int idx = tid; idx < 32 * 52; idx += 512) { const int t = idx / 52, cc = idx % 52;
                const v4u v = *(const v4u*)(U + (size_t)(row0 + t) * UC + 2048 + cc * 8);
                if (cc < 48) *(v4u*)(As + t * 392 + cc * 8) = v;
                else { const int c0 = (cc - 48) * 8; float* kp = kr + t * 32 + c0;
                    kp[0] = __uint_as_float(v.x << 16); kp[1] = __uint_as_float(v.x & 0xffff0000u); kp[2] = __uint_as_float(v.y << 16); kp[3] = __uint_as_float(v.y & 0xffff0000u);
                    kp[4] = __uint_as_float(v.z << 16); kp[5] = __uint_as_float(v.z & 0xffff0000u); kp[6] = __uint_as_float(v.w << 16); kp[7] = __uint_as_float(v.w & 0xffff0000u); } }
            __syncthreads();
#pragma unroll
            for (int q = 0; q < 4; ++q) { const int t = wave * 4 + q; float sq = 0.f, sk = 0.f;
#pragma unroll
                for (int j = 0; j < 4; ++j) { const float v = bf2f(As[t * 392 + lane + 64 * j]); sq += v * v; }
#pragma unroll
                for (int j = 0; j < 2; ++j) { const float v = bf2f(As[t * 392 + 256 + lane + 64 * j]); sk += v * v; }
                sq = wave_sum(sq); sk = wave_sum(sk);
                if (lane == 0) { rs[t * 2] = rsqrtf(sq * (1.f / 256.f) + 1e-6f); rs[t * 2 + 1] = rsqrtf(sk * (1.f / 128.f) + 1e-6f); } }
            __syncthreads();
            const int fr = lane & 15, fq = lane >> 4;
            bf16* QB = (bf16*)(ws + M_QB); bf16* KB = (bf16*)(ws + M_KB); bf16* VT = (bf16*)(ws + M_VT);
            const bf16* WUQ = (const bf16*)(ws + W_UQ); const bf16* WUKV = (const bf16*)(ws + W_UKV);
            const int keybase = ti.isctx ? TLEN : 0;
#pragma unroll 1
            for (int i = 0; i < 3; ++i) { const int nt = wave * 3 + i;
                f32x4 c0 = {0.f, 0.f, 0.f, 0.f}, c1 = c0;
#pragma unroll
                for (int ks = 0; ks < 8; ++ks) { const bf16x8 bfr = *(const bf16x8*)(WUQ + (size_t)(nt * 16 + fr) * 256 + ks * 32 + fq * 8);
                    const bf16x8 a0 = *(const bf16x8*)(As + fr * 392 + ks * 32 + fq * 8), a1 = *(const bf16x8*)(As + (16 + fr) * 392 + ks * 32 + fq * 8);
                    c0 = __builtin_amdgcn_mfma_f32_16x16x32_bf16(a0, bfr, c0, 0, 0, 0); c1 = __builtin_amdgcn_mfma_f32_16x16x32_bf16(a1, bfr, c1, 0, 0, 0); }
                const int hq = nt / 6, wt = nt % 6, dd = wt * 16 + fr;
#pragma unroll
                for (int mt = 0; mt < 2; ++mt)
#pragma unroll
                    for (int j = 0; j < 4; ++j) { const int tl = mt * 16 + fq * 4 + j; const int t = ti.t0 + tl;
                        float v = (mt ? c1[j] : c0[j]) * rs[tl * 2];
                        const float pv = __shfl_xor(v, 8);
                        if (wt >= 4 && !ti.isctx) { const int f = fr & 7; const float pos = (wt == 4) ? (float)(t >> 6) : (float)(t & 63);
                            const float ang = pos * __expf(-(float)f * (9.210340371976184f / 8.f)); float sn, cs; __sincosf(ang, &sn, &cs);
                            v = (fr & 8) ? (v * cs + pv * sn) : (v * cs - pv * sn); }
                        QB[((size_t)(ti.b * 4 + hq) * TT + keybase + t) * 96 + dd] = (bf16)f2bf(v * QSCALE); } }
#pragma unroll 1
            for (int i = 0; i < 4; ++i) { const int nt = wave * 4 + i;
                f32x4 c0 = {0.f, 0.f, 0.f, 0.f}, c1 = c0;
#pragma unroll
                for (int ks = 0; ks < 4; ++ks) { const bf16x8 bfr = *(const bf16x8*)(WUKV + (size_t)(nt * 16 + fr) * 128 + ks * 32 + fq * 8);
                    const bf16x8 a0 = *(const bf16x8*)(As + fr * 392 + 256 + ks * 32 + fq * 8), a1 = *(const bf16x8*)(As + (16 + fr) * 392 + 256 + ks * 32 + fq * 8);
                    c0 = __builtin_amdgcn_mfma_f32_16x16x32_bf16(a0, bfr, c0, 0, 0, 0); c1 = __builtin_amdgcn_mfma_f32_16x16x32_bf16(a1, bfr, c1, 0, 0, 0); }
                const int hk = nt >> 3, wt = nt & 7;
#pragma unroll
                for (int mt = 0; mt < 2; ++mt)
#pragma unroll
                    for (int j = 0; j < 4; ++j) { const int tl = mt * 16 + fq * 4 + j; const int key = keybase + ti.t0 + tl;
                        const float v = (mt ? c1[j] : c0[j]) * rs[tl * 2 + 1];
                        if (wt < 4) KB[((size_t)(ti.b * 4 + hk) * TT + key) * 96 + wt * 16 + fr] = (bf16)f2bf(v);
                        else VT[((size_t)(ti.b * 4 + hk) * 64 + (wt - 4) * 16 + fr) * TT + key] = (bf16)f2bf(v); } }
            { const int tl = tid >> 4, p = tid & 15, ax = p >> 3, f = p & 7; const int t = ti.t0 + tl;
                float x0 = kr[tl * 32 + ax * 16 + f], x1 = kr[tl * 32 + ax * 16 + 8 + f];
                if (!ti.isctx) { const float pos = ax == 0 ? (float)(t >> 6) : (float)(t & 63); const float ang = pos * __expf(-(float)f * (9.210340371976184f / 8.f));
                    float sn, cs; __sincosf(ang, &sn, &cs); const float y0 = x0 * cs - x1 * sn, y1 = x1 * cs + x0 * sn; x0 = y0; x1 = y1; }
                const bf16 b0 = (bf16)f2bf(x0), b1 = (bf16)f2bf(x1);
#pragma unroll
                for (int h = 0; h < 4; ++h) { bf16* kp = KB + ((size_t)(ti.b * 4 + h) * TT + keybase + t) * 96 + 64 + ax * 16 + f; kp[0] = b0; kp[8] = b1; } }
            __syncthreads();
        }
    }
}

__device__ __forceinline__ void attn_unit(unsigned char* lds, const bf16* QB, const bf16* KB, const bf16* VT, bf16* Y, int b, int h, int q0, int key_lo, int nkt, int tid) {
    const int lane = tid & 63, wave = tid >> 6, fr = lane & 15, fq = lane >> 4;
    const int bh = b * 4 + h;
    constexpr int KSTR = 104, VSTR = 72, KBUF = 64 * KSTR, VBUF = 64 * VSTR;
    bf16* Ks = (bf16*)lds;
    bf16* Vs = (bf16*)lds + 2 * KBUF;
    const int qw = q0 + wave * 32;
    bf16x8 qf[2][3];
#pragma unroll
    for (int qt = 0; qt < 2; ++qt)
#pragma unroll
        for (int ks = 0; ks < 3; ++ks) qf[qt][ks] = *(const bf16x8*)(QB + ((size_t)bh * TT + qw + qt * 16 + fr) * 96 + ks * 32 + fq * 8);
    float mrun[2] = {-1e30f, -1e30f}, lrun[2] = {0.f, 0.f};
    f32x4 o[4][2];
#pragma unroll
    for (int dt = 0; dt < 4; ++dt)
#pragma unroll
        for (int qt = 0; qt < 2; ++qt) o[dt][qt] = (f32x4){0.f, 0.f, 0.f, 0.f};
    const v4u* kg = (const v4u*)(KB + ((size_t)bh * TT + key_lo) * 96);
    const bf16* vg = VT + ((size_t)bh * 64 + (tid >> 3)) * TT + key_lo + (tid & 7) * 8;
    const int kc0 = tid, kc1 = 512 + tid;
    const int ko0 = (kc0 / 12) * KSTR + (kc0 % 12) * 8, ko1 = (kc1 / 12) * KSTR + (kc1 % 12) * 8, vo = (tid >> 3) * VSTR + (tid & 7) * 8;
    v4u rk0, rk1 = {0u, 0u, 0u, 0u}, rv;
    rk0 = kg[kc0]; if (tid < 256) rk1 = kg[kc1]; rv = *(const v4u*)vg;
    *(v4u*)(Ks + ko0) = rk0; if (tid < 256) *(v4u*)(Ks + ko1) = rk1; *(v4u*)(Vs + vo) = rv;
    __syncthreads();
    for (int kt = 0; kt < nkt; ++kt) {
        const int cur = kt & 1;
        if (kt + 1 < nkt) { const v4u* kn = kg + (size_t)(kt + 1) * 768; rk0 = kn[kc0]; if (tid < 256) rk1 = kn[kc1]; rv = *(const v4u*)(vg + (kt + 1) * 64); }
        const bf16* kb = Ks + cur * KBUF; const bf16* vb = Vs + cur * VBUF;
        f32x4 st[4][2];
#pragma unroll
        for (int k4 = 0; k4 < 4; ++k4) {
            st[k4][0] = (f32x4){0.f, 0.f, 0.f, 0.f}; st[k4][1] = st[k4][0];
#pragma unroll
            for (int ks = 0; ks < 3; ++ks) { const bf16x8 kf = *(const bf16x8*)(kb + (k4 * 16 + fr) * KSTR + ks * 32 + fq * 8);
                st[k4][0] = __builtin_amdgcn_mfma_f32_16x16x32_bf16(kf, qf[0][ks], st[k4][0], 0, 0, 0);
                st[k4][1] = __builtin_amdgcn_mfma_f32_16x16x32_bf16(kf, qf[1][ks], st[k4][1], 0, 0, 0); }
        }
        bf16x8 pb[2][2];
#pragma unroll
        for (int qt = 0; qt < 2; ++qt) {
            float mx = st[0][qt][0];
#pragma unroll
            for (int k4 = 0; k4 < 4; ++k4)
#pragma unroll
                for (int j = 0; j < 4; ++j) mx = fmaxf(mx, st[k4][qt][j]);
            mx = fmaxf(mx, __shfl_xor(mx, 16)); mx = fmaxf(mx, __shfl_xor(mx, 32));
            const float mn = fmaxf(mrun[qt], mx), alpha = exp2f(mrun[qt] - mn); mrun[qt] = mn;
            float ls = 0.f;
#pragma unroll
            for (int k4 = 0; k4 < 4; ++k4)
#pragma unroll
                for (int j = 0; j < 4; ++j) { const float p = exp2f(st[k4][qt][j] - mn); st[k4][qt][j] = p; ls += p; }
            lrun[qt] = lrun[qt] * alpha + ls;
#pragma unroll
            for (int dt = 0; dt < 4; ++dt) o[dt][qt] *= alpha;
#pragma unroll
            for (int u = 0; u < 2; ++u) { v4u w;
                w.x = pg8::cvt_pk_bf16(st[2 * u][qt][0], st[2 * u][qt][1]); w.y = pg8::cvt_pk_bf16(st[2 * u][qt][2], st[2 * u][qt][3]);
                w.z = pg8::cvt_pk_bf16(st[2 * u + 1][qt][0], st[2 * u + 1][qt][1]); w.w = pg8::cvt_pk_bf16(st[2 * u + 1][qt][2], st[2 * u + 1][qt][3]);
                pb[u][qt] = __builtin_bit_cast(bf16x8, w); }
        }
#pragma unroll
        for (int dt = 0; dt < 4; ++dt)
#pragma unroll
            for (int u = 0; u < 2; ++u) {
                const v2u lo = *(const v2u*)(vb + (dt * 16 + fr) * VSTR + 32 * u + 4 * fq), hi = *(const v2u*)(vb + (dt * 16 + fr) * VSTR + 32 * u + 16 + 4 * fq);
                v4u vw; vw.x = lo.x; vw.y = lo.y; vw.z = hi.x; vw.w = hi.y;
                const bf16x8 va = __builtin_bit_cast(bf16x8, vw);
                o[dt][0] = __builtin_amdgcn_mfma_f32_16x16x32_bf16(va, pb[u][0], o[dt][0], 0, 0, 0);
                o[dt][1] = __builtin_amdgcn_mfma_f32_16x16x32_bf16(va, pb[u][1], o[dt][1], 0, 0, 0);
            }
        if (kt + 1 < nkt) { const int nb = cur ^ 1; *(v4u*)(Ks + nb * KBUF + ko0) = rk0; if (tid < 256) *(v4u*)(Ks + nb * KBUF + ko1) = rk1; *(v4u*)(Vs + nb * VBUF + vo) = rv; }
        __syncthreads();
    }
#pragma unroll
    for (int qt = 0; qt < 2; ++qt) {
        float lt = lrun[qt]; lt += __shfl_xor(lt, 16); lt += __shfl_xor(lt, 32);
        const float inv = 1.f / lt;
        const int q = qw + qt * 16 + fr;
        const size_t row = q < TLEN ? (size_t)b * TLEN + q : (size_t)NLAT + b * CTXL + (q - TLEN);
#pragma unroll
        for (int dt = 0; dt < 4; ++dt) { const f32x4 v = o[dt][qt] * inv; v2u w; w.x = pk2(v[0], v[1]); w.y = pk2(v[2], v[3]);
            *(v2u*)(Y + row * DM + 768 + h * 64 + dt * 16 + fq * 4) = w; }
    }
}
__device__ __forceinline__ void lru_tile(const Args& a, int l, unsigned char* lds, int tile, int tid) {
    unsigned char* ws = karg_ws();
    const int ch = tid & 255, d = tid >> 8;
    const TileInfo ti = tile_info(tile);
    const int row0 = tile * 32;
    const float* SA = (const float*)(ws + M_SEGA); const float* SB = (const float*)(ws + M_SEGB);
    float hst = 0.f;
    const int ctile0 = 512 + ti.b * 8, ltile0 = ti.b * 256;
    if (d == 0) {
        const int nc = ti.isctx ? (tile - ctile0) : 8;
        for (int j = 0; j < nc; ++j) { const size_t o = (size_t)((ctile0 + j) * 2) * 256 + ch; hst = SA[o] * hst + SB[o]; }
        if (!ti.isctx) for (int j = ltile0; j < tile; ++j) { const size_t o = (size_t)(j * 2) * 256 + ch; hst = SA[o] * hst + SB[o]; }
    } else {
        const int lo = ti.isctx ? (tile - ctile0 + 1) : 0;
        for (int j = 7; j >= lo; --j) { const size_t o = (size_t)((ctile0 + j) * 2 + 1) * 256 + ch; hst = SA[o] * hst + SB[o]; }
        if (!ti.isctx) for (int j = ltile0 + 255; j > tile; --j) { const size_t o = (size_t)(j * 2 + 1) * 256 + ch; hst = SA[o] * hst + SB[o]; }
    }
    const float lam = IN(22)[(l * 2 + d) * 256 + ch];
    const float cch = -8.f * log1pf(__expf(-lam));
    const bf16* LR = (const bf16*)(ws + M_LR0 + (size_t)d * A8); const bf16* LIX = (const bf16*)(ws + M_LIX0 + (size_t)d * A8);
    float* hs = (float*)lds;
    for (int tt = 0; tt < 32; ++tt) { const int t = d ? 31 - tt : tt; const size_t o = (size_t)(row0 + t) * 256 + ch;
        const float al = __expf(cch * bf2f(LR[o])); const float bb = sqrtf(fmaxf(1.f - al * al, 0.f)) * bf2f(LIX[o]);
        hst = al * hst + bb; hs[(d * 32 + t) * 256 + ch] = hst; }
    __syncthreads();
    const bf16* GB = (const bf16*)(ws + M_GB); bf16* Y = (bf16*)(ws + OFF_XMY);
    for (int tt = 0; tt < 16; ++tt) { const int t = d * 16 + tt;
        const float y = (hs[t * 256 + ch] + hs[(32 + t) * 256 + ch]) * bf2f(GB[(size_t)(row0 + t) * 256 + ch]);
        Y[(size_t)(row0 + t) * DM + 256 + ch] = (bf16)f2bf(y); }
    __syncthreads();
}
__device__ __forceinline__ void phase_m2(const Args& a, int l, unsigned char* lds, int G, int bid, int tid) {
    unsigned char* ws = karg_ws();
    const bf16* QB = (const bf16*)(ws + M_QB); const bf16* KB = (const bf16*)(ws + M_KB); const bf16* VT = (const bf16*)(ws + M_VT);
    bf16* Y = (bf16*)(ws + OFF_XMY);
    const int nunits = (l == 0) ? 264 : 256;
    for (int u = bid; u < nunits; u += G) {
        if (u < 256) attn_unit(lds, QB, KB, VT, Y, u >> 7, (u >> 5) & 3, (u & 31) * 256, 0, 132, tid);
        else attn_unit(lds, QB, KB, VT, Y, (u - 256) >> 2, (u - 256) & 3, TLEN, TLEN, 4, tid);
    }
    for (int tile = bid; tile < NTILE; tile += G) lru_tile(a, l, lds, tile, tid);
}

__device__ __forceinline__ void phase_m3(const Args& a, int l, unsigned char* lds, int G, int bid, int tid) {
    unsigned char* ws = karg_ws();
    const bf16* U = (const bf16*)(ws + OFF_HU);
    const int lane = tid & 63, ch = tid & 255, part = tid >> 8;
    const float* mup = IN(23) + l * 1024; const float* mun = IN(24) + l * 1024;
    bf16* RR = (bf16*)(ws + M_RR); bf16* KKo = (bf16*)(ws + M_KK); bf16* VV = (bf16*)(ws + M_VV); bf16* GC = (bf16*)(ws + M_GC);
    float* kl = (float*)lds;
    float* kkn = (float*)(lds + 32768);
    bf16* twb = (bf16*)(lds + 65536);
    bf16* tab = (bf16*)(lds + 70144);
    bf16* tgb = (bf16*)(lds + 74752);
    for (int tile = bid; tile < NTILE; tile += G) {
        const TileInfo ti = tile_info(tile);
        const int row0 = tile * 32;
        {
            const int tid2 = ltid(); const int chunk = tid2 & 127, tg8 = tid2 >> 7, c0 = chunk * 8;
            const bf16* ub = U + (size_t)row0 * UC + 1024 + c0;
            v4u rw[10];
#pragma unroll
            for (int q = 0; q < 10; ++q) { const int tl = tg8 * 8 + q - 1; const int t = ti.t0 + tl;
                rw[q] = (t >= 0 && t < ti.seqlen) ? *(const v4u*)(ub + (ptrdiff_t)tl * UC) : (v4u){0u, 0u, 0u, 0u}; }
            const f32x4 mp0 = *(const f32x4*)(mup + c0), mp1 = *(const f32x4*)(mup + c0 + 4), mn0 = *(const f32x4*)(mun + c0), mn1 = *(const f32x4*)(mun + c0 + 4);
            const float mp[8] = {mp0[0], mp0[1], mp0[2], mp0[3], mp1[0], mp1[1], mp1[2], mp1[3]}, mn[8] = {mn0[0], mn0[1], mn0[2], mn0[3], mn1[0], mn1[1], mn1[2], mn1[3]};
#pragma unroll
            for (int q = 0; q < 8; ++q) { const int tl = tg8 * 8 + q; float ts[8];
#pragma unroll
                for (int e = 0; e < 8; ++e) { const unsigned wm = rw[q][e >> 1], w0 = rw[q + 1][e >> 1], wn = rw[q + 2][e >> 1];
                    const float um = (e & 1) ? __uint_as_float(wm & 0xffff0000u) : __uint_as_float(wm << 16);
                    const float u0 = (e & 1) ? __uint_as_float(w0 & 0xffff0000u) : __uint_as_float(w0 << 16);
                    const float un = (e & 1) ? __uint_as_float(wn & 0xffff0000u) : __uint_as_float(wn << 16);
                    ts[e] = u0 + mp[e] * (um - u0) + mn[e] * (un - u0); }
                if (chunk >= 32 && chunk < 64) { float* kp = kl + tl * 256 + (c0 - 256); *(f32x4*)kp = (f32x4){ts[0], ts[1], ts[2], ts[3]}; *(f32x4*)(kp + 4) = (f32x4){ts[4], ts[5], ts[6], ts[7]}; }
                else {
                    if (chunk >= 96 && chunk < 104) {
#pragma unroll
                        for (int e = 0; e < 8; ++e) ts[e] = tanhf_(ts[e]); }
                    if (chunk >= 112) {
#pragma unroll
                        for (int e = 0; e < 8; ++e) ts[e] = sigm(ts[e]); }
                    v4u o; o.x = pk2(ts[0], ts[1]); o.y = pk2(ts[2], ts[3]); o.z = pk2(ts[4], ts[5]); o.w = pk2(ts[6], ts[7]);
                    if (chunk < 32) *(v4u*)(RR + (size_t)(row0 + tl) * 256 + c0) = o;
                    else if (chunk < 96) *(v4u*)(VV + (size_t)(row0 + tl) * 256 + (c0 - 512)) = o;
                    else if (chunk < 104) *(v4u*)(twb + tl * 72 + (c0 - 768)) = o;
                    else if (chunk < 112) *(v4u*)(tab + tl * 72 + (c0 - 832)) = o;
                    else *(v4u*)(tgb + tl * 136 + (c0 - 896)) = o; }
            }
        }
        __syncthreads();
        {
            const int tid2 = ltid(); const int ch = tid2 & 255, pt = tid2 >> 8; const float kkc = IN(30)[l * 256 + ch];
#pragma unroll 4
            for (int q = 0; q < 16; ++q) { const int t = pt * 16 + q; const float kr = kl[t * 256 + ch] * kkc; const float nrm = wave_sum(kr * kr);
                const float kk = kr * rsqrtf(fmaxf(nrm, 1e-24f)); kkn[t * 256 + ch] = kk; KKo[(size_t)(row0 + t) * 256 + ch] = (bf16)f2bf(kk); }
        }
        __syncthreads();
        {
            const int tid2 = ltid(); const int ln = tid2 & 63, wv = __builtin_amdgcn_readfirstlane(tid2 >> 6), fr = ln & 15, fq = ln >> 4;
            const bf16* WUPt = (const bf16*)(ws + W_WUP); const bf16* AUPt = (const bf16*)(ws + W_AUP); const bf16* GUPt = (const bf16*)(ws + W_GUP);
            bf16x8 aw[2][2], aa[2][2];
#pragma unroll
            for (int mt = 0; mt < 2; ++mt)
#pragma unroll
                for (int ks = 0; ks < 2; ++ks) { aw[mt][ks] = *(const bf16x8*)(twb + (mt * 16 + fr) * 72 + ks * 32 + fq * 8); aa[mt][ks] = *(const bf16x8*)(tab + (mt * 16 + fr) * 72 + ks * 32 + fq * 8); }
#pragma unroll 1
            for (int dn = 0; dn < 4; ++dn) { const int d = dn >> 1, nt = wv * 2 + (dn & 1), ch = nt * 16 + fr;
                f32x4 cw[2], ca[2];
#pragma unroll
                for (int mt = 0; mt < 2; ++mt) { cw[mt] = (f32x4){0.f, 0.f, 0.f, 0.f}; ca[mt] = cw[mt]; }
#pragma unroll
                for (int ks = 0; ks < 2; ++ks) { const bf16x8 bw = *(const bf16x8*)(WUPt + ((size_t)d * 256 + ch) * 64 + ks * 32 + fq * 8), ba = *(const bf16x8*)(AUPt + ((size_t)d * 256 + ch) * 64 + ks * 32 + fq * 8);
#pragma unroll
                    for (int mt = 0; mt < 2; ++mt) { cw[mt] = __builtin_amdgcn_mfma_f32_16x16x32_bf16(aw[mt][ks], bw, cw[mt], 0, 0, 0); ca[mt] = __builtin_amdgcn_mfma_f32_16x16x32_bf16(aa[mt][ks], ba, ca[mt], 0, 0, 0); } }
                const float w0 = IN(25)[(l * 2 + d) * 256 + ch], a0 = IN(27)[(l * 2 + d) * 256 + ch], kac = IN(31)[l * 256 + ch];
                float* WW = (float*)(ws + M_WW) + (size_t)d * NR * 256; bf16* BB = (bf16*)(ws + M_BB + (size_t)d * A8); bf16* KD = (bf16*)(ws + M_KD + (size_t)d * A8);
#pragma unroll
                for (int mt = 0; mt < 2; ++mt)
#pragma unroll
                    for (int j = 0; j < 4; ++j) { const int t = mt * 16 + fq * 4 + j; const size_t o = (size_t)(row0 + t) * 256 + ch;
                        const float e = sigm(w0 + cw[mt][j]) * 0.6065306597126334f;
                        const float av = sigm(a0 + ca[mt][j]);
                        WW[o] = __expf(-e);
                        KD[o] = (bf16)f2bf(kl[t * 256 + ch] * (1.f + (av - 1.f) * kac));
                        BB[o] = (bf16)f2bf(kkn[t * 256 + ch] * av); }
            }
#pragma unroll 1
            for (int nl = 0; nl < 2; ++nl) { const int ch = (wv * 2 + nl) * 16 + fr;
                f32x4 cg[2] = {(f32x4){0.f, 0.f, 0.f, 0.f}, (f32x4){0.f, 0.f, 0.f, 0.f}};
#pragma unroll
                for (int ks = 0; ks < 4; ++ks) { const bf16x8 bg = *(const bf16x8*)(GUPt + (size_t)ch * 128 + ks * 32 + fq * 8);
#pragma unroll
                    for (int mt = 0; mt < 2; ++mt) { const bf16x8 ag = *(const bf16x8*)(tgb + (mt * 16 + fr) * 136 + ks * 32 + fq * 8); cg[mt] = __builtin_amdgcn_mfma_f32_16x16x32_bf16(ag, bg, cg[mt], 0, 0, 0); } }
#pragma unroll
                for (int mt = 0; mt < 2; ++mt)
#pragma unroll
                    for (int j = 0; j < 4; ++j) GC[(size_t)(row0 + mt * 16 + fq * 4 + j) * 256 + ch] = (bf16)f2bf(cg[mt][j]);
            }
        }
        __syncthreads();
    }
}

typedef const unsigned cu32;
typedef const float cf32;
__device__ __forceinline__ int chain_row(int b, int d, int tau) {
    return tau < CTXL ? (NLAT + b * CTXL + (d ? CTXL - 1 - tau : tau)) : (b * TLEN + (d ? TLEN - 1 - (tau - CTXL) : (tau - CTXL)));
}
template <int MODE>
__device__ __forceinline__ void rwkv_steps(float (&S)[64], int b, int h, int d, int tau0, int n, unsigned char* ws, int lane, float* wl) {
    const bf16* KKp = (const bf16*)(ws + M_KK); const bf16* RRp = (const bf16*)(ws + M_RR); const bf16* VVp = (const bf16*)(ws + M_VV);
    const float* WWp = (const float*)(ws + M_WW) + (size_t)d * NR * 256; const bf16* BBp = (const bf16*)(ws + M_BB + (size_t)d * A8); const bf16* KDp = (const bf16*)(ws + M_KD + (size_t)d * A8);
    float* YS = (float*)(ws + M_YS) + (size_t)d * NR * 256;
    float pk, pw, pb, pkd = 0.f, pr = 0.f, pv = 0.f; size_t poff;
#define RWKV_LOAD(s_) do { poff = (size_t)chain_row(b, d, tau0 + (s_)) * 256 + h * 64 + lane; pk = bf2f(KKp[poff]); pw = WWp[poff]; pb = bf2f(BBp[poff]); \
        if (MODE != 1) { pkd = bf2f(KDp[poff]); pv = bf2f(VVp[poff]); } if (MODE == 2) pr = bf2f(RRp[poff]); } while (0)
    RWKV_LOAD(0);
    for (int s = 0; s < n; ++s) {
        float* buf = wl + (s & 1) * 320;
        buf[lane] = pk; buf[64 + lane] = pw; buf[128 + lane] = pb;
        if (MODE != 1) buf[192 + lane] = pkd;
        if (MODE == 2) buf[256 + lane] = pr;
        const float vv = pv; const size_t yoff = poff;
        if (s + 1 < n) RWKV_LOAD(s + 1);
        float sa0 = 0.f, sa1 = 0.f, sa2 = 0.f, sa3 = 0.f;
#pragma unroll
        for (int i = 0; i < 64; i += 4) { const f32x4 k4 = *(const f32x4*)(buf + i);
            sa0 += S[i] * k4[0]; sa1 += S[i + 1] * k4[1]; sa2 += S[i + 2] * k4[2]; sa3 += S[i + 3] * k4[3]; }
        const float nsa = -((sa0 + sa1) + (sa2 + sa3));
        float y0 = 0.f, y1 = 0.f, y2 = 0.f, y3 = 0.f;
#pragma unroll
        for (int i = 0; i < 64; i += 4) { const f32x4 w4 = *(const f32x4*)(buf + 64 + i), b4 = *(const f32x4*)(buf + 128 + i);
            f32x4 t = nsa * b4;
            if (MODE != 1) { const f32x4 kd4 = *(const f32x4*)(buf + 192 + i); t += vv * kd4; }
            S[i] = S[i] * w4[0] + t[0]; S[i + 1] = S[i + 1] * w4[1] + t[1]; S[i + 2] = S[i + 2] * w4[2] + t[2]; S[i + 3] = S[i + 3] * w4[3] + t[3];
            if (MODE == 2) { const f32x4 r4 = *(const f32x4*)(buf + 256 + i); y0 += S[i] * r4[0]; y1 += S[i + 1] * r4[1]; y2 += S[i + 2] * r4[2]; y3 += S[i + 3] * r4[3]; } }
        if (MODE == 2) YS[yoff] = (y0 + y1) + (y2 + y3);
    }
#undef RWKV_LOAD
}
typedef float f32x2 __attribute__((ext_vector_type(2)));
__device__ __forceinline__ void rwkv_pass1(f32x2 (&SL)[32], f32x2 (&SI)[32], int b, int h, int d, int tau0, int n, unsigned char* ws, int lane, float* wl) {
    const bf16* KKp = (const bf16*)(ws + M_KK); const bf16* VVp = (const bf16*)(ws + M_VV); const bf16* RRp = (const bf16*)(ws + M_RR);
    const float* WWp = (const float*)(ws + M_WW) + (size_t)d * NR * 256; const bf16* BBp = (const bf16*)(ws + M_BB + (size_t)d * A8); const bf16* KDp = (const bf16*)(ws + M_KD + (size_t)d * A8);
    float* YS = (float*)(ws + M_YS) + (size_t)d * NR * 256; float* PR = (float*)(ws + M_PR) + (size_t)d * NR * 256;
    float pk, pw, pb, pkd, pv, pr; size_t poff;
#define RWKV_LOAD(s_) do { poff = (size_t)chain_row(b, d, tau0 + (s_)) * 256 + h * 64 + lane; pk = bf2f(KKp[poff]); pw = WWp[poff]; pb = bf2f(BBp[poff]); pkd = bf2f(KDp[poff]); pv = bf2f(VVp[poff]); pr = bf2f(RRp[poff]); } while (0)
    RWKV_LOAD(0);
    for (int s = 0; s < n; ++s) {
        float* buf = wl + (s & 1) * 320;
        buf[lane] = pk; buf[64 + lane] = pw; buf[128 + lane] = pb; buf[192 + lane] = pkd; buf[256 + lane] = pr;
        const float vv = pv; const size_t yoff = poff;
        if (s + 1 < n) RWKV_LOAD(s + 1);
        f32x2 aL0 = {0.f, 0.f}, aL1 = aL0, aI0 = aL0, aI1 = aL0;
#pragma unroll
        for (int q = 0; q < 16; ++q) { const f32x4 k4 = *(const f32x4*)(buf + 4 * q);
            aL0 += SL[2 * q] * k4.lo; aL1 += SL[2 * q + 1] * k4.hi; aI0 += SI[2 * q] * k4.lo; aI1 += SI[2 * q + 1] * k4.hi; }
        const f32x2 tL = aL0 + aL1, tI = aI0 + aI1;
        const float nsl = -(tL.x + tL.y), nsi = -(tI.x + tI.y);
        f32x2 yL0 = {0.f, 0.f}, yL1 = yL0, yI0 = yL0, yI1 = yL0;
#pragma unroll
        for (int q = 0; q < 16; ++q) {
            const f32x4 w4 = *(const f32x4*)(buf + 64 + 4 * q), b4 = *(const f32x4*)(buf + 128 + 4 * q), kd4 = *(const f32x4*)(buf + 192 + 4 * q), r4 = *(const f32x4*)(buf + 256 + 4 * q);
            const f32x4 tl = nsl * b4 + vv * kd4, tiv = nsi * b4;
            SL[2 * q] = SL[2 * q] * w4.lo + tl.lo; SL[2 * q + 1] = SL[2 * q + 1] * w4.hi + tl.hi;
            SI[2 * q] = SI[2 * q] * w4.lo + tiv.lo; SI[2 * q + 1] = SI[2 * q + 1] * w4.hi + tiv.hi;
            yL0 += SL[2 * q] * r4.lo; yL1 += SL[2 * q + 1] * r4.hi; yI0 += SI[2 * q] * r4.lo; yI1 += SI[2 * q + 1] * r4.hi; }
        const f32x2 yl = yL0 + yL1, yp = yI0 + yI1;
        YS[yoff] = yl.x + yl.y; PR[yoff] = yp.x + yp.y;
    }
#undef RWKV_LOAD
}
__device__ __forceinline__ void phase_m4(const Args& a, unsigned char* lds, int G, int bid, int tid) {
    const int lane = tid & 63, wave = __builtin_amdgcn_readfirstlane(tid >> 6);
    unsigned char* ws = karg_ws(); float* PL = (float*)(ws + M_PL);
    if (wave >= 4) return;
    for (int task = bid * 4 + wave; task < 16 * NSEG; task += G * 4) {
        const int seg = task & (NSEG - 1), chain = task >> 6;
        const int d = chain & 1, h = (chain >> 1) & 3, b = chain >> 3;
        f32x2 SL[32], SI[32]; int ln = lane; asm volatile("" : "+v"(ln));
#pragma unroll
        for (int i = 0; i < 32; ++i) { SL[i] = (f32x2){0.f, 0.f}; SI[i] = (f32x2){(2 * i == ln) ? 1.f : 0.f, (2 * i + 1 == ln) ? 1.f : 0.f}; }
        rwkv_pass1(SL, SI, b, h, d, seg * SEGLEN, SEGLEN, ws, lane, (float*)lds + wave * 640);
        float* o = PL + (((size_t)(chain * NSEG + seg) * 2) * 64 + lane) * 64;
#pragma unroll
        for (int i = 0; i < 32; i += 2) { *(f32x4*)(o + 2 * i) = (f32x4){SL[i].x, SL[i].y, SL[i + 1].x, SL[i + 1].y}; *(f32x4*)(o + 4096 + 2 * i) = (f32x4){SI[i].x, SI[i].y, SI[i + 1].x, SI[i + 1].y}; }
    }
}
__device__ __forceinline__ void phase_m5(const Args& a, unsigned char* lds, int G, int bid, int tid) {
    unsigned char* ws = karg_ws(); const float* PL = (const float*)(ws + M_PL); float* SI = (float*)(ws + M_SINIT);
    float* Sl = (float*)lds;
    float* Pl = (float*)(lds + 8192);
    typedef float f32x2v __attribute__((ext_vector_type(2)));
    const int rl = tid >> 5, c2 = (tid & 31) * 2;
    for (int u = bid; u < 64; u += G) {
        const int chain = u >> 2, row = (u & 3) * 16 + rl;
        f32x2v cur = {0.f, 0.f};
        const float* Pg = PL + ((size_t)(chain * NSEG) * 2 + 1) * 4096; const float* Lg = PL + ((size_t)(chain * NSEG) * 2) * 4096;
        f32x4 pa[4], pb[4]; f32x2v lv[4];
#pragma unroll
        for (int q = 0; q < 4; ++q) { const float* Pn = Pg + (size_t)q * 8192; const float* Ln = Lg + (size_t)q * 8192;
            pa[q] = *(const f32x4*)(Pn + tid * 8); pb[q] = *(const f32x4*)(Pn + tid * 8 + 4); lv[q] = *(const f32x2v*)(Ln + row * 64 + c2); }
        for (int g0 = 0; g0 < NSEG; g0 += 4) {
#pragma unroll
            for (int q = 0; q < 4; ++q) { const int g = g0 + q;
                *(f32x2v*)(SI + ((size_t)(chain * NSEG + g) * 64 + row) * 64 + c2) = cur;
                if (g < NSEG - 1) {
                    *(f32x2v*)(Sl + rl * 66 + c2) = cur;
                    *(f32x4*)(Pl + tid * 8) = pa[q]; *(f32x4*)(Pl + tid * 8 + 4) = pb[q];
                    f32x2v nw = lv[q];
                    if (g + 4 < NSEG - 1) { const float* Pn = Pg + (size_t)(g + 4) * 8192; const float* Ln = Lg + (size_t)(g + 4) * 8192;
                        pa[q] = *(const f32x4*)(Pn + tid * 8); pb[q] = *(const f32x4*)(Pn + tid * 8 + 4); lv[q] = *(const f32x2v*)(Ln + row * 64 + c2); }
                    __syncthreads();
#pragma unroll 16
                    for (int i = 0; i < 64; ++i) { const float sv = Sl[rl * 66 + i]; const f32x2v pv = *(const f32x2v*)(Pl + i * 64 + c2); nw += sv * pv; }
                    cur = nw;
                    __syncthreads();
                }
            }
        }
    }
}
__device__ __forceinline__ void phase_m6(const Args& a, unsigned char* lds, int G, int bid, int tid) {
    const int lane = tid & 63, wave = __builtin_amdgcn_readfirstlane(tid >> 6);
    unsigned char* ws = karg_ws(); const float* SI = (const float*)(ws + M_SINIT);
    float* wl = (float*)lds + wave * 256;
    for (int task = bid * 8 + wave; task < 16 * (NSEG - 1); task += G * 8) {
        const int seg = 1 + task % (NSEG - 1), chain = task / (NSEG - 1);
        const int d = chain & 1, h = (chain >> 1) & 3, b = chain >> 3;
        float* YS = (float*)(ws + M_YS) + (size_t)d * NR * 256; const float* PR = (const float*)(ws + M_PR) + (size_t)d * NR * 256;
        f32x2 S0[32];
        const float* si = SI + ((size_t)(chain * NSEG + seg) * 64 + lane) * 64;
#pragma unroll
        for (int i = 0; i < 32; i += 2) { const f32x4 v = *(const f32x4*)(si + 2 * i); S0[i] = v.lo; S0[i + 1] = v.hi; }
        const int tau0 = seg * SEGLEN;
        size_t o0 = (size_t)chain_row(b, d, tau0) * 256 + h * 64 + lane, o1 = (size_t)chain_row(b, d, tau0 + 1) * 256 + h * 64 + lane;
        float p0 = PR[o0], p1 = PR[o1], y0 = YS[o0], y1 = YS[o1];
        for (int s = 0; s < SEGLEN; s += 2) {
            wl[lane] = p0; wl[64 + lane] = p1;
            const size_t c0 = o0, c1 = o1; const float yy0 = y0, yy1 = y1;
            if (s + 2 < SEGLEN) { o0 = (size_t)chain_row(b, d, tau0 + s + 2) * 256 + h * 64 + lane; o1 = (size_t)chain_row(b, d, tau0 + s + 3) * 256 + h * 64 + lane; p0 = PR[o0]; p1 = PR[o1]; y0 = YS[o0]; y1 = YS[o1]; }
            f32x2 a0 = {0.f, 0.f}, a1 = a0, b0 = a0, b1 = a0;
#pragma unroll
            for (int q = 0; q < 16; ++q) { const f32x4 u = *(const f32x4*)(wl + 4 * q), w = *(const f32x4*)(wl + 64 + 4 * q);
                a0 += S0[2 * q] * u.lo; a1 += S0[2 * q + 1] * u.hi; b0 += S0[2 * q] * w.lo; b1 += S0[2 * q + 1] * w.hi; }
            const f32x2 ta = a0 + a1, tb = b0 + b1;
            YS[c0] = yy0 + (ta.x + ta.y); YS[c1] = yy1 + (tb.x + tb.y);
            asm volatile("" ::: "memory");
        }
    }
}
__device__ __forceinline__ void phase_m7(const Args& a, int l, int gw, int NGW, int lane) {
    unsigned char* ws = karg_ws();
    const float* Y0 = (const float*)(ws + M_YS); const float* Y1 = Y0 + (size_t)NR * 256;
    const bf16* RR = (const bf16*)(ws + M_RR); const bf16* VV = (const bf16*)(ws + M_VV); const bf16* KD0 = (const bf16*)(ws + M_KD); const bf16* KD1 = (const bf16*)(ws + M_KD + A8);
    const bf16* GC = (const bf16*)(ws + M_GC); bf16* Y = (bf16*)(ws + OFF_XMY);
    for (int r = gw; r < NR; r += NGW) {
#pragma unroll
        for (int h = 0; h < 4; ++h) { const int c = h * 64 + lane; const size_t o = (size_t)r * 256 + c;
            const float ys = Y0[o] + Y1[o];
            const float mu = wave_sum(ys) * (1.f / 64.f); const float dv = ys - mu; const float var = wave_sum(dv * dv) * (1.f / 64.f);
            float ov = dv * rsqrtf(var + 64e-5f) * IN(33)[l * 256 + c] + IN(34)[l * 256 + c];
            const float rv = bf2f(RR[o]), rk = IN(32)[l * 256 + c], vv = bf2f(VV[o]);
            const float b0 = wave_sum(rv * bf2f(KD0[o]) * rk), b1 = wave_sum(rv * bf2f(KD1[o]) * rk);
            ov += (b0 + b1) * vv;
            Y[(size_t)r * DM + 512 + c] = (bf16)f2bf(ov * bf2f(GC[o])); }
    }
}

__global__ void __launch_bounds__(512, 2) mega(Args a) {
    extern __shared__ __attribute__((aligned(16))) unsigned char lds[];
    cg::grid_group grid = cg::this_grid();
    const int G = gridDim.x;
    PG8_LAS unsigned char* glds = (PG8_LAS unsigned char*)lds;
#define bid lbid()
#define tid ltid()
#define lane (ltid() & 63)
#define wave (__builtin_amdgcn_readfirstlane(ltid() >> 6))
#define gw (lbid() * 8 + __builtin_amdgcn_readfirstlane(ltid() >> 6))
#define NGW (G * 8)
#define GSYNC() do { grid.sync(); } while (0)

    phase_modgemv(a, (float*)lds, G, bid, tid);
    phase_copy(a, G, bid, tid);
    convert_weights(a, 0, (float*)(lds + 32768) + wave * (64 * 33), gw, NGW, lane, G, bid, tid);
    GSYNC();
#pragma clang loop unroll(full)
    for (int l = 0; l < 2; ++l) {
        if (l > 0) convert_weights(a, l, (float*)lds + wave * (64 * 33), gw, NGW, lane, G, bid, tid);
        phase_modulate(a, l, 0, gw, NGW, lane);
        GSYNC();
        for (int rp = 0; rp < REP_G1; ++rp)
        {
            unsigned char* ws = karg_ws(); float* outp = karg_out(); float* xctx = (float*)(ws + OFF_XCTX); bf16* XM = (bf16*)(ws + OFF_XMY); bf16* HU = (bf16*)(ws + OFF_HU); const float* modl = (const float*)(ws + OFF_MOD) + (size_t)l * 3 * 9216; (void)xctx; (void)XM; (void)HU; (void)modl; (void)outp;
            pg8::Gemm g{XM, (const bf16*)(ws + W_13A), NR, 2 * DFF, DM}; pg8::StaticOrder S; S.init(NR, 2 * DFF, G, bid);
            EpiSwiglu E{HU};
            pg8::gemm_phase<EpiSwiglu, pg8::StaticOrder, true, true>(glds, g, S, E);
        }
        GSYNC();
        {
            unsigned char* ws = karg_ws(); float* outp = karg_out(); float* xctx = (float*)(ws + OFF_XCTX); bf16* XM = (bf16*)(ws + OFF_XMY); bf16* HU = (bf16*)(ws + OFF_HU); const float* modl = (const float*)(ws + OFF_MOD) + (size_t)l * 3 * 9216; (void)xctx; (void)XM; (void)HU; (void)modl; (void)outp;
            pg8::Gemm g{HU, (const bf16*)(ws + W_2A), NR, DM, DFF}; pg8::StaticOrder S; S.init(NR, DM, G, bid);
            EpiResid E{outp, xctx, modl + 2 * 1024, 0.5f};
            pg8::gemm_phase<EpiResid, pg8::StaticOrder, true, true>(glds, g, S, E);
        }
        GSYNC();
        phase_modulate(a, l, 1, gw, NGW, lane);
        GSYNC();
        {
            unsigned char* ws = karg_ws(); float* outp = karg_out(); float* xctx = (float*)(ws + OFF_XCTX); bf16* XM = (bf16*)(ws + OFF_XMY); bf16* HU = (bf16*)(ws + OFF_HU); const float* modl = (const float*)(ws + OFF_MOD) + (size_t)l * 3 * 9216; (void)xctx; (void)XM; (void)HU; (void)modl; (void)outp;
            pg8::Gemm g{XM, (const bf16*)(ws + W_IN), NR, UC, DM}; pg8::StaticOrder S; S.init(NR, UC, G, bid);
            EpiU E{HU, UC};
            pg8::gemm_phase<EpiU, pg8::StaticOrder, true, true>(glds, g, S, E);
        }
        GSYNC();
        for (int rp = 0; rp < REP_M1; ++rp) { phase_m1(a, l, lds, G, bid, tid);
        GSYNC(); }
        for (int rp = 0; rp < REP_M2; ++rp) { phase_m2(a, l, lds, G, bid, tid);
        GSYNC(); }
        for (int rp = 0; rp < REP_M3; ++rp) { phase_m3(a, l, lds, G, bid, tid);
        GSYNC(); }
        for (int rp = 0; rp < REP_SCAN; ++rp) { phase_m4(a, lds, G, bid, tid);
        GSYNC();
        phase_m5(a, lds, G, bid, tid);
        GSYNC();
        phase_m6(a, lds, G, bid, tid);
        GSYNC(); }
        phase_m7(a, l, gw, NGW, lane);
        GSYNC();
        {
            unsigned char* ws = karg_ws(); float* outp = karg_out(); float* xctx = (float*)(ws + OFF_XCTX); bf16* XM = (bf16*)(ws + OFF_XMY); bf16* HU = (bf16*)(ws + OFF_HU); const float* modl = (const float*)(ws + OFF_MOD) + (size_t)l * 3 * 9216; (void)xctx; (void)XM; (void)HU; (void)modl; (void)outp;
            pg8::Gemm g{XM, (const bf16*)(ws + W_OUT), NR, DM, DM}; pg8::StaticOrder S; S.init(NR, DM, G, bid);
            EpiResid E{outp, xctx, modl + 5 * 1024, 1.0f};
            pg8::gemm_phase<EpiResid, pg8::StaticOrder, true, true>(glds, g, S, E);
        }
        GSYNC();
        phase_modulate(a, l, 2, gw, NGW, lane);
        GSYNC();
        {
            unsigned char* ws = karg_ws(); float* outp = karg_out(); float* xctx = (float*)(ws + OFF_XCTX); bf16* XM = (bf16*)(ws + OFF_XMY); bf16* HU = (bf16*)(ws + OFF_HU); const float* modl = (const float*)(ws + OFF_MOD) + (size_t)l * 3 * 9216; (void)xctx; (void)XM; (void)HU; (void)modl; (void)outp;
            pg8::Gemm g{XM, (const bf16*)(ws + W_13B), NR, 2 * DFF, DM}; pg8::StaticOrder S; S.init(NR, 2 * DFF, G, bid);
            EpiSwiglu E{HU};
            pg8::gemm_phase<EpiSwiglu, pg8::StaticOrder, true, true>(glds, g, S, E);
        }
        GSYNC();
        {
            unsigned char* ws = karg_ws(); float* outp = karg_out(); float* xctx = (float*)(ws + OFF_XCTX); bf16* XM = (bf16*)(ws + OFF_XMY); bf16* HU = (bf16*)(ws + OFF_HU); const float* modl = (const float*)(ws + OFF_MOD) + (size_t)l * 3 * 9216; (void)xctx; (void)XM; (void)HU; (void)modl; (void)outp;
            pg8::Gemm g{HU, (const bf16*)(ws + W_2B), NR, DM, DFF}; pg8::StaticOrder S; S.init(NR, DM, G, bid);
            EpiResid E{outp, xctx, modl + 8 * 1024, 0.5f};
            pg8::gemm_phase<EpiResid, pg8::StaticOrder, true, true>(glds, g, S, E);
        }
        GSYNC();
    }
    phase_final(a, gw, NGW, lane);
#undef bid
#undef tid
#undef lane
#undef wave
#undef gw
#undef NGW
}

extern "C" void kernel_launch(void* const* d_in, const int* in_sizes, int n_in, void* d_out, int out_size, void* d_ws, size_t ws_size, hipStream_t stream) {
    static int grid = 0;
    if (grid == 0) {
        int dev = 0, cus = 0, per_cu = 0;
        (void)hipGetDevice(&dev);
        (void)hipDeviceGetAttribute(&cus, hipDeviceAttributeMultiprocessorCount, dev);
        (void)hipFuncSetAttribute((const void*)mega, hipFuncAttributeMaxDynamicSharedMemorySize, LDS_BYTES);
        (void)hipOccupancyMaxActiveBlocksPerMultiprocessor(&per_cu, (const void*)mega, 512, LDS_BYTES);
        if (per_cu < 1) per_cu = 1;
        grid = cus * per_cu;
        if (n_in != 40 || ws_size < WS_NEED) { fprintf(stderr, "kernel_launch: unexpected n_in %d / ws %zu (need %zu)\n", n_in, ws_size, (size_t)WS_NEED); }
    }
    (void)hipMemsetAsync((char*)d_ws + OFF_MOD, 0, MOD_BYTES, stream);
    Args a{};
    for (int i = 0; i < 40; ++i) a.in[i] = (const float*)d_in[i];
    a.out = (float*)d_out; a.ws = (unsigned char*)d_ws;
    void* args[] = {&a};
    hipError_t e = hipLaunchCooperativeKernel((const void*)mega, dim3(grid), dim3(512), args, LDS_BYTES, stream);
    if (e != hipSuccess) fprintf(stderr, "cooperative launch failed: %s (grid %d)\n", hipGetErrorString(e), grid);
}
```

```cpp
#include <hip/hip_runtime.h>
#include <hip/hip_cooperative_groups.h>
#include <cstdio>
#include <cstdint>
namespace cg = cooperative_groups;
namespace pg8 {
#define PG8_LAS __attribute__((address_space(3)))
typedef unsigned short bf16_t;
typedef short bf16x8 __attribute__((ext_vector_type(8)));
typedef float f32x4 __attribute__((ext_vector_type(4)));
typedef unsigned u32x4 __attribute__((ext_vector_type(4)));
constexpr int BM = 256, BK = 64, HALF = 128, HTB = HALF * BK * 2  , STAGE_BYTES = 8 * HTB, NXCD = 8, WGM = 8;

__host__ __device__ __forceinline__ int lds_byte(int r, int c) { const int st = (r >> 4) * 2 + (c >> 5), rr = r & 15, cc = c & 31, ob = rr * 64 + cc * 2; return st * 1024 + (ob ^ (((ob >> 9) & 1) << 5)); }
__host__ __device__ __forceinline__ void stage_rc(int b, int& R, int& C) { const int st = b / 1024, sb = b % 1024, swz = sb ^ (((sb >> 9) & 1) << 5); R = (st >> 1) * 16 + swz / 64; C = (st & 1) * 32 + (swz % 64) / 2; }
__host__ __device__ __forceinline__ int perm32(int rho) { const int n = rho >> 4, i = rho & 15; return 8 * (i >> 2) + 4 * n + (i & 3); }

struct Unit { int pm, pn; };
struct Gemm { const bf16_t* A; const bf16_t* Bt; int M, N, K; };

struct StaticOrder {
    int nM, nN, nwg, G, c;
    __host__ __device__ void init(int M, int N, int G_, int c_) { nM = M / BM; nN = N / BM; nwg = nM * nN; G = G_; c = c_; }
    __host__ __device__ bool next(int i, Unit& u) const {
        const long L = (long)i * G + c; if (L >= nwg) return false;
        int wgid = (int)L; { const int q = nwg / NXCD, r = nwg % NXCD, xcd = wgid % NXCD, off = wgid / NXCD; wgid = (xcd < r ? xcd * (q + 1) : r * (q + 1) + (xcd - r) * q) + off; }
        const int nig = WGM * nN, gid = wgid / nig, fm = gid * WGM, gsz = (nM - fm) < WGM ? (nM - fm) : WGM;
        u.pm = fm + ((wgid % nig) % gsz); u.pn = (wgid % nig) / gsz; return true;
    }
    __device__ __forceinline__ void a_ready(const Unit&) const {}
    __device__ __forceinline__ void done(const Unit&) const {}
};

__device__ __forceinline__ unsigned cvt_pk_bf16(float lo, float hi) { unsigned r; asm volatile("v_cvt_pk_bf16_f32 %0, %1, %2" : "=v"(r) : "v"(lo), "v"(hi)); return r; }
typedef float f32x2 __attribute__((ext_vector_type(2)));
template <class Epi, class Sched, bool ALIGN_EPI = false, bool SP2 = false>
__device__ __forceinline__ void gemm_phase(PG8_LAS unsigned char* lds, const Gemm g, const Sched& S, const Epi& E) {
    int tid = threadIdx.x; asm volatile("" : "+v"(tid));
    const int wid = __builtin_amdgcn_readfirstlane(tid >> 6), lane = tid & 63, wr = wid >> 2, wc = wid & 3, fr = lane & 15, fq = lane >> 4;
    const int K = g.K, nt = K / BK;
    unsigned voffA[2], voffB[2];
#pragma unroll
    for (int i = 0; i < 2; ++i) { int R, C; stage_rc(tid * 16 + i * 8192, R, C); const int Rb = Epi::PERM ? ((R & ~31) + perm32(R & 31)) : R;
        voffA[i] = (unsigned)(R * K + C) * 2u; voffB[i] = (unsigned)(Rb * K + C) * 2u; }
    const size_t kstep = (size_t)(BK * 2);
    const size_t hstep = (size_t)HALF * K * 2;
    const size_t tstep = 2 * hstep;
    const unsigned ldsw = (unsigned)wid * 1024u;
    const int aoff = lds_byte(wr * 64 + fr, fq * 8), boff = lds_byte(wc * 32 + fr, fq * 8);
#define PG8_SA(b, h) (((b) * 2 + (h)) * HTB)
#define PG8_SB(b, h) ((4 + (b) * 2 + (h)) * HTB)
#define PG8_STAGE(bufoff, gbase, voff) do { _Pragma("unroll") for (int _i = 0; _i < 2; ++_i) \
        __builtin_amdgcn_global_load_lds((const unsigned*)((const char*)(gbase) + (voff)[_i]), (PG8_LAS unsigned*)(lds + (bufoff) + ldsw + _i * 8192), 16, 0, 0); } while (0)
#define PG8_LDA(dst, b, h) do { _Pragma("unroll") for (int m = 0; m < 4; ++m) _Pragma("unroll") for (int k = 0; k < 2; ++k) dst[m][k] = *(const PG8_LAS bf16x8*)(lds + PG8_SA(b, h) + aoff + m * 2048 + k * 1024); } while (0)
#define PG8_LDB(dst, b, h) do { _Pragma("unroll") for (int n = 0; n < 2; ++n) _Pragma("unroll") for (int k = 0; k < 2; ++k) dst[n][k] = *(const PG8_LAS bf16x8*)(lds + PG8_SB(b, h) + boff + n * 2048 + k * 1024); } while (0)
#define PG8_MMA(ai, bj, At, Bt) do { __builtin_amdgcn_s_setprio(1); _Pragma("unroll") for (int m = 0; m < 4; ++m) _Pragma("unroll") for (int n = 0; n < 2; ++n) _Pragma("unroll") for (int k = 0; k < 2; ++k) \
        acc[ai][bj][m][n] = __builtin_amdgcn_mfma_f32_16x16x32_bf16(Bt[n][k], At[m][k], acc[ai][bj][m][n], 0, 0, 0); __builtin_amdgcn_s_setprio(0); } while (0)
#define PG8_WAIT_V(n) asm volatile("s_waitcnt vmcnt(" #n ")" ::: "memory")
#define PG8_WAIT_L(n) asm volatile("s_waitcnt lgkmcnt(" #n ")" ::: "memory")
#define PG8_BAR __builtin_amdgcn_s_barrier()
#define PG8_SCHED __builtin_amdgcn_sched_barrier(0)
    Unit cur, nxt; int ui = 0;
    if (!S.next(0, cur)) return;
    f32x4 acc[2][2][4][2];
#pragma unroll
    for (int a = 0; a < 2; ++a)
#pragma unroll
        for (int b = 0; b < 2; ++b)
#pragma unroll
            for (int m = 0; m < 4; ++m)
#pragma unroll
                for (int n = 0; n < 2; ++n) acc[a][b][m][n] = (f32x4){0.f, 0.f, 0.f, 0.f};
    bf16x8 At[4][2], B0[2][2], B1[2][2];
    const char* cA = (const char*)g.A + (size_t)cur.pm * tstep; const char* cB = (const char*)g.Bt + (size_t)cur.pn * tstep;
    S.a_ready(cur);
    if constexpr (SP2) {
        PG8_STAGE(PG8_SB(0, 0), cB, voffB); PG8_STAGE(PG8_SB(0, 1), cB + hstep, voffB); PG8_STAGE(PG8_SA(0, 0), cA, voffA); PG8_STAGE(PG8_SA(0, 1), cA + hstep, voffA);
        if (wr == 1) PG8_BAR;
        PG8_WAIT_V(2); PG8_BAR;
        PG8_STAGE(PG8_SB(1, 0), cB + kstep, voffB); PG8_STAGE(PG8_SA(1, 0), cA + kstep, voffA); PG8_STAGE(PG8_SB(1, 1), cB + hstep + kstep, voffB);
        PG8_WAIT_V(6); PG8_BAR;
    } else {
        PG8_STAGE(PG8_SB(0, 0), cB, voffB); PG8_STAGE(PG8_SA(0, 0), cA, voffA); PG8_STAGE(PG8_SB(0, 1), cB + hstep, voffB); PG8_STAGE(PG8_SA(0, 1), cA + hstep, voffA);
        if (wr == 1) PG8_BAR;
        PG8_WAIT_V(4); PG8_BAR;
        PG8_STAGE(PG8_SB(1, 0), cB + kstep, voffB); PG8_STAGE(PG8_SA(1, 0), cA + kstep, voffA); PG8_STAGE(PG8_SB(1, 1), cB + hstep + kstep, voffB);
        PG8_WAIT_V(6); PG8_BAR;
    }
    for (;;) {
        const bool has_next = S.next(ui + 1, nxt);
        const char* nA = has_next ? (const char*)g.A + (size_t)nxt.pm * tstep : cA; const char* nB = has_next ? (const char*)g.Bt + (size_t)nxt.pn * tstep : cB;
        for (int t = 0; t < nt; t += 2) {
            const bool last = (t == nt - 2);
            const char* a1 = cA + (size_t)(t + 1) * kstep;
            const char* a2 = last ? nA : cA + (size_t)(t + 2) * kstep; const char* b2 = last ? nB : cB + (size_t)(t + 2) * kstep;
            const char* a3 = a2 + kstep; const char* b3 = b2 + kstep;
            if (last && has_next) S.a_ready(nxt);
            if constexpr (SP2) {
            PG8_LDB(B0, 0, 0); PG8_LDB(B1, 0, 1); PG8_SCHED; PG8_LDA(At, 0, 0); PG8_STAGE(PG8_SA(1, 1), a1 + hstep, voffA);
            PG8_WAIT_V(8); PG8_WAIT_L(0); PG8_BAR; PG8_MMA(0, 0, At, B0); PG8_MMA(0, 1, At, B1); PG8_BAR; PG8_SCHED;
            PG8_LDA(At, 0, 1); PG8_STAGE(PG8_SB(0, 0), b2, voffB); PG8_STAGE(PG8_SB(0, 1), b2 + hstep, voffB); PG8_STAGE(PG8_SA(0, 0), a2, voffA);
            PG8_WAIT_V(8); PG8_WAIT_L(0); PG8_BAR; PG8_MMA(1, 0, At, B0); PG8_MMA(1, 1, At, B1); PG8_BAR; PG8_SCHED;
            PG8_LDB(B0, 1, 0); PG8_LDB(B1, 1, 1); PG8_SCHED; PG8_LDA(At, 1, 0); PG8_STAGE(PG8_SA(0, 1), a2 + hstep, voffA);
            PG8_WAIT_V(8); PG8_WAIT_L(0); PG8_BAR; PG8_MMA(0, 0, At, B0); PG8_MMA(0, 1, At, B1); PG8_BAR; PG8_SCHED;
            PG8_LDA(At, 1, 1); PG8_STAGE(PG8_SB(1, 0), b3, voffB); PG8_STAGE(PG8_SB(1, 1), b3 + hstep, voffB); PG8_STAGE(PG8_SA(1, 0), a3, voffA);
            PG8_WAIT_V(8); PG8_WAIT_L(0); PG8_BAR; PG8_MMA(1, 0, At, B0); PG8_MMA(1, 1, At, B1); PG8_BAR; PG8_SCHED;
            } else {
            PG8_LDB(B0, 0, 0); PG8_SCHED; PG8_LDA(At, 0, 0); PG8_STAGE(PG8_SA(1, 1), a1 + hstep, voffA);
            PG8_WAIT_L(8); PG8_BAR; PG8_WAIT_L(0); PG8_MMA(0, 0, At, B0); PG8_BAR; PG8_SCHED;
            PG8_LDB(B1, 0, 1); PG8_STAGE(PG8_SB(0, 0), b2, voffB);
            PG8_BAR; PG8_WAIT_L(0); PG8_MMA(0, 1, At, B1); PG8_BAR;
            PG8_LDA(At, 0, 1); PG8_STAGE(PG8_SA(0, 0), a2, voffA);
            PG8_BAR; PG8_WAIT_L(0); PG8_MMA(1, 0, At, B0); PG8_BAR; PG8_SCHED;
            PG8_STAGE(PG8_SB(0, 1), b2 + hstep, voffB);
            PG8_WAIT_V(6); PG8_BAR; PG8_MMA(1, 1, At, B1); PG8_BAR;
            PG8_LDB(B0, 1, 0); PG8_SCHED; PG8_LDA(At, 1, 0); PG8_STAGE(PG8_SA(0, 1), a2 + hstep, voffA);
            PG8_WAIT_L(8); PG8_BAR; PG8_WAIT_L(0); PG8_MMA(0, 0, At, B0); PG8_BAR; PG8_SCHED;
            PG8_LDB(B1, 1, 1); PG8_STAGE(PG8_SB(1, 0), b3, voffB);
            PG8_BAR; PG8_WAIT_L(0); PG8_MMA(0, 1, At, B1); PG8_BAR;
            PG8_LDA(At, 1, 1); PG8_STAGE(PG8_SA(1, 0), a3, voffA);
            PG8_BAR; PG8_WAIT_L(0); PG8_MMA(1, 0, At, B0); PG8_BAR; PG8_SCHED;
            PG8_STAGE(PG8_SB(1, 1), b3 + hstep, voffB);
            PG8_WAIT_V(6); PG8_BAR; PG8_MMA(1, 1, At, B1); PG8_BAR;
            }
        }
        if constexpr (ALIGN_EPI) { if (wr == 0) PG8_BAR; }
        if constexpr (!Epi::AFTER_DRAIN) { E(acc, cur, wr, wc, fr, fq); S.done(cur); }
        if (!has_next) break;
#pragma unroll
        for (int a = 0; a < 2; ++a)
#pragma unroll
            for (int b = 0; b < 2; ++b)
#pragma unroll
                for (int m = 0; m < 4; ++m)
#pragma unroll
                    for (int n = 0; n < 2; ++n) acc[a][b][m][n] = (f32x4){0.f, 0.f, 0.f, 0.f};
        cur = nxt; cA = nA; cB = nB; ++ui;
        if constexpr (ALIGN_EPI) { if (wr == 1) PG8_BAR; }
    }
    PG8_WAIT_V(0);
    if constexpr (!ALIGN_EPI) { if (wr == 0) PG8_BAR; }
    PG8_BAR;
    if constexpr (Epi::AFTER_DRAIN) { E.fused(acc, cur, wr, wc, fr, fq, lds, wid, lane); S.done(cur); }
#undef PG8_SA
#undef PG8_SB
#undef PG8_STAGE
#undef PG8_LDA
#undef PG8_LDB
#undef PG8_MMA
#undef PG8_WAIT_V
#undef PG8_WAIT_L
#undef PG8_BAR
#undef PG8_SCHED
}
}

using pg8::f32x4; using pg8::bf16x8;
typedef unsigned short bf16;
typedef unsigned v4u __attribute__((ext_vector_type(4)));
typedef unsigned v2u __attribute__((ext_vector_type(2)));
typedef short s16x4 __attribute__((ext_vector_type(4)));

constexpr int DM = 1024, TLEN = 8192, CTXL = 256, TT = 8448, NLAT = 16384, NR = 16896, DFF = 2816, UC = 2560, NTILE = 528;
constexpr int NSEG = 64, SEGLEN = 132;
constexpr size_t MiB = 1u << 20;
constexpr size_t A8 = (size_t)NR * 256 * 2;
constexpr size_t OFF_MOD = 0, MOD_BYTES = 256 * 1024;
constexpr size_t OFF_XCTX = MiB / 4, OFF_XMY = 2 * MiB + MiB / 4, OFF_HU = 35 * MiB + MiB / 4, OFF_W = 126 * MiB, OFF_MIX = 167 * MiB, OFF_PR = 266 * MiB;
constexpr size_t W_13A = OFF_W, W_2A = OFF_W + 11 * MiB, W_13B = OFF_W + 16 * MiB + MiB / 2, W_2B = OFF_W + 27 * MiB + MiB / 2,
                 W_IN = OFF_W + 33 * MiB, W_OUT = OFF_W + 38 * MiB, W_UQ = OFF_W + 40 * MiB, W_UKV = OFF_W + 40 * MiB + 256 * 1024,
                 W_WUP = OFF_W + 40 * MiB + 384 * 1024, W_AUP = W_WUP + 65536, W_GUP = W_AUP + 65536, W_LWA = W_GUP + 65536, W_LWX = W_LWA + 65536;
constexpr size_t M_QB = OFF_MIX, M_KB = OFF_MIX + 12976128, M_VT = OFF_MIX + 25952256;
constexpr size_t M_LR0 = OFF_MIX + 4 * A8, M_LIX0 = OFF_MIX + 6 * A8, M_GB = OFF_MIX + 8 * A8, M_SEGA = OFF_MIX + 9 * A8, M_SEGB = M_SEGA + 2 * MiB;
constexpr size_t M_RR = OFF_MIX, M_KK = OFF_MIX + A8, M_VV = OFF_MIX + 2 * A8, M_WW = OFF_MIX + 3 * A8, M_BB = OFF_MIX + 7 * A8, M_KD = OFF_MIX + 9 * A8, M_GC = OFF_MIX + 11 * A8;
constexpr size_t M_YS = OFF_HU, M_PL = OFF_HU + 33 * MiB, M_SINIT = OFF_HU + 65 * MiB;
constexpr size_t M_PR = OFF_PR;
constexpr size_t WS_NEED = OFF_PR + 33 * MiB;
constexpr int LDS_BYTES = 131072 + 1024;
#ifndef REP_M1
#define REP_M1 1
#endif
#ifndef REP_M2
#define REP_M2 1
#endif
#ifndef REP_M3
#define REP_M3 1
#endif
#ifndef REP_SCAN
#define REP_SCAN 1
#endif
#ifndef REP_G1
#define REP_G1 1
#endif
constexpr float QSCALE = 0.10206207261596575f * 1.4426950408889634f;

struct Args { const float* in[40]; float* out; unsigned char* ws; };
typedef const __attribute__((address_space(4))) volatile unsigned long long kargq;
__device__ __forceinline__ const float* karg_in(int i) { kargq* p = (kargq*)__builtin_amdgcn_kernarg_segment_ptr(); return (const float*)p[i]; }
__device__ __forceinline__ float* karg_out() { kargq* p = (kargq*)__builtin_amdgcn_kernarg_segment_ptr(); return (float*)p[40]; }
__device__ __forceinline__ unsigned char* karg_ws() { kargq* p = (kargq*)__builtin_amdgcn_kernarg_segment_ptr(); return (unsigned char*)p[41]; }
#define IN(i) karg_in(i)
__device__ __forceinline__ int ltid() { int t = threadIdx.x; asm volatile("" : "+v"(t)); return t; }
__device__ __forceinline__ int lbid() { int t = blockIdx.x; asm volatile("" : "+s"(t)); return t; }
template <class T> __device__ __forceinline__ T* launder(T* p) { asm volatile("" : "+s"(p)); return p; }

__device__ __forceinline__ float bf2f(bf16 h) { return __uint_as_float((unsigned)h << 16); }
__device__ __forceinline__ unsigned f2bf(float f) { unsigned u = __float_as_uint(f); return (u + 0x7fffu + ((u >> 16) & 1u)) >> 16; }
__device__ __forceinline__ unsigned pk2(float lo, float hi) { return f2bf(lo) | (f2bf(hi) << 16); }
__device__ __forceinline__ float sigm(float x) { return 1.f / (1.f + __expf(-x)); }
__device__ __forceinline__ float siluf_(float x) { return x / (1.f + __expf(-x)); }
__device__ __forceinline__ float tanhf_(float y) { return 1.f - 2.f / (1.f + __expf(2.f * y)); }
__device__ __forceinline__ float geluf_(float x) { return 0.5f * x * (1.f + tanhf_(0.7978845608028654f * (x + 0.044715f * x * x * x))); }
__device__ __forceinline__ float wave_sum(float v) {
#pragma unroll
    for (int o = 1; o < 64; o <<= 1) v += __shfl_xor(v, o);
    return v;
}
struct TileInfo { int b, isctx, t0, seqbase, seqlen; };
__device__ __forceinline__ TileInfo tile_info(int tile) {
    TileInfo ti;
    if (tile < 512) { ti.b = tile >> 8; ti.isctx = 0; ti.t0 = (tile & 255) * 32; ti.seqbase = ti.b * TLEN; ti.seqlen = TLEN; }
    else { const int q = tile - 512; ti.b = q >> 3; ti.isctx = 1; ti.t0 = (q & 7) * 32; ti.seqbase = NLAT + ti.b * CTXL; ti.seqlen = CTXL; }
    return ti;
}

struct EpiSwiglu {
    static constexpr bool PERM = true, AFTER_DRAIN = false;
    bf16* H;
    __device__ __forceinline__ void operator()(const f32x4 (&acc)[2][2][4][2], const pg8::Unit& u, int wr, int wc, int fr, int fq) const {
        int pm = u.pm, pn = u.pn; asm volatile("" : "+s"(pm), "+s"(pn), "+s"(wr), "+s"(wc), "+v"(fr), "+v"(fq));
        bf16* tb = H + (size_t)pm * 256 * DFF + pn * 128;
        const unsigned loff = (unsigned)((wr * 64 + fr) * DFF + wc * 32 + 8 * fq);
#pragma unroll
        for (int ai = 0; ai < 2; ++ai)
#pragma unroll
            for (int m = 0; m < 4; ++m) {
                bf16* rowp = tb + (loff + (unsigned)((ai * 128 + m * 16) * DFF));
                const f32x4 g0 = acc[ai][0][m][0], g1 = acc[ai][0][m][1], u0 = acc[ai][1][m][0], u1 = acc[ai][1][m][1];
                v4u w;
                w.x = pg8::cvt_pk_bf16(siluf_(g0[0]) * u0[0], siluf_(g0[1]) * u0[1]); w.y = pg8::cvt_pk_bf16(siluf_(g0[2]) * u0[2], siluf_(g0[3]) * u0[3]);
                w.z = pg8::cvt_pk_bf16(siluf_(g1[0]) * u1[0], siluf_(g1[1]) * u1[1]); w.w = pg8::cvt_pk_bf16(siluf_(g1[2]) * u1[2], siluf_(g1[3]) * u1[3]);
                *(v4u*)rowp = w;
            }
    }
};
struct EpiU {
    static constexpr bool PERM = true, AFTER_DRAIN = false;
    bf16* O; int ldc;
    __device__ __forceinline__ void operator()(const f32x4 (&acc)[2][2][4][2], const pg8::Unit& u, int wr, int wc, int fr, int fq) const {
        int pm = u.pm, pn = u.pn; asm volatile("" : "+s"(pm), "+s"(pn), "+s"(wr), "+s"(wc), "+v"(fr), "+v"(fq));
        bf16* tb = O + (size_t)pm * 256 * ldc + pn * 256;
        const unsigned loff = (unsigned)((wr * 64 + fr) * ldc + wc * 32 + 8 * fq);
#pragma unroll
        for (int ai = 0; ai < 2; ++ai)
#pragma unroll
            for (int m = 0; m < 4; ++m) {
                bf16* rowp = tb + (loff + (unsigned)((ai * 128 + m * 16) * ldc));
#pragma unroll
                for (int bj = 0; bj < 2; ++bj) { const f32x4 v0 = acc[ai][bj][m][0], v1 = acc[ai][bj][m][1]; v4u w;
                    w.x = pg8::cvt_pk_bf16(v0[0], v0[1]); w.y = pg8::cvt_pk_bf16(v0[2], v0[3]); w.z = pg8::cvt_pk_bf16(v1[0], v1[1]); w.w = pg8::cvt_pk_bf16(v1[2], v1[3]);
                    *(v4u*)(rowp + bj * 128) = w; }
            }
    }
};
struct EpiResid {
    static constexpr bool PERM = false, AFTER_DRAIN = false;
    float* xlat; float* xctx; const float* gate; float coef;
    __device__ __forceinline__ void operator()(const f32x4 (&acc)[2][2][4][2], const pg8::Unit& u, int wr, int wc, int fr, int fq) const {
        int pm = u.pm, pn = u.pn; asm volatile("" : "+s"(pm), "+s"(pn), "+s"(wr), "+s"(wc), "+v"(fr), "+v"(fq));
        float* tb = (pm < 64 ? xlat + (size_t)pm * 256 * DM : xctx + (size_t)(pm - 64) * 256 * DM) + pn * 256;
        const float* g = gate + (pm < 64 ? (pm >> 5) : 2) * 9216 + pn * 256;
        const unsigned coff = (unsigned)(wc * 32 + 4 * fq), loff = (unsigned)((wr * 64 + fr) * DM) + coff;
        f32x4 gv[2][2];
#pragma unroll
        for (int bj = 0; bj < 2; ++bj)
#pragma unroll
            for (int n = 0; n < 2; ++n) gv[bj][n] = coef * *(const f32x4*)(g + (coff + (unsigned)(bj * 128 + n * 16)));
#pragma unroll
        for (int ai = 0; ai < 2; ++ai)
#pragma unroll
            for (int m = 0; m < 4; ++m) {
                float* xr = tb + (loff + (unsigned)((ai * 128 + m * 16) * DM));
#pragma unroll
                for (int bj = 0; bj < 2; ++bj)
#pragma unroll
                    for (int n = 0; n < 2; ++n) { float* xp = xr + (bj * 128 + n * 16);
                        f32x4 xv = *(const f32x4*)xp; xv += gv[bj][n] * acc[ai][bj][m][n]; *(f32x4*)xp = xv; }
                asm volatile("" ::: "memory");
            }
    }
};

__device__ __forceinline__ void phase_modgemv(const Args& a, float* red, int G, int bid, int tid) {
    const float* c = IN(1); const float* cctx = IN(3); const float* ada_w = IN(4); const float* ada_b = IN(5);
    float* mod = (float*)(karg_ws() + OFF_MOD);
    const int w = tid >> 6, lane = tid & 63;
    for (int u = bid; u < 576; u += G) {
        const int l = u / 288, rem = u % 288, jt = rem >> 3, ks = rem & 7;
        const int kb = ks * 128 + w * 16, j0 = jt * 256 + lane * 4;
        f32x4 acc0 = {0.f, 0.f, 0.f, 0.f}, acc1 = acc0, acc2 = acc0;
        for (int kk = 0; kk < 16; ++kk) { const int k = kb + kk;
            const float s0 = siluf_(c[k]), s1 = siluf_(c[1024 + k]), s2 = siluf_(cctx[k]);
            const f32x4 wv = *(const f32x4*)(ada_w + ((size_t)(l * 1024 + k)) * 9216 + j0);
            acc0 += s0 * wv; acc1 += s1 * wv; acc2 += s2 * wv; }
        float* rp = red + (w * 3) * 256 + lane * 4;
        *(f32x4*)rp = acc0; *(f32x4*)(rp + 256) = acc1; *(f32x4*)(rp + 512) = acc2;
        __syncthreads();
        for (int o = tid; o < 768; o += 512) { const int m = o >> 8, jj = o & 255; float s = 0.f;
#pragma unroll
            for (int ww = 0; ww < 8; ++ww) s += red[(ww * 3 + m) * 256 + jj];
            const int j = jt * 256 + jj; if (ks == 0) s += ada_b[l * 9216 + j];
            atomicAdd(&mod[(l * 3 + m) * 9216 + j], s); }
        __syncthreads();
    }
}
__device__ __forceinline__ void phase_copy(const Args& a, int G, int bid, int tid) {
    const f32x4* x4 = (const f32x4*)IN(0); f32x4* o4 = (f32x4*)karg_out();
    for (int i = bid * 512 + tid; i < NLAT * DM / 4; i += G * 512) o4[i] = x4[i];
    const f32x4* c4 = (const f32x4*)IN(2); f32x4* xc4 = (f32x4*)(karg_ws() + OFF_XCTX);
    for (int i = bid * 512 + tid; i < 512 * DM / 4; i += G * 512) xc4[i] = c4[i];
}
__device__ __forceinline__ int swiglu_map(int n) { return n < DFF ? ((n >> 7) * 256 + (n & 127)) : ((((n - DFF) >> 7) * 256) + 128 + ((n - DFF) & 127)); }
__device__ __forceinline__ void transpose_item(const float* W, int K, int N, bf16* WT, float* scr, int item, int lane, int mode, const float* kscale) {
    const int nblk = N / 32, kb = item / nblk, nb = item % nblk, k0 = 64 * kb, n0 = 32 * nb;
#pragma unroll 8
    for (int i = 0; i < 32; ++i) { const int kk = 2 * i + (lane >> 5); float v = W[(size_t)(k0 + kk) * N + n0 + (lane & 31)]; if (kscale) v *= kscale[k0 + kk]; scr[kk * 33 + (lane & 31)] = v; }
    __builtin_amdgcn_wave_barrier();
    const int c = lane & 7;
#pragma unroll
    for (int j = 0; j < 4; ++j) { const int n = (lane >> 3) + 8 * j; const float* s = scr + (8 * c) * 33 + n;
        v4u o; o.x = pk2(s[0 * 33], s[1 * 33]); o.y = pk2(s[2 * 33], s[3 * 33]); o.z = pk2(s[4 * 33], s[5 * 33]); o.w = pk2(s[6 * 33], s[7 * 33]);
        const int nn = n0 + n, drow = mode ? swiglu_map(nn) : nn;
        *(v4u*)(WT + (size_t)drow * K + k0 + 8 * c) = o; }
    __builtin_amdgcn_wave_barrier();
}
__device__ __forceinline__ void convert_weights(const Args& a, int l, float* scr, int gw, int NGW, int lane, int G, int bid, int tid) {
    constexpr int I13 = 16 * 176, I2 = 44 * 32, IIN = 16 * 77, IOUT = 16 * 32, IUQ = 4 * 12, IUKV = 2 * 16;
    constexpr int IEX = 80;
    constexpr int NIT = 2 * I13 + 2 * I2 + IIN + IOUT + IUQ + IUKV + IEX;
    unsigned char* ws = karg_ws();
    for (int it = gw; it < NIT; it += NGW) {
        int r = it;
        if (r < I13) { transpose_item(IN(6) + (size_t)l * DM * 2 * DFF, DM, 2 * DFF, (bf16*)(ws + W_13A), scr, r, lane, 1, nullptr); continue; } r -= I13;
        if (r < I13) { transpose_item(IN(8) + (size_t)l * DM * 2 * DFF, DM, 2 * DFF, (bf16*)(ws + W_13B), scr, r, lane, 1, nullptr); continue; } r -= I13;
        if (r < I2) { transpose_item(IN(7) + (size_t)l * DFF * DM, DFF, DM, (bf16*)(ws + W_2A), scr, r, lane, 0, nullptr); continue; } r -= I2;
        if (r < I2) { transpose_item(IN(9) + (size_t)l * DFF * DM, DFF, DM, (bf16*)(ws + W_2B), scr, r, lane, 0, nullptr); continue; } r -= I2;
        if (r < IIN) { transpose_item(IN(10) + (size_t)l * DM * 2464, DM, 2464, (bf16*)(ws + W_IN), scr, r, lane, 0, nullptr); continue; } r -= IIN;
        if (r < IOUT) { transpose_item(IN(11) + (size_t)l * DM * DM, DM, DM, (bf16*)(ws + W_OUT), scr, r, lane, 0, nullptr); continue; } r -= IOUT;
        if (r < IUQ) { transpose_item(IN(36) + (size_t)l * 256 * 384, 256, 384, (bf16*)(ws + W_UQ), scr, r, lane, 0, IN(35) + l * 256); continue; } r -= IUQ;
        if (r < IUKV) { transpose_item(IN(38) + (size_t)l * 128 * 512, 128, 512, (bf16*)(ws + W_UKV), scr, r, lane, 0, IN(37) + l * 128); continue; } r -= IUKV;
        if (r < 16) { const int d = r >> 3; transpose_item(IN(26) + (size_t)(l * 2 + d) * 64 * 256, 64, 256, (bf16*)(ws + W_WUP) + d * 256 * 64, scr, r & 7, lane, 0, nullptr); continue; } r -= 16;
        if (r < 16) { const int d = r >> 3; transpose_item(IN(28) + (size_t)(l * 2 + d) * 64 * 256, 64, 256, (bf16*)(ws + W_AUP) + d * 256 * 64, scr, r & 7, lane, 0, nullptr); continue; } r -= 16;
        if (r < 16) { transpose_item(IN(29) + (size_t)l * 128 * 256, 128, 256, (bf16*)(ws + W_GUP), scr, r, lane, 0, nullptr); continue; } r -= 16;
        if (r < 16) { const int m = r >> 1; transpose_item(IN(18) + (size_t)(l * 8 + m) * 4096, 64, 64, (bf16*)(ws + W_LWA) + m * 4096, scr, r & 1, lane, 0, nullptr); continue; } r -= 16;
        { const int m = r >> 1; transpose_item(IN(20) + (size_t)(l * 8 + m) * 4096, 64, 64, (bf16*)(ws + W_LWX) + m * 4096, scr, r & 1, lane, 0, nullptr); }
    }
    v4u z = {0u, 0u, 0u, 0u}; v4u* zp = (v4u*)(ws + W_IN + (size_t)2464 * DM * 2);
    for (int i = bid * 512 + tid; i < 96 * DM * 2 / 16; i += G * 512) zp[i] = z;
}
__device__ __forceinline__ void phase_modulate(const Args& a, int l, int which, int gw, int NGW, int lane) {
    unsigned char* ws = karg_ws(); const float* outp = karg_out();
    const float* mod = (const float*)(ws + OFF_MOD) + (size_t)l * 3 * 9216;
    bf16* XM = (bf16*)(ws + OFF_XMY);
    for (int r = gw; r < NR; r += NGW) {
        const float* xr = r < NLAT ? outp + (size_t)r * DM : (const float*)(ws + OFF_XCTX) + (size_t)(r - NLAT) * DM;
        const float* mm = mod + (r < NLAT ? (r >> 13) : 2) * 9216 + which * 3 * 1024;
        f32x4 v[4]; float ss = 0.f;
#pragma unroll
        for (int j = 0; j < 4; ++j) { v[j] = *(const f32x4*)(xr + 4 * lane + 256 * j); ss += (v[j][0] * v[j][0] + v[j][1] * v[j][1]) + (v[j][2] * v[j][2] + v[j][3] * v[j][3]); }
        const float rstd = rsqrtf(wave_sum(ss) * (1.f / DM) + 1e-6f);
#pragma unroll
        for (int j = 0; j < 4; ++j) { const int c = 4 * lane + 256 * j; const f32x4 sh = *(const f32x4*)(mm + c), sc = *(const f32x4*)(mm + 1024 + c);
            const f32x4 o = v[j] * rstd * (1.f + sc) + sh; v2u w; w.x = pk2(o[0], o[1]); w.y = pk2(o[2], o[3]);
            *(v2u*)(XM + (size_t)r * DM + c) = w; }
    }
}
__device__ __forceinline__ void phase_final(const Args& a, int gw, int NGW, int lane) {
    const float* fn = IN(39); float* outp = karg_out();
    for (int r = gw; r < NLAT; r += NGW) {
        float* xr = outp + (size_t)r * DM; f32x4 v[4]; float ss = 0.f;
#pragma unroll
        for (int j = 0; j < 4; ++j) { v[j] = *(const f32x4*)(xr + 4 * lane + 256 * j); ss += (v[j][0] * v[j][0] + v[j][1] * v[j][1]) + (v[j][2] * v[j][2] + v[j][3] * v[j][3]); }
        const float rstd = rsqrtf(wave_sum(ss) * (1.f / DM) + 1e-6f);
#pragma unroll
        for (int j = 0; j < 4; ++j) { const int c = 4 * lane + 256 * j; const f32x4 g = *(const f32x4*)(fn + c); *(f32x4*)(xr + c) = v[j] * rstd * g; }
    }
}

__device__ __forceinline__ void phase_m1(const Args& a, int l, unsigned char* lds, int G, int bid, int tid_unused) {
    unsigned char* ws = karg_ws();
    const bf16* U = (const bf16*)(ws + OFF_HU);
    bf16* Y = (bf16*)(ws + OFF_XMY);
    for (int tile = bid; tile < NTILE; tile += G) {
        const TileInfo ti = tile_info(tile);
        const int row0 = tile * 32;
        {
            const int tid = ltid(); const int lane = tid & 63, wave = __builtin_amdgcn_readfirstlane(tid >> 6), ch = tid & 255, part = tid >> 8; (void)lane; (void)wave; (void)ch; (void)part;
            float* z = (float*)lds;
            float* cv = (float*)(lds + 65536);
            for (int tt = part; tt < 62; tt += 2) { const int t = ti.t0 - 15 + tt; float zz = 0.f;
                if (t >= 0 && t < ti.seqlen) { const bf16* ur = U + (size_t)(ti.seqbase + t) * UC; zz = bf2f(ur[ch]) * sigm(bf2f(ur[256 + ch])); }
                z[tt * 256 + ch] = zz; }
            __syncthreads();
            const float* dw = IN(12) + (size_t)l * 31 * 256 + ch;
            float acc[16]; const float bias = IN(13)[l * 256 + ch];
#pragma unroll
            for (int o = 0; o < 16; ++o) acc[o] = bias;
            for (int j = 0; j < 31; ++j) { const float w = dw[j * 256];
#pragma unroll
                for (int o = 0; o < 16; ++o) acc[o] += w * z[(part * 16 + o + j) * 256 + ch]; }
#pragma unroll
            for (int o = 0; o < 16; ++o) cv[(part * 16 + o) * 256 + ch] = acc[o];
            __syncthreads();
            const f32x4 lg = *(const f32x4*)(IN(14) + l * 256 + lane * 4), lb = *(const f32x4*)(IN(15) + l * 256 + lane * 4);
#pragma unroll
            for (int q = 0; q < 4; ++q) { const int t = wave * 4 + q; const f32x4 v = *(const f32x4*)(cv + t * 256 + lane * 4);
                const float mu = wave_sum((v[0] + v[1]) + (v[2] + v[3])) * (1.f / 256.f);
                const f32x4 dv = v - mu; const float var = wave_sum((dv[0] * dv[0] + dv[1] * dv[1]) + (dv[2] * dv[2] + dv[3] * dv[3])) * (1.f / 256.f);
                const f32x4 yn = dv * rsqrtf(var + 1e-5f) * lg + lb;
                v2u w; w.x = pk2(siluf_(yn[0]), siluf_(yn[1])); w.y = pk2(siluf_(yn[2]), siluf_(yn[3]));
                *(v2u*)(Y + (size_t)(row0 + t) * DM + lane * 4) = w; }
            __syncthreads();
        }
        {
            float* xvf = (float*)lds;
            bf16* xvb = (bf16*)(lds + 32768);
            bf16* rg = (bf16*)(lds + 49664);
            bf16* ixg = (bf16*)(lds + 82432);
            {
                const int tid = ltid(); const int ch = tid & 255, part = tid >> 8;
                const float* cw = IN(16) + (size_t)l * 4 * 256 + ch; const float w0 = cw[0], w1 = cw[256], w2 = cw[512], w3 = cw[768], cb = IN(17)[l * 256 + ch];
                float xin[19];
#pragma unroll
                for (int i = 0; i < 19; ++i) { const int t = ti.t0 + part * 16 + i - 2; xin[i] = (t >= 0 && t < ti.seqlen) ? bf2f(U[(size_t)(ti.seqbase + t) * UC + 512 + ch]) : 0.f; }
                bf16* GB = (bf16*)(ws + M_GB);
#pragma unroll
                for (int o = 0; o < 16; ++o) { const int tl = part * 16 + o;
                    const float v = cb + w0 * xin[o] + w1 * xin[o + 1] + w2 * xin[o + 2] + w3 * xin[o + 3];
                    xvf[tl * 256 + ch] = v; xvb[tl * 264 + ch] = (bf16)f2bf(v);
                    GB[(size_t)(row0 + tl) * 256 + ch] = (bf16)f2bf(geluf_(bf2f(U[(size_t)(row0 + tl) * UC + 768 + ch]))); }
            }
            __syncthreads();
            {
                const int tid = ltid(); const int ln = tid & 63, wv = __builtin_amdgcn_readfirstlane(tid >> 6), fr = ln & 15, fq = ln >> 4, blk = wv >> 1;
                const bf16* LWAt = (const bf16*)(ws + W_LWA); const bf16* LWXt = (const bf16*)(ws + W_LWX);
                bf16x8 af[2][2];
#pragma unroll
                for (int mt = 0; mt < 2; ++mt)
#pragma unroll
                    for (int ks = 0; ks < 2; ++ks) af[mt][ks] = *(const bf16x8*)(xvb + (mt * 16 + fr) * 264 + blk * 64 + ks * 32 + fq * 8);
#pragma unroll 1
                for (int dn = 0; dn < 4; ++dn) { const int d = dn >> 1, nt = wv * 2 + (dn & 1), ch = nt * 16 + fr, jj = (nt & 3) * 16 + fr;
                    f32x4 ca[2], cx[2];
#pragma unroll
                    for (int mt = 0; mt < 2; ++mt) { ca[mt] = (f32x4){0.f, 0.f, 0.f, 0.f}; cx[mt] = ca[mt]; }
#pragma unroll
                    for (int ks = 0; ks < 2; ++ks) { const size_t wo = ((size_t)(d * 4 + blk) * 64 + jj) * 64 + ks * 32 + fq * 8;
                        const bf16x8 ba = *(const bf16x8*)(LWAt + wo), bx = *(const bf16x8*)(LWXt + wo);
#pragma unroll
                        for (int mt = 0; mt < 2; ++mt) { ca[mt] = __builtin_amdgcn_mfma_f32_16x16x32_bf16(af[mt][ks], ba, ca[mt], 0, 0, 0); cx[mt] = __builtin_amdgcn_mfma_f32_16x16x32_bf16(af[mt][ks], bx, cx[mt], 0, 0, 0); } }
                    const float bga = IN(19)[(l * 2 + d) * 256 + ch], bgx = IN(21)[(l * 2 + d) * 256 + ch];
                    bf16* LR = (bf16*)(ws + M_LR0 + (size_t)d * A8); bf16* LIX = (bf16*)(ws + M_LIX0 + (size_t)d * A8);
#pragma unroll
                    for (int mt = 0; mt < 2; ++mt)
#pragma unroll
                        for (int j = 0; j < 4; ++j) { const int t = mt * 16 + fq * 4 + j;
                            const bf16 rb = (bf16)f2bf(sigm(ca[mt][j] + bga)), ib = (bf16)f2bf(sigm(cx[mt][j] + bgx) * xvf[t * 256 + ch]);
                            LR[(size_t)(row0 + t) * 256 + ch] = rb; LIX[(size_t)(row0 + t) * 256 + ch] = ib;
                            rg[(d * 32 + t) * 256 + ch] = rb; ixg[(d * 32 + t) * 256 + ch] = ib; }
                }
            }
            __syncthreads();
            {
                const int tid = ltid(); const int ch = tid & 255, d = tid >> 8;
                const float lam = IN(22)[(l * 2 + d) * 256 + ch];
                const float cch = -8.f * log1pf(__expf(-lam));
                float A = 1.f, B = 0.f;
#pragma unroll 8
                for (int tt = 0; tt < 32; ++tt) { const int t = d ? 31 - tt : tt;
                    const float al = __expf(cch * bf2f(rg[(d * 32 + t) * 256 + ch])); const float bb = sqrtf(fmaxf(1.f - al * al, 0.f)) * bf2f(ixg[(d * 32 + t) * 256 + ch]); B = al * B + bb; A *= al; }
                ((float*)(ws + M_SEGA))[(size_t)(tile * 2 + d) * 256 + ch] = A;
                ((float*)(ws + M_SEGB))[(size_t)(tile * 2 + d) * 256 + ch] = B;
            }
            __syncthreads();
        }
        {
            const int tid = ltid(); const int lane = tid & 63, wave = __builtin_amdgcn_readfirstlane(tid >> 6), ch = tid & 255, part = tid >> 8; (void)lane; (void)wave; (void)ch; (void)part;
            bf16* As = (bf16*)lds;
            float* kr = (float*)(lds + 32768);
            float* rs = (float*)(lds + 32768 + 4096);
            for (int idx = tid; idx < 32 * 52; idx += 512) { const int t = idx / 52, cc = idx % 52;
                const v4u v = *(const v4u*)(U + (size_t)(row0 + t) * UC + 2048 + cc * 8);
                if (cc < 48) *(v4u*)(As + t * 392 + cc * 8) = v;
                else { const int c0 = (cc - 48) * 8; float* kp = kr + t * 32 + c0;
                    kp[0] = __uint_as_float(v.x << 16); kp[1] = __uint_as_float(v.x & 0xffff0000u); kp[2] = __uint_as_float(v.y << 16); kp[3] = __uint_as_float(v.y & 0xffff0000u);
                    kp[4] = __uint_as_float(v.z << 16); kp[5] = __uint_as_float(v.z & 0xffff0000u); kp[6] = __uint_as_float(v.w << 16); kp[7] = __uint_as_float(v.w & 0xffff0000u); } }
            __syncthreads();
#pragma unroll
            for (int q = 0; q < 4; ++q) { const int t = wave * 4 + q; float sq = 0.f, sk = 0.f;
#pragma unroll
                for (int j = 0; j < 4; ++j) { const float v = bf2f(As[t * 392 + lane + 64 * j]); sq += v * v; }
#pragma unroll
                for (int j = 0; j < 2; ++j) { const float v = bf2f(As[t * 392 + 256 + lane + 64 * j]); sk += v * v; }
                sq = wave_sum(sq); sk = wave_sum(sk);
                if (lane == 0) { rs[t * 2] = rsqrtf(sq * (1.f / 256.f) + 1e-6f); rs[t * 2 + 1] = rsqrtf(sk * (1.f / 128.f) + 1e-6f); } }
            __syncthreads();
            const int fr = lane & 15, fq = lane >> 4;
            bf16* QB = (bf16*)(ws + M_QB); bf16* KB = (bf16*)(ws + M_KB); bf16* VT = (bf16*)(ws + M_VT);
            const bf16* WUQ = (const bf16*)(ws + W_UQ); const bf16* WUKV = (const bf16*)(ws + W_UKV);
            const int keybase = ti.isctx ? TLEN : 0;
#pragma unroll 1
            for (int i = 0; i < 3; ++i) { const int nt = wave * 3 + i;
                f32x4 c0 = {0.f, 0.f, 0.f, 0.f}, c1 = c0;
#pragma unroll
                for (int ks = 0; ks < 8; ++ks) { const bf16x8 bfr = *(const bf16x8*)(WUQ + (size_t)(nt * 16 + fr) * 256 + ks * 32 + fq * 8);
                    const bf16x8 a0 = *(const bf16x8*)(As + fr * 392 + ks * 32 + fq * 8), a1 = *(const bf16x8*)(As + (16 + fr) * 392 + ks * 32 + fq * 8);
                    c0 = __builtin_amdgcn_mfma_f32_16x16x32_bf16(a0, bfr, c0, 0, 0, 0); c1 = __builtin_amdgcn_mfma_f32_16x16x32_bf16(a1, bfr, c1, 0, 0, 0); }
                const int hq = nt / 6, wt = nt % 6, dd = wt * 16 + fr;
#pragma unroll
                for (int mt = 0; mt < 2; ++mt)
#pragma unroll
                    for (int j = 0; j < 4; ++j) { const int tl = mt * 16 + fq * 4 + j; const int t = ti.t0 + tl;
                        float v = (mt ? c1[j] : c0[j]) * rs[tl * 2];
                        const float pv = __shfl_xor(v, 8);
                        if (wt >= 4 && !ti.isctx) { const int f = fr & 7; const float pos = (wt == 4) ? (float)(t >> 6) : (float)(t & 63);
                            const float ang = pos * __expf(-(float)f * (9.210340371976184f / 8.f)); float sn, cs; __sincosf(ang, &sn, &cs);
                            v = (fr & 8) ? (v * cs + pv * sn) : (v * cs - pv * sn); }
                        QB[((size_t)(ti.b * 4 + hq) * TT + keybase + t) * 96 + dd] = (bf16)f2bf(v * QSCALE); } }
#pragma unroll 1
            for (int i = 0; i < 4; ++i) { const int nt = wave * 4 + i;
                f32x4 c0 = {0.f, 0.f, 0.f, 0.f}, c1 = c0;
#pragma unroll
                for (int ks = 0; ks < 4; ++ks) { const bf16x8 bfr = *(const bf16x8*)(WUKV + (size_t)(nt * 16 + fr) * 128 + ks * 32 + fq * 8);
                    const bf16x8 a0 = *(const bf16x8*)(As + fr * 392 + 256 + ks * 32 + fq * 8), a1 = *(const bf16x8*)(As + (16 + fr) * 392 + 256 + ks * 32 + fq * 8);
                    c0 = __builtin_amdgcn_mfma_f32_16x16x32_bf16(a0, bfr, c0, 0, 0, 0); c1 = __builtin_amdgcn_mfma_f32_16x16x32_bf16(a1, bfr, c1, 0, 0, 0); }
                const int hk = nt >> 3, wt = nt & 7;
#pragma unroll
                for (int mt = 0; mt < 2; ++mt)
#pragma unroll
                    for (int j = 0; j < 4; ++j) { const int tl = mt * 16 + fq * 4 + j; const int key = keybase + ti.t0 + tl;
                        const float v = (mt ? c1[j] : c0[j]) * rs[tl * 2 + 1];
                        if (wt < 4) KB[((size_t)(ti.b * 4 + hk) * TT + key) * 96 + wt * 16 + fr] = (bf16)f2bf(v);
                        else VT[((size_t)(ti.b * 4 + hk) * 64 + (wt - 4) * 16 + fr) * TT + key] = (bf16)f2bf(v); } }
            { const int tl = tid >> 4, p = tid & 15, ax = p >> 3, f = p & 7; const int t = ti.t0 + tl;
                float x0 = kr[tl * 32 + ax * 16 + f], x1 = kr[tl * 32 + ax * 16 + 8 + f];
                if (!ti.isctx) { const float pos = ax == 0 ? (float)(t >> 6) : (float)(t & 63); const float ang = pos * __expf(-(float)f * (9.210340371976184f / 8.f));
                    float sn, cs; __sincosf(ang, &sn, &cs); const float y0 = x0 * cs - x1 * sn, y1 = x1 * cs + x0 * sn; x0 = y0; x1 = y1; }
                const bf16 b0 = (bf16)f2bf(x0), b1 = (bf16)f2bf(x1);
#pragma unroll
                for (int h = 0; h < 4; ++h) { bf16* kp = KB + ((size_t)(ti.b * 4 + h) * TT + keybase + t) * 96 + 64 + ax * 16 + f; kp[0] = b0; kp[8] = b1; } }
            __syncthreads();
        }
    }
}

__device__ __forceinline__ void attn_unit(unsigned char* lds, const bf16* QB, const bf16* KB, const bf16* VT, bf16* Y, int b, int h, int q0, int key_lo, int nkt, int tid) {
    const int lane = tid & 63, wave = tid >> 6, fr = lane & 15, fq = lane >> 4;
    const int bh = b * 4 + h;
    constexpr int KSTR = 104, VSTR = 72, KBUF = 64 * KSTR, VBUF = 64 * VSTR;
    bf16* Ks = (bf16*)lds;
    bf16* Vs = (bf16*)lds + 2 * KBUF;
    const int qw = q0 + wave * 32;
    bf16x8 qf[2][3];
#pragma unroll
    for (int qt = 0; qt < 2; ++qt)
#pragma unroll
        for (int ks = 0; ks < 3; ++ks) qf[qt][ks] = *(const bf16x8*)(QB + ((size_t)bh * TT + qw + qt * 16 + fr) * 96 + ks * 32 + fq * 8);
    float mrun[2] = {-1e30f, -1e30f}, lrun[2] = {0.f, 0.f};
    f32x4 o[4][2];
#pragma unroll
    for (int dt = 0; dt < 4; ++dt)
#pragma unroll
        for (int qt = 0; qt < 2; ++qt) o[dt][qt] = (f32x4){0.f, 0.f, 0.f, 0.f};
    const v4u* kg = (const v4u*)(KB + ((size_t)bh * TT + key_lo) * 96);
    const bf16* vg = VT + ((size_t)bh * 64 + (tid >> 3)) * TT + key_lo + (tid & 7) * 8;
    const int kc0 = tid, kc1 = 512 + tid;
    const int ko0 = (kc0 / 12) * KSTR + (kc0 % 12) * 8, ko1 = (kc1 / 12) * KSTR + (kc1 % 12) * 8, vo = (tid >> 3) * VSTR + (tid & 7) * 8;
    v4u rk0, rk1 = {0u, 0u, 0u, 0u}, rv;
    rk0 = kg[kc0]; if (tid < 256) rk1 = kg[kc1]; rv = *(const v4u*)vg;
    *(v4u*)(Ks + ko0) = rk0; if (tid < 256) *(v4u*)(Ks + ko1) = rk1; *(v4u*)(Vs + vo) = rv;
    __syncthreads();
    for (int kt = 0; kt < nkt; ++kt) {
        const int cur = kt & 1;
        if (kt + 1 < nkt) { const v4u* kn = kg + (size_t)(kt + 1) * 768; rk0 = kn[kc0]; if (tid < 256) rk1 = kn[kc1]; rv = *(const v4u*)(vg + (kt + 1) * 64); }
        const bf16* kb = Ks + cur * KBUF; const bf16* vb = Vs + cur * VBUF;
        f32x4 st[4][2];
#pragma unroll
        for (int k4 = 0; k4 < 4; ++k4) {
            st[k4][0] = (f32x4){0.f, 0.f, 0.f, 0.f}; st[k4][1] = st[k4][0];
#pragma unroll
            for (int ks = 0; ks < 3; ++ks) { const bf16x8 kf = *(const bf16x8*)(kb + (k4 * 16 + fr) * KSTR + ks * 32 + fq * 8);
                st[k4][0] = __builtin_amdgcn_mfma_f32_16x16x32_bf16(kf, qf[0][ks], st[k4][0], 0, 0, 0);
                st[k4][1] = __builtin_amdgcn_mfma_f32_16x16x32_bf16(kf, qf[1][ks], st[k4][1], 0, 0, 0); }
        }
        bf16x8 pb[2][2];
#pragma unroll
        for (int qt = 0; qt < 2; ++qt) {
            float mx = st[0][qt][0];
#pragma unroll
            for (int k4 = 0; k4 < 4; ++k4)
#pragma unroll
                for (int j = 0; j < 4; ++j) mx = fmaxf(mx, st[k4][qt][j]);
            mx = fmaxf(mx, __shfl_xor(mx, 16)); mx = fmaxf(mx, __shfl_xor(mx, 32));
            const float mn = fmaxf(mrun[qt], mx), alpha = __builtin_amdgcn_exp2f(mrun[qt] - mn); mrun[qt] = mn;
            float ls = 0.f;
#pragma unroll
            for (int k4 = 0; k4 < 4; ++k4)
#pragma unroll
                for (int j = 0; j < 4; ++j) { const float p = __builtin_amdgcn_exp2f(st[k4][qt][j] - mn); st[k4][qt][j] = p; ls += p; }
            lrun[qt] = lrun[qt] * alpha + ls;
#pragma unroll
            for (int dt = 0; dt < 4; ++dt) o[dt][qt] *= alpha;
#pragma unroll
            for (int u = 0; u < 2; ++u) { v4u w;
                w.x = pg8::cvt_pk_bf16(st[2 * u][qt][0], st[2 * u][qt][1]); w.y = pg8::cvt_pk_bf16(st[2 * u][qt][2], st[2 * u][qt][3]);
                w.z = pg8::cvt_pk_bf16(st[2 * u + 1][qt][0], st[2 * u + 1][qt][1]); w.w = pg8::cvt_pk_bf16(st[2 * u + 1][qt][2], st[2 * u + 1][qt][3]);
                pb[u][qt] = __builtin_bit_cast(bf16x8, w); }
        }
#pragma unroll
        for (int dt = 0; dt < 4; ++dt)
#pragma unroll
            for (int u = 0; u < 2; ++u) {
                const v2u lo = *(const v2u*)(vb + (dt * 16 + fr) * VSTR + 32 * u + 4 * fq), hi = *(const v2u*)(vb + (dt * 16 + fr) * VSTR + 32 * u + 16 + 4 * fq);
                v4u vw; vw.x = lo.x; vw.y = lo.y; vw.z = hi.x; vw.w = hi.y;
                const bf16x8 va = __builtin_bit_cast(bf16x8, vw);
                o[dt][0] = __builtin_amdgcn_mfma_f32_16x16x32_bf16(va, pb[u][0], o[dt][0], 0, 0, 0);
                o[dt][1] = __builtin_amdgcn_mfma_f32_16x16x32_bf16(va, pb[u][1], o[dt][1], 0, 0, 0);
            }
        if (kt + 1 < nkt) { const int nb = cur ^ 1; *(v4u*)(Ks + nb * KBUF + ko0) = rk0; if (tid < 256) *(v4u*)(Ks + nb * KBUF + ko1) = rk1; *(v4u*)(Vs + nb * VBUF + vo) = rv; }
        __syncthreads();
    }
#pragma unroll
    for (int qt = 0; qt < 2; ++qt) {
        float lt = lrun[qt]; lt += __shfl_xor(lt, 16); lt += __shfl_xor(lt, 32);
        const float inv = 1.f / lt;
        const int q = qw + qt * 16 + fr;
        const size_t row = q < TLEN ? (size_t)b * TLEN + q : (size_t)NLAT + b * CTXL + (q - TLEN);
#pragma unroll
        for (int dt = 0; dt < 4; ++dt) { const f32x4 v = o[dt][qt] * inv; v2u w; w.x = pk2(v[0], v[1]); w.y = pk2(v[2], v[3]);
            *(v2u*)(Y + row * DM + 768 + h * 64 + dt * 16 + fq * 4) = w; }
    }
}
__device__ __forceinline__ void lru_tile(const Args& a, int l, unsigned char* lds, int tile, int tid) {
    unsigned char* ws = karg_ws();
    const int ch = tid & 255, d = tid >> 8;
    const TileInfo ti = tile_info(tile);
    const int row0 = tile * 32;
    const float* SA = (const float*)(ws + M_SEGA); const float* SB = (const float*)(ws + M_SEGB);
    float hst = 0.f;
    const int ctile0 = 512 + ti.b * 8, ltile0 = ti.b * 256;
    if (d == 0) {
        const int nc = ti.isctx ? (tile - ctile0) : 8;
#pragma unroll 16
        for (int j = 0; j < nc; ++j) { const size_t o = (size_t)((ctile0 + j) * 2) * 256 + ch; hst = SA[o] * hst + SB[o]; }
        const int je = ti.isctx ? ltile0 : tile;
#pragma unroll 16
        for (int j = ltile0; j < je; ++j) { const size_t o = (size_t)(j * 2) * 256 + ch; hst = SA[o] * hst + SB[o]; }
    } else {
        const int lo = ti.isctx ? (tile - ctile0 + 1) : 0;
#pragma unroll 8
        for (int j = 7; j >= lo; --j) { const size_t o = (size_t)((ctile0 + j) * 2 + 1) * 256 + ch; hst = SA[o] * hst + SB[o]; }
        const int jb = ti.isctx ? ltile0 + 255 : tile;
#pragma unroll 16
        for (int j = ltile0 + 255; j > jb; --j) { const size_t o = (size_t)(j * 2 + 1) * 256 + ch; hst = SA[o] * hst + SB[o]; }
    }
    const float lam = IN(22)[(l * 2 + d) * 256 + ch];
    const float cch = -8.f * log1pf(__expf(-lam));
    const bf16* LR = (const bf16*)(ws + M_LR0 + (size_t)d * A8); const bf16* LIX = (const bf16*)(ws + M_LIX0 + (size_t)d * A8);
    float* hs = (float*)lds;
#pragma unroll 16
    for (int tt = 0; tt < 32; ++tt) { const int t = d ? 31 - tt : tt; const size_t o = (size_t)(row0 + t) * 256 + ch;
        const float al = __expf(cch * bf2f(LR[o])); const float bb = sqrtf(fmaxf(1.f - al * al, 0.f)) * bf2f(LIX[o]);
        hst = al * hst + bb; hs[(d * 32 + t) * 256 + ch] = hst; }
    __syncthreads();
    const bf16* GB = (const bf16*)(ws + M_GB); bf16* Y = (bf16*)(ws + OFF_XMY);
    for (int tt = 0; tt < 16; ++tt) { const int t = d * 16 + tt;
        const float y = (hs[t * 256 + ch] + hs[(32 + t) * 256 + ch]) * bf2f(GB[(size_t)(row0 + t) * 256 + ch]);
        Y[(size_t)(row0 + t) * DM + 256 + ch] = (bf16)f2bf(y); }
    __syncthreads();
}
__device__ __forceinline__ void phase_m2(const Args& a, int l, unsigned char* lds, int G, int bid, int tid) {
    unsigned char* ws = karg_ws();
    const bf16* QB = (const bf16*)(ws + M_QB); const bf16* KB = (const bf16*)(ws + M_KB); const bf16* VT = (const bf16*)(ws + M_VT);
    bf16* Y = (bf16*)(ws + OFF_XMY);
    const int nunits = (l == 0) ? 264 : 256;
    for (int u = bid; u < nunits; u += G) {
        if (u < 256) attn_unit(lds, QB, KB, VT, Y, u >> 7, (u >> 5) & 3, (u & 31) * 256, 0, 132, tid);
        else attn_unit(lds, QB, KB, VT, Y, (u - 256) >> 2, (u - 256) & 3, TLEN, TLEN, 4, tid);
    }
    for (int tile = bid; tile < NTILE; tile += G) lru_tile(a, l, lds, tile, tid);
}

__device__ __forceinline__ void phase_m3(const Args& a, int l, unsigned char* lds, int G, int bid, int tid) {
    unsigned char* ws = karg_ws();
    const bf16* U = (const bf16*)(ws + OFF_HU);
    const int lane = tid & 63, ch = tid & 255, part = tid >> 8;
    const float* mup = IN(23) + l * 1024; const float* mun = IN(24) + l * 1024;
    bf16* RR = (bf16*)(ws + M_RR); bf16* KKo = (bf16*)(ws + M_KK); bf16* VV = (bf16*)(ws + M_VV); bf16* GC = (bf16*)(ws + M_GC);
    float* kl = (float*)lds;
    float* kkn = (float*)(lds + 32768);
    bf16* twb = (bf16*)(lds + 65536);
    bf16* tab = (bf16*)(lds + 70144);
    bf16* tgb = (bf16*)(lds + 74752);
    for (int tile = bid; tile < NTILE; tile += G) {
        const TileInfo ti = tile_info(tile);
        const int row0 = tile * 32;
        {
            const int tid2 = ltid(); const int chunk = tid2 & 127, tg8 = tid2 >> 7, c0 = chunk * 8;
            const bf16* ub = U + (size_t)row0 * UC + 1024 + c0;
            v4u rw[10];
#pragma unroll
            for (int q = 0; q < 10; ++q) { const int tl = tg8 * 8 + q - 1; const int t = ti.t0 + tl;
                rw[q] = (t >= 0 && t < ti.seqlen) ? *(const v4u*)(ub + (ptrdiff_t)tl * UC) : (v4u){0u, 0u, 0u, 0u}; }
            const f32x4 mp0 = *(const f32x4*)(mup + c0), mp1 = *(const f32x4*)(mup + c0 + 4), mn0 = *(const f32x4*)(mun + c0), mn1 = *(const f32x4*)(mun + c0 + 4);
            const float mp[8] = {mp0[0], mp0[1], mp0[2], mp0[3], mp1[0], mp1[1], mp1[2], mp1[3]}, mn[8] = {mn0[0], mn0[1], mn0[2], mn0[3], mn1[0], mn1[1], mn1[2], mn1[3]};
#pragma unroll
            for (int q = 0; q < 8; ++q) { const int tl = tg8 * 8 + q; float ts[8];
#pragma unroll
                for (int e = 0; e < 8; ++e) { const unsigned wm = rw[q][e >> 1], w0 = rw[q + 1][e >> 1], wn = rw[q + 2][e >> 1];
                    const float um = (e & 1) ? __uint_as_float(wm & 0xffff0000u) : __uint_as_float(wm << 16);
                    const float u0 = (e & 1) ? __uint_as_float(w0 & 0xffff0000u) : __uint_as_float(w0 << 16);
                    const float un = (e & 1) ? __uint_as_float(wn & 0xffff0000u) : __uint_as_float(wn << 16);
                    ts[e] = u0 + mp[e] * (um - u0) + mn[e] * (un - u0); }
                if (chunk >= 32 && chunk < 64) { float* kp = kl + tl * 256 + (c0 - 256); *(f32x4*)kp = (f32x4){ts[0], ts[1], ts[2], ts[3]}; *(f32x4*)(kp + 4) = (f32x4){ts[4], ts[5], ts[6], ts[7]}; }
                else {
                    if (chunk >= 96 && chunk < 104) {
#pragma unroll
                        for (int e = 0; e < 8; ++e) ts[e] = tanhf_(ts[e]); }
                    if (chunk >= 112) {
#pragma unroll
                        for (int e = 0; e < 8; ++e) ts[e] = sigm(ts[e]); }
                    v4u o; o.x = pk2(ts[0], ts[1]); o.y = pk2(ts[2], ts[3]); o.z = pk2(ts[4], ts[5]); o.w = pk2(ts[6], ts[7]);
                    if (chunk < 32) *(v4u*)(RR + (size_t)(row0 + tl) * 256 + c0) = o;
                    else if (chunk < 96) *(v4u*)(VV + (size_t)(row0 + tl) * 256 + (c0 - 512)) = o;
                    else if (chunk < 104) *(v4u*)(twb + tl * 72 + (c0 - 768)) = o;
                    else if (chunk < 112) *(v4u*)(tab + tl * 72 + (c0 - 832)) = o;
                    else *(v4u*)(tgb + tl * 136 + (c0 - 896)) = o; }
            }
        }
        __syncthreads();
        {
            const int tid2 = ltid(); const int ch = tid2 & 255, pt = tid2 >> 8; const float kkc = IN(30)[l * 256 + ch];
#pragma unroll 4
            for (int q = 0; q < 16; ++q) { const int t = pt * 16 + q; const float kr = kl[t * 256 + ch] * kkc; const float nrm = wave_sum(kr * kr);
                const float kk = kr * rsqrtf(fmaxf(nrm, 1e-24f)); kkn[t * 256 + ch] = kk; KKo[(size_t)(row0 + t) * 256 + ch] = (bf16)f2bf(kk); }
        }
        __syncthreads();
        {
            const int tid2 = ltid(); const int ln = tid2 & 63, wv = __builtin_amdgcn_readfirstlane(tid2 >> 6), fr = ln & 15, fq = ln >> 4;
            const bf16* WUPt = (const bf16*)(ws + W_WUP); const bf16* AUPt = (const bf16*)(ws + W_AUP); const bf16* GUPt = (const bf16*)(ws + W_GUP);
            bf16x8 aw[2][2], aa[2][2];
#pragma unroll
            for (int mt = 0; mt < 2; ++mt)
#pragma unroll
                for (int ks = 0; ks < 2; ++ks) { aw[mt][ks] = *(const bf16x8*)(twb + (mt * 16 + fr) * 72 + ks * 32 + fq * 8); aa[mt][ks] = *(const bf16x8*)(tab + (mt * 16 + fr) * 72 + ks * 32 + fq * 8); }
#pragma unroll 1
            for (int dn = 0; dn < 4; ++dn) { const int d = dn >> 1, nt = wv * 2 + (dn & 1), ch = nt * 16 + fr;
                f32x4 cw[2], ca[2];
#pragma unroll
                for (int mt = 0; mt < 2; ++mt) { cw[mt] = (f32x4){0.f, 0.f, 0.f, 0.f}; ca[mt] = cw[mt]; }
#pragma unroll
                for (int ks = 0; ks < 2; ++ks) { const bf16x8 bw = *(const bf16x8*)(WUPt + ((size_t)d * 256 + ch) * 64 + ks * 32 + fq * 8), ba = *(const bf16x8*)(AUPt + ((size_t)d * 256 + ch) * 64 + ks * 32 + fq * 8);
#pragma unroll
                    for (int mt = 0; mt < 2; ++mt) { cw[mt] = __builtin_amdgcn_mfma_f32_16x16x32_bf16(aw[mt][ks], bw, cw[mt], 0, 0, 0); ca[mt] = __builtin_amdgcn_mfma_f32_16x16x32_bf16(aa[mt][ks], ba, ca[mt], 0, 0, 0); } }
                const float w0 = IN(25)[(l * 2 + d) * 256 + ch], a0 = IN(27)[(l * 2 + d) * 256 + ch], kac = IN(31)[l * 256 + ch];
                float* WW = (float*)(ws + M_WW) + (size_t)d * NR * 256; bf16* BB = (bf16*)(ws + M_BB + (size_t)d * A8); bf16* KD = (bf16*)(ws + M_KD + (size_t)d * A8);
#pragma unroll
                for (int mt = 0; mt < 2; ++mt)
#pragma unroll
                    for (int j = 0; j < 4; ++j) { const int t = mt * 16 + fq * 4 + j; const size_t o = (size_t)(row0 + t) * 256 + ch;
                        const float e = sigm(w0 + cw[mt][j]) * 0.6065306597126334f;
                        const float av = sigm(a0 + ca[mt][j]);
                        WW[o] = __expf(-e);
                        KD[o] = (bf16)f2bf(kl[t * 256 + ch] * (1.f + (av - 1.f) * kac));
                        BB[o] = (bf16)f2bf(kkn[t * 256 + ch] * av); }
            }
#pragma unroll 1
            for (int nl = 0; nl < 2; ++nl) { const int ch = (wv * 2 + nl) * 16 + fr;
                f32x4 cg[2] = {(f32x4){0.f, 0.f, 0.f, 0.f}, (f32x4){0.f, 0.f, 0.f, 0.f}};
#pragma unroll
                for (int ks = 0; ks < 4; ++ks) { const bf16x8 bg = *(const bf16x8*)(GUPt + (size_t)ch * 128 + ks * 32 + fq * 8);
#pragma unroll
                    for (int mt = 0; mt < 2; ++mt) { const bf16x8 ag = *(const bf16x8*)(tgb + (mt * 16 + fr) * 136 + ks * 32 + fq * 8); cg[mt] = __builtin_amdgcn_mfma_f32_16x16x32_bf16(ag, bg, cg[mt], 0, 0, 0); } }
#pragma unroll
                for (int mt = 0; mt < 2; ++mt)
#pragma unroll
                    for (int j = 0; j < 4; ++j) GC[(size_t)(row0 + mt * 16 + fq * 4 + j) * 256 + ch] = (bf16)f2bf(cg[mt][j]);
            }
        }
        __syncthreads();
    }
}

typedef const unsigned cu32;
typedef const float cf32;
__device__ __forceinline__ int chain_row(int b, int d, int tau) {
    return tau < CTXL ? (NLAT + b * CTXL + (d ? CTXL - 1 - tau : tau)) : (b * TLEN + (d ? TLEN - 1 - (tau - CTXL) : (tau - CTXL)));
}
template <int MODE>
__device__ __forceinline__ void rwkv_steps(float (&S)[64], int b, int h, int d, int tau0, int n, unsigned char* ws, int lane, float* wl) {
    const bf16* KKp = (const bf16*)(ws + M_KK); const bf16* RRp = (const bf16*)(ws + M_RR); const bf16* VVp = (const bf16*)(ws + M_VV);
    const float* WWp = (const float*)(ws + M_WW) + (size_t)d * NR * 256; const bf16* BBp = (const bf16*)(ws + M_BB + (size_t)d * A8); const bf16* KDp = (const bf16*)(ws + M_KD + (size_t)d * A8);
    float* YS = (float*)(ws + M_YS) + (size_t)d * NR * 256;
    float pk, pw, pb, pkd = 0.f, pr = 0.f, pv = 0.f; size_t poff;
#define RWKV_LOAD(s_) do { poff = (size_t)chain_row(b, d, tau0 + (s_)) * 256 + h * 64 + lane; pk = bf2f(KKp[poff]); pw = WWp[poff]; pb = bf2f(BBp[poff]); \
        if (MODE != 1) { pkd = bf2f(KDp[poff]); pv = bf2f(VVp[poff]); } if (MODE == 2) pr = bf2f(RRp[poff]); } while (0)
    RWKV_LOAD(0);
    for (int s = 0; s < n; ++s) {
        float* buf = wl + (s & 1) * 320;
        buf[lane] = pk; buf[64 + lane] = pw; buf[128 + lane] = pb;
        if (MODE != 1) buf[192 + lane] = pkd;
        if (MODE == 2) buf[256 + lane] = pr;
        const float vv = pv; const size_t yoff = poff;
        if (s + 1 < n) RWKV_LOAD(s + 1);
        float sa0 = 0.f, sa1 = 0.f, sa2 = 0.f, sa3 = 0.f;
#pragma unroll
        for (int i = 0; i < 64; i += 4) { const f32x4 k4 = *(const f32x4*)(buf + i);
            sa0 += S[i] * k4[0]; sa1 += S[i + 1] * k4[1]; sa2 += S[i + 2] * k4[2]; sa3 += S[i + 3] * k4[3]; }
        const float nsa = -((sa0 + sa1) + (sa2 + sa3));
        float y0 = 0.f, y1 = 0.f, y2 = 0.f, y3 = 0.f;
#pragma unroll
        for (int i = 0; i < 64; i += 4) { const f32x4 w4 = *(const f32x4*)(buf + 64 + i), b4 = *(const f32x4*)(buf + 128 + i);
            f32x4 t = nsa * b4;
            if (MODE != 1) { const f32x4 kd4 = *(const f32x4*)(buf + 192 + i); t += vv * kd4; }
            S[i] = S[i] * w4[0] + t[0]; S[i + 1] = S[i + 1] * w4[1] + t[1]; S[i + 2] = S[i + 2] * w4[2] + t[2]; S[i + 3] = S[i + 3] * w4[3] + t[3];
            if (MODE == 2) { const f32x4 r4 = *(const f32x4*)(buf + 256 + i); y0 += S[i] * r4[0]; y1 += S[i + 1] * r4[1]; y2 += S[i + 2] * r4[2]; y3 += S[i + 3] * r4[3]; } }
        if (MODE == 2) YS[yoff] = (y0 + y1) + (y2 + y3);
    }
#undef RWKV_LOAD
}
typedef float f32x2 __attribute__((ext_vector_type(2)));
__device__ __forceinline__ void rwkv_pass1(f32x2 (&SL)[32], f32x2 (&SI)[32], int b, int h, int d, int tau0, int n, unsigned char* ws, int lane, float* wl) {
    const bf16* KKp = (const bf16*)(ws + M_KK); const bf16* VVp = (const bf16*)(ws + M_VV); const bf16* RRp = (const bf16*)(ws + M_RR);
    const float* WWp = (const float*)(ws + M_WW) + (size_t)d * NR * 256; const bf16* BBp = (const bf16*)(ws + M_BB + (size_t)d * A8); const bf16* KDp = (const bf16*)(ws + M_KD + (size_t)d * A8);
    float* YS = (float*)(ws + M_YS) + (size_t)d * NR * 256; float* PR = (float*)(ws + M_PR) + (size_t)d * NR * 256;
    float pk, pw, pb, pkd, pv, pr; size_t poff;
#define RWKV_LOAD(s_) do { poff = (size_t)chain_row(b, d, tau0 + (s_)) * 256 + h * 64 + lane; pk = bf2f(KKp[poff]); pw = WWp[poff]; pb = bf2f(BBp[poff]); pkd = bf2f(KDp[poff]); pv = bf2f(VVp[poff]); pr = bf2f(RRp[poff]); } while (0)
    RWKV_LOAD(0);
    for (int s = 0; s < n; ++s) {
        float* buf = wl + (s & 1) * 320;
        buf[lane] = pk; buf[64 + lane] = pw; buf[128 + lane] = pb; buf[192 + lane] = pkd; buf[256 + lane] = pr;
        const float vv = pv; const size_t yoff = poff;
        if (s + 1 < n) RWKV_LOAD(s + 1);
        f32x2 aL0 = {0.f, 0.f}, aL1 = aL0, aI0 = aL0, aI1 = aL0;
#pragma unroll
        for (int q = 0; q < 16; ++q) { const f32x4 k4 = *(const f32x4*)(buf + 4 * q);
            aL0 += SL[2 * q] * k4.lo; aL1 += SL[2 * q + 1] * k4.hi; aI0 += SI[2 * q] * k4.lo; aI1 += SI[2 * q + 1] * k4.hi; }
        const f32x2 tL = aL0 + aL1, tI = aI0 + aI1;
        const float nsl = -(tL.x + tL.y), nsi = -(tI.x + tI.y);
        f32x2 yL0 = {0.f, 0.f}, yL1 = yL0, yI0 = yL0, yI1 = yL0;
#pragma unroll
        for (int q = 0; q < 16; ++q) {
            const f32x4 w4 = *(const f32x4*)(buf + 64 + 4 * q), b4 = *(const f32x4*)(buf + 128 + 4 * q), kd4 = *(const f32x4*)(buf + 192 + 4 * q), r4 = *(const f32x4*)(buf + 256 + 4 * q);
            const f32x4 tl = nsl * b4 + vv * kd4, tiv = nsi * b4;
            SL[2 * q] = SL[2 * q] * w4.lo + tl.lo; SL[2 * q + 1] = SL[2 * q + 1] * w4.hi + tl.hi;
            SI[2 * q] = SI[2 * q] * w4.lo + tiv.lo; SI[2 * q + 1] = SI[2 * q + 1] * w4.hi + tiv.hi;
            yL0 += SL[2 * q] * r4.lo; yL1 += SL[2 * q + 1] * r4.hi; yI0 += SI[2 * q] * r4.lo; yI1 += SI[2 * q + 1] * r4.hi; }
        const f32x2 yl = yL0 + yL1, yp = yI0 + yI1;
        YS[yoff] = yl.x + yl.y; PR[yoff] = yp.x + yp.y;
    }
#undef RWKV_LOAD
}
__device__ __forceinline__ void phase_m4(const Args& a, unsigned char* lds, int G, int bid, int tid) {
    const int lane = tid & 63, wave = __builtin_amdgcn_readfirstlane(tid >> 6);
    unsigned char* ws = karg_ws(); float* PL = (float*)(ws + M_PL);
    if (wave >= 4) return;
    for (int task = bid * 4 + wave; task < 16 * NSEG; task += G * 4) {
        const int seg = task & (NSEG - 1), chain = task >> 6;
        const int d = chain & 1, h = (chain >> 1) & 3, b = chain >> 3;
        f32x2 SL[32], SI[32]; int ln = lane; asm volatile("" : "+v"(ln));
#pragma unroll
        for (int i = 0; i < 32; ++i) { SL[i] = (f32x2){0.f, 0.f}; SI[i] = (f32x2){(2 * i == ln) ? 1.f : 0.f, (2 * i + 1 == ln) ? 1.f : 0.f}; }
        rwkv_pass1(SL, SI, b, h, d, seg * SEGLEN, SEGLEN, ws, lane, (float*)lds + wave * 640);
        float* o = PL + (((size_t)(chain * NSEG + seg) * 2) * 64 + lane) * 64;
#pragma unroll
        for (int i = 0; i < 32; i += 2) { *(f32x4*)(o + 2 * i) = (f32x4){SL[i].x, SL[i].y, SL[i + 1].x, SL[i + 1].y}; *(f32x4*)(o + 4096 + 2 * i) = (f32x4){SI[i].x, SI[i].y, SI[i + 1].x, SI[i + 1].y}; }
    }
}
__device__ __forceinline__ void phase_m5(const Args& a, unsigned char* lds, int G, int bid, int tid) {
    unsigned char* ws = karg_ws(); const float* PL = (const float*)(ws + M_PL); float* SI = (float*)(ws + M_SINIT);
    float* Sl = (float*)lds;
    float* Pl = (float*)(lds + 8192);
    typedef float f32x2v __attribute__((ext_vector_type(2)));
    const int rl = tid >> 5, c2 = (tid & 31) * 2;
    for (int u = bid; u < 64; u += G) {
        const int chain = u >> 2, row = (u & 3) * 16 + rl;
        f32x2v cur = {0.f, 0.f};
        const float* Pg = PL + ((size_t)(chain * NSEG) * 2 + 1) * 4096; const float* Lg = PL + ((size_t)(chain * NSEG) * 2) * 4096;
        f32x4 pa[4], pb[4]; f32x2v lv[4];
#pragma unroll
        for (int q = 0; q < 4; ++q) { const float* Pn = Pg + (size_t)q * 8192; const float* Ln = Lg + (size_t)q * 8192;
            pa[q] = *(const f32x4*)(Pn + tid * 8); pb[q] = *(const f32x4*)(Pn + tid * 8 + 4); lv[q] = *(const f32x2v*)(Ln + row * 64 + c2); }
        for (int g0 = 0; g0 < NSEG; g0 += 8) {
            f32x2v keep[8];
#pragma unroll
            for (int q = 0; q < 8; ++q) { const int g = g0 + q; const int r = q & 3;
                keep[q] = cur;
                if (g < NSEG - 1) {
                    *(f32x2v*)(Sl + rl * 66 + c2) = cur;
                    *(f32x4*)(Pl + tid * 8) = pa[r]; *(f32x4*)(Pl + tid * 8 + 4) = pb[r];
                    f32x2v nw = lv[r];
                    if (g + 4 < NSEG - 1) { const float* Pn = Pg + (size_t)(g + 4) * 8192; const float* Ln = Lg + (size_t)(g + 4) * 8192;
                        pa[r] = *(const f32x4*)(Pn + tid * 8); pb[r] = *(const f32x4*)(Pn + tid * 8 + 4); lv[r] = *(const f32x2v*)(Ln + row * 64 + c2); }
                    __syncthreads();
#pragma unroll 16
                    for (int i = 0; i < 64; ++i) { const float sv = Sl[rl * 66 + i]; const f32x2v pv = *(const f32x2v*)(Pl + i * 64 + c2); nw += sv * pv; }
                    cur = nw;
                    __syncthreads();
                }
            }
#pragma unroll
            for (int q = 0; q < 8; ++q) *(f32x2v*)(SI + ((size_t)(chain * NSEG + g0 + q) * 64 + row) * 64 + c2) = keep[q];
        }
    }
}
__device__ __forceinline__ void phase_m6(const Args& a, unsigned char* lds, int G, int bid, int tid) {
    const int lane = tid & 63, wave = __builtin_amdgcn_readfirstlane(tid >> 6);
    unsigned char* ws = karg_ws(); const float* SI = (const float*)(ws + M_SINIT);
    float* wl = (float*)lds + wave * 256;
    for (int task = bid * 8 + wave; task < 16 * (NSEG - 1); task += G * 8) {
        const int seg = 1 + task % (NSEG - 1), chain = task / (NSEG - 1);
        const int d = chain & 1, h = (chain >> 1) & 3, b = chain >> 3;
        float* YS = (float*)(ws + M_YS) + (size_t)d * NR * 256; const float* PR = (const float*)(ws + M_PR) + (size_t)d * NR * 256;
        f32x2 S0[32];
        const float* si = SI + ((size_t)(chain * NSEG + seg) * 64 + lane) * 64;
#pragma unroll
        for (int i = 0; i < 32; i += 2) { const f32x4 v = *(const f32x4*)(si + 2 * i); S0[i] = v.lo; S0[i + 1] = v.hi; }
        const int tau0 = seg * SEGLEN;
        size_t o0 = (size_t)chain_row(b, d, tau0) * 256 + h * 64 + lane, o1 = (size_t)chain_row(b, d, tau0 + 1) * 256 + h * 64 + lane;
        float p0 = PR[o0], p1 = PR[o1], y0 = YS[o0], y1 = YS[o1];
        for (int s = 0; s < SEGLEN; s += 2) {
            wl[lane] = p0; wl[64 + lane] = p1;
            const size_t c0 = o0, c1 = o1; const float yy0 = y0, yy1 = y1;
            if (s + 2 < SEGLEN) { o0 = (size_t)chain_row(b, d, tau0 + s + 2) * 256 + h * 64 + lane; o1 = (size_t)chain_row(b, d, tau0 + s + 3) * 256 + h * 64 + lane; p0 = PR[o0]; p1 = PR[o1]; y0 = YS[o0]; y1 = YS[o1]; }
            f32x2 a0 = {0.f, 0.f}, a1 = a0, b0 = a0, b1 = a0;
#pragma unroll
            for (int q = 0; q < 16; ++q) { const f32x4 u = *(const f32x4*)(wl + 4 * q), w = *(const f32x4*)(wl + 64 + 4 * q);
                a0 += S0[2 * q] * u.lo; a1 += S0[2 * q + 1] * u.hi; b0 += S0[2 * q] * w.lo; b1 += S0[2 * q + 1] * w.hi; }
            const f32x2 ta = a0 + a1, tb = b0 + b1;
            YS[c0] = yy0 + (ta.x + ta.y); YS[c1] = yy1 + (tb.x + tb.y);
            asm volatile("" ::: "memory");
        }
    }
}
__device__ __forceinline__ void phase_m7(const Args& a, int l, int gw, int NGW, int lane) {
    unsigned char* ws = karg_ws();
    const float* Y0 = (const float*)(ws + M_YS); const float* Y1 = Y0 + (size_t)NR * 256;
    const bf16* RR = (const bf16*)(ws + M_RR); const bf16* VV = (const bf16*)(ws + M_VV); const bf16* KD0 = (const bf16*)(ws + M_KD); const bf16* KD1 = (const bf16*)(ws + M_KD + A8);
    const bf16* GC = (const bf16*)(ws + M_GC); bf16* Y = (bf16*)(ws + OFF_XMY);
    for (int r = gw; r < NR; r += NGW) {
#pragma unroll
        for (int h = 0; h < 4; ++h) { const int c = h * 64 + lane; const size_t o = (size_t)r * 256 + c;
            const float ys = Y0[o] + Y1[o];
            const float mu = wave_sum(ys) * (1.f / 64.f); const float dv = ys - mu; const float var = wave_sum(dv * dv) * (1.f / 64.f);
            float ov = dv * rsqrtf(var + 64e-5f) * IN(33)[l * 256 + c] + IN(34)[l * 256 + c];
            const float rv = bf2f(RR[o]), rk = IN(32)[l * 256 + c], vv = bf2f(VV[o]);
            const float b0 = wave_sum(rv * bf2f(KD0[o]) * rk), b1 = wave_sum(rv * bf2f(KD1[o]) * rk);
            ov += (b0 + b1) * vv;
            Y[(size_t)r * DM + 512 + c] = (bf16)f2bf(ov * bf2f(GC[o])); }
    }
}

#define LAS __attribute__((address_space(3)))
#define XB_TMO      128
#define XB_XCNT(j)  (256  + 64 * (j))
#define XB_XSUB(j)  (1280 + 64 * (j))
#define XB_XGEN(j)  (2304 + 64 * (j))
#define XB_TOP      3328
#define XB_TOPGEN   3392
#define XCD_BAR_WORDS 3456
#define XB_SPIN_CAP (1u << 18)

__device__ __forceinline__ unsigned xb_ld(unsigned* p)              { return __hip_atomic_load(p, __ATOMIC_RELAXED, __HIP_MEMORY_SCOPE_AGENT); }
__device__ __forceinline__ unsigned xb_add(unsigned* p, unsigned v) { return __hip_atomic_fetch_add(p, v, __ATOMIC_RELAXED, __HIP_MEMORY_SCOPE_AGENT); }
__device__ __forceinline__ unsigned xb_xcc_id() { return (unsigned)__builtin_amdgcn_s_getreg((3 << 11) | 20) & 0xFu; }
#define XB_SPIN(cond, bar) do { unsigned _sp = 0; while (cond) { __builtin_amdgcn_s_sleep(1); \
    if ((++_sp & 255u) == 0u) { if (xb_ld(&(bar)[XB_TMO])) break; if (_sp > XB_SPIN_CAP) { atomicAdd(&(bar)[XB_TMO], 1u); break; } } } } while (0)

struct XcdBarrier {
    unsigned* bar; unsigned x;
    volatile LAS unsigned* st;
};

__device__ __forceinline__ XcdBarrier xcd_barrier_post(unsigned* bar, volatile LAS unsigned* st) {
    XcdBarrier b; b.bar = bar; b.x = xb_xcc_id(); b.st = st;
    if (threadIdx.x == 0) (void)xb_add(&bar[XB_XCNT(b.x)], 1u);
    return b;
}
__device__ __forceinline__ void xcd_barrier_complete(unsigned* bar, unsigned x, unsigned& nloc, unsigned& nx) {
    const unsigned G = gridDim.x * gridDim.y * gridDim.z;
    unsigned sum, cnt, mine, sp = 0u;
    for (;;) {
        sum = 0u; cnt = 0u; mine = 0u;
#pragma unroll
        for (unsigned j = 0; j < 16; ++j) { const unsigned c = xb_ld(&bar[XB_XCNT(j)]); sum += c; cnt += (c > 0u) ? 1u : 0u; mine = (j == x) ? c : mine; }
        if (sum == G) break;
        __builtin_amdgcn_s_sleep(1);
        if ((++sp & 255u) == 0u) { if (xb_ld(&bar[XB_TMO])) break; if (sp > XB_SPIN_CAP) { atomicAdd(&bar[XB_TMO], 1u); break; } }
    }
    nloc = mine > 0u ? mine : 1u; nx = cnt > 0u ? cnt : 1u;
}

__device__ __forceinline__ void xcd_barrier(const XcdBarrier& b) {
    asm volatile("s_waitcnt vmcnt(0)" ::: "memory");
    __syncthreads();
    if (threadIdx.x == 0) {
        unsigned* bar = b.bar;
        __builtin_amdgcn_s_waitcnt(0);
        unsigned nloc = b.st[0], nx = b.st[1];
        if (nloc == 0u) { xcd_barrier_complete(bar, b.x, nloc, nx); b.st[0] = nloc; b.st[1] = nx; }
        const unsigned old = xb_add(&bar[XB_XSUB(b.x)], 1u);
        const unsigned gen = old / nloc;
        if (old + 1u == (gen + 1u) * nloc) {
            __builtin_amdgcn_fence(__ATOMIC_RELEASE, "agent");
            asm volatile("s_waitcnt vmcnt(0)" ::: "memory");
            const unsigned og = xb_add(&bar[XB_TOP], 1u);
            const unsigned tg = og / nx;
            if (og + 1u == (tg + 1u) * nx) xb_add(&bar[XB_TOPGEN], 1u);
            else XB_SPIN(xb_ld(&bar[XB_TOPGEN]) == tg, bar);
            __builtin_amdgcn_fence(__ATOMIC_ACQUIRE, "agent");
            xb_add(&bar[XB_XGEN(b.x)], 1u);
            asm volatile("s_waitcnt vmcnt(0)" ::: "memory");
        } else {
            XB_SPIN(xb_ld(&bar[XB_XGEN(b.x)]) == gen, bar);
            __builtin_amdgcn_fence(__ATOMIC_ACQUIRE, "agent");
            asm volatile("s_waitcnt vmcnt(0)" ::: "memory");
        }
    }
    __syncthreads();
}

__global__ void __launch_bounds__(512, 2) mega(Args a) {
    extern __shared__ __attribute__((aligned(16))) unsigned char lds[];
    cg::grid_group grid = cg::this_grid();
    const int G = gridDim.x;
    PG8_LAS unsigned char* glds = (PG8_LAS unsigned char*)lds;
#define bid lbid()
#define tid ltid()
#define lane (ltid() & 63)
#define wave (__builtin_amdgcn_readfirstlane(ltid() >> 6))
#define gw (lbid() * 8 + __builtin_amdgcn_readfirstlane(ltid() >> 6))
#define NGW (G * 8)
    { volatile LAS unsigned* st0 = (volatile LAS unsigned*)((LAS unsigned char*)lds + 131072); if (threadIdx.x < 4) st0[threadIdx.x] = 0u; }
    __syncthreads();
    const XcdBarrier xbar = xcd_barrier_post((unsigned*)(karg_ws() + 229376), (volatile LAS unsigned*)((LAS unsigned char*)lds + 131072));
#define GSYNC() do { xcd_barrier(xbar); } while (0)

    phase_modgemv(a, (float*)lds, G, bid, tid);
    phase_copy(a, G, bid, tid);
    convert_weights(a, 0, (float*)(lds + 32768) + wave * (64 * 33), gw, NGW, lane, G, bid, tid);
    grid.sync();
#pragma clang loop unroll(full)
    for (int l = 0; l < 2; ++l) {
        if (l > 0) convert_weights(a, l, (float*)lds + wave * (64 * 33), gw, NGW, lane, G, bid, tid);
        phase_modulate(a, l, 0, gw, NGW, lane);
        GSYNC();
        for (int rp = 0; rp < REP_G1; ++rp)
        {
            unsigned char* ws = karg_ws(); float* outp = karg_out(); float* xctx = (float*)(ws + OFF_XCTX); bf16* XM = (bf16*)(ws + OFF_XMY); bf16* HU = (bf16*)(ws + OFF_HU); const float* modl = (const float*)(ws + OFF_MOD) + (size_t)l * 3 * 9216; (void)xctx; (void)XM; (void)HU; (void)modl; (void)outp;
            pg8::Gemm g{XM, (const bf16*)(ws + W_13A), NR, 2 * DFF, DM}; pg8::StaticOrder S; S.init(NR, 2 * DFF, G, bid);
            EpiSwiglu E{HU};
            pg8::gemm_phase<EpiSwiglu, pg8::StaticOrder, true, true>(glds, g, S, E);
        }
        GSYNC();
        {
            unsigned char* ws = karg_ws(); float* outp = karg_out(); float* xctx = (float*)(ws + OFF_XCTX); bf16* XM = (bf16*)(ws + OFF_XMY); bf16* HU = (bf16*)(ws + OFF_HU); const float* modl = (const float*)(ws + OFF_MOD) + (size_t)l * 3 * 9216; (void)xctx; (void)XM; (void)HU; (void)modl; (void)outp;
            pg8::Gemm g{HU, (const bf16*)(ws + W_2A), NR, DM, DFF}; pg8::StaticOrder S; S.init(NR, DM, G, bid);
            EpiResid E{outp, xctx, modl + 2 * 1024, 0.5f};
            pg8::gemm_phase<EpiResid, pg8::StaticOrder, true, true>(glds, g, S, E);
        }
        GSYNC();
        phase_modulate(a, l, 1, gw, NGW, lane);
        GSYNC();
        {
            unsigned char* ws = karg_ws(); float* outp = karg_out(); float* xctx = (float*)(ws + OFF_XCTX); bf16* XM = (bf16*)(ws + OFF_XMY); bf16* HU = (bf16*)(ws + OFF_HU); const float* modl = (const float*)(ws + OFF_MOD) + (size_t)l * 3 * 9216; (void)xctx; (void)XM; (void)HU; (void)modl; (void)outp;
            pg8::Gemm g{XM, (const bf16*)(ws + W_IN), NR, UC, DM}; pg8::StaticOrder S; S.init(NR, UC, G, bid);
            EpiU E{HU, UC};
            pg8::gemm_phase<EpiU, pg8::StaticOrder, true, true>(glds, g, S, E);
        }
        GSYNC();
        for (int rp = 0; rp < REP_M1; ++rp) { phase_m1(a, l, lds, G, bid, tid);
        GSYNC(); }
        for (int rp = 0; rp < REP_M2; ++rp) { phase_m2(a, l, lds, G, bid, tid);
        GSYNC(); }
        for (int rp = 0; rp < REP_M3; ++rp) { phase_m3(a, l, lds, G, bid, tid);
        GSYNC(); }
        for (int rp = 0; rp < REP_SCAN; ++rp) { phase_m4(a, lds, G, bid, tid);
        GSYNC();
        phase_m5(a, lds, G, bid, tid);
        GSYNC();
        phase_m6(a, lds, G, bid, tid);
        GSYNC(); }
        phase_m7(a, l, gw, NGW, lane);
        GSYNC();
        {
            unsigned char* ws = karg_ws(); float* outp = karg_out(); float* xctx = (float*)(ws + OFF_XCTX); bf16* XM = (bf16*)(ws + OFF_XMY); bf16* HU = (bf16*)(ws + OFF_HU); const float* modl = (const float*)(ws + OFF_MOD) + (size_t)l * 3 * 9216; (void)xctx; (void)XM; (void)HU; (void)modl; (void)outp;
            pg8::Gemm g{XM, (const bf16*)(ws + W_OUT), NR, DM, DM}; pg8::StaticOrder S; S.init(NR, DM, G, bid);
            EpiResid E{outp, xctx, modl + 5 * 1024, 1.0f};
            pg8::gemm_phase<EpiResid, pg8::StaticOrder, true, true>(glds, g, S, E);
        }
        GSYNC();
        phase_modulate(a, l, 2, gw, NGW, lane);
        GSYNC();
        {
            unsigned char* ws = karg_ws(); float* outp = karg_out(); float* xctx = (float*)(ws + OFF_XCTX); bf16* XM = (bf16*)(ws + OFF_XMY); bf16* HU = (bf16*)(ws + OFF_HU); const float* modl = (const float*)(ws + OFF_MOD) + (size_t)l * 3 * 9216; (void)xctx; (void)XM; (void)HU; (void)modl; (void)outp;
            pg8::Gemm g{XM, (const bf16*)(ws + W_13B), NR, 2 * DFF, DM}; pg8::StaticOrder S; S.init(NR, 2 * DFF, G, bid);
            EpiSwiglu E{HU};
            pg8::gemm_phase<EpiSwiglu, pg8::StaticOrder, true, true>(glds, g, S, E);
        }
        GSYNC();
        {
            unsigned char* ws = karg_ws(); float* outp = karg_out(); float* xctx = (float*)(ws + OFF_XCTX); bf16* XM = (bf16*)(ws + OFF_XMY); bf16* HU = (bf16*)(ws + OFF_HU); const float* modl = (const float*)(ws + OFF_MOD) + (size_t)l * 3 * 9216; (void)xctx; (void)XM; (void)HU; (void)modl; (void)outp;
            pg8::Gemm g{HU, (const bf16*)(ws + W_2B), NR, DM, DFF}; pg8::StaticOrder S; S.init(NR, DM, G, bid);
            EpiResid E{outp, xctx, modl + 8 * 1024, 0.5f};
            pg8::gemm_phase<EpiResid, pg8::StaticOrder, true, true>(glds, g, S, E);
        }
        GSYNC();
    }
    phase_final(a, gw, NGW, lane);
#undef bid
#undef tid
#undef lane
#undef wave
#undef gw
#undef NGW
}

extern "C" void kernel_launch(void* const* d_in, const int* in_sizes, int n_in, void* d_out, int out_size, void* d_ws, size_t ws_size, hipStream_t stream) {
    static int grid = 0;
    if (grid == 0) {
        int dev = 0, cus = 0, per_cu = 0;
        (void)hipGetDevice(&dev);
        (void)hipDeviceGetAttribute(&cus, hipDeviceAttributeMultiprocessorCount, dev);
        (void)hipFuncSetAttribute((const void*)mega, hipFuncAttributeMaxDynamicSharedMemorySize, LDS_BYTES);
        (void)hipOccupancyMaxActiveBlocksPerMultiprocessor(&per_cu, (const void*)mega, 512, LDS_BYTES);
        if (per_cu < 1) per_cu = 1;
        grid = cus * per_cu;
        if (n_in != 40 || ws_size < WS_NEED) { fprintf(stderr, "kernel_launch: unexpected n_in %d / ws %zu (need %zu)\n", n_in, ws_size, (size_t)WS_NEED); }
    }
    (void)hipMemsetAsync((char*)d_ws + OFF_MOD, 0, MOD_BYTES, stream);
    Args a{};
    for (int i = 0; i < 40; ++i) a.in[i] = (const float*)d_in[i];
    a.out = (float*)d_out; a.ws = (unsigned char*)d_ws;
    void* args[] = {&a};
    hipError_t e = hipLaunchCooperativeKernel((const void*)mega, dim3(grid), dim3(512), args, LDS_BYTES, stream);
    if (e != hipSuccess) fprintf(stderr, "cooperative launch failed: %s (grid %d)\n", hipGetErrorString(e), grid);
}
```

```cpp
#include <hip/hip_runtime.h>
#include <hip/hip_cooperative_groups.h>
#include <cstdio>
#include <cstdint>
namespace cg = cooperative_groups;
namespace pg8 {
#define PG8_LAS __attribute__((address_space(3)))
typedef unsigned short bf16_t;
typedef short bf16x8 __attribute__((ext_vector_type(8)));
typedef float f32x4 __attribute__((ext_vector_type(4)));
typedef unsigned u32x4 __attribute__((ext_vector_type(4)));
constexpr int BM = 256, BK = 64, HALF = 128, HTB = HALF * BK * 2  , STAGE_BYTES = 8 * HTB, NXCD = 8, WGM = 8;

__host__ __device__ __forceinline__ int lds_byte(int r, int c) { const int st = (r >> 4) * 2 + (c >> 5), rr = r & 15, cc = c & 31, ob = rr * 64 + cc * 2; return st * 1024 + (ob ^ (((ob >> 9) & 1) << 5)); }
__host__ __device__ __forceinline__ void stage_rc(int b, int& R, int& C) { const int st = b / 1024, sb = b % 1024, swz = sb ^ (((sb >> 9) & 1) << 5); R = (st >> 1) * 16 + swz / 64; C = (st & 1) * 32 + (swz % 64) / 2; }
__host__ __device__ __forceinline__ int perm32(int rho) { const int n = rho >> 4, i = rho & 15; return 8 * (i >> 2) + 4 * n + (i & 3); }

struct Unit { int pm, pn; };
struct Gemm { const bf16_t* A; const bf16_t* Bt; int M, N, K; };

struct StaticOrder {
    int nM, nN, nwg, G, c;
    __host__ __device__ void init(int M, int N, int G_, int c_) { nM = M / BM; nN = N / BM; nwg = nM * nN; G = G_; c = c_; }
    __host__ __device__ bool next(int i, Unit& u) const {
        const long L = (long)i * G + c; if (L >= nwg) return false;
        int wgid = (int)L; { const int q = nwg / NXCD, r = nwg % NXCD, xcd = wgid % NXCD, off = wgid / NXCD; wgid = (xcd < r ? xcd * (q + 1) : r * (q + 1) + (xcd - r) * q) + off; }
        const int nig = WGM * nN, gid = wgid / nig, fm = gid * WGM, gsz = (nM - fm) < WGM ? (nM - fm) : WGM;
        u.pm = fm + ((wgid % nig) % gsz); u.pn = (wgid % nig) / gsz; return true;
    }
    __device__ __forceinline__ void a_ready(const Unit&) const {}
    __device__ __forceinline__ void done(const Unit&) const {}
};

__device__ __forceinline__ unsigned cvt_pk_bf16(float lo, float hi) { unsigned r; asm volatile("v_cvt_pk_bf16_f32 %0, %1, %2" : "=v"(r) : "v"(lo), "v"(hi)); return r; }
typedef float f32x2 __attribute__((ext_vector_type(2)));
template <class Epi, class Sched, bool ALIGN_EPI = false, bool SP2 = false>
__device__ __forceinline__ void gemm_phase(PG8_LAS unsigned char* lds, const Gemm g, const Sched& S, const Epi& E) {
    int tid = threadIdx.x; asm volatile("" : "+v"(tid));
    const int wid = __builtin_amdgcn_readfirstlane(tid >> 6), lane = tid & 63, wr = wid >> 2, wc = wid & 3, fr = lane & 15, fq = lane >> 4;
    const int K = g.K, nt = K / BK;
    unsigned voffA[2], voffB[2];
#pragma unroll
    for (int i = 0; i < 2; ++i) { int R, C; stage_rc(tid * 16 + i * 8192, R, C); const int Rb = Epi::PERM ? ((R & ~31) + perm32(R & 31)) : R;
        voffA[i] = (unsigned)(R * K + C) * 2u; voffB[i] = (unsigned)(Rb * K + C) * 2u; }
    const size_t kstep = (size_t)(BK * 2);
    const size_t hstep = (size_t)HALF * K * 2;
    const size_t tstep = 2 * hstep;
    const unsigned ldsw = (unsigned)wid * 1024u;
    const int aoff = lds_byte(wr * 64 + fr, fq * 8), boff = lds_byte(wc * 32 + fr, fq * 8);
#define PG8_SA(b, h) (((b) * 2 + (h)) * HTB)
#define PG8_SB(b, h) ((4 + (b) * 2 + (h)) * HTB)
#define PG8_STAGE(bufoff, gbase, voff) do { _Pragma("unroll") for (int _i = 0; _i < 2; ++_i) \
        __builtin_amdgcn_global_load_lds((const unsigned*)((const char*)(gbase) + (voff)[_i]), (PG8_LAS unsigned*)(lds + (bufoff) + ldsw + _i * 8192), 16, 0, 0); } while (0)
#define PG8_LDA(dst, b, h) do { _Pragma("unroll") for (int m = 0; m < 4; ++m) _Pragma("unroll") for (int k = 0; k < 2; ++k) dst[m][k] = *(const PG8_LAS bf16x8*)(lds + PG8_SA(b, h) + aoff + m * 2048 + k * 1024); } while (0)
#define PG8_LDB(dst, b, h) do { _Pragma("unroll") for (int n = 0; n < 2; ++n) _Pragma("unroll") for (int k = 0; k < 2; ++k) dst[n][k] = *(const PG8_LAS bf16x8*)(lds + PG8_SB(b, h) + boff + n * 2048 + k * 1024); } while (0)
#define PG8_MMA(ai, bj, At, Bt) do { __builtin_amdgcn_s_setprio(1); _Pragma("unroll") for (int m = 0; m < 4; ++m) _Pragma("unroll") for (int n = 0; n < 2; ++n) _Pragma("unroll") for (int k = 0; k < 2; ++k) \
        acc[ai][bj][m][n] = __builtin_amdgcn_mfma_f32_16x16x32_bf16(Bt[n][k], At[m][k], acc[ai][bj][m][n], 0, 0, 0); __builtin_amdgcn_s_setprio(0); } while (0)
#define PG8_WAIT_V(n) asm volatile("s_waitcnt vmcnt(" #n ")" ::: "memory")
#define PG8_WAIT_L(n) asm volatile("s_waitcnt lgkmcnt(" #n ")" ::: "memory")
#define PG8_BAR __builtin_amdgcn_s_barrier()
#define PG8_SCHED __builtin_amdgcn_sched_barrier(0)
    Unit cur, nxt; int ui = 0;
    if (!S.next(0, cur)) return;
    f32x4 acc[2][2][4][2];
#pragma unroll
    for (int a = 0; a < 2; ++a)
#pragma unroll
        for (int b = 0; b < 2; ++b)
#pragma unroll
            for (int m = 0; m < 4; ++m)
#pragma unroll
                for (int n = 0; n < 2; ++n) acc[a][b][m][n] = (f32x4){0.f, 0.f, 0.f, 0.f};
    bf16x8 At[4][2], B0[2][2], B1[2][2];
    const char* cA = (const char*)g.A + (size_t)cur.pm * tstep; const char* cB = (const char*)g.Bt + (size_t)cur.pn * tstep;
    S.a_ready(cur);
    if constexpr (SP2) {
        PG8_STAGE(PG8_SB(0, 0), cB, voffB); PG8_STAGE(PG8_SB(0, 1), cB + hstep, voffB); PG8_STAGE(PG8_SA(0, 0), cA, voffA); PG8_STAGE(PG8_SA(0, 1), cA + hstep, voffA);
        if (wr == 1) PG8_BAR;
        PG8_WAIT_V(2); PG8_BAR;
        PG8_STAGE(PG8_SB(1, 0), cB + kstep, voffB); PG8_STAGE(PG8_SA(1, 0), cA + kstep, voffA); PG8_STAGE(PG8_SB(1, 1), cB + hstep + kstep, voffB);
        PG8_WAIT_V(6); PG8_BAR;
    } else {
        PG8_STAGE(PG8_SB(0, 0), cB, voffB); PG8_STAGE(PG8_SA(0, 0), cA, voffA); PG8_STAGE(PG8_SB(0, 1), cB + hstep, voffB); PG8_STAGE(PG8_SA(0, 1), cA + hstep, voffA);
        if (wr == 1) PG8_BAR;
        PG8_WAIT_V(4); PG8_BAR;
        PG8_STAGE(PG8_SB(1, 0), cB + kstep, voffB); PG8_STAGE(PG8_SA(1, 0), cA + kstep, voffA); PG8_STAGE(PG8_SB(1, 1), cB + hstep + kstep, voffB);
        PG8_WAIT_V(6); PG8_BAR;
    }
    for (;;) {
        const bool has_next = S.next(ui + 1, nxt);
        const char* nA = has_next ? (const char*)g.A + (size_t)nxt.pm * tstep : cA; const char* nB = has_next ? (const char*)g.Bt + (size_t)nxt.pn * tstep : cB;
        for (int t = 0; t < nt; t += 2) {
            const bool last = (t == nt - 2);
            const char* a1 = cA + (size_t)(t + 1) * kstep;
            const char* a2 = last ? nA : cA + (size_t)(t + 2) * kstep; const char* b2 = last ? nB : cB + (size_t)(t + 2) * kstep;
            const char* a3 = a2 + kstep; const char* b3 = b2 + kstep;
            if (last && has_next) S.a_ready(nxt);
            if constexpr (SP2) {
            PG8_LDB(B0, 0, 0); PG8_LDB(B1, 0, 1); PG8_SCHED; PG8_LDA(At, 0, 0); PG8_STAGE(PG8_SA(1, 1), a1 + hstep, voffA);
            PG8_WAIT_V(8); PG8_WAIT_L(0); PG8_BAR; PG8_MMA(0, 0, At, B0); PG8_MMA(0, 1, At, B1); PG8_BAR; PG8_SCHED;
            PG8_LDA(At, 0, 1); PG8_STAGE(PG8_SB(0, 0), b2, voffB); PG8_STAGE(PG8_SB(0, 1), b2 + hstep, voffB); PG8_STAGE(PG8_SA(0, 0), a2, voffA);
            PG8_WAIT_V(8); PG8_WAIT_L(0); PG8_BAR; PG8_MMA(1, 0, At, B0); PG8_MMA(1, 1, At, B1); PG8_BAR; PG8_SCHED;
            PG8_LDB(B0, 1, 0); PG8_LDB(B1, 1, 1); PG8_SCHED; PG8_LDA(At, 1, 0); PG8_STAGE(PG8_SA(0, 1), a2 + hstep, voffA);
            PG8_WAIT_V(8); PG8_WAIT_L(0); PG8_BAR; PG8_MMA(0, 0, At, B0); PG8_MMA(0, 1, At, B1); PG8_BAR; PG8_SCHED;
            PG8_LDA(At, 1, 1); PG8_STAGE(PG8_SB(1, 0), b3, voffB); PG8_STAGE(PG8_SB(1, 1), b3 + hstep, voffB); PG8_STAGE(PG8_SA(1, 0), a3, voffA);
            PG8_WAIT_V(8); PG8_WAIT_L(0); PG8_BAR; PG8_MMA(1, 0, At, B0); PG8_MMA(1, 1, At, B1); PG8_BAR; PG8_SCHED;
            } else {
            PG8_LDB(B0, 0, 0); PG8_SCHED; PG8_LDA(At, 0, 0); PG8_STAGE(PG8_SA(1, 1), a1 + hstep, voffA);
            PG8_WAIT_L(8); PG8_BAR; PG8_WAIT_L(0); PG8_MMA(0, 0, At, B0); PG8_BAR; PG8_SCHED;
            PG8_LDB(B1, 0, 1); PG8_STAGE(PG8_SB(0, 0), b2, voffB);
            PG8_BAR; PG8_WAIT_L(0); PG8_MMA(0, 1, At, B1); PG8_BAR;
            PG8_LDA(At, 0, 1); PG8_STAGE(PG8_SA(0, 0), a2, voffA);
            PG8_BAR; PG8_WAIT_L(0); PG8_MMA(1, 0, At, B0); PG8_BAR; PG8_SCHED;
            PG8_STAGE(PG8_SB(0, 1), b2 + hstep, voffB);
            PG8_WAIT_V(6); PG8_BAR; PG8_MMA(1, 1, At, B1); PG8_BAR;
            PG8_LDB(B0, 1, 0); PG8_SCHED; PG8_LDA(At, 1, 0); PG8_STAGE(PG8_SA(0, 1), a2 + hstep, voffA);
            PG8_WAIT_L(8); PG8_BAR; PG8_WAIT_L(0); PG8_MMA(0, 0, At, B0); PG8_BAR; PG8_SCHED;
            PG8_LDB(B1, 1, 1); PG8_STAGE(PG8_SB(1, 0), b3, voffB);
            PG8_BAR; PG8_WAIT_L(0); PG8_MMA(0, 1, At, B1); PG8_BAR;
            PG8_LDA(At, 1, 1); PG8_STAGE(PG8_SA(1, 0), a3, voffA);
            PG8_BAR; PG8_WAIT_L(0); PG8_MMA(1, 0, At, B0); PG8_BAR; PG8_SCHED;
            PG8_STAGE(PG8_SB(1, 1), b3 + hstep, voffB);
            PG8_WAIT_V(6); PG8_BAR; PG8_MMA(1, 1, At, B1); PG8_BAR;
            }
        }
        if constexpr (ALIGN_EPI) { if (wr == 0) PG8_BAR; }
        if constexpr (!Epi::AFTER_DRAIN) { E(acc, cur, wr, wc, fr, fq); S.done(cur); }
        if (!has_next) break;
#pragma unroll
        for (int a = 0; a < 2; ++a)
#pragma unroll
            for (int b = 0; b < 2; ++b)
#pragma unroll
                for (int m = 0; m < 4; ++m)
#pragma unroll
                    for (int n = 0; n < 2; ++n) acc[a][b][m][n] = (f32x4){0.f, 0.f, 0.f, 0.f};
        cur = nxt; cA = nA; cB = nB; ++ui;
        if constexpr (ALIGN_EPI) { if (wr == 1) PG8_BAR; }
    }
    PG8_WAIT_V(0);
    if constexpr (!ALIGN_EPI) { if (wr == 0) PG8_BAR; }
    PG8_BAR;
    if constexpr (Epi::AFTER_DRAIN) { E.fused(acc, cur, wr, wc, fr, fq, lds, wid, lane); S.done(cur); }
#undef PG8_SA
#undef PG8_SB
#undef PG8_STAGE
#undef PG8_LDA
#undef PG8_LDB
#undef PG8_MMA
#undef PG8_WAIT_V
#undef PG8_WAIT_L
#undef PG8_BAR
#undef PG8_SCHED
}
}

using pg8::f32x4; using pg8::bf16x8;
typedef unsigned short bf16;
typedef unsigned v4u __attribute__((ext_vector_type(4)));
typedef unsigned v2u __attribute__((ext_vector_type(2)));
typedef short s16x4 __attribute__((ext_vector_type(4)));

constexpr int DM = 1024, TLEN = 8192, CTXL = 256, TT = 8448, NLAT = 16384, NR = 16896, DFF = 2816, UC = 2560, NTILE = 528;
constexpr int NSEG = 64, SEGLEN = 132;
constexpr size_t MiB = 1u << 20;
constexpr size_t A8 = (size_t)NR * 256 * 2;
constexpr size_t OFF_MOD = 0, MOD_BYTES = 256 * 1024;
constexpr size_t OFF_XCTX = MiB / 4, OFF_XMY = 2 * MiB + MiB / 4, OFF_HU = 35 * MiB + MiB / 4, OFF_W = 126 * MiB, OFF_MIX = 167 * MiB, OFF_PR = 266 * MiB;
constexpr size_t W_13A = OFF_W, W_2A = OFF_W + 11 * MiB, W_13B = OFF_W + 16 * MiB + MiB / 2, W_2B = OFF_W + 27 * MiB + MiB / 2,
                 W_IN = OFF_W + 33 * MiB, W_OUT = OFF_W + 38 * MiB, W_UQ = OFF_W + 40 * MiB, W_UKV = OFF_W + 40 * MiB + 256 * 1024,
                 W_WUP = OFF_W + 40 * MiB + 384 * 1024, W_AUP = W_WUP + 65536, W_GUP = W_AUP + 65536, W_LWA = W_GUP + 65536, W_LWX = W_LWA + 65536;
constexpr size_t M_QB = OFF_MIX, M_KB = OFF_MIX + 12976128, M_VT = OFF_MIX + 25952256;
constexpr size_t M_LR0 = OFF_PR, M_LIX0 = OFF_PR + 2 * A8;
constexpr size_t M_SEGA = OFF_HU + 83 * MiB, M_SEGB = M_SEGA + MiB + MiB / 4, M_H0 = M_SEGB + MiB + MiB / 4;
constexpr size_t M_RR = OFF_MIX, M_KK = OFF_MIX + A8, M_VV = OFF_MIX + 2 * A8, M_WW = OFF_MIX + 3 * A8, M_BB = OFF_MIX + 7 * A8, M_KD = OFF_MIX + 9 * A8, M_GC = OFF_MIX + 11 * A8;
constexpr size_t M_YS = OFF_HU, M_PL = OFF_HU + 33 * MiB, M_SINIT = OFF_HU + 65 * MiB;
constexpr size_t M_PR = OFF_PR;
constexpr size_t WS_NEED = OFF_PR + 33 * MiB;
constexpr int LDS_BYTES = 131072 + 1024;
#ifndef REP_M1
#define REP_M1 1
#endif
#ifndef REP_M2
#define REP_M2 1
#endif
#ifndef REP_M3
#define REP_M3 1
#endif
#ifndef REP_SCAN
#define REP_SCAN 1
#endif
#ifndef REP_G1
#define REP_G1 1
#endif
constexpr float QSCALE = 0.10206207261596575f * 1.4426950408889634f;

struct Args { const float* in[40]; float* out; unsigned char* ws; };
typedef const __attribute__((address_space(4))) volatile unsigned long long kargq;
__device__ __forceinline__ const float* karg_in(int i) { kargq* p = (kargq*)__builtin_amdgcn_kernarg_segment_ptr(); return (const float*)p[i]; }
__device__ __forceinline__ float* karg_out() { kargq* p = (kargq*)__builtin_amdgcn_kernarg_segment_ptr(); return (float*)p[40]; }
__device__ __forceinline__ unsigned char* karg_ws() { kargq* p = (kargq*)__builtin_amdgcn_kernarg_segment_ptr(); return (unsigned char*)p[41]; }
#define IN(i) karg_in(i)
__device__ __forceinline__ int ltid() { int t = threadIdx.x; asm volatile("" : "+v"(t)); return t; }
__device__ __forceinline__ int lbid() { int t = blockIdx.x; asm volatile("" : "+s"(t)); return t; }
template <class T> __device__ __forceinline__ T* launder(T* p) { asm volatile("" : "+s"(p)); return p; }

__device__ __forceinline__ float bf2f(bf16 h) { return __uint_as_float((unsigned)h << 16); }
__device__ __forceinline__ unsigned f2bf(float f) { unsigned u = __float_as_uint(f); return (u + 0x7fffu + ((u >> 16) & 1u)) >> 16; }
__device__ __forceinline__ unsigned pk2(float lo, float hi) { return f2bf(lo) | (f2bf(hi) << 16); }
__device__ __forceinline__ float sigm(float x) { return 1.f / (1.f + __expf(-x)); }
__device__ __forceinline__ float siluf_(float x) { return x / (1.f + __expf(-x)); }
__device__ __forceinline__ float tanhf_(float y) { return 1.f - 2.f / (1.f + __expf(2.f * y)); }
__device__ __forceinline__ float geluf_(float x) { return 0.5f * x * (1.f + tanhf_(0.7978845608028654f * (x + 0.044715f * x * x * x))); }
__device__ __forceinline__ float wave_sum(float v) {
#pragma unroll
    for (int o = 1; o < 64; o <<= 1) v += __shfl_xor(v, o);
    return v;
}
struct TileInfo { int b, isctx, t0, seqbase, seqlen; };
__device__ __forceinline__ TileInfo tile_info(int tile) {
    TileInfo ti;
    if (tile < 512) { ti.b = tile >> 8; ti.isctx = 0; ti.t0 = (tile & 255) * 32; ti.seqbase = ti.b * TLEN; ti.seqlen = TLEN; }
    else { const int q = tile - 512; ti.b = q >> 3; ti.isctx = 1; ti.t0 = (q & 7) * 32; ti.seqbase = NLAT + ti.b * CTXL; ti.seqlen = CTXL; }
    return ti;
}

struct EpiSwiglu {
    static constexpr bool PERM = true, AFTER_DRAIN = false;
    bf16* H;
    __device__ __forceinline__ void operator()(const f32x4 (&acc)[2][2][4][2], const pg8::Unit& u, int wr, int wc, int fr, int fq) const {
        int pm = u.pm, pn = u.pn; asm volatile("" : "+s"(pm), "+s"(pn), "+s"(wr), "+s"(wc), "+v"(fr), "+v"(fq));
        bf16* tb = H + (size_t)pm * 256 * DFF + pn * 128;
        const unsigned loff = (unsigned)((wr * 64 + fr) * DFF + wc * 32 + 8 * fq);
#pragma unroll
        for (int ai = 0; ai < 2; ++ai)
#pragma unroll
            for (int m = 0; m < 4; ++m) {
                bf16* rowp = tb + (loff + (unsigned)((ai * 128 + m * 16) * DFF));
                const f32x4 g0 = acc[ai][0][m][0], g1 = acc[ai][0][m][1], u0 = acc[ai][1][m][0], u1 = acc[ai][1][m][1];
                v4u w;
                w.x = pg8::cvt_pk_bf16(siluf_(g0[0]) * u0[0], siluf_(g0[1]) * u0[1]); w.y = pg8::cvt_pk_bf16(siluf_(g0[2]) * u0[2], siluf_(g0[3]) * u0[3]);
                w.z = pg8::cvt_pk_bf16(siluf_(g1[0]) * u1[0], siluf_(g1[1]) * u1[1]); w.w = pg8::cvt_pk_bf16(siluf_(g1[2]) * u1[2], siluf_(g1[3]) * u1[3]);
                *(v4u*)rowp = w;
            }
    }
};
struct EpiU {
    static constexpr bool PERM = true, AFTER_DRAIN = false;
    bf16* O; int ldc;
    __device__ __forceinline__ void operator()(const f32x4 (&acc)[2][2][4][2], const pg8::Unit& u, int wr, int wc, int fr, int fq) const {
        int pm = u.pm, pn = u.pn; asm volatile("" : "+s"(pm), "+s"(pn), "+s"(wr), "+s"(wc), "+v"(fr), "+v"(fq));
        bf16* tb = O + (size_t)pm * 256 * ldc + pn * 256;
        const unsigned loff = (unsigned)((wr * 64 + fr) * ldc + wc * 32 + 8 * fq);
#pragma unroll
        for (int ai = 0; ai < 2; ++ai)
#pragma unroll
            for (int m = 0; m < 4; ++m) {
                bf16* rowp = tb + (loff + (unsigned)((ai * 128 + m * 16) * ldc));
#pragma unroll
                for (int bj = 0; bj < 2; ++bj) { const f32x4 v0 = acc[ai][bj][m][0], v1 = acc[ai][bj][m][1]; v4u w;
                    w.x = pg8::cvt_pk_bf16(v0[0], v0[1]); w.y = pg8::cvt_pk_bf16(v0[2], v0[3]); w.z = pg8::cvt_pk_bf16(v1[0], v1[1]); w.w = pg8::cvt_pk_bf16(v1[2], v1[3]);
                    *(v4u*)(rowp + bj * 128) = w; }
            }
    }
};
struct EpiResid {
    static constexpr bool PERM = false, AFTER_DRAIN = false;
    float* xlat; float* xctx; const float* gate; float coef; const float* slat; const float* sctx;
    __device__ __forceinline__ void operator()(const f32x4 (&acc)[2][2][4][2], const pg8::Unit& u, int wr, int wc, int fr, int fq) const {
        int pm = u.pm, pn = u.pn; asm volatile("" : "+s"(pm), "+s"(pn), "+s"(wr), "+s"(wc), "+v"(fr), "+v"(fq));
        const size_t toff = (pm < 64 ? (size_t)pm : (size_t)(pm - 64)) * 256 * DM + pn * 256;
        float* tb = (pm < 64 ? xlat : xctx) + toff; const float* sb = (pm < 64 ? slat : sctx) + toff;
        const float* g = gate + (pm < 64 ? (pm >> 5) : 2) * 9216 + pn * 256;
        const unsigned coff = (unsigned)(wc * 32 + 4 * fq), loff = (unsigned)((wr * 64 + fr) * DM) + coff;
        f32x4 gv[2][2];
#pragma unroll
        for (int bj = 0; bj < 2; ++bj)
#pragma unroll
            for (int n = 0; n < 2; ++n) gv[bj][n] = coef * *(const f32x4*)(g + (coff + (unsigned)(bj * 128 + n * 16)));
#pragma unroll
        for (int ai = 0; ai < 2; ++ai)
#pragma unroll
            for (int m = 0; m < 4; ++m) {
                float* xr = tb + (loff + (unsigned)((ai * 128 + m * 16) * DM)); const float* sr = sb + (loff + (unsigned)((ai * 128 + m * 16) * DM));
#pragma unroll
                for (int bj = 0; bj < 2; ++bj)
#pragma unroll
                    for (int n = 0; n < 2; ++n) { float* xp = xr + (bj * 128 + n * 16);
                        f32x4 xv = *(const f32x4*)(sr + (bj * 128 + n * 16)); xv += gv[bj][n] * acc[ai][bj][m][n]; *(f32x4*)xp = xv; }
                asm volatile("" ::: "memory");
            }
    }
};

__device__ __forceinline__ void phase_modgemv(const Args& a, float* red, int G, int bid, int tid) {
    const float* c = IN(1); const float* cctx = IN(3); const float* ada_w = IN(4); const float* ada_b = IN(5);
    float* mod = (float*)(karg_ws() + OFF_MOD);
    const int w = tid >> 6, lane = tid & 63;
    for (int u = bid; u < 576; u += G) {
        const int l = u / 288, rem = u % 288, jt = rem >> 3, ks = rem & 7;
        const int kb = ks * 128 + w * 16, j0 = jt * 256 + lane * 4;
        f32x4 acc0 = {0.f, 0.f, 0.f, 0.f}, acc1 = acc0, acc2 = acc0;
        for (int kk = 0; kk < 16; ++kk) { const int k = kb + kk;
            const float s0 = siluf_(c[k]), s1 = siluf_(c[1024 + k]), s2 = siluf_(cctx[k]);
            const f32x4 wv = *(const f32x4*)(ada_w + ((size_t)(l * 1024 + k)) * 9216 + j0);
            acc0 += s0 * wv; acc1 += s1 * wv; acc2 += s2 * wv; }
        float* rp = red + (w * 3) * 256 + lane * 4;
        *(f32x4*)rp = acc0; *(f32x4*)(rp + 256) = acc1; *(f32x4*)(rp + 512) = acc2;
        __syncthreads();
        for (int o = tid; o < 768; o += 512) { const int m = o >> 8, jj = o & 255; float s = 0.f;
#pragma unroll
            for (int ww = 0; ww < 8; ++ww) s += red[(ww * 3 + m) * 256 + jj];
            const int j = jt * 256 + jj; if (ks == 0) s += ada_b[l * 9216 + j];
            atomicAdd(&mod[(l * 3 + m) * 9216 + j], s); }
        __syncthreads();
    }
}
__device__ __forceinline__ void phase_copy(const Args& a, int G, int bid, int tid) {
    const f32x4* x4 = (const f32x4*)IN(0); f32x4* o4 = (f32x4*)karg_out();
    for (int i = bid * 512 + tid; i < NLAT * DM / 4; i += G * 512) o4[i] = x4[i];
    const f32x4* c4 = (const f32x4*)IN(2); f32x4* xc4 = (f32x4*)(karg_ws() + OFF_XCTX);
    for (int i = bid * 512 + tid; i < 512 * DM / 4; i += G * 512) xc4[i] = c4[i];
}
__device__ __forceinline__ int swiglu_map(int n) { return n < DFF ? ((n >> 7) * 256 + (n & 127)) : ((((n - DFF) >> 7) * 256) + 128 + ((n - DFF) & 127)); }
__device__ __forceinline__ void transpose_item(const float* W, int K, int N, bf16* WT, float* scr, int item, int lane, int mode, const float* kscale) {
    const int nblk = N / 32, kb = item / nblk, nb = item % nblk, k0 = 64 * kb, n0 = 32 * nb;
#pragma unroll 8
    for (int i = 0; i < 32; ++i) { const int kk = 2 * i + (lane >> 5); float v = W[(size_t)(k0 + kk) * N + n0 + (lane & 31)]; if (kscale) v *= kscale[k0 + kk]; scr[kk * 33 + (lane & 31)] = v; }
    __builtin_amdgcn_wave_barrier();
    const int c = lane & 7;
#pragma unroll
    for (int j = 0; j < 4; ++j) { const int n = (lane >> 3) + 8 * j; const float* s = scr + (8 * c) * 33 + n;
        v4u o; o.x = pk2(s[0 * 33], s[1 * 33]); o.y = pk2(s[2 * 33], s[3 * 33]); o.z = pk2(s[4 * 33], s[5 * 33]); o.w = pk2(s[6 * 33], s[7 * 33]);
        const int nn = n0 + n, drow = mode ? swiglu_map(nn) : nn;
        *(v4u*)(WT + (size_t)drow * K + k0 + 8 * c) = o; }
    __builtin_amdgcn_wave_barrier();
}
__device__ __forceinline__ void convert_weights(const Args& a, int l, float* scr, int gw, int NGW, int lane, int G, int bid, int tid) {
    constexpr int I13 = 16 * 176, I2 = 44 * 32, IIN = 16 * 77, IOUT = 16 * 32, IUQ = 4 * 12, IUKV = 2 * 16;
    constexpr int IEX = 80;
    constexpr int NIT = 2 * I13 + 2 * I2 + IIN + IOUT + IUQ + IUKV + IEX;
    unsigned char* ws = karg_ws();
    for (int it = gw; it < NIT; it += NGW) {
        int r = it;
        if (r < I13) { transpose_item(IN(6) + (size_t)l * DM * 2 * DFF, DM, 2 * DFF, (bf16*)(ws + W_13A), scr, r, lane, 1, nullptr); continue; } r -= I13;
        if (r < I13) { transpose_item(IN(8) + (size_t)l * DM * 2 * DFF, DM, 2 * DFF, (bf16*)(ws + W_13B), scr, r, lane, 1, nullptr); continue; } r -= I13;
        if (r < I2) { transpose_item(IN(7) + (size_t)l * DFF * DM, DFF, DM, (bf16*)(ws + W_2A), scr, r, lane, 0, nullptr); continue; } r -= I2;
        if (r < I2) { transpose_item(IN(9) + (size_t)l * DFF * DM, DFF, DM, (bf16*)(ws + W_2B), scr, r, lane, 0, nullptr); continue; } r -= I2;
        if (r < IIN) { transpose_item(IN(10) + (size_t)l * DM * 2464, DM, 2464, (bf16*)(ws + W_IN), scr, r, lane, 0, nullptr); continue; } r -= IIN;
        if (r < IOUT) { transpose_item(IN(11) + (size_t)l * DM * DM, DM, DM, (bf16*)(ws + W_OUT), scr, r, lane, 0, nullptr); continue; } r -= IOUT;
        if (r < IUQ) { transpose_item(IN(36) + (size_t)l * 256 * 384, 256, 384, (bf16*)(ws + W_UQ), scr, r, lane, 0, IN(35) + l * 256); continue; } r -= IUQ;
        if (r < IUKV) { transpose_item(IN(38) + (size_t)l * 128 * 512, 128, 512, (bf16*)(ws + W_UKV), scr, r, lane, 0, IN(37) + l * 128); continue; } r -= IUKV;
        if (r < 16) { const int d = r >> 3; transpose_item(IN(26) + (size_t)(l * 2 + d) * 64 * 256, 64, 256, (bf16*)(ws + W_WUP) + d * 256 * 64, scr, r & 7, lane, 0, nullptr); continue; } r -= 16;
        if (r < 16) { const int d = r >> 3; transpose_item(IN(28) + (size_t)(l * 2 + d) * 64 * 256, 64, 256, (bf16*)(ws + W_AUP) + d * 256 * 64, scr, r & 7, lane, 0, nullptr); continue; } r -= 16;
        if (r < 16) { transpose_item(IN(29) + (size_t)l * 128 * 256, 128, 256, (bf16*)(ws + W_GUP), scr, r, lane, 0, nullptr); continue; } r -= 16;
        if (r < 16) { const int m = r >> 1; transpose_item(IN(18) + (size_t)(l * 8 + m) * 4096, 64, 64, (bf16*)(ws + W_LWA) + m * 4096, scr, r & 1, lane, 0, nullptr); continue; } r -= 16;
        { const int m = r >> 1; transpose_item(IN(20) + (size_t)(l * 8 + m) * 4096, 64, 64, (bf16*)(ws + W_LWX) + m * 4096, scr, r & 1, lane, 0, nullptr); }
    }
    v4u z = {0u, 0u, 0u, 0u}; v4u* zp = (v4u*)(ws + W_IN + (size_t)2464 * DM * 2);
    for (int i = bid * 512 + tid; i < 96 * DM * 2 / 16; i += G * 512) zp[i] = z;
}
__device__ __forceinline__ void phase_modulate(const Args& a, int l, int which, int gw, int NGW, int lane) {
    unsigned char* ws = karg_ws(); const float* outp = karg_out();
    const bool first = (l == 0 && which == 0);
    const float* srcl = first ? IN(0) : outp; const float* srcc = first ? IN(2) : (const float*)(ws + OFF_XCTX);
    const float* mod = (const float*)(ws + OFF_MOD) + (size_t)l * 3 * 9216;
    bf16* XM = (bf16*)(ws + OFF_XMY);
    for (int r = gw; r < NR; r += NGW) {
        const float* xr = r < NLAT ? srcl + (size_t)r * DM : srcc + (size_t)(r - NLAT) * DM;
        const float* mm = mod + (r < NLAT ? (r >> 13) : 2) * 9216 + which * 3 * 1024;
        f32x4 v[4]; float ss = 0.f;
#pragma unroll
        for (int j = 0; j < 4; ++j) { v[j] = *(const f32x4*)(xr + 4 * lane + 256 * j); ss += (v[j][0] * v[j][0] + v[j][1] * v[j][1]) + (v[j][2] * v[j][2] + v[j][3] * v[j][3]); }
        const float rstd = rsqrtf(wave_sum(ss) * (1.f / DM) + 1e-6f);
#pragma unroll
        for (int j = 0; j < 4; ++j) { const int c = 4 * lane + 256 * j; const f32x4 sh = *(const f32x4*)(mm + c), sc = *(const f32x4*)(mm + 1024 + c);
            const f32x4 o = v[j] * rstd * (1.f + sc) + sh; v2u w; w.x = pk2(o[0], o[1]); w.y = pk2(o[2], o[3]);
            *(v2u*)(XM + (size_t)r * DM + c) = w; }
    }
}
__device__ __forceinline__ void phase_final(const Args& a, int gw, int NGW, int lane) {
    const float* fn = IN(39); float* outp = karg_out();
    for (int r = gw; r < NLAT; r += NGW) {
        float* xr = outp + (size_t)r * DM; f32x4 v[4]; float ss = 0.f;
#pragma unroll
        for (int j = 0; j < 4; ++j) { v[j] = *(const f32x4*)(xr + 4 * lane + 256 * j); ss += (v[j][0] * v[j][0] + v[j][1] * v[j][1]) + (v[j][2] * v[j][2] + v[j][3] * v[j][3]); }
        const float rstd = rsqrtf(wave_sum(ss) * (1.f / DM) + 1e-6f);
#pragma unroll
        for (int j = 0; j < 4; ++j) { const int c = 4 * lane + 256 * j; const f32x4 g = *(const f32x4*)(fn + c); *(f32x4*)(xr + c) = v[j] * rstd * g; }
    }
}

__device__ __forceinline__ void phase_m1(const Args& a, int l, unsigned char* lds, int G, int bid, int tid_unused) {
    unsigned char* ws = karg_ws();
    const bf16* U = (const bf16*)(ws + OFF_HU);
    bf16* Y = (bf16*)(ws + OFF_XMY);
    for (int tile = bid; tile < NTILE; tile += G) {
        const TileInfo ti = tile_info(tile);
        const int row0 = tile * 32;
        {
            const int tid = ltid(); const int lane = tid & 63, wave = __builtin_amdgcn_readfirstlane(tid >> 6), ch = tid & 255, part = tid >> 8; (void)lane; (void)wave; (void)ch; (void)part;
            float* z = (float*)lds;
            float* cv = (float*)(lds + 65536);
            for (int tt = part; tt < 62; tt += 2) { const int t = ti.t0 - 15 + tt; float zz = 0.f;
                if (t >= 0 && t < ti.seqlen) { const bf16* ur = U + (size_t)(ti.seqbase + t) * UC; zz = bf2f(ur[ch]) * sigm(bf2f(ur[256 + ch])); }
                z[tt * 256 + ch] = zz; }
            __syncthreads();
            const float* dw = IN(12) + (size_t)l * 31 * 256 + ch;
            float acc[16]; const float bias = IN(13)[l * 256 + ch];
#pragma unroll
            for (int o = 0; o < 16; ++o) acc[o] = bias;
            for (int j = 0; j < 31; ++j) { const float w = dw[j * 256];
#pragma unroll
                for (int o = 0; o < 16; ++o) acc[o] += w * z[(part * 16 + o + j) * 256 + ch]; }
#pragma unroll
            for (int o = 0; o < 16; ++o) cv[(part * 16 + o) * 256 + ch] = acc[o];
            __syncthreads();
            const f32x4 lg = *(const f32x4*)(IN(14) + l * 256 + lane * 4), lb = *(const f32x4*)(IN(15) + l * 256 + lane * 4);
#pragma unroll
            for (int q = 0; q < 4; ++q) { const int t = wave * 4 + q; const f32x4 v = *(const f32x4*)(cv + t * 256 + lane * 4);
                const float mu = wave_sum((v[0] + v[1]) + (v[2] + v[3])) * (1.f / 256.f);
                const f32x4 dv = v - mu; const float var = wave_sum((dv[0] * dv[0] + dv[1] * dv[1]) + (dv[2] * dv[2] + dv[3] * dv[3])) * (1.f / 256.f);
                const f32x4 yn = dv * rsqrtf(var + 1e-5f) * lg + lb;
                v2u w; w.x = pk2(siluf_(yn[0]), siluf_(yn[1])); w.y = pk2(siluf_(yn[2]), siluf_(yn[3]));
                *(v2u*)(Y + (size_t)(row0 + t) * DM + lane * 4) = w; }
            __syncthreads();
        }
        {
            float* xvf = (float*)lds;
            bf16* xvb = (bf16*)(lds + 32768);
            bf16* rg = (bf16*)(lds + 49664);
            bf16* ixg = (bf16*)(lds + 82432);
            {
                const int tid = ltid(); const int ch = tid & 255, part = tid >> 8;
                const float* cw = IN(16) + (size_t)l * 4 * 256 + ch; const float w0 = cw[0], w1 = cw[256], w2 = cw[512], w3 = cw[768], cb = IN(17)[l * 256 + ch];
                float xin[19];
#pragma unroll
                for (int i = 0; i < 19; ++i) { const int t = ti.t0 + part * 16 + i - 2; xin[i] = (t >= 0 && t < ti.seqlen) ? bf2f(U[(size_t)(ti.seqbase + t) * UC + 512 + ch]) : 0.f; }
#pragma unroll
                for (int o = 0; o < 16; ++o) { const int tl = part * 16 + o;
                    const float v = cb + w0 * xin[o] + w1 * xin[o + 1] + w2 * xin[o + 2] + w3 * xin[o + 3];
                    xvf[tl * 256 + ch] = v; xvb[tl * 264 + ch] = (bf16)f2bf(v);
                }
            }
            __syncthreads();
            {
                const int tid = ltid(); const int ln = tid & 63, wv = __builtin_amdgcn_readfirstlane(tid >> 6), fr = ln & 15, fq = ln >> 4, blk = wv >> 1;
                const bf16* LWAt = (const bf16*)(ws + W_LWA); const bf16* LWXt = (const bf16*)(ws + W_LWX);
                bf16x8 af[2][2];
#pragma unroll
                for (int mt = 0; mt < 2; ++mt)
#pragma unroll
                    for (int ks = 0; ks < 2; ++ks) af[mt][ks] = *(const bf16x8*)(xvb + (mt * 16 + fr) * 264 + blk * 64 + ks * 32 + fq * 8);
#pragma unroll 1
                for (int dn = 0; dn < 4; ++dn) { const int d = dn >> 1, nt = wv * 2 + (dn & 1), ch = nt * 16 + fr, jj = (nt & 3) * 16 + fr;
                    f32x4 ca[2], cx[2];
#pragma unroll
                    for (int mt = 0; mt < 2; ++mt) { ca[mt] = (f32x4){0.f, 0.f, 0.f, 0.f}; cx[mt] = ca[mt]; }
#pragma unroll
                    for (int ks = 0; ks < 2; ++ks) { const size_t wo = ((size_t)(d * 4 + blk) * 64 + jj) * 64 + ks * 32 + fq * 8;
                        const bf16x8 ba = *(const bf16x8*)(LWAt + wo), bx = *(const bf16x8*)(LWXt + wo);
#pragma unroll
                        for (int mt = 0; mt < 2; ++mt) { ca[mt] = __builtin_amdgcn_mfma_f32_16x16x32_bf16(af[mt][ks], ba, ca[mt], 0, 0, 0); cx[mt] = __builtin_amdgcn_mfma_f32_16x16x32_bf16(af[mt][ks], bx, cx[mt], 0, 0, 0); } }
                    const float bga = IN(19)[(l * 2 + d) * 256 + ch], bgx = IN(21)[(l * 2 + d) * 256 + ch];
                    bf16* LR = (bf16*)(ws + M_LR0 + (size_t)d * A8); bf16* LIX = (bf16*)(ws + M_LIX0 + (size_t)d * A8);
#pragma unroll
                    for (int mt = 0; mt < 2; ++mt)
#pragma unroll
                        for (int j = 0; j < 4; ++j) { const int t = mt * 16 + fq * 4 + j;
                            const bf16 rb = (bf16)f2bf(sigm(ca[mt][j] + bga)), ib = (bf16)f2bf(sigm(cx[mt][j] + bgx) * xvf[t * 256 + ch]);
                            LR[(size_t)(row0 + t) * 256 + ch] = rb; LIX[(size_t)(row0 + t) * 256 + ch] = ib;
                            rg[(d * 32 + t) * 256 + ch] = rb; ixg[(d * 32 + t) * 256 + ch] = ib; }
                }
            }
            __syncthreads();
            {
                const int tid = ltid(); const int ch = tid & 255, d = tid >> 8;
                const float lam = IN(22)[(l * 2 + d) * 256 + ch];
                const float cch = -8.f * log1pf(__expf(-lam));
                float A = 1.f, B = 0.f;
#pragma unroll 8
                for (int tt = 0; tt < 32; ++tt) { const int t = d ? 31 - tt : tt;
                    const float al = __expf(cch * bf2f(rg[(d * 32 + t) * 256 + ch])); const float bb = sqrtf(fmaxf(1.f - al * al, 0.f)) * bf2f(ixg[(d * 32 + t) * 256 + ch]); B = al * B + bb; A *= al; }
                ((float*)(ws + M_SEGA))[(size_t)(tile * 2 + d) * 256 + ch] = A;
                ((float*)(ws + M_SEGB))[(size_t)(tile * 2 + d) * 256 + ch] = B;
            }
            __syncthreads();
        }
        {
            const int tid = ltid(); const int lane = tid & 63, wave = __builtin_amdgcn_readfirstlane(tid >> 6), ch = tid & 255, part = tid >> 8; (void)lane; (void)wave; (void)ch; (void)part;
            bf16* As = (bf16*)lds;
            float* kr = (float*)(lds + 32768);
            float* rs = (float*)(lds + 32768 + 4096);
            for (int idx = tid; idx < 32 * 52; idx += 512) { const int t = idx / 52, cc = idx % 52;
                const v4u v = *(const v4u*)(U + (size_t)(row0 + t) * UC + 2048 + cc * 8);
                if (cc < 48) *(v4u*)(As + t * 392 + cc * 8) = v;
                else { const int c0 = (cc - 48) * 8; float* kp = kr + t * 32 + c0;
                    kp[0] = __uint_as_float(v.x << 16); kp[1] = __uint_as_float(v.x & 0xffff0000u); kp[2] = __uint_as_float(v.y << 16); kp[3] = __uint_as_float(v.y & 0xffff0000u);
                    kp[4] = __uint_as_float(v.z << 16); kp[5] = __uint_as_float(v.z & 0xffff0000u); kp[6] = __uint_as_float(v.w << 16); kp[7] = __uint_as_float(v.w & 0xffff0000u); } }
            __syncthreads();
#pragma unroll
            for (int q = 0; q < 4; ++q) { const int t = wave * 4 + q; float sq = 0.f, sk = 0.f;
#pragma unroll
                for (int j = 0; j < 4; ++j) { const float v = bf2f(As[t * 392 + lane + 64 * j]); sq += v * v; }
#pragma unroll
                for (int j = 0; j < 2; ++j) { const float v = bf2f(As[t * 392 + 256 + lane + 64 * j]); sk += v * v; }
                sq = wave_sum(sq); sk = wave_sum(sk);
                if (lane == 0) { rs[t * 2] = rsqrtf(sq * (1.f / 256.f) + 1e-6f); rs[t * 2 + 1] = rsqrtf(sk * (1.f / 128.f) + 1e-6f); } }
            __syncthreads();
            const int fr = lane & 15, fq = lane >> 4;
            bf16* QB = (bf16*)(ws + M_QB); bf16* KB = (bf16*)(ws + M_KB); bf16* VT = (bf16*)(ws + M_VT);
            const bf16* WUQ = (const bf16*)(ws + W_UQ); const bf16* WUKV = (const bf16*)(ws + W_UKV);
            const int keybase = ti.isctx ? TLEN : 0;
#pragma unroll 1
            for (int i = 0; i < 3; ++i) { const int nt = wave * 3 + i;
                f32x4 c0 = {0.f, 0.f, 0.f, 0.f}, c1 = c0;
#pragma unroll
                for (int ks = 0; ks < 8; ++ks) { const bf16x8 bfr = *(const bf16x8*)(WUQ + (size_t)(nt * 16 + fr) * 256 + ks * 32 + fq * 8);
                    const bf16x8 a0 = *(const bf16x8*)(As + fr * 392 + ks * 32 + fq * 8), a1 = *(const bf16x8*)(As + (16 + fr) * 392 + ks * 32 + fq * 8);
                    c0 = __builtin_amdgcn_mfma_f32_16x16x32_bf16(a0, bfr, c0, 0, 0, 0); c1 = __builtin_amdgcn_mfma_f32_16x16x32_bf16(a1, bfr, c1, 0, 0, 0); }
                const int hq = nt / 6, wt = nt % 6, dd = wt * 16 + fr;
#pragma unroll
                for (int mt = 0; mt < 2; ++mt)
#pragma unroll
                    for (int j = 0; j < 4; ++j) { const int tl = mt * 16 + fq * 4 + j; const int t = ti.t0 + tl;
                        float v = (mt ? c1[j] : c0[j]) * rs[tl * 2];
                        const float pv = __shfl_xor(v, 8);
                        if (wt >= 4 && !ti.isctx) { const int f = fr & 7; const float pos = (wt == 4) ? (float)(t >> 6) : (float)(t & 63);
                            const float ang = pos * __expf(-(float)f * (9.210340371976184f / 8.f)); float sn, cs; __sincosf(ang, &sn, &cs);
                            v = (fr & 8) ? (v * cs + pv * sn) : (v * cs - pv * sn); }
                        QB[((size_t)(ti.b * 4 + hq) * TT + keybase + t) * 96 + dd] = (bf16)f2bf(v * QSCALE); } }
#pragma unroll 1
            for (int i = 0; i < 4; ++i) { const int nt = wave * 4 + i;
                f32x4 c0 = {0.f, 0.f, 0.f, 0.f}, c1 = c0;
#pragma unroll
                for (int ks = 0; ks < 4; ++ks) { const bf16x8 bfr = *(const bf16x8*)(WUKV + (size_t)(nt * 16 + fr) * 128 + ks * 32 + fq * 8);
                    const bf16x8 a0 = *(const bf16x8*)(As + fr * 392 + 256 + ks * 32 + fq * 8), a1 = *(const bf16x8*)(As + (16 + fr) * 392 + 256 + ks * 32 + fq * 8);
                    c0 = __builtin_amdgcn_mfma_f32_16x16x32_bf16(a0, bfr, c0, 0, 0, 0); c1 = __builtin_amdgcn_mfma_f32_16x16x32_bf16(a1, bfr, c1, 0, 0, 0); }
                const int hk = nt >> 3, wt = nt & 7;
#pragma unroll
                for (int mt = 0; mt < 2; ++mt)
#pragma unroll
                    for (int j = 0; j < 4; ++j) { const int tl = mt * 16 + fq * 4 + j; const int key = keybase + ti.t0 + tl;
                        const float v = (mt ? c1[j] : c0[j]) * rs[tl * 2 + 1];
                        if (wt < 4) KB[((size_t)(ti.b * 4 + hk) * TT + key) * 96 + wt * 16 + fr] = (bf16)f2bf(v);
                        else VT[((size_t)(ti.b * 4 + hk) * 64 + (wt - 4) * 16 + fr) * TT + key] = (bf16)f2bf(v); } }
            { const int tl = tid >> 4, p = tid & 15, ax = p >> 3, f = p & 7; const int t = ti.t0 + tl;
                float x0 = kr[tl * 32 + ax * 16 + f], x1 = kr[tl * 32 + ax * 16 + 8 + f];
                if (!ti.isctx) { const float pos = ax == 0 ? (float)(t >> 6) : (float)(t & 63); const float ang = pos * __expf(-(float)f * (9.210340371976184f / 8.f));
                    float sn, cs; __sincosf(ang, &sn, &cs); const float y0 = x0 * cs - x1 * sn, y1 = x1 * cs + x0 * sn; x0 = y0; x1 = y1; }
                const bf16 b0 = (bf16)f2bf(x0), b1 = (bf16)f2bf(x1);
#pragma unroll
                for (int h = 0; h < 4; ++h) { bf16* kp = KB + ((size_t)(ti.b * 4 + h) * TT + keybase + t) * 96 + 64 + ax * 16 + f; kp[0] = b0; kp[8] = b1; } }
            __syncthreads();
        }
    }
}

__device__ __forceinline__ void attn_unit(unsigned char* lds, const bf16* QB, const bf16* KB, const bf16* VT, bf16* Y, int b, int h, int q0, int key_lo, int nkt, int tid) {
    const int lane = tid & 63, wave = tid >> 6, fr = lane & 15, fq = lane >> 4;
    const int bh = b * 4 + h;
    constexpr int KSTR = 104, VSTR = 72, KBUF = 64 * KSTR, VBUF = 64 * VSTR;
    bf16* Ks = (bf16*)lds;
    bf16* Vs = (bf16*)lds + 2 * KBUF;
    const int qw = q0 + wave * 32;
    bf16x8 qf[2][3];
#pragma unroll
    for (int qt = 0; qt < 2; ++qt)
#pragma unroll
        for (int ks = 0; ks < 3; ++ks) qf[qt][ks] = *(const bf16x8*)(QB + ((size_t)bh * TT + qw + qt * 16 + fr) * 96 + ks * 32 + fq * 8);
    float mrun[2] = {-1e30f, -1e30f}, lrun[2] = {0.f, 0.f};
    f32x4 o[4][2];
#pragma unroll
    for (int dt = 0; dt < 4; ++dt)
#pragma unroll
        for (int qt = 0; qt < 2; ++qt) o[dt][qt] = (f32x4){0.f, 0.f, 0.f, 0.f};
    const v4u* kg = (const v4u*)(KB + ((size_t)bh * TT + key_lo) * 96);
    const bf16* vg = VT + ((size_t)bh * 64 + (tid >> 3)) * TT + key_lo + (tid & 7) * 8;
    const int kc0 = tid, kc1 = 512 + tid;
    const int ko0 = (kc0 / 12) * KSTR + (kc0 % 12) * 8, ko1 = (kc1 / 12) * KSTR + (kc1 % 12) * 8, vo = (tid >> 3) * VSTR + (tid & 7) * 8;
    v4u rk0, rk1 = {0u, 0u, 0u, 0u}, rv;
    rk0 = kg[kc0]; if (tid < 256) rk1 = kg[kc1]; rv = *(const v4u*)vg;
    *(v4u*)(Ks + ko0) = rk0; if (tid < 256) *(v4u*)(Ks + ko1) = rk1; *(v4u*)(Vs + vo) = rv;
    __syncthreads();
    for (int kt = 0; kt < nkt; ++kt) {
        const int cur = kt & 1;
        if (kt + 1 < nkt) { const v4u* kn = kg + (size_t)(kt + 1) * 768; rk0 = kn[kc0]; if (tid < 256) rk1 = kn[kc1]; rv = *(const v4u*)(vg + (kt + 1) * 64); }
        const bf16* kb = Ks + cur * KBUF; const bf16* vb = Vs + cur * VBUF;
        f32x4 st[4][2];
#pragma unroll
        for (int k4 = 0; k4 < 4; ++k4) {
            st[k4][0] = (f32x4){0.f, 0.f, 0.f, 0.f}; st[k4][1] = st[k4][0];
#pragma unroll
            for (int ks = 0; ks < 3; ++ks) { const bf16x8 kf = *(const bf16x8*)(kb + (k4 * 16 + fr) * KSTR + ks * 32 + fq * 8);
                st[k4][0] = __builtin_amdgcn_mfma_f32_16x16x32_bf16(kf, qf[0][ks], st[k4][0], 0, 0, 0);
                st[k4][1] = __builtin_amdgcn_mfma_f32_16x16x32_bf16(kf, qf[1][ks], st[k4][1], 0, 0, 0); }
        }
        bf16x8 pb[2][2];
#pragma unroll
        for (int qt = 0; qt < 2; ++qt) {
            float mx = st[0][qt][0];
#pragma unroll
            for (int k4 = 0; k4 < 4; ++k4)
#pragma unroll
                for (int j = 0; j < 4; ++j) mx = fmaxf(mx, st[k4][qt][j]);
            mx = fmaxf(mx, __shfl_xor(mx, 16)); mx = fmaxf(mx, __shfl_xor(mx, 32));
            const float mn = fmaxf(mrun[qt], mx), alpha = __builtin_amdgcn_exp2f(mrun[qt] - mn); mrun[qt] = mn;
            float ls = 0.f;
#pragma unroll
            for (int k4 = 0; k4 < 4; ++k4)
#pragma unroll
                for (int j = 0; j < 4; ++j) { const float p = __builtin_amdgcn_exp2f(st[k4][qt][j] - mn); st[k4][qt][j] = p; ls += p; }
            lrun[qt] = lrun[qt] * alpha + ls;
#pragma unroll
            for (int dt = 0; dt < 4; ++dt) o[dt][qt] *= alpha;
#pragma unroll
            for (int u = 0; u < 2; ++u) { v4u w;
                w.x = pg8::cvt_pk_bf16(st[2 * u][qt][0], st[2 * u][qt][1]); w.y = pg8::cvt_pk_bf16(st[2 * u][qt][2], st[2 * u][qt][3]);
                w.z = pg8::cvt_pk_bf16(st[2 * u + 1][qt][0], st[2 * u + 1][qt][1]); w.w = pg8::cvt_pk_bf16(st[2 * u + 1][qt][2], st[2 * u + 1][qt][3]);
                pb[u][qt] = __builtin_bit_cast(bf16x8, w); }
        }
#pragma unroll
        for (int dt = 0; dt < 4; ++dt)
#pragma unroll
            for (int u = 0; u < 2; ++u) {
                const v2u lo = *(const v2u*)(vb + (dt * 16 + fr) * VSTR + 32 * u + 4 * fq), hi = *(const v2u*)(vb + (dt * 16 + fr) * VSTR + 32 * u + 16 + 4 * fq);
                v4u vw; vw.x = lo.x; vw.y = lo.y; vw.z = hi.x; vw.w = hi.y;
                const bf16x8 va = __builtin_bit_cast(bf16x8, vw);
                o[dt][0] = __builtin_amdgcn_mfma_f32_16x16x32_bf16(va, pb[u][0], o[dt][0], 0, 0, 0);
                o[dt][1] = __builtin_amdgcn_mfma_f32_16x16x32_bf16(va, pb[u][1], o[dt][1], 0, 0, 0);
            }
        if (kt + 1 < nkt) { const int nb = cur ^ 1; *(v4u*)(Ks + nb * KBUF + ko0) = rk0; if (tid < 256) *(v4u*)(Ks + nb * KBUF + ko1) = rk1; *(v4u*)(Vs + nb * VBUF + vo) = rv; }
        __syncthreads();
    }
#pragma unroll
    for (int qt = 0; qt < 2; ++qt) {
        float lt = lrun[qt]; lt += __shfl_xor(lt, 16); lt += __shfl_xor(lt, 32);
        const float inv = 1.f / lt;
        const int q = qw + qt * 16 + fr;
        const size_t row = q < TLEN ? (size_t)b * TLEN + q : (size_t)NLAT + b * CTXL + (q - TLEN);
#pragma unroll
        for (int dt = 0; dt < 4; ++dt) { const f32x4 v = o[dt][qt] * inv; v2u w; w.x = pk2(v[0], v[1]); w.y = pk2(v[2], v[3]);
            *(v2u*)(Y + row * DM + 768 + h * 64 + dt * 16 + fq * 4) = w; }
    }
}
__device__ __forceinline__ void lru_prefix(int bd, int tid) {
    unsigned char* ws = karg_ws();
    if (tid >= 256) return;
    const int ch = tid, b = bd >> 1, d = bd & 1;
    const float* SA = (const float*)(ws + M_SEGA); const float* SB = (const float*)(ws + M_SEGB); float* H0 = (float*)(ws + M_H0);
    const int ctile0 = 512 + b * 8, ltile0 = b * 256;
    float hst = 0.f;
#pragma unroll 8
    for (int i = 0; i < 8; ++i) { const int j = ctile0 + (d ? 7 - i : i); const size_t o = (size_t)(j * 2 + d) * 256 + ch; H0[o] = hst; hst = SA[o] * hst + SB[o]; }
#pragma unroll 16
    for (int i = 0; i < 256; ++i) { const int j = ltile0 + (d ? 255 - i : i); const size_t o = (size_t)(j * 2 + d) * 256 + ch; H0[o] = hst; hst = SA[o] * hst + SB[o]; }
}
__device__ __forceinline__ void lru_rescan(const Args& a, int l, unsigned char* lds, int tile, int tid) {
    unsigned char* ws = karg_ws();
    const int ch = tid & 255, d = tid >> 8;
    const int row0 = tile * 32;
    float hst = ((const float*)(ws + M_H0))[(size_t)(tile * 2 + d) * 256 + ch];
    const float lam = IN(22)[(l * 2 + d) * 256 + ch];
    const float cch = -8.f * log1pf(__expf(-lam));
    const bf16* LR = (const bf16*)(ws + M_LR0 + (size_t)d * A8); const bf16* LIX = (const bf16*)(ws + M_LIX0 + (size_t)d * A8);
    float* hs = (float*)lds;
#pragma unroll 16
    for (int tt = 0; tt < 32; ++tt) { const int t = d ? 31 - tt : tt; const size_t o = (size_t)(row0 + t) * 256 + ch;
        const float al = __expf(cch * bf2f(LR[o])); const float bb = sqrtf(fmaxf(1.f - al * al, 0.f)) * bf2f(LIX[o]);
        hst = al * hst + bb; hs[(d * 32 + t) * 256 + ch] = hst; }
    __syncthreads();
    const bf16* U = (const bf16*)(ws + OFF_HU); bf16* Y = (bf16*)(ws + OFF_XMY);
#pragma unroll 8
    for (int tt = 0; tt < 16; ++tt) { const int t = d * 16 + tt;
        const float y = (hs[t * 256 + ch] + hs[(32 + t) * 256 + ch]) * geluf_(bf2f(U[(size_t)(row0 + t) * UC + 768 + ch]));
        Y[(size_t)(row0 + t) * DM + 256 + ch] = (bf16)f2bf(y); }
    __syncthreads();
}
__device__ __forceinline__ void phase_m2(const Args& a, int l, unsigned char* lds, int G, int bid, int tid) {
    unsigned char* ws = karg_ws();
    const bf16* QB = (const bf16*)(ws + M_QB); const bf16* KB = (const bf16*)(ws + M_KB); const bf16* VT = (const bf16*)(ws + M_VT);
    bf16* Y = (bf16*)(ws + OFF_XMY);
    const int nunits = (l == 0) ? 264 : 256;
    for (int u = bid; u < nunits; u += G) {
        if (u < 256) attn_unit(lds, QB, KB, VT, Y, u >> 7, (u >> 5) & 3, (u & 31) * 256, 0, 132, tid);
        else attn_unit(lds, QB, KB, VT, Y, (u - 256) >> 2, (u - 256) & 3, TLEN, TLEN, 4, tid);
    }
    if (bid < 4) lru_prefix(bid, tid);
}

__device__ __forceinline__ void phase_m3(const Args& a, int l, unsigned char* lds, int G, int bid, int tid) {
    unsigned char* ws = karg_ws();
    const bf16* U = (const bf16*)(ws + OFF_HU);
    const int lane = tid & 63, ch = tid & 255, part = tid >> 8;
    const float* mup = IN(23) + l * 1024; const float* mun = IN(24) + l * 1024;
    bf16* RR = (bf16*)(ws + M_RR); bf16* KKo = (bf16*)(ws + M_KK); bf16* VV = (bf16*)(ws + M_VV); bf16* GC = (bf16*)(ws + M_GC);
    float* kl = (float*)lds;
    float* kkn = (float*)(lds + 32768);
    bf16* twb = (bf16*)(lds + 65536);
    bf16* tab = (bf16*)(lds + 70144);
    bf16* tgb = (bf16*)(lds + 74752);
    for (int tile = bid; tile < NTILE; tile += G) {
        const TileInfo ti = tile_info(tile);
        const int row0 = tile * 32;
        lru_rescan(a, l, lds, tile, ltid());
        {
            const int tid2 = ltid(); const int chunk = tid2 & 127, tg8 = tid2 >> 7, c0 = chunk * 8;
            const bf16* ub = U + (size_t)row0 * UC + 1024 + c0;
            v4u rw[10];
#pragma unroll
            for (int q = 0; q < 10; ++q) { const int tl = tg8 * 8 + q - 1; const int t = ti.t0 + tl;
                rw[q] = (t >= 0 && t < ti.seqlen) ? *(const v4u*)(ub + (ptrdiff_t)tl * UC) : (v4u){0u, 0u, 0u, 0u}; }
            const f32x4 mp0 = *(const f32x4*)(mup + c0), mp1 = *(const f32x4*)(mup + c0 + 4), mn0 = *(const f32x4*)(mun + c0), mn1 = *(const f32x4*)(mun + c0 + 4);
            const float mp[8] = {mp0[0], mp0[1], mp0[2], mp0[3], mp1[0], mp1[1], mp1[2], mp1[3]}, mn[8] = {mn0[0], mn0[1], mn0[2], mn0[3], mn1[0], mn1[1], mn1[2], mn1[3]};
#pragma unroll
            for (int q = 0; q < 8; ++q) { const int tl = tg8 * 8 + q; float ts[8];
#pragma unroll
                for (int e = 0; e < 8; ++e) { const unsigned wm = rw[q][e >> 1], w0 = rw[q + 1][e >> 1], wn = rw[q + 2][e >> 1];
                    const float um = (e & 1) ? __uint_as_float(wm & 0xffff0000u) : __uint_as_float(wm << 16);
                    const float u0 = (e & 1) ? __uint_as_float(w0 & 0xffff0000u) : __uint_as_float(w0 << 16);
                    const float un = (e & 1) ? __uint_as_float(wn & 0xffff0000u) : __uint_as_float(wn << 16);
                    ts[e] = u0 + mp[e] * (um - u0) + mn[e] * (un - u0); }
                if (chunk >= 32 && chunk < 64) { float* kp = kl + tl * 256 + (c0 - 256); *(f32x4*)kp = (f32x4){ts[0], ts[1], ts[2], ts[3]}; *(f32x4*)(kp + 4) = (f32x4){ts[4], ts[5], ts[6], ts[7]}; }
                else {
                    if (chunk >= 96 && chunk < 104) {
#pragma unroll
                        for (int e = 0; e < 8; ++e) ts[e] = tanhf_(ts[e]); }
                    if (chunk >= 112) {
#pragma unroll
                        for (int e = 0; e < 8; ++e) ts[e] = sigm(ts[e]); }
                    v4u o; o.x = pk2(ts[0], ts[1]); o.y = pk2(ts[2], ts[3]); o.z = pk2(ts[4], ts[5]); o.w = pk2(ts[6], ts[7]);
                    if (chunk < 32) *(v4u*)(RR + (size_t)(row0 + tl) * 256 + c0) = o;
                    else if (chunk < 96) *(v4u*)(VV + (size_t)(row0 + tl) * 256 + (c0 - 512)) = o;
                    else if (chunk < 104) *(v4u*)(twb + tl * 72 + (c0 - 768)) = o;
                    else if (chunk < 112) *(v4u*)(tab + tl * 72 + (c0 - 832)) = o;
                    else *(v4u*)(tgb + tl * 136 + (c0 - 896)) = o; }
            }
        }
        __syncthreads();
        {
            const int tid2 = ltid(); const int ch = tid2 & 255, pt = tid2 >> 8; const float kkc = IN(30)[l * 256 + ch];
#pragma unroll 4
            for (int q = 0; q < 16; ++q) { const int t = pt * 16 + q; const float kr = kl[t * 256 + ch] * kkc; const float nrm = wave_sum(kr * kr);
                const float kk = kr * rsqrtf(fmaxf(nrm, 1e-24f)); kkn[t * 256 + ch] = kk; KKo[(size_t)(row0 + t) * 256 + ch] = (bf16)f2bf(kk); }
        }
        __syncthreads();
        {
            const int tid2 = ltid(); const int ln = tid2 & 63, wv = __builtin_amdgcn_readfirstlane(tid2 >> 6), fr = ln & 15, fq = ln >> 4;
            const bf16* WUPt = (const bf16*)(ws + W_WUP); const bf16* AUPt = (const bf16*)(ws + W_AUP); const bf16* GUPt = (const bf16*)(ws + W_GUP);
            bf16x8 aw[2][2], aa[2][2];
#pragma unroll
            for (int mt = 0; mt < 2; ++mt)
#pragma unroll
                for (int ks = 0; ks < 2; ++ks) { aw[mt][ks] = *(const bf16x8*)(twb + (mt * 16 + fr) * 72 + ks * 32 + fq * 8); aa[mt][ks] = *(const bf16x8*)(tab + (mt * 16 + fr) * 72 + ks * 32 + fq * 8); }
#pragma unroll 1
            for (int dn = 0; dn < 4; ++dn) { const int d = dn >> 1, nt = wv * 2 + (dn & 1), ch = nt * 16 + fr;
                f32x4 cw[2], ca[2];
#pragma unroll
                for (int mt = 0; mt < 2; ++mt) { cw[mt] = (f32x4){0.f, 0.f, 0.f, 0.f}; ca[mt] = cw[mt]; }
#pragma unroll
                for (int ks = 0; ks < 2; ++ks) { const bf16x8 bw = *(const bf16x8*)(WUPt + ((size_t)d * 256 + ch) * 64 + ks * 32 + fq * 8), ba = *(const bf16x8*)(AUPt + ((size_t)d * 256 + ch) * 64 + ks * 32 + fq * 8);
#pragma unroll
                    for (int mt = 0; mt < 2; ++mt) { cw[mt] = __builtin_amdgcn_mfma_f32_16x16x32_bf16(aw[mt][ks], bw, cw[mt], 0, 0, 0); ca[mt] = __builtin_amdgcn_mfma_f32_16x16x32_bf16(aa[mt][ks], ba, ca[mt], 0, 0, 0); } }
                const float w0 = IN(25)[(l * 2 + d) * 256 + ch], a0 = IN(27)[(l * 2 + d) * 256 + ch], kac = IN(31)[l * 256 + ch];
                float* WW = (float*)(ws + M_WW) + (size_t)d * NR * 256; bf16* BB = (bf16*)(ws + M_BB + (size_t)d * A8); bf16* KD = (bf16*)(ws + M_KD + (size_t)d * A8);
#pragma unroll
                for (int mt = 0; mt < 2; ++mt)
#pragma unroll
                    for (int j = 0; j < 4; ++j) { const int t = mt * 16 + fq * 4 + j; const size_t o = (size_t)(row0 + t) * 256 + ch;
                        const float e = sigm(w0 + cw[mt][j]) * 0.6065306597126334f;
                        const float av = sigm(a0 + ca[mt][j]);
                        WW[o] = __expf(-e);
                        KD[o] = (bf16)f2bf(kl[t * 256 + ch] * (1.f + (av - 1.f) * kac));
                        BB[o] = (bf16)f2bf(kkn[t * 256 + ch] * av); }
            }
#pragma unroll 1
            for (int nl = 0; nl < 2; ++nl) { const int ch = (wv * 2 + nl) * 16 + fr;
                f32x4 cg[2] = {(f32x4){0.f, 0.f, 0.f, 0.f}, (f32x4){0.f, 0.f, 0.f, 0.f}};
#pragma unroll
                for (int ks = 0; ks < 4; ++ks) { const bf16x8 bg = *(const bf16x8*)(GUPt + (size_t)ch * 128 + ks * 32 + fq * 8);
#pragma unroll
                    for (int mt = 0; mt < 2; ++mt) { const bf16x8 ag = *(const bf16x8*)(tgb + (mt * 16 + fr) * 136 + ks * 32 + fq * 8); cg[mt] = __builtin_amdgcn_mfma_f32_16x16x32_bf16(ag, bg, cg[mt], 0, 0, 0); } }
#pragma unroll
                for (int mt = 0; mt < 2; ++mt)
#pragma unroll
                    for (int j = 0; j < 4; ++j) GC[(size_t)(row0 + mt * 16 + fq * 4 + j) * 256 + ch] = (bf16)f2bf(cg[mt][j]);
            }
        }
        __syncthreads();
    }
}

typedef const unsigned cu32;
typedef const float cf32;
__device__ __forceinline__ int chain_row(int b, int d, int tau) {
    return tau < CTXL ? (NLAT + b * CTXL + (d ? CTXL - 1 - tau : tau)) : (b * TLEN + (d ? TLEN - 1 - (tau - CTXL) : (tau - CTXL)));
}
template <int MODE>
__device__ __forceinline__ void rwkv_steps(float (&S)[64], int b, int h, int d, int tau0, int n, unsigned char* ws, int lane, float* wl) {
    const bf16* KKp = (const bf16*)(ws + M_KK); const bf16* RRp = (const bf16*)(ws + M_RR); const bf16* VVp = (const bf16*)(ws + M_VV);
    const float* WWp = (const float*)(ws + M_WW) + (size_t)d * NR * 256; const bf16* BBp = (const bf16*)(ws + M_BB + (size_t)d * A8); const bf16* KDp = (const bf16*)(ws + M_KD + (size_t)d * A8);
    float* YS = (float*)(ws + M_YS) + (size_t)d * NR * 256;
    float pk, pw, pb, pkd = 0.f, pr = 0.f, pv = 0.f; size_t poff;
#define RWKV_LOAD(s_) do { poff = (size_t)chain_row(b, d, tau0 + (s_)) * 256 + h * 64 + lane; pk = bf2f(KKp[poff]); pw = WWp[poff]; pb = bf2f(BBp[poff]); \
        if (MODE != 1) { pkd = bf2f(KDp[poff]); pv = bf2f(VVp[poff]); } if (MODE == 2) pr = bf2f(RRp[poff]); } while (0)
    RWKV_LOAD(0);
    for (int s = 0; s < n; ++s) {
        float* buf = wl + (s & 1) * 320;
        buf[lane] = pk; buf[64 + lane] = pw; buf[128 + lane] = pb;
        if (MODE != 1) buf[192 + lane] = pkd;
        if (MODE == 2) buf[256 + lane] = pr;
        const float vv = pv; const size_t yoff = poff;
        if (s + 1 < n) RWKV_LOAD(s + 1);
        float sa0 = 0.f, sa1 = 0.f, sa2 = 0.f, sa3 = 0.f;
#pragma unroll
        for (int i = 0; i < 64; i += 4) { const f32x4 k4 = *(const f32x4*)(buf + i);
            sa0 += S[i] * k4[0]; sa1 += S[i + 1] * k4[1]; sa2 += S[i + 2] * k4[2]; sa3 += S[i + 3] * k4[3]; }
        const float nsa = -((sa0 + sa1) + (sa2 + sa3));
        float y0 = 0.f, y1 = 0.f, y2 = 0.f, y3 = 0.f;
#pragma unroll
        for (int i = 0; i < 64; i += 4) { const f32x4 w4 = *(const f32x4*)(buf + 64 + i), b4 = *(const f32x4*)(buf + 128 + i);
            f32x4 t = nsa * b4;
            if (MODE != 1) { const f32x4 kd4 = *(const f32x4*)(buf + 192 + i); t += vv * kd4; }
            S[i] = S[i] * w4[0] + t[0]; S[i + 1] = S[i + 1] * w4[1] + t[1]; S[i + 2] = S[i + 2] * w4[2] + t[2]; S[i + 3] = S[i + 3] * w4[3] + t[3];
            if (MODE == 2) { const f32x4 r4 = *(const f32x4*)(buf + 256 + i); y0 += S[i] * r4[0]; y1 += S[i + 1] * r4[1]; y2 += S[i + 2] * r4[2]; y3 += S[i + 3] * r4[3]; } }
        if (MODE == 2) YS[yoff] = (y0 + y1) + (y2 + y3);
    }
#undef RWKV_LOAD
}
typedef float f32x2 __attribute__((ext_vector_type(2)));
__device__ __forceinline__ void rwkv_pass1(f32x2 (&SL)[32], f32x2 (&SI)[32], int b, int h, int d, int tau0, int n, unsigned char* ws, int lane, float* wl) {
    const bf16* KKp = (const bf16*)(ws + M_KK); const bf16* VVp = (const bf16*)(ws + M_VV); const bf16* RRp = (const bf16*)(ws + M_RR);
    const float* WWp = (const float*)(ws + M_WW) + (size_t)d * NR * 256; const bf16* BBp = (const bf16*)(ws + M_BB + (size_t)d * A8); const bf16* KDp = (const bf16*)(ws + M_KD + (size_t)d * A8);
    float* YS = (float*)(ws + M_YS) + (size_t)d * NR * 256; float* PR = (float*)(ws + M_PR) + (size_t)d * NR * 256;
    float pk, pw, pb, pkd, pv, pr; size_t poff;
#define RWKV_LOAD(s_) do { poff = (size_t)chain_row(b, d, tau0 + (s_)) * 256 + h * 64 + lane; pk = bf2f(KKp[poff]); pw = WWp[poff]; pb = bf2f(BBp[poff]); pkd = bf2f(KDp[poff]); pv = bf2f(VVp[poff]); pr = bf2f(RRp[poff]); } while (0)
    RWKV_LOAD(0);
    for (int s = 0; s < n; ++s) {
        float* buf = wl + (s & 1) * 320;
        buf[lane] = pk; buf[64 + lane] = pw; buf[128 + lane] = pb; buf[192 + lane] = pkd; buf[256 + lane] = pr;
        const float vv = pv; const size_t yoff = poff;
        if (s + 1 < n) RWKV_LOAD(s + 1);
        f32x2 aL0 = {0.f, 0.f}, aL1 = aL0, aI0 = aL0, aI1 = aL0;
#pragma unroll
        for (int q = 0; q < 16; ++q) { const f32x4 k4 = *(const f32x4*)(buf + 4 * q);
            aL0 += SL[2 * q] * k4.lo; aL1 += SL[2 * q + 1] * k4.hi; aI0 += SI[2 * q] * k4.lo; aI1 += SI[2 * q + 1] * k4.hi; }
        const f32x2 tL = aL0 + aL1, tI = aI0 + aI1;
        const float nsl = -(tL.x + tL.y), nsi = -(tI.x + tI.y);
        f32x2 yL0 = {0.f, 0.f}, yL1 = yL0, yI0 = yL0, yI1 = yL0;
#pragma unroll
        for (int q = 0; q < 16; ++q) {
            const f32x4 w4 = *(const f32x4*)(buf + 64 + 4 * q), b4 = *(const f32x4*)(buf + 128 + 4 * q), kd4 = *(const f32x4*)(buf + 192 + 4 * q), r4 = *(const f32x4*)(buf + 256 + 4 * q);
            const f32x4 tl = nsl * b4 + vv * kd4, tiv = nsi * b4;
            SL[2 * q] = SL[2 * q] * w4.lo + tl.lo; SL[2 * q + 1] = SL[2 * q + 1] * w4.hi + tl.hi;
            SI[2 * q] = SI[2 * q] * w4.lo + tiv.lo; SI[2 * q + 1] = SI[2 * q + 1] * w4.hi + tiv.hi;
            yL0 += SL[2 * q] * r4.lo; yL1 += SL[2 * q + 1] * r4.hi; yI0 += SI[2 * q] * r4.lo; yI1 += SI[2 * q + 1] * r4.hi; }
        const f32x2 yl = yL0 + yL1, yp = yI0 + yI1;
        YS[yoff] = yl.x + yl.y; PR[yoff] = yp.x + yp.y;
    }
#undef RWKV_LOAD
}
__device__ __forceinline__ void phase_m4(const Args& a, unsigned char* lds, int G, int bid, int tid) {
    const int lane = tid & 63, wave = __builtin_amdgcn_readfirstlane(tid >> 6);
    unsigned char* ws = karg_ws(); float* PL = (float*)(ws + M_PL);
    if (wave >= 4) return;
    for (int task = bid * 4 + wave; task < 16 * NSEG; task += G * 4) {
        const int seg = task & (NSEG - 1), chain = task >> 6;
        const int d = chain & 1, h = (chain >> 1) & 3, b = chain >> 3;
        f32x2 SL[32], SI[32]; int ln = lane; asm volatile("" : "+v"(ln));
#pragma unroll
        for (int i = 0; i < 32; ++i) { SL[i] = (f32x2){0.f, 0.f}; SI[i] = (f32x2){(2 * i == ln) ? 1.f : 0.f, (2 * i + 1 == ln) ? 1.f : 0.f}; }
        rwkv_pass1(SL, SI, b, h, d, seg * SEGLEN, SEGLEN, ws, lane, (float*)lds + wave * 640);
        float* o = PL + (((size_t)(chain * NSEG + seg) * 2) * 64 + lane) * 64;
#pragma unroll
        for (int i = 0; i < 32; i += 2) { *(f32x4*)(o + 2 * i) = (f32x4){SL[i].x, SL[i].y, SL[i + 1].x, SL[i + 1].y}; *(f32x4*)(o + 4096 + 2 * i) = (f32x4){SI[i].x, SI[i].y, SI[i + 1].x, SI[i + 1].y}; }
    }
}
__device__ __forceinline__ void phase_m5(const Args& a, unsigned char* lds, int G, int bid, int tid) {
    unsigned char* ws = karg_ws(); const float* PL = (const float*)(ws + M_PL); float* SI = (float*)(ws + M_SINIT);
    float* Sx = (float*)lds;
    const int lane = tid & 63, wv = __builtin_amdgcn_readfirstlane(tid >> 6), fr = lane & 15, fq = lane >> 4;
    const bool act = wv < 4;
    for (int u = bid; u < 64; u += G) {
        const int chain = u >> 2, row0 = (u & 3) * 16, col = (wv & 3) * 16 + fr;
        const float* Pg = PL + ((size_t)(chain * NSEG) * 2 + 1) * 4096; const float* Lg = PL + ((size_t)(chain * NSEG) * 2) * 4096;
        float* SIc = SI + (size_t)(chain * NSEG) * 4096;
        f32x4 cur = {0.f, 0.f, 0.f, 0.f}; f32x4 lv[3]; float pb[3][16];
#pragma unroll
        for (int q = 0; q < 3; ++q) { lv[q] = cur;
            if (act) { const float* Pn = Pg + (size_t)q * 8192; const float* Ln = Lg + (size_t)q * 8192;
#pragma unroll
                for (int ks = 0; ks < 16; ++ks) pb[q][ks] = Pn[(4 * ks + fq) * 64 + col];
#pragma unroll
                for (int j = 0; j < 4; ++j) lv[q][j] = Ln[(row0 + fq * 4 + j) * 64 + col]; } }
        for (int g0 = 0; g0 < NSEG - 1; g0 += 3) {
#pragma unroll
            for (int q = 0; q < 3; ++q) { const int g = g0 + q;
                if (act) {
#pragma unroll
                    for (int j = 0; j < 4; ++j) { SIc[(size_t)g * 4096 + (row0 + fq * 4 + j) * 64 + col] = cur[j]; Sx[(fq * 4 + j) * 68 + col] = cur[j]; }
                }
                __syncthreads();
                if (act) {
                    f32x4 acc = lv[q];
#pragma unroll
                    for (int ks = 0; ks < 16; ++ks) { const float av = Sx[fr * 68 + 4 * ks + fq]; acc = __builtin_amdgcn_mfma_f32_16x16x4f32(av, pb[q][ks], acc, 0, 0, 0); }
                    cur = acc;
                    if (g + 3 < NSEG - 1) { const float* Pn = Pg + (size_t)(g + 3) * 8192; const float* Ln = Lg + (size_t)(g + 3) * 8192;
#pragma unroll
                        for (int ks = 0; ks < 16; ++ks) pb[q][ks] = Pn[(4 * ks + fq) * 64 + col];
#pragma unroll
                        for (int j = 0; j < 4; ++j) lv[q][j] = Ln[(row0 + fq * 4 + j) * 64 + col]; }
                }
                __syncthreads();
            }
        }
        if (act) {
#pragma unroll
            for (int j = 0; j < 4; ++j) SIc[(size_t)(NSEG - 1) * 4096 + (row0 + fq * 4 + j) * 64 + col] = cur[j];
        }
    }
}
__device__ __forceinline__ void phase_m6(const Args& a, unsigned char* lds, int G, int bid, int tid) {
    const int lane = tid & 63, wave = __builtin_amdgcn_readfirstlane(tid >> 6);
    unsigned char* ws = karg_ws(); const float* SI = (const float*)(ws + M_SINIT);
    float* wl = (float*)lds + wave * 256;
    for (int task = bid * 8 + wave; task < 16 * (NSEG - 1); task += G * 8) {
        const int seg = 1 + task % (NSEG - 1), chain = task / (NSEG - 1);
        const int d = chain & 1, h = (chain >> 1) & 3, b = chain >> 3;
        float* YS = (float*)(ws + M_YS) + (size_t)d * NR * 256; const float* PR = (const float*)(ws + M_PR) + (size_t)d * NR * 256;
        f32x2 S0[32];
        const float* si = SI + ((size_t)(chain * NSEG + seg) * 64 + lane) * 64;
#pragma unroll
        for (int i = 0; i < 32; i += 2) { const f32x4 v = *(const f32x4*)(si + 2 * i); S0[i] = v.lo; S0[i + 1] = v.hi; }
        const int tau0 = seg * SEGLEN;
        size_t o0 = (size_t)chain_row(b, d, tau0) * 256 + h * 64 + lane, o1 = (size_t)chain_row(b, d, tau0 + 1) * 256 + h * 64 + lane;
        float p0 = PR[o0], p1 = PR[o1], y0 = YS[o0], y1 = YS[o1];
        for (int s = 0; s < SEGLEN; s += 2) {
            wl[lane] = p0; wl[64 + lane] = p1;
            const size_t c0 = o0, c1 = o1; const float yy0 = y0, yy1 = y1;
            if (s + 2 < SEGLEN) { o0 = (size_t)chain_row(b, d, tau0 + s + 2) * 256 + h * 64 + lane; o1 = (size_t)chain_row(b, d, tau0 + s + 3) * 256 + h * 64 + lane; p0 = PR[o0]; p1 = PR[o1]; y0 = YS[o0]; y1 = YS[o1]; }
            f32x2 a0 = {0.f, 0.f}, a1 = a0, b0 = a0, b1 = a0;
#pragma unroll
            for (int q = 0; q < 16; ++q) { const f32x4 u = *(const f32x4*)(wl + 4 * q), w = *(const f32x4*)(wl + 64 + 4 * q);
                a0 += S0[2 * q] * u.lo; a1 += S0[2 * q + 1] * u.hi; b0 += S0[2 * q] * w.lo; b1 += S0[2 * q + 1] * w.hi; }
            const f32x2 ta = a0 + a1, tb = b0 + b1;
            YS[c0] = yy0 + (ta.x + ta.y); YS[c1] = yy1 + (tb.x + tb.y);
            asm volatile("" ::: "memory");
        }
    }
}
__device__ __forceinline__ void phase_m7(const Args& a, int l, int gw, int NGW, int lane) {
    unsigned char* ws = karg_ws();
    const float* Y0 = (const float*)(ws + M_YS); const float* Y1 = Y0 + (size_t)NR * 256;
    const bf16* RR = (const bf16*)(ws + M_RR); const bf16* VV = (const bf16*)(ws + M_VV); const bf16* KD0 = (const bf16*)(ws + M_KD); const bf16* KD1 = (const bf16*)(ws + M_KD + A8);
    const bf16* GC = (const bf16*)(ws + M_GC); bf16* Y = (bf16*)(ws + OFF_XMY);
    for (int r = gw; r < NR; r += NGW) {
#pragma unroll
        for (int h = 0; h < 4; ++h) { const int c = h * 64 + lane; const size_t o = (size_t)r * 256 + c;
            const float ys = Y0[o] + Y1[o];
            const float mu = wave_sum(ys) * (1.f / 64.f); const float dv = ys - mu; const float var = wave_sum(dv * dv) * (1.f / 64.f);
            float ov = dv * rsqrtf(var + 64e-5f) * IN(33)[l * 256 + c] + IN(34)[l * 256 + c];
            const float rv = bf2f(RR[o]), rk = IN(32)[l * 256 + c], vv = bf2f(VV[o]);
            const float b0 = wave_sum(rv * bf2f(KD0[o]) * rk), b1 = wave_sum(rv * bf2f(KD1[o]) * rk);
            ov += (b0 + b1) * vv;
            Y[(size_t)r * DM + 512 + c] = (bf16)f2bf(ov * bf2f(GC[o])); }
    }
}

#define LAS __attribute__((address_space(3)))
#define XB_TMO      128
#define XB_XCNT(j)  (256  + 64 * (j))
#define XB_XSUB(j)  (1280 + 64 * (j))
#define XB_XGEN(j)  (2304 + 64 * (j))
#define XB_TOP      3328
#define XB_TOPGEN   3392
#define XCD_BAR_WORDS 3456
#define XB_SPIN_CAP (1u << 18)

__device__ __forceinline__ unsigned xb_ld(unsigned* p)              { return __hip_atomic_load(p, __ATOMIC_RELAXED, __HIP_MEMORY_SCOPE_AGENT); }
__device__ __forceinline__ unsigned xb_add(unsigned* p, unsigned v) { return __hip_atomic_fetch_add(p, v, __ATOMIC_RELAXED, __HIP_MEMORY_SCOPE_AGENT); }
__device__ __forceinline__ unsigned xb_xcc_id() { return (unsigned)__builtin_amdgcn_s_getreg((3 << 11) | 20) & 0xFu; }
#define XB_SPIN(cond, bar) do { unsigned _sp = 0; while (cond) { __builtin_amdgcn_s_sleep(1); \
    if ((++_sp & 255u) == 0u) { if (xb_ld(&(bar)[XB_TMO])) break; if (_sp > XB_SPIN_CAP) { atomicAdd(&(bar)[XB_TMO], 1u); break; } } } } while (0)

struct XcdBarrier {
    unsigned* bar; unsigned x;
    volatile LAS unsigned* st;
};

__device__ __forceinline__ XcdBarrier xcd_barrier_post(unsigned* bar, volatile LAS unsigned* st) {
    XcdBarrier b; b.bar = bar; b.x = xb_xcc_id(); b.st = st;
    if (threadIdx.x == 0) (void)xb_add(&bar[XB_XCNT(b.x)], 1u);
    return b;
}
__device__ __forceinline__ void xcd_barrier_complete(unsigned* bar, unsigned x, unsigned& nloc, unsigned& nx) {
    const unsigned G = gridDim.x * gridDim.y * gridDim.z;
    unsigned sum, cnt, mine, sp = 0u;
    for (;;) {
        sum = 0u; cnt = 0u; mine = 0u;
#pragma unroll
        for (unsigned j = 0; j < 16; ++j) { const unsigned c = xb_ld(&bar[XB_XCNT(j)]); sum += c; cnt += (c > 0u) ? 1u : 0u; mine = (j == x) ? c : mine; }
        if (sum == G) break;
        __builtin_amdgcn_s_sleep(1);
        if ((++sp & 255u) == 0u) { if (xb_ld(&bar[XB_TMO])) break; if (sp > XB_SPIN_CAP) { atomicAdd(&bar[XB_TMO], 1u); break; } }
    }
    nloc = mine > 0u ? mine : 1u; nx = cnt > 0u ? cnt : 1u;
}

__device__ __forceinline__ void xcd_barrier(const XcdBarrier& b) {
    asm volatile("s_waitcnt vmcnt(0)" ::: "memory");
    __syncthreads();
    if (threadIdx.x == 0) {
        unsigned* bar = b.bar;
        __builtin_amdgcn_s_waitcnt(0);
        unsigned nloc = b.st[0], nx = b.st[1];
        if (nloc == 0u) { xcd_barrier_complete(bar, b.x, nloc, nx); b.st[0] = nloc; b.st[1] = nx; }
        const unsigned old = xb_add(&bar[XB_XSUB(b.x)], 1u);
        const unsigned gen = old / nloc;
        if (old + 1u == (gen + 1u) * nloc) {
            __builtin_amdgcn_fence(__ATOMIC_RELEASE, "agent");
            asm volatile("s_waitcnt vmcnt(0)" ::: "memory");
            const unsigned og = xb_add(&bar[XB_TOP], 1u);
            const unsigned tg = og / nx;
            if (og + 1u == (tg + 1u) * nx) xb_add(&bar[XB_TOPGEN], 1u);
            else XB_SPIN(xb_ld(&bar[XB_TOPGEN]) == tg, bar);
            __builtin_amdgcn_fence(__ATOMIC_ACQUIRE, "agent");
            xb_add(&bar[XB_XGEN(b.x)], 1u);
            asm volatile("s_waitcnt vmcnt(0)" ::: "memory");
        } else {
            XB_SPIN(xb_ld(&bar[XB_XGEN(b.x)]) == gen, bar);
            __builtin_amdgcn_fence(__ATOMIC_ACQUIRE, "agent");
            asm volatile("s_waitcnt vmcnt(0)" ::: "memory");
        }
    }
    __syncthreads();
}

__global__ void __launch_bounds__(512, 2) mega(Args a) {
    extern __shared__ __attribute__((aligned(16))) unsigned char lds[];
    cg::grid_group grid = cg::this_grid();
    const int G = gridDim.x;
    PG8_LAS unsigned char* glds = (PG8_LAS unsigned char*)lds;
#define bid lbid()
#define tid ltid()
#define lane (ltid() & 63)
#define wave (__builtin_amdgcn_readfirstlane(ltid() >> 6))
#define gw (lbid() * 8 + __builtin_amdgcn_readfirstlane(ltid() >> 6))
#define NGW (G * 8)
    { volatile LAS unsigned* st0 = (volatile LAS unsigned*)((LAS unsigned char*)lds + 131072); if (threadIdx.x < 4) st0[threadIdx.x] = 0u; }
    __syncthreads();
    const XcdBarrier xbar = xcd_barrier_post((unsigned*)(karg_ws() + 229376), (volatile LAS unsigned*)((LAS unsigned char*)lds + 131072));
#define GSYNC() do { xcd_barrier(xbar); } while (0)

    phase_modgemv(a, (float*)lds, G, bid, tid);
    convert_weights(a, 0, (float*)(lds + 32768) + wave * (64 * 33), gw, NGW, lane, G, bid, tid);
    grid.sync();
#pragma clang loop unroll(full)
    for (int l = 0; l < 2; ++l) {
        if (l > 0) convert_weights(a, l, (float*)lds + wave * (64 * 33), gw, NGW, lane, G, bid, tid);
        phase_modulate(a, l, 0, gw, NGW, lane);
        GSYNC();
        for (int rp = 0; rp < REP_G1; ++rp)
        {
            unsigned char* ws = karg_ws(); float* outp = karg_out(); float* xctx = (float*)(ws + OFF_XCTX); bf16* XM = (bf16*)(ws + OFF_XMY); bf16* HU = (bf16*)(ws + OFF_HU); const float* modl = (const float*)(ws + OFF_MOD) + (size_t)l * 3 * 9216; (void)xctx; (void)XM; (void)HU; (void)modl; (void)outp;
            pg8::Gemm g{XM, (const bf16*)(ws + W_13A), NR, 2 * DFF, DM}; pg8::StaticOrder S; S.init(NR, 2 * DFF, G, bid);
            EpiSwiglu E{HU};
            pg8::gemm_phase<EpiSwiglu, pg8::StaticOrder, true, true>(glds, g, S, E);
        }
        GSYNC();
        {
            unsigned char* ws = karg_ws(); float* outp = karg_out(); float* xctx = (float*)(ws + OFF_XCTX); bf16* XM = (bf16*)(ws + OFF_XMY); bf16* HU = (bf16*)(ws + OFF_HU); const float* modl = (const float*)(ws + OFF_MOD) + (size_t)l * 3 * 9216; (void)xctx; (void)XM; (void)HU; (void)modl; (void)outp;
            pg8::Gemm g{HU, (const bf16*)(ws + W_2A), NR, DM, DFF}; pg8::StaticOrder S; S.init(NR, DM, G, bid);
            EpiResid E{outp, xctx, modl + 2 * 1024, 0.5f, l == 0 ? IN(0) : outp, l == 0 ? IN(2) : xctx};
            pg8::gemm_phase<EpiResid, pg8::StaticOrder, true, true>(glds, g, S, E);
        }
        GSYNC();
        phase_modulate(a, l, 1, gw, NGW, lane);
        GSYNC();
        {
            unsigned char* ws = karg_ws(); float* outp = karg_out(); float* xctx = (float*)(ws + OFF_XCTX); bf16* XM = (bf16*)(ws + OFF_XMY); bf16* HU = (bf16*)(ws + OFF_HU); const float* modl = (const float*)(ws + OFF_MOD) + (size_t)l * 3 * 9216; (void)xctx; (void)XM; (void)HU; (void)modl; (void)outp;
            pg8::Gemm g{XM, (const bf16*)(ws + W_IN), NR, UC, DM}; pg8::StaticOrder S; S.init(NR, UC, G, bid);
            EpiU E{HU, UC};
            pg8::gemm_phase<EpiU, pg8::StaticOrder, true, true>(glds, g, S, E);
        }
        GSYNC();
        for (int rp = 0; rp < REP_M1; ++rp) { phase_m1(a, l, lds, G, bid, tid);
        GSYNC(); }
        for (int rp = 0; rp < REP_M2; ++rp) { phase_m2(a, l, lds, G, bid, tid);
        GSYNC(); }
        for (int rp = 0; rp < REP_M3; ++rp) { phase_m3(a, l, lds, G, bid, tid);
        GSYNC(); }
        for (int rp = 0; rp < REP_SCAN; ++rp) { phase_m4(a, lds, G, bid, tid);
        GSYNC();
        phase_m5(a, lds, G, bid, tid);
        GSYNC();
        phase_m6(a, lds, G, bid, tid);
        GSYNC(); }
        phase_m7(a, l, gw, NGW, lane);
        GSYNC();
        {
            unsigned char* ws = karg_ws(); float* outp = karg_out(); float* xctx = (float*)(ws + OFF_XCTX); bf16* XM = (bf16*)(ws + OFF_XMY); bf16* HU = (bf16*)(ws + OFF_HU); const float* modl = (const float*)(ws + OFF_MOD) + (size_t)l * 3 * 9216; (void)xctx; (void)XM; (void)HU; (void)modl; (void)outp;
            const int MR = (l == 1) ? NLAT : NR;
            pg8::Gemm g{XM, (const bf16*)(ws + W_OUT), MR, DM, DM}; pg8::StaticOrder S; S.init(MR, DM, G, bid);
            EpiResid E{outp, xctx, modl + 5 * 1024, 1.0f, outp, xctx};
            pg8::gemm_phase<EpiResid, pg8::StaticOrder, true, true>(glds, g, S, E);
        }
        GSYNC();
        phase_modulate(a, l, 2, gw, NGW, lane);
        GSYNC();
        {
            unsigned char* ws = karg_ws(); float* outp = karg_out(); float* xctx = (float*)(ws + OFF_XCTX); bf16* XM = (bf16*)(ws + OFF_XMY); bf16* HU = (bf16*)(ws + OFF_HU); const float* modl = (const float*)(ws + OFF_MOD) + (size_t)l * 3 * 9216; (void)xctx; (void)XM; (void)HU; (void)modl; (void)outp;
            const int MR = (l == 1) ? NLAT : NR;
            pg8::Gemm g{XM, (const bf16*)(ws + W_13B), MR, 2 * DFF, DM}; pg8::StaticOrder S; S.init(MR, 2 * DFF, G, bid);
            EpiSwiglu E{HU};
            pg8::gemm_phase<EpiSwiglu, pg8::StaticOrder, true, true>(glds, g, S, E);
        }
        GSYNC();
        {
            unsigned char* ws = karg_ws(); float* outp = karg_out(); float* xctx = (float*)(ws + OFF_XCTX); bf16* XM = (bf16*)(ws + OFF_XMY); bf16* HU = (bf16*)(ws + OFF_HU); const float* modl = (const float*)(ws + OFF_MOD) + (size_t)l * 3 * 9216; (void)xctx; (void)XM; (void)HU; (void)modl; (void)outp;
            const int MR = (l == 1) ? NLAT : NR;
            pg8::Gemm g{HU, (const bf16*)(ws + W_2B), MR, DM, DFF}; pg8::StaticOrder S; S.init(MR, DM, G, bid);
            EpiResid E{outp, xctx, modl + 8 * 1024, 0.5f, outp, xctx};
            pg8::gemm_phase<EpiResid, pg8::StaticOrder, true, true>(glds, g, S, E);
        }
        GSYNC();
    }
    phase_final(a, gw, NGW, lane);
#undef bid
#undef tid
#undef lane
#undef wave
#undef gw
#undef NGW
}

extern "C" void kernel_launch(void* const* d_in, const int* in_sizes, int n_in, void* d_out, int out_size, void* d_ws, size_t ws_size, hipStream_t stream) {
    static int grid = 0;
    if (grid == 0) {
        int dev = 0, cus = 0, per_cu = 0;
        (void)hipGetDevice(&dev);
        (void)hipDeviceGetAttribute(&cus, hipDeviceAttributeMultiprocessorCount, dev);
        (void)hipFuncSetAttribute((const void*)mega, hipFuncAttributeMaxDynamicSharedMemorySize, LDS_BYTES);
        (void)hipOccupancyMaxActiveBlocksPerMultiprocessor(&per_cu, (const void*)mega, 512, LDS_BYTES);
        if (per_cu < 1) per_cu = 1;
        grid = cus * per_cu;
        if (n_in != 40 || ws_size < WS_NEED) { fprintf(stderr, "kernel_launch: unexpected n_in %d / ws %zu (need %zu)\n", n_in, ws_size, (size_t)WS_NEED); }
    }
    (void)hipMemsetAsync((char*)d_ws + OFF_MOD, 0, MOD_BYTES, stream);
    Args a{};
    for (int i = 0; i < 40; ++i) a.in[i] = (const float*)d_in[i];
    a.out = (float*)d_out; a.ws = (unsigned char*)d_ws;
    void* args[] = {&a};
    hipError_t e = hipLaunchCooperativeKernel((const void*)mega, dim3(grid), dim3(512), args, LDS_BYTES, stream);
    if (e != hipSuccess) fprintf(stderr, "cooperative launch failed: %s (grid %d)\n", hipGetErrorString(e), grid);
}
```

```cpp
#include <hip/hip_runtime.h>
#include <hip/hip_cooperative_groups.h>
#include <cstdio>
#include <cstdint>
namespace cg = cooperative_groups;
namespace pg8 {
#define PG8_LAS __attribute__((address_space(3)))
typedef unsigned short bf16_t;
typedef short bf16x8 __attribute__((ext_vector_type(8)));
typedef float f32x4 __attribute__((ext_vector_type(4)));
typedef unsigned u32x4 __attribute__((ext_vector_type(4)));
constexpr int BM = 256, BK = 64, HALF = 128, HTB = HALF * BK * 2  , STAGE_BYTES = 8 * HTB, NXCD = 8, WGM = 8;

__host__ __device__ __forceinline__ int lds_byte(int r, int c) { const int st = (r >> 4) * 2 + (c >> 5), rr = r & 15, cc = c & 31, ob = rr * 64 + cc * 2; return st * 1024 + (ob ^ (((ob >> 9) & 1) << 5)); }
__host__ __device__ __forceinline__ void stage_rc(int b, int& R, int& C) { const int st = b / 1024, sb = b % 1024, swz = sb ^ (((sb >> 9) & 1) << 5); R = (st >> 1) * 16 + swz / 64; C = (st & 1) * 32 + (swz % 64) / 2; }
__host__ __device__ __forceinline__ int perm32(int rho) { const int n = rho >> 4, i = rho & 15; return 8 * (i >> 2) + 4 * n + (i & 3); }

struct Unit { int pm, pn; };
struct Gemm { const bf16_t* A; const bf16_t* Bt; int M, N, K; };

struct StaticOrder {
    int nM, nN, nwg, G, c;
    __host__ __device__ void init(int M, int N, int G_, int c_) { nM = M / BM; nN = N / BM; nwg = nM * nN; G = G_; c = c_; }
    __host__ __device__ bool next(int i, Unit& u) const {
        const long L = (long)i * G + c; if (L >= nwg) return false;
        int wgid = (int)L; { const int q = nwg / NXCD, r = nwg % NXCD, xcd = wgid % NXCD, off = wgid / NXCD; wgid = (xcd < r ? xcd * (q + 1) : r * (q + 1) + (xcd - r) * q) + off; }
        const int nig = WGM * nN, gid = wgid / nig, fm = gid * WGM, gsz = (nM - fm) < WGM ? (nM - fm) : WGM;
        u.pm = fm + ((wgid % nig) % gsz); u.pn = (wgid % nig) / gsz; return true;
    }
    __device__ __forceinline__ void a_ready(const Unit&) const {}
    __device__ __forceinline__ void done(const Unit&) const {}
};

__device__ __forceinline__ unsigned cvt_pk_bf16(float lo, float hi) { unsigned r; asm volatile("v_cvt_pk_bf16_f32 %0, %1, %2" : "=v"(r) : "v"(lo), "v"(hi)); return r; }
typedef float f32x2 __attribute__((ext_vector_type(2)));
template <class Epi, class Sched, bool ALIGN_EPI = false, bool SP2 = false>
__device__ __forceinline__ void gemm_phase(PG8_LAS unsigned char* lds, const Gemm g, const Sched& S, const Epi& E) {
    int tid = threadIdx.x; asm volatile("" : "+v"(tid));
    const int wid = __builtin_amdgcn_readfirstlane(tid >> 6), lane = tid & 63, wr = wid >> 2, wc = wid & 3, fr = lane & 15, fq = lane >> 4;
    const int K = g.K, nt = K / BK;
    unsigned voffA[2], voffB[2];
#pragma unroll
    for (int i = 0; i < 2; ++i) { int R, C; stage_rc(tid * 16 + i * 8192, R, C); const int Rb = Epi::PERM ? ((R & ~31) + perm32(R & 31)) : R;
        voffA[i] = (unsigned)(R * K + C) * 2u; voffB[i] = (unsigned)(Rb * K + C) * 2u; }
    const size_t kstep = (size_t)(BK * 2);
    const size_t hstep = (size_t)HALF * K * 2;
    const size_t tstep = 2 * hstep;
    const unsigned ldsw = (unsigned)wid * 1024u;
    const int aoff = lds_byte(wr * 64 + fr, fq * 8), boff = lds_byte(wc * 32 + fr, fq * 8);
#define PG8_SA(b, h) (((b) * 2 + (h)) * HTB)
#define PG8_SB(b, h) ((4 + (b) * 2 + (h)) * HTB)
#define PG8_STAGE(bufoff, gbase, voff) do { _Pragma("unroll") for (int _i = 0; _i < 2; ++_i) \
        __builtin_amdgcn_global_load_lds((const unsigned*)((const char*)(gbase) + (voff)[_i]), (PG8_LAS unsigned*)(lds + (bufoff) + ldsw + _i * 8192), 16, 0, 0); } while (0)
#define PG8_LDA(dst, b, h) do { _Pragma("unroll") for (int m = 0; m < 4; ++m) _Pragma("unroll") for (int k = 0; k < 2; ++k) dst[m][k] = *(const PG8_LAS bf16x8*)(lds + PG8_SA(b, h) + aoff + m * 2048 + k * 1024); } while (0)
#define PG8_LDB(dst, b, h) do { _Pragma("unroll") for (int n = 0; n < 2; ++n) _Pragma("unroll") for (int k = 0; k < 2; ++k) dst[n][k] = *(const PG8_LAS bf16x8*)(lds + PG8_SB(b, h) + boff + n * 2048 + k * 1024); } while (0)
#define PG8_MMA(ai, bj, At, Bt) do { __builtin_amdgcn_s_setprio(1); _Pragma("unroll") for (int m = 0; m < 4; ++m) _Pragma("unroll") for (int n = 0; n < 2; ++n) _Pragma("unroll") for (int k = 0; k < 2; ++k) \
        acc[ai][bj][m][n] = __builtin_amdgcn_mfma_f32_16x16x32_bf16(Bt[n][k], At[m][k], acc[ai][bj][m][n], 0, 0, 0); __builtin_amdgcn_s_setprio(0); } while (0)
#define PG8_WAIT_V(n) asm volatile("s_waitcnt vmcnt(" #n ")" ::: "memory")
#define PG8_WAIT_L(n) asm volatile("s_waitcnt lgkmcnt(" #n ")" ::: "memory")
#define PG8_BAR __builtin_amdgcn_s_barrier()
#define PG8_SCHED __builtin_amdgcn_sched_barrier(0)
    Unit cur, nxt; int ui = 0;
    if (!S.next(0, cur)) return;
    f32x4 acc[2][2][4][2];
#pragma unroll
    for (int a = 0; a < 2; ++a)
#pragma unroll
        for (int b = 0; b < 2; ++b)
#pragma unroll
            for (int m = 0; m < 4; ++m)
#pragma unroll
                for (int n = 0; n < 2; ++n) acc[a][b][m][n] = (f32x4){0.f, 0.f, 0.f, 0.f};
    bf16x8 At[4][2], B0[2][2], B1[2][2];
    const char* cA = (const char*)g.A + (size_t)cur.pm * tstep; const char* cB = (const char*)g.Bt + (size_t)cur.pn * tstep;
    S.a_ready(cur);
    if constexpr (SP2) {
        PG8_STAGE(PG8_SB(0, 0), cB, voffB); PG8_STAGE(PG8_SB(0, 1), cB + hstep, voffB); PG8_STAGE(PG8_SA(0, 0), cA, voffA); PG8_STAGE(PG8_SA(0, 1), cA + hstep, voffA);
        if (wr == 1) PG8_BAR;
        PG8_WAIT_V(2); PG8_BAR;
        PG8_STAGE(PG8_SB(1, 0), cB + kstep, voffB); PG8_STAGE(PG8_SA(1, 0), cA + kstep, voffA); PG8_STAGE(PG8_SB(1, 1), cB + hstep + kstep, voffB);
        PG8_WAIT_V(6); PG8_BAR;
    } else {
        PG8_STAGE(PG8_SB(0, 0), cB, voffB); PG8_STAGE(PG8_SA(0, 0), cA, voffA); PG8_STAGE(PG8_SB(0, 1), cB + hstep, voffB); PG8_STAGE(PG8_SA(0, 1), cA + hstep, voffA);
        if (wr == 1) PG8_BAR;
        PG8_WAIT_V(4); PG8_BAR;
        PG8_STAGE(PG8_SB(1, 0), cB + kstep, voffB); PG8_STAGE(PG8_SA(1, 0), cA + kstep, voffA); PG8_STAGE(PG8_SB(1, 1), cB + hstep + kstep, voffB);
        PG8_WAIT_V(6); PG8_BAR;
    }
    for (;;) {
        const bool has_next = S.next(ui + 1, nxt);
        const char* nA = has_next ? (const char*)g.A + (size_t)nxt.pm * tstep : cA; const char* nB = has_next ? (const char*)g.Bt + (size_t)nxt.pn * tstep : cB;
        for (int t = 0; t < nt; t += 2) {
            const bool last = (t == nt - 2);
            const char* a1 = cA + (size_t)(t + 1) * kstep;
            const char* a2 = last ? nA : cA + (size_t)(t + 2) * kstep; const char* b2 = last ? nB : cB + (size_t)(t + 2) * kstep;
            const char* a3 = a2 + kstep; const char* b3 = b2 + kstep;
            if (last && has_next) S.a_ready(nxt);
            if constexpr (SP2) {
            PG8_LDB(B0, 0, 0); PG8_LDB(B1, 0, 1); PG8_SCHED; PG8_LDA(At, 0, 0); PG8_STAGE(PG8_SA(1, 1), a1 + hstep, voffA);
            PG8_WAIT_V(8); PG8_WAIT_L(0); PG8_BAR; PG8_MMA(0, 0, At, B0); PG8_MMA(0, 1, At, B1); PG8_BAR; PG8_SCHED;
            PG8_LDA(At, 0, 1); PG8_STAGE(PG8_SB(0, 0), b2, voffB); PG8_STAGE(PG8_SB(0, 1), b2 + hstep, voffB); PG8_STAGE(PG8_SA(0, 0), a2, voffA);
            PG8_WAIT_V(8); PG8_WAIT_L(0); PG8_BAR; PG8_MMA(1, 0, At, B0); PG8_MMA(1, 1, At, B1); PG8_BAR; PG8_SCHED;
            PG8_LDB(B0, 1, 0); PG8_LDB(B1, 1, 1); PG8_SCHED; PG8_LDA(At, 1, 0); PG8_STAGE(PG8_SA(0, 1), a2 + hstep, voffA);
            PG8_WAIT_V(8); PG8_WAIT_L(0); PG8_BAR; PG8_MMA(0, 0, At, B0); PG8_MMA(0, 1, At, B1); PG8_BAR; PG8_SCHED;
            PG8_LDA(At, 1, 1); PG8_STAGE(PG8_SB(1, 0), b3, voffB); PG8_STAGE(PG8_SB(1, 1), b3 + hstep, voffB); PG8_STAGE(PG8_SA(1, 0), a3, voffA);
            PG8_WAIT_V(8); PG8_WAIT_L(0); PG8_BAR; PG8_MMA(1, 0, At, B0); PG8_MMA(1, 1, At, B1); PG8_BAR; PG8_SCHED;
            } else {
            PG8_LDB(B0, 0, 0); PG8_SCHED; PG8_LDA(At, 0, 0); PG8_STAGE(PG8_SA(1, 1), a1 + hstep, voffA);
            PG8_WAIT_L(8); PG8_BAR; PG8_WAIT_L(0); PG8_MMA(0, 0, At, B0); PG8_BAR; PG8_SCHED;
            PG8_LDB(B1, 0, 1); PG8_STAGE(PG8_SB(0, 0), b2, voffB);
            PG8_BAR; PG8_WAIT_L(0); PG8_MMA(0, 1, At, B1); PG8_BAR;
            PG8_LDA(At, 0, 1); PG8_STAGE(PG8_SA(0, 0), a2, voffA);
            PG8_BAR; PG8_WAIT_L(0); PG8_MMA(1, 0, At, B0); PG8_BAR; PG8_SCHED;
            PG8_STAGE(PG8_SB(0, 1), b2 + hstep, voffB);
            PG8_WAIT_V(6); PG8_BAR; PG8_MMA(1, 1, At, B1); PG8_BAR;
            PG8_LDB(B0, 1, 0); PG8_SCHED; PG8_LDA(At, 1, 0); PG8_STAGE(PG8_SA(0, 1), a2 + hstep, voffA);
            PG8_WAIT_L(8); PG8_BAR; PG8_WAIT_L(0); PG8_MMA(0, 0, At, B0); PG8_BAR; PG8_SCHED;
            PG8_LDB(B1, 1, 1); PG8_STAGE(PG8_SB(1, 0), b3, voffB);
            PG8_BAR; PG8_WAIT_L(0); PG8_MMA(0, 1, At, B1); PG8_BAR;
            PG8_LDA(At, 1, 1); PG8_STAGE(PG8_SA(1, 0), a3, voffA);
            PG8_BAR; PG8_WAIT_L(0); PG8_MMA(1, 0, At, B0); PG8_BAR; PG8_SCHED;
            PG8_STAGE(PG8_SB(1, 1), b3 + hstep, voffB);
            PG8_WAIT_V(6); PG8_BAR; PG8_MMA(1, 1, At, B1); PG8_BAR;
            }
        }
        if constexpr (ALIGN_EPI) { if (wr == 0) PG8_BAR; }
        if constexpr (!Epi::AFTER_DRAIN) { E(acc, cur, wr, wc, fr, fq); S.done(cur); }
        if (!has_next) break;
#pragma unroll
        for (int a = 0; a < 2; ++a)
#pragma unroll
            for (int b = 0; b < 2; ++b)
#pragma unroll
                for (int m = 0; m < 4; ++m)
#pragma unroll
                    for (int n = 0; n < 2; ++n) acc[a][b][m][n] = (f32x4){0.f, 0.f, 0.f, 0.f};
        cur = nxt; cA = nA; cB = nB; ++ui;
        if constexpr (ALIGN_EPI) { if (wr == 1) PG8_BAR; }
    }
    PG8_WAIT_V(0);
    if constexpr (!ALIGN_EPI) { if (wr == 0) PG8_BAR; }
    PG8_BAR;
    if constexpr (Epi::AFTER_DRAIN) { E.fused(acc, cur, wr, wc, fr, fq, lds, wid, lane); S.done(cur); }
#undef PG8_SA
#undef PG8_SB
#undef PG8_STAGE
#undef PG8_LDA
#undef PG8_LDB
#undef PG8_MMA
#undef PG8_WAIT_V
#undef PG8_WAIT_L
#undef PG8_BAR
#undef PG8_SCHED
}
}

using pg8::f32x4; using pg8::bf16x8;
typedef unsigned short bf16;
typedef unsigned v4u __attribute__((ext_vector_type(4)));
typedef unsigned v2u __attribute__((ext_vector_type(2)));
typedef short s16x4 __attribute__((ext_vector_type(4)));

constexpr int DM = 1024, TLEN = 8192, CTXL = 256, TT = 8448, NLAT = 16384, NR = 16896, DFF = 2816, UC = 2560, NTILE = 528;
constexpr int NSEG = 64, SEGLEN = 132;
constexpr size_t MiB = 1u << 20;
constexpr size_t A8 = (size_t)NR * 256 * 2;
constexpr size_t OFF_MOD = 0, MOD_BYTES = 256 * 1024;
constexpr size_t OFF_XCTX = MiB / 4, OFF_XMY = 2 * MiB + MiB / 4, OFF_HU = 35 * MiB + MiB / 4, OFF_W = 126 * MiB, OFF_MIX = 167 * MiB, OFF_PR = 266 * MiB;
constexpr size_t W_13A = OFF_W, W_2A = OFF_W + 11 * MiB, W_13B = OFF_W + 16 * MiB + MiB / 2, W_2B = OFF_W + 27 * MiB + MiB / 2,
                 W_IN = OFF_W + 33 * MiB, W_OUT = OFF_W + 38 * MiB, W_UQ = OFF_W + 40 * MiB, W_UKV = OFF_W + 40 * MiB + 256 * 1024,
                 W_WUP = OFF_W + 40 * MiB + 384 * 1024, W_AUP = W_WUP + 65536, W_GUP = W_AUP + 65536, W_LWA = W_GUP + 65536, W_LWX = W_LWA + 65536;
constexpr size_t M_QB = OFF_MIX, M_KB = OFF_MIX + 12976128, M_VT = OFF_MIX + 25952256;
constexpr size_t M_LR0 = OFF_PR, M_LIX0 = OFF_PR + 2 * A8;
constexpr size_t M_SEGA = OFF_HU + 83 * MiB, M_SEGB = M_SEGA + MiB + MiB / 4, M_H0 = M_SEGB + MiB + MiB / 4;
constexpr size_t M_RR = OFF_MIX, M_KK = OFF_MIX + A8, M_VV = OFF_MIX + 2 * A8, M_WW = OFF_MIX + 3 * A8, M_BB = OFF_MIX + 7 * A8, M_KD = OFF_MIX + 9 * A8, M_GC = OFF_MIX + 11 * A8;
constexpr size_t M_YS = OFF_HU, M_PL = OFF_HU + 33 * MiB, M_SINIT = OFF_HU + 65 * MiB;
constexpr size_t M_PR = OFF_PR;
constexpr size_t WS_NEED = OFF_PR + 33 * MiB;
constexpr int LDS_BYTES = 131072 + 1024;
#ifndef REP_M1
#define REP_M1 1
#endif
#ifndef REP_M2
#define REP_M2 1
#endif
#ifndef REP_M3
#define REP_M3 1
#endif
#ifndef REP_SCAN
#define REP_SCAN 1
#endif
#ifndef REP_G1
#define REP_G1 1
#endif
constexpr float QSCALE = 0.10206207261596575f * 1.4426950408889634f;

struct Args { const float* in[40]; float* out; unsigned char* ws; };
typedef const __attribute__((address_space(4))) volatile unsigned long long kargq;
__device__ __forceinline__ const float* karg_in(int i) { kargq* p = (kargq*)__builtin_amdgcn_kernarg_segment_ptr(); return (const float*)p[i]; }
__device__ __forceinline__ float* karg_out() { kargq* p = (kargq*)__builtin_amdgcn_kernarg_segment_ptr(); return (float*)p[40]; }
__device__ __forceinline__ unsigned char* karg_ws() { kargq* p = (kargq*)__builtin_amdgcn_kernarg_segment_ptr(); return (unsigned char*)p[41]; }
#define IN(i) karg_in(i)
__device__ __forceinline__ int ltid() { int t = threadIdx.x; asm volatile("" : "+v"(t)); return t; }
__device__ __forceinline__ int lbid() { int t = blockIdx.x; asm volatile("" : "+s"(t)); return t; }
template <class T> __device__ __forceinline__ T* launder(T* p) { asm volatile("" : "+s"(p)); return p; }

__device__ __forceinline__ float bf2f(bf16 h) { return __uint_as_float((unsigned)h << 16); }
__device__ __forceinline__ unsigned f2bf(float f) { unsigned u = __float_as_uint(f); return (u + 0x7fffu + ((u >> 16) & 1u)) >> 16; }
__device__ __forceinline__ unsigned pk2(float lo, float hi) { return f2bf(lo) | (f2bf(hi) << 16); }
__device__ __forceinline__ float sigm(float x) { return 1.f / (1.f + __expf(-x)); }
__device__ __forceinline__ float siluf_(float x) { return x / (1.f + __expf(-x)); }
__device__ __forceinline__ float tanhf_(float y) { return 1.f - 2.f / (1.f + __expf(2.f * y)); }
__device__ __forceinline__ float geluf_(float x) { return 0.5f * x * (1.f + tanhf_(0.7978845608028654f * (x + 0.044715f * x * x * x))); }
__device__ __forceinline__ float wave_sum(float v) {
#pragma unroll
    for (int o = 1; o < 64; o <<= 1) v += __shfl_xor(v, o);
    return v;
}
struct TileInfo { int b, isctx, t0, seqbase, seqlen; };
__device__ __forceinline__ TileInfo tile_info(int tile) {
    TileInfo ti;
    if (tile < 512) { ti.b = tile >> 8; ti.isctx = 0; ti.t0 = (tile & 255) * 32; ti.seqbase = ti.b * TLEN; ti.seqlen = TLEN; }
    else { const int q = tile - 512; ti.b = q >> 3; ti.isctx = 1; ti.t0 = (q & 7) * 32; ti.seqbase = NLAT + ti.b * CTXL; ti.seqlen = CTXL; }
    return ti;
}

struct EpiSwiglu {
    static constexpr bool PERM = true, AFTER_DRAIN = false;
    bf16* H;
    __device__ __forceinline__ void operator()(const f32x4 (&acc)[2][2][4][2], const pg8::Unit& u, int wr, int wc, int fr, int fq) const {
        int pm = u.pm, pn = u.pn; asm volatile("" : "+s"(pm), "+s"(pn), "+s"(wr), "+s"(wc), "+v"(fr), "+v"(fq));
        bf16* tb = H + (size_t)pm * 256 * DFF + pn * 128;
        const unsigned loff = (unsigned)((wr * 64 + fr) * DFF + wc * 32 + 8 * fq);
#pragma unroll
        for (int ai = 0; ai < 2; ++ai)
#pragma unroll
            for (int m = 0; m < 4; ++m) {
                bf16* rowp = tb + (loff + (unsigned)((ai * 128 + m * 16) * DFF));
                const f32x4 g0 = acc[ai][0][m][0], g1 = acc[ai][0][m][1], u0 = acc[ai][1][m][0], u1 = acc[ai][1][m][1];
                v4u w;
                w.x = pg8::cvt_pk_bf16(siluf_(g0[0]) * u0[0], siluf_(g0[1]) * u0[1]); w.y = pg8::cvt_pk_bf16(siluf_(g0[2]) * u0[2], siluf_(g0[3]) * u0[3]);
                w.z = pg8::cvt_pk_bf16(siluf_(g1[0]) * u1[0], siluf_(g1[1]) * u1[1]); w.w = pg8::cvt_pk_bf16(siluf_(g1[2]) * u1[2], siluf_(g1[3]) * u1[3]);
                *(v4u*)rowp = w;
            }
    }
};
struct EpiU {
    static constexpr bool PERM = true, AFTER_DRAIN = false;
    bf16* O; int ldc;
    __device__ __forceinline__ void operator()(const f32x4 (&acc)[2][2][4][2], const pg8::Unit& u, int wr, int wc, int fr, int fq) const {
        int pm = u.pm, pn = u.pn; asm volatile("" : "+s"(pm), "+s"(pn), "+s"(wr), "+s"(wc), "+v"(fr), "+v"(fq));
        bf16* tb = O + (size_t)pm * 256 * ldc + pn * 256;
        const unsigned loff = (unsigned)((wr * 64 + fr) * ldc + wc * 32 + 8 * fq);
#pragma unroll
        for (int ai = 0; ai < 2; ++ai)
#pragma unroll
            for (int m = 0; m < 4; ++m) {
                bf16* rowp = tb + (loff + (unsigned)((ai * 128 + m * 16) * ldc));
#pragma unroll
                for (int bj = 0; bj < 2; ++bj) { const f32x4 v0 = acc[ai][bj][m][0], v1 = acc[ai][bj][m][1]; v4u w;
                    w.x = pg8::cvt_pk_bf16(v0[0], v0[1]); w.y = pg8::cvt_pk_bf16(v0[2], v0[3]); w.z = pg8::cvt_pk_bf16(v1[0], v1[1]); w.w = pg8::cvt_pk_bf16(v1[2], v1[3]);
                    *(v4u*)(rowp + bj * 128) = w; }
            }
    }
};
struct EpiResid {
    static constexpr bool PERM = false, AFTER_DRAIN = false;
    float* xlat; float* xctx; const float* gate; float coef; const float* slat; const float* sctx;
    __device__ __forceinline__ void operator()(const f32x4 (&acc)[2][2][4][2], const pg8::Unit& u, int wr, int wc, int fr, int fq) const {
        int pm = u.pm, pn = u.pn; asm volatile("" : "+s"(pm), "+s"(pn), "+s"(wr), "+s"(wc), "+v"(fr), "+v"(fq));
        const size_t toff = (pm < 64 ? (size_t)pm : (size_t)(pm - 64)) * 256 * DM + pn * 256;
        float* tb = (pm < 64 ? xlat : xctx) + toff; const float* sb = (pm < 64 ? slat : sctx) + toff;
        const float* g = gate + (pm < 64 ? (pm >> 5) : 2) * 9216 + pn * 256;
        const unsigned coff = (unsigned)(wc * 32 + 4 * fq), loff = (unsigned)((wr * 64 + fr) * DM) + coff;
        f32x4 gv[2][2];
#pragma unroll
        for (int bj = 0; bj < 2; ++bj)
#pragma unroll
            for (int n = 0; n < 2; ++n) gv[bj][n] = coef * *(const f32x4*)(g + (coff + (unsigned)(bj * 128 + n * 16)));
#pragma unroll
        for (int ai = 0; ai < 2; ++ai)
#pragma unroll
            for (int m = 0; m < 4; ++m) {
                float* xr = tb + (loff + (unsigned)((ai * 128 + m * 16) * DM)); const float* sr = sb + (loff + (unsigned)((ai * 128 + m * 16) * DM));
#pragma unroll
                for (int bj = 0; bj < 2; ++bj)
#pragma unroll
                    for (int n = 0; n < 2; ++n) { float* xp = xr + (bj * 128 + n * 16);
                        f32x4 xv = *(const f32x4*)(sr + (bj * 128 + n * 16)); xv += gv[bj][n] * acc[ai][bj][m][n]; *(f32x4*)xp = xv; }
                asm volatile("" ::: "memory");
            }
    }
};

__device__ __forceinline__ void phase_modgemv(const Args& a, float* red, int G, int bid, int tid) {
    const float* c = IN(1); const float* cctx = IN(3); const float* ada_w = IN(4); const float* ada_b = IN(5);
    float* mod = (float*)(karg_ws() + OFF_MOD);
    const int w = tid >> 6, lane = tid & 63;
    for (int u = bid; u < 576; u += G) {
        const int l = u / 288, rem = u % 288, jt = rem >> 3, ks = rem & 7;
        const int kb = ks * 128 + w * 16, j0 = jt * 256 + lane * 4;
        f32x4 acc0 = {0.f, 0.f, 0.f, 0.f}, acc1 = acc0, acc2 = acc0;
        for (int kk = 0; kk < 16; ++kk) { const int k = kb + kk;
            const float s0 = siluf_(c[k]), s1 = siluf_(c[1024 + k]), s2 = siluf_(cctx[k]);
            const f32x4 wv = *(const f32x4*)(ada_w + ((size_t)(l * 1024 + k)) * 9216 + j0);
            acc0 += s0 * wv; acc1 += s1 * wv; acc2 += s2 * wv; }
        float* rp = red + (w * 3) * 256 + lane * 4;
        *(f32x4*)rp = acc0; *(f32x4*)(rp + 256) = acc1; *(f32x4*)(rp + 512) = acc2;
        __syncthreads();
        for (int o = tid; o < 768; o += 512) { const int m = o >> 8, jj = o & 255; float s = 0.f;
#pragma unroll
            for (int ww = 0; ww < 8; ++ww) s += red[(ww * 3 + m) * 256 + jj];
            const int j = jt * 256 + jj; if (ks == 0) s += ada_b[l * 9216 + j];
            atomicAdd(&mod[(l * 3 + m) * 9216 + j], s); }
        __syncthreads();
    }
}
__device__ __forceinline__ void phase_copy(const Args& a, int G, int bid, int tid) {
    const f32x4* x4 = (const f32x4*)IN(0); f32x4* o4 = (f32x4*)karg_out();
    for (int i = bid * 512 + tid; i < NLAT * DM / 4; i += G * 512) o4[i] = x4[i];
    const f32x4* c4 = (const f32x4*)IN(2); f32x4* xc4 = (f32x4*)(karg_ws() + OFF_XCTX);
    for (int i = bid * 512 + tid; i < 512 * DM / 4; i += G * 512) xc4[i] = c4[i];
}
__device__ __forceinline__ int swiglu_map(int n) { return n < DFF ? ((n >> 7) * 256 + (n & 127)) : ((((n - DFF) >> 7) * 256) + 128 + ((n - DFF) & 127)); }
__device__ __forceinline__ void transpose_item(const float* W, int K, int N, bf16* WT, float* scr, int item, int lane, int mode, const float* kscale) {
    const int nblk = N / 32, kb = item / nblk, nb = item % nblk, k0 = 64 * kb, n0 = 32 * nb;
#pragma unroll 8
    for (int i = 0; i < 32; ++i) { const int kk = 2 * i + (lane >> 5); float v = W[(size_t)(k0 + kk) * N + n0 + (lane & 31)]; if (kscale) v *= kscale[k0 + kk]; scr[kk * 33 + (lane & 31)] = v; }
    __builtin_amdgcn_wave_barrier();
    const int c = lane & 7;
#pragma unroll
    for (int j = 0; j < 4; ++j) { const int n = (lane >> 3) + 8 * j; const float* s = scr + (8 * c) * 33 + n;
        v4u o; o.x = pk2(s[0 * 33], s[1 * 33]); o.y = pk2(s[2 * 33], s[3 * 33]); o.z = pk2(s[4 * 33], s[5 * 33]); o.w = pk2(s[6 * 33], s[7 * 33]);
        const int nn = n0 + n, drow = mode ? swiglu_map(nn) : nn;
        *(v4u*)(WT + (size_t)drow * K + k0 + 8 * c) = o; }
    __builtin_amdgcn_wave_barrier();
}
__device__ __forceinline__ void convert_weights(const Args& a, int l, float* scr, int gw, int NGW, int lane, int G, int bid, int tid) {
    constexpr int I13 = 16 * 176, I2 = 44 * 32, IIN = 16 * 77, IOUT = 16 * 32, IUQ = 4 * 12, IUKV = 2 * 16;
    constexpr int IEX = 80;
    constexpr int NIT = 2 * I13 + 2 * I2 + IIN + IOUT + IUQ + IUKV + IEX;
    unsigned char* ws = karg_ws();
    for (int it = gw; it < NIT; it += NGW) {
        int r = it;
        if (r < I13) { transpose_item(IN(6) + (size_t)l * DM * 2 * DFF, DM, 2 * DFF, (bf16*)(ws + W_13A), scr, r, lane, 1, nullptr); continue; } r -= I13;
        if (r < I13) { transpose_item(IN(8) + (size_t)l * DM * 2 * DFF, DM, 2 * DFF, (bf16*)(ws + W_13B), scr, r, lane, 1, nullptr); continue; } r -= I13;
        if (r < I2) { transpose_item(IN(7) + (size_t)l * DFF * DM, DFF, DM, (bf16*)(ws + W_2A), scr, r, lane, 0, nullptr); continue; } r -= I2;
        if (r < I2) { transpose_item(IN(9) + (size_t)l * DFF * DM, DFF, DM, (bf16*)(ws + W_2B), scr, r, lane, 0, nullptr); continue; } r -= I2;
        if (r < IIN) { transpose_item(IN(10) + (size_t)l * DM * 2464, DM, 2464, (bf16*)(ws + W_IN), scr, r, lane, 0, nullptr); continue; } r -= IIN;
        if (r < IOUT) { transpose_item(IN(11) + (size_t)l * DM * DM, DM, DM, (bf16*)(ws + W_OUT), scr, r, lane, 0, nullptr); continue; } r -= IOUT;
        if (r < IUQ) { transpose_item(IN(36) + (size_t)l * 256 * 384, 256, 384, (bf16*)(ws + W_UQ), scr, r, lane, 0, IN(35) + l * 256); continue; } r -= IUQ;
        if (r < IUKV) { transpose_item(IN(38) + (size_t)l * 128 * 512, 128, 512, (bf16*)(ws + W_UKV), scr, r, lane, 0, IN(37) + l * 128); continue; } r -= IUKV;
        if (r < 16) { const int d = r >> 3; transpose_item(IN(26) + (size_t)(l * 2 + d) * 64 * 256, 64, 256, (bf16*)(ws + W_WUP) + d * 256 * 64, scr, r & 7, lane, 0, nullptr); continue; } r -= 16;
        if (r < 16) { const int d = r >> 3; transpose_item(IN(28) + (size_t)(l * 2 + d) * 64 * 256, 64, 256, (bf16*)(ws + W_AUP) + d * 256 * 64, scr, r & 7, lane, 0, nullptr); continue; } r -= 16;
        if (r < 16) { transpose_item(IN(29) + (size_t)l * 128 * 256, 128, 256, (bf16*)(ws + W_GUP), scr, r, lane, 0, nullptr); continue; } r -= 16;
        if (r < 16) { const int m = r >> 1; transpose_item(IN(18) + (size_t)(l * 8 + m) * 4096, 64, 64, (bf16*)(ws + W_LWA) + m * 4096, scr, r & 1, lane, 0, nullptr); continue; } r -= 16;
        { const int m = r >> 1; transpose_item(IN(20) + (size_t)(l * 8 + m) * 4096, 64, 64, (bf16*)(ws + W_LWX) + m * 4096, scr, r & 1, lane, 0, nullptr); }
    }
    v4u z = {0u, 0u, 0u, 0u}; v4u* zp = (v4u*)(ws + W_IN + (size_t)2464 * DM * 2);
    for (int i = bid * 512 + tid; i < 96 * DM * 2 / 16; i += G * 512) zp[i] = z;
}
__device__ __forceinline__ void phase_modulate(const Args& a, int l, int which, int gw, int NGW, int lane) {
    unsigned char* ws = karg_ws(); const float* outp = karg_out();
    const bool first = (l == 0 && which == 0);
    const float* srcl = first ? IN(0) : outp; const float* srcc = first ? IN(2) : (const float*)(ws + OFF_XCTX);
    const float* mod = (const float*)(ws + OFF_MOD) + (size_t)l * 3 * 9216;
    bf16* XM = (bf16*)(ws + OFF_XMY);
    for (int r = gw; r < NR; r += NGW) {
        const float* xr = r < NLAT ? srcl + (size_t)r * DM : srcc + (size_t)(r - NLAT) * DM;
        const float* mm = mod + (r < NLAT ? (r >> 13) : 2) * 9216 + which * 3 * 1024;
        f32x4 v[4]; float ss = 0.f;
#pragma unroll
        for (int j = 0; j < 4; ++j) { v[j] = *(const f32x4*)(xr + 4 * lane + 256 * j); ss += (v[j][0] * v[j][0] + v[j][1] * v[j][1]) + (v[j][2] * v[j][2] + v[j][3] * v[j][3]); }
        const float rstd = rsqrtf(wave_sum(ss) * (1.f / DM) + 1e-6f);
#pragma unroll
        for (int j = 0; j < 4; ++j) { const int c = 4 * lane + 256 * j; const f32x4 sh = *(const f32x4*)(mm + c), sc = *(const f32x4*)(mm + 1024 + c);
            const f32x4 o = v[j] * rstd * (1.f + sc) + sh; v2u w; w.x = pk2(o[0], o[1]); w.y = pk2(o[2], o[3]);
            *(v2u*)(XM + (size_t)r * DM + c) = w; }
    }
}
__device__ __forceinline__ void phase_final(const Args& a, int gw, int NGW, int lane) {
    const float* fn = IN(39); float* outp = karg_out();
    for (int r = gw; r < NLAT; r += NGW) {
        float* xr = outp + (size_t)r * DM; f32x4 v[4]; float ss = 0.f;
#pragma unroll
        for (int j = 0; j < 4; ++j) { v[j] = *(const f32x4*)(xr + 4 * lane + 256 * j); ss += (v[j][0] * v[j][0] + v[j][1] * v[j][1]) + (v[j][2] * v[j][2] + v[j][3] * v[j][3]); }
        const float rstd = rsqrtf(wave_sum(ss) * (1.f / DM) + 1e-6f);
#pragma unroll
        for (int j = 0; j < 4; ++j) { const int c = 4 * lane + 256 * j; const f32x4 g = *(const f32x4*)(fn + c); *(f32x4*)(xr + c) = v[j] * rstd * g; }
    }
}

__device__ __forceinline__ void phase_m1(const Args& a, int l, unsigned char* lds, int G, int bid, int tid_unused) {
    unsigned char* ws = karg_ws();
    const bf16* U = (const bf16*)(ws + OFF_HU);
    bf16* Y = (bf16*)(ws + OFF_XMY);
    for (int tile = bid; tile < NTILE; tile += G) {
        const TileInfo ti = tile_info(tile);
        const int row0 = tile * 32;
        {
            const int tid = ltid(); const int lane = tid & 63, wave = __builtin_amdgcn_readfirstlane(tid >> 6), ch = tid & 255, part = tid >> 8; (void)lane; (void)wave; (void)ch; (void)part;
            float* z = (float*)lds;
            float* cv = (float*)(lds + 65536);
            for (int tt = part; tt < 62; tt += 2) { const int t = ti.t0 - 15 + tt; float zz = 0.f;
                if (t >= 0 && t < ti.seqlen) { const bf16* ur = U + (size_t)(ti.seqbase + t) * UC; zz = bf2f(ur[ch]) * sigm(bf2f(ur[256 + ch])); }
                z[tt * 256 + ch] = zz; }
            __syncthreads();
            const float* dw = IN(12) + (size_t)l * 31 * 256 + ch;
            float acc[16]; const float bias = IN(13)[l * 256 + ch];
#pragma unroll
            for (int o = 0; o < 16; ++o) acc[o] = bias;
            for (int j = 0; j < 31; ++j) { const float w = dw[j * 256];
#pragma unroll
                for (int o = 0; o < 16; ++o) acc[o] += w * z[(part * 16 + o + j) * 256 + ch]; }
#pragma unroll
            for (int o = 0; o < 16; ++o) cv[(part * 16 + o) * 256 + ch] = acc[o];
            __syncthreads();
            const f32x4 lg = *(const f32x4*)(IN(14) + l * 256 + lane * 4), lb = *(const f32x4*)(IN(15) + l * 256 + lane * 4);
#pragma unroll
            for (int q = 0; q < 4; ++q) { const int t = wave * 4 + q; const f32x4 v = *(const f32x4*)(cv + t * 256 + lane * 4);
                const float mu = wave_sum((v[0] + v[1]) + (v[2] + v[3])) * (1.f / 256.f);
                const f32x4 dv = v - mu; const float var = wave_sum((dv[0] * dv[0] + dv[1] * dv[1]) + (dv[2] * dv[2] + dv[3] * dv[3])) * (1.f / 256.f);
                const f32x4 yn = dv * rsqrtf(var + 1e-5f) * lg + lb;
                v2u w; w.x = pk2(siluf_(yn[0]), siluf_(yn[1])); w.y = pk2(siluf_(yn[2]), siluf_(yn[3]));
                *(v2u*)(Y + (size_t)(row0 + t) * DM + lane * 4) = w; }
            __syncthreads();
        }
        {
            float* xvf = (float*)lds;
            bf16* xvb = (bf16*)(lds + 32768);
            bf16* rg = (bf16*)(lds + 49664);
            bf16* ixg = (bf16*)(lds + 82432);
            {
                const int tid = ltid(); const int ch = tid & 255, part = tid >> 8;
                const float* cw = IN(16) + (size_t)l * 4 * 256 + ch; const float w0 = cw[0], w1 = cw[256], w2 = cw[512], w3 = cw[768], cb = IN(17)[l * 256 + ch];
                float xin[19];
#pragma unroll
                for (int i = 0; i < 19; ++i) { const int t = ti.t0 + part * 16 + i - 2; xin[i] = (t >= 0 && t < ti.seqlen) ? bf2f(U[(size_t)(ti.seqbase + t) * UC + 512 + ch]) : 0.f; }
#pragma unroll
                for (int o = 0; o < 16; ++o) { const int tl = part * 16 + o;
                    const float v = cb + w0 * xin[o] + w1 * xin[o + 1] + w2 * xin[o + 2] + w3 * xin[o + 3];
                    xvf[tl * 256 + ch] = v; xvb[tl * 264 + ch] = (bf16)f2bf(v);
                }
            }
            __syncthreads();
            {
                const int tid = ltid(); const int ln = tid & 63, wv = __builtin_amdgcn_readfirstlane(tid >> 6), fr = ln & 15, fq = ln >> 4, blk = wv >> 1;
                const bf16* LWAt = (const bf16*)(ws + W_LWA); const bf16* LWXt = (const bf16*)(ws + W_LWX);
                bf16x8 af[2][2];
#pragma unroll
                for (int mt = 0; mt < 2; ++mt)
#pragma unroll
                    for (int ks = 0; ks < 2; ++ks) af[mt][ks] = *(const bf16x8*)(xvb + (mt * 16 + fr) * 264 + blk * 64 + ks * 32 + fq * 8);
#pragma unroll 1
                for (int dn = 0; dn < 4; ++dn) { const int d = dn >> 1, nt = wv * 2 + (dn & 1), ch = nt * 16 + fr, jj = (nt & 3) * 16 + fr;
                    f32x4 ca[2], cx[2];
#pragma unroll
                    for (int mt = 0; mt < 2; ++mt) { ca[mt] = (f32x4){0.f, 0.f, 0.f, 0.f}; cx[mt] = ca[mt]; }
#pragma unroll
                    for (int ks = 0; ks < 2; ++ks) { const size_t wo = ((size_t)(d * 4 + blk) * 64 + jj) * 64 + ks * 32 + fq * 8;
                        const bf16x8 ba = *(const bf16x8*)(LWAt + wo), bx = *(const bf16x8*)(LWXt + wo);
#pragma unroll
                        for (int mt = 0; mt < 2; ++mt) { ca[mt] = __builtin_amdgcn_mfma_f32_16x16x32_bf16(af[mt][ks], ba, ca[mt], 0, 0, 0); cx[mt] = __builtin_amdgcn_mfma_f32_16x16x32_bf16(af[mt][ks], bx, cx[mt], 0, 0, 0); } }
                    const float bga = IN(19)[(l * 2 + d) * 256 + ch], bgx = IN(21)[(l * 2 + d) * 256 + ch];
                    bf16* LR = (bf16*)(ws + M_LR0 + (size_t)d * A8); bf16* LIX = (bf16*)(ws + M_LIX0 + (size_t)d * A8);
#pragma unroll
                    for (int mt = 0; mt < 2; ++mt)
#pragma unroll
                        for (int j = 0; j < 4; ++j) { const int t = mt * 16 + fq * 4 + j;
                            const bf16 rb = (bf16)f2bf(sigm(ca[mt][j] + bga)), ib = (bf16)f2bf(sigm(cx[mt][j] + bgx) * xvf[t * 256 + ch]);
                            LR[(size_t)(row0 + t) * 256 + ch] = rb; LIX[(size_t)(row0 + t) * 256 + ch] = ib;
                            rg[(d * 32 + t) * 256 + ch] = rb; ixg[(d * 32 + t) * 256 + ch] = ib; }
                }
            }
            __syncthreads();
            {
                const int tid = ltid(); const int ch = tid & 255, d = tid >> 8;
                const float lam = IN(22)[(l * 2 + d) * 256 + ch];
                const float cch = -8.f * log1pf(__expf(-lam));
                float A = 1.f, B = 0.f;
#pragma unroll 8
                for (int tt = 0; tt < 32; ++tt) { const int t = d ? 31 - tt : tt;
                    const float al = __expf(cch * bf2f(rg[(d * 32 + t) * 256 + ch])); const float bb = sqrtf(fmaxf(1.f - al * al, 0.f)) * bf2f(ixg[(d * 32 + t) * 256 + ch]); B = al * B + bb; A *= al; }
                ((float*)(ws + M_SEGA))[(size_t)(tile * 2 + d) * 256 + ch] = A;
                ((float*)(ws + M_SEGB))[(size_t)(tile * 2 + d) * 256 + ch] = B;
            }
            __syncthreads();
        }
        {
            const int tid = ltid(); const int lane = tid & 63, wave = __builtin_amdgcn_readfirstlane(tid >> 6), ch = tid & 255, part = tid >> 8; (void)lane; (void)wave; (void)ch; (void)part;
            bf16* As = (bf16*)lds;
            float* kr = (float*)(lds + 32768);
            float* rs = (float*)(lds + 32768 + 4096);
            for (int idx = tid; idx < 32 * 52; idx += 512) { const int t = idx / 52, cc = idx % 52;
                const v4u v = *(const v4u*)(U + (size_t)(row0 + t) * UC + 2048 + cc * 8);
                if (cc < 48) *(v4u*)(As + t * 392 + cc * 8) = v;
                else { const int c0 = (cc - 48) * 8; float* kp = kr + t * 32 + c0;
                    kp[0] = __uint_as_float(v.x << 16); kp[1] = __uint_as_float(v.x & 0xffff0000u); kp[2] = __uint_as_float(v.y << 16); kp[3] = __uint_as_float(v.y & 0xffff0000u);
                    kp[4] = __uint_as_float(v.z << 16); kp[5] = __uint_as_float(v.z & 0xffff0000u); kp[6] = __uint_as_float(v.w << 16); kp[7] = __uint_as_float(v.w & 0xffff0000u); } }
            __syncthreads();
#pragma unroll
            for (int q = 0; q < 4; ++q) { const int t = wave * 4 + q; float sq = 0.f, sk = 0.f;
#pragma unroll
                for (int j = 0; j < 4; ++j) { const float v = bf2f(As[t * 392 + lane + 64 * j]); sq += v * v; }
#pragma unroll
                for (int j = 0; j < 2; ++j) { const float v = bf2f(As[t * 392 + 256 + lane + 64 * j]); sk += v * v; }
                sq = wave_sum(sq); sk = wave_sum(sk);
                if (lane == 0) { rs[t * 2] = rsqrtf(sq * (1.f / 256.f) + 1e-6f); rs[t * 2 + 1] = rsqrtf(sk * (1.f / 128.f) + 1e-6f); } }
            __syncthreads();
            const int fr = lane & 15, fq = lane >> 4;
            bf16* QB = (bf16*)(ws + M_QB); bf16* KB = (bf16*)(ws + M_KB); bf16* VT = (bf16*)(ws + M_VT);
            const bf16* WUQ = (const bf16*)(ws + W_UQ); const bf16* WUKV = (const bf16*)(ws + W_UKV);
            const int keybase = ti.isctx ? TLEN : 0;
#pragma unroll 1
            for (int i = 0; i < 3; ++i) { const int nt = wave * 3 + i;
                f32x4 c0 = {0.f, 0.f, 0.f, 0.f}, c1 = c0;
#pragma unroll
                for (int ks = 0; ks < 8; ++ks) { const bf16x8 bfr = *(const bf16x8*)(WUQ + (size_t)(nt * 16 + fr) * 256 + ks * 32 + fq * 8);
                    const bf16x8 a0 = *(const bf16x8*)(As + fr * 392 + ks * 32 + fq * 8), a1 = *(const bf16x8*)(As + (16 + fr) * 392 + ks * 32 + fq * 8);
                    c0 = __builtin_amdgcn_mfma_f32_16x16x32_bf16(a0, bfr, c0, 0, 0, 0); c1 = __builtin_amdgcn_mfma_f32_16x16x32_bf16(a1, bfr, c1, 0, 0, 0); }
                const int hq = nt / 6, wt = nt % 6, dd = wt * 16 + fr;
#pragma unroll
                for (int mt = 0; mt < 2; ++mt)
#pragma unroll
                    for (int j = 0; j < 4; ++j) { const int tl = mt * 16 + fq * 4 + j; const int t = ti.t0 + tl;
                        float v = (mt ? c1[j] : c0[j]) * rs[tl * 2];
                        const float pv = __shfl_xor(v, 8);
                        if (wt >= 4 && !ti.isctx) { const int f = fr & 7; const float pos = (wt == 4) ? (float)(t >> 6) : (float)(t & 63);
                            const float ang = pos * __expf(-(float)f * (9.210340371976184f / 8.f)); float sn, cs; __sincosf(ang, &sn, &cs);
                            v = (fr & 8) ? (v * cs + pv * sn) : (v * cs - pv * sn); }
                        QB[((size_t)(ti.b * 4 + hq) * TT + keybase + t) * 96 + dd] = (bf16)f2bf(v * QSCALE); } }
#pragma unroll 1
            for (int i = 0; i < 4; ++i) { const int nt = wave * 4 + i;
                f32x4 c0 = {0.f, 0.f, 0.f, 0.f}, c1 = c0;
#pragma unroll
                for (int ks = 0; ks < 4; ++ks) { const bf16x8 bfr = *(const bf16x8*)(WUKV + (size_t)(nt * 16 + fr) * 128 + ks * 32 + fq * 8);
                    const bf16x8 a0 = *(const bf16x8*)(As + fr * 392 + 256 + ks * 32 + fq * 8), a1 = *(const bf16x8*)(As + (16 + fr) * 392 + 256 + ks * 32 + fq * 8);
                    c0 = __builtin_amdgcn_mfma_f32_16x16x32_bf16(a0, bfr, c0, 0, 0, 0); c1 = __builtin_amdgcn_mfma_f32_16x16x32_bf16(a1, bfr, c1, 0, 0, 0); }
                const int hk = nt >> 3, wt = nt & 7;
#pragma unroll
                for (int mt = 0; mt < 2; ++mt)
#pragma unroll
                    for (int j = 0; j < 4; ++j) { const int tl = mt * 16 + fq * 4 + j; const int key = keybase + ti.t0 + tl;
                        const float v = (mt ? c1[j] : c0[j]) * rs[tl * 2 + 1];
                        if (wt < 4) KB[((size_t)(ti.b * 4 + hk) * TT + key) * 96 + wt * 16 + fr] = (bf16)f2bf(v);
                        else VT[((size_t)(ti.b * 4 + hk) * 64 + (wt - 4) * 16 + fr) * TT + key] = (bf16)f2bf(v); } }
            { const int tl = tid >> 4, p = tid & 15, ax = p >> 3, f = p & 7; const int t = ti.t0 + tl;
                float x0 = kr[tl * 32 + ax * 16 + f], x1 = kr[tl * 32 + ax * 16 + 8 + f];
                if (!ti.isctx) { const float pos = ax == 0 ? (float)(t >> 6) : (float)(t & 63); const float ang = pos * __expf(-(float)f * (9.210340371976184f / 8.f));
                    float sn, cs; __sincosf(ang, &sn, &cs); const float y0 = x0 * cs - x1 * sn, y1 = x1 * cs + x0 * sn; x0 = y0; x1 = y1; }
                const bf16 b0 = (bf16)f2bf(x0), b1 = (bf16)f2bf(x1);
#pragma unroll
                for (int h = 0; h < 4; ++h) { bf16* kp = KB + ((size_t)(ti.b * 4 + h) * TT + keybase + t) * 96 + 64 + ax * 16 + f; kp[0] = b0; kp[8] = b1; } }
            __syncthreads();
        }
    }
}

__device__ __forceinline__ void attn_unit(unsigned char* lds, const bf16* QB, const bf16* KB, const bf16* VT, bf16* Y, int b, int h, int q0, int key_lo, int nkt, int tid) {
    const int lane = tid & 63, wave = tid >> 6, fr = lane & 15, fq = lane >> 4;
    const int bh = b * 4 + h;
    constexpr int KSTR = 104, VSTR = 72, KBUF = 64 * KSTR, VBUF = 64 * VSTR;
    bf16* Ks = (bf16*)lds;
    bf16* Vs = (bf16*)lds + 2 * KBUF;
    const int qw = q0 + wave * 32;
    bf16x8 qf[2][3];
#pragma unroll
    for (int qt = 0; qt < 2; ++qt)
#pragma unroll
        for (int ks = 0; ks < 3; ++ks) qf[qt][ks] = *(const bf16x8*)(QB + ((size_t)bh * TT + qw + qt * 16 + fr) * 96 + ks * 32 + fq * 8);
    float mrun[2] = {-1e30f, -1e30f}, lrun[2] = {0.f, 0.f};
    f32x4 o[4][2];
#pragma unroll
    for (int dt = 0; dt < 4; ++dt)
#pragma unroll
        for (int qt = 0; qt < 2; ++qt) o[dt][qt] = (f32x4){0.f, 0.f, 0.f, 0.f};
    const v4u* kg = (const v4u*)(KB + ((size_t)bh * TT + key_lo) * 96);
    const bf16* vg = VT + ((size_t)bh * 64 + (tid >> 3)) * TT + key_lo + (tid & 7) * 8;
    const int kc0 = tid, kc1 = 512 + tid;
    const int ko0 = (kc0 / 12) * KSTR + (kc0 % 12) * 8, ko1 = (kc1 / 12) * KSTR + (kc1 % 12) * 8, vo = (tid >> 3) * VSTR + (tid & 7) * 8;
    v4u rk0, rk1 = {0u, 0u, 0u, 0u}, rv;
    rk0 = kg[kc0]; if (tid < 256) rk1 = kg[kc1]; rv = *(const v4u*)vg;
    *(v4u*)(Ks + ko0) = rk0; if (tid < 256) *(v4u*)(Ks + ko1) = rk1; *(v4u*)(Vs + vo) = rv;
    __syncthreads();
    for (int kt = 0; kt < nkt; ++kt) {
        const int cur = kt & 1;
        if (kt + 1 < nkt) { const v4u* kn = kg + (size_t)(kt + 1) * 768; rk0 = kn[kc0]; if (tid < 256) rk1 = kn[kc1]; rv = *(const v4u*)(vg + (kt + 1) * 64); }
        const bf16* kb = Ks + cur * KBUF; const bf16* vb = Vs + cur * VBUF;
        f32x4 st[4][2];
#pragma unroll
        for (int k4 = 0; k4 < 4; ++k4) {
            st[k4][0] = (f32x4){0.f, 0.f, 0.f, 0.f}; st[k4][1] = st[k4][0];
#pragma unroll
            for (int ks = 0; ks < 3; ++ks) { const bf16x8 kf = *(const bf16x8*)(kb + (k4 * 16 + fr) * KSTR + ks * 32 + fq * 8);
                st[k4][0] = __builtin_amdgcn_mfma_f32_16x16x32_bf16(kf, qf[0][ks], st[k4][0], 0, 0, 0);
                st[k4][1] = __builtin_amdgcn_mfma_f32_16x16x32_bf16(kf, qf[1][ks], st[k4][1], 0, 0, 0); }
        }
        bf16x8 pb[2][2];
#pragma unroll
        for (int qt = 0; qt < 2; ++qt) {
            float mx = st[0][qt][0];
#pragma unroll
            for (int k4 = 0; k4 < 4; ++k4)
#pragma unroll
                for (int j = 0; j < 4; ++j) mx = fmaxf(mx, st[k4][qt][j]);
            mx = fmaxf(mx, __shfl_xor(mx, 16)); mx = fmaxf(mx, __shfl_xor(mx, 32));
            const float mn = fmaxf(mrun[qt], mx), alpha = __builtin_amdgcn_exp2f(mrun[qt] - mn); mrun[qt] = mn;
            float ls = 0.f;
#pragma unroll
            for (int k4 = 0; k4 < 4; ++k4)
#pragma unroll
                for (int j = 0; j < 4; ++j) { const float p = __builtin_amdgcn_exp2f(st[k4][qt][j] - mn); st[k4][qt][j] = p; ls += p; }
            lrun[qt] = lrun[qt] * alpha + ls;
#pragma unroll
            for (int dt = 0; dt < 4; ++dt) o[dt][qt] *= alpha;
#pragma unroll
            for (int u = 0; u < 2; ++u) { v4u w;
                w.x = pg8::cvt_pk_bf16(st[2 * u][qt][0], st[2 * u][qt][1]); w.y = pg8::cvt_pk_bf16(st[2 * u][qt][2], st[2 * u][qt][3]);
                w.z = pg8::cvt_pk_bf16(st[2 * u + 1][qt][0], st[2 * u + 1][qt][1]); w.w = pg8::cvt_pk_bf16(st[2 * u + 1][qt][2], st[2 * u + 1][qt][3]);
                pb[u][qt] = __builtin_bit_cast(bf16x8, w); }
        }
#pragma unroll
        for (int dt = 0; dt < 4; ++dt)
#pragma unroll
            for (int u = 0; u < 2; ++u) {
                const v2u lo = *(const v2u*)(vb + (dt * 16 + fr) * VSTR + 32 * u + 4 * fq), hi = *(const v2u*)(vb + (dt * 16 + fr) * VSTR + 32 * u + 16 + 4 * fq);
                v4u vw; vw.x = lo.x; vw.y = lo.y; vw.z = hi.x; vw.w = hi.y;
                const bf16x8 va = __builtin_bit_cast(bf16x8, vw);
                o[dt][0] = __builtin_amdgcn_mfma_f32_16x16x32_bf16(va, pb[u][0], o[dt][0], 0, 0, 0);
                o[dt][1] = __builtin_amdgcn_mfma_f32_16x16x32_bf16(va, pb[u][1], o[dt][1], 0, 0, 0);
            }
        if (kt + 1 < nkt) { const int nb = cur ^ 1; *(v4u*)(Ks + nb * KBUF + ko0) = rk0; if (tid < 256) *(v4u*)(Ks + nb * KBUF + ko1) = rk1; *(v4u*)(Vs + nb * VBUF + vo) = rv; }
        __syncthreads();
    }
#pragma unroll
    for (int qt = 0; qt < 2; ++qt) {
        float lt = lrun[qt]; lt += __shfl_xor(lt, 16); lt += __shfl_xor(lt, 32);
        const float inv = 1.f / lt;
        const int q = qw + qt * 16 + fr;
        const size_t row = q < TLEN ? (size_t)b * TLEN + q : (size_t)NLAT + b * CTXL + (q - TLEN);
#pragma unroll
        for (int dt = 0; dt < 4; ++dt) { const f32x4 v = o[dt][qt] * inv; v2u w; w.x = pk2(v[0], v[1]); w.y = pk2(v[2], v[3]);
            *(v2u*)(Y + row * DM + 768 + h * 64 + dt * 16 + fq * 4) = w; }
    }
}
__device__ __forceinline__ void lru_prefix(int bd, int tid) {
    unsigned char* ws = karg_ws();
    if (tid >= 256) return;
    const int ch = tid, b = bd >> 1, d = bd & 1;
    const float* SA = (const float*)(ws + M_SEGA); const float* SB = (const float*)(ws + M_SEGB); float* H0 = (float*)(ws + M_H0);
    const int ctile0 = 512 + b * 8, ltile0 = b * 256;
    float hst = 0.f;
#pragma unroll 8
    for (int i = 0; i < 8; ++i) { const int j = ctile0 + (d ? 7 - i : i); const size_t o = (size_t)(j * 2 + d) * 256 + ch; H0[o] = hst; hst = SA[o] * hst + SB[o]; }
#pragma unroll 16
    for (int i = 0; i < 256; ++i) { const int j = ltile0 + (d ? 255 - i : i); const size_t o = (size_t)(j * 2 + d) * 256 + ch; H0[o] = hst; hst = SA[o] * hst + SB[o]; }
}
__device__ __forceinline__ void lru_rescan(const Args& a, int l, unsigned char* lds, int tile, int tid) {
    unsigned char* ws = karg_ws();
    const int ch = tid & 255, d = tid >> 8;
    const int row0 = tile * 32;
    float hst = ((const float*)(ws + M_H0))[(size_t)(tile * 2 + d) * 256 + ch];
    const float lam = IN(22)[(l * 2 + d) * 256 + ch];
    const float cch = -8.f * log1pf(__expf(-lam));
    const bf16* LR = (const bf16*)(ws + M_LR0 + (size_t)d * A8); const bf16* LIX = (const bf16*)(ws + M_LIX0 + (size_t)d * A8);
    float* hs = (float*)lds;
#pragma unroll 16
    for (int tt = 0; tt < 32; ++tt) { const int t = d ? 31 - tt : tt; const size_t o = (size_t)(row0 + t) * 256 + ch;
        const float al = __expf(cch * bf2f(LR[o])); const float bb = sqrtf(fmaxf(1.f - al * al, 0.f)) * bf2f(LIX[o]);
        hst = al * hst + bb; hs[(d * 32 + t) * 256 + ch] = hst; }
    __syncthreads();
    const bf16* U = (const bf16*)(ws + OFF_HU); bf16* Y = (bf16*)(ws + OFF_XMY);
#pragma unroll 8
    for (int tt = 0; tt < 16; ++tt) { const int t = d * 16 + tt;
        const float y = (hs[t * 256 + ch] + hs[(32 + t) * 256 + ch]) * geluf_(bf2f(U[(size_t)(row0 + t) * UC + 768 + ch]));
        Y[(size_t)(row0 + t) * DM + 256 + ch] = (bf16)f2bf(y); }
    __syncthreads();
}
__device__ __forceinline__ void phase_m2(const Args& a, int l, unsigned char* lds, int G, int bid, int tid) {
    unsigned char* ws = karg_ws();
    const bf16* QB = (const bf16*)(ws + M_QB); const bf16* KB = (const bf16*)(ws + M_KB); const bf16* VT = (const bf16*)(ws + M_VT);
    bf16* Y = (bf16*)(ws + OFF_XMY);
    const int nunits = (l == 0) ? 264 : 256;
    for (int u = bid; u < nunits; u += G) {
        if (u < 256) attn_unit(lds, QB, KB, VT, Y, u >> 7, (u >> 5) & 3, (u & 31) * 256, 0, 132, tid);
        else attn_unit(lds, QB, KB, VT, Y, (u - 256) >> 2, (u - 256) & 3, TLEN, TLEN, 4, tid);
    }
    if (bid < 4) lru_prefix(bid, tid);
}

__device__ __forceinline__ void phase_m3(const Args& a, int l, unsigned char* lds, int G, int bid, int tid) {
    unsigned char* ws = karg_ws();
    const bf16* U = (const bf16*)(ws + OFF_HU);
    const int lane = tid & 63, ch = tid & 255, part = tid >> 8;
    const float* mup = IN(23) + l * 1024; const float* mun = IN(24) + l * 1024;
    bf16* RR = (bf16*)(ws + M_RR); bf16* KKo = (bf16*)(ws + M_KK); bf16* VV = (bf16*)(ws + M_VV); bf16* GC = (bf16*)(ws + M_GC);
    float* kl = (float*)lds;
    float* kkn = (float*)(lds + 32768);
    bf16* twb = (bf16*)(lds + 65536);
    bf16* tab = (bf16*)(lds + 70144);
    bf16* tgb = (bf16*)(lds + 74752);
    for (int tile = bid; tile < NTILE; tile += G) {
        const TileInfo ti = tile_info(tile);
        const int row0 = tile * 32;
        lru_rescan(a, l, lds, tile, ltid());
        {
            const int tid2 = ltid(); const int chunk = tid2 & 127, tg8 = tid2 >> 7, c0 = chunk * 8;
            const bf16* ub = U + (size_t)row0 * UC + 1024 + c0;
            v4u rw[10];
#pragma unroll
            for (int q = 0; q < 10; ++q) { const int tl = tg8 * 8 + q - 1; const int t = ti.t0 + tl;
                rw[q] = (t >= 0 && t < ti.seqlen) ? *(const v4u*)(ub + (ptrdiff_t)tl * UC) : (v4u){0u, 0u, 0u, 0u}; }
            const f32x4 mp0 = *(const f32x4*)(mup + c0), mp1 = *(const f32x4*)(mup + c0 + 4), mn0 = *(const f32x4*)(mun + c0), mn1 = *(const f32x4*)(mun + c0 + 4);
            const float mp[8] = {mp0[0], mp0[1], mp0[2], mp0[3], mp1[0], mp1[1], mp1[2], mp1[3]}, mn[8] = {mn0[0], mn0[1], mn0[2], mn0[3], mn1[0], mn1[1], mn1[2], mn1[3]};
#pragma unroll
            for (int q = 0; q < 8; ++q) { const int tl = tg8 * 8 + q; float ts[8];
#pragma unroll
                for (int e = 0; e < 8; ++e) { const unsigned wm = rw[q][e >> 1], w0 = rw[q + 1][e >> 1], wn = rw[q + 2][e >> 1];
                    const float um = (e & 1) ? __uint_as_float(wm & 0xffff0000u) : __uint_as_float(wm << 16);
                    const float u0 = (e & 1) ? __uint_as_float(w0 & 0xffff0000u) : __uint_as_float(w0 << 16);
                    const float un = (e & 1) ? __uint_as_float(wn & 0xffff0000u) : __uint_as_float(wn << 16);
                    ts[e] = u0 + mp[e] * (um - u0) + mn[e] * (un - u0); }
                if (chunk >= 32 && chunk < 64) { float* kp = kl + tl * 256 + (c0 - 256); *(f32x4*)kp = (f32x4){ts[0], ts[1], ts[2], ts[3]}; *(f32x4*)(kp + 4) = (f32x4){ts[4], ts[5], ts[6], ts[7]}; }
                else {
                    if (chunk >= 96 && chunk < 104) {
#pragma unroll
                        for (int e = 0; e < 8; ++e) ts[e] = tanhf_(ts[e]); }
                    if (chunk >= 112) {
#pragma unroll
                        for (int e = 0; e < 8; ++e) ts[e] = sigm(ts[e]); }
                    v4u o; o.x = pk2(ts[0], ts[1]); o.y = pk2(ts[2], ts[3]); o.z = pk2(ts[4], ts[5]); o.w = pk2(ts[6], ts[7]);
                    if (chunk < 32) *(v4u*)(RR + (size_t)(row0 + tl) * 256 + c0) = o;
                    else if (chunk < 96) *(v4u*)(VV + (size_t)(row0 + tl) * 256 + (c0 - 512)) = o;
                    else if (chunk < 104) *(v4u*)(twb + tl * 72 + (c0 - 768)) = o;
                    else if (chunk < 112) *(v4u*)(tab + tl * 72 + (c0 - 832)) = o;
                    else *(v4u*)(tgb + tl * 136 + (c0 - 896)) = o; }
            }
        }
        __syncthreads();
        {
            const int tid2 = ltid(); const int ch = tid2 & 255, pt = tid2 >> 8; const float kkc = IN(30)[l * 256 + ch];
#pragma unroll 4
            for (int q = 0; q < 16; ++q) { const int t = pt * 16 + q; const float kr = kl[t * 256 + ch] * kkc; const float nrm = wave_sum(kr * kr);
                const float kk = kr * rsqrtf(fmaxf(nrm, 1e-24f)); kkn[t * 256 + ch] = kk; KKo[(size_t)(row0 + t) * 256 + ch] = (bf16)f2bf(kk); }
        }
        __syncthreads();
        {
            const int tid2 = ltid(); const int ln = tid2 & 63, wv = __builtin_amdgcn_readfirstlane(tid2 >> 6), fr = ln & 15, fq = ln >> 4;
            const bf16* WUPt = (const bf16*)(ws + W_WUP); const bf16* AUPt = (const bf16*)(ws + W_AUP); const bf16* GUPt = (const bf16*)(ws + W_GUP);
            bf16x8 aw[2][2], aa[2][2];
#pragma unroll
            for (int mt = 0; mt < 2; ++mt)
#pragma unroll
                for (int ks = 0; ks < 2; ++ks) { aw[mt][ks] = *(const bf16x8*)(twb + (mt * 16 + fr) * 72 + ks * 32 + fq * 8); aa[mt][ks] = *(const bf16x8*)(tab + (mt * 16 + fr) * 72 + ks * 32 + fq * 8); }
#pragma unroll 1
            for (int dn = 0; dn < 4; ++dn) { const int d = dn >> 1, nt = wv * 2 + (dn & 1), ch = nt * 16 + fr;
                f32x4 cw[2], ca[2];
#pragma unroll
                for (int mt = 0; mt < 2; ++mt) { cw[mt] = (f32x4){0.f, 0.f, 0.f, 0.f}; ca[mt] = cw[mt]; }
#pragma unroll
                for (int ks = 0; ks < 2; ++ks) { const bf16x8 bw = *(const bf16x8*)(WUPt + ((size_t)d * 256 + ch) * 64 + ks * 32 + fq * 8), ba = *(const bf16x8*)(AUPt + ((size_t)d * 256 + ch) * 64 + ks * 32 + fq * 8);
#pragma unroll
                    for (int mt = 0; mt < 2; ++mt) { cw[mt] = __builtin_amdgcn_mfma_f32_16x16x32_bf16(aw[mt][ks], bw, cw[mt], 0, 0, 0); ca[mt] = __builtin_amdgcn_mfma_f32_16x16x32_bf16(aa[mt][ks], ba, ca[mt], 0, 0, 0); } }
                const float w0 = IN(25)[(l * 2 + d) * 256 + ch], a0 = IN(27)[(l * 2 + d) * 256 + ch], kac = IN(31)[l * 256 + ch];
                float* WW = (float*)(ws + M_WW) + (size_t)d * NR * 256; bf16* BB = (bf16*)(ws + M_BB + (size_t)d * A8); bf16* KD = (bf16*)(ws + M_KD + (size_t)d * A8);
#pragma unroll
                for (int mt = 0; mt < 2; ++mt)
#pragma unroll
                    for (int j = 0; j < 4; ++j) { const int t = mt * 16 + fq * 4 + j; const size_t o = (size_t)(row0 + t) * 256 + ch;
                        const float e = sigm(w0 + cw[mt][j]) * 0.6065306597126334f;
                        const float av = sigm(a0 + ca[mt][j]);
                        WW[o] = __expf(-e);
                        KD[o] = (bf16)f2bf(kl[t * 256 + ch] * (1.f + (av - 1.f) * kac));
                        BB[o] = (bf16)f2bf(kkn[t * 256 + ch] * av); }
            }
#pragma unroll 1
            for (int nl = 0; nl < 2; ++nl) { const int ch = (wv * 2 + nl) * 16 + fr;
                f32x4 cg[2] = {(f32x4){0.f, 0.f, 0.f, 0.f}, (f32x4){0.f, 0.f, 0.f, 0.f}};
#pragma unroll
                for (int ks = 0; ks < 4; ++ks) { const bf16x8 bg = *(const bf16x8*)(GUPt + (size_t)ch * 128 + ks * 32 + fq * 8);
#pragma unroll
                    for (int mt = 0; mt < 2; ++mt) { const bf16x8 ag = *(const bf16x8*)(tgb + (mt * 16 + fr) * 136 + ks * 32 + fq * 8); cg[mt] = __builtin_amdgcn_mfma_f32_16x16x32_bf16(ag, bg, cg[mt], 0, 0, 0); } }
#pragma unroll
                for (int mt = 0; mt < 2; ++mt)
#pragma unroll
                    for (int j = 0; j < 4; ++j) GC[(size_t)(row0 + mt * 16 + fq * 4 + j) * 256 + ch] = (bf16)f2bf(cg[mt][j]);
            }
        }
        __syncthreads();
    }
}

typedef const unsigned cu32;
typedef const float cf32;
__device__ __forceinline__ int chain_row(int b, int d, int tau) {
    return tau < CTXL ? (NLAT + b * CTXL + (d ? CTXL - 1 - tau : tau)) : (b * TLEN + (d ? TLEN - 1 - (tau - CTXL) : (tau - CTXL)));
}
template <int MODE>
__device__ __forceinline__ void rwkv_steps(float (&S)[64], int b, int h, int d, int tau0, int n, unsigned char* ws, int lane, float* wl) {
    const bf16* KKp = (const bf16*)(ws + M_KK); const bf16* RRp = (const bf16*)(ws + M_RR); const bf16* VVp = (const bf16*)(ws + M_VV);
    const float* WWp = (const float*)(ws + M_WW) + (size_t)d * NR * 256; const bf16* BBp = (const bf16*)(ws + M_BB + (size_t)d * A8); const bf16* KDp = (const bf16*)(ws + M_KD + (size_t)d * A8);
    float* YS = (float*)(ws + M_YS) + (size_t)d * NR * 256;
    float pk, pw, pb, pkd = 0.f, pr = 0.f, pv = 0.f; size_t poff;
#define RWKV_LOAD(s_) do { poff = (size_t)chain_row(b, d, tau0 + (s_)) * 256 + h * 64 + lane; pk = bf2f(KKp[poff]); pw = WWp[poff]; pb = bf2f(BBp[poff]); \
        if (MODE != 1) { pkd = bf2f(KDp[poff]); pv = bf2f(VVp[poff]); } if (MODE == 2) pr = bf2f(RRp[poff]); } while (0)
    RWKV_LOAD(0);
    for (int s = 0; s < n; ++s) {
        float* buf = wl + (s & 1) * 320;
        buf[lane] = pk; buf[64 + lane] = pw; buf[128 + lane] = pb;
        if (MODE != 1) buf[192 + lane] = pkd;
        if (MODE == 2) buf[256 + lane] = pr;
        const float vv = pv; const size_t yoff = poff;
        if (s + 1 < n) RWKV_LOAD(s + 1);
        float sa0 = 0.f, sa1 = 0.f, sa2 = 0.f, sa3 = 0.f;
#pragma unroll
        for (int i = 0; i < 64; i += 4) { const f32x4 k4 = *(const f32x4*)(buf + i);
            sa0 += S[i] * k4[0]; sa1 += S[i + 1] * k4[1]; sa2 += S[i + 2] * k4[2]; sa3 += S[i + 3] * k4[3]; }
        const float nsa = -((sa0 + sa1) + (sa2 + sa3));
        float y0 = 0.f, y1 = 0.f, y2 = 0.f, y3 = 0.f;
#pragma unroll
        for (int i = 0; i < 64; i += 4) { const f32x4 w4 = *(const f32x4*)(buf + 64 + i), b4 = *(const f32x4*)(buf + 128 + i);
            f32x4 t = nsa * b4;
            if (MODE != 1) { const f32x4 kd4 = *(const f32x4*)(buf + 192 + i); t += vv * kd4; }
            S[i] = S[i] * w4[0] + t[0]; S[i + 1] = S[i + 1] * w4[1] + t[1]; S[i + 2] = S[i + 2] * w4[2] + t[2]; S[i + 3] = S[i + 3] * w4[3] + t[3];
            if (MODE == 2) { const f32x4 r4 = *(const f32x4*)(buf + 256 + i); y0 += S[i] * r4[0]; y1 += S[i + 1] * r4[1]; y2 += S[i + 2] * r4[2]; y3 += S[i + 3] * r4[3]; } }
        if (MODE == 2) YS[yoff] = (y0 + y1) + (y2 + y3);
    }
#undef RWKV_LOAD
}
typedef float f32x2 __attribute__((ext_vector_type(2)));
__device__ __forceinline__ void rwkv_pass1(f32x2 (&SL)[32], f32x2 (&SI)[32], int b, int h, int d, int tau0, int n, unsigned char* ws, int lane, float* wl) {
    const bf16* KKp = (const bf16*)(ws + M_KK); const bf16* VVp = (const bf16*)(ws + M_VV); const bf16* RRp = (const bf16*)(ws + M_RR);
    const float* WWp = (const float*)(ws + M_WW) + (size_t)d * NR * 256; const bf16* BBp = (const bf16*)(ws + M_BB + (size_t)d * A8); const bf16* KDp = (const bf16*)(ws + M_KD + (size_t)d * A8);
    float* YS = (float*)(ws + M_YS) + (size_t)d * NR * 256; float* PR = (float*)(ws + M_PR) + (size_t)d * NR * 256;
    float pk, pw, pb, pkd, pv, pr; size_t poff;
#define RWKV_LOAD(s_) do { poff = (size_t)chain_row(b, d, tau0 + (s_)) * 256 + h * 64 + lane; pk = bf2f(KKp[poff]); pw = WWp[poff]; pb = bf2f(BBp[poff]); pkd = bf2f(KDp[poff]); pv = bf2f(VVp[poff]); pr = bf2f(RRp[poff]); } while (0)
    RWKV_LOAD(0);
    for (int s = 0; s < n; ++s) {
        float* buf = wl + (s & 1) * 320;
        buf[lane] = pk; buf[64 + lane] = pw; buf[128 + lane] = pb; buf[192 + lane] = pkd; buf[256 + lane] = pr;
        const float vv = pv; const size_t yoff = poff;
        if (s + 1 < n) RWKV_LOAD(s + 1);
        f32x2 aL0 = {0.f, 0.f}, aL1 = aL0, aI0 = aL0, aI1 = aL0;
#pragma unroll
        for (int q = 0; q < 16; ++q) { const f32x4 k4 = *(const f32x4*)(buf + 4 * q);
            aL0 += SL[2 * q] * k4.lo; aL1 += SL[2 * q + 1] * k4.hi; aI0 += SI[2 * q] * k4.lo; aI1 += SI[2 * q + 1] * k4.hi; }
        const f32x2 tL = aL0 + aL1, tI = aI0 + aI1;
        const float nsl = -(tL.x + tL.y), nsi = -(tI.x + tI.y);
        f32x2 yL0 = {0.f, 0.f}, yL1 = yL0, yI0 = yL0, yI1 = yL0;
#pragma unroll
        for (int q = 0; q < 16; ++q) {
            const f32x4 w4 = *(const f32x4*)(buf + 64 + 4 * q), b4 = *(const f32x4*)(buf + 128 + 4 * q), kd4 = *(const f32x4*)(buf + 192 + 4 * q), r4 = *(const f32x4*)(buf + 256 + 4 * q);
            const f32x4 tl = nsl * b4 + vv * kd4, tiv = nsi * b4;
            SL[2 * q] = SL[2 * q] * w4.lo + tl.lo; SL[2 * q + 1] = SL[2 * q + 1] * w4.hi + tl.hi;
            SI[2 * q] = SI[2 * q] * w4.lo + tiv.lo; SI[2 * q + 1] = SI[2 * q + 1] * w4.hi + tiv.hi;
            yL0 += SL[2 * q] * r4.lo; yL1 += SL[2 * q + 1] * r4.hi; yI0 += SI[2 * q] * r4.lo; yI1 += SI[2 * q + 1] * r4.hi; }
        const f32x2 yl = yL0 + yL1, yp = yI0 + yI1;
        YS[yoff] = yl.x + yl.y; PR[yoff] = yp.x + yp.y;
    }
#undef RWKV_LOAD
}
__device__ __forceinline__ void phase_m4(const Args& a, unsigned char* lds, int G, int bid, int tid) {
    const int lane = tid & 63, wave = __builtin_amdgcn_readfirstlane(tid >> 6), half = wave >> 2, tk = wave & 3;
    unsigned char* ws = karg_ws(); float* PL = (float*)(ws + M_PL);
    float* wl = (float*)lds + wave * 320;
    float* xch = (float*)lds + 8 * 320 + tk * 1024;
    float* ych = xch + 512;
    const bf16* KKp = (const bf16*)(ws + M_KK); const bf16* VVp = (const bf16*)(ws + M_VV); const bf16* RRp = (const bf16*)(ws + M_RR);
    for (int task0 = bid * 4; task0 < 16 * NSEG; task0 += G * 4) {
        const int task = task0 + tk; const int seg = task & (NSEG - 1), chain = task >> 6;
        const int d = chain & 1, h = (chain >> 1) & 3, b = chain >> 3;
        const float* WWp = (const float*)(ws + M_WW) + (size_t)d * NR * 256; const bf16* BBp = (const bf16*)(ws + M_BB + (size_t)d * A8); const bf16* KDp = (const bf16*)(ws + M_KD + (size_t)d * A8);
        float* YS = (float*)(ws + M_YS) + (size_t)d * NR * 256; float* PR = (float*)(ws + M_PR) + (size_t)d * NR * 256;
        f32x2 SL[16], SI[16]; int ln = lane; asm volatile("" : "+v"(ln));
#pragma unroll
        for (int i = 0; i < 16; ++i) { SL[i] = (f32x2){0.f, 0.f}; SI[i] = (f32x2){(32 * half + 2 * i == ln) ? 1.f : 0.f, (32 * half + 2 * i + 1 == ln) ? 1.f : 0.f}; }
        const int tau0 = seg * SEGLEN, cidx = h * 64 + 32 * half + (lane & 31);
        float p0, p1, p2, pv; size_t rowoff, prevoff = 0;
#define M4_LOAD(s_) do { rowoff = (size_t)chain_row(b, d, tau0 + (s_)) * 256; const size_t po = rowoff + cidx; \
            if (lane < 32) { p0 = bf2f(KKp[po]); p1 = WWp[po]; p2 = bf2f(BBp[po]); } else { p0 = bf2f(KDp[po]); p1 = bf2f(RRp[po]); p2 = 0.f; } pv = bf2f(VVp[rowoff + h * 64 + lane]); } while (0)
        M4_LOAD(0);
        for (int s = 0; s < SEGLEN; ++s) {
            float* buf = wl + (s & 1) * 160; const int l31 = lane & 31;
            if (lane < 32) { buf[l31] = p0; buf[32 + l31] = p1; buf[64 + l31] = p2; } else { buf[96 + l31] = p0; buf[128 + l31] = p1; }
            const float vv = pv; const size_t yoff = rowoff + h * 64 + lane;
            if (s + 1 < SEGLEN) M4_LOAD(s + 1);
            f32x2 aL0 = {0.f, 0.f}, aL1 = aL0, aI0 = aL0, aI1 = aL0;
#pragma unroll
            for (int q = 0; q < 8; ++q) { const f32x4 k4 = *(const f32x4*)(buf + 4 * q);
                aL0 += SL[2 * q] * k4.lo; aL1 += SL[2 * q + 1] * k4.hi; aI0 += SI[2 * q] * k4.lo; aI1 += SI[2 * q + 1] * k4.hi; }
            const f32x2 tL = aL0 + aL1, tI = aI0 + aI1;
            float* xw = xch + (s & 1) * 256;
            xw[half * 128 + lane] = tL.x + tL.y; xw[half * 128 + 64 + lane] = tI.x + tI.y;
            __syncthreads();
            const float nsl = -(xw[lane] + xw[128 + lane]), nsi = -(xw[64 + lane] + xw[192 + lane]);
            if (s > 0) {
                const float* yr = ych + ((s - 1) & 1) * 256;
                if (half == 0) YS[prevoff] = yr[lane] + yr[128 + lane]; else PR[prevoff] = yr[64 + lane] + yr[192 + lane];
            }
            f32x2 yL0 = {0.f, 0.f}, yL1 = yL0, yI0 = yL0, yI1 = yL0;
#pragma unroll
            for (int q = 0; q < 8; ++q) {
                const f32x4 w4 = *(const f32x4*)(buf + 32 + 4 * q), b4 = *(const f32x4*)(buf + 64 + 4 * q), kd4 = *(const f32x4*)(buf + 96 + 4 * q), r4 = *(const f32x4*)(buf + 128 + 4 * q);
                const f32x4 tl = nsl * b4 + vv * kd4, tiv = nsi * b4;
                SL[2 * q] = SL[2 * q] * w4.lo + tl.lo; SL[2 * q + 1] = SL[2 * q + 1] * w4.hi + tl.hi;
                SI[2 * q] = SI[2 * q] * w4.lo + tiv.lo; SI[2 * q + 1] = SI[2 * q + 1] * w4.hi + tiv.hi;
                yL0 += SL[2 * q] * r4.lo; yL1 += SL[2 * q + 1] * r4.hi; yI0 += SI[2 * q] * r4.lo; yI1 += SI[2 * q + 1] * r4.hi; }
            const f32x2 yl = yL0 + yL1, yp = yI0 + yI1;
            float* yw = ych + (s & 1) * 256;
            yw[half * 128 + lane] = yl.x + yl.y; yw[half * 128 + 64 + lane] = yp.x + yp.y;
            prevoff = yoff;
        }
#undef M4_LOAD
        __syncthreads();
        { const float* yr = ych + ((SEGLEN - 1) & 1) * 256;
          if (half == 0) YS[prevoff] = yr[lane] + yr[128 + lane]; else PR[prevoff] = yr[64 + lane] + yr[192 + lane]; }
        float* o = PL + (((size_t)(chain * NSEG + seg) * 2) * 64 + lane) * 64 + 32 * half;
#pragma unroll
        for (int i = 0; i < 16; i += 2) { *(f32x4*)(o + 2 * i) = (f32x4){SL[i].x, SL[i].y, SL[i + 1].x, SL[i + 1].y}; *(f32x4*)(o + 4096 + 2 * i) = (f32x4){SI[i].x, SI[i].y, SI[i + 1].x, SI[i + 1].y}; }
        __syncthreads();
    }
}
__device__ __forceinline__ void phase_m5(const Args& a, unsigned char* lds, int G, int bid, int tid) {
    unsigned char* ws = karg_ws(); const float* PL = (const float*)(ws + M_PL); float* SI = (float*)(ws + M_SINIT);
    float* Sx = (float*)lds;
    const int lane = tid & 63, wv = __builtin_amdgcn_readfirstlane(tid >> 6), fr = lane & 15, fq = lane >> 4;
    const bool act = wv < 4;
    for (int u = bid; u < 64; u += G) {
        const int chain = u >> 2, row0 = (u & 3) * 16, col = (wv & 3) * 16 + fr;
        const float* Pg = PL + ((size_t)(chain * NSEG) * 2 + 1) * 4096; const float* Lg = PL + ((size_t)(chain * NSEG) * 2) * 4096;
        float* SIc = SI + (size_t)(chain * NSEG) * 4096;
        f32x4 cur = {0.f, 0.f, 0.f, 0.f}; f32x4 lv[3]; float pb[3][16];
#pragma unroll
        for (int q = 0; q < 3; ++q) { lv[q] = cur;
            if (act) { const float* Pn = Pg + (size_t)q * 8192; const float* Ln = Lg + (size_t)q * 8192;
#pragma unroll
                for (int ks = 0; ks < 16; ++ks) pb[q][ks] = Pn[(4 * ks + fq) * 64 + col];
#pragma unroll
                for (int j = 0; j < 4; ++j) lv[q][j] = Ln[(row0 + fq * 4 + j) * 64 + col]; } }
        for (int g0 = 0; g0 < NSEG - 1; g0 += 3) {
#pragma unroll
            for (int q = 0; q < 3; ++q) { const int g = g0 + q;
                if (act) {
#pragma unroll
                    for (int j = 0; j < 4; ++j) { SIc[(size_t)g * 4096 + (row0 + fq * 4 + j) * 64 + col] = cur[j]; Sx[(fq * 4 + j) * 68 + col] = cur[j]; }
                }
                __syncthreads();
                if (act) {
                    f32x4 acc = lv[q];
#pragma unroll
                    for (int ks = 0; ks < 16; ++ks) { const float av = Sx[fr * 68 + 4 * ks + fq]; acc = __builtin_amdgcn_mfma_f32_16x16x4f32(av, pb[q][ks], acc, 0, 0, 0); }
                    cur = acc;
                    if (g + 3 < NSEG - 1) { const float* Pn = Pg + (size_t)(g + 3) * 8192; const float* Ln = Lg + (size_t)(g + 3) * 8192;
#pragma unroll
                        for (int ks = 0; ks < 16; ++ks) pb[q][ks] = Pn[(4 * ks + fq) * 64 + col];
#pragma unroll
                        for (int j = 0; j < 4; ++j) lv[q][j] = Ln[(row0 + fq * 4 + j) * 64 + col]; }
                }
                __syncthreads();
            }
        }
        if (act) {
#pragma unroll
            for (int j = 0; j < 4; ++j) SIc[(size_t)(NSEG - 1) * 4096 + (row0 + fq * 4 + j) * 64 + col] = cur[j];
        }
    }
}
__device__ __forceinline__ void phase_m6(const Args& a, unsigned char* lds, int G, int bid, int tid) {
    const int lane = tid & 63, wave = __builtin_amdgcn_readfirstlane(tid >> 6);
    unsigned char* ws = karg_ws(); const float* SI = (const float*)(ws + M_SINIT);
    float* wl = (float*)lds + wave * 256;
    for (int task = bid * 8 + wave; task < 16 * (NSEG - 1); task += G * 8) {
        const int seg = 1 + task % (NSEG - 1), chain = task / (NSEG - 1);
        const int d = chain & 1, h = (chain >> 1) & 3, b = chain >> 3;
        float* YS = (float*)(ws + M_YS) + (size_t)d * NR * 256; const float* PR = (const float*)(ws + M_PR) + (size_t)d * NR * 256;
        f32x2 S0[32];
        const float* si = SI + ((size_t)(chain * NSEG + seg) * 64 + lane) * 64;
#pragma unroll
        for (int i = 0; i < 32; i += 2) { const f32x4 v = *(const f32x4*)(si + 2 * i); S0[i] = v.lo; S0[i + 1] = v.hi; }
        const int tau0 = seg * SEGLEN;
        size_t o0 = (size_t)chain_row(b, d, tau0) * 256 + h * 64 + lane, o1 = (size_t)chain_row(b, d, tau0 + 1) * 256 + h * 64 + lane;
        float p0 = PR[o0], p1 = PR[o1], y0 = YS[o0], y1 = YS[o1];
        for (int s = 0; s < SEGLEN; s += 2) {
            wl[lane] = p0; wl[64 + lane] = p1;
            const size_t c0 = o0, c1 = o1; const float yy0 = y0, yy1 = y1;
            if (s + 2 < SEGLEN) { o0 = (size_t)chain_row(b, d, tau0 + s + 2) * 256 + h * 64 + lane; o1 = (size_t)chain_row(b, d, tau0 + s + 3) * 256 + h * 64 + lane; p0 = PR[o0]; p1 = PR[o1]; y0 = YS[o0]; y1 = YS[o1]; }
            f32x2 a0 = {0.f, 0.f}, a1 = a0, b0 = a0, b1 = a0;
#pragma unroll
            for (int q = 0; q < 16; ++q) { const f32x4 u = *(const f32x4*)(wl + 4 * q), w = *(const f32x4*)(wl + 64 + 4 * q);
                a0 += S0[2 * q] * u.lo; a1 += S0[2 * q + 1] * u.hi; b0 += S0[2 * q] * w.lo; b1 += S0[2 * q + 1] * w.hi; }
            const f32x2 ta = a0 + a1, tb = b0 + b1;
            YS[c0] = yy0 + (ta.x + ta.y); YS[c1] = yy1 + (tb.x + tb.y);
            asm volatile("" ::: "memory");
        }
    }
}
__device__ __forceinline__ void phase_m7(const Args& a, int l, int gw, int NGW, int lane) {
    unsigned char* ws = karg_ws();
    const float* Y0 = (const float*)(ws + M_YS); const float* Y1 = Y0 + (size_t)NR * 256;
    const bf16* RR = (const bf16*)(ws + M_RR); const bf16* VV = (const bf16*)(ws + M_VV); const bf16* KD0 = (const bf16*)(ws + M_KD); const bf16* KD1 = (const bf16*)(ws + M_KD + A8);
    const bf16* GC = (const bf16*)(ws + M_GC); bf16* Y = (bf16*)(ws + OFF_XMY);
    for (int r = gw; r < NR; r += NGW) {
#pragma unroll
        for (int h = 0; h < 4; ++h) { const int c = h * 64 + lane; const size_t o = (size_t)r * 256 + c;
            const float ys = Y0[o] + Y1[o];
            const float mu = wave_sum(ys) * (1.f / 64.f); const float dv = ys - mu; const float var = wave_sum(dv * dv) * (1.f / 64.f);
            float ov = dv * rsqrtf(var + 64e-5f) * IN(33)[l * 256 + c] + IN(34)[l * 256 + c];
            const float rv = bf2f(RR[o]), rk = IN(32)[l * 256 + c], vv = bf2f(VV[o]);
            const float b0 = wave_sum(rv * bf2f(KD0[o]) * rk), b1 = wave_sum(rv * bf2f(KD1[o]) * rk);
            ov += (b0 + b1) * vv;
            Y[(size_t)r * DM + 512 + c] = (bf16)f2bf(ov * bf2f(GC[o])); }
    }
}

#define LAS __attribute__((address_space(3)))
#define XB_TMO      128
#define XB_XCNT(j)  (256  + 64 * (j))
#define XB_XSUB(j)  (1280 + 64 * (j))
#define XB_XGEN(j)  (2304 + 64 * (j))
#define XB_TOP      3328
#define XB_TOPGEN   3392
#define XCD_BAR_WORDS 3456
#define XB_SPIN_CAP (1u << 18)

__device__ __forceinline__ unsigned xb_ld(unsigned* p)              { return __hip_atomic_load(p, __ATOMIC_RELAXED, __HIP_MEMORY_SCOPE_AGENT); }
__device__ __forceinline__ unsigned xb_add(unsigned* p, unsigned v) { return __hip_atomic_fetch_add(p, v, __ATOMIC_RELAXED, __HIP_MEMORY_SCOPE_AGENT); }
__device__ __forceinline__ unsigned xb_xcc_id() { return (unsigned)__builtin_amdgcn_s_getreg((3 << 11) | 20) & 0xFu; }
#define XB_SPIN(cond, bar) do { unsigned _sp = 0; while (cond) { __builtin_amdgcn_s_sleep(1); \
    if ((++_sp & 255u) == 0u) { if (xb_ld(&(bar)[XB_TMO])) break; if (_sp > XB_SPIN_CAP) { atomicAdd(&(bar)[XB_TMO], 1u); break; } } } } while (0)

struct XcdBarrier {
    unsigned* bar; unsigned x;
    volatile LAS unsigned* st;
};

__device__ __forceinline__ XcdBarrier xcd_barrier_post(unsigned* bar, volatile LAS unsigned* st) {
    XcdBarrier b; b.bar = bar; b.x = xb_xcc_id(); b.st = st;
    if (threadIdx.x == 0) (void)xb_add(&bar[XB_XCNT(b.x)], 1u);
    return b;
}
__device__ __forceinline__ void xcd_barrier_complete(unsigned* bar, unsigned x, unsigned& nloc, unsigned& nx) {
    const unsigned G = gridDim.x * gridDim.y * gridDim.z;
    unsigned sum, cnt, mine, sp = 0u;
    for (;;) {
        sum = 0u; cnt = 0u; mine = 0u;
#pragma unroll
        for (unsigned j = 0; j < 16; ++j) { const unsigned c = xb_ld(&bar[XB_XCNT(j)]); sum += c; cnt += (c > 0u) ? 1u : 0u; mine = (j == x) ? c : mine; }
        if (sum == G) break;
        __builtin_amdgcn_s_sleep(1);
        if ((++sp & 255u) == 0u) { if (xb_ld(&bar[XB_TMO])) break; if (sp > XB_SPIN_CAP) { atomicAdd(&bar[XB_TMO], 1u); break; } }
    }
    nloc = mine > 0u ? mine : 1u; nx = cnt > 0u ? cnt : 1u;
}

__device__ __forceinline__ void xcd_barrier(const XcdBarrier& b) {
    asm volatile("s_waitcnt vmcnt(0)" ::: "memory");
    __syncthreads();
    if (threadIdx.x == 0) {
        unsigned* bar = b.bar;
        __builtin_amdgcn_s_waitcnt(0);
        unsigned nloc = b.st[0], nx = b.st[1];
        if (nloc == 0u) { xcd_barrier_complete(bar, b.x, nloc, nx); b.st[0] = nloc; b.st[1] = nx; }
        const unsigned old = xb_add(&bar[XB_XSUB(b.x)], 1u);
        const unsigned gen = old / nloc;
        if (old + 1u == (gen + 1u) * nloc) {
            __builtin_amdgcn_fence(__ATOMIC_RELEASE, "agent");
            asm volatile("s_waitcnt vmcnt(0)" ::: "memory");
            const unsigned og = xb_add(&bar[XB_TOP], 1u);
            const unsigned tg = og / nx;
            if (og + 1u == (tg + 1u) * nx) xb_add(&bar[XB_TOPGEN], 1u);
            else XB_SPIN(xb_ld(&bar[XB_TOPGEN]) == tg, bar);
            __builtin_amdgcn_fence(__ATOMIC_ACQUIRE, "agent");
            xb_add(&bar[XB_XGEN(b.x)], 1u);
            asm volatile("s_waitcnt vmcnt(0)" ::: "memory");
        } else {
            XB_SPIN(xb_ld(&bar[XB_XGEN(b.x)]) == gen, bar);
            __builtin_amdgcn_fence(__ATOMIC_ACQUIRE, "agent");
            asm volatile("s_waitcnt vmcnt(0)" ::: "memory");
        }
    }
    __syncthreads();
}

__global__ void __launch_bounds__(512, 2) mega(Args a) {
    extern __shared__ __attribute__((aligned(16))) unsigned char lds[];
    cg::grid_group grid = cg::this_grid();
    const int G = gridDim.x;
    PG8_LAS unsigned char* glds = (PG8_LAS unsigned char*)lds;
#define bid lbid()
#define tid ltid()
#define lane (ltid() & 63)
#define wave (__builtin_amdgcn_readfirstlane(ltid() >> 6))
#define gw (lbid() * 8 + __builtin_amdgcn_readfirstlane(ltid() >> 6))
#define NGW (G * 8)
    { volatile LAS unsigned* st0 = (volatile LAS unsigned*)((LAS unsigned char*)lds + 131072); if (threadIdx.x < 4) st0[threadIdx.x] = 0u; }
    __syncthreads();
    const XcdBarrier xbar = xcd_barrier_post((unsigned*)(karg_ws() + 229376), (volatile LAS unsigned*)((LAS unsigned char*)lds + 131072));
#define GSYNC() do { xcd_barrier(xbar); } while (0)

    phase_modgemv(a, (float*)lds, G, bid, tid);
    convert_weights(a, 0, (float*)(lds + 32768) + wave * (64 * 33), gw, NGW, lane, G, bid, tid);
    grid.sync();
#pragma clang loop unroll(full)
    for (int l = 0; l < 2; ++l) {
        if (l > 0) convert_weights(a, l, (float*)lds + wave * (64 * 33), gw, NGW, lane, G, bid, tid);
        phase_modulate(a, l, 0, gw, NGW, lane);
        GSYNC();
        for (int rp = 0; rp < REP_G1; ++rp)
        {
            unsigned char* ws = karg_ws(); float* outp = karg_out(); float* xctx = (float*)(ws + OFF_XCTX); bf16* XM = (bf16*)(ws + OFF_XMY); bf16* HU = (bf16*)(ws + OFF_HU); const float* modl = (const float*)(ws + OFF_MOD) + (size_t)l * 3 * 9216; (void)xctx; (void)XM; (void)HU; (void)modl; (void)outp;
            pg8::Gemm g{XM, (const bf16*)(ws + W_13A), NR, 2 * DFF, DM}; pg8::StaticOrder S; S.init(NR, 2 * DFF, G, bid);
            EpiSwiglu E{HU};
            pg8::gemm_phase<EpiSwiglu, pg8::StaticOrder, true, true>(glds, g, S, E);
        }
        GSYNC();
        {
            unsigned char* ws = karg_ws(); float* outp = karg_out(); float* xctx = (float*)(ws + OFF_XCTX); bf16* XM = (bf16*)(ws + OFF_XMY); bf16* HU = (bf16*)(ws + OFF_HU); const float* modl = (const float*)(ws + OFF_MOD) + (size_t)l * 3 * 9216; (void)xctx; (void)XM; (void)HU; (void)modl; (void)outp;
            pg8::Gemm g{HU, (const bf16*)(ws + W_2A), NR, DM, DFF}; pg8::StaticOrder S; S.init(NR, DM, G, bid);
            EpiResid E{outp, xctx, modl + 2 * 1024, 0.5f, l == 0 ? IN(0) : outp, l == 0 ? IN(2) : xctx};
            pg8::gemm_phase<EpiResid, pg8::StaticOrder, true, true>(glds, g, S, E);
        }
        GSYNC();
        phase_modulate(a, l, 1, gw, NGW, lane);
        GSYNC();
        {
            unsigned char* ws = karg_ws(); float* outp = karg_out(); float* xctx = (float*)(ws + OFF_XCTX); bf16* XM = (bf16*)(ws + OFF_XMY); bf16* HU = (bf16*)(ws + OFF_HU); const float* modl = (const float*)(ws + OFF_MOD) + (size_t)l * 3 * 9216; (void)xctx; (void)XM; (void)HU; (void)modl; (void)outp;
            pg8::Gemm g{XM, (const bf16*)(ws + W_IN), NR, UC, DM}; pg8::StaticOrder S; S.init(NR, UC, G, bid);
            EpiU E{HU, UC};
            pg8::gemm_phase<EpiU, pg8::StaticOrder, true, true>(glds, g, S, E);
        }
        GSYNC();
        for (int rp = 0; rp < REP_M1; ++rp) { phase_m1(a, l, lds, G, bid, tid);
        GSYNC(); }
        for (int rp = 0; rp < REP_M2; ++rp) { phase_m2(a, l, lds, G, bid, tid);
        GSYNC(); }
        for (int rp = 0; rp < REP_M3; ++rp) { phase_m3(a, l, lds, G, bid, tid);
        GSYNC(); }
        for (int rp = 0; rp < REP_SCAN; ++rp) { phase_m4(a, lds, G, bid, tid);
        GSYNC();
        phase_m5(a, lds, G, bid, tid);
        GSYNC();
        phase_m6(a, lds, G, bid, tid);
        GSYNC(); }
        phase_m7(a, l, gw, NGW, lane);
        GSYNC();
        {
            unsigned char* ws = karg_ws(); float* outp = karg_out(); float* xctx = (float*)(ws + OFF_XCTX); bf16* XM = (bf16*)(ws + OFF_XMY); bf16* HU = (bf16*)(ws + OFF_HU); const float* modl = (const float*)(ws + OFF_MOD) + (size_t)l * 3 * 9216; (void)xctx; (void)XM; (void)HU; (void)modl; (void)outp;
            const int MR = (l == 1) ? NLAT : NR;
            pg8::Gemm g{XM, (const bf16*)(ws + W_OUT), MR, DM, DM}; pg8::StaticOrder S; S.init(MR, DM, G, bid);
            EpiResid E{outp, xctx, modl + 5 * 1024, 1.0f, outp, xctx};
            pg8::gemm_phase<EpiResid, pg8::StaticOrder, true, true>(glds, g, S, E);
        }
        GSYNC();
        phase_modulate(a, l, 2, gw, NGW, lane);
        GSYNC();
        {
            unsigned char* ws = karg_ws(); float* outp = karg_out(); float* xctx = (float*)(ws + OFF_XCTX); bf16* XM = (bf16*)(ws + OFF_XMY); bf16* HU = (bf16*)(ws + OFF_HU); const float* modl = (const float*)(ws + OFF_MOD) + (size_t)l * 3 * 9216; (void)xctx; (void)XM; (void)HU; (void)modl; (void)outp;
            const int MR = (l == 1) ? NLAT : NR;
            pg8::Gemm g{XM, (const bf16*)(ws + W_13B), MR, 2 * DFF, DM}; pg8::StaticOrder S; S.init(MR, 2 * DFF, G, bid);
            EpiSwiglu E{HU};
            pg8::gemm_phase<EpiSwiglu, pg8::StaticOrder, true, true>(glds, g, S, E);
        }
        GSYNC();
        {
            unsigned char* ws = karg_ws(); float* outp = karg_out(); float* xctx = (float*)(ws + OFF_XCTX); bf16* XM = (bf16*)(ws + OFF_XMY); bf16* HU = (bf16*)(ws + OFF_HU); const float* modl = (const float*)(ws + OFF_MOD) + (size_t)l * 3 * 9216; (void)xctx; (void)XM; (void)HU; (void)modl; (void)outp;
            const int MR = (l == 1) ? NLAT : NR;
            pg8::Gemm g{HU, (const bf16*)(ws + W_2B), MR, DM, DFF}; pg8::StaticOrder S; S.init(MR, DM, G, bid);
            EpiResid E{outp, xctx, modl + 8 * 1024, 0.5f, outp, xctx};
            pg8::gemm_phase<EpiResid, pg8::StaticOrder, true, true>(glds, g, S, E);
        }
        GSYNC();
    }
    phase_final(a, gw, NGW, lane);
#undef bid
#undef tid
#undef lane
#undef wave
#undef gw
#undef NGW
}

extern "C" void kernel_launch(void* const* d_in, const int* in_sizes, int n_in, void* d_out, int out_size, void* d_ws, size_t ws_size, hipStream_t stream) {
    static int grid = 0;
    if (grid == 0) {
        int dev = 0, cus = 0, per_cu = 0;
        (void)hipGetDevice(&dev);
        (void)hipDeviceGetAttribute(&cus, hipDeviceAttributeMultiprocessorCount, dev);
        (void)hipFuncSetAttribute((const void*)mega, hipFuncAttributeMaxDynamicSharedMemorySize, LDS_BYTES);
        (void)hipOccupancyMaxActiveBlocksPerMultiprocessor(&per_cu, (const void*)mega, 512, LDS_BYTES);
        if (per_cu < 1) per_cu = 1;
        grid = cus * per_cu;
        if (n_in != 40 || ws_size < WS_NEED) { fprintf(stderr, "kernel_launch: unexpected n_in %d / ws %zu (need %zu)\n", n_in, ws_size, (size_t)WS_NEED); }
    }
    (void)hipMemsetAsync((char*)d_ws + OFF_MOD, 0, MOD_BYTES, stream);
    Args a{};
    for (int i = 0; i < 40; ++i) a.in[i] = (const float*)d_in[i];
    a.out = (float*)d_out; a.ws = (unsigned char*)d_ws;
    void* args[] = {&a};
    hipError_t e = hipLaunchCooperativeKernel((const void*)mega, dim3(grid), dim3(512), args, LDS_BYTES, stream);
    if (e != hipSuccess) fprintf(stderr, "cooperative launch failed: %s (grid %d)\n", hipGetErrorString(e), grid);
}
```

```cpp
#include <hip/hip_runtime.h>
#include <hip/hip_cooperative_groups.h>
#include <cstdio>
#include <cstdint>
namespace cg = cooperative_groups;
namespace pg8 {
#define PG8_LAS __attribute__((address_space(3)))
typedef unsigned short bf16_t;
typedef short bf16x8 __attribute__((ext_vector_type(8)));
typedef float f32x4 __attribute__((ext_vector_type(4)));
typedef unsigned u32x4 __attribute__((ext_vector_type(4)));
constexpr int BM = 256, BK = 64, HALF = 128, HTB = HALF * BK * 2  , STAGE_BYTES = 8 * HTB, NXCD = 8, WGM = 8;

__host__ __device__ __forceinline__ int lds_byte(int r, int c) { const int st = (r >> 4) * 2 + (c >> 5), rr = r & 15, cc = c & 31, ob = rr * 64 + cc * 2; return st * 1024 + (ob ^ (((ob >> 9) & 1) << 5)); }
__host__ __device__ __forceinline__ void stage_rc(int b, int& R, int& C) { const int st = b / 1024, sb = b % 1024, swz = sb ^ (((sb >> 9) & 1) << 5); R = (st >> 1) * 16 + swz / 64; C = (st & 1) * 32 + (swz % 64) / 2; }
__host__ __device__ __forceinline__ int perm32(int rho) { const int n = rho >> 4, i = rho & 15; return 8 * (i >> 2) + 4 * n + (i & 3); }

struct Unit { int pm, pn; };
struct Gemm { const bf16_t* A; const bf16_t* Bt; int M, N, K; };

struct StaticOrder {
    int nM, nN, nwg, G, c;
    __host__ __device__ void init(int M, int N, int G_, int c_) { nM = M / BM; nN = N / BM; nwg = nM * nN; G = G_; c = c_; }
    __host__ __device__ bool next(int i, Unit& u) const {
        const long L = (long)i * G + c; if (L >= nwg) return false;
        int wgid = (int)L; { const int q = nwg / NXCD, r = nwg % NXCD, xcd = wgid % NXCD, off = wgid / NXCD; wgid = (xcd < r ? xcd * (q + 1) : r * (q + 1) + (xcd - r) * q) + off; }
        const int nig = WGM * nN, gid = wgid / nig, fm = gid * WGM, gsz = (nM - fm) < WGM ? (nM - fm) : WGM;
        u.pm = fm + ((wgid % nig) % gsz); u.pn = (wgid % nig) / gsz; return true;
    }
    __device__ __forceinline__ void a_ready(const Unit&) const {}
    __device__ __forceinline__ void done(const Unit&) const {}
};

__device__ __forceinline__ unsigned cvt_pk_bf16(float lo, float hi) { unsigned r; asm volatile("v_cvt_pk_bf16_f32 %0, %1, %2" : "=v"(r) : "v"(lo), "v"(hi)); return r; }
typedef float f32x2 __attribute__((ext_vector_type(2)));
template <class Epi, class Sched, bool ALIGN_EPI = false, bool SP2 = false>
__device__ __forceinline__ void gemm_phase(PG8_LAS unsigned char* lds, const Gemm g, const Sched& S, const Epi& E) {
    int tid = threadIdx.x; asm volatile("" : "+v"(tid));
    const int wid = __builtin_amdgcn_readfirstlane(tid >> 6), lane = tid & 63, wr = wid >> 2, wc = wid & 3, fr = lane & 15, fq = lane >> 4;
    const int K = g.K, nt = K / BK;
    unsigned voffA[2], voffB[2];
#pragma unroll
    for (int i = 0; i < 2; ++i) { int R, C; stage_rc(tid * 16 + i * 8192, R, C); const int Rb = Epi::PERM ? ((R & ~31) + perm32(R & 31)) : R;
        voffA[i] = (unsigned)(R * K + C) * 2u; voffB[i] = (unsigned)(Rb * K + C) * 2u; }
    const size_t kstep = (size_t)(BK * 2);
    const size_t hstep = (size_t)HALF * K * 2;
    const size_t tstep = 2 * hstep;
    const unsigned ldsw = (unsigned)wid * 1024u;
    const int aoff = lds_byte(wr * 64 + fr, fq * 8), boff = lds_byte(wc * 32 + fr, fq * 8);
#define PG8_SA(b, h) (((b) * 2 + (h)) * HTB)
#define PG8_SB(b, h) ((4 + (b) * 2 + (h)) * HTB)
#define PG8_STAGE(bufoff, gbase, voff) do { _Pragma("unroll") for (int _i = 0; _i < 2; ++_i) \
        __builtin_amdgcn_global_load_lds((const unsigned*)((const char*)(gbase) + (voff)[_i]), (PG8_LAS unsigned*)(lds + (bufoff) + ldsw + _i * 8192), 16, 0, 0); } while (0)
#define PG8_LDA(dst, b, h) do { _Pragma("unroll") for (int m = 0; m < 4; ++m) _Pragma("unroll") for (int k = 0; k < 2; ++k) dst[m][k] = *(const PG8_LAS bf16x8*)(lds + PG8_SA(b, h) + aoff + m * 2048 + k * 1024); } while (0)
#define PG8_LDB(dst, b, h) do { _Pragma("unroll") for (int n = 0; n < 2; ++n) _Pragma("unroll") for (int k = 0; k < 2; ++k) dst[n][k] = *(const PG8_LAS bf16x8*)(lds + PG8_SB(b, h) + boff + n * 2048 + k * 1024); } while (0)
#define PG8_MMA(ai, bj, At, Bt) do { __builtin_amdgcn_s_setprio(1); _Pragma("unroll") for (int m = 0; m < 4; ++m) _Pragma("unroll") for (int n = 0; n < 2; ++n) _Pragma("unroll") for (int k = 0; k < 2; ++k) \
        acc[ai][bj][m][n] = __builtin_amdgcn_mfma_f32_16x16x32_bf16(Bt[n][k], At[m][k], acc[ai][bj][m][n], 0, 0, 0); __builtin_amdgcn_s_setprio(0); } while (0)
#define PG8_WAIT_V(n) asm volatile("s_waitcnt vmcnt(" #n ")" ::: "memory")
#define PG8_WAIT_L(n) asm volatile("s_waitcnt lgkmcnt(" #n ")" ::: "memory")
#define PG8_BAR __builtin_amdgcn_s_barrier()
#define PG8_SCHED __builtin_amdgcn_sched_barrier(0)
    Unit cur, nxt; int ui = 0;
    if (!S.next(0, cur)) return;
    f32x4 acc[2][2][4][2];
#pragma unroll
    for (int a = 0; a < 2; ++a)
#pragma unroll
        for (int b = 0; b < 2; ++b)
#pragma unroll
            for (int m = 0; m < 4; ++m)
#pragma unroll
                for (int n = 0; n < 2; ++n) acc[a][b][m][n] = (f32x4){0.f, 0.f, 0.f, 0.f};
    bf16x8 At[4][2], B0[2][2], B1[2][2];
    const char* cA = (const char*)g.A + (size_t)cur.pm * tstep; const char* cB = (const char*)g.Bt + (size_t)cur.pn * tstep;
    S.a_ready(cur);
    if constexpr (SP2) {
        PG8_STAGE(PG8_SB(0, 0), cB, voffB); PG8_STAGE(PG8_SB(0, 1), cB + hstep, voffB); PG8_STAGE(PG8_SA(0, 0), cA, voffA); PG8_STAGE(PG8_SA(0, 1), cA + hstep, voffA);
        if (wr == 1) PG8_BAR;
        PG8_WAIT_V(2); PG8_BAR;
        PG8_STAGE(PG8_SB(1, 0), cB + kstep, voffB); PG8_STAGE(PG8_SA(1, 0), cA + kstep, voffA); PG8_STAGE(PG8_SB(1, 1), cB + hstep + kstep, voffB);
        PG8_WAIT_V(6); PG8_BAR;
    } else {
        PG8_STAGE(PG8_SB(0, 0), cB, voffB); PG8_STAGE(PG8_SA(0, 0), cA, voffA); PG8_STAGE(PG8_SB(0, 1), cB + hstep, voffB); PG8_STAGE(PG8_SA(0, 1), cA + hstep, voffA);
        if (wr == 1) PG8_BAR;
        PG8_WAIT_V(4); PG8_BAR;
        PG8_STAGE(PG8_SB(1, 0), cB + kstep, voffB); PG8_STAGE(PG8_SA(1, 0), cA + kstep, voffA); PG8_STAGE(PG8_SB(1, 1), cB + hstep + kstep, voffB);
        PG8_WAIT_V(6); PG8_BAR;
    }
    for (;;) {
        const bool has_next = S.next(ui + 1, nxt);
        const char* nA = has_next ? (const char*)g.A + (size_t)nxt.pm * tstep : cA; const char* nB = has_next ? (const char*)g.Bt + (size_t)nxt.pn * tstep : cB;
        for (int t = 0; t < nt; t += 2) {
            const bool last = (t == nt - 2);
            const char* a1 = cA + (size_t)(t + 1) * kstep;
            const char* a2 = last ? nA : cA + (size_t)(t + 2) * kstep; const char* b2 = last ? nB : cB + (size_t)(t + 2) * kstep;
            const char* a3 = a2 + kstep; const char* b3 = b2 + kstep;
            if (last && has_next) S.a_ready(nxt);
            if constexpr (SP2) {
            PG8_LDB(B0, 0, 0); PG8_LDB(B1, 0, 1); PG8_SCHED; PG8_LDA(At, 0, 0); PG8_STAGE(PG8_SA(1, 1), a1 + hstep, voffA);
            PG8_WAIT_V(8); PG8_WAIT_L(0); PG8_BAR; PG8_MMA(0, 0, At, B0); PG8_MMA(0, 1, At, B1); PG8_BAR; PG8_SCHED;
            PG8_LDA(At, 0, 1); PG8_STAGE(PG8_SB(0, 0), b2, voffB); PG8_STAGE(PG8_SB(0, 1), b2 + hstep, voffB); PG8_STAGE(PG8_SA(0, 0), a2, voffA);
            PG8_WAIT_V(8); PG8_WAIT_L(0); PG8_BAR; PG8_MMA(1, 0, At, B0); PG8_MMA(1, 1, At, B1); PG8_BAR; PG8_SCHED;
            PG8_LDB(B0, 1, 0); PG8_LDB(B1, 1, 1); PG8_SCHED; PG8_LDA(At, 1, 0); PG8_STAGE(PG8_SA(0, 1), a2 + hstep, voffA);
            PG8_WAIT_V(8); PG8_WAIT_L(0); PG8_BAR; PG8_MMA(0, 0, At, B0); PG8_MMA(0, 1, At, B1); PG8_BAR; PG8_SCHED;
            PG8_LDA(At, 1, 1); PG8_STAGE(PG8_SB(1, 0), b3, voffB); PG8_STAGE(PG8_SB(1, 1), b3 + hstep, voffB); PG8_STAGE(PG8_SA(1, 0), a3, voffA);
            PG8_WAIT_V(8); PG8_WAIT_L(0); PG8_BAR; PG8_MMA(1, 0, At, B0); PG8_MMA(1, 1, At, B1); PG8_BAR; PG8_SCHED;
            } else {
            PG8_LDB(B0, 0, 0); PG8_SCHED; PG8_LDA(At, 0, 0); PG8_STAGE(PG8_SA(1, 1), a1 + hstep, voffA);
            PG8_WAIT_L(8); PG8_BAR; PG8_WAIT_L(0); PG8_MMA(0, 0, At, B0); PG8_BAR; PG8_SCHED;
            PG8_LDB(B1, 0, 1); PG8_STAGE(PG8_SB(0, 0), b2, voffB);
            PG8_BAR; PG8_WAIT_L(0); PG8_MMA(0, 1, At, B1); PG8_BAR;
            PG8_LDA(At, 0, 1); PG8_STAGE(PG8_SA(0, 0), a2, voffA);
            PG8_BAR; PG8_WAIT_L(0); PG8_MMA(1, 0, At, B0); PG8_BAR; PG8_SCHED;
            PG8_STAGE(PG8_SB(0, 1), b2 + hstep, voffB);
            PG8_WAIT_V(6); PG8_BAR; PG8_MMA(1, 1, At, B1); PG8_BAR;
            PG8_LDB(B0, 1, 0); PG8_SCHED; PG8_LDA(At, 1, 0); PG8_STAGE(PG8_SA(0, 1), a2 + hstep, voffA);
            PG8_WAIT_L(8); PG8_BAR; PG8_WAIT_L(0); PG8_MMA(0, 0, At, B0); PG8_BAR; PG8_SCHED;
            PG8_LDB(B1, 1, 1); PG8_STAGE(PG8_SB(1, 0), b3, voffB);
            PG8_BAR; PG8_WAIT_L(0); PG8_MMA(0, 1, At, B1); PG8_BAR;
            PG8_LDA(At, 1, 1); PG8_STAGE(PG8_SA(1, 0), a3, voffA);
            PG8_BAR; PG8_WAIT_L(0); PG8_MMA(1, 0, At, B0); PG8_BAR; PG8_SCHED;
            PG8_STAGE(PG8_SB(1, 1), b3 + hstep, voffB);
            PG8_WAIT_V(6); PG8_BAR; PG8_MMA(1, 1, At, B1); PG8_BAR;
            }
        }
        if constexpr (ALIGN_EPI) { if (wr == 0) PG8_BAR; }
        if constexpr (!Epi::AFTER_DRAIN) { E(acc, cur, wr, wc, fr, fq); S.done(cur); }
        if (!has_next) break;
#pragma unroll
        for (int a = 0; a < 2; ++a)
#pragma unroll
            for (int b = 0; b < 2; ++b)
#pragma unroll
                for (int m = 0; m < 4; ++m)
#pragma unroll
                    for (int n = 0; n < 2; ++n) acc[a][b][m][n] = (f32x4){0.f, 0.f, 0.f, 0.f};
        cur = nxt; cA = nA; cB = nB; ++ui;
        if constexpr (ALIGN_EPI) { if (wr == 1) PG8_BAR; }
    }
    PG8_WAIT_V(0);
    if constexpr (!ALIGN_EPI) { if (wr == 0) PG8_BAR; }
    PG8_BAR;
    if constexpr (Epi::AFTER_DRAIN) { E.fused(acc, cur, wr, wc, fr, fq, lds, wid, lane); S.done(cur); }
#undef PG8_SA
#undef PG8_SB
#undef PG8_STAGE
#undef PG8_LDA
#undef PG8_LDB
#undef PG8_MMA
#undef PG8_WAIT_V
#undef PG8_WAIT_L
#undef PG8_BAR
#undef PG8_SCHED
}
}

using pg8::f32x4; using pg8::bf16x8;
typedef unsigned short bf16;
typedef unsigned v4u __attribute__((ext_vector_type(4)));
typedef unsigned v2u __attribute__((ext_vector_type(2)));
typedef short s16x4 __attribute__((ext_vector_type(4)));

constexpr int DM = 1024, TLEN = 8192, CTXL = 256, TT = 8448, NLAT = 16384, NR = 16896, DFF = 2816, UC = 2560, NTILE = 528;
constexpr int NSEG = 64, SEGLEN = 132;
constexpr size_t MiB = 1u << 20;
constexpr size_t A8 = (size_t)NR * 256 * 2;
constexpr size_t OFF_MOD = 0, MOD_BYTES = 256 * 1024;
constexpr size_t OFF_XCTX = MiB / 4, OFF_XMY = 2 * MiB + MiB / 4, OFF_HU = 35 * MiB + MiB / 4, OFF_W = 126 * MiB, OFF_MIX = 167 * MiB, OFF_PR = 266 * MiB;
constexpr size_t W_13A = OFF_W, W_2A = OFF_W + 11 * MiB, W_13B = OFF_W + 16 * MiB + MiB / 2, W_2B = OFF_W + 27 * MiB + MiB / 2,
                 W_IN = OFF_W + 33 * MiB, W_OUT = OFF_W + 38 * MiB, W_UQ = OFF_W + 40 * MiB, W_UKV = OFF_W + 40 * MiB + 256 * 1024,
                 W_WUP = OFF_W + 40 * MiB + 384 * 1024, W_AUP = W_WUP + 65536, W_GUP = W_AUP + 65536, W_LWA = W_GUP + 65536, W_LWX = W_LWA + 65536;
constexpr size_t M_QB = OFF_MIX, M_KB = OFF_MIX + 12976128, M_VT = OFF_MIX + 25952256;
constexpr size_t M_LR0 = OFF_PR, M_LIX0 = OFF_PR + 2 * A8;
constexpr size_t M_SEGA = OFF_HU + 83 * MiB, M_SEGB = M_SEGA + MiB + MiB / 4, M_H0 = M_SEGB + MiB + MiB / 4;
constexpr size_t M_RR = OFF_MIX, M_KK = OFF_MIX + A8, M_VV = OFF_MIX + 2 * A8, M_WW = OFF_MIX + 3 * A8, M_BB = OFF_MIX + 7 * A8, M_KD = OFF_MIX + 9 * A8, M_GC = OFF_MIX + 11 * A8;
constexpr size_t M_YS = OFF_HU, M_PL = OFF_HU + 33 * MiB, M_SINIT = OFF_HU + 65 * MiB;
constexpr size_t M_PR = OFF_PR;
constexpr size_t WS_NEED = OFF_PR + 33 * MiB;
constexpr int LDS_BYTES = 131072 + 1024;
#ifndef REP_M1
#define REP_M1 1
#endif
#ifndef REP_M2
#define REP_M2 1
#endif
#ifndef REP_M3
#define REP_M3 1
#endif
#ifndef REP_SCAN
#define REP_SCAN 1
#endif
#ifndef REP_G1
#define REP_G1 1
#endif
constexpr float QSCALE = 0.10206207261596575f * 1.4426950408889634f;

struct Args { const float* in[40]; float* out; unsigned char* ws; };
typedef const __attribute__((address_space(4))) volatile unsigned long long kargq;
__device__ __forceinline__ const float* karg_in(int i) { kargq* p = (kargq*)__builtin_amdgcn_kernarg_segment_ptr(); return (const float*)p[i]; }
__device__ __forceinline__ float* karg_out() { kargq* p = (kargq*)__builtin_amdgcn_kernarg_segment_ptr(); return (float*)p[40]; }
__device__ __forceinline__ unsigned char* karg_ws() { kargq* p = (kargq*)__builtin_amdgcn_kernarg_segment_ptr(); return (unsigned char*)p[41]; }
#define IN(i) karg_in(i)
__device__ __forceinline__ int ltid() { int t = threadIdx.x; asm volatile("" : "+v"(t)); return t; }
__device__ __forceinline__ int lbid() { int t = blockIdx.x; asm volatile("" : "+s"(t)); return t; }
template <class T> __device__ __forceinline__ T* launder(T* p) { asm volatile("" : "+s"(p)); return p; }

__device__ __forceinline__ float bf2f(bf16 h) { return __uint_as_float((unsigned)h << 16); }
__device__ __forceinline__ unsigned f2bf(float f) { unsigned u = __float_as_uint(f); return (u + 0x7fffu + ((u >> 16) & 1u)) >> 16; }
__device__ __forceinline__ unsigned pk2(float lo, float hi) { return f2bf(lo) | (f2bf(hi) << 16); }
__device__ __forceinline__ float sigm(float x) { return 1.f / (1.f + __expf(-x)); }
__device__ __forceinline__ float siluf_(float x) { return x / (1.f + __expf(-x)); }
__device__ __forceinline__ float tanhf_(float y) { return 1.f - 2.f / (1.f + __expf(2.f * y)); }
__device__ __forceinline__ float geluf_(float x) { return 0.5f * x * (1.f + tanhf_(0.7978845608028654f * (x + 0.044715f * x * x * x))); }
__device__ __forceinline__ float wave_sum(float v) {
#pragma unroll
    for (int o = 1; o < 64; o <<= 1) v += __shfl_xor(v, o);
    return v;
}
struct TileInfo { int b, isctx, t0, seqbase, seqlen; };
__device__ __forceinline__ TileInfo tile_info(int tile) {
    TileInfo ti;
    if (tile < 512) { ti.b = tile >> 8; ti.isctx = 0; ti.t0 = (tile & 255) * 32; ti.seqbase = ti.b * TLEN; ti.seqlen = TLEN; }
    else { const int q = tile - 512; ti.b = q >> 3; ti.isctx = 1; ti.t0 = (q & 7) * 32; ti.seqbase = NLAT + ti.b * CTXL; ti.seqlen = CTXL; }
    return ti;
}

struct EpiSwiglu {
    static constexpr bool PERM = true, AFTER_DRAIN = false;
    bf16* H;
    __device__ __forceinline__ void operator()(const f32x4 (&acc)[2][2][4][2], const pg8::Unit& u, int wr, int wc, int fr, int fq) const {
        int pm = u.pm, pn = u.pn; asm volatile("" : "+s"(pm), "+s"(pn), "+s"(wr), "+s"(wc), "+v"(fr), "+v"(fq));
        bf16* tb = H + (size_t)pm * 256 * DFF + pn * 128;
        const unsigned loff = (unsigned)((wr * 64 + fr) * DFF + wc * 32 + 8 * fq);
#pragma unroll
        for (int ai = 0; ai < 2; ++ai)
#pragma unroll
            for (int m = 0; m < 4; ++m) {
                bf16* rowp = tb + (loff + (unsigned)((ai * 128 + m * 16) * DFF));
                const f32x4 g0 = acc[ai][0][m][0], g1 = acc[ai][0][m][1], u0 = acc[ai][1][m][0], u1 = acc[ai][1][m][1];
                v4u w;
                w.x = pg8::cvt_pk_bf16(siluf_(g0[0]) * u0[0], siluf_(g0[1]) * u0[1]); w.y = pg8::cvt_pk_bf16(siluf_(g0[2]) * u0[2], siluf_(g0[3]) * u0[3]);
                w.z = pg8::cvt_pk_bf16(siluf_(g1[0]) * u1[0], siluf_(g1[1]) * u1[1]); w.w = pg8::cvt_pk_bf16(siluf_(g1[2]) * u1[2], siluf_(g1[3]) * u1[3]);
                *(v4u*)rowp = w;
            }
    }
};
struct EpiU {
    static constexpr bool PERM = true, AFTER_DRAIN = false;
    bf16* O; int ldc;
    __device__ __forceinline__ void operator()(const f32x4 (&acc)[2][2][4][2], const pg8::Unit& u, int wr, int wc, int fr, int fq) const {
        int pm = u.pm, pn = u.pn; asm volatile("" : "+s"(pm), "+s"(pn), "+s"(wr), "+s"(wc), "+v"(fr), "+v"(fq));
        bf16* tb = O + (size_t)pm * 256 * ldc + pn * 256;
        const unsigned loff = (unsigned)((wr * 64 + fr) * ldc + wc * 32 + 8 * fq);
#pragma unroll
        for (int ai = 0; ai < 2; ++ai)
#pragma unroll
            for (int m = 0; m < 4; ++m) {
                bf16* rowp = tb + (loff + (unsigned)((ai * 128 + m * 16) * ldc));
#pragma unroll
                for (int bj = 0; bj < 2; ++bj) { const f32x4 v0 = acc[ai][bj][m][0], v1 = acc[ai][bj][m][1]; v4u w;
                    w.x = pg8::cvt_pk_bf16(v0[0], v0[1]); w.y = pg8::cvt_pk_bf16(v0[2], v0[3]); w.z = pg8::cvt_pk_bf16(v1[0], v1[1]); w.w = pg8::cvt_pk_bf16(v1[2], v1[3]);
                    *(v4u*)(rowp + bj * 128) = w; }
            }
    }
};
struct EpiResid {
    static constexpr bool PERM = false, AFTER_DRAIN = false;
    float* xlat; float* xctx; const float* gate; float coef; const float* slat; const float* sctx;
    __device__ __forceinline__ void operator()(const f32x4 (&acc)[2][2][4][2], const pg8::Unit& u, int wr, int wc, int fr, int fq) const {
        int pm = u.pm, pn = u.pn; asm volatile("" : "+s"(pm), "+s"(pn), "+s"(wr), "+s"(wc), "+v"(fr), "+v"(fq));
        const size_t toff = (pm < 64 ? (size_t)pm : (size_t)(pm - 64)) * 256 * DM + pn * 256;
        float* tb = (pm < 64 ? xlat : xctx) + toff; const float* sb = (pm < 64 ? slat : sctx) + toff;
        const float* g = gate + (pm < 64 ? (pm >> 5) : 2) * 9216 + pn * 256;
        const unsigned coff = (unsigned)(wc * 32 + 4 * fq), loff = (unsigned)((wr * 64 + fr) * DM) + coff;
        f32x4 gv[2][2];
#pragma unroll
        for (int bj = 0; bj < 2; ++bj)
#pragma unroll
            for (int n = 0; n < 2; ++n) gv[bj][n] = coef * *(const f32x4*)(g + (coff + (unsigned)(bj * 128 + n * 16)));
#pragma unroll
        for (int ai = 0; ai < 2; ++ai)
#pragma unroll
            for (int m = 0; m < 4; ++m) {
                float* xr = tb + (loff + (unsigned)((ai * 128 + m * 16) * DM)); const float* sr = sb + (loff + (unsigned)((ai * 128 + m * 16) * DM));
#pragma unroll
                for (int bj = 0; bj < 2; ++bj)
#pragma unroll
                    for (int n = 0; n < 2; ++n) { float* xp = xr + (bj * 128 + n * 16);
                        f32x4 xv = *(const f32x4*)(sr + (bj * 128 + n * 16)); xv += gv[bj][n] * acc[ai][bj][m][n]; *(f32x4*)xp = xv; }
                asm volatile("" ::: "memory");
            }
    }
};

__device__ __forceinline__ void phase_modgemv(const Args& a, float* red, int G, int bid, int tid) {
    const float* c = IN(1); const float* cctx = IN(3); const float* ada_w = IN(4); const float* ada_b = IN(5);
    float* mod = (float*)(karg_ws() + OFF_MOD);
    const int w = tid >> 6, lane = tid & 63;
    for (int u = bid; u < 576; u += G) {
        const int l = u / 288, rem = u % 288, jt = rem >> 3, ks = rem & 7;
        const int kb = ks * 128 + w * 16, j0 = jt * 256 + lane * 4;
        f32x4 acc0 = {0.f, 0.f, 0.f, 0.f}, acc1 = acc0, acc2 = acc0;
        for (int kk = 0; kk < 16; ++kk) { const int k = kb + kk;
            const float s0 = siluf_(c[k]), s1 = siluf_(c[1024 + k]), s2 = siluf_(cctx[k]);
            const f32x4 wv = *(const f32x4*)(ada_w + ((size_t)(l * 1024 + k)) * 9216 + j0);
            acc0 += s0 * wv; acc1 += s1 * wv; acc2 += s2 * wv; }
        float* rp = red + (w * 3) * 256 + lane * 4;
        *(f32x4*)rp = acc0; *(f32x4*)(rp + 256) = acc1; *(f32x4*)(rp + 512) = acc2;
        __syncthreads();
        for (int o = tid; o < 768; o += 512) { const int m = o >> 8, jj = o & 255; float s = 0.f;
#pragma unroll
            for (int ww = 0; ww < 8; ++ww) s += red[(ww * 3 + m) * 256 + jj];
            const int j = jt * 256 + jj; if (ks == 0) s += ada_b[l * 9216 + j];
            atomicAdd(&mod[(l * 3 + m) * 9216 + j], s); }
        __syncthreads();
    }
}
__device__ __forceinline__ void phase_copy(const Args& a, int G, int bid, int tid) {
    const f32x4* x4 = (const f32x4*)IN(0); f32x4* o4 = (f32x4*)karg_out();
    for (int i = bid * 512 + tid; i < NLAT * DM / 4; i += G * 512) o4[i] = x4[i];
    const f32x4* c4 = (const f32x4*)IN(2); f32x4* xc4 = (f32x4*)(karg_ws() + OFF_XCTX);
    for (int i = bid * 512 + tid; i < 512 * DM / 4; i += G * 512) xc4[i] = c4[i];
}
__device__ __forceinline__ int swiglu_map(int n) { return n < DFF ? ((n >> 7) * 256 + (n & 127)) : ((((n - DFF) >> 7) * 256) + 128 + ((n - DFF) & 127)); }
__device__ __forceinline__ void transpose_item(const float* W, int K, int N, bf16* WT, float* scr, int item, int lane, int mode, const float* kscale) {
    const int nblk = N / 32, kb = item / nblk, nb = item % nblk, k0 = 64 * kb, n0 = 32 * nb;
#pragma unroll 8
    for (int i = 0; i < 32; ++i) { const int kk = 2 * i + (lane >> 5); float v = W[(size_t)(k0 + kk) * N + n0 + (lane & 31)]; if (kscale) v *= kscale[k0 + kk]; scr[kk * 33 + (lane & 31)] = v; }
    __builtin_amdgcn_wave_barrier();
    const int c = lane & 7;
#pragma unroll
    for (int j = 0; j < 4; ++j) { const int n = (lane >> 3) + 8 * j; const float* s = scr + (8 * c) * 33 + n;
        v4u o; o.x = pk2(s[0 * 33], s[1 * 33]); o.y = pk2(s[2 * 33], s[3 * 33]); o.z = pk2(s[4 * 33], s[5 * 33]); o.w = pk2(s[6 * 33], s[7 * 33]);
        const int nn = n0 + n, drow = mode ? swiglu_map(nn) : nn;
        *(v4u*)(WT + (size_t)drow * K + k0 + 8 * c) = o; }
    __builtin_amdgcn_wave_barrier();
}
__device__ __forceinline__ void convert_weights(const Args& a, int l, float* scr, int gw, int NGW, int lane, int G, int bid, int tid) {
    constexpr int I13 = 16 * 176, I2 = 44 * 32, IIN = 16 * 77, IOUT = 16 * 32, IUQ = 4 * 12, IUKV = 2 * 16;
    constexpr int IEX = 80;
    constexpr int NIT = 2 * I13 + 2 * I2 + IIN + IOUT + IUQ + IUKV + IEX;
    unsigned char* ws = karg_ws();
    for (int it = gw; it < NIT; it += NGW) {
        int r = it;
        if (r < I13) { transpose_item(IN(6) + (size_t)l * DM * 2 * DFF, DM, 2 * DFF, (bf16*)(ws + W_13A), scr, r, lane, 1, nullptr); continue; } r -= I13;
        if (r < I13) { transpose_item(IN(8) + (size_t)l * DM * 2 * DFF, DM, 2 * DFF, (bf16*)(ws + W_13B), scr, r, lane, 1, nullptr); continue; } r -= I13;
        if (r < I2) { transpose_item(IN(7) + (size_t)l * DFF * DM, DFF, DM, (bf16*)(ws + W_2A), scr, r, lane, 0, nullptr); continue; } r -= I2;
        if (r < I2) { transpose_item(IN(9) + (size_t)l * DFF * DM, DFF, DM, (bf16*)(ws + W_2B), scr, r, lane, 0, nullptr); continue; } r -= I2;
        if (r < IIN) { transpose_item(IN(10) + (size_t)l * DM * 2464, DM, 2464, (bf16*)(ws + W_IN), scr, r, lane, 0, nullptr); continue; } r -= IIN;
        if (r < IOUT) { transpose_item(IN(11) + (size_t)l * DM * DM, DM, DM, (bf16*)(ws + W_OUT), scr, r, lane, 0, nullptr); continue; } r -= IOUT;
        if (r < IUQ) { transpose_item(IN(36) + (size_t)l * 256 * 384, 256, 384, (bf16*)(ws + W_UQ), scr, r, lane, 0, IN(35) + l * 256); continue; } r -= IUQ;
        if (r < IUKV) { transpose_item(IN(38) + (size_t)l * 128 * 512, 128, 512, (bf16*)(ws + W_UKV), scr, r, lane, 0, IN(37) + l * 128); continue; } r -= IUKV;
        if (r < 16) { const int d = r >> 3; transpose_item(IN(26) + (size_t)(l * 2 + d) * 64 * 256, 64, 256, (bf16*)(ws + W_WUP) + d * 256 * 64, scr, r & 7, lane, 0, nullptr); continue; } r -= 16;
        if (r < 16) { const int d = r >> 3; transpose_item(IN(28) + (size_t)(l * 2 + d) * 64 * 256, 64, 256, (bf16*)(ws + W_AUP) + d * 256 * 64, scr, r & 7, lane, 0, nullptr); continue; } r -= 16;
        if (r < 16) { transpose_item(IN(29) + (size_t)l * 128 * 256, 128, 256, (bf16*)(ws + W_GUP), scr, r, lane, 0, nullptr); continue; } r -= 16;
        if (r < 16) { const int m = r >> 1; transpose_item(IN(18) + (size_t)(l * 8 + m) * 4096, 64, 64, (bf16*)(ws + W_LWA) + m * 4096, scr, r & 1, lane, 0, nullptr); continue; } r -= 16;
        { const int m = r >> 1; transpose_item(IN(20) + (size_t)(l * 8 + m) * 4096, 64, 64, (bf16*)(ws + W_LWX) + m * 4096, scr, r & 1, lane, 0, nullptr); }
    }
    v4u z = {0u, 0u, 0u, 0u}; v4u* zp = (v4u*)(ws + W_IN + (size_t)2464 * DM * 2);
    for (int i = bid * 512 + tid; i < 96 * DM * 2 / 16; i += G * 512) zp[i] = z;
}
__device__ __forceinline__ void phase_modulate(const Args& a, int l, int which, int gw, int NGW, int lane) {
    unsigned char* ws = karg_ws(); const float* outp = karg_out();
    const bool first = (l == 0 && which == 0);
    const float* srcl = first ? IN(0) : outp; const float* srcc = first ? IN(2) : (const float*)(ws + OFF_XCTX);
    const float* mod = (const float*)(ws + OFF_MOD) + (size_t)l * 3 * 9216;
    bf16* XM = (bf16*)(ws + OFF_XMY);
    for (int r = gw; r < NR; r += NGW) {
        const float* xr = r < NLAT ? srcl + (size_t)r * DM : srcc + (size_t)(r - NLAT) * DM;
        const float* mm = mod + (r < NLAT ? (r >> 13) : 2) * 9216 + which * 3 * 1024;
        f32x4 v[4]; float ss = 0.f;
#pragma unroll
        for (int j = 0; j < 4; ++j) { v[j] = *(const f32x4*)(xr + 4 * lane + 256 * j); ss += (v[j][0] * v[j][0] + v[j][1] * v[j][1]) + (v[j][2] * v[j][2] + v[j][3] * v[j][3]); }
        const float rstd = rsqrtf(wave_sum(ss) * (1.f / DM) + 1e-6f);
#pragma unroll
        for (int j = 0; j < 4; ++j) { const int c = 4 * lane + 256 * j; const f32x4 sh = *(const f32x4*)(mm + c), sc = *(const f32x4*)(mm + 1024 + c);
            const f32x4 o = v[j] * rstd * (1.f + sc) + sh; v2u w; w.x = pk2(o[0], o[1]); w.y = pk2(o[2], o[3]);
            *(v2u*)(XM + (size_t)r * DM + c) = w; }
    }
}
__device__ __forceinline__ void phase_final(const Args& a, int gw, int NGW, int lane) {
    const float* fn = IN(39); float* outp = karg_out();
    for (int r = gw; r < NLAT; r += NGW) {
        float* xr = outp + (size_t)r * DM; f32x4 v[4]; float ss = 0.f;
#pragma unroll
        for (int j = 0; j < 4; ++j) { v[j] = *(const f32x4*)(xr + 4 * lane + 256 * j); ss += (v[j][0] * v[j][0] + v[j][1] * v[j][1]) + (v[j][2] * v[j][2] + v[j][3] * v[j][3]); }
        const float rstd = rsqrtf(wave_sum(ss) * (1.f / DM) + 1e-6f);
#pragma unroll
        for (int j = 0; j < 4; ++j) { const int c = 4 * lane + 256 * j; const f32x4 g = *(const f32x4*)(fn + c); *(f32x4*)(xr + c) = v[j] * rstd * g; }
    }
}

__device__ __forceinline__ void phase_m1(const Args& a, int l, unsigned char* lds, int G, int bid, int tid_unused) {
    unsigned char* ws = karg_ws();
    const bf16* U = (const bf16*)(ws + OFF_HU);
    bf16* Y = (bf16*)(ws + OFF_XMY);
    for (int tile = bid; tile < NTILE; tile += G) {
        const TileInfo ti = tile_info(tile);
        const int row0 = tile * 32;
        {
            const int tid = ltid(); const int lane = tid & 63, wave = __builtin_amdgcn_readfirstlane(tid >> 6), ch = tid & 255, part = tid >> 8; (void)lane; (void)wave; (void)ch; (void)part;
            float* z = (float*)lds;
            float* cv = (float*)(lds + 65536);
            for (int tt = part; tt < 62; tt += 2) { const int t = ti.t0 - 15 + tt; float zz = 0.f;
                if (t >= 0 && t < ti.seqlen) { const bf16* ur = U + (size_t)(ti.seqbase + t) * UC; zz = bf2f(ur[ch]) * sigm(bf2f(ur[256 + ch])); }
                z[tt * 256 + ch] = zz; }
            __syncthreads();
            const float* dw = IN(12) + (size_t)l * 31 * 256 + ch;
            float acc[16]; const float bias = IN(13)[l * 256 + ch];
#pragma unroll
            for (int o = 0; o < 16; ++o) acc[o] = bias;
            for (int j = 0; j < 31; ++j) { const float w = dw[j * 256];
#pragma unroll
                for (int o = 0; o < 16; ++o) acc[o] += w * z[(part * 16 + o + j) * 256 + ch]; }
#pragma unroll
            for (int o = 0; o < 16; ++o) cv[(part * 16 + o) * 256 + ch] = acc[o];
            __syncthreads();
            const f32x4 lg = *(const f32x4*)(IN(14) + l * 256 + lane * 4), lb = *(const f32x4*)(IN(15) + l * 256 + lane * 4);
#pragma unroll
            for (int q = 0; q < 4; ++q) { const int t = wave * 4 + q; const f32x4 v = *(const f32x4*)(cv + t * 256 + lane * 4);
                const float mu = wave_sum((v[0] + v[1]) + (v[2] + v[3])) * (1.f / 256.f);
                const f32x4 dv = v - mu; const float var = wave_sum((dv[0] * dv[0] + dv[1] * dv[1]) + (dv[2] * dv[2] + dv[3] * dv[3])) * (1.f / 256.f);
                const f32x4 yn = dv * rsqrtf(var + 1e-5f) * lg + lb;
                v2u w; w.x = pk2(siluf_(yn[0]), siluf_(yn[1])); w.y = pk2(siluf_(yn[2]), siluf_(yn[3]));
                *(v2u*)(Y + (size_t)(row0 + t) * DM + lane * 4) = w; }
            __syncthreads();
        }
        {
            float* xvf = (float*)lds;
            bf16* xvb = (bf16*)(lds + 32768);
            bf16* rg = (bf16*)(lds + 49664);
            bf16* ixg = (bf16*)(lds + 82432);
            {
                const int tid = ltid(); const int ch = tid & 255, part = tid >> 8;
                const float* cw = IN(16) + (size_t)l * 4 * 256 + ch; const float w0 = cw[0], w1 = cw[256], w2 = cw[512], w3 = cw[768], cb = IN(17)[l * 256 + ch];
                float xin[19];
#pragma unroll
                for (int i = 0; i < 19; ++i) { const int t = ti.t0 + part * 16 + i - 2; xin[i] = (t >= 0 && t < ti.seqlen) ? bf2f(U[(size_t)(ti.seqbase + t) * UC + 512 + ch]) : 0.f; }
#pragma unroll
                for (int o = 0; o < 16; ++o) { const int tl = part * 16 + o;
                    const float v = cb + w0 * xin[o] + w1 * xin[o + 1] + w2 * xin[o + 2] + w3 * xin[o + 3];
                    xvf[tl * 256 + ch] = v; xvb[tl * 264 + ch] = (bf16)f2bf(v);
                }
            }
            __syncthreads();
            {
                const int tid = ltid(); const int ln = tid & 63, wv = __builtin_amdgcn_readfirstlane(tid >> 6), fr = ln & 15, fq = ln >> 4, blk = wv >> 1;
                const bf16* LWAt = (const bf16*)(ws + W_LWA); const bf16* LWXt = (const bf16*)(ws + W_LWX);
                bf16x8 af[2][2];
#pragma unroll
                for (int mt = 0; mt < 2; ++mt)
#pragma unroll
                    for (int ks = 0; ks < 2; ++ks) af[mt][ks] = *(const bf16x8*)(xvb + (mt * 16 + fr) * 264 + blk * 64 + ks * 32 + fq * 8);
#pragma unroll 1
                for (int dn = 0; dn < 4; ++dn) { const int d = dn >> 1, nt = wv * 2 + (dn & 1), ch = nt * 16 + fr, jj = (nt & 3) * 16 + fr;
                    f32x4 ca[2], cx[2];
#pragma unroll
                    for (int mt = 0; mt < 2; ++mt) { ca[mt] = (f32x4){0.f, 0.f, 0.f, 0.f}; cx[mt] = ca[mt]; }
#pragma unroll
                    for (int ks = 0; ks < 2; ++ks) { const size_t wo = ((size_t)(d * 4 + blk) * 64 + jj) * 64 + ks * 32 + fq * 8;
                        const bf16x8 ba = *(const bf16x8*)(LWAt + wo), bx = *(const bf16x8*)(LWXt + wo);
#pragma unroll
                        for (int mt = 0; mt < 2; ++mt) { ca[mt] = __builtin_amdgcn_mfma_f32_16x16x32_bf16(af[mt][ks], ba, ca[mt], 0, 0, 0); cx[mt] = __builtin_amdgcn_mfma_f32_16x16x32_bf16(af[mt][ks], bx, cx[mt], 0, 0, 0); } }
                    const float bga = IN(19)[(l * 2 + d) * 256 + ch], bgx = IN(21)[(l * 2 + d) * 256 + ch];
                    bf16* LR = (bf16*)(ws + M_LR0 + (size_t)d * A8); bf16* LIX = (bf16*)(ws + M_LIX0 + (size_t)d * A8);
#pragma unroll
                    for (int mt = 0; mt < 2; ++mt)
#pragma unroll
                        for (int j = 0; j < 4; ++j) { const int t = mt * 16 + fq * 4 + j;
                            const bf16 rb = (bf16)f2bf(sigm(ca[mt][j] + bga)), ib = (bf16)f2bf(sigm(cx[mt][j] + bgx) * xvf[t * 256 + ch]);
                            LR[(size_t)(row0 + t) * 256 + ch] = rb; LIX[(size_t)(row0 + t) * 256 + ch] = ib;
                            rg[(d * 32 + t) * 256 + ch] = rb; ixg[(d * 32 + t) * 256 + ch] = ib; }
                }
            }
            __syncthreads();
            {
                const int tid = ltid(); const int ch = tid & 255, d = tid >> 8;
                const float lam = IN(22)[(l * 2 + d) * 256 + ch];
                const float cch = -8.f * log1pf(__expf(-lam));
                float A = 1.f, B = 0.f;
#pragma unroll 8
                for (int tt = 0; tt < 32; ++tt) { const int t = d ? 31 - tt : tt;
                    const float al = __expf(cch * bf2f(rg[(d * 32 + t) * 256 + ch])); const float bb = sqrtf(fmaxf(1.f - al * al, 0.f)) * bf2f(ixg[(d * 32 + t) * 256 + ch]); B = al * B + bb; A *= al; }
                ((float*)(ws + M_SEGA))[(size_t)(tile * 2 + d) * 256 + ch] = A;
                ((float*)(ws + M_SEGB))[(size_t)(tile * 2 + d) * 256 + ch] = B;
            }
            __syncthreads();
        }
        {
            const int tid = ltid(); const int lane = tid & 63, wave = __builtin_amdgcn_readfirstlane(tid >> 6), ch = tid & 255, part = tid >> 8; (void)lane; (void)wave; (void)ch; (void)part;
            bf16* As = (bf16*)lds;
            float* kr = (float*)(lds + 32768);
            float* rs = (float*)(lds + 32768 + 4096);
            for (int idx = tid; idx < 32 * 52; idx += 512) { const int t = idx / 52, cc = idx % 52;
                const v4u v = *(const v4u*)(U + (size_t)(row0 + t) * UC + 2048 + cc * 8);
                if (cc < 48) *(v4u*)(As + t * 392 + cc * 8) = v;
                else { const int c0 = (cc - 48) * 8; float* kp = kr + t * 32 + c0;
                    kp[0] = __uint_as_float(v.x << 16); kp[1] = __uint_as_float(v.x & 0xffff0000u); kp[2] = __uint_as_float(v.y << 16); kp[3] = __uint_as_float(v.y & 0xffff0000u);
                    kp[4] = __uint_as_float(v.z << 16); kp[5] = __uint_as_float(v.z & 0xffff0000u); kp[6] = __uint_as_float(v.w << 16); kp[7] = __uint_as_float(v.w & 0xffff0000u); } }
            __syncthreads();
#pragma unroll
            for (int q = 0; q < 4; ++q) { const int t = wave * 4 + q; float sq = 0.f, sk = 0.f;
#pragma unroll
                for (int j = 0; j < 4; ++j) { const float v = bf2f(As[t * 392 + lane + 64 * j]); sq += v * v; }
#pragma unroll
                for (int j = 0; j < 2; ++j) { const float v = bf2f(As[t * 392 + 256 + lane + 64 * j]); sk += v * v; }
                sq = wave_sum(sq); sk = wave_sum(sk);
                if (lane == 0) { rs[t * 2] = rsqrtf(sq * (1.f / 256.f) + 1e-6f); rs[t * 2 + 1] = rsqrtf(sk * (1.f / 128.f) + 1e-6f); } }
            __syncthreads();
            const int fr = lane & 15, fq = lane >> 4;
            bf16* QB = (bf16*)(ws + M_QB); bf16* KB = (bf16*)(ws + M_KB); bf16* VT = (bf16*)(ws + M_VT);
            const bf16* WUQ = (const bf16*)(ws + W_UQ); const bf16* WUKV = (const bf16*)(ws + W_UKV);
            const int keybase = ti.isctx ? TLEN : 0;
#pragma unroll 1
            for (int i = 0; i < 3; ++i) { const int nt = wave * 3 + i;
                f32x4 c0 = {0.f, 0.f, 0.f, 0.f}, c1 = c0;
#pragma unroll
                for (int ks = 0; ks < 8; ++ks) { const bf16x8 bfr = *(const bf16x8*)(WUQ + (size_t)(nt * 16 + fr) * 256 + ks * 32 + fq * 8);
                    const bf16x8 a0 = *(const bf16x8*)(As + fr * 392 + ks * 32 + fq * 8), a1 = *(const bf16x8*)(As + (16 + fr) * 392 + ks * 32 + fq * 8);
                    c0 = __builtin_amdgcn_mfma_f32_16x16x32_bf16(a0, bfr, c0, 0, 0, 0); c1 = __builtin_amdgcn_mfma_f32_16x16x32_bf16(a1, bfr, c1, 0, 0, 0); }
                const int hq = nt / 6, wt = nt % 6, dd = wt * 16 + fr;
#pragma unroll
                for (int mt = 0; mt < 2; ++mt)
#pragma unroll
                    for (int j = 0; j < 4; ++j) { const int tl = mt * 16 + fq * 4 + j; const int t = ti.t0 + tl;
                        float v = (mt ? c1[j] : c0[j]) * rs[tl * 2];
                        const float pv = __shfl_xor(v, 8);
                        if (wt >= 4 && !ti.isctx) { const int f = fr & 7; const float pos = (wt == 4) ? (float)(t >> 6) : (float)(t & 63);
                            const float ang = pos * __expf(-(float)f * (9.210340371976184f / 8.f)); float sn, cs; __sincosf(ang, &sn, &cs);
                            v = (fr & 8) ? (v * cs + pv * sn) : (v * cs - pv * sn); }
                        QB[((size_t)(ti.b * 4 + hq) * TT + keybase + t) * 96 + dd] = (bf16)f2bf(v * QSCALE); } }
#pragma unroll 1
            for (int i = 0; i < 4; ++i) { const int nt = wave * 4 + i;
                f32x4 c0 = {0.f, 0.f, 0.f, 0.f}, c1 = c0;
#pragma unroll
                for (int ks = 0; ks < 4; ++ks) { const bf16x8 bfr = *(const bf16x8*)(WUKV + (size_t)(nt * 16 + fr) * 128 + ks * 32 + fq * 8);
                    const bf16x8 a0 = *(const bf16x8*)(As + fr * 392 + 256 + ks * 32 + fq * 8), a1 = *(const bf16x8*)(As + (16 + fr) * 392 + 256 + ks * 32 + fq * 8);
                    c0 = __builtin_amdgcn_mfma_f32_16x16x32_bf16(a0, bfr, c0, 0, 0, 0); c1 = __builtin_amdgcn_mfma_f32_16x16x32_bf16(a1, bfr, c1, 0, 0, 0); }
                const int hk = nt >> 3, wt = nt & 7;
#pragma unroll
                for (int mt = 0; mt < 2; ++mt)
#pragma unroll
                    for (int j = 0; j < 4; ++j) { const int tl = mt * 16 + fq * 4 + j; const int key = keybase + ti.t0 + tl;
                        const float v = (mt ? c1[j] : c0[j]) * rs[tl * 2 + 1];
                        if (wt < 4) KB[((size_t)(ti.b * 4 + hk) * TT + key) * 96 + wt * 16 + fr] = (bf16)f2bf(v);
                        else VT[((size_t)(ti.b * 4 + hk) * 64 + (wt - 4) * 16 + fr) * TT + key] = (bf16)f2bf(v); } }
            { const int tl = tid >> 4, p = tid & 15, ax = p >> 3, f = p & 7; const int t = ti.t0 + tl;
                float x0 = kr[tl * 32 + ax * 16 + f], x1 = kr[tl * 32 + ax * 16 + 8 + f];
                if (!ti.isctx) { const float pos = ax == 0 ? (float)(t >> 6) : (float)(t & 63); const float ang = pos * __expf(-(float)f * (9.210340371976184f / 8.f));
                    float sn, cs; __sincosf(ang, &sn, &cs); const float y0 = x0 * cs - x1 * sn, y1 = x1 * cs + x0 * sn; x0 = y0; x1 = y1; }
                const bf16 b0 = (bf16)f2bf(x0), b1 = (bf16)f2bf(x1);
#pragma unroll
                for (int h = 0; h < 4; ++h) { bf16* kp = KB + ((size_t)(ti.b * 4 + h) * TT + keybase + t) * 96 + 64 + ax * 16 + f; kp[0] = b0; kp[8] = b1; } }
            __syncthreads();
        }
    }
}

__device__ __forceinline__ void attn_unit(unsigned char* lds, const bf16* QB, const bf16* KB, const bf16* VT, bf16* Y, int b, int h, int q0, int key_lo, int nkt, int tid) {
    const int lane = tid & 63, wave = tid >> 6, fr = lane & 15, fq = lane >> 4;
    const int bh = b * 4 + h;
    constexpr int KSTR = 104, VSTR = 72, KBUF = 64 * KSTR, VBUF = 64 * VSTR;
    bf16* Ks = (bf16*)lds;
    bf16* Vs = (bf16*)lds + 2 * KBUF;
    const int qw = q0 + wave * 32;
    bf16x8 qf[2][3];
#pragma unroll
    for (int qt = 0; qt < 2; ++qt)
#pragma unroll
        for (int ks = 0; ks < 3; ++ks) qf[qt][ks] = *(const bf16x8*)(QB + ((size_t)bh * TT + qw + qt * 16 + fr) * 96 + ks * 32 + fq * 8);
    float mrun[2] = {-1e30f, -1e30f}, lrun[2] = {0.f, 0.f};
    f32x4 o[4][2];
#pragma unroll
    for (int dt = 0; dt < 4; ++dt)
#pragma unroll
        for (int qt = 0; qt < 2; ++qt) o[dt][qt] = (f32x4){0.f, 0.f, 0.f, 0.f};
    const v4u* kg = (const v4u*)(KB + ((size_t)bh * TT + key_lo) * 96);
    const bf16* vg = VT + ((size_t)bh * 64 + (tid >> 3)) * TT + key_lo + (tid & 7) * 8;
    const int kc0 = tid, kc1 = 512 + tid;
    const int ko0 = (kc0 / 12) * KSTR + (kc0 % 12) * 8, ko1 = (kc1 / 12) * KSTR + (kc1 % 12) * 8, vo = (tid >> 3) * VSTR + (tid & 7) * 8;
    v4u rk0, rk1 = {0u, 0u, 0u, 0u}, rv;
    rk0 = kg[kc0]; if (tid < 256) rk1 = kg[kc1]; rv = *(const v4u*)vg;
    *(v4u*)(Ks + ko0) = rk0; if (tid < 256) *(v4u*)(Ks + ko1) = rk1; *(v4u*)(Vs + vo) = rv;
    __syncthreads();
    for (int kt = 0; kt < nkt; ++kt) {
        const int cur = kt & 1;
        if (kt + 1 < nkt) { const v4u* kn = kg + (size_t)(kt + 1) * 768; rk0 = kn[kc0]; if (tid < 256) rk1 = kn[kc1]; rv = *(const v4u*)(vg + (kt + 1) * 64); }
        const bf16* kb = Ks + cur * KBUF; const bf16* vb = Vs + cur * VBUF;
        f32x4 st[4][2];
#pragma unroll
        for (int k4 = 0; k4 < 4; ++k4) {
            st[k4][0] = (f32x4){0.f, 0.f, 0.f, 0.f}; st[k4][1] = st[k4][0];
#pragma unroll
            for (int ks = 0; ks < 3; ++ks) { const bf16x8 kf = *(const bf16x8*)(kb + (k4 * 16 + fr) * KSTR + ks * 32 + fq * 8);
                st[k4][0] = __builtin_amdgcn_mfma_f32_16x16x32_bf16(kf, qf[0][ks], st[k4][0], 0, 0, 0);
                st[k4][1] = __builtin_amdgcn_mfma_f32_16x16x32_bf16(kf, qf[1][ks], st[k4][1], 0, 0, 0); }
        }
        bf16x8 pb[2][2];
#pragma unroll
        for (int qt = 0; qt < 2; ++qt) {
            float mx = st[0][qt][0];
#pragma unroll
            for (int k4 = 0; k4 < 4; ++k4)
#pragma unroll
                for (int j = 0; j < 4; ++j) mx = fmaxf(mx, st[k4][qt][j]);
            mx = fmaxf(mx, __shfl_xor(mx, 16)); mx = fmaxf(mx, __shfl_xor(mx, 32));
            const float mn = fmaxf(mrun[qt], mx), alpha = __builtin_amdgcn_exp2f(mrun[qt] - mn); mrun[qt] = mn;
            float ls = 0.f;
#pragma unroll
            for (int k4 = 0; k4 < 4; ++k4)
#pragma unroll
                for (int j = 0; j < 4; ++j) { const float p = __builtin_amdgcn_exp2f(st[k4][qt][j] - mn); st[k4][qt][j] = p; ls += p; }
            lrun[qt] = lrun[qt] * alpha + ls;
#pragma unroll
            for (int dt = 0; dt < 4; ++dt) o[dt][qt] *= alpha;
#pragma unroll
            for (int u = 0; u < 2; ++u) { v4u w;
                w.x = pg8::cvt_pk_bf16(st[2 * u][qt][0], st[2 * u][qt][1]); w.y = pg8::cvt_pk_bf16(st[2 * u][qt][2], st[2 * u][qt][3]);
                w.z = pg8::cvt_pk_bf16(st[2 * u + 1][qt][0], st[2 * u + 1][qt][1]); w.w = pg8::cvt_pk_bf16(st[2 * u + 1][qt][2], st[2 * u + 1][qt][3]);
                pb[u][qt] = __builtin_bit_cast(bf16x8, w); }
        }
#pragma unroll
        for (int dt = 0; dt < 4; ++dt)
#pragma unroll
            for (int u = 0; u < 2; ++u) {
                const v2u lo = *(const v2u*)(vb + (dt * 16 + fr) * VSTR + 32 * u + 4 * fq), hi = *(const v2u*)(vb + (dt * 16 + fr) * VSTR + 32 * u + 16 + 4 * fq);
                v4u vw; vw.x = lo.x; vw.y = lo.y; vw.z = hi.x; vw.w = hi.y;
                const bf16x8 va = __builtin_bit_cast(bf16x8, vw);
                o[dt][0] = __builtin_amdgcn_mfma_f32_16x16x32_bf16(va, pb[u][0], o[dt][0], 0, 0, 0);
                o[dt][1] = __builtin_amdgcn_mfma_f32_16x16x32_bf16(va, pb[u][1], o[dt][1], 0, 0, 0);
            }
        if (kt + 1 < nkt) { const int nb = cur ^ 1; *(v4u*)(Ks + nb * KBUF + ko0) = rk0; if (tid < 256) *(v4u*)(Ks + nb * KBUF + ko1) = rk1; *(v4u*)(Vs + nb * VBUF + vo) = rv; }
        __syncthreads();
    }
#pragma unroll
    for (int qt = 0; qt < 2; ++qt) {
        float lt = lrun[qt]; lt += __shfl_xor(lt, 16); lt += __shfl_xor(lt, 32);
        const float inv = 1.f / lt;
        const int q = qw + qt * 16 + fr;
        const size_t row = q < TLEN ? (size_t)b * TLEN + q : (size_t)NLAT + b * CTXL + (q - TLEN);
#pragma unroll
        for (int dt = 0; dt < 4; ++dt) { const f32x4 v = o[dt][qt] * inv; v2u w; w.x = pk2(v[0], v[1]); w.y = pk2(v[2], v[3]);
            *(v2u*)(Y + row * DM + 768 + h * 64 + dt * 16 + fq * 4) = w; }
    }
}
__device__ __forceinline__ void lru_prefix(int bd, int tid) {
    unsigned char* ws = karg_ws();
    if (tid >= 256) return;
    const int ch = tid, b = bd >> 1, d = bd & 1;
    const float* __restrict__ SA = (const float*)(ws + M_SEGA); const float* __restrict__ SB = (const float*)(ws + M_SEGB); float* __restrict__ H0 = (float*)(ws + M_H0);
    const int ctile0 = 512 + b * 8, ltile0 = b * 256;
#define LRU_TILE(i_) ((i_) < 8 ? ctile0 + (d ? 7 - (i_) : (i_)) : ltile0 + (d ? 255 - ((i_) - 8) : ((i_) - 8)))
    float hst = 0.f;
    float ca[24], cb[24], na[24], nb[24];
#pragma unroll
    for (int k = 0; k < 24; ++k) { const size_t o = (size_t)(LRU_TILE(k) * 2 + d) * 256 + ch; ca[k] = SA[o]; cb[k] = SB[o]; }
    for (int i0 = 0; i0 < 264; i0 += 24) {
        if (i0 + 24 < 264) {
#pragma unroll
            for (int k = 0; k < 24; ++k) { const size_t o = (size_t)(LRU_TILE(i0 + 24 + k) * 2 + d) * 256 + ch; na[k] = SA[o]; nb[k] = SB[o]; } }
        float hv[24];
#pragma unroll
        for (int k = 0; k < 24; ++k) { hv[k] = hst; hst = ca[k] * hst + cb[k]; }
#pragma unroll
        for (int k = 0; k < 24; ++k) H0[(size_t)(LRU_TILE(i0 + k) * 2 + d) * 256 + ch] = hv[k];
#pragma unroll
        for (int k = 0; k < 24; ++k) { ca[k] = na[k]; cb[k] = nb[k]; }
    }
#undef LRU_TILE
}
__device__ __forceinline__ void lru_rescan(const Args& a, int l, unsigned char* lds, int tile, int tid) {
    unsigned char* ws = karg_ws();
    const int ch = tid & 255, d = tid >> 8;
    const int row0 = tile * 32;
    float hst = ((const float*)(ws + M_H0))[(size_t)(tile * 2 + d) * 256 + ch];
    const float lam = IN(22)[(l * 2 + d) * 256 + ch];
    const float cch = -8.f * log1pf(__expf(-lam));
    const bf16* LR = (const bf16*)(ws + M_LR0 + (size_t)d * A8); const bf16* LIX = (const bf16*)(ws + M_LIX0 + (size_t)d * A8);
    float* hs = (float*)lds;
#pragma unroll 16
    for (int tt = 0; tt < 32; ++tt) { const int t = d ? 31 - tt : tt; const size_t o = (size_t)(row0 + t) * 256 + ch;
        const float al = __expf(cch * bf2f(LR[o])); const float bb = sqrtf(fmaxf(1.f - al * al, 0.f)) * bf2f(LIX[o]);
        hst = al * hst + bb; hs[(d * 32 + t) * 256 + ch] = hst; }
    __syncthreads();
    const bf16* U = (const bf16*)(ws + OFF_HU); bf16* Y = (bf16*)(ws + OFF_XMY);
#pragma unroll 8
    for (int tt = 0; tt < 16; ++tt) { const int t = d * 16 + tt;
        const float y = (hs[t * 256 + ch] + hs[(32 + t) * 256 + ch]) * geluf_(bf2f(U[(size_t)(row0 + t) * UC + 768 + ch]));
        Y[(size_t)(row0 + t) * DM + 256 + ch] = (bf16)f2bf(y); }
    __syncthreads();
}
__device__ __forceinline__ void phase_m2(const Args& a, int l, unsigned char* lds, int G, int bid, int tid) {
    unsigned char* ws = karg_ws();
    const bf16* QB = (const bf16*)(ws + M_QB); const bf16* KB = (const bf16*)(ws + M_KB); const bf16* VT = (const bf16*)(ws + M_VT);
    bf16* Y = (bf16*)(ws + OFF_XMY);
    const int nunits = (l == 0) ? 264 : 256;
    for (int u = bid; u < nunits; u += G) {
        if (u < 256) attn_unit(lds, QB, KB, VT, Y, u >> 7, (u >> 5) & 3, (u & 31) * 256, 0, 132, tid);
        else attn_unit(lds, QB, KB, VT, Y, (u - 256) >> 2, (u - 256) & 3, TLEN, TLEN, 4, tid);
    }
    if (bid >= G - 4) lru_prefix(bid - (G - 4), tid);
}

__device__ __forceinline__ void phase_m3(const Args& a, int l, unsigned char* lds, int G, int bid, int tid) {
    unsigned char* ws = karg_ws();
    const bf16* U = (const bf16*)(ws + OFF_HU);
    const int lane = tid & 63, ch = tid & 255, part = tid >> 8;
    const float* mup = IN(23) + l * 1024; const float* mun = IN(24) + l * 1024;
    bf16* RR = (bf16*)(ws + M_RR); bf16* KKo = (bf16*)(ws + M_KK); bf16* VV = (bf16*)(ws + M_VV); bf16* GC = (bf16*)(ws + M_GC);
    float* kl = (float*)lds;
    float* kkn = (float*)(lds + 32768);
    bf16* twb = (bf16*)(lds + 65536);
    bf16* tab = (bf16*)(lds + 70144);
    bf16* tgb = (bf16*)(lds + 74752);
    for (int tile = bid; tile < NTILE; tile += G) {
        const TileInfo ti = tile_info(tile);
        const int row0 = tile * 32;
        lru_rescan(a, l, lds, tile, ltid());
        {
            const int tid2 = ltid(); const int chunk = tid2 & 127, tg8 = tid2 >> 7, c0 = chunk * 8;
            const bf16* ub = U + (size_t)row0 * UC + 1024 + c0;
            v4u rw[10];
#pragma unroll
            for (int q = 0; q < 10; ++q) { const int tl = tg8 * 8 + q - 1; const int t = ti.t0 + tl;
                rw[q] = (t >= 0 && t < ti.seqlen) ? *(const v4u*)(ub + (ptrdiff_t)tl * UC) : (v4u){0u, 0u, 0u, 0u}; }
            const f32x4 mp0 = *(const f32x4*)(mup + c0), mp1 = *(const f32x4*)(mup + c0 + 4), mn0 = *(const f32x4*)(mun + c0), mn1 = *(const f32x4*)(mun + c0 + 4);
            const float mp[8] = {mp0[0], mp0[1], mp0[2], mp0[3], mp1[0], mp1[1], mp1[2], mp1[3]}, mn[8] = {mn0[0], mn0[1], mn0[2], mn0[3], mn1[0], mn1[1], mn1[2], mn1[3]};
#pragma unroll
            for (int q = 0; q < 8; ++q) { const int tl = tg8 * 8 + q; float ts[8];
#pragma unroll
                for (int e = 0; e < 8; ++e) { const unsigned wm = rw[q][e >> 1], w0 = rw[q + 1][e >> 1], wn = rw[q + 2][e >> 1];
                    const float um = (e & 1) ? __uint_as_float(wm & 0xffff0000u) : __uint_as_float(wm << 16);
                    const float u0 = (e & 1) ? __uint_as_float(w0 & 0xffff0000u) : __uint_as_float(w0 << 16);
                    const float un = (e & 1) ? __uint_as_float(wn & 0xffff0000u) : __uint_as_float(wn << 16);
                    ts[e] = u0 + mp[e] * (um - u0) + mn[e] * (un - u0); }
                if (chunk >= 32 && chunk < 64) { float* kp = kl + tl * 256 + (c0 - 256); *(f32x4*)kp = (f32x4){ts[0], ts[1], ts[2], ts[3]}; *(f32x4*)(kp + 4) = (f32x4){ts[4], ts[5], ts[6], ts[7]}; }
                else {
                    if (chunk >= 96 && chunk < 104) {
#pragma unroll
                        for (int e = 0; e < 8; ++e) ts[e] = tanhf_(ts[e]); }
                    if (chunk >= 112) {
#pragma unroll
                        for (int e = 0; e < 8; ++e) ts[e] = sigm(ts[e]); }
                    v4u o; o.x = pk2(ts[0], ts[1]); o.y = pk2(ts[2], ts[3]); o.z = pk2(ts[4], ts[5]); o.w = pk2(ts[6], ts[7]);
                    if (chunk < 32) *(v4u*)(RR + (size_t)(row0 + tl) * 256 + c0) = o;
                    else if (chunk < 96) *(v4u*)(VV + (size_t)(row0 + tl) * 256 + (c0 - 512)) = o;
                    else if (chunk < 104) *(v4u*)(twb + tl * 72 + (c0 - 768)) = o;
                    else if (chunk < 112) *(v4u*)(tab + tl * 72 + (c0 - 832)) = o;
                    else *(v4u*)(tgb + tl * 136 + (c0 - 896)) = o; }
            }
        }
        __syncthreads();
        {
            const int tid2 = ltid(); const int ch = tid2 & 255, pt = tid2 >> 8; const float kkc = IN(30)[l * 256 + ch];
#pragma unroll 4
            for (int q = 0; q < 16; ++q) { const int t = pt * 16 + q; const float kr = kl[t * 256 + ch] * kkc; const float nrm = wave_sum(kr * kr);
                const float kk = kr * rsqrtf(fmaxf(nrm, 1e-24f)); kkn[t * 256 + ch] = kk; KKo[(size_t)(row0 + t) * 256 + ch] = (bf16)f2bf(kk); }
        }
        __syncthreads();
        {
            const int tid2 = ltid(); const int ln = tid2 & 63, wv = __builtin_amdgcn_readfirstlane(tid2 >> 6), fr = ln & 15, fq = ln >> 4;
            const bf16* WUPt = (const bf16*)(ws + W_WUP); const bf16* AUPt = (const bf16*)(ws + W_AUP); const bf16* GUPt = (const bf16*)(ws + W_GUP);
            bf16x8 aw[2][2], aa[2][2];
#pragma unroll
            for (int mt = 0; mt < 2; ++mt)
#pragma unroll
                for (int ks = 0; ks < 2; ++ks) { aw[mt][ks] = *(const bf16x8*)(twb + (mt * 16 + fr) * 72 + ks * 32 + fq * 8); aa[mt][ks] = *(const bf16x8*)(tab + (mt * 16 + fr) * 72 + ks * 32 + fq * 8); }
#pragma unroll 1
            for (int dn = 0; dn < 4; ++dn) { const int d = dn >> 1, nt = wv * 2 + (dn & 1), ch = nt * 16 + fr;
                f32x4 cw[2], ca[2];
#pragma unroll
                for (int mt = 0; mt < 2; ++mt) { cw[mt] = (f32x4){0.f, 0.f, 0.f, 0.f}; ca[mt] = cw[mt]; }
#pragma unroll
                for (int ks = 0; ks < 2; ++ks) { const bf16x8 bw = *(const bf16x8*)(WUPt + ((size_t)d * 256 + ch) * 64 + ks * 32 + fq * 8), ba = *(const bf16x8*)(AUPt + ((size_t)d * 256 + ch) * 64 + ks * 32 + fq * 8);
#pragma unroll
                    for (int mt = 0; mt < 2; ++mt) { cw[mt] = __builtin_amdgcn_mfma_f32_16x16x32_bf16(aw[mt][ks], bw, cw[mt], 0, 0, 0); ca[mt] = __builtin_amdgcn_mfma_f32_16x16x32_bf16(aa[mt][ks], ba, ca[mt], 0, 0, 0); } }
                const float w0 = IN(25)[(l * 2 + d) * 256 + ch], a0 = IN(27)[(l * 2 + d) * 256 + ch], kac = IN(31)[l * 256 + ch];
                float* WW = (float*)(ws + M_WW) + (size_t)d * NR * 256; bf16* BB = (bf16*)(ws + M_BB + (size_t)d * A8); bf16* KD = (bf16*)(ws + M_KD + (size_t)d * A8);
#pragma unroll
                for (int mt = 0; mt < 2; ++mt)
#pragma unroll
                    for (int j = 0; j < 4; ++j) { const int t = mt * 16 + fq * 4 + j; const size_t o = (size_t)(row0 + t) * 256 + ch;
                        const float e = sigm(w0 + cw[mt][j]) * 0.6065306597126334f;
                        const float av = sigm(a0 + ca[mt][j]);
                        WW[o] = __expf(-e);
                        KD[o] = (bf16)f2bf(kl[t * 256 + ch] * (1.f + (av - 1.f) * kac));
                        BB[o] = (bf16)f2bf(kkn[t * 256 + ch] * av); }
            }
#pragma unroll 1
            for (int nl = 0; nl < 2; ++nl) { const int ch = (wv * 2 + nl) * 16 + fr;
                f32x4 cg[2] = {(f32x4){0.f, 0.f, 0.f, 0.f}, (f32x4){0.f, 0.f, 0.f, 0.f}};
#pragma unroll
                for (int ks = 0; ks < 4; ++ks) { const bf16x8 bg = *(const bf16x8*)(GUPt + (size_t)ch * 128 + ks * 32 + fq * 8);
#pragma unroll
                    for (int mt = 0; mt < 2; ++mt) { const bf16x8 ag = *(const bf16x8*)(tgb + (mt * 16 + fr) * 136 + ks * 32 + fq * 8); cg[mt] = __builtin_amdgcn_mfma_f32_16x16x32_bf16(ag, bg, cg[mt], 0, 0, 0); } }
#pragma unroll
                for (int mt = 0; mt < 2; ++mt)
#pragma unroll
                    for (int j = 0; j < 4; ++j) GC[(size_t)(row0 + mt * 16 + fq * 4 + j) * 256 + ch] = (bf16)f2bf(cg[mt][j]);
            }
        }
        __syncthreads();
    }
}

typedef const unsigned cu32;
typedef const float cf32;
__device__ __forceinline__ int chain_row(int b, int d, int tau) {
    return tau < CTXL ? (NLAT + b * CTXL + (d ? CTXL - 1 - tau : tau)) : (b * TLEN + (d ? TLEN - 1 - (tau - CTXL) : (tau - CTXL)));
}
template <int MODE>
__device__ __forceinline__ void rwkv_steps(float (&S)[64], int b, int h, int d, int tau0, int n, unsigned char* ws, int lane, float* wl) {
    const bf16* KKp = (const bf16*)(ws + M_KK); const bf16* RRp = (const bf16*)(ws + M_RR); const bf16* VVp = (const bf16*)(ws + M_VV);
    const float* WWp = (const float*)(ws + M_WW) + (size_t)d * NR * 256; const bf16* BBp = (const bf16*)(ws + M_BB + (size_t)d * A8); const bf16* KDp = (const bf16*)(ws + M_KD + (size_t)d * A8);
    float* YS = (float*)(ws + M_YS) + (size_t)d * NR * 256;
    float pk, pw, pb, pkd = 0.f, pr = 0.f, pv = 0.f; size_t poff;
#define RWKV_LOAD(s_) do { poff = (size_t)chain_row(b, d, tau0 + (s_)) * 256 + h * 64 + lane; pk = bf2f(KKp[poff]); pw = WWp[poff]; pb = bf2f(BBp[poff]); \
        if (MODE != 1) { pkd = bf2f(KDp[poff]); pv = bf2f(VVp[poff]); } if (MODE == 2) pr = bf2f(RRp[poff]); } while (0)
    RWKV_LOAD(0);
    for (int s = 0; s < n; ++s) {
        float* buf = wl + (s & 1) * 320;
        buf[lane] = pk; buf[64 + lane] = pw; buf[128 + lane] = pb;
        if (MODE != 1) buf[192 + lane] = pkd;
        if (MODE == 2) buf[256 + lane] = pr;
        const float vv = pv; const size_t yoff = poff;
        if (s + 1 < n) RWKV_LOAD(s + 1);
        float sa0 = 0.f, sa1 = 0.f, sa2 = 0.f, sa3 = 0.f;
#pragma unroll
        for (int i = 0; i < 64; i += 4) { const f32x4 k4 = *(const f32x4*)(buf + i);
            sa0 += S[i] * k4[0]; sa1 += S[i + 1] * k4[1]; sa2 += S[i + 2] * k4[2]; sa3 += S[i + 3] * k4[3]; }
        const float nsa = -((sa0 + sa1) + (sa2 + sa3));
        float y0 = 0.f, y1 = 0.f, y2 = 0.f, y3 = 0.f;
#pragma unroll
        for (int i = 0; i < 64; i += 4) { const f32x4 w4 = *(const f32x4*)(buf + 64 + i), b4 = *(const f32x4*)(buf + 128 + i);
            f32x4 t = nsa * b4;
            if (MODE != 1) { const f32x4 kd4 = *(const f32x4*)(buf + 192 + i); t += vv * kd4; }
            S[i] = S[i] * w4[0] + t[0]; S[i + 1] = S[i + 1] * w4[1] + t[1]; S[i + 2] = S[i + 2] * w4[2] + t[2]; S[i + 3] = S[i + 3] * w4[3] + t[3];
            if (MODE == 2) { const f32x4 r4 = *(const f32x4*)(buf + 256 + i); y0 += S[i] * r4[0]; y1 += S[i + 1] * r4[1]; y2 += S[i + 2] * r4[2]; y3 += S[i + 3] * r4[3]; } }
        if (MODE == 2) YS[yoff] = (y0 + y1) + (y2 + y3);
    }
#undef RWKV_LOAD
}
typedef float f32x2 __attribute__((ext_vector_type(2)));
__device__ __forceinline__ void rwkv_pass1(f32x2 (&SL)[32], f32x2 (&SI)[32], int b, int h, int d, int tau0, int n, unsigned char* ws, int lane, float* wl) {
    const bf16* KKp = (const bf16*)(ws + M_KK); const bf16* VVp = (const bf16*)(ws + M_VV); const bf16* RRp = (const bf16*)(ws + M_RR);
    const float* WWp = (const float*)(ws + M_WW) + (size_t)d * NR * 256; const bf16* BBp = (const bf16*)(ws + M_BB + (size_t)d * A8); const bf16* KDp = (const bf16*)(ws + M_KD + (size_t)d * A8);
    float* YS = (float*)(ws + M_YS) + (size_t)d * NR * 256; float* PR = (float*)(ws + M_PR) + (size_t)d * NR * 256;
    float pk, pw, pb, pkd, pv, pr; size_t poff;
#define RWKV_LOAD(s_) do { poff = (size_t)chain_row(b, d, tau0 + (s_)) * 256 + h * 64 + lane; pk = bf2f(KKp[poff]); pw = WWp[poff]; pb = bf2f(BBp[poff]); pkd = bf2f(KDp[poff]); pv = bf2f(VVp[poff]); pr = bf2f(RRp[poff]); } while (0)
    RWKV_LOAD(0);
    for (int s = 0; s < n; ++s) {
        float* buf = wl + (s & 1) * 320;
        buf[lane] = pk; buf[64 + lane] = pw; buf[128 + lane] = pb; buf[192 + lane] = pkd; buf[256 + lane] = pr;
        const float vv = pv; const size_t yoff = poff;
        if (s + 1 < n) RWKV_LOAD(s + 1);
        f32x2 aL0 = {0.f, 0.f}, aL1 = aL0, aI0 = aL0, aI1 = aL0;
#pragma unroll
        for (int q = 0; q < 16; ++q) { const f32x4 k4 = *(const f32x4*)(buf + 4 * q);
            aL0 += SL[2 * q] * k4.lo; aL1 += SL[2 * q + 1] * k4.hi; aI0 += SI[2 * q] * k4.lo; aI1 += SI[2 * q + 1] * k4.hi; }
        const f32x2 tL = aL0 + aL1, tI = aI0 + aI1;
        const float nsl = -(tL.x + tL.y), nsi = -(tI.x + tI.y);
        f32x2 yL0 = {0.f, 0.f}, yL1 = yL0, yI0 = yL0, yI1 = yL0;
#pragma unroll
        for (int q = 0; q < 16; ++q) {
            const f32x4 w4 = *(const f32x4*)(buf + 64 + 4 * q), b4 = *(const f32x4*)(buf + 128 + 4 * q), kd4 = *(const f32x4*)(buf + 192 + 4 * q), r4 = *(const f32x4*)(buf + 256 + 4 * q);
            const f32x4 tl = nsl * b4 + vv * kd4, tiv = nsi * b4;
            SL[2 * q] = SL[2 * q] * w4.lo + tl.lo; SL[2 * q + 1] = SL[2 * q + 1] * w4.hi + tl.hi;
            SI[2 * q] = SI[2 * q] * w4.lo + tiv.lo; SI[2 * q + 1] = SI[2 * q + 1] * w4.hi + tiv.hi;
            yL0 += SL[2 * q] * r4.lo; yL1 += SL[2 * q + 1] * r4.hi; yI0 += SI[2 * q] * r4.lo; yI1 += SI[2 * q + 1] * r4.hi; }
        const f32x2 yl = yL0 + yL1, yp = yI0 + yI1;
        YS[yoff] = yl.x + yl.y; PR[yoff] = yp.x + yp.y;
    }
#undef RWKV_LOAD
}
__device__ __forceinline__ void phase_m4(const Args& a, unsigned char* lds, int G, int bid, int tid) {
    const int lane = tid & 63, wave = __builtin_amdgcn_readfirstlane(tid >> 6), half = wave >> 2, tk = wave & 3;
    unsigned char* ws = karg_ws(); float* PL = (float*)(ws + M_PL);
    float* wl = (float*)lds + wave * 320;
    float* xch = (float*)lds + 8 * 320 + tk * 1024;
    float* ych = xch + 512;
    const bf16* KKp = (const bf16*)(ws + M_KK); const bf16* VVp = (const bf16*)(ws + M_VV); const bf16* RRp = (const bf16*)(ws + M_RR);
    for (int task0 = bid * 4; task0 < 16 * NSEG; task0 += G * 4) {
        const int task = task0 + tk; const int seg = task & (NSEG - 1), chain = task >> 6;
        const int d = chain & 1, h = (chain >> 1) & 3, b = chain >> 3;
        const float* WWp = (const float*)(ws + M_WW) + (size_t)d * NR * 256; const bf16* BBp = (const bf16*)(ws + M_BB + (size_t)d * A8); const bf16* KDp = (const bf16*)(ws + M_KD + (size_t)d * A8);
        float* YS = (float*)(ws + M_YS) + (size_t)d * NR * 256; float* PR = (float*)(ws + M_PR) + (size_t)d * NR * 256;
        f32x2 SL[16], SI[16]; int ln = lane; asm volatile("" : "+v"(ln));
#pragma unroll
        for (int i = 0; i < 16; ++i) { SL[i] = (f32x2){0.f, 0.f}; SI[i] = (f32x2){(32 * half + 2 * i == ln) ? 1.f : 0.f, (32 * half + 2 * i + 1 == ln) ? 1.f : 0.f}; }
        const int tau0 = seg * SEGLEN, cidx = h * 64 + 32 * half + (lane & 31);
        float p0, p1, p2, pv; size_t rowoff, prevoff = 0;
#define M4_LOAD(s_) do { rowoff = (size_t)chain_row(b, d, tau0 + (s_)) * 256; const size_t po = rowoff + cidx; \
            if (lane < 32) { p0 = bf2f(KKp[po]); p1 = WWp[po]; p2 = bf2f(BBp[po]); } else { p0 = bf2f(KDp[po]); p1 = bf2f(RRp[po]); p2 = 0.f; } pv = bf2f(VVp[rowoff + h * 64 + lane]); } while (0)
        M4_LOAD(0);
        for (int s = 0; s < SEGLEN; ++s) {
            float* buf = wl + (s & 1) * 160; const int l31 = lane & 31;
            if (lane < 32) { buf[l31] = p0; buf[32 + l31] = p1; buf[64 + l31] = p2; } else { buf[96 + l31] = p0; buf[128 + l31] = p1; }
            const float vv = pv; const size_t yoff = rowoff + h * 64 + lane;
            if (s + 1 < SEGLEN) M4_LOAD(s + 1);
            f32x2 aL0 = {0.f, 0.f}, aL1 = aL0, aI0 = aL0, aI1 = aL0;
#pragma unroll
            for (int q = 0; q < 8; ++q) { const f32x4 k4 = *(const f32x4*)(buf + 4 * q);
                aL0 += SL[2 * q] * k4.lo; aL1 += SL[2 * q + 1] * k4.hi; aI0 += SI[2 * q] * k4.lo; aI1 += SI[2 * q + 1] * k4.hi; }
            const f32x2 tL = aL0 + aL1, tI = aI0 + aI1;
            float* xw = xch + (s & 1) * 256;
            xw[half * 128 + lane] = tL.x + tL.y; xw[half * 128 + 64 + lane] = tI.x + tI.y;
            __syncthreads();
            const float nsl = -(xw[lane] + xw[128 + lane]), nsi = -(xw[64 + lane] + xw[192 + lane]);
            if (s > 0) {
                const float* yr = ych + ((s - 1) & 1) * 256;
                if (half == 0) YS[prevoff] = yr[lane] + yr[128 + lane]; else PR[prevoff] = yr[64 + lane] + yr[192 + lane];
            }
            f32x2 yL0 = {0.f, 0.f}, yL1 = yL0, yI0 = yL0, yI1 = yL0;
#pragma unroll
            for (int q = 0; q < 8; ++q) {
                const f32x4 w4 = *(const f32x4*)(buf + 32 + 4 * q), b4 = *(const f32x4*)(buf + 64 + 4 * q), kd4 = *(const f32x4*)(buf + 96 + 4 * q), r4 = *(const f32x4*)(buf + 128 + 4 * q);
                const f32x4 tl = nsl * b4 + vv * kd4, tiv = nsi * b4;
                SL[2 * q] = SL[2 * q] * w4.lo + tl.lo; SL[2 * q + 1] = SL[2 * q + 1] * w4.hi + tl.hi;
                SI[2 * q] = SI[2 * q] * w4.lo + tiv.lo; SI[2 * q + 1] = SI[2 * q + 1] * w4.hi + tiv.hi;
                yL0 += SL[2 * q] * r4.lo; yL1 += SL[2 * q + 1] * r4.hi; yI0 += SI[2 * q] * r4.lo; yI1 += SI[2 * q + 1] * r4.hi; }
            const f32x2 yl = yL0 + yL1, yp = yI0 + yI1;
            float* yw = ych + (s & 1) * 256;
            yw[half * 128 + lane] = yl.x + yl.y; yw[half * 128 + 64 + lane] = yp.x + yp.y;
            prevoff = yoff;
        }
#undef M4_LOAD
        __syncthreads();
        { const float* yr = ych + ((SEGLEN - 1) & 1) * 256;
          if (half == 0) YS[prevoff] = yr[lane] + yr[128 + lane]; else PR[prevoff] = yr[64 + lane] + yr[192 + lane]; }
        float* o = PL + (((size_t)(chain * NSEG + seg) * 2) * 64 + lane) * 64 + 32 * half;
#pragma unroll
        for (int i = 0; i < 16; i += 2) { *(f32x4*)(o + 2 * i) = (f32x4){SL[i].x, SL[i].y, SL[i + 1].x, SL[i + 1].y}; *(f32x4*)(o + 4096 + 2 * i) = (f32x4){SI[i].x, SI[i].y, SI[i + 1].x, SI[i + 1].y}; }
        __syncthreads();
    }
}
__device__ __forceinline__ void phase_m5(const Args& a, unsigned char* lds, int G, int bid, int tid) {
    unsigned char* ws = karg_ws(); const float* PL = (const float*)(ws + M_PL); float* SI = (float*)(ws + M_SINIT);
    float* Sx = (float*)lds;
    const int lane = tid & 63, wv = __builtin_amdgcn_readfirstlane(tid >> 6), fr = lane & 15, fq = lane >> 4;
    const bool act = wv < 4;
    for (int u = bid; u < 64; u += G) {
        const int chain = u >> 2, row0 = (u & 3) * 16, col = (wv & 3) * 16 + fr;
        const float* Pg = PL + ((size_t)(chain * NSEG) * 2 + 1) * 4096; const float* Lg = PL + ((size_t)(chain * NSEG) * 2) * 4096;
        float* SIc = SI + (size_t)(chain * NSEG) * 4096;
        f32x4 cur = {0.f, 0.f, 0.f, 0.f}; f32x4 lv[3]; float pb[3][16];
#pragma unroll
        for (int q = 0; q < 3; ++q) { lv[q] = cur;
            if (act) { const float* Pn = Pg + (size_t)q * 8192; const float* Ln = Lg + (size_t)q * 8192;
#pragma unroll
                for (int ks = 0; ks < 16; ++ks) pb[q][ks] = Pn[(4 * ks + fq) * 64 + col];
#pragma unroll
                for (int j = 0; j < 4; ++j) lv[q][j] = Ln[(row0 + fq * 4 + j) * 64 + col]; } }
        for (int g0 = 0; g0 < NSEG - 1; g0 += 3) {
#pragma unroll
            for (int q = 0; q < 3; ++q) { const int g = g0 + q;
                if (act) {
#pragma unroll
                    for (int j = 0; j < 4; ++j) { SIc[(size_t)g * 4096 + (row0 + fq * 4 + j) * 64 + col] = cur[j]; Sx[(fq * 4 + j) * 68 + col] = cur[j]; }
                }
                __syncthreads();
                if (act) {
                    f32x4 acc = lv[q];
#pragma unroll
                    for (int ks = 0; ks < 16; ++ks) { const float av = Sx[fr * 68 + 4 * ks + fq]; acc = __builtin_amdgcn_mfma_f32_16x16x4f32(av, pb[q][ks], acc, 0, 0, 0); }
                    cur = acc;
                    if (g + 3 < NSEG - 1) { const float* Pn = Pg + (size_t)(g + 3) * 8192; const float* Ln = Lg + (size_t)(g + 3) * 8192;
#pragma unroll
                        for (int ks = 0; ks < 16; ++ks) pb[q][ks] = Pn[(4 * ks + fq) * 64 + col];
#pragma unroll
                        for (int j = 0; j < 4; ++j) lv[q][j] = Ln[(row0 + fq * 4 + j) * 64 + col]; }
                }
                __syncthreads();
            }
        }
        if (act) {
#pragma unroll
            for (int j = 0; j < 4; ++j) SIc[(size_t)(NSEG - 1) * 4096 + (row0 + fq * 4 + j) * 64 + col] = cur[j];
        }
    }
}
__device__ __forceinline__ void phase_m6(const Args& a, unsigned char* lds, int G, int bid, int tid) {
    const int lane = tid & 63, wave = __builtin_amdgcn_readfirstlane(tid >> 6);
    unsigned char* ws = karg_ws(); const float* SI = (const float*)(ws + M_SINIT);
    float* wl = (float*)lds + wave * 256;
    for (int task = bid * 8 + wave; task < 16 * (NSEG - 1); task += G * 8) {
        const int seg = 1 + task % (NSEG - 1), chain = task / (NSEG - 1);
        const int d = chain & 1, h = (chain >> 1) & 3, b = chain >> 3;
        float* YS = (float*)(ws + M_YS) + (size_t)d * NR * 256; const float* PR = (const float*)(ws + M_PR) + (size_t)d * NR * 256;
        f32x2 S0[32];
        const float* si = SI + ((size_t)(chain * NSEG + seg) * 64 + lane) * 64;
#pragma unroll
        for (int i = 0; i < 32; i += 2) { const f32x4 v = *(const f32x4*)(si + 2 * i); S0[i] = v.lo; S0[i + 1] = v.hi; }
        const int tau0 = seg * SEGLEN;
        size_t o0 = (size_t)chain_row(b, d, tau0) * 256 + h * 64 + lane, o1 = (size_t)chain_row(b, d, tau0 + 1) * 256 + h * 64 + lane;
        float p0 = PR[o0], p1 = PR[o1], y0 = YS[o0], y1 = YS[o1];
        for (int s = 0; s < SEGLEN; s += 2) {
            wl[lane] = p0; wl[64 + lane] = p1;
            const size_t c0 = o0, c1 = o1; const float yy0 = y0, yy1 = y1;
            if (s + 2 < SEGLEN) { o0 = (size_t)chain_row(b, d, tau0 + s + 2) * 256 + h * 64 + lane; o1 = (size_t)chain_row(b, d, tau0 + s + 3) * 256 + h * 64 + lane; p0 = PR[o0]; p1 = PR[o1]; y0 = YS[o0]; y1 = YS[o1]; }
            f32x2 a0 = {0.f, 0.f}, a1 = a0, b0 = a0, b1 = a0;
#pragma unroll
            for (int q = 0; q < 16; ++q) { const f32x4 u = *(const f32x4*)(wl + 4 * q), w = *(const f32x4*)(wl + 64 + 4 * q);
                a0 += S0[2 * q] * u.lo; a1 += S0[2 * q + 1] * u.hi; b0 += S0[2 * q] * w.lo; b1 += S0[2 * q + 1] * w.hi; }
            const f32x2 ta = a0 + a1, tb = b0 + b1;
            YS[c0] = yy0 + (ta.x + ta.y); YS[c1] = yy1 + (tb.x + tb.y);
            asm volatile("" ::: "memory");
        }
    }
}
__device__ __forceinline__ void phase_m7(const Args& a, int l, int gw, int NGW, int lane) {
    unsigned char* ws = karg_ws();
    const float* Y0 = (const float*)(ws + M_YS); const float* Y1 = Y0 + (size_t)NR * 256;
    const bf16* RR = (const bf16*)(ws + M_RR); const bf16* VV = (const bf16*)(ws + M_VV); const bf16* KD0 = (const bf16*)(ws + M_KD); const bf16* KD1 = (const bf16*)(ws + M_KD + A8);
    const bf16* GC = (const bf16*)(ws + M_GC); bf16* Y = (bf16*)(ws + OFF_XMY);
    for (int r = gw; r < NR; r += NGW) {
#pragma unroll
        for (int h = 0; h < 4; ++h) { const int c = h * 64 + lane; const size_t o = (size_t)r * 256 + c;
            const float ys = Y0[o] + Y1[o];
            const float mu = wave_sum(ys) * (1.f / 64.f); const float dv = ys - mu; const float var = wave_sum(dv * dv) * (1.f / 64.f);
            float ov = dv * rsqrtf(var + 64e-5f) * IN(33)[l * 256 + c] + IN(34)[l * 256 + c];
            const float rv = bf2f(RR[o]), rk = IN(32)[l * 256 + c], vv = bf2f(VV[o]);
            const float b0 = wave_sum(rv * bf2f(KD0[o]) * rk), b1 = wave_sum(rv * bf2f(KD1[o]) * rk);
            ov += (b0 + b1) * vv;
            Y[(size_t)r * DM + 512 + c] = (bf16)f2bf(ov * bf2f(GC[o])); }
    }
}

#define LAS __attribute__((address_space(3)))
#define XB_TMO      128
#define XB_XCNT(j)  (256  + 64 * (j))
#define XB_XSUB(j)  (1280 + 64 * (j))
#define XB_XGEN(j)  (2304 + 64 * (j))
#define XB_TOP      3328
#define XB_TOPGEN   3392
#define XCD_BAR_WORDS 3456
#define XB_SPIN_CAP (1u << 18)

__device__ __forceinline__ unsigned xb_ld(unsigned* p)              { return __hip_atomic_load(p, __ATOMIC_RELAXED, __HIP_MEMORY_SCOPE_AGENT); }
__device__ __forceinline__ unsigned xb_add(unsigned* p, unsigned v) { return __hip_atomic_fetch_add(p, v, __ATOMIC_RELAXED, __HIP_MEMORY_SCOPE_AGENT); }
__device__ __forceinline__ unsigned xb_xcc_id() { return (unsigned)__builtin_amdgcn_s_getreg((3 << 11) | 20) & 0xFu; }
#define XB_SPIN(cond, bar) do { unsigned _sp = 0; while (cond) { __builtin_amdgcn_s_sleep(1); \
    if ((++_sp & 255u) == 0u) { if (xb_ld(&(bar)[XB_TMO])) break; if (_sp > XB_SPIN_CAP) { atomicAdd(&(bar)[XB_TMO], 1u); break; } } } } while (0)

struct XcdBarrier {
    unsigned* bar; unsigned x;
    volatile LAS unsigned* st;
};

__device__ __forceinline__ XcdBarrier xcd_barrier_post(unsigned* bar, volatile LAS unsigned* st) {
    XcdBarrier b; b.bar = bar; b.x = xb_xcc_id(); b.st = st;
    if (threadIdx.x == 0) (void)xb_add(&bar[XB_XCNT(b.x)], 1u);
    return b;
}
__device__ __forceinline__ void xcd_barrier_complete(unsigned* bar, unsigned x, unsigned& nloc, unsigned& nx) {
    const unsigned G = gridDim.x * gridDim.y * gridDim.z;
    unsigned sum, cnt, mine, sp = 0u;
    for (;;) {
        sum = 0u; cnt = 0u; mine = 0u;
#pragma unroll
        for (unsigned j = 0; j < 16; ++j) { const unsigned c = xb_ld(&bar[XB_XCNT(j)]); sum += c; cnt += (c > 0u) ? 1u : 0u; mine = (j == x) ? c : mine; }
        if (sum == G) break;
        __builtin_amdgcn_s_sleep(1);
        if ((++sp & 255u) == 0u) { if (xb_ld(&bar[XB_TMO])) break; if (sp > XB_SPIN_CAP) { atomicAdd(&bar[XB_TMO], 1u); break; } }
    }
    nloc = mine > 0u ? mine : 1u; nx = cnt > 0u ? cnt : 1u;
}

__device__ __forceinline__ void xcd_barrier(const XcdBarrier& b) {
    asm volatile("s_waitcnt vmcnt(0)" ::: "memory");
    __syncthreads();
    if (threadIdx.x == 0) {
        unsigned* bar = b.bar;
        __builtin_amdgcn_s_waitcnt(0);
        unsigned nloc = b.st[0], nx = b.st[1];
        if (nloc == 0u) { xcd_barrier_complete(bar, b.x, nloc, nx); b.st[0] = nloc; b.st[1] = nx; }
        const unsigned old = xb_add(&bar[XB_XSUB(b.x)], 1u);
        const unsigned gen = old / nloc;
        if (old + 1u == (gen + 1u) * nloc) {
            __builtin_amdgcn_fence(__ATOMIC_RELEASE, "agent");
            asm volatile("s_waitcnt vmcnt(0)" ::: "memory");
            const unsigned og = xb_add(&bar[XB_TOP], 1u);
            const unsigned tg = og / nx;
            if (og + 1u == (tg + 1u) * nx) xb_add(&bar[XB_TOPGEN], 1u);
            else XB_SPIN(xb_ld(&bar[XB_TOPGEN]) == tg, bar);
            __builtin_amdgcn_fence(__ATOMIC_ACQUIRE, "agent");
            xb_add(&bar[XB_XGEN(b.x)], 1u);
            asm volatile("s_waitcnt vmcnt(0)" ::: "memory");
        } else {
            XB_SPIN(xb_ld(&bar[XB_XGEN(b.x)]) == gen, bar);
            __builtin_amdgcn_fence(__ATOMIC_ACQUIRE, "agent");
            asm volatile("s_waitcnt vmcnt(0)" ::: "memory");
        }
    }
    __syncthreads();
}

__global__ void __launch_bounds__(512, 2) mega(Args a) {
    extern __shared__ __attribute__((aligned(16))) unsigned char lds[];
    cg::grid_group grid = cg::this_grid();
    const int G = gridDim.x;
    PG8_LAS unsigned char* glds = (PG8_LAS unsigned char*)lds;
#define bid lbid()
#define tid ltid()
#define lane (ltid() & 63)
#define wave (__builtin_amdgcn_readfirstlane(ltid() >> 6))
#define gw (lbid() * 8 + __builtin_amdgcn_readfirstlane(ltid() >> 6))
#define NGW (G * 8)
    { volatile LAS unsigned* st0 = (volatile LAS unsigned*)((LAS unsigned char*)lds + 131072); if (threadIdx.x < 4) st0[threadIdx.x] = 0u; }
    __syncthreads();
    const XcdBarrier xbar = xcd_barrier_post((unsigned*)(karg_ws() + 229376), (volatile LAS unsigned*)((LAS unsigned char*)lds + 131072));
#define GSYNC() do { xcd_barrier(xbar); } while (0)

    phase_modgemv(a, (float*)lds, G, bid, tid);
    convert_weights(a, 0, (float*)(lds + 32768) + wave * (64 * 33), gw, NGW, lane, G, bid, tid);
    grid.sync();
#pragma clang loop unroll(full)
    for (int l = 0; l < 2; ++l) {
        if (l > 0) convert_weights(a, l, (float*)lds + wave * (64 * 33), gw, NGW, lane, G, bid, tid);
        phase_modulate(a, l, 0, gw, NGW, lane);
        GSYNC();
        for (int rp = 0; rp < REP_G1; ++rp)
        {
            unsigned char* ws = karg_ws(); float* outp = karg_out(); float* xctx = (float*)(ws + OFF_XCTX); bf16* XM = (bf16*)(ws + OFF_XMY); bf16* HU = (bf16*)(ws + OFF_HU); const float* modl = (const float*)(ws + OFF_MOD) + (size_t)l * 3 * 9216; (void)xctx; (void)XM; (void)HU; (void)modl; (void)outp;
            pg8::Gemm g{XM, (const bf16*)(ws + W_13A), NR, 2 * DFF, DM}; pg8::StaticOrder S; S.init(NR, 2 * DFF, G, bid);
            EpiSwiglu E{HU};
            pg8::gemm_phase<EpiSwiglu, pg8::StaticOrder, true, true>(glds, g, S, E);
        }
        GSYNC();
        {
            unsigned char* ws = karg_ws(); float* outp = karg_out(); float* xctx = (float*)(ws + OFF_XCTX); bf16* XM = (bf16*)(ws + OFF_XMY); bf16* HU = (bf16*)(ws + OFF_HU); const float* modl = (const float*)(ws + OFF_MOD) + (size_t)l * 3 * 9216; (void)xctx; (void)XM; (void)HU; (void)modl; (void)outp;
            pg8::Gemm g{HU, (const bf16*)(ws + W_2A), NR, DM, DFF}; pg8::StaticOrder S; S.init(NR, DM, G, bid);
            EpiResid E{outp, xctx, modl + 2 * 1024, 0.5f, l == 0 ? IN(0) : outp, l == 0 ? IN(2) : xctx};
            pg8::gemm_phase<EpiResid, pg8::StaticOrder, true, true>(glds, g, S, E);
        }
        GSYNC();
        phase_modulate(a, l, 1, gw, NGW, lane);
        GSYNC();
        {
            unsigned char* ws = karg_ws(); float* outp = karg_out(); float* xctx = (float*)(ws + OFF_XCTX); bf16* XM = (bf16*)(ws + OFF_XMY); bf16* HU = (bf16*)(ws + OFF_HU); const float* modl = (const float*)(ws + OFF_MOD) + (size_t)l * 3 * 9216; (void)xctx; (void)XM; (void)HU; (void)modl; (void)outp;
            pg8::Gemm g{XM, (const bf16*)(ws + W_IN), NR, UC, DM}; pg8::StaticOrder S; S.init(NR, UC, G, bid);
            EpiU E{HU, UC};
            pg8::gemm_phase<EpiU, pg8::StaticOrder, true, true>(glds, g, S, E);
        }
        GSYNC();
        for (int rp = 0; rp < REP_M1; ++rp) { phase_m1(a, l, lds, G, bid, tid);
        GSYNC(); }
        for (int rp = 0; rp < REP_M2; ++rp) { phase_m2(a, l, lds, G, bid, tid);
        GSYNC(); }
        for (int rp = 0; rp < REP_M3; ++rp) { phase_m3(a, l, lds, G, bid, tid);
        GSYNC(); }
        for (int rp = 0; rp < REP_SCAN; ++rp) { phase_m4(a, lds, G, bid, tid);
        GSYNC();
        phase_m5(a, lds, G, bid, tid);
        GSYNC();
        phase_m6(a, lds, G, bid, tid);
        GSYNC(); }
        phase_m7(a, l, gw, NGW, lane);
        GSYNC();
        {
            unsigned char* ws = karg_ws(); float* outp = karg_out(); float* xctx = (float*)(ws + OFF_XCTX); bf16* XM = (bf16*)(ws + OFF_XMY); bf16* HU = (bf16*)(ws + OFF_HU); const float* modl = (const float*)(ws + OFF_MOD) + (size_t)l * 3 * 9216; (void)xctx; (void)XM; (void)HU; (void)modl; (void)outp;
            const int MR = (l == 1) ? NLAT : NR;
            pg8::Gemm g{XM, (const bf16*)(ws + W_OUT), MR, DM, DM}; pg8::StaticOrder S; S.init(MR, DM, G, bid);
            EpiResid E{outp, xctx, modl + 5 * 1024, 1.0f, outp, xctx};
            pg8::gemm_phase<EpiResid, pg8::StaticOrder, true, true>(glds, g, S, E);
        }
        GSYNC();
        phase_modulate(a, l, 2, gw, NGW, lane);
        GSYNC();
        {
            unsigned char* ws = karg_ws(); float* outp = karg_out(); float* xctx = (float*)(ws + OFF_XCTX); bf16* XM = (bf16*)(ws + OFF_XMY); bf16* HU = (bf16*)(ws + OFF_HU); const float* modl = (const float*)(ws + OFF_MOD) + (size_t)l * 3 * 9216; (void)xctx; (void)XM; (void)HU; (void)modl; (void)outp;
            const int MR = (l == 1) ? NLAT : NR;
            pg8::Gemm g{XM, (const bf16*)(ws + W_13B), MR, 2 * DFF, DM}; pg8::StaticOrder S; S.init(MR, 2 * DFF, G, bid);
            EpiSwiglu E{HU};
            pg8::gemm_phase<EpiSwiglu, pg8::StaticOrder, true, true>(glds, g, S, E);
        }
        GSYNC();
        {
            unsigned char* ws = karg_ws(); float* outp = karg_out(); float* xctx = (float*)(ws + OFF_XCTX); bf16* XM = (bf16*)(ws + OFF_XMY); bf16* HU = (bf16*)(ws + OFF_HU); const float* modl = (const float*)(ws + OFF_MOD) + (size_t)l * 3 * 9216; (void)xctx; (void)XM; (void)HU; (void)modl; (void)outp;
            const int MR = (l == 1) ? NLAT : NR;
            pg8::Gemm g{HU, (const bf16*)(ws + W_2B), MR, DM, DFF}; pg8::StaticOrder S; S.init(MR, DM, G, bid);
            EpiResid E{outp, xctx, modl + 8 * 1024, 0.5f, outp, xctx};
            pg8::gemm_phase<EpiResid, pg8::StaticOrder, true, true>(glds, g, S, E);
        }
        GSYNC();
    }
    phase_final(a, gw, NGW, lane);
#undef bid
#undef tid
#undef lane
#undef wave
#undef gw
#undef NGW
}

extern "C" void kernel_launch(void* const* d_in, const int* in_sizes, int n_in, void* d_out, int out_size, void* d_ws, size_t ws_size, hipStream_t stream) {
    static int grid = 0;
    if (grid == 0) {
        int dev = 0, cus = 0, per_cu = 0;
        (void)hipGetDevice(&dev);
        (void)hipDeviceGetAttribute(&cus, hipDeviceAttributeMultiprocessorCount, dev);
        (void)hipFuncSetAttribute((const void*)mega, hipFuncAttributeMaxDynamicSharedMemorySize, LDS_BYTES);
        (void)hipOccupancyMaxActiveBlocksPerMultiprocessor(&per_cu, (const void*)mega, 512, LDS_BYTES);
        if (per_cu < 1) per_cu = 1;
        grid = cus * per_cu;
        if (n_in != 40 || ws_size < WS_NEED) { fprintf(stderr, "kernel_launch: unexpected n_in %d / ws %zu (need %zu)\n", n_in, ws_size, (size_t)WS_NEED); }
    }
    (void)hipMemsetAsync((char*)d_ws + OFF_MOD, 0, MOD_BYTES, stream);
    Args a{};
    for (int i = 0; i < 40; ++i) a.in[i] = (const float*)d_in[i];
    a.out = (float*)d_out; a.ws = (unsigned char*)d_ws;
    void* args[] = {&a};
    hipError_t e = hipLaunchCooperativeKernel((const void*)mega, dim3(grid), dim3(512), args, LDS_BYTES, stream);
    if (e != hipSuccess) fprintf(stderr, "cooperative launch failed: %s (grid %d)\n", hipGetErrorString(e), grid);
}
```

```cpp
#include <hip/hip_runtime.h>
#include <hip/hip_cooperative_groups.h>
#include <cstdio>
#include <cstdint>
namespace cg = cooperative_groups;
namespace pg8 {
#define PG8_LAS __attribute__((address_space(3)))
typedef unsigned short bf16_t;
typedef short bf16x8 __attribute__((ext_vector_type(8)));
typedef float f32x4 __attribute__((ext_vector_type(4)));
typedef unsigned u32x4 __attribute__((ext_vector_type(4)));
constexpr int BM = 256, BK = 64, HALF = 128, HTB = HALF * BK * 2  , STAGE_BYTES = 8 * HTB, NXCD = 8, WGM = 8;

__host__ __device__ __forceinline__ int lds_byte(int r, int c) { const int st = (r >> 4) * 2 + (c >> 5), rr = r & 15, cc = c & 31, ob = rr * 64 + cc * 2; return st * 1024 + (ob ^ (((ob >> 9) & 1) << 5)); }
__host__ __device__ __forceinline__ void stage_rc(int b, int& R, int& C) { const int st = b / 1024, sb = b % 1024, swz = sb ^ (((sb >> 9) & 1) << 5); R = (st >> 1) * 16 + swz / 64; C = (st & 1) * 32 + (swz % 64) / 2; }
__host__ __device__ __forceinline__ int perm32(int rho) { const int n = rho >> 4, i = rho & 15; return 8 * (i >> 2) + 4 * n + (i & 3); }

struct Unit { int pm, pn; };
struct Gemm { const bf16_t* A; const bf16_t* Bt; int M, N, K; };

struct StaticOrder {
    int nM, nN, nwg, G, c;
    __host__ __device__ void init(int M, int N, int G_, int c_) { nM = M / BM; nN = N / BM; nwg = nM * nN; G = G_; c = c_; }
    __host__ __device__ bool next(int i, Unit& u) const {
        const long L = (long)i * G + c; if (L >= nwg) return false;
        int wgid = (int)L; { const int q = nwg / NXCD, r = nwg % NXCD, xcd = wgid % NXCD, off = wgid / NXCD; wgid = (xcd < r ? xcd * (q + 1) : r * (q + 1) + (xcd - r) * q) + off; }
        const int nig = WGM * nN, gid = wgid / nig, fm = gid * WGM, gsz = (nM - fm) < WGM ? (nM - fm) : WGM;
        u.pm = fm + ((wgid % nig) % gsz); u.pn = (wgid % nig) / gsz; return true;
    }
    __device__ __forceinline__ void a_ready(const Unit&) const {}
    __device__ __forceinline__ void done(const Unit&) const {}
};

__device__ __forceinline__ unsigned cvt_pk_bf16(float lo, float hi) { unsigned r; asm volatile("v_cvt_pk_bf16_f32 %0, %1, %2" : "=v"(r) : "v"(lo), "v"(hi)); return r; }
typedef float f32x2 __attribute__((ext_vector_type(2)));
template <class Epi, class Sched, bool ALIGN_EPI = false, bool SP2 = false>
__device__ __forceinline__ void gemm_phase(PG8_LAS unsigned char* lds, const Gemm g, const Sched& S, const Epi& E) {
    int tid = threadIdx.x; asm volatile("" : "+v"(tid));
    const int wid = __builtin_amdgcn_readfirstlane(tid >> 6), lane = tid & 63, wr = wid >> 2, wc = wid & 3, fr = lane & 15, fq = lane >> 4;
    const int K = g.K, nt = K / BK;
    unsigned voffA[2], voffB[2];
#pragma unroll
    for (int i = 0; i < 2; ++i) { int R, C; stage_rc(tid * 16 + i * 8192, R, C); const int Rb = Epi::PERM ? ((R & ~31) + perm32(R & 31)) : R;
        voffA[i] = (unsigned)(R * K + C) * 2u; voffB[i] = (unsigned)(Rb * K + C) * 2u; }
    const size_t kstep = (size_t)(BK * 2);
    const size_t hstep = (size_t)HALF * K * 2;
    const size_t tstep = 2 * hstep;
    const unsigned ldsw = (unsigned)wid * 1024u;
    const int aoff = lds_byte(wr * 64 + fr, fq * 8), boff = lds_byte(wc * 32 + fr, fq * 8);
#define PG8_SA(b, h) (((b) * 2 + (h)) * HTB)
#define PG8_SB(b, h) ((4 + (b) * 2 + (h)) * HTB)
#define PG8_STAGE(bufoff, gbase, voff) do { _Pragma("unroll") for (int _i = 0; _i < 2; ++_i) \
        __builtin_amdgcn_global_load_lds((const unsigned*)((const char*)(gbase) + (voff)[_i]), (PG8_LAS unsigned*)(lds + (bufoff) + ldsw + _i * 8192), 16, 0, 0); } while (0)
#define PG8_LDA(dst, b, h) do { _Pragma("unroll") for (int m = 0; m < 4; ++m) _Pragma("unroll") for (int k = 0; k < 2; ++k) dst[m][k] = *(const PG8_LAS bf16x8*)(lds + PG8_SA(b, h) + aoff + m * 2048 + k * 1024); } while (0)
#define PG8_LDB(dst, b, h) do { _Pragma("unroll") for (int n = 0; n < 2; ++n) _Pragma("unroll") for (int k = 0; k < 2; ++k) dst[n][k] = *(const PG8_LAS bf16x8*)(lds + PG8_SB(b, h) + boff + n * 2048 + k * 1024); } while (0)
#define PG8_MMA(ai, bj, At, Bt) do { __builtin_amdgcn_s_setprio(1); _Pragma("unroll") for (int m = 0; m < 4; ++m) _Pragma("unroll") for (int n = 0; n < 2; ++n) _Pragma("unroll") for (int k = 0; k < 2; ++k) \
        acc[ai][bj][m][n] = __builtin_amdgcn_mfma_f32_16x16x32_bf16(Bt[n][k], At[m][k], acc[ai][bj][m][n], 0, 0, 0); __builtin_amdgcn_s_setprio(0); } while (0)
#define PG8_WAIT_V(n) asm volatile("s_waitcnt vmcnt(" #n ")" ::: "memory")
#define PG8_WAIT_L(n) asm volatile("s_waitcnt lgkmcnt(" #n ")" ::: "memory")
#define PG8_BAR __builtin_amdgcn_s_barrier()
#define PG8_SCHED __builtin_amdgcn_sched_barrier(0)
    Unit cur, nxt; int ui = 0;
    if (!S.next(0, cur)) return;
    f32x4 acc[2][2][4][2];
#pragma unroll
    for (int a = 0; a < 2; ++a)
#pragma unroll
        for (int b = 0; b < 2; ++b)
#pragma unroll
            for (int m = 0; m < 4; ++m)
#pragma unroll
                for (int n = 0; n < 2; ++n) acc[a][b][m][n] = (f32x4){0.f, 0.f, 0.f, 0.f};
    bf16x8 At[4][2], B0[2][2], B1[2][2];
    const char* cA = (const char*)g.A + (size_t)cur.pm * tstep; const char* cB = (const char*)g.Bt + (size_t)cur.pn * tstep;
    S.a_ready(cur);
    if constexpr (SP2) {
        PG8_STAGE(PG8_SB(0, 0), cB, voffB); PG8_STAGE(PG8_SB(0, 1), cB + hstep, voffB); PG8_STAGE(PG8_SA(0, 0), cA, voffA); PG8_STAGE(PG8_SA(0, 1), cA + hstep, voffA);
        if (wr == 1) PG8_BAR;
        PG8_WAIT_V(2); PG8_BAR;
        PG8_STAGE(PG8_SB(1, 0), cB + kstep, voffB); PG8_STAGE(PG8_SA(1, 0), cA + kstep, voffA); PG8_STAGE(PG8_SB(1, 1), cB + hstep + kstep, voffB);
        PG8_WAIT_V(6); PG8_BAR;
    } else {
        PG8_STAGE(PG8_SB(0, 0), cB, voffB); PG8_STAGE(PG8_SA(0, 0), cA, voffA); PG8_STAGE(PG8_SB(0, 1), cB + hstep, voffB); PG8_STAGE(PG8_SA(0, 1), cA + hstep, voffA);
        if (wr == 1) PG8_BAR;
        PG8_WAIT_V(4); PG8_BAR;
        PG8_STAGE(PG8_SB(1, 0), cB + kstep, voffB); PG8_STAGE(PG8_SA(1, 0), cA + kstep, voffA); PG8_STAGE(PG8_SB(1, 1), cB + hstep + kstep, voffB);
        PG8_WAIT_V(6); PG8_BAR;
    }
    for (;;) {
        const bool has_next = S.next(ui + 1, nxt);
        const char* nA = has_next ? (const char*)g.A + (size_t)nxt.pm * tstep : cA; const char* nB = has_next ? (const char*)g.Bt + (size_t)nxt.pn * tstep : cB;
        for (int t = 0; t < nt; t += 2) {
            const bool last = (t == nt - 2);
            const char* a1 = cA + (size_t)(t + 1) * kstep;
            const char* a2 = last ? nA : cA + (size_t)(t + 2) * kstep; const char* b2 = last ? nB : cB + (size_t)(t + 2) * kstep;
            const char* a3 = a2 + kstep; const char* b3 = b2 + kstep;
            if (last && has_next) S.a_ready(nxt);
            if constexpr (SP2) {
            PG8_LDB(B0, 0, 0); PG8_LDB(B1, 0, 1); PG8_SCHED; PG8_LDA(At, 0, 0); PG8_STAGE(PG8_SA(1, 1), a1 + hstep, voffA);
            PG8_WAIT_V(8); PG8_WAIT_L(0); PG8_BAR; PG8_MMA(0, 0, At, B0); PG8_MMA(0, 1, At, B1); PG8_BAR; PG8_SCHED;
            PG8_LDA(At, 0, 1); PG8_STAGE(PG8_SB(0, 0), b2, voffB); PG8_STAGE(PG8_SB(0, 1), b2 + hstep, voffB); PG8_STAGE(PG8_SA(0, 0), a2, voffA);
            PG8_WAIT_V(8); PG8_WAIT_L(0); PG8_BAR; PG8_MMA(1, 0, At, B0); PG8_MMA(1, 1, At, B1); PG8_BAR; PG8_SCHED;
            PG8_LDB(B0, 1, 0); PG8_LDB(B1, 1, 1); PG8_SCHED; PG8_LDA(At, 1, 0); PG8_STAGE(PG8_SA(0, 1), a2 + hstep, voffA);
            PG8_WAIT_V(8); PG8_WAIT_L(0); PG8_BAR; PG8_MMA(0, 0, At, B0); PG8_MMA(0, 1, At, B1); PG8_BAR; PG8_SCHED;
            PG8_LDA(At, 1, 1); PG8_STAGE(PG8_SB(1, 0), b3, voffB); PG8_STAGE(PG8_SB(1, 1), b3 + hstep, voffB); PG8_STAGE(PG8_SA(1, 0), a3, voffA);
            PG8_WAIT_V(8); PG8_WAIT_L(0); PG8_BAR; PG8_MMA(1, 0, At, B0); PG8_MMA(1, 1, At, B1); PG8_BAR; PG8_SCHED;
            } else {
            PG8_LDB(B0, 0, 0); PG8_SCHED; PG8_LDA(At, 0, 0); PG8_STAGE(PG8_SA(1, 1), a1 + hstep, voffA);
            PG8_WAIT_L(8); PG8_BAR; PG8_WAIT_L(0); PG8_MMA(0, 0, At, B0); PG8_BAR; PG8_SCHED;
            PG8_LDB(B1, 0, 1); PG8_STAGE(PG8_SB(0, 0), b2, voffB);
            PG8_BAR; PG8_WAIT_L(0); PG8_MMA(0, 1, At, B1); PG8_BAR;
            PG8_LDA(At, 0, 1); PG8_STAGE(PG8_SA(0, 0), a2, voffA);
            PG8_BAR; PG8_WAIT_L(0); PG8_MMA(1, 0, At, B0); PG8_BAR; PG8_SCHED;
            PG8_STAGE(PG8_SB(0, 1), b2 + hstep, voffB);
            PG8_WAIT_V(6); PG8_BAR; PG8_MMA(1, 1, At, B1); PG8_BAR;
            PG8_LDB(B0, 1, 0); PG8_SCHED; PG8_LDA(At, 1, 0); PG8_STAGE(PG8_SA(0, 1), a2 + hstep, voffA);
            PG8_WAIT_L(8); PG8_BAR; PG8_WAIT_L(0); PG8_MMA(0, 0, At, B0); PG8_BAR; PG8_SCHED;
            PG8_LDB(B1, 1, 1); PG8_STAGE(PG8_SB(1, 0), b3, voffB);
            PG8_BAR; PG8_WAIT_L(0); PG8_MMA(0, 1, At, B1); PG8_BAR;
            PG8_LDA(At, 1, 1); PG8_STAGE(PG8_SA(1, 0), a3, voffA);
            PG8_BAR; PG8_WAIT_L(0); PG8_MMA(1, 0, At, B0); PG8_BAR; PG8_SCHED;
            PG8_STAGE(PG8_SB(1, 1), b3 + hstep, voffB);
            PG8_WAIT_V(6); PG8_BAR; PG8_MMA(1, 1, At, B1); PG8_BAR;
            }
        }
        if constexpr (ALIGN_EPI) { if (wr == 0) PG8_BAR; }
        if constexpr (!Epi::AFTER_DRAIN) { E(acc, cur, wr, wc, fr, fq); S.done(cur); }
        if (!has_next) break;
#pragma unroll
        for (int a = 0; a < 2; ++a)
#pragma unroll
            for (int b = 0; b < 2; ++b)
#pragma unroll
                for (int m = 0; m < 4; ++m)
#pragma unroll
                    for (int n = 0; n < 2; ++n) acc[a][b][m][n] = (f32x4){0.f, 0.f, 0.f, 0.f};
        cur = nxt; cA = nA; cB = nB; ++ui;
        if constexpr (ALIGN_EPI) { if (wr == 1) PG8_BAR; }
    }
    PG8_WAIT_V(0);
    if constexpr (!ALIGN_EPI) { if (wr == 0) PG8_BAR; }
    PG8_BAR;
    if constexpr (Epi::AFTER_DRAIN) { E.fused(acc, cur, wr, wc, fr, fq, lds, wid, lane); S.done(cur); }
#undef PG8_SA
#undef PG8_SB
#undef PG8_STAGE
#undef PG8_LDA
#undef PG8_LDB
#undef PG8_MMA
#undef PG8_WAIT_V
#undef PG8_WAIT_L
#undef PG8_BAR
#undef PG8_SCHED
}
}

using pg8::f32x4; using pg8::bf16x8;
typedef unsigned short bf16;
typedef unsigned v4u __attribute__((ext_vector_type(4)));
typedef unsigned v2u __attribute__((ext_vector_type(2)));
typedef short s16x4 __attribute__((ext_vector_type(4)));

constexpr int DM = 1024, TLEN = 8192, CTXL = 256, TT = 8448, NLAT = 16384, NR = 16896, DFF = 2816, UC = 2560, NTILE = 528;
constexpr int NSEG = 64, SEGLEN = 132;
constexpr size_t MiB = 1u << 20;
constexpr size_t A8 = (size_t)NR * 256 * 2;
constexpr size_t OFF_MOD = 0, MOD_BYTES = 256 * 1024;
constexpr size_t OFF_XCTX = MiB / 4, OFF_XMY = 2 * MiB + MiB / 4, OFF_HU = 35 * MiB + MiB / 4, OFF_W = 126 * MiB, OFF_MIX = 167 * MiB, OFF_PR = 266 * MiB;
constexpr size_t W_13A = OFF_W, W_2A = OFF_W + 11 * MiB, W_13B = OFF_W + 16 * MiB + MiB / 2, W_2B = OFF_W + 27 * MiB + MiB / 2,
                 W_IN = OFF_W + 33 * MiB, W_OUT = OFF_W + 38 * MiB, W_UQ = OFF_W + 40 * MiB, W_UKV = OFF_W + 40 * MiB + 256 * 1024,
                 W_WUP = OFF_W + 40 * MiB + 384 * 1024, W_AUP = W_WUP + 65536, W_GUP = W_AUP + 65536, W_LWA = W_GUP + 65536, W_LWX = W_LWA + 65536;
constexpr size_t M_QB = OFF_MIX, M_KB = OFF_MIX + 12976128, M_VT = OFF_MIX + 25952256;
constexpr size_t M_LR0 = OFF_PR, M_LIX0 = OFF_PR + 2 * A8;
constexpr size_t M_SEGA = OFF_HU + 83 * MiB, M_SEGB = M_SEGA + MiB + MiB / 4, M_H0 = M_SEGB + MiB + MiB / 4;
constexpr size_t M_RR = OFF_MIX, M_KK = OFF_MIX + A8, M_VV = OFF_MIX + 2 * A8, M_WW = OFF_MIX + 3 * A8, M_BB = OFF_MIX + 7 * A8, M_KD = OFF_MIX + 9 * A8, M_GC = OFF_MIX + 11 * A8;
constexpr size_t M_YS = OFF_HU, M_PL = OFF_HU + 33 * MiB, M_SINIT = OFF_HU + 65 * MiB;
constexpr size_t M_PR = OFF_PR;
constexpr size_t WS_NEED = OFF_PR + 33 * MiB;
constexpr int LDS_BYTES = 131072 + 1024;
#ifndef REP_M1
#define REP_M1 1
#endif
#ifndef REP_M2
#define REP_M2 1
#endif
#ifndef REP_M3
#define REP_M3 1
#endif
#ifndef REP_SCAN
#define REP_SCAN 1
#endif
#ifndef REP_G1
#define REP_G1 1
#endif
constexpr float QSCALE = 0.10206207261596575f * 1.4426950408889634f;

struct Args { const float* in[40]; float* out; unsigned char* ws; };
typedef const __attribute__((address_space(4))) volatile unsigned long long kargq;
__device__ __forceinline__ const float* karg_in(int i) { kargq* p = (kargq*)__builtin_amdgcn_kernarg_segment_ptr(); return (const float*)p[i]; }
__device__ __forceinline__ float* karg_out() { kargq* p = (kargq*)__builtin_amdgcn_kernarg_segment_ptr(); return (float*)p[40]; }
__device__ __forceinline__ unsigned char* karg_ws() { kargq* p = (kargq*)__builtin_amdgcn_kernarg_segment_ptr(); return (unsigned char*)p[41]; }
#define IN(i) karg_in(i)
__device__ __forceinline__ int ltid() { int t = threadIdx.x; asm volatile("" : "+v"(t)); return t; }
__device__ __forceinline__ int lbid() { int t = blockIdx.x; asm volatile("" : "+s"(t)); return t; }
template <class T> __device__ __forceinline__ T* launder(T* p) { asm volatile("" : "+s"(p)); return p; }

__device__ __forceinline__ float bf2f(bf16 h) { return __uint_as_float((unsigned)h << 16); }
__device__ __forceinline__ unsigned f2bf(float f) { unsigned u = __float_as_uint(f); return (u + 0x7fffu + ((u >> 16) & 1u)) >> 16; }
__device__ __forceinline__ unsigned pk2(float lo, float hi) { return f2bf(lo) | (f2bf(hi) << 16); }
__device__ __forceinline__ float sigm(float x) { return 1.f / (1.f + __expf(-x)); }
__device__ __forceinline__ float siluf_(float x) { return x / (1.f + __expf(-x)); }
__device__ __forceinline__ float tanhf_(float y) { return 1.f - 2.f / (1.f + __expf(2.f * y)); }
__device__ __forceinline__ float geluf_(float x) { return 0.5f * x * (1.f + tanhf_(0.7978845608028654f * (x + 0.044715f * x * x * x))); }
__device__ __forceinline__ float wave_sum(float v) {
#pragma unroll
    for (int o = 1; o < 64; o <<= 1) v += __shfl_xor(v, o);
    return v;
}
struct TileInfo { int b, isctx, t0, seqbase, seqlen; };
__device__ __forceinline__ TileInfo tile_info(int tile) {
    TileInfo ti;
    if (tile < 512) { ti.b = tile >> 8; ti.isctx = 0; ti.t0 = (tile & 255) * 32; ti.seqbase = ti.b * TLEN; ti.seqlen = TLEN; }
    else { const int q = tile - 512; ti.b = q >> 3; ti.isctx = 1; ti.t0 = (q & 7) * 32; ti.seqbase = NLAT + ti.b * CTXL; ti.seqlen = CTXL; }
    return ti;
}

struct EpiSwiglu {
    static constexpr bool PERM = true, AFTER_DRAIN = false;
    bf16* H;
    __device__ __forceinline__ void operator()(const f32x4 (&acc)[2][2][4][2], const pg8::Unit& u, int wr, int wc, int fr, int fq) const {
        int pm = u.pm, pn = u.pn; asm volatile("" : "+s"(pm), "+s"(pn), "+s"(wr), "+s"(wc), "+v"(fr), "+v"(fq));
        bf16* tb = H + (size_t)pm * 256 * DFF + pn * 128;
        const unsigned loff = (unsigned)((wr * 64 + fr) * DFF + wc * 32 + 8 * fq);
#pragma unroll
        for (int ai = 0; ai < 2; ++ai)
#pragma unroll
            for (int m = 0; m < 4; ++m) {
                bf16* rowp = tb + (loff + (unsigned)((ai * 128 + m * 16) * DFF));
                const f32x4 g0 = acc[ai][0][m][0], g1 = acc[ai][0][m][1], u0 = acc[ai][1][m][0], u1 = acc[ai][1][m][1];
                v4u w;
                w.x = pg8::cvt_pk_bf16(siluf_(g0[0]) * u0[0], siluf_(g0[1]) * u0[1]); w.y = pg8::cvt_pk_bf16(siluf_(g0[2]) * u0[2], siluf_(g0[3]) * u0[3]);
                w.z = pg8::cvt_pk_bf16(siluf_(g1[0]) * u1[0], siluf_(g1[1]) * u1[1]); w.w = pg8::cvt_pk_bf16(siluf_(g1[2]) * u1[2], siluf_(g1[3]) * u1[3]);
                *(v4u*)rowp = w;
            }
    }
};
struct EpiU {
    static constexpr bool PERM = true, AFTER_DRAIN = false;
    bf16* O; int ldc;
    __device__ __forceinline__ void operator()(const f32x4 (&acc)[2][2][4][2], const pg8::Unit& u, int wr, int wc, int fr, int fq) const {
        int pm = u.pm, pn = u.pn; asm volatile("" : "+s"(pm), "+s"(pn), "+s"(wr), "+s"(wc), "+v"(fr), "+v"(fq));
        bf16* tb = O + (size_t)pm * 256 * ldc + pn * 256;
        const unsigned loff = (unsigned)((wr * 64 + fr) * ldc + wc * 32 + 8 * fq);
#pragma unroll
        for (int ai = 0; ai < 2; ++ai)
#pragma unroll
            for (int m = 0; m < 4; ++m) {
                bf16* rowp = tb + (loff + (unsigned)((ai * 128 + m * 16) * ldc));
#pragma unroll
                for (int bj = 0; bj < 2; ++bj) { const f32x4 v0 = acc[ai][bj][m][0], v1 = acc[ai][bj][m][1]; v4u w;
                    w.x = pg8::cvt_pk_bf16(v0[0], v0[1]); w.y = pg8::cvt_pk_bf16(v0[2], v0[3]); w.z = pg8::cvt_pk_bf16(v1[0], v1[1]); w.w = pg8::cvt_pk_bf16(v1[2], v1[3]);
                    *(v4u*)(rowp + bj * 128) = w; }
            }
    }
};
struct EpiResid {
    static constexpr bool PERM = false, AFTER_DRAIN = false;
    float* xlat; float* xctx; const float* gate; float coef; const float* slat; const float* sctx;
    __device__ __forceinline__ void operator()(const f32x4 (&acc)[2][2][4][2], const pg8::Unit& u, int wr, int wc, int fr, int fq) const {
        int pm = u.pm, pn = u.pn; asm volatile("" : "+s"(pm), "+s"(pn), "+s"(wr), "+s"(wc), "+v"(fr), "+v"(fq));
        const size_t toff = (pm < 64 ? (size_t)pm : (size_t)(pm - 64)) * 256 * DM + pn * 256;
        float* tb = (pm < 64 ? xlat : xctx) + toff; const float* sb = (pm < 64 ? slat : sctx) + toff;
        const float* g = gate + (pm < 64 ? (pm >> 5) : 2) * 9216 + pn * 256;
        const unsigned coff = (unsigned)(wc * 32 + 4 * fq), loff = (unsigned)((wr * 64 + fr) * DM) + coff;
        f32x4 gv[2][2];
#pragma unroll
        for (int bj = 0; bj < 2; ++bj)
#pragma unroll
            for (int n = 0; n < 2; ++n) gv[bj][n] = coef * *(const f32x4*)(g + (coff + (unsigned)(bj * 128 + n * 16)));
#pragma unroll
        for (int ai = 0; ai < 2; ++ai)
#pragma unroll
            for (int m = 0; m < 4; ++m) {
                float* xr = tb + (loff + (unsigned)((ai * 128 + m * 16) * DM)); const float* sr = sb + (loff + (unsigned)((ai * 128 + m * 16) * DM));
#pragma unroll
                for (int bj = 0; bj < 2; ++bj)
#pragma unroll
                    for (int n = 0; n < 2; ++n) { float* xp = xr + (bj * 128 + n * 16);
                        f32x4 xv = *(const f32x4*)(sr + (bj * 128 + n * 16)); xv += gv[bj][n] * acc[ai][bj][m][n]; *(f32x4*)xp = xv; }
                asm volatile("" ::: "memory");
            }
    }
};

__device__ __forceinline__ void phase_modgemv(const Args& a, float* red, int G, int bid, int tid) {
    const float* c = IN(1); const float* cctx = IN(3); const float* ada_w = IN(4); const float* ada_b = IN(5);
    float* mod = (float*)(karg_ws() + OFF_MOD);
    const int w = tid >> 6, lane = tid & 63;
    for (int u = bid; u < 576; u += G) {
        const int l = u / 288, rem = u % 288, jt = rem >> 3, ks = rem & 7;
        const int kb = ks * 128 + w * 16, j0 = jt * 256 + lane * 4;
        f32x4 acc0 = {0.f, 0.f, 0.f, 0.f}, acc1 = acc0, acc2 = acc0;
        for (int kk = 0; kk < 16; ++kk) { const int k = kb + kk;
            const float s0 = siluf_(c[k]), s1 = siluf_(c[1024 + k]), s2 = siluf_(cctx[k]);
            const f32x4 wv = *(const f32x4*)(ada_w + ((size_t)(l * 1024 + k)) * 9216 + j0);
            acc0 += s0 * wv; acc1 += s1 * wv; acc2 += s2 * wv; }
        float* rp = red + (w * 3) * 256 + lane * 4;
        *(f32x4*)rp = acc0; *(f32x4*)(rp + 256) = acc1; *(f32x4*)(rp + 512) = acc2;
        __syncthreads();
        for (int o = tid; o < 768; o += 512) { const int m = o >> 8, jj = o & 255; float s = 0.f;
#pragma unroll
            for (int ww = 0; ww < 8; ++ww) s += red[(ww * 3 + m) * 256 + jj];
            const int j = jt * 256 + jj; if (ks == 0) s += ada_b[l * 9216 + j];
            atomicAdd(&mod[(l * 3 + m) * 9216 + j], s); }
        __syncthreads();
    }
}
__device__ __forceinline__ void phase_copy(const Args& a, int G, int bid, int tid) {
    const f32x4* x4 = (const f32x4*)IN(0); f32x4* o4 = (f32x4*)karg_out();
    for (int i = bid * 512 + tid; i < NLAT * DM / 4; i += G * 512) o4[i] = x4[i];
    const f32x4* c4 = (const f32x4*)IN(2); f32x4* xc4 = (f32x4*)(karg_ws() + OFF_XCTX);
    for (int i = bid * 512 + tid; i < 512 * DM / 4; i += G * 512) xc4[i] = c4[i];
}
__device__ __forceinline__ int swiglu_map(int n) { return n < DFF ? ((n >> 7) * 256 + (n & 127)) : ((((n - DFF) >> 7) * 256) + 128 + ((n - DFF) & 127)); }
__device__ __forceinline__ void transpose_item(const float* W, int K, int N, bf16* WT, float* scr, int item, int lane, int mode, const float* kscale) {
    const int nblk = N / 32, kb = item / nblk, nb = item % nblk, k0 = 64 * kb, n0 = 32 * nb;
    float tv[32];
#pragma unroll
    for (int i = 0; i < 32; ++i) { const int kk = 2 * i + (lane >> 5); tv[i] = W[(size_t)(k0 + kk) * N + n0 + (lane & 31)]; }
#pragma unroll
    for (int i = 0; i < 32; ++i) { const int kk = 2 * i + (lane >> 5); float v = tv[i]; if (kscale) v *= kscale[k0 + kk]; scr[kk * 33 + (lane & 31)] = v; }
    __builtin_amdgcn_wave_barrier();
    const int c = lane & 7;
#pragma unroll
    for (int j = 0; j < 4; ++j) { const int n = (lane >> 3) + 8 * j; const float* s = scr + (8 * c) * 33 + n;
        v4u o; o.x = pk2(s[0 * 33], s[1 * 33]); o.y = pk2(s[2 * 33], s[3 * 33]); o.z = pk2(s[4 * 33], s[5 * 33]); o.w = pk2(s[6 * 33], s[7 * 33]);
        const int nn = n0 + n, drow = mode ? swiglu_map(nn) : nn;
        *(v4u*)(WT + (size_t)drow * K + k0 + 8 * c) = o; }
    __builtin_amdgcn_wave_barrier();
}
__device__ __forceinline__ void convert_weights(const Args& a, int l, float* scr, int gw, int NGW, int lane, int G, int bid, int tid) {
    constexpr int I13 = 16 * 176, I2 = 44 * 32, IIN = 16 * 77, IOUT = 16 * 32, IUQ = 4 * 12, IUKV = 2 * 16;
    constexpr int IEX = 80;
    constexpr int NIT = 2 * I13 + 2 * I2 + IIN + IOUT + IUQ + IUKV + IEX;
    unsigned char* ws = karg_ws();
    for (int it = gw; it < NIT; it += NGW) {
        int r = it;
        if (r < I13) { transpose_item(IN(6) + (size_t)l * DM * 2 * DFF, DM, 2 * DFF, (bf16*)(ws + W_13A), scr, r, lane, 1, nullptr); continue; } r -= I13;
        if (r < I13) { transpose_item(IN(8) + (size_t)l * DM * 2 * DFF, DM, 2 * DFF, (bf16*)(ws + W_13B), scr, r, lane, 1, nullptr); continue; } r -= I13;
        if (r < I2) { transpose_item(IN(7) + (size_t)l * DFF * DM, DFF, DM, (bf16*)(ws + W_2A), scr, r, lane, 0, nullptr); continue; } r -= I2;
        if (r < I2) { transpose_item(IN(9) + (size_t)l * DFF * DM, DFF, DM, (bf16*)(ws + W_2B), scr, r, lane, 0, nullptr); continue; } r -= I2;
        if (r < IIN) { transpose_item(IN(10) + (size_t)l * DM * 2464, DM, 2464, (bf16*)(ws + W_IN), scr, r, lane, 0, nullptr); continue; } r -= IIN;
        if (r < IOUT) { transpose_item(IN(11) + (size_t)l * DM * DM, DM, DM, (bf16*)(ws + W_OUT), scr, r, lane, 0, nullptr); continue; } r -= IOUT;
        if (r < IUQ) { transpose_item(IN(36) + (size_t)l * 256 * 384, 256, 384, (bf16*)(ws + W_UQ), scr, r, lane, 0, IN(35) + l * 256); continue; } r -= IUQ;
        if (r < IUKV) { transpose_item(IN(38) + (size_t)l * 128 * 512, 128, 512, (bf16*)(ws + W_UKV), scr, r, lane, 0, IN(37) + l * 128); continue; } r -= IUKV;
        if (r < 16) { const int d = r >> 3; transpose_item(IN(26) + (size_t)(l * 2 + d) * 64 * 256, 64, 256, (bf16*)(ws + W_WUP) + d * 256 * 64, scr, r & 7, lane, 0, nullptr); continue; } r -= 16;
        if (r < 16) { const int d = r >> 3; transpose_item(IN(28) + (size_t)(l * 2 + d) * 64 * 256, 64, 256, (bf16*)(ws + W_AUP) + d * 256 * 64, scr, r & 7, lane, 0, nullptr); continue; } r -= 16;
        if (r < 16) { transpose_item(IN(29) + (size_t)l * 128 * 256, 128, 256, (bf16*)(ws + W_GUP), scr, r, lane, 0, nullptr); continue; } r -= 16;
        if (r < 16) { const int m = r >> 1; transpose_item(IN(18) + (size_t)(l * 8 + m) * 4096, 64, 64, (bf16*)(ws + W_LWA) + m * 4096, scr, r & 1, lane, 0, nullptr); continue; } r -= 16;
        { const int m = r >> 1; transpose_item(IN(20) + (size_t)(l * 8 + m) * 4096, 64, 64, (bf16*)(ws + W_LWX) + m * 4096, scr, r & 1, lane, 0, nullptr); }
    }
    v4u z = {0u, 0u, 0u, 0u}; v4u* zp = (v4u*)(ws + W_IN + (size_t)2464 * DM * 2);
    for (int i = bid * 512 + tid; i < 96 * DM * 2 / 16; i += G * 512) zp[i] = z;
}
__device__ __forceinline__ void phase_modulate(const Args& a, int l, int which, int gw, int NGW, int lane) {
    unsigned char* ws = karg_ws(); const float* outp = karg_out();
    const bool first = (l == 0 && which == 0);
    const float* srcl = first ? IN(0) : outp; const float* srcc = first ? IN(2) : (const float*)(ws + OFF_XCTX);
    const float* mod = (const float*)(ws + OFF_MOD) + (size_t)l * 3 * 9216;
    bf16* XM = (bf16*)(ws + OFF_XMY);
    for (int r = gw; r < NR; r += NGW) {
        const float* xr = r < NLAT ? srcl + (size_t)r * DM : srcc + (size_t)(r - NLAT) * DM;
        const float* mm = mod + (r < NLAT ? (r >> 13) : 2) * 9216 + which * 3 * 1024;
        f32x4 v[4]; float ss = 0.f;
#pragma unroll
        for (int j = 0; j < 4; ++j) { v[j] = *(const f32x4*)(xr + 4 * lane + 256 * j); ss += (v[j][0] * v[j][0] + v[j][1] * v[j][1]) + (v[j][2] * v[j][2] + v[j][3] * v[j][3]); }
        const float rstd = rsqrtf(wave_sum(ss) * (1.f / DM) + 1e-6f);
#pragma unroll
        for (int j = 0; j < 4; ++j) { const int c = 4 * lane + 256 * j; const f32x4 sh = *(const f32x4*)(mm + c), sc = *(const f32x4*)(mm + 1024 + c);
            const f32x4 o = v[j] * rstd * (1.f + sc) + sh; v2u w; w.x = pk2(o[0], o[1]); w.y = pk2(o[2], o[3]);
            *(v2u*)(XM + (size_t)r * DM + c) = w; }
    }
}
__device__ __forceinline__ void phase_final(const Args& a, int gw, int NGW, int lane) {
    const float* fn = IN(39); float* outp = karg_out();
    for (int r = gw; r < NLAT; r += NGW) {
        float* xr = outp + (size_t)r * DM; f32x4 v[4]; float ss = 0.f;
#pragma unroll
        for (int j = 0; j < 4; ++j) { v[j] = *(const f32x4*)(xr + 4 * lane + 256 * j); ss += (v[j][0] * v[j][0] + v[j][1] * v[j][1]) + (v[j][2] * v[j][2] + v[j][3] * v[j][3]); }
        const float rstd = rsqrtf(wave_sum(ss) * (1.f / DM) + 1e-6f);
#pragma unroll
        for (int j = 0; j < 4; ++j) { const int c = 4 * lane + 256 * j; const f32x4 g = *(const f32x4*)(fn + c); *(f32x4*)(xr + c) = v[j] * rstd * g; }
    }
}

__device__ __forceinline__ void phase_m1(const Args& a, int l, unsigned char* lds, int G, int bid, int tid_unused) {
    unsigned char* ws = karg_ws();
    const bf16* U = (const bf16*)(ws + OFF_HU);
    bf16* Y = (bf16*)(ws + OFF_XMY);
    for (int tile = bid; tile < NTILE; tile += G) {
        const TileInfo ti = tile_info(tile);
        const int row0 = tile * 32;
        {
            const int tid = ltid(); const int lane = tid & 63, wave = __builtin_amdgcn_readfirstlane(tid >> 6), ch = tid & 255, part = tid >> 8; (void)lane; (void)wave; (void)ch; (void)part;
            float* z = (float*)lds;
            float* cv = (float*)(lds + 65536);
            for (int tt = part; tt < 62; tt += 2) { const int t = ti.t0 - 15 + tt; float zz = 0.f;
                if (t >= 0 && t < ti.seqlen) { const bf16* ur = U + (size_t)(ti.seqbase + t) * UC; zz = bf2f(ur[ch]) * sigm(bf2f(ur[256 + ch])); }
                z[tt * 256 + ch] = zz; }
            __syncthreads();
            const float* dw = IN(12) + (size_t)l * 31 * 256 + ch;
            float acc[16]; const float bias = IN(13)[l * 256 + ch];
#pragma unroll
            for (int o = 0; o < 16; ++o) acc[o] = bias;
            for (int j = 0; j < 31; ++j) { const float w = dw[j * 256];
#pragma unroll
                for (int o = 0; o < 16; ++o) acc[o] += w * z[(part * 16 + o + j) * 256 + ch]; }
#pragma unroll
            for (int o = 0; o < 16; ++o) cv[(part * 16 + o) * 256 + ch] = acc[o];
            __syncthreads();
            const f32x4 lg = *(const f32x4*)(IN(14) + l * 256 + lane * 4), lb = *(const f32x4*)(IN(15) + l * 256 + lane * 4);
#pragma unroll
            for (int q = 0; q < 4; ++q) { const int t = wave * 4 + q; const f32x4 v = *(const f32x4*)(cv + t * 256 + lane * 4);
                const float mu = wave_sum((v[0] + v[1]) + (v[2] + v[3])) * (1.f / 256.f);
                const f32x4 dv = v - mu; const float var = wave_sum((dv[0] * dv[0] + dv[1] * dv[1]) + (dv[2] * dv[2] + dv[3] * dv[3])) * (1.f / 256.f);
                const f32x4 yn = dv * rsqrtf(var + 1e-5f) * lg + lb;
                v2u w; w.x = pk2(siluf_(yn[0]), siluf_(yn[1])); w.y = pk2(siluf_(yn[2]), siluf_(yn[3]));
                *(v2u*)(Y + (size_t)(row0 + t) * DM + lane * 4) = w; }
            __syncthreads();
        }
        {
            float* xvf = (float*)lds;
            bf16* xvb = (bf16*)(lds + 32768);
            bf16* rg = (bf16*)(lds + 49664);
            bf16* ixg = (bf16*)(lds + 82432);
            {
                const int tid = ltid(); const int ch = tid & 255, part = tid >> 8;
                const float* cw = IN(16) + (size_t)l * 4 * 256 + ch; const float w0 = cw[0], w1 = cw[256], w2 = cw[512], w3 = cw[768], cb = IN(17)[l * 256 + ch];
                float xin[19];
#pragma unroll
                for (int i = 0; i < 19; ++i) { const int t = ti.t0 + part * 16 + i - 2; xin[i] = (t >= 0 && t < ti.seqlen) ? bf2f(U[(size_t)(ti.seqbase + t) * UC + 512 + ch]) : 0.f; }
#pragma unroll
                for (int o = 0; o < 16; ++o) { const int tl = part * 16 + o;
                    const float v = cb + w0 * xin[o] + w1 * xin[o + 1] + w2 * xin[o + 2] + w3 * xin[o + 3];
                    xvf[tl * 256 + ch] = v; xvb[tl * 264 + ch] = (bf16)f2bf(v);
                }
            }
            __syncthreads();
            {
                const int tid = ltid(); const int ln = tid & 63, wv = __builtin_amdgcn_readfirstlane(tid >> 6), fr = ln & 15, fq = ln >> 4, blk = wv >> 1;
                const bf16* LWAt = (const bf16*)(ws + W_LWA); const bf16* LWXt = (const bf16*)(ws + W_LWX);
                bf16x8 af[2][2];
#pragma unroll
                for (int mt = 0; mt < 2; ++mt)
#pragma unroll
                    for (int ks = 0; ks < 2; ++ks) af[mt][ks] = *(const bf16x8*)(xvb + (mt * 16 + fr) * 264 + blk * 64 + ks * 32 + fq * 8);
#pragma unroll 1
                for (int dn = 0; dn < 4; ++dn) { const int d = dn >> 1, nt = wv * 2 + (dn & 1), ch = nt * 16 + fr, jj = (nt & 3) * 16 + fr;
                    f32x4 ca[2], cx[2];
#pragma unroll
                    for (int mt = 0; mt < 2; ++mt) { ca[mt] = (f32x4){0.f, 0.f, 0.f, 0.f}; cx[mt] = ca[mt]; }
#pragma unroll
                    for (int ks = 0; ks < 2; ++ks) { const size_t wo = ((size_t)(d * 4 + blk) * 64 + jj) * 64 + ks * 32 + fq * 8;
                        const bf16x8 ba = *(const bf16x8*)(LWAt + wo), bx = *(const bf16x8*)(LWXt + wo);
#pragma unroll
                        for (int mt = 0; mt < 2; ++mt) { ca[mt] = __builtin_amdgcn_mfma_f32_16x16x32_bf16(af[mt][ks], ba, ca[mt], 0, 0, 0); cx[mt] = __builtin_amdgcn_mfma_f32_16x16x32_bf16(af[mt][ks], bx, cx[mt], 0, 0, 0); } }
                    const float bga = IN(19)[(l * 2 + d) * 256 + ch], bgx = IN(21)[(l * 2 + d) * 256 + ch];
                    bf16* LR = (bf16*)(ws + M_LR0 + (size_t)d * A8); bf16* LIX = (bf16*)(ws + M_LIX0 + (size_t)d * A8);
#pragma unroll
                    for (int mt = 0; mt < 2; ++mt)
#pragma unroll
                        for (int j = 0; j < 4; ++j) { const int t = mt * 16 + fq * 4 + j;
                            const bf16 rb = (bf16)f2bf(sigm(ca[mt][j] + bga)), ib = (bf16)f2bf(sigm(cx[mt][j] + bgx) * xvf[t * 256 + ch]);
                            LR[(size_t)(row0 + t) * 256 + ch] = rb; LIX[(size_t)(row0 + t) * 256 + ch] = ib;
                            rg[(d * 32 + t) * 256 + ch] = rb; ixg[(d * 32 + t) * 256 + ch] = ib; }
                }
            }
            __syncthreads();
            {
                const int tid = ltid(); const int ch = tid & 255, d = tid >> 8;
                const float lam = IN(22)[(l * 2 + d) * 256 + ch];
                const float cch = -8.f * log1pf(__expf(-lam));
                float A = 1.f, B = 0.f;
#pragma unroll 8
                for (int tt = 0; tt < 32; ++tt) { const int t = d ? 31 - tt : tt;
                    const float al = __expf(cch * bf2f(rg[(d * 32 + t) * 256 + ch])); const float bb = sqrtf(fmaxf(1.f - al * al, 0.f)) * bf2f(ixg[(d * 32 + t) * 256 + ch]); B = al * B + bb; A *= al; }
                ((float*)(ws + M_SEGA))[(size_t)(tile * 2 + d) * 256 + ch] = A;
                ((float*)(ws + M_SEGB))[(size_t)(tile * 2 + d) * 256 + ch] = B;
            }
            __syncthreads();
        }
        {
            const int tid = ltid(); const int lane = tid & 63, wave = __builtin_amdgcn_readfirstlane(tid >> 6), ch = tid & 255, part = tid >> 8; (void)lane; (void)wave; (void)ch; (void)part;
            bf16* As = (bf16*)lds;
            float* kr = (float*)(lds + 32768);
            float* rs = (float*)(lds + 32768 + 4096);
            for (int idx = tid; idx < 32 * 52; idx += 512) { const int t = idx / 52, cc = idx % 52;
                const v4u v = *(const v4u*)(U + (size_t)(row0 + t) * UC + 2048 + cc * 8);
                if (cc < 48) *(v4u*)(As + t * 392 + cc * 8) = v;
                else { const int c0 = (cc - 48) * 8; float* kp = kr + t * 32 + c0;
                    kp[0] = __uint_as_float(v.x << 16); kp[1] = __uint_as_float(v.x & 0xffff0000u); kp[2] = __uint_as_float(v.y << 16); kp[3] = __uint_as_float(v.y & 0xffff0000u);
                    kp[4] = __uint_as_float(v.z << 16); kp[5] = __uint_as_float(v.z & 0xffff0000u); kp[6] = __uint_as_float(v.w << 16); kp[7] = __uint_as_float(v.w & 0xffff0000u); } }
            __syncthreads();
#pragma unroll
            for (int q = 0; q < 4; ++q) { const int t = wave * 4 + q; float sq = 0.f, sk = 0.f;
#pragma unroll
                for (int j = 0; j < 4; ++j) { const float v = bf2f(As[t * 392 + lane + 64 * j]); sq += v * v; }
#pragma unroll
                for (int j = 0; j < 2; ++j) { const float v = bf2f(As[t * 392 + 256 + lane + 64 * j]); sk += v * v; }
                sq = wave_sum(sq); sk = wave_sum(sk);
                if (lane == 0) { rs[t * 2] = rsqrtf(sq * (1.f / 256.f) + 1e-6f); rs[t * 2 + 1] = rsqrtf(sk * (1.f / 128.f) + 1e-6f); } }
            __syncthreads();
            const int fr = lane & 15, fq = lane >> 4;
            bf16* QB = (bf16*)(ws + M_QB); bf16* KB = (bf16*)(ws + M_KB); bf16* VT = (bf16*)(ws + M_VT);
            const bf16* WUQ = (const bf16*)(ws + W_UQ); const bf16* WUKV = (const bf16*)(ws + W_UKV);
            const int keybase = ti.isctx ? TLEN : 0;
#pragma unroll 1
            for (int i = 0; i < 3; ++i) { const int nt = wave * 3 + i;
                f32x4 c0 = {0.f, 0.f, 0.f, 0.f}, c1 = c0;
#pragma unroll
                for (int ks = 0; ks < 8; ++ks) { const bf16x8 bfr = *(const bf16x8*)(WUQ + (size_t)(nt * 16 + fr) * 256 + ks * 32 + fq * 8);
                    const bf16x8 a0 = *(const bf16x8*)(As + fr * 392 + ks * 32 + fq * 8), a1 = *(const bf16x8*)(As + (16 + fr) * 392 + ks * 32 + fq * 8);
                    c0 = __builtin_amdgcn_mfma_f32_16x16x32_bf16(a0, bfr, c0, 0, 0, 0); c1 = __builtin_amdgcn_mfma_f32_16x16x32_bf16(a1, bfr, c1, 0, 0, 0); }
                const int hq = nt / 6, wt = nt % 6, dd = wt * 16 + fr;
#pragma unroll
                for (int mt = 0; mt < 2; ++mt)
#pragma unroll
                    for (int j = 0; j < 4; ++j) { const int tl = mt * 16 + fq * 4 + j; const int t = ti.t0 + tl;
                        float v = (mt ? c1[j] : c0[j]) * rs[tl * 2];
                        const float pv = __shfl_xor(v, 8);
                        if (wt >= 4 && !ti.isctx) { const int f = fr & 7; const float pos = (wt == 4) ? (float)(t >> 6) : (float)(t & 63);
                            const float ang = pos * __expf(-(float)f * (9.210340371976184f / 8.f)); float sn, cs; __sincosf(ang, &sn, &cs);
                            v = (fr & 8) ? (v * cs + pv * sn) : (v * cs - pv * sn); }
                        QB[((size_t)(ti.b * 4 + hq) * TT + keybase + t) * 96 + dd] = (bf16)f2bf(v * QSCALE); } }
#pragma unroll 1
            for (int i = 0; i < 4; ++i) { const int nt = wave * 4 + i;
                f32x4 c0 = {0.f, 0.f, 0.f, 0.f}, c1 = c0;
#pragma unroll
                for (int ks = 0; ks < 4; ++ks) { const bf16x8 bfr = *(const bf16x8*)(WUKV + (size_t)(nt * 16 + fr) * 128 + ks * 32 + fq * 8);
                    const bf16x8 a0 = *(const bf16x8*)(As + fr * 392 + 256 + ks * 32 + fq * 8), a1 = *(const bf16x8*)(As + (16 + fr) * 392 + 256 + ks * 32 + fq * 8);
                    c0 = __builtin_amdgcn_mfma_f32_16x16x32_bf16(a0, bfr, c0, 0, 0, 0); c1 = __builtin_amdgcn_mfma_f32_16x16x32_bf16(a1, bfr, c1, 0, 0, 0); }
                const int hk = nt >> 3, wt = nt & 7;
#pragma unroll
                for (int mt = 0; mt < 2; ++mt)
#pragma unroll
                    for (int j = 0; j < 4; ++j) { const int tl = mt * 16 + fq * 4 + j; const int key = keybase + ti.t0 + tl;
                        const float v = (mt ? c1[j] : c0[j]) * rs[tl * 2 + 1];
                        if (wt < 4) KB[((size_t)(ti.b * 4 + hk) * TT + key) * 96 + wt * 16 + fr] = (bf16)f2bf(v);
                        else VT[((size_t)(ti.b * 4 + hk) * 64 + (wt - 4) * 16 + fr) * TT + key] = (bf16)f2bf(v); } }
            { const int tl = tid >> 4, p = tid & 15, ax = p >> 3, f = p & 7; const int t = ti.t0 + tl;
                float x0 = kr[tl * 32 + ax * 16 + f], x1 = kr[tl * 32 + ax * 16 + 8 + f];
                if (!ti.isctx) { const float pos = ax == 0 ? (float)(t >> 6) : (float)(t & 63); const float ang = pos * __expf(-(float)f * (9.210340371976184f / 8.f));
                    float sn, cs; __sincosf(ang, &sn, &cs); const float y0 = x0 * cs - x1 * sn, y1 = x1 * cs + x0 * sn; x0 = y0; x1 = y1; }
                const bf16 b0 = (bf16)f2bf(x0), b1 = (bf16)f2bf(x1);
#pragma unroll
                for (int h = 0; h < 4; ++h) { bf16* kp = KB + ((size_t)(ti.b * 4 + h) * TT + keybase + t) * 96 + 64 + ax * 16 + f; kp[0] = b0; kp[8] = b1; } }
            __syncthreads();
        }
    }
}

__device__ __forceinline__ void attn_unit(unsigned char* lds, const bf16* QB, const bf16* KB, const bf16* VT, bf16* Y, int b, int h, int q0, int key_lo, int nkt, int tid) {
    const int lane = tid & 63, wave = tid >> 6, fr = lane & 15, fq = lane >> 4;
    const int bh = b * 4 + h;
    constexpr int KSTR = 104, VSTR = 72, KBUF = 64 * KSTR, VBUF = 64 * VSTR;
    bf16* Ks = (bf16*)lds;
    bf16* Vs = (bf16*)lds + 2 * KBUF;
    const int qw = q0 + wave * 32;
    bf16x8 qf[2][3];
#pragma unroll
    for (int qt = 0; qt < 2; ++qt)
#pragma unroll
        for (int ks = 0; ks < 3; ++ks) qf[qt][ks] = *(const bf16x8*)(QB + ((size_t)bh * TT + qw + qt * 16 + fr) * 96 + ks * 32 + fq * 8);
    float mrun[2] = {-1e30f, -1e30f}, lrun[2] = {0.f, 0.f};
    f32x4 o[4][2];
#pragma unroll
    for (int dt = 0; dt < 4; ++dt)
#pragma unroll
        for (int qt = 0; qt < 2; ++qt) o[dt][qt] = (f32x4){0.f, 0.f, 0.f, 0.f};
    const v4u* kg = (const v4u*)(KB + ((size_t)bh * TT + key_lo) * 96);
    const bf16* vg = VT + ((size_t)bh * 64 + (tid >> 3)) * TT + key_lo + (tid & 7) * 8;
    const int kc0 = tid, kc1 = 512 + tid;
    const int ko0 = (kc0 / 12) * KSTR + (kc0 % 12) * 8, ko1 = (kc1 / 12) * KSTR + (kc1 % 12) * 8, vo = (tid >> 3) * VSTR + (tid & 7) * 8;
    v4u rk0, rk1 = {0u, 0u, 0u, 0u}, rv;
    rk0 = kg[kc0]; if (tid < 256) rk1 = kg[kc1]; rv = *(const v4u*)vg;
    *(v4u*)(Ks + ko0) = rk0; if (tid < 256) *(v4u*)(Ks + ko1) = rk1; *(v4u*)(Vs + vo) = rv;
    __syncthreads();
    for (int kt = 0; kt < nkt; ++kt) {
        const int cur = kt & 1;
        if (kt + 1 < nkt) { const v4u* kn = kg + (size_t)(kt + 1) * 768; rk0 = kn[kc0]; if (tid < 256) rk1 = kn[kc1]; rv = *(const v4u*)(vg + (kt + 1) * 64); }
        const bf16* kb = Ks + cur * KBUF; const bf16* vb = Vs + cur * VBUF;
        f32x4 st[4][2];
#pragma unroll
        for (int k4 = 0; k4 < 4; ++k4) {
            st[k4][0] = (f32x4){0.f, 0.f, 0.f, 0.f}; st[k4][1] = st[k4][0];
#pragma unroll
            for (int ks = 0; ks < 3; ++ks) { const bf16x8 kf = *(const bf16x8*)(kb + (k4 * 16 + fr) * KSTR + ks * 32 + fq * 8);
                st[k4][0] = __builtin_amdgcn_mfma_f32_16x16x32_bf16(kf, qf[0][ks], st[k4][0], 0, 0, 0);
                st[k4][1] = __builtin_amdgcn_mfma_f32_16x16x32_bf16(kf, qf[1][ks], st[k4][1], 0, 0, 0); }
        }
        bf16x8 pb[2][2];
#pragma unroll
        for (int qt = 0; qt < 2; ++qt) {
            float mx = st[0][qt][0];
#pragma unroll
            for (int k4 = 0; k4 < 4; ++k4)
#pragma unroll
                for (int j = 0; j < 4; ++j) mx = fmaxf(mx, st[k4][qt][j]);
            mx = fmaxf(mx, __shfl_xor(mx, 16)); mx = fmaxf(mx, __shfl_xor(mx, 32));
            const float mn = fmaxf(mrun[qt], mx), alpha = __builtin_amdgcn_exp2f(mrun[qt] - mn); mrun[qt] = mn;
            float ls = 0.f;
#pragma unroll
            for (int k4 = 0; k4 < 4; ++k4)
#pragma unroll
                for (int j = 0; j < 4; ++j) { const float p = __builtin_amdgcn_exp2f(st[k4][qt][j] - mn); st[k4][qt][j] = p; ls += p; }
            lrun[qt] = lrun[qt] * alpha + ls;
#pragma unroll
            for (int dt = 0; dt < 4; ++dt) o[dt][qt] *= alpha;
#pragma unroll
            for (int u = 0; u < 2; ++u) { v4u w;
                w.x = pg8::cvt_pk_bf16(st[2 * u][qt][0], st[2 * u][qt][1]); w.y = pg8::cvt_pk_bf16(st[2 * u][qt][2], st[2 * u][qt][3]);
                w.z = pg8::cvt_pk_bf16(st[2 * u + 1][qt][0], st[2 * u + 1][qt][1]); w.w = pg8::cvt_pk_bf16(st[2 * u + 1][qt][2], st[2 * u + 1][qt][3]);
                pb[u][qt] = __builtin_bit_cast(bf16x8, w); }
        }
#pragma unroll
        for (int dt = 0; dt < 4; ++dt)
#pragma unroll
            for (int u = 0; u < 2; ++u) {
                const v2u lo = *(const v2u*)(vb + (dt * 16 + fr) * VSTR + 32 * u + 4 * fq), hi = *(const v2u*)(vb + (dt * 16 + fr) * VSTR + 32 * u + 16 + 4 * fq);
                v4u vw; vw.x = lo.x; vw.y = lo.y; vw.z = hi.x; vw.w = hi.y;
                const bf16x8 va = __builtin_bit_cast(bf16x8, vw);
                o[dt][0] = __builtin_amdgcn_mfma_f32_16x16x32_bf16(va, pb[u][0], o[dt][0], 0, 0, 0);
                o[dt][1] = __builtin_amdgcn_mfma_f32_16x16x32_bf16(va, pb[u][1], o[dt][1], 0, 0, 0);
            }
        if (kt + 1 < nkt) { const int nb = cur ^ 1; *(v4u*)(Ks + nb * KBUF + ko0) = rk0; if (tid < 256) *(v4u*)(Ks + nb * KBUF + ko1) = rk1; *(v4u*)(Vs + nb * VBUF + vo) = rv; }
        __syncthreads();
    }
#pragma unroll
    for (int qt = 0; qt < 2; ++qt) {
        float lt = lrun[qt]; lt += __shfl_xor(lt, 16); lt += __shfl_xor(lt, 32);
        const float inv = 1.f / lt;
        const int q = qw + qt * 16 + fr;
        const size_t row = q < TLEN ? (size_t)b * TLEN + q : (size_t)NLAT + b * CTXL + (q - TLEN);
#pragma unroll
        for (int dt = 0; dt < 4; ++dt) { const f32x4 v = o[dt][qt] * inv; v2u w; w.x = pk2(v[0], v[1]); w.y = pk2(v[2], v[3]);
            *(v2u*)(Y + row * DM + 768 + h * 64 + dt * 16 + fq * 4) = w; }
    }
}
__device__ __forceinline__ void lru_prefix(int bd, int tid) {
    unsigned char* ws = karg_ws();
    if (tid >= 256) return;
    const int ch = tid, b = bd >> 1, d = bd & 1;
    const float* __restrict__ SA = (const float*)(ws + M_SEGA); const float* __restrict__ SB = (const float*)(ws + M_SEGB); float* __restrict__ H0 = (float*)(ws + M_H0);
    const int ctile0 = 512 + b * 8, ltile0 = b * 256;
#define LRU_TILE(i_) ((i_) < 8 ? ctile0 + (d ? 7 - (i_) : (i_)) : ltile0 + (d ? 255 - ((i_) - 8) : ((i_) - 8)))
    float hst = 0.f;
    float ca[24], cb[24], na[24], nb[24];
#pragma unroll
    for (int k = 0; k < 24; ++k) { const size_t o = (size_t)(LRU_TILE(k) * 2 + d) * 256 + ch; ca[k] = SA[o]; cb[k] = SB[o]; }
    for (int i0 = 0; i0 < 264; i0 += 24) {
        if (i0 + 24 < 264) {
#pragma unroll
            for (int k = 0; k < 24; ++k) { const size_t o = (size_t)(LRU_TILE(i0 + 24 + k) * 2 + d) * 256 + ch; na[k] = SA[o]; nb[k] = SB[o]; } }
        float hv[24];
#pragma unroll
        for (int k = 0; k < 24; ++k) { hv[k] = hst; hst = ca[k] * hst + cb[k]; }
#pragma unroll
        for (int k = 0; k < 24; ++k) H0[(size_t)(LRU_TILE(i0 + k) * 2 + d) * 256 + ch] = hv[k];
#pragma unroll
        for (int k = 0; k < 24; ++k) { ca[k] = na[k]; cb[k] = nb[k]; }
    }
#undef LRU_TILE
}
__device__ __forceinline__ void lru_rescan(const Args& a, int l, unsigned char* lds, int tile, int tid) {
    unsigned char* ws = karg_ws();
    const int ch = tid & 255, d = tid >> 8;
    const int row0 = tile * 32;
    float hst = ((const float*)(ws + M_H0))[(size_t)(tile * 2 + d) * 256 + ch];
    const float lam = IN(22)[(l * 2 + d) * 256 + ch];
    const float cch = -8.f * log1pf(__expf(-lam));
    const bf16* LR = (const bf16*)(ws + M_LR0 + (size_t)d * A8); const bf16* LIX = (const bf16*)(ws + M_LIX0 + (size_t)d * A8);
    float* hs = (float*)lds;
#pragma unroll 16
    for (int tt = 0; tt < 32; ++tt) { const int t = d ? 31 - tt : tt; const size_t o = (size_t)(row0 + t) * 256 + ch;
        const float al = __expf(cch * bf2f(LR[o])); const float bb = sqrtf(fmaxf(1.f - al * al, 0.f)) * bf2f(LIX[o]);
        hst = al * hst + bb; hs[(d * 32 + t) * 256 + ch] = hst; }
    __syncthreads();
    const bf16* U = (const bf16*)(ws + OFF_HU); bf16* Y = (bf16*)(ws + OFF_XMY);
#pragma unroll 8
    for (int tt = 0; tt < 16; ++tt) { const int t = d * 16 + tt;
        const float y = (hs[t * 256 + ch] + hs[(32 + t) * 256 + ch]) * geluf_(bf2f(U[(size_t)(row0 + t) * UC + 768 + ch]));
        Y[(size_t)(row0 + t) * DM + 256 + ch] = (bf16)f2bf(y); }
    __syncthreads();
}
__device__ __forceinline__ void phase_m2(const Args& a, int l, unsigned char* lds, int G, int bid, int tid) {
    unsigned char* ws = karg_ws();
    const bf16* QB = (const bf16*)(ws + M_QB); const bf16* KB = (const bf16*)(ws + M_KB); const bf16* VT = (const bf16*)(ws + M_VT);
    bf16* Y = (bf16*)(ws + OFF_XMY);
    const int nunits = (l == 0) ? 264 : 256;
    for (int u = bid; u < nunits; u += G) {
        if (u < 256) attn_unit(lds, QB, KB, VT, Y, u >> 7, (u >> 5) & 3, (u & 31) * 256, 0, 132, tid);
        else attn_unit(lds, QB, KB, VT, Y, (u - 256) >> 2, (u - 256) & 3, TLEN, TLEN, 4, tid);
    }
    if (bid >= G - 4) lru_prefix(bid - (G - 4), tid);
}

__device__ __forceinline__ void phase_m3(const Args& a, int l, unsigned char* lds, int G, int bid, int tid) {
    unsigned char* ws = karg_ws();
    const bf16* U = (const bf16*)(ws + OFF_HU);
    const int lane = tid & 63, ch = tid & 255, part = tid >> 8;
    const float* mup = IN(23) + l * 1024; const float* mun = IN(24) + l * 1024;
    bf16* RR = (bf16*)(ws + M_RR); bf16* KKo = (bf16*)(ws + M_KK); bf16* VV = (bf16*)(ws + M_VV); bf16* GC = (bf16*)(ws + M_GC);
    float* kl = (float*)lds;
    float* kkn = (float*)(lds + 32768);
    bf16* twb = (bf16*)(lds + 65536);
    bf16* tab = (bf16*)(lds + 70144);
    bf16* tgb = (bf16*)(lds + 74752);
    for (int tile = bid; tile < NTILE; tile += G) {
        const TileInfo ti = tile_info(tile);
        const int row0 = tile * 32;
        lru_rescan(a, l, lds, tile, ltid());
        {
            const int tid2 = ltid(); const int chunk = tid2 & 127, tg8 = tid2 >> 7, c0 = chunk * 8;
            const bf16* ub = U + (size_t)row0 * UC + 1024 + c0;
            v4u rw[10];
#pragma unroll
            for (int q = 0; q < 10; ++q) { const int tl = tg8 * 8 + q - 1; const int t = ti.t0 + tl;
                rw[q] = (t >= 0 && t < ti.seqlen) ? *(const v4u*)(ub + (ptrdiff_t)tl * UC) : (v4u){0u, 0u, 0u, 0u}; }
            const f32x4 mp0 = *(const f32x4*)(mup + c0), mp1 = *(const f32x4*)(mup + c0 + 4), mn0 = *(const f32x4*)(mun + c0), mn1 = *(const f32x4*)(mun + c0 + 4);
            const float mp[8] = {mp0[0], mp0[1], mp0[2], mp0[3], mp1[0], mp1[1], mp1[2], mp1[3]}, mn[8] = {mn0[0], mn0[1], mn0[2], mn0[3], mn1[0], mn1[1], mn1[2], mn1[3]};
#pragma unroll
            for (int q = 0; q < 8; ++q) { const int tl = tg8 * 8 + q; float ts[8];
#pragma unroll
                for (int e = 0; e < 8; ++e) { const unsigned wm = rw[q][e >> 1], w0 = rw[q + 1][e >> 1], wn = rw[q + 2][e >> 1];
                    const float um = (e & 1) ? __uint_as_float(wm & 0xffff0000u) : __uint_as_float(wm << 16);
                    const float u0 = (e & 1) ? __uint_as_float(w0 & 0xffff0000u) : __uint_as_float(w0 << 16);
                    const float un = (e & 1) ? __uint_as_float(wn & 0xffff0000u) : __uint_as_float(wn << 16);
                    ts[e] = u0 + mp[e] * (um - u0) + mn[e] * (un - u0); }
                if (chunk >= 32 && chunk < 64) { float* kp = kl + tl * 256 + (c0 - 256); *(f32x4*)kp = (f32x4){ts[0], ts[1], ts[2], ts[3]}; *(f32x4*)(kp + 4) = (f32x4){ts[4], ts[5], ts[6], ts[7]}; }
                else {
                    if (chunk >= 96 && chunk < 104) {
#pragma unroll
                        for (int e = 0; e < 8; ++e) ts[e] = tanhf_(ts[e]); }
                    if (chunk >= 112) {
#pragma unroll
                        for (int e = 0; e < 8; ++e) ts[e] = sigm(ts[e]); }
                    v4u o; o.x = pk2(ts[0], ts[1]); o.y = pk2(ts[2], ts[3]); o.z = pk2(ts[4], ts[5]); o.w = pk2(ts[6], ts[7]);
                    if (chunk < 32) *(v4u*)(RR + (size_t)(row0 + tl) * 256 + c0) = o;
                    else if (chunk < 96) *(v4u*)(VV + (size_t)(row0 + tl) * 256 + (c0 - 512)) = o;
                    else if (chunk < 104) *(v4u*)(twb + tl * 72 + (c0 - 768)) = o;
                    else if (chunk < 112) *(v4u*)(tab + tl * 72 + (c0 - 832)) = o;
                    else *(v4u*)(tgb + tl * 136 + (c0 - 896)) = o; }
            }
        }
        __syncthreads();
        {
            const int tid2 = ltid(); const int ch = tid2 & 255, pt = tid2 >> 8; const float kkc = IN(30)[l * 256 + ch];
#pragma unroll 4
            for (int q = 0; q < 16; ++q) { const int t = pt * 16 + q; const float kr = kl[t * 256 + ch] * kkc; const float nrm = wave_sum(kr * kr);
                const float kk = kr * rsqrtf(fmaxf(nrm, 1e-24f)); kkn[t * 256 + ch] = kk; KKo[(size_t)(row0 + t) * 256 + ch] = (bf16)f2bf(kk); }
        }
        __syncthreads();
        {
            const int tid2 = ltid(); const int ln = tid2 & 63, wv = __builtin_amdgcn_readfirstlane(tid2 >> 6), fr = ln & 15, fq = ln >> 4;
            const bf16* WUPt = (const bf16*)(ws + W_WUP); const bf16* AUPt = (const bf16*)(ws + W_AUP); const bf16* GUPt = (const bf16*)(ws + W_GUP);
            bf16x8 aw[2][2], aa[2][2];
#pragma unroll
            for (int mt = 0; mt < 2; ++mt)
#pragma unroll
                for (int ks = 0; ks < 2; ++ks) { aw[mt][ks] = *(const bf16x8*)(twb + (mt * 16 + fr) * 72 + ks * 32 + fq * 8); aa[mt][ks] = *(const bf16x8*)(tab + (mt * 16 + fr) * 72 + ks * 32 + fq * 8); }
#pragma unroll 1
            for (int dn = 0; dn < 4; ++dn) { const int d = dn >> 1, nt = wv * 2 + (dn & 1), ch = nt * 16 + fr;
                f32x4 cw[2], ca[2];
#pragma unroll
                for (int mt = 0; mt < 2; ++mt) { cw[mt] = (f32x4){0.f, 0.f, 0.f, 0.f}; ca[mt] = cw[mt]; }
#pragma unroll
                for (int ks = 0; ks < 2; ++ks) { const bf16x8 bw = *(const bf16x8*)(WUPt + ((size_t)d * 256 + ch) * 64 + ks * 32 + fq * 8), ba = *(const bf16x8*)(AUPt + ((size_t)d * 256 + ch) * 64 + ks * 32 + fq * 8);
#pragma unroll
                    for (int mt = 0; mt < 2; ++mt) { cw[mt] = __builtin_amdgcn_mfma_f32_16x16x32_bf16(aw[mt][ks], bw, cw[mt], 0, 0, 0); ca[mt] = __builtin_amdgcn_mfma_f32_16x16x32_bf16(aa[mt][ks], ba, ca[mt], 0, 0, 0); } }
                const float w0 = IN(25)[(l * 2 + d) * 256 + ch], a0 = IN(27)[(l * 2 + d) * 256 + ch], kac = IN(31)[l * 256 + ch];
                float* WW = (float*)(ws + M_WW) + (size_t)d * NR * 256; bf16* BB = (bf16*)(ws + M_BB + (size_t)d * A8); bf16* KD = (bf16*)(ws + M_KD + (size_t)d * A8);
#pragma unroll
                for (int mt = 0; mt < 2; ++mt)
#pragma unroll
                    for (int j = 0; j < 4; ++j) { const int t = mt * 16 + fq * 4 + j; const size_t o = (size_t)(row0 + t) * 256 + ch;
                        const float e = sigm(w0 + cw[mt][j]) * 0.6065306597126334f;
                        const float av = sigm(a0 + ca[mt][j]);
                        WW[o] = __expf(-e);
                        KD[o] = (bf16)f2bf(kl[t * 256 + ch] * (1.f + (av - 1.f) * kac));
                        BB[o] = (bf16)f2bf(kkn[t * 256 + ch] * av); }
            }
#pragma unroll 1
            for (int nl = 0; nl < 2; ++nl) { const int ch = (wv * 2 + nl) * 16 + fr;
                f32x4 cg[2] = {(f32x4){0.f, 0.f, 0.f, 0.f}, (f32x4){0.f, 0.f, 0.f, 0.f}};
#pragma unroll
                for (int ks = 0; ks < 4; ++ks) { const bf16x8 bg = *(const bf16x8*)(GUPt + (size_t)ch * 128 + ks * 32 + fq * 8);
#pragma unroll
                    for (int mt = 0; mt < 2; ++mt) { const bf16x8 ag = *(const bf16x8*)(tgb + (mt * 16 + fr) * 136 + ks * 32 + fq * 8); cg[mt] = __builtin_amdgcn_mfma_f32_16x16x32_bf16(ag, bg, cg[mt], 0, 0, 0); } }
#pragma unroll
                for (int mt = 0; mt < 2; ++mt)
#pragma unroll
                    for (int j = 0; j < 4; ++j) GC[(size_t)(row0 + mt * 16 + fq * 4 + j) * 256 + ch] = (bf16)f2bf(cg[mt][j]);
            }
        }
        __syncthreads();
    }
}

typedef const unsigned cu32;
typedef const float cf32;
__device__ __forceinline__ int chain_row(int b, int d, int tau) {
    return tau < CTXL ? (NLAT + b * CTXL + (d ? CTXL - 1 - tau : tau)) : (b * TLEN + (d ? TLEN - 1 - (tau - CTXL) : (tau - CTXL)));
}
template <int MODE>
__device__ __forceinline__ void rwkv_steps(float (&S)[64], int b, int h, int d, int tau0, int n, unsigned char* ws, int lane, float* wl) {
    const bf16* KKp = (const bf16*)(ws + M_KK); const bf16* RRp = (const bf16*)(ws + M_RR); const bf16* VVp = (const bf16*)(ws + M_VV);
    const float* WWp = (const float*)(ws + M_WW) + (size_t)d * NR * 256; const bf16* BBp = (const bf16*)(ws + M_BB + (size_t)d * A8); const bf16* KDp = (const bf16*)(ws + M_KD + (size_t)d * A8);
    float* YS = (float*)(ws + M_YS) + (size_t)d * NR * 256;
    float pk, pw, pb, pkd = 0.f, pr = 0.f, pv = 0.f; size_t poff;
#define RWKV_LOAD(s_) do { poff = (size_t)chain_row(b, d, tau0 + (s_)) * 256 + h * 64 + lane; pk = bf2f(KKp[poff]); pw = WWp[poff]; pb = bf2f(BBp[poff]); \
        if (MODE != 1) { pkd = bf2f(KDp[poff]); pv = bf2f(VVp[poff]); } if (MODE == 2) pr = bf2f(RRp[poff]); } while (0)
    RWKV_LOAD(0);
    for (int s = 0; s < n; ++s) {
        float* buf = wl + (s & 1) * 320;
        buf[lane] = pk; buf[64 + lane] = pw; buf[128 + lane] = pb;
        if (MODE != 1) buf[192 + lane] = pkd;
        if (MODE == 2) buf[256 + lane] = pr;
        const float vv = pv; const size_t yoff = poff;
        if (s + 1 < n) RWKV_LOAD(s + 1);
        float sa0 = 0.f, sa1 = 0.f, sa2 = 0.f, sa3 = 0.f;
#pragma unroll
        for (int i = 0; i < 64; i += 4) { const f32x4 k4 = *(const f32x4*)(buf + i);
            sa0 += S[i] * k4[0]; sa1 += S[i + 1] * k4[1]; sa2 += S[i + 2] * k4[2]; sa3 += S[i + 3] * k4[3]; }
        const float nsa = -((sa0 + sa1) + (sa2 + sa3));
        float y0 = 0.f, y1 = 0.f, y2 = 0.f, y3 = 0.f;
#pragma unroll
        for (int i = 0; i < 64; i += 4) { const f32x4 w4 = *(const f32x4*)(buf + 64 + i), b4 = *(const f32x4*)(buf + 128 + i);
            f32x4 t = nsa * b4;
            if (MODE != 1) { const f32x4 kd4 = *(const f32x4*)(buf + 192 + i); t += vv * kd4; }
            S[i] = S[i] * w4[0] + t[0]; S[i + 1] = S[i + 1] * w4[1] + t[1]; S[i + 2] = S[i + 2] * w4[2] + t[2]; S[i + 3] = S[i + 3] * w4[3] + t[3];
            if (MODE == 2) { const f32x4 r4 = *(const f32x4*)(buf + 256 + i); y0 += S[i] * r4[0]; y1 += S[i + 1] * r4[1]; y2 += S[i + 2] * r4[2]; y3 += S[i + 3] * r4[3]; } }
        if (MODE == 2) YS[yoff] = (y0 + y1) + (y2 + y3);
    }
#undef RWKV_LOAD
}
typedef float f32x2 __attribute__((ext_vector_type(2)));
__device__ __forceinline__ void rwkv_pass1(f32x2 (&SL)[32], f32x2 (&SI)[32], int b, int h, int d, int tau0, int n, unsigned char* ws, int lane, float* wl) {
    const bf16* KKp = (const bf16*)(ws + M_KK); const bf16* VVp = (const bf16*)(ws + M_VV); const bf16* RRp = (const bf16*)(ws + M_RR);
    const float* WWp = (const float*)(ws + M_WW) + (size_t)d * NR * 256; const bf16* BBp = (const bf16*)(ws + M_BB + (size_t)d * A8); const bf16* KDp = (const bf16*)(ws + M_KD + (size_t)d * A8);
    float* YS = (float*)(ws + M_YS) + (size_t)d * NR * 256; float* PR = (float*)(ws + M_PR) + (size_t)d * NR * 256;
    float pk, pw, pb, pkd, pv, pr; size_t poff;
#define RWKV_LOAD(s_) do { poff = (size_t)chain_row(b, d, tau0 + (s_)) * 256 + h * 64 + lane; pk = bf2f(KKp[poff]); pw = WWp[poff]; pb = bf2f(BBp[poff]); pkd = bf2f(KDp[poff]); pv = bf2f(VVp[poff]); pr = bf2f(RRp[poff]); } while (0)
    RWKV_LOAD(0);
    for (int s = 0; s < n; ++s) {
        float* buf = wl + (s & 1) * 320;
        buf[lane] = pk; buf[64 + lane] = pw; buf[128 + lane] = pb; buf[192 + lane] = pkd; buf[256 + lane] = pr;
        const float vv = pv; const size_t yoff = poff;
        if (s + 1 < n) RWKV_LOAD(s + 1);
        f32x2 aL0 = {0.f, 0.f}, aL1 = aL0, aI0 = aL0, aI1 = aL0;
#pragma unroll
        for (int q = 0; q < 16; ++q) { const f32x4 k4 = *(const f32x4*)(buf + 4 * q);
            aL0 += SL[2 * q] * k4.lo; aL1 += SL[2 * q + 1] * k4.hi; aI0 += SI[2 * q] * k4.lo; aI1 += SI[2 * q + 1] * k4.hi; }
        const f32x2 tL = aL0 + aL1, tI = aI0 + aI1;
        const float nsl = -(tL.x + tL.y), nsi = -(tI.x + tI.y);
        f32x2 yL0 = {0.f, 0.f}, yL1 = yL0, yI0 = yL0, yI1 = yL0;
#pragma unroll
        for (int q = 0; q < 16; ++q) {
            const f32x4 w4 = *(const f32x4*)(buf + 64 + 4 * q), b4 = *(const f32x4*)(buf + 128 + 4 * q), kd4 = *(const f32x4*)(buf + 192 + 4 * q), r4 = *(const f32x4*)(buf + 256 + 4 * q);
            const f32x4 tl = nsl * b4 + vv * kd4, tiv = nsi * b4;
            SL[2 * q] = SL[2 * q] * w4.lo + tl.lo; SL[2 * q + 1] = SL[2 * q + 1] * w4.hi + tl.hi;
            SI[2 * q] = SI[2 * q] * w4.lo + tiv.lo; SI[2 * q + 1] = SI[2 * q + 1] * w4.hi + tiv.hi;
            yL0 += SL[2 * q] * r4.lo; yL1 += SL[2 * q + 1] * r4.hi; yI0 += SI[2 * q] * r4.lo; yI1 += SI[2 * q + 1] * r4.hi; }
        const f32x2 yl = yL0 + yL1, yp = yI0 + yI1;
        YS[yoff] = yl.x + yl.y; PR[yoff] = yp.x + yp.y;
    }
#undef RWKV_LOAD
}
__device__ __forceinline__ void phase_m4(const Args& a, unsigned char* lds, int G, int bid, int tid) {
    const int lane = tid & 63, wave = __builtin_amdgcn_readfirstlane(tid >> 6), half = wave >> 2, tk = wave & 3;
    unsigned char* ws = karg_ws(); float* PL = (float*)(ws + M_PL);
    float* wl = (float*)lds + wave * 320;
    float* xch = (float*)lds + 8 * 320 + tk * 1024;
    float* ych = xch + 512;
    const bf16* KKp = (const bf16*)(ws + M_KK); const bf16* VVp = (const bf16*)(ws + M_VV); const bf16* RRp = (const bf16*)(ws + M_RR);
    for (int task0 = bid * 4; task0 < 16 * NSEG; task0 += G * 4) {
        const int task = task0 + tk; const int seg = task & (NSEG - 1), chain = task >> 6;
        const int d = chain & 1, h = (chain >> 1) & 3, b = chain >> 3;
        const float* WWp = (const float*)(ws + M_WW) + (size_t)d * NR * 256; const bf16* BBp = (const bf16*)(ws + M_BB + (size_t)d * A8); const bf16* KDp = (const bf16*)(ws + M_KD + (size_t)d * A8);
        float* YS = (float*)(ws + M_YS) + (size_t)d * NR * 256; float* PR = (float*)(ws + M_PR) + (size_t)d * NR * 256;
        f32x2 SL[16], SI[16]; int ln = lane; asm volatile("" : "+v"(ln));
#pragma unroll
        for (int i = 0; i < 16; ++i) { SL[i] = (f32x2){0.f, 0.f}; SI[i] = (f32x2){(32 * half + 2 * i == ln) ? 1.f : 0.f, (32 * half + 2 * i + 1 == ln) ? 1.f : 0.f}; }
        const int tau0 = seg * SEGLEN, cidx = h * 64 + 32 * half + (lane & 31);
        float p0, p1, p2, pv; size_t rowoff, prevoff = 0;
#define M4_LOAD(s_) do { rowoff = (size_t)chain_row(b, d, tau0 + (s_)) * 256; const size_t po = rowoff + cidx; \
            if (lane < 32) { p0 = bf2f(KKp[po]); p1 = WWp[po]; p2 = bf2f(BBp[po]); } else { p0 = bf2f(KDp[po]); p1 = bf2f(RRp[po]); p2 = 0.f; } pv = bf2f(VVp[rowoff + h * 64 + lane]); } while (0)
        M4_LOAD(0);
        for (int s = 0; s < SEGLEN; ++s) {
            float* buf = wl + (s & 1) * 160; const int l31 = lane & 31;
            if (lane < 32) { buf[l31] = p0; buf[32 + l31] = p1; buf[64 + l31] = p2; } else { buf[96 + l31] = p0; buf[128 + l31] = p1; }
            const float vv = pv; const size_t yoff = rowoff + h * 64 + lane;
            if (s + 1 < SEGLEN) M4_LOAD(s + 1);
            f32x2 aL0 = {0.f, 0.f}, aL1 = aL0, aI0 = aL0, aI1 = aL0;
#pragma unroll
            for (int q = 0; q < 8; ++q) { const f32x4 k4 = *(const f32x4*)(buf + 4 * q);
                aL0 += SL[2 * q] * k4.lo; aL1 += SL[2 * q + 1] * k4.hi; aI0 += SI[2 * q] * k4.lo; aI1 += SI[2 * q + 1] * k4.hi; }
            const f32x2 tL = aL0 + aL1, tI = aI0 + aI1;
            float* xw = xch + (s & 1) * 256;
            xw[half * 128 + lane] = tL.x + tL.y; xw[half * 128 + 64 + lane] = tI.x + tI.y;
            __syncthreads();
            const float nsl = -(xw[lane] + xw[128 + lane]), nsi = -(xw[64 + lane] + xw[192 + lane]);
            if (s > 0) {
                const float* yr = ych + ((s - 1) & 1) * 256;
                if (half == 0) YS[prevoff] = yr[lane] + yr[128 + lane]; else PR[prevoff] = yr[64 + lane] + yr[192 + lane];
            }
            f32x2 yL0 = {0.f, 0.f}, yL1 = yL0, yI0 = yL0, yI1 = yL0;
#pragma unroll
            for (int q = 0; q < 8; ++q) {
                const f32x4 w4 = *(const f32x4*)(buf + 32 + 4 * q), b4 = *(const f32x4*)(buf + 64 + 4 * q), kd4 = *(const f32x4*)(buf + 96 + 4 * q), r4 = *(const f32x4*)(buf + 128 + 4 * q);
                const f32x4 tl = nsl * b4 + vv * kd4, tiv = nsi * b4;
                SL[2 * q] = SL[2 * q] * w4.lo + tl.lo; SL[2 * q + 1] = SL[2 * q + 1] * w4.hi + tl.hi;
                SI[2 * q] = SI[2 * q] * w4.lo + tiv.lo; SI[2 * q + 1] = SI[2 * q + 1] * w4.hi + tiv.hi;
                yL0 += SL[2 * q] * r4.lo; yL1 += SL[2 * q + 1] * r4.hi; yI0 += SI[2 * q] * r4.lo; yI1 += SI[2 * q + 1] * r4.hi; }
            const f32x2 yl = yL0 + yL1, yp = yI0 + yI1;
            float* yw = ych + (s & 1) * 256;
            yw[half * 128 + lane] = yl.x + yl.y; yw[half * 128 + 64 + lane] = yp.x + yp.y;
            prevoff = yoff;
        }
#undef M4_LOAD
        __syncthreads();
        { const float* yr = ych + ((SEGLEN - 1) & 1) * 256;
          if (half == 0) YS[prevoff] = yr[lane] + yr[128 + lane]; else PR[prevoff] = yr[64 + lane] + yr[192 + lane]; }
        float* o = PL + (((size_t)(chain * NSEG + seg) * 2) * 64 + lane) * 64 + 32 * half;
#pragma unroll
        for (int i = 0; i < 16; i += 2) { *(f32x4*)(o + 2 * i) = (f32x4){SL[i].x, SL[i].y, SL[i + 1].x, SL[i + 1].y}; *(f32x4*)(o + 4096 + 2 * i) = (f32x4){SI[i].x, SI[i].y, SI[i + 1].x, SI[i + 1].y}; }
        __syncthreads();
    }
}
__device__ __forceinline__ void phase_m5(const Args& a, unsigned char* lds, int G, int bid, int tid) {
    unsigned char* ws = karg_ws(); const float* PL = (const float*)(ws + M_PL); float* SI = (float*)(ws + M_SINIT);
    float* Sx = (float*)lds;
    const int lane = tid & 63, wv = __builtin_amdgcn_readfirstlane(tid >> 6), fr = lane & 15, fq = lane >> 4;
    const bool act = wv < 4;
    for (int u = bid; u < 64; u += G) {
        const int chain = u >> 2, row0 = (u & 3) * 16, col = (wv & 3) * 16 + fr;
        const float* Pg = PL + ((size_t)(chain * NSEG) * 2 + 1) * 4096; const float* Lg = PL + ((size_t)(chain * NSEG) * 2) * 4096;
        float* SIc = SI + (size_t)(chain * NSEG) * 4096;
        f32x4 cur = {0.f, 0.f, 0.f, 0.f}; f32x4 lv[3]; float pb[3][16];
#pragma unroll
        for (int q = 0; q < 3; ++q) { lv[q] = cur;
            if (act) { const float* Pn = Pg + (size_t)q * 8192; const float* Ln = Lg + (size_t)q * 8192;
#pragma unroll
                for (int ks = 0; ks < 16; ++ks) pb[q][ks] = Pn[(4 * ks + fq) * 64 + col];
#pragma unroll
                for (int j = 0; j < 4; ++j) lv[q][j] = Ln[(row0 + fq * 4 + j) * 64 + col]; } }
        for (int g0 = 0; g0 < NSEG - 1; g0 += 3) {
#pragma unroll
            for (int q = 0; q < 3; ++q) { const int g = g0 + q;
                if (act) {
#pragma unroll
                    for (int j = 0; j < 4; ++j) { SIc[(size_t)g * 4096 + (row0 + fq * 4 + j) * 64 + col] = cur[j]; Sx[(fq * 4 + j) * 68 + col] = cur[j]; }
                }
                __syncthreads();
                if (act) {
                    f32x4 acc = lv[q];
#pragma unroll
                    for (int ks = 0; ks < 16; ++ks) { const float av = Sx[fr * 68 + 4 * ks + fq]; acc = __builtin_amdgcn_mfma_f32_16x16x4f32(av, pb[q][ks], acc, 0, 0, 0); }
                    cur = acc;
                    if (g + 3 < NSEG - 1) { const float* Pn = Pg + (size_t)(g + 3) * 8192; const float* Ln = Lg + (size_t)(g + 3) * 8192;
#pragma unroll
                        for (int ks = 0; ks < 16; ++ks) pb[q][ks] = Pn[(4 * ks + fq) * 64 + col];
#pragma unroll
                        for (int j = 0; j < 4; ++j) lv[q][j] = Ln[(row0 + fq * 4 + j) * 64 + col]; }
                }
                __syncthreads();
            }
        }
        if (act) {
#pragma unroll
            for (int j = 0; j < 4; ++j) SIc[(size_t)(NSEG - 1) * 4096 + (row0 + fq * 4 + j) * 64 + col] = cur[j];
        }
    }
}
__device__ __forceinline__ void phase_m6(const Args& a, unsigned char* lds, int G, int bid, int tid) {
    const int lane = tid & 63, wave = __builtin_amdgcn_readfirstlane(tid >> 6);
    unsigned char* ws = karg_ws(); const float* SI = (const float*)(ws + M_SINIT);
    float* wl = (float*)lds + wave * 256;
    for (int task = bid * 8 + wave; task < 16 * (NSEG - 1); task += G * 8) {
        const int seg = 1 + task % (NSEG - 1), chain = task / (NSEG - 1);
        const int d = chain & 1, h = (chain >> 1) & 3, b = chain >> 3;
        float* YS = (float*)(ws + M_YS) + (size_t)d * NR * 256; const float* PR = (const float*)(ws + M_PR) + (size_t)d * NR * 256;
        f32x2 S0[32];
        const float* si = SI + ((size_t)(chain * NSEG + seg) * 64 + lane) * 64;
#pragma unroll
        for (int i = 0; i < 32; i += 2) { const f32x4 v = *(const f32x4*)(si + 2 * i); S0[i] = v.lo; S0[i + 1] = v.hi; }
        const int tau0 = seg * SEGLEN;
        size_t o0 = (size_t)chain_row(b, d, tau0) * 256 + h * 64 + lane, o1 = (size_t)chain_row(b, d, tau0 + 1) * 256 + h * 64 + lane;
        float p0 = PR[o0], p1 = PR[o1], y0 = YS[o0], y1 = YS[o1];
        for (int s = 0; s < SEGLEN; s += 2) {
            wl[lane] = p0; wl[64 + lane] = p1;
            const size_t c0 = o0, c1 = o1; const float yy0 = y0, yy1 = y1;
            if (s + 2 < SEGLEN) { o0 = (size_t)chain_row(b, d, tau0 + s + 2) * 256 + h * 64 + lane; o1 = (size_t)chain_row(b, d, tau0 + s + 3) * 256 + h * 64 + lane; p0 = PR[o0]; p1 = PR[o1]; y0 = YS[o0]; y1 = YS[o1]; }
            f32x2 a0 = {0.f, 0.f}, a1 = a0, b0 = a0, b1 = a0;
#pragma unroll
            for (int q = 0; q < 16; ++q) { const f32x4 u = *(const f32x4*)(wl + 4 * q), w = *(const f32x4*)(wl + 64 + 4 * q);
                a0 += S0[2 * q] * u.lo; a1 += S0[2 * q + 1] * u.hi; b0 += S0[2 * q] * w.lo; b1 += S0[2 * q + 1] * w.hi; }
            const f32x2 ta = a0 + a1, tb = b0 + b1;
            YS[c0] = yy0 + (ta.x + ta.y); YS[c1] = yy1 + (tb.x + tb.y);
            asm volatile("" ::: "memory");
        }
    }
}
__device__ __forceinline__ void phase_m7(const Args& a, int l, int gw, int NGW, int lane) {
    unsigned char* ws = karg_ws();
    const float* Y0 = (const float*)(ws + M_YS); const float* Y1 = Y0 + (size_t)NR * 256;
    const bf16* RR = (const bf16*)(ws + M_RR); const bf16* VV = (const bf16*)(ws + M_VV); const bf16* KD0 = (const bf16*)(ws + M_KD); const bf16* KD1 = (const bf16*)(ws + M_KD + A8);
    const bf16* GC = (const bf16*)(ws + M_GC); bf16* Y = (bf16*)(ws + OFF_XMY);
    for (int r = gw; r < NR; r += NGW) {
#pragma unroll
        for (int h = 0; h < 4; ++h) { const int c = h * 64 + lane; const size_t o = (size_t)r * 256 + c;
            const float ys = Y0[o] + Y1[o];
            const float mu = wave_sum(ys) * (1.f / 64.f); const float dv = ys - mu; const float var = wave_sum(dv * dv) * (1.f / 64.f);
            float ov = dv * rsqrtf(var + 64e-5f) * IN(33)[l * 256 + c] + IN(34)[l * 256 + c];
            const float rv = bf2f(RR[o]), rk = IN(32)[l * 256 + c], vv = bf2f(VV[o]);
            const float b0 = wave_sum(rv * bf2f(KD0[o]) * rk), b1 = wave_sum(rv * bf2f(KD1[o]) * rk);
            ov += (b0 + b1) * vv;
            Y[(size_t)r * DM + 512 + c] = (bf16)f2bf(ov * bf2f(GC[o])); }
    }
}

#define LAS __attribute__((address_space(3)))
#define XB_TMO      128
#define XB_XCNT(j)  (256  + 64 * (j))
#define XB_XSUB(j)  (1280 + 64 * (j))
#define XB_XGEN(j)  (2304 + 64 * (j))
#define XB_TOP      3328
#define XB_TOPGEN   3392
#define XCD_BAR_WORDS 3456
#define XB_SPIN_CAP (1u << 18)

__device__ __forceinline__ unsigned xb_ld(unsigned* p)              { return __hip_atomic_load(p, __ATOMIC_RELAXED, __HIP_MEMORY_SCOPE_AGENT); }
__device__ __forceinline__ unsigned xb_add(unsigned* p, unsigned v) { return __hip_atomic_fetch_add(p, v, __ATOMIC_RELAXED, __HIP_MEMORY_SCOPE_AGENT); }
__device__ __forceinline__ unsigned xb_xcc_id() { return (unsigned)__builtin_amdgcn_s_getreg((3 << 11) | 20) & 0xFu; }
#define XB_SPIN(cond, bar) do { unsigned _sp = 0; while (cond) { __builtin_amdgcn_s_sleep(1); \
    if ((++_sp & 255u) == 0u) { if (xb_ld(&(bar)[XB_TMO])) break; if (_sp > XB_SPIN_CAP) { atomicAdd(&(bar)[XB_TMO], 1u); break; } } } } while (0)

struct XcdBarrier {
    unsigned* bar; unsigned x;
    volatile LAS unsigned* st;
};

__device__ __forceinline__ XcdBarrier xcd_barrier_post(unsigned* bar, volatile LAS unsigned* st) {
    XcdBarrier b; b.bar = bar; b.x = xb_xcc_id(); b.st = st;
    if (threadIdx.x == 0) (void)xb_add(&bar[XB_XCNT(b.x)], 1u);
    return b;
}
__device__ __forceinline__ void xcd_barrier_complete(unsigned* bar, unsigned x, unsigned& nloc, unsigned& nx) {
    const unsigned G = gridDim.x * gridDim.y * gridDim.z;
    unsigned sum, cnt, mine, sp = 0u;
    for (;;) {
        sum = 0u; cnt = 0u; mine = 0u;
#pragma unroll
        for (unsigned j = 0; j < 16; ++j) { const unsigned c = xb_ld(&bar[XB_XCNT(j)]); sum += c; cnt += (c > 0u) ? 1u : 0u; mine = (j == x) ? c : mine; }
        if (sum == G) break;
        __builtin_amdgcn_s_sleep(1);
        if ((++sp & 255u) == 0u) { if (xb_ld(&bar[XB_TMO])) break; if (sp > XB_SPIN_CAP) { atomicAdd(&bar[XB_TMO], 1u); break; } }
    }
    nloc = mine > 0u ? mine : 1u; nx = cnt > 0u ? cnt : 1u;
}

__device__ __forceinline__ void xcd_barrier(const XcdBarrier& b) {
    asm volatile("s_waitcnt vmcnt(0)" ::: "memory");
    __syncthreads();
    if (threadIdx.x == 0) {
        unsigned* bar = b.bar;
        __builtin_amdgcn_s_waitcnt(0);
        unsigned nloc = b.st[0], nx = b.st[1];
        if (nloc == 0u) { xcd_barrier_complete(bar, b.x, nloc, nx); b.st[0] = nloc; b.st[1] = nx; }
        const unsigned old = xb_add(&bar[XB_XSUB(b.x)], 1u);
        const unsigned gen = old / nloc;
        if (old + 1u == (gen + 1u) * nloc) {
            __builtin_amdgcn_fence(__ATOMIC_RELEASE, "agent");
            asm volatile("s_waitcnt vmcnt(0)" ::: "memory");
            const unsigned og = xb_add(&bar[XB_TOP], 1u);
            const unsigned tg = og / nx;
            if (og + 1u == (tg + 1u) * nx) xb_add(&bar[XB_TOPGEN], 1u);
            else XB_SPIN(xb_ld(&bar[XB_TOPGEN]) == tg, bar);
            __builtin_amdgcn_fence(__ATOMIC_ACQUIRE, "agent");
            xb_add(&bar[XB_XGEN(b.x)], 1u);
            asm volatile("s_waitcnt vmcnt(0)" ::: "memory");
        } else {
            XB_SPIN(xb_ld(&bar[XB_XGEN(b.x)]) == gen, bar);
            __builtin_amdgcn_fence(__ATOMIC_ACQUIRE, "agent");
            asm volatile("s_waitcnt vmcnt(0)" ::: "memory");
        }
    }
    __syncthreads();
}

__global__ void __launch_bounds__(512, 2) mega(Args a) {
    extern __shared__ __attribute__((aligned(16))) unsigned char lds[];
    cg::grid_group grid = cg::this_grid();
    const int G = gridDim.x;
    PG8_LAS unsigned char* glds = (PG8_LAS unsigned char*)lds;
#define bid lbid()
#define tid ltid()
#define lane (ltid() & 63)
#define wave (__builtin_amdgcn_readfirstlane(ltid() >> 6))
#define gw (lbid() * 8 + __builtin_amdgcn_readfirstlane(ltid() >> 6))
#define NGW (G * 8)
    { volatile LAS unsigned* st0 = (volatile LAS unsigned*)((LAS unsigned char*)lds + 131072); if (threadIdx.x < 4) st0[threadIdx.x] = 0u; }
    __syncthreads();
    const XcdBarrier xbar = xcd_barrier_post((unsigned*)(karg_ws() + 229376), (volatile LAS unsigned*)((LAS unsigned char*)lds + 131072));
#define GSYNC() do { xcd_barrier(xbar); } while (0)

    phase_modgemv(a, (float*)lds, G, bid, tid);
    convert_weights(a, 0, (float*)(lds + 32768) + wave * (64 * 33), gw, NGW, lane, G, bid, tid);
    grid.sync();
#pragma clang loop unroll(full)
    for (int l = 0; l < 2; ++l) {
        if (l > 0) convert_weights(a, l, (float*)lds + wave * (64 * 33), gw, NGW, lane, G, bid, tid);
        phase_modulate(a, l, 0, gw, NGW, lane);
        GSYNC();
        for (int rp = 0; rp < REP_G1; ++rp)
        {
            unsigned char* ws = karg_ws(); float* outp = karg_out(); float* xctx = (float*)(ws + OFF_XCTX); bf16* XM = (bf16*)(ws + OFF_XMY); bf16* HU = (bf16*)(ws + OFF_HU); const float* modl = (const float*)(ws + OFF_MOD) + (size_t)l * 3 * 9216; (void)xctx; (void)XM; (void)HU; (void)modl; (void)outp;
            pg8::Gemm g{XM, (const bf16*)(ws + W_13A), NR, 2 * DFF, DM}; pg8::StaticOrder S; S.init(NR, 2 * DFF, G, bid);
            EpiSwiglu E{HU};
            pg8::gemm_phase<EpiSwiglu, pg8::StaticOrder, true, true>(glds, g, S, E);
        }
        GSYNC();
        {
            unsigned char* ws = karg_ws(); float* outp = karg_out(); float* xctx = (float*)(ws + OFF_XCTX); bf16* XM = (bf16*)(ws + OFF_XMY); bf16* HU = (bf16*)(ws + OFF_HU); const float* modl = (const float*)(ws + OFF_MOD) + (size_t)l * 3 * 9216; (void)xctx; (void)XM; (void)HU; (void)modl; (void)outp;
            pg8::Gemm g{HU, (const bf16*)(ws + W_2A), NR, DM, DFF}; pg8::StaticOrder S; S.init(NR, DM, G, bid);
            EpiResid E{outp, xctx, modl + 2 * 1024, 0.5f, l == 0 ? IN(0) : outp, l == 0 ? IN(2) : xctx};
            pg8::gemm_phase<EpiResid, pg8::StaticOrder, true, true>(glds, g, S, E);
        }
        GSYNC();
        phase_modulate(a, l, 1, gw, NGW, lane);
        GSYNC();
        {
            unsigned char* ws = karg_ws(); float* outp = karg_out(); float* xctx = (float*)(ws + OFF_XCTX); bf16* XM = (bf16*)(ws + OFF_XMY); bf16* HU = (bf16*)(ws + OFF_HU); const float* modl = (const float*)(ws + OFF_MOD) + (size_t)l * 3 * 9216; (void)xctx; (void)XM; (void)HU; (void)modl; (void)outp;
            pg8::Gemm g{XM, (const bf16*)(ws + W_IN), NR, UC, DM}; pg8::StaticOrder S; S.init(NR, UC, G, bid);
            EpiU E{HU, UC};
            pg8::gemm_phase<EpiU, pg8::StaticOrder, true, true>(glds, g, S, E);
        }
        GSYNC();
        for (int rp = 0; rp < REP_M1; ++rp) { phase_m1(a, l, lds, G, bid, tid);
        GSYNC(); }
        for (int rp = 0; rp < REP_M2; ++rp) { phase_m2(a, l, lds, G, bid, tid);
        GSYNC(); }
        for (int rp = 0; rp < REP_M3; ++rp) { phase_m3(a, l, lds, G, bid, tid);
        GSYNC(); }
        for (int rp = 0; rp < REP_SCAN; ++rp) { phase_m4(a, lds, G, bid, tid);
        GSYNC();
        phase_m5(a, lds, G, bid, tid);
        GSYNC();
        phase_m6(a, lds, G, bid, tid);
        GSYNC(); }
        phase_m7(a, l, gw, NGW, lane);
        GSYNC();
        {
            unsigned char* ws = karg_ws(); float* outp = karg_out(); float* xctx = (float*)(ws + OFF_XCTX); bf16* XM = (bf16*)(ws + OFF_XMY); bf16* HU = (bf16*)(ws + OFF_HU); const float* modl = (const float*)(ws + OFF_MOD) + (size_t)l * 3 * 9216; (void)xctx; (void)XM; (void)HU; (void)modl; (void)outp;
            const int MR = (l == 1) ? NLAT : NR;
            pg8::Gemm g{XM, (const bf16*)(ws + W_OUT), MR, DM, DM}; pg8::StaticOrder S; S.init(MR, DM, G, bid);
            EpiResid E{outp, xctx, modl + 5 * 1024, 1.0f, outp, xctx};
            pg8::gemm_phase<EpiResid, pg8::StaticOrder, true, true>(glds, g, S, E);
        }
        GSYNC();
        phase_modulate(a, l, 2, gw, NGW, lane);
        GSYNC();
        {
            unsigned char* ws = karg_ws(); float* outp = karg_out(); float* xctx = (float*)(ws + OFF_XCTX); bf16* XM = (bf16*)(ws + OFF_XMY); bf16* HU = (bf16*)(ws + OFF_HU); const float* modl = (const float*)(ws + OFF_MOD) + (size_t)l * 3 * 9216; (void)xctx; (void)XM; (void)HU; (void)modl; (void)outp;
            const int MR = (l == 1) ? NLAT : NR;
            pg8::Gemm g{XM, (const bf16*)(ws + W_13B), MR, 2 * DFF, DM}; pg8::StaticOrder S; S.init(MR, 2 * DFF, G, bid);
            EpiSwiglu E{HU};
            pg8::gemm_phase<EpiSwiglu, pg8::StaticOrder, true, true>(glds, g, S, E);
        }
        GSYNC();
        {
            unsigned char* ws = karg_ws(); float* outp = karg_out(); float* xctx = (float*)(ws + OFF_XCTX); bf16* XM = (bf16*)(ws + OFF_XMY); bf16* HU = (bf16*)(ws + OFF_HU); const float* modl = (const float*)(ws + OFF_MOD) + (size_t)l * 3 * 9216; (void)xctx; (void)XM; (void)HU; (void)modl; (void)outp;
            const int MR = (l == 1) ? NLAT : NR;
            pg8::Gemm g{HU, (const bf16*)(ws + W_2B), MR, DM, DFF}; pg8::StaticOrder S; S.init(MR, DM, G, bid);
            EpiResid E{outp, xctx, modl + 8 * 1024, 0.5f, outp, xctx};
            pg8::gemm_phase<EpiResid, pg8::StaticOrder, true, true>(glds, g, S, E);
        }
        GSYNC();
    }
    phase_final(a, gw, NGW, lane);
#undef bid
#undef tid
#undef lane
#undef wave
#undef gw
#undef NGW
}

extern "C" void kernel_launch(void* const* d_in, const int* in_sizes, int n_in, void* d_out, int out_size, void* d_ws, size_t ws_size, hipStream_t stream) {
    static int grid = 0;
    if (grid == 0) {
        int dev = 0, cus = 0, per_cu = 0;
        (void)hipGetDevice(&dev);
        (void)hipDeviceGetAttribute(&cus, hipDeviceAttributeMultiprocessorCount, dev);
        (void)hipFuncSetAttribute((const void*)mega, hipFuncAttributeMaxDynamicSharedMemorySize, LDS_BYTES);
        (void)hipOccupancyMaxActiveBlocksPerMultiprocessor(&per_cu, (const void*)mega, 512, LDS_BYTES);
        if (per_cu < 1) per_cu = 1;
        grid = cus * per_cu;
        if (n_in != 40 || ws_size < WS_NEED) { fprintf(stderr, "kernel_launch: unexpected n_in %d / ws %zu (need %zu)\n", n_in, ws_size, (size_t)WS_NEED); }
    }
    (void)hipMemsetAsync((char*)d_ws + OFF_MOD, 0, MOD_BYTES, stream);
    Args a{};
    for (int i = 0; i < 40; ++i) a.in[i] = (const float*)d_in[i];
    a.out = (float*)d_out; a.ws = (unsigned char*)d_ws;
    void* args[] = {&a};
    hipError_t e = hipLaunchCooperativeKernel((const void*)mega, dim3(grid), dim3(512), args, LDS_BYTES, stream);
    if (e != hipSuccess) fprintf(stderr, "cooperative launch failed: %s (grid %d)\n", hipGetErrorString(e), grid);
}
```

```cpp
#include <hip/hip_runtime.h>
#include <hip/hip_cooperative_groups.h>
#include <cstdio>
#include <cstdint>
namespace cg = cooperative_groups;
namespace pg8 {
#define PG8_LAS __attribute__((address_space(3)))
typedef unsigned short bf16_t;
typedef short bf16x8 __attribute__((ext_vector_type(8)));
typedef float f32x4 __attribute__((ext_vector_type(4)));
typedef unsigned u32x4 __attribute__((ext_vector_type(4)));
constexpr int BM = 256, BK = 64, HALF = 128, HTB = HALF * BK * 2  , STAGE_BYTES = 8 * HTB, NXCD = 8, WGM = 8;

__host__ __device__ __forceinline__ int lds_byte(int r, int c) { const int st = (r >> 4) * 2 + (c >> 5), rr = r & 15, cc = c & 31, ob = rr * 64 + cc * 2; return st * 1024 + (ob ^ (((ob >> 9) & 1) << 5)); }
__host__ __device__ __forceinline__ void stage_rc(int b, int& R, int& C) { const int st = b / 1024, sb = b % 1024, swz = sb ^ (((sb >> 9) & 1) << 5); R = (st >> 1) * 16 + swz / 64; C = (st & 1) * 32 + (swz % 64) / 2; }
__host__ __device__ __forceinline__ int perm32(int rho) { const int n = rho >> 4, i = rho & 15; return 8 * (i >> 2) + 4 * n + (i & 3); }

struct Unit { int pm, pn; };
struct Gemm { const bf16_t* A; const bf16_t* Bt; int M, N, K; };

struct StaticOrder {
    int nM, nN, nwg, G, c;
    __host__ __device__ void init(int M, int N, int G_, int c_) { nM = M / BM; nN = N / BM; nwg = nM * nN; G = G_; c = c_; }
    __host__ __device__ bool next(int i, Unit& u) const {
        const long L = (long)i * G + c; if (L >= nwg) return false;
        int wgid = (int)L; { const int q = nwg / NXCD, r = nwg % NXCD, xcd = wgid % NXCD, off = wgid / NXCD; wgid = (xcd < r ? xcd * (q + 1) : r * (q + 1) + (xcd - r) * q) + off; }
        const int nig = WGM * nN, gid = wgid / nig, fm = gid * WGM, gsz = (nM - fm) < WGM ? (nM - fm) : WGM;
        u.pm = fm + ((wgid % nig) % gsz); u.pn = (wgid % nig) / gsz; return true;
    }
    __device__ __forceinline__ void a_ready(const Unit&) const {}
    __device__ __forceinline__ void done(const Unit&) const {}
};

__device__ __forceinline__ unsigned cvt_pk_bf16(float lo, float hi) { unsigned r; asm volatile("v_cvt_pk_bf16_f32 %0, %1, %2" : "=v"(r) : "v"(lo), "v"(hi)); return r; }
typedef float f32x2 __attribute__((ext_vector_type(2)));
template <class Epi, class Sched, bool ALIGN_EPI = false, bool SP2 = false>
__device__ __forceinline__ void gemm_phase(PG8_LAS unsigned char* lds, const Gemm g, const Sched& S, const Epi& E) {
    int tid = threadIdx.x; asm volatile("" : "+v"(tid));
    const int wid = __builtin_amdgcn_readfirstlane(tid >> 6), lane = tid & 63, wr = wid >> 2, wc = wid & 3, fr = lane & 15, fq = lane >> 4;
    const int K = g.K, nt = K / BK;
    unsigned voffA[2], voffB[2];
#pragma unroll
    for (int i = 0; i < 2; ++i) { int R, C; stage_rc(tid * 16 + i * 8192, R, C); const int Rb = Epi::PERM ? ((R & ~31) + perm32(R & 31)) : R;
        voffA[i] = (unsigned)(R * K + C) * 2u; voffB[i] = (unsigned)(Rb * K + C) * 2u; }
    const size_t kstep = (size_t)(BK * 2);
    const size_t hstep = (size_t)HALF * K * 2;
    const size_t tstep = 2 * hstep;
    const unsigned ldsw = (unsigned)wid * 1024u;
    const int aoff = lds_byte(wr * 64 + fr, fq * 8), boff = lds_byte(wc * 32 + fr, fq * 8);
#define PG8_SA(b, h) (((b) * 2 + (h)) * HTB)
#define PG8_SB(b, h) ((4 + (b) * 2 + (h)) * HTB)
#define PG8_STAGE(bufoff, gbase, voff) do { _Pragma("unroll") for (int _i = 0; _i < 2; ++_i) \
        __builtin_amdgcn_global_load_lds((const unsigned*)((const char*)(gbase) + (voff)[_i]), (PG8_LAS unsigned*)(lds + (bufoff) + ldsw + _i * 8192), 16, 0, 0); } while (0)
#define PG8_LDA(dst, b, h) do { _Pragma("unroll") for (int m = 0; m < 4; ++m) _Pragma("unroll") for (int k = 0; k < 2; ++k) dst[m][k] = *(const PG8_LAS bf16x8*)(lds + PG8_SA(b, h) + aoff + m * 2048 + k * 1024); } while (0)
#define PG8_LDB(dst, b, h) do { _Pragma("unroll") for (int n = 0; n < 2; ++n) _Pragma("unroll") for (int k = 0; k < 2; ++k) dst[n][k] = *(const PG8_LAS bf16x8*)(lds + PG8_SB(b, h) + boff + n * 2048 + k * 1024); } while (0)
#define PG8_MMA(ai, bj, At, Bt) do { __builtin_amdgcn_s_setprio(1); _Pragma("unroll") for (int m = 0; m < 4; ++m) _Pragma("unroll") for (int n = 0; n < 2; ++n) _Pragma("unroll") for (int k = 0; k < 2; ++k) \
        acc[ai][bj][m][n] = __builtin_amdgcn_mfma_f32_16x16x32_bf16(Bt[n][k], At[m][k], acc[ai][bj][m][n], 0, 0, 0); __builtin_amdgcn_s_setprio(0); } while (0)
#define PG8_WAIT_V(n) asm volatile("s_waitcnt vmcnt(" #n ")" ::: "memory")
#define PG8_WAIT_L(n) asm volatile("s_waitcnt lgkmcnt(" #n ")" ::: "memory")
#define PG8_BAR __builtin_amdgcn_s_barrier()
#define PG8_SCHED __builtin_amdgcn_sched_barrier(0)
    Unit cur, nxt; int ui = 0;
    if (!S.next(0, cur)) return;
    f32x4 acc[2][2][4][2];
#pragma unroll
    for (int a = 0; a < 2; ++a)
#pragma unroll
        for (int b = 0; b < 2; ++b)
#pragma unroll
            for (int m = 0; m < 4; ++m)
#pragma unroll
                for (int n = 0; n < 2; ++n) acc[a][b][m][n] = (f32x4){0.f, 0.f, 0.f, 0.f};
    bf16x8 At[4][2], B0[2][2], B1[2][2];
    const char* cA = (const char*)g.A + (size_t)cur.pm * tstep; const char* cB = (const char*)g.Bt + (size_t)cur.pn * tstep;
    S.a_ready(cur);
    if constexpr (SP2) {
        PG8_STAGE(PG8_SB(0, 0), cB, voffB); PG8_STAGE(PG8_SB(0, 1), cB + hstep, voffB); PG8_STAGE(PG8_SA(0, 0), cA, voffA); PG8_STAGE(PG8_SA(0, 1), cA + hstep, voffA);
        if (wr == 1) PG8_BAR;
        PG8_WAIT_V(2); PG8_BAR;
        PG8_STAGE(PG8_SB(1, 0), cB + kstep, voffB); PG8_STAGE(PG8_SA(1, 0), cA + kstep, voffA); PG8_STAGE(PG8_SB(1, 1), cB + hstep + kstep, voffB);
        PG8_WAIT_V(6); PG8_BAR;
    } else {
        PG8_STAGE(PG8_SB(0, 0), cB, voffB); PG8_STAGE(PG8_SA(0, 0), cA, voffA); PG8_STAGE(PG8_SB(0, 1), cB + hstep, voffB); PG8_STAGE(PG8_SA(0, 1), cA + hstep, voffA);
        if (wr == 1) PG8_BAR;
        PG8_WAIT_V(4); PG8_BAR;
        PG8_STAGE(PG8_SB(1, 0), cB + kstep, voffB); PG8_STAGE(PG8_SA(1, 0), cA + kstep, voffA); PG8_STAGE(PG8_SB(1, 1), cB + hstep + kstep, voffB);
        PG8_WAIT_V(6); PG8_BAR;
    }
    for (;;) {
        const bool has_next = S.next(ui + 1, nxt);
        const char* nA = has_next ? (const char*)g.A + (size_t)nxt.pm * tstep : cA; const char* nB = has_next ? (const char*)g.Bt + (size_t)nxt.pn * tstep : cB;
        for (int t = 0; t < nt; t += 2) {
            const bool last = (t == nt - 2);
            const char* a1 = cA + (size_t)(t + 1) * kstep;
            const char* a2 = last ? nA : cA + (size_t)(t + 2) * kstep; const char* b2 = last ? nB : cB + (size_t)(t + 2) * kstep;
            const char* a3 = a2 + kstep; const char* b3 = b2 + kstep;
            if (last && has_next) S.a_ready(nxt);
            if constexpr (SP2) {
            PG8_LDB(B0, 0, 0); PG8_LDB(B1, 0, 1); PG8_SCHED; PG8_LDA(At, 0, 0); PG8_STAGE(PG8_SA(1, 1), a1 + hstep, voffA);
            PG8_WAIT_V(8); PG8_WAIT_L(0); PG8_BAR; PG8_MMA(0, 0, At, B0); PG8_MMA(0, 1, At, B1); PG8_BAR; PG8_SCHED;
            PG8_LDA(At, 0, 1); PG8_STAGE(PG8_SB(0, 0), b2, voffB); PG8_STAGE(PG8_SB(0, 1), b2 + hstep, voffB); PG8_STAGE(PG8_SA(0, 0), a2, voffA);
            PG8_WAIT_V(8); PG8_WAIT_L(0); PG8_BAR; PG8_MMA(1, 0, At, B0); PG8_MMA(1, 1, At, B1); PG8_BAR; PG8_SCHED;
            PG8_LDB(B0, 1, 0); PG8_LDB(B1, 1, 1); PG8_SCHED; PG8_LDA(At, 1, 0); PG8_STAGE(PG8_SA(0, 1), a2 + hstep, voffA);
            PG8_WAIT_V(8); PG8_WAIT_L(0); PG8_BAR; PG8_MMA(0, 0, At, B0); PG8_MMA(0, 1, At, B1); PG8_BAR; PG8_SCHED;
            PG8_LDA(At, 1, 1); PG8_STAGE(PG8_SB(1, 0), b3, voffB); PG8_STAGE(PG8_SB(1, 1), b3 + hstep, voffB); PG8_STAGE(PG8_SA(1, 0), a3, voffA);
            PG8_WAIT_V(8); PG8_WAIT_L(0); PG8_BAR; PG8_MMA(1, 0, At, B0); PG8_MMA(1, 1, At, B1); PG8_BAR; PG8_SCHED;
            } else {
            PG8_LDB(B0, 0, 0); PG8_SCHED; PG8_LDA(At, 0, 0); PG8_STAGE(PG8_SA(1, 1), a1 + hstep, voffA);
            PG8_WAIT_L(8); PG8_BAR; PG8_WAIT_L(0); PG8_MMA(0, 0, At, B0); PG8_BAR; PG8_SCHED;
            PG8_LDB(B1, 0, 1); PG8_STAGE(PG8_SB(0, 0), b2, voffB);
            PG8_BAR; PG8_WAIT_L(0); PG8_MMA(0, 1, At, B1); PG8_BAR;
            PG8_LDA(At, 0, 1); PG8_STAGE(PG8_SA(0, 0), a2, voffA);
            PG8_BAR; PG8_WAIT_L(0); PG8_MMA(1, 0, At, B0); PG8_BAR; PG8_SCHED;
            PG8_STAGE(PG8_SB(0, 1), b2 + hstep, voffB);
            PG8_WAIT_V(6); PG8_BAR; PG8_MMA(1, 1, At, B1); PG8_BAR;
            PG8_LDB(B0, 1, 0); PG8_SCHED; PG8_LDA(At, 1, 0); PG8_STAGE(PG8_SA(0, 1), a2 + hstep, voffA);
            PG8_WAIT_L(8); PG8_BAR; PG8_WAIT_L(0); PG8_MMA(0, 0, At, B0); PG8_BAR; PG8_SCHED;
            PG8_LDB(B1, 1, 1); PG8_STAGE(PG8_SB(1, 0), b3, voffB);
            PG8_BAR; PG8_WAIT_L(0); PG8_MMA(0, 1, At, B1); PG8_BAR;
            PG8_LDA(At, 1, 1); PG8_STAGE(PG8_SA(1, 0), a3, voffA);
            PG8_BAR; PG8_WAIT_L(0); PG8_MMA(1, 0, At, B0); PG8_BAR; PG8_SCHED;
            PG8_STAGE(PG8_SB(1, 1), b3 + hstep, voffB);
            PG8_WAIT_V(6); PG8_BAR; PG8_MMA(1, 1, At, B1); PG8_BAR;
            }
        }
        if constexpr (ALIGN_EPI) { if (wr == 0) PG8_BAR; }
        if constexpr (!Epi::AFTER_DRAIN) { E(acc, cur, wr, wc, fr, fq); S.done(cur); }
        if (!has_next) break;
#pragma unroll
        for (int a = 0; a < 2; ++a)
#pragma unroll
            for (int b = 0; b < 2; ++b)
#pragma unroll
                for (int m = 0; m < 4; ++m)
#pragma unroll
                    for (int n = 0; n < 2; ++n) acc[a][b][m][n] = (f32x4){0.f, 0.f, 0.f, 0.f};
        cur = nxt; cA = nA; cB = nB; ++ui;
        if constexpr (ALIGN_EPI) { if (wr == 1) PG8_BAR; }
    }
    PG8_WAIT_V(0);
    if constexpr (!ALIGN_EPI) { if (wr == 0) PG8_BAR; }
    PG8_BAR;
    if constexpr (Epi::AFTER_DRAIN) { E.fused(acc, cur, wr, wc, fr, fq, lds, wid, lane); S.done(cur); }
#undef PG8_SA
#undef PG8_SB
#undef PG8_STAGE
#undef PG8_LDA
#undef PG8_LDB
#undef PG8_MMA
#undef PG8_WAIT_V
#undef PG8_WAIT_L
#undef PG8_BAR
#undef PG8_SCHED
}
}

using pg8::f32x4; using pg8::bf16x8;
typedef unsigned short bf16;
typedef unsigned v4u __attribute__((ext_vector_type(4)));
typedef unsigned v2u __attribute__((ext_vector_type(2)));
typedef short s16x4 __attribute__((ext_vector_type(4)));

constexpr int DM = 1024, TLEN = 8192, CTXL = 256, TT = 8448, NLAT = 16384, NR = 16896, DFF = 2816, UC = 2560, NTILE = 528;
constexpr int NSEG = 64, SEGLEN = 132;
constexpr size_t MiB = 1u << 20;
constexpr size_t A8 = (size_t)NR * 256 * 2;
constexpr size_t OFF_MOD = 0, MOD_BYTES = 256 * 1024;
constexpr size_t OFF_XCTX = MiB / 4, OFF_XMY = 2 * MiB + MiB / 4, OFF_HU = 35 * MiB + MiB / 4, OFF_W = 126 * MiB, OFF_MIX = 167 * MiB, OFF_PR = 266 * MiB;
constexpr size_t W_13A = OFF_W, W_2A = OFF_W + 11 * MiB, W_13B = OFF_W + 16 * MiB + MiB / 2, W_2B = OFF_W + 27 * MiB + MiB / 2,
                 W_IN = OFF_W + 33 * MiB, W_OUT = OFF_W + 38 * MiB, W_UQ = OFF_W + 40 * MiB, W_UKV = OFF_W + 40 * MiB + 256 * 1024,
                 W_WUP = OFF_W + 40 * MiB + 384 * 1024, W_AUP = W_WUP + 65536, W_GUP = W_AUP + 65536, W_LWA = W_GUP + 65536, W_LWX = W_LWA + 65536;
constexpr size_t M_QB = OFF_MIX, M_KB = OFF_MIX + 12976128, M_VT = OFF_MIX + 25952256;
constexpr size_t M_LR0 = OFF_PR, M_LIX0 = OFF_PR + 2 * A8;
constexpr size_t M_SEGA = OFF_HU + 83 * MiB, M_SEGB = M_SEGA + MiB + MiB / 4, M_H0 = M_SEGB + MiB + MiB / 4;
constexpr size_t M_RR = OFF_MIX, M_KK = OFF_MIX + A8, M_VV = OFF_MIX + 2 * A8, M_WW = OFF_MIX + 3 * A8, M_BB = OFF_MIX + 7 * A8, M_KD = OFF_MIX + 9 * A8, M_GC = OFF_MIX + 11 * A8;
constexpr size_t M_YS = OFF_HU, M_PL = OFF_HU + 33 * MiB, M_SINIT = OFF_HU + 65 * MiB;
constexpr size_t M_PR = OFF_PR;
constexpr size_t WS_NEED = OFF_PR + 33 * MiB;
constexpr int LDS_BYTES = 131072 + 1024;
#ifndef REP_M1
#define REP_M1 1
#endif
#ifndef REP_M2
#define REP_M2 1
#endif
#ifndef REP_M3
#define REP_M3 1
#endif
#ifndef REP_SCAN
#define REP_SCAN 1
#endif
#ifndef REP_G1
#define REP_G1 1
#endif
constexpr float QSCALE = 0.10206207261596575f * 1.4426950408889634f;

struct Args { const float* in[40]; float* out; unsigned char* ws; };
typedef const __attribute__((address_space(4))) volatile unsigned long long kargq;
__device__ __forceinline__ const float* karg_in(int i) { kargq* p = (kargq*)__builtin_amdgcn_kernarg_segment_ptr(); return (const float*)p[i]; }
__device__ __forceinline__ float* karg_out() { kargq* p = (kargq*)__builtin_amdgcn_kernarg_segment_ptr(); return (float*)p[40]; }
__device__ __forceinline__ unsigned char* karg_ws() { kargq* p = (kargq*)__builtin_amdgcn_kernarg_segment_ptr(); return (unsigned char*)p[41]; }
#define IN(i) karg_in(i)
__device__ __forceinline__ int ltid() { int t = threadIdx.x; asm volatile("" : "+v"(t)); return t; }
__device__ __forceinline__ int lbid() { int t = blockIdx.x; asm volatile("" : "+s"(t)); return t; }
template <class T> __device__ __forceinline__ T* launder(T* p) { asm volatile("" : "+s"(p)); return p; }

__device__ __forceinline__ float bf2f(bf16 h) { return __uint_as_float((unsigned)h << 16); }
__device__ __forceinline__ unsigned f2bf(float f) { unsigned u = __float_as_uint(f); return (u + 0x7fffu + ((u >> 16) & 1u)) >> 16; }
__device__ __forceinline__ unsigned pk2(float lo, float hi) { return f2bf(lo) | (f2bf(hi) << 16); }
__device__ __forceinline__ float sigm(float x) { return 1.f / (1.f + __expf(-x)); }
__device__ __forceinline__ float siluf_(float x) { return x / (1.f + __expf(-x)); }
__device__ __forceinline__ float tanhf_(float y) { return 1.f - 2.f / (1.f + __expf(2.f * y)); }
__device__ __forceinline__ float geluf_(float x) { return 0.5f * x * (1.f + tanhf_(0.7978845608028654f * (x + 0.044715f * x * x * x))); }
__device__ __forceinline__ float wave_sum(float v) {
#pragma unroll
    for (int o = 1; o < 64; o <<= 1) v += __shfl_xor(v, o);
    return v;
}
struct TileInfo { int b, isctx, t0, seqbase, seqlen; };
__device__ __forceinline__ TileInfo tile_info(int tile) {
    TileInfo ti;
    if (tile < 512) { ti.b = tile >> 8; ti.isctx = 0; ti.t0 = (tile & 255) * 32; ti.seqbase = ti.b * TLEN; ti.seqlen = TLEN; }
    else { const int q = tile - 512; ti.b = q >> 3; ti.isctx = 1; ti.t0 = (q & 7) * 32; ti.seqbase = NLAT + ti.b * CTXL; ti.seqlen = CTXL; }
    return ti;
}

struct EpiSwiglu {
    static constexpr bool PERM = true, AFTER_DRAIN = false;
    bf16* H;
    __device__ __forceinline__ void operator()(const f32x4 (&acc)[2][2][4][2], const pg8::Unit& u, int wr, int wc, int fr, int fq) const {
        int pm = u.pm, pn = u.pn; asm volatile("" : "+s"(pm), "+s"(pn), "+s"(wr), "+s"(wc), "+v"(fr), "+v"(fq));
        bf16* tb = H + (size_t)pm * 256 * DFF + pn * 128;
        const unsigned loff = (unsigned)((wr * 64 + fr) * DFF + wc * 32 + 8 * fq);
#pragma unroll
        for (int ai = 0; ai < 2; ++ai)
#pragma unroll
            for (int m = 0; m < 4; ++m) {
                bf16* rowp = tb + (loff + (unsigned)((ai * 128 + m * 16) * DFF));
                const f32x4 g0 = acc[ai][0][m][0], g1 = acc[ai][0][m][1], u0 = acc[ai][1][m][0], u1 = acc[ai][1][m][1];
                v4u w;
                w.x = pg8::cvt_pk_bf16(siluf_(g0[0]) * u0[0], siluf_(g0[1]) * u0[1]); w.y = pg8::cvt_pk_bf16(siluf_(g0[2]) * u0[2], siluf_(g0[3]) * u0[3]);
                w.z = pg8::cvt_pk_bf16(siluf_(g1[0]) * u1[0], siluf_(g1[1]) * u1[1]); w.w = pg8::cvt_pk_bf16(siluf_(g1[2]) * u1[2], siluf_(g1[3]) * u1[3]);
                *(v4u*)rowp = w;
            }
    }
};
struct EpiU {
    static constexpr bool PERM = true, AFTER_DRAIN = false;
    bf16* O; int ldc;
    __device__ __forceinline__ void operator()(const f32x4 (&acc)[2][2][4][2], const pg8::Unit& u, int wr, int wc, int fr, int fq) const {
        int pm = u.pm, pn = u.pn; asm volatile("" : "+s"(pm), "+s"(pn), "+s"(wr), "+s"(wc), "+v"(fr), "+v"(fq));
        bf16* tb = O + (size_t)pm * 256 * ldc + pn * 256;
        const unsigned loff = (unsigned)((wr * 64 + fr) * ldc + wc * 32 + 8 * fq);
#pragma unroll
        for (int ai = 0; ai < 2; ++ai)
#pragma unroll
            for (int m = 0; m < 4; ++m) {
                bf16* rowp = tb + (loff + (unsigned)((ai * 128 + m * 16) * ldc));
#pragma unroll
                for (int bj = 0; bj < 2; ++bj) { const f32x4 v0 = acc[ai][bj][m][0], v1 = acc[ai][bj][m][1]; v4u w;
                    w.x = pg8::cvt_pk_bf16(v0[0], v0[1]); w.y = pg8::cvt_pk_bf16(v0[2], v0[3]); w.z = pg8::cvt_pk_bf16(v1[0], v1[1]); w.w = pg8::cvt_pk_bf16(v1[2], v1[3]);
                    *(v4u*)(rowp + bj * 128) = w; }
            }
    }
};
struct EpiResid {
    static constexpr bool PERM = false, AFTER_DRAIN = false;
    float* xlat; float* xctx; const float* gate; float coef; const float* slat; const float* sctx;
    __device__ __forceinline__ void operator()(const f32x4 (&acc)[2][2][4][2], const pg8::Unit& u, int wr, int wc, int fr, int fq) const {
        int pm = u.pm, pn = u.pn; asm volatile("" : "+s"(pm), "+s"(pn), "+s"(wr), "+s"(wc), "+v"(fr), "+v"(fq));
        const size_t toff = (pm < 64 ? (size_t)pm : (size_t)(pm - 64)) * 256 * DM + pn * 256;
        float* tb = (pm < 64 ? xlat : xctx) + toff; const float* sb = (pm < 64 ? slat : sctx) + toff;
        const float* g = gate + (pm < 64 ? (pm >> 5) : 2) * 9216 + pn * 256;
        const unsigned coff = (unsigned)(wc * 32 + 4 * fq), loff = (unsigned)((wr * 64 + fr) * DM) + coff;
        f32x4 gv[2][2];
#pragma unroll
        for (int bj = 0; bj < 2; ++bj)
#pragma unroll
            for (int n = 0; n < 2; ++n) gv[bj][n] = coef * *(const f32x4*)(g + (coff + (unsigned)(bj * 128 + n * 16)));
#pragma unroll
        for (int ai = 0; ai < 2; ++ai)
#pragma unroll
            for (int m = 0; m < 4; ++m) {
                float* xr = tb + (loff + (unsigned)((ai * 128 + m * 16) * DM)); const float* sr = sb + (loff + (unsigned)((ai * 128 + m * 16) * DM));
#pragma unroll
                for (int bj = 0; bj < 2; ++bj)
#pragma unroll
                    for (int n = 0; n < 2; ++n) { float* xp = xr + (bj * 128 + n * 16);
                        f32x4 xv = *(const f32x4*)(sr + (bj * 128 + n * 16)); xv += gv[bj][n] * acc[ai][bj][m][n]; *(f32x4*)xp = xv; }
                asm volatile("" ::: "memory");
            }
    }
};

__device__ __forceinline__ void phase_modgemv(const Args& a, float* red, int G, int bid, int tid) {
    const float* c = IN(1); const float* cctx = IN(3); const float* ada_w = IN(4); const float* ada_b = IN(5);
    float* mod = (float*)(karg_ws() + OFF_MOD);
    const int w = tid >> 6, lane = tid & 63;
    for (int u = bid; u < 576; u += G) {
        const int l = u / 288, rem = u % 288, jt = rem >> 3, ks = rem & 7;
        const int kb = ks * 128 + w * 16, j0 = jt * 256 + lane * 4;
        f32x4 acc0 = {0.f, 0.f, 0.f, 0.f}, acc1 = acc0, acc2 = acc0;
        for (int kk = 0; kk < 16; ++kk) { const int k = kb + kk;
            const float s0 = siluf_(c[k]), s1 = siluf_(c[1024 + k]), s2 = siluf_(cctx[k]);
            const f32x4 wv = *(const f32x4*)(ada_w + ((size_t)(l * 1024 + k)) * 9216 + j0);
            acc0 += s0 * wv; acc1 += s1 * wv; acc2 += s2 * wv; }
        float* rp = red + (w * 3) * 256 + lane * 4;
        *(f32x4*)rp = acc0; *(f32x4*)(rp + 256) = acc1; *(f32x4*)(rp + 512) = acc2;
        __syncthreads();
        for (int o = tid; o < 768; o += 512) { const int m = o >> 8, jj = o & 255; float s = 0.f;
#pragma unroll
            for (int ww = 0; ww < 8; ++ww) s += red[(ww * 3 + m) * 256 + jj];
            const int j = jt * 256 + jj; if (ks == 0) s += ada_b[l * 9216 + j];
            atomicAdd(&mod[(l * 3 + m) * 9216 + j], s); }
        __syncthreads();
    }
}
__device__ __forceinline__ void phase_copy(const Args& a, int G, int bid, int tid) {
    const f32x4* x4 = (const f32x4*)IN(0); f32x4* o4 = (f32x4*)karg_out();
    for (int i = bid * 512 + tid; i < NLAT * DM / 4; i += G * 512) o4[i] = x4[i];
    const f32x4* c4 = (const f32x4*)IN(2); f32x4* xc4 = (f32x4*)(karg_ws() + OFF_XCTX);
    for (int i = bid * 512 + tid; i < 512 * DM / 4; i += G * 512) xc4[i] = c4[i];
}
__device__ __forceinline__ int swiglu_map(int n) { return n < DFF ? ((n >> 7) * 256 + (n & 127)) : ((((n - DFF) >> 7) * 256) + 128 + ((n - DFF) & 127)); }
__device__ __forceinline__ void transpose_item(const float* W, int K, int N, bf16* WT, float* scr, int item, int lane, int mode, const float* kscale) {
    const int nblk = N / 32, kb = item / nblk, nb = item % nblk, k0 = 64 * kb, n0 = 32 * nb;
    float tv[32];
#pragma unroll
    for (int i = 0; i < 32; ++i) { const int kk = 2 * i + (lane >> 5); tv[i] = W[(size_t)(k0 + kk) * N + n0 + (lane & 31)]; }
#pragma unroll
    for (int i = 0; i < 32; ++i) { const int kk = 2 * i + (lane >> 5); float v = tv[i]; if (kscale) v *= kscale[k0 + kk]; scr[kk * 33 + (lane & 31)] = v; }
    __builtin_amdgcn_wave_barrier();
    const int c = lane & 7;
#pragma unroll
    for (int j = 0; j < 4; ++j) { const int n = (lane >> 3) + 8 * j; const float* s = scr + (8 * c) * 33 + n;
        v4u o; o.x = pk2(s[0 * 33], s[1 * 33]); o.y = pk2(s[2 * 33], s[3 * 33]); o.z = pk2(s[4 * 33], s[5 * 33]); o.w = pk2(s[6 * 33], s[7 * 33]);
        const int nn = n0 + n, drow = mode ? swiglu_map(nn) : nn;
        *(v4u*)(WT + (size_t)drow * K + k0 + 8 * c) = o; }
    __builtin_amdgcn_wave_barrier();
}
__device__ __forceinline__ void convert_weights(const Args& a, int l, float* scr, int gw, int NGW, int lane, int G, int bid, int tid) {
    constexpr int I13 = 16 * 176, I2 = 44 * 32, IIN = 16 * 77, IOUT = 16 * 32, IUQ = 4 * 12, IUKV = 2 * 16;
    constexpr int IEX = 80;
    constexpr int NIT = 2 * I13 + 2 * I2 + IIN + IOUT + IUQ + IUKV + IEX;
    unsigned char* ws = karg_ws();
    for (int it = gw; it < NIT; it += NGW) {
        int r = it;
        if (r < I13) { transpose_item(IN(6) + (size_t)l * DM * 2 * DFF, DM, 2 * DFF, (bf16*)(ws + W_13A), scr, r, lane, 1, nullptr); continue; } r -= I13;
        if (r < I13) { transpose_item(IN(8) + (size_t)l * DM * 2 * DFF, DM, 2 * DFF, (bf16*)(ws + W_13B), scr, r, lane, 1, nullptr); continue; } r -= I13;
        if (r < I2) { transpose_item(IN(7) + (size_t)l * DFF * DM, DFF, DM, (bf16*)(ws + W_2A), scr, r, lane, 0, nullptr); continue; } r -= I2;
        if (r < I2) { transpose_item(IN(9) + (size_t)l * DFF * DM, DFF, DM, (bf16*)(ws + W_2B), scr, r, lane, 0, nullptr); continue; } r -= I2;
        if (r < IIN) { transpose_item(IN(10) + (size_t)l * DM * 2464, DM, 2464, (bf16*)(ws + W_IN), scr, r, lane, 0, nullptr); continue; } r -= IIN;
        if (r < IOUT) { transpose_item(IN(11) + (size_t)l * DM * DM, DM, DM, (bf16*)(ws + W_OUT), scr, r, lane, 0, nullptr); continue; } r -= IOUT;
        if (r < IUQ) { transpose_item(IN(36) + (size_t)l * 256 * 384, 256, 384, (bf16*)(ws + W_UQ), scr, r, lane, 0, IN(35) + l * 256); continue; } r -= IUQ;
        if (r < IUKV) { transpose_item(IN(38) + (size_t)l * 128 * 512, 128, 512, (bf16*)(ws + W_UKV), scr, r, lane, 0, IN(37) + l * 128); continue; } r -= IUKV;
        if (r < 16) { const int d = r >> 3; transpose_item(IN(26) + (size_t)(l * 2 + d) * 64 * 256, 64, 256, (bf16*)(ws + W_WUP) + d * 256 * 64, scr, r & 7, lane, 0, nullptr); continue; } r -= 16;
        if (r < 16) { const int d = r >> 3; transpose_item(IN(28) + (size_t)(l * 2 + d) * 64 * 256, 64, 256, (bf16*)(ws + W_AUP) + d * 256 * 64, scr, r & 7, lane, 0, nullptr); continue; } r -= 16;
        if (r < 16) { transpose_item(IN(29) + (size_t)l * 128 * 256, 128, 256, (bf16*)(ws + W_GUP), scr, r, lane, 0, nullptr); continue; } r -= 16;
        if (r < 16) { const int m = r >> 1; transpose_item(IN(18) + (size_t)(l * 8 + m) * 4096, 64, 64, (bf16*)(ws + W_LWA) + m * 4096, scr, r & 1, lane, 0, nullptr); continue; } r -= 16;
        { const int m = r >> 1; transpose_item(IN(20) + (size_t)(l * 8 + m) * 4096, 64, 64, (bf16*)(ws + W_LWX) + m * 4096, scr, r & 1, lane, 0, nullptr); }
    }
    v4u z = {0u, 0u, 0u, 0u}; v4u* zp = (v4u*)(ws + W_IN + (size_t)2464 * DM * 2);
    for (int i = bid * 512 + tid; i < 96 * DM * 2 / 16; i += G * 512) zp[i] = z;
}
__device__ __forceinline__ void phase_modulate(const Args& a, int l, int which, int gw, int NGW, int lane) {
    unsigned char* ws = karg_ws(); const float* outp = karg_out();
    const bool first = (l == 0 && which == 0);
    const float* srcl = first ? IN(0) : outp; const float* srcc = first ? IN(2) : (const float*)(ws + OFF_XCTX);
    const float* mod = (const float*)(ws + OFF_MOD) + (size_t)l * 3 * 9216;
    bf16* XM = (bf16*)(ws + OFF_XMY);
    for (int r = gw; r < NR; r += NGW) {
        const float* xr = r < NLAT ? srcl + (size_t)r * DM : srcc + (size_t)(r - NLAT) * DM;
        const float* mm = mod + (r < NLAT ? (r >> 13) : 2) * 9216 + which * 3 * 1024;
        f32x4 v[4]; float ss = 0.f;
#pragma unroll
        for (int j = 0; j < 4; ++j) { v[j] = *(const f32x4*)(xr + 4 * lane + 256 * j); ss += (v[j][0] * v[j][0] + v[j][1] * v[j][1]) + (v[j][2] * v[j][2] + v[j][3] * v[j][3]); }
        const float rstd = rsqrtf(wave_sum(ss) * (1.f / DM) + 1e-6f);
#pragma unroll
        for (int j = 0; j < 4; ++j) { const int c = 4 * lane + 256 * j; const f32x4 sh = *(const f32x4*)(mm + c), sc = *(const f32x4*)(mm + 1024 + c);
            const f32x4 o = v[j] * rstd * (1.f + sc) + sh; v2u w; w.x = pk2(o[0], o[1]); w.y = pk2(o[2], o[3]);
            *(v2u*)(XM + (size_t)r * DM + c) = w; }
    }
}
__device__ __forceinline__ void phase_final(const Args& a, int gw, int NGW, int lane) {
    const float* fn = IN(39); float* outp = karg_out();
    for (int r = gw; r < NLAT; r += NGW) {
        float* xr = outp + (size_t)r * DM; f32x4 v[4]; float ss = 0.f;
#pragma unroll
        for (int j = 0; j < 4; ++j) { v[j] = *(const f32x4*)(xr + 4 * lane + 256 * j); ss += (v[j][0] * v[j][0] + v[j][1] * v[j][1]) + (v[j][2] * v[j][2] + v[j][3] * v[j][3]); }
        const float rstd = rsqrtf(wave_sum(ss) * (1.f / DM) + 1e-6f);
#pragma unroll
        for (int j = 0; j < 4; ++j) { const int c = 4 * lane + 256 * j; const f32x4 g = *(const f32x4*)(fn + c); *(f32x4*)(xr + c) = v[j] * rstd * g; }
    }
}

__device__ __forceinline__ void phase_m1(const Args& a, int l, unsigned char* lds, int G, int bid, int tid_unused) {
    unsigned char* ws = karg_ws();
    const bf16* U = (const bf16*)(ws + OFF_HU);
    bf16* Y = (bf16*)(ws + OFF_XMY);
    for (int tile = bid; tile < NTILE; tile += G) {
        const TileInfo ti = tile_info(tile);
        const int row0 = tile * 32;
        {
            const int tid = ltid(); const int lane = tid & 63, wave = __builtin_amdgcn_readfirstlane(tid >> 6), ch = tid & 255, part = tid >> 8; (void)lane; (void)wave; (void)ch; (void)part;
            float* z = (float*)lds;
            float* cv = (float*)(lds + 65536);
            for (int tt = part; tt < 62; tt += 2) { const int t = ti.t0 - 15 + tt; float zz = 0.f;
                if (t >= 0 && t < ti.seqlen) { const bf16* ur = U + (size_t)(ti.seqbase + t) * UC; zz = bf2f(ur[ch]) * sigm(bf2f(ur[256 + ch])); }
                z[tt * 256 + ch] = zz; }
            __syncthreads();
            const float* dw = IN(12) + (size_t)l * 31 * 256 + ch;
            float acc[16]; const float bias = IN(13)[l * 256 + ch];
#pragma unroll
            for (int o = 0; o < 16; ++o) acc[o] = bias;
            for (int j = 0; j < 31; ++j) { const float w = dw[j * 256];
#pragma unroll
                for (int o = 0; o < 16; ++o) acc[o] += w * z[(part * 16 + o + j) * 256 + ch]; }
#pragma unroll
            for (int o = 0; o < 16; ++o) cv[(part * 16 + o) * 256 + ch] = acc[o];
            __syncthreads();
            const f32x4 lg = *(const f32x4*)(IN(14) + l * 256 + lane * 4), lb = *(const f32x4*)(IN(15) + l * 256 + lane * 4);
#pragma unroll
            for (int q = 0; q < 4; ++q) { const int t = wave * 4 + q; const f32x4 v = *(const f32x4*)(cv + t * 256 + lane * 4);
                const float mu = wave_sum((v[0] + v[1]) + (v[2] + v[3])) * (1.f / 256.f);
                const f32x4 dv = v - mu; const float var = wave_sum((dv[0] * dv[0] + dv[1] * dv[1]) + (dv[2] * dv[2] + dv[3] * dv[3])) * (1.f / 256.f);
                const f32x4 yn = dv * rsqrtf(var + 1e-5f) * lg + lb;
                v2u w; w.x = pk2(siluf_(yn[0]), siluf_(yn[1])); w.y = pk2(siluf_(yn[2]), siluf_(yn[3]));
                *(v2u*)(Y + (size_t)(row0 + t) * DM + lane * 4) = w; }
            __syncthreads();
        }
        {
            float* xvf = (float*)lds;
            bf16* xvb = (bf16*)(lds + 32768);
            bf16* rg = (bf16*)(lds + 49664);
            bf16* ixg = (bf16*)(lds + 82432);
            {
                const int tid = ltid(); const int ch = tid & 255, part = tid >> 8;
                const float* cw = IN(16) + (size_t)l * 4 * 256 + ch; const float w0 = cw[0], w1 = cw[256], w2 = cw[512], w3 = cw[768], cb = IN(17)[l * 256 + ch];
                float xin[19];
#pragma unroll
                for (int i = 0; i < 19; ++i) { const int t = ti.t0 + part * 16 + i - 2; xin[i] = (t >= 0 && t < ti.seqlen) ? bf2f(U[(size_t)(ti.seqbase + t) * UC + 512 + ch]) : 0.f; }
#pragma unroll
                for (int o = 0; o < 16; ++o) { const int tl = part * 16 + o;
                    const float v = cb + w0 * xin[o] + w1 * xin[o + 1] + w2 * xin[o + 2] + w3 * xin[o + 3];
                    xvf[tl * 256 + ch] = v; xvb[tl * 264 + ch] = (bf16)f2bf(v);
                }
            }
            __syncthreads();
            {
                const int tid = ltid(); const int ln = tid & 63, wv = __builtin_amdgcn_readfirstlane(tid >> 6), fr = ln & 15, fq = ln >> 4, blk = wv >> 1;
                const bf16* LWAt = (const bf16*)(ws + W_LWA); const bf16* LWXt = (const bf16*)(ws + W_LWX);
                bf16x8 af[2][2];
#pragma unroll
                for (int mt = 0; mt < 2; ++mt)
#pragma unroll
                    for (int ks = 0; ks < 2; ++ks) af[mt][ks] = *(const bf16x8*)(xvb + (mt * 16 + fr) * 264 + blk * 64 + ks * 32 + fq * 8);
#pragma unroll 1
                for (int dn = 0; dn < 4; ++dn) { const int d = dn >> 1, nt = wv * 2 + (dn & 1), ch = nt * 16 + fr, jj = (nt & 3) * 16 + fr;
                    f32x4 ca[2], cx[2];
#pragma unroll
                    for (int mt = 0; mt < 2; ++mt) { ca[mt] = (f32x4){0.f, 0.f, 0.f, 0.f}; cx[mt] = ca[mt]; }
#pragma unroll
                    for (int ks = 0; ks < 2; ++ks) { const size_t wo = ((size_t)(d * 4 + blk) * 64 + jj) * 64 + ks * 32 + fq * 8;
                        const bf16x8 ba = *(const bf16x8*)(LWAt + wo), bx = *(const bf16x8*)(LWXt + wo);
#pragma unroll
                        for (int mt = 0; mt < 2; ++mt) { ca[mt] = __builtin_amdgcn_mfma_f32_16x16x32_bf16(af[mt][ks], ba, ca[mt], 0, 0, 0); cx[mt] = __builtin_amdgcn_mfma_f32_16x16x32_bf16(af[mt][ks], bx, cx[mt], 0, 0, 0); } }
                    const float bga = IN(19)[(l * 2 + d) * 256 + ch], bgx = IN(21)[(l * 2 + d) * 256 + ch];
                    bf16* LR = (bf16*)(ws + M_LR0 + (size_t)d * A8); bf16* LIX = (bf16*)(ws + M_LIX0 + (size_t)d * A8);
#pragma unroll
                    for (int mt = 0; mt < 2; ++mt)
#pragma unroll
                        for (int j = 0; j < 4; ++j) { const int t = mt * 16 + fq * 4 + j;
                            const bf16 rb = (bf16)f2bf(sigm(ca[mt][j] + bga)), ib = (bf16)f2bf(sigm(cx[mt][j] + bgx) * xvf[t * 256 + ch]);
                            LR[(size_t)(row0 + t) * 256 + ch] = rb; LIX[(size_t)(row0 + t) * 256 + ch] = ib;
                            rg[(d * 32 + t) * 256 + ch] = rb; ixg[(d * 32 + t) * 256 + ch] = ib; }
                }
            }
            __syncthreads();
            {
                const int tid = ltid(); const int ch = tid & 255, d = tid >> 8;
                const float lam = IN(22)[(l * 2 + d) * 256 + ch];
                const float cch = -8.f * log1pf(__expf(-lam));
                float A = 1.f, B = 0.f;
#pragma unroll 8
                for (int tt = 0; tt < 32; ++tt) { const int t = d ? 31 - tt : tt;
                    const float al = __expf(cch * bf2f(rg[(d * 32 + t) * 256 + ch])); const float bb = sqrtf(fmaxf(1.f - al * al, 0.f)) * bf2f(ixg[(d * 32 + t) * 256 + ch]); B = al * B + bb; A *= al; }
                ((float*)(ws + M_SEGA))[(size_t)(tile * 2 + d) * 256 + ch] = A;
                ((float*)(ws + M_SEGB))[(size_t)(tile * 2 + d) * 256 + ch] = B;
            }
            __syncthreads();
        }
        {
            const int tid = ltid(); const int lane = tid & 63, wave = __builtin_amdgcn_readfirstlane(tid >> 6), ch = tid & 255, part = tid >> 8; (void)lane; (void)wave; (void)ch; (void)part;
            bf16* As = (bf16*)lds;
            float* kr = (float*)(lds + 32768);
            float* rs = (float*)(lds + 32768 + 4096);
            for (int idx = tid; idx < 32 * 52; idx += 512) { const int t = idx / 52, cc = idx % 52;
                const v4u v = *(const v4u*)(U + (size_t)(row0 + t) * UC + 2048 + cc * 8);
                if (cc < 48) *(v4u*)(As + t * 392 + cc * 8) = v;
                else { const int c0 = (cc - 48) * 8; float* kp = kr + t * 32 + c0;
                    kp[0] = __uint_as_float(v.x << 16); kp[1] = __uint_as_float(v.x & 0xffff0000u); kp[2] = __uint_as_float(v.y << 16); kp[3] = __uint_as_float(v.y & 0xffff0000u);
                    kp[4] = __uint_as_float(v.z << 16); kp[5] = __uint_as_float(v.z & 0xffff0000u); kp[6] = __uint_as_float(v.w << 16); kp[7] = __uint_as_float(v.w & 0xffff0000u); } }
            __syncthreads();
#pragma unroll
            for (int q = 0; q < 4; ++q) { const int t = wave * 4 + q; float sq = 0.f, sk = 0.f;
#pragma unroll
                for (int j = 0; j < 4; ++j) { const float v = bf2f(As[t * 392 + lane + 64 * j]); sq += v * v; }
#pragma unroll
                for (int j = 0; j < 2; ++j) { const float v = bf2f(As[t * 392 + 256 + lane + 64 * j]); sk += v * v; }
                sq = wave_sum(sq); sk = wave_sum(sk);
                if (lane == 0) { rs[t * 2] = rsqrtf(sq * (1.f / 256.f) + 1e-6f); rs[t * 2 + 1] = rsqrtf(sk * (1.f / 128.f) + 1e-6f); } }
            __syncthreads();
            const int fr = lane & 15, fq = lane >> 4;
            bf16* QB = (bf16*)(ws + M_QB); bf16* KB = (bf16*)(ws + M_KB); bf16* VT = (bf16*)(ws + M_VT);
            const bf16* WUQ = (const bf16*)(ws + W_UQ); const bf16* WUKV = (const bf16*)(ws + W_UKV);
            const int keybase = ti.isctx ? TLEN : 0;
#pragma unroll 1
            for (int i = 0; i < 3; ++i) { const int nt = wave * 3 + i;
                f32x4 c0 = {0.f, 0.f, 0.f, 0.f}, c1 = c0;
#pragma unroll
                for (int ks = 0; ks < 8; ++ks) { const bf16x8 bfr = *(const bf16x8*)(WUQ + (size_t)(nt * 16 + fr) * 256 + ks * 32 + fq * 8);
                    const bf16x8 a0 = *(const bf16x8*)(As + fr * 392 + ks * 32 + fq * 8), a1 = *(const bf16x8*)(As + (16 + fr) * 392 + ks * 32 + fq * 8);
                    c0 = __builtin_amdgcn_mfma_f32_16x16x32_bf16(a0, bfr, c0, 0, 0, 0); c1 = __builtin_amdgcn_mfma_f32_16x16x32_bf16(a1, bfr, c1, 0, 0, 0); }
                const int hq = nt / 6, wt = nt % 6, dd = wt * 16 + fr;
#pragma unroll
                for (int mt = 0; mt < 2; ++mt)
#pragma unroll
                    for (int j = 0; j < 4; ++j) { const int tl = mt * 16 + fq * 4 + j; const int t = ti.t0 + tl;
                        float v = (mt ? c1[j] : c0[j]) * rs[tl * 2];
                        const float pv = __shfl_xor(v, 8);
                        if (wt >= 4 && !ti.isctx) { const int f = fr & 7; const float pos = (wt == 4) ? (float)(t >> 6) : (float)(t & 63);
                            const float ang = pos * __expf(-(float)f * (9.210340371976184f / 8.f)); float sn, cs; __sincosf(ang, &sn, &cs);
                            v = (fr & 8) ? (v * cs + pv * sn) : (v * cs - pv * sn); }
                        QB[((size_t)(ti.b * 4 + hq) * TT + keybase + t) * 96 + dd] = (bf16)f2bf(v * QSCALE); } }
#pragma unroll 1
            for (int i = 0; i < 4; ++i) { const int nt = wave * 4 + i;
                f32x4 c0 = {0.f, 0.f, 0.f, 0.f}, c1 = c0;
#pragma unroll
                for (int ks = 0; ks < 4; ++ks) { const bf16x8 bfr = *(const bf16x8*)(WUKV + (size_t)(nt * 16 + fr) * 128 + ks * 32 + fq * 8);
                    const bf16x8 a0 = *(const bf16x8*)(As + fr * 392 + 256 + ks * 32 + fq * 8), a1 = *(const bf16x8*)(As + (16 + fr) * 392 + 256 + ks * 32 + fq * 8);
                    c0 = __builtin_amdgcn_mfma_f32_16x16x32_bf16(a0, bfr, c0, 0, 0, 0); c1 = __builtin_amdgcn_mfma_f32_16x16x32_bf16(a1, bfr, c1, 0, 0, 0); }
                const int hk = nt >> 3, wt = nt & 7;
#pragma unroll
                for (int mt = 0; mt < 2; ++mt)
#pragma unroll
                    for (int j = 0; j < 4; ++j) { const int tl = mt * 16 + fq * 4 + j; const int key = keybase + ti.t0 + tl;
                        const float v = (mt ? c1[j] : c0[j]) * rs[tl * 2 + 1];
                        if (wt < 4) KB[((size_t)(ti.b * 4 + hk) * TT + key) * 96 + wt * 16 + fr] = (bf16)f2bf(v);
                        else VT[((size_t)(ti.b * 4 + hk) * 64 + (wt - 4) * 16 + fr) * TT + key] = (bf16)f2bf(v); } }
            { const int tl = tid >> 4, p = tid & 15, ax = p >> 3, f = p & 7; const int t = ti.t0 + tl;
                float x0 = kr[tl * 32 + ax * 16 + f], x1 = kr[tl * 32 + ax * 16 + 8 + f];
                if (!ti.isctx) { const float pos = ax == 0 ? (float)(t >> 6) : (float)(t & 63); const float ang = pos * __expf(-(float)f * (9.210340371976184f / 8.f));
                    float sn, cs; __sincosf(ang, &sn, &cs); const float y0 = x0 * cs - x1 * sn, y1 = x1 * cs + x0 * sn; x0 = y0; x1 = y1; }
                const bf16 b0 = (bf16)f2bf(x0), b1 = (bf16)f2bf(x1);
#pragma unroll
                for (int h = 0; h < 4; ++h) { bf16* kp = KB + ((size_t)(ti.b * 4 + h) * TT + keybase + t) * 96 + 64 + ax * 16 + f; kp[0] = b0; kp[8] = b1; } }
            __syncthreads();
        }
    }
}

__device__ __forceinline__ void attn_unit(unsigned char* lds, const bf16* QB, const bf16* KB, const bf16* VT, bf16* Y, int b, int h, int q0, int key_lo, int nkt, int tid) {
    const int lane = tid & 63, wave = tid >> 6, fr = lane & 15, fq = lane >> 4;
    const int bh = b * 4 + h;
    constexpr int KSTR = 104, VSTR = 72, KBUF = 64 * KSTR, VBUF = 64 * VSTR;
    bf16* Ks = (bf16*)lds;
    bf16* Vs = (bf16*)lds + 2 * KBUF;
    const int qw = q0 + wave * 32;
    bf16x8 qf[2][3];
#pragma unroll
    for (int qt = 0; qt < 2; ++qt)
#pragma unroll
        for (int ks = 0; ks < 3; ++ks) qf[qt][ks] = *(const bf16x8*)(QB + ((size_t)bh * TT + qw + qt * 16 + fr) * 96 + ks * 32 + fq * 8);
    float mrun[2] = {-1e30f, -1e30f}, lrun[2] = {0.f, 0.f};
    f32x4 o[4][2];
#pragma unroll
    for (int dt = 0; dt < 4; ++dt)
#pragma unroll
        for (int qt = 0; qt < 2; ++qt) o[dt][qt] = (f32x4){0.f, 0.f, 0.f, 0.f};
    const v4u* kg = (const v4u*)(KB + ((size_t)bh * TT + key_lo) * 96);
    const bf16* vg = VT + ((size_t)bh * 64 + (tid >> 3)) * TT + key_lo + (tid & 7) * 8;
    const int kc0 = tid, kc1 = 512 + tid;
    const int ko0 = (kc0 / 12) * KSTR + (kc0 % 12) * 8, ko1 = (kc1 / 12) * KSTR + (kc1 % 12) * 8, vo = (tid >> 3) * VSTR + (tid & 7) * 8;
    v4u rk0, rk1 = {0u, 0u, 0u, 0u}, rv;
    rk0 = kg[kc0]; if (tid < 256) rk1 = kg[kc1]; rv = *(const v4u*)vg;
    *(v4u*)(Ks + ko0) = rk0; if (tid < 256) *(v4u*)(Ks + ko1) = rk1; *(v4u*)(Vs + vo) = rv;
    __syncthreads();
    for (int kt = 0; kt < nkt; ++kt) {
        const int cur = kt & 1;
        if (kt + 1 < nkt) { const v4u* kn = kg + (size_t)(kt + 1) * 768; rk0 = kn[kc0]; if (tid < 256) rk1 = kn[kc1]; rv = *(const v4u*)(vg + (kt + 1) * 64); }
        const bf16* kb = Ks + cur * KBUF; const bf16* vb = Vs + cur * VBUF;
        f32x4 st[4][2];
#pragma unroll
        for (int k4 = 0; k4 < 4; ++k4) {
            st[k4][0] = (f32x4){0.f, 0.f, 0.f, 0.f}; st[k4][1] = st[k4][0];
#pragma unroll
            for (int ks = 0; ks < 3; ++ks) { const bf16x8 kf = *(const bf16x8*)(kb + (k4 * 16 + fr) * KSTR + ks * 32 + fq * 8);
                st[k4][0] = __builtin_amdgcn_mfma_f32_16x16x32_bf16(kf, qf[0][ks], st[k4][0], 0, 0, 0);
                st[k4][1] = __builtin_amdgcn_mfma_f32_16x16x32_bf16(kf, qf[1][ks], st[k4][1], 0, 0, 0); }
        }
        bf16x8 pb[2][2];
#pragma unroll
        for (int qt = 0; qt < 2; ++qt) {
            float mx = st[0][qt][0];
#pragma unroll
            for (int k4 = 0; k4 < 4; ++k4)
#pragma unroll
                for (int j = 0; j < 4; ++j) mx = fmaxf(mx, st[k4][qt][j]);
            mx = fmaxf(mx, __shfl_xor(mx, 16)); mx = fmaxf(mx, __shfl_xor(mx, 32));
            const float mn = fmaxf(mrun[qt], mx), alpha = __builtin_amdgcn_exp2f(mrun[qt] - mn); mrun[qt] = mn;
            float ls = 0.f;
#pragma unroll
            for (int k4 = 0; k4 < 4; ++k4)
#pragma unroll
                for (int j = 0; j < 4; ++j) { const float p = __builtin_amdgcn_exp2f(st[k4][qt][j] - mn); st[k4][qt][j] = p; ls += p; }
            lrun[qt] = lrun[qt] * alpha + ls;
#pragma unroll
            for (int dt = 0; dt < 4; ++dt) o[dt][qt] *= alpha;
#pragma unroll
            for (int u = 0; u < 2; ++u) { v4u w;
                w.x = pg8::cvt_pk_bf16(st[2 * u][qt][0], st[2 * u][qt][1]); w.y = pg8::cvt_pk_bf16(st[2 * u][qt][2], st[2 * u][qt][3]);
                w.z = pg8::cvt_pk_bf16(st[2 * u + 1][qt][0], st[2 * u + 1][qt][1]); w.w = pg8::cvt_pk_bf16(st[2 * u + 1][qt][2], st[2 * u + 1][qt][3]);
                pb[u][qt] = __builtin_bit_cast(bf16x8, w); }
        }
#pragma unroll
        for (int dt = 0; dt < 4; ++dt)
#pragma unroll
            for (int u = 0; u < 2; ++u) {
                const v2u lo = *(const v2u*)(vb + (dt * 16 + fr) * VSTR + 32 * u + 4 * fq), hi = *(const v2u*)(vb + (dt * 16 + fr) * VSTR + 32 * u + 16 + 4 * fq);
                v4u vw; vw.x = lo.x; vw.y = lo.y; vw.z = hi.x; vw.w = hi.y;
                const bf16x8 va = __builtin_bit_cast(bf16x8, vw);
                o[dt][0] = __builtin_amdgcn_mfma_f32_16x16x32_bf16(va, pb[u][0], o[dt][0], 0, 0, 0);
                o[dt][1] = __builtin_amdgcn_mfma_f32_16x16x32_bf16(va, pb[u][1], o[dt][1], 0, 0, 0);
            }
        if (kt + 1 < nkt) { const int nb = cur ^ 1; *(v4u*)(Ks + nb * KBUF + ko0) = rk0; if (tid < 256) *(v4u*)(Ks + nb * KBUF + ko1) = rk1; *(v4u*)(Vs + nb * VBUF + vo) = rv; }
        __syncthreads();
    }
#pragma unroll
    for (int qt = 0; qt < 2; ++qt) {
        float lt = lrun[qt]; lt += __shfl_xor(lt, 16); lt += __shfl_xor(lt, 32);
        const float inv = 1.f / lt;
        const int q = qw + qt * 16 + fr;
        const size_t row = q < TLEN ? (size_t)b * TLEN + q : (size_t)NLAT + b * CTXL + (q - TLEN);
#pragma unroll
        for (int dt = 0; dt < 4; ++dt) { const f32x4 v = o[dt][qt] * inv; v2u w; w.x = pk2(v[0], v[1]); w.y = pk2(v[2], v[3]);
            *(v2u*)(Y + row * DM + 768 + h * 64 + dt * 16 + fq * 4) = w; }
    }
}
__device__ __forceinline__ void lru_prefix(int bd, int tid) {
    unsigned char* ws = karg_ws();
    if (tid >= 256) return;
    const int ch = tid, b = bd >> 1, d = bd & 1;
    const float* __restrict__ SA = (const float*)(ws + M_SEGA); const float* __restrict__ SB = (const float*)(ws + M_SEGB); float* __restrict__ H0 = (float*)(ws + M_H0);
    const int ctile0 = 512 + b * 8, ltile0 = b * 256;
#define LRU_TILE(i_) ((i_) < 8 ? ctile0 + (d ? 7 - (i_) : (i_)) : ltile0 + (d ? 255 - ((i_) - 8) : ((i_) - 8)))
    float hst = 0.f;
    float ca[24], cb[24], na[24], nb[24];
#pragma unroll
    for (int k = 0; k < 24; ++k) { const size_t o = (size_t)(LRU_TILE(k) * 2 + d) * 256 + ch; ca[k] = SA[o]; cb[k] = SB[o]; }
    for (int i0 = 0; i0 < 264; i0 += 24) {
        if (i0 + 24 < 264) {
#pragma unroll
            for (int k = 0; k < 24; ++k) { const size_t o = (size_t)(LRU_TILE(i0 + 24 + k) * 2 + d) * 256 + ch; na[k] = SA[o]; nb[k] = SB[o]; } }
        float hv[24];
#pragma unroll
        for (int k = 0; k < 24; ++k) { hv[k] = hst; hst = ca[k] * hst + cb[k]; }
#pragma unroll
        for (int k = 0; k < 24; ++k) H0[(size_t)(LRU_TILE(i0 + k) * 2 + d) * 256 + ch] = hv[k];
#pragma unroll
        for (int k = 0; k < 24; ++k) { ca[k] = na[k]; cb[k] = nb[k]; }
    }
#undef LRU_TILE
}
__device__ __forceinline__ void lru_rescan(const Args& a, int l, unsigned char* lds, int tile, int tid) {
    unsigned char* ws = karg_ws();
    const int ch = tid & 255, d = tid >> 8;
    const int row0 = tile * 32;
    float hst = ((const float*)(ws + M_H0))[(size_t)(tile * 2 + d) * 256 + ch];
    const float lam = IN(22)[(l * 2 + d) * 256 + ch];
    const float cch = -8.f * log1pf(__expf(-lam));
    const bf16* LR = (const bf16*)(ws + M_LR0 + (size_t)d * A8); const bf16* LIX = (const bf16*)(ws + M_LIX0 + (size_t)d * A8);
    float* hs = (float*)lds;
#pragma unroll 16
    for (int tt = 0; tt < 32; ++tt) { const int t = d ? 31 - tt : tt; const size_t o = (size_t)(row0 + t) * 256 + ch;
        const float al = __expf(cch * bf2f(LR[o])); const float bb = sqrtf(fmaxf(1.f - al * al, 0.f)) * bf2f(LIX[o]);
        hst = al * hst + bb; hs[(d * 32 + t) * 256 + ch] = hst; }
    __syncthreads();
    const bf16* U = (const bf16*)(ws + OFF_HU); bf16* Y = (bf16*)(ws + OFF_XMY);
#pragma unroll 8
    for (int tt = 0; tt < 16; ++tt) { const int t = d * 16 + tt;
        const float y = (hs[t * 256 + ch] + hs[(32 + t) * 256 + ch]) * geluf_(bf2f(U[(size_t)(row0 + t) * UC + 768 + ch]));
        Y[(size_t)(row0 + t) * DM + 256 + ch] = (bf16)f2bf(y); }
    __syncthreads();
}
__device__ __forceinline__ void phase_m2(const Args& a, int l, unsigned char* lds, int G, int bid, int tid) {
    unsigned char* ws = karg_ws();
    const bf16* QB = (const bf16*)(ws + M_QB); const bf16* KB = (const bf16*)(ws + M_KB); const bf16* VT = (const bf16*)(ws + M_VT);
    bf16* Y = (bf16*)(ws + OFF_XMY);
    const int nunits = (l == 0) ? 264 : 256;
    for (int u = bid; u < nunits; u += G) {
        if (u < 256) attn_unit(lds, QB, KB, VT, Y, u >> 7, (u >> 5) & 3, (u & 31) * 256, 0, 132, tid);
        else attn_unit(lds, QB, KB, VT, Y, (u - 256) >> 2, (u - 256) & 3, TLEN, TLEN, 4, tid);
    }
    if (bid >= G - 4) lru_prefix(bid - (G - 4), tid);
}

__device__ __forceinline__ void phase_m3(const Args& a, int l, unsigned char* lds, int G, int bid, int tid) {
    unsigned char* ws = karg_ws();
    const bf16* U = (const bf16*)(ws + OFF_HU);
    const int lane = tid & 63, ch = tid & 255, part = tid >> 8;
    const float* mup = IN(23) + l * 1024; const float* mun = IN(24) + l * 1024;
    bf16* RR = (bf16*)(ws + M_RR); bf16* KKo = (bf16*)(ws + M_KK); bf16* VV = (bf16*)(ws + M_VV); bf16* GC = (bf16*)(ws + M_GC);
    float* kl = (float*)lds;
    float* kkn = (float*)(lds + 32768);
    bf16* twb = (bf16*)(lds + 65536);
    bf16* tab = (bf16*)(lds + 70144);
    bf16* tgb = (bf16*)(lds + 74752);
    for (int tile = bid; tile < NTILE; tile += G) {
        const TileInfo ti = tile_info(tile);
        const int row0 = tile * 32;
        lru_rescan(a, l, lds, tile, ltid());
        {
            const int tid2 = ltid(); const int chunk = tid2 & 127, tg8 = tid2 >> 7, c0 = chunk * 8;
            const bf16* ub = U + (size_t)row0 * UC + 1024 + c0;
            v4u rw[10];
#pragma unroll
            for (int q = 0; q < 10; ++q) { const int tl = tg8 * 8 + q - 1; const int t = ti.t0 + tl;
                rw[q] = (t >= 0 && t < ti.seqlen) ? *(const v4u*)(ub + (ptrdiff_t)tl * UC) : (v4u){0u, 0u, 0u, 0u}; }
            const f32x4 mp0 = *(const f32x4*)(mup + c0), mp1 = *(const f32x4*)(mup + c0 + 4), mn0 = *(const f32x4*)(mun + c0), mn1 = *(const f32x4*)(mun + c0 + 4);
            const float mp[8] = {mp0[0], mp0[1], mp0[2], mp0[3], mp1[0], mp1[1], mp1[2], mp1[3]}, mn[8] = {mn0[0], mn0[1], mn0[2], mn0[3], mn1[0], mn1[1], mn1[2], mn1[3]};
#pragma unroll
            for (int q = 0; q < 8; ++q) { const int tl = tg8 * 8 + q; float ts[8];
#pragma unroll
                for (int e = 0; e < 8; ++e) { const unsigned wm = rw[q][e >> 1], w0 = rw[q + 1][e >> 1], wn = rw[q + 2][e >> 1];
                    const float um = (e & 1) ? __uint_as_float(wm & 0xffff0000u) : __uint_as_float(wm << 16);
                    const float u0 = (e & 1) ? __uint_as_float(w0 & 0xffff0000u) : __uint_as_float(w0 << 16);
                    const float un = (e & 1) ? __uint_as_float(wn & 0xffff0000u) : __uint_as_float(wn << 16);
                    ts[e] = u0 + mp[e] * (um - u0) + mn[e] * (un - u0); }
                if (chunk >= 32 && chunk < 64) { float* kp = kl + tl * 256 + (c0 - 256); *(f32x4*)kp = (f32x4){ts[0], ts[1], ts[2], ts[3]}; *(f32x4*)(kp + 4) = (f32x4){ts[4], ts[5], ts[6], ts[7]}; }
                else {
                    if (chunk >= 96 && chunk < 104) {
#pragma unroll
                        for (int e = 0; e < 8; ++e) ts[e] = tanhf_(ts[e]); }
                    if (chunk >= 112) {
#pragma unroll
                        for (int e = 0; e < 8; ++e) ts[e] = sigm(ts[e]); }
                    v4u o; o.x = pk2(ts[0], ts[1]); o.y = pk2(ts[2], ts[3]); o.z = pk2(ts[4], ts[5]); o.w = pk2(ts[6], ts[7]);
                    if (chunk < 32) *(v4u*)(RR + (size_t)(row0 + tl) * 256 + c0) = o;
                    else if (chunk < 96) *(v4u*)(VV + (size_t)(row0 + tl) * 256 + (c0 - 512)) = o;
                    else if (chunk < 104) *(v4u*)(twb + tl * 72 + (c0 - 768)) = o;
                    else if (chunk < 112) *(v4u*)(tab + tl * 72 + (c0 - 832)) = o;
                    else *(v4u*)(tgb + tl * 136 + (c0 - 896)) = o; }
            }
        }
        __syncthreads();
        {
            const int tid2 = ltid(); const int ch = tid2 & 255, pt = tid2 >> 8; const float kkc = IN(30)[l * 256 + ch];
#pragma unroll 4
            for (int q = 0; q < 16; ++q) { const int t = pt * 16 + q; const float kr = kl[t * 256 + ch] * kkc; const float nrm = wave_sum(kr * kr);
                const float kk = kr * rsqrtf(fmaxf(nrm, 1e-24f)); kkn[t * 256 + ch] = kk; KKo[(size_t)(row0 + t) * 256 + ch] = (bf16)f2bf(kk); }
        }
        __syncthreads();
        {
            const int tid2 = ltid(); const int ln = tid2 & 63, wv = __builtin_amdgcn_readfirstlane(tid2 >> 6), fr = ln & 15, fq = ln >> 4;
            const bf16* WUPt = (const bf16*)(ws + W_WUP); const bf16* AUPt = (const bf16*)(ws + W_AUP); const bf16* GUPt = (const bf16*)(ws + W_GUP);
            bf16x8 aw[2][2], aa[2][2];
#pragma unroll
            for (int mt = 0; mt < 2; ++mt)
#pragma unroll
                for (int ks = 0; ks < 2; ++ks) { aw[mt][ks] = *(const bf16x8*)(twb + (mt * 16 + fr) * 72 + ks * 32 + fq * 8); aa[mt][ks] = *(const bf16x8*)(tab + (mt * 16 + fr) * 72 + ks * 32 + fq * 8); }
#pragma unroll 1
            for (int dn = 0; dn < 4; ++dn) { const int d = dn >> 1, nt = wv * 2 + (dn & 1), ch = nt * 16 + fr;
                f32x4 cw[2], ca[2];
#pragma unroll
                for (int mt = 0; mt < 2; ++mt) { cw[mt] = (f32x4){0.f, 0.f, 0.f, 0.f}; ca[mt] = cw[mt]; }
#pragma unroll
                for (int ks = 0; ks < 2; ++ks) { const bf16x8 bw = *(const bf16x8*)(WUPt + ((size_t)d * 256 + ch) * 64 + ks * 32 + fq * 8), ba = *(const bf16x8*)(AUPt + ((size_t)d * 256 + ch) * 64 + ks * 32 + fq * 8);
#pragma unroll
                    for (int mt = 0; mt < 2; ++mt) { cw[mt] = __builtin_amdgcn_mfma_f32_16x16x32_bf16(aw[mt][ks], bw, cw[mt], 0, 0, 0); ca[mt] = __builtin_amdgcn_mfma_f32_16x16x32_bf16(aa[mt][ks], ba, ca[mt], 0, 0, 0); } }
                const float w0 = IN(25)[(l * 2 + d) * 256 + ch], a0 = IN(27)[(l * 2 + d) * 256 + ch], kac = IN(31)[l * 256 + ch];
                float* WW = (float*)(ws + M_WW) + (size_t)d * NR * 256; bf16* BB = (bf16*)(ws + M_BB + (size_t)d * A8); bf16* KD = (bf16*)(ws + M_KD + (size_t)d * A8);
#pragma unroll
                for (int mt = 0; mt < 2; ++mt)
#pragma unroll
                    for (int j = 0; j < 4; ++j) { const int t = mt * 16 + fq * 4 + j; const size_t o = (size_t)(row0 + t) * 256 + ch;
                        const float e = sigm(w0 + cw[mt][j]) * 0.6065306597126334f;
                        const float av = sigm(a0 + ca[mt][j]);
                        WW[o] = __expf(-e);
                        KD[o] = (bf16)f2bf(kl[t * 256 + ch] * (1.f + (av - 1.f) * kac));
                        BB[o] = (bf16)f2bf(kkn[t * 256 + ch] * av); }
            }
#pragma unroll 1
            for (int nl = 0; nl < 2; ++nl) { const int ch = (wv * 2 + nl) * 16 + fr;
                f32x4 cg[2] = {(f32x4){0.f, 0.f, 0.f, 0.f}, (f32x4){0.f, 0.f, 0.f, 0.f}};
#pragma unroll
                for (int ks = 0; ks < 4; ++ks) { const bf16x8 bg = *(const bf16x8*)(GUPt + (size_t)ch * 128 + ks * 32 + fq * 8);
#pragma unroll
                    for (int mt = 0; mt < 2; ++mt) { const bf16x8 ag = *(const bf16x8*)(tgb + (mt * 16 + fr) * 136 + ks * 32 + fq * 8); cg[mt] = __builtin_amdgcn_mfma_f32_16x16x32_bf16(ag, bg, cg[mt], 0, 0, 0); } }
#pragma unroll
                for (int mt = 0; mt < 2; ++mt)
#pragma unroll
                    for (int j = 0; j < 4; ++j) GC[(size_t)(row0 + mt * 16 + fq * 4 + j) * 256 + ch] = (bf16)f2bf(cg[mt][j]);
            }
        }
        __syncthreads();
    }
}

typedef const unsigned cu32;
typedef const float cf32;
__device__ __forceinline__ int chain_row(int b, int d, int tau) {
    return tau < CTXL ? (NLAT + b * CTXL + (d ? CTXL - 1 - tau : tau)) : (b * TLEN + (d ? TLEN - 1 - (tau - CTXL) : (tau - CTXL)));
}
template <int MODE>
__device__ __forceinline__ void rwkv_steps(float (&S)[64], int b, int h, int d, int tau0, int n, unsigned char* ws, int lane, float* wl) {
    const bf16* KKp = (const bf16*)(ws + M_KK); const bf16* RRp = (const bf16*)(ws + M_RR); const bf16* VVp = (const bf16*)(ws + M_VV);
    const float* WWp = (const float*)(ws + M_WW) + (size_t)d * NR * 256; const bf16* BBp = (const bf16*)(ws + M_BB + (size_t)d * A8); const bf16* KDp = (const bf16*)(ws + M_KD + (size_t)d * A8);
    float* YS = (float*)(ws + M_YS) + (size_t)d * NR * 256;
    float pk, pw, pb, pkd = 0.f, pr = 0.f, pv = 0.f; size_t poff;
#define RWKV_LOAD(s_) do { poff = (size_t)chain_row(b, d, tau0 + (s_)) * 256 + h * 64 + lane; pk = bf2f(KKp[poff]); pw = WWp[poff]; pb = bf2f(BBp[poff]); \
        if (MODE != 1) { pkd = bf2f(KDp[poff]); pv = bf2f(VVp[poff]); } if (MODE == 2) pr = bf2f(RRp[poff]); } while (0)
    RWKV_LOAD(0);
    for (int s = 0; s < n; ++s) {
        float* buf = wl + (s & 1) * 320;
        buf[lane] = pk; buf[64 + lane] = pw; buf[128 + lane] = pb;
        if (MODE != 1) buf[192 + lane] = pkd;
        if (MODE == 2) buf[256 + lane] = pr;
        const float vv = pv; const size_t yoff = poff;
        if (s + 1 < n) RWKV_LOAD(s + 1);
        float sa0 = 0.f, sa1 = 0.f, sa2 = 0.f, sa3 = 0.f;
#pragma unroll
        for (int i = 0; i < 64; i += 4) { const f32x4 k4 = *(const f32x4*)(buf + i);
            sa0 += S[i] * k4[0]; sa1 += S[i + 1] * k4[1]; sa2 += S[i + 2] * k4[2]; sa3 += S[i + 3] * k4[3]; }
        const float nsa = -((sa0 + sa1) + (sa2 + sa3));
        float y0 = 0.f, y1 = 0.f, y2 = 0.f, y3 = 0.f;
#pragma unroll
        for (int i = 0; i < 64; i += 4) { const f32x4 w4 = *(const f32x4*)(buf + 64 + i), b4 = *(const f32x4*)(buf + 128 + i);
            f32x4 t = nsa * b4;
            if (MODE != 1) { const f32x4 kd4 = *(const f32x4*)(buf + 192 + i); t += vv * kd4; }
            S[i] = S[i] * w4[0] + t[0]; S[i + 1] = S[i + 1] * w4[1] + t[1]; S[i + 2] = S[i + 2] * w4[2] + t[2]; S[i + 3] = S[i + 3] * w4[3] + t[3];
            if (MODE == 2) { const f32x4 r4 = *(const f32x4*)(buf + 256 + i); y0 += S[i] * r4[0]; y1 += S[i + 1] * r4[1]; y2 += S[i + 2] * r4[2]; y3 += S[i + 3] * r4[3]; } }
        if (MODE == 2) YS[yoff] = (y0 + y1) + (y2 + y3);
    }
#undef RWKV_LOAD
}
typedef float f32x2 __attribute__((ext_vector_type(2)));
__device__ __forceinline__ void rwkv_pass1(f32x2 (&SL)[32], f32x2 (&SI)[32], int b, int h, int d, int tau0, int n, unsigned char* ws, int lane, float* wl) {
    const bf16* KKp = (const bf16*)(ws + M_KK); const bf16* VVp = (const bf16*)(ws + M_VV); const bf16* RRp = (const bf16*)(ws + M_RR);
    const float* WWp = (const float*)(ws + M_WW) + (size_t)d * NR * 256; const bf16* BBp = (const bf16*)(ws + M_BB + (size_t)d * A8); const bf16* KDp = (const bf16*)(ws + M_KD + (size_t)d * A8);
    float* YS = (float*)(ws + M_YS) + (size_t)d * NR * 256; float* PR = (float*)(ws + M_PR) + (size_t)d * NR * 256;
    float pk, pw, pb, pkd, pv, pr; size_t poff;
#define RWKV_LOAD(s_) do { poff = (size_t)chain_row(b, d, tau0 + (s_)) * 256 + h * 64 + lane; pk = bf2f(KKp[poff]); pw = WWp[poff]; pb = bf2f(BBp[poff]); pkd = bf2f(KDp[poff]); pv = bf2f(VVp[poff]); pr = bf2f(RRp[poff]); } while (0)
    RWKV_LOAD(0);
    for (int s = 0; s < n; ++s) {
        float* buf = wl + (s & 1) * 320;
        buf[lane] = pk; buf[64 + lane] = pw; buf[128 + lane] = pb; buf[192 + lane] = pkd; buf[256 + lane] = pr;
        const float vv = pv; const size_t yoff = poff;
        if (s + 1 < n) RWKV_LOAD(s + 1);
        f32x2 aL0 = {0.f, 0.f}, aL1 = aL0, aI0 = aL0, aI1 = aL0;
#pragma unroll
        for (int q = 0; q < 16; ++q) { const f32x4 k4 = *(const f32x4*)(buf + 4 * q);
            aL0 += SL[2 * q] * k4.lo; aL1 += SL[2 * q + 1] * k4.hi; aI0 += SI[2 * q] * k4.lo; aI1 += SI[2 * q + 1] * k4.hi; }
        const f32x2 tL = aL0 + aL1, tI = aI0 + aI1;
        const float nsl = -(tL.x + tL.y), nsi = -(tI.x + tI.y);
        f32x2 yL0 = {0.f, 0.f}, yL1 = yL0, yI0 = yL0, yI1 = yL0;
#pragma unroll
        for (int q = 0; q < 16; ++q) {
            const f32x4 w4 = *(const f32x4*)(buf + 64 + 4 * q), b4 = *(const f32x4*)(buf + 128 + 4 * q), kd4 = *(const f32x4*)(buf + 192 + 4 * q), r4 = *(const f32x4*)(buf + 256 + 4 * q);
            const f32x4 tl = nsl * b4 + vv * kd4, tiv = nsi * b4;
            SL[2 * q] = SL[2 * q] * w4.lo + tl.lo; SL[2 * q + 1] = SL[2 * q + 1] * w4.hi + tl.hi;
            SI[2 * q] = SI[2 * q] * w4.lo + tiv.lo; SI[2 * q + 1] = SI[2 * q + 1] * w4.hi + tiv.hi;
            yL0 += SL[2 * q] * r4.lo; yL1 += SL[2 * q + 1] * r4.hi; yI0 += SI[2 * q] * r4.lo; yI1 += SI[2 * q + 1] * r4.hi; }
        const f32x2 yl = yL0 + yL1, yp = yI0 + yI1;
        YS[yoff] = yl.x + yl.y; PR[yoff] = yp.x + yp.y;
    }
#undef RWKV_LOAD
}
__device__ __forceinline__ void phase_m4(const Args& a, unsigned char* lds, int G, int bid, int tid) {
    const int lane = tid & 63, wave = __builtin_amdgcn_readfirstlane(tid >> 6), half = wave >> 2, tk = wave & 3;
    unsigned char* ws = karg_ws(); float* PL = (float*)(ws + M_PL);
    float* wl = (float*)lds + wave * 320;
    float* xch = (float*)lds + 8 * 320 + tk * 1024;
    float* ych = xch + 512;
    const bf16* KKp = (const bf16*)(ws + M_KK); const bf16* VVp = (const bf16*)(ws + M_VV); const bf16* RRp = (const bf16*)(ws + M_RR);
    for (int task0 = bid * 4; task0 < 16 * NSEG; task0 += G * 4) {
        const int task = task0 + tk; const int seg = task & (NSEG - 1), chain = task >> 6;
        const int d = chain & 1, h = (chain >> 1) & 3, b = chain >> 3;
        const float* WWp = (const float*)(ws + M_WW) + (size_t)d * NR * 256; const bf16* BBp = (const bf16*)(ws + M_BB + (size_t)d * A8); const bf16* KDp = (const bf16*)(ws + M_KD + (size_t)d * A8);
        float* YS = (float*)(ws + M_YS) + (size_t)d * NR * 256; float* PR = (float*)(ws + M_PR) + (size_t)d * NR * 256;
        f32x2 SL[16], SI[16]; int ln = lane; asm volatile("" : "+v"(ln));
#pragma unroll
        for (int i = 0; i < 16; ++i) { SL[i] = (f32x2){0.f, 0.f}; SI[i] = (f32x2){(32 * half + 2 * i == ln) ? 1.f : 0.f, (32 * half + 2 * i + 1 == ln) ? 1.f : 0.f}; }
        const int tau0 = seg * SEGLEN, cidx = h * 64 + 32 * half + (lane & 31);
        unsigned pp; float pw, pv; size_t rowoff, prevoff = 0;
        const int grp = lane >> 4, l15 = lane & 15, l31 = lane & 31;
        const unsigned* srcp = grp == 0 ? (const unsigned*)KKp : grp == 1 ? (const unsigned*)BBp : grp == 2 ? (const unsigned*)KDp : (const unsigned*)RRp;
#define M4_LOAD(s_) do { rowoff = (size_t)chain_row(b, d, tau0 + (s_)) * 256; pp = srcp[(rowoff + h * 64 + 32 * half) / 2 + l15]; \
            pw = (lane < 32) ? WWp[rowoff + cidx] : 0.f; pv = bf2f(VVp[rowoff + h * 64 + lane]); } while (0)
#define UNPK(u_) ((f32x2){__uint_as_float((u_) << 16), __uint_as_float((u_) & 0xffff0000u)})
        M4_LOAD(0);
        for (int s = 0; s < SEGLEN; ++s) {
            float* buf = wl + (s & 1) * 160; const unsigned* bufu = (const unsigned*)buf;
            ((unsigned*)buf)[lane] = pp; if (lane < 32) buf[64 + l31] = pw;
            const float vv = pv; const size_t yoff = rowoff + h * 64 + lane;
            if (s + 1 < SEGLEN) M4_LOAD(s + 1);
            f32x2 aL0 = {0.f, 0.f}, aL1 = aL0, aI0 = aL0, aI1 = aL0;
#pragma unroll
            for (int q = 0; q < 4; ++q) { const v4u k4 = *(const v4u*)(bufu + 4 * q);
                const f32x2 ka = UNPK(k4.x), kb = UNPK(k4.y), kc = UNPK(k4.z), kd_ = UNPK(k4.w);
                aL0 += SL[4 * q] * ka; aL1 += SL[4 * q + 1] * kb; aL0 += SL[4 * q + 2] * kc; aL1 += SL[4 * q + 3] * kd_;
                aI0 += SI[4 * q] * ka; aI1 += SI[4 * q + 1] * kb; aI0 += SI[4 * q + 2] * kc; aI1 += SI[4 * q + 3] * kd_; }
            const f32x2 tL = aL0 + aL1, tI = aI0 + aI1;
            float* xw = xch + (s & 1) * 256;
            xw[half * 128 + lane] = tL.x + tL.y; xw[half * 128 + 64 + lane] = tI.x + tI.y;
            __syncthreads();
            const float nsl = -(xw[lane] + xw[128 + lane]), nsi = -(xw[64 + lane] + xw[192 + lane]);
            if (s > 0) {
                const float* yr = ych + ((s - 1) & 1) * 256;
                if (half == 0) YS[prevoff] = yr[lane] + yr[128 + lane]; else PR[prevoff] = yr[64 + lane] + yr[192 + lane];
            }
            f32x2 yL0 = {0.f, 0.f}, yL1 = yL0, yI0 = yL0, yI1 = yL0;
#pragma unroll
            for (int q = 0; q < 4; ++q) {
                const f32x4 wa = *(const f32x4*)(buf + 64 + 8 * q), wb = *(const f32x4*)(buf + 68 + 8 * q);
                const v4u b4 = *(const v4u*)(bufu + 16 + 4 * q), d4 = *(const v4u*)(bufu + 32 + 4 * q), r4 = *(const v4u*)(bufu + 48 + 4 * q);
                const f32x2 w2[4] = {wa.lo, wa.hi, wb.lo, wb.hi};
                const unsigned bu[4] = {b4.x, b4.y, b4.z, b4.w}, du[4] = {d4.x, d4.y, d4.z, d4.w}, ru[4] = {r4.x, r4.y, r4.z, r4.w};
#pragma unroll
                for (int e = 0; e < 4; ++e) { const int j = 4 * q + e; const f32x2 b2 = UNPK(bu[e]), k2 = UNPK(du[e]), r2 = UNPK(ru[e]);
                    const f32x2 tl = nsl * b2 + vv * k2, tiv = nsi * b2;
                    SL[j] = SL[j] * w2[e] + tl; SI[j] = SI[j] * w2[e] + tiv;
                    if (e & 1) { yL1 += SL[j] * r2; yI1 += SI[j] * r2; } else { yL0 += SL[j] * r2; yI0 += SI[j] * r2; } }
            }
            const f32x2 yl = yL0 + yL1, yp = yI0 + yI1;
            float* yw = ych + (s & 1) * 256;
            yw[half * 128 + lane] = yl.x + yl.y; yw[half * 128 + 64 + lane] = yp.x + yp.y;
            prevoff = yoff;
        }
#undef M4_LOAD
#undef UNPK
        __syncthreads();
        { const float* yr = ych + ((SEGLEN - 1) & 1) * 256;
          if (half == 0) YS[prevoff] = yr[lane] + yr[128 + lane]; else PR[prevoff] = yr[64 + lane] + yr[192 + lane]; }
        float* o = PL + (((size_t)(chain * NSEG + seg) * 2) * 64 + lane) * 64 + 32 * half;
#pragma unroll
        for (int i = 0; i < 16; i += 2) { *(f32x4*)(o + 2 * i) = (f32x4){SL[i].x, SL[i].y, SL[i + 1].x, SL[i + 1].y}; *(f32x4*)(o + 4096 + 2 * i) = (f32x4){SI[i].x, SI[i].y, SI[i + 1].x, SI[i + 1].y}; }
        __syncthreads();
    }
}
__device__ __forceinline__ void phase_m5(const Args& a, unsigned char* lds, int G, int bid, int tid) {
    unsigned char* ws = karg_ws(); const float* PL = (const float*)(ws + M_PL); float* SI = (float*)(ws + M_SINIT);
    float* Sx = (float*)lds;
    const int lane = tid & 63, wv = __builtin_amdgcn_readfirstlane(tid >> 6), fr = lane & 15, fq = lane >> 4;
    const bool act = wv < 4;
    for (int u = bid; u < 64; u += G) {
        const int chain = u >> 2, row0 = (u & 3) * 16, col = (wv & 3) * 16 + fr;
        const float* Pg = PL + ((size_t)(chain * NSEG) * 2 + 1) * 4096; const float* Lg = PL + ((size_t)(chain * NSEG) * 2) * 4096;
        float* SIc = SI + (size_t)(chain * NSEG) * 4096;
        f32x4 cur = {0.f, 0.f, 0.f, 0.f}; f32x4 lv[3]; float pb[3][16];
#pragma unroll
        for (int q = 0; q < 3; ++q) { lv[q] = cur;
            if (act) { const float* Pn = Pg + (size_t)q * 8192; const float* Ln = Lg + (size_t)q * 8192;
#pragma unroll
                for (int ks = 0; ks < 16; ++ks) pb[q][ks] = Pn[(4 * ks + fq) * 64 + col];
#pragma unroll
                for (int j = 0; j < 4; ++j) lv[q][j] = Ln[(row0 + fq * 4 + j) * 64 + col]; } }
        for (int g0 = 0; g0 < NSEG - 1; g0 += 3) {
#pragma unroll
            for (int q = 0; q < 3; ++q) { const int g = g0 + q;
                if (act) {
#pragma unroll
                    for (int j = 0; j < 4; ++j) { SIc[(size_t)g * 4096 + (row0 + fq * 4 + j) * 64 + col] = cur[j]; Sx[(fq * 4 + j) * 68 + col] = cur[j]; }
                }
                __syncthreads();
                if (act) {
                    f32x4 acc = lv[q];
#pragma unroll
                    for (int ks = 0; ks < 16; ++ks) { const float av = Sx[fr * 68 + 4 * ks + fq]; acc = __builtin_amdgcn_mfma_f32_16x16x4f32(av, pb[q][ks], acc, 0, 0, 0); }
                    cur = acc;
                    if (g + 3 < NSEG - 1) { const float* Pn = Pg + (size_t)(g + 3) * 8192; const float* Ln = Lg + (size_t)(g + 3) * 8192;
#pragma unroll
                        for (int ks = 0; ks < 16; ++ks) pb[q][ks] = Pn[(4 * ks + fq) * 64 + col];
#pragma unroll
                        for (int j = 0; j < 4; ++j) lv[q][j] = Ln[(row0 + fq * 4 + j) * 64 + col]; }
                }
                __syncthreads();
            }
        }
        if (act) {
#pragma unroll
            for (int j = 0; j < 4; ++j) SIc[(size_t)(NSEG - 1) * 4096 + (row0 + fq * 4 + j) * 64 + col] = cur[j];
        }
    }
}
__device__ __forceinline__ void phase_m6(const Args& a, unsigned char* lds, int G, int bid, int tid) {
    const int lane = tid & 63, wave = __builtin_amdgcn_readfirstlane(tid >> 6);
    unsigned char* ws = karg_ws(); const float* SI = (const float*)(ws + M_SINIT);
    float* wl = (float*)lds + wave * 256;
    for (int task = bid * 8 + wave; task < 16 * (NSEG - 1); task += G * 8) {
        const int seg = 1 + task % (NSEG - 1), chain = task / (NSEG - 1);
        const int d = chain & 1, h = (chain >> 1) & 3, b = chain >> 3;
        float* YS = (float*)(ws + M_YS) + (size_t)d * NR * 256; const float* PR = (const float*)(ws + M_PR) + (size_t)d * NR * 256;
        f32x2 S0[32];
        const float* si = SI + ((size_t)(chain * NSEG + seg) * 64 + lane) * 64;
#pragma unroll
        for (int i = 0; i < 32; i += 2) { const f32x4 v = *(const f32x4*)(si + 2 * i); S0[i] = v.lo; S0[i + 1] = v.hi; }
        const int tau0 = seg * SEGLEN;
        size_t o0 = (size_t)chain_row(b, d, tau0) * 256 + h * 64 + lane, o1 = (size_t)chain_row(b, d, tau0 + 1) * 256 + h * 64 + lane;
        float p0 = PR[o0], p1 = PR[o1], y0 = YS[o0], y1 = YS[o1];
        for (int s = 0; s < SEGLEN; s += 2) {
            wl[lane] = p0; wl[64 + lane] = p1;
            const size_t c0 = o0, c1 = o1; const float yy0 = y0, yy1 = y1;
            if (s + 2 < SEGLEN) { o0 = (size_t)chain_row(b, d, tau0 + s + 2) * 256 + h * 64 + lane; o1 = (size_t)chain_row(b, d, tau0 + s + 3) * 256 + h * 64 + lane; p0 = PR[o0]; p1 = PR[o1]; y0 = YS[o0]; y1 = YS[o1]; }
            f32x2 a0 = {0.f, 0.f}, a1 = a0, b0 = a0, b1 = a0;
#pragma unroll
            for (int q = 0; q < 16; ++q) { const f32x4 u = *(const f32x4*)(wl + 4 * q), w = *(const f32x4*)(wl + 64 + 4 * q);
                a0 += S0[2 * q] * u.lo; a1 += S0[2 * q + 1] * u.hi; b0 += S0[2 * q] * w.lo; b1 += S0[2 * q + 1] * w.hi; }
            const f32x2 ta = a0 + a1, tb = b0 + b1;
            YS[c0] = yy0 + (ta.x + ta.y); YS[c1] = yy1 + (tb.x + tb.y);
            asm volatile("" ::: "memory");
        }
    }
}
__device__ __forceinline__ void phase_m7(const Args& a, int l, int gw, int NGW, int lane) {
    unsigned char* ws = karg_ws();
    const float* Y0 = (const float*)(ws + M_YS); const float* Y1 = Y0 + (size_t)NR * 256;
    const bf16* RR = (const bf16*)(ws + M_RR); const bf16* VV = (const bf16*)(ws + M_VV); const bf16* KD0 = (const bf16*)(ws + M_KD); const bf16* KD1 = (const bf16*)(ws + M_KD + A8);
    const bf16* GC = (const bf16*)(ws + M_GC); bf16* Y = (bf16*)(ws + OFF_XMY);
    for (int r = gw; r < NR; r += NGW) {
#pragma unroll
        for (int h = 0; h < 4; ++h) { const int c = h * 64 + lane; const size_t o = (size_t)r * 256 + c;
            const float ys = Y0[o] + Y1[o];
            const float mu = wave_sum(ys) * (1.f / 64.f); const float dv = ys - mu; const float var = wave_sum(dv * dv) * (1.f / 64.f);
            float ov = dv * rsqrtf(var + 64e-5f) * IN(33)[l * 256 + c] + IN(34)[l * 256 + c];
            const float rv = bf2f(RR[o]), rk = IN(32)[l * 256 + c], vv = bf2f(VV[o]);
            const float b0 = wave_sum(rv * bf2f(KD0[o]) * rk), b1 = wave_sum(rv * bf2f(KD1[o]) * rk);
            ov += (b0 + b1) * vv;
            Y[(size_t)r * DM + 512 + c] = (bf16)f2bf(ov * bf2f(GC[o])); }
    }
}

#define LAS __attribute__((address_space(3)))
#define XB_TMO      128
#define XB_XCNT(j)  (256  + 64 * (j))
#define XB_XSUB(j)  (1280 + 64 * (j))
#define XB_XGEN(j)  (2304 + 64 * (j))
#define XB_TOP      3328
#define XB_TOPGEN   3392
#define XCD_BAR_WORDS 3456
#define XB_SPIN_CAP (1u << 18)

__device__ __forceinline__ unsigned xb_ld(unsigned* p)              { return __hip_atomic_load(p, __ATOMIC_RELAXED, __HIP_MEMORY_SCOPE_AGENT); }
__device__ __forceinline__ unsigned xb_add(unsigned* p, unsigned v) { return __hip_atomic_fetch_add(p, v, __ATOMIC_RELAXED, __HIP_MEMORY_SCOPE_AGENT); }
__device__ __forceinline__ unsigned xb_xcc_id() { return (unsigned)__builtin_amdgcn_s_getreg((3 << 11) | 20) & 0xFu; }
#define XB_SPIN(cond, bar) do { unsigned _sp = 0; while (cond) { __builtin_amdgcn_s_sleep(1); \
    if ((++_sp & 255u) == 0u) { if (xb_ld(&(bar)[XB_TMO])) break; if (_sp > XB_SPIN_CAP) { atomicAdd(&(bar)[XB_TMO], 1u); break; } } } } while (0)

struct XcdBarrier {
    unsigned* bar; unsigned x;
    volatile LAS unsigned* st;
};

__device__ __forceinline__ XcdBarrier xcd_barrier_post(unsigned* bar, volatile LAS unsigned* st) {
    XcdBarrier b; b.bar = bar; b.x = xb_xcc_id(); b.st = st;
    if (threadIdx.x == 0) (void)xb_add(&bar[XB_XCNT(b.x)], 1u);
    return b;
}
__device__ __forceinline__ void xcd_barrier_complete(unsigned* bar, unsigned x, unsigned& nloc, unsigned& nx) {
    const unsigned G = gridDim.x * gridDim.y * gridDim.z;
    unsigned sum, cnt, mine, sp = 0u;
    for (;;) {
        sum = 0u; cnt = 0u; mine = 0u;
#pragma unroll
        for (unsigned j = 0; j < 16; ++j) { const unsigned c = xb_ld(&bar[XB_XCNT(j)]); sum += c; cnt += (c > 0u) ? 1u : 0u; mine = (j == x) ? c : mine; }
        if (sum == G) break;
        __builtin_amdgcn_s_sleep(1);
        if ((++sp & 255u) == 0u) { if (xb_ld(&bar[XB_TMO])) break; if (sp > XB_SPIN_CAP) { atomicAdd(&bar[XB_TMO], 1u); break; } }
    }
    nloc = mine > 0u ? mine : 1u; nx = cnt > 0u ? cnt : 1u;
}

__device__ __forceinline__ void xcd_barrier(const XcdBarrier& b) {
    asm volatile("s_waitcnt vmcnt(0)" ::: "memory");
    __syncthreads();
    if (threadIdx.x == 0) {
        unsigned* bar = b.bar;
        __builtin_amdgcn_s_waitcnt(0);
        unsigned nloc = b.st[0], nx = b.st[1];
        if (nloc == 0u) { xcd_barrier_complete(bar, b.x, nloc, nx); b.st[0] = nloc; b.st[1] = nx; }
        const unsigned old = xb_add(&bar[XB_XSUB(b.x)], 1u);
        const unsigned gen = old / nloc;
        if (old + 1u == (gen + 1u) * nloc) {
            __builtin_amdgcn_fence(__ATOMIC_RELEASE, "agent");
            asm volatile("s_waitcnt vmcnt(0)" ::: "memory");
            const unsigned og = xb_add(&bar[XB_TOP], 1u);
            const unsigned tg = og / nx;
            if (og + 1u == (tg + 1u) * nx) xb_add(&bar[XB_TOPGEN], 1u);
            else XB_SPIN(xb_ld(&bar[XB_TOPGEN]) == tg, bar);
            __builtin_amdgcn_fence(__ATOMIC_ACQUIRE, "agent");
            xb_add(&bar[XB_XGEN(b.x)], 1u);
            asm volatile("s_waitcnt vmcnt(0)" ::: "memory");
        } else {
            XB_SPIN(xb_ld(&bar[XB_XGEN(b.x)]) == gen, bar);
            __builtin_amdgcn_fence(__ATOMIC_ACQUIRE, "agent");
            asm volatile("s_waitcnt vmcnt(0)" ::: "memory");
        }
    }
    __syncthreads();
}

__global__ void __launch_bounds__(512, 2) mega(Args a) {
    extern __shared__ __attribute__((aligned(16))) unsigned char lds[];
    cg::grid_group grid = cg::this_grid();
    const int G = gridDim.x;
    PG8_LAS unsigned char* glds = (PG8_LAS unsigned char*)lds;
#define bid lbid()
#define tid ltid()
#define lane (ltid() & 63)
#define wave (__builtin_amdgcn_readfirstlane(ltid() >> 6))
#define gw (lbid() * 8 + __builtin_amdgcn_readfirstlane(ltid() >> 6))
#define NGW (G * 8)
    { volatile LAS unsigned* st0 = (volatile LAS unsigned*)((LAS unsigned char*)lds + 131072); if (threadIdx.x < 4) st0[threadIdx.x] = 0u; }
    __syncthreads();
    const XcdBarrier xbar = xcd_barrier_post((unsigned*)(karg_ws() + 229376), (volatile LAS unsigned*)((LAS unsigned char*)lds + 131072));
#define GSYNC() do { xcd_barrier(xbar); } while (0)

    phase_modgemv(a, (float*)lds, G, bid, tid);
    convert_weights(a, 0, (float*)(lds + 32768) + wave * (64 * 33), gw, NGW, lane, G, bid, tid);
    grid.sync();
#pragma clang loop unroll(full)
    for (int l = 0; l < 2; ++l) {
        if (l > 0) convert_weights(a, l, (float*)lds + wave * (64 * 33), gw, NGW, lane, G, bid, tid);
        phase_modulate(a, l, 0, gw, NGW, lane);
        GSYNC();
        for (int rp = 0; rp < REP_G1; ++rp)
        {
            unsigned char* ws = karg_ws(); float* outp = karg_out(); float* xctx = (float*)(ws + OFF_XCTX); bf16* XM = (bf16*)(ws + OFF_XMY); bf16* HU = (bf16*)(ws + OFF_HU); const float* modl = (const float*)(ws + OFF_MOD) + (size_t)l * 3 * 9216; (void)xctx; (void)XM; (void)HU; (void)modl; (void)outp;
            pg8::Gemm g{XM, (const bf16*)(ws + W_13A), NR, 2 * DFF, DM}; pg8::StaticOrder S; S.init(NR, 2 * DFF, G, bid);
            EpiSwiglu E{HU};
            pg8::gemm_phase<EpiSwiglu, pg8::StaticOrder, true, true>(glds, g, S, E);
        }
        GSYNC();
        {
            unsigned char* ws = karg_ws(); float* outp = karg_out(); float* xctx = (float*)(ws + OFF_XCTX); bf16* XM = (bf16*)(ws + OFF_XMY); bf16* HU = (bf16*)(ws + OFF_HU); const float* modl = (const float*)(ws + OFF_MOD) + (size_t)l * 3 * 9216; (void)xctx; (void)XM; (void)HU; (void)modl; (void)outp;
            pg8::Gemm g{HU, (const bf16*)(ws + W_2A), NR, DM, DFF}; pg8::StaticOrder S; S.init(NR, DM, G, bid);
            EpiResid E{outp, xctx, modl + 2 * 1024, 0.5f, l == 0 ? IN(0) : outp, l == 0 ? IN(2) : xctx};
            pg8::gemm_phase<EpiResid, pg8::StaticOrder, true, true>(glds, g, S, E);
        }
        GSYNC();
        phase_modulate(a, l, 1, gw, NGW, lane);
        GSYNC();
        {
            unsigned char* ws = karg_ws(); float* outp = karg_out(); float* xctx = (float*)(ws + OFF_XCTX); bf16* XM = (bf16*)(ws + OFF_XMY); bf16* HU = (bf16*)(ws + OFF_HU); const float* modl = (const float*)(ws + OFF_MOD) + (size_t)l * 3 * 9216; (void)xctx; (void)XM; (void)HU; (void)modl; (void)outp;
            pg8::Gemm g{XM, (const bf16*)(ws + W_IN), NR, UC, DM}; pg8::StaticOrder S; S.init(NR, UC, G, bid);
            EpiU E{HU, UC};
            pg8::gemm_phase<EpiU, pg8::StaticOrder, true, true>(glds, g, S, E);
        }
        GSYNC();
        for (int rp = 0; rp < REP_M1; ++rp) { phase_m1(a, l, lds, G, bid, tid);
        GSYNC(); }
        for (int rp = 0; rp < REP_M2; ++rp) { phase_m2(a, l, lds, G, bid, tid);
        GSYNC(); }
        for (int rp = 0; rp < REP_M3; ++rp) { phase_m3(a, l, lds, G, bid, tid);
        GSYNC(); }
        for (int rp = 0; rp < REP_SCAN; ++rp) { phase_m4(a, lds, G, bid, tid);
        GSYNC();
        phase_m5(a, lds, G, bid, tid);
        GSYNC();
        phase_m6(a, lds, G, bid, tid);
        GSYNC(); }
        phase_m7(a, l, gw, NGW, lane);
        GSYNC();
        {
            unsigned char* ws = karg_ws(); float* outp = karg_out(); float* xctx = (float*)(ws + OFF_XCTX); bf16* XM = (bf16*)(ws + OFF_XMY); bf16* HU = (bf16*)(ws + OFF_HU); const float* modl = (const float*)(ws + OFF_MOD) + (size_t)l * 3 * 9216; (void)xctx; (void)XM; (void)HU; (void)modl; (void)outp;
            const int MR = (l == 1) ? NLAT : NR;
            pg8::Gemm g{XM, (const bf16*)(ws + W_OUT), MR, DM, DM}; pg8::StaticOrder S; S.init(MR, DM, G, bid);
            EpiResid E{outp, xctx, modl + 5 * 1024, 1.0f, outp, xctx};
            pg8::gemm_phase<EpiResid, pg8::StaticOrder, true, true>(glds, g, S, E);
        }
        GSYNC();
        phase_modulate(a, l, 2, gw, NGW, lane);
        GSYNC();
        {
            unsigned char* ws = karg_ws(); float* outp = karg_out(); float* xctx = (float*)(ws + OFF_XCTX); bf16* XM = (bf16*)(ws + OFF_XMY); bf16* HU = (bf16*)(ws + OFF_HU); const float* modl = (const float*)(ws + OFF_MOD) + (size_t)l * 3 * 9216; (void)xctx; (void)XM; (void)HU; (void)modl; (void)outp;
            const int MR = (l == 1) ? NLAT : NR;
            pg8::Gemm g{XM, (const bf16*)(ws + W_13B), MR, 2 * DFF, DM}; pg8::StaticOrder S; S.init(MR, 2 * DFF, G, bid);
            EpiSwiglu E{HU};
            pg8::gemm_phase<EpiSwiglu, pg8::StaticOrder, true, true>(glds, g, S, E);
        }
        GSYNC();
        {
            unsigned char* ws = karg_ws(); float* outp = karg_out(); float* xctx = (float*)(ws + OFF_XCTX); bf16* XM = (bf16*)(ws + OFF_XMY); bf16* HU = (bf16*)(ws + OFF_HU); const float* modl = (const float*)(ws + OFF_MOD) + (size_t)l * 3 * 9216; (void)xctx; (void)XM; (void)HU; (void)modl; (void)outp;
            const int MR = (l == 1) ? NLAT : NR;
            pg8::Gemm g{HU, (const bf16*)(ws + W_2B), MR, DM, DFF}; pg8::StaticOrder S; S.init(MR, DM, G, bid);
            EpiResid E{outp, xctx, modl + 8 * 1024, 0.5f, outp, xctx};
            pg8::gemm_phase<EpiResid, pg8::StaticOrder, true, true>(glds, g, S, E);
        }
        GSYNC();
    }
    phase_final(a, gw, NGW, lane);
#undef bid
#undef tid
#undef lane
#undef wave
#undef gw
#undef NGW
}

extern "C" void kernel_launch(void* const* d_in, const int* in_sizes, int n_in, void* d_out, int out_size, void* d_ws, size_t ws_size, hipStream_t stream) {
    static int grid = 0;
    if (grid == 0) {
        int dev = 0, cus = 0, per_cu = 0;
        (void)hipGetDevice(&dev);
        (void)hipDeviceGetAttribute(&cus, hipDeviceAttributeMultiprocessorCount, dev);
        (void)hipFuncSetAttribute((const void*)mega, hipFuncAttributeMaxDynamicSharedMemorySize, LDS_BYTES);
        (void)hipOccupancyMaxActiveBlocksPerMultiprocessor(&per_cu, (const void*)mega, 512, LDS_BYTES);
        if (per_cu < 1) per_cu = 1;
        grid = cus * per_cu;
        if (n_in != 40 || ws_size < WS_NEED) { fprintf(stderr, "kernel_launch: unexpected n_in %d / ws %zu (need %zu)\n", n_in, ws_size, (size_t)WS_NEED); }
    }
    (void)hipMemsetAsync((char*)d_ws + OFF_MOD, 0, MOD_BYTES, stream);
    Args a{};
    for (int i = 0; i < 40; ++i) a.in[i] = (const float*)d_in[i];
    a.out = (float*)d_out; a.ws = (unsigned char*)d_ws;
    void* args[] = {&a};
    hipError_t e = hipLaunchCooperativeKernel((const void*)mega, dim3(grid), dim3(512), args, LDS_BYTES, stream);
    if (e != hipSuccess) fprintf(stderr, "cooperative launch failed: %s (grid %d)\n", hipGetErrorString(e), grid);
}
```

```cpp
#include <hip/hip_runtime.h>
#include <hip/hip_cooperative_groups.h>
#include <cstdio>
#include <cstdint>
namespace cg = cooperative_groups;
namespace pg8 {
#define PG8_LAS __attribute__((address_space(3)))
typedef unsigned short bf16_t;
typedef short bf16x8 __attribute__((ext_vector_type(8)));
typedef float f32x4 __attribute__((ext_vector_type(4)));
typedef unsigned u32x4 __attribute__((ext_vector_type(4)));
constexpr int BM = 256, BK = 64, HALF = 128, HTB = HALF * BK * 2  , STAGE_BYTES = 8 * HTB, NXCD = 8, WGM = 8;

__host__ __device__ __forceinline__ int lds_byte(int r, int c) { const int st = (r >> 4) * 2 + (c >> 5), rr = r & 15, cc = c & 31, ob = rr * 64 + cc * 2; return st * 1024 + (ob ^ (((ob >> 9) & 1) << 5)); }
__host__ __device__ __forceinline__ void stage_rc(int b, int& R, int& C) { const int st = b / 1024, sb = b % 1024, swz = sb ^ (((sb >> 9) & 1) << 5); R = (st >> 1) * 16 + swz / 64; C = (st & 1) * 32 + (swz % 64) / 2; }
__host__ __device__ __forceinline__ int perm32(int rho) { const int n = rho >> 4, i = rho & 15; return 8 * (i >> 2) + 4 * n + (i & 3); }

struct Unit { int pm, pn; };
struct Gemm { const bf16_t* A; const bf16_t* Bt; int M, N, K; };

struct StaticOrder {
    int nM, nN, nwg, G, c;
    __host__ __device__ void init(int M, int N, int G_, int c_) { nM = M / BM; nN = N / BM; nwg = nM * nN; G = G_; c = c_; }
    __host__ __device__ bool next(int i, Unit& u) const {
        const long L = (long)i * G + c; if (L >= nwg) return false;
        int wgid = (int)L; { const int q = nwg / NXCD, r = nwg % NXCD, xcd = wgid % NXCD, off = wgid / NXCD; wgid = (xcd < r ? xcd * (q + 1) : r * (q + 1) + (xcd - r) * q) + off; }
        const int nig = WGM * nN, gid = wgid / nig, fm = gid * WGM, gsz = (nM - fm) < WGM ? (nM - fm) : WGM;
        u.pm = fm + ((wgid % nig) % gsz); u.pn = (wgid % nig) / gsz; return true;
    }
    __device__ __forceinline__ void a_ready(const Unit&) const {}
    __device__ __forceinline__ void done(const Unit&) const {}
};

__device__ __forceinline__ unsigned cvt_pk_bf16(float lo, float hi) { unsigned r; asm volatile("v_cvt_pk_bf16_f32 %0, %1, %2" : "=v"(r) : "v"(lo), "v"(hi)); return r; }
typedef float f32x2 __attribute__((ext_vector_type(2)));
template <class Epi, class Sched, bool ALIGN_EPI = false, bool SP2 = false>
__device__ __forceinline__ void gemm_phase(PG8_LAS unsigned char* lds, const Gemm g, const Sched& S, const Epi& E) {
    int tid = threadIdx.x; asm volatile("" : "+v"(tid));
    const int wid = __builtin_amdgcn_readfirstlane(tid >> 6), lane = tid & 63, wr = wid >> 2, wc = wid & 3, fr = lane & 15, fq = lane >> 4;
    const int K = g.K, nt = K / BK;
    unsigned voffA[2], voffB[2];
#pragma unroll
    for (int i = 0; i < 2; ++i) { int R, C; stage_rc(tid * 16 + i * 8192, R, C); const int Rb = Epi::PERM ? ((R & ~31) + perm32(R & 31)) : R;
        voffA[i] = (unsigned)(R * K + C) * 2u; voffB[i] = (unsigned)(Rb * K + C) * 2u; }
    const size_t kstep = (size_t)(BK * 2);
    const size_t hstep = (size_t)HALF * K * 2;
    const size_t tstep = 2 * hstep;
    const unsigned ldsw = (unsigned)wid * 1024u;
    const int aoff = lds_byte(wr * 64 + fr, fq * 8), boff = lds_byte(wc * 32 + fr, fq * 8);
#define PG8_SA(b, h) (((b) * 2 + (h)) * HTB)
#define PG8_SB(b, h) ((4 + (b) * 2 + (h)) * HTB)
#define PG8_STAGE(bufoff, gbase, voff) do { _Pragma("unroll") for (int _i = 0; _i < 2; ++_i) \
        __builtin_amdgcn_global_load_lds((const unsigned*)((const char*)(gbase) + (voff)[_i]), (PG8_LAS unsigned*)(lds + (bufoff) + ldsw + _i * 8192), 16, 0, 0); } while (0)
#define PG8_LDA(dst, b, h) do { _Pragma("unroll") for (int m = 0; m < 4; ++m) _Pragma("unroll") for (int k = 0; k < 2; ++k) dst[m][k] = *(const PG8_LAS bf16x8*)(lds + PG8_SA(b, h) + aoff + m * 2048 + k * 1024); } while (0)
#define PG8_LDB(dst, b, h) do { _Pragma("unroll") for (int n = 0; n < 2; ++n) _Pragma("unroll") for (int k = 0; k < 2; ++k) dst[n][k] = *(const PG8_LAS bf16x8*)(lds + PG8_SB(b, h) + boff + n * 2048 + k * 1024); } while (0)
#define PG8_MMA(ai, bj, At, Bt) do { __builtin_amdgcn_s_setprio(1); _Pragma("unroll") for (int m = 0; m < 4; ++m) _Pragma("unroll") for (int n = 0; n < 2; ++n) _Pragma("unroll") for (int k = 0; k < 2; ++k) \
        acc[ai][bj][m][n] = __builtin_amdgcn_mfma_f32_16x16x32_bf16(Bt[n][k], At[m][k], acc[ai][bj][m][n], 0, 0, 0); __builtin_amdgcn_s_setprio(0); } while (0)
#define PG8_WAIT_V(n) asm volatile("s_waitcnt vmcnt(" #n ")" ::: "memory")
#define PG8_WAIT_L(n) asm volatile("s_waitcnt lgkmcnt(" #n ")" ::: "memory")
#define PG8_BAR __builtin_amdgcn_s_barrier()
#define PG8_SCHED __builtin_amdgcn_sched_barrier(0)
    Unit cur, nxt; int ui = 0;
    if (!S.next(0, cur)) return;
    f32x4 acc[2][2][4][2];
#pragma unroll
    for (int a = 0; a < 2; ++a)
#pragma unroll
        for (int b = 0; b < 2; ++b)
#pragma unroll
            for (int m = 0; m < 4; ++m)
#pragma unroll
                for (int n = 0; n < 2; ++n) acc[a][b][m][n] = (f32x4){0.f, 0.f, 0.f, 0.f};
    bf16x8 At[4][2], B0[2][2], B1[2][2];
    const char* cA = (const char*)g.A + (size_t)cur.pm * tstep; const char* cB = (const char*)g.Bt + (size_t)cur.pn * tstep;
    S.a_ready(cur);
    if constexpr (SP2) {
        PG8_STAGE(PG8_SB(0, 0), cB, voffB); PG8_STAGE(PG8_SB(0, 1), cB + hstep, voffB); PG8_STAGE(PG8_SA(0, 0), cA, voffA); PG8_STAGE(PG8_SA(0, 1), cA + hstep, voffA);
        if (wr == 1) PG8_BAR;
        PG8_WAIT_V(2); PG8_BAR;
        PG8_STAGE(PG8_SB(1, 0), cB + kstep, voffB); PG8_STAGE(PG8_SA(1, 0), cA + kstep, voffA); PG8_STAGE(PG8_SB(1, 1), cB + hstep + kstep, voffB);
        PG8_WAIT_V(6); PG8_BAR;
    } else {
        PG8_STAGE(PG8_SB(0, 0), cB, voffB); PG8_STAGE(PG8_SA(0, 0), cA, voffA); PG8_STAGE(PG8_SB(0, 1), cB + hstep, voffB); PG8_STAGE(PG8_SA(0, 1), cA + hstep, voffA);
        if (wr == 1) PG8_BAR;
        PG8_WAIT_V(4); PG8_BAR;
        PG8_STAGE(PG8_SB(1, 0), cB + kstep, voffB); PG8_STAGE(PG8_SA(1, 0), cA + kstep, voffA); PG8_STAGE(PG8_SB(1, 1), cB + hstep + kstep, voffB);
        PG8_WAIT_V(6); PG8_BAR;
    }
    for (;;) {
        const bool has_next = S.next(ui + 1, nxt);
        const char* nA = has_next ? (const char*)g.A + (size_t)nxt.pm * tstep : cA; const char* nB = has_next ? (const char*)g.Bt + (size_t)nxt.pn * tstep : cB;
        for (int t = 0; t < nt; t += 2) {
            const bool last = (t == nt - 2);
            const char* a1 = cA + (size_t)(t + 1) * kstep;
            const char* a2 = last ? nA : cA + (size_t)(t + 2) * kstep; const char* b2 = last ? nB : cB + (size_t)(t + 2) * kstep;
            const char* a3 = a2 + kstep; const char* b3 = b2 + kstep;
            if (last && has_next) S.a_ready(nxt);
            if constexpr (SP2) {
            PG8_LDB(B0, 0, 0); PG8_LDB(B1, 0, 1); PG8_SCHED; PG8_LDA(At, 0, 0); PG8_STAGE(PG8_SA(1, 1), a1 + hstep, voffA);
            PG8_WAIT_V(8); PG8_WAIT_L(0); PG8_BAR; PG8_MMA(0, 0, At, B0); PG8_MMA(0, 1, At, B1); PG8_BAR; PG8_SCHED;
            PG8_LDA(At, 0, 1); PG8_STAGE(PG8_SB(0, 0), b2, voffB); PG8_STAGE(PG8_SB(0, 1), b2 + hstep, voffB); PG8_STAGE(PG8_SA(0, 0), a2, voffA);
            PG8_WAIT_V(8); PG8_WAIT_L(0); PG8_BAR; PG8_MMA(1, 0, At, B0); PG8_MMA(1, 1, At, B1); PG8_BAR; PG8_SCHED;
            PG8_LDB(B0, 1, 0); PG8_LDB(B1, 1, 1); PG8_SCHED; PG8_LDA(At, 1, 0); PG8_STAGE(PG8_SA(0, 1), a2 + hstep, voffA);
            PG8_WAIT_V(8); PG8_WAIT_L(0); PG8_BAR; PG8_MMA(0, 0, At, B0); PG8_MMA(0, 1, At, B1); PG8_BAR; PG8_SCHED;
            PG8_LDA(At, 1, 1); PG8_STAGE(PG8_SB(1, 0), b3, voffB); PG8_STAGE(PG8_SB(1, 1), b3 + hstep, voffB); PG8_STAGE(PG8_SA(1, 0), a3, voffA);
            PG8_WAIT_V(8); PG8_WAIT_L(0); PG8_BAR; PG8_MMA(1, 0, At, B0); PG8_MMA(1, 1, At, B1); PG8_BAR; PG8_SCHED;
            } else {
            PG8_LDB(B0, 0, 0); PG8_SCHED; PG8_LDA(At, 0, 0); PG8_STAGE(PG8_SA(1, 1), a1 + hstep, voffA);
            PG8_WAIT_L(8); PG8_BAR; PG8_WAIT_L(0); PG8_MMA(0, 0, At, B0); PG8_BAR; PG8_SCHED;
            PG8_LDB(B1, 0, 1); PG8_STAGE(PG8_SB(0, 0), b2, voffB);
            PG8_BAR; PG8_WAIT_L(0); PG8_MMA(0, 1, At, B1); PG8_BAR;
            PG8_LDA(At, 0, 1); PG8_STAGE(PG8_SA(0, 0), a2, voffA);
            PG8_BAR; PG8_WAIT_L(0); PG8_MMA(1, 0, At, B0); PG8_BAR; PG8_SCHED;
            PG8_STAGE(PG8_SB(0, 1), b2 + hstep, voffB);
            PG8_WAIT_V(6); PG8_BAR; PG8_MMA(1, 1, At, B1); PG8_BAR;
            PG8_LDB(B0, 1, 0); PG8_SCHED; PG8_LDA(At, 1, 0); PG8_STAGE(PG8_SA(0, 1), a2 + hstep, voffA);
            PG8_WAIT_L(8); PG8_BAR; PG8_WAIT_L(0); PG8_MMA(0, 0, At, B0); PG8_BAR; PG8_SCHED;
            PG8_LDB(B1, 1, 1); PG8_STAGE(PG8_SB(1, 0), b3, voffB);
            PG8_BAR; PG8_WAIT_L(0); PG8_MMA(0, 1, At, B1); PG8_BAR;
            PG8_LDA(At, 1, 1); PG8_STAGE(PG8_SA(1, 0), a3, voffA);
            PG8_BAR; PG8_WAIT_L(0); PG8_MMA(1, 0, At, B0); PG8_BAR; PG8_SCHED;
            PG8_STAGE(PG8_SB(1, 1), b3 + hstep, voffB);
            PG8_WAIT_V(6); PG8_BAR; PG8_MMA(1, 1, At, B1); PG8_BAR;
            }
        }
        if constexpr (ALIGN_EPI) { if (wr == 0) PG8_BAR; }
        if constexpr (!Epi::AFTER_DRAIN) { E(acc, cur, wr, wc, fr, fq); S.done(cur); }
        if (!has_next) break;
#pragma unroll
        for (int a = 0; a < 2; ++a)
#pragma unroll
            for (int b = 0; b < 2; ++b)
#pragma unroll
                for (int m = 0; m < 4; ++m)
#pragma unroll
                    for (int n = 0; n < 2; ++n) acc[a][b][m][n] = (f32x4){0.f, 0.f, 0.f, 0.f};
        cur = nxt; cA = nA; cB = nB; ++ui;
        if constexpr (ALIGN_EPI) { if (wr == 1) PG8_BAR; }
    }
    PG8_WAIT_V(0);
    if constexpr (!ALIGN_EPI) { if (wr == 0) PG8_BAR; }
    PG8_BAR;
    if constexpr (Epi::AFTER_DRAIN) { E.fused(acc, cur, wr, wc, fr, fq, lds, wid, lane); S.done(cur); }
#undef PG8_SA
#undef PG8_SB
#undef PG8_STAGE
#undef PG8_LDA
#undef PG8_LDB
#undef PG8_MMA
#undef PG8_WAIT_V
#undef PG8_WAIT_L
#undef PG8_BAR
#undef PG8_SCHED
}
}

using pg8::f32x4; using pg8::bf16x8;
typedef unsigned short bf16;
typedef unsigned v4u __attribute__((ext_vector_type(4)));
typedef unsigned v2u __attribute__((ext_vector_type(2)));
typedef short s16x4 __attribute__((ext_vector_type(4)));

constexpr int DM = 1024, TLEN = 8192, CTXL = 256, TT = 8448, NLAT = 16384, NR = 16896, DFF = 2816, UC = 2560, NTILE = 528;
constexpr int NSEG = 64, SEGLEN = 132;
constexpr size_t MiB = 1u << 20;
constexpr size_t A8 = (size_t)NR * 256 * 2;
constexpr size_t OFF_MOD = 0, MOD_BYTES = 256 * 1024;
constexpr size_t OFF_XCTX = MiB / 4, OFF_XMY = 2 * MiB + MiB / 4, OFF_HU = 35 * MiB + MiB / 4, OFF_W = 126 * MiB, OFF_MIX = 167 * MiB, OFF_PR = 266 * MiB;
constexpr size_t W_13A = OFF_W, W_2A = OFF_W + 11 * MiB, W_13B = OFF_W + 16 * MiB + MiB / 2, W_2B = OFF_W + 27 * MiB + MiB / 2,
                 W_IN = OFF_W + 33 * MiB, W_OUT = OFF_W + 38 * MiB, W_UQ = OFF_W + 40 * MiB, W_UKV = OFF_W + 40 * MiB + 256 * 1024,
                 W_WUP = OFF_W + 40 * MiB + 384 * 1024, W_AUP = W_WUP + 65536, W_GUP = W_AUP + 65536, W_LWA = W_GUP + 65536, W_LWX = W_LWA + 65536;
constexpr size_t M_QB = OFF_MIX, M_KB = OFF_MIX + 12976128, M_VT = OFF_MIX + 25952256;
constexpr size_t M_LR0 = OFF_PR, M_LIX0 = OFF_PR + 2 * A8;
constexpr size_t M_SEGA = OFF_HU + 83 * MiB, M_SEGB = M_SEGA + MiB + MiB / 4, M_H0 = M_SEGB + MiB + MiB / 4;
constexpr size_t M_RR = OFF_MIX, M_KK = OFF_MIX + A8, M_VV = OFF_MIX + 2 * A8, M_WW = OFF_MIX + 3 * A8, M_BB = OFF_MIX + 7 * A8, M_KD = OFF_MIX + 9 * A8, M_GC = OFF_MIX + 11 * A8;
constexpr size_t M_YS = OFF_HU, M_PL = OFF_HU + 33 * MiB, M_SINIT = OFF_HU + 65 * MiB;
constexpr size_t M_PR = OFF_PR;
constexpr size_t WS_NEED = OFF_PR + 33 * MiB;
constexpr int LDS_BYTES = 131072 + 1024;
#ifndef REP_M1
#define REP_M1 1
#endif
#ifndef REP_M2
#define REP_M2 1
#endif
#ifndef REP_M3
#define REP_M3 1
#endif
#ifndef REP_SCAN
#define REP_SCAN 1
#endif
#ifndef REP_G1
#define REP_G1 1
#endif
constexpr float QSCALE = 0.10206207261596575f * 1.4426950408889634f;

struct Args { const float* in[40]; float* out; unsigned char* ws; };
typedef const __attribute__((address_space(4))) volatile unsigned long long kargq;
__device__ __forceinline__ const float* karg_in(int i) { kargq* p = (kargq*)__builtin_amdgcn_kernarg_segment_ptr(); return (const float*)p[i]; }
__device__ __forceinline__ float* karg_out() { kargq* p = (kargq*)__builtin_amdgcn_kernarg_segment_ptr(); return (float*)p[40]; }
__device__ __forceinline__ unsigned char* karg_ws() { kargq* p = (kargq*)__builtin_amdgcn_kernarg_segment_ptr(); return (unsigned char*)p[41]; }
#define IN(i) karg_in(i)
__device__ __forceinline__ int ltid() { int t = threadIdx.x; asm volatile("" : "+v"(t)); return t; }
__device__ __forceinline__ int lbid() { int t = blockIdx.x; asm volatile("" : "+s"(t)); return t; }
template <class T> __device__ __forceinline__ T* launder(T* p) { asm volatile("" : "+s"(p)); return p; }

__device__ __forceinline__ float bf2f(bf16 h) { return __uint_as_float((unsigned)h << 16); }
__device__ __forceinline__ unsigned f2bf(float f) { unsigned u = __float_as_uint(f); return (u + 0x7fffu + ((u >> 16) & 1u)) >> 16; }
__device__ __forceinline__ unsigned pk2(float lo, float hi) { return f2bf(lo) | (f2bf(hi) << 16); }
__device__ __forceinline__ float sigm(float x) { return 1.f / (1.f + __expf(-x)); }
__device__ __forceinline__ float siluf_(float x) { return x / (1.f + __expf(-x)); }
__device__ __forceinline__ float tanhf_(float y) { return 1.f - 2.f / (1.f + __expf(2.f * y)); }
__device__ __forceinline__ float geluf_(float x) { return 0.5f * x * (1.f + tanhf_(0.7978845608028654f * (x + 0.044715f * x * x * x))); }
__device__ __forceinline__ float wave_sum(float v) {
#pragma unroll
    for (int o = 1; o < 64; o <<= 1) v += __shfl_xor(v, o);
    return v;
}
struct TileInfo { int b, isctx, t0, seqbase, seqlen; };
__device__ __forceinline__ TileInfo tile_info(int tile) {
    TileInfo ti;
    if (tile < 512) { ti.b = tile >> 8; ti.isctx = 0; ti.t0 = (tile & 255) * 32; ti.seqbase = ti.b * TLEN; ti.seqlen = TLEN; }
    else { const int q = tile - 512; ti.b = q >> 3; ti.isctx = 1; ti.t0 = (q & 7) * 32; ti.seqbase = NLAT + ti.b * CTXL; ti.seqlen = CTXL; }
    return ti;
}

struct EpiSwiglu {
    static constexpr bool PERM = true, AFTER_DRAIN = false;
    bf16* H;
    __device__ __forceinline__ void operator()(const f32x4 (&acc)[2][2][4][2], const pg8::Unit& u, int wr, int wc, int fr, int fq) const {
        int pm = u.pm, pn = u.pn; asm volatile("" : "+s"(pm), "+s"(pn), "+s"(wr), "+s"(wc), "+v"(fr), "+v"(fq));
        bf16* tb = H + (size_t)pm * 256 * DFF + pn * 128;
        const unsigned loff = (unsigned)((wr * 64 + fr) * DFF + wc * 32 + 8 * fq);
#pragma unroll
        for (int ai = 0; ai < 2; ++ai)
#pragma unroll
            for (int m = 0; m < 4; ++m) {
                bf16* rowp = tb + (loff + (unsigned)((ai * 128 + m * 16) * DFF));
                const f32x4 g0 = acc[ai][0][m][0], g1 = acc[ai][0][m][1], u0 = acc[ai][1][m][0], u1 = acc[ai][1][m][1];
                v4u w;
                w.x = pg8::cvt_pk_bf16(siluf_(g0[0]) * u0[0], siluf_(g0[1]) * u0[1]); w.y = pg8::cvt_pk_bf16(siluf_(g0[2]) * u0[2], siluf_(g0[3]) * u0[3]);
                w.z = pg8::cvt_pk_bf16(siluf_(g1[0]) * u1[0], siluf_(g1[1]) * u1[1]); w.w = pg8::cvt_pk_bf16(siluf_(g1[2]) * u1[2], siluf_(g1[3]) * u1[3]);
                *(v4u*)rowp = w;
            }
    }
};
struct EpiU {
    static constexpr bool PERM = true, AFTER_DRAIN = false;
    bf16* O; int ldc;
    __device__ __forceinline__ void operator()(const f32x4 (&acc)[2][2][4][2], const pg8::Unit& u, int wr, int wc, int fr, int fq) const {
        int pm = u.pm, pn = u.pn; asm volatile("" : "+s"(pm), "+s"(pn), "+s"(wr), "+s"(wc), "+v"(fr), "+v"(fq));
        bf16* tb = O + (size_t)pm * 256 * ldc + pn * 256;
        const unsigned loff = (unsigned)((wr * 64 + fr) * ldc + wc * 32 + 8 * fq);
#pragma unroll
        for (int ai = 0; ai < 2; ++ai)
#pragma unroll
            for (int m = 0; m < 4; ++m) {
                bf16* rowp = tb + (loff + (unsigned)((ai * 128 + m * 16) * ldc));
#pragma unroll
                for (int bj = 0; bj < 2; ++bj) { const f32x4 v0 = acc[ai][bj][m][0], v1 = acc[ai][bj][m][1]; v4u w;
                    w.x = pg8::cvt_pk_bf16(v0[0], v0[1]); w.y = pg8::cvt_pk_bf16(v0[2], v0[3]); w.z = pg8::cvt_pk_bf16(v1[0], v1[1]); w.w = pg8::cvt_pk_bf16(v1[2], v1[3]);
                    *(v4u*)(rowp + bj * 128) = w; }
            }
    }
};
struct EpiResid {
    static constexpr bool PERM = false, AFTER_DRAIN = false;
    float* xlat; float* xctx; const float* gate; float coef; const float* slat; const float* sctx;
    __device__ __forceinline__ void operator()(const f32x4 (&acc)[2][2][4][2], const pg8::Unit& u, int wr, int wc, int fr, int fq) const {
        int pm = u.pm, pn = u.pn; asm volatile("" : "+s"(pm), "+s"(pn), "+s"(wr), "+s"(wc), "+v"(fr), "+v"(fq));
        const size_t toff = (pm < 64 ? (size_t)pm : (size_t)(pm - 64)) * 256 * DM + pn * 256;
        float* tb = (pm < 64 ? xlat : xctx) + toff; const float* sb = (pm < 64 ? slat : sctx) + toff;
        const float* g = gate + (pm < 64 ? (pm >> 5) : 2) * 9216 + pn * 256;
        const unsigned coff = (unsigned)(wc * 32 + 4 * fq), loff = (unsigned)((wr * 64 + fr) * DM) + coff;
        f32x4 gv[2][2];
#pragma unroll
        for (int bj = 0; bj < 2; ++bj)
#pragma unroll
            for (int n = 0; n < 2; ++n) gv[bj][n] = coef * *(const f32x4*)(g + (coff + (unsigned)(bj * 128 + n * 16)));
#pragma unroll
        for (int ai = 0; ai < 2; ++ai)
#pragma unroll
            for (int m = 0; m < 4; ++m) {
                float* xr = tb + (loff + (unsigned)((ai * 128 + m * 16) * DM)); const float* sr = sb + (loff + (unsigned)((ai * 128 + m * 16) * DM));
#pragma unroll
                for (int bj = 0; bj < 2; ++bj)
#pragma unroll
                    for (int n = 0; n < 2; ++n) { float* xp = xr + (bj * 128 + n * 16);
                        f32x4 xv = *(const f32x4*)(sr + (bj * 128 + n * 16)); xv += gv[bj][n] * acc[ai][bj][m][n]; *(f32x4*)xp = xv; }
                asm volatile("" ::: "memory");
            }
    }
};

__device__ __forceinline__ void phase_modgemv(const Args& a, float* red, int G, int bid, int tid) {
    const float* c = IN(1); const float* cctx = IN(3); const float* ada_w = IN(4); const float* ada_b = IN(5);
    float* mod = (float*)(karg_ws() + OFF_MOD);
    const int w = tid >> 6, lane = tid & 63;
    for (int u = bid; u < 576; u += G) {
        const int l = u / 288, rem = u % 288, jt = rem >> 3, ks = rem & 7;
        const int kb = ks * 128 + w * 16, j0 = jt * 256 + lane * 4;
        f32x4 acc0 = {0.f, 0.f, 0.f, 0.f}, acc1 = acc0, acc2 = acc0;
        for (int kk = 0; kk < 16; ++kk) { const int k = kb + kk;
            const float s0 = siluf_(c[k]), s1 = siluf_(c[1024 + k]), s2 = siluf_(cctx[k]);
            const f32x4 wv = *(const f32x4*)(ada_w + ((size_t)(l * 1024 + k)) * 9216 + j0);
            acc0 += s0 * wv; acc1 += s1 * wv; acc2 += s2 * wv; }
        float* rp = red + (w * 3) * 256 + lane * 4;
        *(f32x4*)rp = acc0; *(f32x4*)(rp + 256) = acc1; *(f32x4*)(rp + 512) = acc2;
        __syncthreads();
        for (int o = tid; o < 768; o += 512) { const int m = o >> 8, jj = o & 255; float s = 0.f;
#pragma unroll
            for (int ww = 0; ww < 8; ++ww) s += red[(ww * 3 + m) * 256 + jj];
            const int j = jt * 256 + jj; if (ks == 0) s += ada_b[l * 9216 + j];
            atomicAdd(&mod[(l * 3 + m) * 9216 + j], s); }
        __syncthreads();
    }
}
__device__ __forceinline__ void phase_copy(const Args& a, int G, int bid, int tid) {
    const f32x4* x4 = (const f32x4*)IN(0); f32x4* o4 = (f32x4*)karg_out();
    for (int i = bid * 512 + tid; i < NLAT * DM / 4; i += G * 512) o4[i] = x4[i];
    const f32x4* c4 = (const f32x4*)IN(2); f32x4* xc4 = (f32x4*)(karg_ws() + OFF_XCTX);
    for (int i = bid * 512 + tid; i < 512 * DM / 4; i += G * 512) xc4[i] = c4[i];
}
__device__ __forceinline__ int swiglu_map(int n) { return n < DFF ? ((n >> 7) * 256 + (n & 127)) : ((((n - DFF) >> 7) * 256) + 128 + ((n - DFF) & 127)); }
__device__ __forceinline__ void transpose_item(const float* W, int K, int N, bf16* WT, float* scr, int item, int lane, int mode, const float* kscale) {
    const int nblk = N / 32, kb = item / nblk, nb = item % nblk, k0 = 64 * kb, n0 = 32 * nb;
    float tv[32];
#pragma unroll
    for (int i = 0; i < 32; ++i) { const int kk = 2 * i + (lane >> 5); tv[i] = W[(size_t)(k0 + kk) * N + n0 + (lane & 31)]; }
#pragma unroll
    for (int i = 0; i < 32; ++i) { const int kk = 2 * i + (lane >> 5); float v = tv[i]; if (kscale) v *= kscale[k0 + kk]; scr[kk * 33 + (lane & 31)] = v; }
    __builtin_amdgcn_wave_barrier();
    const int c = lane & 7;
#pragma unroll
    for (int j = 0; j < 4; ++j) { const int n = (lane >> 3) + 8 * j; const float* s = scr + (8 * c) * 33 + n;
        v4u o; o.x = pk2(s[0 * 33], s[1 * 33]); o.y = pk2(s[2 * 33], s[3 * 33]); o.z = pk2(s[4 * 33], s[5 * 33]); o.w = pk2(s[6 * 33], s[7 * 33]);
        const int nn = n0 + n, drow = mode ? swiglu_map(nn) : nn;
        *(v4u*)(WT + (size_t)drow * K + k0 + 8 * c) = o; }
    __builtin_amdgcn_wave_barrier();
}
__device__ __forceinline__ void convert_weights(const Args& a, int l, float* scr, int gw, int NGW, int lane, int G, int bid, int tid) {
    constexpr int I13 = 16 * 176, I2 = 44 * 32, IIN = 16 * 77, IOUT = 16 * 32, IUQ = 4 * 12, IUKV = 2 * 16;
    constexpr int IEX = 80;
    constexpr int NIT = 2 * I13 + 2 * I2 + IIN + IOUT + IUQ + IUKV + IEX;
    unsigned char* ws = karg_ws();
    for (int it = gw; it < NIT; it += NGW) {
        int r = it;
        if (r < I13) { transpose_item(IN(6) + (size_t)l * DM * 2 * DFF, DM, 2 * DFF, (bf16*)(ws + W_13A), scr, r, lane, 1, nullptr); continue; } r -= I13;
        if (r < I13) { transpose_item(IN(8) + (size_t)l * DM * 2 * DFF, DM, 2 * DFF, (bf16*)(ws + W_13B), scr, r, lane, 1, nullptr); continue; } r -= I13;
        if (r < I2) { transpose_item(IN(7) + (size_t)l * DFF * DM, DFF, DM, (bf16*)(ws + W_2A), scr, r, lane, 0, nullptr); continue; } r -= I2;
        if (r < I2) { transpose_item(IN(9) + (size_t)l * DFF * DM, DFF, DM, (bf16*)(ws + W_2B), scr, r, lane, 0, nullptr); continue; } r -= I2;
        if (r < IIN) { transpose_item(IN(10) + (size_t)l * DM * 2464, DM, 2464, (bf16*)(ws + W_IN), scr, r, lane, 0, nullptr); continue; } r -= IIN;
        if (r < IOUT) { transpose_item(IN(11) + (size_t)l * DM * DM, DM, DM, (bf16*)(ws + W_OUT), scr, r, lane, 0, nullptr); continue; } r -= IOUT;
        if (r < IUQ) { transpose_item(IN(36) + (size_t)l * 256 * 384, 256, 384, (bf16*)(ws + W_UQ), scr, r, lane, 0, IN(35) + l * 256); continue; } r -= IUQ;
        if (r < IUKV) { transpose_item(IN(38) + (size_t)l * 128 * 512, 128, 512, (bf16*)(ws + W_UKV), scr, r, lane, 0, IN(37) + l * 128); continue; } r -= IUKV;
        if (r < 16) { const int d = r >> 3; transpose_item(IN(26) + (size_t)(l * 2 + d) * 64 * 256, 64, 256, (bf16*)(ws + W_WUP) + d * 256 * 64, scr, r & 7, lane, 0, nullptr); continue; } r -= 16;
        if (r < 16) { const int d = r >> 3; transpose_item(IN(28) + (size_t)(l * 2 + d) * 64 * 256, 64, 256, (bf16*)(ws + W_AUP) + d * 256 * 64, scr, r & 7, lane, 0, nullptr); continue; } r -= 16;
        if (r < 16) { transpose_item(IN(29) + (size_t)l * 128 * 256, 128, 256, (bf16*)(ws + W_GUP), scr, r, lane, 0, nullptr); continue; } r -= 16;
        if (r < 16) { const int m = r >> 1; transpose_item(IN(18) + (size_t)(l * 8 + m) * 4096, 64, 64, (bf16*)(ws + W_LWA) + m * 4096, scr, r & 1, lane, 0, nullptr); continue; } r -= 16;
        { const int m = r >> 1; transpose_item(IN(20) + (size_t)(l * 8 + m) * 4096, 64, 64, (bf16*)(ws + W_LWX) + m * 4096, scr, r & 1, lane, 0, nullptr); }
    }
    v4u z = {0u, 0u, 0u, 0u}; v4u* zp = (v4u*)(ws + W_IN + (size_t)2464 * DM * 2);
    for (int i = bid * 512 + tid; i < 96 * DM * 2 / 16; i += G * 512) zp[i] = z;
}
__device__ __forceinline__ void phase_modulate(const Args& a, int l, int which, int gw, int NGW, int lane) {
    unsigned char* ws = karg_ws(); const float* outp = karg_out();
    const bool first = (l == 0 && which == 0);
    const float* srcl = first ? IN(0) : outp; const float* srcc = first ? IN(2) : (const float*)(ws + OFF_XCTX);
    const float* mod = (const float*)(ws + OFF_MOD) + (size_t)l * 3 * 9216;
    bf16* XM = (bf16*)(ws + OFF_XMY);
    for (int r = gw; r < NR; r += NGW) {
        const float* xr = r < NLAT ? srcl + (size_t)r * DM : srcc + (size_t)(r - NLAT) * DM;
        const float* mm = mod + (r < NLAT ? (r >> 13) : 2) * 9216 + which * 3 * 1024;
        f32x4 v[4]; float ss = 0.f;
#pragma unroll
        for (int j = 0; j < 4; ++j) { v[j] = *(const f32x4*)(xr + 4 * lane + 256 * j); ss += (v[j][0] * v[j][0] + v[j][1] * v[j][1]) + (v[j][2] * v[j][2] + v[j][3] * v[j][3]); }
        const float rstd = rsqrtf(wave_sum(ss) * (1.f / DM) + 1e-6f);
#pragma unroll
        for (int j = 0; j < 4; ++j) { const int c = 4 * lane + 256 * j; const f32x4 sh = *(const f32x4*)(mm + c), sc = *(const f32x4*)(mm + 1024 + c);
            const f32x4 o = v[j] * rstd * (1.f + sc) + sh; v2u w; w.x = pk2(o[0], o[1]); w.y = pk2(o[2], o[3]);
            *(v2u*)(XM + (size_t)r * DM + c) = w; }
    }
}
__device__ __forceinline__ void phase_final(const Args& a, int gw, int NGW, int lane) {
    const float* fn = IN(39); float* outp = karg_out();
    for (int r = gw; r < NLAT; r += NGW) {
        float* xr = outp + (size_t)r * DM; f32x4 v[4]; float ss = 0.f;
#pragma unroll
        for (int j = 0; j < 4; ++j) { v[j] = *(const f32x4*)(xr + 4 * lane + 256 * j); ss += (v[j][0] * v[j][0] + v[j][1] * v[j][1]) + (v[j][2] * v[j][2] + v[j][3] * v[j][3]); }
        const float rstd = rsqrtf(wave_sum(ss) * (1.f / DM) + 1e-6f);
#pragma unroll
        for (int j = 0; j < 4; ++j) { const int c = 4 * lane + 256 * j; const f32x4 g = *(const f32x4*)(fn + c); *(f32x4*)(xr + c) = v[j] * rstd * g; }
    }
}

__device__ __forceinline__ void phase_m1(const Args& a, int l, unsigned char* lds, int G, int bid, int tid_unused) {
    unsigned char* ws = karg_ws();
    const bf16* U = (const bf16*)(ws + OFF_HU);
    bf16* Y = (bf16*)(ws + OFF_XMY);
    for (int pass = 0; pass < 2; ++pass)
    for (int tile = (pass == 0 ? bid : (bid < 48 ? 512 + bid / 3 : NTILE)); tile < (pass == 0 ? 512 : NTILE); tile += (pass == 0 ? G : NTILE)) {
        const int mask = pass == 0 ? 7 : ((1 << (bid % 3)) & (l == 1 ? 6 : 7));
        const TileInfo ti = tile_info(tile);
        const int row0 = tile * 32;
        if (mask & 1) {
            const int tid = ltid(); const int lane = tid & 63, wave = __builtin_amdgcn_readfirstlane(tid >> 6), ch = tid & 255, part = tid >> 8; (void)lane; (void)wave; (void)ch; (void)part;
            float* z = (float*)lds;
            float* cv = (float*)(lds + 65536);
            for (int tt = part; tt < 62; tt += 2) { const int t = ti.t0 - 15 + tt; float zz = 0.f;
                if (t >= 0 && t < ti.seqlen) { const bf16* ur = U + (size_t)(ti.seqbase + t) * UC; zz = bf2f(ur[ch]) * sigm(bf2f(ur[256 + ch])); }
                z[tt * 256 + ch] = zz; }
            __syncthreads();
            const float* dw = IN(12) + (size_t)l * 31 * 256 + ch;
            float acc[16]; const float bias = IN(13)[l * 256 + ch];
#pragma unroll
            for (int o = 0; o < 16; ++o) acc[o] = bias;
            for (int j = 0; j < 31; ++j) { const float w = dw[j * 256];
#pragma unroll
                for (int o = 0; o < 16; ++o) acc[o] += w * z[(part * 16 + o + j) * 256 + ch]; }
#pragma unroll
            for (int o = 0; o < 16; ++o) cv[(part * 16 + o) * 256 + ch] = acc[o];
            __syncthreads();
            const f32x4 lg = *(const f32x4*)(IN(14) + l * 256 + lane * 4), lb = *(const f32x4*)(IN(15) + l * 256 + lane * 4);
#pragma unroll
            for (int q = 0; q < 4; ++q) { const int t = wave * 4 + q; const f32x4 v = *(const f32x4*)(cv + t * 256 + lane * 4);
                const float mu = wave_sum((v[0] + v[1]) + (v[2] + v[3])) * (1.f / 256.f);
                const f32x4 dv = v - mu; const float var = wave_sum((dv[0] * dv[0] + dv[1] * dv[1]) + (dv[2] * dv[2] + dv[3] * dv[3])) * (1.f / 256.f);
                const f32x4 yn = dv * rsqrtf(var + 1e-5f) * lg + lb;
                v2u w; w.x = pk2(siluf_(yn[0]), siluf_(yn[1])); w.y = pk2(siluf_(yn[2]), siluf_(yn[3]));
                *(v2u*)(Y + (size_t)(row0 + t) * DM + lane * 4) = w; }
            __syncthreads();
        }
        if (mask & 2) {
            float* xvf = (float*)lds;
            bf16* xvb = (bf16*)(lds + 32768);
            bf16* rg = (bf16*)(lds + 49664);
            bf16* ixg = (bf16*)(lds + 82432);
            {
                const int tid = ltid(); const int ch = tid & 255, part = tid >> 8;
                const float* cw = IN(16) + (size_t)l * 4 * 256 + ch; const float w0 = cw[0], w1 = cw[256], w2 = cw[512], w3 = cw[768], cb = IN(17)[l * 256 + ch];
                float xin[19];
#pragma unroll
                for (int i = 0; i < 19; ++i) { const int t = ti.t0 + part * 16 + i - 2; xin[i] = (t >= 0 && t < ti.seqlen) ? bf2f(U[(size_t)(ti.seqbase + t) * UC + 512 + ch]) : 0.f; }
#pragma unroll
                for (int o = 0; o < 16; ++o) { const int tl = part * 16 + o;
                    const float v = cb + w0 * xin[o] + w1 * xin[o + 1] + w2 * xin[o + 2] + w3 * xin[o + 3];
                    xvf[tl * 256 + ch] = v; xvb[tl * 264 + ch] = (bf16)f2bf(v);
                }
            }
            __syncthreads();
            {
                const int tid = ltid(); const int ln = tid & 63, wv = __builtin_amdgcn_readfirstlane(tid >> 6), fr = ln & 15, fq = ln >> 4, blk = wv >> 1;
                const bf16* LWAt = (const bf16*)(ws + W_LWA); const bf16* LWXt = (const bf16*)(ws + W_LWX);
                bf16x8 af[2][2];
#pragma unroll
                for (int mt = 0; mt < 2; ++mt)
#pragma unroll
                    for (int ks = 0; ks < 2; ++ks) af[mt][ks] = *(const bf16x8*)(xvb + (mt * 16 + fr) * 264 + blk * 64 + ks * 32 + fq * 8);
#pragma unroll 1
                for (int dn = 0; dn < 4; ++dn) { const int d = dn >> 1, nt = wv * 2 + (dn & 1), ch = nt * 16 + fr, jj = (nt & 3) * 16 + fr;
                    f32x4 ca[2], cx[2];
#pragma unroll
                    for (int mt = 0; mt < 2; ++mt) { ca[mt] = (f32x4){0.f, 0.f, 0.f, 0.f}; cx[mt] = ca[mt]; }
#pragma unroll
                    for (int ks = 0; ks < 2; ++ks) { const size_t wo = ((size_t)(d * 4 + blk) * 64 + jj) * 64 + ks * 32 + fq * 8;
                        const bf16x8 ba = *(const bf16x8*)(LWAt + wo), bx = *(const bf16x8*)(LWXt + wo);
#pragma unroll
                        for (int mt = 0; mt < 2; ++mt) { ca[mt] = __builtin_amdgcn_mfma_f32_16x16x32_bf16(af[mt][ks], ba, ca[mt], 0, 0, 0); cx[mt] = __builtin_amdgcn_mfma_f32_16x16x32_bf16(af[mt][ks], bx, cx[mt], 0, 0, 0); } }
                    const float bga = IN(19)[(l * 2 + d) * 256 + ch], bgx = IN(21)[(l * 2 + d) * 256 + ch];
                    bf16* LR = (bf16*)(ws + M_LR0 + (size_t)d * A8); bf16* LIX = (bf16*)(ws + M_LIX0 + (size_t)d * A8);
#pragma unroll
                    for (int mt = 0; mt < 2; ++mt)
#pragma unroll
                        for (int j = 0; j < 4; ++j) { const int t = mt * 16 + fq * 4 + j;
                            const bf16 rb = (bf16)f2bf(sigm(ca[mt][j] + bga)), ib = (bf16)f2bf(sigm(cx[mt][j] + bgx) * xvf[t * 256 + ch]);
                            LR[(size_t)(row0 + t) * 256 + ch] = rb; LIX[(size_t)(row0 + t) * 256 + ch] = ib;
                            rg[(d * 32 + t) * 256 + ch] = rb; ixg[(d * 32 + t) * 256 + ch] = ib; }
                }
            }
            __syncthreads();
            {
                const int tid = ltid(); const int ch = tid & 255, d = tid >> 8;
                const float lam = IN(22)[(l * 2 + d) * 256 + ch];
                const float cch = -8.f * log1pf(__expf(-lam));
                float A = 1.f, B = 0.f;
#pragma unroll 8
                for (int tt = 0; tt < 32; ++tt) { const int t = d ? 31 - tt : tt;
                    const float al = __expf(cch * bf2f(rg[(d * 32 + t) * 256 + ch])); const float bb = sqrtf(fmaxf(1.f - al * al, 0.f)) * bf2f(ixg[(d * 32 + t) * 256 + ch]); B = al * B + bb; A *= al; }
                ((float*)(ws + M_SEGA))[(size_t)(tile * 2 + d) * 256 + ch] = A;
                ((float*)(ws + M_SEGB))[(size_t)(tile * 2 + d) * 256 + ch] = B;
            }
            __syncthreads();
        }
        if (mask & 4) {
            const int tid = ltid(); const int lane = tid & 63, wave = __builtin_amdgcn_readfirstlane(tid >> 6), ch = tid & 255, part = tid >> 8; (void)lane; (void)wave; (void)ch; (void)part;
            bf16* As = (bf16*)lds;
            float* kr = (float*)(lds + 32768);
            float* rs = (float*)(lds + 32768 + 4096);
            for (int idx = tid; idx < 32 * 52; idx += 512) { const int t = idx / 52, cc = idx % 52;
                const v4u v = *(const v4u*)(U + (size_t)(row0 + t) * UC + 2048 + cc * 8);
                if (cc < 48) *(v4u*)(As + t * 392 + cc * 8) = v;
                else { const int c0 = (cc - 48) * 8; float* kp = kr + t * 32 + c0;
                    kp[0] = __uint_as_float(v.x << 16); kp[1] = __uint_as_float(v.x & 0xffff0000u); kp[2] = __uint_as_float(v.y << 16); kp[3] = __uint_as_float(v.y & 0xffff0000u);
                    kp[4] = __uint_as_float(v.z << 16); kp[5] = __uint_as_float(v.z & 0xffff0000u); kp[6] = __uint_as_float(v.w << 16); kp[7] = __uint_as_float(v.w & 0xffff0000u); } }
            __syncthreads();
#pragma unroll
            for (int q = 0; q < 4; ++q) { const int t = wave * 4 + q; float sq = 0.f, sk = 0.f;
#pragma unroll
                for (int j = 0; j < 4; ++j) { const float v = bf2f(As[t * 392 + lane + 64 * j]); sq += v * v; }
#pragma unroll
                for (int j = 0; j < 2; ++j) { const float v = bf2f(As[t * 392 + 256 + lane + 64 * j]); sk += v * v; }
                sq = wave_sum(sq); sk = wave_sum(sk);
                if (lane == 0) { rs[t * 2] = rsqrtf(sq * (1.f / 256.f) + 1e-6f); rs[t * 2 + 1] = rsqrtf(sk * (1.f / 128.f) + 1e-6f); } }
            __syncthreads();
            const int fr = lane & 15, fq = lane >> 4;
            bf16* QB = (bf16*)(ws + M_QB); bf16* KB = (bf16*)(ws + M_KB); bf16* VT = (bf16*)(ws + M_VT);
            const bf16* WUQ = (const bf16*)(ws + W_UQ); const bf16* WUKV = (const bf16*)(ws + W_UKV);
            const int keybase = ti.isctx ? TLEN : 0;
#pragma unroll 1
            for (int i = 0; i < 3; ++i) { const int nt = wave * 3 + i;
                f32x4 c0 = {0.f, 0.f, 0.f, 0.f}, c1 = c0;
#pragma unroll
                for (int ks = 0; ks < 8; ++ks) { const bf16x8 bfr = *(const bf16x8*)(WUQ + (size_t)(nt * 16 + fr) * 256 + ks * 32 + fq * 8);
                    const bf16x8 a0 = *(const bf16x8*)(As + fr * 392 + ks * 32 + fq * 8), a1 = *(const bf16x8*)(As + (16 + fr) * 392 + ks * 32 + fq * 8);
                    c0 = __builtin_amdgcn_mfma_f32_16x16x32_bf16(a0, bfr, c0, 0, 0, 0); c1 = __builtin_amdgcn_mfma_f32_16x16x32_bf16(a1, bfr, c1, 0, 0, 0); }
                const int hq = nt / 6, wt = nt % 6, dd = wt * 16 + fr;
#pragma unroll
                for (int mt = 0; mt < 2; ++mt)
#pragma unroll
                    for (int j = 0; j < 4; ++j) { const int tl = mt * 16 + fq * 4 + j; const int t = ti.t0 + tl;
                        float v = (mt ? c1[j] : c0[j]) * rs[tl * 2];
                        const float pv = __shfl_xor(v, 8);
                        if (wt >= 4 && !ti.isctx) { const int f = fr & 7; const float pos = (wt == 4) ? (float)(t >> 6) : (float)(t & 63);
                            const float ang = pos * __expf(-(float)f * (9.210340371976184f / 8.f)); float sn, cs; __sincosf(ang, &sn, &cs);
                            v = (fr & 8) ? (v * cs + pv * sn) : (v * cs - pv * sn); }
                        QB[((size_t)(ti.b * 4 + hq) * TT + keybase + t) * 96 + dd] = (bf16)f2bf(v * QSCALE); } }
#pragma unroll 1
            for (int i = 0; i < 4; ++i) { const int nt = wave * 4 + i;
                f32x4 c0 = {0.f, 0.f, 0.f, 0.f}, c1 = c0;
#pragma unroll
                for (int ks = 0; ks < 4; ++ks) { const bf16x8 bfr = *(const bf16x8*)(WUKV + (size_t)(nt * 16 + fr) * 128 + ks * 32 + fq * 8);
                    const bf16x8 a0 = *(const bf16x8*)(As + fr * 392 + 256 + ks * 32 + fq * 8), a1 = *(const bf16x8*)(As + (16 + fr) * 392 + 256 + ks * 32 + fq * 8);
                    c0 = __builtin_amdgcn_mfma_f32_16x16x32_bf16(a0, bfr, c0, 0, 0, 0); c1 = __builtin_amdgcn_mfma_f32_16x16x32_bf16(a1, bfr, c1, 0, 0, 0); }
                const int hk = nt >> 3, wt = nt & 7;
#pragma unroll
                for (int mt = 0; mt < 2; ++mt)
#pragma unroll
                    for (int j = 0; j < 4; ++j) { const int tl = mt * 16 + fq * 4 + j; const int key = keybase + ti.t0 + tl;
                        const float v = (mt ? c1[j] : c0[j]) * rs[tl * 2 + 1];
                        if (wt < 4) KB[((size_t)(ti.b * 4 + hk) * TT + key) * 96 + wt * 16 + fr] = (bf16)f2bf(v);
                        else VT[((size_t)(ti.b * 4 + hk) * 64 + (wt - 4) * 16 + fr) * TT + key] = (bf16)f2bf(v); } }
            { const int tl = tid >> 4, p = tid & 15, ax = p >> 3, f = p & 7; const int t = ti.t0 + tl;
                float x0 = kr[tl * 32 + ax * 16 + f], x1 = kr[tl * 32 + ax * 16 + 8 + f];
                if (!ti.isctx) { const float pos = ax == 0 ? (float)(t >> 6) : (float)(t & 63); const float ang = pos * __expf(-(float)f * (9.210340371976184f / 8.f));
                    float sn, cs; __sincosf(ang, &sn, &cs); const float y0 = x0 * cs - x1 * sn, y1 = x1 * cs + x0 * sn; x0 = y0; x1 = y1; }
                const bf16 b0 = (bf16)f2bf(x0), b1 = (bf16)f2bf(x1);
#pragma unroll
                for (int h = 0; h < 4; ++h) { bf16* kp = KB + ((size_t)(ti.b * 4 + h) * TT + keybase + t) * 96 + 64 + ax * 16 + f; kp[0] = b0; kp[8] = b1; } }
            __syncthreads();
        }
    }
}

__device__ __forceinline__ void attn_unit(unsigned char* lds, const bf16* QB, const bf16* KB, const bf16* VT, bf16* Y, int b, int h, int q0, int key_lo, int nkt, int tid) {
    const int lane = tid & 63, wave = tid >> 6, fr = lane & 15, fq = lane >> 4;
    const int bh = b * 4 + h;
    constexpr int KSTR = 104, VSTR = 72, KBUF = 64 * KSTR, VBUF = 64 * VSTR;
    bf16* Ks = (bf16*)lds;
    bf16* Vs = (bf16*)lds + 2 * KBUF;
    const int qw = q0 + wave * 32;
    bf16x8 qf[2][3];
#pragma unroll
    for (int qt = 0; qt < 2; ++qt)
#pragma unroll
        for (int ks = 0; ks < 3; ++ks) qf[qt][ks] = *(const bf16x8*)(QB + ((size_t)bh * TT + qw + qt * 16 + fr) * 96 + ks * 32 + fq * 8);
    float mrun[2] = {-1e30f, -1e30f}, lrun[2] = {0.f, 0.f};
    f32x4 o[4][2];
#pragma unroll
    for (int dt = 0; dt < 4; ++dt)
#pragma unroll
        for (int qt = 0; qt < 2; ++qt) o[dt][qt] = (f32x4){0.f, 0.f, 0.f, 0.f};
    const v4u* kg = (const v4u*)(KB + ((size_t)bh * TT + key_lo) * 96);
    const bf16* vg = VT + ((size_t)bh * 64 + (tid >> 3)) * TT + key_lo + (tid & 7) * 8;
    const int kc0 = tid, kc1 = 512 + tid;
    const int ko0 = (kc0 / 12) * KSTR + (kc0 % 12) * 8, ko1 = (kc1 / 12) * KSTR + (kc1 % 12) * 8, vo = (tid >> 3) * VSTR + (tid & 7) * 8;
    v4u rk0, rk1 = {0u, 0u, 0u, 0u}, rv;
    rk0 = kg[kc0]; if (tid < 256) rk1 = kg[kc1]; rv = *(const v4u*)vg;
    *(v4u*)(Ks + ko0) = rk0; if (tid < 256) *(v4u*)(Ks + ko1) = rk1; *(v4u*)(Vs + vo) = rv;
    __syncthreads();
    for (int kt = 0; kt < nkt; ++kt) {
        const int cur = kt & 1;
        if (kt + 1 < nkt) { const v4u* kn = kg + (size_t)(kt + 1) * 768; rk0 = kn[kc0]; if (tid < 256) rk1 = kn[kc1]; rv = *(const v4u*)(vg + (kt + 1) * 64); }
        const bf16* kb = Ks + cur * KBUF; const bf16* vb = Vs + cur * VBUF;
        f32x4 st[4][2];
#pragma unroll
        for (int k4 = 0; k4 < 4; ++k4) {
            st[k4][0] = (f32x4){0.f, 0.f, 0.f, 0.f}; st[k4][1] = st[k4][0];
#pragma unroll
            for (int ks = 0; ks < 3; ++ks) { const bf16x8 kf = *(const bf16x8*)(kb + (k4 * 16 + fr) * KSTR + ks * 32 + fq * 8);
                st[k4][0] = __builtin_amdgcn_mfma_f32_16x16x32_bf16(kf, qf[0][ks], st[k4][0], 0, 0, 0);
                st[k4][1] = __builtin_amdgcn_mfma_f32_16x16x32_bf16(kf, qf[1][ks], st[k4][1], 0, 0, 0); }
        }
        bf16x8 pb[2][2];
#pragma unroll
        for (int qt = 0; qt < 2; ++qt) {
            float mx = st[0][qt][0];
#pragma unroll
            for (int k4 = 0; k4 < 4; ++k4)
#pragma unroll
                for (int j = 0; j < 4; ++j) mx = fmaxf(mx, st[k4][qt][j]);
            mx = fmaxf(mx, __shfl_xor(mx, 16)); mx = fmaxf(mx, __shfl_xor(mx, 32));
            const float mn = fmaxf(mrun[qt], mx), alpha = __builtin_amdgcn_exp2f(mrun[qt] - mn); mrun[qt] = mn;
            float ls = 0.f;
#pragma unroll
            for (int k4 = 0; k4 < 4; ++k4)
#pragma unroll
                for (int j = 0; j < 4; ++j) { const float p = __builtin_amdgcn_exp2f(st[k4][qt][j] - mn); st[k4][qt][j] = p; ls += p; }
            lrun[qt] = lrun[qt] * alpha + ls;
#pragma unroll
            for (int dt = 0; dt < 4; ++dt) o[dt][qt] *= alpha;
#pragma unroll
            for (int u = 0; u < 2; ++u) { v4u w;
                w.x = pg8::cvt_pk_bf16(st[2 * u][qt][0], st[2 * u][qt][1]); w.y = pg8::cvt_pk_bf16(st[2 * u][qt][2], st[2 * u][qt][3]);
                w.z = pg8::cvt_pk_bf16(st[2 * u + 1][qt][0], st[2 * u + 1][qt][1]); w.w = pg8::cvt_pk_bf16(st[2 * u + 1][qt][2], st[2 * u + 1][qt][3]);
                pb[u][qt] = __builtin_bit_cast(bf16x8, w); }
        }
#pragma unroll
        for (int dt = 0; dt < 4; ++dt)
#pragma unroll
            for (int u = 0; u < 2; ++u) {
                const v2u lo = *(const v2u*)(vb + (dt * 16 + fr) * VSTR + 32 * u + 4 * fq), hi = *(const v2u*)(vb + (dt * 16 + fr) * VSTR + 32 * u + 16 + 4 * fq);
                v4u vw; vw.x = lo.x; vw.y = lo.y; vw.z = hi.x; vw.w = hi.y;
                const bf16x8 va = __builtin_bit_cast(bf16x8, vw);
                o[dt][0] = __builtin_amdgcn_mfma_f32_16x16x32_bf16(va, pb[u][0], o[dt][0], 0, 0, 0);
                o[dt][1] = __builtin_amdgcn_mfma_f32_16x16x32_bf16(va, pb[u][1], o[dt][1], 0, 0, 0);
            }
        if (kt + 1 < nkt) { const int nb = cur ^ 1; *(v4u*)(Ks + nb * KBUF + ko0) = rk0; if (tid < 256) *(v4u*)(Ks + nb * KBUF + ko1) = rk1; *(v4u*)(Vs + nb * VBUF + vo) = rv; }
        __syncthreads();
    }
#pragma unroll
    for (int qt = 0; qt < 2; ++qt) {
        float lt = lrun[qt]; lt += __shfl_xor(lt, 16); lt += __shfl_xor(lt, 32);
        const float inv = 1.f / lt;
        const int q = qw + qt * 16 + fr;
        const size_t row = q < TLEN ? (size_t)b * TLEN + q : (size_t)NLAT + b * CTXL + (q - TLEN);
#pragma unroll
        for (int dt = 0; dt < 4; ++dt) { const f32x4 v = o[dt][qt] * inv; v2u w; w.x = pk2(v[0], v[1]); w.y = pk2(v[2], v[3]);
            *(v2u*)(Y + row * DM + 768 + h * 64 + dt * 16 + fq * 4) = w; }
    }
}
__device__ __forceinline__ void lru_prefix(int bd, int tid) {
    unsigned char* ws = karg_ws();
    if (tid >= 256) return;
    const int ch = tid, b = bd >> 1, d = bd & 1;
    const float* __restrict__ SA = (const float*)(ws + M_SEGA); const float* __restrict__ SB = (const float*)(ws + M_SEGB); float* __restrict__ H0 = (float*)(ws + M_H0);
    const int ctile0 = 512 + b * 8, ltile0 = b * 256;
#define LRU_TILE(i_) ((i_) < 8 ? ctile0 + (d ? 7 - (i_) : (i_)) : ltile0 + (d ? 255 - ((i_) - 8) : ((i_) - 8)))
    float hst = 0.f;
    float ca[24], cb[24], na[24], nb[24];
#pragma unroll
    for (int k = 0; k < 24; ++k) { const size_t o = (size_t)(LRU_TILE(k) * 2 + d) * 256 + ch; ca[k] = SA[o]; cb[k] = SB[o]; }
    for (int i0 = 0; i0 < 264; i0 += 24) {
        if (i0 + 24 < 264) {
#pragma unroll
            for (int k = 0; k < 24; ++k) { const size_t o = (size_t)(LRU_TILE(i0 + 24 + k) * 2 + d) * 256 + ch; na[k] = SA[o]; nb[k] = SB[o]; } }
        float hv[24];
#pragma unroll
        for (int k = 0; k < 24; ++k) { hv[k] = hst; hst = ca[k] * hst + cb[k]; }
#pragma unroll
        for (int k = 0; k < 24; ++k) H0[(size_t)(LRU_TILE(i0 + k) * 2 + d) * 256 + ch] = hv[k];
#pragma unroll
        for (int k = 0; k < 24; ++k) { ca[k] = na[k]; cb[k] = nb[k]; }
    }
#undef LRU_TILE
}
__device__ __forceinline__ void lru_rescan(const Args& a, int l, unsigned char* lds, int tile, int tid) {
    unsigned char* ws = karg_ws();
    const int ch = tid & 255, d = tid >> 8;
    const int row0 = tile * 32;
    float hst = ((const float*)(ws + M_H0))[(size_t)(tile * 2 + d) * 256 + ch];
    const float lam = IN(22)[(l * 2 + d) * 256 + ch];
    const float cch = -8.f * log1pf(__expf(-lam));
    const bf16* LR = (const bf16*)(ws + M_LR0 + (size_t)d * A8); const bf16* LIX = (const bf16*)(ws + M_LIX0 + (size_t)d * A8);
    float* hs = (float*)lds;
#pragma unroll 16
    for (int tt = 0; tt < 32; ++tt) { const int t = d ? 31 - tt : tt; const size_t o = (size_t)(row0 + t) * 256 + ch;
        const float al = __expf(cch * bf2f(LR[o])); const float bb = sqrtf(fmaxf(1.f - al * al, 0.f)) * bf2f(LIX[o]);
        hst = al * hst + bb; hs[(d * 32 + t) * 256 + ch] = hst; }
    __syncthreads();
    const bf16* U = (const bf16*)(ws + OFF_HU); bf16* Y = (bf16*)(ws + OFF_XMY);
#pragma unroll 8
    for (int tt = 0; tt < 16; ++tt) { const int t = d * 16 + tt;
        const float y = (hs[t * 256 + ch] + hs[(32 + t) * 256 + ch]) * geluf_(bf2f(U[(size_t)(row0 + t) * UC + 768 + ch]));
        Y[(size_t)(row0 + t) * DM + 256 + ch] = (bf16)f2bf(y); }
    __syncthreads();
}
__device__ __forceinline__ void phase_m2(const Args& a, int l, unsigned char* lds, int G, int bid, int tid) {
    unsigned char* ws = karg_ws();
    const bf16* QB = (const bf16*)(ws + M_QB); const bf16* KB = (const bf16*)(ws + M_KB); const bf16* VT = (const bf16*)(ws + M_VT);
    bf16* Y = (bf16*)(ws + OFF_XMY);
    const int nunits = (l == 0) ? 264 : 256;
    for (int u = bid; u < nunits; u += G) {
        if (u < 256) attn_unit(lds, QB, KB, VT, Y, u >> 7, (u >> 5) & 3, (u & 31) * 256, 0, 132, tid);
        else attn_unit(lds, QB, KB, VT, Y, (u - 256) >> 2, (u - 256) & 3, TLEN, TLEN, 4, tid);
    }
    if (bid >= G - 4) lru_prefix(bid - (G - 4), tid);
}

__device__ __forceinline__ void phase_m3(const Args& a, int l, unsigned char* lds, int G, int bid, int tid) {
    unsigned char* ws = karg_ws();
    const bf16* U = (const bf16*)(ws + OFF_HU);
    const int lane = tid & 63, ch = tid & 255, part = tid >> 8;
    const float* mup = IN(23) + l * 1024; const float* mun = IN(24) + l * 1024;
    bf16* RR = (bf16*)(ws + M_RR); bf16* KKo = (bf16*)(ws + M_KK); bf16* VV = (bf16*)(ws + M_VV); bf16* GC = (bf16*)(ws + M_GC);
    float* kl = (float*)lds;
    float* kkn = (float*)(lds + 32768);
    bf16* twb = (bf16*)(lds + 65536);
    bf16* tab = (bf16*)(lds + 70144);
    bf16* tgb = (bf16*)(lds + 74752);
    for (int tile = bid; tile < NTILE; tile += G) {
        const TileInfo ti = tile_info(tile);
        const int row0 = tile * 32;
        lru_rescan(a, l, lds, tile, ltid());
        {
            const int tid2 = ltid(); const int chunk = tid2 & 127, tg8 = tid2 >> 7, c0 = chunk * 8;
            const bf16* ub = U + (size_t)row0 * UC + 1024 + c0;
            v4u rw[10];
#pragma unroll
            for (int q = 0; q < 10; ++q) { const int tl = tg8 * 8 + q - 1; const int t = ti.t0 + tl;
                rw[q] = (t >= 0 && t < ti.seqlen) ? *(const v4u*)(ub + (ptrdiff_t)tl * UC) : (v4u){0u, 0u, 0u, 0u}; }
            const f32x4 mp0 = *(const f32x4*)(mup + c0), mp1 = *(const f32x4*)(mup + c0 + 4), mn0 = *(const f32x4*)(mun + c0), mn1 = *(const f32x4*)(mun + c0 + 4);
            const float mp[8] = {mp0[0], mp0[1], mp0[2], mp0[3], mp1[0], mp1[1], mp1[2], mp1[3]}, mn[8] = {mn0[0], mn0[1], mn0[2], mn0[3], mn1[0], mn1[1], mn1[2], mn1[3]};
#pragma unroll
            for (int q = 0; q < 8; ++q) { const int tl = tg8 * 8 + q; float ts[8];
#pragma unroll
                for (int e = 0; e < 8; ++e) { const unsigned wm = rw[q][e >> 1], w0 = rw[q + 1][e >> 1], wn = rw[q + 2][e >> 1];
                    const float um = (e & 1) ? __uint_as_float(wm & 0xffff0000u) : __uint_as_float(wm << 16);
                    const float u0 = (e & 1) ? __uint_as_float(w0 & 0xffff0000u) : __uint_as_float(w0 << 16);
                    const float un = (e & 1) ? __uint_as_float(wn & 0xffff0000u) : __uint_as_float(wn << 16);
                    ts[e] = u0 + mp[e] * (um - u0) + mn[e] * (un - u0); }
                if (chunk >= 32 && chunk < 64) { float* kp = kl + tl * 256 + (c0 - 256); *(f32x4*)kp = (f32x4){ts[0], ts[1], ts[2], ts[3]}; *(f32x4*)(kp + 4) = (f32x4){ts[4], ts[5], ts[6], ts[7]}; }
                else {
                    if (chunk >= 96 && chunk < 104) {
#pragma unroll
                        for (int e = 0; e < 8; ++e) ts[e] = tanhf_(ts[e]); }
                    if (chunk >= 112) {
#pragma unroll
                        for (int e = 0; e < 8; ++e) ts[e] = sigm(ts[e]); }
                    v4u o; o.x = pk2(ts[0], ts[1]); o.y = pk2(ts[2], ts[3]); o.z = pk2(ts[4], ts[5]); o.w = pk2(ts[6], ts[7]);
                    if (chunk < 32) *(v4u*)(RR + (size_t)(row0 + tl) * 256 + c0) = o;
                    else if (chunk < 96) *(v4u*)(VV + (size_t)(row0 + tl) * 256 + (c0 - 512)) = o;
                    else if (chunk < 104) *(v4u*)(twb + tl * 72 + (c0 - 768)) = o;
                    else if (chunk < 112) *(v4u*)(tab + tl * 72 + (c0 - 832)) = o;
                    else *(v4u*)(tgb + tl * 136 + (c0 - 896)) = o; }
            }
        }
        __syncthreads();
        {
            const int tid2 = ltid(); const int ch = tid2 & 255, pt = tid2 >> 8; const float kkc = IN(30)[l * 256 + ch];
#pragma unroll 4
            for (int q = 0; q < 16; ++q) { const int t = pt * 16 + q; const float kr = kl[t * 256 + ch] * kkc; const float nrm = wave_sum(kr * kr);
                const float kk = kr * rsqrtf(fmaxf(nrm, 1e-24f)); kkn[t * 256 + ch] = kk; KKo[(size_t)(row0 + t) * 256 + ch] = (bf16)f2bf(kk); }
        }
        __syncthreads();
        {
            const int tid2 = ltid(); const int ln = tid2 & 63, wv = __builtin_amdgcn_readfirstlane(tid2 >> 6), fr = ln & 15, fq = ln >> 4;
            const bf16* WUPt = (const bf16*)(ws + W_WUP); const bf16* AUPt = (const bf16*)(ws + W_AUP); const bf16* GUPt = (const bf16*)(ws + W_GUP);
            bf16x8 aw[2][2], aa[2][2];
#pragma unroll
            for (int mt = 0; mt < 2; ++mt)
#pragma unroll
                for (int ks = 0; ks < 2; ++ks) { aw[mt][ks] = *(const bf16x8*)(twb + (mt * 16 + fr) * 72 + ks * 32 + fq * 8); aa[mt][ks] = *(const bf16x8*)(tab + (mt * 16 + fr) * 72 + ks * 32 + fq * 8); }
#pragma unroll 1
            for (int dn = 0; dn < 4; ++dn) { const int d = dn >> 1, nt = wv * 2 + (dn & 1), ch = nt * 16 + fr;
                f32x4 cw[2], ca[2];
#pragma unroll
                for (int mt = 0; mt < 2; ++mt) { cw[mt] = (f32x4){0.f, 0.f, 0.f, 0.f}; ca[mt] = cw[mt]; }
#pragma unroll
                for (int ks = 0; ks < 2; ++ks) { const bf16x8 bw = *(const bf16x8*)(WUPt + ((size_t)d * 256 + ch) * 64 + ks * 32 + fq * 8), ba = *(const bf16x8*)(AUPt + ((size_t)d * 256 + ch) * 64 + ks * 32 + fq * 8);
#pragma unroll
                    for (int mt = 0; mt < 2; ++mt) { cw[mt] = __builtin_amdgcn_mfma_f32_16x16x32_bf16(aw[mt][ks], bw, cw[mt], 0, 0, 0); ca[mt] = __builtin_amdgcn_mfma_f32_16x16x32_bf16(aa[mt][ks], ba, ca[mt], 0, 0, 0); } }
                const float w0 = IN(25)[(l * 2 + d) * 256 + ch], a0 = IN(27)[(l * 2 + d) * 256 + ch], kac = IN(31)[l * 256 + ch];
                float* WW = (float*)(ws + M_WW) + (size_t)d * NR * 256; bf16* BB = (bf16*)(ws + M_BB + (size_t)d * A8); bf16* KD = (bf16*)(ws + M_KD + (size_t)d * A8);
#pragma unroll
                for (int mt = 0; mt < 2; ++mt)
#pragma unroll
                    for (int j = 0; j < 4; ++j) { const int t = mt * 16 + fq * 4 + j; const size_t o = (size_t)(row0 + t) * 256 + ch;
                        const float e = sigm(w0 + cw[mt][j]) * 0.6065306597126334f;
                        const float av = sigm(a0 + ca[mt][j]);
                        WW[o] = __expf(-e);
                        KD[o] = (bf16)f2bf(kl[t * 256 + ch] * (1.f + (av - 1.f) * kac));
                        BB[o] = (bf16)f2bf(kkn[t * 256 + ch] * av); }
            }
#pragma unroll 1
            for (int nl = 0; nl < 2; ++nl) { const int ch = (wv * 2 + nl) * 16 + fr;
                f32x4 cg[2] = {(f32x4){0.f, 0.f, 0.f, 0.f}, (f32x4){0.f, 0.f, 0.f, 0.f}};
#pragma unroll
                for (int ks = 0; ks < 4; ++ks) { const bf16x8 bg = *(const bf16x8*)(GUPt + (size_t)ch * 128 + ks * 32 + fq * 8);
#pragma unroll
                    for (int mt = 0; mt < 2; ++mt) { const bf16x8 ag = *(const bf16x8*)(tgb + (mt * 16 + fr) * 136 + ks * 32 + fq * 8); cg[mt] = __builtin_amdgcn_mfma_f32_16x16x32_bf16(ag, bg, cg[mt], 0, 0, 0); } }
#pragma unroll
                for (int mt = 0; mt < 2; ++mt)
#pragma unroll
                    for (int j = 0; j < 4; ++j) GC[(size_t)(row0 + mt * 16 + fq * 4 + j) * 256 + ch] = (bf16)f2bf(cg[mt][j]);
            }
        }
        __syncthreads();
    }
}

typedef const unsigned cu32;
typedef const float cf32;
__device__ __forceinline__ int chain_row(int b, int d, int tau) {
    return tau < CTXL ? (NLAT + b * CTXL + (d ? CTXL - 1 - tau : tau)) : (b * TLEN + (d ? TLEN - 1 - (tau - CTXL) : (tau - CTXL)));
}
template <int MODE>
__device__ __forceinline__ void rwkv_steps(float (&S)[64], int b, int h, int d, int tau0, int n, unsigned char* ws, int lane, float* wl) {
    const bf16* KKp = (const bf16*)(ws + M_KK); const bf16* RRp = (const bf16*)(ws + M_RR); const bf16* VVp = (const bf16*)(ws + M_VV);
    const float* WWp = (const float*)(ws + M_WW) + (size_t)d * NR * 256; const bf16* BBp = (const bf16*)(ws + M_BB + (size_t)d * A8); const bf16* KDp = (const bf16*)(ws + M_KD + (size_t)d * A8);
    float* YS = (float*)(ws + M_YS) + (size_t)d * NR * 256;
    float pk, pw, pb, pkd = 0.f, pr = 0.f, pv = 0.f; size_t poff;
#define RWKV_LOAD(s_) do { poff = (size_t)chain_row(b, d, tau0 + (s_)) * 256 + h * 64 + lane; pk = bf2f(KKp[poff]); pw = WWp[poff]; pb = bf2f(BBp[poff]); \
        if (MODE != 1) { pkd = bf2f(KDp[poff]); pv = bf2f(VVp[poff]); } if (MODE == 2) pr = bf2f(RRp[poff]); } while (0)
    RWKV_LOAD(0);
    for (int s = 0; s < n; ++s) {
        float* buf = wl + (s & 1) * 320;
        buf[lane] = pk; buf[64 + lane] = pw; buf[128 + lane] = pb;
        if (MODE != 1) buf[192 + lane] = pkd;
        if (MODE == 2) buf[256 + lane] = pr;
        const float vv = pv; const size_t yoff = poff;
        if (s + 1 < n) RWKV_LOAD(s + 1);
        float sa0 = 0.f, sa1 = 0.f, sa2 = 0.f, sa3 = 0.f;
#pragma unroll
        for (int i = 0; i < 64; i += 4) { const f32x4 k4 = *(const f32x4*)(buf + i);
            sa0 += S[i] * k4[0]; sa1 += S[i + 1] * k4[1]; sa2 += S[i + 2] * k4[2]; sa3 += S[i + 3] * k4[3]; }
        const float nsa = -((sa0 + sa1) + (sa2 + sa3));
        float y0 = 0.f, y1 = 0.f, y2 = 0.f, y3 = 0.f;
#pragma unroll
        for (int i = 0; i < 64; i += 4) { const f32x4 w4 = *(const f32x4*)(buf + 64 + i), b4 = *(const f32x4*)(buf + 128 + i);
            f32x4 t = nsa * b4;
            if (MODE != 1) { const f32x4 kd4 = *(const f32x4*)(buf + 192 + i); t += vv * kd4; }
            S[i] = S[i] * w4[0] + t[0]; S[i + 1] = S[i + 1] * w4[1] + t[1]; S[i + 2] = S[i + 2] * w4[2] + t[2]; S[i + 3] = S[i + 3] * w4[3] + t[3];
            if (MODE == 2) { const f32x4 r4 = *(const f32x4*)(buf + 256 + i); y0 += S[i] * r4[0]; y1 += S[i + 1] * r4[1]; y2 += S[i + 2] * r4[2]; y3 += S[i + 3] * r4[3]; } }
        if (MODE == 2) YS[yoff] = (y0 + y1) + (y2 + y3);
    }
#undef RWKV_LOAD
}
typedef float f32x2 __attribute__((ext_vector_type(2)));
__device__ __forceinline__ void rwkv_pass1(f32x2 (&SL)[32], f32x2 (&SI)[32], int b, int h, int d, int tau0, int n, unsigned char* ws, int lane, float* wl) {
    const bf16* KKp = (const bf16*)(ws + M_KK); const bf16* VVp = (const bf16*)(ws + M_VV); const bf16* RRp = (const bf16*)(ws + M_RR);
    const float* WWp = (const float*)(ws + M_WW) + (size_t)d * NR * 256; const bf16* BBp = (const bf16*)(ws + M_BB + (size_t)d * A8); const bf16* KDp = (const bf16*)(ws + M_KD + (size_t)d * A8);
    float* YS = (float*)(ws + M_YS) + (size_t)d * NR * 256; float* PR = (float*)(ws + M_PR) + (size_t)d * NR * 256;
    float pk, pw, pb, pkd, pv, pr; size_t poff;
#define RWKV_LOAD(s_) do { poff = (size_t)chain_row(b, d, tau0 + (s_)) * 256 + h * 64 + lane; pk = bf2f(KKp[poff]); pw = WWp[poff]; pb = bf2f(BBp[poff]); pkd = bf2f(KDp[poff]); pv = bf2f(VVp[poff]); pr = bf2f(RRp[poff]); } while (0)
    RWKV_LOAD(0);
    for (int s = 0; s < n; ++s) {
        float* buf = wl + (s & 1) * 320;
        buf[lane] = pk; buf[64 + lane] = pw; buf[128 + lane] = pb; buf[192 + lane] = pkd; buf[256 + lane] = pr;
        const float vv = pv; const size_t yoff = poff;
        if (s + 1 < n) RWKV_LOAD(s + 1);
        f32x2 aL0 = {0.f, 0.f}, aL1 = aL0, aI0 = aL0, aI1 = aL0;
#pragma unroll
        for (int q = 0; q < 16; ++q) { const f32x4 k4 = *(const f32x4*)(buf + 4 * q);
            aL0 += SL[2 * q] * k4.lo; aL1 += SL[2 * q + 1] * k4.hi; aI0 += SI[2 * q] * k4.lo; aI1 += SI[2 * q + 1] * k4.hi; }
        const f32x2 tL = aL0 + aL1, tI = aI0 + aI1;
        const float nsl = -(tL.x + tL.y), nsi = -(tI.x + tI.y);
        f32x2 yL0 = {0.f, 0.f}, yL1 = yL0, yI0 = yL0, yI1 = yL0;
#pragma unroll
        for (int q = 0; q < 16; ++q) {
            const f32x4 w4 = *(const f32x4*)(buf + 64 + 4 * q), b4 = *(const f32x4*)(buf + 128 + 4 * q), kd4 = *(const f32x4*)(buf + 192 + 4 * q), r4 = *(const f32x4*)(buf + 256 + 4 * q);
            const f32x4 tl = nsl * b4 + vv * kd4, tiv = nsi * b4;
            SL[2 * q] = SL[2 * q] * w4.lo + tl.lo; SL[2 * q + 1] = SL[2 * q + 1] * w4.hi + tl.hi;
            SI[2 * q] = SI[2 * q] * w4.lo + tiv.lo; SI[2 * q + 1] = SI[2 * q + 1] * w4.hi + tiv.hi;
            yL0 += SL[2 * q] * r4.lo; yL1 += SL[2 * q + 1] * r4.hi; yI0 += SI[2 * q] * r4.lo; yI1 += SI[2 * q + 1] * r4.hi; }
        const f32x2 yl = yL0 + yL1, yp = yI0 + yI1;
        YS[yoff] = yl.x + yl.y; PR[yoff] = yp.x + yp.y;
    }
#undef RWKV_LOAD
}
__device__ __forceinline__ void phase_m4(const Args& a, unsigned char* lds, int G, int bid, int tid) {
    const int lane = tid & 63, wave = __builtin_amdgcn_readfirstlane(tid >> 6), half = wave >> 2, tk = wave & 3;
    unsigned char* ws = karg_ws(); float* PL = (float*)(ws + M_PL);
    float* wl = (float*)lds + wave * 320;
    float* xch = (float*)lds + 8 * 320 + tk * 1024;
    float* ych = xch + 512;
    const bf16* KKp = (const bf16*)(ws + M_KK); const bf16* VVp = (const bf16*)(ws + M_VV); const bf16* RRp = (const bf16*)(ws + M_RR);
    for (int task0 = bid * 4; task0 < 16 * NSEG; task0 += G * 4) {
        const int task = task0 + tk; const int seg = task & (NSEG - 1), chain = task >> 6;
        const int d = chain & 1, h = (chain >> 1) & 3, b = chain >> 3;
        const float* WWp = (const float*)(ws + M_WW) + (size_t)d * NR * 256; const bf16* BBp = (const bf16*)(ws + M_BB + (size_t)d * A8); const bf16* KDp = (const bf16*)(ws + M_KD + (size_t)d * A8);
        float* YS = (float*)(ws + M_YS) + (size_t)d * NR * 256; float* PR = (float*)(ws + M_PR) + (size_t)d * NR * 256;
        f32x2 SL[16], SI[16]; int ln = lane; asm volatile("" : "+v"(ln));
#pragma unroll
        for (int i = 0; i < 16; ++i) { SL[i] = (f32x2){0.f, 0.f}; SI[i] = (f32x2){(32 * half + 2 * i == ln) ? 1.f : 0.f, (32 * half + 2 * i + 1 == ln) ? 1.f : 0.f}; }
        const int tau0 = seg * SEGLEN, cidx = h * 64 + 32 * half + (lane & 31);
        unsigned pp; float pw, pv; size_t rowoff, prevoff = 0;
        const int grp = lane >> 4, l15 = lane & 15, l31 = lane & 31;
        const unsigned* srcp = grp == 0 ? (const unsigned*)KKp : grp == 1 ? (const unsigned*)BBp : grp == 2 ? (const unsigned*)KDp : (const unsigned*)RRp;
#define M4_LOAD(s_) do { rowoff = (size_t)chain_row(b, d, tau0 + (s_)) * 256; pp = srcp[(rowoff + h * 64 + 32 * half) / 2 + l15]; \
            pw = (lane < 32) ? WWp[rowoff + cidx] : 0.f; pv = bf2f(VVp[rowoff + h * 64 + lane]); } while (0)
#define UNPK(u_) ((f32x2){__uint_as_float((u_) << 16), __uint_as_float((u_) & 0xffff0000u)})
        M4_LOAD(0);
        for (int s = 0; s < SEGLEN; ++s) {
            float* buf = wl + (s & 1) * 160; const unsigned* bufu = (const unsigned*)buf;
            ((unsigned*)buf)[lane] = pp; if (lane < 32) buf[64 + l31] = pw;
            const float vv = pv; const size_t yoff = rowoff + h * 64 + lane;
            if (s + 1 < SEGLEN) M4_LOAD(s + 1);
            f32x2 aL0 = {0.f, 0.f}, aL1 = aL0, aI0 = aL0, aI1 = aL0;
#pragma unroll
            for (int q = 0; q < 4; ++q) { const v4u k4 = *(const v4u*)(bufu + 4 * q);
                const f32x2 ka = UNPK(k4.x), kb = UNPK(k4.y), kc = UNPK(k4.z), kd_ = UNPK(k4.w);
                aL0 += SL[4 * q] * ka; aL1 += SL[4 * q + 1] * kb; aL0 += SL[4 * q + 2] * kc; aL1 += SL[4 * q + 3] * kd_;
                aI0 += SI[4 * q] * ka; aI1 += SI[4 * q + 1] * kb; aI0 += SI[4 * q + 2] * kc; aI1 += SI[4 * q + 3] * kd_; }
            const f32x2 tL = aL0 + aL1, tI = aI0 + aI1;
            float* xw = xch + (s & 1) * 256;
            xw[half * 128 + lane] = tL.x + tL.y; xw[half * 128 + 64 + lane] = tI.x + tI.y;
            __syncthreads();
            const float nsl = -(xw[lane] + xw[128 + lane]), nsi = -(xw[64 + lane] + xw[192 + lane]);
            if (s > 0) {
                const float* yr = ych + ((s - 1) & 1) * 256;
                if (half == 0) YS[prevoff] = yr[lane] + yr[128 + lane]; else PR[prevoff] = yr[64 + lane] + yr[192 + lane];
            }
            f32x2 yL0 = {0.f, 0.f}, yL1 = yL0, yI0 = yL0, yI1 = yL0;
#pragma unroll
            for (int q = 0; q < 4; ++q) {
                const f32x4 wa = *(const f32x4*)(buf + 64 + 8 * q), wb = *(const f32x4*)(buf + 68 + 8 * q);
                const v4u b4 = *(const v4u*)(bufu + 16 + 4 * q), d4 = *(const v4u*)(bufu + 32 + 4 * q), r4 = *(const v4u*)(bufu + 48 + 4 * q);
                const f32x2 w2[4] = {wa.lo, wa.hi, wb.lo, wb.hi};
                const unsigned bu[4] = {b4.x, b4.y, b4.z, b4.w}, du[4] = {d4.x, d4.y, d4.z, d4.w}, ru[4] = {r4.x, r4.y, r4.z, r4.w};
#pragma unroll
                for (int e = 0; e < 4; ++e) { const int j = 4 * q + e; const f32x2 b2 = UNPK(bu[e]), k2 = UNPK(du[e]), r2 = UNPK(ru[e]);
                    const f32x2 tl = nsl * b2 + vv * k2, tiv = nsi * b2;
                    SL[j] = SL[j] * w2[e] + tl; SI[j] = SI[j] * w2[e] + tiv;
                    if (e & 1) { yL1 += SL[j] * r2; yI1 += SI[j] * r2; } else { yL0 += SL[j] * r2; yI0 += SI[j] * r2; } }
            }
            const f32x2 yl = yL0 + yL1, yp = yI0 + yI1;
            float* yw = ych + (s & 1) * 256;
            yw[half * 128 + lane] = yl.x + yl.y; yw[half * 128 + 64 + lane] = yp.x + yp.y;
            prevoff = yoff;
        }
#undef M4_LOAD
#undef UNPK
        __syncthreads();
        { const float* yr = ych + ((SEGLEN - 1) & 1) * 256;
          if (half == 0) YS[prevoff] = yr[lane] + yr[128 + lane]; else PR[prevoff] = yr[64 + lane] + yr[192 + lane]; }
        float* o = PL + (((size_t)(chain * NSEG + seg) * 2) * 64 + lane) * 64 + 32 * half;
#pragma unroll
        for (int i = 0; i < 16; i += 2) { *(f32x4*)(o + 2 * i) = (f32x4){SL[i].x, SL[i].y, SL[i + 1].x, SL[i + 1].y}; *(f32x4*)(o + 4096 + 2 * i) = (f32x4){SI[i].x, SI[i].y, SI[i + 1].x, SI[i + 1].y}; }
        __syncthreads();
    }
}
__device__ __forceinline__ void phase_m5(const Args& a, unsigned char* lds, int G, int bid, int tid) {
    unsigned char* ws = karg_ws(); const float* PL = (const float*)(ws + M_PL); float* SI = (float*)(ws + M_SINIT);
    float* Sx = (float*)lds;
    const int lane = tid & 63, wv = __builtin_amdgcn_readfirstlane(tid >> 6), fr = lane & 15, fq = lane >> 4;
    const bool act = wv < 4;
    for (int u = bid; u < 64; u += G) {
        const int chain = u >> 2, row0 = (u & 3) * 16, col = (wv & 3) * 16 + fr;
        const float* Pg = PL + ((size_t)(chain * NSEG) * 2 + 1) * 4096; const float* Lg = PL + ((size_t)(chain * NSEG) * 2) * 4096;
        float* SIc = SI + (size_t)(chain * NSEG) * 4096;
        f32x4 cur = {0.f, 0.f, 0.f, 0.f}; f32x4 lv[3]; float pb[3][16];
#pragma unroll
        for (int q = 0; q < 3; ++q) { lv[q] = cur;
            if (act) { const float* Pn = Pg + (size_t)q * 8192; const float* Ln = Lg + (size_t)q * 8192;
#pragma unroll
                for (int ks = 0; ks < 16; ++ks) pb[q][ks] = Pn[(4 * ks + fq) * 64 + col];
#pragma unroll
                for (int j = 0; j < 4; ++j) lv[q][j] = Ln[(row0 + fq * 4 + j) * 64 + col]; } }
        for (int g0 = 0; g0 < NSEG - 1; g0 += 3) {
#pragma unroll
            for (int q = 0; q < 3; ++q) { const int g = g0 + q;
                if (act) {
#pragma unroll
                    for (int j = 0; j < 4; ++j) { SIc[(size_t)g * 4096 + (row0 + fq * 4 + j) * 64 + col] = cur[j]; Sx[(fq * 4 + j) * 68 + col] = cur[j]; }
                }
                __syncthreads();
                if (act) {
                    f32x4 acc = lv[q];
#pragma unroll
                    for (int ks = 0; ks < 16; ++ks) { const float av = Sx[fr * 68 + 4 * ks + fq]; acc = __builtin_amdgcn_mfma_f32_16x16x4f32(av, pb[q][ks], acc, 0, 0, 0); }
                    cur = acc;
                    if (g + 3 < NSEG - 1) { const float* Pn = Pg + (size_t)(g + 3) * 8192; const float* Ln = Lg + (size_t)(g + 3) * 8192;
#pragma unroll
                        for (int ks = 0; ks < 16; ++ks) pb[q][ks] = Pn[(4 * ks + fq) * 64 + col];
#pragma unroll
                        for (int j = 0; j < 4; ++j) lv[q][j] = Ln[(row0 + fq * 4 + j) * 64 + col]; }
                }
                __syncthreads();
            }
        }
        if (act) {
#pragma unroll
            for (int j = 0; j < 4; ++j) SIc[(size_t)(NSEG - 1) * 4096 + (row0 + fq * 4 + j) * 64 + col] = cur[j];
        }
    }
}
__device__ __forceinline__ void phase_m6(const Args& a, unsigned char* lds, int G, int bid, int tid) {
    const int lane = tid & 63, wave = __builtin_amdgcn_readfirstlane(tid >> 6);
    unsigned char* ws = karg_ws(); const float* SI = (const float*)(ws + M_SINIT);
    float* wl = (float*)lds + wave * 256;
    for (int task = bid * 8 + wave; task < 16 * (NSEG - 1); task += G * 8) {
        const int seg = 1 + task % (NSEG - 1), chain = task / (NSEG - 1);
        const int d = chain & 1, h = (chain >> 1) & 3, b = chain >> 3;
        float* YS = (float*)(ws + M_YS) + (size_t)d * NR * 256; const float* PR = (const float*)(ws + M_PR) + (size_t)d * NR * 256;
        f32x2 S0[32];
        const float* si = SI + ((size_t)(chain * NSEG + seg) * 64 + lane) * 64;
#pragma unroll
        for (int i = 0; i < 32; i += 2) { const f32x4 v = *(const f32x4*)(si + 2 * i); S0[i] = v.lo; S0[i + 1] = v.hi; }
        const int tau0 = seg * SEGLEN;
        size_t o0 = (size_t)chain_row(b, d, tau0) * 256 + h * 64 + lane, o1 = (size_t)chain_row(b, d, tau0 + 1) * 256 + h * 64 + lane;
        float p0 = PR[o0], p1 = PR[o1], y0 = YS[o0], y1 = YS[o1];
        for (int s = 0; s < SEGLEN; s += 2) {
            wl[lane] = p0; wl[64 + lane] = p1;
            const size_t c0 = o0, c1 = o1; const float yy0 = y0, yy1 = y1;
            if (s + 2 < SEGLEN) { o0 = (size_t)chain_row(b, d, tau0 + s + 2) * 256 + h * 64 + lane; o1 = (size_t)chain_row(b, d, tau0 + s + 3) * 256 + h * 64 + lane; p0 = PR[o0]; p1 = PR[o1]; y0 = YS[o0]; y1 = YS[o1]; }
            f32x2 a0 = {0.f, 0.f}, a1 = a0, b0 = a0, b1 = a0;
#pragma unroll
            for (int q = 0; q < 16; ++q) { const f32x4 u = *(const f32x4*)(wl + 4 * q), w = *(const f32x4*)(wl + 64 + 4 * q);
                a0 += S0[2 * q] * u.lo; a1 += S0[2 * q + 1] * u.hi; b0 += S0[2 * q] * w.lo; b1 += S0[2 * q + 1] * w.hi; }
            const f32x2 ta = a0 + a1, tb = b0 + b1;
            YS[c0] = yy0 + (ta.x + ta.y); YS[c1] = yy1 + (tb.x + tb.y);
            asm volatile("" ::: "memory");
        }
    }
}
__device__ __forceinline__ void phase_m7(const Args& a, int l, int gw, int NGW, int lane) {
    unsigned char* ws = karg_ws();
    const float* Y0 = (const float*)(ws + M_YS); const float* Y1 = Y0 + (size_t)NR * 256;
    const bf16* RR = (const bf16*)(ws + M_RR); const bf16* VV = (const bf16*)(ws + M_VV); const bf16* KD0 = (const bf16*)(ws + M_KD); const bf16* KD1 = (const bf16*)(ws + M_KD + A8);
    const bf16* GC = (const bf16*)(ws + M_GC); bf16* Y = (bf16*)(ws + OFF_XMY);
    for (int r = gw; r < NR; r += NGW) {
#pragma unroll
        for (int h = 0; h < 4; ++h) { const int c = h * 64 + lane; const size_t o = (size_t)r * 256 + c;
            const float ys = Y0[o] + Y1[o];
            const float mu = wave_sum(ys) * (1.f / 64.f); const float dv = ys - mu; const float var = wave_sum(dv * dv) * (1.f / 64.f);
            float ov = dv * rsqrtf(var + 64e-5f) * IN(33)[l * 256 + c] + IN(34)[l * 256 + c];
            const float rv = bf2f(RR[o]), rk = IN(32)[l * 256 + c], vv = bf2f(VV[o]);
            const float b0 = wave_sum(rv * bf2f(KD0[o]) * rk), b1 = wave_sum(rv * bf2f(KD1[o]) * rk);
            ov += (b0 + b1) * vv;
            Y[(size_t)r * DM + 512 + c] = (bf16)f2bf(ov * bf2f(GC[o])); }
    }
}

#define LAS __attribute__((address_space(3)))
#define XB_TMO      128
#define XB_XCNT(j)  (256  + 64 * (j))
#define XB_XSUB(j)  (1280 + 64 * (j))
#define XB_XGEN(j)  (2304 + 64 * (j))
#define XB_TOP      3328
#define XB_TOPGEN   3392
#define XCD_BAR_WORDS 3456
#define XB_SPIN_CAP (1u << 18)

__device__ __forceinline__ unsigned xb_ld(unsigned* p)              { return __hip_atomic_load(p, __ATOMIC_RELAXED, __HIP_MEMORY_SCOPE_AGENT); }
__device__ __forceinline__ unsigned xb_add(unsigned* p, unsigned v) { return __hip_atomic_fetch_add(p, v, __ATOMIC_RELAXED, __HIP_MEMORY_SCOPE_AGENT); }
__device__ __forceinline__ unsigned xb_xcc_id() { return (unsigned)__builtin_amdgcn_s_getreg((3 << 11) | 20) & 0xFu; }
#define XB_SPIN(cond, bar) do { unsigned _sp = 0; while (cond) { __builtin_amdgcn_s_sleep(1); \
    if ((++_sp & 255u) == 0u) { if (xb_ld(&(bar)[XB_TMO])) break; if (_sp > XB_SPIN_CAP) { atomicAdd(&(bar)[XB_TMO], 1u); break; } } } } while (0)

struct XcdBarrier {
    unsigned* bar; unsigned x;
    volatile LAS unsigned* st;
};

__device__ __forceinline__ XcdBarrier xcd_barrier_post(unsigned* bar, volatile LAS unsigned* st) {
    XcdBarrier b; b.bar = bar; b.x = xb_xcc_id(); b.st = st;
    if (threadIdx.x == 0) (void)xb_add(&bar[XB_XCNT(b.x)], 1u);
    return b;
}
__device__ __forceinline__ void xcd_barrier_complete(unsigned* bar, unsigned x, unsigned& nloc, unsigned& nx) {
    const unsigned G = gridDim.x * gridDim.y * gridDim.z;
    unsigned sum, cnt, mine, sp = 0u;
    for (;;) {
        sum = 0u; cnt = 0u; mine = 0u;
#pragma unroll
        for (unsigned j = 0; j < 16; ++j) { const unsigned c = xb_ld(&bar[XB_XCNT(j)]); sum += c; cnt += (c > 0u) ? 1u : 0u; mine = (j == x) ? c : mine; }
        if (sum == G) break;
        __builtin_amdgcn_s_sleep(1);
        if ((++sp & 255u) == 0u) { if (xb_ld(&bar[XB_TMO])) break; if (sp > XB_SPIN_CAP) { atomicAdd(&bar[XB_TMO], 1u); break; } }
    }
    nloc = mine > 0u ? mine : 1u; nx = cnt > 0u ? cnt : 1u;
}

__device__ __forceinline__ void xcd_barrier(const XcdBarrier& b) {
    asm volatile("s_waitcnt vmcnt(0)" ::: "memory");
    __syncthreads();
    if (threadIdx.x == 0) {
        unsigned* bar = b.bar;
        __builtin_amdgcn_s_waitcnt(0);
        unsigned nloc = b.st[0], nx = b.st[1];
        if (nloc == 0u) { xcd_barrier_complete(bar, b.x, nloc, nx); b.st[0] = nloc; b.st[1] = nx; }
        const unsigned old = xb_add(&bar[XB_XSUB(b.x)], 1u);
        const unsigned gen = old / nloc;
        if (old + 1u == (gen + 1u) * nloc) {
            __builtin_amdgcn_fence(__ATOMIC_RELEASE, "agent");
            asm volatile("s_waitcnt vmcnt(0)" ::: "memory");
            const unsigned og = xb_add(&bar[XB_TOP], 1u);
            const unsigned tg = og / nx;
            if (og + 1u == (tg + 1u) * nx) xb_add(&bar[XB_TOPGEN], 1u);
            else XB_SPIN(xb_ld(&bar[XB_TOPGEN]) == tg, bar);
            __builtin_amdgcn_fence(__ATOMIC_ACQUIRE, "agent");
            xb_add(&bar[XB_XGEN(b.x)], 1u);
            asm volatile("s_waitcnt vmcnt(0)" ::: "memory");
        } else {
            XB_SPIN(xb_ld(&bar[XB_XGEN(b.x)]) == gen, bar);
            __builtin_amdgcn_fence(__ATOMIC_ACQUIRE, "agent");
            asm volatile("s_waitcnt vmcnt(0)" ::: "memory");
        }
    }
    __syncthreads();
}

__global__ void __launch_bounds__(512, 2) mega(Args a) {
    extern __shared__ __attribute__((aligned(16))) unsigned char lds[];
    cg::grid_group grid = cg::this_grid();
    const int G = gridDim.x;
    PG8_LAS unsigned char* glds = (PG8_LAS unsigned char*)lds;
#define bid lbid()
#define tid ltid()
#define lane (ltid() & 63)
#define wave (__builtin_amdgcn_readfirstlane(ltid() >> 6))
#define gw (lbid() * 8 + __builtin_amdgcn_readfirstlane(ltid() >> 6))
#define NGW (G * 8)
    { volatile LAS unsigned* st0 = (volatile LAS unsigned*)((LAS unsigned char*)lds + 131072); if (threadIdx.x < 4) st0[threadIdx.x] = 0u; }
    __syncthreads();
    const XcdBarrier xbar = xcd_barrier_post((unsigned*)(karg_ws() + 229376), (volatile LAS unsigned*)((LAS unsigned char*)lds + 131072));
#define GSYNC() do { xcd_barrier(xbar); } while (0)

    phase_modgemv(a, (float*)lds, G, bid, tid);
    convert_weights(a, 0, (float*)(lds + 32768) + wave * (64 * 33), gw, NGW, lane, G, bid, tid);
    grid.sync();
#pragma clang loop unroll(full)
    for (int l = 0; l < 2; ++l) {
        if (l > 0) convert_weights(a, l, (float*)lds + wave * (64 * 33), gw, NGW, lane, G, bid, tid);
        phase_modulate(a, l, 0, gw, NGW, lane);
        GSYNC();
        for (int rp = 0; rp < REP_G1; ++rp)
        {
            unsigned char* ws = karg_ws(); float* outp = karg_out(); float* xctx = (float*)(ws + OFF_XCTX); bf16* XM = (bf16*)(ws + OFF_XMY); bf16* HU = (bf16*)(ws + OFF_HU); const float* modl = (const float*)(ws + OFF_MOD) + (size_t)l * 3 * 9216; (void)xctx; (void)XM; (void)HU; (void)modl; (void)outp;
            pg8::Gemm g{XM, (const bf16*)(ws + W_13A), NR, 2 * DFF, DM}; pg8::StaticOrder S; S.init(NR, 2 * DFF, G, bid);
            EpiSwiglu E{HU};
            pg8::gemm_phase<EpiSwiglu, pg8::StaticOrder, true, true>(glds, g, S, E);
        }
        GSYNC();
        {
            unsigned char* ws = karg_ws(); float* outp = karg_out(); float* xctx = (float*)(ws + OFF_XCTX); bf16* XM = (bf16*)(ws + OFF_XMY); bf16* HU = (bf16*)(ws + OFF_HU); const float* modl = (const float*)(ws + OFF_MOD) + (size_t)l * 3 * 9216; (void)xctx; (void)XM; (void)HU; (void)modl; (void)outp;
            pg8::Gemm g{HU, (const bf16*)(ws + W_2A), NR, DM, DFF}; pg8::StaticOrder S; S.init(NR, DM, G, bid);
            EpiResid E{outp, xctx, modl + 2 * 1024, 0.5f, l == 0 ? IN(0) : outp, l == 0 ? IN(2) : xctx};
            pg8::gemm_phase<EpiResid, pg8::StaticOrder, true, true>(glds, g, S, E);
        }
        GSYNC();
        phase_modulate(a, l, 1, gw, NGW, lane);
        GSYNC();
        {
            unsigned char* ws = karg_ws(); float* outp = karg_out(); float* xctx = (float*)(ws + OFF_XCTX); bf16* XM = (bf16*)(ws + OFF_XMY); bf16* HU = (bf16*)(ws + OFF_HU); const float* modl = (const float*)(ws + OFF_MOD) + (size_t)l * 3 * 9216; (void)xctx; (void)XM; (void)HU; (void)modl; (void)outp;
            pg8::Gemm g{XM, (const bf16*)(ws + W_IN), NR, UC, DM}; pg8::StaticOrder S; S.init(NR, UC, G, bid);
            EpiU E{HU, UC};
            pg8::gemm_phase<EpiU, pg8::StaticOrder, true, true>(glds, g, S, E);
        }
        GSYNC();
        for (int rp = 0; rp < REP_M1; ++rp) { phase_m1(a, l, lds, G, bid, tid);
        GSYNC(); }
        for (int rp = 0; rp < REP_M2; ++rp) { phase_m2(a, l, lds, G, bid, tid);
        GSYNC(); }
        for (int rp = 0; rp < REP_M3; ++rp) { phase_m3(a, l, lds, G, bid, tid);
        GSYNC(); }
        for (int rp = 0; rp < REP_SCAN; ++rp) { phase_m4(a, lds, G, bid, tid);
        GSYNC();
        phase_m5(a, lds, G, bid, tid);
        GSYNC();
        phase_m6(a, lds, G, bid, tid);
        GSYNC(); }
        phase_m7(a, l, gw, NGW, lane);
        GSYNC();
        {
            unsigned char* ws = karg_ws(); float* outp = karg_out(); float* xctx = (float*)(ws + OFF_XCTX); bf16* XM = (bf16*)(ws + OFF_XMY); bf16* HU = (bf16*)(ws + OFF_HU); const float* modl = (const float*)(ws + OFF_MOD) + (size_t)l * 3 * 9216; (void)xctx; (void)XM; (void)HU; (void)modl; (void)outp;
            const int MR = (l == 1) ? NLAT : NR;
            pg8::Gemm g{XM, (const bf16*)(ws + W_OUT), MR, DM, DM}; pg8::StaticOrder S; S.init(MR, DM, G, bid);
            EpiResid E{outp, xctx, modl + 5 * 1024, 1.0f, outp, xctx};
            pg8::gemm_phase<EpiResid, pg8::StaticOrder, true, true>(glds, g, S, E);
        }
        GSYNC();
        phase_modulate(a, l, 2, gw, NGW, lane);
        GSYNC();
        {
            unsigned char* ws = karg_ws(); float* outp = karg_out(); float* xctx = (float*)(ws + OFF_XCTX); bf16* XM = (bf16*)(ws + OFF_XMY); bf16* HU = (bf16*)(ws + OFF_HU); const float* modl = (const float*)(ws + OFF_MOD) + (size_t)l * 3 * 9216; (void)xctx; (void)XM; (void)HU; (void)modl; (void)outp;
            const int MR = (l == 1) ? NLAT : NR;
            pg8::Gemm g{XM, (const bf16*)(ws + W_13B), MR, 2 * DFF, DM}; pg8::StaticOrder S; S.init(MR, 2 * DFF, G, bid);
            EpiSwiglu E{HU};
            pg8::gemm_phase<EpiSwiglu, pg8::StaticOrder, true, true>(glds, g, S, E);
        }
        GSYNC();
        {
            unsigned char* ws = karg_ws(); float* outp = karg_out(); float* xctx = (float*)(ws + OFF_XCTX); bf16* XM = (bf16*)(ws + OFF_XMY); bf16* HU = (bf16*)(ws + OFF_HU); const float* modl = (const float*)(ws + OFF_MOD) + (size_t)l * 3 * 9216; (void)xctx; (void)XM; (void)HU; (void)modl; (void)outp;
            const int MR = (l == 1) ? NLAT : NR;
            pg8::Gemm g{HU, (const bf16*)(ws + W_2B), MR, DM, DFF}; pg8::StaticOrder S; S.init(MR, DM, G, bid);
            EpiResid E{outp, xctx, modl + 8 * 1024, 0.5f, outp, xctx};
            pg8::gemm_phase<EpiResid, pg8::StaticOrder, true, true>(glds, g, S, E);
        }
        GSYNC();
    }
    phase_final(a, gw, NGW, lane);
#undef bid
#undef tid
#undef lane
#undef wave
#undef gw
#undef NGW
}

extern "C" void kernel_launch(void* const* d_in, const int* in_sizes, int n_in, void* d_out, int out_size, void* d_ws, size_t ws_size, hipStream_t stream) {
    static int grid = 0;
    if (grid == 0) {
        int dev = 0, cus = 0, per_cu = 0;
        (void)hipGetDevice(&dev);
        (void)hipDeviceGetAttribute(&cus, hipDeviceAttributeMultiprocessorCount, dev);
        (void)hipFuncSetAttribute((const void*)mega, hipFuncAttributeMaxDynamicSharedMemorySize, LDS_BYTES);
        (void)hipOccupancyMaxActiveBlocksPerMultiprocessor(&per_cu, (const void*)mega, 512, LDS_BYTES);
        if (per_cu < 1) per_cu = 1;
        grid = cus * per_cu;
        if (n_in != 40 || ws_size < WS_NEED) { fprintf(stderr, "kernel_launch: unexpected n_in %d / ws %zu (need %zu)\n", n_in, ws_size, (size_t)WS_NEED); }
    }
    (void)hipMemsetAsync((char*)d_ws + OFF_MOD, 0, MOD_BYTES, stream);
    Args a{};
    for (int i = 0; i < 40; ++i) a.in[i] = (const float*)d_in[i];
    a.out = (float*)d_out; a.ws = (unsigned char*)d_ws;
    void* args[] = {&a};
    hipError_t e = hipLaunchCooperativeKernel((const void*)mega, dim3(grid), dim3(512), args, LDS_BYTES, stream);
    if (e != hipSuccess) fprintf(stderr, "cooperative launch failed: %s (grid %d)\n", hipGetErrorString(e), grid);
}
```

```cpp
#include <hip/hip_runtime.h>
#include <hip/hip_cooperative_groups.h>
#include <cstdio>
#include <cstdint>
namespace cg = cooperative_groups;
namespace pg8 {
#define PG8_LAS __attribute__((address_space(3)))
typedef unsigned short bf16_t;
typedef short bf16x8 __attribute__((ext_vector_type(8)));
typedef float f32x4 __attribute__((ext_vector_type(4)));
typedef unsigned u32x4 __attribute__((ext_vector_type(4)));
constexpr int BM = 256, BK = 64, HALF = 128, HTB = HALF * BK * 2  , STAGE_BYTES = 8 * HTB, NXCD = 8, WGM = 8;

__host__ __device__ __forceinline__ int lds_byte(int r, int c) { const int st = (r >> 4) * 2 + (c >> 5), rr = r & 15, cc = c & 31, ob = rr * 64 + cc * 2; return st * 1024 + (ob ^ (((ob >> 9) & 1) << 5)); }
__host__ __device__ __forceinline__ void stage_rc(int b, int& R, int& C) { const int st = b / 1024, sb = b % 1024, swz = sb ^ (((sb >> 9) & 1) << 5); R = (st >> 1) * 16 + swz / 64; C = (st & 1) * 32 + (swz % 64) / 2; }
__host__ __device__ __forceinline__ int perm32(int rho) { const int n = rho >> 4, i = rho & 15; return 8 * (i >> 2) + 4 * n + (i & 3); }

struct Unit { int pm, pn; };
struct Gemm { const bf16_t* A; const bf16_t* Bt; int M, N, K; };

struct StaticOrder {
    int nM, nN, nwg, G, c;
    __host__ __device__ void init(int M, int N, int G_, int c_) { nM = M / BM; nN = N / BM; nwg = nM * nN; G = G_; c = c_; }
    __host__ __device__ bool next(int i, Unit& u) const {
        const long L = (long)i * G + c; if (L >= nwg) return false;
        int wgid = (int)L; { const int q = nwg / NXCD, r = nwg % NXCD, xcd = wgid % NXCD, off = wgid / NXCD; wgid = (xcd < r ? xcd * (q + 1) : r * (q + 1) + (xcd - r) * q) + off; }
        const int nig = WGM * nN, gid = wgid / nig, fm = gid * WGM, gsz = (nM - fm) < WGM ? (nM - fm) : WGM;
        u.pm = fm + ((wgid % nig) % gsz); u.pn = (wgid % nig) / gsz; return true;
    }
    __device__ __forceinline__ void a_ready(const Unit&) const {}
    __device__ __forceinline__ void done(const Unit&) const {}
};

__device__ __forceinline__ unsigned cvt_pk_bf16(float lo, float hi) { unsigned r; asm volatile("v_cvt_pk_bf16_f32 %0, %1, %2" : "=v"(r) : "v"(lo), "v"(hi)); return r; }
typedef float f32x2 __attribute__((ext_vector_type(2)));
template <class Epi, class Sched, bool ALIGN_EPI = false, bool SP2 = false>
__device__ __forceinline__ void gemm_phase(PG8_LAS unsigned char* lds, const Gemm g, const Sched& S, const Epi& E) {
    int tid = threadIdx.x; asm volatile("" : "+v"(tid));
    const int wid = __builtin_amdgcn_readfirstlane(tid >> 6), lane = tid & 63, wr = wid >> 2, wc = wid & 3, fr = lane & 15, fq = lane >> 4;
    const int K = g.K, nt = K / BK;
    unsigned voffA[2], voffB[2];
#pragma unroll
    for (int i = 0; i < 2; ++i) { int R, C; stage_rc(tid * 16 + i * 8192, R, C); const int Rb = Epi::PERM ? ((R & ~31) + perm32(R & 31)) : R;
        voffA[i] = (unsigned)(R * K + C) * 2u; voffB[i] = (unsigned)(Rb * K + C) * 2u; }
    const size_t kstep = (size_t)(BK * 2);
    const size_t hstep = (size_t)HALF * K * 2;
    const size_t tstep = 2 * hstep;
    const unsigned ldsw = (unsigned)wid * 1024u;
    const int aoff = lds_byte(wr * 64 + fr, fq * 8), boff = lds_byte(wc * 32 + fr, fq * 8);
#define PG8_SA(b, h) (((b) * 2 + (h)) * HTB)
#define PG8_SB(b, h) ((4 + (b) * 2 + (h)) * HTB)
#define PG8_STAGE(bufoff, gbase, voff) do { _Pragma("unroll") for (int _i = 0; _i < 2; ++_i) \
        __builtin_amdgcn_global_load_lds((const unsigned*)((const char*)(gbase) + (voff)[_i]), (PG8_LAS unsigned*)(lds + (bufoff) + ldsw + _i * 8192), 16, 0, 0); } while (0)
#define PG8_LDA(dst, b, h) do { _Pragma("unroll") for (int m = 0; m < 4; ++m) _Pragma("unroll") for (int k = 0; k < 2; ++k) dst[m][k] = *(const PG8_LAS bf16x8*)(lds + PG8_SA(b, h) + aoff + m * 2048 + k * 1024); } while (0)
#define PG8_LDB(dst, b, h) do { _Pragma("unroll") for (int n = 0; n < 2; ++n) _Pragma("unroll") for (int k = 0; k < 2; ++k) dst[n][k] = *(const PG8_LAS bf16x8*)(lds + PG8_SB(b, h) + boff + n * 2048 + k * 1024); } while (0)
#define PG8_MMA(ai, bj, At, Bt) do { __builtin_amdgcn_s_setprio(1); _Pragma("unroll") for (int m = 0; m < 4; ++m) _Pragma("unroll") for (int n = 0; n < 2; ++n) _Pragma("unroll") for (int k = 0; k < 2; ++k) \
        acc[ai][bj][m][n] = __builtin_amdgcn_mfma_f32_16x16x32_bf16(Bt[n][k], At[m][k], acc[ai][bj][m][n], 0, 0, 0); __builtin_amdgcn_s_setprio(0); } while (0)
#define PG8_WAIT_V(n) asm volatile("s_waitcnt vmcnt(" #n ")" ::: "memory")
#define PG8_WAIT_L(n) asm volatile("s_waitcnt lgkmcnt(" #n ")" ::: "memory")
#define PG8_BAR __builtin_amdgcn_s_barrier()
#define PG8_SCHED __builtin_amdgcn_sched_barrier(0)
    Unit cur, nxt; int ui = 0;
    if (!S.next(0, cur)) return;
    f32x4 acc[2][2][4][2];
#pragma unroll
    for (int a = 0; a < 2; ++a)
#pragma unroll
        for (int b = 0; b < 2; ++b)
#pragma unroll
            for (int m = 0; m < 4; ++m)
#pragma unroll
                for (int n = 0; n < 2; ++n) acc[a][b][m][n] = (f32x4){0.f, 0.f, 0.f, 0.f};
    bf16x8 At[4][2], B0[2][2], B1[2][2];
    const char* cA = (const char*)g.A + (size_t)cur.pm * tstep; const char* cB = (const char*)g.Bt + (size_t)cur.pn * tstep;
    S.a_ready(cur);
    if constexpr (SP2) {
        PG8_STAGE(PG8_SB(0, 0), cB, voffB); PG8_STAGE(PG8_SB(0, 1), cB + hstep, voffB); PG8_STAGE(PG8_SA(0, 0), cA, voffA); PG8_STAGE(PG8_SA(0, 1), cA + hstep, voffA);
        if (wr == 1) PG8_BAR;
        PG8_WAIT_V(2); PG8_BAR;
        PG8_STAGE(PG8_SB(1, 0), cB + kstep, voffB); PG8_STAGE(PG8_SA(1, 0), cA + kstep, voffA); PG8_STAGE(PG8_SB(1, 1), cB + hstep + kstep, voffB);
        PG8_WAIT_V(6); PG8_BAR;
    } else {
        PG8_STAGE(PG8_SB(0, 0), cB, voffB); PG8_STAGE(PG8_SA(0, 0), cA, voffA); PG8_STAGE(PG8_SB(0, 1), cB + hstep, voffB); PG8_STAGE(PG8_SA(0, 1), cA + hstep, voffA);
        if (wr == 1) PG8_BAR;
        PG8_WAIT_V(4); PG8_BAR;
        PG8_STAGE(PG8_SB(1, 0), cB + kstep, voffB); PG8_STAGE(PG8_SA(1, 0), cA + kstep, voffA); PG8_STAGE(PG8_SB(1, 1), cB + hstep + kstep, voffB);
        PG8_WAIT_V(6); PG8_BAR;
    }
    for (;;) {
        const bool has_next = S.next(ui + 1, nxt);
        const char* nA = has_next ? (const char*)g.A + (size_t)nxt.pm * tstep : cA; const char* nB = has_next ? (const char*)g.Bt + (size_t)nxt.pn * tstep : cB;
        for (int t = 0; t < nt; t += 2) {
            const bool last = (t == nt - 2);
            const char* a1 = cA + (size_t)(t + 1) * kstep;
            const char* a2 = last ? nA : cA + (size_t)(t + 2) * kstep; const char* b2 = last ? nB : cB + (size_t)(t + 2) * kstep;
            const char* a3 = a2 + kstep; const char* b3 = b2 + kstep;
            if (last && has_next) S.a_ready(nxt);
            if constexpr (SP2) {
            PG8_LDB(B0, 0, 0); PG8_LDB(B1, 0, 1); PG8_SCHED; PG8_LDA(At, 0, 0); PG8_STAGE(PG8_SA(1, 1), a1 + hstep, voffA);
            PG8_WAIT_V(8); PG8_WAIT_L(0); PG8_BAR; PG8_MMA(0, 0, At, B0); PG8_MMA(0, 1, At, B1); PG8_BAR; PG8_SCHED;
            PG8_LDA(At, 0, 1); PG8_STAGE(PG8_SB(0, 0), b2, voffB); PG8_STAGE(PG8_SB(0, 1), b2 + hstep, voffB); PG8_STAGE(PG8_SA(0, 0), a2, voffA);
            PG8_WAIT_V(8); PG8_WAIT_L(0); PG8_BAR; PG8_MMA(1, 0, At, B0); PG8_MMA(1, 1, At, B1); PG8_BAR; PG8_SCHED;
            PG8_LDB(B0, 1, 0); PG8_LDB(B1, 1, 1); PG8_SCHED; PG8_LDA(At, 1, 0); PG8_STAGE(PG8_SA(0, 1), a2 + hstep, voffA);
            PG8_WAIT_V(8); PG8_WAIT_L(0); PG8_BAR; PG8_MMA(0, 0, At, B0); PG8_MMA(0, 1, At, B1); PG8_BAR; PG8_SCHED;
            PG8_LDA(At, 1, 1); PG8_STAGE(PG8_SB(1, 0), b3, voffB); PG8_STAGE(PG8_SB(1, 1), b3 + hstep, voffB); PG8_STAGE(PG8_SA(1, 0), a3, voffA);
            PG8_WAIT_V(8); PG8_WAIT_L(0); PG8_BAR; PG8_MMA(1, 0, At, B0); PG8_MMA(1, 1, At, B1); PG8_BAR; PG8_SCHED;
            } else {
            PG8_LDB(B0, 0, 0); PG8_SCHED; PG8_LDA(At, 0, 0); PG8_STAGE(PG8_SA(1, 1), a1 + hstep, voffA);
            PG8_WAIT_L(8); PG8_BAR; PG8_WAIT_L(0); PG8_MMA(0, 0, At, B0); PG8_BAR; PG8_SCHED;
            PG8_LDB(B1, 0, 1); PG8_STAGE(PG8_SB(0, 0), b2, voffB);
            PG8_BAR; PG8_WAIT_L(0); PG8_MMA(0, 1, At, B1); PG8_BAR;
            PG8_LDA(At, 0, 1); PG8_STAGE(PG8_SA(0, 0), a2, voffA);
            PG8_BAR; PG8_WAIT_L(0); PG8_MMA(1, 0, At, B0); PG8_BAR; PG8_SCHED;
            PG8_STAGE(PG8_SB(0, 1), b2 + hstep, voffB);
            PG8_WAIT_V(6); PG8_BAR; PG8_MMA(1, 1, At, B1); PG8_BAR;
            PG8_LDB(B0, 1, 0); PG8_SCHED; PG8_LDA(At, 1, 0); PG8_STAGE(PG8_SA(0, 1), a2 + hstep, voffA);
            PG8_WAIT_L(8); PG8_BAR; PG8_WAIT_L(0); PG8_MMA(0, 0, At, B0); PG8_BAR; PG8_SCHED;
            PG8_LDB(B1, 1, 1); PG8_STAGE(PG8_SB(1, 0), b3, voffB);
            PG8_BAR; PG8_WAIT_L(0); PG8_MMA(0, 1, At, B1); PG8_BAR;
            PG8_LDA(At, 1, 1); PG8_STAGE(PG8_SA(1, 0), a3, voffA);
            PG8_BAR; PG8_WAIT_L(0); PG8_MMA(1, 0, At, B0); PG8_BAR; PG8_SCHED;
            PG8_STAGE(PG8_SB(1, 1), b3 + hstep, voffB);
            PG8_WAIT_V(6); PG8_BAR; PG8_MMA(1, 1, At, B1); PG8_BAR;
            }
        }
        if constexpr (ALIGN_EPI) { if (wr == 0) PG8_BAR; }
        if constexpr (!Epi::AFTER_DRAIN) { E(acc, cur, wr, wc, fr, fq); S.done(cur); }
        if (!has_next) break;
#pragma unroll
        for (int a = 0; a < 2; ++a)
#pragma unroll
            for (int b = 0; b < 2; ++b)
#pragma unroll
                for (int m = 0; m < 4; ++m)
#pragma unroll
                    for (int n = 0; n < 2; ++n) acc[a][b][m][n] = (f32x4){0.f, 0.f, 0.f, 0.f};
        cur = nxt; cA = nA; cB = nB; ++ui;
        if constexpr (ALIGN_EPI) { if (wr == 1) PG8_BAR; }
    }
    PG8_WAIT_V(0);
    if constexpr (!ALIGN_EPI) { if (wr == 0) PG8_BAR; }
    PG8_BAR;
    if constexpr (Epi::AFTER_DRAIN) { E.fused(acc, cur, wr, wc, fr, fq, lds, wid, lane); S.done(cur); }
#undef PG8_SA
#undef PG8_SB
#undef PG8_STAGE
#undef PG8_LDA
#undef PG8_LDB
#undef PG8_MMA
#undef PG8_WAIT_V
#undef PG8_WAIT_L
#undef PG8_BAR
#undef PG8_SCHED
}
}

using pg8::f32x4; using pg8::bf16x8;
typedef unsigned short bf16;
typedef unsigned v4u __attribute__((ext_vector_type(4)));
typedef unsigned v2u __attribute__((ext_vector_type(2)));
typedef short s16x4 __attribute__((ext_vector_type(4)));

constexpr int DM = 1024, TLEN = 8192, CTXL = 256, TT = 8448, NLAT = 16384, NR = 16896, DFF = 2816, UC = 2560, NTILE = 528;
constexpr int NSEG = 64, SEGLEN = 132;
constexpr size_t MiB = 1u << 20;
constexpr size_t A8 = (size_t)NR * 256 * 2;
constexpr size_t OFF_MOD = 0, MOD_BYTES = 256 * 1024;
constexpr size_t OFF_XCTX = MiB / 4, OFF_XMY = 2 * MiB + MiB / 4, OFF_HU = 35 * MiB + MiB / 4, OFF_W = 126 * MiB, OFF_MIX = 167 * MiB, OFF_PR = 266 * MiB;
constexpr size_t W_13A = OFF_W, W_2A = OFF_W + 11 * MiB, W_13B = OFF_W + 16 * MiB + MiB / 2, W_2B = OFF_W + 27 * MiB + MiB / 2,
                 W_IN = OFF_W + 33 * MiB, W_OUT = OFF_W + 38 * MiB, W_UQ = OFF_W + 40 * MiB, W_UKV = OFF_W + 40 * MiB + 256 * 1024,
                 W_WUP = OFF_W + 40 * MiB + 384 * 1024, W_AUP = W_WUP + 65536, W_GUP = W_AUP + 65536, W_LWA = W_GUP + 65536, W_LWX = W_LWA + 65536;
constexpr size_t M_QB = OFF_MIX, M_KB = OFF_MIX + 12976128, M_VT = OFF_MIX + 25952256;
constexpr size_t M_LR0 = OFF_PR, M_LIX0 = OFF_PR + 2 * A8;
constexpr size_t M_SEGA = OFF_HU + 83 * MiB, M_SEGB = M_SEGA + MiB + MiB / 4, M_H0 = M_SEGB + MiB + MiB / 4;
constexpr size_t M_RR = OFF_MIX, M_KK = OFF_MIX + A8, M_VV = OFF_MIX + 2 * A8, M_WW = OFF_MIX + 3 * A8, M_BB = OFF_MIX + 7 * A8, M_KD = OFF_MIX + 9 * A8, M_GC = OFF_MIX + 11 * A8;
constexpr size_t M_YS = OFF_HU, M_PL = OFF_HU + 33 * MiB, M_SINIT = OFF_HU + 65 * MiB;
constexpr size_t M_PR = OFF_PR;
constexpr size_t WS_NEED = OFF_PR + 33 * MiB;
constexpr int LDS_BYTES = 131072 + 1024;
#ifndef REP_M1
#define REP_M1 1
#endif
#ifndef REP_M2
#define REP_M2 1
#endif
#ifndef REP_M3
#define REP_M3 1
#endif
#ifndef REP_SCAN
#define REP_SCAN 1
#endif
#ifndef REP_G1
#define REP_G1 1
#endif
constexpr float QSCALE = 0.10206207261596575f * 1.4426950408889634f;

struct Args { const float* in[40]; float* out; unsigned char* ws; };
typedef const __attribute__((address_space(4))) volatile unsigned long long kargq;
__device__ __forceinline__ const float* karg_in(int i) { kargq* p = (kargq*)__builtin_amdgcn_kernarg_segment_ptr(); return (const float*)p[i]; }
__device__ __forceinline__ float* karg_out() { kargq* p = (kargq*)__builtin_amdgcn_kernarg_segment_ptr(); return (float*)p[40]; }
__device__ __forceinline__ unsigned char* karg_ws() { kargq* p = (kargq*)__builtin_amdgcn_kernarg_segment_ptr(); return (unsigned char*)p[41]; }
#define IN(i) karg_in(i)
__device__ __forceinline__ int ltid() { int t = threadIdx.x; asm volatile("" : "+v"(t)); return t; }
__device__ __forceinline__ int lbid() { int t = blockIdx.x; asm volatile("" : "+s"(t)); return t; }
template <class T> __device__ __forceinline__ T* launder(T* p) { asm volatile("" : "+s"(p)); return p; }

__device__ __forceinline__ float bf2f(bf16 h) { return __uint_as_float((unsigned)h << 16); }
__device__ __forceinline__ unsigned f2bf(float f) { unsigned u = __float_as_uint(f); return (u + 0x7fffu + ((u >> 16) & 1u)) >> 16; }
__device__ __forceinline__ unsigned pk2(float lo, float hi) { return f2bf(lo) | (f2bf(hi) << 16); }
__device__ __forceinline__ float sigm(float x) { return 1.f / (1.f + __expf(-x)); }
__device__ __forceinline__ float siluf_(float x) { return x / (1.f + __expf(-x)); }
__device__ __forceinline__ float tanhf_(float y) { return 1.f - 2.f / (1.f + __expf(2.f * y)); }
__device__ __forceinline__ float geluf_(float x) { return 0.5f * x * (1.f + tanhf_(0.7978845608028654f * (x + 0.044715f * x * x * x))); }
__device__ __forceinline__ float wave_sum(float v) {
#pragma unroll
    for (int o = 1; o < 64; o <<= 1) v += __shfl_xor(v, o);
    return v;
}
struct TileInfo { int b, isctx, t0, seqbase, seqlen; };
__device__ __forceinline__ TileInfo tile_info(int tile) {
    TileInfo ti;
    if (tile < 512) { ti.b = tile >> 8; ti.isctx = 0; ti.t0 = (tile & 255) * 32; ti.seqbase = ti.b * TLEN; ti.seqlen = TLEN; }
    else { const int q = tile - 512; ti.b = q >> 3; ti.isctx = 1; ti.t0 = (q & 7) * 32; ti.seqbase = NLAT + ti.b * CTXL; ti.seqlen = CTXL; }
    return ti;
}

struct EpiSwiglu {
    static constexpr bool PERM = true, AFTER_DRAIN = false;
    bf16* H;
    __device__ __forceinline__ void operator()(const f32x4 (&acc)[2][2][4][2], const pg8::Unit& u, int wr, int wc, int fr, int fq) const {
        int pm = u.pm, pn = u.pn; asm volatile("" : "+s"(pm), "+s"(pn), "+s"(wr), "+s"(wc), "+v"(fr), "+v"(fq));
        bf16* tb = H + (size_t)pm * 256 * DFF + pn * 128;
        const unsigned loff = (unsigned)((wr * 64 + fr) * DFF + wc * 32 + 8 * fq);
#pragma unroll
        for (int ai = 0; ai < 2; ++ai)
#pragma unroll
            for (int m = 0; m < 4; ++m) {
                bf16* rowp = tb + (loff + (unsigned)((ai * 128 + m * 16) * DFF));
                const f32x4 g0 = acc[ai][0][m][0], g1 = acc[ai][0][m][1], u0 = acc[ai][1][m][0], u1 = acc[ai][1][m][1];
                v4u w;
                w.x = pg8::cvt_pk_bf16(siluf_(g0[0]) * u0[0], siluf_(g0[1]) * u0[1]); w.y = pg8::cvt_pk_bf16(siluf_(g0[2]) * u0[2], siluf_(g0[3]) * u0[3]);
                w.z = pg8::cvt_pk_bf16(siluf_(g1[0]) * u1[0], siluf_(g1[1]) * u1[1]); w.w = pg8::cvt_pk_bf16(siluf_(g1[2]) * u1[2], siluf_(g1[3]) * u1[3]);
                *(v4u*)rowp = w;
            }
    }
};
struct EpiU {
    static constexpr bool PERM = true, AFTER_DRAIN = false;
    bf16* O; int ldc;
    __device__ __forceinline__ void operator()(const f32x4 (&acc)[2][2][4][2], const pg8::Unit& u, int wr, int wc, int fr, int fq) const {
        int pm = u.pm, pn = u.pn; asm volatile("" : "+s"(pm), "+s"(pn), "+s"(wr), "+s"(wc), "+v"(fr), "+v"(fq));
        bf16* tb = O + (size_t)pm * 256 * ldc + pn * 256;
        const unsigned loff = (unsigned)((wr * 64 + fr) * ldc + wc * 32 + 8 * fq);
#pragma unroll
        for (int ai = 0; ai < 2; ++ai)
#pragma unroll
            for (int m = 0; m < 4; ++m) {
                bf16* rowp = tb + (loff + (unsigned)((ai * 128 + m * 16) * ldc));
#pragma unroll
                for (int bj = 0; bj < 2; ++bj) { const f32x4 v0 = acc[ai][bj][m][0], v1 = acc[ai][bj][m][1]; v4u w;
                    w.x = pg8::cvt_pk_bf16(v0[0], v0[1]); w.y = pg8::cvt_pk_bf16(v0[2], v0[3]); w.z = pg8::cvt_pk_bf16(v1[0], v1[1]); w.w = pg8::cvt_pk_bf16(v1[2], v1[3]);
                    *(v4u*)(rowp + bj * 128) = w; }
            }
    }
};
struct EpiResid {
    static constexpr bool PERM = false, AFTER_DRAIN = false;
    float* xlat; float* xctx; const float* gate; float coef; const float* slat; const float* sctx;
    __device__ __forceinline__ void operator()(const f32x4 (&acc)[2][2][4][2], const pg8::Unit& u, int wr, int wc, int fr, int fq) const {
        int pm = u.pm, pn = u.pn; asm volatile("" : "+s"(pm), "+s"(pn), "+s"(wr), "+s"(wc), "+v"(fr), "+v"(fq));
        const size_t toff = (pm < 64 ? (size_t)pm : (size_t)(pm - 64)) * 256 * DM + pn * 256;
        float* tb = (pm < 64 ? xlat : xctx) + toff; const float* sb = (pm < 64 ? slat : sctx) + toff;
        const float* g = gate + (pm < 64 ? (pm >> 5) : 2) * 9216 + pn * 256;
        const unsigned coff = (unsigned)(wc * 32 + 4 * fq), loff = (unsigned)((wr * 64 + fr) * DM) + coff;
        f32x4 gv[2][2];
#pragma unroll
        for (int bj = 0; bj < 2; ++bj)
#pragma unroll
            for (int n = 0; n < 2; ++n) gv[bj][n] = coef * *(const f32x4*)(g + (coff + (unsigned)(bj * 128 + n * 16)));
#pragma unroll
        for (int ai = 0; ai < 2; ++ai)
#pragma unroll
            for (int m = 0; m < 4; ++m) {
                float* xr = tb + (loff + (unsigned)((ai * 128 + m * 16) * DM)); const float* sr = sb + (loff + (unsigned)((ai * 128 + m * 16) * DM));
#pragma unroll
                for (int bj = 0; bj < 2; ++bj)
#pragma unroll
                    for (int n = 0; n < 2; ++n) { float* xp = xr + (bj * 128 + n * 16);
                        f32x4 xv = *(const f32x4*)(sr + (bj * 128 + n * 16)); xv += gv[bj][n] * acc[ai][bj][m][n]; *(f32x4*)xp = xv; }
                asm volatile("" ::: "memory");
            }
    }
};

__device__ __forceinline__ void phase_modgemv(const Args& a, float* red, int G, int bid, int tid) {
    const float* c = IN(1); const float* cctx = IN(3); const float* ada_w = IN(4); const float* ada_b = IN(5);
    float* mod = (float*)(karg_ws() + OFF_MOD);
    const int w = tid >> 6, lane = tid & 63;
    for (int u = bid; u < 576; u += G) {
        const int l = u / 288, rem = u % 288, jt = rem >> 3, ks = rem & 7;
        const int kb = ks * 128 + w * 16, j0 = jt * 256 + lane * 4;
        f32x4 acc0 = {0.f, 0.f, 0.f, 0.f}, acc1 = acc0, acc2 = acc0;
        for (int kk = 0; kk < 16; ++kk) { const int k = kb + kk;
            const float s0 = siluf_(c[k]), s1 = siluf_(c[1024 + k]), s2 = siluf_(cctx[k]);
            const f32x4 wv = *(const f32x4*)(ada_w + ((size_t)(l * 1024 + k)) * 9216 + j0);
            acc0 += s0 * wv; acc1 += s1 * wv; acc2 += s2 * wv; }
        float* rp = red + (w * 3) * 256 + lane * 4;
        *(f32x4*)rp = acc0; *(f32x4*)(rp + 256) = acc1; *(f32x4*)(rp + 512) = acc2;
        __syncthreads();
        for (int o = tid; o < 768; o += 512) { const int m = o >> 8, jj = o & 255; float s = 0.f;
#pragma unroll
            for (int ww = 0; ww < 8; ++ww) s += red[(ww * 3 + m) * 256 + jj];
            const int j = jt * 256 + jj; if (ks == 0) s += ada_b[l * 9216 + j];
            atomicAdd(&mod[(l * 3 + m) * 9216 + j], s); }
        __syncthreads();
    }
}
__device__ __forceinline__ void phase_copy(const Args& a, int G, int bid, int tid) {
    const f32x4* x4 = (const f32x4*)IN(0); f32x4* o4 = (f32x4*)karg_out();
    for (int i = bid * 512 + tid; i < NLAT * DM / 4; i += G * 512) o4[i] = x4[i];
    const f32x4* c4 = (const f32x4*)IN(2); f32x4* xc4 = (f32x4*)(karg_ws() + OFF_XCTX);
    for (int i = bid * 512 + tid; i < 512 * DM / 4; i += G * 512) xc4[i] = c4[i];
}
__device__ __forceinline__ int swiglu_map(int n) { return n < DFF ? ((n >> 7) * 256 + (n & 127)) : ((((n - DFF) >> 7) * 256) + 128 + ((n - DFF) & 127)); }
__device__ __forceinline__ void transpose_item(const float* W, int K, int N, bf16* WT, float* scr, int item, int lane, int mode, const float* kscale) {
    const int nblk = N / 32, kb = item / nblk, nb = item % nblk, k0 = 64 * kb, n0 = 32 * nb;
    float tv[32];
#pragma unroll
    for (int i = 0; i < 32; ++i) { const int kk = 2 * i + (lane >> 5); tv[i] = W[(size_t)(k0 + kk) * N + n0 + (lane & 31)]; }
#pragma unroll
    for (int i = 0; i < 32; ++i) { const int kk = 2 * i + (lane >> 5); float v = tv[i]; if (kscale) v *= kscale[k0 + kk]; scr[kk * 33 + (lane & 31)] = v; }
    __builtin_amdgcn_wave_barrier();
    const int c = lane & 7;
#pragma unroll
    for (int j = 0; j < 4; ++j) { const int n = (lane >> 3) + 8 * j; const float* s = scr + (8 * c) * 33 + n;
        v4u o; o.x = pk2(s[0 * 33], s[1 * 33]); o.y = pk2(s[2 * 33], s[3 * 33]); o.z = pk2(s[4 * 33], s[5 * 33]); o.w = pk2(s[6 * 33], s[7 * 33]);
        const int nn = n0 + n, drow = mode ? swiglu_map(nn) : nn;
        *(v4u*)(WT + (size_t)drow * K + k0 + 8 * c) = o; }
    __builtin_amdgcn_wave_barrier();
}
__device__ __forceinline__ void convert_weights(const Args& a, int l, float* scr, int gw, int NGW, int lane, int G, int bid, int tid) {
    constexpr int I13 = 16 * 176, I2 = 44 * 32, IIN = 16 * 77, IOUT = 16 * 32, IUQ = 4 * 12, IUKV = 2 * 16;
    constexpr int IEX = 80;
    constexpr int NIT = 2 * I13 + 2 * I2 + IIN + IOUT + IUQ + IUKV + IEX;
    unsigned char* ws = karg_ws();
    for (int it = gw; it < NIT; it += NGW) {
        int r = it;
        if (r < I13) { transpose_item(IN(6) + (size_t)l * DM * 2 * DFF, DM, 2 * DFF, (bf16*)(ws + W_13A), scr, r, lane, 1, nullptr); continue; } r -= I13;
        if (r < I13) { transpose_item(IN(8) + (size_t)l * DM * 2 * DFF, DM, 2 * DFF, (bf16*)(ws + W_13B), scr, r, lane, 1, nullptr); continue; } r -= I13;
        if (r < I2) { transpose_item(IN(7) + (size_t)l * DFF * DM, DFF, DM, (bf16*)(ws + W_2A), scr, r, lane, 0, nullptr); continue; } r -= I2;
        if (r < I2) { transpose_item(IN(9) + (size_t)l * DFF * DM, DFF, DM, (bf16*)(ws + W_2B), scr, r, lane, 0, nullptr); continue; } r -= I2;
        if (r < IIN) { transpose_item(IN(10) + (size_t)l * DM * 2464, DM, 2464, (bf16*)(ws + W_IN), scr, r, lane, 0, nullptr); continue; } r -= IIN;
        if (r < IOUT) { transpose_item(IN(11) + (size_t)l * DM * DM, DM, DM, (bf16*)(ws + W_OUT), scr, r, lane, 0, nullptr); continue; } r -= IOUT;
        if (r < IUQ) { transpose_item(IN(36) + (size_t)l * 256 * 384, 256, 384, (bf16*)(ws + W_UQ), scr, r, lane, 0, IN(35) + l * 256); continue; } r -= IUQ;
        if (r < IUKV) { transpose_item(IN(38) + (size_t)l * 128 * 512, 128, 512, (bf16*)(ws + W_UKV), scr, r, lane, 0, IN(37) + l * 128); continue; } r -= IUKV;
        if (r < 16) { const int d = r >> 3; transpose_item(IN(26) + (size_t)(l * 2 + d) * 64 * 256, 64, 256, (bf16*)(ws + W_WUP) + d * 256 * 64, scr, r & 7, lane, 0, nullptr); continue; } r -= 16;
        if (r < 16) { const int d = r >> 3; transpose_item(IN(28) + (size_t)(l * 2 + d) * 64 * 256, 64, 256, (bf16*)(ws + W_AUP) + d * 256 * 64, scr, r & 7, lane, 0, nullptr); continue; } r -= 16;
        if (r < 16) { transpose_item(IN(29) + (size_t)l * 128 * 256, 128, 256, (bf16*)(ws + W_GUP), scr, r, lane, 0, nullptr); continue; } r -= 16;
        if (r < 16) { const int m = r >> 1; transpose_item(IN(18) + (size_t)(l * 8 + m) * 4096, 64, 64, (bf16*)(ws + W_LWA) + m * 4096, scr, r & 1, lane, 0, nullptr); continue; } r -= 16;
        { const int m = r >> 1; transpose_item(IN(20) + (size_t)(l * 8 + m) * 4096, 64, 64, (bf16*)(ws + W_LWX) + m * 4096, scr, r & 1, lane, 0, nullptr); }
    }
    v4u z = {0u, 0u, 0u, 0u}; v4u* zp = (v4u*)(ws + W_IN + (size_t)2464 * DM * 2);
    for (int i = bid * 512 + tid; i < 96 * DM * 2 / 16; i += G * 512) zp[i] = z;
}
__device__ __forceinline__ void phase_modulate(const Args& a, int l, int which, int gw, int NGW, int lane) {
    unsigned char* ws = karg_ws(); const float* outp = karg_out();
    const bool first = (l == 0 && which == 0);
    const float* srcl = first ? IN(0) : outp; const float* srcc = first ? IN(2) : (const float*)(ws + OFF_XCTX);
    const float* mod = (const float*)(ws + OFF_MOD) + (size_t)l * 3 * 9216;
    bf16* XM = (bf16*)(ws + OFF_XMY);
    for (int r = gw; r < NR; r += NGW) {
        const float* xr = r < NLAT ? srcl + (size_t)r * DM : srcc + (size_t)(r - NLAT) * DM;
        const float* mm = mod + (r < NLAT ? (r >> 13) : 2) * 9216 + which * 3 * 1024;
        f32x4 v[4]; float ss = 0.f;
#pragma unroll
        for (int j = 0; j < 4; ++j) { v[j] = *(const f32x4*)(xr + 4 * lane + 256 * j); ss += (v[j][0] * v[j][0] + v[j][1] * v[j][1]) + (v[j][2] * v[j][2] + v[j][3] * v[j][3]); }
        const float rstd = rsqrtf(wave_sum(ss) * (1.f / DM) + 1e-6f);
#pragma unroll
        for (int j = 0; j < 4; ++j) { const int c = 4 * lane + 256 * j; const f32x4 sh = *(const f32x4*)(mm + c), sc = *(const f32x4*)(mm + 1024 + c);
            const f32x4 o = v[j] * rstd * (1.f + sc) + sh; v2u w; w.x = pk2(o[0], o[1]); w.y = pk2(o[2], o[3]);
            *(v2u*)(XM + (size_t)r * DM + c) = w; }
    }
}
__device__ __forceinline__ void phase_final(const Args& a, int gw, int NGW, int lane) {
    const float* fn = IN(39); float* outp = karg_out();
    for (int r = gw; r < NLAT; r += NGW) {
        float* xr = outp + (size_t)r * DM; f32x4 v[4]; float ss = 0.f;
#pragma unroll
        for (int j = 0; j < 4; ++j) { v[j] = *(const f32x4*)(xr + 4 * lane + 256 * j); ss += (v[j][0] * v[j][0] + v[j][1] * v[j][1]) + (v[j][2] * v[j][2] + v[j][3] * v[j][3]); }
        const float rstd = rsqrtf(wave_sum(ss) * (1.f / DM) + 1e-6f);
#pragma unroll
        for (int j = 0; j < 4; ++j) { const int c = 4 * lane + 256 * j; const f32x4 g = *(const f32x4*)(fn + c); *(f32x4*)(xr + c) = v[j] * rstd * g; }
    }
}

__device__ __forceinline__ void phase_m1(const Args& a, int l, unsigned char* lds, int G, int bid, int tid_unused) {
    unsigned char* ws = karg_ws();
    const bf16* U = (const bf16*)(ws + OFF_HU);
    bf16* Y = (bf16*)(ws + OFF_XMY);
    for (int pass = 0; pass < 2; ++pass)
    for (int tile = (pass == 0 ? bid : (bid < 48 ? 512 + bid / 3 : NTILE)); tile < (pass == 0 ? 512 : NTILE); tile += (pass == 0 ? G : NTILE)) {
        const int mask = pass == 0 ? 7 : ((1 << (bid % 3)) & (l == 1 ? 6 : 7));
        const TileInfo ti = tile_info(tile);
        const int row0 = tile * 32;
        if (mask & 1) {
            const int tid = ltid(); const int lane = tid & 63, wave = __builtin_amdgcn_readfirstlane(tid >> 6), ch = tid & 255, part = tid >> 8; (void)lane; (void)wave; (void)ch; (void)part;
            float* z = (float*)lds;
            float* cv = (float*)(lds + 65536);
            for (int tt = part; tt < 62; tt += 2) { const int t = ti.t0 - 15 + tt; float zz = 0.f;
                if (t >= 0 && t < ti.seqlen) { const bf16* ur = U + (size_t)(ti.seqbase + t) * UC; zz = bf2f(ur[ch]) * sigm(bf2f(ur[256 + ch])); }
                z[tt * 256 + ch] = zz; }
            __syncthreads();
            const float* dw = IN(12) + (size_t)l * 31 * 256 + ch;
            float acc[16]; const float bias = IN(13)[l * 256 + ch];
#pragma unroll
            for (int o = 0; o < 16; ++o) acc[o] = bias;
            for (int j = 0; j < 31; ++j) { const float w = dw[j * 256];
#pragma unroll
                for (int o = 0; o < 16; ++o) acc[o] += w * z[(part * 16 + o + j) * 256 + ch]; }
#pragma unroll
            for (int o = 0; o < 16; ++o) cv[(part * 16 + o) * 256 + ch] = acc[o];
            __syncthreads();
            const f32x4 lg = *(const f32x4*)(IN(14) + l * 256 + lane * 4), lb = *(const f32x4*)(IN(15) + l * 256 + lane * 4);
#pragma unroll
            for (int q = 0; q < 4; ++q) { const int t = wave * 4 + q; const f32x4 v = *(const f32x4*)(cv + t * 256 + lane * 4);
                const float mu = wave_sum((v[0] + v[1]) + (v[2] + v[3])) * (1.f / 256.f);
                const f32x4 dv = v - mu; const float var = wave_sum((dv[0] * dv[0] + dv[1] * dv[1]) + (dv[2] * dv[2] + dv[3] * dv[3])) * (1.f / 256.f);
                const f32x4 yn = dv * rsqrtf(var + 1e-5f) * lg + lb;
                v2u w; w.x = pk2(siluf_(yn[0]), siluf_(yn[1])); w.y = pk2(siluf_(yn[2]), siluf_(yn[3]));
                *(v2u*)(Y + (size_t)(row0 + t) * DM + lane * 4) = w; }
            __syncthreads();
        }
        if (mask & 2) {
            float* xvf = (float*)lds;
            bf16* xvb = (bf16*)(lds + 32768);
            bf16* rg = (bf16*)(lds + 49664);
            bf16* ixg = (bf16*)(lds + 82432);
            {
                const int tid = ltid(); const int ch = tid & 255, part = tid >> 8;
                const float* cw = IN(16) + (size_t)l * 4 * 256 + ch; const float w0 = cw[0], w1 = cw[256], w2 = cw[512], w3 = cw[768], cb = IN(17)[l * 256 + ch];
                float xin[19];
#pragma unroll
                for (int i = 0; i < 19; ++i) { const int t = ti.t0 + part * 16 + i - 2; xin[i] = (t >= 0 && t < ti.seqlen) ? bf2f(U[(size_t)(ti.seqbase + t) * UC + 512 + ch]) : 0.f; }
#pragma unroll
                for (int o = 0; o < 16; ++o) { const int tl = part * 16 + o;
                    const float v = cb + w0 * xin[o] + w1 * xin[o + 1] + w2 * xin[o + 2] + w3 * xin[o + 3];
                    xvf[tl * 256 + ch] = v; xvb[tl * 264 + ch] = (bf16)f2bf(v);
                }
            }
            __syncthreads();
            {
                const int tid = ltid(); const int ln = tid & 63, wv = __builtin_amdgcn_readfirstlane(tid >> 6), fr = ln & 15, fq = ln >> 4, blk = wv >> 1;
                const bf16* LWAt = (const bf16*)(ws + W_LWA); const bf16* LWXt = (const bf16*)(ws + W_LWX);
                bf16x8 af[2][2];
#pragma unroll
                for (int mt = 0; mt < 2; ++mt)
#pragma unroll
                    for (int ks = 0; ks < 2; ++ks) af[mt][ks] = *(const bf16x8*)(xvb + (mt * 16 + fr) * 264 + blk * 64 + ks * 32 + fq * 8);
#pragma unroll 1
                for (int dn = 0; dn < 4; ++dn) { const int d = dn >> 1, nt = wv * 2 + (dn & 1), ch = nt * 16 + fr, jj = (nt & 3) * 16 + fr;
                    f32x4 ca[2], cx[2];
#pragma unroll
                    for (int mt = 0; mt < 2; ++mt) { ca[mt] = (f32x4){0.f, 0.f, 0.f, 0.f}; cx[mt] = ca[mt]; }
#pragma unroll
                    for (int ks = 0; ks < 2; ++ks) { const size_t wo = ((size_t)(d * 4 + blk) * 64 + jj) * 64 + ks * 32 + fq * 8;
                        const bf16x8 ba = *(const bf16x8*)(LWAt + wo), bx = *(const bf16x8*)(LWXt + wo);
#pragma unroll
                        for (int mt = 0; mt < 2; ++mt) { ca[mt] = __builtin_amdgcn_mfma_f32_16x16x32_bf16(af[mt][ks], ba, ca[mt], 0, 0, 0); cx[mt] = __builtin_amdgcn_mfma_f32_16x16x32_bf16(af[mt][ks], bx, cx[mt], 0, 0, 0); } }
                    const float bga = IN(19)[(l * 2 + d) * 256 + ch], bgx = IN(21)[(l * 2 + d) * 256 + ch];
                    bf16* LR = (bf16*)(ws + M_LR0 + (size_t)d * A8); bf16* LIX = (bf16*)(ws + M_LIX0 + (size_t)d * A8);
#pragma unroll
                    for (int mt = 0; mt < 2; ++mt)
#pragma unroll
                        for (int j = 0; j < 4; ++j) { const int t = mt * 16 + fq * 4 + j;
                            const bf16 rb = (bf16)f2bf(sigm(ca[mt][j] + bga)), ib = (bf16)f2bf(sigm(cx[mt][j] + bgx) * xvf[t * 256 + ch]);
                            LR[(size_t)(row0 + t) * 256 + ch] = rb; LIX[(size_t)(row0 + t) * 256 + ch] = ib;
                            rg[(d * 32 + t) * 256 + ch] = rb; ixg[(d * 32 + t) * 256 + ch] = ib; }
                }
            }
            __syncthreads();
            {
                const int tid = ltid(); const int ch = tid & 255, d = tid >> 8;
                const float lam = IN(22)[(l * 2 + d) * 256 + ch];
                const float cch = -8.f * log1pf(__expf(-lam));
                float A = 1.f, B = 0.f;
#pragma unroll 8
                for (int tt = 0; tt < 32; ++tt) { const int t = d ? 31 - tt : tt;
                    const float al = __expf(cch * bf2f(rg[(d * 32 + t) * 256 + ch])); const float bb = sqrtf(fmaxf(1.f - al * al, 0.f)) * bf2f(ixg[(d * 32 + t) * 256 + ch]); B = al * B + bb; A *= al; }
                ((float*)(ws + M_SEGA))[(size_t)(tile * 2 + d) * 256 + ch] = A;
                ((float*)(ws + M_SEGB))[(size_t)(tile * 2 + d) * 256 + ch] = B;
            }
            __syncthreads();
        }
        if (mask & 4) {
            const int tid = ltid(); const int lane = tid & 63, wave = __builtin_amdgcn_readfirstlane(tid >> 6), ch = tid & 255, part = tid >> 8; (void)lane; (void)wave; (void)ch; (void)part;
            bf16* As = (bf16*)lds;
            float* kr = (float*)(lds + 32768);
            float* rs = (float*)(lds + 32768 + 4096);
            for (int idx = tid; idx < 32 * 52; idx += 512) { const int t = idx / 52, cc = idx % 52;
                const v4u v = *(const v4u*)(U + (size_t)(row0 + t) * UC + 2048 + cc * 8);
                if (cc < 48) *(v4u*)(As + t * 392 + cc * 8) = v;
                else { const int c0 = (cc - 48) * 8; float* kp = kr + t * 32 + c0;
                    kp[0] = __uint_as_float(v.x << 16); kp[1] = __uint_as_float(v.x & 0xffff0000u); kp[2] = __uint_as_float(v.y << 16); kp[3] = __uint_as_float(v.y & 0xffff0000u);
                    kp[4] = __uint_as_float(v.z << 16); kp[5] = __uint_as_float(v.z & 0xffff0000u); kp[6] = __uint_as_float(v.w << 16); kp[7] = __uint_as_float(v.w & 0xffff0000u); } }
            __syncthreads();
#pragma unroll
            for (int q = 0; q < 4; ++q) { const int t = wave * 4 + q; float sq = 0.f, sk = 0.f;
#pragma unroll
                for (int j = 0; j < 4; ++j) { const float v = bf2f(As[t * 392 + lane + 64 * j]); sq += v * v; }
#pragma unroll
                for (int j = 0; j < 2; ++j) { const float v = bf2f(As[t * 392 + 256 + lane + 64 * j]); sk += v * v; }
                sq = wave_sum(sq); sk = wave_sum(sk);
                if (lane == 0) { rs[t * 2] = rsqrtf(sq * (1.f / 256.f) + 1e-6f); rs[t * 2 + 1] = rsqrtf(sk * (1.f / 128.f) + 1e-6f); } }
            __syncthreads();
            const int fr = lane & 15, fq = lane >> 4;
            bf16* QB = (bf16*)(ws + M_QB); bf16* KB = (bf16*)(ws + M_KB); bf16* VT = (bf16*)(ws + M_VT);
            const bf16* WUQ = (const bf16*)(ws + W_UQ); const bf16* WUKV = (const bf16*)(ws + W_UKV);
            const int keybase = ti.isctx ? TLEN : 0;
#pragma unroll 1
            for (int i = 0; i < 3; ++i) { const int nt = wave * 3 + i;
                f32x4 c0 = {0.f, 0.f, 0.f, 0.f}, c1 = c0;
#pragma unroll
                for (int ks = 0; ks < 8; ++ks) { const bf16x8 bfr = *(const bf16x8*)(WUQ + (size_t)(nt * 16 + fr) * 256 + ks * 32 + fq * 8);
                    const bf16x8 a0 = *(const bf16x8*)(As + fr * 392 + ks * 32 + fq * 8), a1 = *(const bf16x8*)(As + (16 + fr) * 392 + ks * 32 + fq * 8);
                    c0 = __builtin_amdgcn_mfma_f32_16x16x32_bf16(a0, bfr, c0, 0, 0, 0); c1 = __builtin_amdgcn_mfma_f32_16x16x32_bf16(a1, bfr, c1, 0, 0, 0); }
                const int hq = nt / 6, wt = nt % 6, dd = wt * 16 + fr;
#pragma unroll
                for (int mt = 0; mt < 2; ++mt)
#pragma unroll
                    for (int j = 0; j < 4; ++j) { const int tl = mt * 16 + fq * 4 + j; const int t = ti.t0 + tl;
                        float v = (mt ? c1[j] : c0[j]) * rs[tl * 2];
                        const float pv = __shfl_xor(v, 8);
                        if (wt >= 4 && !ti.isctx) { const int f = fr & 7; const float pos = (wt == 4) ? (float)(t >> 6) : (float)(t & 63);
                            const float ang = pos * __expf(-(float)f * (9.210340371976184f / 8.f)); float sn, cs; __sincosf(ang, &sn, &cs);
                            v = (fr & 8) ? (v * cs + pv * sn) : (v * cs - pv * sn); }
                        QB[((size_t)(ti.b * 4 + hq) * TT + keybase + t) * 96 + dd] = (bf16)f2bf(v * QSCALE); } }
#pragma unroll 1
            for (int i = 0; i < 4; ++i) { const int nt = wave * 4 + i;
                f32x4 c0 = {0.f, 0.f, 0.f, 0.f}, c1 = c0;
#pragma unroll
                for (int ks = 0; ks < 4; ++ks) { const bf16x8 bfr = *(const bf16x8*)(WUKV + (size_t)(nt * 16 + fr) * 128 + ks * 32 + fq * 8);
                    const bf16x8 a0 = *(const bf16x8*)(As + fr * 392 + 256 + ks * 32 + fq * 8), a1 = *(const bf16x8*)(As + (16 + fr) * 392 + 256 + ks * 32 + fq * 8);
                    c0 = __builtin_amdgcn_mfma_f32_16x16x32_bf16(a0, bfr, c0, 0, 0, 0); c1 = __builtin_amdgcn_mfma_f32_16x16x32_bf16(a1, bfr, c1, 0, 0, 0); }
                const int hk = nt >> 3, wt = nt & 7;
#pragma unroll
                for (int mt = 0; mt < 2; ++mt)
#pragma unroll
                    for (int j = 0; j < 4; ++j) { const int tl = mt * 16 + fq * 4 + j; const int key = keybase + ti.t0 + tl;
                        const float v = (mt ? c1[j] : c0[j]) * rs[tl * 2 + 1];
                        if (wt < 4) KB[((size_t)(ti.b * 4 + hk) * TT + key) * 96 + wt * 16 + fr] = (bf16)f2bf(v);
                        else VT[((size_t)(ti.b * 4 + hk) * 64 + (wt - 4) * 16 + fr) * TT + key] = (bf16)f2bf(v); } }
            { const int tl = tid >> 4, p = tid & 15, ax = p >> 3, f = p & 7; const int t = ti.t0 + tl;
                float x0 = kr[tl * 32 + ax * 16 + f], x1 = kr[tl * 32 + ax * 16 + 8 + f];
                if (!ti.isctx) { const float pos = ax == 0 ? (float)(t >> 6) : (float)(t & 63); const float ang = pos * __expf(-(float)f * (9.210340371976184f / 8.f));
                    float sn, cs; __sincosf(ang, &sn, &cs); const float y0 = x0 * cs - x1 * sn, y1 = x1 * cs + x0 * sn; x0 = y0; x1 = y1; }
                const bf16 b0 = (bf16)f2bf(x0), b1 = (bf16)f2bf(x1);
#pragma unroll
                for (int h = 0; h < 4; ++h) { bf16* kp = KB + ((size_t)(ti.b * 4 + h) * TT + keybase + t) * 96 + 64 + ax * 16 + f; kp[0] = b0; kp[8] = b1; } }
            __syncthreads();
        }
    }
}

__device__ __forceinline__ void attn_unit(unsigned char* lds, const bf16* QB, const bf16* KB, const bf16* VT, bf16* Y, int b, int h, int q0, int key_lo, int nkt, int tid) {
    const int lane = tid & 63, wave = tid >> 6, fr = lane & 15, fq = lane >> 4;
    const int bh = b * 4 + h;
    constexpr int KSTR = 104, VSTR = 72, KBUF = 64 * KSTR, VBUF = 64 * VSTR;
    bf16* Ks = (bf16*)lds;
    bf16* Vs = (bf16*)lds + 2 * KBUF;
    const int qw = q0 + wave * 32;
    bf16x8 qf[2][3];
#pragma unroll
    for (int qt = 0; qt < 2; ++qt)
#pragma unroll
        for (int ks = 0; ks < 3; ++ks) qf[qt][ks] = *(const bf16x8*)(QB + ((size_t)bh * TT + qw + qt * 16 + fr) * 96 + ks * 32 + fq * 8);
    float mrun[2] = {-1e30f, -1e30f}, lrun[2] = {0.f, 0.f};
    f32x4 o[4][2];
#pragma unroll
    for (int dt = 0; dt < 4; ++dt)
#pragma unroll
        for (int qt = 0; qt < 2; ++qt) o[dt][qt] = (f32x4){0.f, 0.f, 0.f, 0.f};
    const v4u* kg = (const v4u*)(KB + ((size_t)bh * TT + key_lo) * 96);
    const bf16* vg = VT + ((size_t)bh * 64 + (tid >> 3)) * TT + key_lo + (tid & 7) * 8;
    const int kc0 = tid, kc1 = 512 + tid;
    const int ko0 = (kc0 / 12) * KSTR + (kc0 % 12) * 8, ko1 = (kc1 / 12) * KSTR + (kc1 % 12) * 8, vo = (tid >> 3) * VSTR + (tid & 7) * 8;
    v4u rk0, rk1 = {0u, 0u, 0u, 0u}, rv;
    rk0 = kg[kc0]; if (tid < 256) rk1 = kg[kc1]; rv = *(const v4u*)vg;
    *(v4u*)(Ks + ko0) = rk0; if (tid < 256) *(v4u*)(Ks + ko1) = rk1; *(v4u*)(Vs + vo) = rv;
    __syncthreads();
    for (int kt = 0; kt < nkt; ++kt) {
        const int cur = kt & 1;
        if (kt + 1 < nkt) { const v4u* kn = kg + (size_t)(kt + 1) * 768; rk0 = kn[kc0]; if (tid < 256) rk1 = kn[kc1]; rv = *(const v4u*)(vg + (kt + 1) * 64); }
        const bf16* kb = Ks + cur * KBUF; const bf16* vb = Vs + cur * VBUF;
        f32x4 st[4][2];
#pragma unroll
        for (int k4 = 0; k4 < 4; ++k4) {
            st[k4][0] = (f32x4){0.f, 0.f, 0.f, 0.f}; st[k4][1] = st[k4][0];
#pragma unroll
            for (int ks = 0; ks < 3; ++ks) { const bf16x8 kf = *(const bf16x8*)(kb + (k4 * 16 + fr) * KSTR + ks * 32 + fq * 8);
                st[k4][0] = __builtin_amdgcn_mfma_f32_16x16x32_bf16(kf, qf[0][ks], st[k4][0], 0, 0, 0);
                st[k4][1] = __builtin_amdgcn_mfma_f32_16x16x32_bf16(kf, qf[1][ks], st[k4][1], 0, 0, 0); }
        }
        bf16x8 pb[2][2];
#pragma unroll
        for (int qt = 0; qt < 2; ++qt) {
            float mx = st[0][qt][0];
#pragma unroll
            for (int k4 = 0; k4 < 4; ++k4)
#pragma unroll
                for (int j = 0; j < 4; ++j) mx = fmaxf(mx, st[k4][qt][j]);
            mx = fmaxf(mx, __shfl_xor(mx, 16)); mx = fmaxf(mx, __shfl_xor(mx, 32));
            const float mn = fmaxf(mrun[qt], mx), alpha = __builtin_amdgcn_exp2f(mrun[qt] - mn); mrun[qt] = mn;
            float ls = 0.f;
#pragma unroll
            for (int k4 = 0; k4 < 4; ++k4)
#pragma unroll
                for (int j = 0; j < 4; ++j) { const float p = __builtin_amdgcn_exp2f(st[k4][qt][j] - mn); st[k4][qt][j] = p; ls += p; }
            lrun[qt] = lrun[qt] * alpha + ls;
#pragma unroll
            for (int dt = 0; dt < 4; ++dt) o[dt][qt] *= alpha;
#pragma unroll
            for (int u = 0; u < 2; ++u) { v4u w;
                w.x = pg8::cvt_pk_bf16(st[2 * u][qt][0], st[2 * u][qt][1]); w.y = pg8::cvt_pk_bf16(st[2 * u][qt][2], st[2 * u][qt][3]);
                w.z = pg8::cvt_pk_bf16(st[2 * u + 1][qt][0], st[2 * u + 1][qt][1]); w.w = pg8::cvt_pk_bf16(st[2 * u + 1][qt][2], st[2 * u + 1][qt][3]);
                pb[u][qt] = __builtin_bit_cast(bf16x8, w); }
        }
#pragma unroll
        for (int dt = 0; dt < 4; ++dt)
#pragma unroll
            for (int u = 0; u < 2; ++u) {
                const v2u lo = *(const v2u*)(vb + (dt * 16 + fr) * VSTR + 32 * u + 4 * fq), hi = *(const v2u*)(vb + (dt * 16 + fr) * VSTR + 32 * u + 16 + 4 * fq);
                v4u vw; vw.x = lo.x; vw.y = lo.y; vw.z = hi.x; vw.w = hi.y;
                const bf16x8 va = __builtin_bit_cast(bf16x8, vw);
                o[dt][0] = __builtin_amdgcn_mfma_f32_16x16x32_bf16(va, pb[u][0], o[dt][0], 0, 0, 0);
                o[dt][1] = __builtin_amdgcn_mfma_f32_16x16x32_bf16(va, pb[u][1], o[dt][1], 0, 0, 0);
            }
        if (kt + 1 < nkt) { const int nb = cur ^ 1; *(v4u*)(Ks + nb * KBUF + ko0) = rk0; if (tid < 256) *(v4u*)(Ks + nb * KBUF + ko1) = rk1; *(v4u*)(Vs + nb * VBUF + vo) = rv; }
        __syncthreads();
    }
#pragma unroll
    for (int qt = 0; qt < 2; ++qt) {
        float lt = lrun[qt]; lt += __shfl_xor(lt, 16); lt += __shfl_xor(lt, 32);
        const float inv = 1.f / lt;
        const int q = qw + qt * 16 + fr;
        const size_t row = q < TLEN ? (size_t)b * TLEN + q : (size_t)NLAT + b * CTXL + (q - TLEN);
#pragma unroll
        for (int dt = 0; dt < 4; ++dt) { const f32x4 v = o[dt][qt] * inv; v2u w; w.x = pk2(v[0], v[1]); w.y = pk2(v[2], v[3]);
            *(v2u*)(Y + row * DM + 768 + h * 64 + dt * 16 + fq * 4) = w; }
    }
}
__device__ __forceinline__ void lru_prefix(int bd, int tid) {
    unsigned char* ws = karg_ws();
    if (tid >= 256) return;
    const int ch = tid, b = bd >> 1, d = bd & 1;
    const float* __restrict__ SA = (const float*)(ws + M_SEGA); const float* __restrict__ SB = (const float*)(ws + M_SEGB); float* __restrict__ H0 = (float*)(ws + M_H0);
    const int ctile0 = 512 + b * 8, ltile0 = b * 256;
#define LRU_TILE(i_) ((i_) < 8 ? ctile0 + (d ? 7 - (i_) : (i_)) : ltile0 + (d ? 255 - ((i_) - 8) : ((i_) - 8)))
    float hst = 0.f;
    float ca[24], cb[24], na[24], nb[24];
#pragma unroll
    for (int k = 0; k < 24; ++k) { const size_t o = (size_t)(LRU_TILE(k) * 2 + d) * 256 + ch; ca[k] = SA[o]; cb[k] = SB[o]; }
    for (int i0 = 0; i0 < 264; i0 += 24) {
        if (i0 + 24 < 264) {
#pragma unroll
            for (int k = 0; k < 24; ++k) { const size_t o = (size_t)(LRU_TILE(i0 + 24 + k) * 2 + d) * 256 + ch; na[k] = SA[o]; nb[k] = SB[o]; } }
        float hv[24];
#pragma unroll
        for (int k = 0; k < 24; ++k) { hv[k] = hst; hst = ca[k] * hst + cb[k]; }
#pragma unroll
        for (int k = 0; k < 24; ++k) H0[(size_t)(LRU_TILE(i0 + k) * 2 + d) * 256 + ch] = hv[k];
#pragma unroll
        for (int k = 0; k < 24; ++k) { ca[k] = na[k]; cb[k] = nb[k]; }
    }
#undef LRU_TILE
}
__device__ __forceinline__ void lru_rescan(const Args& a, int l, unsigned char* lds, int tile, int tid) {
    unsigned char* ws = karg_ws();
    const int ch = tid & 255, d = tid >> 8;
    const int row0 = tile * 32;
    float hst = ((const float*)(ws + M_H0))[(size_t)(tile * 2 + d) * 256 + ch];
    const float lam = IN(22)[(l * 2 + d) * 256 + ch];
    const float cch = -8.f * log1pf(__expf(-lam));
    const bf16* LR = (const bf16*)(ws + M_LR0 + (size_t)d * A8); const bf16* LIX = (const bf16*)(ws + M_LIX0 + (size_t)d * A8);
    float* hs = (float*)lds;
#pragma unroll 16
    for (int tt = 0; tt < 32; ++tt) { const int t = d ? 31 - tt : tt; const size_t o = (size_t)(row0 + t) * 256 + ch;
        const float al = __expf(cch * bf2f(LR[o])); const float bb = sqrtf(fmaxf(1.f - al * al, 0.f)) * bf2f(LIX[o]);
        hst = al * hst + bb; hs[(d * 32 + t) * 256 + ch] = hst; }
    __syncthreads();
    const bf16* U = (const bf16*)(ws + OFF_HU); bf16* Y = (bf16*)(ws + OFF_XMY);
#pragma unroll 8
    for (int tt = 0; tt < 16; ++tt) { const int t = d * 16 + tt;
        const float y = (hs[t * 256 + ch] + hs[(32 + t) * 256 + ch]) * geluf_(bf2f(U[(size_t)(row0 + t) * UC + 768 + ch]));
        Y[(size_t)(row0 + t) * DM + 256 + ch] = (bf16)f2bf(y); }
    __syncthreads();
}
__device__ __forceinline__ void phase_m2(const Args& a, int l, unsigned char* lds, int G, int bid, int tid) {
    unsigned char* ws = karg_ws();
    const bf16* QB = (const bf16*)(ws + M_QB); const bf16* KB = (const bf16*)(ws + M_KB); const bf16* VT = (const bf16*)(ws + M_VT);
    bf16* Y = (bf16*)(ws + OFF_XMY);
    const int nunits = (l == 0) ? 264 : 256;
    for (int u = bid; u < nunits; u += G) {
        if (u < 256) attn_unit(lds, QB, KB, VT, Y, u >> 7, (u >> 5) & 3, (u & 31) * 256, 0, 132, tid);
        else attn_unit(lds, QB, KB, VT, Y, (u - 256) >> 2, (u - 256) & 3, TLEN, TLEN, 4, tid);
    }
    if (bid >= G - 4) lru_prefix(bid - (G - 4), tid);
}

__device__ __forceinline__ void phase_m3(const Args& a, int l, unsigned char* lds, int G, int bid, int tid) {
    unsigned char* ws = karg_ws();
    const bf16* U = (const bf16*)(ws + OFF_HU);
    const int lane = tid & 63, ch = tid & 255, part = tid >> 8;
    const float* mup = IN(23) + l * 1024; const float* mun = IN(24) + l * 1024;
    bf16* RR = (bf16*)(ws + M_RR); bf16* KKo = (bf16*)(ws + M_KK); bf16* VV = (bf16*)(ws + M_VV); bf16* GC = (bf16*)(ws + M_GC);
    float* kl = (float*)lds;
    float* kkn = (float*)(lds + 32768);
    bf16* twb = (bf16*)(lds + 65536);
    bf16* tab = (bf16*)(lds + 70144);
    bf16* tgb = (bf16*)(lds + 74752);
    for (int pass = 0; pass < 2; ++pass)
    for (int tile = (pass == 0 ? bid : (bid < 48 ? 512 + bid / 3 : NTILE)); tile < (pass == 0 ? 512 : NTILE); tile += (pass == 0 ? G : NTILE)) {
        const int mask = pass == 0 ? 7 : ((1 << (bid % 3)) & (l == 1 ? 6 : 7));
        const TileInfo ti = tile_info(tile);
        const int row0 = tile * 32;
        if (mask & 1) lru_rescan(a, l, lds, tile, ltid());
        if (mask & 6) {
        {
            const int tid2 = ltid(); const int chunk = tid2 & 127, tg8 = tid2 >> 7, c0 = chunk * 8;
            const bf16* ub = U + (size_t)row0 * UC + 1024 + c0;
            v4u rw[10];
#pragma unroll
            for (int q = 0; q < 10; ++q) { const int tl = tg8 * 8 + q - 1; const int t = ti.t0 + tl;
                rw[q] = (t >= 0 && t < ti.seqlen) ? *(const v4u*)(ub + (ptrdiff_t)tl * UC) : (v4u){0u, 0u, 0u, 0u}; }
            const f32x4 mp0 = *(const f32x4*)(mup + c0), mp1 = *(const f32x4*)(mup + c0 + 4), mn0 = *(const f32x4*)(mun + c0), mn1 = *(const f32x4*)(mun + c0 + 4);
            const float mp[8] = {mp0[0], mp0[1], mp0[2], mp0[3], mp1[0], mp1[1], mp1[2], mp1[3]}, mn[8] = {mn0[0], mn0[1], mn0[2], mn0[3], mn1[0], mn1[1], mn1[2], mn1[3]};
#pragma unroll
            for (int q = 0; q < 8; ++q) { const int tl = tg8 * 8 + q; float ts[8];
#pragma unroll
                for (int e = 0; e < 8; ++e) { const unsigned wm = rw[q][e >> 1], w0 = rw[q + 1][e >> 1], wn = rw[q + 2][e >> 1];
                    const float um = (e & 1) ? __uint_as_float(wm & 0xffff0000u) : __uint_as_float(wm << 16);
                    const float u0 = (e & 1) ? __uint_as_float(w0 & 0xffff0000u) : __uint_as_float(w0 << 16);
                    const float un = (e & 1) ? __uint_as_float(wn & 0xffff0000u) : __uint_as_float(wn << 16);
                    ts[e] = u0 + mp[e] * (um - u0) + mn[e] * (un - u0); }
                if (chunk >= 32 && chunk < 64) { float* kp = kl + tl * 256 + (c0 - 256); *(f32x4*)kp = (f32x4){ts[0], ts[1], ts[2], ts[3]}; *(f32x4*)(kp + 4) = (f32x4){ts[4], ts[5], ts[6], ts[7]}; }
                else {
                    if (chunk >= 96 && chunk < 104) {
#pragma unroll
                        for (int e = 0; e < 8; ++e) ts[e] = tanhf_(ts[e]); }
                    if (chunk >= 112) {
#pragma unroll
                        for (int e = 0; e < 8; ++e) ts[e] = sigm(ts[e]); }
                    v4u o; o.x = pk2(ts[0], ts[1]); o.y = pk2(ts[2], ts[3]); o.z = pk2(ts[4], ts[5]); o.w = pk2(ts[6], ts[7]);
                    if (chunk < 32) *(v4u*)(RR + (size_t)(row0 + tl) * 256 + c0) = o;
                    else if (chunk < 96) *(v4u*)(VV + (size_t)(row0 + tl) * 256 + (c0 - 512)) = o;
                    else if (chunk < 104) *(v4u*)(twb + tl * 72 + (c0 - 768)) = o;
                    else if (chunk < 112) *(v4u*)(tab + tl * 72 + (c0 - 832)) = o;
                    else *(v4u*)(tgb + tl * 136 + (c0 - 896)) = o; }
            }
        }
        __syncthreads();
        {
            const int tid2 = ltid(); const int ch = tid2 & 255, pt = tid2 >> 8; const float kkc = IN(30)[l * 256 + ch];
#pragma unroll 4
            for (int q = 0; q < 16; ++q) { const int t = pt * 16 + q; const float kr = kl[t * 256 + ch] * kkc; const float nrm = wave_sum(kr * kr);
                const float kk = kr * rsqrtf(fmaxf(nrm, 1e-24f)); kkn[t * 256 + ch] = kk; KKo[(size_t)(row0 + t) * 256 + ch] = (bf16)f2bf(kk); }
        }
        __syncthreads();
        {
            const int tid2 = ltid(); const int ln = tid2 & 63, wv = __builtin_amdgcn_readfirstlane(tid2 >> 6), fr = ln & 15, fq = ln >> 4;
            const bf16* WUPt = (const bf16*)(ws + W_WUP); const bf16* AUPt = (const bf16*)(ws + W_AUP); const bf16* GUPt = (const bf16*)(ws + W_GUP);
            bf16x8 aw[2][2], aa[2][2];
#pragma unroll
            for (int mt = 0; mt < 2; ++mt)
#pragma unroll
                for (int ks = 0; ks < 2; ++ks) { aw[mt][ks] = *(const bf16x8*)(twb + (mt * 16 + fr) * 72 + ks * 32 + fq * 8); aa[mt][ks] = *(const bf16x8*)(tab + (mt * 16 + fr) * 72 + ks * 32 + fq * 8); }
#pragma unroll 1
            for (int dn = 0; dn < 4; ++dn) { const int d = dn >> 1, nt = wv * 2 + (dn & 1), ch = nt * 16 + fr;
                if (!((mask >> (1 + d)) & 1)) continue;
                f32x4 cw[2], ca[2];
#pragma unroll
                for (int mt = 0; mt < 2; ++mt) { cw[mt] = (f32x4){0.f, 0.f, 0.f, 0.f}; ca[mt] = cw[mt]; }
#pragma unroll
                for (int ks = 0; ks < 2; ++ks) { const bf16x8 bw = *(const bf16x8*)(WUPt + ((size_t)d * 256 + ch) * 64 + ks * 32 + fq * 8), ba = *(const bf16x8*)(AUPt + ((size_t)d * 256 + ch) * 64 + ks * 32 + fq * 8);
#pragma unroll
                    for (int mt = 0; mt < 2; ++mt) { cw[mt] = __builtin_amdgcn_mfma_f32_16x16x32_bf16(aw[mt][ks], bw, cw[mt], 0, 0, 0); ca[mt] = __builtin_amdgcn_mfma_f32_16x16x32_bf16(aa[mt][ks], ba, ca[mt], 0, 0, 0); } }
                const float w0 = IN(25)[(l * 2 + d) * 256 + ch], a0 = IN(27)[(l * 2 + d) * 256 + ch], kac = IN(31)[l * 256 + ch];
                float* WW = (float*)(ws + M_WW) + (size_t)d * NR * 256; bf16* BB = (bf16*)(ws + M_BB + (size_t)d * A8); bf16* KD = (bf16*)(ws + M_KD + (size_t)d * A8);
#pragma unroll
                for (int mt = 0; mt < 2; ++mt)
#pragma unroll
                    for (int j = 0; j < 4; ++j) { const int t = mt * 16 + fq * 4 + j; const size_t o = (size_t)(row0 + t) * 256 + ch;
                        const float e = sigm(w0 + cw[mt][j]) * 0.6065306597126334f;
                        const float av = sigm(a0 + ca[mt][j]);
                        WW[o] = __expf(-e);
                        KD[o] = (bf16)f2bf(kl[t * 256 + ch] * (1.f + (av - 1.f) * kac));
                        BB[o] = (bf16)f2bf(kkn[t * 256 + ch] * av); }
            }
#pragma unroll 1
            for (int nl = 0; nl < 2; ++nl) { const int ch = (wv * 2 + nl) * 16 + fr;
                if (!(mask & 4)) continue;
                f32x4 cg[2] = {(f32x4){0.f, 0.f, 0.f, 0.f}, (f32x4){0.f, 0.f, 0.f, 0.f}};
#pragma unroll
                for (int ks = 0; ks < 4; ++ks) { const bf16x8 bg = *(const bf16x8*)(GUPt + (size_t)ch * 128 + ks * 32 + fq * 8);
#pragma unroll
                    for (int mt = 0; mt < 2; ++mt) { const bf16x8 ag = *(const bf16x8*)(tgb + (mt * 16 + fr) * 136 + ks * 32 + fq * 8); cg[mt] = __builtin_amdgcn_mfma_f32_16x16x32_bf16(ag, bg, cg[mt], 0, 0, 0); } }
#pragma unroll
                for (int mt = 0; mt < 2; ++mt)
#pragma unroll
                    for (int j = 0; j < 4; ++j) GC[(size_t)(row0 + mt * 16 + fq * 4 + j) * 256 + ch] = (bf16)f2bf(cg[mt][j]);
            }
        }
        __syncthreads();
        }
    }
}

typedef const unsigned cu32;
typedef const float cf32;
__device__ __forceinline__ int chain_row(int b, int d, int tau) {
    return tau < CTXL ? (NLAT + b * CTXL + (d ? CTXL - 1 - tau : tau)) : (b * TLEN + (d ? TLEN - 1 - (tau - CTXL) : (tau - CTXL)));
}
template <int MODE>
__device__ __forceinline__ void rwkv_steps(float (&S)[64], int b, int h, int d, int tau0, int n, unsigned char* ws, int lane, float* wl) {
    const bf16* KKp = (const bf16*)(ws + M_KK); const bf16* RRp = (const bf16*)(ws + M_RR); const bf16* VVp = (const bf16*)(ws + M_VV);
    const float* WWp = (const float*)(ws + M_WW) + (size_t)d * NR * 256; const bf16* BBp = (const bf16*)(ws + M_BB + (size_t)d * A8); const bf16* KDp = (const bf16*)(ws + M_KD + (size_t)d * A8);
    float* YS = (float*)(ws + M_YS) + (size_t)d * NR * 256;
    float pk, pw, pb, pkd = 0.f, pr = 0.f, pv = 0.f; size_t poff;
#define RWKV_LOAD(s_) do { poff = (size_t)chain_row(b, d, tau0 + (s_)) * 256 + h * 64 + lane; pk = bf2f(KKp[poff]); pw = WWp[poff]; pb = bf2f(BBp[poff]); \
        if (MODE != 1) { pkd = bf2f(KDp[poff]); pv = bf2f(VVp[poff]); } if (MODE == 2) pr = bf2f(RRp[poff]); } while (0)
    RWKV_LOAD(0);
    for (int s = 0; s < n; ++s) {
        float* buf = wl + (s & 1) * 320;
        buf[lane] = pk; buf[64 + lane] = pw; buf[128 + lane] = pb;
        if (MODE != 1) buf[192 + lane] = pkd;
        if (MODE == 2) buf[256 + lane] = pr;
        const float vv = pv; const size_t yoff = poff;
        if (s + 1 < n) RWKV_LOAD(s + 1);
        float sa0 = 0.f, sa1 = 0.f, sa2 = 0.f, sa3 = 0.f;
#pragma unroll
        for (int i = 0; i < 64; i += 4) { const f32x4 k4 = *(const f32x4*)(buf + i);
            sa0 += S[i] * k4[0]; sa1 += S[i + 1] * k4[1]; sa2 += S[i + 2] * k4[2]; sa3 += S[i + 3] * k4[3]; }
        const float nsa = -((sa0 + sa1) + (sa2 + sa3));
        float y0 = 0.f, y1 = 0.f, y2 = 0.f, y3 = 0.f;
#pragma unroll
        for (int i = 0; i < 64; i += 4) { const f32x4 w4 = *(const f32x4*)(buf + 64 + i), b4 = *(const f32x4*)(buf + 128 + i);
            f32x4 t = nsa * b4;
            if (MODE != 1) { const f32x4 kd4 = *(const f32x4*)(buf + 192 + i); t += vv * kd4; }
            S[i] = S[i] * w4[0] + t[0]; S[i + 1] = S[i + 1] * w4[1] + t[1]; S[i + 2] = S[i + 2] * w4[2] + t[2]; S[i + 3] = S[i + 3] * w4[3] + t[3];
            if (MODE == 2) { const f32x4 r4 = *(const f32x4*)(buf + 256 + i); y0 += S[i] * r4[0]; y1 += S[i + 1] * r4[1]; y2 += S[i + 2] * r4[2]; y3 += S[i + 3] * r4[3]; } }
        if (MODE == 2) YS[yoff] = (y0 + y1) + (y2 + y3);
    }
#undef RWKV_LOAD
}
typedef float f32x2 __attribute__((ext_vector_type(2)));
__device__ __forceinline__ void rwkv_pass1(f32x2 (&SL)[32], f32x2 (&SI)[32], int b, int h, int d, int tau0, int n, unsigned char* ws, int lane, float* wl) {
    const bf16* KKp = (const bf16*)(ws + M_KK); const bf16* VVp = (const bf16*)(ws + M_VV); const bf16* RRp = (const bf16*)(ws + M_RR);
    const float* WWp = (const float*)(ws + M_WW) + (size_t)d * NR * 256; const bf16* BBp = (const bf16*)(ws + M_BB + (size_t)d * A8); const bf16* KDp = (const bf16*)(ws + M_KD + (size_t)d * A8);
    float* YS = (float*)(ws + M_YS) + (size_t)d * NR * 256; float* PR = (float*)(ws + M_PR) + (size_t)d * NR * 256;
    float pk, pw, pb, pkd, pv, pr; size_t poff;
#define RWKV_LOAD(s_) do { poff = (size_t)chain_row(b, d, tau0 + (s_)) * 256 + h * 64 + lane; pk = bf2f(KKp[poff]); pw = WWp[poff]; pb = bf2f(BBp[poff]); pkd = bf2f(KDp[poff]); pv = bf2f(VVp[poff]); pr = bf2f(RRp[poff]); } while (0)
    RWKV_LOAD(0);
    for (int s = 0; s < n; ++s) {
        float* buf = wl + (s & 1) * 320;
        buf[lane] = pk; buf[64 + lane] = pw; buf[128 + lane] = pb; buf[192 + lane] = pkd; buf[256 + lane] = pr;
        const float vv = pv; const size_t yoff = poff;
        if (s + 1 < n) RWKV_LOAD(s + 1);
        f32x2 aL0 = {0.f, 0.f}, aL1 = aL0, aI0 = aL0, aI1 = aL0;
#pragma unroll
        for (int q = 0; q < 16; ++q) { const f32x4 k4 = *(const f32x4*)(buf + 4 * q);
            aL0 += SL[2 * q] * k4.lo; aL1 += SL[2 * q + 1] * k4.hi; aI0 += SI[2 * q] * k4.lo; aI1 += SI[2 * q + 1] * k4.hi; }
        const f32x2 tL = aL0 + aL1, tI = aI0 + aI1;
        const float nsl = -(tL.x + tL.y), nsi = -(tI.x + tI.y);
        f32x2 yL0 = {0.f, 0.f}, yL1 = yL0, yI0 = yL0, yI1 = yL0;
#pragma unroll
        for (int q = 0; q < 16; ++q) {
            const f32x4 w4 = *(const f32x4*)(buf + 64 + 4 * q), b4 = *(const f32x4*)(buf + 128 + 4 * q), kd4 = *(const f32x4*)(buf + 192 + 4 * q), r4 = *(const f32x4*)(buf + 256 + 4 * q);
            const f32x4 tl = nsl * b4 + vv * kd4, tiv = nsi * b4;
            SL[2 * q] = SL[2 * q] * w4.lo + tl.lo; SL[2 * q + 1] = SL[2 * q + 1] * w4.hi + tl.hi;
            SI[2 * q] = SI[2 * q] * w4.lo + tiv.lo; SI[2 * q + 1] = SI[2 * q + 1] * w4.hi + tiv.hi;
            yL0 += SL[2 * q] * r4.lo; yL1 += SL[2 * q + 1] * r4.hi; yI0 += SI[2 * q] * r4.lo; yI1 += SI[2 * q + 1] * r4.hi; }
        const f32x2 yl = yL0 + yL1, yp = yI0 + yI1;
        YS[yoff] = yl.x + yl.y; PR[yoff] = yp.x + yp.y;
    }
#undef RWKV_LOAD
}
__device__ __forceinline__ void phase_m4(const Args& a, unsigned char* lds, int G, int bid, int tid) {
    const int lane = tid & 63, wave = __builtin_amdgcn_readfirstlane(tid >> 6), half = wave >> 2, tk = wave & 3;
    unsigned char* ws = karg_ws(); float* PL = (float*)(ws + M_PL);
    float* wl = (float*)lds + wave * 320;
    float* xch = (float*)lds + 8 * 320 + tk * 1024;
    float* ych = xch + 512;
    const bf16* KKp = (const bf16*)(ws + M_KK); const bf16* VVp = (const bf16*)(ws + M_VV); const bf16* RRp = (const bf16*)(ws + M_RR);
    for (int task0 = bid * 4; task0 < 16 * NSEG; task0 += G * 4) {
        const int task = task0 + tk; const int seg = task & (NSEG - 1), chain = task >> 6;
        const int d = chain & 1, h = (chain >> 1) & 3, b = chain >> 3;
        const float* WWp = (const float*)(ws + M_WW) + (size_t)d * NR * 256; const bf16* BBp = (const bf16*)(ws + M_BB + (size_t)d * A8); const bf16* KDp = (const bf16*)(ws + M_KD + (size_t)d * A8);
        float* YS = (float*)(ws + M_YS) + (size_t)d * NR * 256; float* PR = (float*)(ws + M_PR) + (size_t)d * NR * 256;
        f32x2 SL[16], SI[16]; int ln = lane; asm volatile("" : "+v"(ln));
#pragma unroll
        for (int i = 0; i < 16; ++i) { SL[i] = (f32x2){0.f, 0.f}; SI[i] = (f32x2){(32 * half + 2 * i == ln) ? 1.f : 0.f, (32 * half + 2 * i + 1 == ln) ? 1.f : 0.f}; }
        const int tau0 = seg * SEGLEN, cidx = h * 64 + 32 * half + (lane & 31);
        unsigned pp; float pw, pv; size_t rowoff, prevoff = 0;
        const int grp = lane >> 4, l15 = lane & 15, l31 = lane & 31;
        const unsigned* srcp = grp == 0 ? (const unsigned*)KKp : grp == 1 ? (const unsigned*)BBp : grp == 2 ? (const unsigned*)KDp : (const unsigned*)RRp;
#define M4_LOAD(s_) do { rowoff = (size_t)chain_row(b, d, tau0 + (s_)) * 256; pp = srcp[(rowoff + h * 64 + 32 * half) / 2 + l15]; \
            pw = (lane < 32) ? WWp[rowoff + cidx] : 0.f; pv = bf2f(VVp[rowoff + h * 64 + lane]); } while (0)
#define UNPK(u_) ((f32x2){__uint_as_float((u_) << 16), __uint_as_float((u_) & 0xffff0000u)})
        M4_LOAD(0);
        for (int s = 0; s < SEGLEN; ++s) {
            float* buf = wl + (s & 1) * 160; const unsigned* bufu = (const unsigned*)buf;
            ((unsigned*)buf)[lane] = pp; if (lane < 32) buf[64 + l31] = pw;
            const float vv = pv; const size_t yoff = rowoff + h * 64 + lane;
            if (s + 1 < SEGLEN) M4_LOAD(s + 1);
            f32x2 aL0 = {0.f, 0.f}, aL1 = aL0, aI0 = aL0, aI1 = aL0;
#pragma unroll
            for (int q = 0; q < 4; ++q) { const v4u k4 = *(const v4u*)(bufu + 4 * q);
                const f32x2 ka = UNPK(k4.x), kb = UNPK(k4.y), kc = UNPK(k4.z), kd_ = UNPK(k4.w);
                aL0 += SL[4 * q] * ka; aL1 += SL[4 * q + 1] * kb; aL0 += SL[4 * q + 2] * kc; aL1 += SL[4 * q + 3] * kd_;
                aI0 += SI[4 * q] * ka; aI1 += SI[4 * q + 1] * kb; aI0 += SI[4 * q + 2] * kc; aI1 += SI[4 * q + 3] * kd_; }
            const f32x2 tL = aL0 + aL1, tI = aI0 + aI1;
            float* xw = xch + (s & 1) * 256;
            xw[half * 128 + lane] = tL.x + tL.y; xw[half * 128 + 64 + lane] = tI.x + tI.y;
            __syncthreads();
            const float nsl = -(xw[lane] + xw[128 + lane]), nsi = -(xw[64 + lane] + xw[192 + lane]);
            if (s > 0) {
                const float* yr = ych + ((s - 1) & 1) * 256;
                if (half == 0) YS[prevoff] = yr[lane] + yr[128 + lane]; else PR[prevoff] = yr[64 + lane] + yr[192 + lane];
            }
            f32x2 yL0 = {0.f, 0.f}, yL1 = yL0, yI0 = yL0, yI1 = yL0;
#pragma unroll
            for (int q = 0; q < 4; ++q) {
                const f32x4 wa = *(const f32x4*)(buf + 64 + 8 * q), wb = *(const f32x4*)(buf + 68 + 8 * q);
                const v4u b4 = *(const v4u*)(bufu + 16 + 4 * q), d4 = *(const v4u*)(bufu + 32 + 4 * q), r4 = *(const v4u*)(bufu + 48 + 4 * q);
                const f32x2 w2[4] = {wa.lo, wa.hi, wb.lo, wb.hi};
                const unsigned bu[4] = {b4.x, b4.y, b4.z, b4.w}, du[4] = {d4.x, d4.y, d4.z, d4.w}, ru[4] = {r4.x, r4.y, r4.z, r4.w};
#pragma unroll
                for (int e = 0; e < 4; ++e) { const int j = 4 * q + e; const f32x2 b2 = UNPK(bu[e]), k2 = UNPK(du[e]), r2 = UNPK(ru[e]);
                    const f32x2 tl = nsl * b2 + vv * k2, tiv = nsi * b2;
                    SL[j] = SL[j] * w2[e] + tl; SI[j] = SI[j] * w2[e] + tiv;
                    if (e & 1) { yL1 += SL[j] * r2; yI1 += SI[j] * r2; } else { yL0 += SL[j] * r2; yI0 += SI[j] * r2; } }
            }
            const f32x2 yl = yL0 + yL1, yp = yI0 + yI1;
            float* yw = ych + (s & 1) * 256;
            yw[half * 128 + lane] = yl.x + yl.y; yw[half * 128 + 64 + lane] = yp.x + yp.y;
            prevoff = yoff;
        }
#undef M4_LOAD
#undef UNPK
        __syncthreads();
        { const float* yr = ych + ((SEGLEN - 1) & 1) * 256;
          if (half == 0) YS[prevoff] = yr[lane] + yr[128 + lane]; else PR[prevoff] = yr[64 + lane] + yr[192 + lane]; }
        float* o = PL + (((size_t)(chain * NSEG + seg) * 2) * 64 + lane) * 64 + 32 * half;
#pragma unroll
        for (int i = 0; i < 16; i += 2) { *(f32x4*)(o + 2 * i) = (f32x4){SL[i].x, SL[i].y, SL[i + 1].x, SL[i + 1].y}; *(f32x4*)(o + 4096 + 2 * i) = (f32x4){SI[i].x, SI[i].y, SI[i + 1].x, SI[i + 1].y}; }
        __syncthreads();
    }
}
__device__ __forceinline__ void phase_m5(const Args& a, unsigned char* lds, int G, int bid, int tid) {
    unsigned char* ws = karg_ws(); const float* PL = (const float*)(ws + M_PL); float* SI = (float*)(ws + M_SINIT);
    float* Sx = (float*)lds;
    const int lane = tid & 63, wv = __builtin_amdgcn_readfirstlane(tid >> 6), fr = lane & 15, fq = lane >> 4;
    const bool act = wv < 4;
    for (int u = bid; u < 64; u += G) {
        const int chain = u >> 2, row0 = (u & 3) * 16, col = (wv & 3) * 16 + fr;
        const float* Pg = PL + ((size_t)(chain * NSEG) * 2 + 1) * 4096; const float* Lg = PL + ((size_t)(chain * NSEG) * 2) * 4096;
        float* SIc = SI + (size_t)(chain * NSEG) * 4096;
        f32x4 cur = {0.f, 0.f, 0.f, 0.f}; f32x4 lv[3]; float pb[3][16];
#pragma unroll
        for (int q = 0; q < 3; ++q) { lv[q] = cur;
            if (act) { const float* Pn = Pg + (size_t)q * 8192; const float* Ln = Lg + (size_t)q * 8192;
#pragma unroll
                for (int ks = 0; ks < 16; ++ks) pb[q][ks] = Pn[(4 * ks + fq) * 64 + col];
#pragma unroll
                for (int j = 0; j < 4; ++j) lv[q][j] = Ln[(row0 + fq * 4 + j) * 64 + col]; } }
        for (int g0 = 0; g0 < NSEG - 1; g0 += 3) {
#pragma unroll
            for (int q = 0; q < 3; ++q) { const int g = g0 + q;
                if (act) {
#pragma unroll
                    for (int j = 0; j < 4; ++j) { SIc[(size_t)g * 4096 + (row0 + fq * 4 + j) * 64 + col] = cur[j]; Sx[(fq * 4 + j) * 68 + col] = cur[j]; }
                }
                __syncthreads();
                if (act) {
                    f32x4 acc = lv[q];
#pragma unroll
                    for (int ks = 0; ks < 16; ++ks) { const float av = Sx[fr * 68 + 4 * ks + fq]; acc = __builtin_amdgcn_mfma_f32_16x16x4f32(av, pb[q][ks], acc, 0, 0, 0); }
                    cur = acc;
                    if (g + 3 < NSEG - 1) { const float* Pn = Pg + (size_t)(g + 3) * 8192; const float* Ln = Lg + (size_t)(g + 3) * 8192;
#pragma unroll
                        for (int ks = 0; ks < 16; ++ks) pb[q][ks] = Pn[(4 * ks + fq) * 64 + col];
#pragma unroll
                        for (int j = 0; j < 4; ++j) lv[q][j] = Ln[(row0 + fq * 4 + j) * 64 + col]; }
                }
                __syncthreads();
            }
        }
        if (act) {
#pragma unroll
            for (int j = 0; j < 4; ++j) SIc[(size_t)(NSEG - 1) * 4096 + (row0 + fq * 4 + j) * 64 + col] = cur[j];
        }
    }
}
__device__ __forceinline__ void phase_m6(const Args& a, unsigned char* lds, int G, int bid, int tid) {
    const int lane = tid & 63, wave = __builtin_amdgcn_readfirstlane(tid >> 6);
    unsigned char* ws = karg_ws(); const float* SI = (const float*)(ws + M_SINIT);
    float* wl = (float*)lds + wave * 256;
    for (int task = bid * 8 + wave; task < 16 * (NSEG - 1); task += G * 8) {
        const int seg = 1 + task % (NSEG - 1), chain = task / (NSEG - 1);
        const int d = chain & 1, h = (chain >> 1) & 3, b = chain >> 3;
        float* YS = (float*)(ws + M_YS) + (size_t)d * NR * 256; const float* PR = (const float*)(ws + M_PR) + (size_t)d * NR * 256;
        f32x2 S0[32];
        const float* si = SI + ((size_t)(chain * NSEG + seg) * 64 + lane) * 64;
#pragma unroll
        for (int i = 0; i < 32; i += 2) { const f32x4 v = *(const f32x4*)(si + 2 * i); S0[i] = v.lo; S0[i + 1] = v.hi; }
        const int tau0 = seg * SEGLEN;
        size_t o[4]; float p[4], y[4];
#pragma unroll
        for (int k = 0; k < 4; ++k) { o[k] = (size_t)chain_row(b, d, tau0 + k) * 256 + h * 64 + lane; p[k] = PR[o[k]]; y[k] = YS[o[k]]; }
        for (int s = 0; s < SEGLEN; s += 4) {
            size_t c[4]; float yy[4];
#pragma unroll
            for (int k = 0; k < 4; ++k) { wl[k * 64 + lane] = p[k]; c[k] = o[k]; yy[k] = y[k]; }
            if (s + 4 < SEGLEN) {
#pragma unroll
                for (int k = 0; k < 4; ++k) { o[k] = (size_t)chain_row(b, d, tau0 + s + 4 + k) * 256 + h * 64 + lane; p[k] = PR[o[k]]; y[k] = YS[o[k]]; } }
#pragma unroll
            for (int k = 0; k < 4; k += 2) {
                f32x2 a0 = {0.f, 0.f}, a1 = a0, b0 = a0, b1 = a0;
#pragma unroll
                for (int q = 0; q < 16; ++q) { const f32x4 u = *(const f32x4*)(wl + k * 64 + 4 * q), w = *(const f32x4*)(wl + (k + 1) * 64 + 4 * q);
                    a0 += S0[2 * q] * u.lo; a1 += S0[2 * q + 1] * u.hi; b0 += S0[2 * q] * w.lo; b1 += S0[2 * q + 1] * w.hi; }
                const f32x2 ta = a0 + a1, tb = b0 + b1;
                yy[k] += ta.x + ta.y; yy[k + 1] += tb.x + tb.y;
            }
#pragma unroll
            for (int k = 0; k < 4; ++k) YS[c[k]] = yy[k];
            asm volatile("" ::: "memory");
        }
    }
}
__device__ __forceinline__ void phase_m7(const Args& a, int l, int gw, int NGW, int lane) {
    unsigned char* ws = karg_ws();
    const float* Y0 = (const float*)(ws + M_YS); const float* Y1 = Y0 + (size_t)NR * 256;
    const bf16* RR = (const bf16*)(ws + M_RR); const bf16* VV = (const bf16*)(ws + M_VV); const bf16* KD0 = (const bf16*)(ws + M_KD); const bf16* KD1 = (const bf16*)(ws + M_KD + A8);
    const bf16* GC = (const bf16*)(ws + M_GC); bf16* Y = (bf16*)(ws + OFF_XMY);
    for (int r = gw; r < NR; r += NGW) {
#pragma unroll
        for (int h = 0; h < 4; ++h) { const int c = h * 64 + lane; const size_t o = (size_t)r * 256 + c;
            const float ys = Y0[o] + Y1[o];
            const float mu = wave_sum(ys) * (1.f / 64.f); const float dv = ys - mu; const float var = wave_sum(dv * dv) * (1.f / 64.f);
            float ov = dv * rsqrtf(var + 64e-5f) * IN(33)[l * 256 + c] + IN(34)[l * 256 + c];
            const float rv = bf2f(RR[o]), rk = IN(32)[l * 256 + c], vv = bf2f(VV[o]);
            const float b0 = wave_sum(rv * bf2f(KD0[o]) * rk), b1 = wave_sum(rv * bf2f(KD1[o]) * rk);
            ov += (b0 + b1) * vv;
            Y[(size_t)r * DM + 512 + c] = (bf16)f2bf(ov * bf2f(GC[o])); }
    }
}

#define LAS __attribute__((address_space(3)))
#define XB_TMO      128
#define XB_XCNT(j)  (256  + 64 * (j))
#define XB_XSUB(j)  (1280 + 64 * (j))
#define XB_XGEN(j)  (2304 + 64 * (j))
#define XB_TOP      3328
#define XB_TOPGEN   3392
#define XCD_BAR_WORDS 3456
#define XB_SPIN_CAP (1u << 18)

__device__ __forceinline__ unsigned xb_ld(unsigned* p)              { return __hip_atomic_load(p, __ATOMIC_RELAXED, __HIP_MEMORY_SCOPE_AGENT); }
__device__ __forceinline__ unsigned xb_add(unsigned* p, unsigned v) { return __hip_atomic_fetch_add(p, v, __ATOMIC_RELAXED, __HIP_MEMORY_SCOPE_AGENT); }
__device__ __forceinline__ unsigned xb_xcc_id() { return (unsigned)__builtin_amdgcn_s_getreg((3 << 11) | 20) & 0xFu; }
#define XB_SPIN(cond, bar) do { unsigned _sp = 0; while (cond) { __builtin_amdgcn_s_sleep(1); \
    if ((++_sp & 255u) == 0u) { if (xb_ld(&(bar)[XB_TMO])) break; if (_sp > XB_SPIN_CAP) { atomicAdd(&(bar)[XB_TMO], 1u); break; } } } } while (0)

struct XcdBarrier {
    unsigned* bar; unsigned x;
    volatile LAS unsigned* st;
};

__device__ __forceinline__ XcdBarrier xcd_barrier_post(unsigned* bar, volatile LAS unsigned* st) {
    XcdBarrier b; b.bar = bar; b.x = xb_xcc_id(); b.st = st;
    if (threadIdx.x == 0) (void)xb_add(&bar[XB_XCNT(b.x)], 1u);
    return b;
}
__device__ __forceinline__ void xcd_barrier_complete(unsigned* bar, unsigned x, unsigned& nloc, unsigned& nx) {
    const unsigned G = gridDim.x * gridDim.y * gridDim.z;
    unsigned sum, cnt, mine, sp = 0u;
    for (;;) {
        sum = 0u; cnt = 0u; mine = 0u;
#pragma unroll
        for (unsigned j = 0; j < 16; ++j) { const unsigned c = xb_ld(&bar[XB_XCNT(j)]); sum += c; cnt += (c > 0u) ? 1u : 0u; mine = (j == x) ? c : mine; }
        if (sum == G) break;
        __builtin_amdgcn_s_sleep(1);
        if ((++sp & 255u) == 0u) { if (xb_ld(&bar[XB_TMO])) break; if (sp > XB_SPIN_CAP) { atomicAdd(&bar[XB_TMO], 1u); break; } }
    }
    nloc = mine > 0u ? mine : 1u; nx = cnt > 0u ? cnt : 1u;
}

__device__ __forceinline__ void xcd_barrier(const XcdBarrier& b) {
    asm volatile("s_waitcnt vmcnt(0)" ::: "memory");
    __syncthreads();
    if (threadIdx.x == 0) {
        unsigned* bar = b.bar;
        __builtin_amdgcn_s_waitcnt(0);
        unsigned nloc = b.st[0], nx = b.st[1];
        if (nloc == 0u) { xcd_barrier_complete(bar, b.x, nloc, nx); b.st[0] = nloc; b.st[1] = nx; }
        const unsigned old = xb_add(&bar[XB_XSUB(b.x)], 1u);
        const unsigned gen = old / nloc;
        if (old + 1u == (gen + 1u) * nloc) {
            __builtin_amdgcn_fence(__ATOMIC_RELEASE, "agent");
            asm volatile("s_waitcnt vmcnt(0)" ::: "memory");
            const unsigned og = xb_add(&bar[XB_TOP], 1u);
            const unsigned tg = og / nx;
            if (og + 1u == (tg + 1u) * nx) xb_add(&bar[XB_TOPGEN], 1u);
            else XB_SPIN(xb_ld(&bar[XB_TOPGEN]) == tg, bar);
            __builtin_amdgcn_fence(__ATOMIC_ACQUIRE, "agent");
            xb_add(&bar[XB_XGEN(b.x)], 1u);
            asm volatile("s_waitcnt vmcnt(0)" ::: "memory");
        } else {
            XB_SPIN(xb_ld(&bar[XB_XGEN(b.x)]) == gen, bar);
            __builtin_amdgcn_fence(__ATOMIC_ACQUIRE, "agent");
            asm volatile("s_waitcnt vmcnt(0)" ::: "memory");
        }
    }
    __syncthreads();
}

__global__ void __launch_bounds__(512, 2) mega(Args a) {
    extern __shared__ __attribute__((aligned(16))) unsigned char lds[];
    cg::grid_group grid = cg::this_grid();
    const int G = gridDim.x;
    PG8_LAS unsigned char* glds = (PG8_LAS unsigned char*)lds;
#define bid lbid()
#define tid ltid()
#define lane (ltid() & 63)
#define wave (__builtin_amdgcn_readfirstlane(ltid() >> 6))
#define gw (lbid() * 8 + __builtin_amdgcn_readfirstlane(ltid() >> 6))
#define NGW (G * 8)
    { volatile LAS unsigned* st0 = (volatile LAS unsigned*)((LAS unsigned char*)lds + 131072); if (threadIdx.x < 4) st0[threadIdx.x] = 0u; }
    __syncthreads();
    const XcdBarrier xbar = xcd_barrier_post((unsigned*)(karg_ws() + 229376), (volatile LAS unsigned*)((LAS unsigned char*)lds + 131072));
#define GSYNC() do { xcd_barrier(xbar); } while (0)

    phase_modgemv(a, (float*)lds, G, bid, tid);
    convert_weights(a, 0, (float*)(lds + 32768) + wave * (64 * 33), gw, NGW, lane, G, bid, tid);
    grid.sync();
#pragma clang loop unroll(full)
    for (int l = 0; l < 2; ++l) {
        if (l > 0) convert_weights(a, l, (float*)lds + wave * (64 * 33), gw, NGW, lane, G, bid, tid);
        phase_modulate(a, l, 0, gw, NGW, lane);
        GSYNC();
        for (int rp = 0; rp < REP_G1; ++rp)
        {
            unsigned char* ws = karg_ws(); float* outp = karg_out(); float* xctx = (float*)(ws + OFF_XCTX); bf16* XM = (bf16*)(ws + OFF_XMY); bf16* HU = (bf16*)(ws + OFF_HU); const float* modl = (const float*)(ws + OFF_MOD) + (size_t)l * 3 * 9216; (void)xctx; (void)XM; (void)HU; (void)modl; (void)outp;
            pg8::Gemm g{XM, (const bf16*)(ws + W_13A), NR, 2 * DFF, DM}; pg8::StaticOrder S; S.init(NR, 2 * DFF, G, bid);
            EpiSwiglu E{HU};
            pg8::gemm_phase<EpiSwiglu, pg8::StaticOrder, true, true>(glds, g, S, E);
        }
        GSYNC();
        {
            unsigned char* ws = karg_ws(); float* outp = karg_out(); float* xctx = (float*)(ws + OFF_XCTX); bf16* XM = (bf16*)(ws + OFF_XMY); bf16* HU = (bf16*)(ws + OFF_HU); const float* modl = (const float*)(ws + OFF_MOD) + (size_t)l * 3 * 9216; (void)xctx; (void)XM; (void)HU; (void)modl; (void)outp;
            pg8::Gemm g{HU, (const bf16*)(ws + W_2A), NR, DM, DFF}; pg8::StaticOrder S; S.init(NR, DM, G, bid);
            EpiResid E{outp, xctx, modl + 2 * 1024, 0.5f, l == 0 ? IN(0) : outp, l == 0 ? IN(2) : xctx};
            pg8::gemm_phase<EpiResid, pg8::StaticOrder, true, true>(glds, g, S, E);
        }
        GSYNC();
        phase_modulate(a, l, 1, gw, NGW, lane);
        GSYNC();
        {
            unsigned char* ws = karg_ws(); float* outp = karg_out(); float* xctx = (float*)(ws + OFF_XCTX); bf16* XM = (bf16*)(ws + OFF_XMY); bf16* HU = (bf16*)(ws + OFF_HU); const float* modl = (const float*)(ws + OFF_MOD) + (size_t)l * 3 * 9216; (void)xctx; (void)XM; (void)HU; (void)modl; (void)outp;
            pg8::Gemm g{XM, (const bf16*)(ws + W_IN), NR, UC, DM}; pg8::StaticOrder S; S.init(NR, UC, G, bid);
            EpiU E{HU, UC};
            pg8::gemm_phase<EpiU, pg8::StaticOrder, true, true>(glds, g, S, E);
        }
        GSYNC();
        for (int rp = 0; rp < REP_M1; ++rp) { phase_m1(a, l, lds, G, bid, tid);
        GSYNC(); }
        for (int rp = 0; rp < REP_M2; ++rp) { phase_m2(a, l, lds, G, bid, tid);
        GSYNC(); }
        for (int rp = 0; rp < REP_M3; ++rp) { phase_m3(a, l, lds, G, bid, tid);
        GSYNC(); }
        for (int rp = 0; rp < REP_SCAN; ++rp) { phase_m4(a, lds, G, bid, tid);
        GSYNC();
        phase_m5(a, lds, G, bid, tid);
        GSYNC();
        phase_m6(a, lds, G, bid, tid);
        GSYNC(); }
        phase_m7(a, l, gw, NGW, lane);
        GSYNC();
        {
            unsigned char* ws = karg_ws(); float* outp = karg_out(); float* xctx = (float*)(ws + OFF_XCTX); bf16* XM = (bf16*)(ws + OFF_XMY); bf16* HU = (bf16*)(ws + OFF_HU); const float* modl = (const float*)(ws + OFF_MOD) + (size_t)l * 3 * 9216; (void)xctx; (void)XM; (void)HU; (void)modl; (void)outp;
            const int MR = (l == 1) ? NLAT : NR;
            pg8::Gemm g{XM, (const bf16*)(ws + W_OUT), MR, DM, DM}; pg8::StaticOrder S; S.init(MR, DM, G, bid);
            EpiResid E{outp, xctx, modl + 5 * 1024, 1.0f, outp, xctx};
            pg8::gemm_phase<EpiResid, pg8::StaticOrder, true, true>(glds, g, S, E);
        }
        GSYNC();
        phase_modulate(a, l, 2, gw, NGW, lane);
        GSYNC();
        {
            unsigned char* ws = karg_ws(); float* outp = karg_out(); float* xctx = (float*)(ws + OFF_XCTX); bf16* XM = (bf16*)(ws + OFF_XMY); bf16* HU = (bf16*)(ws + OFF_HU); const float* modl = (const float*)(ws + OFF_MOD) + (size_t)l * 3 * 9216; (void)xctx; (void)XM; (void)HU; (void)modl; (void)outp;
            const int MR = (l == 1) ? NLAT : NR;
            pg8::Gemm g{XM, (const bf16*)(ws + W_13B), MR, 2 * DFF, DM}; pg8::StaticOrder S; S.init(MR, 2 * DFF, G, bid);
            EpiSwiglu E{HU};
            pg8::gemm_phase<EpiSwiglu, pg8::StaticOrder, true, true>(glds, g, S, E);
        }
        GSYNC();
        {
            unsigned char* ws = karg_ws(); float* outp = karg_out(); float* xctx = (float*)(ws + OFF_XCTX); bf16* XM = (bf16*)(ws + OFF_XMY); bf16* HU = (bf16*)(ws + OFF_HU); const float* modl = (const float*)(ws + OFF_MOD) + (size_t)l * 3 * 9216; (void)xctx; (void)XM; (void)HU; (void)modl; (void)outp;
            const int MR = (l == 1) ? NLAT : NR;
            pg8::Gemm g{HU, (const bf16*)(ws + W_2B), MR, DM, DFF}; pg8::StaticOrder S; S.init(MR, DM, G, bid);
            EpiResid E{outp, xctx, modl + 8 * 1024, 0.5f, outp, xctx};
            pg8::gemm_phase<EpiResid, pg8::StaticOrder, true, true>(glds, g, S, E);
        }
        GSYNC();
    }
    phase_final(a, gw, NGW, lane);
#undef bid
#undef tid
#undef lane
#undef wave
#undef gw
#undef NGW
}

extern "C" void kernel_launch(void* const* d_in, const int* in_sizes, int n_in, void* d_out, int out_size, void* d_ws, size_t ws_size, hipStream_t stream) {
    static int grid = 0;
    if (grid == 0) {
        int dev = 0, cus = 0, per_cu = 0;
        (void)hipGetDevice(&dev);
        (void)hipDeviceGetAttribute(&cus, hipDeviceAttributeMultiprocessorCount, dev);
        (void)hipFuncSetAttribute((const void*)mega, hipFuncAttributeMaxDynamicSharedMemorySize, LDS_BYTES);
        (void)hipOccupancyMaxActiveBlocksPerMultiprocessor(&per_cu, (const void*)mega, 512, LDS_BYTES);
        if (per_cu < 1) per_cu = 1;
        grid = cus * per_cu;
        if (n_in != 40 || ws_size < WS_NEED) { fprintf(stderr, "kernel_launch: unexpected n_in %d / ws %zu (need %zu)\n", n_in, ws_size, (size_t)WS_NEED); }
    }
    (void)hipMemsetAsync((char*)d_ws + OFF_MOD, 0, MOD_BYTES, stream);
    Args a{};
    for (int i = 0; i < 40; ++i) a.in[i] = (const float*)d_in[i];
    a.out = (float*)d_out; a.ws = (unsigned char*)d_ws;
    void* args[] = {&a};
    hipError_t e = hipLaunchCooperativeKernel((const void*)mega, dim3(grid), dim3(512), args, LDS_BYTES, stream);
    if (e != hipSuccess) fprintf(stderr, "cooperative launch failed: %s (grid %d)\n", hipGetErrorString(e), grid);
}
```

```cpp
#include <hip/hip_runtime.h>
#include <hip/hip_cooperative_groups.h>
#include <cstdio>
#include <cstdint>
namespace cg = cooperative_groups;
namespace pg8 {
#define PG8_LAS __attribute__((address_space(3)))
typedef unsigned short bf16_t;
typedef short bf16x8 __attribute__((ext_vector_type(8)));
typedef float f32x4 __attribute__((ext_vector_type(4)));
typedef unsigned u32x4 __attribute__((ext_vector_type(4)));
constexpr int BM = 256, BK = 64, HALF = 128, HTB = HALF * BK * 2  , STAGE_BYTES = 8 * HTB, NXCD = 8, WGM = 8;

__host__ __device__ __forceinline__ int lds_byte(int r, int c) { const int st = (r >> 4) * 2 + (c >> 5), rr = r & 15, cc = c & 31, ob = rr * 64 + cc * 2; return st * 1024 + (ob ^ (((ob >> 9) & 1) << 5)); }
__host__ __device__ __forceinline__ void stage_rc(int b, int& R, int& C) { const int st = b / 1024, sb = b % 1024, swz = sb ^ (((sb >> 9) & 1) << 5); R = (st >> 1) * 16 + swz / 64; C = (st & 1) * 32 + (swz % 64) / 2; }
__host__ __device__ __forceinline__ int perm32(int rho) { const int n = rho >> 4, i = rho & 15; return 8 * (i >> 2) + 4 * n + (i & 3); }

struct Unit { int pm, pn; };
struct Gemm { const bf16_t* A; const bf16_t* Bt; int M, N, K; };

struct StaticOrder {
    int nM, nN, nwg, G, c;
    __host__ __device__ void init(int M, int N, int G_, int c_) { nM = M / BM; nN = N / BM; nwg = nM * nN; G = G_; c = c_; }
    __host__ __device__ bool next(int i, Unit& u) const {
        const long L = (long)i * G + c; if (L >= nwg) return false;
        int wgid = (int)L; { const int q = nwg / NXCD, r = nwg % NXCD, xcd = wgid % NXCD, off = wgid / NXCD; wgid = (xcd < r ? xcd * (q + 1) : r * (q + 1) + (xcd - r) * q) + off; }
        const int nig = WGM * nN, gid = wgid / nig, fm = gid * WGM, gsz = (nM - fm) < WGM ? (nM - fm) : WGM;
        u.pm = fm + ((wgid % nig) % gsz); u.pn = (wgid % nig) / gsz; return true;
    }
    __device__ __forceinline__ void a_ready(const Unit&) const {}
    __device__ __forceinline__ void done(const Unit&) const {}
};

__device__ __forceinline__ unsigned cvt_pk_bf16(float lo, float hi) { unsigned r; asm volatile("v_cvt_pk_bf16_f32 %0, %1, %2" : "=v"(r) : "v"(lo), "v"(hi)); return r; }
typedef float f32x2 __attribute__((ext_vector_type(2)));
template <class Epi, class Sched, bool ALIGN_EPI = false, bool SP2 = false>
__device__ __forceinline__ void gemm_phase(PG8_LAS unsigned char* lds, const Gemm g, const Sched& S, const Epi& E) {
    int tid = threadIdx.x; asm volatile("" : "+v"(tid));
    const int wid = __builtin_amdgcn_readfirstlane(tid >> 6), lane = tid & 63, wr = wid >> 2, wc = wid & 3, fr = lane & 15, fq = lane >> 4;
    const int K = g.K, nt = K / BK;
    unsigned voffA[2], voffB[2];
#pragma unroll
    for (int i = 0; i < 2; ++i) { int R, C; stage_rc(tid * 16 + i * 8192, R, C); const int Rb = Epi::PERM ? ((R & ~31) + perm32(R & 31)) : R;
        voffA[i] = (unsigned)(R * K + C) * 2u; voffB[i] = (unsigned)(Rb * K + C) * 2u; }
    const size_t kstep = (size_t)(BK * 2);
    const size_t hstep = (size_t)HALF * K * 2;
    const size_t tstep = 2 * hstep;
    const unsigned ldsw = (unsigned)wid * 1024u;
    const int aoff = lds_byte(wr * 64 + fr, fq * 8), boff = lds_byte(wc * 32 + fr, fq * 8);
#define PG8_SA(b, h) (((b) * 2 + (h)) * HTB)
#define PG8_SB(b, h) ((4 + (b) * 2 + (h)) * HTB)
#define PG8_STAGE(bufoff, gbase, voff) do { _Pragma("unroll") for (int _i = 0; _i < 2; ++_i) \
        __builtin_amdgcn_global_load_lds((const unsigned*)((const char*)(gbase) + (voff)[_i]), (PG8_LAS unsigned*)(lds + (bufoff) + ldsw + _i * 8192), 16, 0, 0); } while (0)
#define PG8_LDA(dst, b, h) do { _Pragma("unroll") for (int m = 0; m < 4; ++m) _Pragma("unroll") for (int k = 0; k < 2; ++k) dst[m][k] = *(const PG8_LAS bf16x8*)(lds + PG8_SA(b, h) + aoff + m * 2048 + k * 1024); } while (0)
#define PG8_LDB(dst, b, h) do { _Pragma("unroll") for (int n = 0; n < 2; ++n) _Pragma("unroll") for (int k = 0; k < 2; ++k) dst[n][k] = *(const PG8_LAS bf16x8*)(lds + PG8_SB(b, h) + boff + n * 2048 + k * 1024); } while (0)
#define PG8_MMA(ai, bj, At, Bt) do { __builtin_amdgcn_s_setprio(1); _Pragma("unroll") for (int m = 0; m < 4; ++m) _Pragma("unroll") for (int n = 0; n < 2; ++n) _Pragma("unroll") for (int k = 0; k < 2; ++k) \
        acc[ai][bj][m][n] = __builtin_amdgcn_mfma_f32_16x16x32_bf16(Bt[n][k], At[m][k], acc[ai][bj][m][n], 0, 0, 0); __builtin_amdgcn_s_setprio(0); } while (0)
#define PG8_WAIT_V(n) asm volatile("s_waitcnt vmcnt(" #n ")" ::: "memory")
#define PG8_WAIT_L(n) asm volatile("s_waitcnt lgkmcnt(" #n ")" ::: "memory")
#define PG8_BAR __builtin_amdgcn_s_barrier()
#define PG8_SCHED __builtin_amdgcn_sched_barrier(0)
    Unit cur, nxt; int ui = 0;
    if (!S.next(0, cur)) return;
    f32x4 acc[2][2][4][2];
#pragma unroll
    for (int a = 0; a < 2; ++a)
#pragma unroll
        for (int b = 0; b < 2; ++b)
#pragma unroll
            for (int m = 0; m < 4; ++m)
#pragma unroll
                for (int n = 0; n < 2; ++n) acc[a][b][m][n] = (f32x4){0.f, 0.f, 0.f, 0.f};
    bf16x8 At[4][2], B0[2][2], B1[2][2];
    const char* cA = (const char*)g.A + (size_t)cur.pm * tstep; const char* cB = (const char*)g.Bt + (size_t)cur.pn * tstep;
    S.a_ready(cur);
    if constexpr (SP2) {
        PG8_STAGE(PG8_SB(0, 0), cB, voffB); PG8_STAGE(PG8_SB(0, 1), cB + hstep, voffB); PG8_STAGE(PG8_SA(0, 0), cA, voffA); PG8_STAGE(PG8_SA(0, 1), cA + hstep, voffA);
        if (wr == 1) PG8_BAR;
        PG8_WAIT_V(2); PG8_BAR;
        PG8_STAGE(PG8_SB(1, 0), cB + kstep, voffB); PG8_STAGE(PG8_SA(1, 0), cA + kstep, voffA); PG8_STAGE(PG8_SB(1, 1), cB + hstep + kstep, voffB);
        PG8_WAIT_V(6); PG8_BAR;
    } else {
        PG8_STAGE(PG8_SB(0, 0), cB, voffB); PG8_STAGE(PG8_SA(0, 0), cA, voffA); PG8_STAGE(PG8_SB(0, 1), cB + hstep, voffB); PG8_STAGE(PG8_SA(0, 1), cA + hstep, voffA);
        if (wr == 1) PG8_BAR;
        PG8_WAIT_V(4); PG8_BAR;
        PG8_STAGE(PG8_SB(1, 0), cB + kstep, voffB); PG8_STAGE(PG8_SA(1, 0), cA + kstep, voffA); PG8_STAGE(PG8_SB(1, 1), cB + hstep + kstep, voffB);
        PG8_WAIT_V(6); PG8_BAR;
    }
    for (;;) {
        const bool has_next = S.next(ui + 1, nxt);
        const char* nA = has_next ? (const char*)g.A + (size_t)nxt.pm * tstep : cA; const char* nB = has_next ? (const char*)g.Bt + (size_t)nxt.pn * tstep : cB;
        for (int t = 0; t < nt; t += 2) {
            const bool last = (t == nt - 2);
            const char* a1 = cA + (size_t)(t + 1) * kstep;
            const char* a2 = last ? nA : cA + (size_t)(t + 2) * kstep; const char* b2 = last ? nB : cB + (size_t)(t + 2) * kstep;
            const char* a3 = a2 + kstep; const char* b3 = b2 + kstep;
            if (last && has_next) S.a_ready(nxt);
            if constexpr (SP2) {
            PG8_LDB(B0, 0, 0); PG8_LDB(B1, 0, 1); PG8_SCHED; PG8_LDA(At, 0, 0); PG8_STAGE(PG8_SA(1, 1), a1 + hstep, voffA);
            PG8_WAIT_V(8); PG8_WAIT_L(0); PG8_BAR; PG8_MMA(0, 0, At, B0); PG8_MMA(0, 1, At, B1); PG8_BAR; PG8_SCHED;
            PG8_LDA(At, 0, 1); PG8_STAGE(PG8_SB(0, 0), b2, voffB); PG8_STAGE(PG8_SB(0, 1), b2 + hstep, voffB); PG8_STAGE(PG8_SA(0, 0), a2, voffA);
            PG8_WAIT_V(8); PG8_WAIT_L(0); PG8_BAR; PG8_MMA(1, 0, At, B0); PG8_MMA(1, 1, At, B1); PG8_BAR; PG8_SCHED;
            PG8_LDB(B0, 1, 0); PG8_LDB(B1, 1, 1); PG8_SCHED; PG8_LDA(At, 1, 0); PG8_STAGE(PG8_SA(0, 1), a2 + hstep, voffA);
            PG8_WAIT_V(8); PG8_WAIT_L(0); PG8_BAR; PG8_MMA(0, 0, At, B0); PG8_MMA(0, 1, At, B1); PG8_BAR; PG8_SCHED;
            PG8_LDA(At, 1, 1); PG8_STAGE(PG8_SB(1, 0), b3, voffB); PG8_STAGE(PG8_SB(1, 1), b3 + hstep, voffB); PG8_STAGE(PG8_SA(1, 0), a3, voffA);
            PG8_WAIT_V(8); PG8_WAIT_L(0); PG8_BAR; PG8_MMA(1, 0, At, B0); PG8_MMA(1, 1, At, B1); PG8_BAR; PG8_SCHED;
            } else {
            PG8_LDB(B0, 0, 0); PG8_SCHED; PG8_LDA(At, 0, 0); PG8_STAGE(PG8_SA(1, 1), a1 + hstep, voffA);
            PG8_WAIT_L(8); PG8_BAR; PG8_WAIT_L(0); PG8_MMA(0, 0, At, B0); PG8_BAR; PG8_SCHED;
            PG8_LDB(B1, 0, 1); PG8_STAGE(PG8_SB(0, 0), b2, voffB);
            PG8_BAR; PG8_WAIT_L(0); PG8_MMA(0, 1, At, B1); PG8_BAR;
            PG8_LDA(At, 0, 1); PG8_STAGE(PG8_SA(0, 0), a2, voffA);
            PG8_BAR; PG8_WAIT_L(0); PG8_MMA(1, 0, At, B0); PG8_BAR; PG8_SCHED;
            PG8_STAGE(PG8_SB(0, 1), b2 + hstep, voffB);
            PG8_WAIT_V(6); PG8_BAR; PG8_MMA(1, 1, At, B1); PG8_BAR;
            PG8_LDB(B0, 1, 0); PG8_SCHED; PG8_LDA(At, 1, 0); PG8_STAGE(PG8_SA(0, 1), a2 + hstep, voffA);
            PG8_WAIT_L(8); PG8_BAR; PG8_WAIT_L(0); PG8_MMA(0, 0, At, B0); PG8_BAR; PG8_SCHED;
            PG8_LDB(B1, 1, 1); PG8_STAGE(PG8_SB(1, 0), b3, voffB);
            PG8_BAR; PG8_WAIT_L(0); PG8_MMA(0, 1, At, B1); PG8_BAR;
            PG8_LDA(At, 1, 1); PG8_STAGE(PG8_SA(1, 0), a3, voffA);
            PG8_BAR; PG8_WAIT_L(0); PG8_MMA(1, 0, At, B0); PG8_BAR; PG8_SCHED;
            PG8_STAGE(PG8_SB(1, 1), b3 + hstep, voffB);
            PG8_WAIT_V(6); PG8_BAR; PG8_MMA(1, 1, At, B1); PG8_BAR;
            }
        }
        if constexpr (ALIGN_EPI) { if (wr == 0) PG8_BAR; }
        if constexpr (!Epi::AFTER_DRAIN) { E(acc, cur, wr, wc, fr, fq); S.done(cur); }
        if (!has_next) break;
#pragma unroll
        for (int a = 0; a < 2; ++a)
#pragma unroll
            for (int b = 0; b < 2; ++b)
#pragma unroll
                for (int m = 0; m < 4; ++m)
#pragma unroll
                    for (int n = 0; n < 2; ++n) acc[a][b][m][n] = (f32x4){0.f, 0.f, 0.f, 0.f};
        cur = nxt; cA = nA; cB = nB; ++ui;
        if constexpr (ALIGN_EPI) { if (wr == 1) PG8_BAR; }
    }
    PG8_WAIT_V(0);
    if constexpr (!ALIGN_EPI) { if (wr == 0) PG8_BAR; }
    PG8_BAR;
    if constexpr (Epi::AFTER_DRAIN) { E.fused(acc, cur, wr, wc, fr, fq, lds, wid, lane); S.done(cur); }
#undef PG8_SA
#undef PG8_SB
#undef PG8_STAGE
#undef PG8_LDA
#undef PG8_LDB
#undef PG8_MMA
#undef PG8_WAIT_V
#undef PG8_WAIT_L
#undef PG8_BAR
#undef PG8_SCHED
}
}

using pg8::f32x4; using pg8::bf16x8;
typedef unsigned short bf16;
typedef unsigned v4u __attribute__((ext_vector_type(4)));
typedef unsigned v2u __attribute__((ext_vector_type(2)));
typedef short s16x4 __attribute__((ext_vector_type(4)));

constexpr int DM = 1024, TLEN = 8192, CTXL = 256, TT = 8448, NLAT = 16384, NR = 16896, DFF = 2816, UC = 2560, NTILE = 528;
constexpr int NSEG = 64, SEGLEN = 132;
constexpr size_t MiB = 1u << 20;
constexpr size_t A8 = (size_t)NR * 256 * 2;
constexpr size_t OFF_MOD = 0, MOD_BYTES = 256 * 1024;
constexpr size_t OFF_XCTX = MiB / 4, OFF_XMY = 2 * MiB + MiB / 4, OFF_HU = 35 * MiB + MiB / 4, OFF_W = 126 * MiB, OFF_MIX = 167 * MiB, OFF_PR = 266 * MiB;
constexpr size_t W_13A = OFF_W, W_2A = OFF_W + 11 * MiB, W_13B = OFF_W + 16 * MiB + MiB / 2, W_2B = OFF_W + 27 * MiB + MiB / 2,
                 W_IN = OFF_W + 33 * MiB, W_OUT = OFF_W + 38 * MiB, W_UQ = OFF_W + 40 * MiB, W_UKV = OFF_W + 40 * MiB + 256 * 1024,
                 W_WUP = OFF_W + 40 * MiB + 384 * 1024, W_AUP = W_WUP + 65536, W_GUP = W_AUP + 65536, W_LWA = W_GUP + 65536, W_LWX = W_LWA + 65536;
constexpr size_t M_QB = OFF_MIX, M_KB = OFF_MIX + 12976128, M_VT = OFF_MIX + 25952256;
constexpr size_t M_LR0 = OFF_PR, M_LIX0 = OFF_PR + 2 * A8;
constexpr size_t M_SEGA = OFF_HU + 83 * MiB, M_SEGB = M_SEGA + MiB + MiB / 4, M_H0 = M_SEGB + MiB + MiB / 4;
constexpr size_t M_RR = OFF_MIX, M_KK = OFF_MIX + A8, M_VV = OFF_MIX + 2 * A8, M_WW = OFF_MIX + 3 * A8, M_BB = OFF_MIX + 7 * A8, M_KD = OFF_MIX + 9 * A8, M_GC = OFF_MIX + 11 * A8;
constexpr size_t M_YS = OFF_HU, M_PL = OFF_HU + 33 * MiB, M_SINIT = OFF_HU + 65 * MiB;
constexpr size_t M_PR = OFF_PR;
constexpr size_t WS_NEED = OFF_PR + 33 * MiB;
constexpr int LDS_BYTES = 131072 + 1024;
#ifndef REP_M1
#define REP_M1 1
#endif
#ifndef REP_M2
#define REP_M2 1
#endif
#ifndef REP_M3
#define REP_M3 1
#endif
#ifndef REP_SCAN
#define REP_SCAN 1
#endif
#ifndef REP_G1
#define REP_G1 1
#endif
constexpr float QSCALE = 0.10206207261596575f * 1.4426950408889634f;

struct Args { const float* in[40]; float* out; unsigned char* ws; };
typedef const __attribute__((address_space(4))) volatile unsigned long long kargq;
__device__ __forceinline__ const float* karg_in(int i) { kargq* p = (kargq*)__builtin_amdgcn_kernarg_segment_ptr(); return (const float*)p[i]; }
__device__ __forceinline__ float* karg_out() { kargq* p = (kargq*)__builtin_amdgcn_kernarg_segment_ptr(); return (float*)p[40]; }
__device__ __forceinline__ unsigned char* karg_ws() { kargq* p = (kargq*)__builtin_amdgcn_kernarg_segment_ptr(); return (unsigned char*)p[41]; }
#define IN(i) karg_in(i)
__device__ __forceinline__ int ltid() { int t = threadIdx.x; asm volatile("" : "+v"(t)); return t; }
__device__ __forceinline__ int lbid() { int t = blockIdx.x; asm volatile("" : "+s"(t)); return t; }
template <class T> __device__ __forceinline__ T* launder(T* p) { asm volatile("" : "+s"(p)); return p; }

__device__ __forceinline__ float bf2f(bf16 h) { return __uint_as_float((unsigned)h << 16); }
__device__ __forceinline__ unsigned f2bf(float f) { unsigned u = __float_as_uint(f); return (u + 0x7fffu + ((u >> 16) & 1u)) >> 16; }
__device__ __forceinline__ unsigned pk2(float lo, float hi) { return f2bf(lo) | (f2bf(hi) << 16); }
__device__ __forceinline__ float sigm(float x) { return __builtin_amdgcn_rcpf(1.f + __expf(-x)); }
__device__ __forceinline__ float siluf_(float x) { return x * __builtin_amdgcn_rcpf(1.f + __expf(-x)); }
__device__ __forceinline__ float tanhf_(float y) { return 1.f - 2.f * __builtin_amdgcn_rcpf(1.f + __expf(2.f * y)); }
__device__ __forceinline__ float geluf_(float x) { return 0.5f * x * (1.f + tanhf_(0.7978845608028654f * (x + 0.044715f * x * x * x))); }
__device__ __forceinline__ float wave_sum(float v) {
#pragma unroll
    for (int o = 1; o < 64; o <<= 1) v += __shfl_xor(v, o);
    return v;
}
struct TileInfo { int b, isctx, t0, seqbase, seqlen; };
__device__ __forceinline__ TileInfo tile_info(int tile) {
    TileInfo ti;
    if (tile < 512) { ti.b = tile >> 8; ti.isctx = 0; ti.t0 = (tile & 255) * 32; ti.seqbase = ti.b * TLEN; ti.seqlen = TLEN; }
    else { const int q = tile - 512; ti.b = q >> 3; ti.isctx = 1; ti.t0 = (q & 7) * 32; ti.seqbase = NLAT + ti.b * CTXL; ti.seqlen = CTXL; }
    return ti;
}

struct EpiSwiglu {
    static constexpr bool PERM = true, AFTER_DRAIN = false;
    bf16* H;
    __device__ __forceinline__ void operator()(const f32x4 (&acc)[2][2][4][2], const pg8::Unit& u, int wr, int wc, int fr, int fq) const {
        int pm = u.pm, pn = u.pn; asm volatile("" : "+s"(pm), "+s"(pn), "+s"(wr), "+s"(wc), "+v"(fr), "+v"(fq));
        bf16* tb = H + (size_t)pm * 256 * DFF + pn * 128;
        const unsigned loff = (unsigned)((wr * 64 + fr) * DFF + wc * 32 + 8 * fq);
#pragma unroll
        for (int ai = 0; ai < 2; ++ai)
#pragma unroll
            for (int m = 0; m < 4; ++m) {
                bf16* rowp = tb + (loff + (unsigned)((ai * 128 + m * 16) * DFF));
                const f32x4 g0 = acc[ai][0][m][0], g1 = acc[ai][0][m][1], u0 = acc[ai][1][m][0], u1 = acc[ai][1][m][1];
                v4u w;
                w.x = pg8::cvt_pk_bf16(siluf_(g0[0]) * u0[0], siluf_(g0[1]) * u0[1]); w.y = pg8::cvt_pk_bf16(siluf_(g0[2]) * u0[2], siluf_(g0[3]) * u0[3]);
                w.z = pg8::cvt_pk_bf16(siluf_(g1[0]) * u1[0], siluf_(g1[1]) * u1[1]); w.w = pg8::cvt_pk_bf16(siluf_(g1[2]) * u1[2], siluf_(g1[3]) * u1[3]);
                *(v4u*)rowp = w;
            }
    }
};
struct EpiU {
    static constexpr bool PERM = true, AFTER_DRAIN = false;
    bf16* O; int ldc;
    __device__ __forceinline__ void operator()(const f32x4 (&acc)[2][2][4][2], const pg8::Unit& u, int wr, int wc, int fr, int fq) const {
        int pm = u.pm, pn = u.pn; asm volatile("" : "+s"(pm), "+s"(pn), "+s"(wr), "+s"(wc), "+v"(fr), "+v"(fq));
        bf16* tb = O + (size_t)pm * 256 * ldc + pn * 256;
        const unsigned loff = (unsigned)((wr * 64 + fr) * ldc + wc * 32 + 8 * fq);
#pragma unroll
        for (int ai = 0; ai < 2; ++ai)
#pragma unroll
            for (int m = 0; m < 4; ++m) {
                bf16* rowp = tb + (loff + (unsigned)((ai * 128 + m * 16) * ldc));
#pragma unroll
                for (int bj = 0; bj < 2; ++bj) { const f32x4 v0 = acc[ai][bj][m][0], v1 = acc[ai][bj][m][1]; v4u w;
                    w.x = pg8::cvt_pk_bf16(v0[0], v0[1]); w.y = pg8::cvt_pk_bf16(v0[2], v0[3]); w.z = pg8::cvt_pk_bf16(v1[0], v1[1]); w.w = pg8::cvt_pk_bf16(v1[2], v1[3]);
                    *(v4u*)(rowp + bj * 128) = w; }
            }
    }
};
struct EpiResid {
    static constexpr bool PERM = false, AFTER_DRAIN = false;
    float* xlat; float* xctx; const float* gate; float coef; const float* slat; const float* sctx;
    __device__ __forceinline__ void operator()(const f32x4 (&acc)[2][2][4][2], const pg8::Unit& u, int wr, int wc, int fr, int fq) const {
        int pm = u.pm, pn = u.pn; asm volatile("" : "+s"(pm), "+s"(pn), "+s"(wr), "+s"(wc), "+v"(fr), "+v"(fq));
        const size_t toff = (pm < 64 ? (size_t)pm : (size_t)(pm - 64)) * 256 * DM + pn * 256;
        float* tb = (pm < 64 ? xlat : xctx) + toff; const float* sb = (pm < 64 ? slat : sctx) + toff;
        const float* g = gate + (pm < 64 ? (pm >> 5) : 2) * 9216 + pn * 256;
        const unsigned coff = (unsigned)(wc * 32 + 4 * fq), loff = (unsigned)((wr * 64 + fr) * DM) + coff;
        f32x4 gv[2][2];
#pragma unroll
        for (int bj = 0; bj < 2; ++bj)
#pragma unroll
            for (int n = 0; n < 2; ++n) gv[bj][n] = coef * *(const f32x4*)(g + (coff + (unsigned)(bj * 128 + n * 16)));
#pragma unroll
        for (int ai = 0; ai < 2; ++ai)
#pragma unroll
            for (int m = 0; m < 4; ++m) {
                float* xr = tb + (loff + (unsigned)((ai * 128 + m * 16) * DM)); const float* sr = sb + (loff + (unsigned)((ai * 128 + m * 16) * DM));
#pragma unroll
                for (int bj = 0; bj < 2; ++bj)
#pragma unroll
                    for (int n = 0; n < 2; ++n) { float* xp = xr + (bj * 128 + n * 16);
                        f32x4 xv = *(const f32x4*)(sr + (bj * 128 + n * 16)); xv += gv[bj][n] * acc[ai][bj][m][n]; *(f32x4*)xp = xv; }
                asm volatile("" ::: "memory");
            }
    }
};

__device__ __forceinline__ void phase_modgemv(const Args& a, float* red, int G, int bid, int tid) {
    const float* c = IN(1); const float* cctx = IN(3); const float* ada_w = IN(4); const float* ada_b = IN(5);
    float* mod = (float*)(karg_ws() + OFF_MOD);
    const int w = tid >> 6, lane = tid & 63;
    for (int u = bid; u < 576; u += G) {
        const int l = u / 288, rem = u % 288, jt = rem >> 3, ks = rem & 7;
        const int kb = ks * 128 + w * 16, j0 = jt * 256 + lane * 4;
        f32x4 acc0 = {0.f, 0.f, 0.f, 0.f}, acc1 = acc0, acc2 = acc0;
        for (int kk = 0; kk < 16; ++kk) { const int k = kb + kk;
            const float s0 = siluf_(c[k]), s1 = siluf_(c[1024 + k]), s2 = siluf_(cctx[k]);
            const f32x4 wv = *(const f32x4*)(ada_w + ((size_t)(l * 1024 + k)) * 9216 + j0);
            acc0 += s0 * wv; acc1 += s1 * wv; acc2 += s2 * wv; }
        float* rp = red + (w * 3) * 256 + lane * 4;
        *(f32x4*)rp = acc0; *(f32x4*)(rp + 256) = acc1; *(f32x4*)(rp + 512) = acc2;
        __syncthreads();
        for (int o = tid; o < 768; o += 512) { const int m = o >> 8, jj = o & 255; float s = 0.f;
#pragma unroll
            for (int ww = 0; ww < 8; ++ww) s += red[(ww * 3 + m) * 256 + jj];
            const int j = jt * 256 + jj; if (ks == 0) s += ada_b[l * 9216 + j];
            atomicAdd(&mod[(l * 3 + m) * 9216 + j], s); }
        __syncthreads();
    }
}
__device__ __forceinline__ void phase_copy(const Args& a, int G, int bid, int tid) {
    const f32x4* x4 = (const f32x4*)IN(0); f32x4* o4 = (f32x4*)karg_out();
    for (int i = bid * 512 + tid; i < NLAT * DM / 4; i += G * 512) o4[i] = x4[i];
    const f32x4* c4 = (const f32x4*)IN(2); f32x4* xc4 = (f32x4*)(karg_ws() + OFF_XCTX);
    for (int i = bid * 512 + tid; i < 512 * DM / 4; i += G * 512) xc4[i] = c4[i];
}
__device__ __forceinline__ int swiglu_map(int n) { return n < DFF ? ((n >> 7) * 256 + (n & 127)) : ((((n - DFF) >> 7) * 256) + 128 + ((n - DFF) & 127)); }
__device__ __forceinline__ void transpose_item(const float* W, int K, int N, bf16* WT, float* scr, int item, int lane, int mode, const float* kscale) {
    const int nblk = N / 32, kb = item / nblk, nb = item % nblk, k0 = 64 * kb, n0 = 32 * nb;
    float tv[32];
#pragma unroll
    for (int i = 0; i < 32; ++i) { const int kk = 2 * i + (lane >> 5); tv[i] = W[(size_t)(k0 + kk) * N + n0 + (lane & 31)]; }
#pragma unroll
    for (int i = 0; i < 32; ++i) { const int kk = 2 * i + (lane >> 5); float v = tv[i]; if (kscale) v *= kscale[k0 + kk]; scr[kk * 33 + (lane & 31)] = v; }
    __builtin_amdgcn_wave_barrier();
    const int c = lane & 7;
#pragma unroll
    for (int j = 0; j < 4; ++j) { const int n = (lane >> 3) + 8 * j; const float* s = scr + (8 * c) * 33 + n;
        v4u o; o.x = pk2(s[0 * 33], s[1 * 33]); o.y = pk2(s[2 * 33], s[3 * 33]); o.z = pk2(s[4 * 33], s[5 * 33]); o.w = pk2(s[6 * 33], s[7 * 33]);
        const int nn = n0 + n, drow = mode ? swiglu_map(nn) : nn;
        *(v4u*)(WT + (size_t)drow * K + k0 + 8 * c) = o; }
    __builtin_amdgcn_wave_barrier();
}
__device__ __forceinline__ void convert_weights(const Args& a, int l, float* scr, int gw, int NGW, int lane, int G, int bid, int tid) {
    constexpr int I13 = 16 * 176, I2 = 44 * 32, IIN = 16 * 77, IOUT = 16 * 32, IUQ = 4 * 12, IUKV = 2 * 16;
    constexpr int IEX = 80;
    constexpr int NIT = 2 * I13 + 2 * I2 + IIN + IOUT + IUQ + IUKV + IEX;
    unsigned char* ws = karg_ws();
    for (int it = gw; it < NIT; it += NGW) {
        int r = it;
        if (r < I13) { transpose_item(IN(6) + (size_t)l * DM * 2 * DFF, DM, 2 * DFF, (bf16*)(ws + W_13A), scr, r, lane, 1, nullptr); continue; } r -= I13;
        if (r < I13) { transpose_item(IN(8) + (size_t)l * DM * 2 * DFF, DM, 2 * DFF, (bf16*)(ws + W_13B), scr, r, lane, 1, nullptr); continue; } r -= I13;
        if (r < I2) { transpose_item(IN(7) + (size_t)l * DFF * DM, DFF, DM, (bf16*)(ws + W_2A), scr, r, lane, 0, nullptr); continue; } r -= I2;
        if (r < I2) { transpose_item(IN(9) + (size_t)l * DFF * DM, DFF, DM, (bf16*)(ws + W_2B), scr, r, lane, 0, nullptr); continue; } r -= I2;
        if (r < IIN) { transpose_item(IN(10) + (size_t)l * DM * 2464, DM, 2464, (bf16*)(ws + W_IN), scr, r, lane, 0, nullptr); continue; } r -= IIN;
        if (r < IOUT) { transpose_item(IN(11) + (size_t)l * DM * DM, DM, DM, (bf16*)(ws + W_OUT), scr, r, lane, 0, nullptr); continue; } r -= IOUT;
        if (r < IUQ) { transpose_item(IN(36) + (size_t)l * 256 * 384, 256, 384, (bf16*)(ws + W_UQ), scr, r, lane, 0, IN(35) + l * 256); continue; } r -= IUQ;
        if (r < IUKV) { transpose_item(IN(38) + (size_t)l * 128 * 512, 128, 512, (bf16*)(ws + W_UKV), scr, r, lane, 0, IN(37) + l * 128); continue; } r -= IUKV;
        if (r < 16) { const int d = r >> 3; transpose_item(IN(26) + (size_t)(l * 2 + d) * 64 * 256, 64, 256, (bf16*)(ws + W_WUP) + d * 256 * 64, scr, r & 7, lane, 0, nullptr); continue; } r -= 16;
        if (r < 16) { const int d = r >> 3; transpose_item(IN(28) + (size_t)(l * 2 + d) * 64 * 256, 64, 256, (bf16*)(ws + W_AUP) + d * 256 * 64, scr, r & 7, lane, 0, nullptr); continue; } r -= 16;
        if (r < 16) { transpose_item(IN(29) + (size_t)l * 128 * 256, 128, 256, (bf16*)(ws + W_GUP), scr, r, lane, 0, nullptr); continue; } r -= 16;
        if (r < 16) { const int m = r >> 1; transpose_item(IN(18) + (size_t)(l * 8 + m) * 4096, 64, 64, (bf16*)(ws + W_LWA) + m * 4096, scr, r & 1, lane, 0, nullptr); continue; } r -= 16;
        { const int m = r >> 1; transpose_item(IN(20) + (size_t)(l * 8 + m) * 4096, 64, 64, (bf16*)(ws + W_LWX) + m * 4096, scr, r & 1, lane, 0, nullptr); }
    }
    v4u z = {0u, 0u, 0u, 0u}; v4u* zp = (v4u*)(ws + W_IN + (size_t)2464 * DM * 2);
    for (int i = bid * 512 + tid; i < 96 * DM * 2 / 16; i += G * 512) zp[i] = z;
}
__device__ __forceinline__ void phase_modulate(const Args& a, int l, int which, int gw, int NGW, int lane) {
    unsigned char* ws = karg_ws(); const float* outp = karg_out();
    const bool first = (l == 0 && which == 0);
    const float* srcl = first ? IN(0) : outp; const float* srcc = first ? IN(2) : (const float*)(ws + OFF_XCTX);
    const float* mod = (const float*)(ws + OFF_MOD) + (size_t)l * 3 * 9216;
    bf16* XM = (bf16*)(ws + OFF_XMY);
    for (int r = gw; r < NR; r += NGW) {
        const float* xr = r < NLAT ? srcl + (size_t)r * DM : srcc + (size_t)(r - NLAT) * DM;
        const float* mm = mod + (r < NLAT ? (r >> 13) : 2) * 9216 + which * 3 * 1024;
        f32x4 v[4]; float ss = 0.f;
#pragma unroll
        for (int j = 0; j < 4; ++j) { v[j] = *(const f32x4*)(xr + 4 * lane + 256 * j); ss += (v[j][0] * v[j][0] + v[j][1] * v[j][1]) + (v[j][2] * v[j][2] + v[j][3] * v[j][3]); }
        const float rstd = rsqrtf(wave_sum(ss) * (1.f / DM) + 1e-6f);
#pragma unroll
        for (int j = 0; j < 4; ++j) { const int c = 4 * lane + 256 * j; const f32x4 sh = *(const f32x4*)(mm + c), sc = *(const f32x4*)(mm + 1024 + c);
            const f32x4 o = v[j] * rstd * (1.f + sc) + sh; v2u w; w.x = pk2(o[0], o[1]); w.y = pk2(o[2], o[3]);
            *(v2u*)(XM + (size_t)r * DM + c) = w; }
    }
}
__device__ __forceinline__ void phase_final(const Args& a, int gw, int NGW, int lane) {
    const float* fn = IN(39); float* outp = karg_out();
    for (int r = gw; r < NLAT; r += NGW) {
        float* xr = outp + (size_t)r * DM; f32x4 v[4]; float ss = 0.f;
#pragma unroll
        for (int j = 0; j < 4; ++j) { v[j] = *(const f32x4*)(xr + 4 * lane + 256 * j); ss += (v[j][0] * v[j][0] + v[j][1] * v[j][1]) + (v[j][2] * v[j][2] + v[j][3] * v[j][3]); }
        const float rstd = rsqrtf(wave_sum(ss) * (1.f / DM) + 1e-6f);
#pragma unroll
        for (int j = 0; j < 4; ++j) { const int c = 4 * lane + 256 * j; const f32x4 g = *(const f32x4*)(fn + c); *(f32x4*)(xr + c) = v[j] * rstd * g; }
    }
}

__device__ __forceinline__ void phase_m1(const Args& a, int l, unsigned char* lds, int G, int bid, int tid_unused) {
    unsigned char* ws = karg_ws();
    const bf16* U = (const bf16*)(ws + OFF_HU);
    bf16* Y = (bf16*)(ws + OFF_XMY);
    for (int pass = 0; pass < 2; ++pass)
    for (int tile = (pass == 0 ? bid : (bid < 48 ? 512 + bid / 3 : NTILE)); tile < (pass == 0 ? 512 : NTILE); tile += (pass == 0 ? G : NTILE)) {
        const int mask = pass == 0 ? 7 : ((1 << (bid % 3)) & (l == 1 ? 6 : 7));
        const TileInfo ti = tile_info(tile);
        const int row0 = tile * 32;
        if (mask & 1) {
            const int tid = ltid(); const int lane = tid & 63, wave = __builtin_amdgcn_readfirstlane(tid >> 6), ch = tid & 255, part = tid >> 8; (void)lane; (void)wave; (void)ch; (void)part;
            float* z = (float*)lds;
            float* cv = (float*)(lds + 65536);
            for (int tt = part; tt < 62; tt += 2) { const int t = ti.t0 - 15 + tt; float zz = 0.f;
                if (t >= 0 && t < ti.seqlen) { const bf16* ur = U + (size_t)(ti.seqbase + t) * UC; zz = bf2f(ur[ch]) * sigm(bf2f(ur[256 + ch])); }
                z[tt * 256 + ch] = zz; }
            __syncthreads();
            const float* dw = IN(12) + (size_t)l * 31 * 256 + ch;
            float acc[16]; const float bias = IN(13)[l * 256 + ch];
#pragma unroll
            for (int o = 0; o < 16; ++o) acc[o] = bias;
            for (int j = 0; j < 31; ++j) { const float w = dw[j * 256];
#pragma unroll
                for (int o = 0; o < 16; ++o) acc[o] += w * z[(part * 16 + o + j) * 256 + ch]; }
#pragma unroll
            for (int o = 0; o < 16; ++o) cv[(part * 16 + o) * 256 + ch] = acc[o];
            __syncthreads();
            const f32x4 lg = *(const f32x4*)(IN(14) + l * 256 + lane * 4), lb = *(const f32x4*)(IN(15) + l * 256 + lane * 4);
#pragma unroll
            for (int q = 0; q < 4; ++q) { const int t = wave * 4 + q; const f32x4 v = *(const f32x4*)(cv + t * 256 + lane * 4);
                const float mu = wave_sum((v[0] + v[1]) + (v[2] + v[3])) * (1.f / 256.f);
                const f32x4 dv = v - mu; const float var = wave_sum((dv[0] * dv[0] + dv[1] * dv[1]) + (dv[2] * dv[2] + dv[3] * dv[3])) * (1.f / 256.f);
                const f32x4 yn = dv * rsqrtf(var + 1e-5f) * lg + lb;
                v2u w; w.x = pk2(siluf_(yn[0]), siluf_(yn[1])); w.y = pk2(siluf_(yn[2]), siluf_(yn[3]));
                *(v2u*)(Y + (size_t)(row0 + t) * DM + lane * 4) = w; }
            __syncthreads();
        }
        if (mask & 2) {
            float* xvf = (float*)lds;
            bf16* xvb = (bf16*)(lds + 32768);
            bf16* rg = (bf16*)(lds + 49664);
            bf16* ixg = (bf16*)(lds + 82432);
            {
                const int tid = ltid(); const int ch = tid & 255, part = tid >> 8;
                const float* cw = IN(16) + (size_t)l * 4 * 256 + ch; const float w0 = cw[0], w1 = cw[256], w2 = cw[512], w3 = cw[768], cb = IN(17)[l * 256 + ch];
                float xin[19];
#pragma unroll
                for (int i = 0; i < 19; ++i) { const int t = ti.t0 + part * 16 + i - 2; xin[i] = (t >= 0 && t < ti.seqlen) ? bf2f(U[(size_t)(ti.seqbase + t) * UC + 512 + ch]) : 0.f; }
#pragma unroll
                for (int o = 0; o < 16; ++o) { const int tl = part * 16 + o;
                    const float v = cb + w0 * xin[o] + w1 * xin[o + 1] + w2 * xin[o + 2] + w3 * xin[o + 3];
                    xvf[tl * 256 + ch] = v; xvb[tl * 264 + ch] = (bf16)f2bf(v);
                }
            }
            __syncthreads();
            {
                const int tid = ltid(); const int ln = tid & 63, wv = __builtin_amdgcn_readfirstlane(tid >> 6), fr = ln & 15, fq = ln >> 4, blk = wv >> 1;
                const bf16* LWAt = (const bf16*)(ws + W_LWA); const bf16* LWXt = (const bf16*)(ws + W_LWX);
                bf16x8 af[2][2];
#pragma unroll
                for (int mt = 0; mt < 2; ++mt)
#pragma unroll
                    for (int ks = 0; ks < 2; ++ks) af[mt][ks] = *(const bf16x8*)(xvb + (mt * 16 + fr) * 264 + blk * 64 + ks * 32 + fq * 8);
#pragma unroll 1
                for (int dn = 0; dn < 4; ++dn) { const int d = dn >> 1, nt = wv * 2 + (dn & 1), ch = nt * 16 + fr, jj = (nt & 3) * 16 + fr;
                    f32x4 ca[2], cx[2];
#pragma unroll
                    for (int mt = 0; mt < 2; ++mt) { ca[mt] = (f32x4){0.f, 0.f, 0.f, 0.f}; cx[mt] = ca[mt]; }
#pragma unroll
                    for (int ks = 0; ks < 2; ++ks) { const size_t wo = ((size_t)(d * 4 + blk) * 64 + jj) * 64 + ks * 32 + fq * 8;
                        const bf16x8 ba = *(const bf16x8*)(LWAt + wo), bx = *(const bf16x8*)(LWXt + wo);
#pragma unroll
                        for (int mt = 0; mt < 2; ++mt) { ca[mt] = __builtin_amdgcn_mfma_f32_16x16x32_bf16(af[mt][ks], ba, ca[mt], 0, 0, 0); cx[mt] = __builtin_amdgcn_mfma_f32_16x16x32_bf16(af[mt][ks], bx, cx[mt], 0, 0, 0); } }
                    const float bga = IN(19)[(l * 2 + d) * 256 + ch], bgx = IN(21)[(l * 2 + d) * 256 + ch];
                    bf16* LR = (bf16*)(ws + M_LR0 + (size_t)d * A8); bf16* LIX = (bf16*)(ws + M_LIX0 + (size_t)d * A8);
#pragma unroll
                    for (int mt = 0; mt < 2; ++mt)
#pragma unroll
                        for (int j = 0; j < 4; ++j) { const int t = mt * 16 + fq * 4 + j;
                            const bf16 rb = (bf16)f2bf(sigm(ca[mt][j] + bga)), ib = (bf16)f2bf(sigm(cx[mt][j] + bgx) * xvf[t * 256 + ch]);
                            LR[(size_t)(row0 + t) * 256 + ch] = rb; LIX[(size_t)(row0 + t) * 256 + ch] = ib;
                            rg[(d * 32 + t) * 256 + ch] = rb; ixg[(d * 32 + t) * 256 + ch] = ib; }
                }
            }
            __syncthreads();
            {
                const int tid = ltid(); const int ch = tid & 255, d = tid >> 8;
                const float lam = IN(22)[(l * 2 + d) * 256 + ch];
                const float cch = -8.f * log1pf(__expf(-lam));
                float A = 1.f, B = 0.f;
#pragma unroll 8
                for (int tt = 0; tt < 32; ++tt) { const int t = d ? 31 - tt : tt;
                    const float al = __expf(cch * bf2f(rg[(d * 32 + t) * 256 + ch])); const float bb = sqrtf(fmaxf(1.f - al * al, 0.f)) * bf2f(ixg[(d * 32 + t) * 256 + ch]); B = al * B + bb; A *= al; }
                ((float*)(ws + M_SEGA))[(size_t)(tile * 2 + d) * 256 + ch] = A;
                ((float*)(ws + M_SEGB))[(size_t)(tile * 2 + d) * 256 + ch] = B;
            }
            __syncthreads();
        }
        if (mask & 4) {
            const int tid = ltid(); const int lane = tid & 63, wave = __builtin_amdgcn_readfirstlane(tid >> 6), ch = tid & 255, part = tid >> 8; (void)lane; (void)wave; (void)ch; (void)part;
            bf16* As = (bf16*)lds;
            float* kr = (float*)(lds + 32768);
            float* rs = (float*)(lds + 32768 + 4096);
            for (int idx = tid; idx < 32 * 52; idx += 512) { const int t = idx / 52, cc = idx % 52;
                const v4u v = *(const v4u*)(U + (size_t)(row0 + t) * UC + 2048 + cc * 8);
                if (cc < 48) *(v4u*)(As + t * 392 + cc * 8) = v;
                else { const int c0 = (cc - 48) * 8; float* kp = kr + t * 32 + c0;
                    kp[0] = __uint_as_float(v.x << 16); kp[1] = __uint_as_float(v.x & 0xffff0000u); kp[2] = __uint_as_float(v.y << 16); kp[3] = __uint_as_float(v.y & 0xffff0000u);
                    kp[4] = __uint_as_float(v.z << 16); kp[5] = __uint_as_float(v.z & 0xffff0000u); kp[6] = __uint_as_float(v.w << 16); kp[7] = __uint_as_float(v.w & 0xffff0000u); } }
            __syncthreads();
#pragma unroll
            for (int q = 0; q < 4; ++q) { const int t = wave * 4 + q; float sq = 0.f, sk = 0.f;
#pragma unroll
                for (int j = 0; j < 4; ++j) { const float v = bf2f(As[t * 392 + lane + 64 * j]); sq += v * v; }
#pragma unroll
                for (int j = 0; j < 2; ++j) { const float v = bf2f(As[t * 392 + 256 + lane + 64 * j]); sk += v * v; }
                sq = wave_sum(sq); sk = wave_sum(sk);
                if (lane == 0) { rs[t * 2] = rsqrtf(sq * (1.f / 256.f) + 1e-6f); rs[t * 2 + 1] = rsqrtf(sk * (1.f / 128.f) + 1e-6f); } }
            __syncthreads();
            const int fr = lane & 15, fq = lane >> 4;
            bf16* QB = (bf16*)(ws + M_QB); bf16* KB = (bf16*)(ws + M_KB); bf16* VT = (bf16*)(ws + M_VT);
            const bf16* WUQ = (const bf16*)(ws + W_UQ); const bf16* WUKV = (const bf16*)(ws + W_UKV);
            const int keybase = ti.isctx ? TLEN : 0;
#pragma unroll 1
            for (int i = 0; i < 3; ++i) { const int nt = wave * 3 + i;
                f32x4 c0 = {0.f, 0.f, 0.f, 0.f}, c1 = c0;
#pragma unroll
                for (int ks = 0; ks < 8; ++ks) { const bf16x8 bfr = *(const bf16x8*)(WUQ + (size_t)(nt * 16 + fr) * 256 + ks * 32 + fq * 8);
                    const bf16x8 a0 = *(const bf16x8*)(As + fr * 392 + ks * 32 + fq * 8), a1 = *(const bf16x8*)(As + (16 + fr) * 392 + ks * 32 + fq * 8);
                    c0 = __builtin_amdgcn_mfma_f32_16x16x32_bf16(a0, bfr, c0, 0, 0, 0); c1 = __builtin_amdgcn_mfma_f32_16x16x32_bf16(a1, bfr, c1, 0, 0, 0); }
                const int hq = nt / 6, wt = nt % 6, dd = wt * 16 + fr;
#pragma unroll
                for (int mt = 0; mt < 2; ++mt)
#pragma unroll
                    for (int j = 0; j < 4; ++j) { const int tl = mt * 16 + fq * 4 + j; const int t = ti.t0 + tl;
                        float v = (mt ? c1[j] : c0[j]) * rs[tl * 2];
                        const float pv = __shfl_xor(v, 8);
                        if (wt >= 4 && !ti.isctx) { const int f = fr & 7; const float pos = (wt == 4) ? (float)(t >> 6) : (float)(t & 63);
                            const float ang = pos * __expf(-(float)f * (9.210340371976184f / 8.f)); float sn, cs; __sincosf(ang, &sn, &cs);
                            v = (fr & 8) ? (v * cs + pv * sn) : (v * cs - pv * sn); }
                        QB[((size_t)(ti.b * 4 + hq) * TT + keybase + t) * 96 + dd] = (bf16)f2bf(v * QSCALE); } }
#pragma unroll 1
            for (int i = 0; i < 4; ++i) { const int nt = wave * 4 + i;
                f32x4 c0 = {0.f, 0.f, 0.f, 0.f}, c1 = c0;
#pragma unroll
                for (int ks = 0; ks < 4; ++ks) { const bf16x8 bfr = *(const bf16x8*)(WUKV + (size_t)(nt * 16 + fr) * 128 + ks * 32 + fq * 8);
                    const bf16x8 a0 = *(const bf16x8*)(As + fr * 392 + 256 + ks * 32 + fq * 8), a1 = *(const bf16x8*)(As + (16 + fr) * 392 + 256 + ks * 32 + fq * 8);
                    c0 = __builtin_amdgcn_mfma_f32_16x16x32_bf16(a0, bfr, c0, 0, 0, 0); c1 = __builtin_amdgcn_mfma_f32_16x16x32_bf16(a1, bfr, c1, 0, 0, 0); }
                const int hk = nt >> 3, wt = nt & 7;
#pragma unroll
                for (int mt = 0; mt < 2; ++mt)
#pragma unroll
                    for (int j = 0; j < 4; ++j) { const int tl = mt * 16 + fq * 4 + j; const int key = keybase + ti.t0 + tl;
                        const float v = (mt ? c1[j] : c0[j]) * rs[tl * 2 + 1];
                        if (wt < 4) KB[((size_t)(ti.b * 4 + hk) * TT + key) * 96 + wt * 16 + fr] = (bf16)f2bf(v);
                        else VT[((size_t)(ti.b * 4 + hk) * 64 + (wt - 4) * 16 + fr) * TT + key] = (bf16)f2bf(v); } }
            { const int tl = tid >> 4, p = tid & 15, ax = p >> 3, f = p & 7; const int t = ti.t0 + tl;
                float x0 = kr[tl * 32 + ax * 16 + f], x1 = kr[tl * 32 + ax * 16 + 8 + f];
                if (!ti.isctx) { const float pos = ax == 0 ? (float)(t >> 6) : (float)(t & 63); const float ang = pos * __expf(-(float)f * (9.210340371976184f / 8.f));
                    float sn, cs; __sincosf(ang, &sn, &cs); const float y0 = x0 * cs - x1 * sn, y1 = x1 * cs + x0 * sn; x0 = y0; x1 = y1; }
                const bf16 b0 = (bf16)f2bf(x0), b1 = (bf16)f2bf(x1);
#pragma unroll
                for (int h = 0; h < 4; ++h) { bf16* kp = KB + ((size_t)(ti.b * 4 + h) * TT + keybase + t) * 96 + 64 + ax * 16 + f; kp[0] = b0; kp[8] = b1; } }
            __syncthreads();
        }
    }
}

__device__ __forceinline__ void attn_unit(unsigned char* lds, const bf16* QB, const bf16* KB, const bf16* VT, bf16* Y, int b, int h, int q0, int key_lo, int nkt, int tid) {
    const int lane = tid & 63, wave = tid >> 6, fr = lane & 15, fq = lane >> 4;
    const int bh = b * 4 + h;
    constexpr int KSTR = 104, VSTR = 72, KBUF = 64 * KSTR, VBUF = 64 * VSTR;
    bf16* Ks = (bf16*)lds;
    bf16* Vs = (bf16*)lds + 2 * KBUF;
    const int qw = q0 + wave * 32;
    bf16x8 qf[2][3];
#pragma unroll
    for (int qt = 0; qt < 2; ++qt)
#pragma unroll
        for (int ks = 0; ks < 3; ++ks) qf[qt][ks] = *(const bf16x8*)(QB + ((size_t)bh * TT + qw + qt * 16 + fr) * 96 + ks * 32 + fq * 8);
    float mrun[2] = {-1e30f, -1e30f}, lrun[2] = {0.f, 0.f};
    f32x4 o[4][2];
#pragma unroll
    for (int dt = 0; dt < 4; ++dt)
#pragma unroll
        for (int qt = 0; qt < 2; ++qt) o[dt][qt] = (f32x4){0.f, 0.f, 0.f, 0.f};
    const v4u* kg = (const v4u*)(KB + ((size_t)bh * TT + key_lo) * 96);
    const bf16* vg = VT + ((size_t)bh * 64 + (tid >> 3)) * TT + key_lo + (tid & 7) * 8;
    const int kc0 = tid, kc1 = 512 + tid;
    const int ko0 = (kc0 / 12) * KSTR + (kc0 % 12) * 8, ko1 = (kc1 / 12) * KSTR + (kc1 % 12) * 8, vo = (tid >> 3) * VSTR + (tid & 7) * 8;
    v4u rk0, rk1 = {0u, 0u, 0u, 0u}, rv;
    rk0 = kg[kc0]; if (tid < 256) rk1 = kg[kc1]; rv = *(const v4u*)vg;
    *(v4u*)(Ks + ko0) = rk0; if (tid < 256) *(v4u*)(Ks + ko1) = rk1; *(v4u*)(Vs + vo) = rv;
    __syncthreads();
    for (int kt = 0; kt < nkt; ++kt) {
        const int cur = kt & 1;
        if (kt + 1 < nkt) { const v4u* kn = kg + (size_t)(kt + 1) * 768; rk0 = kn[kc0]; if (tid < 256) rk1 = kn[kc1]; rv = *(const v4u*)(vg + (kt + 1) * 64); }
        const bf16* kb = Ks + cur * KBUF; const bf16* vb = Vs + cur * VBUF;
        f32x4 st[4][2];
#pragma unroll
        for (int k4 = 0; k4 < 4; ++k4) {
            st[k4][0] = (f32x4){0.f, 0.f, 0.f, 0.f}; st[k4][1] = st[k4][0];
#pragma unroll
            for (int ks = 0; ks < 3; ++ks) { const bf16x8 kf = *(const bf16x8*)(kb + (k4 * 16 + fr) * KSTR + ks * 32 + fq * 8);
                st[k4][0] = __builtin_amdgcn_mfma_f32_16x16x32_bf16(kf, qf[0][ks], st[k4][0], 0, 0, 0);
                st[k4][1] = __builtin_amdgcn_mfma_f32_16x16x32_bf16(kf, qf[1][ks], st[k4][1], 0, 0, 0); }
        }
        bf16x8 pb[2][2];
#pragma unroll
        for (int qt = 0; qt < 2; ++qt) {
            float mx = st[0][qt][0];
#pragma unroll
            for (int k4 = 0; k4 < 4; ++k4)
#pragma unroll
                for (int j = 0; j < 4; ++j) mx = fmaxf(mx, st[k4][qt][j]);
            mx = fmaxf(mx, __shfl_xor(mx, 16)); mx = fmaxf(mx, __shfl_xor(mx, 32));
            const float mn = fmaxf(mrun[qt], mx), alpha = __builtin_amdgcn_exp2f(mrun[qt] - mn); mrun[qt] = mn;
            float ls = 0.f;
#pragma unroll
            for (int k4 = 0; k4 < 4; ++k4)
#pragma unroll
                for (int j = 0; j < 4; ++j) { const float p = __builtin_amdgcn_exp2f(st[k4][qt][j] - mn); st[k4][qt][j] = p; ls += p; }
            lrun[qt] = lrun[qt] * alpha + ls;
#pragma unroll
            for (int dt = 0; dt < 4; ++dt) o[dt][qt] *= alpha;
#pragma unroll
            for (int u = 0; u < 2; ++u) { v4u w;
                w.x = pg8::cvt_pk_bf16(st[2 * u][qt][0], st[2 * u][qt][1]); w.y = pg8::cvt_pk_bf16(st[2 * u][qt][2], st[2 * u][qt][3]);
                w.z = pg8::cvt_pk_bf16(st[2 * u + 1][qt][0], st[2 * u + 1][qt][1]); w.w = pg8::cvt_pk_bf16(st[2 * u + 1][qt][2], st[2 * u + 1][qt][3]);
                pb[u][qt] = __builtin_bit_cast(bf16x8, w); }
        }
#pragma unroll
        for (int dt = 0; dt < 4; ++dt)
#pragma unroll
            for (int u = 0; u < 2; ++u) {
                const v2u lo = *(const v2u*)(vb + (dt * 16 + fr) * VSTR + 32 * u + 4 * fq), hi = *(const v2u*)(vb + (dt * 16 + fr) * VSTR + 32 * u + 16 + 4 * fq);
                v4u vw; vw.x = lo.x; vw.y = lo.y; vw.z = hi.x; vw.w = hi.y;
                const bf16x8 va = __builtin_bit_cast(bf16x8, vw);
                o[dt][0] = __builtin_amdgcn_mfma_f32_16x16x32_bf16(va, pb[u][0], o[dt][0], 0, 0, 0);
                o[dt][1] = __builtin_amdgcn_mfma_f32_16x16x32_bf16(va, pb[u][1], o[dt][1], 0, 0, 0);
            }
        if (kt + 1 < nkt) { const int nb = cur ^ 1; *(v4u*)(Ks + nb * KBUF + ko0) = rk0; if (tid < 256) *(v4u*)(Ks + nb * KBUF + ko1) = rk1; *(v4u*)(Vs + nb * VBUF + vo) = rv; }
        __syncthreads();
    }
#pragma unroll
    for (int qt = 0; qt < 2; ++qt) {
        float lt = lrun[qt]; lt += __shfl_xor(lt, 16); lt += __shfl_xor(lt, 32);
        const float inv = 1.f / lt;
        const int q = qw + qt * 16 + fr;
        const size_t row = q < TLEN ? (size_t)b * TLEN + q : (size_t)NLAT + b * CTXL + (q - TLEN);
#pragma unroll
        for (int dt = 0; dt < 4; ++dt) { const f32x4 v = o[dt][qt] * inv; v2u w; w.x = pk2(v[0], v[1]); w.y = pk2(v[2], v[3]);
            *(v2u*)(Y + row * DM + 768 + h * 64 + dt * 16 + fq * 4) = w; }
    }
}
__device__ __forceinline__ void lru_prefix(int bd, int tid) {
    unsigned char* ws = karg_ws();
    if (tid >= 256) return;
    const int ch = tid, b = bd >> 1, d = bd & 1;
    const float* __restrict__ SA = (const float*)(ws + M_SEGA); const float* __restrict__ SB = (const float*)(ws + M_SEGB); float* __restrict__ H0 = (float*)(ws + M_H0);
    const int ctile0 = 512 + b * 8, ltile0 = b * 256;
#define LRU_TILE(i_) ((i_) < 8 ? ctile0 + (d ? 7 - (i_) : (i_)) : ltile0 + (d ? 255 - ((i_) - 8) : ((i_) - 8)))
    float hst = 0.f;
    float ca[24], cb[24], na[24], nb[24];
#pragma unroll
    for (int k = 0; k < 24; ++k) { const size_t o = (size_t)(LRU_TILE(k) * 2 + d) * 256 + ch; ca[k] = SA[o]; cb[k] = SB[o]; }
    for (int i0 = 0; i0 < 264; i0 += 24) {
        if (i0 + 24 < 264) {
#pragma unroll
            for (int k = 0; k < 24; ++k) { const size_t o = (size_t)(LRU_TILE(i0 + 24 + k) * 2 + d) * 256 + ch; na[k] = SA[o]; nb[k] = SB[o]; } }
        float hv[24];
#pragma unroll
        for (int k = 0; k < 24; ++k) { hv[k] = hst; hst = ca[k] * hst + cb[k]; }
#pragma unroll
        for (int k = 0; k < 24; ++k) H0[(size_t)(LRU_TILE(i0 + k) * 2 + d) * 256 + ch] = hv[k];
#pragma unroll
        for (int k = 0; k < 24; ++k) { ca[k] = na[k]; cb[k] = nb[k]; }
    }
#undef LRU_TILE
}
__device__ __forceinline__ void lru_rescan(const Args& a, int l, unsigned char* lds, int tile, int tid) {
    unsigned char* ws = karg_ws();
    const int ch = tid & 255, d = tid >> 8;
    const int row0 = tile * 32;
    float hst = ((const float*)(ws + M_H0))[(size_t)(tile * 2 + d) * 256 + ch];
    const float lam = IN(22)[(l * 2 + d) * 256 + ch];
    const float cch = -8.f * log1pf(__expf(-lam));
    const bf16* LR = (const bf16*)(ws + M_LR0 + (size_t)d * A8); const bf16* LIX = (const bf16*)(ws + M_LIX0 + (size_t)d * A8);
    float* hs = (float*)lds;
#pragma unroll 16
    for (int tt = 0; tt < 32; ++tt) { const int t = d ? 31 - tt : tt; const size_t o = (size_t)(row0 + t) * 256 + ch;
        const float al = __expf(cch * bf2f(LR[o])); const float bb = sqrtf(fmaxf(1.f - al * al, 0.f)) * bf2f(LIX[o]);
        hst = al * hst + bb; hs[(d * 32 + t) * 256 + ch] = hst; }
    __syncthreads();
    const bf16* U = (const bf16*)(ws + OFF_HU); bf16* Y = (bf16*)(ws + OFF_XMY);
#pragma unroll 8
    for (int tt = 0; tt < 16; ++tt) { const int t = d * 16 + tt;
        const float y = (hs[t * 256 + ch] + hs[(32 + t) * 256 + ch]) * geluf_(bf2f(U[(size_t)(row0 + t) * UC + 768 + ch]));
        Y[(size_t)(row0 + t) * DM + 256 + ch] = (bf16)f2bf(y); }
    __syncthreads();
}
__device__ __forceinline__ void phase_m2(const Args& a, int l, unsigned char* lds, int G, int bid, int tid) {
    unsigned char* ws = karg_ws();
    const bf16* QB = (const bf16*)(ws + M_QB); const bf16* KB = (const bf16*)(ws + M_KB); const bf16* VT = (const bf16*)(ws + M_VT);
    bf16* Y = (bf16*)(ws + OFF_XMY);
    const int nunits = (l == 0) ? 264 : 256;
    for (int u = bid; u < nunits; u += G) {
        if (u < 256) attn_unit(lds, QB, KB, VT, Y, u >> 7, (u >> 5) & 3, (u & 31) * 256, 0, 132, tid);
        else attn_unit(lds, QB, KB, VT, Y, (u - 256) >> 2, (u - 256) & 3, TLEN, TLEN, 4, tid);
    }
    if (bid >= G - 4) lru_prefix(bid - (G - 4), tid);
}

__device__ __forceinline__ void phase_m3(const Args& a, int l, unsigned char* lds, int G, int bid, int tid) {
    unsigned char* ws = karg_ws();
    const bf16* U = (const bf16*)(ws + OFF_HU);
    const int lane = tid & 63, ch = tid & 255, part = tid >> 8;
    const float* mup = IN(23) + l * 1024; const float* mun = IN(24) + l * 1024;
    bf16* RR = (bf16*)(ws + M_RR); bf16* KKo = (bf16*)(ws + M_KK); bf16* VV = (bf16*)(ws + M_VV); bf16* GC = (bf16*)(ws + M_GC);
    float* kl = (float*)lds;
    float* kkn = (float*)(lds + 32768);
    bf16* twb = (bf16*)(lds + 65536);
    bf16* tab = (bf16*)(lds + 70144);
    bf16* tgb = (bf16*)(lds + 74752);
    for (int pass = 0; pass < 2; ++pass)
    for (int tile = (pass == 0 ? bid : (bid < 48 ? 512 + bid / 3 : NTILE)); tile < (pass == 0 ? 512 : NTILE); tile += (pass == 0 ? G : NTILE)) {
        const int mask = pass == 0 ? 7 : ((1 << (bid % 3)) & (l == 1 ? 6 : 7));
        const TileInfo ti = tile_info(tile);
        const int row0 = tile * 32;
        if (mask & 1) lru_rescan(a, l, lds, tile, ltid());
        if (mask & 6) {
        {
            const int tid2 = ltid(); const int chunk = tid2 & 127, tg8 = tid2 >> 7, c0 = chunk * 8;
            const bf16* ub = U + (size_t)row0 * UC + 1024 + c0;
            v4u rw[10];
#pragma unroll
            for (int q = 0; q < 10; ++q) { const int tl = tg8 * 8 + q - 1; const int t = ti.t0 + tl;
                rw[q] = (t >= 0 && t < ti.seqlen) ? *(const v4u*)(ub + (ptrdiff_t)tl * UC) : (v4u){0u, 0u, 0u, 0u}; }
            const f32x4 mp0 = *(const f32x4*)(mup + c0), mp1 = *(const f32x4*)(mup + c0 + 4), mn0 = *(const f32x4*)(mun + c0), mn1 = *(const f32x4*)(mun + c0 + 4);
            const float mp[8] = {mp0[0], mp0[1], mp0[2], mp0[3], mp1[0], mp1[1], mp1[2], mp1[3]}, mn[8] = {mn0[0], mn0[1], mn0[2], mn0[3], mn1[0], mn1[1], mn1[2], mn1[3]};
#pragma unroll
            for (int q = 0; q < 8; ++q) { const int tl = tg8 * 8 + q; float ts[8];
#pragma unroll
                for (int e = 0; e < 8; ++e) { const unsigned wm = rw[q][e >> 1], w0 = rw[q + 1][e >> 1], wn = rw[q + 2][e >> 1];
                    const float um = (e & 1) ? __uint_as_float(wm & 0xffff0000u) : __uint_as_float(wm << 16);
                    const float u0 = (e & 1) ? __uint_as_float(w0 & 0xffff0000u) : __uint_as_float(w0 << 16);
                    const float un = (e & 1) ? __uint_as_float(wn & 0xffff0000u) : __uint_as_float(wn << 16);
                    ts[e] = u0 + mp[e] * (um - u0) + mn[e] * (un - u0); }
                if (chunk >= 32 && chunk < 64) { float* kp = kl + tl * 256 + (c0 - 256); *(f32x4*)kp = (f32x4){ts[0], ts[1], ts[2], ts[3]}; *(f32x4*)(kp + 4) = (f32x4){ts[4], ts[5], ts[6], ts[7]}; }
                else {
                    if (chunk >= 96 && chunk < 104) {
#pragma unroll
                        for (int e = 0; e < 8; ++e) ts[e] = tanhf_(ts[e]); }
                    if (chunk >= 112) {
#pragma unroll
                        for (int e = 0; e < 8; ++e) ts[e] = sigm(ts[e]); }
                    v4u o; o.x = pk2(ts[0], ts[1]); o.y = pk2(ts[2], ts[3]); o.z = pk2(ts[4], ts[5]); o.w = pk2(ts[6], ts[7]);
                    if (chunk < 32) *(v4u*)(RR + (size_t)(row0 + tl) * 256 + c0) = o;
                    else if (chunk < 96) *(v4u*)(VV + (size_t)(row0 + tl) * 256 + (c0 - 512)) = o;
                    else if (chunk < 104) *(v4u*)(twb + tl * 72 + (c0 - 768)) = o;
                    else if (chunk < 112) *(v4u*)(tab + tl * 72 + (c0 - 832)) = o;
                    else *(v4u*)(tgb + tl * 136 + (c0 - 896)) = o; }
            }
        }
        __syncthreads();
        {
            const int tid2 = ltid(); const int ch = tid2 & 255, pt = tid2 >> 8; const float kkc = IN(30)[l * 256 + ch];
#pragma unroll 4
            for (int q = 0; q < 16; ++q) { const int t = pt * 16 + q; const float kr = kl[t * 256 + ch] * kkc; const float nrm = wave_sum(kr * kr);
                const float kk = kr * rsqrtf(fmaxf(nrm, 1e-24f)); kkn[t * 256 + ch] = kk; KKo[(size_t)(row0 + t) * 256 + ch] = (bf16)f2bf(kk); }
        }
        __syncthreads();
        {
            const int tid2 = ltid(); const int ln = tid2 & 63, wv = __builtin_amdgcn_readfirstlane(tid2 >> 6), fr = ln & 15, fq = ln >> 4;
            const bf16* WUPt = (const bf16*)(ws + W_WUP); const bf16* AUPt = (const bf16*)(ws + W_AUP); const bf16* GUPt = (const bf16*)(ws + W_GUP);
            bf16x8 aw[2][2], aa[2][2];
#pragma unroll
            for (int mt = 0; mt < 2; ++mt)
#pragma unroll
                for (int ks = 0; ks < 2; ++ks) { aw[mt][ks] = *(const bf16x8*)(twb + (mt * 16 + fr) * 72 + ks * 32 + fq * 8); aa[mt][ks] = *(const bf16x8*)(tab + (mt * 16 + fr) * 72 + ks * 32 + fq * 8); }
#pragma unroll 1
            for (int dn = 0; dn < 4; ++dn) { const int d = dn >> 1, nt = wv * 2 + (dn & 1), ch = nt * 16 + fr;
                if (!((mask >> (1 + d)) & 1)) continue;
                f32x4 cw[2], ca[2];
#pragma unroll
                for (int mt = 0; mt < 2; ++mt) { cw[mt] = (f32x4){0.f, 0.f, 0.f, 0.f}; ca[mt] = cw[mt]; }
#pragma unroll
                for (int ks = 0; ks < 2; ++ks) { const bf16x8 bw = *(const bf16x8*)(WUPt + ((size_t)d * 256 + ch) * 64 + ks * 32 + fq * 8), ba = *(const bf16x8*)(AUPt + ((size_t)d * 256 + ch) * 64 + ks * 32 + fq * 8);
#pragma unroll
                    for (int mt = 0; mt < 2; ++mt) { cw[mt] = __builtin_amdgcn_mfma_f32_16x16x32_bf16(aw[mt][ks], bw, cw[mt], 0, 0, 0); ca[mt] = __builtin_amdgcn_mfma_f32_16x16x32_bf16(aa[mt][ks], ba, ca[mt], 0, 0, 0); } }
                const float w0 = IN(25)[(l * 2 + d) * 256 + ch], a0 = IN(27)[(l * 2 + d) * 256 + ch], kac = IN(31)[l * 256 + ch];
                float* WW = (float*)(ws + M_WW) + (size_t)d * NR * 256; bf16* BB = (bf16*)(ws + M_BB + (size_t)d * A8); bf16* KD = (bf16*)(ws + M_KD + (size_t)d * A8);
#pragma unroll
                for (int mt = 0; mt < 2; ++mt)
#pragma unroll
                    for (int j = 0; j < 4; ++j) { const int t = mt * 16 + fq * 4 + j; const size_t o = (size_t)(row0 + t) * 256 + ch;
                        const float e = sigm(w0 + cw[mt][j]) * 0.6065306597126334f;
                        const float av = sigm(a0 + ca[mt][j]);
                        WW[o] = __expf(-e);
                        KD[o] = (bf16)f2bf(kl[t * 256 + ch] * (1.f + (av - 1.f) * kac));
                        BB[o] = (bf16)f2bf(kkn[t * 256 + ch] * av); }
            }
#pragma unroll 1
            for (int nl = 0; nl < 2; ++nl) { const int ch = (wv * 2 + nl) * 16 + fr;
                if (!(mask & 4)) continue;
                f32x4 cg[2] = {(f32x4){0.f, 0.f, 0.f, 0.f}, (f32x4){0.f, 0.f, 0.f, 0.f}};
#pragma unroll
                for (int ks = 0; ks < 4; ++ks) { const bf16x8 bg = *(const bf16x8*)(GUPt + (size_t)ch * 128 + ks * 32 + fq * 8);
#pragma unroll
                    for (int mt = 0; mt < 2; ++mt) { const bf16x8 ag = *(const bf16x8*)(tgb + (mt * 16 + fr) * 136 + ks * 32 + fq * 8); cg[mt] = __builtin_amdgcn_mfma_f32_16x16x32_bf16(ag, bg, cg[mt], 0, 0, 0); } }
#pragma unroll
                for (int mt = 0; mt < 2; ++mt)
#pragma unroll
                    for (int j = 0; j < 4; ++j) GC[(size_t)(row0 + mt * 16 + fq * 4 + j) * 256 + ch] = (bf16)f2bf(cg[mt][j]);
            }
        }
        __syncthreads();
        }
    }
}

typedef const unsigned cu32;
typedef const float cf32;
__device__ __forceinline__ int chain_row(int b, int d, int tau) {
    return tau < CTXL ? (NLAT + b * CTXL + (d ? CTXL - 1 - tau : tau)) : (b * TLEN + (d ? TLEN - 1 - (tau - CTXL) : (tau - CTXL)));
}
template <int MODE>
__device__ __forceinline__ void rwkv_steps(float (&S)[64], int b, int h, int d, int tau0, int n, unsigned char* ws, int lane, float* wl) {
    const bf16* KKp = (const bf16*)(ws + M_KK); const bf16* RRp = (const bf16*)(ws + M_RR); const bf16* VVp = (const bf16*)(ws + M_VV);
    const float* WWp = (const float*)(ws + M_WW) + (size_t)d * NR * 256; const bf16* BBp = (const bf16*)(ws + M_BB + (size_t)d * A8); const bf16* KDp = (const bf16*)(ws + M_KD + (size_t)d * A8);
    float* YS = (float*)(ws + M_YS) + (size_t)d * NR * 256;
    float pk, pw, pb, pkd = 0.f, pr = 0.f, pv = 0.f; size_t poff;
#define RWKV_LOAD(s_) do { poff = (size_t)chain_row(b, d, tau0 + (s_)) * 256 + h * 64 + lane; pk = bf2f(KKp[poff]); pw = WWp[poff]; pb = bf2f(BBp[poff]); \
        if (MODE != 1) { pkd = bf2f(KDp[poff]); pv = bf2f(VVp[poff]); } if (MODE == 2) pr = bf2f(RRp[poff]); } while (0)
    RWKV_LOAD(0);
    for (int s = 0; s < n; ++s) {
        float* buf = wl + (s & 1) * 320;
        buf[lane] = pk; buf[64 + lane] = pw; buf[128 + lane] = pb;
        if (MODE != 1) buf[192 + lane] = pkd;
        if (MODE == 2) buf[256 + lane] = pr;
        const float vv = pv; const size_t yoff = poff;
        if (s + 1 < n) RWKV_LOAD(s + 1);
        float sa0 = 0.f, sa1 = 0.f, sa2 = 0.f, sa3 = 0.f;
#pragma unroll
        for (int i = 0; i < 64; i += 4) { const f32x4 k4 = *(const f32x4*)(buf + i);
            sa0 += S[i] * k4[0]; sa1 += S[i + 1] * k4[1]; sa2 += S[i + 2] * k4[2]; sa3 += S[i + 3] * k4[3]; }
        const float nsa = -((sa0 + sa1) + (sa2 + sa3));
        float y0 = 0.f, y1 = 0.f, y2 = 0.f, y3 = 0.f;
#pragma unroll
        for (int i = 0; i < 64; i += 4) { const f32x4 w4 = *(const f32x4*)(buf + 64 + i), b4 = *(const f32x4*)(buf + 128 + i);
            f32x4 t = nsa * b4;
            if (MODE != 1) { const f32x4 kd4 = *(const f32x4*)(buf + 192 + i); t += vv * kd4; }
            S[i] = S[i] * w4[0] + t[0]; S[i + 1] = S[i + 1] * w4[1] + t[1]; S[i + 2] = S[i + 2] * w4[2] + t[2]; S[i + 3] = S[i + 3] * w4[3] + t[3];
            if (MODE == 2) { const f32x4 r4 = *(const f32x4*)(buf + 256 + i); y0 += S[i] * r4[0]; y1 += S[i + 1] * r4[1]; y2 += S[i + 2] * r4[2]; y3 += S[i + 3] * r4[3]; } }
        if (MODE == 2) YS[yoff] = (y0 + y1) + (y2 + y3);
    }
#undef RWKV_LOAD
}
typedef float f32x2 __attribute__((ext_vector_type(2)));
__device__ __forceinline__ void rwkv_pass1(f32x2 (&SL)[32], f32x2 (&SI)[32], int b, int h, int d, int tau0, int n, unsigned char* ws, int lane, float* wl) {
    const bf16* KKp = (const bf16*)(ws + M_KK); const bf16* VVp = (const bf16*)(ws + M_VV); const bf16* RRp = (const bf16*)(ws + M_RR);
    const float* WWp = (const float*)(ws + M_WW) + (size_t)d * NR * 256; const bf16* BBp = (const bf16*)(ws + M_BB + (size_t)d * A8); const bf16* KDp = (const bf16*)(ws + M_KD + (size_t)d * A8);
    float* YS = (float*)(ws + M_YS) + (size_t)d * NR * 256; float* PR = (float*)(ws + M_PR) + (size_t)d * NR * 256;
    float pk, pw, pb, pkd, pv, pr; size_t poff;
#define RWKV_LOAD(s_) do { poff = (size_t)chain_row(b, d, tau0 + (s_)) * 256 + h * 64 + lane; pk = bf2f(KKp[poff]); pw = WWp[poff]; pb = bf2f(BBp[poff]); pkd = bf2f(KDp[poff]); pv = bf2f(VVp[poff]); pr = bf2f(RRp[poff]); } while (0)
    RWKV_LOAD(0);
    for (int s = 0; s < n; ++s) {
        float* buf = wl + (s & 1) * 320;
        buf[lane] = pk; buf[64 + lane] = pw; buf[128 + lane] = pb; buf[192 + lane] = pkd; buf[256 + lane] = pr;
        const float vv = pv; const size_t yoff = poff;
        if (s + 1 < n) RWKV_LOAD(s + 1);
        f32x2 aL0 = {0.f, 0.f}, aL1 = aL0, aI0 = aL0, aI1 = aL0;
#pragma unroll
        for (int q = 0; q < 16; ++q) { const f32x4 k4 = *(const f32x4*)(buf + 4 * q);
            aL0 += SL[2 * q] * k4.lo; aL1 += SL[2 * q + 1] * k4.hi; aI0 += SI[2 * q] * k4.lo; aI1 += SI[2 * q + 1] * k4.hi; }
        const f32x2 tL = aL0 + aL1, tI = aI0 + aI1;
        const float nsl = -(tL.x + tL.y), nsi = -(tI.x + tI.y);
        f32x2 yL0 = {0.f, 0.f}, yL1 = yL0, yI0 = yL0, yI1 = yL0;
#pragma unroll
        for (int q = 0; q < 16; ++q) {
            const f32x4 w4 = *(const f32x4*)(buf + 64 + 4 * q), b4 = *(const f32x4*)(buf + 128 + 4 * q), kd4 = *(const f32x4*)(buf + 192 + 4 * q), r4 = *(const f32x4*)(buf + 256 + 4 * q);
            const f32x4 tl = nsl * b4 + vv * kd4, tiv = nsi * b4;
            SL[2 * q] = SL[2 * q] * w4.lo + tl.lo; SL[2 * q + 1] = SL[2 * q + 1] * w4.hi + tl.hi;
            SI[2 * q] = SI[2 * q] * w4.lo + tiv.lo; SI[2 * q + 1] = SI[2 * q + 1] * w4.hi + tiv.hi;
            yL0 += SL[2 * q] * r4.lo; yL1 += SL[2 * q + 1] * r4.hi; yI0 += SI[2 * q] * r4.lo; yI1 += SI[2 * q + 1] * r4.hi; }
        const f32x2 yl = yL0 + yL1, yp = yI0 + yI1;
        YS[yoff] = yl.x + yl.y; PR[yoff] = yp.x + yp.y;
    }
#undef RWKV_LOAD
}
__device__ __forceinline__ void phase_m4(const Args& a, unsigned char* lds, int G, int bid, int tid) {
    const int lane = tid & 63, wave = __builtin_amdgcn_readfirstlane(tid >> 6), half = wave >> 2, tk = wave & 3;
    unsigned char* ws = karg_ws(); float* PL = (float*)(ws + M_PL);
    float* wl = (float*)lds + wave * 320;
    float* xch = (float*)lds + 8 * 320 + tk * 1024;
    float* ych = xch + 512;
    const bf16* KKp = (const bf16*)(ws + M_KK); const bf16* VVp = (const bf16*)(ws + M_VV); const bf16* RRp = (const bf16*)(ws + M_RR);
    for (int task0 = bid * 4; task0 < 16 * NSEG; task0 += G * 4) {
        const int task = task0 + tk; const int seg = task & (NSEG - 1), chain = task >> 6;
        const int d = chain & 1, h = (chain >> 1) & 3, b = chain >> 3;
        const float* WWp = (const float*)(ws + M_WW) + (size_t)d * NR * 256; const bf16* BBp = (const bf16*)(ws + M_BB + (size_t)d * A8); const bf16* KDp = (const bf16*)(ws + M_KD + (size_t)d * A8);
        float* YS = (float*)(ws + M_YS) + (size_t)d * NR * 256; float* PR = (float*)(ws + M_PR) + (size_t)d * NR * 256;
        f32x2 SL[16], SI[16]; int ln = lane; asm volatile("" : "+v"(ln));
#pragma unroll
        for (int i = 0; i < 16; ++i) { SL[i] = (f32x2){0.f, 0.f}; SI[i] = (f32x2){(32 * half + 2 * i == ln) ? 1.f : 0.f, (32 * half + 2 * i + 1 == ln) ? 1.f : 0.f}; }
        const int tau0 = seg * SEGLEN, cidx = h * 64 + 32 * half + (lane & 31);
        unsigned pp; float pw, pv; size_t rowoff, prevoff = 0;
        const int grp = lane >> 4, l15 = lane & 15, l31 = lane & 31;
        const unsigned* srcp = grp == 0 ? (const unsigned*)KKp : grp == 1 ? (const unsigned*)BBp : grp == 2 ? (const unsigned*)KDp : (const unsigned*)RRp;
#define M4_LOAD(s_) do { rowoff = (size_t)chain_row(b, d, tau0 + (s_)) * 256; pp = srcp[(rowoff + h * 64 + 32 * half) / 2 + l15]; \
            pw = (lane < 32) ? WWp[rowoff + cidx] : 0.f; pv = bf2f(VVp[rowoff + h * 64 + lane]); } while (0)
#define UNPK(u_) ((f32x2){__uint_as_float((u_) << 16), __uint_as_float((u_) & 0xffff0000u)})
        M4_LOAD(0);
        for (int s = 0; s < SEGLEN; ++s) {
            float* buf = wl + (s & 1) * 160; const unsigned* bufu = (const unsigned*)buf;
            ((unsigned*)buf)[lane] = pp; if (lane < 32) buf[64 + l31] = pw;
            const float vv = pv; const size_t yoff = rowoff + h * 64 + lane;
            if (s + 1 < SEGLEN) M4_LOAD(s + 1);
            f32x2 aL0 = {0.f, 0.f}, aL1 = aL0, aI0 = aL0, aI1 = aL0;
#pragma unroll
            for (int q = 0; q < 4; ++q) { const v4u k4 = *(const v4u*)(bufu + 4 * q);
                const f32x2 ka = UNPK(k4.x), kb = UNPK(k4.y), kc = UNPK(k4.z), kd_ = UNPK(k4.w);
                aL0 += SL[4 * q] * ka; aL1 += SL[4 * q + 1] * kb; aL0 += SL[4 * q + 2] * kc; aL1 += SL[4 * q + 3] * kd_;
                aI0 += SI[4 * q] * ka; aI1 += SI[4 * q + 1] * kb; aI0 += SI[4 * q + 2] * kc; aI1 += SI[4 * q + 3] * kd_; }
            const f32x2 tL = aL0 + aL1, tI = aI0 + aI1;
            float* xw = xch + (s & 1) * 256;
            xw[half * 128 + lane] = tL.x + tL.y; xw[half * 128 + 64 + lane] = tI.x + tI.y;
            __syncthreads();
            const float nsl = -(xw[lane] + xw[128 + lane]), nsi = -(xw[64 + lane] + xw[192 + lane]);
            if (s > 0) {
                const float* yr = ych + ((s - 1) & 1) * 256;
                if (half == 0) YS[prevoff] = yr[lane] + yr[128 + lane]; else PR[prevoff] = yr[64 + lane] + yr[192 + lane];
            }
            f32x2 yL0 = {0.f, 0.f}, yL1 = yL0, yI0 = yL0, yI1 = yL0;
#pragma unroll
            for (int q = 0; q < 4; ++q) {
                const f32x4 wa = *(const f32x4*)(buf + 64 + 8 * q), wb = *(const f32x4*)(buf + 68 + 8 * q);
                const v4u b4 = *(const v4u*)(bufu + 16 + 4 * q), d4 = *(const v4u*)(bufu + 32 + 4 * q), r4 = *(const v4u*)(bufu + 48 + 4 * q);
                const f32x2 w2[4] = {wa.lo, wa.hi, wb.lo, wb.hi};
                const unsigned bu[4] = {b4.x, b4.y, b4.z, b4.w}, du[4] = {d4.x, d4.y, d4.z, d4.w}, ru[4] = {r4.x, r4.y, r4.z, r4.w};
#pragma unroll
                for (int e = 0; e < 4; ++e) { const int j = 4 * q + e; const f32x2 b2 = UNPK(bu[e]), k2 = UNPK(du[e]), r2 = UNPK(ru[e]);
                    const f32x2 tl = nsl * b2 + vv * k2, tiv = nsi * b2;
                    SL[j] = SL[j] * w2[e] + tl; SI[j] = SI[j] * w2[e] + tiv;
                    if (e & 1) { yL1 += SL[j] * r2; yI1 += SI[j] * r2; } else { yL0 += SL[j] * r2; yI0 += SI[j] * r2; } }
            }
            const f32x2 yl = yL0 + yL1, yp = yI0 + yI1;
            float* yw = ych + (s & 1) * 256;
            yw[half * 128 + lane] = yl.x + yl.y; yw[half * 128 + 64 + lane] = yp.x + yp.y;
            prevoff = yoff;
        }
#undef M4_LOAD
#undef UNPK
        __syncthreads();
        { const float* yr = ych + ((SEGLEN - 1) & 1) * 256;
          if (half == 0) YS[prevoff] = yr[lane] + yr[128 + lane]; else PR[prevoff] = yr[64 + lane] + yr[192 + lane]; }
        float* o = PL + (((size_t)(chain * NSEG + seg) * 2) * 64 + lane) * 64 + 32 * half;
#pragma unroll
        for (int i = 0; i < 16; i += 2) { *(f32x4*)(o + 2 * i) = (f32x4){SL[i].x, SL[i].y, SL[i + 1].x, SL[i + 1].y}; *(f32x4*)(o + 4096 + 2 * i) = (f32x4){SI[i].x, SI[i].y, SI[i + 1].x, SI[i + 1].y}; }
        __syncthreads();
    }
}
__device__ __forceinline__ void phase_m5(const Args& a, unsigned char* lds, int G, int bid, int tid) {
    unsigned char* ws = karg_ws(); const float* PL = (const float*)(ws + M_PL); float* SI = (float*)(ws + M_SINIT);
    float* Sx = (float*)lds;
    const int lane = tid & 63, wv = __builtin_amdgcn_readfirstlane(tid >> 6), fr = lane & 15, fq = lane >> 4;
    const bool act = wv < 4;
    for (int u = bid; u < 64; u += G) {
        const int chain = u >> 2, row0 = (u & 3) * 16, col = (wv & 3) * 16 + fr;
        const float* Pg = PL + ((size_t)(chain * NSEG) * 2 + 1) * 4096; const float* Lg = PL + ((size_t)(chain * NSEG) * 2) * 4096;
        float* SIc = SI + (size_t)(chain * NSEG) * 4096;
        f32x4 cur = {0.f, 0.f, 0.f, 0.f}; f32x4 lv[3]; float pb[3][16];
#pragma unroll
        for (int q = 0; q < 3; ++q) { lv[q] = cur;
            if (act) { const float* Pn = Pg + (size_t)q * 8192; const float* Ln = Lg + (size_t)q * 8192;
#pragma unroll
                for (int ks = 0; ks < 16; ++ks) pb[q][ks] = Pn[(4 * ks + fq) * 64 + col];
#pragma unroll
                for (int j = 0; j < 4; ++j) lv[q][j] = Ln[(row0 + fq * 4 + j) * 64 + col]; } }
        for (int g0 = 0; g0 < NSEG - 1; g0 += 3) {
#pragma unroll
            for (int q = 0; q < 3; ++q) { const int g = g0 + q;
                if (act) {
#pragma unroll
                    for (int j = 0; j < 4; ++j) { SIc[(size_t)g * 4096 + (row0 + fq * 4 + j) * 64 + col] = cur[j]; Sx[(fq * 4 + j) * 68 + col] = cur[j]; }
                }
                __syncthreads();
                if (act) {
                    f32x4 acc = lv[q];
#pragma unroll
                    for (int ks = 0; ks < 16; ++ks) { const float av = Sx[fr * 68 + 4 * ks + fq]; acc = __builtin_amdgcn_mfma_f32_16x16x4f32(av, pb[q][ks], acc, 0, 0, 0); }
                    cur = acc;
                    if (g + 3 < NSEG - 1) { const float* Pn = Pg + (size_t)(g + 3) * 8192; const float* Ln = Lg + (size_t)(g + 3) * 8192;
#pragma unroll
                        for (int ks = 0; ks < 16; ++ks) pb[q][ks] = Pn[(4 * ks + fq) * 64 + col];
#pragma unroll
                        for (int j = 0; j < 4; ++j) lv[q][j] = Ln[(row0 + fq * 4 + j) * 64 + col]; }
                }
                __syncthreads();
            }
        }
        if (act) {
#pragma unroll
            for (int j = 0; j < 4; ++j) SIc[(size_t)(NSEG - 1) * 4096 + (row0 + fq * 4 + j) * 64 + col] = cur[j];
        }
    }
}
__device__ __forceinline__ void phase_m6(const Args& a, unsigned char* lds, int G, int bid, int tid) {
    const int lane = tid & 63, wave = __builtin_amdgcn_readfirstlane(tid >> 6);
    unsigned char* ws = karg_ws(); const float* SI = (const float*)(ws + M_SINIT);
    float* wl = (float*)lds + wave * 256;
    for (int task = bid * 8 + wave; task < 16 * (NSEG - 1); task += G * 8) {
        const int seg = 1 + task % (NSEG - 1), chain = task / (NSEG - 1);
        const int d = chain & 1, h = (chain >> 1) & 3, b = chain >> 3;
        float* YS = (float*)(ws + M_YS) + (size_t)d * NR * 256; const float* PR = (const float*)(ws + M_PR) + (size_t)d * NR * 256;
        f32x2 S0[32];
        const float* si = SI + ((size_t)(chain * NSEG + seg) * 64 + lane) * 64;
#pragma unroll
        for (int i = 0; i < 32; i += 2) { const f32x4 v = *(const f32x4*)(si + 2 * i); S0[i] = v.lo; S0[i + 1] = v.hi; }
        const int tau0 = seg * SEGLEN;
        size_t o[4]; float p[4], y[4];
#pragma unroll
        for (int k = 0; k < 4; ++k) { o[k] = (size_t)chain_row(b, d, tau0 + k) * 256 + h * 64 + lane; p[k] = PR[o[k]]; y[k] = YS[o[k]]; }
        for (int s = 0; s < SEGLEN; s += 4) {
            size_t c[4]; float yy[4];
#pragma unroll
            for (int k = 0; k < 4; ++k) { wl[k * 64 + lane] = p[k]; c[k] = o[k]; yy[k] = y[k]; }
            if (s + 4 < SEGLEN) {
#pragma unroll
                for (int k = 0; k < 4; ++k) { o[k] = (size_t)chain_row(b, d, tau0 + s + 4 + k) * 256 + h * 64 + lane; p[k] = PR[o[k]]; y[k] = YS[o[k]]; } }
#pragma unroll
            for (int k = 0; k < 4; k += 2) {
                f32x2 a0 = {0.f, 0.f}, a1 = a0, b0 = a0, b1 = a0;
#pragma unroll
                for (int q = 0; q < 16; ++q) { const f32x4 u = *(const f32x4*)(wl + k * 64 + 4 * q), w = *(const f32x4*)(wl + (k + 1) * 64 + 4 * q);
                    a0 += S0[2 * q] * u.lo; a1 += S0[2 * q + 1] * u.hi; b0 += S0[2 * q] * w.lo; b1 += S0[2 * q + 1] * w.hi; }
                const f32x2 ta = a0 + a1, tb = b0 + b1;
                yy[k] += ta.x + ta.y; yy[k + 1] += tb.x + tb.y;
            }
#pragma unroll
            for (int k = 0; k < 4; ++k) YS[c[k]] = yy[k];
            asm volatile("" ::: "memory");
        }
    }
}
__device__ __forceinline__ void phase_m7(const Args& a, int l, int gw, int NGW, int lane) {
    unsigned char* ws = karg_ws();
    const float* Y0 = (const float*)(ws + M_YS); const float* Y1 = Y0 + (size_t)NR * 256;
    const bf16* RR = (const bf16*)(ws + M_RR); const bf16* VV = (const bf16*)(ws + M_VV); const bf16* KD0 = (const bf16*)(ws + M_KD); const bf16* KD1 = (const bf16*)(ws + M_KD + A8);
    const bf16* GC = (const bf16*)(ws + M_GC); bf16* Y = (bf16*)(ws + OFF_XMY);
    for (int r = gw; r < NR; r += NGW) {
#pragma unroll
        for (int h = 0; h < 4; ++h) { const int c = h * 64 + lane; const size_t o = (size_t)r * 256 + c;
            const float ys = Y0[o] + Y1[o];
            const float mu = wave_sum(ys) * (1.f / 64.f); const float dv = ys - mu; const float var = wave_sum(dv * dv) * (1.f / 64.f);
            float ov = dv * rsqrtf(var + 64e-5f) * IN(33)[l * 256 + c] + IN(34)[l * 256 + c];
            const float rv = bf2f(RR[o]), rk = IN(32)[l * 256 + c], vv = bf2f(VV[o]);
            const float b0 = wave_sum(rv * bf2f(KD0[o]) * rk), b1 = wave_sum(rv * bf2f(KD1[o]) * rk);
            ov += (b0 + b1) * vv;
            Y[(size_t)r * DM + 512 + c] = (bf16)f2bf(ov * bf2f(GC[o])); }
    }
}

#define LAS __attribute__((address_space(3)))
#define XB_TMO      128
#define XB_XCNT(j)  (256  + 64 * (j))
#define XB_XSUB(j)  (1280 + 64 * (j))
#define XB_XGEN(j)  (2304 + 64 * (j))
#define XB_TOP      3328
#define XB_TOPGEN   3392
#define XCD_BAR_WORDS 3456
#define XB_SPIN_CAP (1u << 18)

__device__ __forceinline__ unsigned xb_ld(unsigned* p)              { return __hip_atomic_load(p, __ATOMIC_RELAXED, __HIP_MEMORY_SCOPE_AGENT); }
__device__ __forceinline__ unsigned xb_add(unsigned* p, unsigned v) { return __hip_atomic_fetch_add(p, v, __ATOMIC_RELAXED, __HIP_MEMORY_SCOPE_AGENT); }
__device__ __forceinline__ unsigned xb_xcc_id() { return (unsigned)__builtin_amdgcn_s_getreg((3 << 11) | 20) & 0xFu; }
#define XB_SPIN(cond, bar) do { unsigned _sp = 0; while (cond) { __builtin_amdgcn_s_sleep(1); \
    if ((++_sp & 255u) == 0u) { if (xb_ld(&(bar)[XB_TMO])) break; if (_sp > XB_SPIN_CAP) { atomicAdd(&(bar)[XB_TMO], 1u); break; } } } } while (0)

struct XcdBarrier {
    unsigned* bar; unsigned x;
    volatile LAS unsigned* st;
};

__device__ __forceinline__ XcdBarrier xcd_barrier_post(unsigned* bar, volatile LAS unsigned* st) {
    XcdBarrier b; b.bar = bar; b.x = xb_xcc_id(); b.st = st;
    if (threadIdx.x == 0) (void)xb_add(&bar[XB_XCNT(b.x)], 1u);
    return b;
}
__device__ __forceinline__ void xcd_barrier_complete(unsigned* bar, unsigned x, unsigned& nloc, unsigned& nx) {
    const unsigned G = gridDim.x * gridDim.y * gridDim.z;
    unsigned sum, cnt, mine, sp = 0u;
    for (;;) {
        sum = 0u; cnt = 0u; mine = 0u;
#pragma unroll
        for (unsigned j = 0; j < 16; ++j) { const unsigned c = xb_ld(&bar[XB_XCNT(j)]); sum += c; cnt += (c > 0u) ? 1u : 0u; mine = (j == x) ? c : mine; }
        if (sum == G) break;
        __builtin_amdgcn_s_sleep(1);
        if ((++sp & 255u) == 0u) { if (xb_ld(&bar[XB_TMO])) break; if (sp > XB_SPIN_CAP) { atomicAdd(&bar[XB_TMO], 1u); break; } }
    }
    nloc = mine > 0u ? mine : 1u; nx = cnt > 0u ? cnt : 1u;
}

__device__ __forceinline__ void xcd_barrier(const XcdBarrier& b) {
    asm volatile("s_waitcnt vmcnt(0)" ::: "memory");
    __syncthreads();
    if (threadIdx.x == 0) {
        unsigned* bar = b.bar;
        __builtin_amdgcn_s_waitcnt(0);
        unsigned nloc = b.st[0], nx = b.st[1];
        if (nloc == 0u) { xcd_barrier_complete(bar, b.x, nloc, nx); b.st[0] = nloc; b.st[1] = nx; }
        const unsigned old = xb_add(&bar[XB_XSUB(b.x)], 1u);
        const unsigned gen = old / nloc;
        if (old + 1u == (gen + 1u) * nloc) {
            __builtin_amdgcn_fence(__ATOMIC_RELEASE, "agent");
            asm volatile("s_waitcnt vmcnt(0)" ::: "memory");
            const unsigned og = xb_add(&bar[XB_TOP], 1u);
            const unsigned tg = og / nx;
            if (og + 1u == (tg + 1u) * nx) xb_add(&bar[XB_TOPGEN], 1u);
            else XB_SPIN(xb_ld(&bar[XB_TOPGEN]) == tg, bar);
            __builtin_amdgcn_fence(__ATOMIC_ACQUIRE, "agent");
            xb_add(&bar[XB_XGEN(b.x)], 1u);
            asm volatile("s_waitcnt vmcnt(0)" ::: "memory");
        } else {
            XB_SPIN(xb_ld(&bar[XB_XGEN(b.x)]) == gen, bar);
            __builtin_amdgcn_fence(__ATOMIC_ACQUIRE, "agent");
            asm volatile("s_waitcnt vmcnt(0)" ::: "memory");
        }
    }
    __syncthreads();
}

__global__ void __launch_bounds__(512, 2) mega(Args a) {
    extern __shared__ __attribute__((aligned(16))) unsigned char lds[];
    cg::grid_group grid = cg::this_grid();
    const int G = gridDim.x;
    PG8_LAS unsigned char* glds = (PG8_LAS unsigned char*)lds;
#define bid lbid()
#define tid ltid()
#define lane (ltid() & 63)
#define wave (__builtin_amdgcn_readfirstlane(ltid() >> 6))
#define gw (lbid() * 8 + __builtin_amdgcn_readfirstlane(ltid() >> 6))
#define NGW (G * 8)
    { volatile LAS unsigned* st0 = (volatile LAS unsigned*)((LAS unsigned char*)lds + 131072); if (threadIdx.x < 4) st0[threadIdx.x] = 0u; }
    __syncthreads();
    const XcdBarrier xbar = xcd_barrier_post((unsigned*)(karg_ws() + 229376), (volatile LAS unsigned*)((LAS unsigned char*)lds + 131072));
#define GSYNC() do { xcd_barrier(xbar); } while (0)

    phase_modgemv(a, (float*)lds, G, bid, tid);
    convert_weights(a, 0, (float*)(lds + 32768) + wave * (64 * 33), gw, NGW, lane, G, bid, tid);
    grid.sync();
#pragma clang loop unroll(full)
    for (int l = 0; l < 2; ++l) {
        if (l > 0) convert_weights(a, l, (float*)lds + wave * (64 * 33), gw, NGW, lane, G, bid, tid);
        phase_modulate(a, l, 0, gw, NGW, lane);
        GSYNC();
        for (int rp = 0; rp < REP_G1; ++rp)
        {
            unsigned char* ws = karg_ws(); float* outp = karg_out(); float* xctx = (float*)(ws + OFF_XCTX); bf16* XM = (bf16*)(ws + OFF_XMY); bf16* HU = (bf16*)(ws + OFF_HU); const float* modl = (const float*)(ws + OFF_MOD) + (size_t)l * 3 * 9216; (void)xctx; (void)XM; (void)HU; (void)modl; (void)outp;
            pg8::Gemm g{XM, (const bf16*)(ws + W_13A), NR, 2 * DFF, DM}; pg8::StaticOrder S; S.init(NR, 2 * DFF, G, bid);
            EpiSwiglu E{HU};
            pg8::gemm_phase<EpiSwiglu, pg8::StaticOrder, true, true>(glds, g, S, E);
        }
        GSYNC();
        {
            unsigned char* ws = karg_ws(); float* outp = karg_out(); float* xctx = (float*)(ws + OFF_XCTX); bf16* XM = (bf16*)(ws + OFF_XMY); bf16* HU = (bf16*)(ws + OFF_HU); const float* modl = (const float*)(ws + OFF_MOD) + (size_t)l * 3 * 9216; (void)xctx; (void)XM; (void)HU; (void)modl; (void)outp;
            pg8::Gemm g{HU, (const bf16*)(ws + W_2A), NR, DM, DFF}; pg8::StaticOrder S; S.init(NR, DM, G, bid);
            EpiResid E{outp, xctx, modl + 2 * 1024, 0.5f, l == 0 ? IN(0) : outp, l == 0 ? IN(2) : xctx};
            pg8::gemm_phase<EpiResid, pg8::StaticOrder, true, true>(glds, g, S, E);
        }
        GSYNC();
        phase_modulate(a, l, 1, gw, NGW, lane);
        GSYNC();
        {
            unsigned char* ws = karg_ws(); float* outp = karg_out(); float* xctx = (float*)(ws + OFF_XCTX); bf16* XM = (bf16*)(ws + OFF_XMY); bf16* HU = (bf16*)(ws + OFF_HU); const float* modl = (const float*)(ws + OFF_MOD) + (size_t)l * 3 * 9216; (void)xctx; (void)XM; (void)HU; (void)modl; (void)outp;
            pg8::Gemm g{XM, (const bf16*)(ws + W_IN), NR, UC, DM}; pg8::StaticOrder S; S.init(NR, UC, G, bid);
            EpiU E{HU, UC};
            pg8::gemm_phase<EpiU, pg8::StaticOrder, true, true>(glds, g, S, E);
        }
        GSYNC();
        for (int rp = 0; rp < REP_M1; ++rp) { phase_m1(a, l, lds, G, bid, tid);
        GSYNC(); }
        for (int rp = 0; rp < REP_M2; ++rp) { phase_m2(a, l, lds, G, bid, tid);
        GSYNC(); }
        for (int rp = 0; rp < REP_M3; ++rp) { phase_m3(a, l, lds, G, bid, tid);
        GSYNC(); }
        for (int rp = 0; rp < REP_SCAN; ++rp) { phase_m4(a, lds, G, bid, tid);
        GSYNC();
        phase_m5(a, lds, G, bid, tid);
        GSYNC();
        phase_m6(a, lds, G, bid, tid);
        GSYNC(); }
        phase_m7(a, l, gw, NGW, lane);
        GSYNC();
        {
            unsigned char* ws = karg_ws(); float* outp = karg_out(); float* xctx = (float*)(ws + OFF_XCTX); bf16* XM = (bf16*)(ws + OFF_XMY); bf16* HU = (bf16*)(ws + OFF_HU); const float* modl = (const float*)(ws + OFF_MOD) + (size_t)l * 3 * 9216; (void)xctx; (void)XM; (void)HU; (void)modl; (void)outp;
            const int MR = (l == 1) ? NLAT : NR;
            pg8::Gemm g{XM, (const bf16*)(ws + W_OUT), MR, DM, DM}; pg8::StaticOrder S; S.init(MR, DM, G, bid);
            EpiResid E{outp, xctx, modl + 5 * 1024, 1.0f, outp, xctx};
            pg8::gemm_phase<EpiResid, pg8::StaticOrder, true, true>(glds, g, S, E);
        }
        GSYNC();
        phase_modulate(a, l, 2, gw, NGW, lane);
        GSYNC();
        {
            unsigned char* ws = karg_ws(); float* outp = karg_out(); float* xctx = (float*)(ws + OFF_XCTX); bf16* XM = (bf16*)(ws + OFF_XMY); bf16* HU = (bf16*)(ws + OFF_HU); const float* modl = (const float*)(ws + OFF_MOD) + (size_t)l * 3 * 9216; (void)xctx; (void)XM; (void)HU; (void)modl; (void)outp;
            const int MR = (l == 1) ? NLAT : NR;
            pg8::Gemm g{XM, (const bf16*)(ws + W_13B), MR, 2 * DFF, DM}; pg8::StaticOrder S; S.init(MR, 2 * DFF, G, bid);
            EpiSwiglu E{HU};
            pg8::gemm_phase<EpiSwiglu, pg8::StaticOrder, true, true>(glds, g, S, E);
        }
        GSYNC();
        {
            unsigned char* ws = karg_ws(); float* outp = karg_out(); float* xctx = (float*)(ws + OFF_XCTX); bf16* XM = (bf16*)(ws + OFF_XMY); bf16* HU = (bf16*)(ws + OFF_HU); const float* modl = (const float*)(ws + OFF_MOD) + (size_t)l * 3 * 9216; (void)xctx; (void)XM; (void)HU; (void)modl; (void)outp;
            const int MR = (l == 1) ? NLAT : NR;
            pg8::Gemm g{HU, (const bf16*)(ws + W_2B), MR, DM, DFF}; pg8::StaticOrder S; S.init(MR, DM, G, bid);
            EpiResid E{outp, xctx, modl + 8 * 1024, 0.5f, outp, xctx};
            pg8::gemm_phase<EpiResid, pg8::StaticOrder, true, true>(glds, g, S, E);
        }
        GSYNC();
    }
    phase_final(a, gw, NGW, lane);
#undef bid
#undef tid
#undef lane
#undef wave
#undef gw
#undef NGW
}

extern "C" void kernel_launch(void* const* d_in, const int* in_sizes, int n_in, void* d_out, int out_size, void* d_ws, size_t ws_size, hipStream_t stream) {
    static int grid = 0;
    if (grid == 0) {
        int dev = 0, cus = 0, per_cu = 0;
        (void)hipGetDevice(&dev);
        (void)hipDeviceGetAttribute(&cus, hipDeviceAttributeMultiprocessorCount, dev);
        (void)hipFuncSetAttribute((const void*)mega, hipFuncAttributeMaxDynamicSharedMemorySize, LDS_BYTES);
        (void)hipOccupancyMaxActiveBlocksPerMultiprocessor(&per_cu, (const void*)mega, 512, LDS_BYTES);
        if (per_cu < 1) per_cu = 1;
        grid = cus * per_cu;
        if (n_in != 40 || ws_size < WS_NEED) { fprintf(stderr, "kernel_launch: unexpected n_in %d / ws %zu (need %zu)\n", n_in, ws_size, (size_t)WS_NEED); }
    }
    (void)hipMemsetAsync((char*)d_ws + OFF_MOD, 0, MOD_BYTES, stream);
    Args a{};
    for (int i = 0; i < 40; ++i) a.in[i] = (const float*)d_in[i];
    a.out = (float*)d_out; a.ws = (unsigned char*)d_ws;
    void* args[] = {&a};
    hipError_t e = hipLaunchCooperativeKernel((const void*)mega, dim3(grid), dim3(512), args, LDS_BYTES, stream);
    if (e != hipSuccess) fprintf(stderr, "cooperative launch failed: %s (grid %d)\n", hipGetErrorString(e), grid);
}
```

```cpp
#include <hip/hip_runtime.h>
#include <hip/hip_cooperative_groups.h>
#include <cstdio>
#include <cstdint>
namespace cg = cooperative_groups;
namespace pg8 {
#define PG8_LAS __attribute__((address_space(3)))
typedef unsigned short bf16_t;
typedef short bf16x8 __attribute__((ext_vector_type(8)));
typedef float f32x4 __attribute__((ext_vector_type(4)));
typedef unsigned u32x4 __attribute__((ext_vector_type(4)));
constexpr int BM = 256, BK = 64, HALF = 128, HTB = HALF * BK * 2  , STAGE_BYTES = 8 * HTB, NXCD = 8, WGM = 8;

__host__ __device__ __forceinline__ int lds_byte(int r, int c) { const int st = (r >> 4) * 2 + (c >> 5), rr = r & 15, cc = c & 31, ob = rr * 64 + cc * 2; return st * 1024 + (ob ^ (((ob >> 9) & 1) << 5)); }
__host__ __device__ __forceinline__ void stage_rc(int b, int& R, int& C) { const int st = b / 1024, sb = b % 1024, swz = sb ^ (((sb >> 9) & 1) << 5); R = (st >> 1) * 16 + swz / 64; C = (st & 1) * 32 + (swz % 64) / 2; }
__host__ __device__ __forceinline__ int perm32(int rho) { const int n = rho >> 4, i = rho & 15; return 8 * (i >> 2) + 4 * n + (i & 3); }

struct Unit { int pm, pn; };
struct Gemm { const bf16_t* A; const bf16_t* Bt; int M, N, K; };

struct StaticOrder {
    int nM, nN, nwg, G, c;
    __host__ __device__ void init(int M, int N, int G_, int c_) { nM = M / BM; nN = N / BM; nwg = nM * nN; G = G_; c = c_; }
    __host__ __device__ bool next(int i, Unit& u) const {
        const long L = (long)i * G + c; if (L >= nwg) return false;
        int wgid = (int)L; { const int q = nwg / NXCD, r = nwg % NXCD, xcd = wgid % NXCD, off = wgid / NXCD; wgid = (xcd < r ? xcd * (q + 1) : r * (q + 1) + (xcd - r) * q) + off; }
        const int nig = WGM * nN, gid = wgid / nig, fm = gid * WGM, gsz = (nM - fm) < WGM ? (nM - fm) : WGM;
        u.pm = fm + ((wgid % nig) % gsz); u.pn = (wgid % nig) / gsz; return true;
    }
    __device__ __forceinline__ void a_ready(const Unit&) const {}
    __device__ __forceinline__ void done(const Unit&) const {}
};

__device__ __forceinline__ unsigned cvt_pk_bf16(float lo, float hi) { unsigned r; asm volatile("v_cvt_pk_bf16_f32 %0, %1, %2" : "=v"(r) : "v"(lo), "v"(hi)); return r; }
typedef float f32x2 __attribute__((ext_vector_type(2)));
template <class Epi, class Sched, bool ALIGN_EPI = false, bool SP2 = false>
__device__ __forceinline__ void gemm_phase(PG8_LAS unsigned char* lds, const Gemm g, const Sched& S, const Epi& E) {
    int tid = threadIdx.x; asm volatile("" : "+v"(tid));
    const int wid = __builtin_amdgcn_readfirstlane(tid >> 6), lane = tid & 63, wr = wid >> 2, wc = wid & 3, fr = lane & 15, fq = lane >> 4;
    const int K = g.K, nt = K / BK;
    unsigned voffA[2], voffB[2];
#pragma unroll
    for (int i = 0; i < 2; ++i) { int R, C; stage_rc(tid * 16 + i * 8192, R, C); const int Rb = Epi::PERM ? ((R & ~31) + perm32(R & 31)) : R;
        voffA[i] = (unsigned)(R * K + C) * 2u; voffB[i] = (unsigned)(Rb * K + C) * 2u; }
    const size_t kstep = (size_t)(BK * 2);
    const size_t hstep = (size_t)HALF * K * 2;
    const size_t tstep = 2 * hstep;
    const unsigned ldsw = (unsigned)wid * 1024u;
    const int aoff = lds_byte(wr * 64 + fr, fq * 8), boff = lds_byte(wc * 32 + fr, fq * 8);
#define PG8_SA(b, h) (((b) * 2 + (h)) * HTB)
#define PG8_SB(b, h) ((4 + (b) * 2 + (h)) * HTB)
#define PG8_STAGE(bufoff, gbase, voff) do { _Pragma("unroll") for (int _i = 0; _i < 2; ++_i) \
        __builtin_amdgcn_global_load_lds((const unsigned*)((const char*)(gbase) + (voff)[_i]), (PG8_LAS unsigned*)(lds + (bufoff) + ldsw + _i * 8192), 16, 0, 0); } while (0)
#define PG8_LDA(dst, b, h) do { _Pragma("unroll") for (int m = 0; m < 4; ++m) _Pragma("unroll") for (int k = 0; k < 2; ++k) dst[m][k] = *(const PG8_LAS bf16x8*)(lds + PG8_SA(b, h) + aoff + m * 2048 + k * 1024); } while (0)
#define PG8_LDB(dst, b, h) do { _Pragma("unroll") for (int n = 0; n < 2; ++n) _Pragma("unroll") for (int k = 0; k < 2; ++k) dst[n][k] = *(const PG8_LAS bf16x8*)(lds + PG8_SB(b, h) + boff + n * 2048 + k * 1024); } while (0)
#define PG8_MMA(ai, bj, At, Bt) do { __builtin_amdgcn_s_setprio(1); _Pragma("unroll") for (int m = 0; m < 4; ++m) _Pragma("unroll") for (int n = 0; n < 2; ++n) _Pragma("unroll") for (int k = 0; k < 2; ++k) \
        acc[ai][bj][m][n] = __builtin_amdgcn_mfma_f32_16x16x32_bf16(Bt[n][k], At[m][k], acc[ai][bj][m][n], 0, 0, 0); __builtin_amdgcn_s_setprio(0); } while (0)
#define PG8_WAIT_V(n) asm volatile("s_waitcnt vmcnt(" #n ")" ::: "memory")
#define PG8_WAIT_L(n) asm volatile("s_waitcnt lgkmcnt(" #n ")" ::: "memory")
#define PG8_BAR __builtin_amdgcn_s_barrier()
#define PG8_SCHED __builtin_amdgcn_sched_barrier(0)
    Unit cur, nxt; int ui = 0;
    if (!S.next(0, cur)) return;
    f32x4 acc[2][2][4][2];
#pragma unroll
    for (int a = 0; a < 2; ++a)
#pragma unroll
        for (int b = 0; b < 2; ++b)
#pragma unroll
            for (int m = 0; m < 4; ++m)
#pragma unroll
                for (int n = 0; n < 2; ++n) acc[a][b][m][n] = (f32x4){0.f, 0.f, 0.f, 0.f};
    bf16x8 At[4][2], B0[2][2], B1[2][2];
    const char* cA = (const char*)g.A + (size_t)cur.pm * tstep; const char* cB = (const char*)g.Bt + (size_t)cur.pn * tstep;
    S.a_ready(cur);
    if constexpr (SP2) {
        PG8_STAGE(PG8_SB(0, 0), cB, voffB); PG8_STAGE(PG8_SB(0, 1), cB + hstep, voffB); PG8_STAGE(PG8_SA(0, 0), cA, voffA); PG8_STAGE(PG8_SA(0, 1), cA + hstep, voffA);
        if (wr == 1) PG8_BAR;
        PG8_WAIT_V(2); PG8_BAR;
        PG8_STAGE(PG8_SB(1, 0), cB + kstep, voffB); PG8_STAGE(PG8_SA(1, 0), cA + kstep, voffA); PG8_STAGE(PG8_SB(1, 1), cB + hstep + kstep, voffB);
        PG8_WAIT_V(6); PG8_BAR;
    } else {
        PG8_STAGE(PG8_SB(0, 0), cB, voffB); PG8_STAGE(PG8_SA(0, 0), cA, voffA); PG8_STAGE(PG8_SB(0, 1), cB + hstep, voffB); PG8_STAGE(PG8_SA(0, 1), cA + hstep, voffA);
        if (wr == 1) PG8_BAR;
        PG8_WAIT_V(4); PG8_BAR;
        PG8_STAGE(PG8_SB(1, 0), cB + kstep, voffB); PG8_STAGE(PG8_SA(1, 0), cA + kstep, voffA); PG8_STAGE(PG8_SB(1, 1), cB + hstep + kstep, voffB);
        PG8_WAIT_V(6); PG8_BAR;
    }
    for (;;) {
        const bool has_next = S.next(ui + 1, nxt);
        const char* nA = has_next ? (const char*)g.A + (size_t)nxt.pm * tstep : cA; const char* nB = has_next ? (const char*)g.Bt + (size_t)nxt.pn * tstep : cB;
        for (int t = 0; t < nt; t += 2) {
            const bool last = (t == nt - 2);
            const char* a1 = cA + (size_t)(t + 1) * kstep;
            const char* a2 = last ? nA : cA + (size_t)(t + 2) * kstep; const char* b2 = last ? nB : cB + (size_t)(t + 2) * kstep;
            const char* a3 = a2 + kstep; const char* b3 = b2 + kstep;
            if (last && has_next) S.a_ready(nxt);
            if constexpr (SP2) {
            PG8_LDB(B0, 0, 0); PG8_LDB(B1, 0, 1); PG8_SCHED; PG8_LDA(At, 0, 0); PG8_STAGE(PG8_SA(1, 1), a1 + hstep, voffA);
            PG8_WAIT_V(8); PG8_WAIT_L(0); PG8_BAR; PG8_MMA(0, 0, At, B0); PG8_MMA(0, 1, At, B1); PG8_BAR; PG8_SCHED;
            PG8_LDA(At, 0, 1); PG8_STAGE(PG8_SB(0, 0), b2, voffB); PG8_STAGE(PG8_SB(0, 1), b2 + hstep, voffB); PG8_STAGE(PG8_SA(0, 0), a2, voffA);
            PG8_WAIT_V(8); PG8_WAIT_L(0); PG8_BAR; PG8_MMA(1, 0, At, B0); PG8_MMA(1, 1, At, B1); PG8_BAR; PG8_SCHED;
            PG8_LDB(B0, 1, 0); PG8_LDB(B1, 1, 1); PG8_SCHED; PG8_LDA(At, 1, 0); PG8_STAGE(PG8_SA(0, 1), a2 + hstep, voffA);
            PG8_WAIT_V(8); PG8_WAIT_L(0); PG8_BAR; PG8_MMA(0, 0, At, B0); PG8_MMA(0, 1, At, B1); PG8_BAR; PG8_SCHED;
            PG8_LDA(At, 1, 1); PG8_STAGE(PG8_SB(1, 0), b3, voffB); PG8_STAGE(PG8_SB(1, 1), b3 + hstep, voffB); PG8_STAGE(PG8_SA(1, 0), a3, voffA);
            PG8_WAIT_V(8); PG8_WAIT_L(0); PG8_BAR; PG8_MMA(1, 0, At, B0); PG8_MMA(1, 1, At, B1); PG8_BAR; PG8_SCHED;
            } else {
            PG8_LDB(B0, 0, 0); PG8_SCHED; PG8_LDA(At, 0, 0); PG8_STAGE(PG8_SA(1, 1), a1 + hstep, voffA);
            PG8_WAIT_L(8); PG8_BAR; PG8_WAIT_L(0); PG8_MMA(0, 0, At, B0); PG8_BAR; PG8_SCHED;
            PG8_LDB(B1, 0, 1); PG8_STAGE(PG8_SB(0, 0), b2, voffB);
            PG8_BAR; PG8_WAIT_L(0); PG8_MMA(0, 1, At, B1); PG8_BAR;
            PG8_LDA(At, 0, 1); PG8_STAGE(PG8_SA(0, 0), a2, voffA);
            PG8_BAR; PG8_WAIT_L(0); PG8_MMA(1, 0, At, B0); PG8_BAR; PG8_SCHED;
            PG8_STAGE(PG8_SB(0, 1), b2 + hstep, voffB);
            PG8_WAIT_V(6); PG8_BAR; PG8_MMA(1, 1, At, B1); PG8_BAR;
            PG8_LDB(B0, 1, 0); PG8_SCHED; PG8_LDA(At, 1, 0); PG8_STAGE(PG8_SA(0, 1), a2 + hstep, voffA);
            PG8_WAIT_L(8); PG8_BAR; PG8_WAIT_L(0); PG8_MMA(0, 0, At, B0); PG8_BAR; PG8_SCHED;
            PG8_LDB(B1, 1, 1); PG8_STAGE(PG8_SB(1, 0), b3, voffB);
            PG8_BAR; PG8_WAIT_L(0); PG8_MMA(0, 1, At, B1); PG8_BAR;
            PG8_LDA(At, 1, 1); PG8_STAGE(PG8_SA(1, 0), a3, voffA);
            PG8_BAR; PG8_WAIT_L(0); PG8_MMA(1, 0, At, B0); PG8_BAR; PG8_SCHED;
            PG8_STAGE(PG8_SB(1, 1), b3 + hstep, voffB);
            PG8_WAIT_V(6); PG8_BAR; PG8_MMA(1, 1, At, B1); PG8_BAR;
            }
        }
        if constexpr (ALIGN_EPI) { if (wr == 0) PG8_BAR; }
        if constexpr (!Epi::AFTER_DRAIN) { E(acc, cur, wr, wc, fr, fq); S.done(cur); }
        if (!has_next) break;
#pragma unroll
        for (int a = 0; a < 2; ++a)
#pragma unroll
            for (int b = 0; b < 2; ++b)
#pragma unroll
                for (int m = 0; m < 4; ++m)
#pragma unroll
                    for (int n = 0; n < 2; ++n) acc[a][b][m][n] = (f32x4){0.f, 0.f, 0.f, 0.f};
        cur = nxt; cA = nA; cB = nB; ++ui;
        if constexpr (ALIGN_EPI) { if (wr == 1) PG8_BAR; }
    }
    PG8_WAIT_V(0);
    if constexpr (!ALIGN_EPI) { if (wr == 0) PG8_BAR; }
    PG8_BAR;
    if constexpr (Epi::AFTER_DRAIN) { E.fused(acc, cur, wr, wc, fr, fq, lds, wid, lane); S.done(cur); }
#undef PG8_SA
#undef PG8_SB
#undef PG8_STAGE
#undef PG8_LDA
#undef PG8_LDB
#undef PG8_MMA
#undef PG8_WAIT_V
#undef PG8_WAIT_L
#undef PG8_BAR
#undef PG8_SCHED
}
}

using pg8::f32x4; using pg8::bf16x8;
typedef unsigned short bf16;
typedef unsigned v4u __attribute__((ext_vector_type(4)));
typedef unsigned v2u __attribute__((ext_vector_type(2)));
typedef short s16x4 __attribute__((ext_vector_type(4)));

constexpr int DM = 1024, TLEN = 8192, CTXL = 256, TT = 8448, NLAT = 16384, NR = 16896, DFF = 2816, UC = 2560, NTILE = 528;
constexpr int NSEG = 64, SEGLEN = 132;
constexpr size_t MiB = 1u << 20;
constexpr size_t A8 = (size_t)NR * 256 * 2;
constexpr size_t OFF_MOD = 0, MOD_BYTES = 256 * 1024;
constexpr size_t OFF_XCTX = MiB / 4, OFF_XMY = 2 * MiB + MiB / 4, OFF_HU = 35 * MiB + MiB / 4, OFF_W = 126 * MiB, OFF_MIX = 167 * MiB, OFF_PR = 266 * MiB;
constexpr size_t W_13A = OFF_W, W_2A = OFF_W + 11 * MiB, W_13B = OFF_W + 16 * MiB + MiB / 2, W_2B = OFF_W + 27 * MiB + MiB / 2,
                 W_IN = OFF_W + 33 * MiB, W_OUT = OFF_W + 38 * MiB, W_UQ = OFF_W + 40 * MiB, W_UKV = OFF_W + 40 * MiB + 256 * 1024,
                 W_WUP = OFF_W + 40 * MiB + 384 * 1024, W_AUP = W_WUP + 65536, W_GUP = W_AUP + 65536, W_LWA = W_GUP + 65536, W_LWX = W_LWA + 65536;
constexpr size_t M_QB = OFF_MIX, M_KB = OFF_MIX + 12976128, M_VT = OFF_MIX + 25952256;
constexpr size_t M_LR0 = OFF_PR, M_LIX0 = OFF_PR + 2 * A8;
constexpr size_t M_SEGA = OFF_HU + 83 * MiB, M_SEGB = M_SEGA + MiB + MiB / 4, M_H0 = M_SEGB + MiB + MiB / 4;
constexpr size_t M_RR = OFF_MIX, M_KK = OFF_MIX + A8, M_VV = OFF_MIX + 2 * A8, M_WW = OFF_MIX + 3 * A8, M_BB = OFF_MIX + 7 * A8, M_KD = OFF_MIX + 9 * A8, M_GC = OFF_MIX + 11 * A8;
constexpr size_t M_YS = OFF_HU, M_PL = OFF_HU + 33 * MiB, M_SINIT = OFF_HU + 65 * MiB;
constexpr size_t M_PR = OFF_PR;
constexpr size_t WS_NEED = OFF_PR + 33 * MiB;
constexpr int LDS_BYTES = 131072 + 1024;
#ifndef REP_M1
#define REP_M1 1
#endif
#ifndef REP_M2
#define REP_M2 1
#endif
#ifndef REP_M3
#define REP_M3 1
#endif
#ifndef REP_SCAN
#define REP_SCAN 1
#endif
#ifndef REP_G1
#define REP_G1 1
#endif
constexpr float QSCALE = 0.10206207261596575f * 1.4426950408889634f;

struct Args { const float* in[40]; float* out; unsigned char* ws; };
typedef const __attribute__((address_space(4))) volatile unsigned long long kargq;
__device__ __forceinline__ const float* karg_in(int i) { kargq* p = (kargq*)__builtin_amdgcn_kernarg_segment_ptr(); return (const float*)p[i]; }
__device__ __forceinline__ float* karg_out() { kargq* p = (kargq*)__builtin_amdgcn_kernarg_segment_ptr(); return (float*)p[40]; }
__device__ __forceinline__ unsigned char* karg_ws() { kargq* p = (kargq*)__builtin_amdgcn_kernarg_segment_ptr(); return (unsigned char*)p[41]; }
#define IN(i) karg_in(i)
__device__ __forceinline__ int ltid() { int t = threadIdx.x; asm volatile("" : "+v"(t)); return t; }
__device__ __forceinline__ int lbid() { int t = blockIdx.x; asm volatile("" : "+s"(t)); return t; }
template <class T> __device__ __forceinline__ T* launder(T* p) { asm volatile("" : "+s"(p)); return p; }

__device__ __forceinline__ float bf2f(bf16 h) { return __uint_as_float((unsigned)h << 16); }
__device__ __forceinline__ unsigned f2bf(float f) { unsigned u = __float_as_uint(f); return (u + 0x7fffu + ((u >> 16) & 1u)) >> 16; }
__device__ __forceinline__ unsigned pk2(float lo, float hi) { return f2bf(lo) | (f2bf(hi) << 16); }
__device__ __forceinline__ float sigm(float x) { return __builtin_amdgcn_rcpf(1.f + __expf(-x)); }
__device__ __forceinline__ float siluf_(float x) { return x * __builtin_amdgcn_rcpf(1.f + __expf(-x)); }
__device__ __forceinline__ float tanhf_(float y) { return 1.f - 2.f * __builtin_amdgcn_rcpf(1.f + __expf(2.f * y)); }
__device__ __forceinline__ float geluf_(float x) { return 0.5f * x * (1.f + tanhf_(0.7978845608028654f * (x + 0.044715f * x * x * x))); }
__device__ __forceinline__ float wave_sum(float v) {
#pragma unroll
    for (int o = 1; o < 16; o <<= 1) v += __shfl_xor(v, o);
    auto a = __builtin_amdgcn_permlane16_swap(__float_as_uint(v), __float_as_uint(v), false, false); v = __uint_as_float(a[0]) + __uint_as_float(a[1]);
    auto b = __builtin_amdgcn_permlane32_swap(__float_as_uint(v), __float_as_uint(v), false, false); return __uint_as_float(b[0]) + __uint_as_float(b[1]);
}
struct TileInfo { int b, isctx, t0, seqbase, seqlen; };
__device__ __forceinline__ TileInfo tile_info(int tile) {
    TileInfo ti;
    if (tile < 512) { ti.b = tile >> 8; ti.isctx = 0; ti.t0 = (tile & 255) * 32; ti.seqbase = ti.b * TLEN; ti.seqlen = TLEN; }
    else { const int q = tile - 512; ti.b = q >> 3; ti.isctx = 1; ti.t0 = (q & 7) * 32; ti.seqbase = NLAT + ti.b * CTXL; ti.seqlen = CTXL; }
    return ti;
}

struct EpiSwiglu {
    static constexpr bool PERM = true, AFTER_DRAIN = false;
    bf16* H;
    __device__ __forceinline__ void operator()(const f32x4 (&acc)[2][2][4][2], const pg8::Unit& u, int wr, int wc, int fr, int fq) const {
        int pm = u.pm, pn = u.pn; asm volatile("" : "+s"(pm), "+s"(pn), "+s"(wr), "+s"(wc), "+v"(fr), "+v"(fq));
        bf16* tb = H + (size_t)pm * 256 * DFF + pn * 128;
        const unsigned loff = (unsigned)((wr * 64 + fr) * DFF + wc * 32 + 8 * fq);
#pragma unroll
        for (int ai = 0; ai < 2; ++ai)
#pragma unroll
            for (int m = 0; m < 4; ++m) {
                bf16* rowp = tb + (loff + (unsigned)((ai * 128 + m * 16) * DFF));
                const f32x4 g0 = acc[ai][0][m][0], g1 = acc[ai][0][m][1], u0 = acc[ai][1][m][0], u1 = acc[ai][1][m][1];
                v4u w;
                w.x = pg8::cvt_pk_bf16(siluf_(g0[0]) * u0[0], siluf_(g0[1]) * u0[1]); w.y = pg8::cvt_pk_bf16(siluf_(g0[2]) * u0[2], siluf_(g0[3]) * u0[3]);
                w.z = pg8::cvt_pk_bf16(siluf_(g1[0]) * u1[0], siluf_(g1[1]) * u1[1]); w.w = pg8::cvt_pk_bf16(siluf_(g1[2]) * u1[2], siluf_(g1[3]) * u1[3]);
                *(v4u*)rowp = w;
            }
    }
};
struct EpiU {
    static constexpr bool PERM = true, AFTER_DRAIN = false;
    bf16* O; int ldc;
    __device__ __forceinline__ void operator()(const f32x4 (&acc)[2][2][4][2], const pg8::Unit& u, int wr, int wc, int fr, int fq) const {
        int pm = u.pm, pn = u.pn; asm volatile("" : "+s"(pm), "+s"(pn), "+s"(wr), "+s"(wc), "+v"(fr), "+v"(fq));
        bf16* tb = O + (size_t)pm * 256 * ldc + pn * 256;
        const unsigned loff = (unsigned)((wr * 64 + fr) * ldc + wc * 32 + 8 * fq);
#pragma unroll
        for (int ai = 0; ai < 2; ++ai)
#pragma unroll
            for (int m = 0; m < 4; ++m) {
                bf16* rowp = tb + (loff + (unsigned)((ai * 128 + m * 16) * ldc));
#pragma unroll
                for (int bj = 0; bj < 2; ++bj) { const f32x4 v0 = acc[ai][bj][m][0], v1 = acc[ai][bj][m][1]; v4u w;
                    w.x = pg8::cvt_pk_bf16(v0[0], v0[1]); w.y = pg8::cvt_pk_bf16(v0[2], v0[3]); w.z = pg8::cvt_pk_bf16(v1[0], v1[1]); w.w = pg8::cvt_pk_bf16(v1[2], v1[3]);
                    *(v4u*)(rowp + bj * 128) = w; }
            }
    }
};
struct EpiResid {
    static constexpr bool PERM = false, AFTER_DRAIN = false;
    float* xlat; float* xctx; const float* gate; float coef; const float* slat; const float* sctx;
    __device__ __forceinline__ void operator()(const f32x4 (&acc)[2][2][4][2], const pg8::Unit& u, int wr, int wc, int fr, int fq) const {
        int pm = u.pm, pn = u.pn; asm volatile("" : "+s"(pm), "+s"(pn), "+s"(wr), "+s"(wc), "+v"(fr), "+v"(fq));
        const size_t toff = (pm < 64 ? (size_t)pm : (size_t)(pm - 64)) * 256 * DM + pn * 256;
        float* tb = (pm < 64 ? xlat : xctx) + toff; const float* sb = (pm < 64 ? slat : sctx) + toff;
        const float* g = gate + (pm < 64 ? (pm >> 5) : 2) * 9216 + pn * 256;
        const unsigned coff = (unsigned)(wc * 32 + 4 * fq), loff = (unsigned)((wr * 64 + fr) * DM) + coff;
        f32x4 gv[2][2];
#pragma unroll
        for (int bj = 0; bj < 2; ++bj)
#pragma unroll
            for (int n = 0; n < 2; ++n) gv[bj][n] = coef * *(const f32x4*)(g + (coff + (unsigned)(bj * 128 + n * 16)));
#pragma unroll
        for (int ai = 0; ai < 2; ++ai)
#pragma unroll
            for (int m = 0; m < 4; ++m) {
                float* xr = tb + (loff + (unsigned)((ai * 128 + m * 16) * DM)); const float* sr = sb + (loff + (unsigned)((ai * 128 + m * 16) * DM));
#pragma unroll
                for (int bj = 0; bj < 2; ++bj)
#pragma unroll
                    for (int n = 0; n < 2; ++n) { float* xp = xr + (bj * 128 + n * 16);
                        f32x4 xv = *(const f32x4*)(sr + (bj * 128 + n * 16)); xv += gv[bj][n] * acc[ai][bj][m][n]; *(f32x4*)xp = xv; }
                asm volatile("" ::: "memory");
            }
    }
};

__device__ __forceinline__ void phase_modgemv(const Args& a, float* red, int G, int bid, int tid) {
    const float* c = IN(1); const float* cctx = IN(3); const float* ada_w = IN(4); const float* ada_b = IN(5);
    float* mod = (float*)(karg_ws() + OFF_MOD);
    const int w = tid >> 6, lane = tid & 63;
    for (int u = bid; u < 576; u += G) {
        const int l = u / 288, rem = u % 288, jt = rem >> 3, ks = rem & 7;
        const int kb = ks * 128 + w * 16, j0 = jt * 256 + lane * 4;
        f32x4 acc0 = {0.f, 0.f, 0.f, 0.f}, acc1 = acc0, acc2 = acc0;
        for (int kk = 0; kk < 16; ++kk) { const int k = kb + kk;
            const float s0 = siluf_(c[k]), s1 = siluf_(c[1024 + k]), s2 = siluf_(cctx[k]);
            const f32x4 wv = *(const f32x4*)(ada_w + ((size_t)(l * 1024 + k)) * 9216 + j0);
            acc0 += s0 * wv; acc1 += s1 * wv; acc2 += s2 * wv; }
        float* rp = red + (w * 3) * 256 + lane * 4;
        *(f32x4*)rp = acc0; *(f32x4*)(rp + 256) = acc1; *(f32x4*)(rp + 512) = acc2;
        __syncthreads();
        for (int o = tid; o < 768; o += 512) { const int m = o >> 8, jj = o & 255; float s = 0.f;
#pragma unroll
            for (int ww = 0; ww < 8; ++ww) s += red[(ww * 3 + m) * 256 + jj];
            const int j = jt * 256 + jj; if (ks == 0) s += ada_b[l * 9216 + j];
            atomicAdd(&mod[(l * 3 + m) * 9216 + j], s); }
        __syncthreads();
    }
}
__device__ __forceinline__ void phase_copy(const Args& a, int G, int bid, int tid) {
    const f32x4* x4 = (const f32x4*)IN(0); f32x4* o4 = (f32x4*)karg_out();
    for (int i = bid * 512 + tid; i < NLAT * DM / 4; i += G * 512) o4[i] = x4[i];
    const f32x4* c4 = (const f32x4*)IN(2); f32x4* xc4 = (f32x4*)(karg_ws() + OFF_XCTX);
    for (int i = bid * 512 + tid; i < 512 * DM / 4; i += G * 512) xc4[i] = c4[i];
}
__device__ __forceinline__ int swiglu_map(int n) { return n < DFF ? ((n >> 7) * 256 + (n & 127)) : ((((n - DFF) >> 7) * 256) + 128 + ((n - DFF) & 127)); }
__device__ __forceinline__ void transpose_item(const float* W, int K, int N, bf16* WT, float* scr, int item, int lane, int mode, const float* kscale) {
    const int nblk = N / 32, kb = item / nblk, nb = item % nblk, k0 = 64 * kb, n0 = 32 * nb;
    float tv[32];
#pragma unroll
    for (int i = 0; i < 32; ++i) { const int kk = 2 * i + (lane >> 5); tv[i] = W[(size_t)(k0 + kk) * N + n0 + (lane & 31)]; }
#pragma unroll
    for (int i = 0; i < 32; ++i) { const int kk = 2 * i + (lane >> 5); float v = tv[i]; if (kscale) v *= kscale[k0 + kk]; scr[kk * 33 + (lane & 31)] = v; }
    __builtin_amdgcn_wave_barrier();
    const int c = lane & 7;
#pragma unroll
    for (int j = 0; j < 4; ++j) { const int n = (lane >> 3) + 8 * j; const float* s = scr + (8 * c) * 33 + n;
        v4u o; o.x = pk2(s[0 * 33], s[1 * 33]); o.y = pk2(s[2 * 33], s[3 * 33]); o.z = pk2(s[4 * 33], s[5 * 33]); o.w = pk2(s[6 * 33], s[7 * 33]);
        const int nn = n0 + n, drow = mode ? swiglu_map(nn) : nn;
        *(v4u*)(WT + (size_t)drow * K + k0 + 8 * c) = o; }
    __builtin_amdgcn_wave_barrier();
}
__device__ __forceinline__ void convert_weights(const Args& a, int l, float* scr, int gw, int NGW, int lane, int G, int bid, int tid) {
    constexpr int I13 = 16 * 176, I2 = 44 * 32, IIN = 16 * 77, IOUT = 16 * 32, IUQ = 4 * 12, IUKV = 2 * 16;
    constexpr int IEX = 80;
    constexpr int NIT = 2 * I13 + 2 * I2 + IIN + IOUT + IUQ + IUKV + IEX;
    unsigned char* ws = karg_ws();
    for (int it = gw; it < NIT; it += NGW) {
        int r = it;
        if (r < I13) { transpose_item(IN(6) + (size_t)l * DM * 2 * DFF, DM, 2 * DFF, (bf16*)(ws + W_13A), scr, r, lane, 1, nullptr); continue; } r -= I13;
        if (r < I13) { transpose_item(IN(8) + (size_t)l * DM * 2 * DFF, DM, 2 * DFF, (bf16*)(ws + W_13B), scr, r, lane, 1, nullptr); continue; } r -= I13;
        if (r < I2) { transpose_item(IN(7) + (size_t)l * DFF * DM, DFF, DM, (bf16*)(ws + W_2A), scr, r, lane, 0, nullptr); continue; } r -= I2;
        if (r < I2) { transpose_item(IN(9) + (size_t)l * DFF * DM, DFF, DM, (bf16*)(ws + W_2B), scr, r, lane, 0, nullptr); continue; } r -= I2;
        if (r < IIN) { transpose_item(IN(10) + (size_t)l * DM * 2464, DM, 2464, (bf16*)(ws + W_IN), scr, r, lane, 0, nullptr); continue; } r -= IIN;
        if (r < IOUT) { transpose_item(IN(11) + (size_t)l * DM * DM, DM, DM, (bf16*)(ws + W_OUT), scr, r, lane, 0, nullptr); continue; } r -= IOUT;
        if (r < IUQ) { transpose_item(IN(36) + (size_t)l * 256 * 384, 256, 384, (bf16*)(ws + W_UQ), scr, r, lane, 0, IN(35) + l * 256); continue; } r -= IUQ;
        if (r < IUKV) { transpose_item(IN(38) + (size_t)l * 128 * 512, 128, 512, (bf16*)(ws + W_UKV), scr, r, lane, 0, IN(37) + l * 128); continue; } r -= IUKV;
        if (r < 16) { const int d = r >> 3; transpose_item(IN(26) + (size_t)(l * 2 + d) * 64 * 256, 64, 256, (bf16*)(ws + W_WUP) + d * 256 * 64, scr, r & 7, lane, 0, nullptr); continue; } r -= 16;
        if (r < 16) { const int d = r >> 3; transpose_item(IN(28) + (size_t)(l * 2 + d) * 64 * 256, 64, 256, (bf16*)(ws + W_AUP) + d * 256 * 64, scr, r & 7, lane, 0, nullptr); continue; } r -= 16;
        if (r < 16) { transpose_item(IN(29) + (size_t)l * 128 * 256, 128, 256, (bf16*)(ws + W_GUP), scr, r, lane, 0, nullptr); continue; } r -= 16;
        if (r < 16) { const int m = r >> 1; transpose_item(IN(18) + (size_t)(l * 8 + m) * 4096, 64, 64, (bf16*)(ws + W_LWA) + m * 4096, scr, r & 1, lane, 0, nullptr); continue; } r -= 16;
        { const int m = r >> 1; transpose_item(IN(20) + (size_t)(l * 8 + m) * 4096, 64, 64, (bf16*)(ws + W_LWX) + m * 4096, scr, r & 1, lane, 0, nullptr); }
    }
    v4u z = {0u, 0u, 0u, 0u}; v4u* zp = (v4u*)(ws + W_IN + (size_t)2464 * DM * 2);
    for (int i = bid * 512 + tid; i < 96 * DM * 2 / 16; i += G * 512) zp[i] = z;
}
__device__ __forceinline__ void phase_modulate(const Args& a, int l, int which, int gw, int NGW, int lane) {
    unsigned char* ws = karg_ws(); const float* outp = karg_out();
    const bool first = (l == 0 && which == 0);
    const float* srcl = first ? IN(0) : outp; const float* srcc = first ? IN(2) : (const float*)(ws + OFF_XCTX);
    const float* mod = (const float*)(ws + OFF_MOD) + (size_t)l * 3 * 9216;
    bf16* XM = (bf16*)(ws + OFF_XMY);
    for (int r = gw; r < NR; r += NGW) {
        const float* xr = r < NLAT ? srcl + (size_t)r * DM : srcc + (size_t)(r - NLAT) * DM;
        const float* mm = mod + (r < NLAT ? (r >> 13) : 2) * 9216 + which * 3 * 1024;
        f32x4 v[4]; float ss = 0.f;
#pragma unroll
        for (int j = 0; j < 4; ++j) { v[j] = *(const f32x4*)(xr + 4 * lane + 256 * j); ss += (v[j][0] * v[j][0] + v[j][1] * v[j][1]) + (v[j][2] * v[j][2] + v[j][3] * v[j][3]); }
        const float rstd = rsqrtf(wave_sum(ss) * (1.f / DM) + 1e-6f);
#pragma unroll
        for (int j = 0; j < 4; ++j) { const int c = 4 * lane + 256 * j; const f32x4 sh = *(const f32x4*)(mm + c), sc = *(const f32x4*)(mm + 1024 + c);
            const f32x4 o = v[j] * rstd * (1.f + sc) + sh; v2u w; w.x = pk2(o[0], o[1]); w.y = pk2(o[2], o[3]);
            *(v2u*)(XM + (size_t)r * DM + c) = w; }
    }
}
__device__ __forceinline__ void phase_final(const Args& a, int gw, int NGW, int lane) {
    const float* fn = IN(39); float* outp = karg_out();
    for (int r = gw; r < NLAT; r += NGW) {
        float* xr = outp + (size_t)r * DM; f32x4 v[4]; float ss = 0.f;
#pragma unroll
        for (int j = 0; j < 4; ++j) { v[j] = *(const f32x4*)(xr + 4 * lane + 256 * j); ss += (v[j][0] * v[j][0] + v[j][1] * v[j][1]) + (v[j][2] * v[j][2] + v[j][3] * v[j][3]); }
        const float rstd = rsqrtf(wave_sum(ss) * (1.f / DM) + 1e-6f);
#pragma unroll
        for (int j = 0; j < 4; ++j) { const int c = 4 * lane + 256 * j; const f32x4 g = *(const f32x4*)(fn + c); *(f32x4*)(xr + c) = v[j] * rstd * g; }
    }
}

__device__ __forceinline__ void phase_m1(const Args& a, int l, unsigned char* lds, int G, int bid, int tid_unused) {
    unsigned char* ws = karg_ws();
    const bf16* U = (const bf16*)(ws + OFF_HU);
    bf16* Y = (bf16*)(ws + OFF_XMY);
    for (int pass = 0; pass < 2; ++pass)
    for (int tile = (pass == 0 ? bid : (bid < 48 ? 512 + bid / 3 : NTILE)); tile < (pass == 0 ? 512 : NTILE); tile += (pass == 0 ? G : NTILE)) {
        const int mask = pass == 0 ? 7 : ((1 << (bid % 3)) & (l == 1 ? 6 : 7));
        const TileInfo ti = tile_info(tile);
        const int row0 = tile * 32;
        if (mask & 1) {
            const int tid = ltid(); const int lane = tid & 63, wave = __builtin_amdgcn_readfirstlane(tid >> 6), ch = tid & 255, part = tid >> 8; (void)lane; (void)wave; (void)ch; (void)part;
            float* z = (float*)lds;
            float* cv = (float*)(lds + 65536);
            for (int tt = part; tt < 62; tt += 2) { const int t = ti.t0 - 15 + tt; float zz = 0.f;
                if (t >= 0 && t < ti.seqlen) { const bf16* ur = U + (size_t)(ti.seqbase + t) * UC; zz = bf2f(ur[ch]) * sigm(bf2f(ur[256 + ch])); }
                z[tt * 256 + ch] = zz; }
            __syncthreads();
            const float* dw = IN(12) + (size_t)l * 31 * 256 + ch;
            float acc[16]; const float bias = IN(13)[l * 256 + ch];
#pragma unroll
            for (int o = 0; o < 16; ++o) acc[o] = bias;
            for (int j = 0; j < 31; ++j) { const float w = dw[j * 256];
#pragma unroll
                for (int o = 0; o < 16; ++o) acc[o] += w * z[(part * 16 + o + j) * 256 + ch]; }
#pragma unroll
            for (int o = 0; o < 16; ++o) cv[(part * 16 + o) * 256 + ch] = acc[o];
            __syncthreads();
            const f32x4 lg = *(const f32x4*)(IN(14) + l * 256 + lane * 4), lb = *(const f32x4*)(IN(15) + l * 256 + lane * 4);
#pragma unroll
            for (int q = 0; q < 4; ++q) { const int t = wave * 4 + q; const f32x4 v = *(const f32x4*)(cv + t * 256 + lane * 4);
                const float mu = wave_sum((v[0] + v[1]) + (v[2] + v[3])) * (1.f / 256.f);
                const f32x4 dv = v - mu; const float var = wave_sum((dv[0] * dv[0] + dv[1] * dv[1]) + (dv[2] * dv[2] + dv[3] * dv[3])) * (1.f / 256.f);
                const f32x4 yn = dv * rsqrtf(var + 1e-5f) * lg + lb;
                v2u w; w.x = pk2(siluf_(yn[0]), siluf_(yn[1])); w.y = pk2(siluf_(yn[2]), siluf_(yn[3]));
                *(v2u*)(Y + (size_t)(row0 + t) * DM + lane * 4) = w; }
            __syncthreads();
        }
        if (mask & 2) {
            float* xvf = (float*)lds;
            bf16* xvb = (bf16*)(lds + 32768);
            bf16* rg = (bf16*)(lds + 49664);
            bf16* ixg = (bf16*)(lds + 82432);
            {
                const int tid = ltid(); const int ch = tid & 255, part = tid >> 8;
                const float* cw = IN(16) + (size_t)l * 4 * 256 + ch; const float w0 = cw[0], w1 = cw[256], w2 = cw[512], w3 = cw[768], cb = IN(17)[l * 256 + ch];
                float xin[19];
#pragma unroll
                for (int i = 0; i < 19; ++i) { const int t = ti.t0 + part * 16 + i - 2; xin[i] = (t >= 0 && t < ti.seqlen) ? bf2f(U[(size_t)(ti.seqbase + t) * UC + 512 + ch]) : 0.f; }
#pragma unroll
                for (int o = 0; o < 16; ++o) { const int tl = part * 16 + o;
                    const float v = cb + w0 * xin[o] + w1 * xin[o + 1] + w2 * xin[o + 2] + w3 * xin[o + 3];
                    xvf[tl * 256 + ch] = v; xvb[tl * 264 + ch] = (bf16)f2bf(v);
                }
            }
            __syncthreads();
            {
                const int tid = ltid(); const int ln = tid & 63, wv = __builtin_amdgcn_readfirstlane(tid >> 6), fr = ln & 15, fq = ln >> 4, blk = wv >> 1;
                const bf16* LWAt = (const bf16*)(ws + W_LWA); const bf16* LWXt = (const bf16*)(ws + W_LWX);
                bf16x8 af[2][2];
#pragma unroll
                for (int mt = 0; mt < 2; ++mt)
#pragma unroll
                    for (int ks = 0; ks < 2; ++ks) af[mt][ks] = *(const bf16x8*)(xvb + (mt * 16 + fr) * 264 + blk * 64 + ks * 32 + fq * 8);
#pragma unroll 1
                for (int dn = 0; dn < 4; ++dn) { const int d = dn >> 1, nt = wv * 2 + (dn & 1), ch = nt * 16 + fr, jj = (nt & 3) * 16 + fr;
                    f32x4 ca[2], cx[2];
#pragma unroll
                    for (int mt = 0; mt < 2; ++mt) { ca[mt] = (f32x4){0.f, 0.f, 0.f, 0.f}; cx[mt] = ca[mt]; }
#pragma unroll
                    for (int ks = 0; ks < 2; ++ks) { const size_t wo = ((size_t)(d * 4 + blk) * 64 + jj) * 64 + ks * 32 + fq * 8;
                        const bf16x8 ba = *(const bf16x8*)(LWAt + wo), bx = *(const bf16x8*)(LWXt + wo);
#pragma unroll
                        for (int mt = 0; mt < 2; ++mt) { ca[mt] = __builtin_amdgcn_mfma_f32_16x16x32_bf16(af[mt][ks], ba, ca[mt], 0, 0, 0); cx[mt] = __builtin_amdgcn_mfma_f32_16x16x32_bf16(af[mt][ks], bx, cx[mt], 0, 0, 0); } }
                    const float bga = IN(19)[(l * 2 + d) * 256 + ch], bgx = IN(21)[(l * 2 + d) * 256 + ch];
                    bf16* LR = (bf16*)(ws + M_LR0 + (size_t)d * A8); bf16* LIX = (bf16*)(ws + M_LIX0 + (size_t)d * A8);
#pragma unroll
                    for (int mt = 0; mt < 2; ++mt)
#pragma unroll
                        for (int j = 0; j < 4; ++j) { const int t = mt * 16 + fq * 4 + j;
                            const bf16 rb = (bf16)f2bf(sigm(ca[mt][j] + bga)), ib = (bf16)f2bf(sigm(cx[mt][j] + bgx) * xvf[t * 256 + ch]);
                            LR[(size_t)(row0 + t) * 256 + ch] = rb; LIX[(size_t)(row0 + t) * 256 + ch] = ib;
                            rg[(d * 32 + t) * 256 + ch] = rb; ixg[(d * 32 + t) * 256 + ch] = ib; }
                }
            }
            __syncthreads();
            {
                const int tid = ltid(); const int ch = tid & 255, d = tid >> 8;
                const float lam = IN(22)[(l * 2 + d) * 256 + ch];
                const float cch = -8.f * log1pf(__expf(-lam));
                float A = 1.f, B = 0.f;
#pragma unroll 8
                for (int tt = 0; tt < 32; ++tt) { const int t = d ? 31 - tt : tt;
                    const float al = __expf(cch * bf2f(rg[(d * 32 + t) * 256 + ch])); const float bb = sqrtf(fmaxf(1.f - al * al, 0.f)) * bf2f(ixg[(d * 32 + t) * 256 + ch]); B = al * B + bb; A *= al; }
                ((float*)(ws + M_SEGA))[(size_t)(tile * 2 + d) * 256 + ch] = A;
                ((float*)(ws + M_SEGB))[(size_t)(tile * 2 + d) * 256 + ch] = B;
            }
            __syncthreads();
        }
        if (mask & 4) {
            const int tid = ltid(); const int lane = tid & 63, wave = __builtin_amdgcn_readfirstlane(tid >> 6), ch = tid & 255, part = tid >> 8; (void)lane; (void)wave; (void)ch; (void)part;
            bf16* As = (bf16*)lds;
            float* kr = (float*)(lds + 32768);
            float* rs = (float*)(lds + 32768 + 4096);
            for (int idx = tid; idx < 32 * 52; idx += 512) { const int t = idx / 52, cc = idx % 52;
                const v4u v = *(const v4u*)(U + (size_t)(row0 + t) * UC + 2048 + cc * 8);
                if (cc < 48) *(v4u*)(As + t * 392 + cc * 8) = v;
                else { const int c0 = (cc - 48) * 8; float* kp = kr + t * 32 + c0;
                    kp[0] = __uint_as_float(v.x << 16); kp[1] = __uint_as_float(v.x & 0xffff0000u); kp[2] = __uint_as_float(v.y << 16); kp[3] = __uint_as_float(v.y & 0xffff0000u);
                    kp[4] = __uint_as_float(v.z << 16); kp[5] = __uint_as_float(v.z & 0xffff0000u); kp[6] = __uint_as_float(v.w << 16); kp[7] = __uint_as_float(v.w & 0xffff0000u); } }
            __syncthreads();
#pragma unroll
            for (int q = 0; q < 4; ++q) { const int t = wave * 4 + q; float sq = 0.f, sk = 0.f;
#pragma unroll
                for (int j = 0; j < 4; ++j) { const float v = bf2f(As[t * 392 + lane + 64 * j]); sq += v * v; }
#pragma unroll
                for (int j = 0; j < 2; ++j) { const float v = bf2f(As[t * 392 + 256 + lane + 64 * j]); sk += v * v; }
                sq = wave_sum(sq); sk = wave_sum(sk);
                if (lane == 0) { rs[t * 2] = rsqrtf(sq * (1.f / 256.f) + 1e-6f); rs[t * 2 + 1] = rsqrtf(sk * (1.f / 128.f) + 1e-6f); } }
            __syncthreads();
            const int fr = lane & 15, fq = lane >> 4;
            bf16* QB = (bf16*)(ws + M_QB); bf16* KB = (bf16*)(ws + M_KB); bf16* VT = (bf16*)(ws + M_VT);
            const bf16* WUQ = (const bf16*)(ws + W_UQ); const bf16* WUKV = (const bf16*)(ws + W_UKV);
            const int keybase = ti.isctx ? TLEN : 0;
#pragma unroll 1
            for (int i = 0; i < 3; ++i) { const int nt = wave * 3 + i;
                f32x4 c0 = {0.f, 0.f, 0.f, 0.f}, c1 = c0;
#pragma unroll
                for (int ks = 0; ks < 8; ++ks) { const bf16x8 bfr = *(const bf16x8*)(WUQ + (size_t)(nt * 16 + fr) * 256 + ks * 32 + fq * 8);
                    const bf16x8 a0 = *(const bf16x8*)(As + fr * 392 + ks * 32 + fq * 8), a1 = *(const bf16x8*)(As + (16 + fr) * 392 + ks * 32 + fq * 8);
                    c0 = __builtin_amdgcn_mfma_f32_16x16x32_bf16(a0, bfr, c0, 0, 0, 0); c1 = __builtin_amdgcn_mfma_f32_16x16x32_bf16(a1, bfr, c1, 0, 0, 0); }
                const int hq = nt / 6, wt = nt % 6, dd = wt * 16 + fr;
#pragma unroll
                for (int mt = 0; mt < 2; ++mt)
#pragma unroll
                    for (int j = 0; j < 4; ++j) { const int tl = mt * 16 + fq * 4 + j; const int t = ti.t0 + tl;
                        float v = (mt ? c1[j] : c0[j]) * rs[tl * 2];
                        const float pv = __shfl_xor(v, 8);
                        if (wt >= 4 && !ti.isctx) { const int f = fr & 7; const float pos = (wt == 4) ? (float)(t >> 6) : (float)(t & 63);
                            const float ang = pos * __expf(-(float)f * (9.210340371976184f / 8.f)); float sn, cs; __sincosf(ang, &sn, &cs);
                            v = (fr & 8) ? (v * cs + pv * sn) : (v * cs - pv * sn); }
                        QB[((size_t)(ti.b * 4 + hq) * TT + keybase + t) * 96 + dd] = (bf16)f2bf(v * QSCALE); } }
#pragma unroll 1
            for (int i = 0; i < 4; ++i) { const int nt = wave * 4 + i;
                f32x4 c0 = {0.f, 0.f, 0.f, 0.f}, c1 = c0;
#pragma unroll
                for (int ks = 0; ks < 4; ++ks) { const bf16x8 bfr = *(const bf16x8*)(WUKV + (size_t)(nt * 16 + fr) * 128 + ks * 32 + fq * 8);
                    const bf16x8 a0 = *(const bf16x8*)(As + fr * 392 + 256 + ks * 32 + fq * 8), a1 = *(const bf16x8*)(As + (16 + fr) * 392 + 256 + ks * 32 + fq * 8);
                    c0 = __builtin_amdgcn_mfma_f32_16x16x32_bf16(a0, bfr, c0, 0, 0, 0); c1 = __builtin_amdgcn_mfma_f32_16x16x32_bf16(a1, bfr, c1, 0, 0, 0); }
                const int hk = nt >> 3, wt = nt & 7;
#pragma unroll
                for (int mt = 0; mt < 2; ++mt)
#pragma unroll
                    for (int j = 0; j < 4; ++j) { const int tl = mt * 16 + fq * 4 + j; const int key = keybase + ti.t0 + tl;
                        const float v = (mt ? c1[j] : c0[j]) * rs[tl * 2 + 1];
                        if (wt < 4) KB[((size_t)(ti.b * 4 + hk) * TT + key) * 96 + wt * 16 + fr] = (bf16)f2bf(v);
                        else VT[((size_t)(ti.b * 4 + hk) * 64 + (wt - 4) * 16 + fr) * TT + key] = (bf16)f2bf(v); } }
            { const int tl = tid >> 4, p = tid & 15, ax = p >> 3, f = p & 7; const int t = ti.t0 + tl;
                float x0 = kr[tl * 32 + ax * 16 + f], x1 = kr[tl * 32 + ax * 16 + 8 + f];
                if (!ti.isctx) { const float pos = ax == 0 ? (float)(t >> 6) : (float)(t & 63); const float ang = pos * __expf(-(float)f * (9.210340371976184f / 8.f));
                    float sn, cs; __sincosf(ang, &sn, &cs); const float y0 = x0 * cs - x1 * sn, y1 = x1 * cs + x0 * sn; x0 = y0; x1 = y1; }
                const bf16 b0 = (bf16)f2bf(x0), b1 = (bf16)f2bf(x1);
#pragma unroll
                for (int h = 0; h < 4; ++h) { bf16* kp = KB + ((size_t)(ti.b * 4 + h) * TT + keybase + t) * 96 + 64 + ax * 16 + f; kp[0] = b0; kp[8] = b1; } }
            __syncthreads();
        }
    }
}

__device__ __forceinline__ void attn_unit(unsigned char* lds, const bf16* QB, const bf16* KB, const bf16* VT, bf16* Y, int b, int h, int q0, int key_lo, int nkt, int tid) {
    const int lane = tid & 63, wave = tid >> 6, fr = lane & 15, fq = lane >> 4;
    const int bh = b * 4 + h;
    constexpr int KSTR = 104, VSTR = 72, KBUF = 64 * KSTR, VBUF = 64 * VSTR;
    bf16* Ks = (bf16*)lds;
    bf16* Vs = (bf16*)lds + 2 * KBUF;
    const int qw = q0 + wave * 32;
    bf16x8 qf[2][3];
#pragma unroll
    for (int qt = 0; qt < 2; ++qt)
#pragma unroll
        for (int ks = 0; ks < 3; ++ks) qf[qt][ks] = *(const bf16x8*)(QB + ((size_t)bh * TT + qw + qt * 16 + fr) * 96 + ks * 32 + fq * 8);
    float mrun[2] = {-1e30f, -1e30f}, lrun[2] = {0.f, 0.f};
    f32x4 o[4][2];
#pragma unroll
    for (int dt = 0; dt < 4; ++dt)
#pragma unroll
        for (int qt = 0; qt < 2; ++qt) o[dt][qt] = (f32x4){0.f, 0.f, 0.f, 0.f};
    const v4u* kg = (const v4u*)(KB + ((size_t)bh * TT + key_lo) * 96);
    const bf16* vg = VT + ((size_t)bh * 64 + (tid >> 3)) * TT + key_lo + (tid & 7) * 8;
    const int kc0 = tid, kc1 = 512 + tid;
    const int ko0 = (kc0 / 12) * KSTR + (kc0 % 12) * 8, ko1 = (kc1 / 12) * KSTR + (kc1 % 12) * 8, vo = (tid >> 3) * VSTR + (tid & 7) * 8;
    v4u rk0, rk1 = {0u, 0u, 0u, 0u}, rv;
    rk0 = kg[kc0]; if (tid < 256) rk1 = kg[kc1]; rv = *(const v4u*)vg;
    *(v4u*)(Ks + ko0) = rk0; if (tid < 256) *(v4u*)(Ks + ko1) = rk1; *(v4u*)(Vs + vo) = rv;
    __syncthreads();
    for (int kt = 0; kt < nkt; ++kt) {
        const int cur = kt & 1;
        if (kt + 1 < nkt) { const v4u* kn = kg + (size_t)(kt + 1) * 768; rk0 = kn[kc0]; if (tid < 256) rk1 = kn[kc1]; rv = *(const v4u*)(vg + (kt + 1) * 64); }
        const bf16* kb = Ks + cur * KBUF; const bf16* vb = Vs + cur * VBUF;
        f32x4 st[4][2];
#pragma unroll
        for (int k4 = 0; k4 < 4; ++k4) {
            st[k4][0] = (f32x4){0.f, 0.f, 0.f, 0.f}; st[k4][1] = st[k4][0];
#pragma unroll
            for (int ks = 0; ks < 3; ++ks) { const bf16x8 kf = *(const bf16x8*)(kb + (k4 * 16 + fr) * KSTR + ks * 32 + fq * 8);
                st[k4][0] = __builtin_amdgcn_mfma_f32_16x16x32_bf16(kf, qf[0][ks], st[k4][0], 0, 0, 0);
                st[k4][1] = __builtin_amdgcn_mfma_f32_16x16x32_bf16(kf, qf[1][ks], st[k4][1], 0, 0, 0); }
        }
        bf16x8 pb[2][2];
#pragma unroll
        for (int qt = 0; qt < 2; ++qt) {
            float mx = st[0][qt][0];
#pragma unroll
            for (int k4 = 0; k4 < 4; ++k4)
#pragma unroll
                for (int j = 0; j < 4; ++j) mx = fmaxf(mx, st[k4][qt][j]);
            mx = fmaxf(mx, __shfl_xor(mx, 16)); mx = fmaxf(mx, __shfl_xor(mx, 32));
            const float mn = fmaxf(mrun[qt], mx), alpha = __builtin_amdgcn_exp2f(mrun[qt] - mn); mrun[qt] = mn;
            float ls = 0.f;
#pragma unroll
            for (int k4 = 0; k4 < 4; ++k4)
#pragma unroll
                for (int j = 0; j < 4; ++j) { const float p = __builtin_amdgcn_exp2f(st[k4][qt][j] - mn); st[k4][qt][j] = p; ls += p; }
            lrun[qt] = lrun[qt] * alpha + ls;
#pragma unroll
            for (int dt = 0; dt < 4; ++dt) o[dt][qt] *= alpha;
#pragma unroll
            for (int u = 0; u < 2; ++u) { v4u w;
                w.x = pg8::cvt_pk_bf16(st[2 * u][qt][0], st[2 * u][qt][1]); w.y = pg8::cvt_pk_bf16(st[2 * u][qt][2], st[2 * u][qt][3]);
                w.z = pg8::cvt_pk_bf16(st[2 * u + 1][qt][0], st[2 * u + 1][qt][1]); w.w = pg8::cvt_pk_bf16(st[2 * u + 1][qt][2], st[2 * u + 1][qt][3]);
                pb[u][qt] = __builtin_bit_cast(bf16x8, w); }
        }
#pragma unroll
        for (int dt = 0; dt < 4; ++dt)
#pragma unroll
            for (int u = 0; u < 2; ++u) {
                const v2u lo = *(const v2u*)(vb + (dt * 16 + fr) * VSTR + 32 * u + 4 * fq), hi = *(const v2u*)(vb + (dt * 16 + fr) * VSTR + 32 * u + 16 + 4 * fq);
                v4u vw; vw.x = lo.x; vw.y = lo.y; vw.z = hi.x; vw.w = hi.y;
                const bf16x8 va = __builtin_bit_cast(bf16x8, vw);
                o[dt][0] = __builtin_amdgcn_mfma_f32_16x16x32_bf16(va, pb[u][0], o[dt][0], 0, 0, 0);
                o[dt][1] = __builtin_amdgcn_mfma_f32_16x16x32_bf16(va, pb[u][1], o[dt][1], 0, 0, 0);
            }
        if (kt + 1 < nkt) { const int nb = cur ^ 1; *(v4u*)(Ks + nb * KBUF + ko0) = rk0; if (tid < 256) *(v4u*)(Ks + nb * KBUF + ko1) = rk1; *(v4u*)(Vs + nb * VBUF + vo) = rv; }
        __syncthreads();
    }
#pragma unroll
    for (int qt = 0; qt < 2; ++qt) {
        float lt = lrun[qt]; lt += __shfl_xor(lt, 16); lt += __shfl_xor(lt, 32);
        const float inv = 1.f / lt;
        const int q = qw + qt * 16 + fr;
        const size_t row = q < TLEN ? (size_t)b * TLEN + q : (size_t)NLAT + b * CTXL + (q - TLEN);
#pragma unroll
        for (int dt = 0; dt < 4; ++dt) { const f32x4 v = o[dt][qt] * inv; v2u w; w.x = pk2(v[0], v[1]); w.y = pk2(v[2], v[3]);
            *(v2u*)(Y + row * DM + 768 + h * 64 + dt * 16 + fq * 4) = w; }
    }
}
__device__ __forceinline__ void lru_prefix(int bd, int tid) {
    unsigned char* ws = karg_ws();
    if (tid >= 256) return;
    const int ch = tid, b = bd >> 1, d = bd & 1;
    const float* __restrict__ SA = (const float*)(ws + M_SEGA); const float* __restrict__ SB = (const float*)(ws + M_SEGB); float* __restrict__ H0 = (float*)(ws + M_H0);
    const int ctile0 = 512 + b * 8, ltile0 = b * 256;
#define LRU_TILE(i_) ((i_) < 8 ? ctile0 + (d ? 7 - (i_) : (i_)) : ltile0 + (d ? 255 - ((i_) - 8) : ((i_) - 8)))
    float hst = 0.f;
    float ca[24], cb[24], na[24], nb[24];
#pragma unroll
    for (int k = 0; k < 24; ++k) { const size_t o = (size_t)(LRU_TILE(k) * 2 + d) * 256 + ch; ca[k] = SA[o]; cb[k] = SB[o]; }
    for (int i0 = 0; i0 < 264; i0 += 24) {
        if (i0 + 24 < 264) {
#pragma unroll
            for (int k = 0; k < 24; ++k) { const size_t o = (size_t)(LRU_TILE(i0 + 24 + k) * 2 + d) * 256 + ch; na[k] = SA[o]; nb[k] = SB[o]; } }
        float hv[24];
#pragma unroll
        for (int k = 0; k < 24; ++k) { hv[k] = hst; hst = ca[k] * hst + cb[k]; }
#pragma unroll
        for (int k = 0; k < 24; ++k) H0[(size_t)(LRU_TILE(i0 + k) * 2 + d) * 256 + ch] = hv[k];
#pragma unroll
        for (int k = 0; k < 24; ++k) { ca[k] = na[k]; cb[k] = nb[k]; }
    }
#undef LRU_TILE
}
__device__ __forceinline__ void lru_rescan(const Args& a, int l, unsigned char* lds, int tile, int tid) {
    unsigned char* ws = karg_ws();
    const int ch = tid & 255, d = tid >> 8;
    const int row0 = tile * 32;
    float hst = ((const float*)(ws + M_H0))[(size_t)(tile * 2 + d) * 256 + ch];
    const float lam = IN(22)[(l * 2 + d) * 256 + ch];
    const float cch = -8.f * log1pf(__expf(-lam));
    const bf16* LR = (const bf16*)(ws + M_LR0 + (size_t)d * A8); const bf16* LIX = (const bf16*)(ws + M_LIX0 + (size_t)d * A8);
    float* hs = (float*)lds;
#pragma unroll 16
    for (int tt = 0; tt < 32; ++tt) { const int t = d ? 31 - tt : tt; const size_t o = (size_t)(row0 + t) * 256 + ch;
        const float al = __expf(cch * bf2f(LR[o])); const float bb = sqrtf(fmaxf(1.f - al * al, 0.f)) * bf2f(LIX[o]);
        hst = al * hst + bb; hs[(d * 32 + t) * 256 + ch] = hst; }
    __syncthreads();
    const bf16* U = (const bf16*)(ws + OFF_HU); bf16* Y = (bf16*)(ws + OFF_XMY);
#pragma unroll 8
    for (int tt = 0; tt < 16; ++tt) { const int t = d * 16 + tt;
        const float y = (hs[t * 256 + ch] + hs[(32 + t) * 256 + ch]) * geluf_(bf2f(U[(size_t)(row0 + t) * UC + 768 + ch]));
        Y[(size_t)(row0 + t) * DM + 256 + ch] = (bf16)f2bf(y); }
    __syncthreads();
}
__device__ __forceinline__ void phase_m2(const Args& a, int l, unsigned char* lds, int G, int bid, int tid) {
    unsigned char* ws = karg_ws();
    const bf16* QB = (const bf16*)(ws + M_QB); const bf16* KB = (const bf16*)(ws + M_KB); const bf16* VT = (const bf16*)(ws + M_VT);
    bf16* Y = (bf16*)(ws + OFF_XMY);
    const int nunits = (l == 0) ? 264 : 256;
    for (int u = bid; u < nunits; u += G) {
        if (u < 256) attn_unit(lds, QB, KB, VT, Y, u >> 7, (u >> 5) & 3, (u & 31) * 256, 0, 132, tid);
        else attn_unit(lds, QB, KB, VT, Y, (u - 256) >> 2, (u - 256) & 3, TLEN, TLEN, 4, tid);
    }
    if (bid >= G - 4) lru_prefix(bid - (G - 4), tid);
}

__device__ __forceinline__ void phase_m3(const Args& a, int l, unsigned char* lds, int G, int bid, int tid) {
    unsigned char* ws = karg_ws();
    const bf16* U = (const bf16*)(ws + OFF_HU);
    const int lane = tid & 63, ch = tid & 255, part = tid >> 8;
    const float* mup = IN(23) + l * 1024; const float* mun = IN(24) + l * 1024;
    bf16* RR = (bf16*)(ws + M_RR); bf16* KKo = (bf16*)(ws + M_KK); bf16* VV = (bf16*)(ws + M_VV); bf16* GC = (bf16*)(ws + M_GC);
    float* kl = (float*)lds;
    float* kkn = (float*)(lds + 32768);
    bf16* twb = (bf16*)(lds + 65536);
    bf16* tab = (bf16*)(lds + 70144);
    bf16* tgb = (bf16*)(lds + 74752);
    for (int pass = 0; pass < 2; ++pass)
    for (int tile = (pass == 0 ? bid : (bid < 48 ? 512 + bid / 3 : NTILE)); tile < (pass == 0 ? 512 : NTILE); tile += (pass == 0 ? G : NTILE)) {
        const int mask = pass == 0 ? 7 : ((1 << (bid % 3)) & (l == 1 ? 6 : 7));
        const TileInfo ti = tile_info(tile);
        const int row0 = tile * 32;
        if (mask & 1) lru_rescan(a, l, lds, tile, ltid());
        if (mask & 6) {
        {
            const int tid2 = ltid(); const int chunk = tid2 & 127, tg8 = tid2 >> 7, c0 = chunk * 8;
            const bf16* ub = U + (size_t)row0 * UC + 1024 + c0;
            v4u rw[10];
#pragma unroll
            for (int q = 0; q < 10; ++q) { const int tl = tg8 * 8 + q - 1; const int t = ti.t0 + tl;
                rw[q] = (t >= 0 && t < ti.seqlen) ? *(const v4u*)(ub + (ptrdiff_t)tl * UC) : (v4u){0u, 0u, 0u, 0u}; }
            const f32x4 mp0 = *(const f32x4*)(mup + c0), mp1 = *(const f32x4*)(mup + c0 + 4), mn0 = *(const f32x4*)(mun + c0), mn1 = *(const f32x4*)(mun + c0 + 4);
            const float mp[8] = {mp0[0], mp0[1], mp0[2], mp0[3], mp1[0], mp1[1], mp1[2], mp1[3]}, mn[8] = {mn0[0], mn0[1], mn0[2], mn0[3], mn1[0], mn1[1], mn1[2], mn1[3]};
#pragma unroll
            for (int q = 0; q < 8; ++q) { const int tl = tg8 * 8 + q; float ts[8];
#pragma unroll
                for (int e = 0; e < 8; ++e) { const unsigned wm = rw[q][e >> 1], w0 = rw[q + 1][e >> 1], wn = rw[q + 2][e >> 1];
                    const float um = (e & 1) ? __uint_as_float(wm & 0xffff0000u) : __uint_as_float(wm << 16);
                    const float u0 = (e & 1) ? __uint_as_float(w0 & 0xffff0000u) : __uint_as_float(w0 << 16);
                    const float un = (e & 1) ? __uint_as_float(wn & 0xffff0000u) : __uint_as_float(wn << 16);
                    ts[e] = u0 + mp[e] * (um - u0) + mn[e] * (un - u0); }
                if (chunk >= 32 && chunk < 64) { float* kp = kl + tl * 256 + (c0 - 256); *(f32x4*)kp = (f32x4){ts[0], ts[1], ts[2], ts[3]}; *(f32x4*)(kp + 4) = (f32x4){ts[4], ts[5], ts[6], ts[7]}; }
                else {
                    if (chunk >= 96 && chunk < 104) {
#pragma unroll
                        for (int e = 0; e < 8; ++e) ts[e] = tanhf_(ts[e]); }
                    if (chunk >= 112) {
#pragma unroll
                        for (int e = 0; e < 8; ++e) ts[e] = sigm(ts[e]); }
                    v4u o; o.x = pk2(ts[0], ts[1]); o.y = pk2(ts[2], ts[3]); o.z = pk2(ts[4], ts[5]); o.w = pk2(ts[6], ts[7]);
                    if (chunk < 32) *(v4u*)(RR + (size_t)(row0 + tl) * 256 + c0) = o;
                    else if (chunk < 96) *(v4u*)(VV + (size_t)(row0 + tl) * 256 + (c0 - 512)) = o;
                    else if (chunk < 104) *(v4u*)(twb + tl * 72 + (c0 - 768)) = o;
                    else if (chunk < 112) *(v4u*)(tab + tl * 72 + (c0 - 832)) = o;
                    else *(v4u*)(tgb + tl * 136 + (c0 - 896)) = o; }
            }
        }
        __syncthreads();
        {
            const int tid2 = ltid(); const int ch = tid2 & 255, pt = tid2 >> 8; const float kkc = IN(30)[l * 256 + ch];
#pragma unroll 4
            for (int q = 0; q < 16; ++q) { const int t = pt * 16 + q; const float kr = kl[t * 256 + ch] * kkc; const float nrm = wave_sum(kr * kr);
                const float kk = kr * rsqrtf(fmaxf(nrm, 1e-24f)); kkn[t * 256 + ch] = kk; KKo[(size_t)(row0 + t) * 256 + ch] = (bf16)f2bf(kk); }
        }
        __syncthreads();
        {
            const int tid2 = ltid(); const int ln = tid2 & 63, wv = __builtin_amdgcn_readfirstlane(tid2 >> 6), fr = ln & 15, fq = ln >> 4;
            const bf16* WUPt = (const bf16*)(ws + W_WUP); const bf16* AUPt = (const bf16*)(ws + W_AUP); const bf16* GUPt = (const bf16*)(ws + W_GUP);
            bf16x8 aw[2][2], aa[2][2];
#pragma unroll
            for (int mt = 0; mt < 2; ++mt)
#pragma unroll
                for (int ks = 0; ks < 2; ++ks) { aw[mt][ks] = *(const bf16x8*)(twb + (mt * 16 + fr) * 72 + ks * 32 + fq * 8); aa[mt][ks] = *(const bf16x8*)(tab + (mt * 16 + fr) * 72 + ks * 32 + fq * 8); }
#pragma unroll 1
            for (int dn = 0; dn < 4; ++dn) { const int d = dn >> 1, nt = wv * 2 + (dn & 1), ch = nt * 16 + fr;
                if (!((mask >> (1 + d)) & 1)) continue;
                f32x4 cw[2], ca[2];
#pragma unroll
                for (int mt = 0; mt < 2; ++mt) { cw[mt] = (f32x4){0.f, 0.f, 0.f, 0.f}; ca[mt] = cw[mt]; }
#pragma unroll
                for (int ks = 0; ks < 2; ++ks) { const bf16x8 bw = *(const bf16x8*)(WUPt + ((size_t)d * 256 + ch) * 64 + ks * 32 + fq * 8), ba = *(const bf16x8*)(AUPt + ((size_t)d * 256 + ch) * 64 + ks * 32 + fq * 8);
#pragma unroll
                    for (int mt = 0; mt < 2; ++mt) { cw[mt] = __builtin_amdgcn_mfma_f32_16x16x32_bf16(aw[mt][ks], bw, cw[mt], 0, 0, 0); ca[mt] = __builtin_amdgcn_mfma_f32_16x16x32_bf16(aa[mt][ks], ba, ca[mt], 0, 0, 0); } }
                const float w0 = IN(25)[(l * 2 + d) * 256 + ch], a0 = IN(27)[(l * 2 + d) * 256 + ch], kac = IN(31)[l * 256 + ch];
                float* WW = (float*)(ws + M_WW) + (size_t)d * NR * 256; bf16* BB = (bf16*)(ws + M_BB + (size_t)d * A8); bf16* KD = (bf16*)(ws + M_KD + (size_t)d * A8);
#pragma unroll
                for (int mt = 0; mt < 2; ++mt)
#pragma unroll
                    for (int j = 0; j < 4; ++j) { const int t = mt * 16 + fq * 4 + j; const size_t o = (size_t)(row0 + t) * 256 + ch;
                        const float e = sigm(w0 + cw[mt][j]) * 0.6065306597126334f;
                        const float av = sigm(a0 + ca[mt][j]);
                        WW[o] = __expf(-e);
                        KD[o] = (bf16)f2bf(kl[t * 256 + ch] * (1.f + (av - 1.f) * kac));
                        BB[o] = (bf16)f2bf(kkn[t * 256 + ch] * av); }
            }
#pragma unroll 1
            for (int nl = 0; nl < 2; ++nl) { const int ch = (wv * 2 + nl) * 16 + fr;
                if (!(mask & 4)) continue;
                f32x4 cg[2] = {(f32x4){0.f, 0.f, 0.f, 0.f}, (f32x4){0.f, 0.f, 0.f, 0.f}};
#pragma unroll
                for (int ks = 0; ks < 4; ++ks) { const bf16x8 bg = *(const bf16x8*)(GUPt + (size_t)ch * 128 + ks * 32 + fq * 8);
#pragma unroll
                    for (int mt = 0; mt < 2; ++mt) { const bf16x8 ag = *(const bf16x8*)(tgb + (mt * 16 + fr) * 136 + ks * 32 + fq * 8); cg[mt] = __builtin_amdgcn_mfma_f32_16x16x32_bf16(ag, bg, cg[mt], 0, 0, 0); } }
#pragma unroll
                for (int mt = 0; mt < 2; ++mt)
#pragma unroll
                    for (int j = 0; j < 4; ++j) GC[(size_t)(row0 + mt * 16 + fq * 4 + j) * 256 + ch] = (bf16)f2bf(cg[mt][j]);
            }
        }
        __syncthreads();
        }
    }
}

typedef const unsigned cu32;
typedef const float cf32;
__device__ __forceinline__ int chain_row(int b, int d, int tau) {
    return tau < CTXL ? (NLAT + b * CTXL + (d ? CTXL - 1 - tau : tau)) : (b * TLEN + (d ? TLEN - 1 - (tau - CTXL) : (tau - CTXL)));
}
template <int MODE>
__device__ __forceinline__ void rwkv_steps(float (&S)[64], int b, int h, int d, int tau0, int n, unsigned char* ws, int lane, float* wl) {
    const bf16* KKp = (const bf16*)(ws + M_KK); const bf16* RRp = (const bf16*)(ws + M_RR); const bf16* VVp = (const bf16*)(ws + M_VV);
    const float* WWp = (const float*)(ws + M_WW) + (size_t)d * NR * 256; const bf16* BBp = (const bf16*)(ws + M_BB + (size_t)d * A8); const bf16* KDp = (const bf16*)(ws + M_KD + (size_t)d * A8);
    float* YS = (float*)(ws + M_YS) + (size_t)d * NR * 256;
    float pk, pw, pb, pkd = 0.f, pr = 0.f, pv = 0.f; size_t poff;
#define RWKV_LOAD(s_) do { poff = (size_t)chain_row(b, d, tau0 + (s_)) * 256 + h * 64 + lane; pk = bf2f(KKp[poff]); pw = WWp[poff]; pb = bf2f(BBp[poff]); \
        if (MODE != 1) { pkd = bf2f(KDp[poff]); pv = bf2f(VVp[poff]); } if (MODE == 2) pr = bf2f(RRp[poff]); } while (0)
    RWKV_LOAD(0);
    for (int s = 0; s < n; ++s) {
        float* buf = wl + (s & 1) * 320;
        buf[lane] = pk; buf[64 + lane] = pw; buf[128 + lane] = pb;
        if (MODE != 1) buf[192 + lane] = pkd;
        if (MODE == 2) buf[256 + lane] = pr;
        const float vv = pv; const size_t yoff = poff;
        if (s + 1 < n) RWKV_LOAD(s + 1);
        float sa0 = 0.f, sa1 = 0.f, sa2 = 0.f, sa3 = 0.f;
#pragma unroll
        for (int i = 0; i < 64; i += 4) { const f32x4 k4 = *(const f32x4*)(buf + i);
            sa0 += S[i] * k4[0]; sa1 += S[i + 1] * k4[1]; sa2 += S[i + 2] * k4[2]; sa3 += S[i + 3] * k4[3]; }
        const float nsa = -((sa0 + sa1) + (sa2 + sa3));
        float y0 = 0.f, y1 = 0.f, y2 = 0.f, y3 = 0.f;
#pragma unroll
        for (int i = 0; i < 64; i += 4) { const f32x4 w4 = *(const f32x4*)(buf + 64 + i), b4 = *(const f32x4*)(buf + 128 + i);
            f32x4 t = nsa * b4;
            if (MODE != 1) { const f32x4 kd4 = *(const f32x4*)(buf + 192 + i); t += vv * kd4; }
            S[i] = S[i] * w4[0] + t[0]; S[i + 1] = S[i + 1] * w4[1] + t[1]; S[i + 2] = S[i + 2] * w4[2] + t[2]; S[i + 3] = S[i + 3] * w4[3] + t[3];
            if (MODE == 2) { const f32x4 r4 = *(const f32x4*)(buf + 256 + i); y0 += S[i] * r4[0]; y1 += S[i + 1] * r4[1]; y2 += S[i + 2] * r4[2]; y3 += S[i + 3] * r4[3]; } }
        if (MODE == 2) YS[yoff] = (y0 + y1) + (y2 + y3);
    }
#undef RWKV_LOAD
}
typedef float f32x2 __attribute__((ext_vector_type(2)));
__device__ __forceinline__ void rwkv_pass1(f32x2 (&SL)[32], f32x2 (&SI)[32], int b, int h, int d, int tau0, int n, unsigned char* ws, int lane, float* wl) {
    const bf16* KKp = (const bf16*)(ws + M_KK); const bf16* VVp = (const bf16*)(ws + M_VV); const bf16* RRp = (const bf16*)(ws + M_RR);
    const float* WWp = (const float*)(ws + M_WW) + (size_t)d * NR * 256; const bf16* BBp = (const bf16*)(ws + M_BB + (size_t)d * A8); const bf16* KDp = (const bf16*)(ws + M_KD + (size_t)d * A8);
    float* YS = (float*)(ws + M_YS) + (size_t)d * NR * 256; float* PR = (float*)(ws + M_PR) + (size_t)d * NR * 256;
    float pk, pw, pb, pkd, pv, pr; size_t poff;
#define RWKV_LOAD(s_) do { poff = (size_t)chain_row(b, d, tau0 + (s_)) * 256 + h * 64 + lane; pk = bf2f(KKp[poff]); pw = WWp[poff]; pb = bf2f(BBp[poff]); pkd = bf2f(KDp[poff]); pv = bf2f(VVp[poff]); pr = bf2f(RRp[poff]); } while (0)
    RWKV_LOAD(0);
    for (int s = 0; s < n; ++s) {
        float* buf = wl + (s & 1) * 320;
        buf[lane] = pk; buf[64 + lane] = pw; buf[128 + lane] = pb; buf[192 + lane] = pkd; buf[256 + lane] = pr;
        const float vv = pv; const size_t yoff = poff;
        if (s + 1 < n) RWKV_LOAD(s + 1);
        f32x2 aL0 = {0.f, 0.f}, aL1 = aL0, aI0 = aL0, aI1 = aL0;
#pragma unroll
        for (int q = 0; q < 16; ++q) { const f32x4 k4 = *(const f32x4*)(buf + 4 * q);
            aL0 += SL[2 * q] * k4.lo; aL1 += SL[2 * q + 1] * k4.hi; aI0 += SI[2 * q] * k4.lo; aI1 += SI[2 * q + 1] * k4.hi; }
        const f32x2 tL = aL0 + aL1, tI = aI0 + aI1;
        const float nsl = -(tL.x + tL.y), nsi = -(tI.x + tI.y);
        f32x2 yL0 = {0.f, 0.f}, yL1 = yL0, yI0 = yL0, yI1 = yL0;
#pragma unroll
        for (int q = 0; q < 16; ++q) {
            const f32x4 w4 = *(const f32x4*)(buf + 64 + 4 * q), b4 = *(const f32x4*)(buf + 128 + 4 * q), kd4 = *(const f32x4*)(buf + 192 + 4 * q), r4 = *(const f32x4*)(buf + 256 + 4 * q);
            const f32x4 tl = nsl * b4 + vv * kd4, tiv = nsi * b4;
            SL[2 * q] = SL[2 * q] * w4.lo + tl.lo; SL[2 * q + 1] = SL[2 * q + 1] * w4.hi + tl.hi;
            SI[2 * q] = SI[2 * q] * w4.lo + tiv.lo; SI[2 * q + 1] = SI[2 * q + 1] * w4.hi + tiv.hi;
            yL0 += SL[2 * q] * r4.lo; yL1 += SL[2 * q + 1] * r4.hi; yI0 += SI[2 * q] * r4.lo; yI1 += SI[2 * q + 1] * r4.hi; }
        const f32x2 yl = yL0 + yL1, yp = yI0 + yI1;
        YS[yoff] = yl.x + yl.y; PR[yoff] = yp.x + yp.y;
    }
#undef RWKV_LOAD
}
__device__ __forceinline__ void phase_m4(const Args& a, unsigned char* lds, int G, int bid, int tid) {
    const int lane = tid & 63, wave = __builtin_amdgcn_readfirstlane(tid >> 6), half = wave >> 2, tk = wave & 3;
    unsigned char* ws = karg_ws(); float* PL = (float*)(ws + M_PL);
    float* wl = (float*)lds + wave * 320;
    float* xch = (float*)lds + 8 * 320 + tk * 1024;
    float* ych = xch + 512;
    const bf16* KKp = (const bf16*)(ws + M_KK); const bf16* VVp = (const bf16*)(ws + M_VV); const bf16* RRp = (const bf16*)(ws + M_RR);
    for (int task0 = bid * 4; task0 < 16 * NSEG; task0 += G * 4) {
        const int task = task0 + tk; const int seg = task & (NSEG - 1), chain = task >> 6;
        const int d = chain & 1, h = (chain >> 1) & 3, b = chain >> 3;
        const float* WWp = (const float*)(ws + M_WW) + (size_t)d * NR * 256; const bf16* BBp = (const bf16*)(ws + M_BB + (size_t)d * A8); const bf16* KDp = (const bf16*)(ws + M_KD + (size_t)d * A8);
        float* YS = (float*)(ws + M_YS) + (size_t)d * NR * 256; float* PR = (float*)(ws + M_PR) + (size_t)d * NR * 256;
        f32x2 SL[16], SI[16]; int ln = lane; asm volatile("" : "+v"(ln));
#pragma unroll
        for (int i = 0; i < 16; ++i) { SL[i] = (f32x2){0.f, 0.f}; SI[i] = (f32x2){(32 * half + 2 * i == ln) ? 1.f : 0.f, (32 * half + 2 * i + 1 == ln) ? 1.f : 0.f}; }
        const int tau0 = seg * SEGLEN, cidx = h * 64 + 32 * half + (lane & 31);
        unsigned pp; float pw, pv; size_t rowoff, prevoff = 0;
        const int grp = lane >> 4, l15 = lane & 15, l31 = lane & 31;
        const unsigned* srcp = grp == 0 ? (const unsigned*)KKp : grp == 1 ? (const unsigned*)BBp : grp == 2 ? (const unsigned*)KDp : (const unsigned*)RRp;
#define M4_LOAD(s_) do { rowoff = (size_t)chain_row(b, d, tau0 + (s_)) * 256; pp = srcp[(rowoff + h * 64 + 32 * half) / 2 + l15]; \
            pw = (lane < 32) ? WWp[rowoff + cidx] : 0.f; pv = bf2f(VVp[rowoff + h * 64 + lane]); } while (0)
#define UNPK(u_) ((f32x2){__uint_as_float((u_) << 16), __uint_as_float((u_) & 0xffff0000u)})
        M4_LOAD(0);
        for (int s = 0; s < SEGLEN; ++s) {
            float* buf = wl + (s & 1) * 160; const unsigned* bufu = (const unsigned*)buf;
            ((unsigned*)buf)[lane] = pp; if (lane < 32) buf[64 + l31] = pw;
            const float vv = pv; const size_t yoff = rowoff + h * 64 + lane;
            if (s + 1 < SEGLEN) M4_LOAD(s + 1);
            f32x2 aL0 = {0.f, 0.f}, aL1 = aL0, aI0 = aL0, aI1 = aL0;
#pragma unroll
            for (int q = 0; q < 4; ++q) { const v4u k4 = *(const v4u*)(bufu + 4 * q);
                const f32x2 ka = UNPK(k4.x), kb = UNPK(k4.y), kc = UNPK(k4.z), kd_ = UNPK(k4.w);
                aL0 += SL[4 * q] * ka; aL1 += SL[4 * q + 1] * kb; aL0 += SL[4 * q + 2] * kc; aL1 += SL[4 * q + 3] * kd_;
                aI0 += SI[4 * q] * ka; aI1 += SI[4 * q + 1] * kb; aI0 += SI[4 * q + 2] * kc; aI1 += SI[4 * q + 3] * kd_; }
            const f32x2 tL = aL0 + aL1, tI = aI0 + aI1;
            float* xw = xch + (s & 1) * 256;
            xw[half * 128 + lane] = tL.x + tL.y; xw[half * 128 + 64 + lane] = tI.x + tI.y;
            __syncthreads();
            const float nsl = -(xw[lane] + xw[128 + lane]), nsi = -(xw[64 + lane] + xw[192 + lane]);
            if (s > 0) {
                const float* yr = ych + ((s - 1) & 1) * 256;
                if (half == 0) YS[prevoff] = yr[lane] + yr[128 + lane]; else PR[prevoff] = yr[64 + lane] + yr[192 + lane];
            }
            f32x2 yL0 = {0.f, 0.f}, yL1 = yL0, yI0 = yL0, yI1 = yL0;
#pragma unroll
            for (int q = 0; q < 4; ++q) {
                const f32x4 wa = *(const f32x4*)(buf + 64 + 8 * q), wb = *(const f32x4*)(buf + 68 + 8 * q);
                const v4u b4 = *(const v4u*)(bufu + 16 + 4 * q), d4 = *(const v4u*)(bufu + 32 + 4 * q), r4 = *(const v4u*)(bufu + 48 + 4 * q);
                const f32x2 w2[4] = {wa.lo, wa.hi, wb.lo, wb.hi};
                const unsigned bu[4] = {b4.x, b4.y, b4.z, b4.w}, du[4] = {d4.x, d4.y, d4.z, d4.w}, ru[4] = {r4.x, r4.y, r4.z, r4.w};
#pragma unroll
                for (int e = 0; e < 4; ++e) { const int j = 4 * q + e; const f32x2 b2 = UNPK(bu[e]), k2 = UNPK(du[e]), r2 = UNPK(ru[e]);
                    const f32x2 tl = nsl * b2 + vv * k2, tiv = nsi * b2;
                    SL[j] = SL[j] * w2[e] + tl; SI[j] = SI[j] * w2[e] + tiv;
                    if (e & 1) { yL1 += SL[j] * r2; yI1 += SI[j] * r2; } else { yL0 += SL[j] * r2; yI0 += SI[j] * r2; } }
            }
            const f32x2 yl = yL0 + yL1, yp = yI0 + yI1;
            float* yw = ych + (s & 1) * 256;
            yw[half * 128 + lane] = yl.x + yl.y; yw[half * 128 + 64 + lane] = yp.x + yp.y;
            prevoff = yoff;
        }
#undef M4_LOAD
#undef UNPK
        __syncthreads();
        { const float* yr = ych + ((SEGLEN - 1) & 1) * 256;
          if (half == 0) YS[prevoff] = yr[lane] + yr[128 + lane]; else PR[prevoff] = yr[64 + lane] + yr[192 + lane]; }
        float* o = PL + (((size_t)(chain * NSEG + seg) * 2) * 64 + lane) * 64 + 32 * half;
#pragma unroll
        for (int i = 0; i < 16; i += 2) { *(f32x4*)(o + 2 * i) = (f32x4){SL[i].x, SL[i].y, SL[i + 1].x, SL[i + 1].y}; *(f32x4*)(o + 4096 + 2 * i) = (f32x4){SI[i].x, SI[i].y, SI[i + 1].x, SI[i + 1].y}; }
        __syncthreads();
    }
}
__device__ __forceinline__ void phase_m5(const Args& a, unsigned char* lds, int G, int bid, int tid) {
    unsigned char* ws = karg_ws(); const float* PL = (const float*)(ws + M_PL); float* SI = (float*)(ws + M_SINIT);
    float* Sx = (float*)lds;
    const int lane = tid & 63, wv = __builtin_amdgcn_readfirstlane(tid >> 6), fr = lane & 15, fq = lane >> 4;
    const bool act = wv < 4;
    for (int u = bid; u < 64; u += G) {
        const int chain = u >> 2, row0 = (u & 3) * 16, col = (wv & 3) * 16 + fr;
        const float* Pg = PL + ((size_t)(chain * NSEG) * 2 + 1) * 4096; const float* Lg = PL + ((size_t)(chain * NSEG) * 2) * 4096;
        float* SIc = SI + (size_t)(chain * NSEG) * 4096;
        f32x4 cur = {0.f, 0.f, 0.f, 0.f}; f32x4 lv[3]; float pb[3][16];
#pragma unroll
        for (int q = 0; q < 3; ++q) { lv[q] = cur;
            if (act) { const float* Pn = Pg + (size_t)q * 8192; const float* Ln = Lg + (size_t)q * 8192;
#pragma unroll
                for (int ks = 0; ks < 16; ++ks) pb[q][ks] = Pn[(4 * ks + fq) * 64 + col];
#pragma unroll
                for (int j = 0; j < 4; ++j) lv[q][j] = Ln[(row0 + fq * 4 + j) * 64 + col]; } }
        for (int g0 = 0; g0 < NSEG - 1; g0 += 3) {
#pragma unroll
            for (int q = 0; q < 3; ++q) { const int g = g0 + q;
                if (act) {
#pragma unroll
                    for (int j = 0; j < 4; ++j) { SIc[(size_t)g * 4096 + (row0 + fq * 4 + j) * 64 + col] = cur[j]; Sx[(fq * 4 + j) * 68 + col] = cur[j]; }
                }
                __syncthreads();
                if (act) {
                    f32x4 acc = lv[q];
#pragma unroll
                    for (int ks = 0; ks < 16; ++ks) { const float av = Sx[fr * 68 + 4 * ks + fq]; acc = __builtin_amdgcn_mfma_f32_16x16x4f32(av, pb[q][ks], acc, 0, 0, 0); }
                    cur = acc;
                    if (g + 3 < NSEG - 1) { const float* Pn = Pg + (size_t)(g + 3) * 8192; const float* Ln = Lg + (size_t)(g + 3) * 8192;
#pragma unroll
                        for (int ks = 0; ks < 16; ++ks) pb[q][ks] = Pn[(4 * ks + fq) * 64 + col];
#pragma unroll
                        for (int j = 0; j < 4; ++j) lv[q][j] = Ln[(row0 + fq * 4 + j) * 64 + col]; }
                }
                __syncthreads();
            }
        }
        if (act) {
#pragma unroll
            for (int j = 0; j < 4; ++j) SIc[(size_t)(NSEG - 1) * 4096 + (row0 + fq * 4 + j) * 64 + col] = cur[j];
        }
    }
}
__device__ __forceinline__ void phase_m6(const Args& a, unsigned char* lds, int G, int bid, int tid) {
    const int lane = tid & 63, wave = __builtin_amdgcn_readfirstlane(tid >> 6);
    unsigned char* ws = karg_ws(); const float* SI = (const float*)(ws + M_SINIT);
    float* wl = (float*)lds + wave * 256;
    for (int task = bid * 8 + wave; task < 16 * (NSEG - 1); task += G * 8) {
        const int seg = 1 + task % (NSEG - 1), chain = task / (NSEG - 1);
        const int d = chain & 1, h = (chain >> 1) & 3, b = chain >> 3;
        float* YS = (float*)(ws + M_YS) + (size_t)d * NR * 256; const float* PR = (const float*)(ws + M_PR) + (size_t)d * NR * 256;
        f32x2 S0[32];
        const float* si = SI + ((size_t)(chain * NSEG + seg) * 64 + lane) * 64;
#pragma unroll
        for (int i = 0; i < 32; i += 2) { const f32x4 v = *(const f32x4*)(si + 2 * i); S0[i] = v.lo; S0[i + 1] = v.hi; }
        const int tau0 = seg * SEGLEN;
        size_t o[4]; float p[4], y[4];
#pragma unroll
        for (int k = 0; k < 4; ++k) { o[k] = (size_t)chain_row(b, d, tau0 + k) * 256 + h * 64 + lane; p[k] = PR[o[k]]; y[k] = YS[o[k]]; }
        for (int s = 0; s < SEGLEN; s += 4) {
            size_t c[4]; float yy[4];
#pragma unroll
            for (int k = 0; k < 4; ++k) { wl[k * 64 + lane] = p[k]; c[k] = o[k]; yy[k] = y[k]; }
            if (s + 4 < SEGLEN) {
#pragma unroll
                for (int k = 0; k < 4; ++k) { o[k] = (size_t)chain_row(b, d, tau0 + s + 4 + k) * 256 + h * 64 + lane; p[k] = PR[o[k]]; y[k] = YS[o[k]]; } }
#pragma unroll
            for (int k = 0; k < 4; k += 2) {
                f32x2 a0 = {0.f, 0.f}, a1 = a0, b0 = a0, b1 = a0;
#pragma unroll
                for (int q = 0; q < 16; ++q) { const f32x4 u = *(const f32x4*)(wl + k * 64 + 4 * q), w = *(const f32x4*)(wl + (k + 1) * 64 + 4 * q);
                    a0 += S0[2 * q] * u.lo; a1 += S0[2 * q + 1] * u.hi; b0 += S0[2 * q] * w.lo; b1 += S0[2 * q + 1] * w.hi; }
                const f32x2 ta = a0 + a1, tb = b0 + b1;
                yy[k] += ta.x + ta.y; yy[k + 1] += tb.x + tb.y;
            }
#pragma unroll
            for (int k = 0; k < 4; ++k) YS[c[k]] = yy[k];
            asm volatile("" ::: "memory");
        }
    }
}
__device__ __forceinline__ void phase_m7(const Args& a, int l, int gw, int NGW, int lane) {
    unsigned char* ws = karg_ws();
    const float* Y0 = (const float*)(ws + M_YS); const float* Y1 = Y0 + (size_t)NR * 256;
    const bf16* RR = (const bf16*)(ws + M_RR); const bf16* VV = (const bf16*)(ws + M_VV); const bf16* KD0 = (const bf16*)(ws + M_KD); const bf16* KD1 = (const bf16*)(ws + M_KD + A8);
    const bf16* GC = (const bf16*)(ws + M_GC); bf16* Y = (bf16*)(ws + OFF_XMY);
    for (int r = gw; r < NR; r += NGW) {
#pragma unroll
        for (int h = 0; h < 4; ++h) { const int c = h * 64 + lane; const size_t o = (size_t)r * 256 + c;
            const float ys = Y0[o] + Y1[o];
            const float mu = wave_sum(ys) * (1.f / 64.f); const float dv = ys - mu; const float var = wave_sum(dv * dv) * (1.f / 64.f);
            float ov = dv * rsqrtf(var + 64e-5f) * IN(33)[l * 256 + c] + IN(34)[l * 256 + c];
            const float rv = bf2f(RR[o]), rk = IN(32)[l * 256 + c], vv = bf2f(VV[o]);
            const float b0 = wave_sum(rv * bf2f(KD0[o]) * rk), b1 = wave_sum(rv * bf2f(KD1[o]) * rk);
            ov += (b0 + b1) * vv;
            Y[(size_t)r * DM + 512 + c] = (bf16)f2bf(ov * bf2f(GC[o])); }
    }
}

#define LAS __attribute__((address_space(3)))
#define XB_TMO      128
#define XB_XCNT(j)  (256  + 64 * (j))
#define XB_XSUB(j)  (1280 + 64 * (j))
#define XB_XGEN(j)  (2304 + 64 * (j))
#define XB_TOP      3328
#define XB_TOPGEN   3392
#define XCD_BAR_WORDS 3456
#define XB_SPIN_CAP (1u << 18)

__device__ __forceinline__ unsigned xb_ld(unsigned* p)              { return __hip_atomic_load(p, __ATOMIC_RELAXED, __HIP_MEMORY_SCOPE_AGENT); }
__device__ __forceinline__ unsigned xb_add(unsigned* p, unsigned v) { return __hip_atomic_fetch_add(p, v, __ATOMIC_RELAXED, __HIP_MEMORY_SCOPE_AGENT); }
__device__ __forceinline__ unsigned xb_xcc_id() { return (unsigned)__builtin_amdgcn_s_getreg((3 << 11) | 20) & 0xFu; }
#define XB_SPIN(cond, bar) do { unsigned _sp = 0; while (cond) { __builtin_amdgcn_s_sleep(1); \
    if ((++_sp & 255u) == 0u) { if (xb_ld(&(bar)[XB_TMO])) break; if (_sp > XB_SPIN_CAP) { atomicAdd(&(bar)[XB_TMO], 1u); break; } } } } while (0)

struct XcdBarrier {
    unsigned* bar; unsigned x;
    volatile LAS unsigned* st;
};

__device__ __forceinline__ XcdBarrier xcd_barrier_post(unsigned* bar, volatile LAS unsigned* st) {
    XcdBarrier b; b.bar = bar; b.x = xb_xcc_id(); b.st = st;
    if (threadIdx.x == 0) (void)xb_add(&bar[XB_XCNT(b.x)], 1u);
    return b;
}
__device__ __forceinline__ void xcd_barrier_complete(unsigned* bar, unsigned x, unsigned& nloc, unsigned& nx) {
    const unsigned G = gridDim.x * gridDim.y * gridDim.z;
    unsigned sum, cnt, mine, sp = 0u;
    for (;;) {
        sum = 0u; cnt = 0u; mine = 0u;
#pragma unroll
        for (unsigned j = 0; j < 16; ++j) { const unsigned c = xb_ld(&bar[XB_XCNT(j)]); sum += c; cnt += (c > 0u) ? 1u : 0u; mine = (j == x) ? c : mine; }
        if (sum == G) break;
        __builtin_amdgcn_s_sleep(1);
        if ((++sp & 255u) == 0u) { if (xb_ld(&bar[XB_TMO])) break; if (sp > XB_SPIN_CAP) { atomicAdd(&bar[XB_TMO], 1u); break; } }
    }
    nloc = mine > 0u ? mine : 1u; nx = cnt > 0u ? cnt : 1u;
}

__device__ __forceinline__ void xcd_barrier(const XcdBarrier& b) {
    asm volatile("s_waitcnt vmcnt(0)" ::: "memory");
    __syncthreads();
    if (threadIdx.x == 0) {
        unsigned* bar = b.bar;
        __builtin_amdgcn_s_waitcnt(0);
        unsigned nloc = b.st[0], nx = b.st[1];
        if (nloc == 0u) { xcd_barrier_complete(bar, b.x, nloc, nx); b.st[0] = nloc; b.st[1] = nx; }
        const unsigned old = xb_add(&bar[XB_XSUB(b.x)], 1u);
        const unsigned gen = old / nloc;
        if (old + 1u == (gen + 1u) * nloc) {
            __builtin_amdgcn_fence(__ATOMIC_RELEASE, "agent");
            asm volatile("s_waitcnt vmcnt(0)" ::: "memory");
            const unsigned og = xb_add(&bar[XB_TOP], 1u);
            const unsigned tg = og / nx;
            if (og + 1u == (tg + 1u) * nx) xb_add(&bar[XB_TOPGEN], 1u);
            else XB_SPIN(xb_ld(&bar[XB_TOPGEN]) == tg, bar);
            __builtin_amdgcn_fence(__ATOMIC_ACQUIRE, "agent");
            xb_add(&bar[XB_XGEN(b.x)], 1u);
            asm volatile("s_waitcnt vmcnt(0)" ::: "memory");
        } else {
            XB_SPIN(xb_ld(&bar[XB_XGEN(b.x)]) == gen, bar);
            __builtin_amdgcn_fence(__ATOMIC_ACQUIRE, "agent");
            asm volatile("s_waitcnt vmcnt(0)" ::: "memory");
        }
    }
    __syncthreads();
}

__global__ void __launch_bounds__(512, 2) mega(Args a) {
    extern __shared__ __attribute__((aligned(16))) unsigned char lds[];
    cg::grid_group grid = cg::this_grid();
    const int G = gridDim.x;
    PG8_LAS unsigned char* glds = (PG8_LAS unsigned char*)lds;
#define bid lbid()
#define tid ltid()
#define lane (ltid() & 63)
#define wave (__builtin_amdgcn_readfirstlane(ltid() >> 6))
#define gw (lbid() * 8 + __builtin_amdgcn_readfirstlane(ltid() >> 6))
#define NGW (G * 8)
    { volatile LAS unsigned* st0 = (volatile LAS unsigned*)((LAS unsigned char*)lds + 131072); if (threadIdx.x < 4) st0[threadIdx.x] = 0u; }
    __syncthreads();
    const XcdBarrier xbar = xcd_barrier_post((unsigned*)(karg_ws() + 229376), (volatile LAS unsigned*)((LAS unsigned char*)lds + 131072));
#define GSYNC() do { xcd_barrier(xbar); } while (0)

    phase_modgemv(a, (float*)lds, G, bid, tid);
    convert_weights(a, 0, (float*)(lds + 32768) + wave * (64 * 33), gw, NGW, lane, G, bid, tid);
    grid.sync();
#pragma clang loop unroll(full)
    for (int l = 0; l < 2; ++l) {
        if (l > 0) convert_weights(a, l, (float*)lds + wave * (64 * 33), gw, NGW, lane, G, bid, tid);
        phase_modulate(a, l, 0, gw, NGW, lane);
        GSYNC();
        for (int rp = 0; rp < REP_G1; ++rp)
        {
            unsigned char* ws = karg_ws(); float* outp = karg_out(); float* xctx = (float*)(ws + OFF_XCTX); bf16* XM = (bf16*)(ws + OFF_XMY); bf16* HU = (bf16*)(ws + OFF_HU); const float* modl = (const float*)(ws + OFF_MOD) + (size_t)l * 3 * 9216; (void)xctx; (void)XM; (void)HU; (void)modl; (void)outp;
            pg8::Gemm g{XM, (const bf16*)(ws + W_13A), NR, 2 * DFF, DM}; pg8::StaticOrder S; S.init(NR, 2 * DFF, G, bid);
            EpiSwiglu E{HU};
            pg8::gemm_phase<EpiSwiglu, pg8::StaticOrder, true, true>(glds, g, S, E);
        }
        GSYNC();
        {
            unsigned char* ws = karg_ws(); float* outp = karg_out(); float* xctx = (float*)(ws + OFF_XCTX); bf16* XM = (bf16*)(ws + OFF_XMY); bf16* HU = (bf16*)(ws + OFF_HU); const float* modl = (const float*)(ws + OFF_MOD) + (size_t)l * 3 * 9216; (void)xctx; (void)XM; (void)HU; (void)modl; (void)outp;
            pg8::Gemm g{HU, (const bf16*)(ws + W_2A), NR, DM, DFF}; pg8::StaticOrder S; S.init(NR, DM, G, bid);
            EpiResid E{outp, xctx, modl + 2 * 1024, 0.5f, l == 0 ? IN(0) : outp, l == 0 ? IN(2) : xctx};
            pg8::gemm_phase<EpiResid, pg8::StaticOrder, true, true>(glds, g, S, E);
        }
        GSYNC();
        phase_modulate(a, l, 1, gw, NGW, lane);
        GSYNC();
        {
            unsigned char* ws = karg_ws(); float* outp = karg_out(); float* xctx = (float*)(ws + OFF_XCTX); bf16* XM = (bf16*)(ws + OFF_XMY); bf16* HU = (bf16*)(ws + OFF_HU); const float* modl = (const float*)(ws + OFF_MOD) + (size_t)l * 3 * 9216; (void)xctx; (void)XM; (void)HU; (void)modl; (void)outp;
            pg8::Gemm g{XM, (const bf16*)(ws + W_IN), NR, UC, DM}; pg8::StaticOrder S; S.init(NR, UC, G, bid);
            EpiU E{HU, UC};
            pg8::gemm_phase<EpiU, pg8::StaticOrder, true, true>(glds, g, S, E);
        }
        GSYNC();
        for (int rp = 0; rp < REP_M1; ++rp) { phase_m1(a, l, lds, G, bid, tid);
        GSYNC(); }
        for (int rp = 0; rp < REP_M2; ++rp) { phase_m2(a, l, lds, G, bid, tid);
        GSYNC(); }
        for (int rp = 0; rp < REP_M3; ++rp) { phase_m3(a, l, lds, G, bid, tid);
        GSYNC(); }
        for (int rp = 0; rp < REP_SCAN; ++rp) { phase_m4(a, lds, G, bid, tid);
        GSYNC();
        phase_m5(a, lds, G, bid, tid);
        GSYNC();
        phase_m6(a, lds, G, bid, tid);
        GSYNC(); }
        phase_m7(a, l, gw, NGW, lane);
        GSYNC();
        {
            unsigned char* ws = karg_ws(); float* outp = karg_out(); float* xctx = (float*)(ws + OFF_XCTX); bf16* XM = (bf16*)(ws + OFF_XMY); bf16* HU = (bf16*)(ws + OFF_HU); const float* modl = (const float*)(ws + OFF_MOD) + (size_t)l * 3 * 9216; (void)xctx; (void)XM; (void)HU; (void)modl; (void)outp;
            const int MR = (l == 1) ? NLAT : NR;
            pg8::Gemm g{XM, (const bf16*)(ws + W_OUT), MR, DM, DM}; pg8::StaticOrder S; S.init(MR, DM, G, bid);
            EpiResid E{outp, xctx, modl + 5 * 1024, 1.0f, outp, xctx};
            pg8::gemm_phase<EpiResid, pg8::StaticOrder, true, true>(glds, g, S, E);
        }
        GSYNC();
        phase_modulate(a, l, 2, gw, NGW, lane);
        GSYNC();
        {
            unsigned char* ws = karg_ws(); float* outp = karg_out(); float* xctx = (float*)(ws + OFF_XCTX); bf16* XM = (bf16*)(ws + OFF_XMY); bf16* HU = (bf16*)(ws + OFF_HU); const float* modl = (const float*)(ws + OFF_MOD) + (size_t)l * 3 * 9216; (void)xctx; (void)XM; (void)HU; (void)modl; (void)outp;
            const int MR = (l == 1) ? NLAT : NR;
            pg8::Gemm g{XM, (const bf16*)(ws + W_13B), MR, 2 * DFF, DM}; pg8::StaticOrder S; S.init(MR, 2 * DFF, G, bid);
            EpiSwiglu E{HU};
            pg8::gemm_phase<EpiSwiglu, pg8::StaticOrder, true, true>(glds, g, S, E);
        }
        GSYNC();
        {
            unsigned char* ws = karg_ws(); float* outp = karg_out(); float* xctx = (float*)(ws + OFF_XCTX); bf16* XM = (bf16*)(ws + OFF_XMY); bf16* HU = (bf16*)(ws + OFF_HU); const float* modl = (const float*)(ws + OFF_MOD) + (size_t)l * 3 * 9216; (void)xctx; (void)XM; (void)HU; (void)modl; (void)outp;
            const int MR = (l == 1) ? NLAT : NR;
            pg8::Gemm g{HU, (const bf16*)(ws + W_2B), MR, DM, DFF}; pg8::StaticOrder S; S.init(MR, DM, G, bid);
            EpiResid E{outp, xctx, modl + 8 * 1024, 0.5f, outp, xctx};
            pg8::gemm_phase<EpiResid, pg8::StaticOrder, true, true>(glds, g, S, E);
        }
        GSYNC();
    }
    phase_final(a, gw, NGW, lane);
#undef bid
#undef tid
#undef lane
#undef wave
#undef gw
#undef NGW
}

extern "C" void kernel_launch(void* const* d_in, const int* in_sizes, int n_in, void* d_out, int out_size, void* d_ws, size_t ws_size, hipStream_t stream) {
    static int grid = 0;
    if (grid == 0) {
        int dev = 0, cus = 0, per_cu = 0;
        (void)hipGetDevice(&dev);
        (void)hipDeviceGetAttribute(&cus, hipDeviceAttributeMultiprocessorCount, dev);
        (void)hipFuncSetAttribute((const void*)mega, hipFuncAttributeMaxDynamicSharedMemorySize, LDS_BYTES);
        (void)hipOccupancyMaxActiveBlocksPerMultiprocessor(&per_cu, (const void*)mega, 512, LDS_BYTES);
        if (per_cu < 1) per_cu = 1;
        grid = cus * per_cu;
        if (n_in != 40 || ws_size < WS_NEED) { fprintf(stderr, "kernel_launch: unexpected n_in %d / ws %zu (need %zu)\n", n_in, ws_size, (size_t)WS_NEED); }
    }
    (void)hipMemsetAsync((char*)d_ws + OFF_MOD, 0, MOD_BYTES, stream);
    Args a{};
    for (int i = 0; i < 40; ++i) a.in[i] = (const float*)d_in[i];
    a.out = (float*)d_out; a.ws = (unsigned char*)d_ws;
    void* args[] = {&a};
    hipError_t e = hipLaunchCooperativeKernel((const void*)mega, dim3(grid), dim3(512), args, LDS_BYTES, stream);
    if (e != hipSuccess) fprintf(stderr, "cooperative launch failed: %s (grid %d)\n", hipGetErrorString(e), grid);
}
```

```cpp
#include <hip/hip_runtime.h>
#include <hip/hip_cooperative_groups.h>
#include <cstdio>
#include <cstdint>
namespace cg = cooperative_groups;
namespace pg8 {
#define PG8_LAS __attribute__((address_space(3)))
typedef unsigned short bf16_t;
typedef short bf16x8 __attribute__((ext_vector_type(8)));
typedef float f32x4 __attribute__((ext_vector_type(4)));
typedef unsigned u32x4 __attribute__((ext_vector_type(4)));
constexpr int BM = 256, BK = 64, HALF = 128, HTB = HALF * BK * 2  , STAGE_BYTES = 8 * HTB, NXCD = 8, WGM = 8;

__host__ __device__ __forceinline__ int lds_byte(int r, int c) { const int st = (r >> 4) * 2 + (c >> 5), rr = r & 15, cc = c & 31, ob = rr * 64 + cc * 2; return st * 1024 + (ob ^ (((ob >> 9) & 1) << 5)); }
__host__ __device__ __forceinline__ void stage_rc(int b, int& R, int& C) { const int st = b / 1024, sb = b % 1024, swz = sb ^ (((sb >> 9) & 1) << 5); R = (st >> 1) * 16 + swz / 64; C = (st & 1) * 32 + (swz % 64) / 2; }
__host__ __device__ __forceinline__ int perm32(int rho) { const int n = rho >> 4, i = rho & 15; return 8 * (i >> 2) + 4 * n + (i & 3); }

struct Unit { int pm, pn; };
struct Gemm { const bf16_t* A; const bf16_t* Bt; int M, N, K; };

struct StaticOrder {
    int nM, nN, nwg, G, c;
    __host__ __device__ void init(int M, int N, int G_, int c_) { nM = M / BM; nN = N / BM; nwg = nM * nN; G = G_; c = c_; }
    __host__ __device__ bool next(int i, Unit& u) const {
        const long L = (long)i * G + c; if (L >= nwg) return false;
        int wgid = (int)L; { const int q = nwg / NXCD, r = nwg % NXCD, xcd = wgid % NXCD, off = wgid / NXCD; wgid = (xcd < r ? xcd * (q + 1) : r * (q + 1) + (xcd - r) * q) + off; }
        const int nig = WGM * nN, gid = wgid / nig, fm = gid * WGM, gsz = (nM - fm) < WGM ? (nM - fm) : WGM;
        u.pm = fm + ((wgid % nig) % gsz); u.pn = (wgid % nig) / gsz; return true;
    }
    __device__ __forceinline__ void a_ready(const Unit&) const {}
    __device__ __forceinline__ void done(const Unit&) const {}
};

__device__ __forceinline__ unsigned cvt_pk_bf16(float lo, float hi) { unsigned r; asm volatile("v_cvt_pk_bf16_f32 %0, %1, %2" : "=v"(r) : "v"(lo), "v"(hi)); return r; }
typedef float f32x2 __attribute__((ext_vector_type(2)));
template <class Epi, class Sched, bool ALIGN_EPI = false, bool SP2 = false>
__device__ __forceinline__ void gemm_phase(PG8_LAS unsigned char* lds, const Gemm g, const Sched& S, const Epi& E) {
    int tid = threadIdx.x; asm volatile("" : "+v"(tid));
    const int wid = __builtin_amdgcn_readfirstlane(tid >> 6), lane = tid & 63, wr = wid >> 2, wc = wid & 3, fr = lane & 15, fq = lane >> 4;
    const int K = g.K, nt = K / BK;
    unsigned voffA[2], voffB[2];
#pragma unroll
    for (int i = 0; i < 2; ++i) { int R, C; stage_rc(tid * 16 + i * 8192, R, C); const int Rb = Epi::PERM ? ((R & ~31) + perm32(R & 31)) : R;
        voffA[i] = (unsigned)(R * K + C) * 2u; voffB[i] = (unsigned)(Rb * K + C) * 2u; }
    const size_t kstep = (size_t)(BK * 2);
    const size_t hstep = (size_t)HALF * K * 2;
    const size_t tstep = 2 * hstep;
    const unsigned ldsw = (unsigned)wid * 1024u;
    const int aoff = lds_byte(wr * 64 + fr, fq * 8), boff = lds_byte(wc * 32 + fr, fq * 8);
#define PG8_SA(b, h) (((b) * 2 + (h)) * HTB)
#define PG8_SB(b, h) ((4 + (b) * 2 + (h)) * HTB)
#define PG8_STAGE(bufoff, gbase, voff) do { _Pragma("unroll") for (int _i = 0; _i < 2; ++_i) \
        __builtin_amdgcn_global_load_lds((const unsigned*)((const char*)(gbase) + (voff)[_i]), (PG8_LAS unsigned*)(lds + (bufoff) + ldsw + _i * 8192), 16, 0, 0); } while (0)
#define PG8_LDA(dst, b, h) do { _Pragma("unroll") for (int m = 0; m < 4; ++m) _Pragma("unroll") for (int k = 0; k < 2; ++k) dst[m][k] = *(const PG8_LAS bf16x8*)(lds + PG8_SA(b, h) + aoff + m * 2048 + k * 1024); } while (0)
#define PG8_LDB(dst, b, h) do { _Pragma("unroll") for (int n = 0; n < 2; ++n) _Pragma("unroll") for (int k = 0; k < 2; ++k) dst[n][k] = *(const PG8_LAS bf16x8*)(lds + PG8_SB(b, h) + boff + n * 2048 + k * 1024); } while (0)
#define PG8_MMA(ai, bj, At, Bt) do { __builtin_amdgcn_s_setprio(1); _Pragma("unroll") for (int m = 0; m < 4; ++m) _Pragma("unroll") for (int n = 0; n < 2; ++n) _Pragma("unroll") for (int k = 0; k < 2; ++k) \
        acc[ai][bj][m][n] = __builtin_amdgcn_mfma_f32_16x16x32_bf16(Bt[n][k], At[m][k], acc[ai][bj][m][n], 0, 0, 0); __builtin_amdgcn_s_setprio(0); } while (0)
#define PG8_WAIT_V(n) asm volatile("s_waitcnt vmcnt(" #n ")" ::: "memory")
#define PG8_WAIT_L(n) asm volatile("s_waitcnt lgkmcnt(" #n ")" ::: "memory")
#define PG8_BAR __builtin_amdgcn_s_barrier()
#define PG8_SCHED __builtin_amdgcn_sched_barrier(0)
    Unit cur, nxt; int ui = 0;
    if (!S.next(0, cur)) return;
    f32x4 acc[2][2][4][2];
#pragma unroll
    for (int a = 0; a < 2; ++a)
#pragma unroll
        for (int b = 0; b < 2; ++b)
#pragma unroll
            for (int m = 0; m < 4; ++m)
#pragma unroll
                for (int n = 0; n < 2; ++n) acc[a][b][m][n] = (f32x4){0.f, 0.f, 0.f, 0.f};
    bf16x8 At[4][2], B0[2][2], B1[2][2];
    const char* cA = (const char*)g.A + (size_t)cur.pm * tstep; const char* cB = (const char*)g.Bt + (size_t)cur.pn * tstep;
    S.a_ready(cur);
    if constexpr (SP2) {
        PG8_STAGE(PG8_SB(0, 0), cB, voffB); PG8_STAGE(PG8_SB(0, 1), cB + hstep, voffB); PG8_STAGE(PG8_SA(0, 0), cA, voffA); PG8_STAGE(PG8_SA(0, 1), cA + hstep, voffA);
        if (wr == 1) PG8_BAR;
        PG8_WAIT_V(2); PG8_BAR;
        PG8_STAGE(PG8_SB(1, 0), cB + kstep, voffB); PG8_STAGE(PG8_SA(1, 0), cA + kstep, voffA); PG8_STAGE(PG8_SB(1, 1), cB + hstep + kstep, voffB);
        PG8_WAIT_V(6); PG8_BAR;
    } else {
        PG8_STAGE(PG8_SB(0, 0), cB, voffB); PG8_STAGE(PG8_SA(0, 0), cA, voffA); PG8_STAGE(PG8_SB(0, 1), cB + hstep, voffB); PG8_STAGE(PG8_SA(0, 1), cA + hstep, voffA);
        if (wr == 1) PG8_BAR;
        PG8_WAIT_V(4); PG8_BAR;
        PG8_STAGE(PG8_SB(1, 0), cB + kstep, voffB); PG8_STAGE(PG8_SA(1, 0), cA + kstep, voffA); PG8_STAGE(PG8_SB(1, 1), cB + hstep + kstep, voffB);
        PG8_WAIT_V(6); PG8_BAR;
    }
    for (;;) {
        const bool has_next = S.next(ui + 1, nxt);
        const char* nA = has_next ? (const char*)g.A + (size_t)nxt.pm * tstep : cA; const char* nB = has_next ? (const char*)g.Bt + (size_t)nxt.pn * tstep : cB;
        for (int t = 0; t < nt; t += 2) {
            const bool last = (t == nt - 2);
            const char* a1 = cA + (size_t)(t + 1) * kstep;
            const char* a2 = last ? nA : cA + (size_t)(t + 2) * kstep; const char* b2 = last ? nB : cB + (size_t)(t + 2) * kstep;
            const char* a3 = a2 + kstep; const char* b3 = b2 + kstep;
            if (last && has_next) S.a_ready(nxt);
            if constexpr (SP2) {
            PG8_LDB(B0, 0, 0); PG8_LDB(B1, 0, 1); PG8_SCHED; PG8_LDA(At, 0, 0); PG8_STAGE(PG8_SA(1, 1), a1 + hstep, voffA);
            PG8_WAIT_V(8); PG8_WAIT_L(0); PG8_BAR; PG8_MMA(0, 0, At, B0); PG8_MMA(0, 1, At, B1); PG8_BAR; PG8_SCHED;
            PG8_LDA(At, 0, 1); PG8_STAGE(PG8_SB(0, 0), b2, voffB); PG8_STAGE(PG8_SB(0, 1), b2 + hstep, voffB); PG8_STAGE(PG8_SA(0, 0), a2, voffA);
            PG8_WAIT_V(8); PG8_WAIT_L(0); PG8_BAR; PG8_MMA(1, 0, At, B0); PG8_MMA(1, 1, At, B1); PG8_BAR; PG8_SCHED;
            PG8_LDB(B0, 1, 0); PG8_LDB(B1, 1, 1); PG8_SCHED; PG8_LDA(At, 1, 0); PG8_STAGE(PG8_SA(0, 1), a2 + hstep, voffA);
            PG8_WAIT_V(8); PG8_WAIT_L(0); PG8_BAR; PG8_MMA(0, 0, At, B0); PG8_MMA(0, 1, At, B1); PG8_BAR; PG8_SCHED;
            PG8_LDA(At, 1, 1); PG8_STAGE(PG8_SB(1, 0), b3, voffB); PG8_STAGE(PG8_SB(1, 1), b3 + hstep, voffB); PG8_STAGE(PG8_SA(1, 0), a3, voffA);
            PG8_WAIT_V(8); PG8_WAIT_L(0); PG8_BAR; PG8_MMA(1, 0, At, B0); PG8_MMA(1, 1, At, B1); PG8_BAR; PG8_SCHED;
            } else {
            PG8_LDB(B0, 0, 0); PG8_SCHED; PG8_LDA(At, 0, 0); PG8_STAGE(PG8_SA(1, 1), a1 + hstep, voffA);
            PG8_WAIT_L(8); PG8_BAR; PG8_WAIT_L(0); PG8_MMA(0, 0, At, B0); PG8_BAR; PG8_SCHED;
            PG8_LDB(B1, 0, 1); PG8_STAGE(PG8_SB(0, 0), b2, voffB);
            PG8_BAR; PG8_WAIT_L(0); PG8_MMA(0, 1, At, B1); PG8_BAR;
            PG8_LDA(At, 0, 1); PG8_STAGE(PG8_SA(0, 0), a2, voffA);
            PG8_BAR; PG8_WAIT_L(0); PG8_MMA(1, 0, At, B0); PG8_BAR; PG8_SCHED;
            PG8_STAGE(PG8_SB(0, 1), b2 + hstep, voffB);
            PG8_WAIT_V(6); PG8_BAR; PG8_MMA(1, 1, At, B1); PG8_BAR;
            PG8_LDB(B0, 1, 0); PG8_SCHED; PG8_LDA(At, 1, 0); PG8_STAGE(PG8_SA(0, 1), a2 + hstep, voffA);
            PG8_WAIT_L(8); PG8_BAR; PG8_WAIT_L(0); PG8_MMA(0, 0, At, B0); PG8_BAR; PG8_SCHED;
            PG8_LDB(B1, 1, 1); PG8_STAGE(PG8_SB(1, 0), b3, voffB);
            PG8_BAR; PG8_WAIT_L(0); PG8_MMA(0, 1, At, B1); PG8_BAR;
            PG8_LDA(At, 1, 1); PG8_STAGE(PG8_SA(1, 0), a3, voffA);
            PG8_BAR; PG8_WAIT_L(0); PG8_MMA(1, 0, At, B0); PG8_BAR; PG8_SCHED;
            PG8_STAGE(PG8_SB(1, 1), b3 + hstep, voffB);
            PG8_WAIT_V(6); PG8_BAR; PG8_MMA(1, 1, At, B1); PG8_BAR;
            }
        }
        if constexpr (ALIGN_EPI) { if (wr == 0) PG8_BAR; }
        if constexpr (!Epi::AFTER_DRAIN) { E(acc, cur, wr, wc, fr, fq); S.done(cur); }
        if (!has_next) break;
#pragma unroll
        for (int a = 0; a < 2; ++a)
#pragma unroll
            for (int b = 0; b < 2; ++b)
#pragma unroll
                for (int m = 0; m < 4; ++m)
#pragma unroll
                    for (int n = 0; n < 2; ++n) acc[a][b][m][n] = (f32x4){0.f, 0.f, 0.f, 0.f};
        cur = nxt; cA = nA; cB = nB; ++ui;
        if constexpr (ALIGN_EPI) { if (wr == 1) PG8_BAR; }
    }
    PG8_WAIT_V(0);
    if constexpr (!ALIGN_EPI) { if (wr == 0) PG8_BAR; }
    PG8_BAR;
    if constexpr (Epi::AFTER_DRAIN) { E.fused(acc, cur, wr, wc, fr, fq, lds, wid, lane); S.done(cur); }
#undef PG8_SA
#undef PG8_SB
#undef PG8_STAGE
#undef PG8_LDA
#undef PG8_LDB
#undef PG8_MMA
#undef PG8_WAIT_V
#undef PG8_WAIT_L
#undef PG8_BAR
#undef PG8_SCHED
}
}

using pg8::f32x4; using pg8::bf16x8;
typedef unsigned short bf16;
typedef unsigned v4u __attribute__((ext_vector_type(4)));
typedef unsigned v2u __attribute__((ext_vector_type(2)));
typedef short s16x4 __attribute__((ext_vector_type(4)));

constexpr int DM = 1024, TLEN = 8192, CTXL = 256, TT = 8448, NLAT = 16384, NR = 16896, DFF = 2816, UC = 2560, NTILE = 528;
constexpr int NSEG = 64, SEGLEN = 132;
constexpr size_t MiB = 1u << 20;
constexpr size_t A8 = (size_t)NR * 256 * 2;
constexpr size_t OFF_MOD = 0, MOD_BYTES = 256 * 1024;
constexpr size_t OFF_XCTX = MiB / 4, OFF_XMY = 2 * MiB + MiB / 4, OFF_HU = 35 * MiB + MiB / 4, OFF_W = 126 * MiB, OFF_MIX = 167 * MiB, OFF_PR = 266 * MiB;
constexpr size_t W_13A = OFF_W, W_2A = OFF_W + 11 * MiB, W_13B = OFF_W + 16 * MiB + MiB / 2, W_2B = OFF_W + 27 * MiB + MiB / 2,
                 W_IN = OFF_W + 33 * MiB, W_OUT = OFF_W + 38 * MiB, W_UQ = OFF_W + 40 * MiB, W_UKV = OFF_W + 40 * MiB + 256 * 1024,
                 W_WUP = OFF_W + 40 * MiB + 384 * 1024, W_AUP = W_WUP + 65536, W_GUP = W_AUP + 65536, W_LWA = W_GUP + 65536, W_LWX = W_LWA + 65536;
constexpr size_t M_QB = OFF_MIX, M_KB = OFF_MIX + 12976128, M_VT = OFF_MIX + 25952256;
constexpr size_t M_LR0 = OFF_PR, M_LIX0 = OFF_PR + 2 * A8;
constexpr size_t M_SEGA = OFF_HU + 83 * MiB, M_SEGB = M_SEGA + MiB + MiB / 4, M_H0 = M_SEGB + MiB + MiB / 4;
constexpr size_t M_RR = OFF_MIX, M_KK = OFF_MIX + A8, M_VV = OFF_MIX + 2 * A8, M_WW = OFF_MIX + 3 * A8, M_BB = OFF_MIX + 7 * A8, M_KD = OFF_MIX + 9 * A8, M_GC = OFF_MIX + 11 * A8;
constexpr size_t M_YS = OFF_HU, M_PL = OFF_HU + 33 * MiB, M_SINIT = OFF_HU + 65 * MiB;
constexpr size_t M_PR = OFF_PR;
constexpr size_t WS_NEED = OFF_PR + 33 * MiB;
constexpr int LDS_BYTES = 131072 + 1024;
#ifndef REP_M1
#define REP_M1 1
#endif
#ifndef REP_M2
#define REP_M2 1
#endif
#ifndef REP_M3
#define REP_M3 1
#endif
#ifndef REP_SCAN
#define REP_SCAN 1
#endif
#ifndef REP_G1
#define REP_G1 1
#endif
constexpr float QSCALE = 0.10206207261596575f * 1.4426950408889634f;

struct Args { const float* in[40]; float* out; unsigned char* ws; };
typedef const __attribute__((address_space(4))) volatile unsigned long long kargq;
__device__ __forceinline__ const float* karg_in(int i) { kargq* p = (kargq*)__builtin_amdgcn_kernarg_segment_ptr(); return (const float*)p[i]; }
__device__ __forceinline__ float* karg_out() { kargq* p = (kargq*)__builtin_amdgcn_kernarg_segment_ptr(); return (float*)p[40]; }
__device__ __forceinline__ unsigned char* karg_ws() { kargq* p = (kargq*)__builtin_amdgcn_kernarg_segment_ptr(); return (unsigned char*)p[41]; }
#define IN(i) karg_in(i)
__device__ __forceinline__ int ltid() { int t = threadIdx.x; asm volatile("" : "+v"(t)); return t; }
__device__ __forceinline__ int lbid() { int t = blockIdx.x; asm volatile("" : "+s"(t)); return t; }
template <class T> __device__ __forceinline__ T* launder(T* p) { asm volatile("" : "+s"(p)); return p; }

__device__ __forceinline__ float bf2f(bf16 h) { return __uint_as_float((unsigned)h << 16); }
__device__ __forceinline__ unsigned f2bf(float f) { unsigned u = __float_as_uint(f); return (u + 0x7fffu + ((u >> 16) & 1u)) >> 16; }
__device__ __forceinline__ unsigned pk2(float lo, float hi) { return f2bf(lo) | (f2bf(hi) << 16); }
__device__ __forceinline__ float sigm(float x) { return __builtin_amdgcn_rcpf(1.f + __expf(-x)); }
__device__ __forceinline__ float siluf_(float x) { return x * __builtin_amdgcn_rcpf(1.f + __expf(-x)); }
__device__ __forceinline__ float tanhf_(float y) { return 1.f - 2.f * __builtin_amdgcn_rcpf(1.f + __expf(2.f * y)); }
__device__ __forceinline__ float geluf_(float x) { return 0.5f * x * (1.f + tanhf_(0.7978845608028654f * (x + 0.044715f * x * x * x))); }
template <int CTRL> __device__ __forceinline__ float dppf(float v) { return __int_as_float(__builtin_amdgcn_update_dpp(0, __float_as_int(v), CTRL, 0xF, 0xF, true)); }
__device__ __forceinline__ float rows4_max(float v) {
    auto a = __builtin_amdgcn_permlane16_swap(__float_as_uint(v), __float_as_uint(v), false, false); v = fmaxf(__uint_as_float(a[0]), __uint_as_float(a[1]));
    auto b = __builtin_amdgcn_permlane32_swap(__float_as_uint(v), __float_as_uint(v), false, false); return fmaxf(__uint_as_float(b[0]), __uint_as_float(b[1]));
}
__device__ __forceinline__ float rows4_sum(float v) {
    auto a = __builtin_amdgcn_permlane16_swap(__float_as_uint(v), __float_as_uint(v), false, false); v = __uint_as_float(a[0]) + __uint_as_float(a[1]);
    auto b = __builtin_amdgcn_permlane32_swap(__float_as_uint(v), __float_as_uint(v), false, false); return __uint_as_float(b[0]) + __uint_as_float(b[1]);
}
__device__ __forceinline__ float wave_sum(float v) {
    v += dppf<0xB1>(v); v += dppf<0x4E>(v); v += dppf<0x141>(v); v += dppf<0x140>(v);
    auto a = __builtin_amdgcn_permlane16_swap(__float_as_uint(v), __float_as_uint(v), false, false); v = __uint_as_float(a[0]) + __uint_as_float(a[1]);
    auto b = __builtin_amdgcn_permlane32_swap(__float_as_uint(v), __float_as_uint(v), false, false); return __uint_as_float(b[0]) + __uint_as_float(b[1]);
}
struct TileInfo { int b, isctx, t0, seqbase, seqlen; };
__device__ __forceinline__ TileInfo tile_info(int tile) {
    TileInfo ti;
    if (tile < 512) { ti.b = tile >> 8; ti.isctx = 0; ti.t0 = (tile & 255) * 32; ti.seqbase = ti.b * TLEN; ti.seqlen = TLEN; }
    else { const int q = tile - 512; ti.b = q >> 3; ti.isctx = 1; ti.t0 = (q & 7) * 32; ti.seqbase = NLAT + ti.b * CTXL; ti.seqlen = CTXL; }
    return ti;
}

struct EpiSwiglu {
    static constexpr bool PERM = true, AFTER_DRAIN = false;
    bf16* H;
    __device__ __forceinline__ void operator()(const f32x4 (&acc)[2][2][4][2], const pg8::Unit& u, int wr, int wc, int fr, int fq) const {
        int pm = u.pm, pn = u.pn; asm volatile("" : "+s"(pm), "+s"(pn), "+s"(wr), "+s"(wc), "+v"(fr), "+v"(fq));
        bf16* tb = H + (size_t)pm * 256 * DFF + pn * 128;
        const unsigned loff = (unsigned)((wr * 64 + fr) * DFF + wc * 32 + 8 * fq);
#pragma unroll
        for (int ai = 0; ai < 2; ++ai)
#pragma unroll
            for (int m = 0; m < 4; ++m) {
                bf16* rowp = tb + (loff + (unsigned)((ai * 128 + m * 16) * DFF));
                const f32x4 g0 = acc[ai][0][m][0], g1 = acc[ai][0][m][1], u0 = acc[ai][1][m][0], u1 = acc[ai][1][m][1];
                v4u w;
                w.x = pg8::cvt_pk_bf16(siluf_(g0[0]) * u0[0], siluf_(g0[1]) * u0[1]); w.y = pg8::cvt_pk_bf16(siluf_(g0[2]) * u0[2], siluf_(g0[3]) * u0[3]);
                w.z = pg8::cvt_pk_bf16(siluf_(g1[0]) * u1[0], siluf_(g1[1]) * u1[1]); w.w = pg8::cvt_pk_bf16(siluf_(g1[2]) * u1[2], siluf_(g1[3]) * u1[3]);
                *(v4u*)rowp = w;
            }
    }
};
struct EpiU {
    static constexpr bool PERM = true, AFTER_DRAIN = false;
    bf16* O; int ldc;
    __device__ __forceinline__ void operator()(const f32x4 (&acc)[2][2][4][2], const pg8::Unit& u, int wr, int wc, int fr, int fq) const {
        int pm = u.pm, pn = u.pn; asm volatile("" : "+s"(pm), "+s"(pn), "+s"(wr), "+s"(wc), "+v"(fr), "+v"(fq));
        bf16* tb = O + (size_t)pm * 256 * ldc + pn * 256;
        const unsigned loff = (unsigned)((wr * 64 + fr) * ldc + wc * 32 + 8 * fq);
#pragma unroll
        for (int ai = 0; ai < 2; ++ai)
#pragma unroll
            for (int m = 0; m < 4; ++m) {
                bf16* rowp = tb + (loff + (unsigned)((ai * 128 + m * 16) * ldc));
#pragma unroll
                for (int bj = 0; bj < 2; ++bj) { const f32x4 v0 = acc[ai][bj][m][0], v1 = acc[ai][bj][m][1]; v4u w;
                    w.x = pg8::cvt_pk_bf16(v0[0], v0[1]); w.y = pg8::cvt_pk_bf16(v0[2], v0[3]); w.z = pg8::cvt_pk_bf16(v1[0], v1[1]); w.w = pg8::cvt_pk_bf16(v1[2], v1[3]);
                    *(v4u*)(rowp + bj * 128) = w; }
            }
    }
};
struct EpiResid {
    static constexpr bool PERM = false, AFTER_DRAIN = false;
    float* xlat; float* xctx; const float* gate; float coef; const float* slat; const float* sctx;
    __device__ __forceinline__ void operator()(const f32x4 (&acc)[2][2][4][2], const pg8::Unit& u, int wr, int wc, int fr, int fq) const {
        int pm = u.pm, pn = u.pn; asm volatile("" : "+s"(pm), "+s"(pn), "+s"(wr), "+s"(wc), "+v"(fr), "+v"(fq));
        const size_t toff = (pm < 64 ? (size_t)pm : (size_t)(pm - 64)) * 256 * DM + pn * 256;
        float* tb = (pm < 64 ? xlat : xctx) + toff; const float* sb = (pm < 64 ? slat : sctx) + toff;
        const float* g = gate + (pm < 64 ? (pm >> 5) : 2) * 9216 + pn * 256;
        const unsigned coff = (unsigned)(wc * 32 + 4 * fq), loff = (unsigned)((wr * 64 + fr) * DM) + coff;
        f32x4 gv[2][2];
#pragma unroll
        for (int bj = 0; bj < 2; ++bj)
#pragma unroll
            for (int n = 0; n < 2; ++n) gv[bj][n] = coef * *(const f32x4*)(g + (coff + (unsigned)(bj * 128 + n * 16)));
#pragma unroll
        for (int ai = 0; ai < 2; ++ai)
#pragma unroll
            for (int m = 0; m < 4; ++m) {
                float* xr = tb + (loff + (unsigned)((ai * 128 + m * 16) * DM)); const float* sr = sb + (loff + (unsigned)((ai * 128 + m * 16) * DM));
#pragma unroll
                for (int bj = 0; bj < 2; ++bj)
#pragma unroll
                    for (int n = 0; n < 2; ++n) { float* xp = xr + (bj * 128 + n * 16);
                        f32x4 xv = *(const f32x4*)(sr + (bj * 128 + n * 16)); xv += gv[bj][n] * acc[ai][bj][m][n]; *(f32x4*)xp = xv; }
                asm volatile("" ::: "memory");
            }
    }
};

__device__ __forceinline__ void phase_modgemv(const Args& a, float* red, int G, int bid, int tid) {
    const float* c = IN(1); const float* cctx = IN(3); const float* ada_w = IN(4); const float* ada_b = IN(5);
    float* mod = (float*)(karg_ws() + OFF_MOD);
    const int w = tid >> 6, lane = tid & 63;
    for (int u = bid; u < 576; u += G) {
        const int l = u / 288, rem = u % 288, jt = rem >> 3, ks = rem & 7;
        const int kb = ks * 128 + w * 16, j0 = jt * 256 + lane * 4;
        f32x4 acc0 = {0.f, 0.f, 0.f, 0.f}, acc1 = acc0, acc2 = acc0;
        for (int kk = 0; kk < 16; ++kk) { const int k = kb + kk;
            const float s0 = siluf_(c[k]), s1 = siluf_(c[1024 + k]), s2 = siluf_(cctx[k]);
            const f32x4 wv = *(const f32x4*)(ada_w + ((size_t)(l * 1024 + k)) * 9216 + j0);
            acc0 += s0 * wv; acc1 += s1 * wv; acc2 += s2 * wv; }
        float* rp = red + (w * 3) * 256 + lane * 4;
        *(f32x4*)rp = acc0; *(f32x4*)(rp + 256) = acc1; *(f32x4*)(rp + 512) = acc2;
        __syncthreads();
        for (int o = tid; o < 768; o += 512) { const int m = o >> 8, jj = o & 255; float s = 0.f;
#pragma unroll
            for (int ww = 0; ww < 8; ++ww) s += red[(ww * 3 + m) * 256 + jj];
            const int j = jt * 256 + jj; if (ks == 0) s += ada_b[l * 9216 + j];
            atomicAdd(&mod[(l * 3 + m) * 9216 + j], s); }
        __syncthreads();
    }
}
__device__ __forceinline__ void phase_copy(const Args& a, int G, int bid, int tid) {
    const f32x4* x4 = (const f32x4*)IN(0); f32x4* o4 = (f32x4*)karg_out();
    for (int i = bid * 512 + tid; i < NLAT * DM / 4; i += G * 512) o4[i] = x4[i];
    const f32x4* c4 = (const f32x4*)IN(2); f32x4* xc4 = (f32x4*)(karg_ws() + OFF_XCTX);
    for (int i = bid * 512 + tid; i < 512 * DM / 4; i += G * 512) xc4[i] = c4[i];
}
__device__ __forceinline__ int swiglu_map(int n) { return n < DFF ? ((n >> 7) * 256 + (n & 127)) : ((((n - DFF) >> 7) * 256) + 128 + ((n - DFF) & 127)); }
__device__ __forceinline__ void transpose_item(const float* W, int K, int N, bf16* WT, float* scr, int item, int lane, int mode, const float* kscale) {
    const int nblk = N / 32, kb = item / nblk, nb = item % nblk, k0 = 64 * kb, n0 = 32 * nb;
    float tv[32];
#pragma unroll
    for (int i = 0; i < 32; ++i) { const int kk = 2 * i + (lane >> 5); tv[i] = W[(size_t)(k0 + kk) * N + n0 + (lane & 31)]; }
#pragma unroll
    for (int i = 0; i < 32; ++i) { const int kk = 2 * i + (lane >> 5); float v = tv[i]; if (kscale) v *= kscale[k0 + kk]; scr[kk * 33 + (lane & 31)] = v; }
    __builtin_amdgcn_wave_barrier();
    const int c = lane & 7;
#pragma unroll
    for (int j = 0; j < 4; ++j) { const int n = (lane >> 3) + 8 * j; const float* s = scr + (8 * c) * 33 + n;
        v4u o; o.x = pk2(s[0 * 33], s[1 * 33]); o.y = pk2(s[2 * 33], s[3 * 33]); o.z = pk2(s[4 * 33], s[5 * 33]); o.w = pk2(s[6 * 33], s[7 * 33]);
        const int nn = n0 + n, drow = mode ? swiglu_map(nn) : nn;
        *(v4u*)(WT + (size_t)drow * K + k0 + 8 * c) = o; }
    __builtin_amdgcn_wave_barrier();
}
__device__ __forceinline__ void convert_weights(const Args& a, int l, float* scr, int gw, int NGW, int lane, int G, int bid, int tid) {
    constexpr int I13 = 16 * 176, I2 = 44 * 32, IIN = 16 * 77, IOUT = 16 * 32, IUQ = 4 * 12, IUKV = 2 * 16;
    constexpr int IEX = 80;
    constexpr int NIT = 2 * I13 + 2 * I2 + IIN + IOUT + IUQ + IUKV + IEX;
    unsigned char* ws = karg_ws();
    for (int it = gw; it < NIT; it += NGW) {
        int r = it;
        if (r < I13) { transpose_item(IN(6) + (size_t)l * DM * 2 * DFF, DM, 2 * DFF, (bf16*)(ws + W_13A), scr, r, lane, 1, nullptr); continue; } r -= I13;
        if (r < I13) { transpose_item(IN(8) + (size_t)l * DM * 2 * DFF, DM, 2 * DFF, (bf16*)(ws + W_13B), scr, r, lane, 1, nullptr); continue; } r -= I13;
        if (r < I2) { transpose_item(IN(7) + (size_t)l * DFF * DM, DFF, DM, (bf16*)(ws + W_2A), scr, r, lane, 0, nullptr); continue; } r -= I2;
        if (r < I2) { transpose_item(IN(9) + (size_t)l * DFF * DM, DFF, DM, (bf16*)(ws + W_2B), scr, r, lane, 0, nullptr); continue; } r -= I2;
        if (r < IIN) { transpose_item(IN(10) + (size_t)l * DM * 2464, DM, 2464, (bf16*)(ws + W_IN), scr, r, lane, 0, nullptr); continue; } r -= IIN;
        if (r < IOUT) { transpose_item(IN(11) + (size_t)l * DM * DM, DM, DM, (bf16*)(ws + W_OUT), scr, r, lane, 0, nullptr); continue; } r -= IOUT;
        if (r < IUQ) { transpose_item(IN(36) + (size_t)l * 256 * 384, 256, 384, (bf16*)(ws + W_UQ), scr, r, lane, 0, IN(35) + l * 256); continue; } r -= IUQ;
        if (r < IUKV) { transpose_item(IN(38) + (size_t)l * 128 * 512, 128, 512, (bf16*)(ws + W_UKV), scr, r, lane, 0, IN(37) + l * 128); continue; } r -= IUKV;
        if (r < 16) { const int d = r >> 3; transpose_item(IN(26) + (size_t)(l * 2 + d) * 64 * 256, 64, 256, (bf16*)(ws + W_WUP) + d * 256 * 64, scr, r & 7, lane, 0, nullptr); continue; } r -= 16;
        if (r < 16) { const int d = r >> 3; transpose_item(IN(28) + (size_t)(l * 2 + d) * 64 * 256, 64, 256, (bf16*)(ws + W_AUP) + d * 256 * 64, scr, r & 7, lane, 0, nullptr); continue; } r -= 16;
        if (r < 16) { transpose_item(IN(29) + (size_t)l * 128 * 256, 128, 256, (bf16*)(ws + W_GUP), scr, r, lane, 0, nullptr); continue; } r -= 16;
        if (r < 16) { const int m = r >> 1; transpose_item(IN(18) + (size_t)(l * 8 + m) * 4096, 64, 64, (bf16*)(ws + W_LWA) + m * 4096, scr, r & 1, lane, 0, nullptr); continue; } r -= 16;
        { const int m = r >> 1; transpose_item(IN(20) + (size_t)(l * 8 + m) * 4096, 64, 64, (bf16*)(ws + W_LWX) + m * 4096, scr, r & 1, lane, 0, nullptr); }
    }
    v4u z = {0u, 0u, 0u, 0u}; v4u* zp = (v4u*)(ws + W_IN + (size_t)2464 * DM * 2);
    for (int i = bid * 512 + tid; i < 96 * DM * 2 / 16; i += G * 512) zp[i] = z;
}
__device__ __forceinline__ void phase_modulate(const Args& a, int l, int which, int gw, int NGW, int lane) {
    unsigned char* ws = karg_ws(); const float* outp = karg_out();
    const bool first = (l == 0 && which == 0);
    const float* srcl = first ? IN(0) : outp; const float* srcc = first ? IN(2) : (const float*)(ws + OFF_XCTX);
    const float* mod = (const float*)(ws + OFF_MOD) + (size_t)l * 3 * 9216;
    bf16* XM = (bf16*)(ws + OFF_XMY);
    for (int r = gw; r < NR; r += NGW) {
        const float* xr = r < NLAT ? srcl + (size_t)r * DM : srcc + (size_t)(r - NLAT) * DM;
        const float* mm = mod + (r < NLAT ? (r >> 13) : 2) * 9216 + which * 3 * 1024;
        f32x4 v[4]; float ss = 0.f;
#pragma unroll
        for (int j = 0; j < 4; ++j) { v[j] = *(const f32x4*)(xr + 4 * lane + 256 * j); ss += (v[j][0] * v[j][0] + v[j][1] * v[j][1]) + (v[j][2] * v[j][2] + v[j][3] * v[j][3]); }
        const float rstd = rsqrtf(wave_sum(ss) * (1.f / DM) + 1e-6f);
#pragma unroll
        for (int j = 0; j < 4; ++j) { const int c = 4 * lane + 256 * j; const f32x4 sh = *(const f32x4*)(mm + c), sc = *(const f32x4*)(mm + 1024 + c);
            const f32x4 o = v[j] * rstd * (1.f + sc) + sh; v2u w; w.x = pk2(o[0], o[1]); w.y = pk2(o[2], o[3]);
            *(v2u*)(XM + (size_t)r * DM + c) = w; }
    }
}
__device__ __forceinline__ void phase_final(const Args& a, int gw, int NGW, int lane) {
    const float* fn = IN(39); float* outp = karg_out();
    for (int r = gw; r < NLAT; r += NGW) {
        float* xr = outp + (size_t)r * DM; f32x4 v[4]; float ss = 0.f;
#pragma unroll
        for (int j = 0; j < 4; ++j) { v[j] = *(const f32x4*)(xr + 4 * lane + 256 * j); ss += (v[j][0] * v[j][0] + v[j][1] * v[j][1]) + (v[j][2] * v[j][2] + v[j][3] * v[j][3]); }
        const float rstd = rsqrtf(wave_sum(ss) * (1.f / DM) + 1e-6f);
#pragma unroll
        for (int j = 0; j < 4; ++j) { const int c = 4 * lane + 256 * j; const f32x4 g = *(const f32x4*)(fn + c); *(f32x4*)(xr + c) = v[j] * rstd * g; }
    }
}

__device__ __forceinline__ void phase_m1(const Args& a, int l, unsigned char* lds, int G, int bid, int tid_unused) {
    unsigned char* ws = karg_ws();
    const bf16* U = (const bf16*)(ws + OFF_HU);
    bf16* Y = (bf16*)(ws + OFF_XMY);
    for (int pass = 0; pass < 2; ++pass)
    for (int tile = (pass == 0 ? bid : (bid < 48 ? 512 + bid / 3 : NTILE)); tile < (pass == 0 ? 512 : NTILE); tile += (pass == 0 ? G : NTILE)) {
        const int mask = pass == 0 ? 7 : ((1 << (bid % 3)) & (l == 1 ? 6 : 7));
        const TileInfo ti = tile_info(tile);
        const int row0 = tile * 32;
        if (mask & 1) {
            const int tid = ltid(); const int lane = tid & 63, wave = __builtin_amdgcn_readfirstlane(tid >> 6), ch = tid & 255, part = tid >> 8; (void)lane; (void)wave; (void)ch; (void)part;
            float* z = (float*)lds;
            float* cv = (float*)(lds + 65536);
            for (int tt = part; tt < 62; tt += 2) { const int t = ti.t0 - 15 + tt; float zz = 0.f;
                if (t >= 0 && t < ti.seqlen) { const bf16* ur = U + (size_t)(ti.seqbase + t) * UC; zz = bf2f(ur[ch]) * sigm(bf2f(ur[256 + ch])); }
                z[tt * 256 + ch] = zz; }
            __syncthreads();
            const float* dw = IN(12) + (size_t)l * 31 * 256 + ch;
            float acc[16]; const float bias = IN(13)[l * 256 + ch];
#pragma unroll
            for (int o = 0; o < 16; ++o) acc[o] = bias;
            for (int j = 0; j < 31; ++j) { const float w = dw[j * 256];
#pragma unroll
                for (int o = 0; o < 16; ++o) acc[o] += w * z[(part * 16 + o + j) * 256 + ch]; }
#pragma unroll
            for (int o = 0; o < 16; ++o) cv[(part * 16 + o) * 256 + ch] = acc[o];
            __syncthreads();
            const f32x4 lg = *(const f32x4*)(IN(14) + l * 256 + lane * 4), lb = *(const f32x4*)(IN(15) + l * 256 + lane * 4);
#pragma unroll
            for (int q = 0; q < 4; ++q) { const int t = wave * 4 + q; const f32x4 v = *(const f32x4*)(cv + t * 256 + lane * 4);
                const float mu = wave_sum((v[0] + v[1]) + (v[2] + v[3])) * (1.f / 256.f);
                const f32x4 dv = v - mu; const float var = wave_sum((dv[0] * dv[0] + dv[1] * dv[1]) + (dv[2] * dv[2] + dv[3] * dv[3])) * (1.f / 256.f);
                const f32x4 yn = dv * rsqrtf(var + 1e-5f) * lg + lb;
                v2u w; w.x = pk2(siluf_(yn[0]), siluf_(yn[1])); w.y = pk2(siluf_(yn[2]), siluf_(yn[3]));
                *(v2u*)(Y + (size_t)(row0 + t) * DM + lane * 4) = w; }
            __syncthreads();
        }
        if (mask & 2) {
            float* xvf = (float*)lds;
            bf16* xvb = (bf16*)(lds + 32768);
            bf16* rg = (bf16*)(lds + 49664);
            bf16* ixg = (bf16*)(lds + 82432);
            {
                const int tid = ltid(); const int ch = tid & 255, part = tid >> 8;
                const float* cw = IN(16) + (size_t)l * 4 * 256 + ch; const float w0 = cw[0], w1 = cw[256], w2 = cw[512], w3 = cw[768], cb = IN(17)[l * 256 + ch];
                float xin[19];
#pragma unroll
                for (int i = 0; i < 19; ++i) { const int t = ti.t0 + part * 16 + i - 2; xin[i] = (t >= 0 && t < ti.seqlen) ? bf2f(U[(size_t)(ti.seqbase + t) * UC + 512 + ch]) : 0.f; }
#pragma unroll
                for (int o = 0; o < 16; ++o) { const int tl = part * 16 + o;
                    const float v = cb + w0 * xin[o] + w1 * xin[o + 1] + w2 * xin[o + 2] + w3 * xin[o + 3];
                    xvf[tl * 256 + ch] = v; xvb[tl * 264 + ch] = (bf16)f2bf(v);
                }
            }
            __syncthreads();
            {
                const int tid = ltid(); const int ln = tid & 63, wv = __builtin_amdgcn_readfirstlane(tid >> 6), fr = ln & 15, fq = ln >> 4, blk = wv >> 1;
                const bf16* LWAt = (const bf16*)(ws + W_LWA); const bf16* LWXt = (const bf16*)(ws + W_LWX);
                bf16x8 af[2][2];
#pragma unroll
                for (int mt = 0; mt < 2; ++mt)
#pragma unroll
                    for (int ks = 0; ks < 2; ++ks) af[mt][ks] = *(const bf16x8*)(xvb + (mt * 16 + fr) * 264 + blk * 64 + ks * 32 + fq * 8);
#pragma unroll 1
                for (int dn = 0; dn < 4; ++dn) { const int d = dn >> 1, nt = wv * 2 + (dn & 1), ch = nt * 16 + fr, jj = (nt & 3) * 16 + fr;
                    f32x4 ca[2], cx[2];
#pragma unroll
                    for (int mt = 0; mt < 2; ++mt) { ca[mt] = (f32x4){0.f, 0.f, 0.f, 0.f}; cx[mt] = ca[mt]; }
#pragma unroll
                    for (int ks = 0; ks < 2; ++ks) { const size_t wo = ((size_t)(d * 4 + blk) * 64 + jj) * 64 + ks * 32 + fq * 8;
                        const bf16x8 ba = *(const bf16x8*)(LWAt + wo), bx = *(const bf16x8*)(LWXt + wo);
#pragma unroll
                        for (int mt = 0; mt < 2; ++mt) { ca[mt] = __builtin_amdgcn_mfma_f32_16x16x32_bf16(af[mt][ks], ba, ca[mt], 0, 0, 0); cx[mt] = __builtin_amdgcn_mfma_f32_16x16x32_bf16(af[mt][ks], bx, cx[mt], 0, 0, 0); } }
                    const float bga = IN(19)[(l * 2 + d) * 256 + ch], bgx = IN(21)[(l * 2 + d) * 256 + ch];
                    bf16* LR = (bf16*)(ws + M_LR0 + (size_t)d * A8); bf16* LIX = (bf16*)(ws + M_LIX0 + (size_t)d * A8);
#pragma unroll
                    for (int mt = 0; mt < 2; ++mt)
#pragma unroll
                        for (int j = 0; j < 4; ++j) { const int t = mt * 16 + fq * 4 + j;
                            const bf16 rb = (bf16)f2bf(sigm(ca[mt][j] + bga)), ib = (bf16)f2bf(sigm(cx[mt][j] + bgx) * xvf[t * 256 + ch]);
                            LR[(size_t)(row0 + t) * 256 + ch] = rb; LIX[(size_t)(row0 + t) * 256 + ch] = ib;
                            rg[(d * 32 + t) * 256 + ch] = rb; ixg[(d * 32 + t) * 256 + ch] = ib; }
                }
            }
            __syncthreads();
            {
                const int tid = ltid(); const int ch = tid & 255, d = tid >> 8;
                const float lam = IN(22)[(l * 2 + d) * 256 + ch];
                const float cch = -8.f * log1pf(__expf(-lam));
                float A = 1.f, B = 0.f;
#pragma unroll 8
                for (int tt = 0; tt < 32; ++tt) { const int t = d ? 31 - tt : tt;
                    const float al = __expf(cch * bf2f(rg[(d * 32 + t) * 256 + ch])); const float bb = sqrtf(fmaxf(1.f - al * al, 0.f)) * bf2f(ixg[(d * 32 + t) * 256 + ch]); B = al * B + bb; A *= al; }
                ((float*)(ws + M_SEGA))[(size_t)(tile * 2 + d) * 256 + ch] = A;
                ((float*)(ws + M_SEGB))[(size_t)(tile * 2 + d) * 256 + ch] = B;
            }
            __syncthreads();
        }
        if (mask & 4) {
            const int tid = ltid(); const int lane = tid & 63, wave = __builtin_amdgcn_readfirstlane(tid >> 6), ch = tid & 255, part = tid >> 8; (void)lane; (void)wave; (void)ch; (void)part;
            bf16* As = (bf16*)lds;
            float* kr = (float*)(lds + 32768);
            float* rs = (float*)(lds + 32768 + 4096);
            for (int idx = tid; idx < 32 * 52; idx += 512) { const int t = idx / 52, cc = idx % 52;
                const v4u v = *(const v4u*)(U + (size_t)(row0 + t) * UC + 2048 + cc * 8);
                if (cc < 48) *(v4u*)(As + t * 392 + cc * 8) = v;
                else { const int c0 = (cc - 48) * 8; float* kp = kr + t * 32 + c0;
                    kp[0] = __uint_as_float(v.x << 16); kp[1] = __uint_as_float(v.x & 0xffff0000u); kp[2] = __uint_as_float(v.y << 16); kp[3] = __uint_as_float(v.y & 0xffff0000u);
                    kp[4] = __uint_as_float(v.z << 16); kp[5] = __uint_as_float(v.z & 0xffff0000u); kp[6] = __uint_as_float(v.w << 16); kp[7] = __uint_as_float(v.w & 0xffff0000u); } }
            __syncthreads();
#pragma unroll
            for (int q = 0; q < 4; ++q) { const int t = wave * 4 + q; float sq = 0.f, sk = 0.f;
#pragma unroll
                for (int j = 0; j < 4; ++j) { const float v = bf2f(As[t * 392 + lane + 64 * j]); sq += v * v; }
#pragma unroll
                for (int j = 0; j < 2; ++j) { const float v = bf2f(As[t * 392 + 256 + lane + 64 * j]); sk += v * v; }
                sq = wave_sum(sq); sk = wave_sum(sk);
                if (lane == 0) { rs[t * 2] = rsqrtf(sq * (1.f / 256.f) + 1e-6f); rs[t * 2 + 1] = rsqrtf(sk * (1.f / 128.f) + 1e-6f); } }
            __syncthreads();
            const int fr = lane & 15, fq = lane >> 4;
            bf16* QB = (bf16*)(ws + M_QB); bf16* KB = (bf16*)(ws + M_KB); bf16* VT = (bf16*)(ws + M_VT);
            const bf16* WUQ = (const bf16*)(ws + W_UQ); const bf16* WUKV = (const bf16*)(ws + W_UKV);
            const int keybase = ti.isctx ? TLEN : 0;
#pragma unroll 1
            for (int i = 0; i < 3; ++i) { const int nt = wave * 3 + i;
                f32x4 c0 = {0.f, 0.f, 0.f, 0.f}, c1 = c0;
#pragma unroll
                for (int ks = 0; ks < 8; ++ks) { const bf16x8 bfr = *(const bf16x8*)(WUQ + (size_t)(nt * 16 + fr) * 256 + ks * 32 + fq * 8);
                    const bf16x8 a0 = *(const bf16x8*)(As + fr * 392 + ks * 32 + fq * 8), a1 = *(const bf16x8*)(As + (16 + fr) * 392 + ks * 32 + fq * 8);
                    c0 = __builtin_amdgcn_mfma_f32_16x16x32_bf16(a0, bfr, c0, 0, 0, 0); c1 = __builtin_amdgcn_mfma_f32_16x16x32_bf16(a1, bfr, c1, 0, 0, 0); }
                const int hq = nt / 6, wt = nt % 6, dd = wt * 16 + fr;
#pragma unroll
                for (int mt = 0; mt < 2; ++mt)
#pragma unroll
                    for (int j = 0; j < 4; ++j) { const int tl = mt * 16 + fq * 4 + j; const int t = ti.t0 + tl;
                        float v = (mt ? c1[j] : c0[j]) * rs[tl * 2];
                        const float pv = dppf<0x128>(v);
                        if (wt >= 4 && !ti.isctx) { const int f = fr & 7; const float pos = (wt == 4) ? (float)(t >> 6) : (float)(t & 63);
                            const float ang = pos * __expf(-(float)f * (9.210340371976184f / 8.f)); float sn, cs; __sincosf(ang, &sn, &cs);
                            v = (fr & 8) ? (v * cs + pv * sn) : (v * cs - pv * sn); }
                        QB[((size_t)(ti.b * 4 + hq) * TT + keybase + t) * 96 + dd] = (bf16)f2bf(v * QSCALE); } }
#pragma unroll 1
            for (int i = 0; i < 4; ++i) { const int nt = wave * 4 + i;
                f32x4 c0 = {0.f, 0.f, 0.f, 0.f}, c1 = c0;
#pragma unroll
                for (int ks = 0; ks < 4; ++ks) { const bf16x8 bfr = *(const bf16x8*)(WUKV + (size_t)(nt * 16 + fr) * 128 + ks * 32 + fq * 8);
                    const bf16x8 a0 = *(const bf16x8*)(As + fr * 392 + 256 + ks * 32 + fq * 8), a1 = *(const bf16x8*)(As + (16 + fr) * 392 + 256 + ks * 32 + fq * 8);
                    c0 = __builtin_amdgcn_mfma_f32_16x16x32_bf16(a0, bfr, c0, 0, 0, 0); c1 = __builtin_amdgcn_mfma_f32_16x16x32_bf16(a1, bfr, c1, 0, 0, 0); }
                const int hk = nt >> 3, wt = nt & 7;
#pragma unroll
                for (int mt = 0; mt < 2; ++mt)
#pragma unroll
                    for (int j = 0; j < 4; ++j) { const int tl = mt * 16 + fq * 4 + j; const int key = keybase + ti.t0 + tl;
                        const float v = (mt ? c1[j] : c0[j]) * rs[tl * 2 + 1];
                        if (wt < 4) KB[((size_t)(ti.b * 4 + hk) * TT + key) * 96 + wt * 16 + fr] = (bf16)f2bf(v);
                        else VT[((size_t)(ti.b * 4 + hk) * 64 + (wt - 4) * 16 + fr) * TT + key] = (bf16)f2bf(v); } }
            { const int tl = tid >> 4, p = tid & 15, ax = p >> 3, f = p & 7; const int t = ti.t0 + tl;
                float x0 = kr[tl * 32 + ax * 16 + f], x1 = kr[tl * 32 + ax * 16 + 8 + f];
                if (!ti.isctx) { const float pos = ax == 0 ? (float)(t >> 6) : (float)(t & 63); const float ang = pos * __expf(-(float)f * (9.210340371976184f / 8.f));
                    float sn, cs; __sincosf(ang, &sn, &cs); const float y0 = x0 * cs - x1 * sn, y1 = x1 * cs + x0 * sn; x0 = y0; x1 = y1; }
                const bf16 b0 = (bf16)f2bf(x0), b1 = (bf16)f2bf(x1);
#pragma unroll
                for (int h = 0; h < 4; ++h) { bf16* kp = KB + ((size_t)(ti.b * 4 + h) * TT + keybase + t) * 96 + 64 + ax * 16 + f; kp[0] = b0; kp[8] = b1; } }
            __syncthreads();
        }
    }
}

__device__ __forceinline__ void attn_unit(unsigned char* lds, const bf16* QB, const bf16* KB, const bf16* VT, bf16* Y, int b, int h, int q0, int key_lo, int nkt, int tid) {
    const int lane = tid & 63, wave = tid >> 6, fr = lane & 15, fq = lane >> 4;
    const int bh = b * 4 + h;
    constexpr int KSTR = 104, VSTR = 72, KBUF = 64 * KSTR, VBUF = 64 * VSTR;
    bf16* Ks = (bf16*)lds;
    bf16* Vs = (bf16*)lds + 2 * KBUF;
    const int qw = q0 + wave * 32;
    bf16x8 qf[2][3];
#pragma unroll
    for (int qt = 0; qt < 2; ++qt)
#pragma unroll
        for (int ks = 0; ks < 3; ++ks) qf[qt][ks] = *(const bf16x8*)(QB + ((size_t)bh * TT + qw + qt * 16 + fr) * 96 + ks * 32 + fq * 8);
    float mrun[2] = {-1e30f, -1e30f}, lrun[2] = {0.f, 0.f};
    f32x4 o[4][2];
#pragma unroll
    for (int dt = 0; dt < 4; ++dt)
#pragma unroll
        for (int qt = 0; qt < 2; ++qt) o[dt][qt] = (f32x4){0.f, 0.f, 0.f, 0.f};
    const v4u* kg = (const v4u*)(KB + ((size_t)bh * TT + key_lo) * 96);
    const bf16* vg = VT + ((size_t)bh * 64 + (tid >> 3)) * TT + key_lo + (tid & 7) * 8;
    const int kc0 = tid, kc1 = 512 + tid;
    const int ko0 = (kc0 / 12) * KSTR + (kc0 % 12) * 8, ko1 = (kc1 / 12) * KSTR + (kc1 % 12) * 8, vo = (tid >> 3) * VSTR + (tid & 7) * 8;
    v4u rk0, rk1 = {0u, 0u, 0u, 0u}, rv;
    rk0 = kg[kc0]; if (tid < 256) rk1 = kg[kc1]; rv = *(const v4u*)vg;
    *(v4u*)(Ks + ko0) = rk0; if (tid < 256) *(v4u*)(Ks + ko1) = rk1; *(v4u*)(Vs + vo) = rv;
    __syncthreads();
    for (int kt = 0; kt < nkt; ++kt) {
        const int cur = kt & 1;
        if (kt + 1 < nkt) { const v4u* kn = kg + (size_t)(kt + 1) * 768; rk0 = kn[kc0]; if (tid < 256) rk1 = kn[kc1]; rv = *(const v4u*)(vg + (kt + 1) * 64); }
        const bf16* kb = Ks + cur * KBUF; const bf16* vb = Vs + cur * VBUF;
        f32x4 st[4][2];
#pragma unroll
        for (int k4 = 0; k4 < 4; ++k4) {
            st[k4][0] = (f32x4){0.f, 0.f, 0.f, 0.f}; st[k4][1] = st[k4][0];
#pragma unroll
            for (int ks = 0; ks < 3; ++ks) { const bf16x8 kf = *(const bf16x8*)(kb + (k4 * 16 + fr) * KSTR + ks * 32 + fq * 8);
                st[k4][0] = __builtin_amdgcn_mfma_f32_16x16x32_bf16(kf, qf[0][ks], st[k4][0], 0, 0, 0);
                st[k4][1] = __builtin_amdgcn_mfma_f32_16x16x32_bf16(kf, qf[1][ks], st[k4][1], 0, 0, 0); }
        }
        bf16x8 pb[2][2];
#pragma unroll
        for (int qt = 0; qt < 2; ++qt) {
            float mx = st[0][qt][0];
#pragma unroll
            for (int k4 = 0; k4 < 4; ++k4)
#pragma unroll
                for (int j = 0; j < 4; ++j) mx = fmaxf(mx, st[k4][qt][j]);
            mx = rows4_max(mx);
            const float mn = fmaxf(mrun[qt], mx), alpha = __builtin_amdgcn_exp2f(mrun[qt] - mn); mrun[qt] = mn;
            float ls = 0.f;
#pragma unroll
            for (int k4 = 0; k4 < 4; ++k4)
#pragma unroll
                for (int j = 0; j < 4; ++j) { const float p = __builtin_amdgcn_exp2f(st[k4][qt][j] - mn); st[k4][qt][j] = p; ls += p; }
            lrun[qt] = lrun[qt] * alpha + ls;
#pragma unroll
            for (int dt = 0; dt < 4; ++dt) o[dt][qt] *= alpha;
#pragma unroll
            for (int u = 0; u < 2; ++u) { v4u w;
                w.x = pg8::cvt_pk_bf16(st[2 * u][qt][0], st[2 * u][qt][1]); w.y = pg8::cvt_pk_bf16(st[2 * u][qt][2], st[2 * u][qt][3]);
                w.z = pg8::cvt_pk_bf16(st[2 * u + 1][qt][0], st[2 * u + 1][qt][1]); w.w = pg8::cvt_pk_bf16(st[2 * u + 1][qt][2], st[2 * u + 1][qt][3]);
                pb[u][qt] = __builtin_bit_cast(bf16x8, w); }
        }
#pragma unroll
        for (int dt = 0; dt < 4; ++dt)
#pragma unroll
            for (int u = 0; u < 2; ++u) {
                const v2u lo = *(const v2u*)(vb + (dt * 16 + fr) * VSTR + 32 * u + 4 * fq), hi = *(const v2u*)(vb + (dt * 16 + fr) * VSTR + 32 * u + 16 + 4 * fq);
                v4u vw; vw.x = lo.x; vw.y = lo.y; vw.z = hi.x; vw.w = hi.y;
                const bf16x8 va = __builtin_bit_cast(bf16x8, vw);
                o[dt][0] = __builtin_amdgcn_mfma_f32_16x16x32_bf16(va, pb[u][0], o[dt][0], 0, 0, 0);
                o[dt][1] = __builtin_amdgcn_mfma_f32_16x16x32_bf16(va, pb[u][1], o[dt][1], 0, 0, 0);
            }
        if (kt + 1 < nkt) { const int nb = cur ^ 1; *(v4u*)(Ks + nb * KBUF + ko0) = rk0; if (tid < 256) *(v4u*)(Ks + nb * KBUF + ko1) = rk1; *(v4u*)(Vs + nb * VBUF + vo) = rv; }
        __syncthreads();
    }
#pragma unroll
    for (int qt = 0; qt < 2; ++qt) {
        const float lt = rows4_sum(lrun[qt]);
        const float inv = 1.f / lt;
        const int q = qw + qt * 16 + fr;
        const size_t row = q < TLEN ? (size_t)b * TLEN + q : (size_t)NLAT + b * CTXL + (q - TLEN);
#pragma unroll
        for (int dt = 0; dt < 4; ++dt) { const f32x4 v = o[dt][qt] * inv; v2u w; w.x = pk2(v[0], v[1]); w.y = pk2(v[2], v[3]);
            *(v2u*)(Y + row * DM + 768 + h * 64 + dt * 16 + fq * 4) = w; }
    }
}
__device__ __forceinline__ void lru_prefix(int bd, int tid) {
    unsigned char* ws = karg_ws();
    if (tid >= 256) return;
    const int ch = tid, b = bd >> 1, d = bd & 1;
    const float* __restrict__ SA = (const float*)(ws + M_SEGA); const float* __restrict__ SB = (const float*)(ws + M_SEGB); float* __restrict__ H0 = (float*)(ws + M_H0);
    const int ctile0 = 512 + b * 8, ltile0 = b * 256;
#define LRU_TILE(i_) ((i_) < 8 ? ctile0 + (d ? 7 - (i_) : (i_)) : ltile0 + (d ? 255 - ((i_) - 8) : ((i_) - 8)))
    float hst = 0.f;
    float ca[24], cb[24], na[24], nb[24];
#pragma unroll
    for (int k = 0; k < 24; ++k) { const size_t o = (size_t)(LRU_TILE(k) * 2 + d) * 256 + ch; ca[k] = SA[o]; cb[k] = SB[o]; }
    for (int i0 = 0; i0 < 264; i0 += 24) {
        if (i0 + 24 < 264) {
#pragma unroll
            for (int k = 0; k < 24; ++k) { const size_t o = (size_t)(LRU_TILE(i0 + 24 + k) * 2 + d) * 256 + ch; na[k] = SA[o]; nb[k] = SB[o]; } }
        float hv[24];
#pragma unroll
        for (int k = 0; k < 24; ++k) { hv[k] = hst; hst = ca[k] * hst + cb[k]; }
#pragma unroll
        for (int k = 0; k < 24; ++k) H0[(size_t)(LRU_TILE(i0 + k) * 2 + d) * 256 + ch] = hv[k];
#pragma unroll
        for (int k = 0; k < 24; ++k) { ca[k] = na[k]; cb[k] = nb[k]; }
    }
#undef LRU_TILE
}
__device__ __forceinline__ void lru_rescan(const Args& a, int l, unsigned char* lds, int tile, int tid) {
    unsigned char* ws = karg_ws();
    const int ch = tid & 255, d = tid >> 8;
    const int row0 = tile * 32;
    float hst = ((const float*)(ws + M_H0))[(size_t)(tile * 2 + d) * 256 + ch];
    const float lam = IN(22)[(l * 2 + d) * 256 + ch];
    const float cch = -8.f * log1pf(__expf(-lam));
    const bf16* LR = (const bf16*)(ws + M_LR0 + (size_t)d * A8); const bf16* LIX = (const bf16*)(ws + M_LIX0 + (size_t)d * A8);
    float* hs = (float*)lds;
#pragma unroll 16
    for (int tt = 0; tt < 32; ++tt) { const int t = d ? 31 - tt : tt; const size_t o = (size_t)(row0 + t) * 256 + ch;
        const float al = __expf(cch * bf2f(LR[o])); const float bb = sqrtf(fmaxf(1.f - al * al, 0.f)) * bf2f(LIX[o]);
        hst = al * hst + bb; hs[(d * 32 + t) * 256 + ch] = hst; }
    __syncthreads();
    const bf16* U = (const bf16*)(ws + OFF_HU); bf16* Y = (bf16*)(ws + OFF_XMY);
#pragma unroll 8
    for (int tt = 0; tt < 16; ++tt) { const int t = d * 16 + tt;
        const float y = (hs[t * 256 + ch] + hs[(32 + t) * 256 + ch]) * geluf_(bf2f(U[(size_t)(row0 + t) * UC + 768 + ch]));
        Y[(size_t)(row0 + t) * DM + 256 + ch] = (bf16)f2bf(y); }
    __syncthreads();
}
__device__ __forceinline__ void phase_m2(const Args& a, int l, unsigned char* lds, int G, int bid, int tid) {
    unsigned char* ws = karg_ws();
    const bf16* QB = (const bf16*)(ws + M_QB); const bf16* KB = (const bf16*)(ws + M_KB); const bf16* VT = (const bf16*)(ws + M_VT);
    bf16* Y = (bf16*)(ws + OFF_XMY);
    const int nunits = (l == 0) ? 264 : 256;
    for (int u = bid; u < nunits; u += G) {
        if (u < 256) attn_unit(lds, QB, KB, VT, Y, u >> 7, (u >> 5) & 3, (u & 31) * 256, 0, 132, tid);
        else attn_unit(lds, QB, KB, VT, Y, (u - 256) >> 2, (u - 256) & 3, TLEN, TLEN, 4, tid);
    }
    if (bid >= G - 4) lru_prefix(bid - (G - 4), tid);
}

__device__ __forceinline__ void phase_m3(const Args& a, int l, unsigned char* lds, int G, int bid, int tid) {
    unsigned char* ws = karg_ws();
    const bf16* U = (const bf16*)(ws + OFF_HU);
    const int lane = tid & 63, ch = tid & 255, part = tid >> 8;
    const float* mup = IN(23) + l * 1024; const float* mun = IN(24) + l * 1024;
    bf16* RR = (bf16*)(ws + M_RR); bf16* KKo = (bf16*)(ws + M_KK); bf16* VV = (bf16*)(ws + M_VV); bf16* GC = (bf16*)(ws + M_GC);
    float* kl = (float*)lds;
    float* kkn = (float*)(lds + 32768);
    bf16* twb = (bf16*)(lds + 65536);
    bf16* tab = (bf16*)(lds + 70144);
    bf16* tgb = (bf16*)(lds + 74752);
    for (int pass = 0; pass < 2; ++pass)
    for (int tile = (pass == 0 ? bid : (bid < 48 ? 512 + bid / 3 : NTILE)); tile < (pass == 0 ? 512 : NTILE); tile += (pass == 0 ? G : NTILE)) {
        const int mask = pass == 0 ? 7 : ((1 << (bid % 3)) & (l == 1 ? 6 : 7));
        const TileInfo ti = tile_info(tile);
        const int row0 = tile * 32;
        if (mask & 1) lru_rescan(a, l, lds, tile, ltid());
        if (mask & 6) {
        {
            const int tid2 = ltid(); const int chunk = tid2 & 127, tg8 = tid2 >> 7, c0 = chunk * 8;
            const bf16* ub = U + (size_t)row0 * UC + 1024 + c0;
            v4u rw[10];
#pragma unroll
            for (int q = 0; q < 10; ++q) { const int tl = tg8 * 8 + q - 1; const int t = ti.t0 + tl;
                rw[q] = (t >= 0 && t < ti.seqlen) ? *(const v4u*)(ub + (ptrdiff_t)tl * UC) : (v4u){0u, 0u, 0u, 0u}; }
            const f32x4 mp0 = *(const f32x4*)(mup + c0), mp1 = *(const f32x4*)(mup + c0 + 4), mn0 = *(const f32x4*)(mun + c0), mn1 = *(const f32x4*)(mun + c0 + 4);
            const float mp[8] = {mp0[0], mp0[1], mp0[2], mp0[3], mp1[0], mp1[1], mp1[2], mp1[3]}, mn[8] = {mn0[0], mn0[1], mn0[2], mn0[3], mn1[0], mn1[1], mn1[2], mn1[3]};
#pragma unroll
            for (int q = 0; q < 8; ++q) { const int tl = tg8 * 8 + q; float ts[8];
#pragma unroll
                for (int e = 0; e < 8; ++e) { const unsigned wm = rw[q][e >> 1], w0 = rw[q + 1][e >> 1], wn = rw[q + 2][e >> 1];
                    const float um = (e & 1) ? __uint_as_float(wm & 0xffff0000u) : __uint_as_float(wm << 16);
                    const float u0 = (e & 1) ? __uint_as_float(w0 & 0xffff0000u) : __uint_as_float(w0 << 16);
                    const float un = (e & 1) ? __uint_as_float(wn & 0xffff0000u) : __uint_as_float(wn << 16);
                    ts[e] = u0 + mp[e] * (um - u0) + mn[e] * (un - u0); }
                if (chunk >= 32 && chunk < 64) { float* kp = kl + tl * 256 + (c0 - 256); *(f32x4*)kp = (f32x4){ts[0], ts[1], ts[2], ts[3]}; *(f32x4*)(kp + 4) = (f32x4){ts[4], ts[5], ts[6], ts[7]}; }
                else {
                    if (chunk >= 96 && chunk < 104) {
#pragma unroll
                        for (int e = 0; e < 8; ++e) ts[e] = tanhf_(ts[e]); }
                    if (chunk >= 112) {
#pragma unroll
                        for (int e = 0; e < 8; ++e) ts[e] = sigm(ts[e]); }
                    v4u o; o.x = pk2(ts[0], ts[1]); o.y = pk2(ts[2], ts[3]); o.z = pk2(ts[4], ts[5]); o.w = pk2(ts[6], ts[7]);
                    if (chunk < 32) *(v4u*)(RR + (size_t)(row0 + tl) * 256 + c0) = o;
                    else if (chunk < 96) *(v4u*)(VV + (size_t)(row0 + tl) * 256 + (c0 - 512)) = o;
                    else if (chunk < 104) *(v4u*)(twb + tl * 72 + (c0 - 768)) = o;
                    else if (chunk < 112) *(v4u*)(tab + tl * 72 + (c0 - 832)) = o;
                    else *(v4u*)(tgb + tl * 136 + (c0 - 896)) = o; }
            }
        }
        __syncthreads();
        {
            const int tid2 = ltid(); const int ch = tid2 & 255, pt = tid2 >> 8; const float kkc = IN(30)[l * 256 + ch];
#pragma unroll 4
            for (int q = 0; q < 16; ++q) { const int t = pt * 16 + q; const float kr = kl[t * 256 + ch] * kkc; const float nrm = wave_sum(kr * kr);
                const float kk = kr * rsqrtf(fmaxf(nrm, 1e-24f)); kkn[t * 256 + ch] = kk; KKo[(size_t)(row0 + t) * 256 + ch] = (bf16)f2bf(kk); }
        }
        __syncthreads();
        {
            const int tid2 = ltid(); const int ln = tid2 & 63, wv = __builtin_amdgcn_readfirstlane(tid2 >> 6), fr = ln & 15, fq = ln >> 4;
            const bf16* WUPt = (const bf16*)(ws + W_WUP); const bf16* AUPt = (const bf16*)(ws + W_AUP); const bf16* GUPt = (const bf16*)(ws + W_GUP);
            bf16x8 aw[2][2], aa[2][2];
#pragma unroll
            for (int mt = 0; mt < 2; ++mt)
#pragma unroll
                for (int ks = 0; ks < 2; ++ks) { aw[mt][ks] = *(const bf16x8*)(twb + (mt * 16 + fr) * 72 + ks * 32 + fq * 8); aa[mt][ks] = *(const bf16x8*)(tab + (mt * 16 + fr) * 72 + ks * 32 + fq * 8); }
#pragma unroll 1
            for (int dn = 0; dn < 4; ++dn) { const int d = dn >> 1, nt = wv * 2 + (dn & 1), ch = nt * 16 + fr;
                if (!((mask >> (1 + d)) & 1)) continue;
                f32x4 cw[2], ca[2];
#pragma unroll
                for (int mt = 0; mt < 2; ++mt) { cw[mt] = (f32x4){0.f, 0.f, 0.f, 0.f}; ca[mt] = cw[mt]; }
#pragma unroll
                for (int ks = 0; ks < 2; ++ks) { const bf16x8 bw = *(const bf16x8*)(WUPt + ((size_t)d * 256 + ch) * 64 + ks * 32 + fq * 8), ba = *(const bf16x8*)(AUPt + ((size_t)d * 256 + ch) * 64 + ks * 32 + fq * 8);
#pragma unroll
                    for (int mt = 0; mt < 2; ++mt) { cw[mt] = __builtin_amdgcn_mfma_f32_16x16x32_bf16(aw[mt][ks], bw, cw[mt], 0, 0, 0); ca[mt] = __builtin_amdgcn_mfma_f32_16x16x32_bf16(aa[mt][ks], ba, ca[mt], 0, 0, 0); } }
                const float w0 = IN(25)[(l * 2 + d) * 256 + ch], a0 = IN(27)[(l * 2 + d) * 256 + ch], kac = IN(31)[l * 256 + ch];
                float* WW = (float*)(ws + M_WW) + (size_t)d * NR * 256; bf16* BB = (bf16*)(ws + M_BB + (size_t)d * A8); bf16* KD = (bf16*)(ws + M_KD + (size_t)d * A8);
#pragma unroll
                for (int mt = 0; mt < 2; ++mt)
#pragma unroll
                    for (int j = 0; j < 4; ++j) { const int t = mt * 16 + fq * 4 + j; const size_t o = (size_t)(row0 + t) * 256 + ch;
                        const float e = sigm(w0 + cw[mt][j]) * 0.6065306597126334f;
                        const float av = sigm(a0 + ca[mt][j]);
                        WW[o] = __expf(-e);
                        KD[o] = (bf16)f2bf(kl[t * 256 + ch] * (1.f + (av - 1.f) * kac));
                        BB[o] = (bf16)f2bf(kkn[t * 256 + ch] * av); }
            }
#pragma unroll 1
            for (int nl = 0; nl < 2; ++nl) { const int ch = (wv * 2 + nl) * 16 + fr;
                if (!(mask & 4)) continue;
                f32x4 cg[2] = {(f32x4){0.f, 0.f, 0.f, 0.f}, (f32x4){0.f, 0.f, 0.f, 0.f}};
#pragma unroll
                for (int ks = 0; ks < 4; ++ks) { const bf16x8 bg = *(const bf16x8*)(GUPt + (size_t)ch * 128 + ks * 32 + fq * 8);
#pragma unroll
                    for (int mt = 0; mt < 2; ++mt) { const bf16x8 ag = *(const bf16x8*)(tgb + (mt * 16 + fr) * 136 + ks * 32 + fq * 8); cg[mt] = __builtin_amdgcn_mfma_f32_16x16x32_bf16(ag, bg, cg[mt], 0, 0, 0); } }
#pragma unroll
                for (int mt = 0; mt < 2; ++mt)
#pragma unroll
                    for (int j = 0; j < 4; ++j) GC[(size_t)(row0 + mt * 16 + fq * 4 + j) * 256 + ch] = (bf16)f2bf(cg[mt][j]);
            }
        }
        __syncthreads();
        }
    }
}

typedef const unsigned cu32;
typedef const float cf32;
__device__ __forceinline__ int chain_row(int b, int d, int tau) {
    return tau < CTXL ? (NLAT + b * CTXL + (d ? CTXL - 1 - tau : tau)) : (b * TLEN + (d ? TLEN - 1 - (tau - CTXL) : (tau - CTXL)));
}
template <int MODE>
__device__ __forceinline__ void rwkv_steps(float (&S)[64], int b, int h, int d, int tau0, int n, unsigned char* ws, int lane, float* wl) {
    const bf16* KKp = (const bf16*)(ws + M_KK); const bf16* RRp = (const bf16*)(ws + M_RR); const bf16* VVp = (const bf16*)(ws + M_VV);
    const float* WWp = (const float*)(ws + M_WW) + (size_t)d * NR * 256; const bf16* BBp = (const bf16*)(ws + M_BB + (size_t)d * A8); const bf16* KDp = (const bf16*)(ws + M_KD + (size_t)d * A8);
    float* YS = (float*)(ws + M_YS) + (size_t)d * NR * 256;
    float pk, pw, pb, pkd = 0.f, pr = 0.f, pv = 0.f; size_t poff;
#define RWKV_LOAD(s_) do { poff = (size_t)chain_row(b, d, tau0 + (s_)) * 256 + h * 64 + lane; pk = bf2f(KKp[poff]); pw = WWp[poff]; pb = bf2f(BBp[poff]); \
        if (MODE != 1) { pkd = bf2f(KDp[poff]); pv = bf2f(VVp[poff]); } if (MODE == 2) pr = bf2f(RRp[poff]); } while (0)
    RWKV_LOAD(0);
    for (int s = 0; s < n; ++s) {
        float* buf = wl + (s & 1) * 320;
        buf[lane] = pk; buf[64 + lane] = pw; buf[128 + lane] = pb;
        if (MODE != 1) buf[192 + lane] = pkd;
        if (MODE == 2) buf[256 + lane] = pr;
        const float vv = pv; const size_t yoff = poff;
        if (s + 1 < n) RWKV_LOAD(s + 1);
        float sa0 = 0.f, sa1 = 0.f, sa2 = 0.f, sa3 = 0.f;
#pragma unroll
        for (int i = 0; i < 64; i += 4) { const f32x4 k4 = *(const f32x4*)(buf + i);
            sa0 += S[i] * k4[0]; sa1 += S[i + 1] * k4[1]; sa2 += S[i + 2] * k4[2]; sa3 += S[i + 3] * k4[3]; }
        const float nsa = -((sa0 + sa1) + (sa2 + sa3));
        float y0 = 0.f, y1 = 0.f, y2 = 0.f, y3 = 0.f;
#pragma unroll
        for (int i = 0; i < 64; i += 4) { const f32x4 w4 = *(const f32x4*)(buf + 64 + i), b4 = *(const f32x4*)(buf + 128 + i);
            f32x4 t = nsa * b4;
            if (MODE != 1) { const f32x4 kd4 = *(const f32x4*)(buf + 192 + i); t += vv * kd4; }
            S[i] = S[i] * w4[0] + t[0]; S[i + 1] = S[i + 1] * w4[1] + t[1]; S[i + 2] = S[i + 2] * w4[2] + t[2]; S[i + 3] = S[i + 3] * w4[3] + t[3];
            if (MODE == 2) { const f32x4 r4 = *(const f32x4*)(buf + 256 + i); y0 += S[i] * r4[0]; y1 += S[i + 1] * r4[1]; y2 += S[i + 2] * r4[2]; y3 += S[i + 3] * r4[3]; } }
        if (MODE == 2) YS[yoff] = (y0 + y1) + (y2 + y3);
    }
#undef RWKV_LOAD
}
typedef float f32x2 __attribute__((ext_vector_type(2)));
__device__ __forceinline__ void rwkv_pass1(f32x2 (&SL)[32], f32x2 (&SI)[32], int b, int h, int d, int tau0, int n, unsigned char* ws, int lane, float* wl) {
    const bf16* KKp = (const bf16*)(ws + M_KK); const bf16* VVp = (const bf16*)(ws + M_VV); const bf16* RRp = (const bf16*)(ws + M_RR);
    const float* WWp = (const float*)(ws + M_WW) + (size_t)d * NR * 256; const bf16* BBp = (const bf16*)(ws + M_BB + (size_t)d * A8); const bf16* KDp = (const bf16*)(ws + M_KD + (size_t)d * A8);
    float* YS = (float*)(ws + M_YS) + (size_t)d * NR * 256; float* PR = (float*)(ws + M_PR) + (size_t)d * NR * 256;
    float pk, pw, pb, pkd, pv, pr; size_t poff;
#define RWKV_LOAD(s_) do { poff = (size_t)chain_row(b, d, tau0 + (s_)) * 256 + h * 64 + lane; pk = bf2f(KKp[poff]); pw = WWp[poff]; pb = bf2f(BBp[poff]); pkd = bf2f(KDp[poff]); pv = bf2f(VVp[poff]); pr = bf2f(RRp[poff]); } while (0)
    RWKV_LOAD(0);
    for (int s = 0; s < n; ++s) {
        float* buf = wl + (s & 1) * 320;
        buf[lane] = pk; buf[64 + lane] = pw; buf[128 + lane] = pb; buf[192 + lane] = pkd; buf[256 + lane] = pr;
        const float vv = pv; const size_t yoff = poff;
        if (s + 1 < n) RWKV_LOAD(s + 1);
        f32x2 aL0 = {0.f, 0.f}, aL1 = aL0, aI0 = aL0, aI1 = aL0;
#pragma unroll
        for (int q = 0; q < 16; ++q) { const f32x4 k4 = *(const f32x4*)(buf + 4 * q);
            aL0 += SL[2 * q] * k4.lo; aL1 += SL[2 * q + 1] * k4.hi; aI0 += SI[2 * q] * k4.lo; aI1 += SI[2 * q + 1] * k4.hi; }
        const f32x2 tL = aL0 + aL1, tI = aI0 + aI1;
        const float nsl = -(tL.x + tL.y), nsi = -(tI.x + tI.y);
        f32x2 yL0 = {0.f, 0.f}, yL1 = yL0, yI0 = yL0, yI1 = yL0;
#pragma unroll
        for (int q = 0; q < 16; ++q) {
            const f32x4 w4 = *(const f32x4*)(buf + 64 + 4 * q), b4 = *(const f32x4*)(buf + 128 + 4 * q), kd4 = *(const f32x4*)(buf + 192 + 4 * q), r4 = *(const f32x4*)(buf + 256 + 4 * q);
            const f32x4 tl = nsl * b4 + vv * kd4, tiv = nsi * b4;
            SL[2 * q] = SL[2 * q] * w4.lo + tl.lo; SL[2 * q + 1] = SL[2 * q + 1] * w4.hi + tl.hi;
            SI[2 * q] = SI[2 * q] * w4.lo + tiv.lo; SI[2 * q + 1] = SI[2 * q + 1] * w4.hi + tiv.hi;
            yL0 += SL[2 * q] * r4.lo; yL1 += SL[2 * q + 1] * r4.hi; yI0 += SI[2 * q] * r4.lo; yI1 += SI[2 * q + 1] * r4.hi; }
        const f32x2 yl = yL0 + yL1, yp = yI0 + yI1;
        YS[yoff] = yl.x + yl.y; PR[yoff] = yp.x + yp.y;
    }
#undef RWKV_LOAD
}
__device__ __forceinline__ void phase_m4(const Args& a, unsigned char* lds, int G, int bid, int tid) {
    const int lane = tid & 63, wave = __builtin_amdgcn_readfirstlane(tid >> 6), half = wave >> 2, tk = wave & 3;
    unsigned char* ws = karg_ws(); float* PL = (float*)(ws + M_PL);
    float* wl = (float*)lds + wave * 320;
    float* xch = (float*)lds + 8 * 320 + tk * 1024;
    float* ych = xch + 512;
    const bf16* KKp = (const bf16*)(ws + M_KK); const bf16* VVp = (const bf16*)(ws + M_VV); const bf16* RRp = (const bf16*)(ws + M_RR);
    for (int task0 = bid * 4; task0 < 16 * NSEG; task0 += G * 4) {
        const int task = task0 + tk; const int seg = task & (NSEG - 1), chain = task >> 6;
        const int d = chain & 1, h = (chain >> 1) & 3, b = chain >> 3;
        const float* WWp = (const float*)(ws + M_WW) + (size_t)d * NR * 256; const bf16* BBp = (const bf16*)(ws + M_BB + (size_t)d * A8); const bf16* KDp = (const bf16*)(ws + M_KD + (size_t)d * A8);
        float* YS = (float*)(ws + M_YS) + (size_t)d * NR * 256; float* PR = (float*)(ws + M_PR) + (size_t)d * NR * 256;
        f32x2 SL[16], SI[16]; int ln = lane; asm volatile("" : "+v"(ln));
#pragma unroll
        for (int i = 0; i < 16; ++i) { SL[i] = (f32x2){0.f, 0.f}; SI[i] = (f32x2){(32 * half + 2 * i == ln) ? 1.f : 0.f, (32 * half + 2 * i + 1 == ln) ? 1.f : 0.f}; }
        const int tau0 = seg * SEGLEN, cidx = h * 64 + 32 * half + (lane & 31);
        unsigned pp; float pw, pv; size_t rowoff, prevoff = 0;
        const int grp = lane >> 4, l15 = lane & 15, l31 = lane & 31;
        const unsigned* srcp = grp == 0 ? (const unsigned*)KKp : grp == 1 ? (const unsigned*)BBp : grp == 2 ? (const unsigned*)KDp : (const unsigned*)RRp;
#define M4_LOAD(s_) do { rowoff = (size_t)chain_row(b, d, tau0 + (s_)) * 256; pp = srcp[(rowoff + h * 64 + 32 * half) / 2 + l15]; \
            pw = (lane < 32) ? WWp[rowoff + cidx] : 0.f; pv = bf2f(VVp[rowoff + h * 64 + lane]); } while (0)
#define UNPK(u_) ((f32x2){__uint_as_float((u_) << 16), __uint_as_float((u_) & 0xffff0000u)})
        M4_LOAD(0);
        for (int s = 0; s < SEGLEN; ++s) {
            float* buf = wl + (s & 1) * 160; const unsigned* bufu = (const unsigned*)buf;
            ((unsigned*)buf)[lane] = pp; if (lane < 32) buf[64 + l31] = pw;
            const float vv = pv; const size_t yoff = rowoff + h * 64 + lane;
            if (s + 1 < SEGLEN) M4_LOAD(s + 1);
            f32x2 aL0 = {0.f, 0.f}, aL1 = aL0, aI0 = aL0, aI1 = aL0;
#pragma unroll
            for (int q = 0; q < 4; ++q) { const v4u k4 = *(const v4u*)(bufu + 4 * q);
                const f32x2 ka = UNPK(k4.x), kb = UNPK(k4.y), kc = UNPK(k4.z), kd_ = UNPK(k4.w);
                aL0 += SL[4 * q] * ka; aL1 += SL[4 * q + 1] * kb; aL0 += SL[4 * q + 2] * kc; aL1 += SL[4 * q + 3] * kd_;
                aI0 += SI[4 * q] * ka; aI1 += SI[4 * q + 1] * kb; aI0 += SI[4 * q + 2] * kc; aI1 += SI[4 * q + 3] * kd_; }
            const f32x2 tL = aL0 + aL1, tI = aI0 + aI1;
            float* xw = xch + (s & 1) * 256;
            xw[half * 128 + lane] = tL.x + tL.y; xw[half * 128 + 64 + lane] = tI.x + tI.y;
            __syncthreads();
            const float nsl = -(xw[lane] + xw[128 + lane]), nsi = -(xw[64 + lane] + xw[192 + lane]);
            if (s > 0) {
                const float* yr = ych + ((s - 1) & 1) * 256;
                if (half == 0) YS[prevoff] = yr[lane] + yr[128 + lane]; else PR[prevoff] = yr[64 + lane] + yr[192 + lane];
            }
            f32x2 yL0 = {0.f, 0.f}, yL1 = yL0, yI0 = yL0, yI1 = yL0;
#pragma unroll
            for (int q = 0; q < 4; ++q) {
                const f32x4 wa = *(const f32x4*)(buf + 64 + 8 * q), wb = *(const f32x4*)(buf + 68 + 8 * q);
                const v4u b4 = *(const v4u*)(bufu + 16 + 4 * q), d4 = *(const v4u*)(bufu + 32 + 4 * q), r4 = *(const v4u*)(bufu + 48 + 4 * q);
                const f32x2 w2[4] = {wa.lo, wa.hi, wb.lo, wb.hi};
                const unsigned bu[4] = {b4.x, b4.y, b4.z, b4.w}, du[4] = {d4.x, d4.y, d4.z, d4.w}, ru[4] = {r4.x, r4.y, r4.z, r4.w};
#pragma unroll
                for (int e = 0; e < 4; ++e) { const int j = 4 * q + e; const f32x2 b2 = UNPK(bu[e]), k2 = UNPK(du[e]), r2 = UNPK(ru[e]);
                    const f32x2 tl = nsl * b2 + vv * k2, tiv = nsi * b2;
                    SL[j] = SL[j] * w2[e] + tl; SI[j] = SI[j] * w2[e] + tiv;
                    if (e & 1) { yL1 += SL[j] * r2; yI1 += SI[j] * r2; } else { yL0 += SL[j] * r2; yI0 += SI[j] * r2; } }
            }
            const f32x2 yl = yL0 + yL1, yp = yI0 + yI1;
            float* yw = ych + (s & 1) * 256;
            yw[half * 128 + lane] = yl.x + yl.y; yw[half * 128 + 64 + lane] = yp.x + yp.y;
            prevoff = yoff;
        }
#undef M4_LOAD
#undef UNPK
        __syncthreads();
        { const float* yr = ych + ((SEGLEN - 1) & 1) * 256;
          if (half == 0) YS[prevoff] = yr[lane] + yr[128 + lane]; else PR[prevoff] = yr[64 + lane] + yr[192 + lane]; }
        float* o = PL + (((size_t)(chain * NSEG + seg) * 2) * 64 + lane) * 64 + 32 * half;
#pragma unroll
        for (int i = 0; i < 16; i += 2) { *(f32x4*)(o + 2 * i) = (f32x4){SL[i].x, SL[i].y, SL[i + 1].x, SL[i + 1].y}; *(f32x4*)(o + 4096 + 2 * i) = (f32x4){SI[i].x, SI[i].y, SI[i + 1].x, SI[i + 1].y}; }
        __syncthreads();
    }
}
__device__ __forceinline__ void phase_m5(const Args& a, unsigned char* lds, int G, int bid, int tid) {
    unsigned char* ws = karg_ws(); const float* PL = (const float*)(ws + M_PL); float* SI = (float*)(ws + M_SINIT);
    float* Sx = (float*)lds;
    const int lane = tid & 63, wv = __builtin_amdgcn_readfirstlane(tid >> 6), fr = lane & 15, fq = lane >> 4;
    const bool act = wv < 4;
    for (int u = bid; u < 64; u += G) {
        const int chain = u >> 2, row0 = (u & 3) * 16, col = (wv & 3) * 16 + fr;
        const float* Pg = PL + ((size_t)(chain * NSEG) * 2 + 1) * 4096; const float* Lg = PL + ((size_t)(chain * NSEG) * 2) * 4096;
        float* SIc = SI + (size_t)(chain * NSEG) * 4096;
        f32x4 cur = {0.f, 0.f, 0.f, 0.f}; f32x4 lv[3]; float pb[3][16];
#pragma unroll
        for (int q = 0; q < 3; ++q) { lv[q] = cur;
            if (act) { const float* Pn = Pg + (size_t)q * 8192; const float* Ln = Lg + (size_t)q * 8192;
#pragma unroll
                for (int ks = 0; ks < 16; ++ks) pb[q][ks] = Pn[(4 * ks + fq) * 64 + col];
#pragma unroll
                for (int j = 0; j < 4; ++j) lv[q][j] = Ln[(row0 + fq * 4 + j) * 64 + col]; } }
        for (int g0 = 0; g0 < NSEG - 1; g0 += 3) {
#pragma unroll
            for (int q = 0; q < 3; ++q) { const int g = g0 + q;
                if (act) {
#pragma unroll
                    for (int j = 0; j < 4; ++j) { SIc[(size_t)g * 4096 + (row0 + fq * 4 + j) * 64 + col] = cur[j]; Sx[(fq * 4 + j) * 68 + col] = cur[j]; }
                }
                __syncthreads();
                if (act) {
                    f32x4 acc = lv[q];
#pragma unroll
                    for (int ks = 0; ks < 16; ++ks) { const float av = Sx[fr * 68 + 4 * ks + fq]; acc = __builtin_amdgcn_mfma_f32_16x16x4f32(av, pb[q][ks], acc, 0, 0, 0); }
                    cur = acc;
                    if (g + 3 < NSEG - 1) { const float* Pn = Pg + (size_t)(g + 3) * 8192; const float* Ln = Lg + (size_t)(g + 3) * 8192;
#pragma unroll
                        for (int ks = 0; ks < 16; ++ks) pb[q][ks] = Pn[(4 * ks + fq) * 64 + col];
#pragma unroll
                        for (int j = 0; j < 4; ++j) lv[q][j] = Ln[(row0 + fq * 4 + j) * 64 + col]; }
                }
                __syncthreads();
            }
        }
        if (act) {
#pragma unroll
            for (int j = 0; j < 4; ++j) SIc[(size_t)(NSEG - 1) * 4096 + (row0 + fq * 4 + j) * 64 + col] = cur[j];
        }
    }
}
__device__ __forceinline__ void phase_m6(const Args& a, unsigned char* lds, int G, int bid, int tid) {
    const int lane = tid & 63, wave = __builtin_amdgcn_readfirstlane(tid >> 6);
    unsigned char* ws = karg_ws(); const float* SI = (const float*)(ws + M_SINIT);
    float* wl = (float*)lds + wave * 256;
    for (int task = bid * 8 + wave; task < 16 * (NSEG - 1); task += G * 8) {
        const int seg = 1 + task % (NSEG - 1), chain = task / (NSEG - 1);
        const int d = chain & 1, h = (chain >> 1) & 3, b = chain >> 3;
        float* YS = (float*)(ws + M_YS) + (size_t)d * NR * 256; const float* PR = (const float*)(ws + M_PR) + (size_t)d * NR * 256;
        f32x2 S0[32];
        const float* si = SI + ((size_t)(chain * NSEG + seg) * 64 + lane) * 64;
#pragma unroll
        for (int i = 0; i < 32; i += 2) { const f32x4 v = *(const f32x4*)(si + 2 * i); S0[i] = v.lo; S0[i + 1] = v.hi; }
        const int tau0 = seg * SEGLEN;
        size_t o[4]; float p[4], y[4];
#pragma unroll
        for (int k = 0; k < 4; ++k) { o[k] = (size_t)chain_row(b, d, tau0 + k) * 256 + h * 64 + lane; p[k] = PR[o[k]]; y[k] = YS[o[k]]; }
        for (int s = 0; s < SEGLEN; s += 4) {
            size_t c[4]; float yy[4];
#pragma unroll
            for (int k = 0; k < 4; ++k) { wl[k * 64 + lane] = p[k]; c[k] = o[k]; yy[k] = y[k]; }
            if (s + 4 < SEGLEN) {
#pragma unroll
                for (int k = 0; k < 4; ++k) { o[k] = (size_t)chain_row(b, d, tau0 + s + 4 + k) * 256 + h * 64 + lane; p[k] = PR[o[k]]; y[k] = YS[o[k]]; } }
#pragma unroll
            for (int k = 0; k < 4; k += 2) {
                f32x2 a0 = {0.f, 0.f}, a1 = a0, b0 = a0, b1 = a0;
#pragma unroll
                for (int q = 0; q < 16; ++q) { const f32x4 u = *(const f32x4*)(wl + k * 64 + 4 * q), w = *(const f32x4*)(wl + (k + 1) * 64 + 4 * q);
                    a0 += S0[2 * q] * u.lo; a1 += S0[2 * q + 1] * u.hi; b0 += S0[2 * q] * w.lo; b1 += S0[2 * q + 1] * w.hi; }
                const f32x2 ta = a0 + a1, tb = b0 + b1;
                yy[k] += ta.x + ta.y; yy[k + 1] += tb.x + tb.y;
            }
#pragma unroll
            for (int k = 0; k < 4; ++k) YS[c[k]] = yy[k];
            asm volatile("" ::: "memory");
        }
    }
}
__device__ __forceinline__ void phase_m7(const Args& a, int l, int gw, int NGW, int lane) {
    unsigned char* ws = karg_ws();
    const float* Y0 = (const float*)(ws + M_YS); const float* Y1 = Y0 + (size_t)NR * 256;
    const bf16* RR = (const bf16*)(ws + M_RR); const bf16* VV = (const bf16*)(ws + M_VV); const bf16* KD0 = (const bf16*)(ws + M_KD); const bf16* KD1 = (const bf16*)(ws + M_KD + A8);
    const bf16* GC = (const bf16*)(ws + M_GC); bf16* Y = (bf16*)(ws + OFF_XMY);
    for (int r = gw; r < NR; r += NGW) {
#pragma unroll
        for (int h = 0; h < 4; ++h) { const int c = h * 64 + lane; const size_t o = (size_t)r * 256 + c;
            const float ys = Y0[o] + Y1[o];
            const float mu = wave_sum(ys) * (1.f / 64.f); const float dv = ys - mu; const float var = wave_sum(dv * dv) * (1.f / 64.f);
            float ov = dv * rsqrtf(var + 64e-5f) * IN(33)[l * 256 + c] + IN(34)[l * 256 + c];
            const float rv = bf2f(RR[o]), rk = IN(32)[l * 256 + c], vv = bf2f(VV[o]);
            const float b0 = wave_sum(rv * bf2f(KD0[o]) * rk), b1 = wave_sum(rv * bf2f(KD1[o]) * rk);
            ov += (b0 + b1) * vv;
            Y[(size_t)r * DM + 512 + c] = (bf16)f2bf(ov * bf2f(GC[o])); }
    }
}

#define LAS __attribute__((address_space(3)))
#define XB_TMO      128
#define XB_XCNT(j)  (256  + 64 * (j))
#define XB_XSUB(j)  (1280 + 64 * (j))
#define XB_XGEN(j)  (2304 + 64 * (j))
#define XB_TOP      3328
#define XB_TOPGEN   3392
#define XCD_BAR_WORDS 3456
#define XB_SPIN_CAP (1u << 18)

__device__ __forceinline__ unsigned xb_ld(unsigned* p)              { return __hip_atomic_load(p, __ATOMIC_RELAXED, __HIP_MEMORY_SCOPE_AGENT); }
__device__ __forceinline__ unsigned xb_add(unsigned* p, unsigned v) { return __hip_atomic_fetch_add(p, v, __ATOMIC_RELAXED, __HIP_MEMORY_SCOPE_AGENT); }
__device__ __forceinline__ unsigned xb_xcc_id() { return (unsigned)__builtin_amdgcn_s_getreg((3 << 11) | 20) & 0xFu; }
#define XB_SPIN(cond, bar) do { unsigned _sp = 0; while (cond) { __builtin_amdgcn_s_sleep(1); \
    if ((++_sp & 255u) == 0u) { if (xb_ld(&(bar)[XB_TMO])) break; if (_sp > XB_SPIN_CAP) { atomicAdd(&(bar)[XB_TMO], 1u); break; } } } } while (0)

struct XcdBarrier {
    unsigned* bar; unsigned x;
    volatile LAS unsigned* st;
};

__device__ __forceinline__ XcdBarrier xcd_barrier_post(unsigned* bar, volatile LAS unsigned* st) {
    XcdBarrier b; b.bar = bar; b.x = xb_xcc_id(); b.st = st;
    if (threadIdx.x == 0) (void)xb_add(&bar[XB_XCNT(b.x)], 1u);
    return b;
}
__device__ __forceinline__ void xcd_barrier_complete(unsigned* bar, unsigned x, unsigned& nloc, unsigned& nx) {
    const unsigned G = gridDim.x * gridDim.y * gridDim.z;
    unsigned sum, cnt, mine, sp = 0u;
    for (;;) {
        sum = 0u; cnt = 0u; mine = 0u;
#pragma unroll
        for (unsigned j = 0; j < 16; ++j) { const unsigned c = xb_ld(&bar[XB_XCNT(j)]); sum += c; cnt += (c > 0u) ? 1u : 0u; mine = (j == x) ? c : mine; }
        if (sum == G) break;
        __builtin_amdgcn_s_sleep(1);
        if ((++sp & 255u) == 0u) { if (xb_ld(&bar[XB_TMO])) break; if (sp > XB_SPIN_CAP) { atomicAdd(&bar[XB_TMO], 1u); break; } }
    }
    nloc = mine > 0u ? mine : 1u; nx = cnt > 0u ? cnt : 1u;
}

__device__ __forceinline__ void xcd_barrier(const XcdBarrier& b) {
    asm volatile("s_waitcnt vmcnt(0)" ::: "memory");
    __syncthreads();
    if (threadIdx.x == 0) {
        unsigned* bar = b.bar;
        __builtin_amdgcn_s_waitcnt(0);
        unsigned nloc = b.st[0], nx = b.st[1];
        if (nloc == 0u) { xcd_barrier_complete(bar, b.x, nloc, nx); b.st[0] = nloc; b.st[1] = nx; }
        const unsigned old = xb_add(&bar[XB_XSUB(b.x)], 1u);
        const unsigned gen = old / nloc;
        if (old + 1u == (gen + 1u) * nloc) {
            __builtin_amdgcn_fence(__ATOMIC_RELEASE, "agent");
            asm volatile("s_waitcnt vmcnt(0)" ::: "memory");
            const unsigned og = xb_add(&bar[XB_TOP], 1u);
            const unsigned tg = og / nx;
            if (og + 1u == (tg + 1u) * nx) xb_add(&bar[XB_TOPGEN], 1u);
            else XB_SPIN(xb_ld(&bar[XB_TOPGEN]) == tg, bar);
            __builtin_amdgcn_fence(__ATOMIC_ACQUIRE, "agent");
            xb_add(&bar[XB_XGEN(b.x)], 1u);
            asm volatile("s_waitcnt vmcnt(0)" ::: "memory");
        } else {
            XB_SPIN(xb_ld(&bar[XB_XGEN(b.x)]) == gen, bar);
            __builtin_amdgcn_fence(__ATOMIC_ACQUIRE, "agent");
            asm volatile("s_waitcnt vmcnt(0)" ::: "memory");
        }
    }
    __syncthreads();
}

__global__ void __launch_bounds__(512, 2) mega(Args a) {
    extern __shared__ __attribute__((aligned(16))) unsigned char lds[];
    cg::grid_group grid = cg::this_grid();
    const int G = gridDim.x;
    PG8_LAS unsigned char* glds = (PG8_LAS unsigned char*)lds;
#define bid lbid()
#define tid ltid()
#define lane (ltid() & 63)
#define wave (__builtin_amdgcn_readfirstlane(ltid() >> 6))
#define gw (lbid() * 8 + __builtin_amdgcn_readfirstlane(ltid() >> 6))
#define NGW (G * 8)
    { volatile LAS unsigned* st0 = (volatile LAS unsigned*)((LAS unsigned char*)lds + 131072); if (threadIdx.x < 4) st0[threadIdx.x] = 0u; }
    __syncthreads();
    const XcdBarrier xbar = xcd_barrier_post((unsigned*)(karg_ws() + 229376), (volatile LAS unsigned*)((LAS unsigned char*)lds + 131072));
#define GSYNC() do { xcd_barrier(xbar); } while (0)

    phase_modgemv(a, (float*)lds, G, bid, tid);
    convert_weights(a, 0, (float*)(lds + 32768) + wave * (64 * 33), gw, NGW, lane, G, bid, tid);
    grid.sync();
#pragma clang loop unroll(full)
    for (int l = 0; l < 2; ++l) {
        if (l > 0) convert_weights(a, l, (float*)lds + wave * (64 * 33), gw, NGW, lane, G, bid, tid);
        phase_modulate(a, l, 0, gw, NGW, lane);
        GSYNC();
        for (int rp = 0; rp < REP_G1; ++rp)
        {
            unsigned char* ws = karg_ws(); float* outp = karg_out(); float* xctx = (float*)(ws + OFF_XCTX); bf16* XM = (bf16*)(ws + OFF_XMY); bf16* HU = (bf16*)(ws + OFF_HU); const float* modl = (const float*)(ws + OFF_MOD) + (size_t)l * 3 * 9216; (void)xctx; (void)XM; (void)HU; (void)modl; (void)outp;
            pg8::Gemm g{XM, (const bf16*)(ws + W_13A), NR, 2 * DFF, DM}; pg8::StaticOrder S; S.init(NR, 2 * DFF, G, bid);
            EpiSwiglu E{HU};
            pg8::gemm_phase<EpiSwiglu, pg8::StaticOrder, true, true>(glds, g, S, E);
        }
        GSYNC();
        {
            unsigned char* ws = karg_ws(); float* outp = karg_out(); float* xctx = (float*)(ws + OFF_XCTX); bf16* XM = (bf16*)(ws + OFF_XMY); bf16* HU = (bf16*)(ws + OFF_HU); const float* modl = (const float*)(ws + OFF_MOD) + (size_t)l * 3 * 9216; (void)xctx; (void)XM; (void)HU; (void)modl; (void)outp;
            pg8::Gemm g{HU, (const bf16*)(ws + W_2A), NR, DM, DFF}; pg8::StaticOrder S; S.init(NR, DM, G, bid);
            EpiResid E{outp, xctx, modl + 2 * 1024, 0.5f, l == 0 ? IN(0) : outp, l == 0 ? IN(2) : xctx};
            pg8::gemm_phase<EpiResid, pg8::StaticOrder, true, true>(glds, g, S, E);
        }
        GSYNC();
        phase_modulate(a, l, 1, gw, NGW, lane);
        GSYNC();
        {
            unsigned char* ws = karg_ws(); float* outp = karg_out(); float* xctx = (float*)(ws + OFF_XCTX); bf16* XM = (bf16*)(ws + OFF_XMY); bf16* HU = (bf16*)(ws + OFF_HU); const float* modl = (const float*)(ws + OFF_MOD) + (size_t)l * 3 * 9216; (void)xctx; (void)XM; (void)HU; (void)modl; (void)outp;
            pg8::Gemm g{XM, (const bf16*)(ws + W_IN), NR, UC, DM}; pg8::StaticOrder S; S.init(NR, UC, G, bid);
            EpiU E{HU, UC};
            pg8::gemm_phase<EpiU, pg8::StaticOrder, true, true>(glds, g, S, E);
        }
        GSYNC();
        for (int rp = 0; rp < REP_M1; ++rp) { phase_m1(a, l, lds, G, bid, tid);
        GSYNC(); }
        for (int rp = 0; rp < REP_M2; ++rp) { phase_m2(a, l, lds, G, bid, tid);
        GSYNC(); }
        for (int rp = 0; rp < REP_M3; ++rp) { phase_m3(a, l, lds, G, bid, tid);
        GSYNC(); }
        for (int rp = 0; rp < REP_SCAN; ++rp) { phase_m4(a, lds, G, bid, tid);
        GSYNC();
        phase_m5(a, lds, G, bid, tid);
        GSYNC();
        phase_m6(a, lds, G, bid, tid);
        GSYNC(); }
        phase_m7(a, l, gw, NGW, lane);
        GSYNC();
        {
            unsigned char* ws = karg_ws(); float* outp = karg_out(); float* xctx = (float*)(ws + OFF_XCTX); bf16* XM = (bf16*)(ws + OFF_XMY); bf16* HU = (bf16*)(ws + OFF_HU); const float* modl = (const float*)(ws + OFF_MOD) + (size_t)l * 3 * 9216; (void)xctx; (void)XM; (void)HU; (void)modl; (void)outp;
            const int MR = (l == 1) ? NLAT : NR;
            pg8::Gemm g{XM, (const bf16*)(ws + W_OUT), MR, DM, DM}; pg8::StaticOrder S; S.init(MR, DM, G, bid);
            EpiResid E{outp, xctx, modl + 5 * 1024, 1.0f, outp, xctx};
            pg8::gemm_phase<EpiResid, pg8::StaticOrder, true, true>(glds, g, S, E);
        }
        GSYNC();
        phase_modulate(a, l, 2, gw, NGW, lane);
        GSYNC();
        {
            unsigned char* ws = karg_ws(); float* outp = karg_out(); float* xctx = (float*)(ws + OFF_XCTX); bf16* XM = (bf16*)(ws + OFF_XMY); bf16* HU = (bf16*)(ws + OFF_HU); const float* modl = (const float*)(ws + OFF_MOD) + (size_t)l * 3 * 9216; (void)xctx; (void)XM; (void)HU; (void)modl; (void)outp;
            const int MR = (l == 1) ? NLAT : NR;
            pg8::Gemm g{XM, (const bf16*)(ws + W_13B), MR, 2 * DFF, DM}; pg8::StaticOrder S; S.init(MR, 2 * DFF, G, bid);
            EpiSwiglu E{HU};
            pg8::gemm_phase<EpiSwiglu, pg8::StaticOrder, true, true>(glds, g, S, E);
        }
        GSYNC();
        {
            unsigned char* ws = karg_ws(); float* outp = karg_out(); float* xctx = (float*)(ws + OFF_XCTX); bf16* XM = (bf16*)(ws + OFF_XMY); bf16* HU = (bf16*)(ws + OFF_HU); const float* modl = (const float*)(ws + OFF_MOD) + (size_t)l * 3 * 9216; (void)xctx; (void)XM; (void)HU; (void)modl; (void)outp;
            const int MR = (l == 1) ? NLAT : NR;
            pg8::Gemm g{HU, (const bf16*)(ws + W_2B), MR, DM, DFF}; pg8::StaticOrder S; S.init(MR, DM, G, bid);
            EpiResid E{outp, xctx, modl + 8 * 1024, 0.5f, outp, xctx};
            pg8::gemm_phase<EpiResid, pg8::StaticOrder, true, true>(glds, g, S, E);
        }
        GSYNC();
    }
    phase_final(a, gw, NGW, lane);
#undef bid
#undef tid
#undef lane
#undef wave
#undef gw
#undef NGW
}

extern "C" void kernel_launch(void* const* d_in, const int* in_sizes, int n_in, void* d_out, int out_size, void* d_ws, size_t ws_size, hipStream_t stream) {
    static int grid = 0;
    if (grid == 0) {
        int dev = 0, cus = 0, per_cu = 0;
        (void)hipGetDevice(&dev);
        (void)hipDeviceGetAttribute(&cus, hipDeviceAttributeMultiprocessorCount, dev);
        (void)hipFuncSetAttribute((const void*)mega, hipFuncAttributeMaxDynamicSharedMemorySize, LDS_BYTES);
        (void)hipOccupancyMaxActiveBlocksPerMultiprocessor(&per_cu, (const void*)mega, 512, LDS_BYTES);
        if (per_cu < 1) per_cu = 1;
        grid = cus * per_cu;
        if (n_in != 40 || ws_size < WS_NEED) { fprintf(stderr, "kernel_launch: unexpected n_in %d / ws %zu (need %zu)\n", n_in, ws_size, (size_t)WS_NEED); }
    }
    (void)hipMemsetAsync((char*)d_ws + OFF_MOD, 0, MOD_BYTES, stream);
    Args a{};
    for (int i = 0; i < 40; ++i) a.in[i] = (const float*)d_in[i];
    a.out = (float*)d_out; a.ws = (unsigned char*)d_ws;
    void* args[] = {&a};
    hipError_t e = hipLaunchCooperativeKernel((const void*)mega, dim3(grid), dim3(512), args, LDS_BYTES, stream);
    if (e != hipSuccess) fprintf(stderr, "cooperative launch failed: %s (grid %d)\n", hipGetErrorString(e), grid);
}
```

```cpp
#include <hip/hip_runtime.h>
#include <hip/hip_cooperative_groups.h>
#include <cstdio>
#include <cstdint>
namespace cg = cooperative_groups;
namespace pg8 {
#define PG8_LAS __attribute__((address_space(3)))
typedef unsigned short bf16_t;
typedef short bf16x8 __attribute__((ext_vector_type(8)));
typedef float f32x4 __attribute__((ext_vector_type(4)));
typedef unsigned u32x4 __attribute__((ext_vector_type(4)));
constexpr int BM = 256, BK = 64, HALF = 128, HTB = HALF * BK * 2  , STAGE_BYTES = 8 * HTB, NXCD = 8, WGM = 8;

__host__ __device__ __forceinline__ int lds_byte(int r, int c) { const int st = (r >> 4) * 2 + (c >> 5), rr = r & 15, cc = c & 31, ob = rr * 64 + cc * 2; return st * 1024 + (ob ^ (((ob >> 9) & 1) << 5)); }
__host__ __device__ __forceinline__ void stage_rc(int b, int& R, int& C) { const int st = b / 1024, sb = b % 1024, swz = sb ^ (((sb >> 9) & 1) << 5); R = (st >> 1) * 16 + swz / 64; C = (st & 1) * 32 + (swz % 64) / 2; }
__host__ __device__ __forceinline__ int perm32(int rho) { const int n = rho >> 4, i = rho & 15; return 8 * (i >> 2) + 4 * n + (i & 3); }

struct Unit { int pm, pn; };
struct Gemm { const bf16_t* A; const bf16_t* Bt; int M, N, K; };

struct StaticOrder {
    int nM, nN, nwg, G, c;
    __host__ __device__ void init(int M, int N, int G_, int c_) { nM = M / BM; nN = N / BM; nwg = nM * nN; G = G_; c = c_; }
    __host__ __device__ bool next(int i, Unit& u) const {
        const long L = (long)i * G + c; if (L >= nwg) return false;
        int wgid = (int)L; { const int q = nwg / NXCD, r = nwg % NXCD, xcd = wgid % NXCD, off = wgid / NXCD; wgid = (xcd < r ? xcd * (q + 1) : r * (q + 1) + (xcd - r) * q) + off; }
        const int nig = WGM * nN, gid = wgid / nig, fm = gid * WGM, gsz = (nM - fm) < WGM ? (nM - fm) : WGM;
        u.pm = fm + ((wgid % nig) % gsz); u.pn = (wgid % nig) / gsz; return true;
    }
    __device__ __forceinline__ void a_ready(const Unit&) const {}
    __device__ __forceinline__ void done(const Unit&) const {}
};

__device__ __forceinline__ unsigned cvt_pk_bf16(float lo, float hi) { unsigned r; asm volatile("v_cvt_pk_bf16_f32 %0, %1, %2" : "=v"(r) : "v"(lo), "v"(hi)); return r; }
typedef float f32x2 __attribute__((ext_vector_type(2)));
template <class Epi, class Sched, bool ALIGN_EPI = false, bool SP2 = false>
__device__ __forceinline__ void gemm_phase(PG8_LAS unsigned char* lds, const Gemm g, const Sched& S, const Epi& E) {
    int tid = threadIdx.x; asm volatile("" : "+v"(tid));
    const int wid = __builtin_amdgcn_readfirstlane(tid >> 6), lane = tid & 63, wr = wid >> 2, wc = wid & 3, fr = lane & 15, fq = lane >> 4;
    const int K = g.K, nt = K / BK;
    unsigned voffA[2], voffB[2];
#pragma unroll
    for (int i = 0; i < 2; ++i) { int R, C; stage_rc(tid * 16 + i * 8192, R, C); const int Rb = Epi::PERM ? ((R & ~31) + perm32(R & 31)) : R;
        voffA[i] = (unsigned)(R * K + C) * 2u; voffB[i] = (unsigned)(Rb * K + C) * 2u; }
    const size_t kstep = (size_t)(BK * 2);
    const size_t hstep = (size_t)HALF * K * 2;
    const size_t tstep = 2 * hstep;
    const unsigned ldsw = (unsigned)wid * 1024u;
    const int aoff = lds_byte(wr * 64 + fr, fq * 8), boff = lds_byte(wc * 32 + fr, fq * 8);
#define PG8_SA(b, h) (((b) * 2 + (h)) * HTB)
#define PG8_SB(b, h) ((4 + (b) * 2 + (h)) * HTB)
#define PG8_STAGE(bufoff, gbase, voff) do { _Pragma("unroll") for (int _i = 0; _i < 2; ++_i) \
        __builtin_amdgcn_global_load_lds((const unsigned*)((const char*)(gbase) + (voff)[_i]), (PG8_LAS unsigned*)(lds + (bufoff) + ldsw + _i * 8192), 16, 0, 0); } while (0)
#define PG8_LDA(dst, b, h) do { _Pragma("unroll") for (int m = 0; m < 4; ++m) _Pragma("unroll") for (int k = 0; k < 2; ++k) dst[m][k] = *(const PG8_LAS bf16x8*)(lds + PG8_SA(b, h) + aoff + m * 2048 + k * 1024); } while (0)
#define PG8_LDB(dst, b, h) do { _Pragma("unroll") for (int n = 0; n < 2; ++n) _Pragma("unroll") for (int k = 0; k < 2; ++k) dst[n][k] = *(const PG8_LAS bf16x8*)(lds + PG8_SB(b, h) + boff + n * 2048 + k * 1024); } while (0)
#define PG8_MMA(ai, bj, At, Bt) do { __builtin_amdgcn_s_setprio(1); _Pragma("unroll") for (int m = 0; m < 4; ++m) _Pragma("unroll") for (int n = 0; n < 2; ++n) _Pragma("unroll") for (int k = 0; k < 2; ++k) \
        acc[ai][bj][m][n] = __builtin_amdgcn_mfma_f32_16x16x32_bf16(Bt[n][k], At[m][k], acc[ai][bj][m][n], 0, 0, 0); __builtin_amdgcn_s_setprio(0); } while (0)
#define PG8_WAIT_V(n) asm volatile("s_waitcnt vmcnt(" #n ")" ::: "memory")
#define PG8_WAIT_L(n) asm volatile("s_waitcnt lgkmcnt(" #n ")" ::: "memory")
#define PG8_BAR __builtin_amdgcn_s_barrier()
#define PG8_SCHED __builtin_amdgcn_sched_barrier(0)
    Unit cur, nxt; int ui = 0;
    if (!S.next(0, cur)) return;
    f32x4 acc[2][2][4][2];
#pragma unroll
    for (int a = 0; a < 2; ++a)
#pragma unroll
        for (int b = 0; b < 2; ++b)
#pragma unroll
            for (int m = 0; m < 4; ++m)
#pragma unroll
                for (int n = 0; n < 2; ++n) acc[a][b][m][n] = (f32x4){0.f, 0.f, 0.f, 0.f};
    bf16x8 At[4][2], B0[2][2], B1[2][2];
    const char* cA = (const char*)g.A + (size_t)cur.pm * tstep; const char* cB = (const char*)g.Bt + (size_t)cur.pn * tstep;
    S.a_ready(cur);
    if constexpr (SP2) {
        PG8_STAGE(PG8_SB(0, 0), cB, voffB); PG8_STAGE(PG8_SB(0, 1), cB + hstep, voffB); PG8_STAGE(PG8_SA(0, 0), cA, voffA); PG8_STAGE(PG8_SA(0, 1), cA + hstep, voffA);
        if (wr == 1) PG8_BAR;
        PG8_WAIT_V(2); PG8_BAR;
        PG8_STAGE(PG8_SB(1, 0), cB + kstep, voffB); PG8_STAGE(PG8_SA(1, 0), cA + kstep, voffA); PG8_STAGE(PG8_SB(1, 1), cB + hstep + kstep, voffB);
        PG8_WAIT_V(6); PG8_BAR;
    } else {
        PG8_STAGE(PG8_SB(0, 0), cB, voffB); PG8_STAGE(PG8_SA(0, 0), cA, voffA); PG8_STAGE(PG8_SB(0, 1), cB + hstep, voffB); PG8_STAGE(PG8_SA(0, 1), cA + hstep, voffA);
        if (wr == 1) PG8_BAR;
        PG8_WAIT_V(4); PG8_BAR;
        PG8_STAGE(PG8_SB(1, 0), cB + kstep, voffB); PG8_STAGE(PG8_SA(1, 0), cA + kstep, voffA); PG8_STAGE(PG8_SB(1, 1), cB + hstep + kstep, voffB);
        PG8_WAIT_V(6); PG8_BAR;
    }
    for (;;) {
        const bool has_next = S.next(ui + 1, nxt);
        const char* nA = has_next ? (const char*)g.A + (size_t)nxt.pm * tstep : cA; const char* nB = has_next ? (const char*)g.Bt + (size_t)nxt.pn * tstep : cB;
        for (int t = 0; t < nt; t += 2) {
            const bool last = (t == nt - 2);
            const char* a1 = cA + (size_t)(t + 1) * kstep;
            const char* a2 = last ? nA : cA + (size_t)(t + 2) * kstep; const char* b2 = last ? nB : cB + (size_t)(t + 2) * kstep;
            const char* a3 = a2 + kstep; const char* b3 = b2 + kstep;
            if (last && has_next) S.a_ready(nxt);
            if constexpr (SP2) {
            PG8_LDB(B0, 0, 0); PG8_LDB(B1, 0, 1); PG8_SCHED; PG8_LDA(At, 0, 0); PG8_STAGE(PG8_SA(1, 1), a1 + hstep, voffA);
            PG8_WAIT_V(8); PG8_WAIT_L(0); PG8_BAR; PG8_MMA(0, 0, At, B0); PG8_MMA(0, 1, At, B1); PG8_BAR; PG8_SCHED;
            PG8_LDA(At, 0, 1); PG8_STAGE(PG8_SB(0, 0), b2, voffB); PG8_STAGE(PG8_SB(0, 1), b2 + hstep, voffB); PG8_STAGE(PG8_SA(0, 0), a2, voffA);
            PG8_WAIT_V(8); PG8_WAIT_L(0); PG8_BAR; PG8_MMA(1, 0, At, B0); PG8_MMA(1, 1, At, B1); PG8_BAR; PG8_SCHED;
            PG8_LDB(B0, 1, 0); PG8_LDB(B1, 1, 1); PG8_SCHED; PG8_LDA(At, 1, 0); PG8_STAGE(PG8_SA(0, 1), a2 + hstep, voffA);
            PG8_WAIT_V(8); PG8_WAIT_L(0); PG8_BAR; PG8_MMA(0, 0, At, B0); PG8_MMA(0, 1, At, B1); PG8_BAR; PG8_SCHED;
            PG8_LDA(At, 1, 1); PG8_STAGE(PG8_SB(1, 0), b3, voffB); PG8_STAGE(PG8_SB(1, 1), b3 + hstep, voffB); PG8_STAGE(PG8_SA(1, 0), a3, voffA);
            PG8_WAIT_V(8); PG8_WAIT_L(0); PG8_BAR; PG8_MMA(1, 0, At, B0); PG8_MMA(1, 1, At, B1); PG8_BAR; PG8_SCHED;
            } else {
            PG8_LDB(B0, 0, 0); PG8_SCHED; PG8_LDA(At, 0, 0); PG8_STAGE(PG8_SA(1, 1), a1 + hstep, voffA);
            PG8_WAIT_L(8); PG8_BAR; PG8_WAIT_L(0); PG8_MMA(0, 0, At, B0); PG8_BAR; PG8_SCHED;
            PG8_LDB(B1, 0, 1); PG8_STAGE(PG8_SB(0, 0), b2, voffB);
            PG8_BAR; PG8_WAIT_L(0); PG8_MMA(0, 1, At, B1); PG8_BAR;
            PG8_LDA(At, 0, 1); PG8_STAGE(PG8_SA(0, 0), a2, voffA);
            PG8_BAR; PG8_WAIT_L(0); PG8_MMA(1, 0, At, B0); PG8_BAR; PG8_SCHED;
            PG8_STAGE(PG8_SB(0, 1), b2 + hstep, voffB);
            PG8_WAIT_V(6); PG8_BAR; PG8_MMA(1, 1, At, B1); PG8_BAR;
            PG8_LDB(B0, 1, 0); PG8_SCHED; PG8_LDA(At, 1, 0); PG8_STAGE(PG8_SA(0, 1), a2 + hstep, voffA);
            PG8_WAIT_L(8); PG8_BAR; PG8_WAIT_L(0); PG8_MMA(0, 0, At, B0); PG8_BAR; PG8_SCHED;
            PG8_LDB(B1, 1, 1); PG8_STAGE(PG8_SB(1, 0), b3, voffB);
            PG8_BAR; PG8_WAIT_L(0); PG8_MMA(0, 1, At, B1); PG8_BAR;
            PG8_LDA(At, 1, 1); PG8_STAGE(PG8_SA(1, 0), a3, voffA);
            PG8_BAR; PG8_WAIT_L(0); PG8_MMA(1, 0, At, B0); PG8_BAR; PG8_SCHED;
            PG8_STAGE(PG8_SB(1, 1), b3 + hstep, voffB);
            PG8_WAIT_V(6); PG8_BAR; PG8_MMA(1, 1, At, B1); PG8_BAR;
            }
        }
        if constexpr (ALIGN_EPI) { if (wr == 0) PG8_BAR; }
        if constexpr (!Epi::AFTER_DRAIN) { E(acc, cur, wr, wc, fr, fq); S.done(cur); }
        if (!has_next) break;
#pragma unroll
        for (int a = 0; a < 2; ++a)
#pragma unroll
            for (int b = 0; b < 2; ++b)
#pragma unroll
                for (int m = 0; m < 4; ++m)
#pragma unroll
                    for (int n = 0; n < 2; ++n) acc[a][b][m][n] = (f32x4){0.f, 0.f, 0.f, 0.f};
        cur = nxt; cA = nA; cB = nB; ++ui;
        if constexpr (ALIGN_EPI) { if (wr == 1) PG8_BAR; }
    }
    PG8_WAIT_V(0);
    if constexpr (!ALIGN_EPI) { if (wr == 0) PG8_BAR; }
    PG8_BAR;
    if constexpr (Epi::AFTER_DRAIN) { E.fused(acc, cur, wr, wc, fr, fq, lds, wid, lane); S.done(cur); }
#undef PG8_SA
#undef PG8_SB
#undef PG8_STAGE
#undef PG8_LDA
#undef PG8_LDB
#undef PG8_MMA
#undef PG8_WAIT_V
#undef PG8_WAIT_L
#undef PG8_BAR
#undef PG8_SCHED
}
}

using pg8::f32x4; using pg8::bf16x8;
typedef unsigned short bf16;
typedef unsigned v4u __attribute__((ext_vector_type(4)));
typedef unsigned v2u __attribute__((ext_vector_type(2)));
typedef short s16x4 __attribute__((ext_vector_type(4)));

constexpr int DM = 1024, TLEN = 8192, CTXL = 256, TT = 8448, NLAT = 16384, NR = 16896, DFF = 2816, UC = 2560, NTILE = 528;
constexpr int NSEG = 64, SEGLEN = 132;
constexpr size_t MiB = 1u << 20;
constexpr size_t A8 = (size_t)NR * 256 * 2;
constexpr size_t OFF_MOD = 0, MOD_BYTES = 256 * 1024;
constexpr size_t OFF_XCTX = MiB / 4, OFF_XMY = 2 * MiB + MiB / 4, OFF_HU = 35 * MiB + MiB / 4, OFF_W = 126 * MiB, OFF_MIX = 167 * MiB, OFF_PR = 266 * MiB;
constexpr size_t W_13A = OFF_W, W_2A = OFF_W + 11 * MiB, W_13B = OFF_W + 16 * MiB + MiB / 2, W_2B = OFF_W + 27 * MiB + MiB / 2,
                 W_IN = OFF_W + 33 * MiB, W_OUT = OFF_W + 38 * MiB, W_UQ = OFF_W + 40 * MiB, W_UKV = OFF_W + 40 * MiB + 256 * 1024,
                 W_WUP = OFF_W + 40 * MiB + 384 * 1024, W_AUP = W_WUP + 65536, W_GUP = W_AUP + 65536, W_LWA = W_GUP + 65536, W_LWX = W_LWA + 65536;
constexpr size_t M_QB = OFF_MIX, M_KB = OFF_MIX + 12976128, M_VT = OFF_MIX + 25952256;
constexpr size_t M_LR0 = OFF_PR, M_LIX0 = OFF_PR + 2 * A8;
constexpr size_t M_SEGA = OFF_HU + 83 * MiB, M_SEGB = M_SEGA + MiB + MiB / 4, M_H0 = M_SEGB + MiB + MiB / 4;
constexpr size_t M_RR = OFF_MIX, M_KK = OFF_MIX + A8, M_VV = OFF_MIX + 2 * A8, M_WW = OFF_MIX + 3 * A8, M_BB = OFF_MIX + 7 * A8, M_KD = OFF_MIX + 9 * A8, M_GC = OFF_MIX + 11 * A8;
constexpr size_t M_YS = OFF_HU, M_PL = OFF_HU + 33 * MiB, M_SINIT = OFF_HU + 65 * MiB;
constexpr size_t M_PR = OFF_PR;
constexpr size_t WS_NEED = OFF_PR + 33 * MiB;
constexpr int LDS_BYTES = 131072 + 1024;
#ifndef REP_M1
#define REP_M1 1
#endif
#ifndef REP_M2
#define REP_M2 1
#endif
#ifndef REP_M3
#define REP_M3 1
#endif
#ifndef REP_SCAN
#define REP_SCAN 1
#endif
#ifndef REP_G1
#define REP_G1 1
#endif
constexpr float QSCALE = 0.10206207261596575f * 1.4426950408889634f;

struct Args { const float* in[40]; float* out; unsigned char* ws; };
typedef const __attribute__((address_space(4))) volatile unsigned long long kargq;
__device__ __forceinline__ const float* karg_in(int i) { kargq* p = (kargq*)__builtin_amdgcn_kernarg_segment_ptr(); return (const float*)p[i]; }
__device__ __forceinline__ float* karg_out() { kargq* p = (kargq*)__builtin_amdgcn_kernarg_segment_ptr(); return (float*)p[40]; }
__device__ __forceinline__ unsigned char* karg_ws() { kargq* p = (kargq*)__builtin_amdgcn_kernarg_segment_ptr(); return (unsigned char*)p[41]; }
#define IN(i) karg_in(i)
__device__ __forceinline__ int ltid() { int t = threadIdx.x; asm volatile("" : "+v"(t)); return t; }
__device__ __forceinline__ int lbid() { int t = blockIdx.x; asm volatile("" : "+s"(t)); return t; }
template <class T> __device__ __forceinline__ T* launder(T* p) { asm volatile("" : "+s"(p)); return p; }

__device__ __forceinline__ float bf2f(bf16 h) { return __uint_as_float((unsigned)h << 16); }
__device__ __forceinline__ unsigned f2bf(float f) { unsigned u = __float_as_uint(f); return (u + 0x7fffu + ((u >> 16) & 1u)) >> 16; }
__device__ __forceinline__ unsigned pk2(float lo, float hi) { return f2bf(lo) | (f2bf(hi) << 16); }
__device__ __forceinline__ float sigm(float x) { return __builtin_amdgcn_rcpf(1.f + __expf(-x)); }
__device__ __forceinline__ float siluf_(float x) { return x * __builtin_amdgcn_rcpf(1.f + __expf(-x)); }
__device__ __forceinline__ float tanhf_(float y) { return 1.f - 2.f * __builtin_amdgcn_rcpf(1.f + __expf(2.f * y)); }
__device__ __forceinline__ float geluf_(float x) { return 0.5f * x * (1.f + tanhf_(0.7978845608028654f * (x + 0.044715f * x * x * x))); }
template <int CTRL> __device__ __forceinline__ float dppf(float v) { return __int_as_float(__builtin_amdgcn_update_dpp(0, __float_as_int(v), CTRL, 0xF, 0xF, true)); }
__device__ __forceinline__ float rows4_max(float v) {
    auto a = __builtin_amdgcn_permlane16_swap(__float_as_uint(v), __float_as_uint(v), false, false); v = fmaxf(__uint_as_float(a[0]), __uint_as_float(a[1]));
    auto b = __builtin_amdgcn_permlane32_swap(__float_as_uint(v), __float_as_uint(v), false, false); return fmaxf(__uint_as_float(b[0]), __uint_as_float(b[1]));
}
__device__ __forceinline__ float rows4_sum(float v) {
    auto a = __builtin_amdgcn_permlane16_swap(__float_as_uint(v), __float_as_uint(v), false, false); v = __uint_as_float(a[0]) + __uint_as_float(a[1]);
    auto b = __builtin_amdgcn_permlane32_swap(__float_as_uint(v), __float_as_uint(v), false, false); return __uint_as_float(b[0]) + __uint_as_float(b[1]);
}
__device__ __forceinline__ float wave_sum(float v) {
    v += dppf<0xB1>(v); v += dppf<0x4E>(v); v += dppf<0x141>(v); v += dppf<0x140>(v);
    auto a = __builtin_amdgcn_permlane16_swap(__float_as_uint(v), __float_as_uint(v), false, false); v = __uint_as_float(a[0]) + __uint_as_float(a[1]);
    auto b = __builtin_amdgcn_permlane32_swap(__float_as_uint(v), __float_as_uint(v), false, false); return __uint_as_float(b[0]) + __uint_as_float(b[1]);
}
struct TileInfo { int b, isctx, t0, seqbase, seqlen; };
__device__ __forceinline__ TileInfo tile_info(int tile) {
    TileInfo ti;
    if (tile < 512) { ti.b = tile >> 8; ti.isctx = 0; ti.t0 = (tile & 255) * 32; ti.seqbase = ti.b * TLEN; ti.seqlen = TLEN; }
    else { const int q = tile - 512; ti.b = q >> 3; ti.isctx = 1; ti.t0 = (q & 7) * 32; ti.seqbase = NLAT + ti.b * CTXL; ti.seqlen = CTXL; }
    return ti;
}

struct EpiSwiglu {
    static constexpr bool PERM = true, AFTER_DRAIN = false;
    bf16* H;
    __device__ __forceinline__ void operator()(const f32x4 (&acc)[2][2][4][2], const pg8::Unit& u, int wr, int wc, int fr, int fq) const {
        int pm = u.pm, pn = u.pn; asm volatile("" : "+s"(pm), "+s"(pn), "+s"(wr), "+s"(wc), "+v"(fr), "+v"(fq));
        bf16* tb = H + (size_t)pm * 256 * DFF + pn * 128;
        const unsigned loff = (unsigned)((wr * 64 + fr) * DFF + wc * 32 + 8 * fq);
#pragma unroll
        for (int ai = 0; ai < 2; ++ai)
#pragma unroll
            for (int m = 0; m < 4; ++m) {
                bf16* rowp = tb + (loff + (unsigned)((ai * 128 + m * 16) * DFF));
                const f32x4 g0 = acc[ai][0][m][0], g1 = acc[ai][0][m][1], u0 = acc[ai][1][m][0], u1 = acc[ai][1][m][1];
                v4u w;
                w.x = pg8::cvt_pk_bf16(siluf_(g0[0]) * u0[0], siluf_(g0[1]) * u0[1]); w.y = pg8::cvt_pk_bf16(siluf_(g0[2]) * u0[2], siluf_(g0[3]) * u0[3]);
                w.z = pg8::cvt_pk_bf16(siluf_(g1[0]) * u1[0], siluf_(g1[1]) * u1[1]); w.w = pg8::cvt_pk_bf16(siluf_(g1[2]) * u1[2], siluf_(g1[3]) * u1[3]);
                *(v4u*)rowp = w;
            }
    }
};
struct EpiU {
    static constexpr bool PERM = true, AFTER_DRAIN = false;
    bf16* O; int ldc;
    __device__ __forceinline__ void operator()(const f32x4 (&acc)[2][2][4][2], const pg8::Unit& u, int wr, int wc, int fr, int fq) const {
        int pm = u.pm, pn = u.pn; asm volatile("" : "+s"(pm), "+s"(pn), "+s"(wr), "+s"(wc), "+v"(fr), "+v"(fq));
        bf16* tb = O + (size_t)pm * 256 * ldc + pn * 256;
        const unsigned loff = (unsigned)((wr * 64 + fr) * ldc + wc * 32 + 8 * fq);
#pragma unroll
        for (int ai = 0; ai < 2; ++ai)
#pragma unroll
            for (int m = 0; m < 4; ++m) {
                bf16* rowp = tb + (loff + (unsigned)((ai * 128 + m * 16) * ldc));
#pragma unroll
                for (int bj = 0; bj < 2; ++bj) { const f32x4 v0 = acc[ai][bj][m][0], v1 = acc[ai][bj][m][1]; v4u w;
                    w.x = pg8::cvt_pk_bf16(v0[0], v0[1]); w.y = pg8::cvt_pk_bf16(v0[2], v0[3]); w.z = pg8::cvt_pk_bf16(v1[0], v1[1]); w.w = pg8::cvt_pk_bf16(v1[2], v1[3]);
                    *(v4u*)(rowp + bj * 128) = w; }
            }
    }
};
struct EpiResid {
    static constexpr bool PERM = false, AFTER_DRAIN = false;
    float* xlat; float* xctx; const float* gate; float coef; const float* slat; const float* sctx;
    __device__ __forceinline__ void operator()(const f32x4 (&acc)[2][2][4][2], const pg8::Unit& u, int wr, int wc, int fr, int fq) const {
        int pm = u.pm, pn = u.pn; asm volatile("" : "+s"(pm), "+s"(pn), "+s"(wr), "+s"(wc), "+v"(fr), "+v"(fq));
        const size_t toff = (pm < 64 ? (size_t)pm : (size_t)(pm - 64)) * 256 * DM + pn * 256;
        float* tb = (pm < 64 ? xlat : xctx) + toff; const float* sb = (pm < 64 ? slat : sctx) + toff;
        const float* g = gate + (pm < 64 ? (pm >> 5) : 2) * 9216 + pn * 256;
        const unsigned coff = (unsigned)(wc * 32 + 4 * fq), loff = (unsigned)((wr * 64 + fr) * DM) + coff;
        f32x4 gv[2][2];
#pragma unroll
        for (int bj = 0; bj < 2; ++bj)
#pragma unroll
            for (int n = 0; n < 2; ++n) gv[bj][n] = coef * *(const f32x4*)(g + (coff + (unsigned)(bj * 128 + n * 16)));
#pragma unroll
        for (int ai = 0; ai < 2; ++ai)
#pragma unroll
            for (int m = 0; m < 4; ++m) {
                float* xr = tb + (loff + (unsigned)((ai * 128 + m * 16) * DM)); const float* sr = sb + (loff + (unsigned)((ai * 128 + m * 16) * DM));
#pragma unroll
                for (int bj = 0; bj < 2; ++bj)
#pragma unroll
                    for (int n = 0; n < 2; ++n) { float* xp = xr + (bj * 128 + n * 16);
                        f32x4 xv = *(const f32x4*)(sr + (bj * 128 + n * 16)); xv += gv[bj][n] * acc[ai][bj][m][n]; *(f32x4*)xp = xv; }
                asm volatile("" ::: "memory");
            }
    }
};

__device__ __forceinline__ void phase_modgemv(const Args& a, float* red, int G, int bid, int tid) {
    const float* c = IN(1); const float* cctx = IN(3); const float* ada_w = IN(4); const float* ada_b = IN(5);
    float* mod = (float*)(karg_ws() + OFF_MOD);
    const int w = tid >> 6, lane = tid & 63;
    for (int u = bid; u < 576; u += G) {
        const int l = u / 288, rem = u % 288, jt = rem >> 3, ks = rem & 7;
        const int kb = ks * 128 + w * 16, j0 = jt * 256 + lane * 4;
        f32x4 acc0 = {0.f, 0.f, 0.f, 0.f}, acc1 = acc0, acc2 = acc0;
        for (int kk = 0; kk < 16; ++kk) { const int k = kb + kk;
            const float s0 = siluf_(c[k]), s1 = siluf_(c[1024 + k]), s2 = siluf_(cctx[k]);
            const f32x4 wv = *(const f32x4*)(ada_w + ((size_t)(l * 1024 + k)) * 9216 + j0);
            acc0 += s0 * wv; acc1 += s1 * wv; acc2 += s2 * wv; }
        float* rp = red + (w * 3) * 256 + lane * 4;
        *(f32x4*)rp = acc0; *(f32x4*)(rp + 256) = acc1; *(f32x4*)(rp + 512) = acc2;
        __syncthreads();
        for (int o = tid; o < 768; o += 512) { const int m = o >> 8, jj = o & 255; float s = 0.f;
#pragma unroll
            for (int ww = 0; ww < 8; ++ww) s += red[(ww * 3 + m) * 256 + jj];
            const int j = jt * 256 + jj; if (ks == 0) s += ada_b[l * 9216 + j];
            atomicAdd(&mod[(l * 3 + m) * 9216 + j], s); }
        __syncthreads();
    }
}
__device__ __forceinline__ void phase_copy(const Args& a, int G, int bid, int tid) {
    const f32x4* x4 = (const f32x4*)IN(0); f32x4* o4 = (f32x4*)karg_out();
    for (int i = bid * 512 + tid; i < NLAT * DM / 4; i += G * 512) o4[i] = x4[i];
    const f32x4* c4 = (const f32x4*)IN(2); f32x4* xc4 = (f32x4*)(karg_ws() + OFF_XCTX);
    for (int i = bid * 512 + tid; i < 512 * DM / 4; i += G * 512) xc4[i] = c4[i];
}
__device__ __forceinline__ int swiglu_map(int n) { return n < DFF ? ((n >> 7) * 256 + (n & 127)) : ((((n - DFF) >> 7) * 256) + 128 + ((n - DFF) & 127)); }
__device__ __forceinline__ void transpose_item(const float* W, int K, int N, bf16* WT, float* scr, int item, int lane, int mode, const float* kscale) {
    const int nblk = N / 32, kb = item / nblk, nb = item % nblk, k0 = 64 * kb, n0 = 32 * nb;
    float tv[32];
#pragma unroll
    for (int i = 0; i < 32; ++i) { const int kk = 2 * i + (lane >> 5); tv[i] = W[(size_t)(k0 + kk) * N + n0 + (lane & 31)]; }
#pragma unroll
    for (int i = 0; i < 32; ++i) { const int kk = 2 * i + (lane >> 5); float v = tv[i]; if (kscale) v *= kscale[k0 + kk]; scr[kk * 33 + (lane & 31)] = v; }
    __builtin_amdgcn_wave_barrier();
    const int c = lane & 7;
#pragma unroll
    for (int j = 0; j < 4; ++j) { const int n = (lane >> 3) + 8 * j; const float* s = scr + (8 * c) * 33 + n;
        v4u o; o.x = pk2(s[0 * 33], s[1 * 33]); o.y = pk2(s[2 * 33], s[3 * 33]); o.z = pk2(s[4 * 33], s[5 * 33]); o.w = pk2(s[6 * 33], s[7 * 33]);
        const int nn = n0 + n, drow = mode ? swiglu_map(nn) : nn;
        *(v4u*)(WT + (size_t)drow * K + k0 + 8 * c) = o; }
    __builtin_amdgcn_wave_barrier();
}
__device__ __forceinline__ void convert_weights(const Args& a, int l, float* scr, int gw, int NGW, int lane, int G, int bid, int tid) {
    constexpr int I13 = 16 * 176, I2 = 44 * 32, IIN = 16 * 77, IOUT = 16 * 32, IUQ = 4 * 12, IUKV = 2 * 16;
    constexpr int IEX = 80;
    constexpr int NIT = 2 * I13 + 2 * I2 + IIN + IOUT + IUQ + IUKV + IEX;
    unsigned char* ws = karg_ws();
    for (int it = gw; it < NIT; it += NGW) {
        int r = it;
        if (r < I13) { transpose_item(IN(6) + (size_t)l * DM * 2 * DFF, DM, 2 * DFF, (bf16*)(ws + W_13A), scr, r, lane, 1, nullptr); continue; } r -= I13;
        if (r < I13) { transpose_item(IN(8) + (size_t)l * DM * 2 * DFF, DM, 2 * DFF, (bf16*)(ws + W_13B), scr, r, lane, 1, nullptr); continue; } r -= I13;
        if (r < I2) { transpose_item(IN(7) + (size_t)l * DFF * DM, DFF, DM, (bf16*)(ws + W_2A), scr, r, lane, 0, nullptr); continue; } r -= I2;
        if (r < I2) { transpose_item(IN(9) + (size_t)l * DFF * DM, DFF, DM, (bf16*)(ws + W_2B), scr, r, lane, 0, nullptr); continue; } r -= I2;
        if (r < IIN) { transpose_item(IN(10) + (size_t)l * DM * 2464, DM, 2464, (bf16*)(ws + W_IN), scr, r, lane, 0, nullptr); continue; } r -= IIN;
        if (r < IOUT) { transpose_item(IN(11) + (size_t)l * DM * DM, DM, DM, (bf16*)(ws + W_OUT), scr, r, lane, 0, nullptr); continue; } r -= IOUT;
        if (r < IUQ) { transpose_item(IN(36) + (size_t)l * 256 * 384, 256, 384, (bf16*)(ws + W_UQ), scr, r, lane, 0, IN(35) + l * 256); continue; } r -= IUQ;
        if (r < IUKV) { transpose_item(IN(38) + (size_t)l * 128 * 512, 128, 512, (bf16*)(ws + W_UKV), scr, r, lane, 0, IN(37) + l * 128); continue; } r -= IUKV;
        if (r < 16) { const int d = r >> 3; transpose_item(IN(26) + (size_t)(l * 2 + d) * 64 * 256, 64, 256, (bf16*)(ws + W_WUP) + d * 256 * 64, scr, r & 7, lane, 0, nullptr); continue; } r -= 16;
        if (r < 16) { const int d = r >> 3; transpose_item(IN(28) + (size_t)(l * 2 + d) * 64 * 256, 64, 256, (bf16*)(ws + W_AUP) + d * 256 * 64, scr, r & 7, lane, 0, nullptr); continue; } r -= 16;
        if (r < 16) { transpose_item(IN(29) + (size_t)l * 128 * 256, 128, 256, (bf16*)(ws + W_GUP), scr, r, lane, 0, nullptr); continue; } r -= 16;
        if (r < 16) { const int m = r >> 1; transpose_item(IN(18) + (size_t)(l * 8 + m) * 4096, 64, 64, (bf16*)(ws + W_LWA) + m * 4096, scr, r & 1, lane, 0, nullptr); continue; } r -= 16;
        { const int m = r >> 1; transpose_item(IN(20) + (size_t)(l * 8 + m) * 4096, 64, 64, (bf16*)(ws + W_LWX) + m * 4096, scr, r & 1, lane, 0, nullptr); }
    }
    v4u z = {0u, 0u, 0u, 0u}; v4u* zp = (v4u*)(ws + W_IN + (size_t)2464 * DM * 2);
    for (int i = bid * 512 + tid; i < 96 * DM * 2 / 16; i += G * 512) zp[i] = z;
}
__device__ __forceinline__ void phase_modulate(const Args& a, int l, int which, int gw, int NGW, int lane) {
    unsigned char* ws = karg_ws(); const float* outp = karg_out();
    const bool first = (l == 0 && which == 0);
    const float* srcl = first ? IN(0) : outp; const float* srcc = first ? IN(2) : (const float*)(ws + OFF_XCTX);
    const float* mod = (const float*)(ws + OFF_MOD) + (size_t)l * 3 * 9216;
    bf16* XM = (bf16*)(ws + OFF_XMY);
    for (int r = gw; r < NR; r += NGW) {
        const float* xr = r < NLAT ? srcl + (size_t)r * DM : srcc + (size_t)(r - NLAT) * DM;
        const float* mm = mod + (r < NLAT ? (r >> 13) : 2) * 9216 + which * 3 * 1024;
        f32x4 v[4]; float ss = 0.f;
#pragma unroll
        for (int j = 0; j < 4; ++j) { v[j] = *(const f32x4*)(xr + 4 * lane + 256 * j); ss += (v[j][0] * v[j][0] + v[j][1] * v[j][1]) + (v[j][2] * v[j][2] + v[j][3] * v[j][3]); }
        const float rstd = rsqrtf(wave_sum(ss) * (1.f / DM) + 1e-6f);
#pragma unroll
        for (int j = 0; j < 4; ++j) { const int c = 4 * lane + 256 * j; const f32x4 sh = *(const f32x4*)(mm + c), sc = *(const f32x4*)(mm + 1024 + c);
            const f32x4 o = v[j] * rstd * (1.f + sc) + sh; v2u w; w.x = pk2(o[0], o[1]); w.y = pk2(o[2], o[3]);
            *(v2u*)(XM + (size_t)r * DM + c) = w; }
    }
}
__device__ __forceinline__ void phase_final(const Args& a, int gw, int NGW, int lane) {
    const float* fn = IN(39); float* outp = karg_out();
    for (int r = gw; r < NLAT; r += NGW) {
        float* xr = outp + (size_t)r * DM; f32x4 v[4]; float ss = 0.f;
#pragma unroll
        for (int j = 0; j < 4; ++j) { v[j] = *(const f32x4*)(xr + 4 * lane + 256 * j); ss += (v[j][0] * v[j][0] + v[j][1] * v[j][1]) + (v[j][2] * v[j][2] + v[j][3] * v[j][3]); }
        const float rstd = rsqrtf(wave_sum(ss) * (1.f / DM) + 1e-6f);
#pragma unroll
        for (int j = 0; j < 4; ++j) { const int c = 4 * lane + 256 * j; const f32x4 g = *(const f32x4*)(fn + c); *(f32x4*)(xr + c) = v[j] * rstd * g; }
    }
}

__device__ __forceinline__ void phase_m1(const Args& a, int l, unsigned char* lds, int G, int bid, int tid_unused) {
    unsigned char* ws = karg_ws();
    const bf16* U = (const bf16*)(ws + OFF_HU);
    bf16* Y = (bf16*)(ws + OFF_XMY);
    for (int pass = 0; pass < 2; ++pass)
    for (int tile = (pass == 0 ? bid : (bid < 48 ? 512 + bid / 3 : NTILE)); tile < (pass == 0 ? 512 : NTILE); tile += (pass == 0 ? G : NTILE)) {
        const int mask = pass == 0 ? 7 : ((1 << (bid % 3)) & (l == 1 ? 6 : 7));
        const TileInfo ti = tile_info(tile);
        const int row0 = tile * 32;
        if (mask & 1) {
            const int tid = ltid(); const int lane = tid & 63, wave = __builtin_amdgcn_readfirstlane(tid >> 6), ch = tid & 255, part = tid >> 8; (void)lane; (void)wave; (void)ch; (void)part;
            float* z = (float*)lds;
            float* cv = (float*)(lds + 65536);
            for (int tt = part; tt < 62; tt += 2) { const int t = ti.t0 - 15 + tt; float zz = 0.f;
                if (t >= 0 && t < ti.seqlen) { const bf16* ur = U + (size_t)(ti.seqbase + t) * UC; zz = bf2f(ur[ch]) * sigm(bf2f(ur[256 + ch])); }
                z[tt * 256 + ch] = zz; }
            __syncthreads();
            const float* dw = IN(12) + (size_t)l * 31 * 256 + ch;
            float acc[16]; const float bias = IN(13)[l * 256 + ch];
#pragma unroll
            for (int o = 0; o < 16; ++o) acc[o] = bias;
            for (int j = 0; j < 31; ++j) { const float w = dw[j * 256];
#pragma unroll
                for (int o = 0; o < 16; ++o) acc[o] += w * z[(part * 16 + o + j) * 256 + ch]; }
#pragma unroll
            for (int o = 0; o < 16; ++o) cv[(part * 16 + o) * 256 + ch] = acc[o];
            __syncthreads();
            const f32x4 lg = *(const f32x4*)(IN(14) + l * 256 + lane * 4), lb = *(const f32x4*)(IN(15) + l * 256 + lane * 4);
#pragma unroll
            for (int q = 0; q < 4; ++q) { const int t = wave * 4 + q; const f32x4 v = *(const f32x4*)(cv + t * 256 + lane * 4);
                const float mu = wave_sum((v[0] + v[1]) + (v[2] + v[3])) * (1.f / 256.f);
                const f32x4 dv = v - mu; const float var = wave_sum((dv[0] * dv[0] + dv[1] * dv[1]) + (dv[2] * dv[2] + dv[3] * dv[3])) * (1.f / 256.f);
                const f32x4 yn = dv * rsqrtf(var + 1e-5f) * lg + lb;
                v2u w; w.x = pk2(siluf_(yn[0]), siluf_(yn[1])); w.y = pk2(siluf_(yn[2]), siluf_(yn[3]));
                *(v2u*)(Y + (size_t)(row0 + t) * DM + lane * 4) = w; }
            __syncthreads();
        }
        if (mask & 2) {
            float* xvf = (float*)lds;
            bf16* xvb = (bf16*)(lds + 32768);
            bf16* rg = (bf16*)(lds + 49664);
            bf16* ixg = (bf16*)(lds + 82432);
            {
                const int tid = ltid(); const int ch = tid & 255, part = tid >> 8;
                const float* cw = IN(16) + (size_t)l * 4 * 256 + ch; const float w0 = cw[0], w1 = cw[256], w2 = cw[512], w3 = cw[768], cb = IN(17)[l * 256 + ch];
                float xin[19];
#pragma unroll
                for (int i = 0; i < 19; ++i) { const int t = ti.t0 + part * 16 + i - 2; xin[i] = (t >= 0 && t < ti.seqlen) ? bf2f(U[(size_t)(ti.seqbase + t) * UC + 512 + ch]) : 0.f; }
#pragma unroll
                for (int o = 0; o < 16; ++o) { const int tl = part * 16 + o;
                    const float v = cb + w0 * xin[o] + w1 * xin[o + 1] + w2 * xin[o + 2] + w3 * xin[o + 3];
                    xvf[tl * 256 + ch] = v; xvb[tl * 264 + ch] = (bf16)f2bf(v);
                }
            }
            __syncthreads();
            {
                const int tid = ltid(); const int ln = tid & 63, wv = __builtin_amdgcn_readfirstlane(tid >> 6), fr = ln & 15, fq = ln >> 4, blk = wv >> 1;
                const bf16* LWAt = (const bf16*)(ws + W_LWA); const bf16* LWXt = (const bf16*)(ws + W_LWX);
                bf16x8 af[2][2];
#pragma unroll
                for (int mt = 0; mt < 2; ++mt)
#pragma unroll
                    for (int ks = 0; ks < 2; ++ks) af[mt][ks] = *(const bf16x8*)(xvb + (mt * 16 + fr) * 264 + blk * 64 + ks * 32 + fq * 8);
#pragma unroll 1
                for (int dn = 0; dn < 4; ++dn) { const int d = dn >> 1, nt = wv * 2 + (dn & 1), ch = nt * 16 + fr, jj = (nt & 3) * 16 + fr;
                    f32x4 ca[2], cx[2];
#pragma unroll
                    for (int mt = 0; mt < 2; ++mt) { ca[mt] = (f32x4){0.f, 0.f, 0.f, 0.f}; cx[mt] = ca[mt]; }
#pragma unroll
                    for (int ks = 0; ks < 2; ++ks) { const size_t wo = ((size_t)(d * 4 + blk) * 64 + jj) * 64 + ks * 32 + fq * 8;
                        const bf16x8 ba = *(const bf16x8*)(LWAt + wo), bx = *(const bf16x8*)(LWXt + wo);
#pragma unroll
                        for (int mt = 0; mt < 2; ++mt) { ca[mt] = __builtin_amdgcn_mfma_f32_16x16x32_bf16(af[mt][ks], ba, ca[mt], 0, 0, 0); cx[mt] = __builtin_amdgcn_mfma_f32_16x16x32_bf16(af[mt][ks], bx, cx[mt], 0, 0, 0); } }
                    const float bga = IN(19)[(l * 2 + d) * 256 + ch], bgx = IN(21)[(l * 2 + d) * 256 + ch];
                    bf16* LR = (bf16*)(ws + M_LR0 + (size_t)d * A8); bf16* LIX = (bf16*)(ws + M_LIX0 + (size_t)d * A8);
#pragma unroll
                    for (int mt = 0; mt < 2; ++mt)
#pragma unroll
                        for (int j = 0; j < 4; ++j) { const int t = mt * 16 + fq * 4 + j;
                            const bf16 rb = (bf16)f2bf(sigm(ca[mt][j] + bga)), ib = (bf16)f2bf(sigm(cx[mt][j] + bgx) * xvf[t * 256 + ch]);
                            LR[(size_t)(row0 + t) * 256 + ch] = rb; LIX[(size_t)(row0 + t) * 256 + ch] = ib;
                            rg[(d * 32 + t) * 256 + ch] = rb; ixg[(d * 32 + t) * 256 + ch] = ib; }
                }
            }
            __syncthreads();
            {
                const int tid = ltid(); const int ch = tid & 255, d = tid >> 8;
                const float lam = IN(22)[(l * 2 + d) * 256 + ch];
                const float cch = -8.f * log1pf(__expf(-lam));
                float A = 1.f, B = 0.f;
#pragma unroll 8
                for (int tt = 0; tt < 32; ++tt) { const int t = d ? 31 - tt : tt;
                    const float al = __expf(cch * bf2f(rg[(d * 32 + t) * 256 + ch])); const float bb = sqrtf(fmaxf(1.f - al * al, 0.f)) * bf2f(ixg[(d * 32 + t) * 256 + ch]); B = al * B + bb; A *= al; }
                ((float*)(ws + M_SEGA))[(size_t)(tile * 2 + d) * 256 + ch] = A;
                ((float*)(ws + M_SEGB))[(size_t)(tile * 2 + d) * 256 + ch] = B;
            }
            __syncthreads();
        }
        if (mask & 4) {
            const int tid = ltid(); const int lane = tid & 63, wave = __builtin_amdgcn_readfirstlane(tid >> 6), ch = tid & 255, part = tid >> 8; (void)lane; (void)wave; (void)ch; (void)part;
            bf16* As = (bf16*)lds;
            float* kr = (float*)(lds + 32768);
            float* rs = (float*)(lds + 32768 + 4096);
            for (int idx = tid; idx < 32 * 52; idx += 512) { const int t = idx / 52, cc = idx % 52;
                const v4u v = *(const v4u*)(U + (size_t)(row0 + t) * UC + 2048 + cc * 8);
                if (cc < 48) *(v4u*)(As + t * 392 + cc * 8) = v;
                else { const int c0 = (cc - 48) * 8; float* kp = kr + t * 32 + c0;
                    kp[0] = __uint_as_float(v.x << 16); kp[1] = __uint_as_float(v.x & 0xffff0000u); kp[2] = __uint_as_float(v.y << 16); kp[3] = __uint_as_float(v.y & 0xffff0000u);
                    kp[4] = __uint_as_float(v.z << 16); kp[5] = __uint_as_float(v.z & 0xffff0000u); kp[6] = __uint_as_float(v.w << 16); kp[7] = __uint_as_float(v.w & 0xffff0000u); } }
            __syncthreads();
#pragma unroll
            for (int q = 0; q < 4; ++q) { const int t = wave * 4 + q; float sq = 0.f, sk = 0.f;
#pragma unroll
                for (int j = 0; j < 4; ++j) { const float v = bf2f(As[t * 392 + lane + 64 * j]); sq += v * v; }
#pragma unroll
                for (int j = 0; j < 2; ++j) { const float v = bf2f(As[t * 392 + 256 + lane + 64 * j]); sk += v * v; }
                sq = wave_sum(sq); sk = wave_sum(sk);
                if (lane == 0) { rs[t * 2] = rsqrtf(sq * (1.f / 256.f) + 1e-6f); rs[t * 2 + 1] = rsqrtf(sk * (1.f / 128.f) + 1e-6f); } }
            __syncthreads();
            const int fr = lane & 15, fq = lane >> 4;
            bf16* QB = (bf16*)(ws + M_QB); bf16* KB = (bf16*)(ws + M_KB); bf16* VT = (bf16*)(ws + M_VT);
            const bf16* WUQ = (const bf16*)(ws + W_UQ); const bf16* WUKV = (const bf16*)(ws + W_UKV);
            const int keybase = ti.isctx ? TLEN : 0;
#pragma unroll 1
            for (int i = 0; i < 3; ++i) { const int nt = wave * 3 + i;
                f32x4 c0 = {0.f, 0.f, 0.f, 0.f}, c1 = c0;
#pragma unroll
                for (int ks = 0; ks < 8; ++ks) { const bf16x8 bfr = *(const bf16x8*)(WUQ + (size_t)(nt * 16 + fr) * 256 + ks * 32 + fq * 8);
                    const bf16x8 a0 = *(const bf16x8*)(As + fr * 392 + ks * 32 + fq * 8), a1 = *(const bf16x8*)(As + (16 + fr) * 392 + ks * 32 + fq * 8);
                    c0 = __builtin_amdgcn_mfma_f32_16x16x32_bf16(a0, bfr, c0, 0, 0, 0); c1 = __builtin_amdgcn_mfma_f32_16x16x32_bf16(a1, bfr, c1, 0, 0, 0); }
                const int hq = nt / 6, wt = nt % 6, dd = wt * 16 + fr;
#pragma unroll
                for (int mt = 0; mt < 2; ++mt)
#pragma unroll
                    for (int j = 0; j < 4; ++j) { const int tl = mt * 16 + fq * 4 + j; const int t = ti.t0 + tl;
                        float v = (mt ? c1[j] : c0[j]) * rs[tl * 2];
                        const float pv = dppf<0x128>(v);
                        if (wt >= 4 && !ti.isctx) { const int f = fr & 7; const float pos = (wt == 4) ? (float)(t >> 6) : (float)(t & 63);
                            const float ang = pos * __expf(-(float)f * (9.210340371976184f / 8.f)); float sn, cs; __sincosf(ang, &sn, &cs);
                            v = (fr & 8) ? (v * cs + pv * sn) : (v * cs - pv * sn); }
                        QB[((size_t)(ti.b * 4 + hq) * TT + keybase + t) * 96 + dd] = (bf16)f2bf(v * QSCALE); } }
#pragma unroll 1
            for (int i = 0; i < 4; ++i) { const int nt = wave * 4 + i;
                f32x4 c0 = {0.f, 0.f, 0.f, 0.f}, c1 = c0;
#pragma unroll
                for (int ks = 0; ks < 4; ++ks) { const bf16x8 bfr = *(const bf16x8*)(WUKV + (size_t)(nt * 16 + fr) * 128 + ks * 32 + fq * 8);
                    const bf16x8 a0 = *(const bf16x8*)(As + fr * 392 + 256 + ks * 32 + fq * 8), a1 = *(const bf16x8*)(As + (16 + fr) * 392 + 256 + ks * 32 + fq * 8);
                    c0 = __builtin_amdgcn_mfma_f32_16x16x32_bf16(a0, bfr, c0, 0, 0, 0); c1 = __builtin_amdgcn_mfma_f32_16x16x32_bf16(a1, bfr, c1, 0, 0, 0); }
                const int hk = nt >> 3, wt = nt & 7;
#pragma unroll
                for (int mt = 0; mt < 2; ++mt)
#pragma unroll
                    for (int j = 0; j < 4; ++j) { const int tl = mt * 16 + fq * 4 + j; const int key = keybase + ti.t0 + tl;
                        const float v = (mt ? c1[j] : c0[j]) * rs[tl * 2 + 1];
                        if (wt < 4) KB[((size_t)(ti.b * 4 + hk) * TT + key) * 96 + wt * 16 + fr] = (bf16)f2bf(v);
                        else VT[((size_t)(ti.b * 4 + hk) * 64 + (wt - 4) * 16 + fr) * TT + key] = (bf16)f2bf(v); } }
            { const int tl = tid >> 4, p = tid & 15, ax = p >> 3, f = p & 7; const int t = ti.t0 + tl;
                float x0 = kr[tl * 32 + ax * 16 + f], x1 = kr[tl * 32 + ax * 16 + 8 + f];
                if (!ti.isctx) { const float pos = ax == 0 ? (float)(t >> 6) : (float)(t & 63); const float ang = pos * __expf(-(float)f * (9.210340371976184f / 8.f));
                    float sn, cs; __sincosf(ang, &sn, &cs); const float y0 = x0 * cs - x1 * sn, y1 = x1 * cs + x0 * sn; x0 = y0; x1 = y1; }
                const bf16 b0 = (bf16)f2bf(x0), b1 = (bf16)f2bf(x1);
#pragma unroll
                for (int h = 0; h < 4; ++h) { bf16* kp = KB + ((size_t)(ti.b * 4 + h) * TT + keybase + t) * 96 + 64 + ax * 16 + f; kp[0] = b0; kp[8] = b1; } }
            __syncthreads();
        }
    }
}

__device__ __forceinline__ void attn_unit(unsigned char* lds, const bf16* QB, const bf16* KB, const bf16* VT, bf16* Y, int b, int h, int q0, int key_lo, int nkt, int tid) {
    const int lane = tid & 63, wave = tid >> 6, fr = lane & 15, fq = lane >> 4;
    const int bh = b * 4 + h;
    constexpr int KSTR = 104, VSTR = 72, KBUF = 64 * KSTR, VBUF = 64 * VSTR;
    bf16* Ks = (bf16*)lds;
    bf16* Vs = (bf16*)lds + 2 * KBUF;
    const int qw = q0 + wave * 32;
    bf16x8 qf[2][3];
#pragma unroll
    for (int qt = 0; qt < 2; ++qt)
#pragma unroll
        for (int ks = 0; ks < 3; ++ks) qf[qt][ks] = *(const bf16x8*)(QB + ((size_t)bh * TT + qw + qt * 16 + fr) * 96 + ks * 32 + fq * 8);
    float mrun[2] = {-1e30f, -1e30f}, lrun[2] = {0.f, 0.f};
    f32x4 o[4][2];
#pragma unroll
    for (int dt = 0; dt < 4; ++dt)
#pragma unroll
        for (int qt = 0; qt < 2; ++qt) o[dt][qt] = (f32x4){0.f, 0.f, 0.f, 0.f};
    const v4u* kg = (const v4u*)(KB + ((size_t)bh * TT + key_lo) * 96);
    const bf16* vg = VT + ((size_t)bh * 64 + (tid >> 3)) * TT + key_lo + (tid & 7) * 8;
    const int kc0 = tid, kc1 = 512 + tid;
    const int ko0 = (kc0 / 12) * KSTR + (kc0 % 12) * 8, ko1 = (kc1 / 12) * KSTR + (kc1 % 12) * 8, vo = (tid >> 3) * VSTR + (tid & 7) * 8;
    v4u rk0, rk1 = {0u, 0u, 0u, 0u}, rv;
    rk0 = kg[kc0]; if (tid < 256) rk1 = kg[kc1]; rv = *(const v4u*)vg;
    *(v4u*)(Ks + ko0) = rk0; if (tid < 256) *(v4u*)(Ks + ko1) = rk1; *(v4u*)(Vs + vo) = rv;
    __syncthreads();
    for (int kt = 0; kt < nkt; ++kt) {
        const int cur = kt & 1;
        if (kt + 1 < nkt) { const v4u* kn = kg + (size_t)(kt + 1) * 768; rk0 = kn[kc0]; if (tid < 256) rk1 = kn[kc1]; rv = *(const v4u*)(vg + (kt + 1) * 64); }
        const bf16* kb = Ks + cur * KBUF; const bf16* vb = Vs + cur * VBUF;
        f32x4 st[4][2];
#pragma unroll
        for (int k4 = 0; k4 < 4; ++k4) {
            st[k4][0] = (f32x4){0.f, 0.f, 0.f, 0.f}; st[k4][1] = st[k4][0];
#pragma unroll
            for (int ks = 0; ks < 3; ++ks) { const bf16x8 kf = *(const bf16x8*)(kb + (k4 * 16 + fr) * KSTR + ks * 32 + fq * 8);
                st[k4][0] = __builtin_amdgcn_mfma_f32_16x16x32_bf16(kf, qf[0][ks], st[k4][0], 0, 0, 0);
                st[k4][1] = __builtin_amdgcn_mfma_f32_16x16x32_bf16(kf, qf[1][ks], st[k4][1], 0, 0, 0); }
        }
        bf16x8 pb[2][2];
#pragma unroll
        for (int qt = 0; qt < 2; ++qt) {
            float mx = st[0][qt][0];
#pragma unroll
            for (int k4 = 0; k4 < 4; ++k4)
#pragma unroll
                for (int j = 0; j < 4; ++j) mx = fmaxf(mx, st[k4][qt][j]);
            mx = rows4_max(mx);
            const float mn = fmaxf(mrun[qt], mx), alpha = __builtin_amdgcn_exp2f(mrun[qt] - mn); mrun[qt] = mn;
            float ls = 0.f;
#pragma unroll
            for (int k4 = 0; k4 < 4; ++k4)
#pragma unroll
                for (int j = 0; j < 4; ++j) { const float p = __builtin_amdgcn_exp2f(st[k4][qt][j] - mn); st[k4][qt][j] = p; ls += p; }
            lrun[qt] = lrun[qt] * alpha + ls;
#pragma unroll
            for (int dt = 0; dt < 4; ++dt) o[dt][qt] *= alpha;
#pragma unroll
            for (int u = 0; u < 2; ++u) { v4u w;
                w.x = pg8::cvt_pk_bf16(st[2 * u][qt][0], st[2 * u][qt][1]); w.y = pg8::cvt_pk_bf16(st[2 * u][qt][2], st[2 * u][qt][3]);
                w.z = pg8::cvt_pk_bf16(st[2 * u + 1][qt][0], st[2 * u + 1][qt][1]); w.w = pg8::cvt_pk_bf16(st[2 * u + 1][qt][2], st[2 * u + 1][qt][3]);
                pb[u][qt] = __builtin_bit_cast(bf16x8, w); }
        }
#pragma unroll
        for (int dt = 0; dt < 4; ++dt)
#pragma unroll
            for (int u = 0; u < 2; ++u) {
                const v2u lo = *(const v2u*)(vb + (dt * 16 + fr) * VSTR + 32 * u + 4 * fq), hi = *(const v2u*)(vb + (dt * 16 + fr) * VSTR + 32 * u + 16 + 4 * fq);
                v4u vw; vw.x = lo.x; vw.y = lo.y; vw.z = hi.x; vw.w = hi.y;
                const bf16x8 va = __builtin_bit_cast(bf16x8, vw);
                o[dt][0] = __builtin_amdgcn_mfma_f32_16x16x32_bf16(va, pb[u][0], o[dt][0], 0, 0, 0);
                o[dt][1] = __builtin_amdgcn_mfma_f32_16x16x32_bf16(va, pb[u][1], o[dt][1], 0, 0, 0);
            }
        if (kt + 1 < nkt) { const int nb = cur ^ 1; *(v4u*)(Ks + nb * KBUF + ko0) = rk0; if (tid < 256) *(v4u*)(Ks + nb * KBUF + ko1) = rk1; *(v4u*)(Vs + nb * VBUF + vo) = rv; }
        __syncthreads();
    }
#pragma unroll
    for (int qt = 0; qt < 2; ++qt) {
        const float lt = rows4_sum(lrun[qt]);
        const float inv = 1.f / lt;
        const int q = qw + qt * 16 + fr;
        const size_t row = q < TLEN ? (size_t)b * TLEN + q : (size_t)NLAT + b * CTXL + (q - TLEN);
#pragma unroll
        for (int dt = 0; dt < 4; ++dt) { const f32x4 v = o[dt][qt] * inv; v2u w; w.x = pk2(v[0], v[1]); w.y = pk2(v[2], v[3]);
            *(v2u*)(Y + row * DM + 768 + h * 64 + dt * 16 + fq * 4) = w; }
    }
}
__device__ __forceinline__ void lru_prefix(int bd, int tid) {
    unsigned char* ws = karg_ws();
    if (tid >= 256) return;
    const int ch = tid, b = bd >> 1, d = bd & 1;
    const float* __restrict__ SA = (const float*)(ws + M_SEGA); const float* __restrict__ SB = (const float*)(ws + M_SEGB); float* __restrict__ H0 = (float*)(ws + M_H0);
    const int ctile0 = 512 + b * 8, ltile0 = b * 256;
#define LRU_TILE(i_) ((i_) < 8 ? ctile0 + (d ? 7 - (i_) : (i_)) : ltile0 + (d ? 255 - ((i_) - 8) : ((i_) - 8)))
    float hst = 0.f;
    float ca[24], cb[24], na[24], nb[24];
#pragma unroll
    for (int k = 0; k < 24; ++k) { const size_t o = (size_t)(LRU_TILE(k) * 2 + d) * 256 + ch; ca[k] = SA[o]; cb[k] = SB[o]; }
    for (int i0 = 0; i0 < 264; i0 += 24) {
        if (i0 + 24 < 264) {
#pragma unroll
            for (int k = 0; k < 24; ++k) { const size_t o = (size_t)(LRU_TILE(i0 + 24 + k) * 2 + d) * 256 + ch; na[k] = SA[o]; nb[k] = SB[o]; } }
        float hv[24];
#pragma unroll
        for (int k = 0; k < 24; ++k) { hv[k] = hst; hst = ca[k] * hst + cb[k]; }
#pragma unroll
        for (int k = 0; k < 24; ++k) H0[(size_t)(LRU_TILE(i0 + k) * 2 + d) * 256 + ch] = hv[k];
#pragma unroll
        for (int k = 0; k < 24; ++k) { ca[k] = na[k]; cb[k] = nb[k]; }
    }
#undef LRU_TILE
}
__device__ __forceinline__ void lru_rescan(const Args& a, int l, unsigned char* lds, int tile, int tid) {
    unsigned char* ws = karg_ws();
    const int ch = tid & 255, d = tid >> 8;
    const int row0 = tile * 32;
    float hst = ((const float*)(ws + M_H0))[(size_t)(tile * 2 + d) * 256 + ch];
    const float lam = IN(22)[(l * 2 + d) * 256 + ch];
    const float cch = -8.f * log1pf(__expf(-lam));
    const bf16* LR = (const bf16*)(ws + M_LR0 + (size_t)d * A8); const bf16* LIX = (const bf16*)(ws + M_LIX0 + (size_t)d * A8);
    float* hs = (float*)lds;
#pragma unroll 16
    for (int tt = 0; tt < 32; ++tt) { const int t = d ? 31 - tt : tt; const size_t o = (size_t)(row0 + t) * 256 + ch;
        const float al = __expf(cch * bf2f(LR[o])); const float bb = sqrtf(fmaxf(1.f - al * al, 0.f)) * bf2f(LIX[o]);
        hst = al * hst + bb; hs[(d * 32 + t) * 256 + ch] = hst; }
    __syncthreads();
    const bf16* U = (const bf16*)(ws + OFF_HU); bf16* Y = (bf16*)(ws + OFF_XMY);
#pragma unroll 8
    for (int tt = 0; tt < 16; ++tt) { const int t = d * 16 + tt;
        const float y = (hs[t * 256 + ch] + hs[(32 + t) * 256 + ch]) * geluf_(bf2f(U[(size_t)(row0 + t) * UC + 768 + ch]));
        Y[(size_t)(row0 + t) * DM + 256 + ch] = (bf16)f2bf(y); }
    __syncthreads();
}
__device__ __forceinline__ void phase_m2(const Args& a, int l, unsigned char* lds, int G, int bid, int tid) {
    unsigned char* ws = karg_ws();
    const bf16* QB = (const bf16*)(ws + M_QB); const bf16* KB = (const bf16*)(ws + M_KB); const bf16* VT = (const bf16*)(ws + M_VT);
    bf16* Y = (bf16*)(ws + OFF_XMY);
    const int nunits = (l == 0) ? 264 : 256;
    for (int u = bid; u < nunits; u += G) {
        if (u < 256) attn_unit(lds, QB, KB, VT, Y, u >> 7, (u >> 5) & 3, (u & 31) * 256, 0, 132, tid);
        else attn_unit(lds, QB, KB, VT, Y, (u - 256) >> 2, (u - 256) & 3, TLEN, TLEN, 4, tid);
    }
    if (bid >= G - 4) lru_prefix(bid - (G - 4), tid);
}

__device__ __forceinline__ void phase_m3(const Args& a, int l, unsigned char* lds, int G, int bid, int tid) {
    unsigned char* ws = karg_ws();
    const bf16* U = (const bf16*)(ws + OFF_HU);
    const int lane = tid & 63, ch = tid & 255, part = tid >> 8;
    const float* mup = IN(23) + l * 1024; const float* mun = IN(24) + l * 1024;
    bf16* RR = (bf16*)(ws + M_RR); bf16* KKo = (bf16*)(ws + M_KK); bf16* VV = (bf16*)(ws + M_VV); bf16* GC = (bf16*)(ws + M_GC);
    float* kl = (float*)lds;
    float* kkn = (float*)(lds + 32768);
    bf16* twb = (bf16*)(lds + 65536);
    bf16* tab = (bf16*)(lds + 70144);
    bf16* tgb = (bf16*)(lds + 74752);
    for (int pass = 0; pass < 2; ++pass)
    for (int tile = (pass == 0 ? bid : (bid < 48 ? 512 + bid / 3 : NTILE)); tile < (pass == 0 ? 512 : NTILE); tile += (pass == 0 ? G : NTILE)) {
        const int mask = pass == 0 ? 7 : ((1 << (bid % 3)) & (l == 1 ? 6 : 7));
        const TileInfo ti = tile_info(tile);
        const int row0 = tile * 32;
        if (mask & 1) lru_rescan(a, l, lds, tile, ltid());
        if (mask & 6) {
        {
            const int tid2 = ltid(); const int chunk = tid2 & 127, tg8 = tid2 >> 7, c0 = chunk * 8;
            const bf16* ub = U + (size_t)row0 * UC + 1024 + c0;
            v4u rw[10];
#pragma unroll
            for (int q = 0; q < 10; ++q) { const int tl = tg8 * 8 + q - 1; const int t = ti.t0 + tl;
                rw[q] = (t >= 0 && t < ti.seqlen) ? *(const v4u*)(ub + (ptrdiff_t)tl * UC) : (v4u){0u, 0u, 0u, 0u}; }
            const f32x4 mp0 = *(const f32x4*)(mup + c0), mp1 = *(const f32x4*)(mup + c0 + 4), mn0 = *(const f32x4*)(mun + c0), mn1 = *(const f32x4*)(mun + c0 + 4);
            const float mp[8] = {mp0[0], mp0[1], mp0[2], mp0[3], mp1[0], mp1[1], mp1[2], mp1[3]}, mn[8] = {mn0[0], mn0[1], mn0[2], mn0[3], mn1[0], mn1[1], mn1[2], mn1[3]};
#pragma unroll
            for (int q = 0; q < 8; ++q) { const int tl = tg8 * 8 + q; float ts[8];
#pragma unroll
                for (int e = 0; e < 8; ++e) { const unsigned wm = rw[q][e >> 1], w0 = rw[q + 1][e >> 1], wn = rw[q + 2][e >> 1];
                    const float um = (e & 1) ? __uint_as_float(wm & 0xffff0000u) : __uint_as_float(wm << 16);
                    const float u0 = (e & 1) ? __uint_as_float(w0 & 0xffff0000u) : __uint_as_float(w0 << 16);
                    const float un = (e & 1) ? __uint_as_float(wn & 0xffff0000u) : __uint_as_float(wn << 16);
                    ts[e] = u0 + mp[e] * (um - u0) + mn[e] * (un - u0); }
                if (chunk >= 32 && chunk < 64) { float* kp = kl + tl * 256 + (c0 - 256); *(f32x4*)kp = (f32x4){ts[0], ts[1], ts[2], ts[3]}; *(f32x4*)(kp + 4) = (f32x4){ts[4], ts[5], ts[6], ts[7]}; }
                else {
                    if (chunk >= 96 && chunk < 104) {
#pragma unroll
                        for (int e = 0; e < 8; ++e) ts[e] = tanhf_(ts[e]); }
                    if (chunk >= 112) {
#pragma unroll
                        for (int e = 0; e < 8; ++e) ts[e] = sigm(ts[e]); }
                    v4u o; o.x = pk2(ts[0], ts[1]); o.y = pk2(ts[2], ts[3]); o.z = pk2(ts[4], ts[5]); o.w = pk2(ts[6], ts[7]);
                    if (chunk < 32) *(v4u*)(RR + (size_t)(row0 + tl) * 256 + c0) = o;
                    else if (chunk < 96) *(v4u*)(VV + (size_t)(row0 + tl) * 256 + (c0 - 512)) = o;
                    else if (chunk < 104) *(v4u*)(twb + tl * 72 + (c0 - 768)) = o;
                    else if (chunk < 112) *(v4u*)(tab + tl * 72 + (c0 - 832)) = o;
                    else *(v4u*)(tgb + tl * 136 + (c0 - 896)) = o; }
            }
        }
        __syncthreads();
        {
            const int tid2 = ltid(); const int ch = tid2 & 255, pt = tid2 >> 8; const float kkc = IN(30)[l * 256 + ch];
#pragma unroll 4
            for (int q = 0; q < 16; ++q) { const int t = pt * 16 + q; const float kr = kl[t * 256 + ch] * kkc; const float nrm = wave_sum(kr * kr);
                const float kk = kr * rsqrtf(fmaxf(nrm, 1e-24f)); kkn[t * 256 + ch] = kk; KKo[(size_t)(row0 + t) * 256 + ch] = (bf16)f2bf(kk); }
        }
        __syncthreads();
        {
            const int tid2 = ltid(); const int ln = tid2 & 63, wv = __builtin_amdgcn_readfirstlane(tid2 >> 6), fr = ln & 15, fq = ln >> 4;
            const bf16* WUPt = (const bf16*)(ws + W_WUP); const bf16* AUPt = (const bf16*)(ws + W_AUP); const bf16* GUPt = (const bf16*)(ws + W_GUP);
            bf16x8 aw[2][2], aa[2][2];
#pragma unroll
            for (int mt = 0; mt < 2; ++mt)
#pragma unroll
                for (int ks = 0; ks < 2; ++ks) { aw[mt][ks] = *(const bf16x8*)(twb + (mt * 16 + fr) * 72 + ks * 32 + fq * 8); aa[mt][ks] = *(const bf16x8*)(tab + (mt * 16 + fr) * 72 + ks * 32 + fq * 8); }
#pragma unroll 1
            for (int dn = 0; dn < 4; ++dn) { const int d = dn >> 1, nt = wv * 2 + (dn & 1), ch = nt * 16 + fr;
                if (!((mask >> (1 + d)) & 1)) continue;
                f32x4 cw[2], ca[2];
#pragma unroll
                for (int mt = 0; mt < 2; ++mt) { cw[mt] = (f32x4){0.f, 0.f, 0.f, 0.f}; ca[mt] = cw[mt]; }
#pragma unroll
                for (int ks = 0; ks < 2; ++ks) { const bf16x8 bw = *(const bf16x8*)(WUPt + ((size_t)d * 256 + ch) * 64 + ks * 32 + fq * 8), ba = *(const bf16x8*)(AUPt + ((size_t)d * 256 + ch) * 64 + ks * 32 + fq * 8);
#pragma unroll
                    for (int mt = 0; mt < 2; ++mt) { cw[mt] = __builtin_amdgcn_mfma_f32_16x16x32_bf16(aw[mt][ks], bw, cw[mt], 0, 0, 0); ca[mt] = __builtin_amdgcn_mfma_f32_16x16x32_bf16(aa[mt][ks], ba, ca[mt], 0, 0, 0); } }
                const float w0 = IN(25)[(l * 2 + d) * 256 + ch], a0 = IN(27)[(l * 2 + d) * 256 + ch], kac = IN(31)[l * 256 + ch];
                float* WW = (float*)(ws + M_WW) + (size_t)d * NR * 256; bf16* BB = (bf16*)(ws + M_BB + (size_t)d * A8); bf16* KD = (bf16*)(ws + M_KD + (size_t)d * A8);
#pragma unroll
                for (int mt = 0; mt < 2; ++mt)
#pragma unroll
                    for (int j = 0; j < 4; ++j) { const int t = mt * 16 + fq * 4 + j; const size_t o = (size_t)(row0 + t) * 256 + ch;
                        const float e = sigm(w0 + cw[mt][j]) * 0.6065306597126334f;
                        const float av = sigm(a0 + ca[mt][j]);
                        WW[o] = __expf(-e);
                        KD[o] = (bf16)f2bf(kl[t * 256 + ch] * (1.f + (av - 1.f) * kac));
                        BB[o] = (bf16)f2bf(kkn[t * 256 + ch] * av); }
            }
#pragma unroll 1
            for (int nl = 0; nl < 2; ++nl) { const int ch = (wv * 2 + nl) * 16 + fr;
                if (!(mask & 4)) continue;
                f32x4 cg[2] = {(f32x4){0.f, 0.f, 0.f, 0.f}, (f32x4){0.f, 0.f, 0.f, 0.f}};
#pragma unroll
                for (int ks = 0; ks < 4; ++ks) { const bf16x8 bg = *(const bf16x8*)(GUPt + (size_t)ch * 128 + ks * 32 + fq * 8);
#pragma unroll
                    for (int mt = 0; mt < 2; ++mt) { const bf16x8 ag = *(const bf16x8*)(tgb + (mt * 16 + fr) * 136 + ks * 32 + fq * 8); cg[mt] = __builtin_amdgcn_mfma_f32_16x16x32_bf16(ag, bg, cg[mt], 0, 0, 0); } }
#pragma unroll
                for (int mt = 0; mt < 2; ++mt)
#pragma unroll
                    for (int j = 0; j < 4; ++j) GC[(size_t)(row0 + mt * 16 + fq * 4 + j) * 256 + ch] = (bf16)f2bf(cg[mt][j]);
            }
        }
        __syncthreads();
        }
    }
}

typedef const unsigned cu32;
typedef const float cf32;
__device__ __forceinline__ int chain_row(int b, int d, int tau) {
    return tau < CTXL ? (NLAT + b * CTXL + (d ? CTXL - 1 - tau : tau)) : (b * TLEN + (d ? TLEN - 1 - (tau - CTXL) : (tau - CTXL)));
}
template <int MODE>
__device__ __forceinline__ void rwkv_steps(float (&S)[64], int b, int h, int d, int tau0, int n, unsigned char* ws, int lane, float* wl) {
    const bf16* KKp = (const bf16*)(ws + M_KK); const bf16* RRp = (const bf16*)(ws + M_RR); const bf16* VVp = (const bf16*)(ws + M_VV);
    const float* WWp = (const float*)(ws + M_WW) + (size_t)d * NR * 256; const bf16* BBp = (const bf16*)(ws + M_BB + (size_t)d * A8); const bf16* KDp = (const bf16*)(ws + M_KD + (size_t)d * A8);
    float* YS = (float*)(ws + M_YS) + (size_t)d * NR * 256;
    float pk, pw, pb, pkd = 0.f, pr = 0.f, pv = 0.f; size_t poff;
#define RWKV_LOAD(s_) do { poff = (size_t)chain_row(b, d, tau0 + (s_)) * 256 + h * 64 + lane; pk = bf2f(KKp[poff]); pw = WWp[poff]; pb = bf2f(BBp[poff]); \
        if (MODE != 1) { pkd = bf2f(KDp[poff]); pv = bf2f(VVp[poff]); } if (MODE == 2) pr = bf2f(RRp[poff]); } while (0)
    RWKV_LOAD(0);
    for (int s = 0; s < n; ++s) {
        float* buf = wl + (s & 1) * 320;
        buf[lane] = pk; buf[64 + lane] = pw; buf[128 + lane] = pb;
        if (MODE != 1) buf[192 + lane] = pkd;
        if (MODE == 2) buf[256 + lane] = pr;
        const float vv = pv; const size_t yoff = poff;
        if (s + 1 < n) RWKV_LOAD(s + 1);
        float sa0 = 0.f, sa1 = 0.f, sa2 = 0.f, sa3 = 0.f;
#pragma unroll
        for (int i = 0; i < 64; i += 4) { const f32x4 k4 = *(const f32x4*)(buf + i);
            sa0 += S[i] * k4[0]; sa1 += S[i + 1] * k4[1]; sa2 += S[i + 2] * k4[2]; sa3 += S[i + 3] * k4[3]; }
        const float nsa = -((sa0 + sa1) + (sa2 + sa3));
        float y0 = 0.f, y1 = 0.f, y2 = 0.f, y3 = 0.f;
#pragma unroll
        for (int i = 0; i < 64; i += 4) { const f32x4 w4 = *(const f32x4*)(buf + 64 + i), b4 = *(const f32x4*)(buf + 128 + i);
            f32x4 t = nsa * b4;
            if (MODE != 1) { const f32x4 kd4 = *(const f32x4*)(buf + 192 + i); t += vv * kd4; }
            S[i] = S[i] * w4[0] + t[0]; S[i + 1] = S[i + 1] * w4[1] + t[1]; S[i + 2] = S[i + 2] * w4[2] + t[2]; S[i + 3] = S[i + 3] * w4[3] + t[3];
            if (MODE == 2) { const f32x4 r4 = *(const f32x4*)(buf + 256 + i); y0 += S[i] * r4[0]; y1 += S[i + 1] * r4[1]; y2 += S[i + 2] * r4[2]; y3 += S[i + 3] * r4[3]; } }
        if (MODE == 2) YS[yoff] = (y0 + y1) + (y2 + y3);
    }
#undef RWKV_LOAD
}
typedef float f32x2 __attribute__((ext_vector_type(2)));
__device__ __forceinline__ void rwkv_pass1(f32x2 (&SL)[32], f32x2 (&SI)[32], int b, int h, int d, int tau0, int n, unsigned char* ws, int lane, float* wl) {
    const bf16* KKp = (const bf16*)(ws + M_KK); const bf16* VVp = (const bf16*)(ws + M_VV); const bf16* RRp = (const bf16*)(ws + M_RR);
    const float* WWp = (const float*)(ws + M_WW) + (size_t)d * NR * 256; const bf16* BBp = (const bf16*)(ws + M_BB + (size_t)d * A8); const bf16* KDp = (const bf16*)(ws + M_KD + (size_t)d * A8);
    float* YS = (float*)(ws + M_YS) + (size_t)d * NR * 256; float* PR = (float*)(ws + M_PR) + (size_t)d * NR * 256;
    float pk, pw, pb, pkd, pv, pr; size_t poff;
#define RWKV_LOAD(s_) do { poff = (size_t)chain_row(b, d, tau0 + (s_)) * 256 + h * 64 + lane; pk = bf2f(KKp[poff]); pw = WWp[poff]; pb = bf2f(BBp[poff]); pkd = bf2f(KDp[poff]); pv = bf2f(VVp[poff]); pr = bf2f(RRp[poff]); } while (0)
    RWKV_LOAD(0);
    for (int s = 0; s < n; ++s) {
        float* buf = wl + (s & 1) * 320;
        buf[lane] = pk; buf[64 + lane] = pw; buf[128 + lane] = pb; buf[192 + lane] = pkd; buf[256 + lane] = pr;
        const float vv = pv; const size_t yoff = poff;
        if (s + 1 < n) RWKV_LOAD(s + 1);
        f32x2 aL0 = {0.f, 0.f}, aL1 = aL0, aI0 = aL0, aI1 = aL0;
#pragma unroll
        for (int q = 0; q < 16; ++q) { const f32x4 k4 = *(const f32x4*)(buf + 4 * q);
            aL0 += SL[2 * q] * k4.lo; aL1 += SL[2 * q + 1] * k4.hi; aI0 += SI[2 * q] * k4.lo; aI1 += SI[2 * q + 1] * k4.hi; }
        const f32x2 tL = aL0 + aL1, tI = aI0 + aI1;
        const float nsl = -(tL.x + tL.y), nsi = -(tI.x + tI.y);
        f32x2 yL0 = {0.f, 0.f}, yL1 = yL0, yI0 = yL0, yI1 = yL0;
#pragma unroll
        for (int q = 0; q < 16; ++q) {
            const f32x4 w4 = *(const f32x4*)(buf + 64 + 4 * q), b4 = *(const f32x4*)(buf + 128 + 4 * q), kd4 = *(const f32x4*)(buf + 192 + 4 * q), r4 = *(const f32x4*)(buf + 256 + 4 * q);
            const f32x4 tl = nsl * b4 + vv * kd4, tiv = nsi * b4;
            SL[2 * q] = SL[2 * q] * w4.lo + tl.lo; SL[2 * q + 1] = SL[2 * q + 1] * w4.hi + tl.hi;
            SI[2 * q] = SI[2 * q] * w4.lo + tiv.lo; SI[2 * q + 1] = SI[2 * q + 1] * w4.hi + tiv.hi;
            yL0 += SL[2 * q] * r4.lo; yL1 += SL[2 * q + 1] * r4.hi; yI0 += SI[2 * q] * r4.lo; yI1 += SI[2 * q + 1] * r4.hi; }
        const f32x2 yl = yL0 + yL1, yp = yI0 + yI1;
        YS[yoff] = yl.x + yl.y; PR[yoff] = yp.x + yp.y;
    }
#undef RWKV_LOAD
}
__device__ __forceinline__ void phase_m4(const Args& a, unsigned char* lds, int G, int bid, int tid) {
    const int lane = tid & 63, wave = __builtin_amdgcn_readfirstlane(tid >> 6), half = wave >> 2, tk = wave & 3;
    unsigned char* ws = karg_ws(); float* PL = (float*)(ws + M_PL);
    float* wl = (float*)lds + wave * 320;
    float* xch = (float*)lds + 8 * 320 + tk * 1024;
    float* ych = xch + 512;
    const bf16* KKp = (const bf16*)(ws + M_KK); const bf16* VVp = (const bf16*)(ws + M_VV); const bf16* RRp = (const bf16*)(ws + M_RR);
    for (int task0 = bid * 4; task0 < 16 * NSEG; task0 += G * 4) {
        const int task = task0 + tk; const int seg = task & (NSEG - 1), chain = task >> 6;
        const int d = chain & 1, h = (chain >> 1) & 3, b = chain >> 3;
        const float* WWp = (const float*)(ws + M_WW) + (size_t)d * NR * 256; const bf16* BBp = (const bf16*)(ws + M_BB + (size_t)d * A8); const bf16* KDp = (const bf16*)(ws + M_KD + (size_t)d * A8);
        float* YS = (float*)(ws + M_YS) + (size_t)d * NR * 256; float* PR = (float*)(ws + M_PR) + (size_t)d * NR * 256;
        f32x2 SL[16], SI[16]; int ln = lane; asm volatile("" : "+v"(ln));
#pragma unroll
        for (int i = 0; i < 16; ++i) { SL[i] = (f32x2){0.f, 0.f}; SI[i] = (f32x2){(32 * half + 2 * i == ln) ? 1.f : 0.f, (32 * half + 2 * i + 1 == ln) ? 1.f : 0.f}; }
        const int tau0 = seg * SEGLEN, cidx = h * 64 + 32 * half + (lane & 31);
        unsigned pp; float pw, pv; size_t rowoff, prevoff = 0;
        const int grp = lane >> 4, l15 = lane & 15, l31 = lane & 31;
        const unsigned* srcp = grp == 0 ? (const unsigned*)KKp : grp == 1 ? (const unsigned*)BBp : grp == 2 ? (const unsigned*)KDp : (const unsigned*)RRp;
#define M4_LOAD(s_) do { rowoff = (size_t)chain_row(b, d, tau0 + (s_)) * 256; pp = srcp[(rowoff + h * 64 + 32 * half) / 2 + l15]; \
            pw = (lane < 32) ? WWp[rowoff + cidx] : 0.f; pv = bf2f(VVp[rowoff + h * 64 + lane]); } while (0)
#define UNPK(u_) ((f32x2){__uint_as_float((u_) << 16), __uint_as_float((u_) & 0xffff0000u)})
        M4_LOAD(0);
        for (int s = 0; s < SEGLEN; ++s) {
            float* buf = wl + (s & 1) * 160; const unsigned* bufu = (const unsigned*)buf;
            ((unsigned*)buf)[lane] = pp; if (lane < 32) buf[64 + l31] = pw;
            const float vv = pv; const size_t yoff = rowoff + h * 64 + lane;
            if (s + 1 < SEGLEN) M4_LOAD(s + 1);
            f32x2 aL0 = {0.f, 0.f}, aL1 = aL0, aI0 = aL0, aI1 = aL0;
#pragma unroll
            for (int q = 0; q < 4; ++q) { const v4u k4 = *(const v4u*)(bufu + 4 * q);
                const f32x2 ka = UNPK(k4.x), kb = UNPK(k4.y), kc = UNPK(k4.z), kd_ = UNPK(k4.w);
                aL0 += SL[4 * q] * ka; aL1 += SL[4 * q + 1] * kb; aL0 += SL[4 * q + 2] * kc; aL1 += SL[4 * q + 3] * kd_;
                aI0 += SI[4 * q] * ka; aI1 += SI[4 * q + 1] * kb; aI0 += SI[4 * q + 2] * kc; aI1 += SI[4 * q + 3] * kd_; }
            const f32x2 tL = aL0 + aL1, tI = aI0 + aI1;
            float* xw = xch + (s & 1) * 256;
            xw[half * 128 + lane] = tL.x + tL.y; xw[half * 128 + 64 + lane] = tI.x + tI.y;
            __syncthreads();
            const float nsl = -(xw[lane] + xw[128 + lane]), nsi = -(xw[64 + lane] + xw[192 + lane]);
            if (s > 0) {
                const float* yr = ych + ((s - 1) & 1) * 256;
                if (half == 0) YS[prevoff] = yr[lane] + yr[128 + lane]; else PR[prevoff] = yr[64 + lane] + yr[192 + lane];
            }
            f32x2 yL0 = {0.f, 0.f}, yL1 = yL0, yI0 = yL0, yI1 = yL0;
#pragma unroll
            for (int q = 0; q < 4; ++q) {
                const f32x4 wa = *(const f32x4*)(buf + 64 + 8 * q), wb = *(const f32x4*)(buf + 68 + 8 * q);
                const v4u b4 = *(const v4u*)(bufu + 16 + 4 * q), d4 = *(const v4u*)(bufu + 32 + 4 * q), r4 = *(const v4u*)(bufu + 48 + 4 * q);
                const f32x2 w2[4] = {wa.lo, wa.hi, wb.lo, wb.hi};
                const unsigned bu[4] = {b4.x, b4.y, b4.z, b4.w}, du[4] = {d4.x, d4.y, d4.z, d4.w}, ru[4] = {r4.x, r4.y, r4.z, r4.w};
#pragma unroll
                for (int e = 0; e < 4; ++e) { const int j = 4 * q + e; const f32x2 b2 = UNPK(bu[e]), k2 = UNPK(du[e]), r2 = UNPK(ru[e]);
                    const f32x2 tl = nsl * b2 + vv * k2, tiv = nsi * b2;
                    SL[j] = SL[j] * w2[e] + tl; SI[j] = SI[j] * w2[e] + tiv;
                    if (e & 1) { yL1 += SL[j] * r2; yI1 += SI[j] * r2; } else { yL0 += SL[j] * r2; yI0 += SI[j] * r2; } }
            }
            const f32x2 yl = yL0 + yL1, yp = yI0 + yI1;
            float* yw = ych + (s & 1) * 256;
            yw[half * 128 + lane] = yl.x + yl.y; yw[half * 128 + 64 + lane] = yp.x + yp.y;
            prevoff = yoff;
        }
#undef M4_LOAD
#undef UNPK
        __syncthreads();
        { const float* yr = ych + ((SEGLEN - 1) & 1) * 256;
          if (half == 0) YS[prevoff] = yr[lane] + yr[128 + lane]; else PR[prevoff] = yr[64 + lane] + yr[192 + lane]; }
        float* o = PL + (((size_t)(chain * NSEG + seg) * 2) * 64 + lane) * 64 + 32 * half;
#pragma unroll
        for (int i = 0; i < 16; i += 2) { *(f32x4*)(o + 2 * i) = (f32x4){SL[i].x, SL[i].y, SL[i + 1].x, SL[i + 1].y}; *(f32x4*)(o + 4096 + 2 * i) = (f32x4){SI[i].x, SI[i].y, SI[i + 1].x, SI[i + 1].y}; }
        __syncthreads();
    }
}
__device__ __forceinline__ void phase_m5(const Args& a, unsigned char* lds, int G, int bid, int tid) {
    unsigned char* ws = karg_ws(); const float* PL = (const float*)(ws + M_PL); float* SI = (float*)(ws + M_SINIT);
    float* Sx = (float*)lds;
    const int lane = tid & 63, wv = __builtin_amdgcn_readfirstlane(tid >> 6), fr = lane & 15, fq = lane >> 4;
    const bool act = wv < 4;
    for (int u = bid; u < 64; u += G) {
        const int chain = u >> 2, row0 = (u & 3) * 16, col = (wv & 3) * 16 + fr;
        const float* Pg = PL + ((size_t)(chain * NSEG) * 2 + 1) * 4096; const float* Lg = PL + ((size_t)(chain * NSEG) * 2) * 4096;
        float* SIc = SI + (size_t)(chain * NSEG) * 4096;
        f32x4 cur = {0.f, 0.f, 0.f, 0.f}; f32x4 lv[3]; float pb[3][16];
#pragma unroll
        for (int q = 0; q < 3; ++q) { lv[q] = cur;
            if (act) { const float* Pn = Pg + (size_t)q * 8192; const float* Ln = Lg + (size_t)q * 8192;
#pragma unroll
                for (int ks = 0; ks < 16; ++ks) pb[q][ks] = Pn[(4 * ks + fq) * 64 + col];
#pragma unroll
                for (int j = 0; j < 4; ++j) lv[q][j] = Ln[(row0 + fq * 4 + j) * 64 + col]; } }
        for (int g0 = 0; g0 < NSEG - 1; g0 += 3) {
#pragma unroll
            for (int q = 0; q < 3; ++q) { const int g = g0 + q;
                if (act) {
#pragma unroll
                    for (int j = 0; j < 4; ++j) { SIc[(size_t)g * 4096 + (row0 + fq * 4 + j) * 64 + col] = cur[j]; Sx[(fq * 4 + j) * 68 + col] = cur[j]; }
                }
                __syncthreads();
                if (act) {
                    f32x4 acc = lv[q];
#pragma unroll
                    for (int ks = 0; ks < 16; ++ks) { const float av = Sx[fr * 68 + 4 * ks + fq]; acc = __builtin_amdgcn_mfma_f32_16x16x4f32(av, pb[q][ks], acc, 0, 0, 0); }
                    cur = acc;
                    if (g + 3 < NSEG - 1) { const float* Pn = Pg + (size_t)(g + 3) * 8192; const float* Ln = Lg + (size_t)(g + 3) * 8192;
#pragma unroll
                        for (int ks = 0; ks < 16; ++ks) pb[q][ks] = Pn[(4 * ks + fq) * 64 + col];
#pragma unroll
                        for (int j = 0; j < 4; ++j) lv[q][j] = Ln[(row0 + fq * 4 + j) * 64 + col]; }
                }
                __syncthreads();
            }
        }
        if (act) {
#pragma unroll
            for (int j = 0; j < 4; ++j) SIc[(size_t)(NSEG - 1) * 4096 + (row0 + fq * 4 + j) * 64 + col] = cur[j];
        }
    }
}
__device__ __forceinline__ void phase_m6(const Args& a, unsigned char* lds, int G, int bid, int tid) {
    const int lane = tid & 63, wave = __builtin_amdgcn_readfirstlane(tid >> 6);
    unsigned char* ws = karg_ws(); const float* SI = (const float*)(ws + M_SINIT);
    float* wl = (float*)lds + wave * 256;
    for (int task = bid * 8 + wave; task < 16 * (NSEG - 1); task += G * 8) {
        const int seg = 1 + task % (NSEG - 1), chain = task / (NSEG - 1);
        const int d = chain & 1, h = (chain >> 1) & 3, b = chain >> 3;
        float* YS = (float*)(ws + M_YS) + (size_t)d * NR * 256; const float* PR = (const float*)(ws + M_PR) + (size_t)d * NR * 256;
        f32x2 S0[32];
        const float* si = SI + ((size_t)(chain * NSEG + seg) * 64 + lane) * 64;
#pragma unroll
        for (int i = 0; i < 32; i += 2) { const f32x4 v = *(const f32x4*)(si + 2 * i); S0[i] = v.lo; S0[i + 1] = v.hi; }
        const int tau0 = seg * SEGLEN;
        size_t o[4]; float p[4], y[4];
#pragma unroll
        for (int k = 0; k < 4; ++k) { o[k] = (size_t)chain_row(b, d, tau0 + k) * 256 + h * 64 + lane; p[k] = PR[o[k]]; y[k] = YS[o[k]]; }
        for (int s = 0; s < SEGLEN; s += 4) {
            size_t c[4]; float yy[4];
#pragma unroll
            for (int k = 0; k < 4; ++k) { wl[k * 64 + lane] = p[k]; c[k] = o[k]; yy[k] = y[k]; }
            if (s + 4 < SEGLEN) {
#pragma unroll
                for (int k = 0; k < 4; ++k) { o[k] = (size_t)chain_row(b, d, tau0 + s + 4 + k) * 256 + h * 64 + lane; p[k] = PR[o[k]]; y[k] = YS[o[k]]; } }
#pragma unroll
            for (int k = 0; k < 4; k += 2) {
                f32x2 a0 = {0.f, 0.f}, a1 = a0, b0 = a0, b1 = a0;
#pragma unroll
                for (int q = 0; q < 16; ++q) { const f32x4 u = *(const f32x4*)(wl + k * 64 + 4 * q), w = *(const f32x4*)(wl + (k + 1) * 64 + 4 * q);
                    a0 += S0[2 * q] * u.lo; a1 += S0[2 * q + 1] * u.hi; b0 += S0[2 * q] * w.lo; b1 += S0[2 * q + 1] * w.hi; }
                const f32x2 ta = a0 + a1, tb = b0 + b1;
                yy[k] += ta.x + ta.y; yy[k + 1] += tb.x + tb.y;
            }
#pragma unroll
            for (int k = 0; k < 4; ++k) YS[c[k]] = yy[k];
            asm volatile("" ::: "memory");
        }
    }
}
__device__ __forceinline__ void phase_m7(const Args& a, int l, int gw, int NGW, int lane) {
    unsigned char* ws = karg_ws();
    const float* Y0 = (const float*)(ws + M_YS); const float* Y1 = Y0 + (size_t)NR * 256;
    const bf16* RR = (const bf16*)(ws + M_RR); const bf16* VV = (const bf16*)(ws + M_VV); const bf16* KD0 = (const bf16*)(ws + M_KD); const bf16* KD1 = (const bf16*)(ws + M_KD + A8);
    const bf16* GC = (const bf16*)(ws + M_GC); bf16* Y = (bf16*)(ws + OFF_XMY);
    for (int r = gw; r < NR; r += NGW) {
#pragma unroll
        for (int h = 0; h < 4; ++h) { const int c = h * 64 + lane; const size_t o = (size_t)r * 256 + c;
            const float ys = Y0[o] + Y1[o];
            const float mu = wave_sum(ys) * (1.f / 64.f); const float dv = ys - mu; const float var = wave_sum(dv * dv) * (1.f / 64.f);
            float ov = dv * rsqrtf(var + 64e-5f) * IN(33)[l * 256 + c] + IN(34)[l * 256 + c];
            const float rv = bf2f(RR[o]), rk = IN(32)[l * 256 + c], vv = bf2f(VV[o]);
            const float b0 = wave_sum(rv * bf2f(KD0[o]) * rk), b1 = wave_sum(rv * bf2f(KD1[o]) * rk);
            ov += (b0 + b1) * vv;
            Y[(size_t)r * DM + 512 + c] = (bf16)f2bf(ov * bf2f(GC[o])); }
    }
}

#define LAS __attribute__((address_space(3)))
#define XB_TMO      128
#define XB_XCNT(j)  (256  + 64 * (j))
#define XB_XSUB(j)  (1280 + 64 * (j))
#define XB_XGEN(j)  (2304 + 64 * (j))
#define XB_TOP      3328
#define XB_TOPGEN   3392
#define XCD_BAR_WORDS 3456
#define XB_SPIN_CAP (1u << 18)

__device__ __forceinline__ unsigned xb_ld(unsigned* p)              { return __hip_atomic_load(p, __ATOMIC_RELAXED, __HIP_MEMORY_SCOPE_AGENT); }
__device__ __forceinline__ unsigned xb_add(unsigned* p, unsigned v) { return __hip_atomic_fetch_add(p, v, __ATOMIC_RELAXED, __HIP_MEMORY_SCOPE_AGENT); }
__device__ __forceinline__ unsigned xb_xcc_id() { return (unsigned)__builtin_amdgcn_s_getreg((3 << 11) | 20) & 0xFu; }
#define XB_SPIN(cond, bar) do { unsigned _sp = 0; while (cond) { __builtin_amdgcn_s_sleep(1); \
    if ((++_sp & 255u) == 0u) { if (xb_ld(&(bar)[XB_TMO])) break; if (_sp > XB_SPIN_CAP) { atomicAdd(&(bar)[XB_TMO], 1u); break; } } } } while (0)

struct XcdBarrier {
    unsigned* bar; unsigned x;
    volatile LAS unsigned* st;
};

__device__ __forceinline__ XcdBarrier xcd_barrier_post(unsigned* bar, volatile LAS unsigned* st) {
    XcdBarrier b; b.bar = bar; b.x = xb_xcc_id(); b.st = st;
    if (threadIdx.x == 0) (void)xb_add(&bar[XB_XCNT(b.x)], 1u);
    return b;
}
__device__ __forceinline__ void xcd_barrier_complete(unsigned* bar, unsigned x, unsigned& nloc, unsigned& nx) {
    const unsigned G = gridDim.x * gridDim.y * gridDim.z;
    unsigned sum, cnt, mine, sp = 0u;
    for (;;) {
        sum = 0u; cnt = 0u; mine = 0u;
#pragma unroll
        for (unsigned j = 0; j < 16; ++j) { const unsigned c = xb_ld(&bar[XB_XCNT(j)]); sum += c; cnt += (c > 0u) ? 1u : 0u; mine = (j == x) ? c : mine; }
        if (sum == G) break;
        __builtin_amdgcn_s_sleep(1);
        if ((++sp & 255u) == 0u) { if (xb_ld(&bar[XB_TMO])) break; if (sp > XB_SPIN_CAP) { atomicAdd(&bar[XB_TMO], 1u); break; } }
    }
    nloc = mine > 0u ? mine : 1u; nx = cnt > 0u ? cnt : 1u;
}

__device__ __forceinline__ void xcd_barrier(const XcdBarrier& b) {
    asm volatile("s_waitcnt vmcnt(0)" ::: "memory");
    __syncthreads();
    if (threadIdx.x == 0) {
        unsigned* bar = b.bar;
        __builtin_amdgcn_s_waitcnt(0);
        unsigned nloc = b.st[0], nx = b.st[1];
        if (nloc == 0u) { xcd_barrier_complete(bar, b.x, nloc, nx); b.st[0] = nloc; b.st[1] = nx; }
        const unsigned old = xb_add(&bar[XB_XSUB(b.x)], 1u);
        const unsigned gen = old / nloc;
        if (old + 1u == (gen + 1u) * nloc) {
            __builtin_amdgcn_fence(__ATOMIC_RELEASE, "agent");
            asm volatile("s_waitcnt vmcnt(0)" ::: "memory");
            const unsigned og = xb_add(&bar[XB_TOP], 1u);
            const unsigned tg = og / nx;
            if (og + 1u == (tg + 1u) * nx) xb_add(&bar[XB_TOPGEN], 1u);
            else XB_SPIN(xb_ld(&bar[XB_TOPGEN]) == tg, bar);
            __builtin_amdgcn_fence(__ATOMIC_ACQUIRE, "agent");
            xb_add(&bar[XB_XGEN(b.x)], 1u);
            asm volatile("s_waitcnt vmcnt(0)" ::: "memory");
        } else {
            XB_SPIN(xb_ld(&bar[XB_XGEN(b.x)]) == gen, bar);
            __builtin_amdgcn_fence(__ATOMIC_ACQUIRE, "agent");
            asm volatile("s_waitcnt vmcnt(0)" ::: "memory");
        }
    }
    __syncthreads();
}

__global__ void __launch_bounds__(512, 2) mega(Args a) {
    extern __shared__ __attribute__((aligned(16))) unsigned char lds[];
    cg::grid_group grid = cg::this_grid();
    const int G = gridDim.x;
    PG8_LAS unsigned char* glds = (PG8_LAS unsigned char*)lds;
#define bid lbid()
#define tid ltid()
#define lane (ltid() & 63)
#define wave (__builtin_amdgcn_readfirstlane(ltid() >> 6))
#define gw (lbid() * 8 + __builtin_amdgcn_readfirstlane(ltid() >> 6))
#define NGW (G * 8)
    { volatile LAS unsigned* st0 = (volatile LAS unsigned*)((LAS unsigned char*)lds + 131072); if (threadIdx.x < 4) st0[threadIdx.x] = 0u; }
    __syncthreads();
    const XcdBarrier xbar = xcd_barrier_post((unsigned*)(karg_ws() + 229376), (volatile LAS unsigned*)((LAS unsigned char*)lds + 131072));
#define GSYNC() do { xcd_barrier(xbar); } while (0)

    phase_modgemv(a, (float*)lds, G, bid, tid);
    convert_weights(a, 0, (float*)(lds + 32768) + wave * (64 * 33), gw, NGW, lane, G, bid, tid);
    if (G == 0x7fffffff) grid.sync();
    GSYNC();
#pragma clang loop unroll(full)
    for (int l = 0; l < 2; ++l) {
        if (l > 0) convert_weights(a, l, (float*)lds + wave * (64 * 33), gw, NGW, lane, G, bid, tid);
        phase_modulate(a, l, 0, gw, NGW, lane);
        GSYNC();
        for (int rp = 0; rp < REP_G1; ++rp)
        {
            unsigned char* ws = karg_ws(); float* outp = karg_out(); float* xctx = (float*)(ws + OFF_XCTX); bf16* XM = (bf16*)(ws + OFF_XMY); bf16* HU = (bf16*)(ws + OFF_HU); const float* modl = (const float*)(ws + OFF_MOD) + (size_t)l * 3 * 9216; (void)xctx; (void)XM; (void)HU; (void)modl; (void)outp;
            pg8::Gemm g{XM, (const bf16*)(ws + W_13A), NR, 2 * DFF, DM}; pg8::StaticOrder S; S.init(NR, 2 * DFF, G, bid);
            EpiSwiglu E{HU};
            pg8::gemm_phase<EpiSwiglu, pg8::StaticOrder, true, true>(glds, g, S, E);
        }
        GSYNC();
        {
            unsigned char* ws = karg_ws(); float* outp = karg_out(); float* xctx = (float*)(ws + OFF_XCTX); bf16* XM = (bf16*)(ws + OFF_XMY); bf16* HU = (bf16*)(ws + OFF_HU); const float* modl = (const float*)(ws + OFF_MOD) + (size_t)l * 3 * 9216; (void)xctx; (void)XM; (void)HU; (void)modl; (void)outp;
            pg8::Gemm g{HU, (const bf16*)(ws + W_2A), NR, DM, DFF}; pg8::StaticOrder S; S.init(NR, DM, G, bid);
            EpiResid E{outp, xctx, modl + 2 * 1024, 0.5f, l == 0 ? IN(0) : outp, l == 0 ? IN(2) : xctx};
            pg8::gemm_phase<EpiResid, pg8::StaticOrder, true, true>(glds, g, S, E);
        }
        GSYNC();
        phase_modulate(a, l, 1, gw, NGW, lane);
        GSYNC();
        {
            unsigned char* ws = karg_ws(); float* outp = karg_out(); float* xctx = (float*)(ws + OFF_XCTX); bf16* XM = (bf16*)(ws + OFF_XMY); bf16* HU = (bf16*)(ws + OFF_HU); const float* modl = (const float*)(ws + OFF_MOD) + (size_t)l * 3 * 9216; (void)xctx; (void)XM; (void)HU; (void)modl; (void)outp;
            pg8::Gemm g{XM, (const bf16*)(ws + W_IN), NR, UC, DM}; pg8::StaticOrder S; S.init(NR, UC, G, bid);
            EpiU E{HU, UC};
            pg8::gemm_phase<EpiU, pg8::StaticOrder, true, true>(glds, g, S, E);
        }
        GSYNC();
        for (int rp = 0; rp < REP_M1; ++rp) { phase_m1(a, l, lds, G, bid, tid);
        GSYNC(); }
        for (int rp = 0; rp < REP_M2; ++rp) { phase_m2(a, l, lds, G, bid, tid);
        GSYNC(); }
        for (int rp = 0; rp < REP_M3; ++rp) { phase_m3(a, l, lds, G, bid, tid);
        GSYNC(); }
        for (int rp = 0; rp < REP_SCAN; ++rp) { phase_m4(a, lds, G, bid, tid);
        GSYNC();
        phase_m5(a, lds, G, bid, tid);
        GSYNC();
        phase_m6(a, lds, G, bid, tid);
        GSYNC(); }
        phase_m7(a, l, gw, NGW, lane);
        GSYNC();
        {
            unsigned char* ws = karg_ws(); float* outp = karg_out(); float* xctx = (float*)(ws + OFF_XCTX); bf16* XM = (bf16*)(ws + OFF_XMY); bf16* HU = (bf16*)(ws + OFF_HU); const float* modl = (const float*)(ws + OFF_MOD) + (size_t)l * 3 * 9216; (void)xctx; (void)XM; (void)HU; (void)modl; (void)outp;
            const int MR = (l == 1) ? NLAT : NR;
            pg8::Gemm g{XM, (const bf16*)(ws + W_OUT), MR, DM, DM}; pg8::StaticOrder S; S.init(MR, DM, G, bid);
            EpiResid E{outp, xctx, modl + 5 * 1024, 1.0f, outp, xctx};
            pg8::gemm_phase<EpiResid, pg8::StaticOrder, true, true>(glds, g, S, E);
        }
        GSYNC();
        phase_modulate(a, l, 2, gw, NGW, lane);
        GSYNC();
        {
            unsigned char* ws = karg_ws(); float* outp = karg_out(); float* xctx = (float*)(ws + OFF_XCTX); bf16* XM = (bf16*)(ws + OFF_XMY); bf16* HU = (bf16*)(ws + OFF_HU); const float* modl = (const float*)(ws + OFF_MOD) + (size_t)l * 3 * 9216; (void)xctx; (void)XM; (void)HU; (void)modl; (void)outp;
            const int MR = (l == 1) ? NLAT : NR;
            pg8::Gemm g{XM, (const bf16*)(ws + W_13B), MR, 2 * DFF, DM}; pg8::StaticOrder S; S.init(MR, 2 * DFF, G, bid);
            EpiSwiglu E{HU};
            pg8::gemm_phase<EpiSwiglu, pg8::StaticOrder, true, true>(glds, g, S, E);
        }
        GSYNC();
        {
            unsigned char* ws = karg_ws(); float* outp = karg_out(); float* xctx = (float*)(ws + OFF_XCTX); bf16* XM = (bf16*)(ws + OFF_XMY); bf16* HU = (bf16*)(ws + OFF_HU); const float* modl = (const float*)(ws + OFF_MOD) + (size_t)l * 3 * 9216; (void)xctx; (void)XM; (void)HU; (void)modl; (void)outp;
            const int MR = (l == 1) ? NLAT : NR;
            pg8::Gemm g{HU, (const bf16*)(ws + W_2B), MR, DM, DFF}; pg8::StaticOrder S; S.init(MR, DM, G, bid);
            EpiResid E{outp, xctx, modl + 8 * 1024, 0.5f, outp, xctx};
            pg8::gemm_phase<EpiResid, pg8::StaticOrder, true, true>(glds, g, S, E);
        }
        GSYNC();
    }
    phase_final(a, gw, NGW, lane);
#undef bid
#undef tid
#undef lane
#undef wave
#undef gw
#undef NGW
}

extern "C" void kernel_launch(void* const* d_in, const int* in_sizes, int n_in, void* d_out, int out_size, void* d_ws, size_t ws_size, hipStream_t stream) {
    static int grid = 0;
    if (grid == 0) {
        int dev = 0, cus = 0, per_cu = 0;
        (void)hipGetDevice(&dev);
        (void)hipDeviceGetAttribute(&cus, hipDeviceAttributeMultiprocessorCount, dev);
        (void)hipFuncSetAttribute((const void*)mega, hipFuncAttributeMaxDynamicSharedMemorySize, LDS_BYTES);
        (void)hipOccupancyMaxActiveBlocksPerMultiprocessor(&per_cu, (const void*)mega, 512, LDS_BYTES);
        if (per_cu < 1) per_cu = 1;
        grid = cus * per_cu;
        if (n_in != 40 || ws_size < WS_NEED) { fprintf(stderr, "kernel_launch: unexpected n_in %d / ws %zu (need %zu)\n", n_in, ws_size, (size_t)WS_NEED); }
    }
    (void)hipMemsetAsync((char*)d_ws + OFF_MOD, 0, MOD_BYTES, stream);
    Args a{};
    for (int i = 0; i < 40; ++i) a.in[i] = (const float*)d_in[i];
    a.out = (float*)d_out; a.ws = (unsigned char*)d_ws;
    void* args[] = {&a};
    hipError_t e = hipLaunchCooperativeKernel((const void*)mega, dim3(grid), dim3(512), args, LDS_BYTES, stream);
    if (e != hipSuccess) fprintf(stderr, "cooperative launch failed: %s (grid %d)\n", hipGetErrorString(e), grid);
}
```

```cpp
#include <hip/hip_runtime.h>
#include <hip/hip_cooperative_groups.h>
#include <cstdio>
#include <cstdint>
namespace cg = cooperative_groups;
namespace pg8 {
#define PG8_LAS __attribute__((address_space(3)))
typedef unsigned short bf16_t;
typedef short bf16x8 __attribute__((ext_vector_type(8)));
typedef float f32x4 __attribute__((ext_vector_type(4)));
typedef unsigned u32x4 __attribute__((ext_vector_type(4)));
constexpr int BM = 256, BK = 64, HALF = 128, HTB = HALF * BK * 2  , STAGE_BYTES = 8 * HTB, NXCD = 8, WGM = 8;

__host__ __device__ __forceinline__ int lds_byte(int r, int c) { const int st = (r >> 4) * 2 + (c >> 5), rr = r & 15, cc = c & 31, ob = rr * 64 + cc * 2; return st * 1024 + (ob ^ (((ob >> 9) & 1) << 5)); }
__host__ __device__ __forceinline__ void stage_rc(int b, int& R, int& C) { const int st = b / 1024, sb = b % 1024, swz = sb ^ (((sb >> 9) & 1) << 5); R = (st >> 1) * 16 + swz / 64; C = (st & 1) * 32 + (swz % 64) / 2; }
__host__ __device__ __forceinline__ int perm32(int rho) { const int n = rho >> 4, i = rho & 15; return 8 * (i >> 2) + 4 * n + (i & 3); }

struct Unit { int pm, pn; };
struct Gemm { const bf16_t* A; const bf16_t* Bt; int M, N, K; };

struct StaticOrder {
    int nM, nN, nwg, G, c;
    __host__ __device__ void init(int M, int N, int G_, int c_) { nM = M / BM; nN = N / BM; nwg = nM * nN; G = G_; c = c_; }
    __host__ __device__ bool next(int i, Unit& u) const {
        const long L = (long)i * G + c; if (L >= nwg) return false;
        int wgid = (int)L; { const int q = nwg / NXCD, r = nwg % NXCD, xcd = wgid % NXCD, off = wgid / NXCD; wgid = (xcd < r ? xcd * (q + 1) : r * (q + 1) + (xcd - r) * q) + off; }
        const int nig = WGM * nN, gid = wgid / nig, fm = gid * WGM, gsz = (nM - fm) < WGM ? (nM - fm) : WGM;
        u.pm = fm + ((wgid % nig) % gsz); u.pn = (wgid % nig) / gsz; return true;
    }
    __device__ __forceinline__ void a_ready(const Unit&) const {}
    __device__ __forceinline__ void done(const Unit&) const {}
};

__device__ __forceinline__ unsigned cvt_pk_bf16(float lo, float hi) { unsigned r; asm volatile("v_cvt_pk_bf16_f32 %0, %1, %2" : "=v"(r) : "v"(lo), "v"(hi)); return r; }
typedef float f32x2 __attribute__((ext_vector_type(2)));
template <class Epi, class Sched, bool ALIGN_EPI = false, bool SP2 = false>
__device__ __forceinline__ void gemm_phase(PG8_LAS unsigned char* lds, const Gemm g, const Sched& S, const Epi& E) {
    int tid = threadIdx.x; asm volatile("" : "+v"(tid));
    const int wid = __builtin_amdgcn_readfirstlane(tid >> 6), lane = tid & 63, wr = wid >> 2, wc = wid & 3, fr = lane & 15, fq = lane >> 4;
    const int K = g.K, nt = K / BK;
    unsigned voffA[2], voffB[2];
#pragma unroll
    for (int i = 0; i < 2; ++i) { int R, C; stage_rc(tid * 16 + i * 8192, R, C); const int Rb = Epi::PERM ? ((R & ~31) + perm32(R & 31)) : R;
        voffA[i] = (unsigned)(R * K + C) * 2u; voffB[i] = (unsigned)(Rb * K + C) * 2u; }
    const size_t kstep = (size_t)(BK * 2);
    const size_t hstep = (size_t)HALF * K * 2;
    const size_t tstep = 2 * hstep;
    const unsigned ldsw = (unsigned)wid * 1024u;
    const int aoff = lds_byte(wr * 64 + fr, fq * 8), boff = lds_byte(wc * 32 + fr, fq * 8);
#define PG8_SA(b, h) (((b) * 2 + (h)) * HTB)
#define PG8_SB(b, h) ((4 + (b) * 2 + (h)) * HTB)
#define PG8_STAGE(bufoff, gbase, voff) do { _Pragma("unroll") for (int _i = 0; _i < 2; ++_i) \
        __builtin_amdgcn_global_load_lds((const unsigned*)((const char*)(gbase) + (voff)[_i]), (PG8_LAS unsigned*)(lds + (bufoff) + ldsw + _i * 8192), 16, 0, 0); } while (0)
#define PG8_LDA(dst, b, h) do { _Pragma("unroll") for (int m = 0; m < 4; ++m) _Pragma("unroll") for (int k = 0; k < 2; ++k) dst[m][k] = *(const PG8_LAS bf16x8*)(lds + PG8_SA(b, h) + aoff + m * 2048 + k * 1024); } while (0)
#define PG8_LDB(dst, b, h) do { _Pragma("unroll") for (int n = 0; n < 2; ++n) _Pragma("unroll") for (int k = 0; k < 2; ++k) dst[n][k] = *(const PG8_LAS bf16x8*)(lds + PG8_SB(b, h) + boff + n * 2048 + k * 1024); } while (0)
#define PG8_MMA(ai, bj, At, Bt) do { __builtin_amdgcn_s_setprio(1); _Pragma("unroll") for (int m = 0; m < 4; ++m) _Pragma("unroll") for (int n = 0; n < 2; ++n) _Pragma("unroll") for (int k = 0; k < 2; ++k) \
        acc[ai][bj][m][n] = __builtin_amdgcn_mfma_f32_16x16x32_bf16(Bt[n][k], At[m][k], acc[ai][bj][m][n], 0, 0, 0); __builtin_amdgcn_s_setprio(0); } while (0)
#define PG8_WAIT_V(n) asm volatile("s_waitcnt vmcnt(" #n ")" ::: "memory")
#define PG8_WAIT_L(n) asm volatile("s_waitcnt lgkmcnt(" #n ")" ::: "memory")
#define PG8_BAR __builtin_amdgcn_s_barrier()
#define PG8_SCHED __builtin_amdgcn_sched_barrier(0)
    Unit cur, nxt; int ui = 0;
    if (!S.next(0, cur)) return;
    f32x4 acc[2][2][4][2];
#pragma unroll
    for (int a = 0; a < 2; ++a)
#pragma unroll
        for (int b = 0; b < 2; ++b)
#pragma unroll
            for (int m = 0; m < 4; ++m)
#pragma unroll
                for (int n = 0; n < 2; ++n) acc[a][b][m][n] = (f32x4){0.f, 0.f, 0.f, 0.f};
    bf16x8 At[4][2], B0[2][2], B1[2][2];
    const char* cA = (const char*)g.A + (size_t)cur.pm * tstep; const char* cB = (const char*)g.Bt + (size_t)cur.pn * tstep;
    S.a_ready(cur);
    if constexpr (SP2) {
        PG8_STAGE(PG8_SB(0, 0), cB, voffB); PG8_STAGE(PG8_SB(0, 1), cB + hstep, voffB); PG8_STAGE(PG8_SA(0, 0), cA, voffA); PG8_STAGE(PG8_SA(0, 1), cA + hstep, voffA);
        if (wr == 1) PG8_BAR;
        PG8_WAIT_V(2); PG8_BAR;
        PG8_STAGE(PG8_SB(1, 0), cB + kstep, voffB); PG8_STAGE(PG8_SA(1, 0), cA + kstep, voffA); PG8_STAGE(PG8_SB(1, 1), cB + hstep + kstep, voffB);
        PG8_WAIT_V(6); PG8_BAR;
    } else {
        PG8_STAGE(PG8_SB(0, 0), cB, voffB); PG8_STAGE(PG8_SA(0, 0), cA, voffA); PG8_STAGE(PG8_SB(0, 1), cB + hstep, voffB); PG8_STAGE(PG8_SA(0, 1), cA + hstep, voffA);
        if (wr == 1) PG8_BAR;
        PG8_WAIT_V(4); PG8_BAR;
        PG8_STAGE(PG8_SB(1, 0), cB + kstep, voffB); PG8_STAGE(PG8_SA(1, 0), cA + kstep, voffA); PG8_STAGE(PG8_SB(1, 1), cB + hstep + kstep, voffB);
        PG8_WAIT_V(6); PG8_BAR;
    }
    for (;;) {
        const bool has_next = S.next(ui + 1, nxt);
        const char* nA = has_next ? (const char*)g.A + (size_t)nxt.pm * tstep : cA; const char* nB = has_next ? (const char*)g.Bt + (size_t)nxt.pn * tstep : cB;
        for (int t = 0; t < nt; t += 2) {
            const bool last = (t == nt - 2);
            const char* a1 = cA + (size_t)(t + 1) * kstep;
            const char* a2 = last ? nA : cA + (size_t)(t + 2) * kstep; const char* b2 = last ? nB : cB + (size_t)(t + 2) * kstep;
            const char* a3 = a2 + kstep; const char* b3 = b2 + kstep;
            if (last && has_next) S.a_ready(nxt);
            if constexpr (SP2) {
            PG8_LDB(B0, 0, 0); PG8_LDB(B1, 0, 1); PG8_SCHED; PG8_LDA(At, 0, 0); PG8_STAGE(PG8_SA(1, 1), a1 + hstep, voffA);
            PG8_WAIT_V(8); PG8_WAIT_L(0); PG8_BAR; PG8_MMA(0, 0, At, B0); PG8_MMA(0, 1, At, B1); PG8_BAR; PG8_SCHED;
            PG8_LDA(At, 0, 1); PG8_STAGE(PG8_SB(0, 0), b2, voffB); PG8_STAGE(PG8_SB(0, 1), b2 + hstep, voffB); PG8_STAGE(PG8_SA(0, 0), a2, voffA);
            PG8_WAIT_V(8); PG8_WAIT_L(0); PG8_BAR; PG8_MMA(1, 0, At, B0); PG8_MMA(1, 1, At, B1); PG8_BAR; PG8_SCHED;
            PG8_LDB(B0, 1, 0); PG8_LDB(B1, 1, 1); PG8_SCHED; PG8_LDA(At, 1, 0); PG8_STAGE(PG8_SA(0, 1), a2 + hstep, voffA);
            PG8_WAIT_V(8); PG8_WAIT_L(0); PG8_BAR; PG8_MMA(0, 0, At, B0); PG8_MMA(0, 1, At, B1); PG8_BAR; PG8_SCHED;
            PG8_LDA(At, 1, 1); PG8_STAGE(PG8_SB(1, 0), b3, voffB); PG8_STAGE(PG8_SB(1, 1), b3 + hstep, voffB); PG8_STAGE(PG8_SA(1, 0), a3, voffA);
            PG8_WAIT_V(8); PG8_WAIT_L(0); PG8_BAR; PG8_MMA(1, 0, At, B0); PG8_MMA(1, 1, At, B1); PG8_BAR; PG8_SCHED;
            } else {
            PG8_LDB(B0, 0, 0); PG8_SCHED; PG8_LDA(At, 0, 0); PG8_STAGE(PG8_SA(1, 1), a1 + hstep, voffA);
            PG8_WAIT_L(8); PG8_BAR; PG8_WAIT_L(0); PG8_MMA(0, 0, At, B0); PG8_BAR; PG8_SCHED;
            PG8_LDB(B1, 0, 1); PG8_STAGE(PG8_SB(0, 0), b2, voffB);
            PG8_BAR; PG8_WAIT_L(0); PG8_MMA(0, 1, At, B1); PG8_BAR;
            PG8_LDA(At, 0, 1); PG8_STAGE(PG8_SA(0, 0), a2, voffA);
            PG8_BAR; PG8_WAIT_L(0); PG8_MMA(1, 0, At, B0); PG8_BAR; PG8_SCHED;
            PG8_STAGE(PG8_SB(0, 1), b2 + hstep, voffB);
            PG8_WAIT_V(6); PG8_BAR; PG8_MMA(1, 1, At, B1); PG8_BAR;
            PG8_LDB(B0, 1, 0); PG8_SCHED; PG8_LDA(At, 1, 0); PG8_STAGE(PG8_SA(0, 1), a2 + hstep, voffA);
            PG8_WAIT_L(8); PG8_BAR; PG8_WAIT_L(0); PG8_MMA(0, 0, At, B0); PG8_BAR; PG8_SCHED;
            PG8_LDB(B1, 1, 1); PG8_STAGE(PG8_SB(1, 0), b3, voffB);
            PG8_BAR; PG8_WAIT_L(0); PG8_MMA(0, 1, At, B1); PG8_BAR;
            PG8_LDA(At, 1, 1); PG8_STAGE(PG8_SA(1, 0), a3, voffA);
            PG8_BAR; PG8_WAIT_L(0); PG8_MMA(1, 0, At, B0); PG8_BAR; PG8_SCHED;
            PG8_STAGE(PG8_SB(1, 1), b3 + hstep, voffB);
            PG8_WAIT_V(6); PG8_BAR; PG8_MMA(1, 1, At, B1); PG8_BAR;
            }
        }
        if constexpr (ALIGN_EPI) { if (wr == 0) PG8_BAR; }
        if constexpr (!Epi::AFTER_DRAIN) { E(acc, cur, wr, wc, fr, fq); S.done(cur); }
        if (!has_next) break;
#pragma unroll
        for (int a = 0; a < 2; ++a)
#pragma unroll
            for (int b = 0; b < 2; ++b)
#pragma unroll
                for (int m = 0; m < 4; ++m)
#pragma unroll
                    for (int n = 0; n < 2; ++n) acc[a][b][m][n] = (f32x4){0.f, 0.f, 0.f, 0.f};
        cur = nxt; cA = nA; cB = nB; ++ui;
        if constexpr (ALIGN_EPI) { if (wr == 1) PG8_BAR; }
    }
    PG8_WAIT_V(0);
    if constexpr (!ALIGN_EPI) { if (wr == 0) PG8_BAR; }
    PG8_BAR;
    if constexpr (Epi::AFTER_DRAIN) { E.fused(acc, cur, wr, wc, fr, fq, lds, wid, lane); S.done(cur); }
#undef PG8_SA
#undef PG8_SB
#undef PG8_STAGE
#undef PG8_LDA
#undef PG8_LDB
#undef PG8_MMA
#undef PG8_WAIT_V
#undef PG8_WAIT_L
#undef PG8_BAR
#undef PG8_SCHED
}
}

using pg8::f32x4; using pg8::bf16x8;
typedef unsigned short bf16;
typedef unsigned v4u __attribute__((ext_vector_type(4)));
typedef unsigned v2u __attribute__((ext_vector_type(2)));
typedef short s16x4 __attribute__((ext_vector_type(4)));

constexpr int DM = 1024, TLEN = 8192, CTXL = 256, TT = 8448, NLAT = 16384, NR = 16896, DFF = 2816, UC = 2560, NTILE = 528;
constexpr int NSEG = 64, SEGLEN = 132;
constexpr size_t MiB = 1u << 20;
constexpr size_t A8 = (size_t)NR * 256 * 2;
constexpr size_t OFF_MOD = 0, MOD_BYTES = 256 * 1024;
constexpr size_t OFF_XCTX = MiB / 4, OFF_XMY = 2 * MiB + MiB / 4, OFF_HU = 35 * MiB + MiB / 4, OFF_W = 126 * MiB, OFF_MIX = 167 * MiB, OFF_PR = 266 * MiB;
constexpr size_t W_13A = OFF_W, W_2A = OFF_W + 11 * MiB, W_13B = OFF_W + 16 * MiB + MiB / 2, W_2B = OFF_W + 27 * MiB + MiB / 2,
                 W_IN = OFF_W + 33 * MiB, W_OUT = OFF_W + 38 * MiB, W_UQ = OFF_W + 40 * MiB, W_UKV = OFF_W + 40 * MiB + 256 * 1024,
                 W_WUP = OFF_W + 40 * MiB + 384 * 1024, W_AUP = W_WUP + 65536, W_GUP = W_AUP + 65536, W_LWA = W_GUP + 65536, W_LWX = W_LWA + 65536;
constexpr size_t M_QB = OFF_MIX, M_KB = OFF_MIX + 12976128, M_VT = OFF_MIX + 25952256;
constexpr size_t M_LR0 = OFF_PR, M_LIX0 = OFF_PR + 2 * A8;
constexpr size_t M_SEGA = OFF_HU + 83 * MiB, M_SEGB = M_SEGA + MiB + MiB / 4, M_H0 = M_SEGB + MiB + MiB / 4;
constexpr size_t M_RR = OFF_MIX, M_KK = OFF_MIX + A8, M_VV = OFF_MIX + 2 * A8, M_WW = OFF_MIX + 3 * A8, M_BB = OFF_MIX + 7 * A8, M_KD = OFF_MIX + 9 * A8, M_GC = OFF_MIX + 11 * A8;
constexpr size_t M_YS = OFF_HU, M_PL = OFF_HU + 33 * MiB, M_SINIT = OFF_HU + 65 * MiB;
constexpr size_t M_PR = OFF_PR;
constexpr size_t WS_NEED = OFF_PR + 33 * MiB;
constexpr int LDS_BYTES = 131072 + 1024;
#ifndef REP_M1
#define REP_M1 1
#endif
#ifndef REP_M2
#define REP_M2 1
#endif
#ifndef REP_M3
#define REP_M3 1
#endif
#ifndef REP_SCAN
#define REP_SCAN 1
#endif
#ifndef REP_G1
#define REP_G1 1
#endif
constexpr float QSCALE = 0.10206207261596575f * 1.4426950408889634f;

struct Args { const float* in[40]; float* out; unsigned char* ws; };
typedef const __attribute__((address_space(4))) volatile unsigned long long kargq;
__device__ __forceinline__ const float* karg_in(int i) { kargq* p = (kargq*)__builtin_amdgcn_kernarg_segment_ptr(); return (const float*)p[i]; }
__device__ __forceinline__ float* karg_out() { kargq* p = (kargq*)__builtin_amdgcn_kernarg_segment_ptr(); return (float*)p[40]; }
__device__ __forceinline__ unsigned char* karg_ws() { kargq* p = (kargq*)__builtin_amdgcn_kernarg_segment_ptr(); return (unsigned char*)p[41]; }
#define IN(i) karg_in(i)
__device__ __forceinline__ int ltid() { int t = threadIdx.x; asm volatile("" : "+v"(t)); return t; }
__device__ __forceinline__ int lbid() { int t = blockIdx.x; asm volatile("" : "+s"(t)); return t; }
template <class T> __device__ __forceinline__ T* launder(T* p) { asm volatile("" : "+s"(p)); return p; }

__device__ __forceinline__ float bf2f(bf16 h) { return __uint_as_float((unsigned)h << 16); }
typedef float cvf32x2 __attribute__((ext_vector_type(2))); typedef __bf16 cvbf16x2 __attribute__((ext_vector_type(2)));
__device__ __forceinline__ unsigned pk2(float lo, float hi) { cvf32x2 v = {lo, hi}; cvbf16x2 b = __builtin_convertvector(v, cvbf16x2); return __builtin_bit_cast(unsigned, b); }
__device__ __forceinline__ unsigned f2bf(float f) { return pk2(f, 0.f) & 0xffffu; }
__device__ __forceinline__ float sigm(float x) { return __builtin_amdgcn_rcpf(1.f + __expf(-x)); }
__device__ __forceinline__ float siluf_(float x) { return x * __builtin_amdgcn_rcpf(1.f + __expf(-x)); }
__device__ __forceinline__ float tanhf_(float y) { return 1.f - 2.f * __builtin_amdgcn_rcpf(1.f + __expf(2.f * y)); }
__device__ __forceinline__ float geluf_(float x) { return 0.5f * x * (1.f + tanhf_(0.7978845608028654f * (x + 0.044715f * x * x * x))); }
template <int CTRL> __device__ __forceinline__ float dppf(float v) { return __int_as_float(__builtin_amdgcn_update_dpp(0, __float_as_int(v), CTRL, 0xF, 0xF, true)); }
__device__ __forceinline__ float rows4_max(float v) {
    auto a = __builtin_amdgcn_permlane16_swap(__float_as_uint(v), __float_as_uint(v), false, false); v = fmaxf(__uint_as_float(a[0]), __uint_as_float(a[1]));
    auto b = __builtin_amdgcn_permlane32_swap(__float_as_uint(v), __float_as_uint(v), false, false); return fmaxf(__uint_as_float(b[0]), __uint_as_float(b[1]));
}
__device__ __forceinline__ float rows4_sum(float v) {
    auto a = __builtin_amdgcn_permlane16_swap(__float_as_uint(v), __float_as_uint(v), false, false); v = __uint_as_float(a[0]) + __uint_as_float(a[1]);
    auto b = __builtin_amdgcn_permlane32_swap(__float_as_uint(v), __float_as_uint(v), false, false); return __uint_as_float(b[0]) + __uint_as_float(b[1]);
}
__device__ __forceinline__ float wave_sum(float v) {
    v += dppf<0xB1>(v); v += dppf<0x4E>(v); v += dppf<0x141>(v); v += dppf<0x140>(v);
    auto a = __builtin_amdgcn_permlane16_swap(__float_as_uint(v), __float_as_uint(v), false, false); v = __uint_as_float(a[0]) + __uint_as_float(a[1]);
    auto b = __builtin_amdgcn_permlane32_swap(__float_as_uint(v), __float_as_uint(v), false, false); return __uint_as_float(b[0]) + __uint_as_float(b[1]);
}
struct TileInfo { int b, isctx, t0, seqbase, seqlen; };
__device__ __forceinline__ TileInfo tile_info(int tile) {
    TileInfo ti;
    if (tile < 512) { ti.b = tile >> 8; ti.isctx = 0; ti.t0 = (tile & 255) * 32; ti.seqbase = ti.b * TLEN; ti.seqlen = TLEN; }
    else { const int q = tile - 512; ti.b = q >> 3; ti.isctx = 1; ti.t0 = (q & 7) * 32; ti.seqbase = NLAT + ti.b * CTXL; ti.seqlen = CTXL; }
    return ti;
}

struct EpiSwiglu {
    static constexpr bool PERM = true, AFTER_DRAIN = false;
    bf16* H;
    __device__ __forceinline__ void operator()(const f32x4 (&acc)[2][2][4][2], const pg8::Unit& u, int wr, int wc, int fr, int fq) const {
        int pm = u.pm, pn = u.pn; asm volatile("" : "+s"(pm), "+s"(pn), "+s"(wr), "+s"(wc), "+v"(fr), "+v"(fq));
        bf16* tb = H + (size_t)pm * 256 * DFF + pn * 128;
        const unsigned loff = (unsigned)((wr * 64 + fr) * DFF + wc * 32 + 8 * fq);
#pragma unroll
        for (int ai = 0; ai < 2; ++ai)
#pragma unroll
            for (int m = 0; m < 4; ++m) {
                bf16* rowp = tb + (loff + (unsigned)((ai * 128 + m * 16) * DFF));
                const f32x4 g0 = acc[ai][0][m][0], g1 = acc[ai][0][m][1], u0 = acc[ai][1][m][0], u1 = acc[ai][1][m][1];
                v4u w;
                w.x = pg8::cvt_pk_bf16(siluf_(g0[0]) * u0[0], siluf_(g0[1]) * u0[1]); w.y = pg8::cvt_pk_bf16(siluf_(g0[2]) * u0[2], siluf_(g0[3]) * u0[3]);
                w.z = pg8::cvt_pk_bf16(siluf_(g1[0]) * u1[0], siluf_(g1[1]) * u1[1]); w.w = pg8::cvt_pk_bf16(siluf_(g1[2]) * u1[2], siluf_(g1[3]) * u1[3]);
                *(v4u*)rowp = w;
            }
    }
};
struct EpiU {
    static constexpr bool PERM = true, AFTER_DRAIN = false;
    bf16* O; int ldc;
    __device__ __forceinline__ void operator()(const f32x4 (&acc)[2][2][4][2], const pg8::Unit& u, int wr, int wc, int fr, int fq) const {
        int pm = u.pm, pn = u.pn; asm volatile("" : "+s"(pm), "+s"(pn), "+s"(wr), "+s"(wc), "+v"(fr), "+v"(fq));
        bf16* tb = O + (size_t)pm * 256 * ldc + pn * 256;
        const unsigned loff = (unsigned)((wr * 64 + fr) * ldc + wc * 32 + 8 * fq);
#pragma unroll
        for (int ai = 0; ai < 2; ++ai)
#pragma unroll
            for (int m = 0; m < 4; ++m) {
                bf16* rowp = tb + (loff + (unsigned)((ai * 128 + m * 16) * ldc));
#pragma unroll
                for (int bj = 0; bj < 2; ++bj) { const f32x4 v0 = acc[ai][bj][m][0], v1 = acc[ai][bj][m][1]; v4u w;
                    w.x = pg8::cvt_pk_bf16(v0[0], v0[1]); w.y = pg8::cvt_pk_bf16(v0[2], v0[3]); w.z = pg8::cvt_pk_bf16(v1[0], v1[1]); w.w = pg8::cvt_pk_bf16(v1[2], v1[3]);
                    *(v4u*)(rowp + bj * 128) = w; }
            }
    }
};
struct EpiResid {
    static constexpr bool PERM = false, AFTER_DRAIN = false;
    float* xlat; float* xctx; const float* gate; float coef; const float* slat; const float* sctx;
    __device__ __forceinline__ void operator()(const f32x4 (&acc)[2][2][4][2], const pg8::Unit& u, int wr, int wc, int fr, int fq) const {
        int pm = u.pm, pn = u.pn; asm volatile("" : "+s"(pm), "+s"(pn), "+s"(wr), "+s"(wc), "+v"(fr), "+v"(fq));
        const size_t toff = (pm < 64 ? (size_t)pm : (size_t)(pm - 64)) * 256 * DM + pn * 256;
        float* tb = (pm < 64 ? xlat : xctx) + toff; const float* sb = (pm < 64 ? slat : sctx) + toff;
        const float* g = gate + (pm < 64 ? (pm >> 5) : 2) * 9216 + pn * 256;
        const unsigned coff = (unsigned)(wc * 32 + 4 * fq), loff = (unsigned)((wr * 64 + fr) * DM) + coff;
        f32x4 gv[2][2];
#pragma unroll
        for (int bj = 0; bj < 2; ++bj)
#pragma unroll
            for (int n = 0; n < 2; ++n) gv[bj][n] = coef * *(const f32x4*)(g + (coff + (unsigned)(bj * 128 + n * 16)));
#pragma unroll
        for (int ai = 0; ai < 2; ++ai)
#pragma unroll
            for (int m = 0; m < 4; ++m) {
                float* xr = tb + (loff + (unsigned)((ai * 128 + m * 16) * DM)); const float* sr = sb + (loff + (unsigned)((ai * 128 + m * 16) * DM));
#pragma unroll
                for (int bj = 0; bj < 2; ++bj)
#pragma unroll
                    for (int n = 0; n < 2; ++n) { float* xp = xr + (bj * 128 + n * 16);
                        f32x4 xv = *(const f32x4*)(sr + (bj * 128 + n * 16)); xv += gv[bj][n] * acc[ai][bj][m][n]; *(f32x4*)xp = xv; }
                asm volatile("" ::: "memory");
            }
    }
};

__device__ __forceinline__ void phase_modgemv(const Args& a, float* red, int G, int bid, int tid) {
    const float* c = IN(1); const float* cctx = IN(3); const float* ada_w = IN(4); const float* ada_b = IN(5);
    float* mod = (float*)(karg_ws() + OFF_MOD);
    const int w = tid >> 6, lane = tid & 63;
    for (int u = bid; u < 576; u += G) {
        const int l = u / 288, rem = u % 288, jt = rem >> 3, ks = rem & 7;
        const int kb = ks * 128 + w * 16, j0 = jt * 256 + lane * 4;
        f32x4 acc0 = {0.f, 0.f, 0.f, 0.f}, acc1 = acc0, acc2 = acc0;
        for (int kk = 0; kk < 16; ++kk) { const int k = kb + kk;
            const float s0 = siluf_(c[k]), s1 = siluf_(c[1024 + k]), s2 = siluf_(cctx[k]);
            const f32x4 wv = *(const f32x4*)(ada_w + ((size_t)(l * 1024 + k)) * 9216 + j0);
            acc0 += s0 * wv; acc1 += s1 * wv; acc2 += s2 * wv; }
        float* rp = red + (w * 3) * 256 + lane * 4;
        *(f32x4*)rp = acc0; *(f32x4*)(rp + 256) = acc1; *(f32x4*)(rp + 512) = acc2;
        __syncthreads();
        for (int o = tid; o < 768; o += 512) { const int m = o >> 8, jj = o & 255; float s = 0.f;
#pragma unroll
            for (int ww = 0; ww < 8; ++ww) s += red[(ww * 3 + m) * 256 + jj];
            const int j = jt * 256 + jj; if (ks == 0) s += ada_b[l * 9216 + j];
            atomicAdd(&mod[(l * 3 + m) * 9216 + j], s); }
        __syncthreads();
    }
}
__device__ __forceinline__ void phase_copy(const Args& a, int G, int bid, int tid) {
    const f32x4* x4 = (const f32x4*)IN(0); f32x4* o4 = (f32x4*)karg_out();
    for (int i = bid * 512 + tid; i < NLAT * DM / 4; i += G * 512) o4[i] = x4[i];
    const f32x4* c4 = (const f32x4*)IN(2); f32x4* xc4 = (f32x4*)(karg_ws() + OFF_XCTX);
    for (int i = bid * 512 + tid; i < 512 * DM / 4; i += G * 512) xc4[i] = c4[i];
}
__device__ __forceinline__ int swiglu_map(int n) { return n < DFF ? ((n >> 7) * 256 + (n & 127)) : ((((n - DFF) >> 7) * 256) + 128 + ((n - DFF) & 127)); }
__device__ __forceinline__ void transpose_item(const float* W, int K, int N, bf16* WT, float* scr, int item, int lane, int mode, const float* kscale) {
    const int nblk = N / 32, kb = item / nblk, nb = item % nblk, k0 = 64 * kb, n0 = 32 * nb;
    float tv[32];
#pragma unroll
    for (int i = 0; i < 32; ++i) { const int kk = 2 * i + (lane >> 5); tv[i] = W[(size_t)(k0 + kk) * N + n0 + (lane & 31)]; }
#pragma unroll
    for (int i = 0; i < 32; ++i) { const int kk = 2 * i + (lane >> 5); float v = tv[i]; if (kscale) v *= kscale[k0 + kk]; scr[kk * 33 + (lane & 31)] = v; }
    __builtin_amdgcn_wave_barrier();
    const int c = lane & 7;
#pragma unroll
    for (int j = 0; j < 4; ++j) { const int n = (lane >> 3) + 8 * j; const float* s = scr + (8 * c) * 33 + n;
        v4u o; o.x = pk2(s[0 * 33], s[1 * 33]); o.y = pk2(s[2 * 33], s[3 * 33]); o.z = pk2(s[4 * 33], s[5 * 33]); o.w = pk2(s[6 * 33], s[7 * 33]);
        const int nn = n0 + n, drow = mode ? swiglu_map(nn) : nn;
        *(v4u*)(WT + (size_t)drow * K + k0 + 8 * c) = o; }
    __builtin_amdgcn_wave_barrier();
}
__device__ __forceinline__ void convert_weights(const Args& a, int l, float* scr, int gw, int NGW, int lane, int G, int bid, int tid) {
    constexpr int I13 = 16 * 176, I2 = 44 * 32, IIN = 16 * 77, IOUT = 16 * 32, IUQ = 4 * 12, IUKV = 2 * 16;
    constexpr int IEX = 80;
    constexpr int NIT = 2 * I13 + 2 * I2 + IIN + IOUT + IUQ + IUKV + IEX;
    unsigned char* ws = karg_ws();
    for (int it = gw; it < NIT; it += NGW) {
        int r = it;
        if (r < I13) { transpose_item(IN(6) + (size_t)l * DM * 2 * DFF, DM, 2 * DFF, (bf16*)(ws + W_13A), scr, r, lane, 1, nullptr); continue; } r -= I13;
        if (r < I13) { transpose_item(IN(8) + (size_t)l * DM * 2 * DFF, DM, 2 * DFF, (bf16*)(ws + W_13B), scr, r, lane, 1, nullptr); continue; } r -= I13;
        if (r < I2) { transpose_item(IN(7) + (size_t)l * DFF * DM, DFF, DM, (bf16*)(ws + W_2A), scr, r, lane, 0, nullptr); continue; } r -= I2;
        if (r < I2) { transpose_item(IN(9) + (size_t)l * DFF * DM, DFF, DM, (bf16*)(ws + W_2B), scr, r, lane, 0, nullptr); continue; } r -= I2;
        if (r < IIN) { transpose_item(IN(10) + (size_t)l * DM * 2464, DM, 2464, (bf16*)(ws + W_IN), scr, r, lane, 0, nullptr); continue; } r -= IIN;
        if (r < IOUT) { transpose_item(IN(11) + (size_t)l * DM * DM, DM, DM, (bf16*)(ws + W_OUT), scr, r, lane, 0, nullptr); continue; } r -= IOUT;
        if (r < IUQ) { transpose_item(IN(36) + (size_t)l * 256 * 384, 256, 384, (bf16*)(ws + W_UQ), scr, r, lane, 0, IN(35) + l * 256); continue; } r -= IUQ;
        if (r < IUKV) { transpose_item(IN(38) + (size_t)l * 128 * 512, 128, 512, (bf16*)(ws + W_UKV), scr, r, lane, 0, IN(37) + l * 128); continue; } r -= IUKV;
        if (r < 16) { const int d = r >> 3; transpose_item(IN(26) + (size_t)(l * 2 + d) * 64 * 256, 64, 256, (bf16*)(ws + W_WUP) + d * 256 * 64, scr, r & 7, lane, 0, nullptr); continue; } r -= 16;
        if (r < 16) { const int d = r >> 3; transpose_item(IN(28) + (size_t)(l * 2 + d) * 64 * 256, 64, 256, (bf16*)(ws + W_AUP) + d * 256 * 64, scr, r & 7, lane, 0, nullptr); continue; } r -= 16;
        if (r < 16) { transpose_item(IN(29) + (size_t)l * 128 * 256, 128, 256, (bf16*)(ws + W_GUP), scr, r, lane, 0, nullptr); continue; } r -= 16;
        if (r < 16) { const int m = r >> 1; transpose_item(IN(18) + (size_t)(l * 8 + m) * 4096, 64, 64, (bf16*)(ws + W_LWA) + m * 4096, scr, r & 1, lane, 0, nullptr); continue; } r -= 16;
        { const int m = r >> 1; transpose_item(IN(20) + (size_t)(l * 8 + m) * 4096, 64, 64, (bf16*)(ws + W_LWX) + m * 4096, scr, r & 1, lane, 0, nullptr); }
    }
    v4u z = {0u, 0u, 0u, 0u}; v4u* zp = (v4u*)(ws + W_IN + (size_t)2464 * DM * 2);
    for (int i = bid * 512 + tid; i < 96 * DM * 2 / 16; i += G * 512) zp[i] = z;
}
__device__ __forceinline__ void phase_modulate(const Args& a, int l, int which, int gw, int NGW, int lane) {
    unsigned char* ws = karg_ws(); const float* outp = karg_out();
    const bool first = (l == 0 && which == 0);
    const float* srcl = first ? IN(0) : outp; const float* srcc = first ? IN(2) : (const float*)(ws + OFF_XCTX);
    const float* mod = (const float*)(ws + OFF_MOD) + (size_t)l * 3 * 9216;
    bf16* XM = (bf16*)(ws + OFF_XMY);
    for (int r = gw; r < NR; r += NGW) {
        const float* xr = r < NLAT ? srcl + (size_t)r * DM : srcc + (size_t)(r - NLAT) * DM;
        const float* mm = mod + (r < NLAT ? (r >> 13) : 2) * 9216 + which * 3 * 1024;
        f32x4 v[4]; float ss = 0.f;
#pragma unroll
        for (int j = 0; j < 4; ++j) { v[j] = *(const f32x4*)(xr + 4 * lane + 256 * j); ss += (v[j][0] * v[j][0] + v[j][1] * v[j][1]) + (v[j][2] * v[j][2] + v[j][3] * v[j][3]); }
        const float rstd = rsqrtf(wave_sum(ss) * (1.f / DM) + 1e-6f);
#pragma unroll
        for (int j = 0; j < 4; ++j) { const int c = 4 * lane + 256 * j; const f32x4 sh = *(const f32x4*)(mm + c), sc = *(const f32x4*)(mm + 1024 + c);
            const f32x4 o = v[j] * rstd * (1.f + sc) + sh; v2u w; w.x = pk2(o[0], o[1]); w.y = pk2(o[2], o[3]);
            *(v2u*)(XM + (size_t)r * DM + c) = w; }
    }
}
__device__ __forceinline__ void phase_final(const Args& a, int gw, int NGW, int lane) {
    const float* fn = IN(39); float* outp = karg_out();
    for (int r = gw; r < NLAT; r += NGW) {
        float* xr = outp + (size_t)r * DM; f32x4 v[4]; float ss = 0.f;
#pragma unroll
        for (int j = 0; j < 4; ++j) { v[j] = *(const f32x4*)(xr + 4 * lane + 256 * j); ss += (v[j][0] * v[j][0] + v[j][1] * v[j][1]) + (v[j][2] * v[j][2] + v[j][3] * v[j][3]); }
        const float rstd = rsqrtf(wave_sum(ss) * (1.f / DM) + 1e-6f);
#pragma unroll
        for (int j = 0; j < 4; ++j) { const int c = 4 * lane + 256 * j; const f32x4 g = *(const f32x4*)(fn + c); *(f32x4*)(xr + c) = v[j] * rstd * g; }
    }
}

__device__ __forceinline__ void phase_m1(const Args& a, int l, unsigned char* lds, int G, int bid, int tid_unused) {
    unsigned char* ws = karg_ws();
    const bf16* U = (const bf16*)(ws + OFF_HU);
    bf16* Y = (bf16*)(ws + OFF_XMY);
    for (int pass = 0; pass < 2; ++pass)
    for (int tile = (pass == 0 ? bid : (bid < 48 ? 512 + bid / 3 : NTILE)); tile < (pass == 0 ? 512 : NTILE); tile += (pass == 0 ? G : NTILE)) {
        const int mask = pass == 0 ? 7 : ((1 << (bid % 3)) & (l == 1 ? 6 : 7));
        const TileInfo ti = tile_info(tile);
        const int row0 = tile * 32;
        if (mask & 1) {
            const int tid = ltid(); const int lane = tid & 63, wave = __builtin_amdgcn_readfirstlane(tid >> 6), ch = tid & 255, part = tid >> 8; (void)lane; (void)wave; (void)ch; (void)part;
            float* z = (float*)lds;
            float* cv = (float*)(lds + 65536);
            for (int tt = part; tt < 62; tt += 2) { const int t = ti.t0 - 15 + tt; float zz = 0.f;
                if (t >= 0 && t < ti.seqlen) { const bf16* ur = U + (size_t)(ti.seqbase + t) * UC; zz = bf2f(ur[ch]) * sigm(bf2f(ur[256 + ch])); }
                z[tt * 256 + ch] = zz; }
            __syncthreads();
            const float* dw = IN(12) + (size_t)l * 31 * 256 + ch;
            float acc[16]; const float bias = IN(13)[l * 256 + ch];
#pragma unroll
            for (int o = 0; o < 16; ++o) acc[o] = bias;
            for (int j = 0; j < 31; ++j) { const float w = dw[j * 256];
#pragma unroll
                for (int o = 0; o < 16; ++o) acc[o] += w * z[(part * 16 + o + j) * 256 + ch]; }
#pragma unroll
            for (int o = 0; o < 16; ++o) cv[(part * 16 + o) * 256 + ch] = acc[o];
            __syncthreads();
            const f32x4 lg = *(const f32x4*)(IN(14) + l * 256 + lane * 4), lb = *(const f32x4*)(IN(15) + l * 256 + lane * 4);
#pragma unroll
            for (int q = 0; q < 4; ++q) { const int t = wave * 4 + q; const f32x4 v = *(const f32x4*)(cv + t * 256 + lane * 4);
                const float mu = wave_sum((v[0] + v[1]) + (v[2] + v[3])) * (1.f / 256.f);
                const f32x4 dv = v - mu; const float var = wave_sum((dv[0] * dv[0] + dv[1] * dv[1]) + (dv[2] * dv[2] + dv[3] * dv[3])) * (1.f / 256.f);
                const f32x4 yn = dv * rsqrtf(var + 1e-5f) * lg + lb;
                v2u w; w.x = pk2(siluf_(yn[0]), siluf_(yn[1])); w.y = pk2(siluf_(yn[2]), siluf_(yn[3]));
                *(v2u*)(Y + (size_t)(row0 + t) * DM + lane * 4) = w; }
            __syncthreads();
        }
        if (mask & 2) {
            float* xvf = (float*)lds;
            bf16* xvb = (bf16*)(lds + 32768);
            bf16* rg = (bf16*)(lds + 49664);
            bf16* ixg = (bf16*)(lds + 82432);
            {
                const int tid = ltid(); const int ch = tid & 255, part = tid >> 8;
                const float* cw = IN(16) + (size_t)l * 4 * 256 + ch; const float w0 = cw[0], w1 = cw[256], w2 = cw[512], w3 = cw[768], cb = IN(17)[l * 256 + ch];
                float xin[19];
#pragma unroll
                for (int i = 0; i < 19; ++i) { const int t = ti.t0 + part * 16 + i - 2; xin[i] = (t >= 0 && t < ti.seqlen) ? bf2f(U[(size_t)(ti.seqbase + t) * UC + 512 + ch]) : 0.f; }
#pragma unroll
                for (int o = 0; o < 16; ++o) { const int tl = part * 16 + o;
                    const float v = cb + w0 * xin[o] + w1 * xin[o + 1] + w2 * xin[o + 2] + w3 * xin[o + 3];
                    xvf[tl * 256 + ch] = v; xvb[tl * 264 + ch] = (bf16)f2bf(v);
                }
            }
            __syncthreads();
            {
                const int tid = ltid(); const int ln = tid & 63, wv = __builtin_amdgcn_readfirstlane(tid >> 6), fr = ln & 15, fq = ln >> 4, blk = wv >> 1;
                const bf16* LWAt = (const bf16*)(ws + W_LWA); const bf16* LWXt = (const bf16*)(ws + W_LWX);
                bf16x8 af[2][2];
#pragma unroll
                for (int mt = 0; mt < 2; ++mt)
#pragma unroll
                    for (int ks = 0; ks < 2; ++ks) af[mt][ks] = *(const bf16x8*)(xvb + (mt * 16 + fr) * 264 + blk * 64 + ks * 32 + fq * 8);
#pragma unroll
                for (int dn = 0; dn < 4; ++dn) { const int d = dn >> 1, nt = wv * 2 + (dn & 1), ch = nt * 16 + fr, jj = (nt & 3) * 16 + fr;
                    f32x4 ca[2], cx[2];
#pragma unroll
                    for (int mt = 0; mt < 2; ++mt) { ca[mt] = (f32x4){0.f, 0.f, 0.f, 0.f}; cx[mt] = ca[mt]; }
#pragma unroll
                    for (int ks = 0; ks < 2; ++ks) { const size_t wo = ((size_t)(d * 4 + blk) * 64 + jj) * 64 + ks * 32 + fq * 8;
                        const bf16x8 ba = *(const bf16x8*)(LWAt + wo), bx = *(const bf16x8*)(LWXt + wo);
#pragma unroll
                        for (int mt = 0; mt < 2; ++mt) { ca[mt] = __builtin_amdgcn_mfma_f32_16x16x32_bf16(af[mt][ks], ba, ca[mt], 0, 0, 0); cx[mt] = __builtin_amdgcn_mfma_f32_16x16x32_bf16(af[mt][ks], bx, cx[mt], 0, 0, 0); } }
                    const float bga = IN(19)[(l * 2 + d) * 256 + ch], bgx = IN(21)[(l * 2 + d) * 256 + ch];
                    bf16* LR = (bf16*)(ws + M_LR0 + (size_t)d * A8); bf16* LIX = (bf16*)(ws + M_LIX0 + (size_t)d * A8);
#pragma unroll
                    for (int mt = 0; mt < 2; ++mt)
#pragma unroll
                        for (int j = 0; j < 4; ++j) { const int t = mt * 16 + fq * 4 + j;
                            const bf16 rb = (bf16)f2bf(sigm(ca[mt][j] + bga)), ib = (bf16)f2bf(sigm(cx[mt][j] + bgx) * xvf[t * 256 + ch]);
                            LR[(size_t)(row0 + t) * 256 + ch] = rb; LIX[(size_t)(row0 + t) * 256 + ch] = ib;
                            rg[(d * 32 + t) * 256 + ch] = rb; ixg[(d * 32 + t) * 256 + ch] = ib; }
                }
            }
            __syncthreads();
            {
                const int tid = ltid(); const int ch = tid & 255, d = tid >> 8;
                const float lam = IN(22)[(l * 2 + d) * 256 + ch];
                const float cch = -8.f * log1pf(__expf(-lam));
                float A = 1.f, B = 0.f;
#pragma unroll 8
                for (int tt = 0; tt < 32; ++tt) { const int t = d ? 31 - tt : tt;
                    const float al = __expf(cch * bf2f(rg[(d * 32 + t) * 256 + ch])); const float bb = sqrtf(fmaxf(1.f - al * al, 0.f)) * bf2f(ixg[(d * 32 + t) * 256 + ch]); B = al * B + bb; A *= al; }
                ((float*)(ws + M_SEGA))[(size_t)(tile * 2 + d) * 256 + ch] = A;
                ((float*)(ws + M_SEGB))[(size_t)(tile * 2 + d) * 256 + ch] = B;
            }
            __syncthreads();
        }
        if (mask & 4) {
            const int tid = ltid(); const int lane = tid & 63, wave = __builtin_amdgcn_readfirstlane(tid >> 6), ch = tid & 255, part = tid >> 8; (void)lane; (void)wave; (void)ch; (void)part;
            bf16* As = (bf16*)lds;
            float* kr = (float*)(lds + 32768);
            float* rs = (float*)(lds + 32768 + 4096);
            for (int idx = tid; idx < 32 * 52; idx += 512) { const int t = idx / 52, cc = idx % 52;
                const v4u v = *(const v4u*)(U + (size_t)(row0 + t) * UC + 2048 + cc * 8);
                if (cc < 48) *(v4u*)(As + t * 392 + cc * 8) = v;
                else { const int c0 = (cc - 48) * 8; float* kp = kr + t * 32 + c0;
                    kp[0] = __uint_as_float(v.x << 16); kp[1] = __uint_as_float(v.x & 0xffff0000u); kp[2] = __uint_as_float(v.y << 16); kp[3] = __uint_as_float(v.y & 0xffff0000u);
                    kp[4] = __uint_as_float(v.z << 16); kp[5] = __uint_as_float(v.z & 0xffff0000u); kp[6] = __uint_as_float(v.w << 16); kp[7] = __uint_as_float(v.w & 0xffff0000u); } }
            __syncthreads();
#pragma unroll
            for (int q = 0; q < 4; ++q) { const int t = wave * 4 + q; float sq = 0.f, sk = 0.f;
#pragma unroll
                for (int j = 0; j < 4; ++j) { const float v = bf2f(As[t * 392 + lane + 64 * j]); sq += v * v; }
#pragma unroll
                for (int j = 0; j < 2; ++j) { const float v = bf2f(As[t * 392 + 256 + lane + 64 * j]); sk += v * v; }
                sq = wave_sum(sq); sk = wave_sum(sk);
                if (lane == 0) { rs[t * 2] = rsqrtf(sq * (1.f / 256.f) + 1e-6f); rs[t * 2 + 1] = rsqrtf(sk * (1.f / 128.f) + 1e-6f); } }
            __syncthreads();
            const int fr = lane & 15, fq = lane >> 4;
            bf16* QB = (bf16*)(ws + M_QB); bf16* KB = (bf16*)(ws + M_KB); bf16* VT = (bf16*)(ws + M_VT);
            const bf16* WUQ = (const bf16*)(ws + W_UQ); const bf16* WUKV = (const bf16*)(ws + W_UKV);
            const int keybase = ti.isctx ? TLEN : 0;
#pragma unroll
            for (int i = 0; i < 3; ++i) { const int nt = wave * 3 + i;
                f32x4 c0 = {0.f, 0.f, 0.f, 0.f}, c1 = c0;
#pragma unroll
                for (int ks = 0; ks < 8; ++ks) { const bf16x8 bfr = *(const bf16x8*)(WUQ + (size_t)(nt * 16 + fr) * 256 + ks * 32 + fq * 8);
                    const bf16x8 a0 = *(const bf16x8*)(As + fr * 392 + ks * 32 + fq * 8), a1 = *(const bf16x8*)(As + (16 + fr) * 392 + ks * 32 + fq * 8);
                    c0 = __builtin_amdgcn_mfma_f32_16x16x32_bf16(a0, bfr, c0, 0, 0, 0); c1 = __builtin_amdgcn_mfma_f32_16x16x32_bf16(a1, bfr, c1, 0, 0, 0); }
                const int hq = nt / 6, wt = nt % 6, dd = wt * 16 + fr;
#pragma unroll
                for (int mt = 0; mt < 2; ++mt)
#pragma unroll
                    for (int j = 0; j < 4; ++j) { const int tl = mt * 16 + fq * 4 + j; const int t = ti.t0 + tl;
                        float v = (mt ? c1[j] : c0[j]) * rs[tl * 2];
                        const float pv = dppf<0x128>(v);
                        if (wt >= 4 && !ti.isctx) { const int f = fr & 7; const float pos = (wt == 4) ? (float)(t >> 6) : (float)(t & 63);
                            const float ang = pos * __expf(-(float)f * (9.210340371976184f / 8.f)); float sn, cs; __sincosf(ang, &sn, &cs);
                            v = (fr & 8) ? (v * cs + pv * sn) : (v * cs - pv * sn); }
                        QB[((size_t)(ti.b * 4 + hq) * TT + keybase + t) * 96 + dd] = (bf16)f2bf(v * QSCALE); } }
#pragma unroll
            for (int i = 0; i < 4; ++i) { const int nt = wave * 4 + i;
                f32x4 c0 = {0.f, 0.f, 0.f, 0.f}, c1 = c0;
#pragma unroll
                for (int ks = 0; ks < 4; ++ks) { const bf16x8 bfr = *(const bf16x8*)(WUKV + (size_t)(nt * 16 + fr) * 128 + ks * 32 + fq * 8);
                    const bf16x8 a0 = *(const bf16x8*)(As + fr * 392 + 256 + ks * 32 + fq * 8), a1 = *(const bf16x8*)(As + (16 + fr) * 392 + 256 + ks * 32 + fq * 8);
                    c0 = __builtin_amdgcn_mfma_f32_16x16x32_bf16(a0, bfr, c0, 0, 0, 0); c1 = __builtin_amdgcn_mfma_f32_16x16x32_bf16(a1, bfr, c1, 0, 0, 0); }
                const int hk = nt >> 3, wt = nt & 7;
#pragma unroll
                for (int mt = 0; mt < 2; ++mt) { float vv[4];
#pragma unroll
                    for (int j = 0; j < 4; ++j) { const int tl = mt * 16 + fq * 4 + j; vv[j] = (mt ? c1[j] : c0[j]) * rs[tl * 2 + 1]; }
                    const int key0 = keybase + ti.t0 + mt * 16 + fq * 4;
                    if (wt < 4) {
#pragma unroll
                        for (int j = 0; j < 4; ++j) KB[((size_t)(ti.b * 4 + hk) * TT + key0 + j) * 96 + wt * 16 + fr] = (bf16)f2bf(vv[j]); }
                    else { v2u w; w.x = pk2(vv[0], vv[1]); w.y = pk2(vv[2], vv[3]);
                        *(v2u*)(VT + ((size_t)(ti.b * 4 + hk) * 64 + (wt - 4) * 16 + fr) * TT + key0) = w; } } }
            { const int tl = tid >> 4, p = tid & 15, ax = p >> 3, f = p & 7; const int t = ti.t0 + tl;
                float x0 = kr[tl * 32 + ax * 16 + f], x1 = kr[tl * 32 + ax * 16 + 8 + f];
                if (!ti.isctx) { const float pos = ax == 0 ? (float)(t >> 6) : (float)(t & 63); const float ang = pos * __expf(-(float)f * (9.210340371976184f / 8.f));
                    float sn, cs; __sincosf(ang, &sn, &cs); const float y0 = x0 * cs - x1 * sn, y1 = x1 * cs + x0 * sn; x0 = y0; x1 = y1; }
                const bf16 b0 = (bf16)f2bf(x0), b1 = (bf16)f2bf(x1);
#pragma unroll
                for (int h = 0; h < 4; ++h) { bf16* kp = KB + ((size_t)(ti.b * 4 + h) * TT + keybase + t) * 96 + 64 + ax * 16 + f; kp[0] = b0; kp[8] = b1; } }
            __syncthreads();
        }
    }
}

__device__ __forceinline__ void attn_unit(unsigned char* lds, const bf16* QB, const bf16* KB, const bf16* VT, bf16* Y, int b, int h, int q0, int key_lo, int nkt, int tid) {
    const int lane = tid & 63, wave = tid >> 6, fr = lane & 15, fq = lane >> 4;
    const int bh = b * 4 + h;
    constexpr int KSTR = 104, VSTR = 72, KBUF = 64 * KSTR, VBUF = 64 * VSTR;
    bf16* Ks = (bf16*)lds;
    bf16* Vs = (bf16*)lds + 2 * KBUF;
    const int qw = q0 + wave * 32;
    bf16x8 qf[2][3];
#pragma unroll
    for (int qt = 0; qt < 2; ++qt)
#pragma unroll
        for (int ks = 0; ks < 3; ++ks) qf[qt][ks] = *(const bf16x8*)(QB + ((size_t)bh * TT + qw + qt * 16 + fr) * 96 + ks * 32 + fq * 8);
    float mrun[2] = {-1e30f, -1e30f}, lrun[2] = {0.f, 0.f};
    f32x4 o[4][2];
#pragma unroll
    for (int dt = 0; dt < 4; ++dt)
#pragma unroll
        for (int qt = 0; qt < 2; ++qt) o[dt][qt] = (f32x4){0.f, 0.f, 0.f, 0.f};
    const v4u* kg = (const v4u*)(KB + ((size_t)bh * TT + key_lo) * 96);
    const bf16* vg = VT + ((size_t)bh * 64 + (tid >> 3)) * TT + key_lo + (tid & 7) * 8;
    const int kc0 = tid, kc1 = 512 + tid;
    const int ko0 = (kc0 / 12) * KSTR + (kc0 % 12) * 8, ko1 = (kc1 / 12) * KSTR + (kc1 % 12) * 8, vo = (tid >> 3) * VSTR + (tid & 7) * 8;
    v4u rk0, rk1 = {0u, 0u, 0u, 0u}, rv;
    rk0 = kg[kc0]; if (tid < 256) rk1 = kg[kc1]; rv = *(const v4u*)vg;
    *(v4u*)(Ks + ko0) = rk0; if (tid < 256) *(v4u*)(Ks + ko1) = rk1; *(v4u*)(Vs + vo) = rv;
    __syncthreads();
    for (int kt = 0; kt < nkt; ++kt) {
        const int cur = kt & 1;
        if (kt + 1 < nkt) { const v4u* kn = kg + (size_t)(kt + 1) * 768; rk0 = kn[kc0]; if (tid < 256) rk1 = kn[kc1]; rv = *(const v4u*)(vg + (kt + 1) * 64); }
        const bf16* kb = Ks + cur * KBUF; const bf16* vb = Vs + cur * VBUF;
        f32x4 st[4][2];
#pragma unroll
        for (int k4 = 0; k4 < 4; ++k4) {
            st[k4][0] = (f32x4){0.f, 0.f, 0.f, 0.f}; st[k4][1] = st[k4][0];
#pragma unroll
            for (int ks = 0; ks < 3; ++ks) { const bf16x8 kf = *(const bf16x8*)(kb + (k4 * 16 + fr) * KSTR + ks * 32 + fq * 8);
                st[k4][0] = __builtin_amdgcn_mfma_f32_16x16x32_bf16(kf, qf[0][ks], st[k4][0], 0, 0, 0);
                st[k4][1] = __builtin_amdgcn_mfma_f32_16x16x32_bf16(kf, qf[1][ks], st[k4][1], 0, 0, 0); }
        }
        bf16x8 pb[2][2];
#pragma unroll
        for (int qt = 0; qt < 2; ++qt) {
            float mx = st[0][qt][0];
#pragma unroll
            for (int k4 = 0; k4 < 4; ++k4)
#pragma unroll
                for (int j = 0; j < 4; ++j) mx = fmaxf(mx, st[k4][qt][j]);
            mx = rows4_max(mx);
            const float mn = fmaxf(mrun[qt], mx), alpha = __builtin_amdgcn_exp2f(mrun[qt] - mn); mrun[qt] = mn;
            float ls = 0.f;
#pragma unroll
            for (int k4 = 0; k4 < 4; ++k4)
#pragma unroll
                for (int j = 0; j < 4; ++j) { const float p = __builtin_amdgcn_exp2f(st[k4][qt][j] - mn); st[k4][qt][j] = p; ls += p; }
            lrun[qt] = lrun[qt] * alpha + ls;
#pragma unroll
            for (int dt = 0; dt < 4; ++dt) o[dt][qt] *= alpha;
#pragma unroll
            for (int u = 0; u < 2; ++u) { v4u w;
                w.x = pg8::cvt_pk_bf16(st[2 * u][qt][0], st[2 * u][qt][1]); w.y = pg8::cvt_pk_bf16(st[2 * u][qt][2], st[2 * u][qt][3]);
                w.z = pg8::cvt_pk_bf16(st[2 * u + 1][qt][0], st[2 * u + 1][qt][1]); w.w = pg8::cvt_pk_bf16(st[2 * u + 1][qt][2], st[2 * u + 1][qt][3]);
                pb[u][qt] = __builtin_bit_cast(bf16x8, w); }
        }
#pragma unroll
        for (int dt = 0; dt < 4; ++dt)
#pragma unroll
            for (int u = 0; u < 2; ++u) {
                const v2u lo = *(const v2u*)(vb + (dt * 16 + fr) * VSTR + 32 * u + 4 * fq), hi = *(const v2u*)(vb + (dt * 16 + fr) * VSTR + 32 * u + 16 + 4 * fq);
                v4u vw; vw.x = lo.x; vw.y = lo.y; vw.z = hi.x; vw.w = hi.y;
                const bf16x8 va = __builtin_bit_cast(bf16x8, vw);
                o[dt][0] = __builtin_amdgcn_mfma_f32_16x16x32_bf16(va, pb[u][0], o[dt][0], 0, 0, 0);
                o[dt][1] = __builtin_amdgcn_mfma_f32_16x16x32_bf16(va, pb[u][1], o[dt][1], 0, 0, 0);
            }
        if (kt + 1 < nkt) { const int nb = cur ^ 1; *(v4u*)(Ks + nb * KBUF + ko0) = rk0; if (tid < 256) *(v4u*)(Ks + nb * KBUF + ko1) = rk1; *(v4u*)(Vs + nb * VBUF + vo) = rv; }
        __syncthreads();
    }
#pragma unroll
    for (int qt = 0; qt < 2; ++qt) {
        const float lt = rows4_sum(lrun[qt]);
        const float inv = 1.f / lt;
        const int q = qw + qt * 16 + fr;
        const size_t row = q < TLEN ? (size_t)b * TLEN + q : (size_t)NLAT + b * CTXL + (q - TLEN);
#pragma unroll
        for (int dt = 0; dt < 4; ++dt) { const f32x4 v = o[dt][qt] * inv; v2u w; w.x = pk2(v[0], v[1]); w.y = pk2(v[2], v[3]);
            *(v2u*)(Y + row * DM + 768 + h * 64 + dt * 16 + fq * 4) = w; }
    }
}
__device__ __forceinline__ void lru_prefix(int bd, int tid) {
    unsigned char* ws = karg_ws();
    if (tid >= 256) return;
    const int ch = tid, b = bd >> 1, d = bd & 1;
    const float* __restrict__ SA = (const float*)(ws + M_SEGA); const float* __restrict__ SB = (const float*)(ws + M_SEGB); float* __restrict__ H0 = (float*)(ws + M_H0);
    const int ctile0 = 512 + b * 8, ltile0 = b * 256;
#define LRU_TILE(i_) ((i_) < 8 ? ctile0 + (d ? 7 - (i_) : (i_)) : ltile0 + (d ? 255 - ((i_) - 8) : ((i_) - 8)))
    float hst = 0.f;
    float ca[24], cb[24], na[24], nb[24];
#pragma unroll
    for (int k = 0; k < 24; ++k) { const size_t o = (size_t)(LRU_TILE(k) * 2 + d) * 256 + ch; ca[k] = SA[o]; cb[k] = SB[o]; }
    for (int i0 = 0; i0 < 264; i0 += 24) {
        if (i0 + 24 < 264) {
#pragma unroll
            for (int k = 0; k < 24; ++k) { const size_t o = (size_t)(LRU_TILE(i0 + 24 + k) * 2 + d) * 256 + ch; na[k] = SA[o]; nb[k] = SB[o]; } }
        float hv[24];
#pragma unroll
        for (int k = 0; k < 24; ++k) { hv[k] = hst; hst = ca[k] * hst + cb[k]; }
#pragma unroll
        for (int k = 0; k < 24; ++k) H0[(size_t)(LRU_TILE(i0 + k) * 2 + d) * 256 + ch] = hv[k];
#pragma unroll
        for (int k = 0; k < 24; ++k) { ca[k] = na[k]; cb[k] = nb[k]; }
    }
#undef LRU_TILE
}
__device__ __forceinline__ void lru_rescan(const Args& a, int l, unsigned char* lds, int tile, int tid) {
    unsigned char* ws = karg_ws();
    const int ch = tid & 255, d = tid >> 8;
    const int row0 = tile * 32;
    float hst = ((const float*)(ws + M_H0))[(size_t)(tile * 2 + d) * 256 + ch];
    const float lam = IN(22)[(l * 2 + d) * 256 + ch];
    const float cch = -8.f * log1pf(__expf(-lam));
    const bf16* LR = (const bf16*)(ws + M_LR0 + (size_t)d * A8); const bf16* LIX = (const bf16*)(ws + M_LIX0 + (size_t)d * A8);
    float* hs = (float*)lds;
#pragma unroll 16
    for (int tt = 0; tt < 32; ++tt) { const int t = d ? 31 - tt : tt; const size_t o = (size_t)(row0 + t) * 256 + ch;
        const float al = __expf(cch * bf2f(LR[o])); const float bb = sqrtf(fmaxf(1.f - al * al, 0.f)) * bf2f(LIX[o]);
        hst = al * hst + bb; hs[(d * 32 + t) * 256 + ch] = hst; }
    __syncthreads();
    const bf16* U = (const bf16*)(ws + OFF_HU); bf16* Y = (bf16*)(ws + OFF_XMY);
#pragma unroll 8
    for (int tt = 0; tt < 16; ++tt) { const int t = d * 16 + tt;
        const float y = (hs[t * 256 + ch] + hs[(32 + t) * 256 + ch]) * geluf_(bf2f(U[(size_t)(row0 + t) * UC + 768 + ch]));
        Y[(size_t)(row0 + t) * DM + 256 + ch] = (bf16)f2bf(y); }
    __syncthreads();
}
__device__ __forceinline__ void phase_m2(const Args& a, int l, unsigned char* lds, int G, int bid, int tid) {
    unsigned char* ws = karg_ws();
    const bf16* QB = (const bf16*)(ws + M_QB); const bf16* KB = (const bf16*)(ws + M_KB); const bf16* VT = (const bf16*)(ws + M_VT);
    bf16* Y = (bf16*)(ws + OFF_XMY);
    const int nunits = (l == 0) ? 264 : 256;
    for (int u = bid; u < nunits; u += G) {
        if (u < 256) attn_unit(lds, QB, KB, VT, Y, u >> 7, (u >> 5) & 3, (u & 31) * 256, 0, 132, tid);
        else attn_unit(lds, QB, KB, VT, Y, (u - 256) >> 2, (u - 256) & 3, TLEN, TLEN, 4, tid);
    }
    if (bid >= G - 4) lru_prefix(bid - (G - 4), tid);
}

__device__ __forceinline__ void phase_m3(const Args& a, int l, unsigned char* lds, int G, int bid, int tid) {
    unsigned char* ws = karg_ws();
    const bf16* U = (const bf16*)(ws + OFF_HU);
    const int lane = tid & 63, ch = tid & 255, part = tid >> 8;
    const float* mup = IN(23) + l * 1024; const float* mun = IN(24) + l * 1024;
    bf16* RR = (bf16*)(ws + M_RR); bf16* KKo = (bf16*)(ws + M_KK); bf16* VV = (bf16*)(ws + M_VV); bf16* GC = (bf16*)(ws + M_GC);
    float* kl = (float*)lds;
    float* kkn = (float*)(lds + 32768);
    bf16* twb = (bf16*)(lds + 65536);
    bf16* tab = (bf16*)(lds + 70144);
    bf16* tgb = (bf16*)(lds + 74752);
    for (int pass = 0; pass < 2; ++pass)
    for (int tile = (pass == 0 ? bid : (bid < 48 ? 512 + bid / 3 : NTILE)); tile < (pass == 0 ? 512 : NTILE); tile += (pass == 0 ? G : NTILE)) {
        const int mask = pass == 0 ? 7 : ((1 << (bid % 3)) & (l == 1 ? 6 : 7));
        const TileInfo ti = tile_info(tile);
        const int row0 = tile * 32;
        if (mask & 1) lru_rescan(a, l, lds, tile, ltid());
        if (mask & 6) {
        {
            const int tid2 = ltid(); const int chunk = tid2 & 127, tg8 = tid2 >> 7, c0 = chunk * 8;
            const bf16* ub = U + (size_t)row0 * UC + 1024 + c0;
            v4u rw[10];
#pragma unroll
            for (int q = 0; q < 10; ++q) { const int tl = tg8 * 8 + q - 1; const int t = ti.t0 + tl;
                rw[q] = (t >= 0 && t < ti.seqlen) ? *(const v4u*)(ub + (ptrdiff_t)tl * UC) : (v4u){0u, 0u, 0u, 0u}; }
            const f32x4 mp0 = *(const f32x4*)(mup + c0), mp1 = *(const f32x4*)(mup + c0 + 4), mn0 = *(const f32x4*)(mun + c0), mn1 = *(const f32x4*)(mun + c0 + 4);
            const float mp[8] = {mp0[0], mp0[1], mp0[2], mp0[3], mp1[0], mp1[1], mp1[2], mp1[3]}, mn[8] = {mn0[0], mn0[1], mn0[2], mn0[3], mn1[0], mn1[1], mn1[2], mn1[3]};
#pragma unroll
            for (int q = 0; q < 8; ++q) { const int tl = tg8 * 8 + q; float ts[8];
#pragma unroll
                for (int e = 0; e < 8; ++e) { const unsigned wm = rw[q][e >> 1], w0 = rw[q + 1][e >> 1], wn = rw[q + 2][e >> 1];
                    const float um = (e & 1) ? __uint_as_float(wm & 0xffff0000u) : __uint_as_float(wm << 16);
                    const float u0 = (e & 1) ? __uint_as_float(w0 & 0xffff0000u) : __uint_as_float(w0 << 16);
                    const float un = (e & 1) ? __uint_as_float(wn & 0xffff0000u) : __uint_as_float(wn << 16);
                    ts[e] = u0 + mp[e] * (um - u0) + mn[e] * (un - u0); }
                if (chunk >= 32 && chunk < 64) { float* kp = kl + tl * 256 + (c0 - 256); *(f32x4*)kp = (f32x4){ts[0], ts[1], ts[2], ts[3]}; *(f32x4*)(kp + 4) = (f32x4){ts[4], ts[5], ts[6], ts[7]}; }
                else {
                    if (chunk >= 96 && chunk < 104) {
#pragma unroll
                        for (int e = 0; e < 8; ++e) ts[e] = tanhf_(ts[e]); }
                    if (chunk >= 112) {
#pragma unroll
                        for (int e = 0; e < 8; ++e) ts[e] = sigm(ts[e]); }
                    v4u o; o.x = pk2(ts[0], ts[1]); o.y = pk2(ts[2], ts[3]); o.z = pk2(ts[4], ts[5]); o.w = pk2(ts[6], ts[7]);
                    if (chunk < 32) *(v4u*)(RR + (size_t)(row0 + tl) * 256 + c0) = o;
                    else if (chunk < 96) *(v4u*)(VV + (size_t)(row0 + tl) * 256 + (c0 - 512)) = o;
                    else if (chunk < 104) *(v4u*)(twb + tl * 72 + (c0 - 768)) = o;
                    else if (chunk < 112) *(v4u*)(tab + tl * 72 + (c0 - 832)) = o;
                    else *(v4u*)(tgb + tl * 136 + (c0 - 896)) = o; }
            }
        }
        __syncthreads();
        {
            const int tid2 = ltid(); const int ch = tid2 & 255, pt = tid2 >> 8; const float kkc = IN(30)[l * 256 + ch];
#pragma unroll 4
            for (int q = 0; q < 16; ++q) { const int t = pt * 16 + q; const float kr = kl[t * 256 + ch] * kkc; const float nrm = wave_sum(kr * kr);
                const float kk = kr * rsqrtf(fmaxf(nrm, 1e-24f)); kkn[t * 256 + ch] = kk; KKo[(size_t)(row0 + t) * 256 + ch] = (bf16)f2bf(kk); }
        }
        __syncthreads();
        {
            const int tid2 = ltid(); const int ln = tid2 & 63, wv = __builtin_amdgcn_readfirstlane(tid2 >> 6), fr = ln & 15, fq = ln >> 4;
            const bf16* WUPt = (const bf16*)(ws + W_WUP); const bf16* AUPt = (const bf16*)(ws + W_AUP); const bf16* GUPt = (const bf16*)(ws + W_GUP);
            bf16x8 aw[2][2], aa[2][2];
#pragma unroll
            for (int mt = 0; mt < 2; ++mt)
#pragma unroll
                for (int ks = 0; ks < 2; ++ks) { aw[mt][ks] = *(const bf16x8*)(twb + (mt * 16 + fr) * 72 + ks * 32 + fq * 8); aa[mt][ks] = *(const bf16x8*)(tab + (mt * 16 + fr) * 72 + ks * 32 + fq * 8); }
#pragma unroll
            for (int dn = 0; dn < 4; ++dn) { const int d = dn >> 1, nt = wv * 2 + (dn & 1), ch = nt * 16 + fr;
                if (!((mask >> (1 + d)) & 1)) continue;
                f32x4 cw[2], ca[2];
#pragma unroll
                for (int mt = 0; mt < 2; ++mt) { cw[mt] = (f32x4){0.f, 0.f, 0.f, 0.f}; ca[mt] = cw[mt]; }
#pragma unroll
                for (int ks = 0; ks < 2; ++ks) { const bf16x8 bw = *(const bf16x8*)(WUPt + ((size_t)d * 256 + ch) * 64 + ks * 32 + fq * 8), ba = *(const bf16x8*)(AUPt + ((size_t)d * 256 + ch) * 64 + ks * 32 + fq * 8);
#pragma unroll
                    for (int mt = 0; mt < 2; ++mt) { cw[mt] = __builtin_amdgcn_mfma_f32_16x16x32_bf16(aw[mt][ks], bw, cw[mt], 0, 0, 0); ca[mt] = __builtin_amdgcn_mfma_f32_16x16x32_bf16(aa[mt][ks], ba, ca[mt], 0, 0, 0); } }
                const float w0 = IN(25)[(l * 2 + d) * 256 + ch], a0 = IN(27)[(l * 2 + d) * 256 + ch], kac = IN(31)[l * 256 + ch];
                float* WW = (float*)(ws + M_WW) + (size_t)d * NR * 256; bf16* BB = (bf16*)(ws + M_BB + (size_t)d * A8); bf16* KD = (bf16*)(ws + M_KD + (size_t)d * A8);
#pragma unroll
                for (int mt = 0; mt < 2; ++mt)
#pragma unroll
                    for (int j = 0; j < 4; ++j) { const int t = mt * 16 + fq * 4 + j; const size_t o = (size_t)(row0 + t) * 256 + ch;
                        const float e = sigm(w0 + cw[mt][j]) * 0.6065306597126334f;
                        const float av = sigm(a0 + ca[mt][j]);
                        WW[o] = __expf(-e);
                        KD[o] = (bf16)f2bf(kl[t * 256 + ch] * (1.f + (av - 1.f) * kac));
                        BB[o] = (bf16)f2bf(kkn[t * 256 + ch] * av); }
            }
#pragma unroll
            for (int nl = 0; nl < 2; ++nl) { const int ch = (wv * 2 + nl) * 16 + fr;
                if (!(mask & 4)) continue;
                f32x4 cg[2] = {(f32x4){0.f, 0.f, 0.f, 0.f}, (f32x4){0.f, 0.f, 0.f, 0.f}};
#pragma unroll
                for (int ks = 0; ks < 4; ++ks) { const bf16x8 bg = *(const bf16x8*)(GUPt + (size_t)ch * 128 + ks * 32 + fq * 8);
#pragma unroll
                    for (int mt = 0; mt < 2; ++mt) { const bf16x8 ag = *(const bf16x8*)(tgb + (mt * 16 + fr) * 136 + ks * 32 + fq * 8); cg[mt] = __builtin_amdgcn_mfma_f32_16x16x32_bf16(ag, bg, cg[mt], 0, 0, 0); } }
#pragma unroll
                for (int mt = 0; mt < 2; ++mt)
#pragma unroll
                    for (int j = 0; j < 4; ++j) GC[(size_t)(row0 + mt * 16 + fq * 4 + j) * 256 + ch] = (bf16)f2bf(cg[mt][j]);
            }
        }
        __syncthreads();
        }
    }
}

typedef const unsigned cu32;
typedef const float cf32;
__device__ __forceinline__ int chain_row(int b, int d, int tau) {
    return tau < CTXL ? (NLAT + b * CTXL + (d ? CTXL - 1 - tau : tau)) : (b * TLEN + (d ? TLEN - 1 - (tau - CTXL) : (tau - CTXL)));
}
template <int MODE>
__device__ __forceinline__ void rwkv_steps(float (&S)[64], int b, int h, int d, int tau0, int n, unsigned char* ws, int lane, float* wl) {
    const bf16* KKp = (const bf16*)(ws + M_KK); const bf16* RRp = (const bf16*)(ws + M_RR); const bf16* VVp = (const bf16*)(ws + M_VV);
    const float* WWp = (const float*)(ws + M_WW) + (size_t)d * NR * 256; const bf16* BBp = (const bf16*)(ws + M_BB + (size_t)d * A8); const bf16* KDp = (const bf16*)(ws + M_KD + (size_t)d * A8);
    float* YS = (float*)(ws + M_YS) + (size_t)d * NR * 256;
    float pk, pw, pb, pkd = 0.f, pr = 0.f, pv = 0.f; size_t poff;
#define RWKV_LOAD(s_) do { poff = (size_t)chain_row(b, d, tau0 + (s_)) * 256 + h * 64 + lane; pk = bf2f(KKp[poff]); pw = WWp[poff]; pb = bf2f(BBp[poff]); \
        if (MODE != 1) { pkd = bf2f(KDp[poff]); pv = bf2f(VVp[poff]); } if (MODE == 2) pr = bf2f(RRp[poff]); } while (0)
    RWKV_LOAD(0);
    for (int s = 0; s < n; ++s) {
        float* buf = wl + (s & 1) * 320;
        buf[lane] = pk; buf[64 + lane] = pw; buf[128 + lane] = pb;
        if (MODE != 1) buf[192 + lane] = pkd;
        if (MODE == 2) buf[256 + lane] = pr;
        const float vv = pv; const size_t yoff = poff;
        if (s + 1 < n) RWKV_LOAD(s + 1);
        float sa0 = 0.f, sa1 = 0.f, sa2 = 0.f, sa3 = 0.f;
#pragma unroll
        for (int i = 0; i < 64; i += 4) { const f32x4 k4 = *(const f32x4*)(buf + i);
            sa0 += S[i] * k4[0]; sa1 += S[i + 1] * k4[1]; sa2 += S[i + 2] * k4[2]; sa3 += S[i + 3] * k4[3]; }
        const float nsa = -((sa0 + sa1) + (sa2 + sa3));
        float y0 = 0.f, y1 = 0.f, y2 = 0.f, y3 = 0.f;
#pragma unroll
        for (int i = 0; i < 64; i += 4) { const f32x4 w4 = *(const f32x4*)(buf + 64 + i), b4 = *(const f32x4*)(buf + 128 + i);
            f32x4 t = nsa * b4;
            if (MODE != 1) { const f32x4 kd4 = *(const f32x4*)(buf + 192 + i); t += vv * kd4; }
            S[i] = S[i] * w4[0] + t[0]; S[i + 1] = S[i + 1] * w4[1] + t[1]; S[i + 2] = S[i + 2] * w4[2] + t[2]; S[i + 3] = S[i + 3] * w4[3] + t[3];
            if (MODE == 2) { const f32x4 r4 = *(const f32x4*)(buf + 256 + i); y0 += S[i] * r4[0]; y1 += S[i + 1] * r4[1]; y2 += S[i + 2] * r4[2]; y3 += S[i + 3] * r4[3]; } }
        if (MODE == 2) YS[yoff] = (y0 + y1) + (y2 + y3);
    }
#undef RWKV_LOAD
}
typedef float f32x2 __attribute__((ext_vector_type(2)));
__device__ __forceinline__ void rwkv_pass1(f32x2 (&SL)[32], f32x2 (&SI)[32], int b, int h, int d, int tau0, int n, unsigned char* ws, int lane, float* wl) {
    const bf16* KKp = (const bf16*)(ws + M_KK); const bf16* VVp = (const bf16*)(ws + M_VV); const bf16* RRp = (const bf16*)(ws + M_RR);
    const float* WWp = (const float*)(ws + M_WW) + (size_t)d * NR * 256; const bf16* BBp = (const bf16*)(ws + M_BB + (size_t)d * A8); const bf16* KDp = (const bf16*)(ws + M_KD + (size_t)d * A8);
    float* YS = (float*)(ws + M_YS) + (size_t)d * NR * 256; float* PR = (float*)(ws + M_PR) + (size_t)d * NR * 256;
    float pk, pw, pb, pkd, pv, pr; size_t poff;
#define RWKV_LOAD(s_) do { poff = (size_t)chain_row(b, d, tau0 + (s_)) * 256 + h * 64 + lane; pk = bf2f(KKp[poff]); pw = WWp[poff]; pb = bf2f(BBp[poff]); pkd = bf2f(KDp[poff]); pv = bf2f(VVp[poff]); pr = bf2f(RRp[poff]); } while (0)
    RWKV_LOAD(0);
    for (int s = 0; s < n; ++s) {
        float* buf = wl + (s & 1) * 320;
        buf[lane] = pk; buf[64 + lane] = pw; buf[128 + lane] = pb; buf[192 + lane] = pkd; buf[256 + lane] = pr;
        const float vv = pv; const size_t yoff = poff;
        if (s + 1 < n) RWKV_LOAD(s + 1);
        f32x2 aL0 = {0.f, 0.f}, aL1 = aL0, aI0 = aL0, aI1 = aL0;
#pragma unroll
        for (int q = 0; q < 16; ++q) { const f32x4 k4 = *(const f32x4*)(buf + 4 * q);
            aL0 += SL[2 * q] * k4.lo; aL1 += SL[2 * q + 1] * k4.hi; aI0 += SI[2 * q] * k4.lo; aI1 += SI[2 * q + 1] * k4.hi; }
        const f32x2 tL = aL0 + aL1, tI = aI0 + aI1;
        const float nsl = -(tL.x + tL.y), nsi = -(tI.x + tI.y);
        f32x2 yL0 = {0.f, 0.f}, yL1 = yL0, yI0 = yL0, yI1 = yL0;
#pragma unroll
        for (int q = 0; q < 16; ++q) {
            const f32x4 w4 = *(const f32x4*)(buf + 64 + 4 * q), b4 = *(const f32x4*)(buf + 128 + 4 * q), kd4 = *(const f32x4*)(buf + 192 + 4 * q), r4 = *(const f32x4*)(buf + 256 + 4 * q);
            const f32x4 tl = nsl * b4 + vv * kd4, tiv = nsi * b4;
            SL[2 * q] = SL[2 * q] * w4.lo + tl.lo; SL[2 * q + 1] = SL[2 * q + 1] * w4.hi + tl.hi;
            SI[2 * q] = SI[2 * q] * w4.lo + tiv.lo; SI[2 * q + 1] = SI[2 * q + 1] * w4.hi + tiv.hi;
            yL0 += SL[2 * q] * r4.lo; yL1 += SL[2 * q + 1] * r4.hi; yI0 += SI[2 * q] * r4.lo; yI1 += SI[2 * q + 1] * r4.hi; }
        const f32x2 yl = yL0 + yL1, yp = yI0 + yI1;
        YS[yoff] = yl.x + yl.y; PR[yoff] = yp.x + yp.y;
    }
#undef RWKV_LOAD
}
__device__ __forceinline__ void phase_m4(const Args& a, unsigned char* lds, int G, int bid, int tid) {
    const int lane = tid & 63, wave = __builtin_amdgcn_readfirstlane(tid >> 6), half = wave >> 2, tk = wave & 3;
    unsigned char* ws = karg_ws(); float* PL = (float*)(ws + M_PL);
    float* wl = (float*)lds + wave * 320;
    float* xch = (float*)lds + 8 * 320 + tk * 1024;
    float* ych = xch + 512;
    const bf16* KKp = (const bf16*)(ws + M_KK); const bf16* VVp = (const bf16*)(ws + M_VV); const bf16* RRp = (const bf16*)(ws + M_RR);
    for (int task0 = bid * 4; task0 < 16 * NSEG; task0 += G * 4) {
        const int task = task0 + tk; const int seg = task & (NSEG - 1), chain = task >> 6;
        const int d = chain & 1, h = (chain >> 1) & 3, b = chain >> 3;
        const float* WWp = (const float*)(ws + M_WW) + (size_t)d * NR * 256; const bf16* BBp = (const bf16*)(ws + M_BB + (size_t)d * A8); const bf16* KDp = (const bf16*)(ws + M_KD + (size_t)d * A8);
        float* YS = (float*)(ws + M_YS) + (size_t)d * NR * 256; float* PR = (float*)(ws + M_PR) + (size_t)d * NR * 256;
        f32x2 SL[16], SI[16]; int ln = lane; asm volatile("" : "+v"(ln));
#pragma unroll
        for (int i = 0; i < 16; ++i) { SL[i] = (f32x2){0.f, 0.f}; SI[i] = (f32x2){(32 * half + 2 * i == ln) ? 1.f : 0.f, (32 * half + 2 * i + 1 == ln) ? 1.f : 0.f}; }
        const int tau0 = seg * SEGLEN, cidx = h * 64 + 32 * half + (lane & 31);
        unsigned pp; float pw, pv; size_t rowoff, prevoff = 0;
        const int grp = lane >> 4, l15 = lane & 15, l31 = lane & 31;
        const unsigned* srcp = grp == 0 ? (const unsigned*)KKp : grp == 1 ? (const unsigned*)BBp : grp == 2 ? (const unsigned*)KDp : (const unsigned*)RRp;
#define M4_LOAD(s_) do { rowoff = (size_t)chain_row(b, d, tau0 + (s_)) * 256; pp = srcp[(rowoff + h * 64 + 32 * half) / 2 + l15]; \
            pw = (lane < 32) ? WWp[rowoff + cidx] : 0.f; pv = bf2f(VVp[rowoff + h * 64 + lane]); } while (0)
#define UNPK(u_) ((f32x2){__uint_as_float((u_) << 16), __uint_as_float((u_) & 0xffff0000u)})
        M4_LOAD(0);
        for (int s = 0; s < SEGLEN; ++s) {
            float* buf = wl + (s & 1) * 160; const unsigned* bufu = (const unsigned*)buf;
            ((unsigned*)buf)[lane] = pp; if (lane < 32) buf[64 + l31] = pw;
            const float vv = pv; const size_t yoff = rowoff + h * 64 + lane;
            if (s + 1 < SEGLEN) M4_LOAD(s + 1);
            f32x2 aL0 = {0.f, 0.f}, aL1 = aL0, aI0 = aL0, aI1 = aL0;
#pragma unroll
            for (int q = 0; q < 4; ++q) { const v4u k4 = *(const v4u*)(bufu + 4 * q);
                const f32x2 ka = UNPK(k4.x), kb = UNPK(k4.y), kc = UNPK(k4.z), kd_ = UNPK(k4.w);
                aL0 += SL[4 * q] * ka; aL1 += SL[4 * q + 1] * kb; aL0 += SL[4 * q + 2] * kc; aL1 += SL[4 * q + 3] * kd_;
                aI0 += SI[4 * q] * ka; aI1 += SI[4 * q + 1] * kb; aI0 += SI[4 * q + 2] * kc; aI1 += SI[4 * q + 3] * kd_; }
            const f32x2 tL = aL0 + aL1, tI = aI0 + aI1;
            float* xw = xch + (s & 1) * 256;
            xw[half * 128 + lane] = tL.x + tL.y; xw[half * 128 + 64 + lane] = tI.x + tI.y;
            __syncthreads();
            const float nsl = -(xw[lane] + xw[128 + lane]), nsi = -(xw[64 + lane] + xw[192 + lane]);
            if (s > 0) {
                const float* yr = ych + ((s - 1) & 1) * 256;
                if (half == 0) YS[prevoff] = yr[lane] + yr[128 + lane]; else PR[prevoff] = yr[64 + lane] + yr[192 + lane];
            }
            f32x2 yL0 = {0.f, 0.f}, yL1 = yL0, yI0 = yL0, yI1 = yL0;
#pragma unroll
            for (int q = 0; q < 4; ++q) {
                const f32x4 wa = *(const f32x4*)(buf + 64 + 8 * q), wb = *(const f32x4*)(buf + 68 + 8 * q);
                const v4u b4 = *(const v4u*)(bufu + 16 + 4 * q), d4 = *(const v4u*)(bufu + 32 + 4 * q), r4 = *(const v4u*)(bufu + 48 + 4 * q);
                const f32x2 w2[4] = {wa.lo, wa.hi, wb.lo, wb.hi};
                const unsigned bu[4] = {b4.x, b4.y, b4.z, b4.w}, du[4] = {d4.x, d4.y, d4.z, d4.w}, ru[4] = {r4.x, r4.y, r4.z, r4.w};
#pragma unroll
                for (int e = 0; e < 4; ++e) { const int j = 4 * q + e; const f32x2 b2 = UNPK(bu[e]), k2 = UNPK(du[e]), r2 = UNPK(ru[e]);
                    const f32x2 tl = nsl * b2 + vv * k2, tiv = nsi * b2;
                    SL[j] = SL[j] * w2[e] + tl; SI[j] = SI[j] * w2[e] + tiv;
                    if (e & 1) { yL1 += SL[j] * r2; yI1 += SI[j] * r2; } else { yL0 += SL[j] * r2; yI0 += SI[j] * r2; } }
            }
            const f32x2 yl = yL0 + yL1, yp = yI0 + yI1;
            float* yw = ych + (s & 1) * 256;
            yw[half * 128 + lane] = yl.x + yl.y; yw[half * 128 + 64 + lane] = yp.x + yp.y;
            prevoff = yoff;
        }
#undef M4_LOAD
#undef UNPK
        __syncthreads();
        { const float* yr = ych + ((SEGLEN - 1) & 1) * 256;
          if (half == 0) YS[prevoff] = yr[lane] + yr[128 + lane]; else PR[prevoff] = yr[64 + lane] + yr[192 + lane]; }
        float* o = PL + (((size_t)(chain * NSEG + seg) * 2) * 64 + lane) * 64 + 32 * half;
#pragma unroll
        for (int i = 0; i < 16; i += 2) { *(f32x4*)(o + 2 * i) = (f32x4){SL[i].x, SL[i].y, SL[i + 1].x, SL[i + 1].y}; *(f32x4*)(o + 4096 + 2 * i) = (f32x4){SI[i].x, SI[i].y, SI[i + 1].x, SI[i + 1].y}; }
        __syncthreads();
    }
}
__device__ __forceinline__ void phase_m5(const Args& a, unsigned char* lds, int G, int bid, int tid) {
    unsigned char* ws = karg_ws(); const float* PL = (const float*)(ws + M_PL); float* SI = (float*)(ws + M_SINIT);
    float* Sx = (float*)lds;
    const int lane = tid & 63, wv = __builtin_amdgcn_readfirstlane(tid >> 6), fr = lane & 15, fq = lane >> 4;
    const bool act = wv < 4;
    for (int u = bid; u < 64; u += G) {
        const int chain = u >> 2, row0 = (u & 3) * 16, col = (wv & 3) * 16 + fr;
        const float* Pg = PL + ((size_t)(chain * NSEG) * 2 + 1) * 4096; const float* Lg = PL + ((size_t)(chain * NSEG) * 2) * 4096;
        float* SIc = SI + (size_t)(chain * NSEG) * 4096;
        f32x4 cur = {0.f, 0.f, 0.f, 0.f}; f32x4 lv[3]; float pb[3][16];
#pragma unroll
        for (int q = 0; q < 3; ++q) { lv[q] = cur;
            if (act) { const float* Pn = Pg + (size_t)q * 8192; const float* Ln = Lg + (size_t)q * 8192;
#pragma unroll
                for (int ks = 0; ks < 16; ++ks) pb[q][ks] = Pn[(4 * ks + fq) * 64 + col];
#pragma unroll
                for (int j = 0; j < 4; ++j) lv[q][j] = Ln[(row0 + fq * 4 + j) * 64 + col]; } }
        for (int g0 = 0; g0 < NSEG - 1; g0 += 3) {
#pragma unroll
            for (int q = 0; q < 3; ++q) { const int g = g0 + q;
                if (act) {
#pragma unroll
                    for (int j = 0; j < 4; ++j) { SIc[(size_t)g * 4096 + (row0 + fq * 4 + j) * 64 + col] = cur[j]; Sx[(fq * 4 + j) * 68 + col] = cur[j]; }
                }
                __syncthreads();
                if (act) {
                    f32x4 acc = lv[q];
#pragma unroll
                    for (int ks = 0; ks < 16; ++ks) { const float av = Sx[fr * 68 + 4 * ks + fq]; acc = __builtin_amdgcn_mfma_f32_16x16x4f32(av, pb[q][ks], acc, 0, 0, 0); }
                    cur = acc;
                    if (g + 3 < NSEG - 1) { const float* Pn = Pg + (size_t)(g + 3) * 8192; const float* Ln = Lg + (size_t)(g + 3) * 8192;
#pragma unroll
                        for (int ks = 0; ks < 16; ++ks) pb[q][ks] = Pn[(4 * ks + fq) * 64 + col];
#pragma unroll
                        for (int j = 0; j < 4; ++j) lv[q][j] = Ln[(row0 + fq * 4 + j) * 64 + col]; }
                }
                __syncthreads();
            }
        }
        if (act) {
#pragma unroll
            for (int j = 0; j < 4; ++j) SIc[(size_t)(NSEG - 1) * 4096 + (row0 + fq * 4 + j) * 64 + col] = cur[j];
        }
    }
}
__device__ __forceinline__ void phase_m6(const Args& a, unsigned char* lds, int G, int bid, int tid) {
    const int lane = tid & 63, wave = __builtin_amdgcn_readfirstlane(tid >> 6);
    unsigned char* ws = karg_ws(); const float* SI = (const float*)(ws + M_SINIT);
    float* wl = (float*)lds + wave * 256;
    for (int task = wave * G + bid; task < 16 * (NSEG - 1); task += G * 8) {
        const int seg = 1 + task % (NSEG - 1), chain = task / (NSEG - 1);
        const int d = chain & 1, h = (chain >> 1) & 3, b = chain >> 3;
        float* YS = (float*)(ws + M_YS) + (size_t)d * NR * 256; const float* PR = (const float*)(ws + M_PR) + (size_t)d * NR * 256;
        f32x2 S0[32];
        const float* si = SI + ((size_t)(chain * NSEG + seg) * 64 + lane) * 64;
#pragma unroll
        for (int i = 0; i < 32; i += 2) { const f32x4 v = *(const f32x4*)(si + 2 * i); S0[i] = v.lo; S0[i + 1] = v.hi; }
        const int tau0 = seg * SEGLEN;
        size_t o[4]; float p[4], y[4];
#pragma unroll
        for (int k = 0; k < 4; ++k) { o[k] = (size_t)chain_row(b, d, tau0 + k) * 256 + h * 64 + lane; p[k] = PR[o[k]]; y[k] = YS[o[k]]; }
        for (int s = 0; s < SEGLEN; s += 4) {
            size_t c[4]; float yy[4];
#pragma unroll
            for (int k = 0; k < 4; ++k) { wl[k * 64 + lane] = p[k]; c[k] = o[k]; yy[k] = y[k]; }
            if (s + 4 < SEGLEN) {
#pragma unroll
                for (int k = 0; k < 4; ++k) { o[k] = (size_t)chain_row(b, d, tau0 + s + 4 + k) * 256 + h * 64 + lane; p[k] = PR[o[k]]; y[k] = YS[o[k]]; } }
#pragma unroll
            for (int k = 0; k < 4; k += 2) {
                f32x2 a0 = {0.f, 0.f}, a1 = a0, b0 = a0, b1 = a0;
#pragma unroll
                for (int q = 0; q < 16; ++q) { const f32x4 u = *(const f32x4*)(wl + k * 64 + 4 * q), w = *(const f32x4*)(wl + (k + 1) * 64 + 4 * q);
                    a0 += S0[2 * q] * u.lo; a1 += S0[2 * q + 1] * u.hi; b0 += S0[2 * q] * w.lo; b1 += S0[2 * q + 1] * w.hi; }
                const f32x2 ta = a0 + a1, tb = b0 + b1;
                yy[k] += ta.x + ta.y; yy[k + 1] += tb.x + tb.y;
            }
#pragma unroll
            for (int k = 0; k < 4; ++k) YS[c[k]] = yy[k];
            asm volatile("" ::: "memory");
        }
    }
}
__device__ __forceinline__ void phase_m7(const Args& a, int l, int gw, int NGW, int lane) {
    unsigned char* ws = karg_ws();
    const float* Y0 = (const float*)(ws + M_YS); const float* Y1 = Y0 + (size_t)NR * 256;
    const bf16* RR = (const bf16*)(ws + M_RR); const bf16* VV = (const bf16*)(ws + M_VV); const bf16* KD0 = (const bf16*)(ws + M_KD); const bf16* KD1 = (const bf16*)(ws + M_KD + A8);
    const bf16* GC = (const bf16*)(ws + M_GC); bf16* Y = (bf16*)(ws + OFF_XMY);
    for (int r = gw; r < NR; r += NGW) {
#pragma unroll
        for (int h = 0; h < 4; ++h) { const int c = h * 64 + lane; const size_t o = (size_t)r * 256 + c;
            const float ys = Y0[o] + Y1[o];
            const float mu = wave_sum(ys) * (1.f / 64.f); const float dv = ys - mu; const float var = wave_sum(dv * dv) * (1.f / 64.f);
            float ov = dv * rsqrtf(var + 64e-5f) * IN(33)[l * 256 + c] + IN(34)[l * 256 + c];
            const float rv = bf2f(RR[o]), rk = IN(32)[l * 256 + c], vv = bf2f(VV[o]);
            const float b0 = wave_sum(rv * bf2f(KD0[o]) * rk), b1 = wave_sum(rv * bf2f(KD1[o]) * rk);
            ov += (b0 + b1) * vv;
            Y[(size_t)r * DM + 512 + c] = (bf16)f2bf(ov * bf2f(GC[o])); }
    }
}

#define LAS __attribute__((address_space(3)))
#define XB_TMO      128
#define XB_XCNT(j)  (256  + 64 * (j))
#define XB_XSUB(j)  (1280 + 64 * (j))
#define XB_XGEN(j)  (2304 + 64 * (j))
#define XB_TOP      3328
#define XB_TOPGEN   3392
#define XCD_BAR_WORDS 3456
#define XB_SPIN_CAP (1u << 18)

__device__ __forceinline__ unsigned xb_ld(unsigned* p)              { return __hip_atomic_load(p, __ATOMIC_RELAXED, __HIP_MEMORY_SCOPE_AGENT); }
__device__ __forceinline__ unsigned xb_add(unsigned* p, unsigned v) { return __hip_atomic_fetch_add(p, v, __ATOMIC_RELAXED, __HIP_MEMORY_SCOPE_AGENT); }
__device__ __forceinline__ unsigned xb_xcc_id() { return (unsigned)__builtin_amdgcn_s_getreg((3 << 11) | 20) & 0xFu; }
#define XB_SPIN(cond, bar) do { unsigned _sp = 0; while (cond) { __builtin_amdgcn_s_sleep(1); \
    if ((++_sp & 255u) == 0u) { if (xb_ld(&(bar)[XB_TMO])) break; if (_sp > XB_SPIN_CAP) { atomicAdd(&(bar)[XB_TMO], 1u); break; } } } } while (0)

struct XcdBarrier {
    unsigned* bar; unsigned x;
    volatile LAS unsigned* st;
};

__device__ __forceinline__ XcdBarrier xcd_barrier_post(unsigned* bar, volatile LAS unsigned* st) {
    XcdBarrier b; b.bar = bar; b.x = xb_xcc_id(); b.st = st;
    if (threadIdx.x == 0) (void)xb_add(&bar[XB_XCNT(b.x)], 1u);
    return b;
}
__device__ __forceinline__ void xcd_barrier_complete(unsigned* bar, unsigned x, unsigned& nloc, unsigned& nx) {
    const unsigned G = gridDim.x * gridDim.y * gridDim.z;
    unsigned sum, cnt, mine, sp = 0u;
    for (;;) {
        sum = 0u; cnt = 0u; mine = 0u;
#pragma unroll
        for (unsigned j = 0; j < 16; ++j) { const unsigned c = xb_ld(&bar[XB_XCNT(j)]); sum += c; cnt += (c > 0u) ? 1u : 0u; mine = (j == x) ? c : mine; }
        if (sum == G) break;
        __builtin_amdgcn_s_sleep(1);
        if ((++sp & 255u) == 0u) { if (xb_ld(&bar[XB_TMO])) break; if (sp > XB_SPIN_CAP) { atomicAdd(&bar[XB_TMO], 1u); break; } }
    }
    nloc = mine > 0u ? mine : 1u; nx = cnt > 0u ? cnt : 1u;
}

__device__ __forceinline__ void xcd_barrier(const XcdBarrier& b) {
    asm volatile("s_waitcnt vmcnt(0)" ::: "memory");
    __syncthreads();
    if (threadIdx.x == 0) {
        unsigned* bar = b.bar;
        __builtin_amdgcn_s_waitcnt(0);
        unsigned nloc = b.st[0], nx = b.st[1];
        if (nloc == 0u) { xcd_barrier_complete(bar, b.x, nloc, nx); b.st[0] = nloc; b.st[1] = nx; }
        const unsigned old = xb_add(&bar[XB_XSUB(b.x)], 1u);
        const unsigned gen = old / nloc;
        if (old + 1u == (gen + 1u) * nloc) {
            __builtin_amdgcn_fence(__ATOMIC_RELEASE, "agent");
            asm volatile("s_waitcnt vmcnt(0)" ::: "memory");
            const unsigned og = xb_add(&bar[XB_TOP], 1u);
            const unsigned tg = og / nx;
            if (og + 1u == (tg + 1u) * nx) xb_add(&bar[XB_TOPGEN], 1u);
            else XB_SPIN(xb_ld(&bar[XB_TOPGEN]) == tg, bar);
            __builtin_amdgcn_fence(__ATOMIC_ACQUIRE, "agent");
            xb_add(&bar[XB_XGEN(b.x)], 1u);
            asm volatile("s_waitcnt vmcnt(0)" ::: "memory");
        } else {
            XB_SPIN(xb_ld(&bar[XB_XGEN(b.x)]) == gen, bar);
            __builtin_amdgcn_fence(__ATOMIC_ACQUIRE, "agent");
            asm volatile("s_waitcnt vmcnt(0)" ::: "memory");
        }
    }
    __syncthreads();
}

__global__ void __launch_bounds__(512, 2) mega(Args a) {
    extern __shared__ __attribute__((aligned(16))) unsigned char lds[];
    cg::grid_group grid = cg::this_grid();
    const int G = gridDim.x;
    PG8_LAS unsigned char* glds = (PG8_LAS unsigned char*)lds;
#define bid lbid()
#define tid ltid()
#define lane (ltid() & 63)
#define wave (__builtin_amdgcn_readfirstlane(ltid() >> 6))
#define gw (lbid() * 8 + __builtin_amdgcn_readfirstlane(ltid() >> 6))
#define NGW (G * 8)
    { volatile LAS unsigned* st0 = (volatile LAS unsigned*)((LAS unsigned char*)lds + 131072); if (threadIdx.x < 4) st0[threadIdx.x] = 0u; }
    __syncthreads();
    const XcdBarrier xbar = xcd_barrier_post((unsigned*)(karg_ws() + 229376), (volatile LAS unsigned*)((LAS unsigned char*)lds + 131072));
#define GSYNC() do { xcd_barrier(xbar); } while (0)

    phase_modgemv(a, (float*)lds, G, bid, tid);
    convert_weights(a, 0, (float*)(lds + 32768) + wave * (64 * 33), gw, NGW, lane, G, bid, tid);
    if (G == 0x7fffffff) grid.sync();
    GSYNC();
#pragma clang loop unroll(full)
    for (int l = 0; l < 2; ++l) {
        if (l > 0) convert_weights(a, l, (float*)lds + wave * (64 * 33), gw, NGW, lane, G, bid, tid);
        phase_modulate(a, l, 0, gw, NGW, lane);
        GSYNC();
        for (int rp = 0; rp < REP_G1; ++rp)
        {
            unsigned char* ws = karg_ws(); float* outp = karg_out(); float* xctx = (float*)(ws + OFF_XCTX); bf16* XM = (bf16*)(ws + OFF_XMY); bf16* HU = (bf16*)(ws + OFF_HU); const float* modl = (const float*)(ws + OFF_MOD) + (size_t)l * 3 * 9216; (void)xctx; (void)XM; (void)HU; (void)modl; (void)outp;
            pg8::Gemm g{XM, (const bf16*)(ws + W_13A), NR, 2 * DFF, DM}; pg8::StaticOrder S; S.init(NR, 2 * DFF, G, bid);
            EpiSwiglu E{HU};
            pg8::gemm_phase<EpiSwiglu, pg8::StaticOrder, true, true>(glds, g, S, E);
        }
        GSYNC();
        {
            unsigned char* ws = karg_ws(); float* outp = karg_out(); float* xctx = (float*)(ws + OFF_XCTX); bf16* XM = (bf16*)(ws + OFF_XMY); bf16* HU = (bf16*)(ws + OFF_HU); const float* modl = (const float*)(ws + OFF_MOD) + (size_t)l * 3 * 9216; (void)xctx; (void)XM; (void)HU; (void)modl; (void)outp;
            pg8::Gemm g{HU, (const bf16*)(ws + W_2A), NR, DM, DFF}; pg8::StaticOrder S; S.init(NR, DM, G, bid);
            EpiResid E{outp, xctx, modl + 2 * 1024, 0.5f, l == 0 ? IN(0) : outp, l == 0 ? IN(2) : xctx};
            pg8::gemm_phase<EpiResid, pg8::StaticOrder, true, true>(glds, g, S, E);
        }
        GSYNC();
        phase_modulate(a, l, 1, gw, NGW, lane);
        GSYNC();
        {
            unsigned char* ws = karg_ws(); float* outp = karg_out(); float* xctx = (float*)(ws + OFF_XCTX); bf16* XM = (bf16*)(ws + OFF_XMY); bf16* HU = (bf16*)(ws + OFF_HU); const float* modl = (const float*)(ws + OFF_MOD) + (size_t)l * 3 * 9216; (void)xctx; (void)XM; (void)HU; (void)modl; (void)outp;
            pg8::Gemm g{XM, (const bf16*)(ws + W_IN), NR, UC, DM}; pg8::StaticOrder S; S.init(NR, UC, G, bid);
            EpiU E{HU, UC};
            pg8::gemm_phase<EpiU, pg8::StaticOrder, true, true>(glds, g, S, E);
        }
        GSYNC();
        for (int rp = 0; rp < REP_M1; ++rp) { phase_m1(a, l, lds, G, bid, tid);
        GSYNC(); }
        for (int rp = 0; rp < REP_M2; ++rp) { phase_m2(a, l, lds, G, bid, tid);
        GSYNC(); }
        for (int rp = 0; rp < REP_M3; ++rp) { phase_m3(a, l, lds, G, bid, tid);
        GSYNC(); }
        for (int rp = 0; rp < REP_SCAN; ++rp) { phase_m4(a, lds, G, bid, tid);
        GSYNC();
        phase_m5(a, lds, G, bid, tid);
        GSYNC();
        phase_m6(a, lds, G, bid, tid);
        GSYNC(); }
        phase_m7(a, l, gw, NGW, lane);
        GSYNC();
        {
            unsigned char* ws = karg_ws(); float* outp = karg_out(); float* xctx = (float*)(ws + OFF_XCTX); bf16* XM = (bf16*)(ws + OFF_XMY); bf16* HU = (bf16*)(ws + OFF_HU); const float* modl = (const float*)(ws + OFF_MOD) + (size_t)l * 3 * 9216; (void)xctx; (void)XM; (void)HU; (void)modl; (void)outp;
            const int MR = (l == 1) ? NLAT : NR;
            pg8::Gemm g{XM, (const bf16*)(ws + W_OUT), MR, DM, DM}; pg8::StaticOrder S; S.init(MR, DM, G, bid);
            EpiResid E{outp, xctx, modl + 5 * 1024, 1.0f, outp, xctx};
            pg8::gemm_phase<EpiResid, pg8::StaticOrder, true, true>(glds, g, S, E);
        }
        GSYNC();
        phase_modulate(a, l, 2, gw, NGW, lane);
        GSYNC();
        {
            unsigned char* ws = karg_ws(); float* outp = karg_out(); float* xctx = (float*)(ws + OFF_XCTX); bf16* XM = (bf16*)(ws + OFF_XMY); bf16* HU = (bf16*)(ws + OFF_HU); const float* modl = (const float*)(ws + OFF_MOD) + (size_t)l * 3 * 9216; (void)xctx; (void)XM; (void)HU; (void)modl; (void)outp;
            const int MR = (l == 1) ? NLAT : NR;
            pg8::Gemm g{XM, (const bf16*)(ws + W_13B), MR, 2 * DFF, DM}; pg8::StaticOrder S; S.init(MR, 2 * DFF, G, bid);
            EpiSwiglu E{HU};
            pg8::gemm_phase<EpiSwiglu, pg8::StaticOrder, true, true>(glds, g, S, E);
        }
        GSYNC();
        {
            unsigned char* ws = karg_ws(); float* outp = karg_out(); float* xctx = (float*)(ws + OFF_XCTX); bf16* XM = (bf16*)(ws + OFF_XMY); bf16* HU = (bf16*)(ws + OFF_HU); const float* modl = (const float*)(ws + OFF_MOD) + (size_t)l * 3 * 9216; (void)xctx; (void)XM; (void)HU; (void)modl; (void)outp;
            const int MR = (l == 1) ? NLAT : NR;
            pg8::Gemm g{HU, (const bf16*)(ws + W_2B), MR, DM, DFF}; pg8::StaticOrder S; S.init(MR, DM, G, bid);
            EpiResid E{outp, xctx, modl + 8 * 1024, 0.5f, outp, xctx};
            pg8::gemm_phase<EpiResid, pg8::StaticOrder, true, true>(glds, g, S, E);
        }
        GSYNC();
    }
    phase_final(a, gw, NGW, lane);
#undef bid
#undef tid
#undef lane
#undef wave
#undef gw
#undef NGW
}

extern "C" void kernel_launch(void* const* d_in, const int* in_sizes, int n_in, void* d_out, int out_size, void* d_ws, size_t ws_size, hipStream_t stream) {
    static int grid = 0;
    if (grid == 0) {
        int dev = 0, cus = 0, per_cu = 0;
        (void)hipGetDevice(&dev);
        (void)hipDeviceGetAttribute(&cus, hipDeviceAttributeMultiprocessorCount, dev);
        (void)hipFuncSetAttribute((const void*)mega, hipFuncAttributeMaxDynamicSharedMemorySize, LDS_BYTES);
        (void)hipOccupancyMaxActiveBlocksPerMultiprocessor(&per_cu, (const void*)mega, 512, LDS_BYTES);
        if (per_cu < 1) per_cu = 1;
        grid = cus * per_cu;
        if (n_in != 40 || ws_size < WS_NEED) { fprintf(stderr, "kernel_launch: unexpected n_in %d / ws %zu (need %zu)\n", n_in, ws_size, (size_t)WS_NEED); }
    }
    (void)hipMemsetAsync((char*)d_ws + OFF_MOD, 0, MOD_BYTES, stream);
    Args a{};
    for (int i = 0; i < 40; ++i) a.in[i] = (const float*)d_in[i];
    a.out = (float*)d_out; a.ws = (unsigned char*)d_ws;
    void* args[] = {&a};
    hipError_t e = hipLaunchCooperativeKernel((const void*)mega, dim3(grid), dim3(512), args, LDS_BYTES, stream);
    if (e != hipSuccess) fprintf(stderr, "cooperative launch failed: %s (grid %d)\n", hipGetErrorString(e), grid);
}
```

```cpp
#include <hip/hip_runtime.h>
#include <hip/hip_cooperative_groups.h>
#include <cstdio>
#include <cstdint>
namespace cg = cooperative_groups;
namespace pg8 {
#define PG8_LAS __attribute__((address_space(3)))
typedef unsigned short bf16_t;
typedef short bf16x8 __attribute__((ext_vector_type(8)));
typedef float f32x4 __attribute__((ext_vector_type(4)));
typedef unsigned u32x4 __attribute__((ext_vector_type(4)));
constexpr int BM = 256, BK = 64, HALF = 128, HTB = HALF * BK * 2  , STAGE_BYTES = 8 * HTB, NXCD = 8, WGM = 8;

__host__ __device__ __forceinline__ int lds_byte(int r, int c) { const int st = (r >> 4) * 2 + (c >> 5), rr = r & 15, cc = c & 31, ob = rr * 64 + cc * 2; return st * 1024 + (ob ^ (((ob >> 9) & 1) << 5)); }
__host__ __device__ __forceinline__ void stage_rc(int b, int& R, int& C) { const int st = b / 1024, sb = b % 1024, swz = sb ^ (((sb >> 9) & 1) << 5); R = (st >> 1) * 16 + swz / 64; C = (st & 1) * 32 + (swz % 64) / 2; }
__host__ __device__ __forceinline__ int perm32(int rho) { const int n = rho >> 4, i = rho & 15; return 8 * (i >> 2) + 4 * n + (i & 3); }

struct Unit { int pm, pn; };
struct Gemm { const bf16_t* A; const bf16_t* Bt; int M, N, K; };

struct StaticOrder {
    int nM, nN, nwg, G, c;
    __host__ __device__ void init(int M, int N, int G_, int c_) { nM = M / BM; nN = N / BM; nwg = nM * nN; G = G_; c = c_; }
    __host__ __device__ bool next(int i, Unit& u) const {
        const long L = (long)i * G + c; if (L >= nwg) return false;
        int wgid = (int)L; { const int q = nwg / NXCD, r = nwg % NXCD, xcd = wgid % NXCD, off = wgid / NXCD; wgid = (xcd < r ? xcd * (q + 1) : r * (q + 1) + (xcd - r) * q) + off; }
        const int nig = WGM * nN, gid = wgid / nig, fm = gid * WGM, gsz = (nM - fm) < WGM ? (nM - fm) : WGM;
        u.pm = fm + ((wgid % nig) % gsz); u.pn = (wgid % nig) / gsz; return true;
    }
    __device__ __forceinline__ void a_ready(const Unit&) const {}
    __device__ __forceinline__ void done(const Unit&) const {}
};

__device__ __forceinline__ unsigned cvt_pk_bf16(float lo, float hi) { unsigned r; asm volatile("v_cvt_pk_bf16_f32 %0, %1, %2" : "=v"(r) : "v"(lo), "v"(hi)); return r; }
typedef float f32x2 __attribute__((ext_vector_type(2)));
template <class Epi, class Sched, bool ALIGN_EPI = false, bool SP2 = false>
__device__ __forceinline__ void gemm_phase(PG8_LAS unsigned char* lds, const Gemm g, const Sched& S, const Epi& E) {
    int tid = threadIdx.x; asm volatile("" : "+v"(tid));
    const int wid = __builtin_amdgcn_readfirstlane(tid >> 6), lane = tid & 63, wr = wid >> 2, wc = wid & 3, fr = lane & 15, fq = lane >> 4;
    const int K = g.K, nt = K / BK;
    unsigned voffA[2], voffB[2];
#pragma unroll
    for (int i = 0; i < 2; ++i) { int R, C; stage_rc(tid * 16 + i * 8192, R, C); const int Rb = Epi::PERM ? ((R & ~31) + perm32(R & 31)) : R;
        voffA[i] = (unsigned)(R * K + C) * 2u; voffB[i] = (unsigned)(Rb * K + C) * 2u; }
    const size_t kstep = (size_t)(BK * 2);
    const size_t hstep = (size_t)HALF * K * 2;
    const size_t tstep = 2 * hstep;
    const unsigned ldsw = (unsigned)wid * 1024u;
    const int aoff = lds_byte(wr * 64 + fr, fq * 8), boff = lds_byte(wc * 32 + fr, fq * 8);
#define PG8_SA(b, h) (((b) * 2 + (h)) * HTB)
#define PG8_SB(b, h) ((4 + (b) * 2 + (h)) * HTB)
#define PG8_STAGE(bufoff, gbase, voff) do { _Pragma("unroll") for (int _i = 0; _i < 2; ++_i) \
        __builtin_amdgcn_global_load_lds((const unsigned*)((const char*)(gbase) + (voff)[_i]), (PG8_LAS unsigned*)(lds + (bufoff) + ldsw + _i * 8192), 16, 0, 0); } while (0)
#define PG8_LDA(dst, b, h) do { _Pragma("unroll") for (int m = 0; m < 4; ++m) _Pragma("unroll") for (int k = 0; k < 2; ++k) dst[m][k] = *(const PG8_LAS bf16x8*)(lds + PG8_SA(b, h) + aoff + m * 2048 + k * 1024); } while (0)
#define PG8_LDB(dst, b, h) do { _Pragma("unroll") for (int n = 0; n < 2; ++n) _Pragma("unroll") for (int k = 0; k < 2; ++k) dst[n][k] = *(const PG8_LAS bf16x8*)(lds + PG8_SB(b, h) + boff + n * 2048 + k * 1024); } while (0)
#define PG8_MMA(ai, bj, At, Bt) do { __builtin_amdgcn_s_setprio(1); _Pragma("unroll") for (int m = 0; m < 4; ++m) _Pragma("unroll") for (int n = 0; n < 2; ++n) _Pragma("unroll") for (int k = 0; k < 2; ++k) \
        acc[ai][bj][m][n] = __builtin_amdgcn_mfma_f32_16x16x32_bf16(Bt[n][k], At[m][k], acc[ai][bj][m][n], 0, 0, 0); __builtin_amdgcn_s_setprio(0); } while (0)
#define PG8_WAIT_V(n) asm volatile("s_waitcnt vmcnt(" #n ")" ::: "memory")
#define PG8_WAIT_L(n) asm volatile("s_waitcnt lgkmcnt(" #n ")" ::: "memory")
#define PG8_BAR __builtin_amdgcn_s_barrier()
#define PG8_SCHED __builtin_amdgcn_sched_barrier(0)
    Unit cur, nxt; int ui = 0;
    if (!S.next(0, cur)) return;
    f32x4 acc[2][2][4][2];
#pragma unroll
    for (int a = 0; a < 2; ++a)
#pragma unroll
        for (int b = 0; b < 2; ++b)
#pragma unroll
            for (int m = 0; m < 4; ++m)
#pragma unroll
                for (int n = 0; n < 2; ++n) acc[a][b][m][n] = (f32x4){0.f, 0.f, 0.f, 0.f};
    bf16x8 At[4][2], B0[2][2], B1[2][2];
    const char* cA = (const char*)g.A + (size_t)cur.pm * tstep; const char* cB = (const char*)g.Bt + (size_t)cur.pn * tstep;
    S.a_ready(cur);
    if constexpr (SP2) {
        PG8_STAGE(PG8_SB(0, 0), cB, voffB); PG8_STAGE(PG8_SB(0, 1), cB + hstep, voffB); PG8_STAGE(PG8_SA(0, 0), cA, voffA); PG8_STAGE(PG8_SA(0, 1), cA + hstep, voffA);
        if (wr == 1) PG8_BAR;
        PG8_WAIT_V(2); PG8_BAR;
        PG8_STAGE(PG8_SB(1, 0), cB + kstep, voffB); PG8_STAGE(PG8_SA(1, 0), cA + kstep, voffA); PG8_STAGE(PG8_SB(1, 1), cB + hstep + kstep, voffB);
        PG8_WAIT_V(6); PG8_BAR;
    } else {
        PG8_STAGE(PG8_SB(0, 0), cB, voffB); PG8_STAGE(PG8_SA(0, 0), cA, voffA); PG8_STAGE(PG8_SB(0, 1), cB + hstep, voffB); PG8_STAGE(PG8_SA(0, 1), cA + hstep, voffA);
        if (wr == 1) PG8_BAR;
        PG8_WAIT_V(4); PG8_BAR;
        PG8_STAGE(PG8_SB(1, 0), cB + kstep, voffB); PG8_STAGE(PG8_SA(1, 0), cA + kstep, voffA); PG8_STAGE(PG8_SB(1, 1), cB + hstep + kstep, voffB);
        PG8_WAIT_V(6); PG8_BAR;
    }
    for (;;) {
        const bool has_next = S.next(ui + 1, nxt);
        const char* nA = has_next ? (const char*)g.A + (size_t)nxt.pm * tstep : cA; const char* nB = has_next ? (const char*)g.Bt + (size_t)nxt.pn * tstep : cB;
        for (int t = 0; t < nt; t += 2) {
            const bool last = (t == nt - 2);
            const char* a1 = cA + (size_t)(t + 1) * kstep;
            const char* a2 = last ? nA : cA + (size_t)(t + 2) * kstep; const char* b2 = last ? nB : cB + (size_t)(t + 2) * kstep;
            const char* a3 = a2 + kstep; const char* b3 = b2 + kstep;
            if (last && has_next) S.a_ready(nxt);
            if constexpr (SP2) {
            PG8_LDB(B0, 0, 0); PG8_LDB(B1, 0, 1); PG8_SCHED; PG8_LDA(At, 0, 0); PG8_STAGE(PG8_SA(1, 1), a1 + hstep, voffA);
            PG8_WAIT_V(8); PG8_WAIT_L(0); PG8_BAR; PG8_MMA(0, 0, At, B0); PG8_MMA(0, 1, At, B1); PG8_BAR; PG8_SCHED;
            PG8_LDA(At, 0, 1); PG8_STAGE(PG8_SB(0, 0), b2, voffB); PG8_STAGE(PG8_SB(0, 1), b2 + hstep, voffB); PG8_STAGE(PG8_SA(0, 0), a2, voffA);
            PG8_WAIT_V(8); PG8_WAIT_L(0); PG8_BAR; PG8_MMA(1, 0, At, B0); PG8_MMA(1, 1, At, B1); PG8_BAR; PG8_SCHED;
            PG8_LDB(B0, 1, 0); PG8_LDB(B1, 1, 1); PG8_SCHED; PG8_LDA(At, 1, 0); PG8_STAGE(PG8_SA(0, 1), a2 + hstep, voffA);
            PG8_WAIT_V(8); PG8_WAIT_L(0); PG8_BAR; PG8_MMA(0, 0, At, B0); PG8_MMA(0, 1, At, B1); PG8_BAR; PG8_SCHED;
            PG8_LDA(At, 1, 1); PG8_STAGE(PG8_SB(1, 0), b3, voffB); PG8_STAGE(PG8_SB(1, 1), b3 + hstep, voffB); PG8_STAGE(PG8_SA(1, 0), a3, voffA);
            PG8_WAIT_V(8); PG8_WAIT_L(0); PG8_BAR; PG8_MMA(1, 0, At, B0); PG8_MMA(1, 1, At, B1); PG8_BAR; PG8_SCHED;
            } else {
            PG8_LDB(B0, 0, 0); PG8_SCHED; PG8_LDA(At, 0, 0); PG8_STAGE(PG8_SA(1, 1), a1 + hstep, voffA);
            PG8_WAIT_L(8); PG8_BAR; PG8_WAIT_L(0); PG8_MMA(0, 0, At, B0); PG8_BAR; PG8_SCHED;
            PG8_LDB(B1, 0, 1); PG8_STAGE(PG8_SB(0, 0), b2, voffB);
            PG8_BAR; PG8_WAIT_L(0); PG8_MMA(0, 1, At, B1); PG8_BAR;
            PG8_LDA(At, 0, 1); PG8_STAGE(PG8_SA(0, 0), a2, voffA);
            PG8_BAR; PG8_WAIT_L(0); PG8_MMA(1, 0, At, B0); PG8_BAR; PG8_SCHED;
            PG8_STAGE(PG8_SB(0, 1), b2 + hstep, voffB);
            PG8_WAIT_V(6); PG8_BAR; PG8_MMA(1, 1, At, B1); PG8_BAR;
            PG8_LDB(B0, 1, 0); PG8_SCHED; PG8_LDA(At, 1, 0); PG8_STAGE(PG8_SA(0, 1), a2 + hstep, voffA);
            PG8_WAIT_L(8); PG8_BAR; PG8_WAIT_L(0); PG8_MMA(0, 0, At, B0); PG8_BAR; PG8_SCHED;
            PG8_LDB(B1, 1, 1); PG8_STAGE(PG8_SB(1, 0), b3, voffB);
            PG8_BAR; PG8_WAIT_L(0); PG8_MMA(0, 1, At, B1); PG8_BAR;
            PG8_LDA(At, 1, 1); PG8_STAGE(PG8_SA(1, 0), a3, voffA);
            PG8_BAR; PG8_WAIT_L(0); PG8_MMA(1, 0, At, B0); PG8_BAR; PG8_SCHED;
            PG8_STAGE(PG8_SB(1, 1), b3 + hstep, voffB);
            PG8_WAIT_V(6); PG8_BAR; PG8_MMA(1, 1, At, B1); PG8_BAR;
            }
        }
        if constexpr (ALIGN_EPI) { if (wr == 0) PG8_BAR; }
        if constexpr (!Epi::AFTER_DRAIN) { E(acc, cur, wr, wc, fr, fq); S.done(cur); }
        if (!has_next) break;
#pragma unroll
        for (int a = 0; a < 2; ++a)
#pragma unroll
            for (int b = 0; b < 2; ++b)
#pragma unroll
                for (int m = 0; m < 4; ++m)
#pragma unroll
                    for (int n = 0; n < 2; ++n) acc[a][b][m][n] = (f32x4){0.f, 0.f, 0.f, 0.f};
        cur = nxt; cA = nA; cB = nB; ++ui;
        if constexpr (ALIGN_EPI) { if (wr == 1) PG8_BAR; }
    }
    PG8_WAIT_V(0);
    if constexpr (!ALIGN_EPI) { if (wr == 0) PG8_BAR; }
    PG8_BAR;
    if constexpr (Epi::AFTER_DRAIN) { E.fused(acc, cur, wr, wc, fr, fq, lds, wid, lane); S.done(cur); }
#undef PG8_SA
#undef PG8_SB
#undef PG8_STAGE
#undef PG8_LDA
#undef PG8_LDB
#undef PG8_MMA
#undef PG8_WAIT_V
#undef PG8_WAIT_L
#undef PG8_BAR
#undef PG8_SCHED
}
}

using pg8::f32x4; using pg8::bf16x8;
typedef unsigned short bf16;
typedef unsigned v4u __attribute__((ext_vector_type(4)));
typedef unsigned v2u __attribute__((ext_vector_type(2)));
typedef short s16x4 __attribute__((ext_vector_type(4)));

constexpr int DM = 1024, TLEN = 8192, CTXL = 256, TT = 8448, NLAT = 16384, NR = 16896, DFF = 2816, UC = 2560, NTILE = 528;
constexpr int NSEG = 64, SEGLEN = 132;
constexpr size_t MiB = 1u << 20;
constexpr size_t A8 = (size_t)NR * 256 * 2;
constexpr size_t OFF_MOD = 0, MOD_BYTES = 256 * 1024;
constexpr size_t OFF_XCTX = MiB / 4, OFF_XMY = 2 * MiB + MiB / 4, OFF_HU = 35 * MiB + MiB / 4, OFF_W = 126 * MiB, OFF_MIX = 167 * MiB, OFF_PR = 266 * MiB;
constexpr size_t W_13A = OFF_W, W_2A = OFF_W + 11 * MiB, W_13B = OFF_W + 16 * MiB + MiB / 2, W_2B = OFF_W + 27 * MiB + MiB / 2,
                 W_IN = OFF_W + 33 * MiB, W_OUT = OFF_W + 38 * MiB, W_UQ = OFF_W + 40 * MiB, W_UKV = OFF_W + 40 * MiB + 256 * 1024,
                 W_WUP = OFF_W + 40 * MiB + 384 * 1024, W_AUP = W_WUP + 65536, W_GUP = W_AUP + 65536, W_LWA = W_GUP + 65536, W_LWX = W_LWA + 65536;
constexpr size_t M_QB = OFF_MIX, M_KB = OFF_MIX + 12976128, M_VT = OFF_MIX + 25952256;
constexpr size_t M_LR0 = OFF_PR, M_LIX0 = OFF_PR + 2 * A8;
constexpr size_t M_SEGA = OFF_HU + 83 * MiB, M_SEGB = M_SEGA + MiB + MiB / 4, M_H0 = M_SEGB + MiB + MiB / 4;
constexpr size_t M_RR = OFF_MIX, M_KK = OFF_MIX + A8, M_VV = OFF_MIX + 2 * A8, M_WW = OFF_MIX + 3 * A8, M_BB = OFF_MIX + 7 * A8, M_KD = OFF_MIX + 9 * A8, M_GC = OFF_MIX + 11 * A8;
constexpr size_t M_YS = OFF_HU, M_PL = OFF_HU + 33 * MiB, M_SINIT = OFF_HU + 65 * MiB;
constexpr size_t M_PR = OFF_PR;
constexpr size_t WS_NEED = OFF_PR + 33 * MiB;
constexpr int LDS_BYTES = 131072 + 1024;
#ifndef REP_M1
#define REP_M1 1
#endif
#ifndef REP_M2
#define REP_M2 1
#endif
#ifndef REP_M3
#define REP_M3 1
#endif
#ifndef REP_SCAN
#define REP_SCAN 1
#endif
#ifndef REP_G1
#define REP_G1 1
#endif
constexpr float QSCALE = 0.10206207261596575f * 1.4426950408889634f;

struct Args { const float* in[40]; float* out; unsigned char* ws; };
typedef const __attribute__((address_space(4))) volatile unsigned long long kargq;
__device__ __forceinline__ const float* karg_in(int i) { kargq* p = (kargq*)__builtin_amdgcn_kernarg_segment_ptr(); return (const float*)p[i]; }
__device__ __forceinline__ float* karg_out() { kargq* p = (kargq*)__builtin_amdgcn_kernarg_segment_ptr(); return (float*)p[40]; }
__device__ __forceinline__ unsigned char* karg_ws() { kargq* p = (kargq*)__builtin_amdgcn_kernarg_segment_ptr(); return (unsigned char*)p[41]; }
#define IN(i) karg_in(i)
__device__ __forceinline__ int ltid() { int t = threadIdx.x; asm volatile("" : "+v"(t)); return t; }
__device__ __forceinline__ int lbid() { int t = blockIdx.x; asm volatile("" : "+s"(t)); return t; }
template <class T> __device__ __forceinline__ T* launder(T* p) { asm volatile("" : "+s"(p)); return p; }

__device__ __forceinline__ float bf2f(bf16 h) { return __uint_as_float((unsigned)h << 16); }
typedef float cvf32x2 __attribute__((ext_vector_type(2))); typedef __bf16 cvbf16x2 __attribute__((ext_vector_type(2)));
__device__ __forceinline__ unsigned pk2(float lo, float hi) { cvf32x2 v = {lo, hi}; cvbf16x2 b = __builtin_convertvector(v, cvbf16x2); return __builtin_bit_cast(unsigned, b); }
__device__ __forceinline__ unsigned f2bf(float f) { return pk2(f, 0.f) & 0xffffu; }
__device__ __forceinline__ float sigm(float x) { return __builtin_amdgcn_rcpf(1.f + __expf(-x)); }
__device__ __forceinline__ float siluf_(float x) { return x * __builtin_amdgcn_rcpf(1.f + __expf(-x)); }
__device__ __forceinline__ float tanhf_(float y) { return 1.f - 2.f * __builtin_amdgcn_rcpf(1.f + __expf(2.f * y)); }
__device__ __forceinline__ float geluf_(float x) { return 0.5f * x * (1.f + tanhf_(0.7978845608028654f * (x + 0.044715f * x * x * x))); }
template <int CTRL> __device__ __forceinline__ float dppf(float v) { return __int_as_float(__builtin_amdgcn_update_dpp(0, __float_as_int(v), CTRL, 0xF, 0xF, true)); }
__device__ __forceinline__ float rows4_max(float v) {
    auto a = __builtin_amdgcn_permlane16_swap(__float_as_uint(v), __float_as_uint(v), false, false); v = fmaxf(__uint_as_float(a[0]), __uint_as_float(a[1]));
    auto b = __builtin_amdgcn_permlane32_swap(__float_as_uint(v), __float_as_uint(v), false, false); return fmaxf(__uint_as_float(b[0]), __uint_as_float(b[1]));
}
__device__ __forceinline__ float rows4_sum(float v) {
    auto a = __builtin_amdgcn_permlane16_swap(__float_as_uint(v), __float_as_uint(v), false, false); v = __uint_as_float(a[0]) + __uint_as_float(a[1]);
    auto b = __builtin_amdgcn_permlane32_swap(__float_as_uint(v), __float_as_uint(v), false, false); return __uint_as_float(b[0]) + __uint_as_float(b[1]);
}
__device__ __forceinline__ float wave_sum(float v) {
    v += dppf<0xB1>(v); v += dppf<0x4E>(v); v += dppf<0x141>(v); v += dppf<0x140>(v);
    auto a = __builtin_amdgcn_permlane16_swap(__float_as_uint(v), __float_as_uint(v), false, false); v = __uint_as_float(a[0]) + __uint_as_float(a[1]);
    auto b = __builtin_amdgcn_permlane32_swap(__float_as_uint(v), __float_as_uint(v), false, false); return __uint_as_float(b[0]) + __uint_as_float(b[1]);
}
struct TileInfo { int b, isctx, t0, seqbase, seqlen; };
__device__ __forceinline__ TileInfo tile_info(int tile) {
    TileInfo ti;
    if (tile < 512) { ti.b = tile >> 8; ti.isctx = 0; ti.t0 = (tile & 255) * 32; ti.seqbase = ti.b * TLEN; ti.seqlen = TLEN; }
    else { const int q = tile - 512; ti.b = q >> 3; ti.isctx = 1; ti.t0 = (q & 7) * 32; ti.seqbase = NLAT + ti.b * CTXL; ti.seqlen = CTXL; }
    return ti;
}

struct EpiSwiglu {
    static constexpr bool PERM = true, AFTER_DRAIN = false;
    bf16* H;
    __device__ __forceinline__ void operator()(const f32x4 (&acc)[2][2][4][2], const pg8::Unit& u, int wr, int wc, int fr, int fq) const {
        int pm = u.pm, pn = u.pn; asm volatile("" : "+s"(pm), "+s"(pn), "+s"(wr), "+s"(wc), "+v"(fr), "+v"(fq));
        bf16* tb = H + (size_t)pm * 256 * DFF + pn * 128;
        const unsigned loff = (unsigned)((wr * 64 + fr) * DFF + wc * 32 + 8 * fq);
#pragma unroll
        for (int ai = 0; ai < 2; ++ai)
#pragma unroll
            for (int m = 0; m < 4; ++m) {
                bf16* rowp = tb + (loff + (unsigned)((ai * 128 + m * 16) * DFF));
                const f32x4 g0 = acc[ai][0][m][0], g1 = acc[ai][0][m][1], u0 = acc[ai][1][m][0], u1 = acc[ai][1][m][1];
                v4u w;
                w.x = pg8::cvt_pk_bf16(siluf_(g0[0]) * u0[0], siluf_(g0[1]) * u0[1]); w.y = pg8::cvt_pk_bf16(siluf_(g0[2]) * u0[2], siluf_(g0[3]) * u0[3]);
                w.z = pg8::cvt_pk_bf16(siluf_(g1[0]) * u1[0], siluf_(g1[1]) * u1[1]); w.w = pg8::cvt_pk_bf16(siluf_(g1[2]) * u1[2], siluf_(g1[3]) * u1[3]);
                *(v4u*)rowp = w;
            }
    }
};
struct EpiU {
    static constexpr bool PERM = true, AFTER_DRAIN = false;
    bf16* O; int ldc;
    __device__ __forceinline__ void operator()(const f32x4 (&acc)[2][2][4][2], const pg8::Unit& u, int wr, int wc, int fr, int fq) const {
        int pm = u.pm, pn = u.pn; asm volatile("" : "+s"(pm), "+s"(pn), "+s"(wr), "+s"(wc), "+v"(fr), "+v"(fq));
        bf16* tb = O + (size_t)pm * 256 * ldc + pn * 256;
        const unsigned loff = (unsigned)((wr * 64 + fr) * ldc + wc * 32 + 8 * fq);
#pragma unroll
        for (int ai = 0; ai < 2; ++ai)
#pragma unroll
            for (int m = 0; m < 4; ++m) {
                bf16* rowp = tb + (loff + (unsigned)((ai * 128 + m * 16) * ldc));
#pragma unroll
                for (int bj = 0; bj < 2; ++bj) { const f32x4 v0 = acc[ai][bj][m][0], v1 = acc[ai][bj][m][1]; v4u w;
                    w.x = pg8::cvt_pk_bf16(v0[0], v0[1]); w.y = pg8::cvt_pk_bf16(v0[2], v0[3]); w.z = pg8::cvt_pk_bf16(v1[0], v1[1]); w.w = pg8::cvt_pk_bf16(v1[2], v1[3]);
                    *(v4u*)(rowp + bj * 128) = w; }
            }
    }
};
struct EpiResid {
    static constexpr bool PERM = false, AFTER_DRAIN = false;
    float* xlat; float* xctx; const float* gate; float coef; const float* slat; const float* sctx;
    __device__ __forceinline__ void operator()(const f32x4 (&acc)[2][2][4][2], const pg8::Unit& u, int wr, int wc, int fr, int fq) const {
        int pm = u.pm, pn = u.pn; asm volatile("" : "+s"(pm), "+s"(pn), "+s"(wr), "+s"(wc), "+v"(fr), "+v"(fq));
        const size_t toff = (pm < 64 ? (size_t)pm : (size_t)(pm - 64)) * 256 * DM + pn * 256;
        float* tb = (pm < 64 ? xlat : xctx) + toff; const float* sb = (pm < 64 ? slat : sctx) + toff;
        const float* g = gate + (pm < 64 ? (pm >> 5) : 2) * 9216 + pn * 256;
        const unsigned coff = (unsigned)(wc * 32 + 4 * fq), loff = (unsigned)((wr * 64 + fr) * DM) + coff;
        f32x4 gv[2][2];
#pragma unroll
        for (int bj = 0; bj < 2; ++bj)
#pragma unroll
            for (int n = 0; n < 2; ++n) gv[bj][n] = coef * *(const f32x4*)(g + (coff + (unsigned)(bj * 128 + n * 16)));
#pragma unroll
        for (int ai = 0; ai < 2; ++ai)
#pragma unroll
            for (int m = 0; m < 4; ++m) {
                float* xr = tb + (loff + (unsigned)((ai * 128 + m * 16) * DM)); const float* sr = sb + (loff + (unsigned)((ai * 128 + m * 16) * DM));
#pragma unroll
                for (int bj = 0; bj < 2; ++bj)
#pragma unroll
                    for (int n = 0; n < 2; ++n) { float* xp = xr + (bj * 128 + n * 16);
                        f32x4 xv = *(const f32x4*)(sr + (bj * 128 + n * 16)); xv += gv[bj][n] * acc[ai][bj][m][n]; *(f32x4*)xp = xv; }
                asm volatile("" ::: "memory");
            }
    }
};

__device__ __forceinline__ void phase_modgemv(const Args& a, float* red, int G, int bid, int tid) {
    const float* c = IN(1); const float* cctx = IN(3); const float* ada_w = IN(4); const float* ada_b = IN(5);
    float* mod = (float*)(karg_ws() + OFF_MOD);
    const int w = tid >> 6, lane = tid & 63;
    for (int u = bid; u < 576; u += G) {
        const int l = u / 288, rem = u % 288, jt = rem >> 3, ks = rem & 7;
        const int kb = ks * 128 + w * 16, j0 = jt * 256 + lane * 4;
        f32x4 acc0 = {0.f, 0.f, 0.f, 0.f}, acc1 = acc0, acc2 = acc0;
        for (int kk = 0; kk < 16; ++kk) { const int k = kb + kk;
            const float s0 = siluf_(c[k]), s1 = siluf_(c[1024 + k]), s2 = siluf_(cctx[k]);
            const f32x4 wv = *(const f32x4*)(ada_w + ((size_t)(l * 1024 + k)) * 9216 + j0);
            acc0 += s0 * wv; acc1 += s1 * wv; acc2 += s2 * wv; }
        float* rp = red + (w * 3) * 256 + lane * 4;
        *(f32x4*)rp = acc0; *(f32x4*)(rp + 256) = acc1; *(f32x4*)(rp + 512) = acc2;
        __syncthreads();
        for (int o = tid; o < 768; o += 512) { const int m = o >> 8, jj = o & 255; float s = 0.f;
#pragma unroll
            for (int ww = 0; ww < 8; ++ww) s += red[(ww * 3 + m) * 256 + jj];
            const int j = jt * 256 + jj; if (ks == 0) s += ada_b[l * 9216 + j];
            atomicAdd(&mod[(l * 3 + m) * 9216 + j], s); }
        __syncthreads();
    }
}
__device__ __forceinline__ void phase_copy(const Args& a, int G, int bid, int tid) {
    const f32x4* x4 = (const f32x4*)IN(0); f32x4* o4 = (f32x4*)karg_out();
    for (int i = bid * 512 + tid; i < NLAT * DM / 4; i += G * 512) o4[i] = x4[i];
    const f32x4* c4 = (const f32x4*)IN(2); f32x4* xc4 = (f32x4*)(karg_ws() + OFF_XCTX);
    for (int i = bid * 512 + tid; i < 512 * DM / 4; i += G * 512) xc4[i] = c4[i];
}
__device__ __forceinline__ int swiglu_map(int n) { return n < DFF ? ((n >> 7) * 256 + (n & 127)) : ((((n - DFF) >> 7) * 256) + 128 + ((n - DFF) & 127)); }
__device__ __forceinline__ void transpose_item(const float* W, int K, int N, bf16* WT, float* scr, int item, int lane, int mode, const float* kscale) {
    const int nblk = N / 32, kb = item / nblk, nb = item % nblk, k0 = 64 * kb, n0 = 32 * nb;
    float tv[32];
#pragma unroll
    for (int i = 0; i < 32; ++i) { const int kk = 2 * i + (lane >> 5); tv[i] = W[(size_t)(k0 + kk) * N + n0 + (lane & 31)]; }
#pragma unroll
    for (int i = 0; i < 32; ++i) { const int kk = 2 * i + (lane >> 5); float v = tv[i]; if (kscale) v *= kscale[k0 + kk]; scr[kk * 33 + (lane & 31)] = v; }
    __builtin_amdgcn_wave_barrier();
    const int c = lane & 7;
#pragma unroll
    for (int j = 0; j < 4; ++j) { const int n = (lane >> 3) + 8 * j; const float* s = scr + (8 * c) * 33 + n;
        v4u o; o.x = pk2(s[0 * 33], s[1 * 33]); o.y = pk2(s[2 * 33], s[3 * 33]); o.z = pk2(s[4 * 33], s[5 * 33]); o.w = pk2(s[6 * 33], s[7 * 33]);
        const int nn = n0 + n, drow = mode ? swiglu_map(nn) : nn;
        *(v4u*)(WT + (size_t)drow * K + k0 + 8 * c) = o; }
    __builtin_amdgcn_wave_barrier();
}
__device__ __forceinline__ void convert_weights(const Args& a, int l, float* scr, int gw, int NGW, int lane, int G, int bid, int tid) {
    constexpr int I13 = 16 * 176, I2 = 44 * 32, IIN = 16 * 77, IOUT = 16 * 32, IUQ = 4 * 12, IUKV = 2 * 16;
    constexpr int IEX = 80;
    constexpr int NIT = 2 * I13 + 2 * I2 + IIN + IOUT + IUQ + IUKV + IEX;
    unsigned char* ws = karg_ws();
    for (int it = gw; it < NIT; it += NGW) {
        int r = it;
        if (r < I13) { transpose_item(IN(6) + (size_t)l * DM * 2 * DFF, DM, 2 * DFF, (bf16*)(ws + W_13A), scr, r, lane, 1, nullptr); continue; } r -= I13;
        if (r < I13) { transpose_item(IN(8) + (size_t)l * DM * 2 * DFF, DM, 2 * DFF, (bf16*)(ws + W_13B), scr, r, lane, 1, nullptr); continue; } r -= I13;
        if (r < I2) { transpose_item(IN(7) + (size_t)l * DFF * DM, DFF, DM, (bf16*)(ws + W_2A), scr, r, lane, 0, nullptr); continue; } r -= I2;
        if (r < I2) { transpose_item(IN(9) + (size_t)l * DFF * DM, DFF, DM, (bf16*)(ws + W_2B), scr, r, lane, 0, nullptr); continue; } r -= I2;
        if (r < IIN) { transpose_item(IN(10) + (size_t)l * DM * 2464, DM, 2464, (bf16*)(ws + W_IN), scr, r, lane, 0, nullptr); continue; } r -= IIN;
        if (r < IOUT) { transpose_item(IN(11) + (size_t)l * DM * DM, DM, DM, (bf16*)(ws + W_OUT), scr, r, lane, 0, nullptr); continue; } r -= IOUT;
        if (r < IUQ) { transpose_item(IN(36) + (size_t)l * 256 * 384, 256, 384, (bf16*)(ws + W_UQ), scr, r, lane, 0, IN(35) + l * 256); continue; } r -= IUQ;
        if (r < IUKV) { transpose_item(IN(38) + (size_t)l * 128 * 512, 128, 512, (bf16*)(ws + W_UKV), scr, r, lane, 0, IN(37) + l * 128); continue; } r -= IUKV;
        if (r < 16) { const int d = r >> 3; transpose_item(IN(26) + (size_t)(l * 2 + d) * 64 * 256, 64, 256, (bf16*)(ws + W_WUP) + d * 256 * 64, scr, r & 7, lane, 0, nullptr); continue; } r -= 16;
        if (r < 16) { const int d = r >> 3; transpose_item(IN(28) + (size_t)(l * 2 + d) * 64 * 256, 64, 256, (bf16*)(ws + W_AUP) + d * 256 * 64, scr, r & 7, lane, 0, nullptr); continue; } r -= 16;
        if (r < 16) { transpose_item(IN(29) + (size_t)l * 128 * 256, 128, 256, (bf16*)(ws + W_GUP), scr, r, lane, 0, nullptr); continue; } r -= 16;
        if (r < 16) { const int m = r >> 1; transpose_item(IN(18) + (size_t)(l * 8 + m) * 4096, 64, 64, (bf16*)(ws + W_LWA) + m * 4096, scr, r & 1, lane, 0, nullptr); continue; } r -= 16;
        { const int m = r >> 1; transpose_item(IN(20) + (size_t)(l * 8 + m) * 4096, 64, 64, (bf16*)(ws + W_LWX) + m * 4096, scr, r & 1, lane, 0, nullptr); }
    }
    v4u z = {0u, 0u, 0u, 0u}; v4u* zp = (v4u*)(ws + W_IN + (size_t)2464 * DM * 2);
    for (int i = bid * 512 + tid; i < 96 * DM * 2 / 16; i += G * 512) zp[i] = z;
}
__device__ __forceinline__ void phase_modulate(const Args& a, int l, int which, int gw, int NGW, int lane) {
    unsigned char* ws = karg_ws(); const float* outp = karg_out();
    const bool first = (l == 0 && which == 0);
    const float* srcl = first ? IN(0) : outp; const float* srcc = first ? IN(2) : (const float*)(ws + OFF_XCTX);
    const float* mod = (const float*)(ws + OFF_MOD) + (size_t)l * 3 * 9216;
    bf16* XM = (bf16*)(ws + OFF_XMY);
    for (int r = gw; r < NR; r += NGW) {
        const float* xr = r < NLAT ? srcl + (size_t)r * DM : srcc + (size_t)(r - NLAT) * DM;
        const float* mm = mod + (r < NLAT ? (r >> 13) : 2) * 9216 + which * 3 * 1024;
        f32x4 v[4]; float ss = 0.f;
#pragma unroll
        for (int j = 0; j < 4; ++j) { v[j] = *(const f32x4*)(xr + 4 * lane + 256 * j); ss += (v[j][0] * v[j][0] + v[j][1] * v[j][1]) + (v[j][2] * v[j][2] + v[j][3] * v[j][3]); }
        const float rstd = rsqrtf(wave_sum(ss) * (1.f / DM) + 1e-6f);
#pragma unroll
        for (int j = 0; j < 4; ++j) { const int c = 4 * lane + 256 * j; const f32x4 sh = *(const f32x4*)(mm + c), sc = *(const f32x4*)(mm + 1024 + c);
            const f32x4 o = v[j] * rstd * (1.f + sc) + sh; v2u w; w.x = pk2(o[0], o[1]); w.y = pk2(o[2], o[3]);
            *(v2u*)(XM + (size_t)r * DM + c) = w; }
    }
}
__device__ __forceinline__ void phase_final(const Args& a, int gw, int NGW, int lane) {
    const float* fn = IN(39); float* outp = karg_out();
    for (int r = gw; r < NLAT; r += NGW) {
        float* xr = outp + (size_t)r * DM; f32x4 v[4]; float ss = 0.f;
#pragma unroll
        for (int j = 0; j < 4; ++j) { v[j] = *(const f32x4*)(xr + 4 * lane + 256 * j); ss += (v[j][0] * v[j][0] + v[j][1] * v[j][1]) + (v[j][2] * v[j][2] + v[j][3] * v[j][3]); }
        const float rstd = rsqrtf(wave_sum(ss) * (1.f / DM) + 1e-6f);
#pragma unroll
        for (int j = 0; j < 4; ++j) { const int c = 4 * lane + 256 * j; const f32x4 g = *(const f32x4*)(fn + c); *(f32x4*)(xr + c) = v[j] * rstd * g; }
    }
}

__device__ __forceinline__ void phase_m1(const Args& a, int l, unsigned char* lds, int G, int bid, int tid_unused) {
    unsigned char* ws = karg_ws();
    const bf16* U = (const bf16*)(ws + OFF_HU);
    bf16* Y = (bf16*)(ws + OFF_XMY);
    for (int pass = 0; pass < 2; ++pass)
    for (int tile = (pass == 0 ? bid : (bid < 48 ? 512 + bid / 3 : NTILE)); tile < (pass == 0 ? 512 : NTILE); tile += (pass == 0 ? G : NTILE)) {
        const int mask = pass == 0 ? 7 : ((1 << (bid % 3)) & (l == 1 ? 6 : 7));
        const TileInfo ti = tile_info(tile);
        const int row0 = tile * 32;
        if (mask & 1) {
            const int tid = ltid(); const int lane = tid & 63, wave = __builtin_amdgcn_readfirstlane(tid >> 6), ch = tid & 255, part = tid >> 8; (void)lane; (void)wave; (void)ch; (void)part;
            float* z = (float*)lds;
            float* cv = (float*)(lds + 65536);
            for (int tt = part; tt < 62; tt += 2) { const int t = ti.t0 - 15 + tt; float zz = 0.f;
                if (t >= 0 && t < ti.seqlen) { const bf16* ur = U + (size_t)(ti.seqbase + t) * UC; zz = bf2f(ur[ch]) * sigm(bf2f(ur[256 + ch])); }
                z[tt * 256 + ch] = zz; }
            __syncthreads();
            const float* dw = IN(12) + (size_t)l * 31 * 256 + ch;
            float acc[16]; const float bias = IN(13)[l * 256 + ch];
#pragma unroll
            for (int o = 0; o < 16; ++o) acc[o] = bias;
            for (int j = 0; j < 31; ++j) { const float w = dw[j * 256];
#pragma unroll
                for (int o = 0; o < 16; ++o) acc[o] += w * z[(part * 16 + o + j) * 256 + ch]; }
#pragma unroll
            for (int o = 0; o < 16; ++o) cv[(part * 16 + o) * 256 + ch] = acc[o];
            __syncthreads();
            const f32x4 lg = *(const f32x4*)(IN(14) + l * 256 + lane * 4), lb = *(const f32x4*)(IN(15) + l * 256 + lane * 4);
#pragma unroll
            for (int q = 0; q < 4; ++q) { const int t = wave * 4 + q; const f32x4 v = *(const f32x4*)(cv + t * 256 + lane * 4);
                const float mu = wave_sum((v[0] + v[1]) + (v[2] + v[3])) * (1.f / 256.f);
                const f32x4 dv = v - mu; const float var = wave_sum((dv[0] * dv[0] + dv[1] * dv[1]) + (dv[2] * dv[2] + dv[3] * dv[3])) * (1.f / 256.f);
                const f32x4 yn = dv * rsqrtf(var + 1e-5f) * lg + lb;
                v2u w; w.x = pk2(siluf_(yn[0]), siluf_(yn[1])); w.y = pk2(siluf_(yn[2]), siluf_(yn[3]));
                *(v2u*)(Y + (size_t)(row0 + t) * DM + lane * 4) = w; }
            __syncthreads();
        }
        if (mask & 2) {
            float* xvf = (float*)lds;
            bf16* xvb = (bf16*)(lds + 32768);
            bf16* rg = (bf16*)(lds + 49664);
            bf16* ixg = (bf16*)(lds + 82432);
            {
                const int tid = ltid(); const int ch = tid & 255, part = tid >> 8;
                const float* cw = IN(16) + (size_t)l * 4 * 256 + ch; const float w0 = cw[0], w1 = cw[256], w2 = cw[512], w3 = cw[768], cb = IN(17)[l * 256 + ch];
                float xin[19];
#pragma unroll
                for (int i = 0; i < 19; ++i) { const int t = ti.t0 + part * 16 + i - 2; xin[i] = (t >= 0 && t < ti.seqlen) ? bf2f(U[(size_t)(ti.seqbase + t) * UC + 512 + ch]) : 0.f; }
#pragma unroll
                for (int o = 0; o < 16; ++o) { const int tl = part * 16 + o;
                    const float v = cb + w0 * xin[o] + w1 * xin[o + 1] + w2 * xin[o + 2] + w3 * xin[o + 3];
                    xvf[tl * 256 + ch] = v; xvb[tl * 264 + ch] = (bf16)f2bf(v);
                }
            }
            __syncthreads();
            {
                const int tid = ltid(); const int ln = tid & 63, wv = __builtin_amdgcn_readfirstlane(tid >> 6), fr = ln & 15, fq = ln >> 4, blk = wv >> 1;
                const bf16* LWAt = (const bf16*)(ws + W_LWA); const bf16* LWXt = (const bf16*)(ws + W_LWX);
                bf16x8 af[2][2];
#pragma unroll
                for (int mt = 0; mt < 2; ++mt)
#pragma unroll
                    for (int ks = 0; ks < 2; ++ks) af[mt][ks] = *(const bf16x8*)(xvb + (mt * 16 + fr) * 264 + blk * 64 + ks * 32 + fq * 8);
#pragma unroll
                for (int dn = 0; dn < 4; ++dn) { const int d = dn >> 1, nt = wv * 2 + (dn & 1), ch = nt * 16 + fr, jj = (nt & 3) * 16 + fr;
                    f32x4 ca[2], cx[2];
#pragma unroll
                    for (int mt = 0; mt < 2; ++mt) { ca[mt] = (f32x4){0.f, 0.f, 0.f, 0.f}; cx[mt] = ca[mt]; }
#pragma unroll
                    for (int ks = 0; ks < 2; ++ks) { const size_t wo = ((size_t)(d * 4 + blk) * 64 + jj) * 64 + ks * 32 + fq * 8;
                        const bf16x8 ba = *(const bf16x8*)(LWAt + wo), bx = *(const bf16x8*)(LWXt + wo);
#pragma unroll
                        for (int mt = 0; mt < 2; ++mt) { ca[mt] = __builtin_amdgcn_mfma_f32_16x16x32_bf16(af[mt][ks], ba, ca[mt], 0, 0, 0); cx[mt] = __builtin_amdgcn_mfma_f32_16x16x32_bf16(af[mt][ks], bx, cx[mt], 0, 0, 0); } }
                    const float bga = IN(19)[(l * 2 + d) * 256 + ch], bgx = IN(21)[(l * 2 + d) * 256 + ch];
                    bf16* LR = (bf16*)(ws + M_LR0 + (size_t)d * A8); bf16* LIX = (bf16*)(ws + M_LIX0 + (size_t)d * A8);
#pragma unroll
                    for (int mt = 0; mt < 2; ++mt)
#pragma unroll
                        for (int j = 0; j < 4; ++j) { const int t = mt * 16 + fq * 4 + j;
                            const bf16 rb = (bf16)f2bf(sigm(ca[mt][j] + bga)), ib = (bf16)f2bf(sigm(cx[mt][j] + bgx) * xvf[t * 256 + ch]);
                            LR[(size_t)(row0 + t) * 256 + ch] = rb; LIX[(size_t)(row0 + t) * 256 + ch] = ib;
                            rg[(d * 32 + t) * 256 + ch] = rb; ixg[(d * 32 + t) * 256 + ch] = ib; }
                }
            }
            __syncthreads();
            {
                const int tid = ltid(); const int ch = tid & 255, d = tid >> 8;
                const float lam = IN(22)[(l * 2 + d) * 256 + ch];
                const float cch = -8.f * log1pf(__expf(-lam));
                float A = 1.f, B = 0.f;
#pragma unroll 8
                for (int tt = 0; tt < 32; ++tt) { const int t = d ? 31 - tt : tt;
                    const float al = __expf(cch * bf2f(rg[(d * 32 + t) * 256 + ch])); const float bb = __builtin_amdgcn_sqrtf(fmaxf(1.f - al * al, 0.f)) * bf2f(ixg[(d * 32 + t) * 256 + ch]); B = al * B + bb; A *= al; }
                ((float*)(ws + M_SEGA))[(size_t)(tile * 2 + d) * 256 + ch] = A;
                ((float*)(ws + M_SEGB))[(size_t)(tile * 2 + d) * 256 + ch] = B;
            }
            __syncthreads();
        }
        if (mask & 4) {
            const int tid = ltid(); const int lane = tid & 63, wave = __builtin_amdgcn_readfirstlane(tid >> 6), ch = tid & 255, part = tid >> 8; (void)lane; (void)wave; (void)ch; (void)part;
            bf16* As = (bf16*)lds;
            float* kr = (float*)(lds + 32768);
            float* rs = (float*)(lds + 32768 + 4096);
            for (int idx = tid; idx < 32 * 52; idx += 512) { const int t = idx / 52, cc = idx % 52;
                const v4u v = *(const v4u*)(U + (size_t)(row0 + t) * UC + 2048 + cc * 8);
                if (cc < 48) *(v4u*)(As + t * 392 + cc * 8) = v;
                else { const int c0 = (cc - 48) * 8; float* kp = kr + t * 32 + c0;
                    kp[0] = __uint_as_float(v.x << 16); kp[1] = __uint_as_float(v.x & 0xffff0000u); kp[2] = __uint_as_float(v.y << 16); kp[3] = __uint_as_float(v.y & 0xffff0000u);
                    kp[4] = __uint_as_float(v.z << 16); kp[5] = __uint_as_float(v.z & 0xffff0000u); kp[6] = __uint_as_float(v.w << 16); kp[7] = __uint_as_float(v.w & 0xffff0000u); } }
            __syncthreads();
#pragma unroll
            for (int q = 0; q < 4; ++q) { const int t = wave * 4 + q; float sq = 0.f, sk = 0.f;
#pragma unroll
                for (int j = 0; j < 4; ++j) { const float v = bf2f(As[t * 392 + lane + 64 * j]); sq += v * v; }
#pragma unroll
                for (int j = 0; j < 2; ++j) { const float v = bf2f(As[t * 392 + 256 + lane + 64 * j]); sk += v * v; }
                sq = wave_sum(sq); sk = wave_sum(sk);
                if (lane == 0) { rs[t * 2] = rsqrtf(sq * (1.f / 256.f) + 1e-6f); rs[t * 2 + 1] = rsqrtf(sk * (1.f / 128.f) + 1e-6f); } }
            __syncthreads();
            const int fr = lane & 15, fq = lane >> 4;
            bf16* QB = (bf16*)(ws + M_QB); bf16* KB = (bf16*)(ws + M_KB); bf16* VT = (bf16*)(ws + M_VT);
            const bf16* WUQ = (const bf16*)(ws + W_UQ); const bf16* WUKV = (const bf16*)(ws + W_UKV);
            const int keybase = ti.isctx ? TLEN : 0;
#pragma unroll
            for (int i = 0; i < 3; ++i) { const int nt = wave * 3 + i;
                f32x4 c0 = {0.f, 0.f, 0.f, 0.f}, c1 = c0;
#pragma unroll
                for (int ks = 0; ks < 8; ++ks) { const bf16x8 bfr = *(const bf16x8*)(WUQ + (size_t)(nt * 16 + fr) * 256 + ks * 32 + fq * 8);
                    const bf16x8 a0 = *(const bf16x8*)(As + fr * 392 + ks * 32 + fq * 8), a1 = *(const bf16x8*)(As + (16 + fr) * 392 + ks * 32 + fq * 8);
                    c0 = __builtin_amdgcn_mfma_f32_16x16x32_bf16(a0, bfr, c0, 0, 0, 0); c1 = __builtin_amdgcn_mfma_f32_16x16x32_bf16(a1, bfr, c1, 0, 0, 0); }
                const int hq = nt / 6, wt = nt % 6, dd = wt * 16 + fr;
#pragma unroll
                for (int mt = 0; mt < 2; ++mt)
#pragma unroll
                    for (int j = 0; j < 4; ++j) { const int tl = mt * 16 + fq * 4 + j; const int t = ti.t0 + tl;
                        float v = (mt ? c1[j] : c0[j]) * rs[tl * 2];
                        const float pv = dppf<0x128>(v);
                        if (wt >= 4 && !ti.isctx) { const int f = fr & 7; const float pos = (wt == 4) ? (float)(t >> 6) : (float)(t & 63);
                            const float ang = pos * __expf(-(float)f * (9.210340371976184f / 8.f)); float sn, cs; __sincosf(ang, &sn, &cs);
                            v = (fr & 8) ? (v * cs + pv * sn) : (v * cs - pv * sn); }
                        QB[((size_t)(ti.b * 4 + hq) * TT + keybase + t) * 96 + dd] = (bf16)f2bf(v * QSCALE); } }
#pragma unroll
            for (int i = 0; i < 4; ++i) { const int nt = wave * 4 + i;
                f32x4 c0 = {0.f, 0.f, 0.f, 0.f}, c1 = c0;
#pragma unroll
                for (int ks = 0; ks < 4; ++ks) { const bf16x8 bfr = *(const bf16x8*)(WUKV + (size_t)(nt * 16 + fr) * 128 + ks * 32 + fq * 8);
                    const bf16x8 a0 = *(const bf16x8*)(As + fr * 392 + 256 + ks * 32 + fq * 8), a1 = *(const bf16x8*)(As + (16 + fr) * 392 + 256 + ks * 32 + fq * 8);
                    c0 = __builtin_amdgcn_mfma_f32_16x16x32_bf16(a0, bfr, c0, 0, 0, 0); c1 = __builtin_amdgcn_mfma_f32_16x16x32_bf16(a1, bfr, c1, 0, 0, 0); }
                const int hk = nt >> 3, wt = nt & 7;
#pragma unroll
                for (int mt = 0; mt < 2; ++mt) { float vv[4];
#pragma unroll
                    for (int j = 0; j < 4; ++j) { const int tl = mt * 16 + fq * 4 + j; vv[j] = (mt ? c1[j] : c0[j]) * rs[tl * 2 + 1]; }
                    const int key0 = keybase + ti.t0 + mt * 16 + fq * 4;
                    if (wt < 4) {
#pragma unroll
                        for (int j = 0; j < 4; ++j) KB[((size_t)(ti.b * 4 + hk) * TT + key0 + j) * 96 + wt * 16 + fr] = (bf16)f2bf(vv[j]); }
                    else { v2u w; w.x = pk2(vv[0], vv[1]); w.y = pk2(vv[2], vv[3]);
                        *(v2u*)(VT + ((size_t)(ti.b * 4 + hk) * 64 + (wt - 4) * 16 + fr) * TT + key0) = w; } } }
            { const int tl = tid >> 4, p = tid & 15, ax = p >> 3, f = p & 7; const int t = ti.t0 + tl;
                float x0 = kr[tl * 32 + ax * 16 + f], x1 = kr[tl * 32 + ax * 16 + 8 + f];
                if (!ti.isctx) { const float pos = ax == 0 ? (float)(t >> 6) : (float)(t & 63); const float ang = pos * __expf(-(float)f * (9.210340371976184f / 8.f));
                    float sn, cs; __sincosf(ang, &sn, &cs); const float y0 = x0 * cs - x1 * sn, y1 = x1 * cs + x0 * sn; x0 = y0; x1 = y1; }
                const bf16 b0 = (bf16)f2bf(x0), b1 = (bf16)f2bf(x1);
#pragma unroll
                for (int h = 0; h < 4; ++h) { bf16* kp = KB + ((size_t)(ti.b * 4 + h) * TT + keybase + t) * 96 + 64 + ax * 16 + f; kp[0] = b0; kp[8] = b1; } }
            __syncthreads();
        }
    }
}

__device__ __forceinline__ void attn_unit(unsigned char* lds, const bf16* QB, const bf16* KB, const bf16* VT, bf16* Y, int b, int h, int q0, int key_lo, int nkt, int tid) {
    const int lane = tid & 63, wave = tid >> 6, fr = lane & 15, fq = lane >> 4;
    const int bh = b * 4 + h;
    constexpr int KSTR = 104, VSTR = 72, KBUF = 64 * KSTR, VBUF = 64 * VSTR;
    bf16* Ks = (bf16*)lds;
    bf16* Vs = (bf16*)lds + 2 * KBUF;
    const int qw = q0 + wave * 32;
    bf16x8 qf[2][3];
#pragma unroll
    for (int qt = 0; qt < 2; ++qt)
#pragma unroll
        for (int ks = 0; ks < 3; ++ks) qf[qt][ks] = *(const bf16x8*)(QB + ((size_t)bh * TT + qw + qt * 16 + fr) * 96 + ks * 32 + fq * 8);
    float mrun[2] = {-1e30f, -1e30f}, lrun[2] = {0.f, 0.f};
    f32x4 o[4][2];
#pragma unroll
    for (int dt = 0; dt < 4; ++dt)
#pragma unroll
        for (int qt = 0; qt < 2; ++qt) o[dt][qt] = (f32x4){0.f, 0.f, 0.f, 0.f};
    const v4u* kg = (const v4u*)(KB + ((size_t)bh * TT + key_lo) * 96);
    const bf16* vg = VT + ((size_t)bh * 64 + (tid >> 3)) * TT + key_lo + (tid & 7) * 8;
    const int kc0 = tid, kc1 = 512 + tid;
    const int ko0 = (kc0 / 12) * KSTR + (kc0 % 12) * 8, ko1 = (kc1 / 12) * KSTR + (kc1 % 12) * 8, vo = (tid >> 3) * VSTR + (tid & 7) * 8;
    v4u rk0, rk1 = {0u, 0u, 0u, 0u}, rv;
    rk0 = kg[kc0]; if (tid < 256) rk1 = kg[kc1]; rv = *(const v4u*)vg;
    *(v4u*)(Ks + ko0) = rk0; if (tid < 256) *(v4u*)(Ks + ko1) = rk1; *(v4u*)(Vs + vo) = rv;
    __syncthreads();
    for (int kt = 0; kt < nkt; ++kt) {
        const int cur = kt & 1;
        if (kt + 1 < nkt) { const v4u* kn = kg + (size_t)(kt + 1) * 768; rk0 = kn[kc0]; if (tid < 256) rk1 = kn[kc1]; rv = *(const v4u*)(vg + (kt + 1) * 64); }
        const bf16* kb = Ks + cur * KBUF; const bf16* vb = Vs + cur * VBUF;
        f32x4 st[4][2];
        __builtin_amdgcn_s_setprio(1);
#pragma unroll
        for (int k4 = 0; k4 < 4; ++k4) {
            st[k4][0] = (f32x4){0.f, 0.f, 0.f, 0.f}; st[k4][1] = st[k4][0];
#pragma unroll
            for (int ks = 0; ks < 3; ++ks) { const bf16x8 kf = *(const bf16x8*)(kb + (k4 * 16 + fr) * KSTR + ks * 32 + fq * 8);
                st[k4][0] = __builtin_amdgcn_mfma_f32_16x16x32_bf16(kf, qf[0][ks], st[k4][0], 0, 0, 0);
                st[k4][1] = __builtin_amdgcn_mfma_f32_16x16x32_bf16(kf, qf[1][ks], st[k4][1], 0, 0, 0); }
        }
        __builtin_amdgcn_s_setprio(0);
        bf16x8 pb[2][2];
#pragma unroll
        for (int qt = 0; qt < 2; ++qt) {
            float mx = st[0][qt][0];
#pragma unroll
            for (int k4 = 0; k4 < 4; ++k4)
#pragma unroll
                for (int j = 0; j < 4; ++j) mx = fmaxf(mx, st[k4][qt][j]);
            mx = rows4_max(mx);
            const float mn = fmaxf(mrun[qt], mx), alpha = __builtin_amdgcn_exp2f(mrun[qt] - mn); mrun[qt] = mn;
            float ls = 0.f;
#pragma unroll
            for (int k4 = 0; k4 < 4; ++k4)
#pragma unroll
                for (int j = 0; j < 4; ++j) { const float p = __builtin_amdgcn_exp2f(st[k4][qt][j] - mn); st[k4][qt][j] = p; ls += p; }
            lrun[qt] = lrun[qt] * alpha + ls;
#pragma unroll
            for (int dt = 0; dt < 4; ++dt) o[dt][qt] *= alpha;
#pragma unroll
            for (int u = 0; u < 2; ++u) { v4u w;
                w.x = pg8::cvt_pk_bf16(st[2 * u][qt][0], st[2 * u][qt][1]); w.y = pg8::cvt_pk_bf16(st[2 * u][qt][2], st[2 * u][qt][3]);
                w.z = pg8::cvt_pk_bf16(st[2 * u + 1][qt][0], st[2 * u + 1][qt][1]); w.w = pg8::cvt_pk_bf16(st[2 * u + 1][qt][2], st[2 * u + 1][qt][3]);
                pb[u][qt] = __builtin_bit_cast(bf16x8, w); }
        }
#pragma unroll
        for (int dt = 0; dt < 4; ++dt)
#pragma unroll
            for (int u = 0; u < 2; ++u) {
                const v2u lo = *(const v2u*)(vb + (dt * 16 + fr) * VSTR + 32 * u + 4 * fq), hi = *(const v2u*)(vb + (dt * 16 + fr) * VSTR + 32 * u + 16 + 4 * fq);
                v4u vw; vw.x = lo.x; vw.y = lo.y; vw.z = hi.x; vw.w = hi.y;
                const bf16x8 va = __builtin_bit_cast(bf16x8, vw);
                o[dt][0] = __builtin_amdgcn_mfma_f32_16x16x32_bf16(va, pb[u][0], o[dt][0], 0, 0, 0);
                o[dt][1] = __builtin_amdgcn_mfma_f32_16x16x32_bf16(va, pb[u][1], o[dt][1], 0, 0, 0);
            }
        if (kt + 1 < nkt) { const int nb = cur ^ 1; *(v4u*)(Ks + nb * KBUF + ko0) = rk0; if (tid < 256) *(v4u*)(Ks + nb * KBUF + ko1) = rk1; *(v4u*)(Vs + nb * VBUF + vo) = rv; }
        __syncthreads();
    }
#pragma unroll
    for (int qt = 0; qt < 2; ++qt) {
        const float lt = rows4_sum(lrun[qt]);
        const float inv = 1.f / lt;
        const int q = qw + qt * 16 + fr;
        const size_t row = q < TLEN ? (size_t)b * TLEN + q : (size_t)NLAT + b * CTXL + (q - TLEN);
#pragma unroll
        for (int dt = 0; dt < 4; ++dt) { const f32x4 v = o[dt][qt] * inv; v2u w; w.x = pk2(v[0], v[1]); w.y = pk2(v[2], v[3]);
            *(v2u*)(Y + row * DM + 768 + h * 64 + dt * 16 + fq * 4) = w; }
    }
}
__device__ __forceinline__ void lru_prefix(int bd, int tid) {
    unsigned char* ws = karg_ws();
    if (tid >= 256) return;
    const int ch = tid, b = bd >> 1, d = bd & 1;
    const float* __restrict__ SA = (const float*)(ws + M_SEGA); const float* __restrict__ SB = (const float*)(ws + M_SEGB); float* __restrict__ H0 = (float*)(ws + M_H0);
    const int ctile0 = 512 + b * 8, ltile0 = b * 256;
#define LRU_TILE(i_) ((i_) < 8 ? ctile0 + (d ? 7 - (i_) : (i_)) : ltile0 + (d ? 255 - ((i_) - 8) : ((i_) - 8)))
    float hst = 0.f;
    float ca[24], cb[24], na[24], nb[24];
#pragma unroll
    for (int k = 0; k < 24; ++k) { const size_t o = (size_t)(LRU_TILE(k) * 2 + d) * 256 + ch; ca[k] = SA[o]; cb[k] = SB[o]; }
    for (int i0 = 0; i0 < 264; i0 += 24) {
        if (i0 + 24 < 264) {
#pragma unroll
            for (int k = 0; k < 24; ++k) { const size_t o = (size_t)(LRU_TILE(i0 + 24 + k) * 2 + d) * 256 + ch; na[k] = SA[o]; nb[k] = SB[o]; } }
        float hv[24];
#pragma unroll
        for (int k = 0; k < 24; ++k) { hv[k] = hst; hst = ca[k] * hst + cb[k]; }
#pragma unroll
        for (int k = 0; k < 24; ++k) H0[(size_t)(LRU_TILE(i0 + k) * 2 + d) * 256 + ch] = hv[k];
#pragma unroll
        for (int k = 0; k < 24; ++k) { ca[k] = na[k]; cb[k] = nb[k]; }
    }
#undef LRU_TILE
}
__device__ __forceinline__ void lru_rescan(const Args& a, int l, unsigned char* lds, int tile, int tid) {
    unsigned char* ws = karg_ws();
    const int ch = tid & 255, d = tid >> 8;
    const int row0 = tile * 32;
    float hst = ((const float*)(ws + M_H0))[(size_t)(tile * 2 + d) * 256 + ch];
    const float lam = IN(22)[(l * 2 + d) * 256 + ch];
    const float cch = -8.f * log1pf(__expf(-lam));
    const bf16* LR = (const bf16*)(ws + M_LR0 + (size_t)d * A8); const bf16* LIX = (const bf16*)(ws + M_LIX0 + (size_t)d * A8);
    float* hs = (float*)lds;
#pragma unroll 16
    for (int tt = 0; tt < 32; ++tt) { const int t = d ? 31 - tt : tt; const size_t o = (size_t)(row0 + t) * 256 + ch;
        const float al = __expf(cch * bf2f(LR[o])); const float bb = __builtin_amdgcn_sqrtf(fmaxf(1.f - al * al, 0.f)) * bf2f(LIX[o]);
        hst = al * hst + bb; hs[(d * 32 + t) * 256 + ch] = hst; }
    __syncthreads();
    const bf16* U = (const bf16*)(ws + OFF_HU); bf16* Y = (bf16*)(ws + OFF_XMY);
#pragma unroll 8
    for (int tt = 0; tt < 16; ++tt) { const int t = d * 16 + tt;
        const float y = (hs[t * 256 + ch] + hs[(32 + t) * 256 + ch]) * geluf_(bf2f(U[(size_t)(row0 + t) * UC + 768 + ch]));
        Y[(size_t)(row0 + t) * DM + 256 + ch] = (bf16)f2bf(y); }
    __syncthreads();
}
__device__ __forceinline__ void phase_m2(const Args& a, int l, unsigned char* lds, int G, int bid, int tid) {
    unsigned char* ws = karg_ws();
    const bf16* QB = (const bf16*)(ws + M_QB); const bf16* KB = (const bf16*)(ws + M_KB); const bf16* VT = (const bf16*)(ws + M_VT);
    bf16* Y = (bf16*)(ws + OFF_XMY);
    const int nunits = (l == 0) ? 264 : 256;
    for (int u = bid; u < nunits; u += G) {
        if (u < 256) attn_unit(lds, QB, KB, VT, Y, u >> 7, (u >> 5) & 3, (u & 31) * 256, 0, 132, tid);
        else attn_unit(lds, QB, KB, VT, Y, (u - 256) >> 2, (u - 256) & 3, TLEN, TLEN, 4, tid);
    }
    if (bid >= G - 4) lru_prefix(bid - (G - 4), tid);
}

__device__ __forceinline__ void phase_m3(const Args& a, int l, unsigned char* lds, int G, int bid, int tid) {
    unsigned char* ws = karg_ws();
    const bf16* U = (const bf16*)(ws + OFF_HU);
    const int lane = tid & 63, ch = tid & 255, part = tid >> 8;
    const float* mup = IN(23) + l * 1024; const float* mun = IN(24) + l * 1024;
    bf16* RR = (bf16*)(ws + M_RR); bf16* KKo = (bf16*)(ws + M_KK); bf16* VV = (bf16*)(ws + M_VV); bf16* GC = (bf16*)(ws + M_GC);
    float* kl = (float*)lds;
    float* kkn = (float*)(lds + 32768);
    bf16* twb = (bf16*)(lds + 65536);
    bf16* tab = (bf16*)(lds + 70144);
    bf16* tgb = (bf16*)(lds + 74752);
    for (int pass = 0; pass < 2; ++pass)
    for (int tile = (pass == 0 ? bid : (bid < 48 ? 512 + bid / 3 : NTILE)); tile < (pass == 0 ? 512 : NTILE); tile += (pass == 0 ? G : NTILE)) {
        const int mask = pass == 0 ? 7 : ((1 << (bid % 3)) & (l == 1 ? 6 : 7));
        const TileInfo ti = tile_info(tile);
        const int row0 = tile * 32;
        if (mask & 1) lru_rescan(a, l, lds, tile, ltid());
        if (mask & 6) {
        {
            const int tid2 = ltid(); const int chunk = tid2 & 127, tg8 = tid2 >> 7, c0 = chunk * 8;
            const bf16* ub = U + (size_t)row0 * UC + 1024 + c0;
            v4u rw[10];
#pragma unroll
            for (int q = 0; q < 10; ++q) { const int tl = tg8 * 8 + q - 1; const int t = ti.t0 + tl;
                rw[q] = (t >= 0 && t < ti.seqlen) ? *(const v4u*)(ub + (ptrdiff_t)tl * UC) : (v4u){0u, 0u, 0u, 0u}; }
            const f32x4 mp0 = *(const f32x4*)(mup + c0), mp1 = *(const f32x4*)(mup + c0 + 4), mn0 = *(const f32x4*)(mun + c0), mn1 = *(const f32x4*)(mun + c0 + 4);
            const float mp[8] = {mp0[0], mp0[1], mp0[2], mp0[3], mp1[0], mp1[1], mp1[2], mp1[3]}, mn[8] = {mn0[0], mn0[1], mn0[2], mn0[3], mn1[0], mn1[1], mn1[2], mn1[3]};
#pragma unroll
            for (int q = 0; q < 8; ++q) { const int tl = tg8 * 8 + q; float ts[8];
#pragma unroll
                for (int e = 0; e < 8; ++e) { const unsigned wm = rw[q][e >> 1], w0 = rw[q + 1][e >> 1], wn = rw[q + 2][e >> 1];
                    const float um = (e & 1) ? __uint_as_float(wm & 0xffff0000u) : __uint_as_float(wm << 16);
                    const float u0 = (e & 1) ? __uint_as_float(w0 & 0xffff0000u) : __uint_as_float(w0 << 16);
                    const float un = (e & 1) ? __uint_as_float(wn & 0xffff0000u) : __uint_as_float(wn << 16);
                    ts[e] = u0 + mp[e] * (um - u0) + mn[e] * (un - u0); }
                if (chunk >= 32 && chunk < 64) { float* kp = kl + tl * 256 + (c0 - 256); *(f32x4*)kp = (f32x4){ts[0], ts[1], ts[2], ts[3]}; *(f32x4*)(kp + 4) = (f32x4){ts[4], ts[5], ts[6], ts[7]}; }
                else {
                    if (chunk >= 96 && chunk < 104) {
#pragma unroll
                        for (int e = 0; e < 8; ++e) ts[e] = tanhf_(ts[e]); }
                    if (chunk >= 112) {
#pragma unroll
                        for (int e = 0; e < 8; ++e) ts[e] = sigm(ts[e]); }
                    v4u o; o.x = pk2(ts[0], ts[1]); o.y = pk2(ts[2], ts[3]); o.z = pk2(ts[4], ts[5]); o.w = pk2(ts[6], ts[7]);
                    if (chunk < 32) *(v4u*)(RR + (size_t)(row0 + tl) * 256 + c0) = o;
                    else if (chunk < 96) *(v4u*)(VV + (size_t)(row0 + tl) * 256 + (c0 - 512)) = o;
                    else if (chunk < 104) *(v4u*)(twb + tl * 72 + (c0 - 768)) = o;
                    else if (chunk < 112) *(v4u*)(tab + tl * 72 + (c0 - 832)) = o;
                    else *(v4u*)(tgb + tl * 136 + (c0 - 896)) = o; }
            }
        }
        __syncthreads();
        {
            const int tid2 = ltid(); const int ch = tid2 & 255, pt = tid2 >> 8; const float kkc = IN(30)[l * 256 + ch];
#pragma unroll 4
            for (int q = 0; q < 16; ++q) { const int t = pt * 16 + q; const float kr = kl[t * 256 + ch] * kkc; const float nrm = wave_sum(kr * kr);
                const float kk = kr * rsqrtf(fmaxf(nrm, 1e-24f)); kkn[t * 256 + ch] = kk; KKo[(size_t)(row0 + t) * 256 + ch] = (bf16)f2bf(kk); }
        }
        __syncthreads();
        {
            const int tid2 = ltid(); const int ln = tid2 & 63, wv = __builtin_amdgcn_readfirstlane(tid2 >> 6), fr = ln & 15, fq = ln >> 4;
            const bf16* WUPt = (const bf16*)(ws + W_WUP); const bf16* AUPt = (const bf16*)(ws + W_AUP); const bf16* GUPt = (const bf16*)(ws + W_GUP);
            bf16x8 aw[2][2], aa[2][2];
#pragma unroll
            for (int mt = 0; mt < 2; ++mt)
#pragma unroll
                for (int ks = 0; ks < 2; ++ks) { aw[mt][ks] = *(const bf16x8*)(twb + (mt * 16 + fr) * 72 + ks * 32 + fq * 8); aa[mt][ks] = *(const bf16x8*)(tab + (mt * 16 + fr) * 72 + ks * 32 + fq * 8); }
#pragma unroll
            for (int dn = 0; dn < 4; ++dn) { const int d = dn >> 1, nt = wv * 2 + (dn & 1), ch = nt * 16 + fr;
                if (!((mask >> (1 + d)) & 1)) continue;
                f32x4 cw[2], ca[2];
#pragma unroll
                for (int mt = 0; mt < 2; ++mt) { cw[mt] = (f32x4){0.f, 0.f, 0.f, 0.f}; ca[mt] = cw[mt]; }
#pragma unroll
                for (int ks = 0; ks < 2; ++ks) { const bf16x8 bw = *(const bf16x8*)(WUPt + ((size_t)d * 256 + ch) * 64 + ks * 32 + fq * 8), ba = *(const bf16x8*)(AUPt + ((size_t)d * 256 + ch) * 64 + ks * 32 + fq * 8);
#pragma unroll
                    for (int mt = 0; mt < 2; ++mt) { cw[mt] = __builtin_amdgcn_mfma_f32_16x16x32_bf16(aw[mt][ks], bw, cw[mt], 0, 0, 0); ca[mt] = __builtin_amdgcn_mfma_f32_16x16x32_bf16(aa[mt][ks], ba, ca[mt], 0, 0, 0); } }
                const float w0 = IN(25)[(l * 2 + d) * 256 + ch], a0 = IN(27)[(l * 2 + d) * 256 + ch], kac = IN(31)[l * 256 + ch];
                float* WW = (float*)(ws + M_WW) + (size_t)d * NR * 256; bf16* BB = (bf16*)(ws + M_BB + (size_t)d * A8); bf16* KD = (bf16*)(ws + M_KD + (size_t)d * A8);
#pragma unroll
                for (int mt = 0; mt < 2; ++mt)
#pragma unroll
                    for (int j = 0; j < 4; ++j) { const int t = mt * 16 + fq * 4 + j; const size_t o = (size_t)(row0 + t) * 256 + ch;
                        const float e = sigm(w0 + cw[mt][j]) * 0.6065306597126334f;
                        const float av = sigm(a0 + ca[mt][j]);
                        WW[o] = __expf(-e);
                        KD[o] = (bf16)f2bf(kl[t * 256 + ch] * (1.f + (av - 1.f) * kac));
                        BB[o] = (bf16)f2bf(kkn[t * 256 + ch] * av); }
            }
#pragma unroll
            for (int nl = 0; nl < 2; ++nl) { const int ch = (wv * 2 + nl) * 16 + fr;
                if (!(mask & 4)) continue;
                f32x4 cg[2] = {(f32x4){0.f, 0.f, 0.f, 0.f}, (f32x4){0.f, 0.f, 0.f, 0.f}};
#pragma unroll
                for (int ks = 0; ks < 4; ++ks) { const bf16x8 bg = *(const bf16x8*)(GUPt + (size_t)ch * 128 + ks * 32 + fq * 8);
#pragma unroll
                    for (int mt = 0; mt < 2; ++mt) { const bf16x8 ag = *(const bf16x8*)(tgb + (mt * 16 + fr) * 136 + ks * 32 + fq * 8); cg[mt] = __builtin_amdgcn_mfma_f32_16x16x32_bf16(ag, bg, cg[mt], 0, 0, 0); } }
#pragma unroll
                for (int mt = 0; mt < 2; ++mt)
#pragma unroll
                    for (int j = 0; j < 4; ++j) GC[(size_t)(row0 + mt * 16 + fq * 4 + j) * 256 + ch] = (bf16)f2bf(cg[mt][j]);
            }
        }
        __syncthreads();
        }
    }
}

typedef const unsigned cu32;
typedef const float cf32;
__device__ __forceinline__ int chain_row(int b, int d, int tau) {
    return tau < CTXL ? (NLAT + b * CTXL + (d ? CTXL - 1 - tau : tau)) : (b * TLEN + (d ? TLEN - 1 - (tau - CTXL) : (tau - CTXL)));
}
template <int MODE>
__device__ __forceinline__ void rwkv_steps(float (&S)[64], int b, int h, int d, int tau0, int n, unsigned char* ws, int lane, float* wl) {
    const bf16* KKp = (const bf16*)(ws + M_KK); const bf16* RRp = (const bf16*)(ws + M_RR); const bf16* VVp = (const bf16*)(ws + M_VV);
    const float* WWp = (const float*)(ws + M_WW) + (size_t)d * NR * 256; const bf16* BBp = (const bf16*)(ws + M_BB + (size_t)d * A8); const bf16* KDp = (const bf16*)(ws + M_KD + (size_t)d * A8);
    float* YS = (float*)(ws + M_YS) + (size_t)d * NR * 256;
    float pk, pw, pb, pkd = 0.f, pr = 0.f, pv = 0.f; size_t poff;
#define RWKV_LOAD(s_) do { poff = (size_t)chain_row(b, d, tau0 + (s_)) * 256 + h * 64 + lane; pk = bf2f(KKp[poff]); pw = WWp[poff]; pb = bf2f(BBp[poff]); \
        if (MODE != 1) { pkd = bf2f(KDp[poff]); pv = bf2f(VVp[poff]); } if (MODE == 2) pr = bf2f(RRp[poff]); } while (0)
    RWKV_LOAD(0);
    for (int s = 0; s < n; ++s) {
        float* buf = wl + (s & 1) * 320;
        buf[lane] = pk; buf[64 + lane] = pw; buf[128 + lane] = pb;
        if (MODE != 1) buf[192 + lane] = pkd;
        if (MODE == 2) buf[256 + lane] = pr;
        const float vv = pv; const size_t yoff = poff;
        if (s + 1 < n) RWKV_LOAD(s + 1);
        float sa0 = 0.f, sa1 = 0.f, sa2 = 0.f, sa3 = 0.f;
#pragma unroll
        for (int i = 0; i < 64; i += 4) { const f32x4 k4 = *(const f32x4*)(buf + i);
            sa0 += S[i] * k4[0]; sa1 += S[i + 1] * k4[1]; sa2 += S[i + 2] * k4[2]; sa3 += S[i + 3] * k4[3]; }
        const float nsa = -((sa0 + sa1) + (sa2 + sa3));
        float y0 = 0.f, y1 = 0.f, y2 = 0.f, y3 = 0.f;
#pragma unroll
        for (int i = 0; i < 64; i += 4) { const f32x4 w4 = *(const f32x4*)(buf + 64 + i), b4 = *(const f32x4*)(buf + 128 + i);
            f32x4 t = nsa * b4;
            if (MODE != 1) { const f32x4 kd4 = *(const f32x4*)(buf + 192 + i); t += vv * kd4; }
            S[i] = S[i] * w4[0] + t[0]; S[i + 1] = S[i + 1] * w4[1] + t[1]; S[i + 2] = S[i + 2] * w4[2] + t[2]; S[i + 3] = S[i + 3] * w4[3] + t[3];
            if (MODE == 2) { const f32x4 r4 = *(const f32x4*)(buf + 256 + i); y0 += S[i] * r4[0]; y1 += S[i + 1] * r4[1]; y2 += S[i + 2] * r4[2]; y3 += S[i + 3] * r4[3]; } }
        if (MODE == 2) YS[yoff] = (y0 + y1) + (y2 + y3);
    }
#undef RWKV_LOAD
}
typedef float f32x2 __attribute__((ext_vector_type(2)));
__device__ __forceinline__ void rwkv_pass1(f32x2 (&SL)[32], f32x2 (&SI)[32], int b, int h, int d, int tau0, int n, unsigned char* ws, int lane, float* wl) {
    const bf16* KKp = (const bf16*)(ws + M_KK); const bf16* VVp = (const bf16*)(ws + M_VV); const bf16* RRp = (const bf16*)(ws + M_RR);
    const float* WWp = (const float*)(ws + M_WW) + (size_t)d * NR * 256; const bf16* BBp = (const bf16*)(ws + M_BB + (size_t)d * A8); const bf16* KDp = (const bf16*)(ws + M_KD + (size_t)d * A8);
    float* YS = (float*)(ws + M_YS) + (size_t)d * NR * 256; float* PR = (float*)(ws + M_PR) + (size_t)d * NR * 256;
    float pk, pw, pb, pkd, pv, pr; size_t poff;
#define RWKV_LOAD(s_) do { poff = (size_t)chain_row(b, d, tau0 + (s_)) * 256 + h * 64 + lane; pk = bf2f(KKp[poff]); pw = WWp[poff]; pb = bf2f(BBp[poff]); pkd = bf2f(KDp[poff]); pv = bf2f(VVp[poff]); pr = bf2f(RRp[poff]); } while (0)
    RWKV_LOAD(0);
    for (int s = 0; s < n; ++s) {
        float* buf = wl + (s & 1) * 320;
        buf[lane] = pk; buf[64 + lane] = pw; buf[128 + lane] = pb; buf[192 + lane] = pkd; buf[256 + lane] = pr;
        const float vv = pv; const size_t yoff = poff;
        if (s + 1 < n) RWKV_LOAD(s + 1);
        f32x2 aL0 = {0.f, 0.f}, aL1 = aL0, aI0 = aL0, aI1 = aL0;
#pragma unroll
        for (int q = 0; q < 16; ++q) { const f32x4 k4 = *(const f32x4*)(buf + 4 * q);
            aL0 += SL[2 * q] * k4.lo; aL1 += SL[2 * q + 1] * k4.hi; aI0 += SI[2 * q] * k4.lo; aI1 += SI[2 * q + 1] * k4.hi; }
        const f32x2 tL = aL0 + aL1, tI = aI0 + aI1;
        const float nsl = -(tL.x + tL.y), nsi = -(tI.x + tI.y);
        f32x2 yL0 = {0.f, 0.f}, yL1 = yL0, yI0 = yL0, yI1 = yL0;
#pragma unroll
        for (int q = 0; q < 16; ++q) {
            const f32x4 w4 = *(const f32x4*)(buf + 64 + 4 * q), b4 = *(const f32x4*)(buf + 128 + 4 * q), kd4 = *(const f32x4*)(buf + 192 + 4 * q), r4 = *(const f32x4*)(buf + 256 + 4 * q);
            const f32x4 tl = nsl * b4 + vv * kd4, tiv = nsi * b4;
            SL[2 * q] = SL[2 * q] * w4.lo + tl.lo; SL[2 * q + 1] = SL[2 * q + 1] * w4.hi + tl.hi;
            SI[2 * q] = SI[2 * q] * w4.lo + tiv.lo; SI[2 * q + 1] = SI[2 * q + 1] * w4.hi + tiv.hi;
            yL0 += SL[2 * q] * r4.lo; yL1 += SL[2 * q + 1] * r4.hi; yI0 += SI[2 * q] * r4.lo; yI1 += SI[2 * q + 1] * r4.hi; }
        const f32x2 yl = yL0 + yL1, yp = yI0 + yI1;
        YS[yoff] = yl.x + yl.y; PR[yoff] = yp.x + yp.y;
    }
#undef RWKV_LOAD
}
__device__ __forceinline__ void phase_m4(const Args& a, unsigned char* lds, int G, int bid, int tid) {
    const int lane = tid & 63, wave = __builtin_amdgcn_readfirstlane(tid >> 6), half = wave >> 2, tk = wave & 3;
    unsigned char* ws = karg_ws(); float* PL = (float*)(ws + M_PL);
    float* wl = (float*)lds + wave * 320;
    float* xch = (float*)lds + 8 * 320 + tk * 1024;
    float* ych = xch + 512;
    const bf16* KKp = (const bf16*)(ws + M_KK); const bf16* VVp = (const bf16*)(ws + M_VV); const bf16* RRp = (const bf16*)(ws + M_RR);
    for (int task0 = bid * 4; task0 < 16 * NSEG; task0 += G * 4) {
        const int task = task0 + tk; const int seg = task & (NSEG - 1), chain = task >> 6;
        const int d = chain & 1, h = (chain >> 1) & 3, b = chain >> 3;
        const float* WWp = (const float*)(ws + M_WW) + (size_t)d * NR * 256; const bf16* BBp = (const bf16*)(ws + M_BB + (size_t)d * A8); const bf16* KDp = (const bf16*)(ws + M_KD + (size_t)d * A8);
        float* YS = (float*)(ws + M_YS) + (size_t)d * NR * 256; float* PR = (float*)(ws + M_PR) + (size_t)d * NR * 256;
        f32x2 SL[16], SI[16]; int ln = lane; asm volatile("" : "+v"(ln));
#pragma unroll
        for (int i = 0; i < 16; ++i) { SL[i] = (f32x2){0.f, 0.f}; SI[i] = (f32x2){(32 * half + 2 * i == ln) ? 1.f : 0.f, (32 * half + 2 * i + 1 == ln) ? 1.f : 0.f}; }
        const int tau0 = seg * SEGLEN, cidx = h * 64 + 32 * half + (lane & 31);
        unsigned pp; float pw, pv; size_t rowoff, prevoff = 0;
        const int grp = lane >> 4, l15 = lane & 15, l31 = lane & 31;
        const unsigned* srcp = grp == 0 ? (const unsigned*)KKp : grp == 1 ? (const unsigned*)BBp : grp == 2 ? (const unsigned*)KDp : (const unsigned*)RRp;
#define M4_LOAD(s_) do { rowoff = (size_t)chain_row(b, d, tau0 + (s_)) * 256; pp = srcp[(rowoff + h * 64 + 32 * half) / 2 + l15]; \
            pw = (lane < 32) ? WWp[rowoff + cidx] : 0.f; pv = bf2f(VVp[rowoff + h * 64 + lane]); } while (0)
#define UNPK(u_) ((f32x2){__uint_as_float((u_) << 16), __uint_as_float((u_) & 0xffff0000u)})
        M4_LOAD(0);
        for (int s = 0; s < SEGLEN; ++s) {
            float* buf = wl + (s & 1) * 160; const unsigned* bufu = (const unsigned*)buf;
            ((unsigned*)buf)[lane] = pp; if (lane < 32) buf[64 + l31] = pw;
            const float vv = pv; const size_t yoff = rowoff + h * 64 + lane;
            if (s + 1 < SEGLEN) M4_LOAD(s + 1);
            f32x2 aL0 = {0.f, 0.f}, aL1 = aL0, aI0 = aL0, aI1 = aL0;
#pragma unroll
            for (int q = 0; q < 4; ++q) { const v4u k4 = *(const v4u*)(bufu + 4 * q);
                const f32x2 ka = UNPK(k4.x), kb = UNPK(k4.y), kc = UNPK(k4.z), kd_ = UNPK(k4.w);
                aL0 += SL[4 * q] * ka; aL1 += SL[4 * q + 1] * kb; aL0 += SL[4 * q + 2] * kc; aL1 += SL[4 * q + 3] * kd_;
                aI0 += SI[4 * q] * ka; aI1 += SI[4 * q + 1] * kb; aI0 += SI[4 * q + 2] * kc; aI1 += SI[4 * q + 3] * kd_; }
            const f32x2 tL = aL0 + aL1, tI = aI0 + aI1;
            float* xw = xch + (s & 1) * 256;
            xw[half * 128 + lane] = tL.x + tL.y; xw[half * 128 + 64 + lane] = tI.x + tI.y;
            __syncthreads();
            const float nsl = -(xw[lane] + xw[128 + lane]), nsi = -(xw[64 + lane] + xw[192 + lane]);
            if (s > 0) {
                const float* yr = ych + ((s - 1) & 1) * 256;
                if (half == 0) YS[prevoff] = yr[lane] + yr[128 + lane]; else PR[prevoff] = yr[64 + lane] + yr[192 + lane];
            }
            f32x2 yL0 = {0.f, 0.f}, yL1 = yL0, yI0 = yL0, yI1 = yL0;
#pragma unroll
            for (int q = 0; q < 4; ++q) {
                const f32x4 wa = *(const f32x4*)(buf + 64 + 8 * q), wb = *(const f32x4*)(buf + 68 + 8 * q);
                const v4u b4 = *(const v4u*)(bufu + 16 + 4 * q), d4 = *(const v4u*)(bufu + 32 + 4 * q), r4 = *(const v4u*)(bufu + 48 + 4 * q);
                const f32x2 w2[4] = {wa.lo, wa.hi, wb.lo, wb.hi};
                const unsigned bu[4] = {b4.x, b4.y, b4.z, b4.w}, du[4] = {d4.x, d4.y, d4.z, d4.w}, ru[4] = {r4.x, r4.y, r4.z, r4.w};
#pragma unroll
                for (int e = 0; e < 4; ++e) { const int j = 4 * q + e; const f32x2 b2 = UNPK(bu[e]), k2 = UNPK(du[e]), r2 = UNPK(ru[e]);
                    const f32x2 tl = nsl * b2 + vv * k2, tiv = nsi * b2;
                    SL[j] = SL[j] * w2[e] + tl; SI[j] = SI[j] * w2[e] + tiv;
                    if (e & 1) { yL1 += SL[j] * r2; yI1 += SI[j] * r2; } else { yL0 += SL[j] * r2; yI0 += SI[j] * r2; } }
            }
            const f32x2 yl = yL0 + yL1, yp = yI0 + yI1;
            float* yw = ych + (s & 1) * 256;
            yw[half * 128 + lane] = yl.x + yl.y; yw[half * 128 + 64 + lane] = yp.x + yp.y;
            prevoff = yoff;
        }
#undef M4_LOAD
#undef UNPK
        __syncthreads();
        { const float* yr = ych + ((SEGLEN - 1) & 1) * 256;
          if (half == 0) YS[prevoff] = yr[lane] + yr[128 + lane]; else PR[prevoff] = yr[64 + lane] + yr[192 + lane]; }
        float* o = PL + (((size_t)(chain * NSEG + seg) * 2) * 64 + lane) * 64 + 32 * half;
#pragma unroll
        for (int i = 0; i < 16; i += 2) { *(f32x4*)(o + 2 * i) = (f32x4){SL[i].x, SL[i].y, SL[i + 1].x, SL[i + 1].y}; *(f32x4*)(o + 4096 + 2 * i) = (f32x4){SI[i].x, SI[i].y, SI[i + 1].x, SI[i + 1].y}; }
        __syncthreads();
    }
}
__device__ __forceinline__ void phase_m5(const Args& a, unsigned char* lds, int G, int bid, int tid) {
    unsigned char* ws = karg_ws(); const float* PL = (const float*)(ws + M_PL); float* SI = (float*)(ws + M_SINIT);
    float* Sx = (float*)lds;
    const int lane = tid & 63, wv = __builtin_amdgcn_readfirstlane(tid >> 6), fr = lane & 15, fq = lane >> 4;
    const bool act = wv < 4;
    for (int u = bid; u < 64; u += G) {
        const int chain = u >> 2, row0 = (u & 3) * 16, col = (wv & 3) * 16 + fr;
        const float* Pg = PL + ((size_t)(chain * NSEG) * 2 + 1) * 4096; const float* Lg = PL + ((size_t)(chain * NSEG) * 2) * 4096;
        float* SIc = SI + (size_t)(chain * NSEG) * 4096;
        f32x4 cur = {0.f, 0.f, 0.f, 0.f}; f32x4 lv[3]; float pb[3][16];
#pragma unroll
        for (int q = 0; q < 3; ++q) { lv[q] = cur;
            if (act) { const float* Pn = Pg + (size_t)q * 8192; const float* Ln = Lg + (size_t)q * 8192;
#pragma unroll
                for (int ks = 0; ks < 16; ++ks) pb[q][ks] = Pn[(4 * ks + fq) * 64 + col];
#pragma unroll
                for (int j = 0; j < 4; ++j) lv[q][j] = Ln[(row0 + fq * 4 + j) * 64 + col]; } }
        for (int g0 = 0; g0 < NSEG - 1; g0 += 3) {
#pragma unroll
            for (int q = 0; q < 3; ++q) { const int g = g0 + q;
                if (act) {
#pragma unroll
                    for (int j = 0; j < 4; ++j) { SIc[(size_t)g * 4096 + (row0 + fq * 4 + j) * 64 + col] = cur[j]; Sx[(fq * 4 + j) * 68 + col] = cur[j]; }
                }
                __syncthreads();
                if (act) {
                    f32x4 acc = lv[q];
#pragma unroll
                    for (int ks = 0; ks < 16; ++ks) { const float av = Sx[fr * 68 + 4 * ks + fq]; acc = __builtin_amdgcn_mfma_f32_16x16x4f32(av, pb[q][ks], acc, 0, 0, 0); }
                    cur = acc;
                    if (g + 3 < NSEG - 1) { const float* Pn = Pg + (size_t)(g + 3) * 8192; const float* Ln = Lg + (size_t)(g + 3) * 8192;
#pragma unroll
                        for (int ks = 0; ks < 16; ++ks) pb[q][ks] = Pn[(4 * ks + fq) * 64 + col];
#pragma unroll
                        for (int j = 0; j < 4; ++j) lv[q][j] = Ln[(row0 + fq * 4 + j) * 64 + col]; }
                }
                __syncthreads();
            }
        }
        if (act) {
#pragma unroll
            for (int j = 0; j < 4; ++j) SIc[(size_t)(NSEG - 1) * 4096 + (row0 + fq * 4 + j) * 64 + col] = cur[j];
        }
    }
}
__device__ __forceinline__ void phase_m6(const Args& a, unsigned char* lds, int G, int bid, int tid) {
    const int lane = tid & 63, wave = __builtin_amdgcn_readfirstlane(tid >> 6);
    unsigned char* ws = karg_ws(); const float* SI = (const float*)(ws + M_SINIT);
    float* wl = (float*)lds + wave * 256;
    for (int task = wave * G + bid; task < 16 * (NSEG - 1); task += G * 8) {
        const int seg = 1 + task % (NSEG - 1), chain = task / (NSEG - 1);
        const int d = chain & 1, h = (chain >> 1) & 3, b = chain >> 3;
        float* YS = (float*)(ws + M_YS) + (size_t)d * NR * 256; const float* PR = (const float*)(ws + M_PR) + (size_t)d * NR * 256;
        f32x2 S0[32];
        const float* si = SI + ((size_t)(chain * NSEG + seg) * 64 + lane) * 64;
#pragma unroll
        for (int i = 0; i < 32; i += 2) { const f32x4 v = *(const f32x4*)(si + 2 * i); S0[i] = v.lo; S0[i + 1] = v.hi; }
        const int tau0 = seg * SEGLEN;
        size_t o[4]; float p[4], y[4];
#pragma unroll
        for (int k = 0; k < 4; ++k) { o[k] = (size_t)chain_row(b, d, tau0 + k) * 256 + h * 64 + lane; p[k] = PR[o[k]]; y[k] = YS[o[k]]; }
        for (int s = 0; s < SEGLEN; s += 4) {
            size_t c[4]; float yy[4];
#pragma unroll
            for (int k = 0; k < 4; ++k) { wl[k * 64 + lane] = p[k]; c[k] = o[k]; yy[k] = y[k]; }
            if (s + 4 < SEGLEN) {
#pragma unroll
                for (int k = 0; k < 4; ++k) { o[k] = (size_t)chain_row(b, d, tau0 + s + 4 + k) * 256 + h * 64 + lane; p[k] = PR[o[k]]; y[k] = YS[o[k]]; } }
#pragma unroll
            for (int k = 0; k < 4; k += 2) {
                f32x2 a0 = {0.f, 0.f}, a1 = a0, b0 = a0, b1 = a0;
#pragma unroll
                for (int q = 0; q < 16; ++q) { const f32x4 u = *(const f32x4*)(wl + k * 64 + 4 * q), w = *(const f32x4*)(wl + (k + 1) * 64 + 4 * q);
                    a0 += S0[2 * q] * u.lo; a1 += S0[2 * q + 1] * u.hi; b0 += S0[2 * q] * w.lo; b1 += S0[2 * q + 1] * w.hi; }
                const f32x2 ta = a0 + a1, tb = b0 + b1;
                yy[k] += ta.x + ta.y; yy[k + 1] += tb.x + tb.y;
            }
#pragma unroll
            for (int k = 0; k < 4; ++k) YS[c[k]] = yy[k];
            asm volatile("" ::: "memory");
        }
    }
}
__device__ __forceinline__ void phase_m7(const Args& a, int l, int gw, int NGW, int lane) {
    unsigned char* ws = karg_ws();
    const float* Y0 = (const float*)(ws + M_YS); const float* Y1 = Y0 + (size_t)NR * 256;
    const bf16* RR = (const bf16*)(ws + M_RR); const bf16* VV = (const bf16*)(ws + M_VV); const bf16* KD0 = (const bf16*)(ws + M_KD); const bf16* KD1 = (const bf16*)(ws + M_KD + A8);
    const bf16* GC = (const bf16*)(ws + M_GC); bf16* Y = (bf16*)(ws + OFF_XMY);
    for (int r = gw; r < NR; r += NGW) {
#pragma unroll
        for (int h = 0; h < 4; ++h) { const int c = h * 64 + lane; const size_t o = (size_t)r * 256 + c;
            const float ys = Y0[o] + Y1[o];
            const float mu = wave_sum(ys) * (1.f / 64.f); const float dv = ys - mu; const float var = wave_sum(dv * dv) * (1.f / 64.f);
            float ov = dv * rsqrtf(var + 64e-5f) * IN(33)[l * 256 + c] + IN(34)[l * 256 + c];
            const float rv = bf2f(RR[o]), rk = IN(32)[l * 256 + c], vv = bf2f(VV[o]);
            const float b0 = wave_sum(rv * bf2f(KD0[o]) * rk), b1 = wave_sum(rv * bf2f(KD1[o]) * rk);
            ov += (b0 + b1) * vv;
            Y[(size_t)r * DM + 512 + c] = (bf16)f2bf(ov * bf2f(GC[o])); }
    }
}

#define LAS __attribute__((address_space(3)))
#define XB_TMO      128
#define XB_XCNT(j)  (256  + 64 * (j))
#define XB_XSUB(j)  (1280 + 64 * (j))
#define XB_XGEN(j)  (2304 + 64 * (j))
#define XB_TOP      3328
#define XB_TOPGEN   3392
#define XCD_BAR_WORDS 3456
#define XB_SPIN_CAP (1u << 18)

__device__ __forceinline__ unsigned xb_ld(unsigned* p)              { return __hip_atomic_load(p, __ATOMIC_RELAXED, __HIP_MEMORY_SCOPE_AGENT); }
__device__ __forceinline__ unsigned xb_add(unsigned* p, unsigned v) { return __hip_atomic_fetch_add(p, v, __ATOMIC_RELAXED, __HIP_MEMORY_SCOPE_AGENT); }
__device__ __forceinline__ unsigned xb_xcc_id() { return (unsigned)__builtin_amdgcn_s_getreg((3 << 11) | 20) & 0xFu; }
#define XB_SPIN(cond, bar) do { unsigned _sp = 0; while (cond) { __builtin_amdgcn_s_sleep(1); \
    if ((++_sp & 255u) == 0u) { if (xb_ld(&(bar)[XB_TMO])) break; if (_sp > XB_SPIN_CAP) { atomicAdd(&(bar)[XB_TMO], 1u); break; } } } } while (0)

struct XcdBarrier {
    unsigned* bar; unsigned x;
    volatile LAS unsigned* st;
};

__device__ __forceinline__ XcdBarrier xcd_barrier_post(unsigned* bar, volatile LAS unsigned* st) {
    XcdBarrier b; b.bar = bar; b.x = xb_xcc_id(); b.st = st;
    if (threadIdx.x == 0) (void)xb_add(&bar[XB_XCNT(b.x)], 1u);
    return b;
}
__device__ __forceinline__ void xcd_barrier_complete(unsigned* bar, unsigned x, unsigned& nloc, unsigned& nx) {
    const unsigned G = gridDim.x * gridDim.y * gridDim.z;
    unsigned sum, cnt, mine, sp = 0u;
    for (;;) {
        sum = 0u; cnt = 0u; mine = 0u;
#pragma unroll
        for (unsigned j = 0; j < 16; ++j) { const unsigned c = xb_ld(&bar[XB_XCNT(j)]); sum += c; cnt += (c > 0u) ? 1u : 0u; mine = (j == x) ? c : mine; }
        if (sum == G) break;
        __builtin_amdgcn_s_sleep(1);
        if ((++sp & 255u) == 0u) { if (xb_ld(&bar[XB_TMO])) break; if (sp > XB_SPIN_CAP) { atomicAdd(&bar[XB_TMO], 1u); break; } }
    }
    nloc = mine > 0u ? mine : 1u; nx = cnt > 0u ? cnt : 1u;
}

__device__ __forceinline__ void xcd_barrier(const XcdBarrier& b) {
    asm volatile("s_waitcnt vmcnt(0)" ::: "memory");
    __syncthreads();
    if (threadIdx.x == 0) {
        unsigned* bar = b.bar;
        __builtin_amdgcn_s_waitcnt(0);
        unsigned nloc = b.st[0], nx = b.st[1];
        if (nloc == 0u) { xcd_barrier_complete(bar, b.x, nloc, nx); b.st[0] = nloc; b.st[1] = nx; }
        const unsigned old = xb_add(&bar[XB_XSUB(b.x)], 1u);
        const unsigned gen = old / nloc;
        if (old + 1u == (gen + 1u) * nloc) {
            __builtin_amdgcn_fence(__ATOMIC_RELEASE, "agent");
            asm volatile("s_waitcnt vmcnt(0)" ::: "memory");
            const unsigned og = xb_add(&bar[XB_TOP], 1u);
            const unsigned tg = og / nx;
            if (og + 1u == (tg + 1u) * nx) xb_add(&bar[XB_TOPGEN], 1u);
            else XB_SPIN(xb_ld(&bar[XB_TOPGEN]) == tg, bar);
            __builtin_amdgcn_fence(__ATOMIC_ACQUIRE, "agent");
            xb_add(&bar[XB_XGEN(b.x)], 1u);
            asm volatile("s_waitcnt vmcnt(0)" ::: "memory");
        } else {
            XB_SPIN(xb_ld(&bar[XB_XGEN(b.x)]) == gen, bar);
            __builtin_amdgcn_fence(__ATOMIC_ACQUIRE, "agent");
            asm volatile("s_waitcnt vmcnt(0)" ::: "memory");
        }
    }
    __syncthreads();
}

__global__ void __launch_bounds__(512, 2) mega(Args a) {
    extern __shared__ __attribute__((aligned(16))) unsigned char lds[];
    cg::grid_group grid = cg::this_grid();
    const int G = gridDim.x;
    PG8_LAS unsigned char* glds = (PG8_LAS unsigned char*)lds;
#define bid lbid()
#define tid ltid()
#define lane (ltid() & 63)
#define wave (__builtin_amdgcn_readfirstlane(ltid() >> 6))
#define gw (lbid() * 8 + __builtin_amdgcn_readfirstlane(ltid() >> 6))
#define NGW (G * 8)
    { volatile LAS unsigned* st0 = (volatile LAS unsigned*)((LAS unsigned char*)lds + 131072); if (threadIdx.x < 4) st0[threadIdx.x] = 0u; }
    __syncthreads();
    const XcdBarrier xbar = xcd_barrier_post((unsigned*)(karg_ws() + 229376), (volatile LAS unsigned*)((LAS unsigned char*)lds + 131072));
#define GSYNC() do { xcd_barrier(xbar); } while (0)

    phase_modgemv(a, (float*)lds, G, bid, tid);
    convert_weights(a, 0, (float*)(lds + 32768) + wave * (64 * 33), gw, NGW, lane, G, bid, tid);
    if (G == 0x7fffffff) grid.sync();
    GSYNC();
#pragma clang loop unroll(full)
    for (int l = 0; l < 2; ++l) {
        if (l > 0) convert_weights(a, l, (float*)lds + wave * (64 * 33), gw, NGW, lane, G, bid, tid);
        phase_modulate(a, l, 0, gw, NGW, lane);
        GSYNC();
        for (int rp = 0; rp < REP_G1; ++rp)
        {
            unsigned char* ws = karg_ws(); float* outp = karg_out(); float* xctx = (float*)(ws + OFF_XCTX); bf16* XM = (bf16*)(ws + OFF_XMY); bf16* HU = (bf16*)(ws + OFF_HU); const float* modl = (const float*)(ws + OFF_MOD) + (size_t)l * 3 * 9216; (void)xctx; (void)XM; (void)HU; (void)modl; (void)outp;
            pg8::Gemm g{XM, (const bf16*)(ws + W_13A), NR, 2 * DFF, DM}; pg8::StaticOrder S; S.init(NR, 2 * DFF, G, bid);
            EpiSwiglu E{HU};
            pg8::gemm_phase<EpiSwiglu, pg8::StaticOrder, true, true>(glds, g, S, E);
        }
        GSYNC();
        {
            unsigned char* ws = karg_ws(); float* outp = karg_out(); float* xctx = (float*)(ws + OFF_XCTX); bf16* XM = (bf16*)(ws + OFF_XMY); bf16* HU = (bf16*)(ws + OFF_HU); const float* modl = (const float*)(ws + OFF_MOD) + (size_t)l * 3 * 9216; (void)xctx; (void)XM; (void)HU; (void)modl; (void)outp;
            pg8::Gemm g{HU, (const bf16*)(ws + W_2A), NR, DM, DFF}; pg8::StaticOrder S; S.init(NR, DM, G, bid);
            EpiResid E{outp, xctx, modl + 2 * 1024, 0.5f, l == 0 ? IN(0) : outp, l == 0 ? IN(2) : xctx};
            pg8::gemm_phase<EpiResid, pg8::StaticOrder, true, true>(glds, g, S, E);
        }
        GSYNC();
        phase_modulate(a, l, 1, gw, NGW, lane);
        GSYNC();
        {
            unsigned char* ws = karg_ws(); float* outp = karg_out(); float* xctx = (float*)(ws + OFF_XCTX); bf16* XM = (bf16*)(ws + OFF_XMY); bf16* HU = (bf16*)(ws + OFF_HU); const float* modl = (const float*)(ws + OFF_MOD) + (size_t)l * 3 * 9216; (void)xctx; (void)XM; (void)HU; (void)modl; (void)outp;
            pg8::Gemm g{XM, (const bf16*)(ws + W_IN), NR, UC, DM}; pg8::StaticOrder S; S.init(NR, UC, G, bid);
            EpiU E{HU, UC};
            pg8::gemm_phase<EpiU, pg8::StaticOrder, true, true>(glds, g, S, E);
        }
        GSYNC();
        for (int rp = 0; rp < REP_M1; ++rp) { phase_m1(a, l, lds, G, bid, tid);
        GSYNC(); }
        for (int rp = 0; rp < REP_M2; ++rp) { phase_m2(a, l, lds, G, bid, tid);
        GSYNC(); }
        for (int rp = 0; rp < REP_M3; ++rp) { phase_m3(a, l, lds, G, bid, tid);
        GSYNC(); }
        for (int rp = 0; rp < REP_SCAN; ++rp) { phase_m4(a, lds, G, bid, tid);
        GSYNC();
        phase_m5(a, lds, G, bid, tid);
        GSYNC();
        phase_m6(a, lds, G, bid, tid);
        GSYNC(); }
        phase_m7(a, l, gw, NGW, lane);
        GSYNC();
        {
            unsigned char* ws = karg_ws(); float* outp = karg_out(); float* xctx = (float*)(ws + OFF_XCTX); bf16* XM = (bf16*)(ws + OFF_XMY); bf16* HU = (bf16*)(ws + OFF_HU); const float* modl = (const float*)(ws + OFF_MOD) + (size_t)l * 3 * 9216; (void)xctx; (void)XM; (void)HU; (void)modl; (void)outp;
            const int MR = (l == 1) ? NLAT : NR;
            pg8::Gemm g{XM, (const bf16*)(ws + W_OUT), MR, DM, DM}; pg8::StaticOrder S; S.init(MR, DM, G, bid);
            EpiResid E{outp, xctx, modl + 5 * 1024, 1.0f, outp, xctx};
            pg8::gemm_phase<EpiResid, pg8::StaticOrder, true, true>(glds, g, S, E);
        }
        GSYNC();
        phase_modulate(a, l, 2, gw, NGW, lane);
        GSYNC();
        {
            unsigned char* ws = karg_ws(); float* outp = karg_out(); float* xctx = (float*)(ws + OFF_XCTX); bf16* XM = (bf16*)(ws + OFF_XMY); bf16* HU = (bf16*)(ws + OFF_HU); const float* modl = (const float*)(ws + OFF_MOD) + (size_t)l * 3 * 9216; (void)xctx; (void)XM; (void)HU; (void)modl; (void)outp;
            const int MR = (l == 1) ? NLAT : NR;
            pg8::Gemm g{XM, (const bf16*)(ws + W_13B), MR, 2 * DFF, DM}; pg8::StaticOrder S; S.init(MR, 2 * DFF, G, bid);
            EpiSwiglu E{HU};
            pg8::gemm_phase<EpiSwiglu, pg8::StaticOrder, true, true>(glds, g, S, E);
        }
        GSYNC();
        {
            unsigned char* ws = karg_ws(); float* outp = karg_out(); float* xctx = (float*)(ws + OFF_XCTX); bf16* XM = (bf16*)(ws + OFF_XMY); bf16* HU = (bf16*)(ws + OFF_HU); const float* modl = (const float*)(ws + OFF_MOD) + (size_t)l * 3 * 9216; (void)xctx; (void)XM; (void)HU; (void)modl; (void)outp;
            const int MR = (l == 1) ? NLAT : NR;
            pg8::Gemm g{HU, (const bf16*)(ws + W_2B), MR, DM, DFF}; pg8::StaticOrder S; S.init(MR, DM, G, bid);
            EpiResid E{outp, xctx, modl + 8 * 1024, 0.5f, outp, xctx};
            pg8::gemm_phase<EpiResid, pg8::StaticOrder, true, true>(glds, g, S, E);
        }
        GSYNC();
    }
    phase_final(a, gw, NGW, lane);
#undef bid
#undef tid
#undef lane
#undef wave
#undef gw
#undef NGW
}

extern "C" void kernel_launch(void* const* d_in, const int* in_sizes, int n_in, void* d_out, int out_size, void* d_ws, size_t ws_size, hipStream_t stream) {
    static int grid = 0;
    if (grid == 0) {
        int dev = 0, cus = 0, per_cu = 0;
        (void)hipGetDevice(&dev);
        (void)hipDeviceGetAttribute(&cus, hipDeviceAttributeMultiprocessorCount, dev);
        (void)hipFuncSetAttribute((const void*)mega, hipFuncAttributeMaxDynamicSharedMemorySize, LDS_BYTES);
        (void)hipOccupancyMaxActiveBlocksPerMultiprocessor(&per_cu, (const void*)mega, 512, LDS_BYTES);
        if (per_cu < 1) per_cu = 1;
        grid = cus * per_cu;
        if (n_in != 40 || ws_size < WS_NEED) { fprintf(stderr, "kernel_launch: unexpected n_in %d / ws %zu (need %zu)\n", n_in, ws_size, (size_t)WS_NEED); }
    }
    (void)hipMemsetAsync((char*)d_ws + OFF_MOD, 0, MOD_BYTES, stream);
    Args a{};
    for (int i = 0; i < 40; ++i) a.in[i] = (const float*)d_in[i];
    a.out = (float*)d_out; a.ws = (unsigned char*)d_ws;
    void* args[] = {&a};
    hipError_t e = hipLaunchCooperativeKernel((const void*)mega, dim3(grid), dim3(512), args, LDS_BYTES, stream);
    if (e != hipSuccess) fprintf(stderr, "cooperative launch failed: %s (grid %d)\n", hipGetErrorString(e), grid);
}
```
